# Optimizing an MI355X kernel written in HIP

```python
import jax
import jax.numpy as jnp
from jax import lax
import numpy as np

D_MODEL = 1024
BATCH = 4
SEQ = 4096
DEPTH = 2

CTX_LEN = 256
GRID_W = 64
HEAD_DIM = 64
GROUP_W = D_MODEL // 4
N_FOURIER_HEADS = GROUP_W // HEAD_DIM
N_Q_HEADS = GROUP_W // HEAD_DIM
N_KV_HEADS = 2
Q_PER_KV = N_Q_HEADS // N_KV_HEADS
KV_W = N_KV_HEADS * HEAD_DIM
WINDOW = 128
ATTN_BLOCK = 128
POOL_WINDOWS = (2, 4, 8, 16)
POOL_CH = GROUP_W // len(POOL_WINDOWS)
N_SGU_HEADS = 4
SGU_HEAD = GROUP_W // N_SGU_HEADS
SGU_CHUNK = 128
N_EXPERT_GROUPS = 4
EXPERTS_PER_GROUP = 8
N_EXPERTS = N_EXPERT_GROUPS * EXPERTS_PER_GROUP
TOP_K_FINE = 2
D_EXPERT = D_MODEL // 2
MOE_BLOCK = 128
ROPE_BASE = 10000.0
LN_EPS = 1e-6
NEG_INF = -1e30
RES_ALPHA = (2 * DEPTH) ** 0.25
INIT_BETA = (8 * DEPTH) ** -0.25

COL_FOURIER = 0
COL_Q = COL_FOURIER + GROUP_W
COL_K = COL_Q + N_Q_HEADS * HEAD_DIM
COL_V = COL_K + KV_W
COL_POOL = COL_V + KV_W
COL_U = COL_POOL + GROUP_W
COL_G = COL_U + GROUP_W
D_IN = COL_G + GROUP_W

kernel_name = 'hybrid_parallel_heads_flow_backbone'


def layer_norm(t, gain=None, bias=None):
    tf = t.astype(jnp.float32)
    mu = tf.mean(-1, keepdims=True)
    var = jnp.square(tf - mu).mean(-1, keepdims=True)
    y = (tf - mu) * lax.rsqrt(var + LN_EPS)
    if gain is not None:
        y = y * gain.astype(jnp.float32) + bias.astype(jnp.float32)
    return y.astype(t.dtype)


def modulate(t, shift, scale):
    return layer_norm(t) * (1 + scale) + shift


def axial_rope_tables(n_tokens):
    rows = n_tokens // GRID_W
    row = jnp.repeat(jnp.arange(rows), GRID_W).astype(jnp.float32)
    col = jnp.tile(jnp.arange(GRID_W), rows).astype(jnp.float32)
    n_freq = HEAD_DIM // 4
    freq = ROPE_BASE ** (-jnp.arange(n_freq, dtype=jnp.float32) / n_freq)
    ang = jnp.stack([row[:, None] * freq, col[:, None] * freq], axis=1)
    return jnp.cos(ang), jnp.sin(ang)


def apply_axial_rope(t, cos, sin):
    b, s, h, d = t.shape
    tf = t.astype(jnp.float32).reshape(b, s, h, 2, 2, d // 4)
    c = cos[None, :, None]
    sn = sin[None, :, None]
    t1, t2 = tf[..., 0, :], tf[..., 1, :]
    out = jnp.stack([t1 * c - t2 * sn, t1 * sn + t2 * c], axis=-2)
    return out.reshape(b, s, h, d).astype(t.dtype)


def to_heads(t, n_heads):
    return t.reshape(t.shape[0], t.shape[1], n_heads, HEAD_DIM)


def split_projection(z):
    return (z[..., COL_FOURIER:COL_Q],
            to_heads(z[..., COL_Q:COL_K], N_Q_HEADS),
            to_heads(z[..., COL_K:COL_V], N_KV_HEADS),
            to_heads(z[..., COL_V:COL_POOL], N_KV_HEADS),
            z[..., COL_POOL:COL_U],
            z[..., COL_U:COL_G],
            z[..., COL_G:D_IN])


def fourier_mix(a, w_fourier):
    b, n, _ = a.shape
    ah = a.astype(jnp.float32).reshape(b, n, N_FOURIER_HEADS, HEAD_DIM)
    f = jnp.fft.fft2(ah, axes=(1, 3), norm='ortho').real
    return f.reshape(b, n, GROUP_W).astype(a.dtype) @ w_fourier


def pool_mix(p, w_pool, pool_scale):
    b, n, _ = p.shape
    pf = p.astype(jnp.float32)
    cs = jnp.pad(jnp.cumsum(pf, axis=1), ((0, 0), (1, 0), (0, 0)))
    pos = jnp.arange(n)
    means = []
    for g, w in enumerate(POOL_WINDOWS):
        lo = jnp.clip(pos - w // 2, 0, n)
        hi = jnp.clip(pos + w // 2, 0, n)
        csg = cs[..., g * POOL_CH:(g + 1) * POOL_CH]
        means.append((csg[:, hi] - csg[:, lo]) / (hi - lo).astype(jnp.float32)[:, None])
    pooled = jnp.stack(means, axis=2) - pf.reshape(b, n, len(POOL_WINDOWS), POOL_CH)
    mixed = jnp.einsum('bngc,gcd->bngd', pooled.astype(p.dtype), w_pool)
    return mixed.reshape(b, n, GROUP_W) * pool_scale


def spatial_gating(u, g, w_sgu, b_sgu):
    b, n, _ = u.shape
    u = jax.nn.gelu(u, approximate=False)
    v = layer_norm(jax.nn.gelu(g, approximate=False))
    vh = v.reshape(b, n // SGU_CHUNK, SGU_CHUNK, N_SGU_HEADS, SGU_HEAD)
    mixed = jnp.einsum('hpq,bcqhd->bcphd', w_sgu, vh) + b_sgu.T[None, None, :, :, None]
    return u * mixed.reshape(b, n, GROUP_W)


def window_attention(q, k, v, kc, vc, sink):
    b, s, _, d = q.shape
    nb = s // ATTN_BLOCK
    n_ctx = kc.shape[1]
    scale = d ** -0.5
    qb = q.reshape(b, nb, ATTN_BLOCK, N_KV_HEADS, Q_PER_KV, d)

    def band(t):
        tp = jnp.pad(t, ((0, 0), (ATTN_BLOCK, ATTN_BLOCK), (0, 0), (0, 0)))
        tp = tp.reshape(b, nb + 2, ATTN_BLOCK, N_KV_HEADS, d)
        return jnp.concatenate([tp[:, :-2], tp[:, 1:-1], tp[:, 2:]], axis=2)

    kw, vw = band(k), band(v)
    s_loc = jnp.einsum('bnikgd,bnjkd->bnkgij', qb, kw).astype(jnp.float32) * scale
    s_ctx = jnp.einsum('bnikgd,bckd->bnkgic', qb, kc).astype(jnp.float32) * scale
    blk = jnp.arange(nb)[:, None, None]
    qpos = blk * ATTN_BLOCK + jnp.arange(ATTN_BLOCK)[None, :, None]
    kpos = (blk - 1) * ATTN_BLOCK + jnp.arange(3 * ATTN_BLOCK)[None, None, :]
    valid = (jnp.abs(qpos - kpos) <= WINDOW) & (kpos >= 0) & (kpos < s)
    s_loc = jnp.where(valid[None, :, None, None], s_loc, NEG_INF)
    sink_l = jnp.broadcast_to(
        sink.astype(jnp.float32).reshape(N_KV_HEADS, Q_PER_KV)[None, None, :, :, None, None],
        s_loc.shape[:-1] + (1,))
    probs = jax.nn.softmax(jnp.concatenate([s_loc, s_ctx, sink_l], axis=-1), axis=-1)
    n_loc = 3 * ATTN_BLOCK
    o = (jnp.einsum('bnkgij,bnjkd->bnikgd', probs[..., :n_loc].astype(v.dtype), vw)
         + jnp.einsum('bnkgic,bckd->bnikgd', probs[..., n_loc:n_loc + n_ctx].astype(vc.dtype), vc))
    return o.reshape(b, s, N_Q_HEADS * d)


def context_attention(qc, kc, vc, sink):
    b, n_ctx, _, d = qc.shape
    qg = qc.reshape(b, n_ctx, N_KV_HEADS, Q_PER_KV, d)
    sc = jnp.einsum('bikgd,bjkd->bkgij', qg, kc).astype(jnp.float32) * (d ** -0.5)
    sink_c = jnp.broadcast_to(
        sink.astype(jnp.float32).reshape(N_KV_HEADS, Q_PER_KV)[None, :, :, None, None],
        sc.shape[:-1] + (1,))
    probs = jax.nn.softmax(jnp.concatenate([sc, sink_c], axis=-1), axis=-1)
    o = jnp.einsum('bkgij,bjkd->bikgd', probs[..., :n_ctx].astype(vc.dtype), vc)
    return o.reshape(b, n_ctx, N_Q_HEADS * d)


def merge_groups(a, y_attn, p, u, g, w_fourier, w_pool, pool_scale, w_sgu, b_sgu, w_out):
    y_four = fourier_mix(a, w_fourier)
    y_pool = pool_mix(p, w_pool, pool_scale)
    y_sgu = spatial_gating(u, g, w_sgu, b_sgu)
    return jnp.concatenate([y_four, y_attn, y_pool, y_sgu], axis=-1) @ w_out


def parallel_mixers(h, hc, w_in, w_fourier, sink, w_pool, pool_scale, w_sgu, b_sgu, w_out,
                    rope_cos, rope_sin, ctx_out):
    a, q, k, v, p, u, g = split_projection(h @ w_in)
    q = apply_axial_rope(q, rope_cos, rope_sin)
    k = apply_axial_rope(k, rope_cos, rope_sin)
    if ctx_out:
        ac, qc, kc, vc, pc, uc, gc = split_projection(hc @ w_in)
    else:
        kvc = hc @ w_in[:, COL_K:COL_POOL]
        kc = to_heads(kvc[..., :KV_W], N_KV_HEADS)
        vc = to_heads(kvc[..., KV_W:], N_KV_HEADS)
    y_attn = window_attention(q, k, v, kc, vc, sink)
    y = merge_groups(a, y_attn, p, u, g, w_fourier, w_pool, pool_scale, w_sgu, b_sgu, w_out)
    if not ctx_out:
        return y, None
    yc_attn = context_attention(qc, kc, vc, sink)
    yc = merge_groups(ac, yc_attn, pc, uc, gc, w_fourier, w_pool, pool_scale, w_sgu, b_sgu, w_out)
    return y, yc


def grouped_experts(t, expert_idx, gates, w_gate, w_up, w_down):
    n_tok, d = t.shape
    k = expert_idx.shape[1]
    n_exp = w_gate.shape[0]
    flat_e = expert_idx.reshape(-1)
    order = jnp.argsort(flat_e)
    se = flat_e[order]
    counts = jnp.bincount(flat_e, length=n_exp)
    padded = (counts + MOE_BLOCK - 1) // MOE_BLOCK * MOE_BLOCK
    pad_end = jnp.cumsum(padded)
    pad_start = pad_end - padded
    start = jnp.cumsum(counts) - counts
    dest = pad_start[se] + jnp.arange(n_tok * k) - start[se]
    n_blocks = -(-(n_tok * k) // MOE_BLOCK) + n_exp
    rows = n_blocks * MOE_BLOCK
    slot_tok = jnp.full((rows,), n_tok, jnp.int32).at[dest].set((order // k).astype(jnp.int32))
    slot_gate = jnp.zeros((rows,), jnp.float32).at[dest].set(gates.reshape(-1)[order])
    block_e = jnp.minimum(jnp.searchsorted(pad_end, jnp.arange(n_blocks) * MOE_BLOCK, side='right'),
                          n_exp - 1)
    t_pad = jnp.concatenate([t, jnp.zeros((1, d), t.dtype)], axis=0)
    xb = t_pad[slot_tok].reshape(n_blocks, MOE_BLOCK, d)

    def expert_block(args):
        xblk, e = args
        hid = jax.nn.silu(xblk @ w_gate[e]) * (xblk @ w_up[e])
        return hid @ w_down[e]

    yb = lax.map(expert_block, (xb, block_e)).reshape(rows, d)
    out = jnp.zeros((n_tok + 1, d), t.dtype).at[slot_tok].add(yb * slot_gate[:, None].astype(yb.dtype))
    return out[:n_tok]


def hier_moe(t, w_router_group, w_router_expert, w_exp_gate, w_exp_up, w_exp_down):
    p_group = jax.nn.softmax((t @ w_router_group).astype(jnp.float32), axis=-1)
    grp = jnp.argmax(p_group, axis=-1).astype(jnp.int32)
    gate_group = jnp.take_along_axis(p_group, grp[:, None], axis=-1)
    logits_e = jnp.einsum('td,dge->tge', t, w_router_expert).astype(jnp.float32)
    logits_sel = jnp.take_along_axis(logits_e, grp[:, None, None], axis=1)[:, 0]
    top_p, top_j = lax.top_k(jax.nn.softmax(logits_sel, axis=-1), TOP_K_FINE)
    top_p = top_p / top_p.sum(-1, keepdims=True)
    expert_idx = grp[:, None] * EXPERTS_PER_GROUP + top_j.astype(jnp.int32)
    return grouped_experts(t, expert_idx, gate_group * top_p, w_exp_gate, w_exp_up, w_exp_down)


def setup_inputs(seed: int = 0) -> dict:
    key = jax.random.key(seed)
    ks = jax.random.split(key, 24)
    f32 = jnp.float32
    L, D = DEPTH, D_MODEL

    def nrm(k, shape, fan_in, gain=1.0):
        return jax.random.normal(k, shape, f32) * (gain * fan_in ** -0.5)

    def std(k, shape, s=1.0):
        return jax.random.normal(k, shape, f32) * s

    return {
        'x': std(ks[0], (BATCH, SEQ, D)),
        'c': std(ks[1], (BATCH, D)),
        'ctx': std(ks[2], (BATCH, CTX_LEN, D)),
        'c_ctx': std(ks[3], (D,)),
        'w_ada': nrm(ks[4], (L, D, 6 * D), D, 0.5),
        'b_ada': std(ks[5], (L, 6 * D), 0.02),
        'w_in': nrm(ks[6], (L, D, D_IN), D),
        'w_fourier': nrm(ks[7], (L, GROUP_W, GROUP_W), GROUP_W),
        'attn_sink': std(ks[8], (L, N_Q_HEADS)),
        'w_pool': nrm(ks[9], (L, len(POOL_WINDOWS), POOL_CH, POOL_CH), POOL_CH),
        'pool_scale': 1.0 + std(ks[10], (L, GROUP_W), 0.1),
        'w_sgu': nrm(ks[11], (L, N_SGU_HEADS, SGU_CHUNK, SGU_CHUNK), SGU_CHUNK),
        'b_sgu': 1.0 + std(ks[12], (L, N_SGU_HEADS, SGU_CHUNK), 0.1),
        'w_out': nrm(ks[13], (L, D, D), D, INIT_BETA),
        'ln1_g': 1.0 + std(ks[14], (L, D), 0.1),
        'ln1_b': std(ks[15], (L, D), 0.02),
        'w_router_group': nrm(ks[16], (L, D, N_EXPERT_GROUPS), D),
        'w_router_expert': nrm(ks[17], (L, D, N_EXPERT_GROUPS, EXPERTS_PER_GROUP), D),
        'w_exp_gate': nrm(ks[18], (L, N_EXPERTS, D, D_EXPERT), D),
        'w_exp_up': nrm(ks[19], (L, N_EXPERTS, D, D_EXPERT), D),
        'w_exp_down': nrm(ks[20], (L, N_EXPERTS, D_EXPERT, D), D_EXPERT, INIT_BETA),
        'ln2_g': 1.0 + std(ks[21], (L, D), 0.1),
        'ln2_b': std(ks[22], (L, D), 0.02),
    }


def reference(x, c, ctx, c_ctx, w_ada, b_ada, w_in, w_fourier, attn_sink, w_pool, pool_scale,
              w_sgu, b_sgu, w_out, ln1_g, ln1_b, w_router_group, w_router_expert,
              w_exp_gate, w_exp_up, w_exp_down, ln2_g, ln2_b):
    b, s, d = x.shape
    rope_cos, rope_sin = axial_rope_tables(s)
    cond_lat = jax.nn.silu(c)
    cond_ctx = jax.nn.silu(c_ctx)
    for layer in range(DEPTH):
        last = layer == DEPTH - 1
        m = (cond_lat @ w_ada[layer] + b_ada[layer])[:, None, :]
        mc = (cond_ctx @ w_ada[layer] + b_ada[layer])[None, None, :]
        sh1, sc1, g1, sh2, sc2, g2 = jnp.split(m, 6, axis=-1)
        csh1, csc1, cg1, csh2, csc2, cg2 = jnp.split(mc, 6, axis=-1)

        h = modulate(x, sh1, sc1)
        hc = modulate(ctx, csh1, csc1)
        y, yc = parallel_mixers(h, hc, w_in[layer], w_fourier[layer], attn_sink[layer], w_pool[layer],
                                pool_scale[layer], w_sgu[layer], b_sgu[layer], w_out[layer],
                                rope_cos, rope_sin, not last)
        x = layer_norm(RES_ALPHA * x + g1 * y, ln1_g[layer], ln1_b[layer])

        h2 = modulate(x, sh2, sc2)
        if last:
            f = hier_moe(h2.reshape(-1, d), w_router_group[layer], w_router_expert[layer],
                         w_exp_gate[layer], w_exp_up[layer], w_exp_down[layer]).reshape(b, s, d)
        else:
            ctx = layer_norm(RES_ALPHA * ctx + cg1 * yc, ln1_g[layer], ln1_b[layer])
            hc2 = modulate(ctx, csh2, csc2)
            tokens = jnp.concatenate([h2.reshape(-1, d), hc2.reshape(-1, d)], axis=0)
            f_all = hier_moe(tokens, w_router_group[layer], w_router_expert[layer],
                             w_exp_gate[layer], w_exp_up[layer], w_exp_down[layer])
            f = f_all[:b * s].reshape(b, s, d)
            fc = f_all[b * s:].reshape(ctx.shape)
            ctx = layer_norm(RES_ALPHA * ctx + cg2 * fc, ln2_g[layer], ln2_b[layer])
        x = layer_norm(RES_ALPHA * x + g2 * f, ln2_g[layer], ln2_b[layer])
    return x
```

```cpp
#include <hip/hip_runtime.h>
#include <stdint.h>
#include <stdio.h>

#ifndef NAIVE_GEMM
#define NAIVE_GEMM 1
#endif
#ifndef N_LAUNCH_MODE
#define N_LAUNCH_MODE 0
#endif

#define LAS __attribute__((address_space(3)))
typedef unsigned short bf16_t;
typedef short bf16x8 __attribute__((ext_vector_type(8)));
typedef float f32x4 __attribute__((ext_vector_type(4)));
typedef unsigned u32x4 __attribute__((ext_vector_type(4)));
typedef unsigned u32x2 __attribute__((ext_vector_type(2)));

constexpr int D = 1024, NBATCH = 4, SEQ = 4096, CTXL = 256;
constexpr int NLAT = NBATCH * SEQ, NCTX = NBATCH * CTXL, NTOK = NLAT + NCTX;
constexpr int ZC = 1792;
constexpr int NEXP = 32, DEXP = 512;
constexpr int NSLOT = 2 * NTOK + NEXP * 128;
constexpr int NT = 512;
constexpr int MAXG = 512;
constexpr float RES_ALPHA = 1.41421356237309515f;
constexpr int LDS_BYTES = 98304 + 1024;

constexpr size_t WS_BAR   = 0;
constexpr size_t WS_CNT   = 16384;
constexpr size_t WS_BCNT  = WS_CNT + 256;
constexpr size_t WS_MOD   = WS_BCNT + (size_t)2 * MAXG * 32 * 4;
constexpr size_t WS_ROPE  = WS_MOD + (size_t)2 * 5 * 6144 * 4;
constexpr size_t WS_TOKE  = WS_ROPE + 8192;
constexpr size_t WS_TOKR  = WS_TOKE + (size_t)NTOK * 8;
constexpr size_t WS_TOKS  = WS_TOKR + (size_t)NTOK * 8;
constexpr size_t WS_TOKG  = WS_TOKS + (size_t)NTOK * 8;
constexpr size_t WS_SLOTT = WS_TOKG + (size_t)NTOK * 8;
constexpr size_t WS_WIN   = WS_SLOTT + (size_t)NSLOT * 4;
constexpr size_t WS_WOUT  = WS_WIN + (size_t)2 * ZC * 1024 * 2;
constexpr size_t WS_WSGU  = WS_WOUT + (size_t)2 * 1024 * 1024 * 2;
constexpr size_t WS_DFT   = WS_WSGU + (size_t)2 * 4 * 128 * 128 * 2;
constexpr size_t WS_DFTC  = WS_DFT + (size_t)4096 * 8192 * 2;
constexpr size_t WS_WEXP  = WS_DFTC + (size_t)256 * 512 * 2;
constexpr size_t EXPMAT   = (size_t)NEXP * 512 * 1024;
constexpr size_t WS_X1    = WS_WEXP + 3 * EXPMAT * 2;
constexpr size_t WS_XC    = WS_X1 + (size_t)NTOK * D * 4;
constexpr size_t WS_H     = WS_XC + (size_t)NTOK * D * 4;
constexpr size_t WS_R     = WS_H + (size_t)NTOK * D * 2;
constexpr size_t WS_Z     = WS_R;
constexpr size_t WS_AT    = WS_Z + (size_t)NTOK * ZC * 2;
constexpr size_t WS_ATC   = WS_AT + (size_t)4 * 256 * 8192 * 2;
constexpr size_t WS_VT    = WS_ATC + (size_t)4 * 256 * 512 * 2;
constexpr size_t WS_VTC   = WS_VT + (size_t)4 * 2 * 64 * 4096 * 2;
constexpr size_t WS_CAT   = WS_VTC + (size_t)4 * 2 * 64 * 256 * 2;
constexpr size_t WS_REND  = WS_CAT + (size_t)NTOK * D * 2;
constexpr size_t WS_Y     = WS_R;
constexpr size_t WS_HID   = WS_R;
constexpr size_t WS_YS    = WS_HID + (size_t)NSLOT * DEXP * 2;
constexpr size_t WS_END   = WS_REND;
static_assert(WS_Y + (size_t)NTOK * D * 4 <= WS_CAT, "Y must not reach CAT");
static_assert(WS_YS + (size_t)NSLOT * D * 2 <= WS_REND, "YS must fit the region");
static_assert(WS_WIN % 256 == 0 && WS_DFT % 256 == 0 && WS_WEXP % 256 == 0 && WS_X1 % 256 == 0 && WS_H % 256 == 0 && WS_R % 256 == 0 && WS_AT % 256 == 0 && WS_CAT % 256 == 0 && WS_YS % 256 == 0, "alignment");

struct Args { const float* in[23]; float* out; unsigned char* ws; int ph_lo, ph_hi; };

#define XB_TMO      128
#define XB_XCNT(j)  (256  + 64 * (j))
#define XB_XSUB(j)  (1280 + 64 * (j))
#define XB_XGEN(j)  (2304 + 64 * (j))
#define XB_TOP      3328
#define XB_TOPGEN   3392
#define XCD_BAR_WORDS 3456
#define XB_SPIN_CAP (1u << 18)

__device__ __forceinline__ unsigned xb_ld(unsigned* p)              { return __hip_atomic_load(p, __ATOMIC_RELAXED, __HIP_MEMORY_SCOPE_AGENT); }
__device__ __forceinline__ unsigned xb_add(unsigned* p, unsigned v) { return __hip_atomic_fetch_add(p, v, __ATOMIC_RELAXED, __HIP_MEMORY_SCOPE_AGENT); }
__device__ __forceinline__ unsigned xb_xcc_id() { return (unsigned)__builtin_amdgcn_s_getreg((3 << 11) | 20) & 0xFu; }
#define XB_SPIN(cond, bar) do { unsigned _sp = 0; while (cond) { __builtin_amdgcn_s_sleep(1); \
    if ((++_sp & 255u) == 0u) { if (xb_ld(&(bar)[XB_TMO])) break; if (_sp > XB_SPIN_CAP) { atomicAdd(&(bar)[XB_TMO], 1u); break; } } } } while (0)

struct XcdBarrier { unsigned* bar; unsigned x; volatile LAS unsigned* st; };

__device__ __forceinline__ XcdBarrier xcd_barrier_post(unsigned* bar, volatile LAS unsigned* st) {
    XcdBarrier b; b.bar = bar; b.x = xb_xcc_id(); b.st = st;
    if (threadIdx.x == 0) (void)xb_add(&bar[XB_XCNT(b.x)], 1u);
    return b;
}
__device__ __forceinline__ void xcd_barrier_complete(unsigned* bar, unsigned x, unsigned& nloc, unsigned& nx) {
    const unsigned G = gridDim.x * gridDim.y * gridDim.z;
    unsigned sum, cnt, mine, sp = 0u;
    for (;;) {
        sum = 0u; cnt = 0u; mine = 0u;
#pragma unroll
        for (unsigned j = 0; j < 16; ++j) { const unsigned c = xb_ld(&bar[XB_XCNT(j)]); sum += c; cnt += (c > 0u) ? 1u : 0u; mine = (j == x) ? c : mine; }
        if (sum == G) break;
        __builtin_amdgcn_s_sleep(1);
        if ((++sp & 255u) == 0u) { if (xb_ld(&bar[XB_TMO])) break; if (sp > XB_SPIN_CAP) { atomicAdd(&bar[XB_TMO], 1u); break; } }
    }
    nloc = mine > 0u ? mine : 1u; nx = cnt > 0u ? cnt : 1u;
}
__device__ __forceinline__ void xcd_barrier(const XcdBarrier& b) {
    asm volatile("s_waitcnt vmcnt(0)" ::: "memory");
    __syncthreads();
    if (threadIdx.x == 0) {
        unsigned* bar = b.bar;
        __builtin_amdgcn_s_waitcnt(0);
        unsigned nloc = b.st[0], nx = b.st[1];
        if (nloc == 0u) { xcd_barrier_complete(bar, b.x, nloc, nx); b.st[0] = nloc; b.st[1] = nx; }
        const unsigned old = xb_add(&bar[XB_XSUB(b.x)], 1u);
        const unsigned gen = old / nloc;
        if (old + 1u == (gen + 1u) * nloc) {
            __builtin_amdgcn_fence(__ATOMIC_RELEASE, "agent");
            asm volatile("s_waitcnt vmcnt(0)" ::: "memory");
            const unsigned og = xb_add(&bar[XB_TOP], 1u);
            const unsigned tg = og / nx;
            if (og + 1u == (tg + 1u) * nx) xb_add(&bar[XB_TOPGEN], 1u);
            else XB_SPIN(xb_ld(&bar[XB_TOPGEN]) == tg, bar);
            __builtin_amdgcn_fence(__ATOMIC_ACQUIRE, "agent");
            xb_add(&bar[XB_XGEN(b.x)], 1u);
            asm volatile("s_waitcnt vmcnt(0)" ::: "memory");
        } else {
            XB_SPIN(xb_ld(&bar[XB_XGEN(b.x)]) == gen, bar);
            __builtin_amdgcn_fence(__ATOMIC_ACQUIRE, "agent");
            asm volatile("s_waitcnt vmcnt(0)" ::: "memory");
        }
    }
    __syncthreads();
}

__device__ __forceinline__ float bf2f(bf16_t v) { return __uint_as_float(((unsigned)v) << 16); }
__device__ __forceinline__ bf16_t f2bf(float f) { unsigned u = __float_as_uint(f); u += 0x7FFFu + ((u >> 16) & 1u); return (bf16_t)(u >> 16); }
__device__ __forceinline__ unsigned pack2(float a, float b) { return (unsigned)f2bf(a) | ((unsigned)f2bf(b) << 16); }
__device__ __forceinline__ float lo2f(unsigned w) { return __uint_as_float(w << 16); }
__device__ __forceinline__ float hi2f(unsigned w) { return __uint_as_float(w & 0xffff0000u); }
__device__ __forceinline__ float wave_sum(float v) {
#pragma unroll
    for (int o = 32; o >= 1; o >>= 1) v += __shfl_xor(v, o);
    return v;
}
__device__ __forceinline__ float gelu_erf(float x) { return 0.5f * x * (1.0f + erff(x * 0.70710678118654752f)); }
__device__ __forceinline__ float silu_f(float x) { return x / (1.0f + __expf(-x)); }

__device__ __forceinline__ void ln_stats(const f32x4 (&v)[4], float& mean, float& rstd) {
    float s = 0.f;
#pragma unroll
    for (int i = 0; i < 4; ++i) s += (v[i][0] + v[i][1]) + (v[i][2] + v[i][3]);
    s = wave_sum(s); mean = s * (1.0f / 1024.0f);
    float q = 0.f;
#pragma unroll
    for (int i = 0; i < 4; ++i)
#pragma unroll
        for (int e = 0; e < 4; ++e) { const float d = v[i][e] - mean; q += d * d; }
    q = wave_sum(q); rstd = 1.0f / sqrtf(q * (1.0f / 1024.0f) + 1e-6f);
}

template <int BN> struct MfmaLayout {
    static constexpr int FG = BN / 128, NI = 4, NJ = 2 * FG;
    int rbase, cbase;
    __device__ __forceinline__ int row(int i) const { return rbase + 16 * i; }
    __device__ __forceinline__ int col(int jj) const { return (jj / FG) * (BN / 2) + (jj % FG) * 16 + cbase; }
};
template <int BN> struct NaiveLayout {
    static constexpr int TX = BN / 8, TY = NT / TX, NI = 128 / TY, NJ = 2;
    int ty, tx;
    __device__ __forceinline__ int row(int i) const { return ty + TY * i; }
    __device__ __forceinline__ int col(int jj) const { return jj * (BN / 2) + 4 * tx; }
};

__device__ __forceinline__ void glds16(const bf16_t* g, LAS unsigned char* l) {
    __builtin_amdgcn_global_load_lds((const unsigned*)g, (LAS unsigned*)l, 16, 0, 0);
}

template <int BN, bool GATHER, class Epi>
__device__ __forceinline__ void gemm_tile(LAS unsigned char* lds, const bf16_t* A, int lda, const int* rowidx, int valid_rows,
                                          const bf16_t* B0, const bf16_t* B1, int ldb, int K, const Epi& epi) {
    constexpr int A_B = 16384, B_B = BN * 128, STAGE = A_B + B_B, NBL = BN / 64;
    const int tid = threadIdx.x, lane = tid & 63, wid = __builtin_amdgcn_readfirstlane(tid >> 6);
    const bf16_t* ap[2]; const bf16_t* bp[NBL];
#pragma unroll
    for (int i = 0; i < 2; ++i) {
        const int P = i * 512 + tid, row = P >> 3, c = (P & 7) ^ ((row >> 1) & 7);
        size_t ro;
        if (GATHER) ro = (size_t)(row < valid_rows ? rowidx[row] : 0) * (size_t)lda; else ro = (size_t)row * (size_t)lda;
        ap[i] = A + ro + c * 8;
    }
#pragma unroll
    for (int i = 0; i < NBL; ++i) {
        const int P = i * 512 + tid, row = P >> 3, c = (P & 7) ^ ((row >> 1) & 7);
        const bf16_t* base = (row < BN / 2) ? (B0 + (size_t)row * ldb) : (B1 + (size_t)(row - BN / 2) * ldb);
        bp[i] = base + c * 8;
    }
    const int nk = K / 64;
#define GT_STAGE(buf, k0) do { \
        _Pragma("unroll") for (int _i = 0; _i < 2; ++_i) glds16(ap[_i] + (k0), lds + (buf) * STAGE + _i * 8192 + wid * 1024); \
        _Pragma("unroll") for (int _i = 0; _i < NBL; ++_i) glds16(bp[_i] + (k0), lds + (buf) * STAGE + A_B + _i * 8192 + wid * 1024); } while (0)

#if NAIVE_GEMM
    typedef NaiveLayout<BN> Lay;
    Lay lay; lay.tx = tid % Lay::TX; lay.ty = tid / Lay::TX;
    f32x4 acc[Lay::NI][Lay::NJ];
#pragma unroll
    for (int i = 0; i < Lay::NI; ++i)
#pragma unroll
        for (int j = 0; j < Lay::NJ; ++j) acc[i][j] = (f32x4){0.f, 0.f, 0.f, 0.f};
    GT_STAGE(0, 0);
    asm volatile("s_waitcnt vmcnt(0)" ::: "memory"); __syncthreads();
    for (int kt = 0; kt < nk; ++kt) {
        if (kt + 1 < nk) GT_STAGE((kt + 1) & 1, (kt + 1) * 64);
        const LAS unsigned char* sa = lds + (kt & 1) * STAGE; const LAS unsigned char* sb = sa + A_B;
#pragma unroll 1
        for (int kc = 0; kc < 8; ++kc)
#pragma unroll 1
            for (int hh = 0; hh < 2; ++hh) {
                float a[Lay::NI][4];
#pragma unroll
                for (int i = 0; i < Lay::NI; ++i) { const int row = lay.row(i);
                    const u32x2 w = *(const LAS u32x2*)(sa + row * 128 + ((kc ^ ((row >> 1) & 7)) << 4) + hh * 8);
                    a[i][0] = lo2f(w.x); a[i][1] = hi2f(w.x); a[i][2] = lo2f(w.y); a[i][3] = hi2f(w.y); }
#pragma unroll
                for (int j = 0; j < 2; ++j)
#pragma unroll
                    for (int e = 0; e < 4; ++e) { const int row = j * (BN / 2) + 4 * lay.tx + e;
                        const u32x2 w = *(const LAS u32x2*)(sb + row * 128 + ((kc ^ ((row >> 1) & 7)) << 4) + hh * 8);
                        const float b0 = lo2f(w.x), b1 = hi2f(w.x), b2 = lo2f(w.y), b3 = hi2f(w.y);
#pragma unroll
                        for (int i = 0; i < Lay::NI; ++i) acc[i][j][e] += (a[i][0] * b0 + a[i][1] * b1) + (a[i][2] * b2 + a[i][3] * b3); }
            }
        asm volatile("s_waitcnt vmcnt(0)" ::: "memory"); __syncthreads();
    }
    epi.run(acc, lay);
#else
    typedef MfmaLayout<BN> Lay;
    constexpr int FG = Lay::FG;
    const int fr = lane & 15, g = lane >> 4, wr = wid >> 2, wc = wid & 3;
    Lay lay; lay.rbase = wr * 64 + fr; lay.cbase = wc * 16 * FG + 4 * g;
    f32x4 acc[Lay::NI][Lay::NJ];
#pragma unroll
    for (int i = 0; i < Lay::NI; ++i)
#pragma unroll
        for (int j = 0; j < Lay::NJ; ++j) acc[i][j] = (f32x4){0.f, 0.f, 0.f, 0.f};
    int aoff[4], boff[Lay::NJ];
#pragma unroll
    for (int m = 0; m < 4; ++m) { const int row = wr * 64 + m * 16 + fr; aoff[m] = row * 128 + ((g ^ ((row >> 1) & 7)) << 4); }
#pragma unroll
    for (int jj = 0; jj < Lay::NJ; ++jj) { const int row = (jj / FG) * (BN / 2) + wc * 16 * FG + (jj % FG) * 16 + fr; boff[jj] = A_B + row * 128 + ((g ^ ((row >> 1) & 7)) << 4); }
    GT_STAGE(0, 0);
    asm volatile("s_waitcnt vmcnt(0)" ::: "memory"); __syncthreads();
    for (int kt = 0; kt < nk; ++kt) {
        if (kt + 1 < nk) GT_STAGE((kt + 1) & 1, (kt + 1) * 64);
        const LAS unsigned char* sa = lds + (kt & 1) * STAGE;
#pragma unroll
        for (int ks = 0; ks < 2; ++ks) {
            bf16x8 af[4], bfv[Lay::NJ];
#pragma unroll
            for (int m = 0; m < 4; ++m) af[m] = *(const LAS bf16x8*)(sa + (aoff[m] ^ (ks << 6)));
#pragma unroll
            for (int jj = 0; jj < Lay::NJ; ++jj) bfv[jj] = *(const LAS bf16x8*)(sa + (boff[jj] ^ (ks << 6)));
#pragma unroll
            for (int m = 0; m < 4; ++m)
#pragma unroll
                for (int jj = 0; jj < Lay::NJ; ++jj) acc[m][jj] = __builtin_amdgcn_mfma_f32_16x16x32_bf16(bfv[jj], af[m], acc[m][jj], 0, 0, 0);
        }
        asm volatile("s_waitcnt vmcnt(0)" ::: "memory"); __syncthreads();
    }
    epi.run(acc, lay);
#endif
#undef GT_STAGE
}

struct EpiF32 {
    float* C; int ld;
    template <class L> __device__ __forceinline__ void run(const f32x4 (&acc)[L::NI][L::NJ], const L& lay) const {
#pragma unroll
        for (int i = 0; i < L::NI; ++i)
#pragma unroll
            for (int j = 0; j < L::NJ; ++j) *(f32x4*)(C + (size_t)lay.row(i) * ld + lay.col(j)) = acc[i][j];
    }
};
struct EpiBf16 {
    bf16_t* C; int ld;
    template <class L> __device__ __forceinline__ void run(const f32x4 (&acc)[L::NI][L::NJ], const L& lay) const {
#pragma unroll
        for (int i = 0; i < L::NI; ++i)
#pragma unroll
            for (int j = 0; j < L::NJ; ++j) { u32x2 w; w.x = pack2(acc[i][j][0], acc[i][j][1]); w.y = pack2(acc[i][j][2], acc[i][j][3]);
                *(u32x2*)(C + (size_t)lay.row(i) * ld + lay.col(j)) = w; }
    }
};
struct EpiGateUp {
    bf16_t* C; int ld;
    template <class L> __device__ __forceinline__ void run(const f32x4 (&acc)[L::NI][L::NJ], const L& lay) const {
#pragma unroll
        for (int i = 0; i < L::NI; ++i)
#pragma unroll
            for (int j = 0; j < L::NJ / 2; ++j) { const f32x4 gt = acc[i][j], up = acc[i][j + L::NJ / 2];
                u32x2 w; w.x = pack2(silu_f(gt[0]) * up[0], silu_f(gt[1]) * up[1]); w.y = pack2(silu_f(gt[2]) * up[2], silu_f(gt[3]) * up[3]);
                *(u32x2*)(C + (size_t)lay.row(i) * ld + lay.col(j)) = w; }
    }
};
struct EpiInProj {
    bf16_t* Zt;
    bf16_t* tF;
    bf16_t* tV;
    int n0, pos0, n;
    template <class L> __device__ __forceinline__ void run(const f32x4 (&acc)[L::NI][L::NJ], const L& lay) const {
#pragma unroll
        for (int i = 0; i < L::NI; ++i)
#pragma unroll
            for (int j = 0; j < L::NJ; ++j) {
                const int r = lay.row(i), cl = lay.col(j), c = n0 + cl;
                const f32x4 v = acc[i][j];
                if (c < 512) {
                    const int part = c >> 8, ch = c & 255;
#pragma unroll
                    for (int e = 0; e < 4; ++e) tF[((size_t)(ch + e) * 2 + part) * n + pos0 + r] = f2bf(v[e]);
                } else {
                    u32x2 w; w.x = pack2(v[0], v[1]); w.y = pack2(v[2], v[3]);
                    *(u32x2*)(Zt + (size_t)r * ZC + cl) = w;
                    if (c >= 896 && c < 1024) {
#pragma unroll
                        for (int e = 0; e < 4; ++e) tV[(size_t)(c - 896 + e) * n + pos0 + r] = f2bf(v[e]);
                    }
                }
            }
    }
};

constexpr int U_ADA = 192, U_WIN = 2 * 16 * 28, U_WOUT = 2 * 16 * 16, U_SGU = 32, U_DFT = 4096 + 256, U_ROPE = 1, U_EXP = 3 * 32 * 128;
constexpr int LDS_SIL = 0, LDS_RED = 20480, LDS_TILE = 32768, LDS_T64 = 49408, LDS_CTAB = 50176;

__device__ __forceinline__ void ada_unit(const Args& a, unsigned char* lds, int u) {
    float* sil = (float*)(lds + LDS_SIL); float* red = (float*)(lds + LDS_RED);
    const int tid = threadIdx.x, lane = tid & 63, w = tid >> 6;
    const int l = u / 96, cg = u % 96;
    for (int i = tid; i < 5120; i += NT) { const int r = i >> 10, k = i & 1023; const float v = (r < 4) ? a.in[1][r * 1024 + k] : a.in[3][k]; sil[i] = v / (1.0f + expf(-v)); }
    __syncthreads();
    const float* W = a.in[4] + (size_t)l * 1024 * 6144 + cg * 64 + lane;
    float acc[5] = {0.f, 0.f, 0.f, 0.f, 0.f};
#pragma unroll 8
    for (int k = w * 128; k < w * 128 + 128; ++k) { const float wv = W[(size_t)k * 6144];
#pragma unroll
        for (int r = 0; r < 5; ++r) acc[r] += sil[r * 1024 + k] * wv; }
#pragma unroll
    for (int r = 0; r < 5; ++r) red[(w * 5 + r) * 64 + lane] = acc[r];
    __syncthreads();
    if (tid < 320) { const int r = tid >> 6; float s = 0.f;
#pragma unroll
        for (int ww = 0; ww < 8; ++ww) s += red[(ww * 5 + r) * 64 + lane];
        const int j = cg * 64 + lane; ((float*)(a.ws + WS_MOD))[(size_t)(l * 5 + r) * 6144 + j] = s + a.in[5][l * 6144 + j]; }
    __syncthreads();
}

__device__ __forceinline__ void tile_store_T(const float* tile, bf16_t* dst, int ldd) {
    const int tid = threadIdx.x, n = tid >> 3, kc = tid & 7;
    u32x4 w;
    w.x = pack2(tile[(kc * 8 + 0) * 65 + n], tile[(kc * 8 + 1) * 65 + n]); w.y = pack2(tile[(kc * 8 + 2) * 65 + n], tile[(kc * 8 + 3) * 65 + n]);
    w.z = pack2(tile[(kc * 8 + 4) * 65 + n], tile[(kc * 8 + 5) * 65 + n]); w.w = pack2(tile[(kc * 8 + 6) * 65 + n], tile[(kc * 8 + 7) * 65 + n]);
    *(u32x4*)(dst + (size_t)n * ldd + kc * 8) = w;
}
__device__ __forceinline__ void tile_load(float* tile, const float* src, int lds_) {
    const int tid = threadIdx.x;
#pragma unroll
    for (int i = 0; i < 2; ++i) { const int row = (tid >> 4) + 32 * i, c4 = (tid & 15) * 4; const f32x4 v = *(const f32x4*)(src + (size_t)row * lds_ + c4);
        tile[row * 65 + c4 + 0] = v[0]; tile[row * 65 + c4 + 1] = v[1]; tile[row * 65 + c4 + 2] = v[2]; tile[row * 65 + c4 + 3] = v[3]; }
}

__device__ __forceinline__ void win_unit(const Args& a, unsigned char* lds, int u) {
    float* tile = (float*)(lds + LDS_TILE); float* T = (float*)(lds + LDS_T64);
    const int tid = threadIdx.x;
    const int l = u / 448, r = u % 448, kb = r / 28, nb = r % 28;
    const float* Win = a.in[6] + (size_t)l * 1024 * 1536;
    const int srccol = (nb >= 8) ? nb * 64 - 256 : (nb & 3) * 64;
    tile_load(tile, Win + (size_t)(kb * 64) * 1536 + srccol, 1536);
    if (nb < 8 && tid < 64) { T[tid] = cospif((float)tid / 32.0f); T[64 + tid] = sinpif((float)tid / 32.0f); }
    __syncthreads();
    bf16_t* dst = (bf16_t*)(a.ws + WS_WIN) + ((size_t)l * ZC + nb * 64) * 1024 + kb * 64;
    if (nb >= 8) tile_store_T(tile, dst, 1024);
    else {
        const int n = tid >> 3, kc = tid & 7, part = nb >> 2; float o[8];
#pragma unroll
        for (int e = 0; e < 8; ++e) { float s = 0.f; for (int c = 0; c < 64; ++c) s += tile[(kc * 8 + e) * 65 + c] * T[part * 64 + ((c * n) & 63)]; o[e] = (part ? -s : s) * 0.125f; }
        u32x4 w; w.x = pack2(o[0], o[1]); w.y = pack2(o[2], o[3]); w.z = pack2(o[4], o[5]); w.w = pack2(o[6], o[7]);
        *(u32x4*)(dst + (size_t)n * 1024 + kc * 8) = w;
    }
    __syncthreads();
}

__device__ __forceinline__ void wout_unit(const Args& a, unsigned char* lds, int u) {
    float* tile = (float*)(lds + LDS_TILE);
    const int tid = threadIdx.x;
    const int l = u / 256, r = u % 256, kb = r / 16, nb = r % 16;
    const float* Wo = a.in[13] + (size_t)l * 1024 * 1024;
    const int n = tid & 63, kq = __builtin_amdgcn_readfirstlane(tid >> 6);
    if (kb < 4) {
        const float* wf = a.in[7] + (size_t)l * 256 * 256 + (size_t)(kb * 64 + kq * 8) * 256;
        float acc[8] = {0.f, 0.f, 0.f, 0.f, 0.f, 0.f, 0.f, 0.f};
        for (int j = 0; j < 256; ++j) { const float wv = Wo[(size_t)j * 1024 + nb * 64 + n];
#pragma unroll
            for (int e = 0; e < 8; ++e) acc[e] += wf[e * 256 + j] * wv; }
#pragma unroll
        for (int e = 0; e < 8; ++e) tile[(kq * 8 + e) * 65 + n] = acc[e];
    } else if (kb >= 8 && kb < 12) {
        const int g = kb - 8;
        const float* wp = a.in[9] + ((size_t)(l * 4 + g) * 64 + kq * 8) * 64;
        const float* ps = a.in[10] + l * 256 + g * 64;
        float acc[8] = {0.f, 0.f, 0.f, 0.f, 0.f, 0.f, 0.f, 0.f};
        for (int d = 0; d < 64; ++d) { const float wv = ps[d] * Wo[(size_t)(512 + g * 64 + d) * 1024 + nb * 64 + n];
#pragma unroll
            for (int e = 0; e < 8; ++e) acc[e] += wp[e * 64 + d] * wv; }
#pragma unroll
        for (int e = 0; e < 8; ++e) tile[(kq * 8 + e) * 65 + n] = acc[e];
    } else tile_load(tile, Wo + (size_t)(kb * 64) * 1024 + nb * 64, 1024);
    __syncthreads();
    tile_store_T(tile, (bf16_t*)(a.ws + WS_WOUT) + ((size_t)l * 1024 + nb * 64) * 1024 + kb * 64, 1024);
    __syncthreads();
}

__device__ __forceinline__ void exp_unit(const Args& a, unsigned char* lds, int l, int u) {
    float* tile = (float*)(lds + LDS_TILE);
    const int mat = u / 4096, e = (u % 4096) / 128, t = u % 128;
    const int kb = (mat < 2) ? t / 8 : t / 16, nb = (mat < 2) ? t % 8 : t % 16;
    const int srcld = (mat < 2) ? 512 : 1024, dstld = (mat < 2) ? 1024 : 512;
    const float* src = a.in[18 + mat] + ((size_t)(l * 32 + e) * 512 * 1024) + (size_t)(kb * 64) * srcld + nb * 64;
    bf16_t* dst = (bf16_t*)(a.ws + WS_WEXP) + (size_t)mat * EXPMAT + (size_t)e * 512 * 1024 + (size_t)(nb * 64) * dstld + kb * 64;
    tile_load(tile, src, srcld);
    __syncthreads();
    tile_store_T(tile, dst, dstld);
    __syncthreads();
}

__device__ __forceinline__ void p0_prologue(const Args& a, unsigned char* lds) {
    const int tid = threadIdx.x;
    bool have_tab = false;
    constexpr int E0 = U_ADA, E1 = E0 + U_WIN, E2 = E1 + U_WOUT, E3 = E2 + U_SGU, E4 = E3 + U_DFT, E5 = E4 + U_ROPE, E6 = E5 + U_EXP;
    for (int u = blockIdx.x; u < E6; u += gridDim.x) {
        if (u < E0) ada_unit(a, lds, u);
        else if (u < E1) win_unit(a, lds, u - E0);
        else if (u < E2) wout_unit(a, lds, u - E1);
        else if (u < E3) { const size_t i0 = (size_t)(u - E2) * 4096 + tid * 8; const float* s = a.in[11] + i0; bf16_t* d = (bf16_t*)(a.ws + WS_WSGU) + i0;
            const f32x4 v0 = *(const f32x4*)s, v1 = *(const f32x4*)(s + 4); u32x4 w; w.x = pack2(v0[0], v0[1]); w.y = pack2(v0[2], v0[3]); w.z = pack2(v1[0], v1[1]); w.w = pack2(v1[2], v1[3]); *(u32x4*)d = w; }
        else if (u < E4) {
            float* ctab = (float*)(lds + LDS_CTAB);
            if (!have_tab) { for (int i = tid; i < 4096; i += NT) ctab[i] = cospif((float)i / 2048.0f); __syncthreads(); have_tab = true; }
            const int k = u - E3;
            if (k < 4096) {
                const int n0 = tid * 8; float c[8], s[8];
#pragma unroll
                for (int e = 0; e < 8; ++e) { const int idx = (k * (n0 + e)) & 4095; c[e] = ctab[idx] * (1.0f / 64.0f); s[e] = ctab[(idx - 1024) & 4095] * (1.0f / 64.0f); }
                bf16_t* d = (bf16_t*)(a.ws + WS_DFT) + (size_t)k * 8192 + n0;
                u32x4 w; w.x = pack2(c[0], c[1]); w.y = pack2(c[2], c[3]); w.z = pack2(c[4], c[5]); w.w = pack2(c[6], c[7]); *(u32x4*)d = w;
                w.x = pack2(s[0], s[1]); w.y = pack2(s[2], s[3]); w.z = pack2(s[4], s[5]); w.w = pack2(s[6], s[7]); *(u32x4*)(d + 4096) = w;
            } else if (tid < 32) {
                const int kk = k - 4096, n0 = tid * 8; float c[8], s[8];
#pragma unroll
                for (int e = 0; e < 8; ++e) { const int idx = ((kk * (n0 + e)) & 255) * 16; c[e] = ctab[idx] * (1.0f / 16.0f); s[e] = ctab[(idx - 1024) & 4095] * (1.0f / 16.0f); }
                bf16_t* d = (bf16_t*)(a.ws + WS_DFTC) + (size_t)kk * 512 + n0;
                u32x4 w; w.x = pack2(c[0], c[1]); w.y = pack2(c[2], c[3]); w.z = pack2(c[4], c[5]); w.w = pack2(c[6], c[7]); *(u32x4*)d = w;
                w.x = pack2(s[0], s[1]); w.y = pack2(s[2], s[3]); w.z = pack2(s[4], s[5]); w.w = pack2(s[6], s[7]); *(u32x4*)(d + 256) = w;
            }
        }
        else if (u < E5) {
            for (int i = tid; i < 1024; i += NT) { const int pos = i >> 4, f = i & 15; const float freq = powf(10000.0f, -(float)f / 16.0f); const float ang = (float)pos * freq;
                ((float2*)(a.ws + WS_ROPE))[i] = make_float2(cosf(ang), sinf(ang)); }
        }
        else exp_unit(a, lds, 0, u - E5);
    }
}

__device__ __forceinline__ void p_lnmod0(const Args& a) {
    const int lane = threadIdx.x & 63, w = threadIdx.x >> 6;
    const float* mod = (const float*)(a.ws + WS_MOD);
    bf16_t* H = (bf16_t*)(a.ws + WS_H);
    for (int t = blockIdx.x * 8 + w; t < NTOK; t += gridDim.x * 8) {
        const float* src = (t < NLAT) ? a.in[0] + (size_t)t * D : a.in[2] + (size_t)(t - NLAT) * D;
        const float* m = mod + (size_t)((t < NLAT) ? (t >> 12) : 4) * 6144;
        f32x4 v[4];
#pragma unroll
        for (int i = 0; i < 4; ++i) v[i] = *(const f32x4*)(src + 256 * i + 4 * lane);
        float mean, rstd; ln_stats(v, mean, rstd);
#pragma unroll
        for (int i = 0; i < 4; ++i) { const int c = 256 * i + 4 * lane; const f32x4 sh = *(const f32x4*)(m + c), sc = *(const f32x4*)(m + 1024 + c);
            f32x4 o;
#pragma unroll
            for (int e = 0; e < 4; ++e) o[e] = (v[i][e] - mean) * rstd * (1.0f + sc[e]) + sh[e];
            u32x2 pk; pk.x = pack2(o[0], o[1]); pk.y = pack2(o[2], o[3]); *(u32x2*)(H + (size_t)t * D + c) = pk; }
    }
}

__device__ __forceinline__ void p1_inproj(const Args& a, LAS unsigned char* lds, int l) {
    const int n_lat = 128 * 7, n_ctx = (l == 0) ? 8 * 7 : 8;
    const bf16_t* H = (const bf16_t*)(a.ws + WS_H);
    const bf16_t* W = (const bf16_t*)(a.ws + WS_WIN) + (size_t)l * ZC * 1024;
    for (int u = blockIdx.x; u < n_lat + n_ctx; u += gridDim.x) {
        int row0, b, pos0, ct, n; bf16_t *tF, *tV;
        if (u < n_lat) { const int rt = u / 7; ct = u % 7; row0 = rt * 128; b = row0 >> 12; pos0 = row0 & 4095; n = 4096;
            tF = (bf16_t*)(a.ws + WS_AT) + (size_t)b * 256 * 2 * 4096; tV = (bf16_t*)(a.ws + WS_VT) + (size_t)b * 128 * 4096; }
        else { const int uu = u - n_lat; int rt; if (l == 0) { rt = uu / 7; ct = uu % 7; } else { rt = uu; ct = 3; }
            row0 = NLAT + rt * 128; b = rt >> 1; pos0 = (rt & 1) * 128; n = 256;
            tF = (bf16_t*)(a.ws + WS_ATC) + (size_t)b * 256 * 2 * 256; tV = (bf16_t*)(a.ws + WS_VTC) + (size_t)b * 128 * 256; }
        EpiInProj E; E.Zt = (bf16_t*)(a.ws + WS_Z) + (size_t)row0 * ZC + ct * 256; E.tF = tF; E.tV = tV; E.n0 = ct * 256; E.pos0 = pos0; E.n = n;
        const bf16_t* B0 = W + (size_t)(ct * 256) * 1024;
        gemm_tile<256, false, EpiInProj>(lds, H + (size_t)row0 * D, D, nullptr, 128, B0, B0 + (size_t)128 * 1024, 1024, 1024, E);
    }
}

__device__ __forceinline__ void rope32(float (&t)[32], const float2* tab) {
#pragma unroll
    for (int f = 0; f < 16; ++f) { const float2 cs = tab[f]; const float t1 = t[f], t2 = t[16 + f]; t[f] = t1 * cs.x - t2 * cs.y; t[16 + f] = t1 * cs.y + t2 * cs.x; }
}
__device__ __forceinline__ void load32(float (&t)[32], const bf16_t* p) {
#pragma unroll
    for (int q = 0; q < 4; ++q) { const u32x4 w = *(const u32x4*)(p + 8 * q);
        t[8 * q + 0] = lo2f(w.x); t[8 * q + 1] = hi2f(w.x); t[8 * q + 2] = lo2f(w.y); t[8 * q + 3] = hi2f(w.y);
        t[8 * q + 4] = lo2f(w.z); t[8 * q + 5] = hi2f(w.z); t[8 * q + 6] = lo2f(w.w); t[8 * q + 7] = hi2f(w.w); }
}

__device__ __forceinline__ float kdot(const bf16_t* kp, const bf16_t* q, const float2* tab0, const float2* tab1, bool do_rope) {
    float dot = 0.f;
#pragma unroll 1
    for (int ax = 0; ax < 2; ++ax) {
        const float2* tab = ax ? tab1 : tab0;
#pragma unroll 1
        for (int h8 = 0; h8 < 2; ++h8) {
            const u32x4 wl = *(const u32x4*)(kp + ax * 32 + h8 * 8), wh = *(const u32x4*)(kp + ax * 32 + 16 + h8 * 8);
            const float tl[8] = {lo2f(wl.x), hi2f(wl.x), lo2f(wl.y), hi2f(wl.y), lo2f(wl.z), hi2f(wl.z), lo2f(wl.w), hi2f(wl.w)};
            const float th[8] = {lo2f(wh.x), hi2f(wh.x), lo2f(wh.y), hi2f(wh.y), lo2f(wh.z), hi2f(wh.z), lo2f(wh.w), hi2f(wh.w)};
#pragma unroll
            for (int j = 0; j < 8; ++j) {
                float r1 = tl[j], r2 = th[j];
                if (do_rope) { const float2 cs = tab[h8 * 8 + j]; r1 = tl[j] * cs.x - th[j] * cs.y; r2 = tl[j] * cs.y + th[j] * cs.x; }
                dot += bf2f(q[ax * 32 + h8 * 8 + j]) * r1 + bf2f(q[ax * 32 + 16 + h8 * 8 + j]) * r2;
            }
        }
    }
    return dot;
}

__device__ __forceinline__ void mixer_tile(const Args& a, unsigned char* lds, int l, int row0, int seq_row0, int pos0, int n, int b, bool is_ctx) {
    const int tid = threadIdx.x, lane = tid & 63, w = tid >> 6;
    const bf16_t* Z = (const bf16_t*)(a.ws + WS_Z);
    bf16_t* CAT = (bf16_t*)(a.ws + WS_CAT);
    {
        const int c = tid & 255, half = tid >> 8, g = c >> 6, hw = 1 << g;
        for (int tl = half * 64; tl < half * 64 + 64; ++tl) {
            const int pos = pos0 + tl; const int lo = max(pos - hw, 0), hi = min(pos + hw, n);
            float s = 0.f; for (int j = lo; j < hi; ++j) s += bf2f(Z[(size_t)(seq_row0 + j) * ZC + 1024 + c]);
            const float self = bf2f(Z[(size_t)(seq_row0 + pos) * ZC + 1024 + c]);
            CAT[(size_t)(row0 + tl) * D + 512 + c] = f2bf(s / (float)(hi - lo) - self);
        }
    }
    bf16_t* vT = (bf16_t*)lds;
    for (int q = w; q < 128; q += 8) {
        const u32x2 gw = *(const u32x2*)(Z + (size_t)(row0 + q) * ZC + 1536 + 4 * lane);
        float gv[4] = {gelu_erf(lo2f(gw.x)), gelu_erf(hi2f(gw.x)), gelu_erf(lo2f(gw.y)), gelu_erf(hi2f(gw.y))};
        float s = wave_sum((gv[0] + gv[1]) + (gv[2] + gv[3])); const float mean = s * (1.0f / 256.0f);
        float qq = 0.f;
#pragma unroll
        for (int e = 0; e < 4; ++e) { const float d = gv[e] - mean; qq += d * d; }
        qq = wave_sum(qq); const float rstd = 1.0f / sqrtf(qq * (1.0f / 256.0f) + 1e-6f);
#pragma unroll
        for (int e = 0; e < 4; ++e) vT[(4 * lane + e) * 128 + q] = f2bf((gv[e] - mean) * rstd);
    }
    __syncthreads();
    {
        const int c = tid & 255, ph = tid >> 8, h = c >> 6;
        const bf16_t* Ws = (const bf16_t*)(a.ws + WS_WSGU) + (size_t)(l * 4 + h) * 128 * 128;
        const float* bs = a.in[12] + (size_t)(l * 4 + h) * 128;
        for (int p = ph * 64; p < ph * 64 + 64; ++p) {
            float s = 0.f;
#pragma unroll 2
            for (int q8 = 0; q8 < 16; ++q8) {
                const u32x4 ww = *(const u32x4*)(Ws + (size_t)p * 128 + q8 * 8);
                const u32x4 vv = *(const u32x4*)(vT + c * 128 + q8 * 8);
                s += lo2f(ww.x) * lo2f(vv.x) + hi2f(ww.x) * hi2f(vv.x) + lo2f(ww.y) * lo2f(vv.y) + hi2f(ww.y) * hi2f(vv.y)
                   + lo2f(ww.z) * lo2f(vv.z) + hi2f(ww.z) * hi2f(vv.z) + lo2f(ww.w) * lo2f(vv.w) + hi2f(ww.w) * hi2f(vv.w);
            }
            const float uv = gelu_erf(bf2f(Z[(size_t)(row0 + p) * ZC + 1280 + c]));
            CAT[(size_t)(row0 + p) * D + 768 + c] = f2bf(uv * (s + bs[p]));
        }
    }
    __syncthreads();
    {
        const int i = tid & 127, h = tid >> 7, kvh = h >> 1;
        const float2* rope = (const float2*)(a.ws + WS_ROPE);
        const int qpos = pos0 + i;
        bf16_t* q = (bf16_t*)lds + tid * 66;
        {
            float t0[32];
            load32(t0, Z + (size_t)(row0 + i) * ZC + 512 + h * 64);
            if (!is_ctx) rope32(t0, rope + (qpos >> 6) * 16);
#pragma unroll
            for (int d = 0; d < 32; ++d) q[d] = f2bf(t0[d]);
            load32(t0, Z + (size_t)(row0 + i) * ZC + 512 + h * 64 + 32);
            if (!is_ctx) rope32(t0, rope + (qpos & 63) * 16);
#pragma unroll
            for (int d = 0; d < 32; ++d) q[32 + d] = f2bf(t0[d]);
        }
#pragma unroll 1
        for (int dh = 0; dh < 2; ++dh) {
        float m = a.in[8][l * 4 + h], den = 1.0f;
        float o[32];
#pragma unroll
        for (int d = 0; d < 32; ++d) o[d] = 0.f;
        if (!is_ctx) {
            const bf16_t* VT = (const bf16_t*)(a.ws + WS_VT) + ((size_t)(b * 2 + kvh) * 64 + dh * 32) * 4096;
            const int slo = max(qpos - 128, 0), shi = min(qpos + 128, n - 1);
#pragma unroll 1
            for (int s = slo; s <= shi; ++s) {
                const float dot = 0.125f * kdot(Z + (size_t)(seq_row0 + s) * ZC + 768 + kvh * 64, q, rope + (s >> 6) * 16, rope + (s & 63) * 16, true);
                const float mn = fmaxf(m, dot), corr = __expf(m - mn), p = __expf(dot - mn);
                den = den * corr + p; m = mn;
#pragma unroll
                for (int d = 0; d < 32; ++d) o[d] = o[d] * corr + p * bf2f(VT[(size_t)d * 4096 + s]);
            }
        }
        {
            const bf16_t* VTC = (const bf16_t*)(a.ws + WS_VTC) + ((size_t)(b * 2 + kvh) * 64 + dh * 32) * 256;
#pragma unroll 1
            for (int j = 0; j < 256; ++j) {
                const float dot = 0.125f * kdot(Z + (size_t)(NLAT + b * 256 + j) * ZC + 768 + kvh * 64, q, rope, rope, false);
                const float mn = fmaxf(m, dot), corr = __expf(m - mn), p = __expf(dot - mn);
                den = den * corr + p; m = mn;
#pragma unroll
                for (int d = 0; d < 32; ++d) o[d] = o[d] * corr + p * bf2f(VTC[(size_t)d * 256 + j]);
            }
        }
        const float inv = 1.0f / den;
        bf16_t* dst = CAT + (size_t)(row0 + i) * D + 256 + h * 64 + dh * 32;
#pragma unroll
        for (int d8 = 0; d8 < 4; ++d8) { u32x4 pk; pk.x = pack2(o[8 * d8] * inv, o[8 * d8 + 1] * inv); pk.y = pack2(o[8 * d8 + 2] * inv, o[8 * d8 + 3] * inv);
            pk.z = pack2(o[8 * d8 + 4] * inv, o[8 * d8 + 5] * inv); pk.w = pack2(o[8 * d8 + 6] * inv, o[8 * d8 + 7] * inv); *(u32x4*)(dst + 8 * d8) = pk; }
        }
    }
    __syncthreads();
}

__device__ __forceinline__ void p2_mix(const Args& a, unsigned char* ldsg, LAS unsigned char* lds, int l) {
    const int n_dft = 256, n_dftc = (l == 0) ? 16 : 0, n_mix = 128 + ((l == 0) ? 8 : 0);
    bf16_t* CAT = (bf16_t*)(a.ws + WS_CAT);
    for (int u = blockIdx.x; u < n_dft + n_dftc + n_mix; u += gridDim.x) {
        if (u < n_dft) {
            const int mt = u >> 3, nt = u & 7, b = nt >> 1, ch0 = (nt & 1) * 128;
            const bf16_t* A = (const bf16_t*)(a.ws + WS_DFT) + (size_t)(mt * 128) * 8192;
            const bf16_t* B0 = (const bf16_t*)(a.ws + WS_AT) + ((size_t)b * 256 + ch0) * 8192;
            EpiBf16 E; E.C = CAT + (size_t)(b * 4096 + mt * 128) * D + ch0; E.ld = D;
            gemm_tile<128, false, EpiBf16>(lds, A, 8192, nullptr, 128, B0, B0 + (size_t)64 * 8192, 8192, 8192, E);
        } else if (u < n_dft + n_dftc) {
            const int uu = u - n_dft, b = uu >> 2, mt = (uu >> 1) & 1, ch0 = (uu & 1) * 128;
            const bf16_t* A = (const bf16_t*)(a.ws + WS_DFTC) + (size_t)(mt * 128) * 512;
            const bf16_t* B0 = (const bf16_t*)(a.ws + WS_ATC) + ((size_t)b * 256 + ch0) * 512;
            EpiBf16 E; E.C = CAT + (size_t)(NLAT + b * 256 + mt * 128) * D + ch0; E.ld = D;
            gemm_tile<128, false, EpiBf16>(lds, A, 512, nullptr, 128, B0, B0 + (size_t)64 * 512, 512, 512, E);
        } else {
            const int t = u - n_dft - n_dftc;
            if (t < 128) { const int b = t >> 5; mixer_tile(a, ldsg, l, t * 128, b * 4096, (t & 31) * 128, 4096, b, false); }
            else { const int tt = t - 128, b = tt >> 1; mixer_tile(a, ldsg, l, NLAT + tt * 128, NLAT + b * 256, (tt & 1) * 128, 256, b, true); }
        }
    }
}

__device__ __forceinline__ void p3_outproj(const Args& a, LAS unsigned char* lds, int l) {
    const int nrt = (l == 0) ? NTOK / 128 : NLAT / 128;
    const bf16_t* W = (const bf16_t*)(a.ws + WS_WOUT) + (size_t)l * 1024 * 1024;
    for (int u = blockIdx.x; u < nrt * 4; u += gridDim.x) {
        const int rt = u >> 2, ct = u & 3;
        EpiF32 E; E.C = (float*)(a.ws + WS_Y) + (size_t)(rt * 128) * D + ct * 256; E.ld = D;
        const bf16_t* B0 = W + (size_t)(ct * 256) * 1024;
        gemm_tile<256, false, EpiF32>(lds, (const bf16_t*)(a.ws + WS_CAT) + (size_t)(rt * 128) * D, D, nullptr, 128, B0, B0 + (size_t)128 * 1024, 1024, 1024, E);
    }
}

__device__ __forceinline__ void p4_ln1_router(const Args& a, unsigned char* lds, int l) {
    const int tid = threadIdx.x, lane = tid & 63, w = tid >> 6;
    const int ntok = (l == 0) ? NTOK : NLAT;
    int* cnt = (int*)(lds + 98304);
    if (tid < 32) cnt[tid] = 0;
    __syncthreads();
    const float* mod = (const float*)(a.ws + WS_MOD) + (size_t)l * 5 * 6144;
    const float* Y = (const float*)(a.ws + WS_Y);
    float* X1 = (float*)(a.ws + WS_X1);
    bf16_t* H = (bf16_t*)(a.ws + WS_H);
    const float* g1w = a.in[14] + l * 1024; const float* b1w = a.in[15] + l * 1024;
    const float* wrg = a.in[16] + (size_t)l * 1024 * 4; const float* wre = a.in[17] + (size_t)l * 1024 * 32;
    int* tokE = (int*)(a.ws + WS_TOKE); int* tokR = (int*)(a.ws + WS_TOKR); float* tokG = (float*)(a.ws + WS_TOKG);
    for (int t = blockIdx.x * 8 + w; t < ntok; t += gridDim.x * 8) {
        const float* xs = (l == 0) ? ((t < NLAT) ? a.in[0] + (size_t)t * D : a.in[2] + (size_t)(t - NLAT) * D) : (const float*)(a.ws + WS_XC) + (size_t)t * D;
        const float* m = mod + (size_t)((t < NLAT) ? (t >> 12) : 4) * 6144;
        f32x4 v[4];
#pragma unroll
        for (int i = 0; i < 4; ++i) { const int c = 256 * i + 4 * lane; const f32x4 xv = *(const f32x4*)(xs + c), yv = *(const f32x4*)(Y + (size_t)t * D + c), gv = *(const f32x4*)(m + 2048 + c);
#pragma unroll
            for (int e = 0; e < 4; ++e) v[i][e] = RES_ALPHA * xv[e] + gv[e] * yv[e]; }
        float mean, rstd; ln_stats(v, mean, rstd);
#pragma unroll
        for (int i = 0; i < 4; ++i) { const int c = 256 * i + 4 * lane; const f32x4 gg = *(const f32x4*)(g1w + c), bb = *(const f32x4*)(b1w + c);
#pragma unroll
            for (int e = 0; e < 4; ++e) v[i][e] = (v[i][e] - mean) * rstd * gg[e] + bb[e];
            *(f32x4*)(X1 + (size_t)t * D + c) = v[i]; }
        ln_stats(v, mean, rstd);
#pragma unroll
        for (int i = 0; i < 4; ++i) { const int c = 256 * i + 4 * lane; const f32x4 sh = *(const f32x4*)(m + 3072 + c), sc = *(const f32x4*)(m + 4096 + c);
#pragma unroll
            for (int e = 0; e < 4; ++e) v[i][e] = (v[i][e] - mean) * rstd * (1.0f + sc[e]) + sh[e];
            u32x2 pk; pk.x = pack2(v[i][0], v[i][1]); pk.y = pack2(v[i][2], v[i][3]); *(u32x2*)(H + (size_t)t * D + c) = pk; }
        float lg[4] = {0.f, 0.f, 0.f, 0.f};
#pragma unroll
        for (int i = 0; i < 4; ++i)
#pragma unroll
            for (int e = 0; e < 4; ++e) { const int c = 256 * i + 4 * lane + e; const f32x4 wv = *(const f32x4*)(wrg + (size_t)c * 4);
                lg[0] += v[i][e] * wv[0]; lg[1] += v[i][e] * wv[1]; lg[2] += v[i][e] * wv[2]; lg[3] += v[i][e] * wv[3]; }
#pragma unroll
        for (int q = 0; q < 4; ++q) lg[q] = wave_sum(lg[q]);
        int grp = 0; float mx = lg[0];
#pragma unroll
        for (int q = 1; q < 4; ++q) if (lg[q] > mx) { mx = lg[q]; grp = q; }
        float se = 0.f;
#pragma unroll
        for (int q = 0; q < 4; ++q) se += expf(lg[q] - mx);
        const float gate_group = 1.0f / se;
        float le[8] = {0.f, 0.f, 0.f, 0.f, 0.f, 0.f, 0.f, 0.f};
#pragma unroll
        for (int i = 0; i < 4; ++i)
#pragma unroll
            for (int e = 0; e < 4; ++e) { const int c = 256 * i + 4 * lane + e; const float* wp = wre + (size_t)c * 32 + grp * 8; const f32x4 w0 = *(const f32x4*)wp, w1 = *(const f32x4*)(wp + 4);
                le[0] += v[i][e] * w0[0]; le[1] += v[i][e] * w0[1]; le[2] += v[i][e] * w0[2]; le[3] += v[i][e] * w0[3];
                le[4] += v[i][e] * w1[0]; le[5] += v[i][e] * w1[1]; le[6] += v[i][e] * w1[2]; le[7] += v[i][e] * w1[3]; }
#pragma unroll
        for (int q = 0; q < 8; ++q) le[q] = wave_sum(le[q]);
        int j1 = 0; float l1 = le[0];
#pragma unroll
        for (int q = 1; q < 8; ++q) if (le[q] > l1) { l1 = le[q]; j1 = q; }
        int j2 = -1; float l2 = -3.0e38f;
#pragma unroll
        for (int q = 0; q < 8; ++q) if (q != j1 && le[q] > l2) { l2 = le[q]; j2 = q; }
        const float e2 = expf(l2 - l1), p1 = 1.0f / (1.0f + e2), p2 = e2 / (1.0f + e2);
        if (lane == 0) {
            const int ex0 = grp * 8 + j1, ex1 = grp * 8 + j2;
            const int r0 = atomicAdd(&cnt[ex0], 1), r1 = atomicAdd(&cnt[ex1], 1);
            tokE[2 * t] = ex0; tokE[2 * t + 1] = ex1; tokR[2 * t] = r0; tokR[2 * t + 1] = r1;
            tokG[2 * t] = gate_group * p1; tokG[2 * t + 1] = gate_group * p2;
        }
    }
    __syncthreads();
    if (tid < 32) ((int*)(a.ws + WS_BCNT))[((size_t)l * MAXG + blockIdx.x) * 32 + tid] = cnt[tid];
    __syncthreads();
}

__device__ __forceinline__ void p5_dispatch(const Args& a, unsigned char* lds, int l) {
    const int tid = threadIdx.x;
    const int ntok = (l == 0) ? NTOK : NLAT;
    int* part = (int*)lds;
    int* tot = (int*)(lds + 4096);
    int* off = (int*)(lds + 4096 + 128);
    int* pstart = (int*)(lds + 4096 + 256);
    const int* bc = (const int*)(a.ws + WS_BCNT) + (size_t)l * MAXG * 32;
    const int G = gridDim.x, me = blockIdx.x;
    { const int e = tid & 31, p = tid >> 5; int s = 0, so = 0; for (int bb = p; bb < G; bb += 16) { const int c = bc[bb * 32 + e]; s += c; if (bb < me) so += c; } part[p * 32 + e] = s; part[512 + p * 32 + e] = so; }
    __syncthreads();
    if (tid < 32) { int s = 0, so = 0; for (int p = 0; p < 16; ++p) { s += part[p * 32 + tid]; so += part[512 + p * 32 + tid]; } tot[tid] = s; off[tid] = so; }
    __syncthreads();
    if (tid == 0) { int acc = 0; for (int e = 0; e < 32; ++e) { pstart[e] = acc; acc += ((tot[e] + 127) >> 7) << 7; } }
    __syncthreads();
    if (me == 0 && tid < 32) ((int*)(a.ws + WS_CNT))[l * 32 + tid] = tot[tid];
    const int* tokE = (const int*)(a.ws + WS_TOKE); const int* tokR = (const int*)(a.ws + WS_TOKR);
    int* tokS = (int*)(a.ws + WS_TOKS); int* slotT = (int*)(a.ws + WS_SLOTT);
    for (int base = me * 8; base < ntok; base += G * 8) {
        if (tid < 16) { const int t = base + (tid >> 1); if (t < ntok) { const int idx = 2 * t + (tid & 1); const int e = tokE[idx]; const int slot = pstart[e] + off[e] + tokR[idx]; tokS[idx] = slot; slotT[slot] = t; } }
    }
    __syncthreads();
}

__device__ __forceinline__ int moe_table(const Args& a, unsigned char* lds, int l, int* blk) {
    const int* tot = (const int*)(a.ws + WS_CNT) + l * 32;
    if (threadIdx.x == 0) { int acc = 0; for (int e = 0; e < 32; ++e) { blk[e] = acc; acc += (tot[e] + 127) >> 7; } blk[32] = acc; }
    __syncthreads();
    return blk[32];
}

__device__ __forceinline__ void p6_gateup(const Args& a, unsigned char* ldsg, LAS unsigned char* lds, int l) {
    int* blk = (int*)(ldsg + 98304 + 256);
    const int nrb = moe_table(a, ldsg, l, blk);
    const int* tot = (const int*)(a.ws + WS_CNT) + l * 32;
    const bf16_t* WG = (const bf16_t*)(a.ws + WS_WEXP); const bf16_t* WU = WG + EXPMAT;
    for (int u = blockIdx.x; u < nrb * 4; u += gridDim.x) {
        const int rb = u >> 2, ct = u & 3;
        int e = 0; for (int q = 1; q < 32; ++q) if (blk[q] <= rb) e = q;
        const int valid = min(128, tot[e] - (rb - blk[e]) * 128);
        EpiGateUp E; E.C = (bf16_t*)(a.ws + WS_HID) + (size_t)(rb * 128) * DEXP + ct * 128; E.ld = DEXP;
        gemm_tile<256, true, EpiGateUp>(lds, (const bf16_t*)(a.ws + WS_H), D, (const int*)(a.ws + WS_SLOTT) + rb * 128, valid,
                                        WG + ((size_t)e * 512 + ct * 128) * 1024, WU + ((size_t)e * 512 + ct * 128) * 1024, 1024, 1024, E);
    }
    __syncthreads();
}
__device__ __forceinline__ void p7_down(const Args& a, unsigned char* ldsg, LAS unsigned char* lds, int l) {
    int* blk = (int*)(ldsg + 98304 + 256);
    const int nrb = moe_table(a, ldsg, l, blk);
    const bf16_t* WD = (const bf16_t*)(a.ws + WS_WEXP) + 2 * EXPMAT;
    for (int u = blockIdx.x; u < nrb * 4; u += gridDim.x) {
        const int rb = u >> 2, ct = u & 3;
        int e = 0; for (int q = 1; q < 32; ++q) if (blk[q] <= rb) e = q;
        EpiBf16 E; E.C = (bf16_t*)(a.ws + WS_YS) + (size_t)(rb * 128) * D + ct * 256; E.ld = D;
        const bf16_t* B0 = WD + ((size_t)e * 1024 + ct * 256) * 512;
        gemm_tile<256, false, EpiBf16>(lds, (const bf16_t*)(a.ws + WS_HID) + (size_t)(rb * 128) * DEXP, DEXP, nullptr, 128, B0, B0 + (size_t)128 * 512, 512, 512, E);
    }
    __syncthreads();
}

__device__ __forceinline__ void p8_ln2(const Args& a, unsigned char* lds, int l) {
    const int lane = threadIdx.x & 63, w = threadIdx.x >> 6;
    const int ntok = (l == 0) ? NTOK : NLAT;
    const float* mod = (const float*)(a.ws + WS_MOD) + (size_t)l * 5 * 6144;
    const float* modn = (const float*)(a.ws + WS_MOD) + (size_t)5 * 6144;
    const float* X1 = (const float*)(a.ws + WS_X1);
    const bf16_t* YS = (const bf16_t*)(a.ws + WS_YS);
    const int* tokS = (const int*)(a.ws + WS_TOKS); const float* tokG = (const float*)(a.ws + WS_TOKG);
    const float* g2w = a.in[21] + l * 1024; const float* b2w = a.in[22] + l * 1024;
    for (int t = blockIdx.x * 8 + w; t < ntok; t += gridDim.x * 8) {
        const float* m = mod + (size_t)((t < NLAT) ? (t >> 12) : 4) * 6144;
        const int s0 = tokS[2 * t], s1 = tokS[2 * t + 1]; const float ga = tokG[2 * t], gb = tokG[2 * t + 1];
        f32x4 v[4];
#pragma unroll
        for (int i = 0; i < 4; ++i) { const int c = 256 * i + 4 * lane; const f32x4 xv = *(const f32x4*)(X1 + (size_t)t * D + c), gv = *(const f32x4*)(m + 5120 + c);
            const u32x2 ya = *(const u32x2*)(YS + (size_t)s0 * D + c), yb = *(const u32x2*)(YS + (size_t)s1 * D + c);
            const float f0 = ga * lo2f(ya.x) + gb * lo2f(yb.x), f1 = ga * hi2f(ya.x) + gb * hi2f(yb.x), f2 = ga * lo2f(ya.y) + gb * lo2f(yb.y), f3 = ga * hi2f(ya.y) + gb * hi2f(yb.y);
            v[i][0] = RES_ALPHA * xv[0] + gv[0] * f0; v[i][1] = RES_ALPHA * xv[1] + gv[1] * f1; v[i][2] = RES_ALPHA * xv[2] + gv[2] * f2; v[i][3] = RES_ALPHA * xv[3] + gv[3] * f3; }
        float mean, rstd; ln_stats(v, mean, rstd);
        float* dst = (l == 0) ? (float*)(a.ws + WS_XC) + (size_t)t * D : a.out + (size_t)t * D;
#pragma unroll
        for (int i = 0; i < 4; ++i) { const int c = 256 * i + 4 * lane; const f32x4 gg = *(const f32x4*)(g2w + c), bb = *(const f32x4*)(b2w + c);
#pragma unroll
            for (int e = 0; e < 4; ++e) v[i][e] = (v[i][e] - mean) * rstd * gg[e] + bb[e];
            *(f32x4*)(dst + c) = v[i]; }
        if (l == 0) {
            const float* mn = modn + (size_t)((t < NLAT) ? (t >> 12) : 4) * 6144;
            ln_stats(v, mean, rstd);
            bf16_t* H = (bf16_t*)(a.ws + WS_H);
#pragma unroll
            for (int i = 0; i < 4; ++i) { const int c = 256 * i + 4 * lane; const f32x4 sh = *(const f32x4*)(mn + c), sc = *(const f32x4*)(mn + 1024 + c);
                f32x4 o;
#pragma unroll
                for (int e = 0; e < 4; ++e) o[e] = (v[i][e] - mean) * rstd * (1.0f + sc[e]) + sh[e];
                u32x2 pk; pk.x = pack2(o[0], o[1]); pk.y = pack2(o[2], o[3]); *(u32x2*)(H + (size_t)t * D + c) = pk; }
        }
    }
    if (l == 0) { __syncthreads(); for (int u = blockIdx.x; u < U_EXP; u += gridDim.x) exp_unit(a, lds, 1, u); }
}

constexpr int N_PHASES = 18;
template <int P> __device__ __forceinline__ void run_phase(const Args& a, unsigned char* smem, LAS unsigned char* lds, int l) {
    if (P == 0) p0_prologue(a, smem);
    if (P == 1) p_lnmod0(a);
    if (P == 2) p1_inproj(a, lds, l);
    if (P == 3) p2_mix(a, smem, lds, l);
    if (P == 4) p3_outproj(a, lds, l);
    if (P == 5) p4_ln1_router(a, smem, l);
    if (P == 6) p5_dispatch(a, smem, l);
    if (P == 7) p6_gateup(a, smem, lds, l);
    if (P == 8) p7_down(a, smem, lds, l);
    if (P == 9) p8_ln2(a, smem, l);
}
#if N_LAUNCH_MODE == 1
__global__ void __launch_bounds__(NT, 2) fwd(Args a) {
    extern __shared__ __attribute__((aligned(16))) unsigned char smem[];
    LAS unsigned char* lds = (LAS unsigned char*)smem;
    if (threadIdx.x < 4) ((volatile LAS unsigned*)(lds + 98304 + 512))[threadIdx.x] = 0u;
    __syncthreads();
    XcdBarrier bar = xcd_barrier_post((unsigned*)(a.ws + WS_BAR), (volatile LAS unsigned*)(lds + 98304 + 512));
    run_phase<0>(a, smem, lds, 0); xcd_barrier(bar);
    run_phase<1>(a, smem, lds, 0); xcd_barrier(bar);
    for (int l = 0; l < 2; ++l) {
        run_phase<2>(a, smem, lds, l); xcd_barrier(bar);
        run_phase<3>(a, smem, lds, l); xcd_barrier(bar);
        run_phase<4>(a, smem, lds, l); xcd_barrier(bar);
        run_phase<5>(a, smem, lds, l); xcd_barrier(bar);
        run_phase<6>(a, smem, lds, l); xcd_barrier(bar);
        run_phase<7>(a, smem, lds, l); xcd_barrier(bar);
        run_phase<8>(a, smem, lds, l); xcd_barrier(bar);
        run_phase<9>(a, smem, lds, l); if (l == 0) xcd_barrier(bar);
    }
}
#else
template <int P> __global__ void __launch_bounds__(NT, 2) k_phase(Args a) {
    extern __shared__ __attribute__((aligned(16))) unsigned char smem[];
    LAS unsigned char* lds = (LAS unsigned char*)smem;
    run_phase<P>(a, smem, lds, a.ph_lo);
}
template <int P> static void launch_phase(Args a, int l, int grid, hipStream_t stream) {
    static bool attr = false;
    if (!attr) { (void)hipFuncSetAttribute((const void*)k_phase<P>, hipFuncAttributeMaxDynamicSharedMemorySize, LDS_BYTES); attr = true; }
    a.ph_lo = l; a.ph_hi = P;
    hipLaunchKernelGGL(k_phase<P>, dim3(grid), dim3(NT), LDS_BYTES, stream, a);
}
#endif

extern "C" void kernel_launch(void* const* d_in, const int* in_sizes, int n_in, void* d_out, int out_size, void* d_ws, size_t ws_size, hipStream_t stream) {
    static int grid = 0;
    if (grid == 0) {
        if (n_in != 23 || out_size != NLAT * D || ws_size < WS_END) { fprintf(stderr, "kernel_launch: unexpected shapes (n_in %d, out %d, ws %zu, need %zu)\n", n_in, out_size, ws_size, (size_t)WS_END); grid = -1; return; }
        int dev = 0, cus = 0;
        if (hipGetDevice(&dev) != hipSuccess || hipDeviceGetAttribute(&cus, hipDeviceAttributeMultiprocessorCount, dev) != hipSuccess) { grid = -1; return; }
#if N_LAUNCH_MODE == 1
        int per_cu = 0;
        if (hipFuncSetAttribute((const void*)fwd, hipFuncAttributeMaxDynamicSharedMemorySize, LDS_BYTES) != hipSuccess) { fprintf(stderr, "kernel_launch: hipFuncSetAttribute failed\n"); grid = -1; return; }
        if (hipOccupancyMaxActiveBlocksPerMultiprocessor(&per_cu, (const void*)fwd, NT, LDS_BYTES) != hipSuccess || per_cu < 1) { fprintf(stderr, "kernel_launch: occupancy query says %d\n", per_cu); }
        (void)hipGetLastError();
#endif
        grid = cus; if (grid > MAXG) grid = MAXG;
    }
    if (grid < 0) return;
    (void)hipMemsetAsync((char*)d_ws + WS_BAR, 0, 16384 + 256, stream);
    Args a{};
    for (int i = 0; i < 23; ++i) a.in[i] = (const float*)d_in[i];
    a.out = (float*)d_out; a.ws = (unsigned char*)d_ws;
#if N_LAUNCH_MODE == 1
    a.ph_lo = 0; a.ph_hi = N_PHASES;
    hipLaunchKernelGGL(fwd, dim3(grid), dim3(NT), LDS_BYTES, stream, a);
#else
    launch_phase<0>(a, 0, grid, stream);
    launch_phase<1>(a, 0, grid, stream);
    for (int l = 0; l < 2; ++l) {
        launch_phase<2>(a, l, grid, stream); launch_phase<3>(a, l, grid, stream); launch_phase<4>(a, l, grid, stream); launch_phase<5>(a, l, grid, stream);
        launch_phase<6>(a, l, grid, stream); launch_phase<7>(a, l, grid, stream); launch_phase<8>(a, l, grid, stream); launch_phase<9>(a, l, grid, stream);
    }
#endif
}
```

```cpp
#include <hip/hip_runtime.h>
#include <stdint.h>
#include <stdio.h>

#ifndef NAIVE_GEMM
#define NAIVE_GEMM 0
#endif
#ifndef N_LAUNCH_MODE
#define N_LAUNCH_MODE 1
#endif

#define LAS __attribute__((address_space(3)))
typedef unsigned short bf16_t;
typedef short bf16x8 __attribute__((ext_vector_type(8)));
typedef float f32x4 __attribute__((ext_vector_type(4)));
typedef unsigned u32x4 __attribute__((ext_vector_type(4)));
typedef unsigned u32x2 __attribute__((ext_vector_type(2)));

constexpr int D = 1024, NBATCH = 4, SEQ = 4096, CTXL = 256;
constexpr int NLAT = NBATCH * SEQ, NCTX = NBATCH * CTXL, NTOK = NLAT + NCTX;
constexpr int ZC = 1792;
constexpr int NEXP = 32, DEXP = 512;
constexpr int NSLOT = 2 * NTOK + NEXP * 128;
constexpr int NT = 512;
constexpr int MAXG = 512;
constexpr float RES_ALPHA = 1.41421356237309515f;
constexpr int LDS_BYTES = 98304 + 1024;

constexpr size_t WS_BAR   = 0;
constexpr size_t WS_CNT   = 16384;
constexpr size_t WS_BCNT  = WS_CNT + 256;
constexpr size_t WS_MOD   = WS_BCNT + (size_t)2 * MAXG * 32 * 4;
constexpr size_t WS_ROPE  = WS_MOD + (size_t)2 * 5 * 6144 * 4;
constexpr size_t WS_TOKE  = WS_ROPE + 8192;
constexpr size_t WS_TOKR  = WS_TOKE + (size_t)NTOK * 8;
constexpr size_t WS_TOKS  = WS_TOKR + (size_t)NTOK * 8;
constexpr size_t WS_TOKG  = WS_TOKS + (size_t)NTOK * 8;
constexpr size_t WS_SLOTT = WS_TOKG + (size_t)NTOK * 8;
constexpr size_t WS_WIN   = WS_SLOTT + (size_t)NSLOT * 4;
constexpr size_t WS_WOUT  = WS_WIN + (size_t)2 * ZC * 1024 * 2;
constexpr size_t WS_WSGU  = WS_WOUT + (size_t)2 * 1024 * 1024 * 2;
constexpr size_t WS_DFT   = WS_WSGU + (size_t)2 * 4 * 128 * 128 * 2;
constexpr size_t WS_DFTC  = WS_DFT + (size_t)4096 * 8192 * 2;
constexpr size_t WS_WEXP  = WS_DFTC + (size_t)256 * 512 * 2;
constexpr size_t EXPMAT   = (size_t)NEXP * 512 * 1024;
constexpr size_t WS_X1    = WS_WEXP + 3 * EXPMAT * 2;
constexpr size_t WS_XC    = WS_X1 + (size_t)NTOK * D * 4;
constexpr size_t WS_H     = WS_XC + (size_t)NTOK * D * 4;
constexpr size_t WS_R     = WS_H + (size_t)NTOK * D * 2;
constexpr size_t WS_Z     = WS_R;
constexpr size_t WS_AT    = WS_Z + (size_t)NTOK * ZC * 2;
constexpr size_t WS_ATC   = WS_AT + (size_t)4 * 256 * 8192 * 2;
constexpr size_t WS_VT    = WS_ATC + (size_t)4 * 256 * 512 * 2;
constexpr size_t WS_VTC   = WS_VT + (size_t)4 * 2 * 64 * 4096 * 2;
constexpr size_t WS_CAT   = WS_VTC + (size_t)4 * 2 * 64 * 256 * 2;
constexpr size_t WS_REND  = WS_CAT + (size_t)NTOK * D * 2;
constexpr size_t WS_Y     = WS_R;
constexpr size_t WS_HID   = WS_R;
constexpr size_t WS_YS    = WS_HID + (size_t)NSLOT * DEXP * 2;
constexpr size_t WS_END   = WS_REND;
static_assert(WS_Y + (size_t)NTOK * D * 4 <= WS_CAT, "Y must not reach CAT");
static_assert(WS_YS + (size_t)NSLOT * D * 2 <= WS_REND, "YS must fit the region");
static_assert(WS_WIN % 256 == 0 && WS_DFT % 256 == 0 && WS_WEXP % 256 == 0 && WS_X1 % 256 == 0 && WS_H % 256 == 0 && WS_R % 256 == 0 && WS_AT % 256 == 0 && WS_CAT % 256 == 0 && WS_YS % 256 == 0, "alignment");

struct Args { const float* in[23]; float* out; unsigned char* ws; int ph_lo, ph_hi; };
#define CAS __attribute__((address_space(4)))
typedef const CAS Args* AP;

#define XB_TMO      128
#define XB_XCNT(j)  (256  + 64 * (j))
#define XB_XSUB(j)  (1280 + 64 * (j))
#define XB_XGEN(j)  (2304 + 64 * (j))
#define XB_TOP      3328
#define XB_TOPGEN   3392
#define XCD_BAR_WORDS 3456
#define XB_SPIN_CAP (1u << 18)

__device__ __forceinline__ unsigned xb_ld(unsigned* p)              { return __hip_atomic_load(p, __ATOMIC_RELAXED, __HIP_MEMORY_SCOPE_AGENT); }
__device__ __forceinline__ unsigned xb_add(unsigned* p, unsigned v) { return __hip_atomic_fetch_add(p, v, __ATOMIC_RELAXED, __HIP_MEMORY_SCOPE_AGENT); }
__device__ __forceinline__ unsigned xb_xcc_id() { return (unsigned)__builtin_amdgcn_s_getreg((3 << 11) | 20) & 0xFu; }
#define XB_SPIN(cond, bar) do { unsigned _sp = 0; while (cond) { __builtin_amdgcn_s_sleep(1); \
    if ((++_sp & 255u) == 0u) { if (xb_ld(&(bar)[XB_TMO])) break; if (_sp > XB_SPIN_CAP) { atomicAdd(&(bar)[XB_TMO], 1u); break; } } } } while (0)

struct XcdBarrier { unsigned* bar; unsigned x; volatile LAS unsigned* st; };

__device__ __forceinline__ XcdBarrier xcd_barrier_post(unsigned* bar, volatile LAS unsigned* st) {
    XcdBarrier b; b.bar = bar; b.x = xb_xcc_id(); b.st = st;
    if (threadIdx.x == 0) (void)xb_add(&bar[XB_XCNT(b.x)], 1u);
    return b;
}
__device__ __forceinline__ void xcd_barrier_complete(unsigned* bar, unsigned x, unsigned& nloc, unsigned& nx) {
    const unsigned G = gridDim.x * gridDim.y * gridDim.z;
    unsigned sum, cnt, mine, sp = 0u;
    for (;;) {
        sum = 0u; cnt = 0u; mine = 0u;
#pragma unroll
        for (unsigned j = 0; j < 16; ++j) { const unsigned c = xb_ld(&bar[XB_XCNT(j)]); sum += c; cnt += (c > 0u) ? 1u : 0u; mine = (j == x) ? c : mine; }
        if (sum == G) break;
        __builtin_amdgcn_s_sleep(1);
        if ((++sp & 255u) == 0u) { if (xb_ld(&bar[XB_TMO])) break; if (sp > XB_SPIN_CAP) { atomicAdd(&bar[XB_TMO], 1u); break; } }
    }
    nloc = mine > 0u ? mine : 1u; nx = cnt > 0u ? cnt : 1u;
}
__device__ __forceinline__ void xcd_barrier(const XcdBarrier& b) {
    asm volatile("s_waitcnt vmcnt(0)" ::: "memory");
    __syncthreads();
    if (threadIdx.x == 0) {
        unsigned* bar = b.bar;
        __builtin_amdgcn_s_waitcnt(0);
        unsigned nloc = b.st[0], nx = b.st[1];
        if (nloc == 0u) { xcd_barrier_complete(bar, b.x, nloc, nx); b.st[0] = nloc; b.st[1] = nx; }
        const unsigned old = xb_add(&bar[XB_XSUB(b.x)], 1u);
        const unsigned gen = old / nloc;
        if (old + 1u == (gen + 1u) * nloc) {
            __builtin_amdgcn_fence(__ATOMIC_RELEASE, "agent");
            asm volatile("s_waitcnt vmcnt(0)" ::: "memory");
            const unsigned og = xb_add(&bar[XB_TOP], 1u);
            const unsigned tg = og / nx;
            if (og + 1u == (tg + 1u) * nx) xb_add(&bar[XB_TOPGEN], 1u);
            else XB_SPIN(xb_ld(&bar[XB_TOPGEN]) == tg, bar);
            __builtin_amdgcn_fence(__ATOMIC_ACQUIRE, "agent");
            xb_add(&bar[XB_XGEN(b.x)], 1u);
            asm volatile("s_waitcnt vmcnt(0)" ::: "memory");
        } else {
            XB_SPIN(xb_ld(&bar[XB_XGEN(b.x)]) == gen, bar);
            __builtin_amdgcn_fence(__ATOMIC_ACQUIRE, "agent");
            asm volatile("s_waitcnt vmcnt(0)" ::: "memory");
        }
    }
    __syncthreads();
}

__device__ __forceinline__ int tid_opaque() { int t = threadIdx.x; asm volatile("" : "+v"(t)); return t; }
__device__ __forceinline__ float bf2f(bf16_t v) { return __uint_as_float(((unsigned)v) << 16); }
__device__ __forceinline__ bf16_t f2bf(float f) { unsigned u = __float_as_uint(f); u += 0x7FFFu + ((u >> 16) & 1u); return (bf16_t)(u >> 16); }
__device__ __forceinline__ unsigned pack2(float a, float b) { return (unsigned)f2bf(a) | ((unsigned)f2bf(b) << 16); }
__device__ __forceinline__ float lo2f(unsigned w) { return __uint_as_float(w << 16); }
__device__ __forceinline__ float hi2f(unsigned w) { return __uint_as_float(w & 0xffff0000u); }
__device__ __forceinline__ float wave_sum(float v) {
#pragma unroll
    for (int o = 32; o >= 1; o >>= 1) v += __shfl_xor(v, o);
    return v;
}
__device__ __forceinline__ float gelu_erf(float x) { return 0.5f * x * (1.0f + erff(x * 0.70710678118654752f)); }
__device__ __forceinline__ float silu_f(float x) { return x / (1.0f + __expf(-x)); }

__device__ __forceinline__ void ln_stats(const f32x4 (&v)[4], float& mean, float& rstd) {
    float s = 0.f;
#pragma unroll
    for (int i = 0; i < 4; ++i) s += (v[i][0] + v[i][1]) + (v[i][2] + v[i][3]);
    s = wave_sum(s); mean = s * (1.0f / 1024.0f);
    float q = 0.f;
#pragma unroll
    for (int i = 0; i < 4; ++i)
#pragma unroll
        for (int e = 0; e < 4; ++e) { const float d = v[i][e] - mean; q += d * d; }
    q = wave_sum(q); rstd = 1.0f / sqrtf(q * (1.0f / 1024.0f) + 1e-6f);
}

template <int BN> struct MfmaLayout {
    static constexpr int FG = BN / 128, NI = 4, NJ = 2 * FG;
    int rbase, cbase;
    __device__ __forceinline__ int row(int i) const { return rbase + 16 * i; }
    __device__ __forceinline__ int col(int jj) const { return (jj / FG) * (BN / 2) + (jj % FG) * 16 + cbase; }
};
template <int BN> struct NaiveLayout {
    static constexpr int TX = BN / 8, TY = NT / TX, NI = 128 / TY, NJ = 2;
    int ty, tx;
    __device__ __forceinline__ int row(int i) const { return ty + TY * i; }
    __device__ __forceinline__ int col(int jj) const { return jj * (BN / 2) + 4 * tx; }
};

__device__ __forceinline__ void glds16(const bf16_t* g, LAS unsigned char* l) {
    __builtin_amdgcn_global_load_lds((const unsigned*)g, (LAS unsigned*)l, 16, 0, 0);
}

template <int BN, bool GATHER, class Epi>
__device__ __forceinline__ void gemm_tile(LAS unsigned char* lds, const bf16_t* A, int lda, const int* rowidx, int valid_rows,
                                          const bf16_t* B0, const bf16_t* B1, int ldb, int K, const Epi& epi) {
    constexpr int A_B = 16384, B_B = BN * 128, STAGE = A_B + B_B, NBL = BN / 64;
    const int tid = tid_opaque(), lane = tid & 63, wid = __builtin_amdgcn_readfirstlane(tid >> 6);
    const bf16_t* ap[2]; const bf16_t* bp[NBL];
#pragma unroll
    for (int i = 0; i < 2; ++i) {
        const int P = i * 512 + tid, row = P >> 3, c = (P & 7) ^ ((row >> 1) & 7);
        size_t ro;
        if (GATHER) ro = (size_t)(row < valid_rows ? rowidx[row] : 0) * (size_t)lda; else ro = (size_t)row * (size_t)lda;
        ap[i] = A + ro + c * 8;
    }
#pragma unroll
    for (int i = 0; i < NBL; ++i) {
        const int P = i * 512 + tid, row = P >> 3, c = (P & 7) ^ ((row >> 1) & 7);
        const bf16_t* base = (row < BN / 2) ? (B0 + (size_t)row * ldb) : (B1 + (size_t)(row - BN / 2) * ldb);
        bp[i] = base + c * 8;
    }
    const int nk = K / 64;
#define GT_STAGE(buf, k0) do { \
        _Pragma("unroll") for (int _i = 0; _i < 2; ++_i) glds16(ap[_i] + (k0), lds + (buf) * STAGE + _i * 8192 + wid * 1024); \
        _Pragma("unroll") for (int _i = 0; _i < NBL; ++_i) glds16(bp[_i] + (k0), lds + (buf) * STAGE + A_B + _i * 8192 + wid * 1024); } while (0)

#if NAIVE_GEMM
    typedef NaiveLayout<BN> Lay;
    Lay lay; lay.tx = tid % Lay::TX; lay.ty = tid / Lay::TX;
    f32x4 acc[Lay::NI][Lay::NJ];
#pragma unroll
    for (int i = 0; i < Lay::NI; ++i)
#pragma unroll
        for (int j = 0; j < Lay::NJ; ++j) acc[i][j] = (f32x4){0.f, 0.f, 0.f, 0.f};
    GT_STAGE(0, 0);
    asm volatile("s_waitcnt vmcnt(0)" ::: "memory"); __syncthreads();
    for (int kt = 0; kt < nk; ++kt) {
        if (kt + 1 < nk) GT_STAGE((kt + 1) & 1, (kt + 1) * 64);
        const LAS unsigned char* sa = lds + (kt & 1) * STAGE; const LAS unsigned char* sb = sa + A_B;
#pragma unroll 1
        for (int kc = 0; kc < 8; ++kc)
#pragma unroll 1
            for (int hh = 0; hh < 2; ++hh) {
                float a[Lay::NI][4];
#pragma unroll
                for (int i = 0; i < Lay::NI; ++i) { const int row = lay.row(i);
                    const u32x2 w = *(const LAS u32x2*)(sa + row * 128 + ((kc ^ ((row >> 1) & 7)) << 4) + hh * 8);
                    a[i][0] = lo2f(w.x); a[i][1] = hi2f(w.x); a[i][2] = lo2f(w.y); a[i][3] = hi2f(w.y); }
#pragma unroll
                for (int j = 0; j < 2; ++j)
#pragma unroll
                    for (int e = 0; e < 4; ++e) { const int row = j * (BN / 2) + 4 * lay.tx + e;
                        const u32x2 w = *(const LAS u32x2*)(sb + row * 128 + ((kc ^ ((row >> 1) & 7)) << 4) + hh * 8);
                        const float b0 = lo2f(w.x), b1 = hi2f(w.x), b2 = lo2f(w.y), b3 = hi2f(w.y);
#pragma unroll
                        for (int i = 0; i < Lay::NI; ++i) acc[i][j][e] += (a[i][0] * b0 + a[i][1] * b1) + (a[i][2] * b2 + a[i][3] * b3); }
            }
        asm volatile("s_waitcnt vmcnt(0)" ::: "memory"); __syncthreads();
    }
    epi.run(acc, lay);
#else
    typedef MfmaLayout<BN> Lay;
    constexpr int FG = Lay::FG;
    const int fr = lane & 15, g = lane >> 4, wr = wid >> 2, wc = wid & 3;
    Lay lay; lay.rbase = wr * 64 + fr; lay.cbase = wc * 16 * FG + 4 * g;
    f32x4 acc[Lay::NI][Lay::NJ];
#pragma unroll
    for (int i = 0; i < Lay::NI; ++i)
#pragma unroll
        for (int j = 0; j < Lay::NJ; ++j) acc[i][j] = (f32x4){0.f, 0.f, 0.f, 0.f};
    int aoff[4], boff[Lay::NJ];
#pragma unroll
    for (int m = 0; m < 4; ++m) { const int row = wr * 64 + m * 16 + fr; aoff[m] = row * 128 + ((g ^ ((row >> 1) & 7)) << 4); }
#pragma unroll
    for (int jj = 0; jj < Lay::NJ; ++jj) { const int row = (jj / FG) * (BN / 2) + wc * 16 * FG + (jj % FG) * 16 + fr; boff[jj] = A_B + row * 128 + ((g ^ ((row >> 1) & 7)) << 4); }
    GT_STAGE(0, 0);
    asm volatile("s_waitcnt vmcnt(0)" ::: "memory"); __syncthreads();
    for (int kt = 0; kt < nk; ++kt) {
        if (kt + 1 < nk) GT_STAGE((kt + 1) & 1, (kt + 1) * 64);
        const LAS unsigned char* sa = lds + (kt & 1) * STAGE;
#pragma unroll
        for (int ks = 0; ks < 2; ++ks) {
            bf16x8 af[4], bfv[Lay::NJ];
#pragma unroll
            for (int m = 0; m < 4; ++m) af[m] = *(const LAS bf16x8*)(sa + (aoff[m] ^ (ks << 6)));
#pragma unroll
            for (int jj = 0; jj < Lay::NJ; ++jj) bfv[jj] = *(const LAS bf16x8*)(sa + (boff[jj] ^ (ks << 6)));
#pragma unroll
            for (int m = 0; m < 4; ++m)
#pragma unroll
                for (int jj = 0; jj < Lay::NJ; ++jj) acc[m][jj] = __builtin_amdgcn_mfma_f32_16x16x32_bf16(bfv[jj], af[m], acc[m][jj], 0, 0, 0);
        }
        asm volatile("s_waitcnt vmcnt(0)" ::: "memory"); __syncthreads();
    }
    epi.run(acc, lay);
#endif
#undef GT_STAGE
}

struct EpiF32 {
    float* C; int ld;
    template <class L> __device__ __forceinline__ void run(const f32x4 (&acc)[L::NI][L::NJ], const L& lay) const {
#pragma unroll
        for (int i = 0; i < L::NI; ++i)
#pragma unroll
            for (int j = 0; j < L::NJ; ++j) *(f32x4*)(C + (size_t)lay.row(i) * ld + lay.col(j)) = acc[i][j];
    }
};
struct EpiBf16 {
    bf16_t* C; int ld;
    template <class L> __device__ __forceinline__ void run(const f32x4 (&acc)[L::NI][L::NJ], const L& lay) const {
#pragma unroll
        for (int i = 0; i < L::NI; ++i)
#pragma unroll
            for (int j = 0; j < L::NJ; ++j) { u32x2 w; w.x = pack2(acc[i][j][0], acc[i][j][1]); w.y = pack2(acc[i][j][2], acc[i][j][3]);
                *(u32x2*)(C + (size_t)lay.row(i) * ld + lay.col(j)) = w; }
    }
};
struct EpiGateUp {
    bf16_t* C; int ld;
    template <class L> __device__ __forceinline__ void run(const f32x4 (&acc)[L::NI][L::NJ], const L& lay) const {
#pragma unroll
        for (int i = 0; i < L::NI; ++i)
#pragma unroll
            for (int j = 0; j < L::NJ / 2; ++j) { const f32x4 gt = acc[i][j], up = acc[i][j + L::NJ / 2];
                u32x2 w; w.x = pack2(silu_f(gt[0]) * up[0], silu_f(gt[1]) * up[1]); w.y = pack2(silu_f(gt[2]) * up[2], silu_f(gt[3]) * up[3]);
                *(u32x2*)(C + (size_t)lay.row(i) * ld + lay.col(j)) = w; }
    }
};
struct EpiInProj {
    bf16_t* Zt;
    bf16_t* tF;
    bf16_t* tV;
    int n0, pos0, n;
    template <class L> __device__ __forceinline__ void run(const f32x4 (&acc)[L::NI][L::NJ], const L& lay) const {
#pragma unroll
        for (int i = 0; i < L::NI; ++i)
#pragma unroll
            for (int j = 0; j < L::NJ; ++j) {
                const int r = lay.row(i), cl = lay.col(j), c = n0 + cl;
                const f32x4 v = acc[i][j];
                if (c < 512) {
                    const int part = c >> 8, ch = c & 255;
#pragma unroll
                    for (int e = 0; e < 4; ++e) tF[((size_t)(ch + e) * 2 + part) * n + pos0 + r] = f2bf(v[e]);
                } else {
                    u32x2 w; w.x = pack2(v[0], v[1]); w.y = pack2(v[2], v[3]);
                    *(u32x2*)(Zt + (size_t)r * ZC + cl) = w;
                    if (c >= 896 && c < 1024) {
#pragma unroll
                        for (int e = 0; e < 4; ++e) tV[(size_t)(c - 896 + e) * n + pos0 + r] = f2bf(v[e]);
                    }
                }
            }
    }
};

constexpr int U_ADA = 192, U_WIN = 2 * 16 * 28, U_WOUT = 2 * 16 * 16, U_SGU = 32, U_DFT = 4096 + 256, U_ROPE = 1, U_EXP = 3 * 32 * 128;
constexpr int LDS_SIL = 0, LDS_RED = 20480, LDS_TILE = 32768, LDS_T64 = 49408, LDS_CTAB = 50176;

__device__ __forceinline__ void ada_unit(AP a, unsigned char* lds, int u) {
    float* sil = (float*)(lds + LDS_SIL); float* red = (float*)(lds + LDS_RED);
    const int tid = tid_opaque(), lane = tid & 63, w = tid >> 6;
    const int l = u / 96, cg = u % 96;
    for (int i = tid; i < 5120; i += NT) { const int r = i >> 10, k = i & 1023; const float v = (r < 4) ? a->in[1][r * 1024 + k] : a->in[3][k]; sil[i] = v / (1.0f + expf(-v)); }
    __syncthreads();
    const float* W = a->in[4] + (size_t)l * 1024 * 6144 + cg * 64 + lane;
    float acc[5] = {0.f, 0.f, 0.f, 0.f, 0.f};
#pragma unroll 4
    for (int k = w * 128; k < w * 128 + 128; ++k) { const float wv = W[(size_t)k * 6144];
#pragma unroll
        for (int r = 0; r < 5; ++r) acc[r] += sil[r * 1024 + k] * wv; }
#pragma unroll
    for (int r = 0; r < 5; ++r) red[(w * 5 + r) * 64 + lane] = acc[r];
    __syncthreads();
    if (tid < 320) { const int r = tid >> 6; float s = 0.f;
#pragma unroll
        for (int ww = 0; ww < 8; ++ww) s += red[(ww * 5 + r) * 64 + lane];
        const int j = cg * 64 + lane; ((float*)(a->ws + WS_MOD))[(size_t)(l * 5 + r) * 6144 + j] = s + a->in[5][l * 6144 + j]; }
    __syncthreads();
}

__device__ __forceinline__ void tile_store_T(const float* tile, bf16_t* dst, int ldd) {
    const int tid = tid_opaque(), n = tid >> 3, kc = tid & 7;
    u32x4 w;
    w.x = pack2(tile[(kc * 8 + 0) * 65 + n], tile[(kc * 8 + 1) * 65 + n]); w.y = pack2(tile[(kc * 8 + 2) * 65 + n], tile[(kc * 8 + 3) * 65 + n]);
    w.z = pack2(tile[(kc * 8 + 4) * 65 + n], tile[(kc * 8 + 5) * 65 + n]); w.w = pack2(tile[(kc * 8 + 6) * 65 + n], tile[(kc * 8 + 7) * 65 + n]);
    *(u32x4*)(dst + (size_t)n * ldd + kc * 8) = w;
}
__device__ __forceinline__ void tile_load(float* tile, const float* src, int lds_) {
    const int tid = tid_opaque();
#pragma unroll
    for (int i = 0; i < 2; ++i) { const int row = (tid >> 4) + 32 * i, c4 = (tid & 15) * 4; const f32x4 v = *(const f32x4*)(src + (size_t)row * lds_ + c4);
        tile[row * 65 + c4 + 0] = v[0]; tile[row * 65 + c4 + 1] = v[1]; tile[row * 65 + c4 + 2] = v[2]; tile[row * 65 + c4 + 3] = v[3]; }
}

__device__ __forceinline__ void win_unit(AP a, unsigned char* lds, int u) {
    float* tile = (float*)(lds + LDS_TILE); float* T = (float*)(lds + LDS_T64);
    const int tid = tid_opaque();
    const int l = u / 448, r = u % 448, kb = r / 28, nb = r % 28;
    const float* Win = a->in[6] + (size_t)l * 1024 * 1536;
    const int srccol = (nb >= 8) ? nb * 64 - 256 : (nb & 3) * 64;
    tile_load(tile, Win + (size_t)(kb * 64) * 1536 + srccol, 1536);
    if (nb < 8 && tid < 64) { T[tid] = cospif((float)tid / 32.0f); T[64 + tid] = sinpif((float)tid / 32.0f); }
    __syncthreads();
    bf16_t* dst = (bf16_t*)(a->ws + WS_WIN) + ((size_t)l * ZC + nb * 64) * 1024 + kb * 64;
    if (nb >= 8) tile_store_T(tile, dst, 1024);
    else {
        const int n = tid >> 3, kc = tid & 7, part = nb >> 2; float o[8];
#pragma unroll
        for (int e = 0; e < 8; ++e) { float s = 0.f;
#pragma unroll 4
            for (int c = 0; c < 64; ++c) s += tile[(kc * 8 + e) * 65 + c] * T[part * 64 + ((c * n) & 63)]; o[e] = (part ? -s : s) * 0.125f; }
        u32x4 w; w.x = pack2(o[0], o[1]); w.y = pack2(o[2], o[3]); w.z = pack2(o[4], o[5]); w.w = pack2(o[6], o[7]);
        *(u32x4*)(dst + (size_t)n * 1024 + kc * 8) = w;
    }
    __syncthreads();
}

__device__ __forceinline__ void wout_unit(AP a, unsigned char* lds, int u) {
    float* tile = (float*)(lds + LDS_TILE);
    const int tid = tid_opaque();
    const int l = u / 256, r = u % 256, kb = r / 16, nb = r % 16;
    const float* Wo = a->in[13] + (size_t)l * 1024 * 1024;
    const int n = tid & 63, kq = __builtin_amdgcn_readfirstlane(tid >> 6);
    if (kb < 4) {
        const float* wf = a->in[7] + (size_t)l * 256 * 256 + (size_t)(kb * 64 + kq * 8) * 256;
        float acc[8] = {0.f, 0.f, 0.f, 0.f, 0.f, 0.f, 0.f, 0.f};
#pragma unroll 2
        for (int j = 0; j < 256; ++j) { const float wv = Wo[(size_t)j * 1024 + nb * 64 + n];
#pragma unroll
            for (int e = 0; e < 8; ++e) acc[e] += wf[e * 256 + j] * wv; }
#pragma unroll
        for (int e = 0; e < 8; ++e) tile[(kq * 8 + e) * 65 + n] = acc[e];
    } else if (kb >= 8 && kb < 12) {
        const int g = kb - 8;
        const float* wp = a->in[9] + ((size_t)(l * 4 + g) * 64 + kq * 8) * 64;
        const float* ps = a->in[10] + l * 256 + g * 64;
        float acc[8] = {0.f, 0.f, 0.f, 0.f, 0.f, 0.f, 0.f, 0.f};
#pragma unroll 2
        for (int d = 0; d < 64; ++d) { const float wv = ps[d] * Wo[(size_t)(512 + g * 64 + d) * 1024 + nb * 64 + n];
#pragma unroll
            for (int e = 0; e < 8; ++e) acc[e] += wp[e * 64 + d] * wv; }
#pragma unroll
        for (int e = 0; e < 8; ++e) tile[(kq * 8 + e) * 65 + n] = acc[e];
    } else tile_load(tile, Wo + (size_t)(kb * 64) * 1024 + nb * 64, 1024);
    __syncthreads();
    tile_store_T(tile, (bf16_t*)(a->ws + WS_WOUT) + ((size_t)l * 1024 + nb * 64) * 1024 + kb * 64, 1024);
    __syncthreads();
}

__device__ __forceinline__ void exp_unit(AP a, unsigned char* lds, int l, int u) {
    float* tile = (float*)(lds + LDS_TILE);
    const int mat = u / 4096, e = (u % 4096) / 128, t = u % 128;
    const int kb = (mat < 2) ? t / 8 : t / 16, nb = (mat < 2) ? t % 8 : t % 16;
    const int srcld = (mat < 2) ? 512 : 1024, dstld = (mat < 2) ? 1024 : 512;
    const float* src = a->in[18 + mat] + ((size_t)(l * 32 + e) * 512 * 1024) + (size_t)(kb * 64) * srcld + nb * 64;
    bf16_t* dst = (bf16_t*)(a->ws + WS_WEXP) + (size_t)mat * EXPMAT + (size_t)e * 512 * 1024 + (size_t)(nb * 64) * dstld + kb * 64;
    tile_load(tile, src, srcld);
    __syncthreads();
    tile_store_T(tile, dst, dstld);
    __syncthreads();
}

__device__ __forceinline__ void p0_prologue(AP a, unsigned char* lds) {
    const int tid = tid_opaque();
    bool have_tab = false;
    constexpr int E0 = U_ADA, E1 = E0 + U_WIN, E2 = E1 + U_WOUT, E3 = E2 + U_SGU, E4 = E3 + U_DFT, E5 = E4 + U_ROPE, E6 = E5 + U_EXP;
    for (int u = blockIdx.x; u < E6; u += gridDim.x) {
        if (u < E0) ada_unit(a, lds, u);
        else if (u < E1) win_unit(a, lds, u - E0);
        else if (u < E2) wout_unit(a, lds, u - E1);
        else if (u < E3) { const size_t i0 = (size_t)(u - E2) * 4096 + tid * 8; const float* s = a->in[11] + i0; bf16_t* d = (bf16_t*)(a->ws + WS_WSGU) + i0;
            const f32x4 v0 = *(const f32x4*)s, v1 = *(const f32x4*)(s + 4); u32x4 w; w.x = pack2(v0[0], v0[1]); w.y = pack2(v0[2], v0[3]); w.z = pack2(v1[0], v1[1]); w.w = pack2(v1[2], v1[3]); *(u32x4*)d = w; }
        else if (u < E4) {
            float* ctab = (float*)(lds + LDS_CTAB);
            if (!have_tab) { for (int i = tid; i < 4096; i += NT) ctab[i] = cospif((float)i / 2048.0f); __syncthreads(); have_tab = true; }
            const int k = u - E3;
            if (k < 4096) {
                const int n0 = tid * 8; float c[8], s[8];
#pragma unroll
                for (int e = 0; e < 8; ++e) { const int idx = (k * (n0 + e)) & 4095; c[e] = ctab[idx] * (1.0f / 64.0f); s[e] = ctab[(idx - 1024) & 4095] * (1.0f / 64.0f); }
                bf16_t* d = (bf16_t*)(a->ws + WS_DFT) + (size_t)k * 8192 + n0;
                u32x4 w; w.x = pack2(c[0], c[1]); w.y = pack2(c[2], c[3]); w.z = pack2(c[4], c[5]); w.w = pack2(c[6], c[7]); *(u32x4*)d = w;
                w.x = pack2(s[0], s[1]); w.y = pack2(s[2], s[3]); w.z = pack2(s[4], s[5]); w.w = pack2(s[6], s[7]); *(u32x4*)(d + 4096) = w;
            } else if (tid < 32) {
                const int kk = k - 4096, n0 = tid * 8; float c[8], s[8];
#pragma unroll
                for (int e = 0; e < 8; ++e) { const int idx = ((kk * (n0 + e)) & 255) * 16; c[e] = ctab[idx] * (1.0f / 16.0f); s[e] = ctab[(idx - 1024) & 4095] * (1.0f / 16.0f); }
                bf16_t* d = (bf16_t*)(a->ws + WS_DFTC) + (size_t)kk * 512 + n0;
                u32x4 w; w.x = pack2(c[0], c[1]); w.y = pack2(c[2], c[3]); w.z = pack2(c[4], c[5]); w.w = pack2(c[6], c[7]); *(u32x4*)d = w;
                w.x = pack2(s[0], s[1]); w.y = pack2(s[2], s[3]); w.z = pack2(s[4], s[5]); w.w = pack2(s[6], s[7]); *(u32x4*)(d + 256) = w;
            }
        }
        else if (u < E5) {
            for (int i = tid; i < 1024; i += NT) { const int pos = i >> 4, f = i & 15; const float freq = powf(10000.0f, -(float)f / 16.0f); const float ang = (float)pos * freq;
                ((float2*)(a->ws + WS_ROPE))[i] = make_float2(cosf(ang), sinf(ang)); }
        }
        else exp_unit(a, lds, 0, u - E5);
    }
}

__device__ __forceinline__ void p_lnmod0(AP a) {
    const int tid = tid_opaque(), lane = tid & 63, w = tid >> 6;
    const float* mod = (const float*)(a->ws + WS_MOD);
    bf16_t* H = (bf16_t*)(a->ws + WS_H);
    for (int t = blockIdx.x * 8 + w; t < NTOK; t += gridDim.x * 8) {
        const float* src = (t < NLAT) ? a->in[0] + (size_t)t * D : a->in[2] + (size_t)(t - NLAT) * D;
        const float* m = mod + (size_t)((t < NLAT) ? (t >> 12) : 4) * 6144;
        f32x4 v[4];
#pragma unroll
        for (int i = 0; i < 4; ++i) v[i] = *(const f32x4*)(src + 256 * i + 4 * lane);
        float mean, rstd; ln_stats(v, mean, rstd);
#pragma unroll
        for (int i = 0; i < 4; ++i) { const int c = 256 * i + 4 * lane; const f32x4 sh = *(const f32x4*)(m + c), sc = *(const f32x4*)(m + 1024 + c);
            f32x4 o;
#pragma unroll
            for (int e = 0; e < 4; ++e) o[e] = (v[i][e] - mean) * rstd * (1.0f + sc[e]) + sh[e];
            u32x2 pk; pk.x = pack2(o[0], o[1]); pk.y = pack2(o[2], o[3]); *(u32x2*)(H + (size_t)t * D + c) = pk; }
    }
}

__device__ __forceinline__ void p1_inproj(AP a, LAS unsigned char* lds, int l) {
    const int n_lat = 128 * 7, n_ctx = (l == 0) ? 8 * 7 : 8;
    const bf16_t* H = (const bf16_t*)(a->ws + WS_H);
    const bf16_t* W = (const bf16_t*)(a->ws + WS_WIN) + (size_t)l * ZC * 1024;
    for (int u = blockIdx.x; u < n_lat + n_ctx; u += gridDim.x) {
        int row0, b, pos0, ct, n; bf16_t *tF, *tV;
        if (u < n_lat) { const int rt = u / 7; ct = u % 7; row0 = rt * 128; b = row0 >> 12; pos0 = row0 & 4095; n = 4096;
            tF = (bf16_t*)(a->ws + WS_AT) + (size_t)b * 256 * 2 * 4096; tV = (bf16_t*)(a->ws + WS_VT) + (size_t)b * 128 * 4096; }
        else { const int uu = u - n_lat; int rt; if (l == 0) { rt = uu / 7; ct = uu % 7; } else { rt = uu; ct = 3; }
            row0 = NLAT + rt * 128; b = rt >> 1; pos0 = (rt & 1) * 128; n = 256;
            tF = (bf16_t*)(a->ws + WS_ATC) + (size_t)b * 256 * 2 * 256; tV = (bf16_t*)(a->ws + WS_VTC) + (size_t)b * 128 * 256; }
        EpiInProj E; E.Zt = (bf16_t*)(a->ws + WS_Z) + (size_t)row0 * ZC + ct * 256; E.tF = tF; E.tV = tV; E.n0 = ct * 256; E.pos0 = pos0; E.n = n;
        const bf16_t* B0 = W + (size_t)(ct * 256) * 1024;
        gemm_tile<256, false, EpiInProj>(lds, H + (size_t)row0 * D, D, nullptr, 128, B0, B0 + (size_t)128 * 1024, 1024, 1024, E);
    }
}

__device__ __forceinline__ void rope32(float (&t)[32], const float2* tab) {
#pragma unroll
    for (int f = 0; f < 16; ++f) { const float2 cs = tab[f]; const float t1 = t[f], t2 = t[16 + f]; t[f] = t1 * cs.x - t2 * cs.y; t[16 + f] = t1 * cs.y + t2 * cs.x; }
}
__device__ __forceinline__ void load32(float (&t)[32], const bf16_t* p) {
#pragma unroll
    for (int q = 0; q < 4; ++q) { const u32x4 w = *(const u32x4*)(p + 8 * q);
        t[8 * q + 0] = lo2f(w.x); t[8 * q + 1] = hi2f(w.x); t[8 * q + 2] = lo2f(w.y); t[8 * q + 3] = hi2f(w.y);
        t[8 * q + 4] = lo2f(w.z); t[8 * q + 5] = hi2f(w.z); t[8 * q + 6] = lo2f(w.w); t[8 * q + 7] = hi2f(w.w); }
}

__device__ __forceinline__ float kdot(const bf16_t* kp, const bf16_t* q, const float2* tab0, const float2* tab1, bool do_rope) {
    float dot = 0.f;
#pragma unroll 1
    for (int ax = 0; ax < 2; ++ax) {
        const float2* tab = ax ? tab1 : tab0;
#pragma unroll 1
        for (int h8 = 0; h8 < 2; ++h8) {
            const u32x4 wl = *(const u32x4*)(kp + ax * 32 + h8 * 8), wh = *(const u32x4*)(kp + ax * 32 + 16 + h8 * 8);
            const float tl[8] = {lo2f(wl.x), hi2f(wl.x), lo2f(wl.y), hi2f(wl.y), lo2f(wl.z), hi2f(wl.z), lo2f(wl.w), hi2f(wl.w)};
            const float th[8] = {lo2f(wh.x), hi2f(wh.x), lo2f(wh.y), hi2f(wh.y), lo2f(wh.z), hi2f(wh.z), lo2f(wh.w), hi2f(wh.w)};
#pragma unroll
            for (int j = 0; j < 8; ++j) {
                float r1 = tl[j], r2 = th[j];
                if (do_rope) { const float2 cs = tab[h8 * 8 + j]; r1 = tl[j] * cs.x - th[j] * cs.y; r2 = tl[j] * cs.y + th[j] * cs.x; }
                dot += bf2f(q[ax * 32 + h8 * 8 + j]) * r1 + bf2f(q[ax * 32 + 16 + h8 * 8 + j]) * r2;
            }
        }
    }
    return dot;
}

__device__ __forceinline__ void mixer_tile(AP a, unsigned char* lds, int l, int row0, int seq_row0, int pos0, int n, int b, bool is_ctx) {
    const int tid = tid_opaque(), lane = tid & 63, w = tid >> 6;
    const bf16_t* Z = (const bf16_t*)(a->ws + WS_Z);
    bf16_t* CAT = (bf16_t*)(a->ws + WS_CAT);
    {
        const int c = tid & 255, half = tid >> 8, g = c >> 6, hw = 1 << g;
        for (int tl = half * 64; tl < half * 64 + 64; ++tl) {
            const int pos = pos0 + tl; const int lo = max(pos - hw, 0), hi = min(pos + hw, n);
            float s = 0.f; for (int j = lo; j < hi; ++j) s += bf2f(Z[(size_t)(seq_row0 + j) * ZC + 1024 + c]);
            const float self = bf2f(Z[(size_t)(seq_row0 + pos) * ZC + 1024 + c]);
            CAT[(size_t)(row0 + tl) * D + 512 + c] = f2bf(s / (float)(hi - lo) - self);
        }
    }
    bf16_t* vT = (bf16_t*)lds;
    for (int q = w; q < 128; q += 8) {
        const u32x2 gw = *(const u32x2*)(Z + (size_t)(row0 + q) * ZC + 1536 + 4 * lane);
        float gv[4] = {gelu_erf(lo2f(gw.x)), gelu_erf(hi2f(gw.x)), gelu_erf(lo2f(gw.y)), gelu_erf(hi2f(gw.y))};
        float s = wave_sum((gv[0] + gv[1]) + (gv[2] + gv[3])); const float mean = s * (1.0f / 256.0f);
        float qq = 0.f;
#pragma unroll
        for (int e = 0; e < 4; ++e) { const float d = gv[e] - mean; qq += d * d; }
        qq = wave_sum(qq); const float rstd = 1.0f / sqrtf(qq * (1.0f / 256.0f) + 1e-6f);
#pragma unroll
        for (int e = 0; e < 4; ++e) vT[(4 * lane + e) * 128 + q] = f2bf((gv[e] - mean) * rstd);
    }
    __syncthreads();
    {
        const int c = tid & 255, ph = tid >> 8, h = c >> 6;
        const bf16_t* Ws = (const bf16_t*)(a->ws + WS_WSGU) + (size_t)(l * 4 + h) * 128 * 128;
        const float* bs = a->in[12] + (size_t)(l * 4 + h) * 128;
        for (int p = ph * 64; p < ph * 64 + 64; ++p) {
            float s = 0.f;
#pragma unroll 2
            for (int q8 = 0; q8 < 16; ++q8) {
                const u32x4 ww = *(const u32x4*)(Ws + (size_t)p * 128 + q8 * 8);
                const u32x4 vv = *(const u32x4*)(vT + c * 128 + q8 * 8);
                s += lo2f(ww.x) * lo2f(vv.x) + hi2f(ww.x) * hi2f(vv.x) + lo2f(ww.y) * lo2f(vv.y) + hi2f(ww.y) * hi2f(vv.y)
                   + lo2f(ww.z) * lo2f(vv.z) + hi2f(ww.z) * hi2f(vv.z) + lo2f(ww.w) * lo2f(vv.w) + hi2f(ww.w) * hi2f(vv.w);
            }
            const float uv = gelu_erf(bf2f(Z[(size_t)(row0 + p) * ZC + 1280 + c]));
            CAT[(size_t)(row0 + p) * D + 768 + c] = f2bf(uv * (s + bs[p]));
        }
    }
    __syncthreads();
    {
        const int i = tid & 127, h = tid >> 7, kvh = h >> 1;
        const float2* rope = (const float2*)(a->ws + WS_ROPE);
        const int qpos = pos0 + i;
        bf16_t* q = (bf16_t*)lds + tid * 66;
        {
            float t0[32];
            load32(t0, Z + (size_t)(row0 + i) * ZC + 512 + h * 64);
            if (!is_ctx) rope32(t0, rope + (qpos >> 6) * 16);
#pragma unroll
            for (int d = 0; d < 32; ++d) q[d] = f2bf(t0[d]);
            load32(t0, Z + (size_t)(row0 + i) * ZC + 512 + h * 64 + 32);
            if (!is_ctx) rope32(t0, rope + (qpos & 63) * 16);
#pragma unroll
            for (int d = 0; d < 32; ++d) q[32 + d] = f2bf(t0[d]);
        }
#pragma unroll 1
        for (int dh = 0; dh < 2; ++dh) {
        float m = a->in[8][l * 4 + h], den = 1.0f;
        float o[32];
#pragma unroll
        for (int d = 0; d < 32; ++d) o[d] = 0.f;
        if (!is_ctx) {
            const bf16_t* VT = (const bf16_t*)(a->ws + WS_VT) + ((size_t)(b * 2 + kvh) * 64 + dh * 32) * 4096;
            const int slo = max(qpos - 128, 0), shi = min(qpos + 128, n - 1);
#pragma unroll 1
            for (int s = slo; s <= shi; ++s) {
                const float dot = 0.125f * kdot(Z + (size_t)(seq_row0 + s) * ZC + 768 + kvh * 64, q, rope + (s >> 6) * 16, rope + (s & 63) * 16, true);
                const float mn = fmaxf(m, dot), corr = __expf(m - mn), p = __expf(dot - mn);
                den = den * corr + p; m = mn;
#pragma unroll
                for (int d = 0; d < 32; ++d) o[d] = o[d] * corr + p * bf2f(VT[(size_t)d * 4096 + s]);
            }
        }
        {
            const bf16_t* VTC = (const bf16_t*)(a->ws + WS_VTC) + ((size_t)(b * 2 + kvh) * 64 + dh * 32) * 256;
#pragma unroll 1
            for (int j = 0; j < 256; ++j) {
                const float dot = 0.125f * kdot(Z + (size_t)(NLAT + b * 256 + j) * ZC + 768 + kvh * 64, q, rope, rope, false);
                const float mn = fmaxf(m, dot), corr = __expf(m - mn), p = __expf(dot - mn);
                den = den * corr + p; m = mn;
#pragma unroll
                for (int d = 0; d < 32; ++d) o[d] = o[d] * corr + p * bf2f(VTC[(size_t)d * 256 + j]);
            }
        }
        const float inv = 1.0f / den;
        bf16_t* dst = CAT + (size_t)(row0 + i) * D + 256 + h * 64 + dh * 32;
#pragma unroll
        for (int d8 = 0; d8 < 4; ++d8) { u32x4 pk; pk.x = pack2(o[8 * d8] * inv, o[8 * d8 + 1] * inv); pk.y = pack2(o[8 * d8 + 2] * inv, o[8 * d8 + 3] * inv);
            pk.z = pack2(o[8 * d8 + 4] * inv, o[8 * d8 + 5] * inv); pk.w = pack2(o[8 * d8 + 6] * inv, o[8 * d8 + 7] * inv); *(u32x4*)(dst + 8 * d8) = pk; }
        }
    }
    __syncthreads();
}

__device__ __forceinline__ void p2_mix(AP a, unsigned char* ldsg, LAS unsigned char* lds, int l) {
    const int n_dft = 256, n_dftc = (l == 0) ? 16 : 0, n_mix = 128 + ((l == 0) ? 8 : 0);
    bf16_t* CAT = (bf16_t*)(a->ws + WS_CAT);
    for (int u = blockIdx.x; u < n_dft + n_dftc + n_mix; u += gridDim.x) {
        if (u < n_dft) {
            const int mt = u >> 3, nt = u & 7, b = nt >> 1, ch0 = (nt & 1) * 128;
            const bf16_t* A = (const bf16_t*)(a->ws + WS_DFT) + (size_t)(mt * 128) * 8192;
            const bf16_t* B0 = (const bf16_t*)(a->ws + WS_AT) + ((size_t)b * 256 + ch0) * 8192;
            EpiBf16 E; E.C = CAT + (size_t)(b * 4096 + mt * 128) * D + ch0; E.ld = D;
            gemm_tile<128, false, EpiBf16>(lds, A, 8192, nullptr, 128, B0, B0 + (size_t)64 * 8192, 8192, 8192, E);
        } else if (u < n_dft + n_dftc) {
            const int uu = u - n_dft, b = uu >> 2, mt = (uu >> 1) & 1, ch0 = (uu & 1) * 128;
            const bf16_t* A = (const bf16_t*)(a->ws + WS_DFTC) + (size_t)(mt * 128) * 512;
            const bf16_t* B0 = (const bf16_t*)(a->ws + WS_ATC) + ((size_t)b * 256 + ch0) * 512;
            EpiBf16 E; E.C = CAT + (size_t)(NLAT + b * 256 + mt * 128) * D + ch0; E.ld = D;
            gemm_tile<128, false, EpiBf16>(lds, A, 512, nullptr, 128, B0, B0 + (size_t)64 * 512, 512, 512, E);
        } else {
            const int t = u - n_dft - n_dftc;
            if (t < 128) { const int b = t >> 5; mixer_tile(a, ldsg, l, t * 128, b * 4096, (t & 31) * 128, 4096, b, false); }
            else { const int tt = t - 128, b = tt >> 1; mixer_tile(a, ldsg, l, NLAT + tt * 128, NLAT + b * 256, (tt & 1) * 128, 256, b, true); }
        }
    }
}

__device__ __forceinline__ void p3_outproj(AP a, LAS unsigned char* lds, int l) {
    const int nrt = (l == 0) ? NTOK / 128 : NLAT / 128;
    const bf16_t* W = (const bf16_t*)(a->ws + WS_WOUT) + (size_t)l * 1024 * 1024;
    for (int u = blockIdx.x; u < nrt * 4; u += gridDim.x) {
        const int rt = u >> 2, ct = u & 3;
        EpiF32 E; E.C = (float*)(a->ws + WS_Y) + (size_t)(rt * 128) * D + ct * 256; E.ld = D;
        const bf16_t* B0 = W + (size_t)(ct * 256) * 1024;
        gemm_tile<256, false, EpiF32>(lds, (const bf16_t*)(a->ws + WS_CAT) + (size_t)(rt * 128) * D, D, nullptr, 128, B0, B0 + (size_t)128 * 1024, 1024, 1024, E);
    }
}

__device__ __forceinline__ void p4_ln1_router(AP a, unsigned char* lds, int l) {
    const int tid = tid_opaque(), lane = tid & 63, w = tid >> 6;
    const int ntok = (l == 0) ? NTOK : NLAT;
    int* cnt = (int*)(lds + 98304);
    if (tid < 32) cnt[tid] = 0;
    __syncthreads();
    const float* mod = (const float*)(a->ws + WS_MOD) + (size_t)l * 5 * 6144;
    const float* Y = (const float*)(a->ws + WS_Y);
    float* X1 = (float*)(a->ws + WS_X1);
    bf16_t* H = (bf16_t*)(a->ws + WS_H);
    const float* g1w = a->in[14] + l * 1024; const float* b1w = a->in[15] + l * 1024;
    const float* wrg = a->in[16] + (size_t)l * 1024 * 4; const float* wre = a->in[17] + (size_t)l * 1024 * 32;
    int* tokE = (int*)(a->ws + WS_TOKE); int* tokR = (int*)(a->ws + WS_TOKR); float* tokG = (float*)(a->ws + WS_TOKG);
    for (int t = blockIdx.x * 8 + w; t < ntok; t += gridDim.x * 8) {
        const float* xs = (l == 0) ? ((t < NLAT) ? a->in[0] + (size_t)t * D : a->in[2] + (size_t)(t - NLAT) * D) : (const float*)(a->ws + WS_XC) + (size_t)t * D;
        const float* m = mod + (size_t)((t < NLAT) ? (t >> 12) : 4) * 6144;
        f32x4 v[4];
#pragma unroll
        for (int i = 0; i < 4; ++i) { const int c = 256 * i + 4 * lane; const f32x4 xv = *(const f32x4*)(xs + c), yv = *(const f32x4*)(Y + (size_t)t * D + c), gv = *(const f32x4*)(m + 2048 + c);
#pragma unroll
            for (int e = 0; e < 4; ++e) v[i][e] = RES_ALPHA * xv[e] + gv[e] * yv[e]; }
        float mean, rstd; ln_stats(v, mean, rstd);
#pragma unroll
        for (int i = 0; i < 4; ++i) { const int c = 256 * i + 4 * lane; const f32x4 gg = *(const f32x4*)(g1w + c), bb = *(const f32x4*)(b1w + c);
#pragma unroll
            for (int e = 0; e < 4; ++e) v[i][e] = (v[i][e] - mean) * rstd * gg[e] + bb[e];
            *(f32x4*)(X1 + (size_t)t * D + c) = v[i]; }
        ln_stats(v, mean, rstd);
#pragma unroll
        for (int i = 0; i < 4; ++i) { const int c = 256 * i + 4 * lane; const f32x4 sh = *(const f32x4*)(m + 3072 + c), sc = *(const f32x4*)(m + 4096 + c);
#pragma unroll
            for (int e = 0; e < 4; ++e) v[i][e] = (v[i][e] - mean) * rstd * (1.0f + sc[e]) + sh[e];
            u32x2 pk; pk.x = pack2(v[i][0], v[i][1]); pk.y = pack2(v[i][2], v[i][3]); *(u32x2*)(H + (size_t)t * D + c) = pk; }
        float lg[4] = {0.f, 0.f, 0.f, 0.f};
#pragma unroll
        for (int i = 0; i < 4; ++i)
#pragma unroll
            for (int e = 0; e < 4; ++e) { const int c = 256 * i + 4 * lane + e; const f32x4 wv = *(const f32x4*)(wrg + (size_t)c * 4);
                lg[0] += v[i][e] * wv[0]; lg[1] += v[i][e] * wv[1]; lg[2] += v[i][e] * wv[2]; lg[3] += v[i][e] * wv[3]; }
#pragma unroll
        for (int q = 0; q < 4; ++q) lg[q] = wave_sum(lg[q]);
        int grp = 0; float mx = lg[0];
#pragma unroll
        for (int q = 1; q < 4; ++q) if (lg[q] > mx) { mx = lg[q]; grp = q; }
        float se = 0.f;
#pragma unroll
        for (int q = 0; q < 4; ++q) se += expf(lg[q] - mx);
        const float gate_group = 1.0f / se;
        float le[8] = {0.f, 0.f, 0.f, 0.f, 0.f, 0.f, 0.f, 0.f};
#pragma unroll
        for (int i = 0; i < 4; ++i)
#pragma unroll
            for (int e = 0; e < 4; ++e) { const int c = 256 * i + 4 * lane + e; const float* wp = wre + (size_t)c * 32 + grp * 8; const f32x4 w0 = *(const f32x4*)wp, w1 = *(const f32x4*)(wp + 4);
                le[0] += v[i][e] * w0[0]; le[1] += v[i][e] * w0[1]; le[2] += v[i][e] * w0[2]; le[3] += v[i][e] * w0[3];
                le[4] += v[i][e] * w1[0]; le[5] += v[i][e] * w1[1]; le[6] += v[i][e] * w1[2]; le[7] += v[i][e] * w1[3]; }
#pragma unroll
        for (int q = 0; q < 8; ++q) le[q] = wave_sum(le[q]);
        int j1 = 0; float l1 = le[0];
#pragma unroll
        for (int q = 1; q < 8; ++q) if (le[q] > l1) { l1 = le[q]; j1 = q; }
        int j2 = -1; float l2 = -3.0e38f;
#pragma unroll
        for (int q = 0; q < 8; ++q) if (q != j1 && le[q] > l2) { l2 = le[q]; j2 = q; }
        const float e2 = expf(l2 - l1), p1 = 1.0f / (1.0f + e2), p2 = e2 / (1.0f + e2);
        if (lane == 0) {
            const int ex0 = grp * 8 + j1, ex1 = grp * 8 + j2;
            const int r0 = atomicAdd(&cnt[ex0], 1), r1 = atomicAdd(&cnt[ex1], 1);
            tokE[2 * t] = ex0; tokE[2 * t + 1] = ex1; tokR[2 * t] = r0; tokR[2 * t + 1] = r1;
            tokG[2 * t] = gate_group * p1; tokG[2 * t + 1] = gate_group * p2;
        }
    }
    __syncthreads();
    if (tid < 32) ((int*)(a->ws + WS_BCNT))[((size_t)l * MAXG + blockIdx.x) * 32 + tid] = cnt[tid];
    __syncthreads();
}

__device__ __forceinline__ void p5_dispatch(AP a, unsigned char* lds, int l) {
    const int tid = tid_opaque();
    const int ntok = (l == 0) ? NTOK : NLAT;
    int* part = (int*)lds;
    int* tot = (int*)(lds + 4096);
    int* off = (int*)(lds + 4096 + 128);
    int* pstart = (int*)(lds + 4096 + 256);
    const int* bc = (const int*)(a->ws + WS_BCNT) + (size_t)l * MAXG * 32;
    const int G = gridDim.x, me = blockIdx.x;
    { const int e = tid & 31, p = tid >> 5; int s = 0, so = 0; for (int bb = p; bb < G; bb += 16) { const int c = bc[bb * 32 + e]; s += c; if (bb < me) so += c; } part[p * 32 + e] = s; part[512 + p * 32 + e] = so; }
    __syncthreads();
    if (tid < 32) { int s = 0, so = 0; for (int p = 0; p < 16; ++p) { s += part[p * 32 + tid]; so += part[512 + p * 32 + tid]; } tot[tid] = s; off[tid] = so; }
    __syncthreads();
    if (tid == 0) { int acc = 0; for (int e = 0; e < 32; ++e) { pstart[e] = acc; acc += ((tot[e] + 127) >> 7) << 7; } }
    __syncthreads();
    if (me == 0 && tid < 32) ((int*)(a->ws + WS_CNT))[l * 32 + tid] = tot[tid];
    const int* tokE = (const int*)(a->ws + WS_TOKE); const int* tokR = (const int*)(a->ws + WS_TOKR);
    int* tokS = (int*)(a->ws + WS_TOKS); int* slotT = (int*)(a->ws + WS_SLOTT);
    for (int base = me * 8; base < ntok; base += G * 8) {
        if (tid < 16) { const int t = base + (tid >> 1); if (t < ntok) { const int idx = 2 * t + (tid & 1); const int e = tokE[idx]; const int slot = pstart[e] + off[e] + tokR[idx]; tokS[idx] = slot; slotT[slot] = t; } }
    }
    __syncthreads();
}

__device__ __forceinline__ int moe_table(AP a, unsigned char* lds, int l, int* blk) {
    const int* tot = (const int*)(a->ws + WS_CNT) + l * 32;
    if (threadIdx.x == 0) { int acc = 0; for (int e = 0; e < 32; ++e) { blk[e] = acc; acc += (tot[e] + 127) >> 7; } blk[32] = acc; }
    __syncthreads();
    return blk[32];
}

__device__ __forceinline__ void p6_gateup(AP a, unsigned char* ldsg, LAS unsigned char* lds, int l) {
    int* blk = (int*)(ldsg + 98304 + 256);
    const int nrb = moe_table(a, ldsg, l, blk);
    const int* tot = (const int*)(a->ws + WS_CNT) + l * 32;
    const bf16_t* WG = (const bf16_t*)(a->ws + WS_WEXP); const bf16_t* WU = WG + EXPMAT;
    for (int u = blockIdx.x; u < nrb * 4; u += gridDim.x) {
        const int rb = u >> 2, ct = u & 3;
        int e = 0; for (int q = 1; q < 32; ++q) if (blk[q] <= rb) e = q;
        const int valid = min(128, tot[e] - (rb - blk[e]) * 128);
        EpiGateUp E; E.C = (bf16_t*)(a->ws + WS_HID) + (size_t)(rb * 128) * DEXP + ct * 128; E.ld = DEXP;
        gemm_tile<256, true, EpiGateUp>(lds, (const bf16_t*)(a->ws + WS_H), D, (const int*)(a->ws + WS_SLOTT) + rb * 128, valid,
                                        WG + ((size_t)e * 512 + ct * 128) * 1024, WU + ((size_t)e * 512 + ct * 128) * 1024, 1024, 1024, E);
    }
    __syncthreads();
}
__device__ __forceinline__ void p7_down(AP a, unsigned char* ldsg, LAS unsigned char* lds, int l) {
    int* blk = (int*)(ldsg + 98304 + 256);
    const int nrb = moe_table(a, ldsg, l, blk);
    const bf16_t* WD = (const bf16_t*)(a->ws + WS_WEXP) + 2 * EXPMAT;
    for (int u = blockIdx.x; u < nrb * 4; u += gridDim.x) {
        const int rb = u >> 2, ct = u & 3;
        int e = 0; for (int q = 1; q < 32; ++q) if (blk[q] <= rb) e = q;
        EpiBf16 E; E.C = (bf16_t*)(a->ws + WS_YS) + (size_t)(rb * 128) * D + ct * 256; E.ld = D;
        const bf16_t* B0 = WD + ((size_t)e * 1024 + ct * 256) * 512;
        gemm_tile<256, false, EpiBf16>(lds, (const bf16_t*)(a->ws + WS_HID) + (size_t)(rb * 128) * DEXP, DEXP, nullptr, 128, B0, B0 + (size_t)128 * 512, 512, 512, E);
    }
    __syncthreads();
}

__device__ __forceinline__ void p8_ln2(AP a, unsigned char* lds, int l) {
    const int tid = tid_opaque(), lane = tid & 63, w = tid >> 6;
    const int ntok = (l == 0) ? NTOK : NLAT;
    const float* mod = (const float*)(a->ws + WS_MOD) + (size_t)l * 5 * 6144;
    const float* modn = (const float*)(a->ws + WS_MOD) + (size_t)5 * 6144;
    const float* X1 = (const float*)(a->ws + WS_X1);
    const bf16_t* YS = (const bf16_t*)(a->ws + WS_YS);
    const int* tokS = (const int*)(a->ws + WS_TOKS); const float* tokG = (const float*)(a->ws + WS_TOKG);
    const float* g2w = a->in[21] + l * 1024; const float* b2w = a->in[22] + l * 1024;
    for (int t = blockIdx.x * 8 + w; t < ntok; t += gridDim.x * 8) {
        const float* m = mod + (size_t)((t < NLAT) ? (t >> 12) : 4) * 6144;
        const int s0 = tokS[2 * t], s1 = tokS[2 * t + 1]; const float ga = tokG[2 * t], gb = tokG[2 * t + 1];
        f32x4 v[4];
#pragma unroll
        for (int i = 0; i < 4; ++i) { const int c = 256 * i + 4 * lane; const f32x4 xv = *(const f32x4*)(X1 + (size_t)t * D + c), gv = *(const f32x4*)(m + 5120 + c);
            const u32x2 ya = *(const u32x2*)(YS + (size_t)s0 * D + c), yb = *(const u32x2*)(YS + (size_t)s1 * D + c);
            const float f0 = ga * lo2f(ya.x) + gb * lo2f(yb.x), f1 = ga * hi2f(ya.x) + gb * hi2f(yb.x), f2 = ga * lo2f(ya.y) + gb * lo2f(yb.y), f3 = ga * hi2f(ya.y) + gb * hi2f(yb.y);
            v[i][0] = RES_ALPHA * xv[0] + gv[0] * f0; v[i][1] = RES_ALPHA * xv[1] + gv[1] * f1; v[i][2] = RES_ALPHA * xv[2] + gv[2] * f2; v[i][3] = RES_ALPHA * xv[3] + gv[3] * f3; }
        float mean, rstd; ln_stats(v, mean, rstd);
        float* dst = (l == 0) ? (float*)(a->ws + WS_XC) + (size_t)t * D : a->out + (size_t)t * D;
#pragma unroll
        for (int i = 0; i < 4; ++i) { const int c = 256 * i + 4 * lane; const f32x4 gg = *(const f32x4*)(g2w + c), bb = *(const f32x4*)(b2w + c);
#pragma unroll
            for (int e = 0; e < 4; ++e) v[i][e] = (v[i][e] - mean) * rstd * gg[e] + bb[e];
            *(f32x4*)(dst + c) = v[i]; }
        if (l == 0) {
            const float* mn = modn + (size_t)((t < NLAT) ? (t >> 12) : 4) * 6144;
            ln_stats(v, mean, rstd);
            bf16_t* H = (bf16_t*)(a->ws + WS_H);
#pragma unroll
            for (int i = 0; i < 4; ++i) { const int c = 256 * i + 4 * lane; const f32x4 sh = *(const f32x4*)(mn + c), sc = *(const f32x4*)(mn + 1024 + c);
                f32x4 o;
#pragma unroll
                for (int e = 0; e < 4; ++e) o[e] = (v[i][e] - mean) * rstd * (1.0f + sc[e]) + sh[e];
                u32x2 pk; pk.x = pack2(o[0], o[1]); pk.y = pack2(o[2], o[3]); *(u32x2*)(H + (size_t)t * D + c) = pk; }
        }
    }
    if (l == 0) { __syncthreads(); for (int u = blockIdx.x; u < U_EXP; u += gridDim.x) exp_unit(a, lds, 1, u); }
}

constexpr int N_PHASES = 18;
template <int P> __device__ __forceinline__ void run_phase(AP a, unsigned char* smem, LAS unsigned char* lds, int l) {
    if (P == 0) p0_prologue(a, smem);
    if (P == 1) p_lnmod0(a);
    if (P == 2) p1_inproj(a, lds, l);
    if (P == 3) p2_mix(a, smem, lds, l);
    if (P == 4) p3_outproj(a, lds, l);
    if (P == 5) p4_ln1_router(a, smem, l);
    if (P == 6) p5_dispatch(a, smem, l);
    if (P == 7) p6_gateup(a, smem, lds, l);
    if (P == 8) p7_down(a, smem, lds, l);
    if (P == 9) p8_ln2(a, smem, l);
}
template <int P> __device__ __noinline__ void phase_fn(AP ap, int l) {
    extern __shared__ __attribute__((aligned(16))) unsigned char smem[];
    run_phase<P>(ap, smem, (LAS unsigned char*)smem, l);
}
#if N_LAUNCH_MODE == 1
__global__ void __launch_bounds__(NT, 2) fwd(Args a) {
    extern __shared__ __attribute__((aligned(16))) unsigned char smem[];
    LAS unsigned char* lds = (LAS unsigned char*)smem;
    if (threadIdx.x < 4) ((volatile LAS unsigned*)(lds + 98304 + 512))[threadIdx.x] = 0u;
    __syncthreads();
    XcdBarrier bar = xcd_barrier_post((unsigned*)(a.ws + WS_BAR), (volatile LAS unsigned*)(lds + 98304 + 512));
    AP ap = (AP)__builtin_amdgcn_kernarg_segment_ptr();
    run_phase<0>(ap, smem, lds, 0); xcd_barrier(bar);
    run_phase<1>(ap, smem, lds, 0); xcd_barrier(bar);
    for (int l = 0; l < 2; ++l) {
        run_phase<2>(ap, smem, lds, l); xcd_barrier(bar);
        run_phase<3>(ap, smem, lds, l); xcd_barrier(bar);
        run_phase<4>(ap, smem, lds, l); xcd_barrier(bar);
        run_phase<5>(ap, smem, lds, l); xcd_barrier(bar);
        run_phase<6>(ap, smem, lds, l); xcd_barrier(bar);
        run_phase<7>(ap, smem, lds, l); xcd_barrier(bar);
        run_phase<8>(ap, smem, lds, l); xcd_barrier(bar);
        run_phase<9>(ap, smem, lds, l); if (l == 0) xcd_barrier(bar);
    }
}
#else
template <int P> __global__ void __launch_bounds__(NT, 2) k_phase(Args a) {
    extern __shared__ __attribute__((aligned(16))) unsigned char smem[];
    LAS unsigned char* lds = (LAS unsigned char*)smem;
    AP ap = (AP)__builtin_amdgcn_kernarg_segment_ptr();
    run_phase<P>(ap, smem, lds, ap->ph_lo);
}
template <int P> static void launch_phase(Args a, int l, int grid, hipStream_t stream) {
    static bool attr = false;
    if (!attr) { (void)hipFuncSetAttribute((const void*)k_phase<P>, hipFuncAttributeMaxDynamicSharedMemorySize, LDS_BYTES); attr = true; }
    a.ph_lo = l; a.ph_hi = P;
    hipLaunchKernelGGL(k_phase<P>, dim3(grid), dim3(NT), LDS_BYTES, stream, a);
}
#endif

extern "C" void kernel_launch(void* const* d_in, const int* in_sizes, int n_in, void* d_out, int out_size, void* d_ws, size_t ws_size, hipStream_t stream) {
    static int grid = 0;
    if (grid == 0) {
        if (n_in != 23 || out_size != NLAT * D || ws_size < WS_END) { fprintf(stderr, "kernel_launch: unexpected shapes (n_in %d, out %d, ws %zu, need %zu)\n", n_in, out_size, ws_size, (size_t)WS_END); grid = -1; return; }
        int dev = 0, cus = 0;
        if (hipGetDevice(&dev) != hipSuccess || hipDeviceGetAttribute(&cus, hipDeviceAttributeMultiprocessorCount, dev) != hipSuccess) { grid = -1; return; }
#if N_LAUNCH_MODE == 1
        int per_cu = 0;
        if (hipFuncSetAttribute((const void*)fwd, hipFuncAttributeMaxDynamicSharedMemorySize, LDS_BYTES) != hipSuccess) { fprintf(stderr, "kernel_launch: hipFuncSetAttribute failed\n"); grid = -1; return; }
        if (hipOccupancyMaxActiveBlocksPerMultiprocessor(&per_cu, (const void*)fwd, NT, LDS_BYTES) != hipSuccess || per_cu < 1) { fprintf(stderr, "kernel_launch: occupancy query says %d\n", per_cu); }
        (void)hipGetLastError();
#endif
        grid = cus; if (grid > MAXG) grid = MAXG;
    }
    if (grid < 0) return;
    (void)hipMemsetAsync((char*)d_ws + WS_BAR, 0, 16384 + 256, stream);
    Args a{};
    for (int i = 0; i < 23; ++i) a.in[i] = (const float*)d_in[i];
    a.out = (float*)d_out; a.ws = (unsigned char*)d_ws;
#if N_LAUNCH_MODE == 1
    a.ph_lo = 0; a.ph_hi = N_PHASES;
    hipLaunchKernelGGL(fwd, dim3(grid), dim3(NT), LDS_BYTES, stream, a);
#else
    launch_phase<0>(a, 0, grid, stream);
    launch_phase<1>(a, 0, grid, stream);
    for (int l = 0; l < 2; ++l) {
        launch_phase<2>(a, l, grid, stream); launch_phase<3>(a, l, grid, stream); launch_phase<4>(a, l, grid, stream); launch_phase<5>(a, l, grid, stream);
        launch_phase<6>(a, l, grid, stream); launch_phase<7>(a, l, grid, stream); launch_phase<8>(a, l, grid, stream); launch_phase<9>(a, l, grid, stream);
    }
#endif
}
```

```cpp
#include <hip/hip_runtime.h>
#include <stdint.h>
#include <stdio.h>

#ifndef NAIVE_GEMM
#define NAIVE_GEMM 0
#endif
#ifndef NAIVE_MIXER
#define NAIVE_MIXER 0
#endif
#ifndef N_LAUNCH_MODE
#define N_LAUNCH_MODE 1
#endif

#define LAS __attribute__((address_space(3)))
typedef unsigned short bf16_t;
typedef short bf16x8 __attribute__((ext_vector_type(8)));
typedef float f32x4 __attribute__((ext_vector_type(4)));
typedef unsigned u32x4 __attribute__((ext_vector_type(4)));
typedef unsigned u32x2 __attribute__((ext_vector_type(2)));

constexpr int D = 1024, NBATCH = 4, SEQ = 4096, CTXL = 256;
constexpr int NLAT = NBATCH * SEQ, NCTX = NBATCH * CTXL, NTOK = NLAT + NCTX;
constexpr int ZC = 1792;
constexpr int NEXP = 32, DEXP = 512;
constexpr int NSLOT = 2 * NTOK + NEXP * 128;
constexpr int NT = 512;
constexpr int MAXG = 512;
constexpr float RES_ALPHA = 1.41421356237309515f;
constexpr int LDS_BYTES = 98304 + 1024;

constexpr size_t WS_BAR   = 0;
constexpr size_t WS_CNT   = 16384;
constexpr size_t WS_BCNT  = WS_CNT + 256;
constexpr size_t WS_MOD   = WS_BCNT + (size_t)2 * MAXG * 32 * 4;
constexpr size_t WS_ROPE  = WS_MOD + (size_t)2 * 5 * 6144 * 4;
constexpr size_t WS_TOKE  = WS_ROPE + 8192;
constexpr size_t WS_TOKR  = WS_TOKE + (size_t)NTOK * 8;
constexpr size_t WS_TOKS  = WS_TOKR + (size_t)NTOK * 8;
constexpr size_t WS_TOKG  = WS_TOKS + (size_t)NTOK * 8;
constexpr size_t WS_SLOTT = WS_TOKG + (size_t)NTOK * 8;
constexpr size_t WS_WIN   = WS_SLOTT + (size_t)NSLOT * 4;
constexpr size_t WS_WOUT  = WS_WIN + (size_t)2 * ZC * 1024 * 2;
constexpr size_t WS_WSGU  = WS_WOUT + (size_t)2 * 1024 * 1024 * 2;
constexpr size_t WS_DFT   = WS_WSGU + (size_t)2 * 4 * 128 * 128 * 2;
constexpr size_t WS_DFTC  = WS_DFT + (size_t)4096 * 8192 * 2;
constexpr size_t WS_WEXP  = WS_DFTC + (size_t)256 * 512 * 2;
constexpr size_t EXPMAT   = (size_t)NEXP * 512 * 1024;
constexpr size_t WS_X1    = WS_WEXP + 3 * EXPMAT * 2;
constexpr size_t WS_XC    = WS_X1 + (size_t)NTOK * D * 4;
constexpr size_t WS_H     = WS_XC + (size_t)NTOK * D * 4;
constexpr size_t WS_R     = WS_H + (size_t)NTOK * D * 2;
constexpr size_t WS_Z     = WS_R;
constexpr size_t WS_AT    = WS_Z + (size_t)NTOK * ZC * 2;
constexpr size_t WS_ATC   = WS_AT + (size_t)4 * 256 * 8192 * 2;
constexpr size_t WS_VT    = WS_ATC + (size_t)4 * 256 * 512 * 2;
constexpr size_t WS_VTC   = WS_VT + (size_t)4 * 2 * 64 * 4096 * 2;
constexpr size_t WS_CAT   = WS_VTC + (size_t)4 * 2 * 64 * 256 * 2;
constexpr size_t WS_REND  = WS_CAT + (size_t)NTOK * D * 2;
constexpr size_t WS_Y     = WS_R;
constexpr size_t WS_HID   = WS_R;
constexpr size_t WS_YS    = WS_HID + (size_t)NSLOT * DEXP * 2;
constexpr size_t WS_END   = WS_REND;
static_assert(WS_Y + (size_t)NTOK * D * 4 <= WS_CAT, "Y must not reach CAT");
static_assert(WS_YS + (size_t)NSLOT * D * 2 <= WS_REND, "YS must fit the region");
static_assert(WS_WIN % 256 == 0 && WS_DFT % 256 == 0 && WS_WEXP % 256 == 0 && WS_X1 % 256 == 0 && WS_H % 256 == 0 && WS_R % 256 == 0 && WS_AT % 256 == 0 && WS_CAT % 256 == 0 && WS_YS % 256 == 0, "alignment");

struct Args { const float* in[23]; float* out; unsigned char* ws; int ph_lo, ph_hi; };
#define CAS __attribute__((address_space(4)))
typedef const CAS Args* AP;

#define XB_TMO      128
#define XB_XCNT(j)  (256  + 64 * (j))
#define XB_XSUB(j)  (1280 + 64 * (j))
#define XB_XGEN(j)  (2304 + 64 * (j))
#define XB_TOP      3328
#define XB_TOPGEN   3392
#define XCD_BAR_WORDS 3456
#define XB_SPIN_CAP (1u << 18)

__device__ __forceinline__ unsigned xb_ld(unsigned* p)              { return __hip_atomic_load(p, __ATOMIC_RELAXED, __HIP_MEMORY_SCOPE_AGENT); }
__device__ __forceinline__ unsigned xb_add(unsigned* p, unsigned v) { return __hip_atomic_fetch_add(p, v, __ATOMIC_RELAXED, __HIP_MEMORY_SCOPE_AGENT); }
__device__ __forceinline__ unsigned xb_xcc_id() { return (unsigned)__builtin_amdgcn_s_getreg((3 << 11) | 20) & 0xFu; }
#define XB_SPIN(cond, bar) do { unsigned _sp = 0; while (cond) { __builtin_amdgcn_s_sleep(1); \
    if ((++_sp & 255u) == 0u) { if (xb_ld(&(bar)[XB_TMO])) break; if (_sp > XB_SPIN_CAP) { atomicAdd(&(bar)[XB_TMO], 1u); break; } } } } while (0)

struct XcdBarrier { unsigned* bar; unsigned x; volatile LAS unsigned* st; };

__device__ __forceinline__ XcdBarrier xcd_barrier_post(unsigned* bar, volatile LAS unsigned* st) {
    XcdBarrier b; b.bar = bar; b.x = xb_xcc_id(); b.st = st;
    if (threadIdx.x == 0) (void)xb_add(&bar[XB_XCNT(b.x)], 1u);
    return b;
}
__device__ __forceinline__ void xcd_barrier_complete(unsigned* bar, unsigned x, unsigned& nloc, unsigned& nx) {
    const unsigned G = gridDim.x * gridDim.y * gridDim.z;
    unsigned sum, cnt, mine, sp = 0u;
    for (;;) {
        sum = 0u; cnt = 0u; mine = 0u;
#pragma unroll
        for (unsigned j = 0; j < 16; ++j) { const unsigned c = xb_ld(&bar[XB_XCNT(j)]); sum += c; cnt += (c > 0u) ? 1u : 0u; mine = (j == x) ? c : mine; }
        if (sum == G) break;
        __builtin_amdgcn_s_sleep(1);
        if ((++sp & 255u) == 0u) { if (xb_ld(&bar[XB_TMO])) break; if (sp > XB_SPIN_CAP) { atomicAdd(&bar[XB_TMO], 1u); break; } }
    }
    nloc = mine > 0u ? mine : 1u; nx = cnt > 0u ? cnt : 1u;
}
__device__ __forceinline__ void xcd_barrier(const XcdBarrier& b) {
    asm volatile("s_waitcnt vmcnt(0)" ::: "memory");
    __syncthreads();
    if (threadIdx.x == 0) {
        unsigned* bar = b.bar;
        __builtin_amdgcn_s_waitcnt(0);
        unsigned nloc = b.st[0], nx = b.st[1];
        if (nloc == 0u) { xcd_barrier_complete(bar, b.x, nloc, nx); b.st[0] = nloc; b.st[1] = nx; }
        const unsigned old = xb_add(&bar[XB_XSUB(b.x)], 1u);
        const unsigned gen = old / nloc;
        if (old + 1u == (gen + 1u) * nloc) {
            __builtin_amdgcn_fence(__ATOMIC_RELEASE, "agent");
            asm volatile("s_waitcnt vmcnt(0)" ::: "memory");
            const unsigned og = xb_add(&bar[XB_TOP], 1u);
            const unsigned tg = og / nx;
            if (og + 1u == (tg + 1u) * nx) xb_add(&bar[XB_TOPGEN], 1u);
            else XB_SPIN(xb_ld(&bar[XB_TOPGEN]) == tg, bar);
            __builtin_amdgcn_fence(__ATOMIC_ACQUIRE, "agent");
            xb_add(&bar[XB_XGEN(b.x)], 1u);
            asm volatile("s_waitcnt vmcnt(0)" ::: "memory");
        } else {
            XB_SPIN(xb_ld(&bar[XB_XGEN(b.x)]) == gen, bar);
            __builtin_amdgcn_fence(__ATOMIC_ACQUIRE, "agent");
            asm volatile("s_waitcnt vmcnt(0)" ::: "memory");
        }
    }
    __syncthreads();
}

__device__ __forceinline__ int tid_opaque() { int t = threadIdx.x; asm volatile("" : "+v"(t)); return t; }
__device__ __forceinline__ float bf2f(bf16_t v) { return __uint_as_float(((unsigned)v) << 16); }
__device__ __forceinline__ bf16_t f2bf(float f) { unsigned u = __float_as_uint(f); u += 0x7FFFu + ((u >> 16) & 1u); return (bf16_t)(u >> 16); }
__device__ __forceinline__ unsigned pack2(float a, float b) { return (unsigned)f2bf(a) | ((unsigned)f2bf(b) << 16); }
__device__ __forceinline__ float lo2f(unsigned w) { return __uint_as_float(w << 16); }
__device__ __forceinline__ float hi2f(unsigned w) { return __uint_as_float(w & 0xffff0000u); }
__device__ __forceinline__ float wave_sum(float v) {
#pragma unroll
    for (int o = 32; o >= 1; o >>= 1) v += __shfl_xor(v, o);
    return v;
}
__device__ __forceinline__ float gelu_erf(float x) { return 0.5f * x * (1.0f + erff(x * 0.70710678118654752f)); }
__device__ __forceinline__ float silu_f(float x) { return x / (1.0f + __expf(-x)); }

__device__ __forceinline__ void ln_stats(const f32x4 (&v)[4], float& mean, float& rstd) {
    float s = 0.f;
#pragma unroll
    for (int i = 0; i < 4; ++i) s += (v[i][0] + v[i][1]) + (v[i][2] + v[i][3]);
    s = wave_sum(s); mean = s * (1.0f / 1024.0f);
    float q = 0.f;
#pragma unroll
    for (int i = 0; i < 4; ++i)
#pragma unroll
        for (int e = 0; e < 4; ++e) { const float d = v[i][e] - mean; q += d * d; }
    q = wave_sum(q); rstd = 1.0f / sqrtf(q * (1.0f / 1024.0f) + 1e-6f);
}

template <int BN> struct MfmaLayout {
    static constexpr int FG = BN / 128, NI = 4, NJ = 2 * FG;
    int rbase, cbase;
    __device__ __forceinline__ int row(int i) const { return rbase + 16 * i; }
    __device__ __forceinline__ int col(int jj) const { return (jj / FG) * (BN / 2) + (jj % FG) * 16 + cbase; }
};
template <int BN> struct NaiveLayout {
    static constexpr int TX = BN / 8, TY = NT / TX, NI = 128 / TY, NJ = 2;
    int ty, tx;
    __device__ __forceinline__ int row(int i) const { return ty + TY * i; }
    __device__ __forceinline__ int col(int jj) const { return jj * (BN / 2) + 4 * tx; }
};

__device__ __forceinline__ void glds16(const bf16_t* g, LAS unsigned char* l) {
    __builtin_amdgcn_global_load_lds((const unsigned*)g, (LAS unsigned*)l, 16, 0, 0);
}

template <int BN, bool GATHER, class Epi>
__device__ __forceinline__ void gemm_tile(LAS unsigned char* lds, const bf16_t* A, int lda, const int* rowidx, int valid_rows,
                                          const bf16_t* B0, const bf16_t* B1, int ldb, int K, const Epi& epi) {
    constexpr int A_B = 16384, B_B = BN * 128, STAGE = A_B + B_B, NBL = BN / 64;
    const int tid = tid_opaque(), lane = tid & 63, wid = __builtin_amdgcn_readfirstlane(tid >> 6);
    const bf16_t* ap[2]; const bf16_t* bp[NBL];
#pragma unroll
    for (int i = 0; i < 2; ++i) {
        const int P = i * 512 + tid, row = P >> 3, c = (P & 7) ^ ((row >> 1) & 7);
        size_t ro;
        if (GATHER) ro = (size_t)(row < valid_rows ? rowidx[row] : 0) * (size_t)lda; else ro = (size_t)row * (size_t)lda;
        ap[i] = A + ro + c * 8;
    }
#pragma unroll
    for (int i = 0; i < NBL; ++i) {
        const int P = i * 512 + tid, row = P >> 3, c = (P & 7) ^ ((row >> 1) & 7);
        const bf16_t* base = (row < BN / 2) ? (B0 + (size_t)row * ldb) : (B1 + (size_t)(row - BN / 2) * ldb);
        bp[i] = base + c * 8;
    }
    const int nk = K / 64;
#define GT_STAGE(buf, k0) do { \
        _Pragma("unroll") for (int _i = 0; _i < 2; ++_i) glds16(ap[_i] + (k0), lds + (buf) * STAGE + _i * 8192 + wid * 1024); \
        _Pragma("unroll") for (int _i = 0; _i < NBL; ++_i) glds16(bp[_i] + (k0), lds + (buf) * STAGE + A_B + _i * 8192 + wid * 1024); } while (0)

#if NAIVE_GEMM
    typedef NaiveLayout<BN> Lay;
    Lay lay; lay.tx = tid % Lay::TX; lay.ty = tid / Lay::TX;
    f32x4 acc[Lay::NI][Lay::NJ];
#pragma unroll
    for (int i = 0; i < Lay::NI; ++i)
#pragma unroll
        for (int j = 0; j < Lay::NJ; ++j) acc[i][j] = (f32x4){0.f, 0.f, 0.f, 0.f};
    GT_STAGE(0, 0);
    asm volatile("s_waitcnt vmcnt(0)" ::: "memory"); __syncthreads();
    for (int kt = 0; kt < nk; ++kt) {
        if (kt + 1 < nk) GT_STAGE((kt + 1) & 1, (kt + 1) * 64);
        const LAS unsigned char* sa = lds + (kt & 1) * STAGE; const LAS unsigned char* sb = sa + A_B;
#pragma unroll 1
        for (int kc = 0; kc < 8; ++kc)
#pragma unroll 1
            for (int hh = 0; hh < 2; ++hh) {
                float a[Lay::NI][4];
#pragma unroll
                for (int i = 0; i < Lay::NI; ++i) { const int row = lay.row(i);
                    const u32x2 w = *(const LAS u32x2*)(sa + row * 128 + ((kc ^ ((row >> 1) & 7)) << 4) + hh * 8);
                    a[i][0] = lo2f(w.x); a[i][1] = hi2f(w.x); a[i][2] = lo2f(w.y); a[i][3] = hi2f(w.y); }
#pragma unroll
                for (int j = 0; j < 2; ++j)
#pragma unroll
                    for (int e = 0; e < 4; ++e) { const int row = j * (BN / 2) + 4 * lay.tx + e;
                        const u32x2 w = *(const LAS u32x2*)(sb + row * 128 + ((kc ^ ((row >> 1) & 7)) << 4) + hh * 8);
                        const float b0 = lo2f(w.x), b1 = hi2f(w.x), b2 = lo2f(w.y), b3 = hi2f(w.y);
#pragma unroll
                        for (int i = 0; i < Lay::NI; ++i) acc[i][j][e] += (a[i][0] * b0 + a[i][1] * b1) + (a[i][2] * b2 + a[i][3] * b3); }
            }
        asm volatile("s_waitcnt vmcnt(0)" ::: "memory"); __syncthreads();
    }
    epi.run(acc, lay);
#else
    typedef MfmaLayout<BN> Lay;
    constexpr int FG = Lay::FG;
    const int fr = lane & 15, g = lane >> 4, wr = wid >> 2, wc = wid & 3;
    Lay lay; lay.rbase = wr * 64 + fr; lay.cbase = wc * 16 * FG + 4 * g;
    f32x4 acc[Lay::NI][Lay::NJ];
#pragma unroll
    for (int i = 0; i < Lay::NI; ++i)
#pragma unroll
        for (int j = 0; j < Lay::NJ; ++j) acc[i][j] = (f32x4){0.f, 0.f, 0.f, 0.f};
    int aoff[4], boff[Lay::NJ];
#pragma unroll
    for (int m = 0; m < 4; ++m) { const int row = wr * 64 + m * 16 + fr; aoff[m] = row * 128 + ((g ^ ((row >> 1) & 7)) << 4); }
#pragma unroll
    for (int jj = 0; jj < Lay::NJ; ++jj) { const int row = (jj / FG) * (BN / 2) + wc * 16 * FG + (jj % FG) * 16 + fr; boff[jj] = A_B + row * 128 + ((g ^ ((row >> 1) & 7)) << 4); }
    GT_STAGE(0, 0);
    asm volatile("s_waitcnt vmcnt(0)" ::: "memory"); __syncthreads();
    for (int kt = 0; kt < nk; ++kt) {
        if (kt + 1 < nk) GT_STAGE((kt + 1) & 1, (kt + 1) * 64);
        const LAS unsigned char* sa = lds + (kt & 1) * STAGE;
#pragma unroll
        for (int ks = 0; ks < 2; ++ks) {
            bf16x8 af[4], bfv[Lay::NJ];
#pragma unroll
            for (int m = 0; m < 4; ++m) af[m] = *(const LAS bf16x8*)(sa + (aoff[m] ^ (ks << 6)));
#pragma unroll
            for (int jj = 0; jj < Lay::NJ; ++jj) bfv[jj] = *(const LAS bf16x8*)(sa + (boff[jj] ^ (ks << 6)));
#pragma unroll
            for (int m = 0; m < 4; ++m)
#pragma unroll
                for (int jj = 0; jj < Lay::NJ; ++jj) acc[m][jj] = __builtin_amdgcn_mfma_f32_16x16x32_bf16(bfv[jj], af[m], acc[m][jj], 0, 0, 0);
        }
        asm volatile("s_waitcnt vmcnt(0)" ::: "memory"); __syncthreads();
    }
    epi.run(acc, lay);
#endif
#undef GT_STAGE
}

struct EpiF32 {
    float* C; int ld;
    template <class L> __device__ __forceinline__ void run(const f32x4 (&acc)[L::NI][L::NJ], const L& lay) const {
#pragma unroll
        for (int i = 0; i < L::NI; ++i)
#pragma unroll
            for (int j = 0; j < L::NJ; ++j) *(f32x4*)(C + (size_t)lay.row(i) * ld + lay.col(j)) = acc[i][j];
    }
};
struct EpiBf16 {
    bf16_t* C; int ld;
    template <class L> __device__ __forceinline__ void run(const f32x4 (&acc)[L::NI][L::NJ], const L& lay) const {
#pragma unroll
        for (int i = 0; i < L::NI; ++i)
#pragma unroll
            for (int j = 0; j < L::NJ; ++j) { u32x2 w; w.x = pack2(acc[i][j][0], acc[i][j][1]); w.y = pack2(acc[i][j][2], acc[i][j][3]);
                *(u32x2*)(C + (size_t)lay.row(i) * ld + lay.col(j)) = w; }
    }
};
struct EpiGateUp {
    bf16_t* C; int ld;
    template <class L> __device__ __forceinline__ void run(const f32x4 (&acc)[L::NI][L::NJ], const L& lay) const {
#pragma unroll
        for (int i = 0; i < L::NI; ++i)
#pragma unroll
            for (int j = 0; j < L::NJ / 2; ++j) { const f32x4 gt = acc[i][j], up = acc[i][j + L::NJ / 2];
                u32x2 w; w.x = pack2(silu_f(gt[0]) * up[0], silu_f(gt[1]) * up[1]); w.y = pack2(silu_f(gt[2]) * up[2], silu_f(gt[3]) * up[3]);
                *(u32x2*)(C + (size_t)lay.row(i) * ld + lay.col(j)) = w; }
    }
};
struct EpiInProj {
    bf16_t* Zt;
    bf16_t* tF;
    bf16_t* tV;
    int n0, pos0, n;
    template <class L> __device__ __forceinline__ void run(const f32x4 (&acc)[L::NI][L::NJ], const L& lay) const {
#pragma unroll
        for (int i = 0; i < L::NI; ++i)
#pragma unroll
            for (int j = 0; j < L::NJ; ++j) {
                const int r = lay.row(i), cl = lay.col(j), c = n0 + cl;
                const f32x4 v = acc[i][j];
                if (c < 512) {
                    const int part = c >> 8, ch = c & 255;
#pragma unroll
                    for (int e = 0; e < 4; ++e) tF[((size_t)(ch + e) * 2 + part) * n + pos0 + r] = f2bf(v[e]);
                } else {
                    u32x2 w; w.x = pack2(v[0], v[1]); w.y = pack2(v[2], v[3]);
                    *(u32x2*)(Zt + (size_t)r * ZC + cl) = w;
                    if (c >= 896 && c < 1024) {
#pragma unroll
                        for (int e = 0; e < 4; ++e) tV[(size_t)(c - 896 + e) * n + pos0 + r] = f2bf(v[e]);
                    }
                }
            }
    }
};

constexpr int U_ADA = 192, U_WIN = 2 * 16 * 28, U_WOUT = 2 * 16 * 16, U_SGU = 32, U_DFT = 4096 + 256, U_ROPE = 1, U_EXP = 3 * 32 * 128;
constexpr int LDS_SIL = 0, LDS_RED = 20480, LDS_TILE = 32768, LDS_T64 = 49408, LDS_CTAB = 50176;

__device__ __forceinline__ void ada_unit(AP a, unsigned char* lds, int u) {
    float* sil = (float*)(lds + LDS_SIL); float* red = (float*)(lds + LDS_RED);
    const int tid = tid_opaque(), lane = tid & 63, w = tid >> 6;
    const int l = u / 96, cg = u % 96;
    for (int i = tid; i < 5120; i += NT) { const int r = i >> 10, k = i & 1023; const float v = (r < 4) ? a->in[1][r * 1024 + k] : a->in[3][k]; sil[i] = v / (1.0f + expf(-v)); }
    __syncthreads();
    const float* W = a->in[4] + (size_t)l * 1024 * 6144 + cg * 64 + lane;
    float acc[5] = {0.f, 0.f, 0.f, 0.f, 0.f};
#pragma unroll 4
    for (int k = w * 128; k < w * 128 + 128; ++k) { const float wv = W[(size_t)k * 6144];
#pragma unroll
        for (int r = 0; r < 5; ++r) acc[r] += sil[r * 1024 + k] * wv; }
#pragma unroll
    for (int r = 0; r < 5; ++r) red[(w * 5 + r) * 64 + lane] = acc[r];
    __syncthreads();
    if (tid < 320) { const int r = tid >> 6; float s = 0.f;
#pragma unroll
        for (int ww = 0; ww < 8; ++ww) s += red[(ww * 5 + r) * 64 + lane];
        const int j = cg * 64 + lane; ((float*)(a->ws + WS_MOD))[(size_t)(l * 5 + r) * 6144 + j] = s + a->in[5][l * 6144 + j]; }
    __syncthreads();
}

__device__ __forceinline__ void tile_store_T(const float* tile, bf16_t* dst, int ldd) {
    const int tid = tid_opaque(), n = tid >> 3, kc = tid & 7;
    u32x4 w;
    w.x = pack2(tile[(kc * 8 + 0) * 65 + n], tile[(kc * 8 + 1) * 65 + n]); w.y = pack2(tile[(kc * 8 + 2) * 65 + n], tile[(kc * 8 + 3) * 65 + n]);
    w.z = pack2(tile[(kc * 8 + 4) * 65 + n], tile[(kc * 8 + 5) * 65 + n]); w.w = pack2(tile[(kc * 8 + 6) * 65 + n], tile[(kc * 8 + 7) * 65 + n]);
    *(u32x4*)(dst + (size_t)n * ldd + kc * 8) = w;
}
__device__ __forceinline__ void tile_load(float* tile, const float* src, int lds_) {
    const int tid = tid_opaque();
#pragma unroll
    for (int i = 0; i < 2; ++i) { const int row = (tid >> 4) + 32 * i, c4 = (tid & 15) * 4; const f32x4 v = *(const f32x4*)(src + (size_t)row * lds_ + c4);
        tile[row * 65 + c4 + 0] = v[0]; tile[row * 65 + c4 + 1] = v[1]; tile[row * 65 + c4 + 2] = v[2]; tile[row * 65 + c4 + 3] = v[3]; }
}

__device__ __forceinline__ void win_unit(AP a, unsigned char* lds, int u) {
    float* tile = (float*)(lds + LDS_TILE); float* T = (float*)(lds + LDS_T64);
    const int tid = tid_opaque();
    const int l = u / 448, r = u % 448, kb = r / 28, nb = r % 28;
    const float* Win = a->in[6] + (size_t)l * 1024 * 1536;
    const int srccol = (nb >= 8) ? nb * 64 - 256 : (nb & 3) * 64;
    tile_load(tile, Win + (size_t)(kb * 64) * 1536 + srccol, 1536);
    if (nb < 8 && tid < 64) { T[tid] = cospif((float)tid / 32.0f); T[64 + tid] = sinpif((float)tid / 32.0f); }
    __syncthreads();
    bf16_t* dst = (bf16_t*)(a->ws + WS_WIN) + ((size_t)l * ZC + nb * 64) * 1024 + kb * 64;
    if (nb >= 8) tile_store_T(tile, dst, 1024);
    else {
        const int n = tid >> 3, kc = tid & 7, part = nb >> 2; float o[8];
#pragma unroll
        for (int e = 0; e < 8; ++e) { float s = 0.f;
#pragma unroll 4
            for (int c = 0; c < 64; ++c) s += tile[(kc * 8 + e) * 65 + c] * T[part * 64 + ((c * n) & 63)]; o[e] = (part ? -s : s) * 0.125f; }
        u32x4 w; w.x = pack2(o[0], o[1]); w.y = pack2(o[2], o[3]); w.z = pack2(o[4], o[5]); w.w = pack2(o[6], o[7]);
        *(u32x4*)(dst + (size_t)n * 1024 + kc * 8) = w;
    }
    __syncthreads();
}

__device__ __forceinline__ void wout_unit(AP a, unsigned char* lds, int u) {
    float* tile = (float*)(lds + LDS_TILE);
    const int tid = tid_opaque();
    const int l = u / 256, r = u % 256, kb = r / 16, nb = r % 16;
    const float* Wo = a->in[13] + (size_t)l * 1024 * 1024;
    const int n = tid & 63, kq = __builtin_amdgcn_readfirstlane(tid >> 6);
    if (kb < 4) {
        const float* wf = a->in[7] + (size_t)l * 256 * 256 + (size_t)(kb * 64 + kq * 8) * 256;
        float acc[8] = {0.f, 0.f, 0.f, 0.f, 0.f, 0.f, 0.f, 0.f};
#pragma unroll 2
        for (int j = 0; j < 256; ++j) { const float wv = Wo[(size_t)j * 1024 + nb * 64 + n];
#pragma unroll
            for (int e = 0; e < 8; ++e) acc[e] += wf[e * 256 + j] * wv; }
#pragma unroll
        for (int e = 0; e < 8; ++e) tile[(kq * 8 + e) * 65 + n] = acc[e];
    } else if (kb >= 8 && kb < 12) {
        const int g = kb - 8;
        const float* wp = a->in[9] + ((size_t)(l * 4 + g) * 64 + kq * 8) * 64;
        const float* ps = a->in[10] + l * 256 + g * 64;
        float acc[8] = {0.f, 0.f, 0.f, 0.f, 0.f, 0.f, 0.f, 0.f};
#pragma unroll 2
        for (int d = 0; d < 64; ++d) { const float wv = ps[d] * Wo[(size_t)(512 + g * 64 + d) * 1024 + nb * 64 + n];
#pragma unroll
            for (int e = 0; e < 8; ++e) acc[e] += wp[e * 64 + d] * wv; }
#pragma unroll
        for (int e = 0; e < 8; ++e) tile[(kq * 8 + e) * 65 + n] = acc[e];
    } else tile_load(tile, Wo + (size_t)(kb * 64) * 1024 + nb * 64, 1024);
    __syncthreads();
    tile_store_T(tile, (bf16_t*)(a->ws + WS_WOUT) + ((size_t)l * 1024 + nb * 64) * 1024 + kb * 64, 1024);
    __syncthreads();
}

__device__ __forceinline__ void exp_unit(AP a, unsigned char* lds, int l, int u) {
    float* tile = (float*)(lds + LDS_TILE);
    const int mat = u / 4096, e = (u % 4096) / 128, t = u % 128;
    const int kb = (mat < 2) ? t / 8 : t / 16, nb = (mat < 2) ? t % 8 : t % 16;
    const int srcld = (mat < 2) ? 512 : 1024, dstld = (mat < 2) ? 1024 : 512;
    const float* src = a->in[18 + mat] + ((size_t)(l * 32 + e) * 512 * 1024) + (size_t)(kb * 64) * srcld + nb * 64;
    bf16_t* dst = (bf16_t*)(a->ws + WS_WEXP) + (size_t)mat * EXPMAT + (size_t)e * 512 * 1024 + (size_t)(nb * 64) * dstld + kb * 64;
    tile_load(tile, src, srcld);
    __syncthreads();
    tile_store_T(tile, dst, dstld);
    __syncthreads();
}

__device__ __forceinline__ void p0_prologue(AP a, unsigned char* lds) {
    const int tid = tid_opaque();
    bool have_tab = false;
    constexpr int E0 = U_ADA, E1 = E0 + U_WIN, E2 = E1 + U_WOUT, E3 = E2 + U_SGU, E4 = E3 + U_DFT, E5 = E4 + U_ROPE, E6 = E5 + U_EXP;
    for (int u = blockIdx.x; u < E6; u += gridDim.x) {
        if (u < E0) ada_unit(a, lds, u);
        else if (u < E1) win_unit(a, lds, u - E0);
        else if (u < E2) wout_unit(a, lds, u - E1);
        else if (u < E3) { const size_t i0 = (size_t)(u - E2) * 4096 + tid * 8; const float* s = a->in[11] + i0; bf16_t* d = (bf16_t*)(a->ws + WS_WSGU) + i0;
            const f32x4 v0 = *(const f32x4*)s, v1 = *(const f32x4*)(s + 4); u32x4 w; w.x = pack2(v0[0], v0[1]); w.y = pack2(v0[2], v0[3]); w.z = pack2(v1[0], v1[1]); w.w = pack2(v1[2], v1[3]); *(u32x4*)d = w; }
        else if (u < E4) {
            float* ctab = (float*)(lds + LDS_CTAB);
            if (!have_tab) { for (int i = tid; i < 4096; i += NT) ctab[i] = cospif((float)i / 2048.0f); __syncthreads(); have_tab = true; }
            const int k = u - E3;
            if (k < 4096) {
                const int n0 = tid * 8; float c[8], s[8];
#pragma unroll
                for (int e = 0; e < 8; ++e) { const int idx = (k * (n0 + e)) & 4095; c[e] = ctab[idx] * (1.0f / 64.0f); s[e] = ctab[(idx - 1024) & 4095] * (1.0f / 64.0f); }
                bf16_t* d = (bf16_t*)(a->ws + WS_DFT) + (size_t)k * 8192 + n0;
                u32x4 w; w.x = pack2(c[0], c[1]); w.y = pack2(c[2], c[3]); w.z = pack2(c[4], c[5]); w.w = pack2(c[6], c[7]); *(u32x4*)d = w;
                w.x = pack2(s[0], s[1]); w.y = pack2(s[2], s[3]); w.z = pack2(s[4], s[5]); w.w = pack2(s[6], s[7]); *(u32x4*)(d + 4096) = w;
            } else if (tid < 32) {
                const int kk = k - 4096, n0 = tid * 8; float c[8], s[8];
#pragma unroll
                for (int e = 0; e < 8; ++e) { const int idx = ((kk * (n0 + e)) & 255) * 16; c[e] = ctab[idx] * (1.0f / 16.0f); s[e] = ctab[(idx - 1024) & 4095] * (1.0f / 16.0f); }
                bf16_t* d = (bf16_t*)(a->ws + WS_DFTC) + (size_t)kk * 512 + n0;
                u32x4 w; w.x = pack2(c[0], c[1]); w.y = pack2(c[2], c[3]); w.z = pack2(c[4], c[5]); w.w = pack2(c[6], c[7]); *(u32x4*)d = w;
                w.x = pack2(s[0], s[1]); w.y = pack2(s[2], s[3]); w.z = pack2(s[4], s[5]); w.w = pack2(s[6], s[7]); *(u32x4*)(d + 256) = w;
            }
        }
        else if (u < E5) {
            for (int i = tid; i < 1024; i += NT) { const int pos = i >> 4, f = i & 15; const float freq = powf(10000.0f, -(float)f / 16.0f); const float ang = (float)pos * freq;
                ((float2*)(a->ws + WS_ROPE))[i] = make_float2(cosf(ang), sinf(ang)); }
        }
        else exp_unit(a, lds, 0, u - E5);
    }
}

__device__ __forceinline__ void p_lnmod0(AP a) {
    const int tid = tid_opaque(), lane = tid & 63, w = tid >> 6;
    const float* mod = (const float*)(a->ws + WS_MOD);
    bf16_t* H = (bf16_t*)(a->ws + WS_H);
    for (int t = blockIdx.x * 8 + w; t < NTOK; t += gridDim.x * 8) {
        const float* src = (t < NLAT) ? a->in[0] + (size_t)t * D : a->in[2] + (size_t)(t - NLAT) * D;
        const float* m = mod + (size_t)((t < NLAT) ? (t >> 12) : 4) * 6144;
        f32x4 v[4];
#pragma unroll
        for (int i = 0; i < 4; ++i) v[i] = *(const f32x4*)(src + 256 * i + 4 * lane);
        float mean, rstd; ln_stats(v, mean, rstd);
#pragma unroll
        for (int i = 0; i < 4; ++i) { const int c = 256 * i + 4 * lane; const f32x4 sh = *(const f32x4*)(m + c), sc = *(const f32x4*)(m + 1024 + c);
            f32x4 o;
#pragma unroll
            for (int e = 0; e < 4; ++e) o[e] = (v[i][e] - mean) * rstd * (1.0f + sc[e]) + sh[e];
            u32x2 pk; pk.x = pack2(o[0], o[1]); pk.y = pack2(o[2], o[3]); *(u32x2*)(H + (size_t)t * D + c) = pk; }
    }
}

__device__ __forceinline__ void p1_inproj(AP a, LAS unsigned char* lds, int l) {
    const int n_lat = 128 * 7, n_ctx = (l == 0) ? 8 * 7 : 8;
    const bf16_t* H = (const bf16_t*)(a->ws + WS_H);
    const bf16_t* W = (const bf16_t*)(a->ws + WS_WIN) + (size_t)l * ZC * 1024;
    for (int u = blockIdx.x; u < n_lat + n_ctx; u += gridDim.x) {
        int row0, b, pos0, ct, n; bf16_t *tF, *tV;
        if (u < n_lat) { const int rt = u / 7; ct = u % 7; row0 = rt * 128; b = row0 >> 12; pos0 = row0 & 4095; n = 4096;
            tF = (bf16_t*)(a->ws + WS_AT) + (size_t)b * 256 * 2 * 4096; tV = (bf16_t*)(a->ws + WS_VT) + (size_t)b * 128 * 4096; }
        else { const int uu = u - n_lat; int rt; if (l == 0) { rt = uu / 7; ct = uu % 7; } else { rt = uu; ct = 3; }
            row0 = NLAT + rt * 128; b = rt >> 1; pos0 = (rt & 1) * 128; n = 256;
            tF = (bf16_t*)(a->ws + WS_ATC) + (size_t)b * 256 * 2 * 256; tV = (bf16_t*)(a->ws + WS_VTC) + (size_t)b * 128 * 256; }
        EpiInProj E; E.Zt = (bf16_t*)(a->ws + WS_Z) + (size_t)row0 * ZC + ct * 256; E.tF = tF; E.tV = tV; E.n0 = ct * 256; E.pos0 = pos0; E.n = n;
        const bf16_t* B0 = W + (size_t)(ct * 256) * 1024;
        gemm_tile<256, false, EpiInProj>(lds, H + (size_t)row0 * D, D, nullptr, 128, B0, B0 + (size_t)128 * 1024, 1024, 1024, E);
    }
}

__device__ __forceinline__ void rope32(float (&t)[32], const float2* tab) {
#pragma unroll
    for (int f = 0; f < 16; ++f) { const float2 cs = tab[f]; const float t1 = t[f], t2 = t[16 + f]; t[f] = t1 * cs.x - t2 * cs.y; t[16 + f] = t1 * cs.y + t2 * cs.x; }
}
__device__ __forceinline__ void load32(float (&t)[32], const bf16_t* p) {
#pragma unroll
    for (int q = 0; q < 4; ++q) { const u32x4 w = *(const u32x4*)(p + 8 * q);
        t[8 * q + 0] = lo2f(w.x); t[8 * q + 1] = hi2f(w.x); t[8 * q + 2] = lo2f(w.y); t[8 * q + 3] = hi2f(w.y);
        t[8 * q + 4] = lo2f(w.z); t[8 * q + 5] = hi2f(w.z); t[8 * q + 6] = lo2f(w.w); t[8 * q + 7] = hi2f(w.w); }
}

__device__ __forceinline__ float kdot(const bf16_t* kp, const bf16_t* q, const float2* tab0, const float2* tab1, bool do_rope) {
    float dot = 0.f;
#pragma unroll 1
    for (int ax = 0; ax < 2; ++ax) {
        const float2* tab = ax ? tab1 : tab0;
#pragma unroll 1
        for (int h8 = 0; h8 < 2; ++h8) {
            const u32x4 wl = *(const u32x4*)(kp + ax * 32 + h8 * 8), wh = *(const u32x4*)(kp + ax * 32 + 16 + h8 * 8);
            const float tl[8] = {lo2f(wl.x), hi2f(wl.x), lo2f(wl.y), hi2f(wl.y), lo2f(wl.z), hi2f(wl.z), lo2f(wl.w), hi2f(wl.w)};
            const float th[8] = {lo2f(wh.x), hi2f(wh.x), lo2f(wh.y), hi2f(wh.y), lo2f(wh.z), hi2f(wh.z), lo2f(wh.w), hi2f(wh.w)};
#pragma unroll
            for (int j = 0; j < 8; ++j) {
                float r1 = tl[j], r2 = th[j];
                if (do_rope) { const float2 cs = tab[h8 * 8 + j]; r1 = tl[j] * cs.x - th[j] * cs.y; r2 = tl[j] * cs.y + th[j] * cs.x; }
                dot += bf2f(q[ax * 32 + h8 * 8 + j]) * r1 + bf2f(q[ax * 32 + 16 + h8 * 8 + j]) * r2;
            }
        }
    }
    return dot;
}

__device__ __forceinline__ void mixer_tile(AP a, unsigned char* lds, int l, int row0, int seq_row0, int pos0, int n, int b, bool is_ctx) {
    const int tid = tid_opaque(), lane = tid & 63, w = tid >> 6;
    const bf16_t* Z = (const bf16_t*)(a->ws + WS_Z);
    bf16_t* CAT = (bf16_t*)(a->ws + WS_CAT);
    {
        const int c = tid & 255, half = tid >> 8, g = c >> 6, hw = 1 << g;
        for (int tl = half * 64; tl < half * 64 + 64; ++tl) {
            const int pos = pos0 + tl; const int lo = max(pos - hw, 0), hi = min(pos + hw, n);
            float s = 0.f; for (int j = lo; j < hi; ++j) s += bf2f(Z[(size_t)(seq_row0 + j) * ZC + 1024 + c]);
            const float self = bf2f(Z[(size_t)(seq_row0 + pos) * ZC + 1024 + c]);
            CAT[(size_t)(row0 + tl) * D + 512 + c] = f2bf(s / (float)(hi - lo) - self);
        }
    }
    bf16_t* vT = (bf16_t*)lds;
    for (int q = w; q < 128; q += 8) {
        const u32x2 gw = *(const u32x2*)(Z + (size_t)(row0 + q) * ZC + 1536 + 4 * lane);
        float gv[4] = {gelu_erf(lo2f(gw.x)), gelu_erf(hi2f(gw.x)), gelu_erf(lo2f(gw.y)), gelu_erf(hi2f(gw.y))};
        float s = wave_sum((gv[0] + gv[1]) + (gv[2] + gv[3])); const float mean = s * (1.0f / 256.0f);
        float qq = 0.f;
#pragma unroll
        for (int e = 0; e < 4; ++e) { const float d = gv[e] - mean; qq += d * d; }
        qq = wave_sum(qq); const float rstd = 1.0f / sqrtf(qq * (1.0f / 256.0f) + 1e-6f);
#pragma unroll
        for (int e = 0; e < 4; ++e) vT[(4 * lane + e) * 128 + q] = f2bf((gv[e] - mean) * rstd);
    }
    __syncthreads();
    {
        const int c = tid & 255, ph = tid >> 8, h = c >> 6;
        const bf16_t* Ws = (const bf16_t*)(a->ws + WS_WSGU) + (size_t)(l * 4 + h) * 128 * 128;
        const float* bs = a->in[12] + (size_t)(l * 4 + h) * 128;
        for (int p = ph * 64; p < ph * 64 + 64; ++p) {
            float s = 0.f;
#pragma unroll 2
            for (int q8 = 0; q8 < 16; ++q8) {
                const u32x4 ww = *(const u32x4*)(Ws + (size_t)p * 128 + q8 * 8);
                const u32x4 vv = *(const u32x4*)(vT + c * 128 + q8 * 8);
                s += lo2f(ww.x) * lo2f(vv.x) + hi2f(ww.x) * hi2f(vv.x) + lo2f(ww.y) * lo2f(vv.y) + hi2f(ww.y) * hi2f(vv.y)
                   + lo2f(ww.z) * lo2f(vv.z) + hi2f(ww.z) * hi2f(vv.z) + lo2f(ww.w) * lo2f(vv.w) + hi2f(ww.w) * hi2f(vv.w);
            }
            const float uv = gelu_erf(bf2f(Z[(size_t)(row0 + p) * ZC + 1280 + c]));
            CAT[(size_t)(row0 + p) * D + 768 + c] = f2bf(uv * (s + bs[p]));
        }
    }
    __syncthreads();
    {
        const int i = tid & 127, h = tid >> 7, kvh = h >> 1;
        const float2* rope = (const float2*)(a->ws + WS_ROPE);
        const int qpos = pos0 + i;
        bf16_t* q = (bf16_t*)lds + tid * 66;
        {
            float t0[32];
            load32(t0, Z + (size_t)(row0 + i) * ZC + 512 + h * 64);
            if (!is_ctx) rope32(t0, rope + (qpos >> 6) * 16);
#pragma unroll
            for (int d = 0; d < 32; ++d) q[d] = f2bf(t0[d]);
            load32(t0, Z + (size_t)(row0 + i) * ZC + 512 + h * 64 + 32);
            if (!is_ctx) rope32(t0, rope + (qpos & 63) * 16);
#pragma unroll
            for (int d = 0; d < 32; ++d) q[32 + d] = f2bf(t0[d]);
        }
#pragma unroll 1
        for (int dh = 0; dh < 2; ++dh) {
        float m = a->in[8][l * 4 + h], den = 1.0f;
        float o[32];
#pragma unroll
        for (int d = 0; d < 32; ++d) o[d] = 0.f;
        if (!is_ctx) {
            const bf16_t* VT = (const bf16_t*)(a->ws + WS_VT) + ((size_t)(b * 2 + kvh) * 64 + dh * 32) * 4096;
            const int slo = max(qpos - 128, 0), shi = min(qpos + 128, n - 1);
#pragma unroll 1
            for (int s = slo; s <= shi; ++s) {
                const float dot = 0.125f * kdot(Z + (size_t)(seq_row0 + s) * ZC + 768 + kvh * 64, q, rope + (s >> 6) * 16, rope + (s & 63) * 16, true);
                const float mn = fmaxf(m, dot), corr = __expf(m - mn), p = __expf(dot - mn);
                den = den * corr + p; m = mn;
#pragma unroll
                for (int d = 0; d < 32; ++d) o[d] = o[d] * corr + p * bf2f(VT[(size_t)d * 4096 + s]);
            }
        }
        {
            const bf16_t* VTC = (const bf16_t*)(a->ws + WS_VTC) + ((size_t)(b * 2 + kvh) * 64 + dh * 32) * 256;
#pragma unroll 1
            for (int j = 0; j < 256; ++j) {
                const float dot = 0.125f * kdot(Z + (size_t)(NLAT + b * 256 + j) * ZC + 768 + kvh * 64, q, rope, rope, false);
                const float mn = fmaxf(m, dot), corr = __expf(m - mn), p = __expf(dot - mn);
                den = den * corr + p; m = mn;
#pragma unroll
                for (int d = 0; d < 32; ++d) o[d] = o[d] * corr + p * bf2f(VTC[(size_t)d * 256 + j]);
            }
        }
        const float inv = 1.0f / den;
        bf16_t* dst = CAT + (size_t)(row0 + i) * D + 256 + h * 64 + dh * 32;
#pragma unroll
        for (int d8 = 0; d8 < 4; ++d8) { u32x4 pk; pk.x = pack2(o[8 * d8] * inv, o[8 * d8 + 1] * inv); pk.y = pack2(o[8 * d8 + 2] * inv, o[8 * d8 + 3] * inv);
            pk.z = pack2(o[8 * d8 + 4] * inv, o[8 * d8 + 5] * inv); pk.w = pack2(o[8 * d8 + 6] * inv, o[8 * d8 + 7] * inv); *(u32x4*)(dst + 8 * d8) = pk; }
        }
    }
    __syncthreads();
}

__device__ __forceinline__ u32x4 ld16g(const bf16_t* p) { return *(const u32x4*)p; }
__device__ __forceinline__ void rope_pack8(u32x4& wl, u32x4& wh, const float2* tab, bool do_rope, float scale) {
    float tl[8] = {lo2f(wl.x), hi2f(wl.x), lo2f(wl.y), hi2f(wl.y), lo2f(wl.z), hi2f(wl.z), lo2f(wl.w), hi2f(wl.w)};
    float th[8] = {lo2f(wh.x), hi2f(wh.x), lo2f(wh.y), hi2f(wh.y), lo2f(wh.z), hi2f(wh.z), lo2f(wh.w), hi2f(wh.w)};
#pragma unroll
    for (int j = 0; j < 8; ++j) {
        float r1 = tl[j], r2 = th[j];
        if (do_rope) { const float2 cs = tab[j]; r1 = tl[j] * cs.x - th[j] * cs.y; r2 = tl[j] * cs.y + th[j] * cs.x; }
        tl[j] = r1 * scale; th[j] = r2 * scale;
    }
    wl.x = pack2(tl[0], tl[1]); wl.y = pack2(tl[2], tl[3]); wl.z = pack2(tl[4], tl[5]); wl.w = pack2(tl[6], tl[7]);
    wh.x = pack2(th[0], th[1]); wh.y = pack2(th[2], th[3]); wh.z = pack2(th[4], th[5]); wh.w = pack2(th[6], th[7]);
}

__device__ __forceinline__ void mixer_tile_fast(AP a, LAS unsigned char* lds, int l, int row0, int seq_row0, int pos0, int n, int b, bool is_ctx) {
    const int tid = tid_opaque(), lane = tid & 63, w = __builtin_amdgcn_readfirstlane(tid >> 6), fr = lane & 15, g = lane >> 4;
    const bf16_t* Z = (const bf16_t*)(a->ws + WS_Z);
    bf16_t* CAT = (bf16_t*)(a->ws + WS_CAT);
    {
        const int c = tid & 255, half = tid >> 8, hw = 1 << (c >> 6);
        const bf16_t* P = Z + (size_t)seq_row0 * ZC + 1024 + c;
        const int p0 = pos0 + half * 64;
        float s = 0.f;
        for (int j = max(p0 - hw, 0); j < min(p0 + hw, n); ++j) s += bf2f(P[(size_t)j * ZC]);
        for (int tl = 0; tl < 64; ++tl) {
            const int pos = p0 + tl; const int lo = max(pos - hw, 0), hi = min(pos + hw, n);
            const float self = bf2f(P[(size_t)pos * ZC]);
            CAT[(size_t)(row0 + half * 64 + tl) * D + 512 + c] = f2bf(s / (float)(hi - lo) - self);
            if (pos + hw < n) s += bf2f(P[(size_t)(pos + hw) * ZC]);
            if (pos - hw >= 0) s -= bf2f(P[(size_t)(pos - hw) * ZC]);
        }
    }
    for (int q = w; q < 128; q += 8) {
        const u32x2 gw = *(const u32x2*)(Z + (size_t)(row0 + q) * ZC + 1536 + 4 * lane);
        float gv[4] = {gelu_erf(lo2f(gw.x)), gelu_erf(hi2f(gw.x)), gelu_erf(lo2f(gw.y)), gelu_erf(hi2f(gw.y))};
        float s = wave_sum((gv[0] + gv[1]) + (gv[2] + gv[3])); const float mean = s * (1.0f / 256.0f);
        float qq = 0.f;
#pragma unroll
        for (int e = 0; e < 4; ++e) { const float d = gv[e] - mean; qq += d * d; }
        qq = wave_sum(qq); const float rstd = 1.0f / sqrtf(qq * (1.0f / 256.0f) + 1e-6f);
#pragma unroll
        for (int e = 0; e < 4; ++e) { const int c = 4 * lane + e; *(LAS bf16_t*)(lds + c * 256 + ((((q >> 3) ^ (c & 15))) << 4) + (q & 7) * 2) = f2bf((gv[e] - mean) * rstd); }
    }
    __syncthreads();
    {
        const int h = w >> 1, ph = w & 1;
        const bf16_t* Ws = (const bf16_t*)(a->ws + WS_WSGU) + (size_t)(l * 4 + h) * 128 * 128;
        const float* bs = a->in[12] + (size_t)(l * 4 + h) * 128;
        f32x4 acc[4][4];
#pragma unroll
        for (int i = 0; i < 4; ++i)
#pragma unroll
            for (int j = 0; j < 4; ++j) acc[i][j] = (f32x4){0.f, 0.f, 0.f, 0.f};
#pragma unroll
        for (int ks = 0; ks < 4; ++ks) {
            bf16x8 af[4], bfv[4];
#pragma unroll
            for (int cf = 0; cf < 4; ++cf) { const int c = h * 64 + 16 * cf + fr; af[cf] = *(const LAS bf16x8*)(lds + c * 256 + (((4 * ks + g) ^ (c & 15)) << 4)); }
#pragma unroll
            for (int pf = 0; pf < 4; ++pf) { const int p = ph * 64 + 16 * pf + fr; bfv[pf] = *(const bf16x8*)(Ws + (size_t)p * 128 + 32 * ks + 8 * g); }
#pragma unroll
            for (int cf = 0; cf < 4; ++cf)
#pragma unroll
                for (int pf = 0; pf < 4; ++pf) acc[cf][pf] = __builtin_amdgcn_mfma_f32_16x16x32_bf16(af[cf], bfv[pf], acc[cf][pf], 0, 0, 0);
        }
#pragma unroll
        for (int pf = 0; pf < 4; ++pf) { const int p = ph * 64 + 16 * pf + fr; const float bias = bs[p];
#pragma unroll
            for (int cf = 0; cf < 4; ++cf) { const int c0 = h * 64 + 16 * cf + 4 * g;
                const u32x2 uw = *(const u32x2*)(Z + (size_t)(row0 + p) * ZC + 1280 + c0);
                u32x2 o; o.x = pack2(gelu_erf(lo2f(uw.x)) * (acc[cf][pf][0] + bias), gelu_erf(hi2f(uw.x)) * (acc[cf][pf][1] + bias));
                o.y = pack2(gelu_erf(lo2f(uw.y)) * (acc[cf][pf][2] + bias), gelu_erf(hi2f(uw.y)) * (acc[cf][pf][3] + bias));
                *(u32x2*)(CAT + (size_t)(row0 + p) * D + 768 + c0) = o; } }
    }
    const float2* rope = (const float2*)(a->ws + WS_ROPE);
    constexpr float QS = 0.125f * 1.44269504088896341f;
    constexpr int QS_OFF = 0, KS_OFF = 32768, VS_OFF = 49152;
    const int nbq = pos0 >> 7;
#pragma unroll 1
    for (int kvh = 0; kvh < 2; ++kvh) {
        __syncthreads();
#pragma unroll
        for (int it = 0; it < 2; ++it) {
            const int item = tid + 512 * it, r = item >> 2, ax = (item >> 1) & 1, h8 = item & 1, i = r & 127, qpos = pos0 + i;
            const bf16_t* src = Z + (size_t)(row0 + i) * ZC + 512 + (2 * kvh + (r >> 7)) * 64 + ax * 32 + h8 * 8;
            u32x4 wl = ld16g(src), wh = ld16g(src + 16);
            rope_pack8(wl, wh, rope + (ax ? (qpos & 63) : (qpos >> 6)) * 16 + h8 * 8, !is_ctx, QS);
            const int ch = ax * 4 + h8, sw = (r >> 1) & 7;
            *(LAS u32x4*)(lds + QS_OFF + r * 128 + ((ch ^ sw) << 4)) = wl;
            *(LAS u32x4*)(lds + QS_OFF + r * 128 + (((ch + 2) ^ sw) << 4)) = wh;
        }
        const int hh = w >> 2, qb = (w & 3) * 32, h = 2 * kvh + hh;
        float m[2], lsum[2];
        m[0] = m[1] = a->in[8][l * 4 + h] * 1.44269504088896341f;
        lsum[0] = lsum[1] = (g == 0) ? 1.0f : 0.0f;
        f32x4 O[4][2];
#pragma unroll
        for (int i = 0; i < 4; ++i) { O[i][0] = (f32x4){0.f, 0.f, 0.f, 0.f}; O[i][1] = (f32x4){0.f, 0.f, 0.f, 0.f}; }
        bf16x8 Qf[2][2];
        bool have_q = false;
#pragma unroll 1
        for (int blk = 0; blk < 5; ++blk) {
            const int jb = blk - 1;
            const bool band = blk < 3;
            if (band && (is_ctx || nbq + jb < 0 || nbq + jb >= (n >> 7))) continue;
            const int key0 = band ? (nbq + jb) * 128 : (blk - 3) * 128;
            const int krow0 = band ? seq_row0 + key0 : NLAT + b * 256 + key0;
            {
                const int r = tid >> 2, ax = (tid >> 1) & 1, h8 = tid & 1, kpos = key0 + r;
                const bf16_t* src = Z + (size_t)(krow0 + r) * ZC + 768 + kvh * 64 + ax * 32 + h8 * 8;
                u32x4 wl = ld16g(src), wh = ld16g(src + 16);
                rope_pack8(wl, wh, rope + (ax ? (kpos & 63) : (kpos >> 6)) * 16 + h8 * 8, band, 1.0f);
                const int ch = ax * 4 + h8, sw = (r >> 1) & 7;
                *(LAS u32x4*)(lds + KS_OFF + r * 128 + ((ch ^ sw) << 4)) = wl;
                *(LAS u32x4*)(lds + KS_OFF + r * 128 + (((ch + 2) ^ sw) << 4)) = wh;
            }
            {
                const bf16_t* vsrc = band ? (const bf16_t*)(a->ws + WS_VT) + (size_t)(b * 2 + kvh) * 64 * 4096 + key0 : (const bf16_t*)(a->ws + WS_VTC) + (size_t)(b * 2 + kvh) * 64 * 256 + key0;
                const int vld = band ? 4096 : 256;
#pragma unroll
                for (int i = 0; i < 2; ++i) { const int P = i * 512 + tid, d = P >> 4, c = (P & 15) ^ (d & 15);
                    glds16(vsrc + (size_t)d * vld + c * 8, lds + VS_OFF + i * 8192 + w * 1024); }
            }
            asm volatile("s_waitcnt vmcnt(0)" ::: "memory");
            __syncthreads();
            if (!have_q) {
#pragma unroll
                for (int qf = 0; qf < 2; ++qf)
#pragma unroll
                    for (int ks = 0; ks < 2; ++ks) { const int r = hh * 128 + qb + 16 * qf + fr; Qf[qf][ks] = *(const LAS bf16x8*)(lds + QS_OFF + r * 128 + (((4 * ks + g) ^ ((r >> 1) & 7)) << 4)); }
                have_q = true;
            }
            f32x4 S[8][2];
#pragma unroll
            for (int kf = 0; kf < 8; ++kf) { S[kf][0] = (f32x4){0.f, 0.f, 0.f, 0.f}; S[kf][1] = (f32x4){0.f, 0.f, 0.f, 0.f}; }
#pragma unroll
            for (int kf = 0; kf < 8; ++kf)
#pragma unroll
                for (int ks = 0; ks < 2; ++ks) { const int r = 16 * kf + fr;
                    const bf16x8 kfr = *(const LAS bf16x8*)(lds + KS_OFF + r * 128 + (((4 * ks + g) ^ ((r >> 1) & 7)) << 4));
                    S[kf][0] = __builtin_amdgcn_mfma_f32_16x16x32_bf16(kfr, Qf[0][ks], S[kf][0], 0, 0, 0);
                    S[kf][1] = __builtin_amdgcn_mfma_f32_16x16x32_bf16(kfr, Qf[1][ks], S[kf][1], 0, 0, 0); }
            bf16x8 Pp[4][2];
#pragma unroll
            for (int qf = 0; qf < 2; ++qf) {
                const int qi = qb + 16 * qf + fr;
                if (band && jb != 0) {
#pragma unroll
                    for (int kf = 0; kf < 8; ++kf)
#pragma unroll
                        for (int r = 0; r < 4; ++r) { const int kk = 16 * kf + 4 * g + r; const bool ok = (jb < 0) ? (kk >= qi) : (kk <= qi); if (!ok) S[kf][qf][r] = -1.0e30f; }
                }
                float mx = S[0][qf][0];
#pragma unroll
                for (int kf = 0; kf < 8; ++kf)
#pragma unroll
                    for (int r = 0; r < 4; ++r) mx = fmaxf(mx, S[kf][qf][r]);
                mx = fmaxf(mx, __shfl_xor(mx, 16)); mx = fmaxf(mx, __shfl_xor(mx, 32));
                const float mn = fmaxf(m[qf], mx), corr = __builtin_amdgcn_exp2f(m[qf] - mn);
                m[qf] = mn;
                float ps = 0.f;
#pragma unroll
                for (int kf = 0; kf < 8; ++kf)
#pragma unroll
                    for (int r = 0; r < 4; ++r) { const float p = __builtin_amdgcn_exp2f(S[kf][qf][r] - mn); S[kf][qf][r] = p; ps += p; }
                lsum[qf] = lsum[qf] * corr + ps;
#pragma unroll
                for (int df = 0; df < 4; ++df) O[df][qf] *= corr;
#pragma unroll
                for (int t = 0; t < 4; ++t) { u32x4 pw; pw.x = pack2(S[2 * t][qf][0], S[2 * t][qf][1]); pw.y = pack2(S[2 * t][qf][2], S[2 * t][qf][3]);
                    pw.z = pack2(S[2 * t + 1][qf][0], S[2 * t + 1][qf][1]); pw.w = pack2(S[2 * t + 1][qf][2], S[2 * t + 1][qf][3]); Pp[t][qf] = __builtin_bit_cast(bf16x8, pw); }
            }
#pragma unroll
            for (int t = 0; t < 4; ++t)
#pragma unroll
                for (int df = 0; df < 4; ++df) { const int d = 16 * df + fr;
                    const u32x2 v0 = *(const LAS u32x2*)(lds + VS_OFF + d * 256 + (((4 * t + (g >> 1)) ^ (d & 15)) << 4) + (g & 1) * 8);
                    const u32x2 v1 = *(const LAS u32x2*)(lds + VS_OFF + d * 256 + (((4 * t + 2 + (g >> 1)) ^ (d & 15)) << 4) + (g & 1) * 8);
                    u32x4 vw; vw.x = v0.x; vw.y = v0.y; vw.z = v1.x; vw.w = v1.y; const bf16x8 vf = __builtin_bit_cast(bf16x8, vw);
                    O[df][0] = __builtin_amdgcn_mfma_f32_16x16x32_bf16(vf, Pp[t][0], O[df][0], 0, 0, 0);
                    O[df][1] = __builtin_amdgcn_mfma_f32_16x16x32_bf16(vf, Pp[t][1], O[df][1], 0, 0, 0); }
            __syncthreads();
        }
#pragma unroll
        for (int qf = 0; qf < 2; ++qf) {
            float lt = lsum[qf]; lt += __shfl_xor(lt, 16); lt += __shfl_xor(lt, 32);
            const float inv = 1.0f / lt;
            bf16_t* dst = CAT + (size_t)(row0 + qb + 16 * qf + fr) * D + 256 + h * 64 + 4 * g;
#pragma unroll
            for (int df = 0; df < 4; ++df) { u32x2 o; o.x = pack2(O[df][qf][0] * inv, O[df][qf][1] * inv); o.y = pack2(O[df][qf][2] * inv, O[df][qf][3] * inv); *(u32x2*)(dst + 16 * df) = o; }
        }
    }
    __syncthreads();
}

__device__ __forceinline__ void p2_mix(AP a, unsigned char* ldsg, LAS unsigned char* lds, int l) {
    const int n_dft = 256, n_dftc = (l == 0) ? 16 : 0, n_mix = 128 + ((l == 0) ? 8 : 0);
    bf16_t* CAT = (bf16_t*)(a->ws + WS_CAT);
    for (int u = blockIdx.x; u < n_dft + n_dftc + n_mix; u += gridDim.x) {
        if (u < n_dft) {
            const int mt = u >> 3, nt = u & 7, b = nt >> 1, ch0 = (nt & 1) * 128;
            const bf16_t* A = (const bf16_t*)(a->ws + WS_DFT) + (size_t)(mt * 128) * 8192;
            const bf16_t* B0 = (const bf16_t*)(a->ws + WS_AT) + ((size_t)b * 256 + ch0) * 8192;
            EpiBf16 E; E.C = CAT + (size_t)(b * 4096 + mt * 128) * D + ch0; E.ld = D;
            gemm_tile<128, false, EpiBf16>(lds, A, 8192, nullptr, 128, B0, B0 + (size_t)64 * 8192, 8192, 8192, E);
        } else if (u < n_dft + n_dftc) {
            const int uu = u - n_dft, b = uu >> 2, mt = (uu >> 1) & 1, ch0 = (uu & 1) * 128;
            const bf16_t* A = (const bf16_t*)(a->ws + WS_DFTC) + (size_t)(mt * 128) * 512;
            const bf16_t* B0 = (const bf16_t*)(a->ws + WS_ATC) + ((size_t)b * 256 + ch0) * 512;
            EpiBf16 E; E.C = CAT + (size_t)(NLAT + b * 256 + mt * 128) * D + ch0; E.ld = D;
            gemm_tile<128, false, EpiBf16>(lds, A, 512, nullptr, 128, B0, B0 + (size_t)64 * 512, 512, 512, E);
        } else {
            const int t = u - n_dft - n_dftc;
#if NAIVE_MIXER
            if (t < 128) { const int b = t >> 5; mixer_tile(a, ldsg, l, t * 128, b * 4096, (t & 31) * 128, 4096, b, false); }
            else { const int tt = t - 128, b = tt >> 1; mixer_tile(a, ldsg, l, NLAT + tt * 128, NLAT + b * 256, (tt & 1) * 128, 256, b, true); }
#else
            const bool isc = t >= 128; const int tt = t - 128;
            const int b = isc ? (tt >> 1) : (t >> 5);
            mixer_tile_fast(a, lds, l, isc ? NLAT + tt * 128 : t * 128, isc ? NLAT + b * 256 : b * 4096, isc ? (tt & 1) * 128 : (t & 31) * 128, isc ? 256 : 4096, b, isc);
#endif
        }
    }
}

__device__ __forceinline__ void p3_outproj(AP a, LAS unsigned char* lds, int l) {
    const int nrt = (l == 0) ? NTOK / 128 : NLAT / 128;
    const bf16_t* W = (const bf16_t*)(a->ws + WS_WOUT) + (size_t)l * 1024 * 1024;
    for (int u = blockIdx.x; u < nrt * 4; u += gridDim.x) {
        const int rt = u >> 2, ct = u & 3;
        EpiF32 E; E.C = (float*)(a->ws + WS_Y) + (size_t)(rt * 128) * D + ct * 256; E.ld = D;
        const bf16_t* B0 = W + (size_t)(ct * 256) * 1024;
        gemm_tile<256, false, EpiF32>(lds, (const bf16_t*)(a->ws + WS_CAT) + (size_t)(rt * 128) * D, D, nullptr, 128, B0, B0 + (size_t)128 * 1024, 1024, 1024, E);
    }
}

__device__ __forceinline__ void p4_ln1_router(AP a, unsigned char* lds, int l) {
    const int tid = tid_opaque(), lane = tid & 63, w = tid >> 6;
    const int ntok = (l == 0) ? NTOK : NLAT;
    int* cnt = (int*)(lds + 98304);
    if (tid < 32) cnt[tid] = 0;
    __syncthreads();
    const float* mod = (const float*)(a->ws + WS_MOD) + (size_t)l * 5 * 6144;
    const float* Y = (const float*)(a->ws + WS_Y);
    float* X1 = (float*)(a->ws + WS_X1);
    bf16_t* H = (bf16_t*)(a->ws + WS_H);
    const float* g1w = a->in[14] + l * 1024; const float* b1w = a->in[15] + l * 1024;
    const float* wrg = a->in[16] + (size_t)l * 1024 * 4; const float* wre = a->in[17] + (size_t)l * 1024 * 32;
    int* tokE = (int*)(a->ws + WS_TOKE); int* tokR = (int*)(a->ws + WS_TOKR); float* tokG = (float*)(a->ws + WS_TOKG);
    for (int t = blockIdx.x * 8 + w; t < ntok; t += gridDim.x * 8) {
        const float* xs = (l == 0) ? ((t < NLAT) ? a->in[0] + (size_t)t * D : a->in[2] + (size_t)(t - NLAT) * D) : (const float*)(a->ws + WS_XC) + (size_t)t * D;
        const float* m = mod + (size_t)((t < NLAT) ? (t >> 12) : 4) * 6144;
        f32x4 v[4];
#pragma unroll
        for (int i = 0; i < 4; ++i) { const int c = 256 * i + 4 * lane; const f32x4 xv = *(const f32x4*)(xs + c), yv = *(const f32x4*)(Y + (size_t)t * D + c), gv = *(const f32x4*)(m + 2048 + c);
#pragma unroll
            for (int e = 0; e < 4; ++e) v[i][e] = RES_ALPHA * xv[e] + gv[e] * yv[e]; }
        float mean, rstd; ln_stats(v, mean, rstd);
#pragma unroll
        for (int i = 0; i < 4; ++i) { const int c = 256 * i + 4 * lane; const f32x4 gg = *(const f32x4*)(g1w + c), bb = *(const f32x4*)(b1w + c);
#pragma unroll
            for (int e = 0; e < 4; ++e) v[i][e] = (v[i][e] - mean) * rstd * gg[e] + bb[e];
            *(f32x4*)(X1 + (size_t)t * D + c) = v[i]; }
        ln_stats(v, mean, rstd);
#pragma unroll
        for (int i = 0; i < 4; ++i) { const int c = 256 * i + 4 * lane; const f32x4 sh = *(const f32x4*)(m + 3072 + c), sc = *(const f32x4*)(m + 4096 + c);
#pragma unroll
            for (int e = 0; e < 4; ++e) v[i][e] = (v[i][e] - mean) * rstd * (1.0f + sc[e]) + sh[e];
            u32x2 pk; pk.x = pack2(v[i][0], v[i][1]); pk.y = pack2(v[i][2], v[i][3]); *(u32x2*)(H + (size_t)t * D + c) = pk; }
        float lg[4] = {0.f, 0.f, 0.f, 0.f};
#pragma unroll
        for (int i = 0; i < 4; ++i)
#pragma unroll
            for (int e = 0; e < 4; ++e) { const int c = 256 * i + 4 * lane + e; const f32x4 wv = *(const f32x4*)(wrg + (size_t)c * 4);
                lg[0] += v[i][e] * wv[0]; lg[1] += v[i][e] * wv[1]; lg[2] += v[i][e] * wv[2]; lg[3] += v[i][e] * wv[3]; }
#pragma unroll
        for (int q = 0; q < 4; ++q) lg[q] = wave_sum(lg[q]);
        int grp = 0; float mx = lg[0];
#pragma unroll
        for (int q = 1; q < 4; ++q) if (lg[q] > mx) { mx = lg[q]; grp = q; }
        float se = 0.f;
#pragma unroll
        for (int q = 0; q < 4; ++q) se += expf(lg[q] - mx);
        const float gate_group = 1.0f / se;
        float le[8] = {0.f, 0.f, 0.f, 0.f, 0.f, 0.f, 0.f, 0.f};
#pragma unroll
        for (int i = 0; i < 4; ++i)
#pragma unroll
            for (int e = 0; e < 4; ++e) { const int c = 256 * i + 4 * lane + e; const float* wp = wre + (size_t)c * 32 + grp * 8; const f32x4 w0 = *(const f32x4*)wp, w1 = *(const f32x4*)(wp + 4);
                le[0] += v[i][e] * w0[0]; le[1] += v[i][e] * w0[1]; le[2] += v[i][e] * w0[2]; le[3] += v[i][e] * w0[3];
                le[4] += v[i][e] * w1[0]; le[5] += v[i][e] * w1[1]; le[6] += v[i][e] * w1[2]; le[7] += v[i][e] * w1[3]; }
#pragma unroll
        for (int q = 0; q < 8; ++q) le[q] = wave_sum(le[q]);
        int j1 = 0; float l1 = le[0];
#pragma unroll
        for (int q = 1; q < 8; ++q) if (le[q] > l1) { l1 = le[q]; j1 = q; }
        int j2 = -1; float l2 = -3.0e38f;
#pragma unroll
        for (int q = 0; q < 8; ++q) if (q != j1 && le[q] > l2) { l2 = le[q]; j2 = q; }
        const float e2 = expf(l2 - l1), p1 = 1.0f / (1.0f + e2), p2 = e2 / (1.0f + e2);
        if (lane == 0) {
            const int ex0 = grp * 8 + j1, ex1 = grp * 8 + j2;
            const int r0 = atomicAdd(&cnt[ex0], 1), r1 = atomicAdd(&cnt[ex1], 1);
            tokE[2 * t] = ex0; tokE[2 * t + 1] = ex1; tokR[2 * t] = r0; tokR[2 * t + 1] = r1;
            tokG[2 * t] = gate_group * p1; tokG[2 * t + 1] = gate_group * p2;
        }
    }
    __syncthreads();
    if (tid < 32) ((int*)(a->ws + WS_BCNT))[((size_t)l * MAXG + blockIdx.x) * 32 + tid] = cnt[tid];
    __syncthreads();
}

__device__ __forceinline__ void p5_dispatch(AP a, unsigned char* lds, int l) {
    const int tid = tid_opaque();
    const int ntok = (l == 0) ? NTOK : NLAT;
    int* part = (int*)lds;
    int* tot = (int*)(lds + 4096);
    int* off = (int*)(lds + 4096 + 128);
    int* pstart = (int*)(lds + 4096 + 256);
    const int* bc = (const int*)(a->ws + WS_BCNT) + (size_t)l * MAXG * 32;
    const int G = gridDim.x, me = blockIdx.x;
    { const int e = tid & 31, p = tid >> 5; int s = 0, so = 0; for (int bb = p; bb < G; bb += 16) { const int c = bc[bb * 32 + e]; s += c; if (bb < me) so += c; } part[p * 32 + e] = s; part[512 + p * 32 + e] = so; }
    __syncthreads();
    if (tid < 32) { int s = 0, so = 0; for (int p = 0; p < 16; ++p) { s += part[p * 32 + tid]; so += part[512 + p * 32 + tid]; } tot[tid] = s; off[tid] = so; }
    __syncthreads();
    if (tid == 0) { int acc = 0; for (int e = 0; e < 32; ++e) { pstart[e] = acc; acc += ((tot[e] + 127) >> 7) << 7; } }
    __syncthreads();
    if (me == 0 && tid < 32) ((int*)(a->ws + WS_CNT))[l * 32 + tid] = tot[tid];
    const int* tokE = (const int*)(a->ws + WS_TOKE); const int* tokR = (const int*)(a->ws + WS_TOKR);
    int* tokS = (int*)(a->ws + WS_TOKS); int* slotT = (int*)(a->ws + WS_SLOTT);
    for (int base = me * 8; base < ntok; base += G * 8) {
        if (tid < 16) { const int t = base + (tid >> 1); if (t < ntok) { const int idx = 2 * t + (tid & 1); const int e = tokE[idx]; const int slot = pstart[e] + off[e] + tokR[idx]; tokS[idx] = slot; slotT[slot] = t; } }
    }
    __syncthreads();
}

__device__ __forceinline__ int moe_table(AP a, unsigned char* lds, int l, int* blk) {
    const int* tot = (const int*)(a->ws + WS_CNT) + l * 32;
    if (threadIdx.x == 0) { int acc = 0; for (int e = 0; e < 32; ++e) { blk[e] = acc; acc += (tot[e] + 127) >> 7; } blk[32] = acc; }
    __syncthreads();
    return blk[32];
}

__device__ __forceinline__ void p6_gateup(AP a, unsigned char* ldsg, LAS unsigned char* lds, int l) {
    int* blk = (int*)(ldsg + 98304 + 256);
    const int nrb = moe_table(a, ldsg, l, blk);
    const int* tot = (const int*)(a->ws + WS_CNT) + l * 32;
    const bf16_t* WG = (const bf16_t*)(a->ws + WS_WEXP); const bf16_t* WU = WG + EXPMAT;
    for (int u = blockIdx.x; u < nrb * 4; u += gridDim.x) {
        const int rb = u >> 2, ct = u & 3;
        int e = 0; for (int q = 1; q < 32; ++q) if (blk[q] <= rb) e = q;
        const int valid = min(128, tot[e] - (rb - blk[e]) * 128);
        EpiGateUp E; E.C = (bf16_t*)(a->ws + WS_HID) + (size_t)(rb * 128) * DEXP + ct * 128; E.ld = DEXP;
        gemm_tile<256, true, EpiGateUp>(lds, (const bf16_t*)(a->ws + WS_H), D, (const int*)(a->ws + WS_SLOTT) + rb * 128, valid,
                                        WG + ((size_t)e * 512 + ct * 128) * 1024, WU + ((size_t)e * 512 + ct * 128) * 1024, 1024, 1024, E);
    }
    __syncthreads();
}
__device__ __forceinline__ void p7_down(AP a, unsigned char* ldsg, LAS unsigned char* lds, int l) {
    int* blk = (int*)(ldsg + 98304 + 256);
    const int nrb = moe_table(a, ldsg, l, blk);
    const bf16_t* WD = (const bf16_t*)(a->ws + WS_WEXP) + 2 * EXPMAT;
    for (int u = blockIdx.x; u < nrb * 4; u += gridDim.x) {
        const int rb = u >> 2, ct = u & 3;
        int e = 0; for (int q = 1; q < 32; ++q) if (blk[q] <= rb) e = q;
        EpiBf16 E; E.C = (bf16_t*)(a->ws + WS_YS) + (size_t)(rb * 128) * D + ct * 256; E.ld = D;
        const bf16_t* B0 = WD + ((size_t)e * 1024 + ct * 256) * 512;
        gemm_tile<256, false, EpiBf16>(lds, (const bf16_t*)(a->ws + WS_HID) + (size_t)(rb * 128) * DEXP, DEXP, nullptr, 128, B0, B0 + (size_t)128 * 512, 512, 512, E);
    }
    __syncthreads();
}

__device__ __forceinline__ void p8_ln2(AP a, unsigned char* lds, int l) {
    const int tid = tid_opaque(), lane = tid & 63, w = tid >> 6;
    const int ntok = (l == 0) ? NTOK : NLAT;
    const float* mod = (const float*)(a->ws + WS_MOD) + (size_t)l * 5 * 6144;
    const float* modn = (const float*)(a->ws + WS_MOD) + (size_t)5 * 6144;
    const float* X1 = (const float*)(a->ws + WS_X1);
    const bf16_t* YS = (const bf16_t*)(a->ws + WS_YS);
    const int* tokS = (const int*)(a->ws + WS_TOKS); const float* tokG = (const float*)(a->ws + WS_TOKG);
    const float* g2w = a->in[21] + l * 1024; const float* b2w = a->in[22] + l * 1024;
    for (int t = blockIdx.x * 8 + w; t < ntok; t += gridDim.x * 8) {
        const float* m = mod + (size_t)((t < NLAT) ? (t >> 12) : 4) * 6144;
        const int s0 = tokS[2 * t], s1 = tokS[2 * t + 1]; const float ga = tokG[2 * t], gb = tokG[2 * t + 1];
        f32x4 v[4];
#pragma unroll
        for (int i = 0; i < 4; ++i) { const int c = 256 * i + 4 * lane; const f32x4 xv = *(const f32x4*)(X1 + (size_t)t * D + c), gv = *(const f32x4*)(m + 5120 + c);
            const u32x2 ya = *(const u32x2*)(YS + (size_t)s0 * D + c), yb = *(const u32x2*)(YS + (size_t)s1 * D + c);
            const float f0 = ga * lo2f(ya.x) + gb * lo2f(yb.x), f1 = ga * hi2f(ya.x) + gb * hi2f(yb.x), f2 = ga * lo2f(ya.y) + gb * lo2f(yb.y), f3 = ga * hi2f(ya.y) + gb * hi2f(yb.y);
            v[i][0] = RES_ALPHA * xv[0] + gv[0] * f0; v[i][1] = RES_ALPHA * xv[1] + gv[1] * f1; v[i][2] = RES_ALPHA * xv[2] + gv[2] * f2; v[i][3] = RES_ALPHA * xv[3] + gv[3] * f3; }
        float mean, rstd; ln_stats(v, mean, rstd);
        float* dst = (l == 0) ? (float*)(a->ws + WS_XC) + (size_t)t * D : a->out + (size_t)t * D;
#pragma unroll
        for (int i = 0; i < 4; ++i) { const int c = 256 * i + 4 * lane; const f32x4 gg = *(const f32x4*)(g2w + c), bb = *(const f32x4*)(b2w + c);
#pragma unroll
            for (int e = 0; e < 4; ++e) v[i][e] = (v[i][e] - mean) * rstd * gg[e] + bb[e];
            *(f32x4*)(dst + c) = v[i]; }
        if (l == 0) {
            const float* mn = modn + (size_t)((t < NLAT) ? (t >> 12) : 4) * 6144;
            ln_stats(v, mean, rstd);
            bf16_t* H = (bf16_t*)(a->ws + WS_H);
#pragma unroll
            for (int i = 0; i < 4; ++i) { const int c = 256 * i + 4 * lane; const f32x4 sh = *(const f32x4*)(mn + c), sc = *(const f32x4*)(mn + 1024 + c);
                f32x4 o;
#pragma unroll
                for (int e = 0; e < 4; ++e) o[e] = (v[i][e] - mean) * rstd * (1.0f + sc[e]) + sh[e];
                u32x2 pk; pk.x = pack2(o[0], o[1]); pk.y = pack2(o[2], o[3]); *(u32x2*)(H + (size_t)t * D + c) = pk; }
        }
    }
    if (l == 0) { __syncthreads(); for (int u = blockIdx.x; u < U_EXP; u += gridDim.x) exp_unit(a, lds, 1, u); }
}

constexpr int N_PHASES = 18;
template <int P> __device__ __forceinline__ void run_phase(AP a, unsigned char* smem, LAS unsigned char* lds, int l) {
    if (P == 0) p0_prologue(a, smem);
    if (P == 1) p_lnmod0(a);
    if (P == 2) p1_inproj(a, lds, l);
    if (P == 3) p2_mix(a, smem, lds, l);
    if (P == 4) p3_outproj(a, lds, l);
    if (P == 5) p4_ln1_router(a, smem, l);
    if (P == 6) p5_dispatch(a, smem, l);
    if (P == 7) p6_gateup(a, smem, lds, l);
    if (P == 8) p7_down(a, smem, lds, l);
    if (P == 9) p8_ln2(a, smem, l);
}
template <int P> __device__ __noinline__ void phase_fn(AP ap, int l) {
    extern __shared__ __attribute__((aligned(16))) unsigned char smem[];
    run_phase<P>(ap, smem, (LAS unsigned char*)smem, l);
}
#if N_LAUNCH_MODE == 1
__global__ void __launch_bounds__(NT, 2) fwd(Args a) {
    extern __shared__ __attribute__((aligned(16))) unsigned char smem[];
    LAS unsigned char* lds = (LAS unsigned char*)smem;
    if (threadIdx.x < 4) ((volatile LAS unsigned*)(lds + 98304 + 512))[threadIdx.x] = 0u;
    __syncthreads();
    XcdBarrier bar = xcd_barrier_post((unsigned*)(a.ws + WS_BAR), (volatile LAS unsigned*)(lds + 98304 + 512));
    AP ap = (AP)__builtin_amdgcn_kernarg_segment_ptr();
    run_phase<0>(ap, smem, lds, 0); xcd_barrier(bar);
    run_phase<1>(ap, smem, lds, 0); xcd_barrier(bar);
    for (int l = 0; l < 2; ++l) {
        run_phase<2>(ap, smem, lds, l); xcd_barrier(bar);
        run_phase<3>(ap, smem, lds, l); xcd_barrier(bar);
        run_phase<4>(ap, smem, lds, l); xcd_barrier(bar);
        run_phase<5>(ap, smem, lds, l); xcd_barrier(bar);
        run_phase<6>(ap, smem, lds, l); xcd_barrier(bar);
        run_phase<7>(ap, smem, lds, l); xcd_barrier(bar);
        run_phase<8>(ap, smem, lds, l); xcd_barrier(bar);
        run_phase<9>(ap, smem, lds, l); if (l == 0) xcd_barrier(bar);
    }
}
#else
template <int P> __global__ void __launch_bounds__(NT, 2) k_phase(Args a) {
    extern __shared__ __attribute__((aligned(16))) unsigned char smem[];
    LAS unsigned char* lds = (LAS unsigned char*)smem;
    AP ap = (AP)__builtin_amdgcn_kernarg_segment_ptr();
    run_phase<P>(ap, smem, lds, ap->ph_lo);
}
template <int P> static void launch_phase(Args a, int l, int grid, hipStream_t stream) {
    static bool attr = false;
    if (!attr) { (void)hipFuncSetAttribute((const void*)k_phase<P>, hipFuncAttributeMaxDynamicSharedMemorySize, LDS_BYTES); attr = true; }
    a.ph_lo = l; a.ph_hi = P;
    hipLaunchKernelGGL(k_phase<P>, dim3(grid), dim3(NT), LDS_BYTES, stream, a);
}
#endif

extern "C" void kernel_launch(void* const* d_in, const int* in_sizes, int n_in, void* d_out, int out_size, void* d_ws, size_t ws_size, hipStream_t stream) {
    static int grid = 0;
    if (grid == 0) {
        if (n_in != 23 || out_size != NLAT * D || ws_size < WS_END) { fprintf(stderr, "kernel_launch: unexpected shapes (n_in %d, out %d, ws %zu, need %zu)\n", n_in, out_size, ws_size, (size_t)WS_END); grid = -1; return; }
        int dev = 0, cus = 0;
        if (hipGetDevice(&dev) != hipSuccess || hipDeviceGetAttribute(&cus, hipDeviceAttributeMultiprocessorCount, dev) != hipSuccess) { grid = -1; return; }
#if N_LAUNCH_MODE == 1
        int per_cu = 0;
        if (hipFuncSetAttribute((const void*)fwd, hipFuncAttributeMaxDynamicSharedMemorySize, LDS_BYTES) != hipSuccess) { fprintf(stderr, "kernel_launch: hipFuncSetAttribute failed\n"); grid = -1; return; }
        if (hipOccupancyMaxActiveBlocksPerMultiprocessor(&per_cu, (const void*)fwd, NT, LDS_BYTES) != hipSuccess || per_cu < 1) { fprintf(stderr, "kernel_launch: occupancy query says %d\n", per_cu); }
        (void)hipGetLastError();
#endif
        grid = cus; if (grid > MAXG) grid = MAXG;
    }
    if (grid < 0) return;
    (void)hipMemsetAsync((char*)d_ws + WS_BAR, 0, 16384 + 256, stream);
    Args a{};
    for (int i = 0; i < 23; ++i) a.in[i] = (const float*)d_in[i];
    a.out = (float*)d_out; a.ws = (unsigned char*)d_ws;
#if N_LAUNCH_MODE == 1
    a.ph_lo = 0; a.ph_hi = N_PHASES;
    hipLaunchKernelGGL(fwd, dim3(grid), dim3(NT), LDS_BYTES, stream, a);
#else
    launch_phase<0>(a, 0, grid, stream);
    launch_phase<1>(a, 0, grid, stream);
    for (int l = 0; l < 2; ++l) {
        launch_phase<2>(a, l, grid, stream); launch_phase<3>(a, l, grid, stream); launch_phase<4>(a, l, grid, stream); launch_phase<5>(a, l, grid, stream);
        launch_phase<6>(a, l, grid, stream); launch_phase<7>(a, l, grid, stream); launch_phase<8>(a, l, grid, stream); launch_phase<9>(a, l, grid, stream);
    }
#endif
}
```

```cpp
#include <hip/hip_runtime.h>
#include <stdint.h>
#include <stdio.h>

#ifndef NAIVE_GEMM
#define NAIVE_GEMM 0
#endif
#ifndef NAIVE_MIXER
#define NAIVE_MIXER 0
#endif
#ifndef PROBE_MASK
#define PROBE_MASK 0
#endif
#ifndef N_LAUNCH_MODE
#define N_LAUNCH_MODE 1
#endif

#define LAS __attribute__((address_space(3)))
typedef unsigned short bf16_t;
typedef short bf16x8 __attribute__((ext_vector_type(8)));
typedef float f32x4 __attribute__((ext_vector_type(4)));
typedef unsigned u32x4 __attribute__((ext_vector_type(4)));
typedef unsigned u32x2 __attribute__((ext_vector_type(2)));

constexpr int D = 1024, NBATCH = 4, SEQ = 4096, CTXL = 256;
constexpr int NLAT = NBATCH * SEQ, NCTX = NBATCH * CTXL, NTOK = NLAT + NCTX;
constexpr int ZC = 1792;
constexpr int NEXP = 32, DEXP = 512;
constexpr int NSLOT = 2 * NTOK + NEXP * 128;
constexpr int NT = 512;
constexpr int MAXG = 512;
constexpr float RES_ALPHA = 1.41421356237309515f;
constexpr int LDS_BYTES = 98304 + 1024;

constexpr size_t WS_BAR   = 0;
constexpr size_t WS_CNT   = 16384;
constexpr size_t WS_BCNT  = WS_CNT + 256;
constexpr size_t WS_MOD   = WS_BCNT + (size_t)2 * MAXG * 32 * 4;
constexpr size_t WS_ROPE  = WS_MOD + (size_t)2 * 5 * 6144 * 4;
constexpr size_t WS_TOKE  = WS_ROPE + 8192;
constexpr size_t WS_TOKR  = WS_TOKE + (size_t)NTOK * 8;
constexpr size_t WS_TOKS  = WS_TOKR + (size_t)NTOK * 8;
constexpr size_t WS_TOKG  = WS_TOKS + (size_t)NTOK * 8;
constexpr size_t WS_SLOTT = WS_TOKG + (size_t)NTOK * 8;
constexpr size_t WS_WIN   = WS_SLOTT + (size_t)NSLOT * 4;
constexpr size_t WS_WOUT  = WS_WIN + (size_t)2 * ZC * 1024 * 2;
constexpr size_t WS_WSGU  = WS_WOUT + (size_t)2 * 1024 * 1024 * 2;
constexpr size_t WS_DFT   = WS_WSGU + (size_t)2 * 4 * 128 * 128 * 2;
constexpr size_t WS_DFTC  = WS_DFT + (size_t)4096 * 8192 * 2;
constexpr size_t WS_WEXP  = WS_DFTC + (size_t)256 * 512 * 2;
constexpr size_t EXPMAT   = (size_t)NEXP * 512 * 1024;
constexpr size_t WS_X1    = WS_WEXP + 3 * EXPMAT * 2;
constexpr size_t WS_XC    = WS_X1 + (size_t)NTOK * D * 4;
constexpr size_t WS_H     = WS_XC + (size_t)NTOK * D * 4;
constexpr size_t WS_R     = WS_H + (size_t)NTOK * D * 2;
constexpr size_t WS_Z     = WS_R;
constexpr size_t WS_AT    = WS_Z + (size_t)NTOK * ZC * 2;
constexpr size_t WS_ATC   = WS_AT + (size_t)4 * 256 * 8192 * 2;
constexpr size_t WS_VT    = WS_ATC + (size_t)4 * 256 * 512 * 2;
constexpr size_t WS_VTC   = WS_VT + (size_t)4 * 2 * 64 * 4096 * 2;
constexpr size_t WS_CAT   = WS_VTC + (size_t)4 * 2 * 64 * 256 * 2;
constexpr size_t WS_REND  = WS_CAT + (size_t)NTOK * D * 2;
constexpr size_t WS_Y     = WS_R;
constexpr size_t WS_HID   = WS_R;
constexpr size_t WS_YS    = WS_HID + (size_t)NSLOT * DEXP * 2;
constexpr size_t WS_END   = WS_REND;
static_assert(WS_Y + (size_t)NTOK * D * 4 <= WS_CAT, "Y must not reach CAT");
static_assert(WS_YS + (size_t)NSLOT * D * 2 <= WS_REND, "YS must fit the region");
static_assert(WS_WIN % 256 == 0 && WS_DFT % 256 == 0 && WS_WEXP % 256 == 0 && WS_X1 % 256 == 0 && WS_H % 256 == 0 && WS_R % 256 == 0 && WS_AT % 256 == 0 && WS_CAT % 256 == 0 && WS_YS % 256 == 0, "alignment");

struct Args { const float* in[23]; float* out; unsigned char* ws; int ph_lo, ph_hi; };
#define CAS __attribute__((address_space(4)))
typedef const CAS Args* AP;

#define XB_TMO      128
#define XB_XCNT(j)  (256  + 64 * (j))
#define XB_XSUB(j)  (1280 + 64 * (j))
#define XB_XGEN(j)  (2304 + 64 * (j))
#define XB_TOP      3328
#define XB_TOPGEN   3392
#define XCD_BAR_WORDS 3456
#define XB_SPIN_CAP (1u << 18)

__device__ __forceinline__ unsigned xb_ld(unsigned* p)              { return __hip_atomic_load(p, __ATOMIC_RELAXED, __HIP_MEMORY_SCOPE_AGENT); }
__device__ __forceinline__ unsigned xb_add(unsigned* p, unsigned v) { return __hip_atomic_fetch_add(p, v, __ATOMIC_RELAXED, __HIP_MEMORY_SCOPE_AGENT); }
__device__ __forceinline__ unsigned xb_xcc_id() { return (unsigned)__builtin_amdgcn_s_getreg((3 << 11) | 20) & 0xFu; }
#define XB_SPIN(cond, bar) do { unsigned _sp = 0; while (cond) { __builtin_amdgcn_s_sleep(1); \
    if ((++_sp & 255u) == 0u) { if (xb_ld(&(bar)[XB_TMO])) break; if (_sp > XB_SPIN_CAP) { atomicAdd(&(bar)[XB_TMO], 1u); break; } } } } while (0)

struct XcdBarrier { unsigned* bar; unsigned x; volatile LAS unsigned* st; };

__device__ __forceinline__ XcdBarrier xcd_barrier_post(unsigned* bar, volatile LAS unsigned* st) {
    XcdBarrier b; b.bar = bar; b.x = xb_xcc_id(); b.st = st;
    if (threadIdx.x == 0) (void)xb_add(&bar[XB_XCNT(b.x)], 1u);
    return b;
}
__device__ __forceinline__ void xcd_barrier_complete(unsigned* bar, unsigned x, unsigned& nloc, unsigned& nx) {
    const unsigned G = gridDim.x * gridDim.y * gridDim.z;
    unsigned sum, cnt, mine, sp = 0u;
    for (;;) {
        sum = 0u; cnt = 0u; mine = 0u;
#pragma unroll
        for (unsigned j = 0; j < 16; ++j) { const unsigned c = xb_ld(&bar[XB_XCNT(j)]); sum += c; cnt += (c > 0u) ? 1u : 0u; mine = (j == x) ? c : mine; }
        if (sum == G) break;
        __builtin_amdgcn_s_sleep(1);
        if ((++sp & 255u) == 0u) { if (xb_ld(&bar[XB_TMO])) break; if (sp > XB_SPIN_CAP) { atomicAdd(&bar[XB_TMO], 1u); break; } }
    }
    nloc = mine > 0u ? mine : 1u; nx = cnt > 0u ? cnt : 1u;
}
__device__ __forceinline__ void xcd_barrier(const XcdBarrier& b) {
    asm volatile("s_waitcnt vmcnt(0)" ::: "memory");
    __syncthreads();
    if (threadIdx.x == 0) {
        unsigned* bar = b.bar;
        __builtin_amdgcn_s_waitcnt(0);
        unsigned nloc = b.st[0], nx = b.st[1];
        if (nloc == 0u) { xcd_barrier_complete(bar, b.x, nloc, nx); b.st[0] = nloc; b.st[1] = nx; }
        const unsigned old = xb_add(&bar[XB_XSUB(b.x)], 1u);
        const unsigned gen = old / nloc;
        if (old + 1u == (gen + 1u) * nloc) {
            __builtin_amdgcn_fence(__ATOMIC_RELEASE, "agent");
            asm volatile("s_waitcnt vmcnt(0)" ::: "memory");
            const unsigned og = xb_add(&bar[XB_TOP], 1u);
            const unsigned tg = og / nx;
            if (og + 1u == (tg + 1u) * nx) xb_add(&bar[XB_TOPGEN], 1u);
            else XB_SPIN(xb_ld(&bar[XB_TOPGEN]) == tg, bar);
            __builtin_amdgcn_fence(__ATOMIC_ACQUIRE, "agent");
            xb_add(&bar[XB_XGEN(b.x)], 1u);
            asm volatile("s_waitcnt vmcnt(0)" ::: "memory");
        } else {
            XB_SPIN(xb_ld(&bar[XB_XGEN(b.x)]) == gen, bar);
            __builtin_amdgcn_fence(__ATOMIC_ACQUIRE, "agent");
            asm volatile("s_waitcnt vmcnt(0)" ::: "memory");
        }
    }
    __syncthreads();
}

__device__ __forceinline__ int tid_opaque() { int t = threadIdx.x; asm volatile("" : "+v"(t)); return t; }
__device__ __forceinline__ float bf2f(bf16_t v) { return __uint_as_float(((unsigned)v) << 16); }
__device__ __forceinline__ bf16_t f2bf(float f) { unsigned u = __float_as_uint(f); u += 0x7FFFu + ((u >> 16) & 1u); return (bf16_t)(u >> 16); }
__device__ __forceinline__ unsigned pack2(float a, float b) { return (unsigned)f2bf(a) | ((unsigned)f2bf(b) << 16); }
__device__ __forceinline__ float lo2f(unsigned w) { return __uint_as_float(w << 16); }
__device__ __forceinline__ float hi2f(unsigned w) { return __uint_as_float(w & 0xffff0000u); }
template <int CTRL> __device__ __forceinline__ float dpp_mov(float v) { return __builtin_bit_cast(float, __builtin_amdgcn_update_dpp(0, __builtin_bit_cast(int, v), CTRL, 0xf, 0xf, true)); }
__device__ __forceinline__ float row_sum16(float v) {
    v += dpp_mov<0xB1>(v);
    v += dpp_mov<0x4E>(v);
    v += dpp_mov<0x141>(v);
    v += dpp_mov<0x140>(v);
    return v;
}
__device__ __forceinline__ float row_max16(float v) {
    v = fmaxf(v, dpp_mov<0xB1>(v)); v = fmaxf(v, dpp_mov<0x4E>(v)); v = fmaxf(v, dpp_mov<0x141>(v)); v = fmaxf(v, dpp_mov<0x140>(v));
    return v;
}
__device__ __forceinline__ float wave_sum(float v) {
    v = row_sum16(v);
    const int iv = __builtin_bit_cast(int, v);
    const float a0 = __builtin_bit_cast(float, __builtin_amdgcn_readlane(iv, 0)), a1 = __builtin_bit_cast(float, __builtin_amdgcn_readlane(iv, 16));
    const float a2 = __builtin_bit_cast(float, __builtin_amdgcn_readlane(iv, 32)), a3 = __builtin_bit_cast(float, __builtin_amdgcn_readlane(iv, 48));
    return (a0 + a1) + (a2 + a3);
}
__device__ __forceinline__ float gelu_erf(float x) { return 0.5f * x * (1.0f + erff(x * 0.70710678118654752f)); }
__device__ __forceinline__ float silu_f(float x) { return x / (1.0f + __expf(-x)); }

__device__ __forceinline__ void ln_stats(const f32x4 (&v)[4], float& mean, float& rstd) {
    float s = 0.f;
#pragma unroll
    for (int i = 0; i < 4; ++i) s += (v[i][0] + v[i][1]) + (v[i][2] + v[i][3]);
    s = wave_sum(s); mean = s * (1.0f / 1024.0f);
    float q = 0.f;
#pragma unroll
    for (int i = 0; i < 4; ++i)
#pragma unroll
        for (int e = 0; e < 4; ++e) { const float d = v[i][e] - mean; q += d * d; }
    q = wave_sum(q); rstd = 1.0f / sqrtf(q * (1.0f / 1024.0f) + 1e-6f);
}

__device__ __forceinline__ void ln_stats16(const f32x4 (&v)[16], float& mean, float& rstd) {
    float s = 0.f;
#pragma unroll
    for (int k = 0; k < 16; ++k) s += (v[k][0] + v[k][1]) + (v[k][2] + v[k][3]);
    s = row_sum16(s); mean = s * (1.0f / 1024.0f);
    float q = 0.f;
#pragma unroll
    for (int k = 0; k < 16; ++k)
#pragma unroll
        for (int e = 0; e < 4; ++e) { const float d = v[k][e] - mean; q += d * d; }
    q = row_sum16(q); rstd = 1.0f / sqrtf(q * (1.0f / 1024.0f) + 1e-6f);
}

template <int BN> struct MfmaLayout {
    static constexpr int FG = BN / 128, NI = 4, NJ = 2 * FG;
    int rbase, cbase;
    __device__ __forceinline__ int row(int i) const { return rbase + 16 * i; }
    __device__ __forceinline__ int col(int jj) const { return (jj / FG) * (BN / 2) + (jj % FG) * 16 + cbase; }
};
template <int BN> struct NaiveLayout {
    static constexpr int TX = BN / 8, TY = NT / TX, NI = 128 / TY, NJ = 2;
    int ty, tx;
    __device__ __forceinline__ int row(int i) const { return ty + TY * i; }
    __device__ __forceinline__ int col(int jj) const { return jj * (BN / 2) + 4 * tx; }
};

__device__ __forceinline__ void glds16(const bf16_t* g, LAS unsigned char* l) {
    __builtin_amdgcn_global_load_lds((const unsigned*)g, (LAS unsigned*)l, 16, 0, 0);
}

template <int BN, bool GATHER, class Epi>
__device__ __forceinline__ void gemm_tile(LAS unsigned char* lds, const bf16_t* A, int lda, const int* rowidx, int valid_rows,
                                          const bf16_t* B0, const bf16_t* B1, int ldb, int K, const Epi& epi) {
    constexpr int A_B = 16384, B_B = BN * 128, STAGE = A_B + B_B, NBL = BN / 64;
    const int tid = tid_opaque(), lane = tid & 63, wid = __builtin_amdgcn_readfirstlane(tid >> 6);
    const bf16_t* ap[2]; const bf16_t* bp[NBL];
#pragma unroll
    for (int i = 0; i < 2; ++i) {
        const int P = i * 512 + tid, row = P >> 3, c = (P & 7) ^ ((row >> 1) & 7);
        size_t ro;
        if (GATHER) ro = (size_t)(row < valid_rows ? rowidx[row] : 0) * (size_t)lda; else ro = (size_t)row * (size_t)lda;
        ap[i] = A + ro + c * 8;
    }
#pragma unroll
    for (int i = 0; i < NBL; ++i) {
        const int P = i * 512 + tid, row = P >> 3, c = (P & 7) ^ ((row >> 1) & 7);
        const bf16_t* base = (row < BN / 2) ? (B0 + (size_t)row * ldb) : (B1 + (size_t)(row - BN / 2) * ldb);
        bp[i] = base + c * 8;
    }
    const int nk = K / 64;
#define GT_STAGE(buf, k0) do { \
        _Pragma("unroll") for (int _i = 0; _i < 2; ++_i) glds16(ap[_i] + (k0), lds + (buf) * STAGE + _i * 8192 + wid * 1024); \
        _Pragma("unroll") for (int _i = 0; _i < NBL; ++_i) glds16(bp[_i] + (k0), lds + (buf) * STAGE + A_B + _i * 8192 + wid * 1024); } while (0)

#if NAIVE_GEMM
    typedef NaiveLayout<BN> Lay;
    Lay lay; lay.tx = tid % Lay::TX; lay.ty = tid / Lay::TX;
    f32x4 acc[Lay::NI][Lay::NJ];
#pragma unroll
    for (int i = 0; i < Lay::NI; ++i)
#pragma unroll
        for (int j = 0; j < Lay::NJ; ++j) acc[i][j] = (f32x4){0.f, 0.f, 0.f, 0.f};
    GT_STAGE(0, 0);
    asm volatile("s_waitcnt vmcnt(0)" ::: "memory"); __syncthreads();
    for (int kt = 0; kt < nk; ++kt) {
        if (kt + 1 < nk) GT_STAGE((kt + 1) & 1, (kt + 1) * 64);
        const LAS unsigned char* sa = lds + (kt & 1) * STAGE; const LAS unsigned char* sb = sa + A_B;
#pragma unroll 1
        for (int kc = 0; kc < 8; ++kc)
#pragma unroll 1
            for (int hh = 0; hh < 2; ++hh) {
                float a[Lay::NI][4];
#pragma unroll
                for (int i = 0; i < Lay::NI; ++i) { const int row = lay.row(i);
                    const u32x2 w = *(const LAS u32x2*)(sa + row * 128 + ((kc ^ ((row >> 1) & 7)) << 4) + hh * 8);
                    a[i][0] = lo2f(w.x); a[i][1] = hi2f(w.x); a[i][2] = lo2f(w.y); a[i][3] = hi2f(w.y); }
#pragma unroll
                for (int j = 0; j < 2; ++j)
#pragma unroll
                    for (int e = 0; e < 4; ++e) { const int row = j * (BN / 2) + 4 * lay.tx + e;
                        const u32x2 w = *(const LAS u32x2*)(sb + row * 128 + ((kc ^ ((row >> 1) & 7)) << 4) + hh * 8);
                        const float b0 = lo2f(w.x), b1 = hi2f(w.x), b2 = lo2f(w.y), b3 = hi2f(w.y);
#pragma unroll
                        for (int i = 0; i < Lay::NI; ++i) acc[i][j][e] += (a[i][0] * b0 + a[i][1] * b1) + (a[i][2] * b2 + a[i][3] * b3); }
            }
        asm volatile("s_waitcnt vmcnt(0)" ::: "memory"); __syncthreads();
    }
    epi.run(acc, lay);
#else
    typedef MfmaLayout<BN> Lay;
    constexpr int FG = Lay::FG;
    const int fr = lane & 15, g = lane >> 4, wr = wid >> 2, wc = wid & 3;
    Lay lay; lay.rbase = wr * 64 + fr; lay.cbase = wc * 16 * FG + 4 * g;
    f32x4 acc[Lay::NI][Lay::NJ];
#pragma unroll
    for (int i = 0; i < Lay::NI; ++i)
#pragma unroll
        for (int j = 0; j < Lay::NJ; ++j) acc[i][j] = (f32x4){0.f, 0.f, 0.f, 0.f};
    int aoff[4], boff[Lay::NJ];
#pragma unroll
    for (int m = 0; m < 4; ++m) { const int row = wr * 64 + m * 16 + fr; aoff[m] = row * 128 + ((g ^ ((row >> 1) & 7)) << 4); }
#pragma unroll
    for (int jj = 0; jj < Lay::NJ; ++jj) { const int row = (jj / FG) * (BN / 2) + wc * 16 * FG + (jj % FG) * 16 + fr; boff[jj] = A_B + row * 128 + ((g ^ ((row >> 1) & 7)) << 4); }
    GT_STAGE(0, 0);
    asm volatile("s_waitcnt vmcnt(0)" ::: "memory"); __syncthreads();
    for (int kt = 0; kt < nk; ++kt) {
        if (kt + 1 < nk) GT_STAGE((kt + 1) & 1, (kt + 1) * 64);
        const LAS unsigned char* sa = lds + (kt & 1) * STAGE;
#pragma unroll
        for (int ks = 0; ks < 2; ++ks) {
            bf16x8 af[4], bfv[Lay::NJ];
#pragma unroll
            for (int m = 0; m < 4; ++m) af[m] = *(const LAS bf16x8*)(sa + (aoff[m] ^ (ks << 6)));
#pragma unroll
            for (int jj = 0; jj < Lay::NJ; ++jj) bfv[jj] = *(const LAS bf16x8*)(sa + (boff[jj] ^ (ks << 6)));
#pragma unroll
            for (int m = 0; m < 4; ++m)
#pragma unroll
                for (int jj = 0; jj < Lay::NJ; ++jj) acc[m][jj] = __builtin_amdgcn_mfma_f32_16x16x32_bf16(bfv[jj], af[m], acc[m][jj], 0, 0, 0);
        }
        asm volatile("s_waitcnt vmcnt(0)" ::: "memory"); __syncthreads();
    }
    epi.run(acc, lay);
#endif
#undef GT_STAGE
}

struct EpiF32 {
    float* C; int ld;
    template <class L> __device__ __forceinline__ void run(const f32x4 (&acc)[L::NI][L::NJ], const L& lay) const {
#pragma unroll
        for (int i = 0; i < L::NI; ++i)
#pragma unroll
            for (int j = 0; j < L::NJ; ++j) *(f32x4*)(C + (size_t)lay.row(i) * ld + lay.col(j)) = acc[i][j];
    }
};
struct EpiBf16 {
    bf16_t* C; int ld;
    template <class L> __device__ __forceinline__ void run(const f32x4 (&acc)[L::NI][L::NJ], const L& lay) const {
#pragma unroll
        for (int i = 0; i < L::NI; ++i)
#pragma unroll
            for (int j = 0; j < L::NJ; ++j) { u32x2 w; w.x = pack2(acc[i][j][0], acc[i][j][1]); w.y = pack2(acc[i][j][2], acc[i][j][3]);
                *(u32x2*)(C + (size_t)lay.row(i) * ld + lay.col(j)) = w; }
    }
};
struct EpiGateUp {
    bf16_t* C; int ld;
    template <class L> __device__ __forceinline__ void run(const f32x4 (&acc)[L::NI][L::NJ], const L& lay) const {
#pragma unroll
        for (int i = 0; i < L::NI; ++i)
#pragma unroll
            for (int j = 0; j < L::NJ / 2; ++j) { const f32x4 gt = acc[i][j], up = acc[i][j + L::NJ / 2];
                u32x2 w; w.x = pack2(silu_f(gt[0]) * up[0], silu_f(gt[1]) * up[1]); w.y = pack2(silu_f(gt[2]) * up[2], silu_f(gt[3]) * up[3]);
                *(u32x2*)(C + (size_t)lay.row(i) * ld + lay.col(j)) = w; }
    }
};
struct EpiInProj {
    bf16_t* Zt;
    bf16_t* tF;
    bf16_t* tV;
    int n0, pos0, n;
    template <class L> __device__ __forceinline__ void run(const f32x4 (&acc)[L::NI][L::NJ], const L& lay) const {
#pragma unroll
        for (int i = 0; i < L::NI; ++i)
#pragma unroll
            for (int j = 0; j < L::NJ; ++j) {
                const int r = lay.row(i), cl = lay.col(j), c = n0 + cl;
                const f32x4 v = acc[i][j];
                if (c < 512) {
                    const int part = c >> 8, ch = c & 255;
#pragma unroll
                    for (int e = 0; e < 4; ++e) tF[((size_t)(ch + e) * 2 + part) * n + pos0 + r] = f2bf(v[e]);
                } else {
                    u32x2 w; w.x = pack2(v[0], v[1]); w.y = pack2(v[2], v[3]);
                    *(u32x2*)(Zt + (size_t)r * ZC + cl) = w;
                    if (c >= 896 && c < 1024) {
#pragma unroll
                        for (int e = 0; e < 4; ++e) tV[(size_t)(c - 896 + e) * n + pos0 + r] = f2bf(v[e]);
                    }
                }
            }
    }
};

constexpr int U_ADA = 192, U_WIN = 2 * 16 * 28, U_WOUT = 2 * 16 * 16, U_SGU = 32, U_DFT = 4096 + 256, U_ROPE = 1, U_EXP = 3 * 32 * 32;
constexpr int LDS_SIL = 0, LDS_RED = 20480, LDS_TILE = 32768, LDS_T64 = 49408, LDS_CTAB = 50176;

__device__ __forceinline__ void ada_unit(AP a, unsigned char* lds, int u) {
    float* sil = (float*)(lds + LDS_SIL); float* red = (float*)(lds + LDS_RED);
    const int tid = tid_opaque(), lane = tid & 63, w = tid >> 6;
    const int l = u / 96, cg = u % 96;
    for (int i = tid; i < 5120; i += NT) { const int r = i >> 10, k = i & 1023; const float v = (r < 4) ? a->in[1][r * 1024 + k] : a->in[3][k]; sil[i] = v / (1.0f + expf(-v)); }
    __syncthreads();
    const float* W = a->in[4] + (size_t)l * 1024 * 6144 + cg * 64 + lane;
    float acc[5] = {0.f, 0.f, 0.f, 0.f, 0.f};
#pragma unroll 4
    for (int k = w * 128; k < w * 128 + 128; ++k) { const float wv = W[(size_t)k * 6144];
#pragma unroll
        for (int r = 0; r < 5; ++r) acc[r] += sil[r * 1024 + k] * wv; }
#pragma unroll
    for (int r = 0; r < 5; ++r) red[(w * 5 + r) * 64 + lane] = acc[r];
    __syncthreads();
    if (tid < 320) { const int r = tid >> 6; float s = 0.f;
#pragma unroll
        for (int ww = 0; ww < 8; ++ww) s += red[(ww * 5 + r) * 64 + lane];
        const int j = cg * 64 + lane; ((float*)(a->ws + WS_MOD))[(size_t)(l * 5 + r) * 6144 + j] = s + a->in[5][l * 6144 + j]; }
    __syncthreads();
}

__device__ __forceinline__ void tile_store_T(const float* tile, bf16_t* dst, int ldd) {
    const int tid = tid_opaque(), n = tid >> 3, kc = tid & 7;
    u32x4 w;
    w.x = pack2(tile[(kc * 8 + 0) * 65 + n], tile[(kc * 8 + 1) * 65 + n]); w.y = pack2(tile[(kc * 8 + 2) * 65 + n], tile[(kc * 8 + 3) * 65 + n]);
    w.z = pack2(tile[(kc * 8 + 4) * 65 + n], tile[(kc * 8 + 5) * 65 + n]); w.w = pack2(tile[(kc * 8 + 6) * 65 + n], tile[(kc * 8 + 7) * 65 + n]);
    *(u32x4*)(dst + (size_t)n * ldd + kc * 8) = w;
}
__device__ __forceinline__ void tile_load(float* tile, const float* src, int lds_) {
    const int tid = tid_opaque();
#pragma unroll
    for (int i = 0; i < 2; ++i) { const int row = (tid >> 4) + 32 * i, c4 = (tid & 15) * 4; const f32x4 v = *(const f32x4*)(src + (size_t)row * lds_ + c4);
        tile[row * 65 + c4 + 0] = v[0]; tile[row * 65 + c4 + 1] = v[1]; tile[row * 65 + c4 + 2] = v[2]; tile[row * 65 + c4 + 3] = v[3]; }
}

__device__ __forceinline__ void win_unit(AP a, unsigned char* lds, int u) {
    float* tile = (float*)(lds + LDS_TILE); float* T = (float*)(lds + LDS_T64);
    const int tid = tid_opaque();
    const int l = u / 448, r = u % 448, kb = r / 28, nb = r % 28;
    const float* Win = a->in[6] + (size_t)l * 1024 * 1536;
    const int srccol = (nb >= 8) ? nb * 64 - 256 : (nb & 3) * 64;
    tile_load(tile, Win + (size_t)(kb * 64) * 1536 + srccol, 1536);
    if (nb < 8 && tid < 64) { T[tid] = cospif((float)tid / 32.0f); T[64 + tid] = sinpif((float)tid / 32.0f); }
    __syncthreads();
    bf16_t* dst = (bf16_t*)(a->ws + WS_WIN) + ((size_t)l * ZC + nb * 64) * 1024 + kb * 64;
    if (nb >= 8) tile_store_T(tile, dst, 1024);
    else {
        const int n = tid >> 3, kc = tid & 7, part = nb >> 2; float o[8];
#pragma unroll
        for (int e = 0; e < 8; ++e) { float s = 0.f;
#pragma unroll 4
            for (int c = 0; c < 64; ++c) s += tile[(kc * 8 + e) * 65 + c] * T[part * 64 + ((c * n) & 63)]; o[e] = (part ? -s : s) * 0.125f; }
        u32x4 w; w.x = pack2(o[0], o[1]); w.y = pack2(o[2], o[3]); w.z = pack2(o[4], o[5]); w.w = pack2(o[6], o[7]);
        *(u32x4*)(dst + (size_t)n * 1024 + kc * 8) = w;
    }
    __syncthreads();
}

__device__ __forceinline__ void wout_unit(AP a, unsigned char* lds, int u) {
    float* tile = (float*)(lds + LDS_TILE);
    const int tid = tid_opaque();
    const int l = u / 256, r = u % 256, kb = r / 16, nb = r % 16;
    const float* Wo = a->in[13] + (size_t)l * 1024 * 1024;
    const int n = tid & 63, kq = __builtin_amdgcn_readfirstlane(tid >> 6);
    if (kb < 4) {
        const float* wf = a->in[7] + (size_t)l * 256 * 256 + (size_t)(kb * 64 + kq * 8) * 256;
        float acc[8] = {0.f, 0.f, 0.f, 0.f, 0.f, 0.f, 0.f, 0.f};
#pragma unroll 2
        for (int j = 0; j < 256; ++j) { const float wv = Wo[(size_t)j * 1024 + nb * 64 + n];
#pragma unroll
            for (int e = 0; e < 8; ++e) acc[e] += wf[e * 256 + j] * wv; }
#pragma unroll
        for (int e = 0; e < 8; ++e) tile[(kq * 8 + e) * 65 + n] = acc[e];
    } else if (kb >= 8 && kb < 12) {
        const int g = kb - 8;
        const float* wp = a->in[9] + ((size_t)(l * 4 + g) * 64 + kq * 8) * 64;
        const float* ps = a->in[10] + l * 256 + g * 64;
        float acc[8] = {0.f, 0.f, 0.f, 0.f, 0.f, 0.f, 0.f, 0.f};
#pragma unroll 2
        for (int d = 0; d < 64; ++d) { const float wv = ps[d] * Wo[(size_t)(512 + g * 64 + d) * 1024 + nb * 64 + n];
#pragma unroll
            for (int e = 0; e < 8; ++e) acc[e] += wp[e * 64 + d] * wv; }
#pragma unroll
        for (int e = 0; e < 8; ++e) tile[(kq * 8 + e) * 65 + n] = acc[e];
    } else tile_load(tile, Wo + (size_t)(kb * 64) * 1024 + nb * 64, 1024);
    __syncthreads();
    tile_store_T(tile, (bf16_t*)(a->ws + WS_WOUT) + ((size_t)l * 1024 + nb * 64) * 1024 + kb * 64, 1024);
    __syncthreads();
}

__device__ __forceinline__ void exp_unit(AP a, unsigned char* lds, int l, int u) {
    float* tile = (float*)lds;
    const int tid = tid_opaque();
    __syncthreads();
    const int mat = u / 1024, e = (u % 1024) / 32, t = u % 32;
    const int kb = (mat < 2) ? t / 4 : t / 8, nb = (mat < 2) ? t % 4 : t % 8;
    const int srcld = (mat < 2) ? 512 : 1024, dstld = (mat < 2) ? 1024 : 512;
    const float* src = a->in[18 + mat] + ((size_t)(l * 32 + e) * 512 * 1024) + (size_t)(kb * 128) * srcld + nb * 128;
    bf16_t* dst = (bf16_t*)(a->ws + WS_WEXP) + (size_t)mat * EXPMAT + (size_t)e * 512 * 1024 + (size_t)(nb * 128) * dstld + kb * 128;
    f32x4 v[8];
#pragma unroll
    for (int i = 0; i < 8; ++i) v[i] = *(const f32x4*)(src + (size_t)((tid >> 5) + 16 * i) * srcld + (tid & 31) * 4);
#pragma unroll
    for (int i = 0; i < 8; ++i) { float* tp = tile + ((tid >> 5) + 16 * i) * 129 + (tid & 31) * 4; tp[0] = v[i][0]; tp[1] = v[i][1]; tp[2] = v[i][2]; tp[3] = v[i][3]; }
    __syncthreads();
    const int n = tid >> 2, kq = tid & 3;
#pragma unroll
    for (int j = 0; j < 4; ++j) { const float* tp = tile + (kq * 32 + j * 8) * 129 + n; u32x4 w;
        w.x = pack2(tp[0], tp[129]); w.y = pack2(tp[2 * 129], tp[3 * 129]); w.z = pack2(tp[4 * 129], tp[5 * 129]); w.w = pack2(tp[6 * 129], tp[7 * 129]);
        *(u32x4*)(dst + (size_t)n * dstld + kq * 32 + j * 8) = w; }
    __syncthreads();
}

__device__ __forceinline__ void p0_prologue(AP a, unsigned char* lds) {
    const int tid = tid_opaque();
    bool have_tab = false;
    constexpr int E0 = U_ADA, E1 = E0 + U_WIN, E2 = E1 + U_WOUT, E3 = E2 + U_SGU, E4 = E3 + U_DFT, E5 = E4 + U_ROPE, E6 = E5 + U_EXP;
    for (int u = blockIdx.x; u < E6; u += gridDim.x) {
        if (u < E0) ada_unit(a, lds, u);
        else if (u < E1) win_unit(a, lds, u - E0);
        else if (u < E2) wout_unit(a, lds, u - E1);
        else if (u < E3) { const size_t i0 = (size_t)(u - E2) * 4096 + tid * 8; const float* s = a->in[11] + i0; bf16_t* d = (bf16_t*)(a->ws + WS_WSGU) + i0;
            const f32x4 v0 = *(const f32x4*)s, v1 = *(const f32x4*)(s + 4); u32x4 w; w.x = pack2(v0[0], v0[1]); w.y = pack2(v0[2], v0[3]); w.z = pack2(v1[0], v1[1]); w.w = pack2(v1[2], v1[3]); *(u32x4*)d = w; }
        else if (u < E4) {
            float* ctab = (float*)(lds + LDS_CTAB);
            if (!have_tab) { for (int i = tid; i < 4096; i += NT) ctab[i] = cospif((float)i / 2048.0f); __syncthreads(); have_tab = true; }
            const int k = u - E3;
            if (k < 4096) {
                const int n0 = tid * 8; float c[8], s[8];
#pragma unroll
                for (int e = 0; e < 8; ++e) { const int idx = (k * (n0 + e)) & 4095; c[e] = ctab[idx] * (1.0f / 64.0f); s[e] = ctab[(idx - 1024) & 4095] * (1.0f / 64.0f); }
                bf16_t* d = (bf16_t*)(a->ws + WS_DFT) + (size_t)k * 8192 + n0;
                u32x4 w; w.x = pack2(c[0], c[1]); w.y = pack2(c[2], c[3]); w.z = pack2(c[4], c[5]); w.w = pack2(c[6], c[7]); *(u32x4*)d = w;
                w.x = pack2(s[0], s[1]); w.y = pack2(s[2], s[3]); w.z = pack2(s[4], s[5]); w.w = pack2(s[6], s[7]); *(u32x4*)(d + 4096) = w;
            } else if (tid < 32) {
                const int kk = k - 4096, n0 = tid * 8; float c[8], s[8];
#pragma unroll
                for (int e = 0; e < 8; ++e) { const int idx = ((kk * (n0 + e)) & 255) * 16; c[e] = ctab[idx] * (1.0f / 16.0f); s[e] = ctab[(idx - 1024) & 4095] * (1.0f / 16.0f); }
                bf16_t* d = (bf16_t*)(a->ws + WS_DFTC) + (size_t)kk * 512 + n0;
                u32x4 w; w.x = pack2(c[0], c[1]); w.y = pack2(c[2], c[3]); w.z = pack2(c[4], c[5]); w.w = pack2(c[6], c[7]); *(u32x4*)d = w;
                w.x = pack2(s[0], s[1]); w.y = pack2(s[2], s[3]); w.z = pack2(s[4], s[5]); w.w = pack2(s[6], s[7]); *(u32x4*)(d + 256) = w;
            }
        }
        else if (u < E5) {
            for (int i = tid; i < 1024; i += NT) { const int pos = i >> 4, f = i & 15; const float freq = powf(10000.0f, -(float)f / 16.0f); const float ang = (float)pos * freq;
                ((float2*)(a->ws + WS_ROPE))[i] = make_float2(cosf(ang), sinf(ang)); }
        }
        else exp_unit(a, lds, 0, u - E5);
    }
}

__device__ __forceinline__ void p_lnmod0(AP a) {
    const int tid = tid_opaque(), lane = tid & 63, w = tid >> 6;
    const float* mod = (const float*)(a->ws + WS_MOD);
    bf16_t* H = (bf16_t*)(a->ws + WS_H);
    for (int t = blockIdx.x * 8 + w; t < NTOK; t += gridDim.x * 8) {
        const float* src = (t < NLAT) ? a->in[0] + (size_t)t * D : a->in[2] + (size_t)(t - NLAT) * D;
        const float* m = mod + (size_t)((t < NLAT) ? (t >> 12) : 4) * 6144;
        f32x4 v[4];
#pragma unroll
        for (int i = 0; i < 4; ++i) v[i] = *(const f32x4*)(src + 256 * i + 4 * lane);
        float mean, rstd; ln_stats(v, mean, rstd);
#pragma unroll
        for (int i = 0; i < 4; ++i) { const int c = 256 * i + 4 * lane; const f32x4 sh = *(const f32x4*)(m + c), sc = *(const f32x4*)(m + 1024 + c);
            f32x4 o;
#pragma unroll
            for (int e = 0; e < 4; ++e) o[e] = (v[i][e] - mean) * rstd * (1.0f + sc[e]) + sh[e];
            u32x2 pk; pk.x = pack2(o[0], o[1]); pk.y = pack2(o[2], o[3]); *(u32x2*)(H + (size_t)t * D + c) = pk; }
    }
}

__device__ __forceinline__ void p1_inproj(AP a, LAS unsigned char* lds, int l) {
    const int n_lat = 128 * 7, n_ctx = (l == 0) ? 8 * 7 : 8;
    const bf16_t* H = (const bf16_t*)(a->ws + WS_H);
    const bf16_t* W = (const bf16_t*)(a->ws + WS_WIN) + (size_t)l * ZC * 1024;
    for (int u = blockIdx.x; u < n_lat + n_ctx; u += gridDim.x) {
        int row0, b, pos0, ct, n; bf16_t *tF, *tV;
        if (u < n_lat) { const int rt = u / 7; ct = u % 7; row0 = rt * 128; b = row0 >> 12; pos0 = row0 & 4095; n = 4096;
            tF = (bf16_t*)(a->ws + WS_AT) + (size_t)b * 256 * 2 * 4096; tV = (bf16_t*)(a->ws + WS_VT) + (size_t)b * 128 * 4096; }
        else { const int uu = u - n_lat; int rt; if (l == 0) { rt = uu / 7; ct = uu % 7; } else { rt = uu; ct = 3; }
            row0 = NLAT + rt * 128; b = rt >> 1; pos0 = (rt & 1) * 128; n = 256;
            tF = (bf16_t*)(a->ws + WS_ATC) + (size_t)b * 256 * 2 * 256; tV = (bf16_t*)(a->ws + WS_VTC) + (size_t)b * 128 * 256; }
        EpiInProj E; E.Zt = (bf16_t*)(a->ws + WS_Z) + (size_t)row0 * ZC + ct * 256; E.tF = tF; E.tV = tV; E.n0 = ct * 256; E.pos0 = pos0; E.n = n;
        const bf16_t* B0 = W + (size_t)(ct * 256) * 1024;
        gemm_tile<256, false, EpiInProj>(lds, H + (size_t)row0 * D, D, nullptr, 128, B0, B0 + (size_t)128 * 1024, 1024, 1024, E);
    }
}

__device__ __forceinline__ void rope32(float (&t)[32], const float2* tab) {
#pragma unroll
    for (int f = 0; f < 16; ++f) { const float2 cs = tab[f]; const float t1 = t[f], t2 = t[16 + f]; t[f] = t1 * cs.x - t2 * cs.y; t[16 + f] = t1 * cs.y + t2 * cs.x; }
}
__device__ __forceinline__ void load32(float (&t)[32], const bf16_t* p) {
#pragma unroll
    for (int q = 0; q < 4; ++q) { const u32x4 w = *(const u32x4*)(p + 8 * q);
        t[8 * q + 0] = lo2f(w.x); t[8 * q + 1] = hi2f(w.x); t[8 * q + 2] = lo2f(w.y); t[8 * q + 3] = hi2f(w.y);
        t[8 * q + 4] = lo2f(w.z); t[8 * q + 5] = hi2f(w.z); t[8 * q + 6] = lo2f(w.w); t[8 * q + 7] = hi2f(w.w); }
}

__device__ __forceinline__ float kdot(const bf16_t* kp, const bf16_t* q, const float2* tab0, const float2* tab1, bool do_rope) {
    float dot = 0.f;
#pragma unroll 1
    for (int ax = 0; ax < 2; ++ax) {
        const float2* tab = ax ? tab1 : tab0;
#pragma unroll 1
        for (int h8 = 0; h8 < 2; ++h8) {
            const u32x4 wl = *(const u32x4*)(kp + ax * 32 + h8 * 8), wh = *(const u32x4*)(kp + ax * 32 + 16 + h8 * 8);
            const float tl[8] = {lo2f(wl.x), hi2f(wl.x), lo2f(wl.y), hi2f(wl.y), lo2f(wl.z), hi2f(wl.z), lo2f(wl.w), hi2f(wl.w)};
            const float th[8] = {lo2f(wh.x), hi2f(wh.x), lo2f(wh.y), hi2f(wh.y), lo2f(wh.z), hi2f(wh.z), lo2f(wh.w), hi2f(wh.w)};
#pragma unroll
            for (int j = 0; j < 8; ++j) {
                float r1 = tl[j], r2 = th[j];
                if (do_rope) { const float2 cs = tab[h8 * 8 + j]; r1 = tl[j] * cs.x - th[j] * cs.y; r2 = tl[j] * cs.y + th[j] * cs.x; }
                dot += bf2f(q[ax * 32 + h8 * 8 + j]) * r1 + bf2f(q[ax * 32 + 16 + h8 * 8 + j]) * r2;
            }
        }
    }
    return dot;
}

__device__ __forceinline__ void mixer_tile(AP a, unsigned char* lds, int l, int row0, int seq_row0, int pos0, int n, int b, bool is_ctx) {
    const int tid = tid_opaque(), lane = tid & 63, w = tid >> 6;
    const bf16_t* Z = (const bf16_t*)(a->ws + WS_Z);
    bf16_t* CAT = (bf16_t*)(a->ws + WS_CAT);
    {
        const int c = tid & 255, half = tid >> 8, g = c >> 6, hw = 1 << g;
        for (int tl = half * 64; tl < half * 64 + 64; ++tl) {
            const int pos = pos0 + tl; const int lo = max(pos - hw, 0), hi = min(pos + hw, n);
            float s = 0.f; for (int j = lo; j < hi; ++j) s += bf2f(Z[(size_t)(seq_row0 + j) * ZC + 1024 + c]);
            const float self = bf2f(Z[(size_t)(seq_row0 + pos) * ZC + 1024 + c]);
            CAT[(size_t)(row0 + tl) * D + 512 + c] = f2bf(s / (float)(hi - lo) - self);
        }
    }
    bf16_t* vT = (bf16_t*)lds;
    for (int q = w; q < 128; q += 8) {
        const u32x2 gw = *(const u32x2*)(Z + (size_t)(row0 + q) * ZC + 1536 + 4 * lane);
        float gv[4] = {gelu_erf(lo2f(gw.x)), gelu_erf(hi2f(gw.x)), gelu_erf(lo2f(gw.y)), gelu_erf(hi2f(gw.y))};
        float s = wave_sum((gv[0] + gv[1]) + (gv[2] + gv[3])); const float mean = s * (1.0f / 256.0f);
        float qq = 0.f;
#pragma unroll
        for (int e = 0; e < 4; ++e) { const float d = gv[e] - mean; qq += d * d; }
        qq = wave_sum(qq); const float rstd = 1.0f / sqrtf(qq * (1.0f / 256.0f) + 1e-6f);
#pragma unroll
        for (int e = 0; e < 4; ++e) vT[(4 * lane + e) * 128 + q] = f2bf((gv[e] - mean) * rstd);
    }
    __syncthreads();
    {
        const int c = tid & 255, ph = tid >> 8, h = c >> 6;
        const bf16_t* Ws = (const bf16_t*)(a->ws + WS_WSGU) + (size_t)(l * 4 + h) * 128 * 128;
        const float* bs = a->in[12] + (size_t)(l * 4 + h) * 128;
        for (int p = ph * 64; p < ph * 64 + 64; ++p) {
            float s = 0.f;
#pragma unroll 2
            for (int q8 = 0; q8 < 16; ++q8) {
                const u32x4 ww = *(const u32x4*)(Ws + (size_t)p * 128 + q8 * 8);
                const u32x4 vv = *(const u32x4*)(vT + c * 128 + q8 * 8);
                s += lo2f(ww.x) * lo2f(vv.x) + hi2f(ww.x) * hi2f(vv.x) + lo2f(ww.y) * lo2f(vv.y) + hi2f(ww.y) * hi2f(vv.y)
                   + lo2f(ww.z) * lo2f(vv.z) + hi2f(ww.z) * hi2f(vv.z) + lo2f(ww.w) * lo2f(vv.w) + hi2f(ww.w) * hi2f(vv.w);
            }
            const float uv = gelu_erf(bf2f(Z[(size_t)(row0 + p) * ZC + 1280 + c]));
            CAT[(size_t)(row0 + p) * D + 768 + c] = f2bf(uv * (s + bs[p]));
        }
    }
    __syncthreads();
    {
        const int i = tid & 127, h = tid >> 7, kvh = h >> 1;
        const float2* rope = (const float2*)(a->ws + WS_ROPE);
        const int qpos = pos0 + i;
        bf16_t* q = (bf16_t*)lds + tid * 66;
        {
            float t0[32];
            load32(t0, Z + (size_t)(row0 + i) * ZC + 512 + h * 64);
            if (!is_ctx) rope32(t0, rope + (qpos >> 6) * 16);
#pragma unroll
            for (int d = 0; d < 32; ++d) q[d] = f2bf(t0[d]);
            load32(t0, Z + (size_t)(row0 + i) * ZC + 512 + h * 64 + 32);
            if (!is_ctx) rope32(t0, rope + (qpos & 63) * 16);
#pragma unroll
            for (int d = 0; d < 32; ++d) q[32 + d] = f2bf(t0[d]);
        }
#pragma unroll 1
        for (int dh = 0; dh < 2; ++dh) {
        float m = a->in[8][l * 4 + h], den = 1.0f;
        float o[32];
#pragma unroll
        for (int d = 0; d < 32; ++d) o[d] = 0.f;
        if (!is_ctx) {
            const bf16_t* VT = (const bf16_t*)(a->ws + WS_VT) + ((size_t)(b * 2 + kvh) * 64 + dh * 32) * 4096;
            const int slo = max(qpos - 128, 0), shi = min(qpos + 128, n - 1);
#pragma unroll 1
            for (int s = slo; s <= shi; ++s) {
                const float dot = 0.125f * kdot(Z + (size_t)(seq_row0 + s) * ZC + 768 + kvh * 64, q, rope + (s >> 6) * 16, rope + (s & 63) * 16, true);
                const float mn = fmaxf(m, dot), corr = __expf(m - mn), p = __expf(dot - mn);
                den = den * corr + p; m = mn;
#pragma unroll
                for (int d = 0; d < 32; ++d) o[d] = o[d] * corr + p * bf2f(VT[(size_t)d * 4096 + s]);
            }
        }
        {
            const bf16_t* VTC = (const bf16_t*)(a->ws + WS_VTC) + ((size_t)(b * 2 + kvh) * 64 + dh * 32) * 256;
#pragma unroll 1
            for (int j = 0; j < 256; ++j) {
                const float dot = 0.125f * kdot(Z + (size_t)(NLAT + b * 256 + j) * ZC + 768 + kvh * 64, q, rope, rope, false);
                const float mn = fmaxf(m, dot), corr = __expf(m - mn), p = __expf(dot - mn);
                den = den * corr + p; m = mn;
#pragma unroll
                for (int d = 0; d < 32; ++d) o[d] = o[d] * corr + p * bf2f(VTC[(size_t)d * 256 + j]);
            }
        }
        const float inv = 1.0f / den;
        bf16_t* dst = CAT + (size_t)(row0 + i) * D + 256 + h * 64 + dh * 32;
#pragma unroll
        for (int d8 = 0; d8 < 4; ++d8) { u32x4 pk; pk.x = pack2(o[8 * d8] * inv, o[8 * d8 + 1] * inv); pk.y = pack2(o[8 * d8 + 2] * inv, o[8 * d8 + 3] * inv);
            pk.z = pack2(o[8 * d8 + 4] * inv, o[8 * d8 + 5] * inv); pk.w = pack2(o[8 * d8 + 6] * inv, o[8 * d8 + 7] * inv); *(u32x4*)(dst + 8 * d8) = pk; }
        }
    }
    __syncthreads();
}

__device__ __forceinline__ u32x4 ld16g(const bf16_t* p) { return *(const u32x4*)p; }
__device__ __forceinline__ void rope_pack8(u32x4& wl, u32x4& wh, const float2* tab, bool do_rope, float scale) {
    float tl[8] = {lo2f(wl.x), hi2f(wl.x), lo2f(wl.y), hi2f(wl.y), lo2f(wl.z), hi2f(wl.z), lo2f(wl.w), hi2f(wl.w)};
    float th[8] = {lo2f(wh.x), hi2f(wh.x), lo2f(wh.y), hi2f(wh.y), lo2f(wh.z), hi2f(wh.z), lo2f(wh.w), hi2f(wh.w)};
#pragma unroll
    for (int j = 0; j < 8; ++j) {
        float r1 = tl[j], r2 = th[j];
        if (do_rope) { const float2 cs = tab[j]; r1 = tl[j] * cs.x - th[j] * cs.y; r2 = tl[j] * cs.y + th[j] * cs.x; }
        tl[j] = r1 * scale; th[j] = r2 * scale;
    }
    wl.x = pack2(tl[0], tl[1]); wl.y = pack2(tl[2], tl[3]); wl.z = pack2(tl[4], tl[5]); wl.w = pack2(tl[6], tl[7]);
    wh.x = pack2(th[0], th[1]); wh.y = pack2(th[2], th[3]); wh.z = pack2(th[4], th[5]); wh.w = pack2(th[6], th[7]);
}

__device__ __forceinline__ void mixer_tile_fast(AP a, LAS unsigned char* lds, int l, int row0, int seq_row0, int pos0, int n, int b, bool is_ctx) {
    const int tid = tid_opaque(), lane = tid & 63, w = __builtin_amdgcn_readfirstlane(tid >> 6), fr = lane & 15, g = lane >> 4;
    const bf16_t* Z = (const bf16_t*)(a->ws + WS_Z);
    bf16_t* CAT = (bf16_t*)(a->ws + WS_CAT);
    {
#pragma unroll
        for (int it = 0; it < 9; ++it) { const int id = tid + 512 * it, rr = id >> 5, ch = id & 31, j = pos0 - 8 + rr;
            u32x4 v = (u32x4){0u, 0u, 0u, 0u};
            if (j >= 0 && j < n) v = ld16g(Z + (size_t)(seq_row0 + j) * ZC + 1024 + ch * 8);
            *(LAS u32x4*)(lds + rr * 512 + ch * 16) = v; }
        __syncthreads();
        const int c = tid & 255, half = tid >> 8, hw = 1 << (c >> 6);
        const LAS bf16_t* P = (const LAS bf16_t*)lds + c;
        const int t0 = half * 64;
        float s = 0.f;
        for (int j = t0 - hw; j < t0 + hw; ++j) s += bf2f(P[(8 + j) * 256]);
        for (int tl = t0; tl < t0 + 64; ++tl) {
            const int pos = pos0 + tl; const int lo = max(pos - hw, 0), hi = min(pos + hw, n);
            CAT[(size_t)(row0 + tl) * D + 512 + c] = f2bf(s / (float)(hi - lo) - bf2f(P[(8 + tl) * 256]));
            s += bf2f(P[(8 + tl + hw) * 256]) - bf2f(P[(8 + tl - hw) * 256]);
        }
        __syncthreads();
    }
    {
        const int i16 = lane & 15;
        u32x4 gw[4][2];
#pragma unroll
        for (int ps = 0; ps < 4; ++ps) { const int q = w * 16 + ps * 4 + g; const bf16_t* src = Z + (size_t)(row0 + q) * ZC + 1536 + 16 * i16; gw[ps][0] = ld16g(src); gw[ps][1] = ld16g(src + 8); }
#pragma unroll
        for (int ps = 0; ps < 4; ++ps) {
            const int q = w * 16 + ps * 4 + g;
            float gv[16];
#pragma unroll
            for (int hh = 0; hh < 2; ++hh) { const u32x4 x = gw[ps][hh];
                gv[8 * hh + 0] = gelu_erf(lo2f(x.x)); gv[8 * hh + 1] = gelu_erf(hi2f(x.x)); gv[8 * hh + 2] = gelu_erf(lo2f(x.y)); gv[8 * hh + 3] = gelu_erf(hi2f(x.y));
                gv[8 * hh + 4] = gelu_erf(lo2f(x.z)); gv[8 * hh + 5] = gelu_erf(hi2f(x.z)); gv[8 * hh + 6] = gelu_erf(lo2f(x.w)); gv[8 * hh + 7] = gelu_erf(hi2f(x.w)); }
            float sm = 0.f;
#pragma unroll
            for (int e = 0; e < 16; ++e) sm += gv[e];
            const float mean = row_sum16(sm) * (1.0f / 256.0f);
            float qq = 0.f;
#pragma unroll
            for (int e = 0; e < 16; ++e) { const float d = gv[e] - mean; qq += d * d; }
            const float rstd = 1.0f / sqrtf(row_sum16(qq) * (1.0f / 256.0f) + 1e-6f);
#pragma unroll
            for (int e = 0; e < 16; ++e) { const int c = 16 * i16 + e; *(LAS bf16_t*)(lds + c * 256 + ((((q >> 3) ^ (c & 15))) << 4) + (q & 7) * 2) = f2bf((gv[e] - mean) * rstd); }
        }
    }
    __syncthreads();
    {
        const int h = w >> 1, ph = w & 1;
        const bf16_t* Ws = (const bf16_t*)(a->ws + WS_WSGU) + (size_t)(l * 4 + h) * 128 * 128;
        const float* bs = a->in[12] + (size_t)(l * 4 + h) * 128;
        f32x4 acc[4][4];
#pragma unroll
        for (int i = 0; i < 4; ++i)
#pragma unroll
            for (int j = 0; j < 4; ++j) acc[i][j] = (f32x4){0.f, 0.f, 0.f, 0.f};
#pragma unroll
        for (int ks = 0; ks < 4; ++ks) {
            bf16x8 af[4], bfv[4];
#pragma unroll
            for (int cf = 0; cf < 4; ++cf) { const int c = h * 64 + 16 * cf + fr; af[cf] = *(const LAS bf16x8*)(lds + c * 256 + (((4 * ks + g) ^ (c & 15)) << 4)); }
#pragma unroll
            for (int pf = 0; pf < 4; ++pf) { const int p = ph * 64 + 16 * pf + fr; bfv[pf] = *(const bf16x8*)(Ws + (size_t)p * 128 + 32 * ks + 8 * g); }
#pragma unroll
            for (int cf = 0; cf < 4; ++cf)
#pragma unroll
                for (int pf = 0; pf < 4; ++pf) acc[cf][pf] = __builtin_amdgcn_mfma_f32_16x16x32_bf16(af[cf], bfv[pf], acc[cf][pf], 0, 0, 0);
        }
#pragma unroll
        for (int pf = 0; pf < 4; ++pf) { const int p = ph * 64 + 16 * pf + fr; const float bias = bs[p];
#pragma unroll
            for (int cf = 0; cf < 4; ++cf) { const int c0 = h * 64 + 16 * cf + 4 * g;
                const u32x2 uw = *(const u32x2*)(Z + (size_t)(row0 + p) * ZC + 1280 + c0);
                u32x2 o; o.x = pack2(gelu_erf(lo2f(uw.x)) * (acc[cf][pf][0] + bias), gelu_erf(hi2f(uw.x)) * (acc[cf][pf][1] + bias));
                o.y = pack2(gelu_erf(lo2f(uw.y)) * (acc[cf][pf][2] + bias), gelu_erf(hi2f(uw.y)) * (acc[cf][pf][3] + bias));
                *(u32x2*)(CAT + (size_t)(row0 + p) * D + 768 + c0) = o; } }
    }
    const float2* rope = (const float2*)(a->ws + WS_ROPE);
    constexpr float QS = 0.125f * 1.44269504088896341f;
    constexpr int QS_OFF = 0, KS_OFF = 32768, VS_OFF = 49152;
    const int nbq = pos0 >> 7;
#pragma unroll 1
    for (int kvh = 0; kvh < 2; ++kvh) {
        __syncthreads();
#pragma unroll
        for (int it = 0; it < 2; ++it) {
            const int item = tid + 512 * it, r = item >> 2, ax = (item >> 1) & 1, h8 = item & 1, i = r & 127, qpos = pos0 + i;
            const bf16_t* src = Z + (size_t)(row0 + i) * ZC + 512 + (2 * kvh + (r >> 7)) * 64 + ax * 32 + h8 * 8;
            u32x4 wl = ld16g(src), wh = ld16g(src + 16);
            rope_pack8(wl, wh, rope + (ax ? (qpos & 63) : (qpos >> 6)) * 16 + h8 * 8, !is_ctx, QS);
            const int ch = ax * 4 + h8, sw = (r >> 1) & 7;
            *(LAS u32x4*)(lds + QS_OFF + r * 128 + ((ch ^ sw) << 4)) = wl;
            *(LAS u32x4*)(lds + QS_OFF + r * 128 + (((ch + 2) ^ sw) << 4)) = wh;
        }
        const int hh = w >> 2, qb = (w & 3) * 32, h = 2 * kvh + hh;
        float m[2], lsum[2];
        m[0] = m[1] = a->in[8][l * 4 + h] * 1.44269504088896341f;
        lsum[0] = lsum[1] = (g == 0) ? 1.0f : 0.0f;
        f32x4 O[4][2];
#pragma unroll
        for (int i = 0; i < 4; ++i) { O[i][0] = (f32x4){0.f, 0.f, 0.f, 0.f}; O[i][1] = (f32x4){0.f, 0.f, 0.f, 0.f}; }
        bf16x8 Qf[2][2];
        bool have_q = false;
#pragma unroll 1
        for (int blk = 0; blk < 5; ++blk) {
            const int jb = blk - 1;
            const bool band = blk < 3;
            if (band && (is_ctx || nbq + jb < 0 || nbq + jb >= (n >> 7))) continue;
            const int key0 = band ? (nbq + jb) * 128 : (blk - 3) * 128;
            const int krow0 = band ? seq_row0 + key0 : NLAT + b * 256 + key0;
            {
                const int r = tid >> 2, ax = (tid >> 1) & 1, h8 = tid & 1, kpos = key0 + r;
                const bf16_t* src = Z + (size_t)(krow0 + r) * ZC + 768 + kvh * 64 + ax * 32 + h8 * 8;
                u32x4 wl = ld16g(src), wh = ld16g(src + 16);
                rope_pack8(wl, wh, rope + (ax ? (kpos & 63) : (kpos >> 6)) * 16 + h8 * 8, band, 1.0f);
                const int ch = ax * 4 + h8, sw = (r >> 1) & 7;
                *(LAS u32x4*)(lds + KS_OFF + r * 128 + ((ch ^ sw) << 4)) = wl;
                *(LAS u32x4*)(lds + KS_OFF + r * 128 + (((ch + 2) ^ sw) << 4)) = wh;
            }
            {
                const bf16_t* vsrc = band ? (const bf16_t*)(a->ws + WS_VT) + (size_t)(b * 2 + kvh) * 64 * 4096 + key0 : (const bf16_t*)(a->ws + WS_VTC) + (size_t)(b * 2 + kvh) * 64 * 256 + key0;
                const int vld = band ? 4096 : 256;
#pragma unroll
                for (int i = 0; i < 2; ++i) { const int P = i * 512 + tid, d = P >> 4, c = (P & 15) ^ (d & 15);
                    glds16(vsrc + (size_t)d * vld + c * 8, lds + VS_OFF + i * 8192 + w * 1024); }
            }
            asm volatile("s_waitcnt vmcnt(0)" ::: "memory");
            __syncthreads();
            if (!have_q) {
#pragma unroll
                for (int qf = 0; qf < 2; ++qf)
#pragma unroll
                    for (int ks = 0; ks < 2; ++ks) { const int r = hh * 128 + qb + 16 * qf + fr; Qf[qf][ks] = *(const LAS bf16x8*)(lds + QS_OFF + r * 128 + (((4 * ks + g) ^ ((r >> 1) & 7)) << 4)); }
                have_q = true;
            }
            f32x4 S[8][2];
#pragma unroll
            for (int kf = 0; kf < 8; ++kf) { S[kf][0] = (f32x4){0.f, 0.f, 0.f, 0.f}; S[kf][1] = (f32x4){0.f, 0.f, 0.f, 0.f}; }
#pragma unroll
            for (int kf = 0; kf < 8; ++kf)
#pragma unroll
                for (int ks = 0; ks < 2; ++ks) { const int r = 16 * kf + fr;
                    const bf16x8 kfr = *(const LAS bf16x8*)(lds + KS_OFF + r * 128 + (((4 * ks + g) ^ ((r >> 1) & 7)) << 4));
                    S[kf][0] = __builtin_amdgcn_mfma_f32_16x16x32_bf16(kfr, Qf[0][ks], S[kf][0], 0, 0, 0);
                    S[kf][1] = __builtin_amdgcn_mfma_f32_16x16x32_bf16(kfr, Qf[1][ks], S[kf][1], 0, 0, 0); }
            bf16x8 Pp[4][2];
#pragma unroll
            for (int qf = 0; qf < 2; ++qf) {
                const int qi = qb + 16 * qf + fr;
                if (band && jb != 0) {
#pragma unroll
                    for (int kf = 0; kf < 8; ++kf)
#pragma unroll
                        for (int r = 0; r < 4; ++r) { const int kk = 16 * kf + 4 * g + r; const bool ok = (jb < 0) ? (kk >= qi) : (kk <= qi); if (!ok) S[kf][qf][r] = -1.0e30f; }
                }
                float mx = S[0][qf][0];
#pragma unroll
                for (int kf = 0; kf < 8; ++kf)
#pragma unroll
                    for (int r = 0; r < 4; ++r) mx = fmaxf(mx, S[kf][qf][r]);
                mx = fmaxf(mx, __shfl_xor(mx, 16)); mx = fmaxf(mx, __shfl_xor(mx, 32));
                const float mn = fmaxf(m[qf], mx), corr = __builtin_amdgcn_exp2f(m[qf] - mn);
                m[qf] = mn;
                float ps = 0.f;
#pragma unroll
                for (int kf = 0; kf < 8; ++kf)
#pragma unroll
                    for (int r = 0; r < 4; ++r) { const float p = __builtin_amdgcn_exp2f(S[kf][qf][r] - mn); S[kf][qf][r] = p; ps += p; }
                lsum[qf] = lsum[qf] * corr + ps;
#pragma unroll
                for (int df = 0; df < 4; ++df) O[df][qf] *= corr;
#pragma unroll
                for (int t = 0; t < 4; ++t) { u32x4 pw; pw.x = pack2(S[2 * t][qf][0], S[2 * t][qf][1]); pw.y = pack2(S[2 * t][qf][2], S[2 * t][qf][3]);
                    pw.z = pack2(S[2 * t + 1][qf][0], S[2 * t + 1][qf][1]); pw.w = pack2(S[2 * t + 1][qf][2], S[2 * t + 1][qf][3]); Pp[t][qf] = __builtin_bit_cast(bf16x8, pw); }
            }
#pragma unroll
            for (int t = 0; t < 4; ++t)
#pragma unroll
                for (int df = 0; df < 4; ++df) { const int d = 16 * df + fr;
                    const u32x2 v0 = *(const LAS u32x2*)(lds + VS_OFF + d * 256 + (((4 * t + (g >> 1)) ^ (d & 15)) << 4) + (g & 1) * 8);
                    const u32x2 v1 = *(const LAS u32x2*)(lds + VS_OFF + d * 256 + (((4 * t + 2 + (g >> 1)) ^ (d & 15)) << 4) + (g & 1) * 8);
                    u32x4 vw; vw.x = v0.x; vw.y = v0.y; vw.z = v1.x; vw.w = v1.y; const bf16x8 vf = __builtin_bit_cast(bf16x8, vw);
                    O[df][0] = __builtin_amdgcn_mfma_f32_16x16x32_bf16(vf, Pp[t][0], O[df][0], 0, 0, 0);
                    O[df][1] = __builtin_amdgcn_mfma_f32_16x16x32_bf16(vf, Pp[t][1], O[df][1], 0, 0, 0); }
            __syncthreads();
        }
#pragma unroll
        for (int qf = 0; qf < 2; ++qf) {
            float lt = lsum[qf]; lt += __shfl_xor(lt, 16); lt += __shfl_xor(lt, 32);
            const float inv = 1.0f / lt;
            bf16_t* dst = CAT + (size_t)(row0 + qb + 16 * qf + fr) * D + 256 + h * 64 + 4 * g;
#pragma unroll
            for (int df = 0; df < 4; ++df) { u32x2 o; o.x = pack2(O[df][qf][0] * inv, O[df][qf][1] * inv); o.y = pack2(O[df][qf][2] * inv, O[df][qf][3] * inv); *(u32x2*)(dst + 16 * df) = o; }
        }
    }
    __syncthreads();
}

__device__ __forceinline__ void p2_mix(AP a, unsigned char* ldsg, LAS unsigned char* lds, int l) {
    const int n_dft = 256, n_dftc = (l == 0) ? 16 : 0, n_mix = 128 + ((l == 0) ? 8 : 0);
    bf16_t* CAT = (bf16_t*)(a->ws + WS_CAT);
    for (int u = blockIdx.x; u < n_dft + n_dftc + n_mix; u += gridDim.x) {
        if (u < n_dft) {
            const int mt = u >> 3, nt = u & 7, b = nt >> 1, ch0 = (nt & 1) * 128;
            const bf16_t* A = (const bf16_t*)(a->ws + WS_DFT) + (size_t)(mt * 128) * 8192;
            const bf16_t* B0 = (const bf16_t*)(a->ws + WS_AT) + ((size_t)b * 256 + ch0) * 8192;
            EpiBf16 E; E.C = CAT + (size_t)(b * 4096 + mt * 128) * D + ch0; E.ld = D;
            gemm_tile<128, false, EpiBf16>(lds, A, 8192, nullptr, 128, B0, B0 + (size_t)64 * 8192, 8192, 8192, E);
        } else if (u < n_dft + n_dftc) {
            const int uu = u - n_dft, b = uu >> 2, mt = (uu >> 1) & 1, ch0 = (uu & 1) * 128;
            const bf16_t* A = (const bf16_t*)(a->ws + WS_DFTC) + (size_t)(mt * 128) * 512;
            const bf16_t* B0 = (const bf16_t*)(a->ws + WS_ATC) + ((size_t)b * 256 + ch0) * 512;
            EpiBf16 E; E.C = CAT + (size_t)(NLAT + b * 256 + mt * 128) * D + ch0; E.ld = D;
            gemm_tile<128, false, EpiBf16>(lds, A, 512, nullptr, 128, B0, B0 + (size_t)64 * 512, 512, 512, E);
        } else {
            const int t = u - n_dft - n_dftc;
#if NAIVE_MIXER
            if (t < 128) { const int b = t >> 5; mixer_tile(a, ldsg, l, t * 128, b * 4096, (t & 31) * 128, 4096, b, false); }
            else { const int tt = t - 128, b = tt >> 1; mixer_tile(a, ldsg, l, NLAT + tt * 128, NLAT + b * 256, (tt & 1) * 128, 256, b, true); }
#else
            const bool isc = t >= 128; const int tt = t - 128;
            const int b = isc ? (tt >> 1) : (t >> 5);
            mixer_tile_fast(a, lds, l, isc ? NLAT + tt * 128 : t * 128, isc ? NLAT + b * 256 : b * 4096, isc ? (tt & 1) * 128 : (t & 31) * 128, isc ? 256 : 4096, b, isc);
#endif
        }
    }
}

__device__ __forceinline__ void p3_outproj(AP a, LAS unsigned char* lds, int l) {
    const int nrt = (l == 0) ? NTOK / 128 : NLAT / 128;
    const bf16_t* W = (const bf16_t*)(a->ws + WS_WOUT) + (size_t)l * 1024 * 1024;
    for (int u = blockIdx.x; u < nrt * 4; u += gridDim.x) {
        const int rt = u >> 2, ct = u & 3;
        EpiF32 E; E.C = (float*)(a->ws + WS_Y) + (size_t)(rt * 128) * D + ct * 256; E.ld = D;
        const bf16_t* B0 = W + (size_t)(ct * 256) * 1024;
        gemm_tile<256, false, EpiF32>(lds, (const bf16_t*)(a->ws + WS_CAT) + (size_t)(rt * 128) * D, D, nullptr, 128, B0, B0 + (size_t)128 * 1024, 1024, 1024, E);
    }
}

__device__ __forceinline__ void p4_ln1_router(AP a, unsigned char* lds, int l) {
    const int tid = tid_opaque(), lane = tid & 63, w = tid >> 6;
    const int ntok = (l == 0) ? NTOK : NLAT;
    int* cnt = (int*)(lds + 98304);
    if (tid < 32) cnt[tid] = 0;
    __syncthreads();
    const float* mod = (const float*)(a->ws + WS_MOD) + (size_t)l * 5 * 6144;
    const float* Y = (const float*)(a->ws + WS_Y);
    float* X1 = (float*)(a->ws + WS_X1);
    bf16_t* H = (bf16_t*)(a->ws + WS_H);
    const float* g1w = a->in[14] + l * 1024; const float* b1w = a->in[15] + l * 1024;
    const float* wrg = a->in[16] + (size_t)l * 1024 * 4; const float* wre = a->in[17] + (size_t)l * 1024 * 32;
    int* tokE = (int*)(a->ws + WS_TOKE); int* tokR = (int*)(a->ws + WS_TOKR); float* tokG = (float*)(a->ws + WS_TOKG);
    const int tstep = gridDim.x * 8;
    f32x4 nx[4], ny[4];
    {   const int t = blockIdx.x * 8 + w;
        if (t < ntok) { const float* xs = (l == 0) ? ((t < NLAT) ? a->in[0] + (size_t)t * D : a->in[2] + (size_t)(t - NLAT) * D) : (const float*)(a->ws + WS_XC) + (size_t)t * D;
#pragma unroll
            for (int i = 0; i < 4; ++i) { nx[i] = *(const f32x4*)(xs + 256 * i + 4 * lane); ny[i] = *(const f32x4*)(Y + (size_t)t * D + 256 * i + 4 * lane); } } }
    for (int t = blockIdx.x * 8 + w; t < ntok; t += tstep) {
        const float* m = mod + (size_t)((t < NLAT) ? (t >> 12) : 4) * 6144;
        f32x4 v[4];
#pragma unroll
        for (int i = 0; i < 4; ++i) { const int c = 256 * i + 4 * lane; const f32x4 gv = *(const f32x4*)(m + 2048 + c);
#pragma unroll
            for (int e = 0; e < 4; ++e) v[i][e] = RES_ALPHA * nx[i][e] + gv[e] * ny[i][e]; }
        {   const int tn = t + tstep;
            if (tn < ntok) { const float* xs = (l == 0) ? ((tn < NLAT) ? a->in[0] + (size_t)tn * D : a->in[2] + (size_t)(tn - NLAT) * D) : (const float*)(a->ws + WS_XC) + (size_t)tn * D;
#pragma unroll
                for (int i = 0; i < 4; ++i) { nx[i] = *(const f32x4*)(xs + 256 * i + 4 * lane); ny[i] = *(const f32x4*)(Y + (size_t)tn * D + 256 * i + 4 * lane); } } }
        float mean, rstd; ln_stats(v, mean, rstd);
#pragma unroll
        for (int i = 0; i < 4; ++i) { const int c = 256 * i + 4 * lane; const f32x4 gg = *(const f32x4*)(g1w + c), bb = *(const f32x4*)(b1w + c);
#pragma unroll
            for (int e = 0; e < 4; ++e) v[i][e] = (v[i][e] - mean) * rstd * gg[e] + bb[e];
            *(f32x4*)(X1 + (size_t)t * D + c) = v[i]; }
        ln_stats(v, mean, rstd);
#pragma unroll
        for (int i = 0; i < 4; ++i) { const int c = 256 * i + 4 * lane; const f32x4 sh = *(const f32x4*)(m + 3072 + c), sc = *(const f32x4*)(m + 4096 + c);
#pragma unroll
            for (int e = 0; e < 4; ++e) v[i][e] = (v[i][e] - mean) * rstd * (1.0f + sc[e]) + sh[e];
            u32x2 pk; pk.x = pack2(v[i][0], v[i][1]); pk.y = pack2(v[i][2], v[i][3]); *(u32x2*)(H + (size_t)t * D + c) = pk; }
        float lg[4] = {0.f, 0.f, 0.f, 0.f};
#pragma unroll
        for (int i = 0; i < 4; ++i)
#pragma unroll
            for (int e = 0; e < 4; ++e) { const int c = 256 * i + 4 * lane + e; const f32x4 wv = *(const f32x4*)(wrg + (size_t)c * 4);
                lg[0] += v[i][e] * wv[0]; lg[1] += v[i][e] * wv[1]; lg[2] += v[i][e] * wv[2]; lg[3] += v[i][e] * wv[3]; }
#pragma unroll
        for (int q = 0; q < 4; ++q) lg[q] = wave_sum(lg[q]);
        int grp = 0; float mx = lg[0];
#pragma unroll
        for (int q = 1; q < 4; ++q) if (lg[q] > mx) { mx = lg[q]; grp = q; }
        float se = 0.f;
#pragma unroll
        for (int q = 0; q < 4; ++q) se += expf(lg[q] - mx);
        const float gate_group = 1.0f / se;
        float le[8] = {0.f, 0.f, 0.f, 0.f, 0.f, 0.f, 0.f, 0.f};
#pragma unroll
        for (int i = 0; i < 4; ++i)
#pragma unroll
            for (int e = 0; e < 4; ++e) { const int c = 256 * i + 4 * lane + e; const float* wp = wre + (size_t)c * 32 + grp * 8; const f32x4 w0 = *(const f32x4*)wp, w1 = *(const f32x4*)(wp + 4);
                le[0] += v[i][e] * w0[0]; le[1] += v[i][e] * w0[1]; le[2] += v[i][e] * w0[2]; le[3] += v[i][e] * w0[3];
                le[4] += v[i][e] * w1[0]; le[5] += v[i][e] * w1[1]; le[6] += v[i][e] * w1[2]; le[7] += v[i][e] * w1[3]; }
#pragma unroll
        for (int q = 0; q < 8; ++q) le[q] = wave_sum(le[q]);
        int j1 = 0; float l1 = le[0];
#pragma unroll
        for (int q = 1; q < 8; ++q) if (le[q] > l1) { l1 = le[q]; j1 = q; }
        int j2 = -1; float l2 = -3.0e38f;
#pragma unroll
        for (int q = 0; q < 8; ++q) if (q != j1 && le[q] > l2) { l2 = le[q]; j2 = q; }
        const float e2 = expf(l2 - l1), p1 = 1.0f / (1.0f + e2), p2 = e2 / (1.0f + e2);
        if (lane == 0) {
            const int ex0 = grp * 8 + j1, ex1 = grp * 8 + j2;
            const int r0 = atomicAdd(&cnt[ex0], 1), r1 = atomicAdd(&cnt[ex1], 1);
            tokE[2 * t] = ex0; tokE[2 * t + 1] = ex1; tokR[2 * t] = r0; tokR[2 * t + 1] = r1;
            tokG[2 * t] = gate_group * p1; tokG[2 * t + 1] = gate_group * p2;
        }
    }
    __syncthreads();
    if (tid < 32) ((int*)(a->ws + WS_BCNT))[((size_t)l * MAXG + blockIdx.x) * 32 + tid] = cnt[tid];
    __syncthreads();
}

__device__ __forceinline__ void p5_dispatch(AP a, unsigned char* lds, int l) {
    const int tid = tid_opaque();
    const int ntok = (l == 0) ? NTOK : NLAT;
    int* part = (int*)lds;
    int* tot = (int*)(lds + 4096);
    int* off = (int*)(lds + 4096 + 128);
    int* pstart = (int*)(lds + 4096 + 256);
    const int* bc = (const int*)(a->ws + WS_BCNT) + (size_t)l * MAXG * 32;
    const int G = gridDim.x, me = blockIdx.x;
    { const int e = tid & 31, p = tid >> 5; int s = 0, so = 0; for (int bb = p; bb < G; bb += 16) { const int c = bc[bb * 32 + e]; s += c; if (bb < me) so += c; } part[p * 32 + e] = s; part[512 + p * 32 + e] = so; }
    __syncthreads();
    if (tid < 32) { int s = 0, so = 0; for (int p = 0; p < 16; ++p) { s += part[p * 32 + tid]; so += part[512 + p * 32 + tid]; } tot[tid] = s; off[tid] = so; }
    __syncthreads();
    if (tid == 0) { int acc = 0; for (int e = 0; e < 32; ++e) { pstart[e] = acc; acc += ((tot[e] + 127) >> 7) << 7; } }
    __syncthreads();
    if (me == 0 && tid < 32) ((int*)(a->ws + WS_CNT))[l * 32 + tid] = tot[tid];
    const int* tokE = (const int*)(a->ws + WS_TOKE); const int* tokR = (const int*)(a->ws + WS_TOKR);
    int* tokS = (int*)(a->ws + WS_TOKS); int* slotT = (int*)(a->ws + WS_SLOTT);
    for (int base = me * 8; base < ntok; base += G * 8) {
        if (tid < 16) { const int t = base + (tid >> 1); if (t < ntok) { const int idx = 2 * t + (tid & 1); const int e = tokE[idx]; const int slot = pstart[e] + off[e] + tokR[idx]; tokS[idx] = slot; slotT[slot] = t; } }
    }
    __syncthreads();
}

__device__ __forceinline__ int moe_table(AP a, unsigned char* lds, int l, int* blk) {
    const int* tot = (const int*)(a->ws + WS_CNT) + l * 32;
    if (threadIdx.x == 0) { int acc = 0; for (int e = 0; e < 32; ++e) { blk[e] = acc; acc += (tot[e] + 127) >> 7; } blk[32] = acc; }
    __syncthreads();
    return blk[32];
}

__device__ __forceinline__ void p6_gateup(AP a, unsigned char* ldsg, LAS unsigned char* lds, int l) {
    int* blk = (int*)(ldsg + 98304 + 256);
    const int nrb = moe_table(a, ldsg, l, blk);
    const int* tot = (const int*)(a->ws + WS_CNT) + l * 32;
    const bf16_t* WG = (const bf16_t*)(a->ws + WS_WEXP); const bf16_t* WU = WG + EXPMAT;
    for (int u = blockIdx.x; u < nrb * 4; u += gridDim.x) {
        const int rb = u >> 2, ct = u & 3;
        int e = 0; for (int q = 1; q < 32; ++q) if (blk[q] <= rb) e = q;
        const int valid = min(128, tot[e] - (rb - blk[e]) * 128);
        EpiGateUp E; E.C = (bf16_t*)(a->ws + WS_HID) + (size_t)(rb * 128) * DEXP + ct * 128; E.ld = DEXP;
        gemm_tile<256, true, EpiGateUp>(lds, (const bf16_t*)(a->ws + WS_H), D, (const int*)(a->ws + WS_SLOTT) + rb * 128, valid,
                                        WG + ((size_t)e * 512 + ct * 128) * 1024, WU + ((size_t)e * 512 + ct * 128) * 1024, 1024, 1024, E);
    }
    __syncthreads();
}
__device__ __forceinline__ void p7_down(AP a, unsigned char* ldsg, LAS unsigned char* lds, int l) {
    int* blk = (int*)(ldsg + 98304 + 256);
    const int nrb = moe_table(a, ldsg, l, blk);
    const bf16_t* WD = (const bf16_t*)(a->ws + WS_WEXP) + 2 * EXPMAT;
    for (int u = blockIdx.x; u < nrb * 4; u += gridDim.x) {
        const int rb = u >> 2, ct = u & 3;
        int e = 0; for (int q = 1; q < 32; ++q) if (blk[q] <= rb) e = q;
        EpiBf16 E; E.C = (bf16_t*)(a->ws + WS_YS) + (size_t)(rb * 128) * D + ct * 256; E.ld = D;
        const bf16_t* B0 = WD + ((size_t)e * 1024 + ct * 256) * 512;
        gemm_tile<256, false, EpiBf16>(lds, (const bf16_t*)(a->ws + WS_HID) + (size_t)(rb * 128) * DEXP, DEXP, nullptr, 128, B0, B0 + (size_t)128 * 512, 512, 512, E);
    }
    __syncthreads();
}

__device__ __forceinline__ void p8_ln2(AP a, unsigned char* lds, int l) {
    const int tid = tid_opaque(), lane = tid & 63, w = tid >> 6;
    const int ntok = (l == 0) ? NTOK : NLAT;
    const float* mod = (const float*)(a->ws + WS_MOD) + (size_t)l * 5 * 6144;
    const float* modn = (const float*)(a->ws + WS_MOD) + (size_t)5 * 6144;
    const float* X1 = (const float*)(a->ws + WS_X1);
    const bf16_t* YS = (const bf16_t*)(a->ws + WS_YS);
    const int* tokS = (const int*)(a->ws + WS_TOKS); const float* tokG = (const float*)(a->ws + WS_TOKG);
    const float* g2w = a->in[21] + l * 1024; const float* b2w = a->in[22] + l * 1024;
    const int tstep = gridDim.x * 8;
    int t = blockIdx.x * 8 + w;
    int ns0 = 0, ns1 = 0; float nga = 0.f, ngb = 0.f;
    f32x4 nx[4]; u32x2 nya[4], nyb[4];
    float cga = 0.f, cgb = 0.f;
    if (t < ntok) { const int s0 = tokS[2 * t], s1 = tokS[2 * t + 1]; cga = tokG[2 * t]; cgb = tokG[2 * t + 1];
#pragma unroll
        for (int i = 0; i < 4; ++i) { const int c = 256 * i + 4 * lane; nx[i] = *(const f32x4*)(X1 + (size_t)t * D + c); nya[i] = *(const u32x2*)(YS + (size_t)s0 * D + c); nyb[i] = *(const u32x2*)(YS + (size_t)s1 * D + c); } }
    if (t + tstep < ntok) { ns0 = tokS[2 * (t + tstep)]; ns1 = tokS[2 * (t + tstep) + 1]; nga = tokG[2 * (t + tstep)]; ngb = tokG[2 * (t + tstep) + 1]; }
    for (; t < ntok; t += tstep) {
        const float* m = mod + (size_t)((t < NLAT) ? (t >> 12) : 4) * 6144;
        f32x4 v[4];
#pragma unroll
        for (int i = 0; i < 4; ++i) { const int c = 256 * i + 4 * lane; const f32x4 gv = *(const f32x4*)(m + 5120 + c);
            const u32x2 ya = nya[i], yb = nyb[i];
            const float f0 = cga * lo2f(ya.x) + cgb * lo2f(yb.x), f1 = cga * hi2f(ya.x) + cgb * hi2f(yb.x), f2 = cga * lo2f(ya.y) + cgb * lo2f(yb.y), f3 = cga * hi2f(ya.y) + cgb * hi2f(yb.y);
            v[i][0] = RES_ALPHA * nx[i][0] + gv[0] * f0; v[i][1] = RES_ALPHA * nx[i][1] + gv[1] * f1; v[i][2] = RES_ALPHA * nx[i][2] + gv[2] * f2; v[i][3] = RES_ALPHA * nx[i][3] + gv[3] * f3; }
        {   const int tn = t + tstep, tn2 = t + 2 * tstep;
            if (tn < ntok) {
#pragma unroll
                for (int i = 0; i < 4; ++i) { const int c = 256 * i + 4 * lane; nx[i] = *(const f32x4*)(X1 + (size_t)tn * D + c); nya[i] = *(const u32x2*)(YS + (size_t)ns0 * D + c); nyb[i] = *(const u32x2*)(YS + (size_t)ns1 * D + c); }
                cga = nga; cgb = ngb; }
            if (tn2 < ntok) { ns0 = tokS[2 * tn2]; ns1 = tokS[2 * tn2 + 1]; nga = tokG[2 * tn2]; ngb = tokG[2 * tn2 + 1]; } }
        float mean, rstd; ln_stats(v, mean, rstd);
        float* dst = (l == 0) ? (float*)(a->ws + WS_XC) + (size_t)t * D : a->out + (size_t)t * D;
#pragma unroll
        for (int i = 0; i < 4; ++i) { const int c = 256 * i + 4 * lane; const f32x4 gg = *(const f32x4*)(g2w + c), bb = *(const f32x4*)(b2w + c);
#pragma unroll
            for (int e = 0; e < 4; ++e) v[i][e] = (v[i][e] - mean) * rstd * gg[e] + bb[e];
            *(f32x4*)(dst + c) = v[i]; }
        if (l == 0) {
            const float* mn = modn + (size_t)((t < NLAT) ? (t >> 12) : 4) * 6144;
            ln_stats(v, mean, rstd);
            bf16_t* H = (bf16_t*)(a->ws + WS_H);
#pragma unroll
            for (int i = 0; i < 4; ++i) { const int c = 256 * i + 4 * lane; const f32x4 sh = *(const f32x4*)(mn + c), sc = *(const f32x4*)(mn + 1024 + c);
                f32x4 o;
#pragma unroll
                for (int e = 0; e < 4; ++e) o[e] = (v[i][e] - mean) * rstd * (1.0f + sc[e]) + sh[e];
                u32x2 pk; pk.x = pack2(o[0], o[1]); pk.y = pack2(o[2], o[3]); *(u32x2*)(H + (size_t)t * D + c) = pk; }
        }
    }
    if (l == 0) { __syncthreads(); for (int u = blockIdx.x; u < U_EXP; u += gridDim.x) exp_unit(a, lds, 1, u); }
}

constexpr int N_PHASES = 18;
template <int P> __device__ __forceinline__ void run_phase(AP a, unsigned char* smem, LAS unsigned char* lds, int l) {
    if (P == 0) p0_prologue(a, smem);
    if (P == 1) p_lnmod0(a);
    if (P == 2) p1_inproj(a, lds, l);
    if (P == 3) p2_mix(a, smem, lds, l);
    if (P == 4) p3_outproj(a, lds, l);
    if (P == 5) p4_ln1_router(a, smem, l);
    if (P == 6) p5_dispatch(a, smem, l);
    if (P == 7) p6_gateup(a, smem, lds, l);
    if (P == 8) p7_down(a, smem, lds, l);
    if (P == 9) p8_ln2(a, smem, l);
}
template <int P> __device__ __noinline__ void phase_fn(AP ap, int l) {
    extern __shared__ __attribute__((aligned(16))) unsigned char smem[];
    run_phase<P>(ap, smem, (LAS unsigned char*)smem, l);
}
#if N_LAUNCH_MODE == 1
__global__ void __launch_bounds__(NT, 2) fwd(Args a) {
    extern __shared__ __attribute__((aligned(16))) unsigned char smem[];
    LAS unsigned char* lds = (LAS unsigned char*)smem;
    if (threadIdx.x < 4) ((volatile LAS unsigned*)(lds + 98304 + 512))[threadIdx.x] = 0u;
    __syncthreads();
    XcdBarrier bar = xcd_barrier_post((unsigned*)(a.ws + WS_BAR), (volatile LAS unsigned*)(lds + 98304 + 512));
    AP ap = (AP)__builtin_amdgcn_kernarg_segment_ptr();
#define PROBE(P, l) do { if (PROBE_MASK & (1 << (P))) { for (int _r = 0; _r < 2; ++_r) { xcd_barrier(bar); run_phase<P>(ap, smem, lds, l); } } } while (0)
    run_phase<0>(ap, smem, lds, 0); PROBE(0, 0); xcd_barrier(bar);
    run_phase<1>(ap, smem, lds, 0); PROBE(1, 0); xcd_barrier(bar);
    for (int l = 0; l < 2; ++l) {
        run_phase<2>(ap, smem, lds, l); PROBE(2, l); xcd_barrier(bar);
        run_phase<3>(ap, smem, lds, l); PROBE(3, l); xcd_barrier(bar);
        run_phase<4>(ap, smem, lds, l); PROBE(4, l); xcd_barrier(bar);
        run_phase<5>(ap, smem, lds, l); PROBE(5, l); xcd_barrier(bar);
        run_phase<6>(ap, smem, lds, l); PROBE(6, l); xcd_barrier(bar);
        run_phase<7>(ap, smem, lds, l); PROBE(7, l); xcd_barrier(bar);
        run_phase<8>(ap, smem, lds, l); PROBE(8, l); xcd_barrier(bar);
        run_phase<9>(ap, smem, lds, l); PROBE(9, l); if (l == 0) xcd_barrier(bar);
    }
}
#else
template <int P> __global__ void __launch_bounds__(NT, 2) k_phase(Args a) {
    extern __shared__ __attribute__((aligned(16))) unsigned char smem[];
    LAS unsigned char* lds = (LAS unsigned char*)smem;
    AP ap = (AP)__builtin_amdgcn_kernarg_segment_ptr();
    run_phase<P>(ap, smem, lds, ap->ph_lo);
}
template <int P> static void launch_phase(Args a, int l, int grid, hipStream_t stream) {
    static bool attr = false;
    if (!attr) { (void)hipFuncSetAttribute((const void*)k_phase<P>, hipFuncAttributeMaxDynamicSharedMemorySize, LDS_BYTES); attr = true; }
    a.ph_lo = l; a.ph_hi = P;
    hipLaunchKernelGGL(k_phase<P>, dim3(grid), dim3(NT), LDS_BYTES, stream, a);
}
#endif

extern "C" void kernel_launch(void* const* d_in, const int* in_sizes, int n_in, void* d_out, int out_size, void* d_ws, size_t ws_size, hipStream_t stream) {
    static int grid = 0;
    if (grid == 0) {
        if (n_in != 23 || out_size != NLAT * D || ws_size < WS_END) { fprintf(stderr, "kernel_launch: unexpected shapes (n_in %d, out %d, ws %zu, need %zu)\n", n_in, out_size, ws_size, (size_t)WS_END); grid = -1; return; }
        int dev = 0, cus = 0;
        if (hipGetDevice(&dev) != hipSuccess || hipDeviceGetAttribute(&cus, hipDeviceAttributeMultiprocessorCount, dev) != hipSuccess) { grid = -1; return; }
#if N_LAUNCH_MODE == 1
        int per_cu = 0;
        if (hipFuncSetAttribute((const void*)fwd, hipFuncAttributeMaxDynamicSharedMemorySize, LDS_BYTES) != hipSuccess) { fprintf(stderr, "kernel_launch: hipFuncSetAttribute failed\n"); grid = -1; return; }
        if (hipOccupancyMaxActiveBlocksPerMultiprocessor(&per_cu, (const void*)fwd, NT, LDS_BYTES) != hipSuccess || per_cu < 1) { fprintf(stderr, "kernel_launch: occupancy query says %d\n", per_cu); }
        (void)hipGetLastError();
#endif
        grid = cus; if (grid > MAXG) grid = MAXG;
    }
    if (grid < 0) return;
    (void)hipMemsetAsync((char*)d_ws + WS_BAR, 0, 16384 + 256, stream);
    Args a{};
    for (int i = 0; i < 23; ++i) a.in[i] = (const float*)d_in[i];
    a.out = (float*)d_out; a.ws = (unsigned char*)d_ws;
#if N_LAUNCH_MODE == 1
    a.ph_lo = 0; a.ph_hi = N_PHASES;
    hipLaunchKernelGGL(fwd, dim3(grid), dim3(NT), LDS_BYTES, stream, a);
#else
    launch_phase<0>(a, 0, grid, stream);
    launch_phase<1>(a, 0, grid, stream);
    for (int l = 0; l < 2; ++l) {
        launch_phase<2>(a, l, grid, stream); launch_phase<3>(a, l, grid, stream); launch_phase<4>(a, l, grid, stream); launch_phase<5>(a, l, grid, stream);
        launch_phase<6>(a, l, grid, stream); launch_phase<7>(a, l, grid, stream); launch_phase<8>(a, l, grid, stream); launch_phase<9>(a, l, grid, stream);
    }
#endif
}
```

```cpp
#include <hip/hip_runtime.h>
#include <stdint.h>
#include <stdio.h>

#ifndef NAIVE_GEMM
#define NAIVE_GEMM 0
#endif
#ifndef NAIVE_MIXER
#define NAIVE_MIXER 0
#endif
#ifndef PROBE_MASK
#define PROBE_MASK 0
#endif
#ifndef N_LAUNCH_MODE
#define N_LAUNCH_MODE 1
#endif

#define LAS __attribute__((address_space(3)))
typedef unsigned short bf16_t;
typedef short bf16x8 __attribute__((ext_vector_type(8)));
typedef float f32x4 __attribute__((ext_vector_type(4)));
typedef unsigned u32x4 __attribute__((ext_vector_type(4)));
typedef unsigned u32x2 __attribute__((ext_vector_type(2)));

constexpr int D = 1024, NBATCH = 4, SEQ = 4096, CTXL = 256;
constexpr int NLAT = NBATCH * SEQ, NCTX = NBATCH * CTXL, NTOK = NLAT + NCTX;
constexpr int ZC = 1792;
constexpr int NEXP = 32, DEXP = 512;
constexpr int NSLOT = 2 * NTOK + NEXP * 256;
constexpr int NT = 512;
constexpr int MAXG = 512;
constexpr float RES_ALPHA = 1.41421356237309515f;
constexpr int MISC_OFF = 155648;
constexpr int RIDX_OFF = 131072;
constexpr int LDS_BYTES = MISC_OFF + 1024;

constexpr size_t WS_BAR   = 0;
constexpr size_t WS_CNT   = 16384;
constexpr size_t WS_BCNT  = WS_CNT + 256;
constexpr size_t WS_MOD   = WS_BCNT + (size_t)2 * MAXG * 32 * 4;
constexpr size_t WS_ROPE  = WS_MOD + (size_t)2 * 5 * 6144 * 4;
constexpr size_t WS_TOKE  = WS_ROPE + 8192;
constexpr size_t WS_TOKR  = WS_TOKE + (size_t)NTOK * 8;
constexpr size_t WS_TOKS  = WS_TOKR + (size_t)NTOK * 8;
constexpr size_t WS_TOKG  = WS_TOKS + (size_t)NTOK * 8;
constexpr size_t WS_SLOTT = WS_TOKG + (size_t)NTOK * 8;
constexpr size_t WS_WIN   = WS_SLOTT + (size_t)NSLOT * 4;
constexpr size_t WS_WOUT  = WS_WIN + (size_t)2 * ZC * 1024 * 2;
constexpr size_t WS_WSGU  = WS_WOUT + (size_t)2 * 1024 * 1024 * 2;
constexpr size_t WS_DFT   = WS_WSGU + (size_t)2 * 4 * 128 * 128 * 2;
constexpr size_t WS_DFTC  = WS_DFT + (size_t)4096 * 8192 * 2;
constexpr size_t WS_WEXP  = WS_DFTC + (size_t)256 * 512 * 2;
constexpr size_t EXPMAT   = (size_t)NEXP * 512 * 1024;
constexpr size_t WS_X1    = WS_WEXP + 3 * EXPMAT * 2;
constexpr size_t WS_XC    = WS_X1 + (size_t)NTOK * D * 4;
constexpr size_t WS_H     = WS_XC + (size_t)NTOK * D * 4;
constexpr size_t WS_R     = WS_H + (size_t)NTOK * D * 2;
constexpr size_t WS_Z     = WS_R;
constexpr size_t WS_AT    = WS_Z + (size_t)NTOK * ZC * 2;
constexpr size_t WS_ATC   = WS_AT + (size_t)4 * 256 * 8192 * 2;
constexpr size_t WS_VT    = WS_ATC + (size_t)4 * 256 * 512 * 2;
constexpr size_t WS_VTC   = WS_VT + (size_t)4 * 2 * 64 * 4096 * 2;
constexpr size_t WS_CAT   = WS_VTC + (size_t)4 * 2 * 64 * 256 * 2;
constexpr size_t WS_REND  = WS_CAT + (size_t)NTOK * D * 2;
constexpr size_t WS_Y     = WS_R;
constexpr size_t WS_HID   = WS_R;
constexpr size_t WS_YS    = WS_HID + (size_t)NSLOT * DEXP * 2;
constexpr size_t WS_END   = (WS_YS + (size_t)NSLOT * D * 2 > WS_REND) ? WS_YS + (size_t)NSLOT * D * 2 : WS_REND;
static_assert(WS_Y + (size_t)NTOK * D * 4 <= WS_CAT, "Y must not reach CAT");
static_assert(WS_WIN % 256 == 0 && WS_DFT % 256 == 0 && WS_WEXP % 256 == 0 && WS_X1 % 256 == 0 && WS_H % 256 == 0 && WS_R % 256 == 0 && WS_AT % 256 == 0 && WS_CAT % 256 == 0 && WS_YS % 256 == 0, "alignment");

struct Args { const float* in[23]; float* out; unsigned char* ws; int ph_lo, ph_hi; };
#define CAS __attribute__((address_space(4)))
typedef const CAS Args* AP;

#define XB_TMO      128
#define XB_XCNT(j)  (256  + 64 * (j))
#define XB_XSUB(j)  (1280 + 64 * (j))
#define XB_XGEN(j)  (2304 + 64 * (j))
#define XB_TOP      3328
#define XB_TOPGEN   3392
#define XCD_BAR_WORDS 3456
#define XB_SPIN_CAP (1u << 18)

__device__ __forceinline__ unsigned xb_ld(unsigned* p)              { return __hip_atomic_load(p, __ATOMIC_RELAXED, __HIP_MEMORY_SCOPE_AGENT); }
__device__ __forceinline__ unsigned xb_add(unsigned* p, unsigned v) { return __hip_atomic_fetch_add(p, v, __ATOMIC_RELAXED, __HIP_MEMORY_SCOPE_AGENT); }
__device__ __forceinline__ unsigned xb_xcc_id() { return (unsigned)__builtin_amdgcn_s_getreg((3 << 11) | 20) & 0xFu; }
#define XB_SPIN(cond, bar) do { unsigned _sp = 0; while (cond) { __builtin_amdgcn_s_sleep(1); \
    if ((++_sp & 255u) == 0u) { if (xb_ld(&(bar)[XB_TMO])) break; if (_sp > XB_SPIN_CAP) { atomicAdd(&(bar)[XB_TMO], 1u); break; } } } } while (0)

struct XcdBarrier { unsigned* bar; unsigned x; volatile LAS unsigned* st; };

__device__ __forceinline__ XcdBarrier xcd_barrier_post(unsigned* bar, volatile LAS unsigned* st) {
    XcdBarrier b; b.bar = bar; b.x = (unsigned)__builtin_amdgcn_readfirstlane((int)xb_xcc_id()); b.st = st;
    if (threadIdx.x == 0) (void)xb_add(&bar[XB_XCNT(b.x)], 1u);
    return b;
}
__device__ __forceinline__ void xcd_barrier_complete(unsigned* bar, unsigned x, unsigned& nloc, unsigned& nx) {
    const unsigned G = gridDim.x * gridDim.y * gridDim.z;
    unsigned sum, cnt, mine, sp = 0u;
    for (;;) {
        sum = 0u; cnt = 0u; mine = 0u;
#pragma unroll
        for (unsigned j = 0; j < 16; ++j) { const unsigned c = xb_ld(&bar[XB_XCNT(j)]); sum += c; cnt += (c > 0u) ? 1u : 0u; mine = (j == x) ? c : mine; }
        if (sum == G) break;
        __builtin_amdgcn_s_sleep(1);
        if ((++sp & 255u) == 0u) { if (xb_ld(&bar[XB_TMO])) break; if (sp > XB_SPIN_CAP) { atomicAdd(&bar[XB_TMO], 1u); break; } }
    }
    nloc = mine > 0u ? mine : 1u; nx = cnt > 0u ? cnt : 1u;
}
__device__ __forceinline__ void xcd_barrier(const XcdBarrier& b) {
    asm volatile("s_waitcnt vmcnt(0)" ::: "memory");
    __syncthreads();
    if (threadIdx.x == 0) {
        unsigned* bar = b.bar;
        asm volatile("" : "+s"(bar));
        __builtin_amdgcn_s_waitcnt(0);
        unsigned nloc = b.st[0], nx = b.st[1];
        if (nloc == 0u) { xcd_barrier_complete(bar, b.x, nloc, nx); b.st[0] = nloc; b.st[1] = nx; }
        const unsigned old = xb_add(&bar[XB_XSUB(b.x)], 1u);
        const unsigned gen = old / nloc;
        if (old + 1u == (gen + 1u) * nloc) {
            __builtin_amdgcn_fence(__ATOMIC_RELEASE, "agent");
            asm volatile("s_waitcnt vmcnt(0)" ::: "memory");
            const unsigned og = xb_add(&bar[XB_TOP], 1u);
            const unsigned tg = og / nx;
            if (og + 1u == (tg + 1u) * nx) xb_add(&bar[XB_TOPGEN], 1u);
            else XB_SPIN(xb_ld(&bar[XB_TOPGEN]) == tg, bar);
            __builtin_amdgcn_fence(__ATOMIC_ACQUIRE, "agent");
            xb_add(&bar[XB_XGEN(b.x)], 1u);
            asm volatile("s_waitcnt vmcnt(0)" ::: "memory");
        } else {
            XB_SPIN(xb_ld(&bar[XB_XGEN(b.x)]) == gen, bar);
            __builtin_amdgcn_fence(__ATOMIC_ACQUIRE, "agent");
            asm volatile("s_waitcnt vmcnt(0)" ::: "memory");
        }
    }
    __syncthreads();
}

__device__ __forceinline__ int tid_opaque() { int t = threadIdx.x; asm volatile("" : "+v"(t)); return t; }
__device__ __forceinline__ float bf2f(bf16_t v) { return __uint_as_float(((unsigned)v) << 16); }
__device__ __forceinline__ bf16_t f2bf(float f) { unsigned u = __float_as_uint(f); u += 0x7FFFu + ((u >> 16) & 1u); return (bf16_t)(u >> 16); }
__device__ __forceinline__ unsigned pack2(float a, float b) { return (unsigned)f2bf(a) | ((unsigned)f2bf(b) << 16); }
__device__ __forceinline__ float lo2f(unsigned w) { return __uint_as_float(w << 16); }
__device__ __forceinline__ float hi2f(unsigned w) { return __uint_as_float(w & 0xffff0000u); }
template <int CTRL> __device__ __forceinline__ float dpp_mov(float v) { return __builtin_bit_cast(float, __builtin_amdgcn_update_dpp(0, __builtin_bit_cast(int, v), CTRL, 0xf, 0xf, true)); }
__device__ __forceinline__ float row_sum16(float v) {
    v += dpp_mov<0xB1>(v);
    v += dpp_mov<0x4E>(v);
    v += dpp_mov<0x141>(v);
    v += dpp_mov<0x140>(v);
    return v;
}
__device__ __forceinline__ float row_max16(float v) {
    v = fmaxf(v, dpp_mov<0xB1>(v)); v = fmaxf(v, dpp_mov<0x4E>(v)); v = fmaxf(v, dpp_mov<0x141>(v)); v = fmaxf(v, dpp_mov<0x140>(v));
    return v;
}
__device__ __forceinline__ float wave_sum(float v) {
    v = row_sum16(v);
    const int iv = __builtin_bit_cast(int, v);
    const float a0 = __builtin_bit_cast(float, __builtin_amdgcn_readlane(iv, 0)), a1 = __builtin_bit_cast(float, __builtin_amdgcn_readlane(iv, 16));
    const float a2 = __builtin_bit_cast(float, __builtin_amdgcn_readlane(iv, 32)), a3 = __builtin_bit_cast(float, __builtin_amdgcn_readlane(iv, 48));
    return (a0 + a1) + (a2 + a3);
}
__device__ __forceinline__ float gelu_erf(float x) { return 0.5f * x * (1.0f + erff(x * 0.70710678118654752f)); }
__device__ __forceinline__ float silu_f(float x) { return x / (1.0f + __expf(-x)); }

__device__ __forceinline__ void ln_stats(const f32x4 (&v)[4], float& mean, float& rstd) {
    float s = 0.f;
#pragma unroll
    for (int i = 0; i < 4; ++i) s += (v[i][0] + v[i][1]) + (v[i][2] + v[i][3]);
    s = wave_sum(s); mean = s * (1.0f / 1024.0f);
    float q = 0.f;
#pragma unroll
    for (int i = 0; i < 4; ++i)
#pragma unroll
        for (int e = 0; e < 4; ++e) { const float d = v[i][e] - mean; q += d * d; }
    q = wave_sum(q); rstd = 1.0f / sqrtf(q * (1.0f / 1024.0f) + 1e-6f);
}

__device__ __forceinline__ void ln_stats16(const f32x4 (&v)[16], float& mean, float& rstd) {
    float s = 0.f;
#pragma unroll
    for (int k = 0; k < 16; ++k) s += (v[k][0] + v[k][1]) + (v[k][2] + v[k][3]);
    s = row_sum16(s); mean = s * (1.0f / 1024.0f);
    float q = 0.f;
#pragma unroll
    for (int k = 0; k < 16; ++k)
#pragma unroll
        for (int e = 0; e < 4; ++e) { const float d = v[k][e] - mean; q += d * d; }
    q = row_sum16(q); rstd = 1.0f / sqrtf(q * (1.0f / 1024.0f) + 1e-6f);
}

template <int BN> struct MfmaLayout {
    static constexpr int FG = BN / 128, NI = 4, NJ = 2 * FG;
    int rbase, cbase;
    __device__ __forceinline__ int row(int i) const { return rbase + 16 * i; }
    __device__ __forceinline__ int col(int jj) const { return (jj / FG) * (BN / 2) + (jj % FG) * 16 + cbase; }
};
template <int BN> struct NaiveLayout {
    static constexpr int TX = BN / 8, TY = NT / TX, NI = 128 / TY, NJ = 2;
    int ty, tx;
    __device__ __forceinline__ int row(int i) const { return ty + TY * i; }
    __device__ __forceinline__ int col(int jj) const { return jj * (BN / 2) + 4 * tx; }
};

__device__ __forceinline__ void glds16(const bf16_t* g, LAS unsigned char* l) {
    __builtin_amdgcn_global_load_lds((const unsigned*)g, (LAS unsigned*)l, 16, 0, 0);
}

template <int BN, bool GATHER, class Epi>
__device__ __forceinline__ void gemm_tile(LAS unsigned char* lds, const bf16_t* A, int lda, const int* rowidx, int valid_rows,
                                          const bf16_t* B0, const bf16_t* B1, int ldb, int K, const Epi& epi) {
    constexpr int A_B = 16384, B_B = BN * 128, STAGE = A_B + B_B, NBL = BN / 64;
    const int tid = tid_opaque(), lane = tid & 63, wid = __builtin_amdgcn_readfirstlane(tid >> 6);
    const bf16_t* ap[2]; const bf16_t* bp[NBL];
#pragma unroll
    for (int i = 0; i < 2; ++i) {
        const int P = i * 512 + tid, row = P >> 3, c = (P & 7) ^ ((row >> 1) & 7);
        size_t ro;
        if (GATHER) ro = (size_t)(row < valid_rows ? rowidx[row] : 0) * (size_t)lda; else ro = (size_t)row * (size_t)lda;
        ap[i] = A + ro + c * 8;
    }
#pragma unroll
    for (int i = 0; i < NBL; ++i) {
        const int P = i * 512 + tid, row = P >> 3, c = (P & 7) ^ ((row >> 1) & 7);
        const bf16_t* base = (row < BN / 2) ? (B0 + (size_t)row * ldb) : (B1 + (size_t)(row - BN / 2) * ldb);
        bp[i] = base + c * 8;
    }
    const int nk = K / 64;
#define GT_STAGE(buf, k0) do { \
        _Pragma("unroll") for (int _i = 0; _i < 2; ++_i) glds16(ap[_i] + (k0), lds + (buf) * STAGE + _i * 8192 + wid * 1024); \
        _Pragma("unroll") for (int _i = 0; _i < NBL; ++_i) glds16(bp[_i] + (k0), lds + (buf) * STAGE + A_B + _i * 8192 + wid * 1024); } while (0)

#if NAIVE_GEMM
    typedef NaiveLayout<BN> Lay;
    Lay lay; lay.tx = tid % Lay::TX; lay.ty = tid / Lay::TX;
    f32x4 acc[Lay::NI][Lay::NJ];
#pragma unroll
    for (int i = 0; i < Lay::NI; ++i)
#pragma unroll
        for (int j = 0; j < Lay::NJ; ++j) acc[i][j] = (f32x4){0.f, 0.f, 0.f, 0.f};
    GT_STAGE(0, 0);
    asm volatile("s_waitcnt vmcnt(0)" ::: "memory"); __syncthreads();
    for (int kt = 0; kt < nk; ++kt) {
        if (kt + 1 < nk) GT_STAGE((kt + 1) & 1, (kt + 1) * 64);
        const LAS unsigned char* sa = lds + (kt & 1) * STAGE; const LAS unsigned char* sb = sa + A_B;
#pragma unroll 1
        for (int kc = 0; kc < 8; ++kc)
#pragma unroll 1
            for (int hh = 0; hh < 2; ++hh) {
                float a[Lay::NI][4];
#pragma unroll
                for (int i = 0; i < Lay::NI; ++i) { const int row = lay.row(i);
                    const u32x2 w = *(const LAS u32x2*)(sa + row * 128 + ((kc ^ ((row >> 1) & 7)) << 4) + hh * 8);
                    a[i][0] = lo2f(w.x); a[i][1] = hi2f(w.x); a[i][2] = lo2f(w.y); a[i][3] = hi2f(w.y); }
#pragma unroll
                for (int j = 0; j < 2; ++j)
#pragma unroll
                    for (int e = 0; e < 4; ++e) { const int row = j * (BN / 2) + 4 * lay.tx + e;
                        const u32x2 w = *(const LAS u32x2*)(sb + row * 128 + ((kc ^ ((row >> 1) & 7)) << 4) + hh * 8);
                        const float b0 = lo2f(w.x), b1 = hi2f(w.x), b2 = lo2f(w.y), b3 = hi2f(w.y);
#pragma unroll
                        for (int i = 0; i < Lay::NI; ++i) acc[i][j][e] += (a[i][0] * b0 + a[i][1] * b1) + (a[i][2] * b2 + a[i][3] * b3); }
            }
        asm volatile("s_waitcnt vmcnt(0)" ::: "memory"); __syncthreads();
    }
    epi.run(acc, lay);
#else
    typedef MfmaLayout<BN> Lay;
    constexpr int FG = Lay::FG;
    const int fr = lane & 15, g = lane >> 4, wr = wid >> 2, wc = wid & 3;
    Lay lay; lay.rbase = wr * 64 + fr; lay.cbase = wc * 16 * FG + 4 * g;
    f32x4 acc[Lay::NI][Lay::NJ];
#pragma unroll
    for (int i = 0; i < Lay::NI; ++i)
#pragma unroll
        for (int j = 0; j < Lay::NJ; ++j) acc[i][j] = (f32x4){0.f, 0.f, 0.f, 0.f};
    int aoff[4], boff[Lay::NJ];
#pragma unroll
    for (int m = 0; m < 4; ++m) { const int row = wr * 64 + m * 16 + fr; aoff[m] = row * 128 + ((g ^ ((row >> 1) & 7)) << 4); }
#pragma unroll
    for (int jj = 0; jj < Lay::NJ; ++jj) { const int row = (jj / FG) * (BN / 2) + wc * 16 * FG + (jj % FG) * 16 + fr; boff[jj] = A_B + row * 128 + ((g ^ ((row >> 1) & 7)) << 4); }
    GT_STAGE(0, 0);
    asm volatile("s_waitcnt vmcnt(0)" ::: "memory"); __syncthreads();
    for (int kt = 0; kt < nk; ++kt) {
        if (kt + 1 < nk) GT_STAGE((kt + 1) & 1, (kt + 1) * 64);
        const LAS unsigned char* sa = lds + (kt & 1) * STAGE;
#pragma unroll
        for (int ks = 0; ks < 2; ++ks) {
            bf16x8 af[4], bfv[Lay::NJ];
#pragma unroll
            for (int m = 0; m < 4; ++m) af[m] = *(const LAS bf16x8*)(sa + (aoff[m] ^ (ks << 6)));
#pragma unroll
            for (int jj = 0; jj < Lay::NJ; ++jj) bfv[jj] = *(const LAS bf16x8*)(sa + (boff[jj] ^ (ks << 6)));
#pragma unroll
            for (int m = 0; m < 4; ++m)
#pragma unroll
                for (int jj = 0; jj < Lay::NJ; ++jj) acc[m][jj] = __builtin_amdgcn_mfma_f32_16x16x32_bf16(bfv[jj], af[m], acc[m][jj], 0, 0, 0);
        }
        asm volatile("s_waitcnt vmcnt(0)" ::: "memory"); __syncthreads();
    }
    epi.run(acc, lay);
#endif
#undef GT_STAGE
}

namespace g256 {
constexpr int BK = 64, HALF = 128, HTB = HALF * BK * 2, STAGE_BYTES = 8 * HTB;
__device__ __forceinline__ int lds_byte(int r, int c) { const int st = (r >> 4) * 2 + (c >> 5), rr = r & 15, cc = c & 31, ob = rr * 64 + cc * 2; return st * 1024 + (ob ^ (((ob >> 9) & 1) << 5)); }
__device__ __forceinline__ void stage_rc(int b, int& R, int& C) { const int st = b / 1024, sb = b % 1024, swz = sb ^ (((sb >> 9) & 1) << 5); R = (st >> 1) * 16 + swz / 64; C = (st & 1) * 32 + (swz % 64) / 2; }
struct Lay {
    static constexpr int NI = 8, NJ = 4;
    int rbase, cbase;
    __device__ __forceinline__ int row(int i) const { return (i >> 2) * 128 + (i & 3) * 16 + rbase; }
    __device__ __forceinline__ int col(int j) const { return (j >> 1) * 128 + (j & 1) * 16 + cbase; }
};
template <class Epi> struct Unit { const bf16_t* A; const bf16_t* B0; const bf16_t* B1; const LAS int* ridx; int valid; Epi epi; };

template <class Sched>
__device__ __forceinline__ void gemm_phase(LAS unsigned char* lds, const int K, const Sched& S) {
    typedef typename Sched::Epi Epi;
    const int tid = tid_opaque(), wid = __builtin_amdgcn_readfirstlane(tid >> 6), lane = tid & 63, wr = wid >> 2, wc = wid & 3, fr = lane & 15, fq = lane >> 4;
    const int nt = K / BK;
    int sR[2], sC[2];
#pragma unroll
    for (int i = 0; i < 2; ++i) stage_rc(tid * 16 + i * 8192, sR[i], sC[i]);
    unsigned voffB[2];
#pragma unroll
    for (int i = 0; i < 2; ++i) voffB[i] = (unsigned)(sR[i] * K + sC[i]) * 2u;
    const size_t kstep = (size_t)(BK * 2);
    const unsigned ldsw = (unsigned)wid * 1024u;
    const int aoff = lds_byte(wr * 64 + fr, fq * 8), boff = lds_byte(wc * 32 + fr, fq * 8);
#define G2_SA(b, h) (((b) * 2 + (h)) * HTB)
#define G2_SB(b, h) ((4 + (b) * 2 + (h)) * HTB)
#define G2_STAGE(bufoff, gbase, v0, v1) do { \
        __builtin_amdgcn_global_load_lds((const unsigned*)((const char*)(gbase) + (v0)), (LAS unsigned*)(lds + (bufoff) + ldsw), 16, 0, 0); \
        __builtin_amdgcn_global_load_lds((const unsigned*)((const char*)(gbase) + (v1)), (LAS unsigned*)(lds + (bufoff) + ldsw + 8192), 16, 0, 0); } while (0)
#define G2_LDA(dst, b, h) do { _Pragma("unroll") for (int m = 0; m < 4; ++m) _Pragma("unroll") for (int k = 0; k < 2; ++k) dst[m][k] = *(const LAS bf16x8*)(lds + G2_SA(b, h) + aoff + m * 2048 + k * 1024); } while (0)
#define G2_LDB(dst, b, h) do { _Pragma("unroll") for (int n = 0; n < 2; ++n) _Pragma("unroll") for (int k = 0; k < 2; ++k) dst[n][k] = *(const LAS bf16x8*)(lds + G2_SB(b, h) + boff + n * 2048 + k * 1024); } while (0)
#define G2_MMA(ai, bj, At, Bt) do { __builtin_amdgcn_s_setprio(1); _Pragma("unroll") for (int m = 0; m < 4; ++m) _Pragma("unroll") for (int n = 0; n < 2; ++n) _Pragma("unroll") for (int k = 0; k < 2; ++k) \
        acc[(ai) * 4 + m][(bj) * 2 + n] = __builtin_amdgcn_mfma_f32_16x16x32_bf16(Bt[n][k], At[m][k], acc[(ai) * 4 + m][(bj) * 2 + n], 0, 0, 0); __builtin_amdgcn_s_setprio(0); } while (0)
#define G2_WAIT_V(n) asm volatile("s_waitcnt vmcnt(" #n ")" ::: "memory")
#define G2_WAIT_L(n) asm volatile("s_waitcnt lgkmcnt(" #n ")" ::: "memory")
#define G2_BAR __builtin_amdgcn_s_barrier()
#define G2_SCHED __builtin_amdgcn_sched_barrier(0)
#define G2_VOFFA(U, dst) do { _Pragma("unroll") for (int _h = 0; _h < 2; ++_h) _Pragma("unroll") for (int _i = 0; _i < 2; ++_i) { const int _row = _h * 128 + sR[_i]; \
        int _tok = _row; if (Sched::GATHER) _tok = (_row < (U).valid) ? (U).ridx[_row] : 0; dst[_h][_i] = (unsigned)(_tok * K + sC[_i]) * 2u; } } while (0)
    Unit<Epi> cur, nxt; int ui = 0;
    if (!S.get(0, cur)) return;
    f32x4 acc[8][4];
#pragma unroll
    for (int i = 0; i < 8; ++i)
#pragma unroll
        for (int j = 0; j < 4; ++j) acc[i][j] = (f32x4){0.f, 0.f, 0.f, 0.f};
    bf16x8 At[4][2], B0[2][2], B1[2][2];
    unsigned cvA[2][2], nvA[2][2];
    G2_VOFFA(cur, cvA);
    const char* cA = (const char*)cur.A; const char* cB0 = (const char*)cur.B0; const char* cB1 = (const char*)cur.B1;
    G2_STAGE(G2_SB(0, 0), cB0, voffB[0], voffB[1]); G2_STAGE(G2_SA(0, 0), cA, cvA[0][0], cvA[0][1]); G2_STAGE(G2_SB(0, 1), cB1, voffB[0], voffB[1]); G2_STAGE(G2_SA(0, 1), cA, cvA[1][0], cvA[1][1]);
    if (wr == 1) G2_BAR;
    G2_WAIT_V(4); G2_BAR;
    G2_STAGE(G2_SB(1, 0), cB0 + kstep, voffB[0], voffB[1]); G2_STAGE(G2_SA(1, 0), cA + kstep, cvA[0][0], cvA[0][1]); G2_STAGE(G2_SB(1, 1), cB1 + kstep, voffB[0], voffB[1]);
    G2_WAIT_V(6); G2_BAR;
    for (;;) {
        const bool has_next = S.get(ui + 1, nxt);
        if (Sched::GATHER) {
            if (has_next) { G2_VOFFA(nxt, nvA); }
            else {
#pragma unroll
                for (int h = 0; h < 2; ++h) { nvA[h][0] = cvA[h][0]; nvA[h][1] = cvA[h][1]; } }
        }
        const char* nA = has_next ? (const char*)nxt.A : cA; const char* nB0 = has_next ? (const char*)nxt.B0 : cB0; const char* nB1 = has_next ? (const char*)nxt.B1 : cB1;
        for (int t = 0; t < nt; t += 2) {
            const bool last = (t == nt - 2);
            const char* a1 = cA + (size_t)(t + 1) * kstep;
            const char* a2 = last ? nA : cA + (size_t)(t + 2) * kstep;
            const char* b20 = last ? nB0 : cB0 + (size_t)(t + 2) * kstep; const char* b21 = last ? nB1 : cB1 + (size_t)(t + 2) * kstep;
#define x00 ((Sched::GATHER && last) ? nvA[0][0] : cvA[0][0])
#define x01 ((Sched::GATHER && last) ? nvA[0][1] : cvA[0][1])
#define x10 ((Sched::GATHER && last) ? nvA[1][0] : cvA[1][0])
#define x11 ((Sched::GATHER && last) ? nvA[1][1] : cvA[1][1])
            G2_LDB(B0, 0, 0); G2_SCHED; G2_LDA(At, 0, 0); G2_STAGE(G2_SA(1, 1), a1, cvA[1][0], cvA[1][1]);
            G2_WAIT_L(8); G2_BAR; G2_WAIT_L(0); G2_MMA(0, 0, At, B0); G2_BAR; G2_SCHED;
            G2_LDB(B1, 0, 1); G2_STAGE(G2_SB(0, 0), b20, voffB[0], voffB[1]);
            G2_BAR; G2_WAIT_L(0); G2_MMA(0, 1, At, B1); G2_BAR;
            G2_LDA(At, 0, 1); G2_STAGE(G2_SA(0, 0), a2, x00, x01);
            G2_BAR; G2_WAIT_L(0); G2_MMA(1, 0, At, B0); G2_BAR; G2_SCHED;
            G2_STAGE(G2_SB(0, 1), b21, voffB[0], voffB[1]);
            G2_WAIT_V(6); G2_BAR; G2_MMA(1, 1, At, B1); G2_BAR;
            G2_LDB(B0, 1, 0); G2_SCHED; G2_LDA(At, 1, 0); G2_STAGE(G2_SA(0, 1), a2, x10, x11);
            G2_WAIT_L(8); G2_BAR; G2_WAIT_L(0); G2_MMA(0, 0, At, B0); G2_BAR; G2_SCHED;
            G2_LDB(B1, 1, 1); G2_STAGE(G2_SB(1, 0), b20 + kstep, voffB[0], voffB[1]);
            G2_BAR; G2_WAIT_L(0); G2_MMA(0, 1, At, B1); G2_BAR;
            G2_LDA(At, 1, 1); G2_STAGE(G2_SA(1, 0), a2 + kstep, x00, x01);
            G2_BAR; G2_WAIT_L(0); G2_MMA(1, 0, At, B0); G2_BAR; G2_SCHED;
            G2_STAGE(G2_SB(1, 1), b21 + kstep, voffB[0], voffB[1]);
            G2_WAIT_V(6); G2_BAR; G2_MMA(1, 1, At, B1); G2_BAR;
        }
        { Lay lay; int rbv = wr * 64 + fr, cbv = wc * 32 + 4 * fq; asm volatile("" : "+v"(rbv), "+v"(cbv));
          lay.rbase = rbv; lay.cbase = cbv; cur.epi.run(acc, lay); }
        if (!has_next) break;
#pragma unroll
        for (int i = 0; i < 8; ++i)
#pragma unroll
            for (int j = 0; j < 4; ++j) acc[i][j] = (f32x4){0.f, 0.f, 0.f, 0.f};
        cur = nxt; cA = nA; cB0 = nB0; cB1 = nB1; ++ui;
        if (Sched::GATHER) {
#pragma unroll
            for (int h = 0; h < 2; ++h) { cvA[h][0] = nvA[h][0]; cvA[h][1] = nvA[h][1]; } }
    }
#undef x00
#undef x01
#undef x10
#undef x11
    G2_WAIT_V(0);
    if (wr == 0) G2_BAR;
    G2_BAR;
#undef G2_SA
#undef G2_SB
#undef G2_STAGE
#undef G2_LDA
#undef G2_LDB
#undef G2_MMA
#undef G2_WAIT_V
#undef G2_WAIT_L
#undef G2_BAR
#undef G2_SCHED
#undef G2_VOFFA
}
}

struct EpiF32 {
    float* C; int ld;
    template <class L> __device__ __forceinline__ void run(const f32x4 (&acc)[L::NI][L::NJ], const L& lay) const {
#pragma unroll
        for (int i = 0; i < L::NI; ++i)
#pragma unroll
            for (int j = 0; j < L::NJ; ++j) *(f32x4*)(C + (size_t)lay.row(i) * ld + lay.col(j)) = acc[i][j];
    }
};
struct EpiBf16 {
    bf16_t* C; int ld;
    template <class L> __device__ __forceinline__ void run(const f32x4 (&acc)[L::NI][L::NJ], const L& lay) const {
#pragma unroll
        for (int i = 0; i < L::NI; ++i)
#pragma unroll
            for (int j = 0; j < L::NJ; ++j) { u32x2 w; w.x = pack2(acc[i][j][0], acc[i][j][1]); w.y = pack2(acc[i][j][2], acc[i][j][3]);
                *(u32x2*)(C + (size_t)lay.row(i) * ld + lay.col(j)) = w; }
    }
};
struct EpiGateUp {
    bf16_t* C; int ld;
    template <class L> __device__ __forceinline__ void run(const f32x4 (&acc)[L::NI][L::NJ], const L& lay) const {
#pragma unroll
        for (int i = 0; i < L::NI; ++i)
#pragma unroll
            for (int j = 0; j < L::NJ / 2; ++j) { const f32x4 gt = acc[i][j], up = acc[i][j + L::NJ / 2];
                u32x2 w; w.x = pack2(silu_f(gt[0]) * up[0], silu_f(gt[1]) * up[1]); w.y = pack2(silu_f(gt[2]) * up[2], silu_f(gt[3]) * up[3]);
                *(u32x2*)(C + (size_t)lay.row(i) * ld + lay.col(j)) = w; }
    }
};
struct EpiInProj {
    bf16_t* Zt;
    bf16_t* tF;
    bf16_t* tV;
    int n0, pos0, n;
    template <class L> __device__ __forceinline__ void run(const f32x4 (&acc)[L::NI][L::NJ], const L& lay) const {
#pragma unroll
        for (int i = 0; i < L::NI; ++i)
#pragma unroll
            for (int j = 0; j < L::NJ; ++j) {
                const int r = lay.row(i), cl = lay.col(j), c = n0 + cl;
                const f32x4 v = acc[i][j];
                if (c < 512) {
                    const int part = c >> 8, ch = c & 255;
#pragma unroll
                    for (int e = 0; e < 4; ++e) tF[((size_t)(ch + e) * 2 + part) * n + pos0 + r] = f2bf(v[e]);
                } else {
                    u32x2 w; w.x = pack2(v[0], v[1]); w.y = pack2(v[2], v[3]);
                    *(u32x2*)(Zt + (size_t)r * ZC + cl) = w;
                    if (c >= 896 && c < 1024) {
#pragma unroll
                        for (int e = 0; e < 4; ++e) tV[(size_t)(c - 896 + e) * n + pos0 + r] = f2bf(v[e]);
                    }
                }
            }
    }
};

constexpr int U_ADA = 192, U_WIN = 2 * 16 * 28, U_WOUT = 2 * 16 * 16, U_SGU = 32, U_DFT = 4096 + 256, U_ROPE = 1, U_EXP = 3 * 32 * 32;
constexpr int LDS_SIL = 0, LDS_RED = 20480, LDS_TILE = 32768, LDS_T64 = 49408, LDS_CTAB = 50176;

__device__ __forceinline__ void ada_unit(AP a, unsigned char* lds, int u) {
    float* sil = (float*)(lds + LDS_SIL); float* red = (float*)(lds + LDS_RED);
    const int tid = tid_opaque(), lane = tid & 63, w = tid >> 6;
    const int l = u / 96, cg = u % 96;
    for (int i = tid; i < 5120; i += NT) { const int r = i >> 10, k = i & 1023; const float v = (r < 4) ? a->in[1][r * 1024 + k] : a->in[3][k]; sil[i] = v / (1.0f + expf(-v)); }
    __syncthreads();
    const float* W = a->in[4] + (size_t)l * 1024 * 6144 + cg * 64 + lane;
    float acc[5] = {0.f, 0.f, 0.f, 0.f, 0.f};
#pragma unroll 32
    for (int k = w * 128; k < w * 128 + 128; ++k) { const float wv = W[(size_t)k * 6144];
#pragma unroll
        for (int r = 0; r < 5; ++r) acc[r] += sil[r * 1024 + k] * wv; }
#pragma unroll
    for (int r = 0; r < 5; ++r) red[(w * 5 + r) * 64 + lane] = acc[r];
    __syncthreads();
    if (tid < 320) { const int r = tid >> 6; float s = 0.f;
#pragma unroll
        for (int ww = 0; ww < 8; ++ww) s += red[(ww * 5 + r) * 64 + lane];
        const int j = cg * 64 + lane; ((float*)(a->ws + WS_MOD))[(size_t)(l * 5 + r) * 6144 + j] = s + a->in[5][l * 6144 + j]; }
    __syncthreads();
}

__device__ __forceinline__ void tile_store_T(const float* tile, bf16_t* dst, int ldd) {
    const int tid = tid_opaque(), n = tid >> 3, kc = tid & 7;
    u32x4 w;
    w.x = pack2(tile[(kc * 8 + 0) * 65 + n], tile[(kc * 8 + 1) * 65 + n]); w.y = pack2(tile[(kc * 8 + 2) * 65 + n], tile[(kc * 8 + 3) * 65 + n]);
    w.z = pack2(tile[(kc * 8 + 4) * 65 + n], tile[(kc * 8 + 5) * 65 + n]); w.w = pack2(tile[(kc * 8 + 6) * 65 + n], tile[(kc * 8 + 7) * 65 + n]);
    *(u32x4*)(dst + (size_t)n * ldd + kc * 8) = w;
}
__device__ __forceinline__ void tile_load(float* tile, const float* src, int lds_) {
    const int tid = tid_opaque();
#pragma unroll
    for (int i = 0; i < 2; ++i) { const int row = (tid >> 4) + 32 * i, c4 = (tid & 15) * 4; const f32x4 v = *(const f32x4*)(src + (size_t)row * lds_ + c4);
        tile[row * 65 + c4 + 0] = v[0]; tile[row * 65 + c4 + 1] = v[1]; tile[row * 65 + c4 + 2] = v[2]; tile[row * 65 + c4 + 3] = v[3]; }
}

__device__ __forceinline__ void win_unit(AP a, unsigned char* lds, int u) {
    float* tile = (float*)(lds + LDS_TILE); float* T = (float*)(lds + LDS_T64);
    const int tid = tid_opaque();
    const int l = u / 448, r = u % 448, kb = r / 28, nb = r % 28;
    const float* Win = a->in[6] + (size_t)l * 1024 * 1536;
    const int srccol = (nb >= 8) ? nb * 64 - 256 : (nb & 3) * 64;
    tile_load(tile, Win + (size_t)(kb * 64) * 1536 + srccol, 1536);
    if (nb < 8 && tid < 64) { T[tid] = cospif((float)tid / 32.0f); T[64 + tid] = sinpif((float)tid / 32.0f); }
    __syncthreads();
    bf16_t* dst = (bf16_t*)(a->ws + WS_WIN) + ((size_t)l * ZC + nb * 64) * 1024 + kb * 64;
    if (nb >= 8) tile_store_T(tile, dst, 1024);
    else {
        const int n = tid >> 3, kc = tid & 7, part = nb >> 2; float o[8];
#pragma unroll
        for (int e = 0; e < 8; ++e) { float s = 0.f;
#pragma unroll 4
            for (int c = 0; c < 64; ++c) s += tile[(kc * 8 + e) * 65 + c] * T[part * 64 + ((c * n) & 63)]; o[e] = (part ? -s : s) * 0.125f; }
        u32x4 w; w.x = pack2(o[0], o[1]); w.y = pack2(o[2], o[3]); w.z = pack2(o[4], o[5]); w.w = pack2(o[6], o[7]);
        *(u32x4*)(dst + (size_t)n * 1024 + kc * 8) = w;
    }
    __syncthreads();
}

__device__ __forceinline__ void wout_unit(AP a, unsigned char* lds, int u) {
    float* tile = (float*)(lds + LDS_TILE);
    const int tid = tid_opaque();
    const int l = u / 256, r = u % 256, kb = r / 16, nb = r % 16;
    const float* Wo = a->in[13] + (size_t)l * 1024 * 1024;
    const int n = tid & 63, kq = __builtin_amdgcn_readfirstlane(tid >> 6);
    if (kb < 4) {
        const float* wf = a->in[7] + (size_t)l * 256 * 256 + (size_t)(kb * 64 + kq * 8) * 256;
        float acc[8] = {0.f, 0.f, 0.f, 0.f, 0.f, 0.f, 0.f, 0.f};
#pragma unroll 16
        for (int j = 0; j < 256; ++j) { const float wv = Wo[(size_t)j * 1024 + nb * 64 + n];
#pragma unroll
            for (int e = 0; e < 8; ++e) acc[e] += wf[e * 256 + j] * wv; }
#pragma unroll
        for (int e = 0; e < 8; ++e) tile[(kq * 8 + e) * 65 + n] = acc[e];
    } else if (kb >= 8 && kb < 12) {
        const int g = kb - 8;
        const float* wp = a->in[9] + ((size_t)(l * 4 + g) * 64 + kq * 8) * 64;
        const float* ps = a->in[10] + l * 256 + g * 64;
        float acc[8] = {0.f, 0.f, 0.f, 0.f, 0.f, 0.f, 0.f, 0.f};
#pragma unroll 16
        for (int d = 0; d < 64; ++d) { const float wv = ps[d] * Wo[(size_t)(512 + g * 64 + d) * 1024 + nb * 64 + n];
#pragma unroll
            for (int e = 0; e < 8; ++e) acc[e] += wp[e * 64 + d] * wv; }
#pragma unroll
        for (int e = 0; e < 8; ++e) tile[(kq * 8 + e) * 65 + n] = acc[e];
    } else tile_load(tile, Wo + (size_t)(kb * 64) * 1024 + nb * 64, 1024);
    __syncthreads();
    tile_store_T(tile, (bf16_t*)(a->ws + WS_WOUT) + ((size_t)l * 1024 + nb * 64) * 1024 + kb * 64, 1024);
    __syncthreads();
}

__device__ __forceinline__ void exp_src_dst(AP a, int l, int u, const float*& src, int& srcld, bf16_t*& dst, int& dstld) {
    const int mat = u / 1024, e = (u % 1024) / 32, t = u % 32;
    const int kb = (mat < 2) ? t / 4 : t / 8, nb = (mat < 2) ? t % 4 : t % 8;
    srcld = (mat < 2) ? 512 : 1024; dstld = (mat < 2) ? 1024 : 512;
    src = a->in[18 + mat] + ((size_t)(l * 32 + e) * 512 * 1024) + (size_t)(kb * 128) * srcld + nb * 128;
    dst = (bf16_t*)(a->ws + WS_WEXP) + (size_t)mat * EXPMAT + (size_t)e * 512 * 1024 + (size_t)(nb * 128) * dstld + kb * 128;
}
__device__ __forceinline__ void exp_range(AP a, unsigned char* lds, int l, int u0) {
    float* tile = (float*)lds;
    const int tid = tid_opaque(), G = gridDim.x;
    __syncthreads();
    if (u0 >= U_EXP) return;
    const float* src; bf16_t* dst; int srcld, dstld;
    exp_src_dst(a, l, u0, src, srcld, dst, dstld);
    f32x4 v[8];
#pragma unroll
    for (int i = 0; i < 8; ++i) v[i] = *(const f32x4*)(src + (size_t)((tid >> 5) + 16 * i) * srcld + (tid & 31) * 4);
    for (int u = u0; u < U_EXP; u += G) {
#pragma unroll
        for (int i = 0; i < 8; ++i) { float* tp = tile + ((tid >> 5) + 16 * i) * 129 + (tid & 31) * 4; tp[0] = v[i][0]; tp[1] = v[i][1]; tp[2] = v[i][2]; tp[3] = v[i][3]; }
        __syncthreads();
        bf16_t* cdst = dst; const int cdstld = dstld;
        if (u + G < U_EXP) { exp_src_dst(a, l, u + G, src, srcld, dst, dstld);
#pragma unroll
            for (int i = 0; i < 8; ++i) v[i] = *(const f32x4*)(src + (size_t)((tid >> 5) + 16 * i) * srcld + (tid & 31) * 4); }
        const int n = tid >> 2, kq = tid & 3;
#pragma unroll
        for (int j = 0; j < 4; ++j) { const float* tp = tile + (kq * 32 + j * 8) * 129 + n; u32x4 w;
            w.x = pack2(tp[0], tp[129]); w.y = pack2(tp[2 * 129], tp[3 * 129]); w.z = pack2(tp[4 * 129], tp[5 * 129]); w.w = pack2(tp[6 * 129], tp[7 * 129]);
            *(u32x4*)(cdst + (size_t)n * cdstld + kq * 32 + j * 8) = w; }
        __syncthreads();
    }
}

__device__ __forceinline__ void p0_prologue(AP a, unsigned char* lds) {
    const int tid = tid_opaque();
    bool have_tab = false;
    constexpr int E0 = U_ADA, E1 = E0 + U_WIN, E2 = E1 + U_WOUT, E3 = E2 + U_SGU, E4 = E3 + U_DFT, E5 = E4 + U_ROPE;
    int u = blockIdx.x;
    for (; u < E5; u += gridDim.x) {
        if (u < E0) ada_unit(a, lds, u);
        else if (u < E1) win_unit(a, lds, u - E0);
        else if (u < E2) wout_unit(a, lds, u - E1);
        else if (u < E3) { const size_t i0 = (size_t)(u - E2) * 4096 + tid * 8; const float* s = a->in[11] + i0; bf16_t* d = (bf16_t*)(a->ws + WS_WSGU) + i0;
            const f32x4 v0 = *(const f32x4*)s, v1 = *(const f32x4*)(s + 4); u32x4 w; w.x = pack2(v0[0], v0[1]); w.y = pack2(v0[2], v0[3]); w.z = pack2(v1[0], v1[1]); w.w = pack2(v1[2], v1[3]); *(u32x4*)d = w; }
        else if (u < E4) {
            float* ctab = (float*)(lds + LDS_CTAB);
            if (!have_tab) { for (int i = tid; i < 4096; i += NT) ctab[i] = cospif((float)i / 2048.0f); __syncthreads(); have_tab = true; }
            const int k = u - E3;
            if (k < 4096) {
                const int n0 = tid * 8; float c[8], s[8];
#pragma unroll
                for (int e = 0; e < 8; ++e) { const int idx = (k * (n0 + e)) & 4095; c[e] = ctab[idx] * (1.0f / 64.0f); s[e] = ctab[(idx - 1024) & 4095] * (1.0f / 64.0f); }
                bf16_t* d = (bf16_t*)(a->ws + WS_DFT) + (size_t)k * 8192 + n0;
                u32x4 w; w.x = pack2(c[0], c[1]); w.y = pack2(c[2], c[3]); w.z = pack2(c[4], c[5]); w.w = pack2(c[6], c[7]); *(u32x4*)d = w;
                w.x = pack2(s[0], s[1]); w.y = pack2(s[2], s[3]); w.z = pack2(s[4], s[5]); w.w = pack2(s[6], s[7]); *(u32x4*)(d + 4096) = w;
            } else if (tid < 32) {
                const int kk = k - 4096, n0 = tid * 8; float c[8], s[8];
#pragma unroll
                for (int e = 0; e < 8; ++e) { const int idx = ((kk * (n0 + e)) & 255) * 16; c[e] = ctab[idx] * (1.0f / 16.0f); s[e] = ctab[(idx - 1024) & 4095] * (1.0f / 16.0f); }
                bf16_t* d = (bf16_t*)(a->ws + WS_DFTC) + (size_t)kk * 512 + n0;
                u32x4 w; w.x = pack2(c[0], c[1]); w.y = pack2(c[2], c[3]); w.z = pack2(c[4], c[5]); w.w = pack2(c[6], c[7]); *(u32x4*)d = w;
                w.x = pack2(s[0], s[1]); w.y = pack2(s[2], s[3]); w.z = pack2(s[4], s[5]); w.w = pack2(s[6], s[7]); *(u32x4*)(d + 256) = w;
            }
        }
        else {
            for (int i = tid; i < 1024; i += NT) { const int pos = i >> 4, f = i & 15; const float freq = powf(10000.0f, -(float)f / 16.0f); const float ang = (float)pos * freq;
                ((float2*)(a->ws + WS_ROPE))[i] = make_float2(cosf(ang), sinf(ang)); }
        }
    }
    exp_range(a, lds, 0, u - E5);
}

__device__ __forceinline__ void p_lnmod0(AP a) {
    const int tid = tid_opaque(), lane = tid & 63, w = tid >> 6;
    const float* mod = (const float*)(a->ws + WS_MOD);
    bf16_t* H = (bf16_t*)(a->ws + WS_H);
    for (int t = blockIdx.x * 8 + w; t < NTOK; t += gridDim.x * 8) {
        const float* src = (t < NLAT) ? a->in[0] + (size_t)t * D : a->in[2] + (size_t)(t - NLAT) * D;
        const float* m = mod + (size_t)((t < NLAT) ? (t >> 12) : 4) * 6144;
        f32x4 v[4];
#pragma unroll
        for (int i = 0; i < 4; ++i) v[i] = *(const f32x4*)(src + 256 * i + 4 * lane);
        float mean, rstd; ln_stats(v, mean, rstd);
#pragma unroll
        for (int i = 0; i < 4; ++i) { const int c = 256 * i + 4 * lane; const f32x4 sh = *(const f32x4*)(m + c), sc = *(const f32x4*)(m + 1024 + c);
            f32x4 o;
#pragma unroll
            for (int e = 0; e < 4; ++e) o[e] = (v[i][e] - mean) * rstd * (1.0f + sc[e]) + sh[e];
            u32x2 pk; pk.x = pack2(o[0], o[1]); pk.y = pack2(o[2], o[3]); *(u32x2*)(H + (size_t)t * D + c) = pk; }
    }
}

__device__ __forceinline__ void p1_inproj(AP a, LAS unsigned char* lds, int l);
__device__ __forceinline__ void rope32(float (&t)[32], const float2* tab) {
#pragma unroll
    for (int f = 0; f < 16; ++f) { const float2 cs = tab[f]; const float t1 = t[f], t2 = t[16 + f]; t[f] = t1 * cs.x - t2 * cs.y; t[16 + f] = t1 * cs.y + t2 * cs.x; }
}
__device__ __forceinline__ void load32(float (&t)[32], const bf16_t* p) {
#pragma unroll
    for (int q = 0; q < 4; ++q) { const u32x4 w = *(const u32x4*)(p + 8 * q);
        t[8 * q + 0] = lo2f(w.x); t[8 * q + 1] = hi2f(w.x); t[8 * q + 2] = lo2f(w.y); t[8 * q + 3] = hi2f(w.y);
        t[8 * q + 4] = lo2f(w.z); t[8 * q + 5] = hi2f(w.z); t[8 * q + 6] = lo2f(w.w); t[8 * q + 7] = hi2f(w.w); }
}

__device__ __forceinline__ float kdot(const bf16_t* kp, const bf16_t* q, const float2* tab0, const float2* tab1, bool do_rope) {
    float dot = 0.f;
#pragma unroll 1
    for (int ax = 0; ax < 2; ++ax) {
        const float2* tab = ax ? tab1 : tab0;
#pragma unroll 1
        for (int h8 = 0; h8 < 2; ++h8) {
            const u32x4 wl = *(const u32x4*)(kp + ax * 32 + h8 * 8), wh = *(const u32x4*)(kp + ax * 32 + 16 + h8 * 8);
            const float tl[8] = {lo2f(wl.x), hi2f(wl.x), lo2f(wl.y), hi2f(wl.y), lo2f(wl.z), hi2f(wl.z), lo2f(wl.w), hi2f(wl.w)};
            const float th[8] = {lo2f(wh.x), hi2f(wh.x), lo2f(wh.y), hi2f(wh.y), lo2f(wh.z), hi2f(wh.z), lo2f(wh.w), hi2f(wh.w)};
#pragma unroll
            for (int j = 0; j < 8; ++j) {
                float r1 = tl[j], r2 = th[j];
                if (do_rope) { const float2 cs = tab[h8 * 8 + j]; r1 = tl[j] * cs.x - th[j] * cs.y; r2 = tl[j] * cs.y + th[j] * cs.x; }
                dot += bf2f(q[ax * 32 + h8 * 8 + j]) * r1 + bf2f(q[ax * 32 + 16 + h8 * 8 + j]) * r2;
            }
        }
    }
    return dot;
}

__device__ __forceinline__ void mixer_tile(AP a, unsigned char* lds, int l, int row0, int seq_row0, int pos0, int n, int b, bool is_ctx) {
    const int tid = tid_opaque(), lane = tid & 63, w = tid >> 6;
    const bf16_t* Z = (const bf16_t*)(a->ws + WS_Z);
    bf16_t* CAT = (bf16_t*)(a->ws + WS_CAT);
    {
        const int c = tid & 255, half = tid >> 8, g = c >> 6, hw = 1 << g;
        for (int tl = half * 64; tl < half * 64 + 64; ++tl) {
            const int pos = pos0 + tl; const int lo = max(pos - hw, 0), hi = min(pos + hw, n);
            float s = 0.f; for (int j = lo; j < hi; ++j) s += bf2f(Z[(size_t)(seq_row0 + j) * ZC + 1024 + c]);
            const float self = bf2f(Z[(size_t)(seq_row0 + pos) * ZC + 1024 + c]);
            CAT[(size_t)(row0 + tl) * D + 512 + c] = f2bf(s / (float)(hi - lo) - self);
        }
    }
    bf16_t* vT = (bf16_t*)lds;
    for (int q = w; q < 128; q += 8) {
        const u32x2 gw = *(const u32x2*)(Z + (size_t)(row0 + q) * ZC + 1536 + 4 * lane);
        float gv[4] = {gelu_erf(lo2f(gw.x)), gelu_erf(hi2f(gw.x)), gelu_erf(lo2f(gw.y)), gelu_erf(hi2f(gw.y))};
        float s = wave_sum((gv[0] + gv[1]) + (gv[2] + gv[3])); const float mean = s * (1.0f / 256.0f);
        float qq = 0.f;
#pragma unroll
        for (int e = 0; e < 4; ++e) { const float d = gv[e] - mean; qq += d * d; }
        qq = wave_sum(qq); const float rstd = 1.0f / sqrtf(qq * (1.0f / 256.0f) + 1e-6f);
#pragma unroll
        for (int e = 0; e < 4; ++e) vT[(4 * lane + e) * 128 + q] = f2bf((gv[e] - mean) * rstd);
    }
    __syncthreads();
    {
        const int c = tid & 255, ph = tid >> 8, h = c >> 6;
        const bf16_t* Ws = (const bf16_t*)(a->ws + WS_WSGU) + (size_t)(l * 4 + h) * 128 * 128;
        const float* bs = a->in[12] + (size_t)(l * 4 + h) * 128;
        for (int p = ph * 64; p < ph * 64 + 64; ++p) {
            float s = 0.f;
#pragma unroll 2
            for (int q8 = 0; q8 < 16; ++q8) {
                const u32x4 ww = *(const u32x4*)(Ws + (size_t)p * 128 + q8 * 8);
                const u32x4 vv = *(const u32x4*)(vT + c * 128 + q8 * 8);
                s += lo2f(ww.x) * lo2f(vv.x) + hi2f(ww.x) * hi2f(vv.x) + lo2f(ww.y) * lo2f(vv.y) + hi2f(ww.y) * hi2f(vv.y)
                   + lo2f(ww.z) * lo2f(vv.z) + hi2f(ww.z) * hi2f(vv.z) + lo2f(ww.w) * lo2f(vv.w) + hi2f(ww.w) * hi2f(vv.w);
            }
            const float uv = gelu_erf(bf2f(Z[(size_t)(row0 + p) * ZC + 1280 + c]));
            CAT[(size_t)(row0 + p) * D + 768 + c] = f2bf(uv * (s + bs[p]));
        }
    }
    __syncthreads();
    {
        const int i = tid & 127, h = tid >> 7, kvh = h >> 1;
        const float2* rope = (const float2*)(a->ws + WS_ROPE);
        const int qpos = pos0 + i;
        bf16_t* q = (bf16_t*)lds + tid * 66;
        {
            float t0[32];
            load32(t0, Z + (size_t)(row0 + i) * ZC + 512 + h * 64);
            if (!is_ctx) rope32(t0, rope + (qpos >> 6) * 16);
#pragma unroll
            for (int d = 0; d < 32; ++d) q[d] = f2bf(t0[d]);
            load32(t0, Z + (size_t)(row0 + i) * ZC + 512 + h * 64 + 32);
            if (!is_ctx) rope32(t0, rope + (qpos & 63) * 16);
#pragma unroll
            for (int d = 0; d < 32; ++d) q[32 + d] = f2bf(t0[d]);
        }
#pragma unroll 1
        for (int dh = 0; dh < 2; ++dh) {
        float m = a->in[8][l * 4 + h], den = 1.0f;
        float o[32];
#pragma unroll
        for (int d = 0; d < 32; ++d) o[d] = 0.f;
        if (!is_ctx) {
            const bf16_t* VT = (const bf16_t*)(a->ws + WS_VT) + ((size_t)(b * 2 + kvh) * 64 + dh * 32) * 4096;
            const int slo = max(qpos - 128, 0), shi = min(qpos + 128, n - 1);
#pragma unroll 1
            for (int s = slo; s <= shi; ++s) {
                const float dot = 0.125f * kdot(Z + (size_t)(seq_row0 + s) * ZC + 768 + kvh * 64, q, rope + (s >> 6) * 16, rope + (s & 63) * 16, true);
                const float mn = fmaxf(m, dot), corr = __expf(m - mn), p = __expf(dot - mn);
                den = den * corr + p; m = mn;
#pragma unroll
                for (int d = 0; d < 32; ++d) o[d] = o[d] * corr + p * bf2f(VT[(size_t)d * 4096 + s]);
            }
        }
        {
            const bf16_t* VTC = (const bf16_t*)(a->ws + WS_VTC) + ((size_t)(b * 2 + kvh) * 64 + dh * 32) * 256;
#pragma unroll 1
            for (int j = 0; j < 256; ++j) {
                const float dot = 0.125f * kdot(Z + (size_t)(NLAT + b * 256 + j) * ZC + 768 + kvh * 64, q, rope, rope, false);
                const float mn = fmaxf(m, dot), corr = __expf(m - mn), p = __expf(dot - mn);
                den = den * corr + p; m = mn;
#pragma unroll
                for (int d = 0; d < 32; ++d) o[d] = o[d] * corr + p * bf2f(VTC[(size_t)d * 256 + j]);
            }
        }
        const float inv = 1.0f / den;
        bf16_t* dst = CAT + (size_t)(row0 + i) * D + 256 + h * 64 + dh * 32;
#pragma unroll
        for (int d8 = 0; d8 < 4; ++d8) { u32x4 pk; pk.x = pack2(o[8 * d8] * inv, o[8 * d8 + 1] * inv); pk.y = pack2(o[8 * d8 + 2] * inv, o[8 * d8 + 3] * inv);
            pk.z = pack2(o[8 * d8 + 4] * inv, o[8 * d8 + 5] * inv); pk.w = pack2(o[8 * d8 + 6] * inv, o[8 * d8 + 7] * inv); *(u32x4*)(dst + 8 * d8) = pk; }
        }
    }
    __syncthreads();
}

__device__ __forceinline__ u32x4 ld16g(const bf16_t* p) { return *(const u32x4*)p; }
__device__ __forceinline__ void rope_pack8(u32x4& wl, u32x4& wh, const float2* tab, bool do_rope, float scale) {
    float tl[8] = {lo2f(wl.x), hi2f(wl.x), lo2f(wl.y), hi2f(wl.y), lo2f(wl.z), hi2f(wl.z), lo2f(wl.w), hi2f(wl.w)};
    float th[8] = {lo2f(wh.x), hi2f(wh.x), lo2f(wh.y), hi2f(wh.y), lo2f(wh.z), hi2f(wh.z), lo2f(wh.w), hi2f(wh.w)};
#pragma unroll
    for (int j = 0; j < 8; ++j) {
        float r1 = tl[j], r2 = th[j];
        if (do_rope) { const float2 cs = tab[j]; r1 = tl[j] * cs.x - th[j] * cs.y; r2 = tl[j] * cs.y + th[j] * cs.x; }
        tl[j] = r1 * scale; th[j] = r2 * scale;
    }
    wl.x = pack2(tl[0], tl[1]); wl.y = pack2(tl[2], tl[3]); wl.z = pack2(tl[4], tl[5]); wl.w = pack2(tl[6], tl[7]);
    wh.x = pack2(th[0], th[1]); wh.y = pack2(th[2], th[3]); wh.z = pack2(th[4], th[5]); wh.w = pack2(th[6], th[7]);
}

__device__ __forceinline__ void mixer_tile_fast(AP a, LAS unsigned char* lds, int l, int row0, int seq_row0, int pos0, int n, int b, bool is_ctx) {
    const int tid = tid_opaque(), lane = tid & 63, w = __builtin_amdgcn_readfirstlane(tid >> 6), fr = lane & 15, g = lane >> 4;
    const bf16_t* Z = (const bf16_t*)(a->ws + WS_Z);
    bf16_t* CAT = (bf16_t*)(a->ws + WS_CAT);
    {
#pragma unroll
        for (int it = 0; it < 9; ++it) { const int id = tid + 512 * it, rr = id >> 5, ch = id & 31, j = pos0 - 8 + rr;
            u32x4 v = (u32x4){0u, 0u, 0u, 0u};
            if (j >= 0 && j < n) v = ld16g(Z + (size_t)(seq_row0 + j) * ZC + 1024 + ch * 8);
            *(LAS u32x4*)(lds + rr * 512 + ch * 16) = v; }
        __syncthreads();
        const int c = tid & 255, half = tid >> 8, hw = 1 << (c >> 6);
        const LAS bf16_t* P = (const LAS bf16_t*)lds + c;
        const int t0 = half * 64;
        float s = 0.f;
        for (int j = t0 - hw; j < t0 + hw; ++j) s += bf2f(P[(8 + j) * 256]);
        for (int tl = t0; tl < t0 + 64; ++tl) {
            const int pos = pos0 + tl; const int lo = max(pos - hw, 0), hi = min(pos + hw, n);
            CAT[(size_t)(row0 + tl) * D + 512 + c] = f2bf(s / (float)(hi - lo) - bf2f(P[(8 + tl) * 256]));
            s += bf2f(P[(8 + tl + hw) * 256]) - bf2f(P[(8 + tl - hw) * 256]);
        }
        __syncthreads();
    }
    {
        const int i16 = lane & 15;
        u32x4 gw[4][2];
#pragma unroll
        for (int ps = 0; ps < 4; ++ps) { const int q = w * 16 + ps * 4 + g; const bf16_t* src = Z + (size_t)(row0 + q) * ZC + 1536 + 16 * i16; gw[ps][0] = ld16g(src); gw[ps][1] = ld16g(src + 8); }
#pragma unroll
        for (int ps = 0; ps < 4; ++ps) {
            const int q = w * 16 + ps * 4 + g;
            float gv[16];
#pragma unroll
            for (int hh = 0; hh < 2; ++hh) { const u32x4 x = gw[ps][hh];
                gv[8 * hh + 0] = gelu_erf(lo2f(x.x)); gv[8 * hh + 1] = gelu_erf(hi2f(x.x)); gv[8 * hh + 2] = gelu_erf(lo2f(x.y)); gv[8 * hh + 3] = gelu_erf(hi2f(x.y));
                gv[8 * hh + 4] = gelu_erf(lo2f(x.z)); gv[8 * hh + 5] = gelu_erf(hi2f(x.z)); gv[8 * hh + 6] = gelu_erf(lo2f(x.w)); gv[8 * hh + 7] = gelu_erf(hi2f(x.w)); }
            float sm = 0.f;
#pragma unroll
            for (int e = 0; e < 16; ++e) sm += gv[e];
            const float mean = row_sum16(sm) * (1.0f / 256.0f);
            float qq = 0.f;
#pragma unroll
            for (int e = 0; e < 16; ++e) { const float d = gv[e] - mean; qq += d * d; }
            const float rstd = 1.0f / sqrtf(row_sum16(qq) * (1.0f / 256.0f) + 1e-6f);
#pragma unroll
            for (int e = 0; e < 16; ++e) { const int c = 16 * i16 + e; *(LAS bf16_t*)(lds + c * 256 + ((((q >> 3) ^ (c & 15))) << 4) + (q & 7) * 2) = f2bf((gv[e] - mean) * rstd); }
        }
    }
    __syncthreads();
    {
        const int h = w >> 1, ph = w & 1;
        const bf16_t* Ws = (const bf16_t*)(a->ws + WS_WSGU) + (size_t)(l * 4 + h) * 128 * 128;
        const float* bs = a->in[12] + (size_t)(l * 4 + h) * 128;
        f32x4 acc[4][4];
#pragma unroll
        for (int i = 0; i < 4; ++i)
#pragma unroll
            for (int j = 0; j < 4; ++j) acc[i][j] = (f32x4){0.f, 0.f, 0.f, 0.f};
#pragma unroll
        for (int ks = 0; ks < 4; ++ks) {
            bf16x8 af[4], bfv[4];
#pragma unroll
            for (int cf = 0; cf < 4; ++cf) { const int c = h * 64 + 16 * cf + fr; af[cf] = *(const LAS bf16x8*)(lds + c * 256 + (((4 * ks + g) ^ (c & 15)) << 4)); }
#pragma unroll
            for (int pf = 0; pf < 4; ++pf) { const int p = ph * 64 + 16 * pf + fr; bfv[pf] = *(const bf16x8*)(Ws + (size_t)p * 128 + 32 * ks + 8 * g); }
#pragma unroll
            for (int cf = 0; cf < 4; ++cf)
#pragma unroll
                for (int pf = 0; pf < 4; ++pf) acc[cf][pf] = __builtin_amdgcn_mfma_f32_16x16x32_bf16(af[cf], bfv[pf], acc[cf][pf], 0, 0, 0);
        }
#pragma unroll
        for (int pf = 0; pf < 4; ++pf) { const int p = ph * 64 + 16 * pf + fr; const float bias = bs[p];
#pragma unroll
            for (int cf = 0; cf < 4; ++cf) { const int c0 = h * 64 + 16 * cf + 4 * g;
                const u32x2 uw = *(const u32x2*)(Z + (size_t)(row0 + p) * ZC + 1280 + c0);
                u32x2 o; o.x = pack2(gelu_erf(lo2f(uw.x)) * (acc[cf][pf][0] + bias), gelu_erf(hi2f(uw.x)) * (acc[cf][pf][1] + bias));
                o.y = pack2(gelu_erf(lo2f(uw.y)) * (acc[cf][pf][2] + bias), gelu_erf(hi2f(uw.y)) * (acc[cf][pf][3] + bias));
                *(u32x2*)(CAT + (size_t)(row0 + p) * D + 768 + c0) = o; } }
    }
    const float2* rope = (const float2*)(a->ws + WS_ROPE);
    constexpr float QS = 0.125f * 1.44269504088896341f;
    constexpr int QS_OFF = 0, KS_OFF = 32768, VS_OFF = 49152;
    const int nbq = pos0 >> 7;
#pragma unroll 1
    for (int kvh = 0; kvh < 2; ++kvh) {
        __syncthreads();
#pragma unroll
        for (int it = 0; it < 2; ++it) {
            const int item = tid + 512 * it, r = item >> 2, ax = (item >> 1) & 1, h8 = item & 1, i = r & 127, qpos = pos0 + i;
            const bf16_t* src = Z + (size_t)(row0 + i) * ZC + 512 + (2 * kvh + (r >> 7)) * 64 + ax * 32 + h8 * 8;
            u32x4 wl = ld16g(src), wh = ld16g(src + 16);
            rope_pack8(wl, wh, rope + (ax ? (qpos & 63) : (qpos >> 6)) * 16 + h8 * 8, !is_ctx, QS);
            const int ch = ax * 4 + h8, sw = (r >> 1) & 7;
            *(LAS u32x4*)(lds + QS_OFF + r * 128 + ((ch ^ sw) << 4)) = wl;
            *(LAS u32x4*)(lds + QS_OFF + r * 128 + (((ch + 2) ^ sw) << 4)) = wh;
        }
        const int hh = w >> 2, qb = (w & 3) * 32, h = 2 * kvh + hh;
        float m[2], lsum[2];
        m[0] = m[1] = a->in[8][l * 4 + h] * 1.44269504088896341f;
        lsum[0] = lsum[1] = (g == 0) ? 1.0f : 0.0f;
        f32x4 O[4][2];
#pragma unroll
        for (int i = 0; i < 4; ++i) { O[i][0] = (f32x4){0.f, 0.f, 0.f, 0.f}; O[i][1] = (f32x4){0.f, 0.f, 0.f, 0.f}; }
        bf16x8 Qf[2][2];
        bool have_q = false;
#pragma unroll 1
        for (int blk = 0; blk < 5; ++blk) {
            const int jb = blk - 1;
            const bool band = blk < 3;
            if (band && (is_ctx || nbq + jb < 0 || nbq + jb >= (n >> 7))) continue;
            const int key0 = band ? (nbq + jb) * 128 : (blk - 3) * 128;
            const int krow0 = band ? seq_row0 + key0 : NLAT + b * 256 + key0;
            {
                const int r = tid >> 2, ax = (tid >> 1) & 1, h8 = tid & 1, kpos = key0 + r;
                const bf16_t* src = Z + (size_t)(krow0 + r) * ZC + 768 + kvh * 64 + ax * 32 + h8 * 8;
                u32x4 wl = ld16g(src), wh = ld16g(src + 16);
                rope_pack8(wl, wh, rope + (ax ? (kpos & 63) : (kpos >> 6)) * 16 + h8 * 8, band, 1.0f);
                const int ch = ax * 4 + h8, sw = (r >> 1) & 7;
                *(LAS u32x4*)(lds + KS_OFF + r * 128 + ((ch ^ sw) << 4)) = wl;
                *(LAS u32x4*)(lds + KS_OFF + r * 128 + (((ch + 2) ^ sw) << 4)) = wh;
            }
            {
                const bf16_t* vsrc = band ? (const bf16_t*)(a->ws + WS_VT) + (size_t)(b * 2 + kvh) * 64 * 4096 + key0 : (const bf16_t*)(a->ws + WS_VTC) + (size_t)(b * 2 + kvh) * 64 * 256 + key0;
                const int vld = band ? 4096 : 256;
#pragma unroll
                for (int i = 0; i < 2; ++i) { const int P = i * 512 + tid, d = P >> 4, c = (P & 15) ^ (d & 15);
                    glds16(vsrc + (size_t)d * vld + c * 8, lds + VS_OFF + i * 8192 + w * 1024); }
            }
            asm volatile("s_waitcnt vmcnt(0)" ::: "memory");
            __syncthreads();
            if (!have_q) {
#pragma unroll
                for (int qf = 0; qf < 2; ++qf)
#pragma unroll
                    for (int ks = 0; ks < 2; ++ks) { const int r = hh * 128 + qb + 16 * qf + fr; Qf[qf][ks] = *(const LAS bf16x8*)(lds + QS_OFF + r * 128 + (((4 * ks + g) ^ ((r >> 1) & 7)) << 4)); }
                have_q = true;
            }
            f32x4 S[8][2];
#pragma unroll
            for (int kf = 0; kf < 8; ++kf) { S[kf][0] = (f32x4){0.f, 0.f, 0.f, 0.f}; S[kf][1] = (f32x4){0.f, 0.f, 0.f, 0.f}; }
#pragma unroll
            for (int kf = 0; kf < 8; ++kf)
#pragma unroll
                for (int ks = 0; ks < 2; ++ks) { const int r = 16 * kf + fr;
                    const bf16x8 kfr = *(const LAS bf16x8*)(lds + KS_OFF + r * 128 + (((4 * ks + g) ^ ((r >> 1) & 7)) << 4));
                    S[kf][0] = __builtin_amdgcn_mfma_f32_16x16x32_bf16(kfr, Qf[0][ks], S[kf][0], 0, 0, 0);
                    S[kf][1] = __builtin_amdgcn_mfma_f32_16x16x32_bf16(kfr, Qf[1][ks], S[kf][1], 0, 0, 0); }
            bf16x8 Pp[4][2];
#pragma unroll
            for (int qf = 0; qf < 2; ++qf) {
                const int qi = qb + 16 * qf + fr;
                if (band && jb != 0) {
#pragma unroll
                    for (int kf = 0; kf < 8; ++kf)
#pragma unroll
                        for (int r = 0; r < 4; ++r) { const int kk = 16 * kf + 4 * g + r; const bool ok = (jb < 0) ? (kk >= qi) : (kk <= qi); if (!ok) S[kf][qf][r] = -1.0e30f; }
                }
                float mx = S[0][qf][0];
#pragma unroll
                for (int kf = 0; kf < 8; ++kf)
#pragma unroll
                    for (int r = 0; r < 4; ++r) mx = fmaxf(mx, S[kf][qf][r]);
                mx = fmaxf(mx, __shfl_xor(mx, 16)); mx = fmaxf(mx, __shfl_xor(mx, 32));
                const float mn = fmaxf(m[qf], mx), corr = __builtin_amdgcn_exp2f(m[qf] - mn);
                m[qf] = mn;
                float ps = 0.f;
#pragma unroll
                for (int kf = 0; kf < 8; ++kf)
#pragma unroll
                    for (int r = 0; r < 4; ++r) { const float p = __builtin_amdgcn_exp2f(S[kf][qf][r] - mn); S[kf][qf][r] = p; ps += p; }
                lsum[qf] = lsum[qf] * corr + ps;
#pragma unroll
                for (int df = 0; df < 4; ++df) O[df][qf] *= corr;
#pragma unroll
                for (int t = 0; t < 4; ++t) { u32x4 pw; pw.x = pack2(S[2 * t][qf][0], S[2 * t][qf][1]); pw.y = pack2(S[2 * t][qf][2], S[2 * t][qf][3]);
                    pw.z = pack2(S[2 * t + 1][qf][0], S[2 * t + 1][qf][1]); pw.w = pack2(S[2 * t + 1][qf][2], S[2 * t + 1][qf][3]); Pp[t][qf] = __builtin_bit_cast(bf16x8, pw); }
            }
#pragma unroll
            for (int t = 0; t < 4; ++t)
#pragma unroll
                for (int df = 0; df < 4; ++df) { const int d = 16 * df + fr;
                    const u32x2 v0 = *(const LAS u32x2*)(lds + VS_OFF + d * 256 + (((4 * t + (g >> 1)) ^ (d & 15)) << 4) + (g & 1) * 8);
                    const u32x2 v1 = *(const LAS u32x2*)(lds + VS_OFF + d * 256 + (((4 * t + 2 + (g >> 1)) ^ (d & 15)) << 4) + (g & 1) * 8);
                    u32x4 vw; vw.x = v0.x; vw.y = v0.y; vw.z = v1.x; vw.w = v1.y; const bf16x8 vf = __builtin_bit_cast(bf16x8, vw);
                    O[df][0] = __builtin_amdgcn_mfma_f32_16x16x32_bf16(vf, Pp[t][0], O[df][0], 0, 0, 0);
                    O[df][1] = __builtin_amdgcn_mfma_f32_16x16x32_bf16(vf, Pp[t][1], O[df][1], 0, 0, 0); }
            __syncthreads();
        }
#pragma unroll
        for (int qf = 0; qf < 2; ++qf) {
            float lt = lsum[qf]; lt += __shfl_xor(lt, 16); lt += __shfl_xor(lt, 32);
            const float inv = 1.0f / lt;
            bf16_t* dst = CAT + (size_t)(row0 + qb + 16 * qf + fr) * D + 256 + h * 64 + 4 * g;
#pragma unroll
            for (int df = 0; df < 4; ++df) { u32x2 o; o.x = pack2(O[df][qf][0] * inv, O[df][qf][1] * inv); o.y = pack2(O[df][qf][2] * inv, O[df][qf][3] * inv); *(u32x2*)(dst + 16 * df) = o; }
        }
    }
    __syncthreads();
}

__device__ __forceinline__ void p2_mix(AP a, unsigned char* ldsg, LAS unsigned char* lds, int l) {
    const int n_dft = 256, n_dftc = (l == 0) ? 16 : 0, n_mix = 128 + ((l == 0) ? 8 : 0);
    bf16_t* CAT = (bf16_t*)(a->ws + WS_CAT);
    for (int u = blockIdx.x; u < n_dft + n_dftc + n_mix; u += gridDim.x) {
        if (u < n_dft) {
            const int mt = u >> 3, nt = u & 7, b = nt >> 1, ch0 = (nt & 1) * 128;
            const bf16_t* A = (const bf16_t*)(a->ws + WS_DFT) + (size_t)(mt * 128) * 8192;
            const bf16_t* B0 = (const bf16_t*)(a->ws + WS_AT) + ((size_t)b * 256 + ch0) * 8192;
            EpiBf16 E; E.C = CAT + (size_t)(b * 4096 + mt * 128) * D + ch0; E.ld = D;
            gemm_tile<128, false, EpiBf16>(lds, A, 8192, nullptr, 128, B0, B0 + (size_t)64 * 8192, 8192, 8192, E);
        } else if (u < n_dft + n_dftc) {
            const int uu = u - n_dft, b = uu >> 2, mt = (uu >> 1) & 1, ch0 = (uu & 1) * 128;
            const bf16_t* A = (const bf16_t*)(a->ws + WS_DFTC) + (size_t)(mt * 128) * 512;
            const bf16_t* B0 = (const bf16_t*)(a->ws + WS_ATC) + ((size_t)b * 256 + ch0) * 512;
            EpiBf16 E; E.C = CAT + (size_t)(NLAT + b * 256 + mt * 128) * D + ch0; E.ld = D;
            gemm_tile<128, false, EpiBf16>(lds, A, 512, nullptr, 128, B0, B0 + (size_t)64 * 512, 512, 512, E);
        } else {
            const int t = u - n_dft - n_dftc;
#if NAIVE_MIXER
            if (t < 128) { const int b = t >> 5; mixer_tile(a, ldsg, l, t * 128, b * 4096, (t & 31) * 128, 4096, b, false); }
            else { const int tt = t - 128, b = tt >> 1; mixer_tile(a, ldsg, l, NLAT + tt * 128, NLAT + b * 256, (tt & 1) * 128, 256, b, true); }
#else
            const bool isc = t >= 128; const int tt = t - 128;
            const int b = isc ? (tt >> 1) : (t >> 5);
            mixer_tile_fast(a, lds, l, isc ? NLAT + tt * 128 : t * 128, isc ? NLAT + b * 256 : b * 4096, isc ? (tt & 1) * 128 : (t & 31) * 128, isc ? 256 : 4096, b, isc);
#endif
        }
    }
}

__device__ __forceinline__ int uni(int v) { return __builtin_amdgcn_readfirstlane(v); }
template <class T> __device__ __forceinline__ T* unip(T* p) { const unsigned long long v = (unsigned long long)p; const unsigned lo = __builtin_amdgcn_readfirstlane((unsigned)v), hi = __builtin_amdgcn_readfirstlane((unsigned)(v >> 32)); return (T*)(((unsigned long long)hi << 32) | lo); }
struct SchedInProj {
    typedef EpiInProj Epi; static constexpr bool GATHER = false;
    unsigned char* ws; int l, G, me;
    __device__ __forceinline__ bool get(int i, g256::Unit<Epi>& u) const {
        const int n_lat = 64 * 7, n_ctx = (l == 0) ? 4 * 7 : 4;
        const int idx = i * G + me; if (idx >= n_lat + n_ctx) return false;
        int row0, b, ct, n; bf16_t *tF, *tV;
        if (idx < n_lat) { const int rt = idx / 7; ct = idx % 7; row0 = rt * 256; b = row0 >> 12; n = 4096;
            tF = (bf16_t*)(ws + WS_AT) + (size_t)b * 256 * 2 * 4096; tV = (bf16_t*)(ws + WS_VT) + (size_t)b * 128 * 4096; }
        else { const int uu = idx - n_lat; int rt; if (l == 0) { rt = uu / 7; ct = uu % 7; } else { rt = uu; ct = 3; }
            row0 = NLAT + rt * 256; b = rt; n = 256;
            tF = (bf16_t*)(ws + WS_ATC) + (size_t)b * 256 * 2 * 256; tV = (bf16_t*)(ws + WS_VTC) + (size_t)b * 128 * 256; }
        u.A = (const bf16_t*)(ws + WS_H) + (size_t)row0 * D;
        u.B0 = (const bf16_t*)(ws + WS_WIN) + ((size_t)l * ZC + ct * 256) * 1024; u.B1 = u.B0 + (size_t)128 * 1024; u.ridx = nullptr; u.valid = 256;
        u.epi.Zt = (bf16_t*)(ws + WS_Z) + (size_t)row0 * ZC + ct * 256; u.epi.tF = tF; u.epi.tV = tV; u.epi.n0 = ct * 256; u.epi.pos0 = (idx < n_lat) ? (row0 & 4095) : 0; u.epi.n = n;
        return true;
    }
};
struct SchedOutProj {
    typedef EpiF32 Epi; static constexpr bool GATHER = false;
    unsigned char* ws; int l, G, me;
    __device__ __forceinline__ bool get(int i, g256::Unit<Epi>& u) const {
        const int nrt = (l == 0) ? NTOK / 256 : NLAT / 256;
        const int idx = i * G + me; if (idx >= nrt * 4) return false;
        const int rt = idx >> 2, ct = idx & 3;
        u.A = (const bf16_t*)(ws + WS_CAT) + (size_t)(rt * 256) * D;
        u.B0 = (const bf16_t*)(ws + WS_WOUT) + ((size_t)l * 1024 + ct * 256) * 1024; u.B1 = u.B0 + (size_t)128 * 1024; u.ridx = nullptr; u.valid = 256;
        u.epi.C = (float*)(ws + WS_Y) + (size_t)(rt * 256) * D + ct * 256; u.epi.ld = D;
        return true;
    }
};
struct SchedGateUp {
    typedef EpiGateUp Epi; static constexpr bool GATHER = true;
    unsigned char* ws; const LAS int* blk; const LAS int* tot; const LAS int* ridx_lds; int G, me;
    __device__ __forceinline__ bool get(int i, g256::Unit<Epi>& u) const {
        const int idx = i * G + me; if (idx >= uni(blk[32]) * 4) return false;
        const int rb = idx >> 2, ct = idx & 3;
        int e = 0;
#pragma unroll 1
        for (int q = 1; q < 32; ++q) if (uni(blk[q]) <= rb) e = q;
        u.A = (const bf16_t*)(ws + WS_H);
        u.B0 = (const bf16_t*)(ws + WS_WEXP) + ((size_t)e * 512 + ct * 128) * 1024; u.B1 = u.B0 + EXPMAT;
        u.ridx = ridx_lds + (i & 7) * 256; u.valid = uni(min(256, tot[e] - (rb - blk[e]) * 256));
        u.epi.C = (bf16_t*)(ws + WS_HID) + (size_t)(rb * 256) * DEXP + ct * 128; u.epi.ld = DEXP;
        return true;
    }
};
struct SchedDown {
    typedef EpiBf16 Epi; static constexpr bool GATHER = false;
    unsigned char* ws; const LAS int* blk; int G, me;
    __device__ __forceinline__ bool get(int i, g256::Unit<Epi>& u) const {
        const int idx = i * G + me; if (idx >= uni(blk[32]) * 4) return false;
        const int rb = idx >> 2, ct = idx & 3;
        int e = 0;
#pragma unroll 1
        for (int q = 1; q < 32; ++q) if (uni(blk[q]) <= rb) e = q;
        u.A = (const bf16_t*)(ws + WS_HID) + (size_t)(rb * 256) * DEXP;
        u.B0 = (const bf16_t*)(ws + WS_WEXP) + 2 * EXPMAT + ((size_t)e * 1024 + ct * 256) * 512; u.B1 = u.B0 + (size_t)128 * 512; u.ridx = nullptr; u.valid = 256;
        u.epi.C = (bf16_t*)(ws + WS_YS) + (size_t)(rb * 256) * D + ct * 256; u.epi.ld = D;
        return true;
    }
};

__device__ __forceinline__ void p4_ln1_router(AP a, unsigned char* lds, int l) {
    const int tid = tid_opaque(), lane = tid & 63, w = tid >> 6;
    const int ntok = (l == 0) ? NTOK : NLAT;
    int* cnt = (int*)(lds + MISC_OFF);
    if (tid < 32) cnt[tid] = 0;
    f32x4* Lg = (f32x4*)lds; f32x4* Le = (f32x4*)(lds + 16384); f32x4* Lgb = (f32x4*)(lds + 147456);
    {
        const float* wrg_ = a->in[16] + (size_t)l * 1024 * 4; const float* wre_ = a->in[17] + (size_t)l * 1024 * 32;
#pragma unroll
        for (int it = 0; it < 2; ++it) { const int c = tid + 512 * it, slot = (((c >> 8) * 4 + (c & 3)) << 6) + ((c >> 2) & 63);
            Lg[slot] = *(const f32x4*)(wrg_ + (size_t)c * 4);
#pragma unroll
            for (int q = 0; q < 8; ++q) Le[q * 1024 + slot] = *(const f32x4*)(wre_ + (size_t)c * 32 + q * 4); }
        Lgb[tid] = (tid < 256) ? *(const f32x4*)(a->in[14] + l * 1024 + tid * 4) : *(const f32x4*)(a->in[15] + l * 1024 + (tid - 256) * 4);
    }
    __syncthreads();
    const float* mod = (const float*)(a->ws + WS_MOD) + (size_t)l * 5 * 6144;
    const float* Y = (const float*)(a->ws + WS_Y);
    float* X1 = (float*)(a->ws + WS_X1);
    bf16_t* H = (bf16_t*)(a->ws + WS_H);
    int* tokE = (int*)(a->ws + WS_TOKE); int* tokR = (int*)(a->ws + WS_TOKR); float* tokG = (float*)(a->ws + WS_TOKG);
    const int tstep = gridDim.x * 8;
    f32x4 nx[4], ny[4];
    {   const int t = blockIdx.x * 8 + w;
        if (t < ntok) { const float* xs = (l == 0) ? ((t < NLAT) ? a->in[0] + (size_t)t * D : a->in[2] + (size_t)(t - NLAT) * D) : (const float*)(a->ws + WS_XC) + (size_t)t * D;
#pragma unroll
            for (int i = 0; i < 4; ++i) { nx[i] = *(const f32x4*)(xs + 256 * i + 4 * lane); ny[i] = *(const f32x4*)(Y + (size_t)t * D + 256 * i + 4 * lane); } } }
    int mrow = -1; f32x4 mg[4], msh[4], msc[4];
    for (int t = blockIdx.x * 8 + w; t < ntok; t += tstep) {
        const int mr = (t < NLAT) ? (t >> 12) : 4;
        if (mr != mrow) { mrow = mr; const float* m = mod + (size_t)mr * 6144;
#pragma unroll
            for (int i = 0; i < 4; ++i) { const int c = 256 * i + 4 * lane; mg[i] = *(const f32x4*)(m + 2048 + c); msh[i] = *(const f32x4*)(m + 3072 + c); msc[i] = *(const f32x4*)(m + 4096 + c); } }
        f32x4 v[4];
#pragma unroll
        for (int i = 0; i < 4; ++i) {
#pragma unroll
            for (int e = 0; e < 4; ++e) v[i][e] = RES_ALPHA * nx[i][e] + mg[i][e] * ny[i][e]; }
        {   const int tn = t + tstep;
            if (tn < ntok) { const float* xs = (l == 0) ? ((tn < NLAT) ? a->in[0] + (size_t)tn * D : a->in[2] + (size_t)(tn - NLAT) * D) : (const float*)(a->ws + WS_XC) + (size_t)tn * D;
#pragma unroll
                for (int i = 0; i < 4; ++i) { nx[i] = *(const f32x4*)(xs + 256 * i + 4 * lane); ny[i] = *(const f32x4*)(Y + (size_t)tn * D + 256 * i + 4 * lane); } } }
        float mean, rstd; ln_stats(v, mean, rstd);
#pragma unroll
        for (int i = 0; i < 4; ++i) { const int c = 256 * i + 4 * lane; const f32x4 gg = Lgb[64 * i + lane], bb = Lgb[256 + 64 * i + lane];
#pragma unroll
            for (int e = 0; e < 4; ++e) v[i][e] = (v[i][e] - mean) * rstd * gg[e] + bb[e];
            *(f32x4*)(X1 + (size_t)t * D + c) = v[i]; }
        ln_stats(v, mean, rstd);
#pragma unroll
        for (int i = 0; i < 4; ++i) { const int c = 256 * i + 4 * lane; const f32x4 sh = msh[i], sc = msc[i];
#pragma unroll
            for (int e = 0; e < 4; ++e) v[i][e] = (v[i][e] - mean) * rstd * (1.0f + sc[e]) + sh[e];
            u32x2 pk; pk.x = pack2(v[i][0], v[i][1]); pk.y = pack2(v[i][2], v[i][3]); *(u32x2*)(H + (size_t)t * D + c) = pk; }
        float lg[4] = {0.f, 0.f, 0.f, 0.f};
#pragma unroll
        for (int i = 0; i < 4; ++i)
#pragma unroll
            for (int e = 0; e < 4; ++e) { const f32x4 wv = Lg[((i * 4 + e) << 6) + lane];
                lg[0] += v[i][e] * wv[0]; lg[1] += v[i][e] * wv[1]; lg[2] += v[i][e] * wv[2]; lg[3] += v[i][e] * wv[3]; }
#pragma unroll
        for (int q = 0; q < 4; ++q) lg[q] = wave_sum(lg[q]);
        int grp = 0; float mx = lg[0];
#pragma unroll
        for (int q = 1; q < 4; ++q) if (lg[q] > mx) { mx = lg[q]; grp = q; }
        float se = 0.f;
#pragma unroll
        for (int q = 0; q < 4; ++q) se += expf(lg[q] - mx);
        const float gate_group = 1.0f / se;
        float le[8] = {0.f, 0.f, 0.f, 0.f, 0.f, 0.f, 0.f, 0.f};
#pragma unroll
        for (int i = 0; i < 4; ++i)
#pragma unroll
            for (int e = 0; e < 4; ++e) { const f32x4* wp = Le + grp * 2048 + ((i * 4 + e) << 6) + lane; const f32x4 w0 = wp[0], w1 = wp[1024];
                le[0] += v[i][e] * w0[0]; le[1] += v[i][e] * w0[1]; le[2] += v[i][e] * w0[2]; le[3] += v[i][e] * w0[3];
                le[4] += v[i][e] * w1[0]; le[5] += v[i][e] * w1[1]; le[6] += v[i][e] * w1[2]; le[7] += v[i][e] * w1[3]; }
#pragma unroll
        for (int q = 0; q < 8; ++q) le[q] = wave_sum(le[q]);
        int j1 = 0; float l1 = le[0];
#pragma unroll
        for (int q = 1; q < 8; ++q) if (le[q] > l1) { l1 = le[q]; j1 = q; }
        int j2 = -1; float l2 = -3.0e38f;
#pragma unroll
        for (int q = 0; q < 8; ++q) if (q != j1 && le[q] > l2) { l2 = le[q]; j2 = q; }
        const float e2 = expf(l2 - l1), p1 = 1.0f / (1.0f + e2), p2 = e2 / (1.0f + e2);
        if (lane == 0) {
            const int ex0 = grp * 8 + j1, ex1 = grp * 8 + j2;
            const int r0 = atomicAdd(&cnt[ex0], 1), r1 = atomicAdd(&cnt[ex1], 1);
            tokE[2 * t] = ex0; tokE[2 * t + 1] = ex1; tokR[2 * t] = r0; tokR[2 * t + 1] = r1;
            tokG[2 * t] = gate_group * p1; tokG[2 * t + 1] = gate_group * p2;
        }
    }
    __syncthreads();
    if (tid < 32) ((int*)(a->ws + WS_BCNT))[((size_t)l * MAXG + blockIdx.x) * 32 + tid] = cnt[tid];
    __syncthreads();
}

__device__ __forceinline__ void p5_dispatch(AP a, unsigned char* lds, int l) {
    const int tid = tid_opaque();
    const int ntok = (l == 0) ? NTOK : NLAT;
    int* part = (int*)lds;
    int* tot = (int*)(lds + 4096);
    int* off = (int*)(lds + 4096 + 128);
    int* pstart = (int*)(lds + 4096 + 256);
    const int* bc = (const int*)(a->ws + WS_BCNT) + (size_t)l * MAXG * 32;
    const int G = gridDim.x, me = blockIdx.x;
    { const int e = tid & 31, p = tid >> 5; int s = 0, so = 0; for (int bb = p; bb < G; bb += 16) { const int c = bc[bb * 32 + e]; s += c; if (bb < me) so += c; } part[p * 32 + e] = s; part[512 + p * 32 + e] = so; }
    __syncthreads();
    if (tid < 32) { int s = 0, so = 0; for (int p = 0; p < 16; ++p) { s += part[p * 32 + tid]; so += part[512 + p * 32 + tid]; } tot[tid] = s; off[tid] = so; }
    __syncthreads();
    if (tid == 0) { int acc = 0; for (int e = 0; e < 32; ++e) { pstart[e] = acc; acc += ((tot[e] + 255) >> 8) << 8; } }
    __syncthreads();
    if (me == 0 && tid < 32) ((int*)(a->ws + WS_CNT))[l * 32 + tid] = tot[tid];
    const int* tokE = (const int*)(a->ws + WS_TOKE); const int* tokR = (const int*)(a->ws + WS_TOKR);
    int* tokS = (int*)(a->ws + WS_TOKS); int* slotT = (int*)(a->ws + WS_SLOTT);
    for (int base = me * 8; base < ntok; base += G * 8) {
        if (tid < 16) { const int t = base + (tid >> 1); if (t < ntok) { const int idx = 2 * t + (tid & 1); const int e = tokE[idx]; const int slot = pstart[e] + off[e] + tokR[idx]; tokS[idx] = slot; slotT[slot] = t; } }
    }
    __syncthreads();
}

__device__ __forceinline__ void moe_table(AP a, int l, LAS int* blk) {
    const int* tot = (const int*)(a->ws + WS_CNT) + l * 32;
    if (threadIdx.x == 0) { int acc = 0; for (int e = 0; e < 32; ++e) { const int c = tot[e]; blk[e] = acc; blk[33 + e] = c; acc += (c + 255) >> 8; } blk[32] = acc; }
    __syncthreads();
}
__device__ __forceinline__ void p1_inproj(AP a, LAS unsigned char* lds, int l) {
    SchedInProj S; S.ws = a->ws; S.l = l; S.G = gridDim.x; S.me = blockIdx.x;
    g256::gemm_phase(lds, 1024, S);
}
__device__ __forceinline__ void p3_outproj(AP a, LAS unsigned char* lds, int l) {
    SchedOutProj S; S.ws = a->ws; S.l = l; S.G = gridDim.x; S.me = blockIdx.x;
    g256::gemm_phase(lds, 1024, S);
}
__device__ __forceinline__ void p6_gateup(AP a, LAS unsigned char* lds, int l) {
    LAS int* blk = (LAS int*)(lds + MISC_OFF + 256);
    moe_table(a, l, blk);
    LAS int* ridx = (LAS int*)(lds + RIDX_OFF);
    const int tid = tid_opaque(), G = gridDim.x, me = blockIdx.x, nu = blk[32] * 4;
    const int* slotT = (const int*)(a->ws + WS_SLOTT);
    for (int i = 0; i < 8; ++i) { const int idx = i * G + me; if (idx >= nu) break;
        const int rb = idx >> 2; int e = 0; for (int q = 1; q < 32; ++q) if (blk[q] <= rb) e = q;
        const int valid = min(256, blk[33 + e] - (rb - blk[e]) * 256);
        if (tid < 256) ridx[i * 256 + tid] = (tid < valid) ? slotT[rb * 256 + tid] : 0; }
    __syncthreads();
    SchedGateUp S; S.ws = a->ws; S.blk = blk; S.tot = blk + 33; S.ridx_lds = ridx; S.G = G; S.me = me;
    g256::gemm_phase(lds, 1024, S);
    __syncthreads();
}
__device__ __forceinline__ void p7_down(AP a, LAS unsigned char* lds, int l) {
    LAS int* blk = (LAS int*)(lds + MISC_OFF + 256);
    moe_table(a, l, blk);
    SchedDown S; S.ws = a->ws; S.blk = blk; S.G = gridDim.x; S.me = blockIdx.x;
    g256::gemm_phase(lds, 512, S);
    __syncthreads();
}

__device__ __forceinline__ void p8_ln2(AP a, unsigned char* lds, int l) {
    const int tid = tid_opaque(), lane = tid & 63, w = tid >> 6;
    const int ntok = (l == 0) ? NTOK : NLAT;
    const float* mod = (const float*)(a->ws + WS_MOD) + (size_t)l * 5 * 6144;
    const float* modn = (const float*)(a->ws + WS_MOD) + (size_t)5 * 6144;
    const float* X1 = (const float*)(a->ws + WS_X1);
    const bf16_t* YS = (const bf16_t*)(a->ws + WS_YS);
    const int* tokS = (const int*)(a->ws + WS_TOKS); const float* tokG = (const float*)(a->ws + WS_TOKG);
    f32x4* Lgb = (f32x4*)lds;
    __syncthreads();
    Lgb[tid] = (tid < 256) ? *(const f32x4*)(a->in[21] + l * 1024 + tid * 4) : *(const f32x4*)(a->in[22] + l * 1024 + (tid - 256) * 4);
    __syncthreads();
    int mrow = -1; f32x4 mg[4], nsh[4], nsc[4];
    const int tstep = gridDim.x * 8;
    int t = blockIdx.x * 8 + w;
    int ns0 = 0, ns1 = 0; float nga = 0.f, ngb = 0.f;
    f32x4 nx[4]; u32x2 nya[4], nyb[4];
    float cga = 0.f, cgb = 0.f;
    if (t < ntok) { const int s0 = tokS[2 * t], s1 = tokS[2 * t + 1]; cga = tokG[2 * t]; cgb = tokG[2 * t + 1];
#pragma unroll
        for (int i = 0; i < 4; ++i) { const int c = 256 * i + 4 * lane; nx[i] = *(const f32x4*)(X1 + (size_t)t * D + c); nya[i] = *(const u32x2*)(YS + (size_t)s0 * D + c); nyb[i] = *(const u32x2*)(YS + (size_t)s1 * D + c); } }
    if (t + tstep < ntok) { ns0 = tokS[2 * (t + tstep)]; ns1 = tokS[2 * (t + tstep) + 1]; nga = tokG[2 * (t + tstep)]; ngb = tokG[2 * (t + tstep) + 1]; }
    for (; t < ntok; t += tstep) {
        const int mr = (t < NLAT) ? (t >> 12) : 4;
        if (mr != mrow) { mrow = mr; const float* m = mod + (size_t)mr * 6144; const float* mn = modn + (size_t)mr * 6144;
#pragma unroll
            for (int i = 0; i < 4; ++i) { const int c = 256 * i + 4 * lane; mg[i] = *(const f32x4*)(m + 5120 + c); if (l == 0) { nsh[i] = *(const f32x4*)(mn + c); nsc[i] = *(const f32x4*)(mn + 1024 + c); } } }
        f32x4 v[4];
#pragma unroll
        for (int i = 0; i < 4; ++i) { const f32x4 gv = mg[i];
            const u32x2 ya = nya[i], yb = nyb[i];
            const float f0 = cga * lo2f(ya.x) + cgb * lo2f(yb.x), f1 = cga * hi2f(ya.x) + cgb * hi2f(yb.x), f2 = cga * lo2f(ya.y) + cgb * lo2f(yb.y), f3 = cga * hi2f(ya.y) + cgb * hi2f(yb.y);
            v[i][0] = RES_ALPHA * nx[i][0] + gv[0] * f0; v[i][1] = RES_ALPHA * nx[i][1] + gv[1] * f1; v[i][2] = RES_ALPHA * nx[i][2] + gv[2] * f2; v[i][3] = RES_ALPHA * nx[i][3] + gv[3] * f3; }
        {   const int tn = t + tstep, tn2 = t + 2 * tstep;
            if (tn < ntok) {
#pragma unroll
                for (int i = 0; i < 4; ++i) { const int c = 256 * i + 4 * lane; nx[i] = *(const f32x4*)(X1 + (size_t)tn * D + c); nya[i] = *(const u32x2*)(YS + (size_t)ns0 * D + c); nyb[i] = *(const u32x2*)(YS + (size_t)ns1 * D + c); }
                cga = nga; cgb = ngb; }
            if (tn2 < ntok) { ns0 = tokS[2 * tn2]; ns1 = tokS[2 * tn2 + 1]; nga = tokG[2 * tn2]; ngb = tokG[2 * tn2 + 1]; } }
        float mean, rstd; ln_stats(v, mean, rstd);
        float* dst = (l == 0) ? (float*)(a->ws + WS_XC) + (size_t)t * D : a->out + (size_t)t * D;
#pragma unroll
        for (int i = 0; i < 4; ++i) { const int c = 256 * i + 4 * lane; const f32x4 gg = Lgb[64 * i + lane], bb = Lgb[256 + 64 * i + lane];
#pragma unroll
            for (int e = 0; e < 4; ++e) v[i][e] = (v[i][e] - mean) * rstd * gg[e] + bb[e];
            *(f32x4*)(dst + c) = v[i]; }
        if (l == 0) {
            ln_stats(v, mean, rstd);
            bf16_t* H = (bf16_t*)(a->ws + WS_H);
#pragma unroll
            for (int i = 0; i < 4; ++i) { const int c = 256 * i + 4 * lane; const f32x4 sh = nsh[i], sc = nsc[i];
                f32x4 o;
#pragma unroll
                for (int e = 0; e < 4; ++e) o[e] = (v[i][e] - mean) * rstd * (1.0f + sc[e]) + sh[e];
                u32x2 pk; pk.x = pack2(o[0], o[1]); pk.y = pack2(o[2], o[3]); *(u32x2*)(H + (size_t)t * D + c) = pk; }
        }
    }
    if (l == 0) exp_range(a, lds, 1, blockIdx.x);
}

constexpr int N_PHASES = 18;
template <int P> __device__ __forceinline__ void run_phase(AP a, unsigned char* smem, LAS unsigned char* lds, int l) {
    asm volatile("" : "+s"(a));
    if (P == 0) p0_prologue(a, smem);
    if (P == 1) p_lnmod0(a);
    if (P == 2) p1_inproj(a, lds, l);
    if (P == 3) p2_mix(a, smem, lds, l);
    if (P == 4) p3_outproj(a, lds, l);
    if (P == 5) p4_ln1_router(a, smem, l);
    if (P == 6) p5_dispatch(a, smem, l);
    if (P == 7) p6_gateup(a, lds, l);
    if (P == 8) p7_down(a, lds, l);
    if (P == 9) p8_ln2(a, smem, l);
}
template <int P> __device__ __noinline__ void phase_fn(AP ap, int l) {
    extern __shared__ __attribute__((aligned(16))) unsigned char smem[];
    run_phase<P>(ap, smem, (LAS unsigned char*)smem, l);
}
#if N_LAUNCH_MODE == 1
__global__ void __launch_bounds__(NT, 2) fwd(Args a) {
    extern __shared__ __attribute__((aligned(16))) unsigned char smem[];
    LAS unsigned char* lds = (LAS unsigned char*)smem;
    if (threadIdx.x < 4) ((volatile LAS unsigned*)(lds + MISC_OFF + 768))[threadIdx.x] = 0u;
    __syncthreads();
    XcdBarrier bar = xcd_barrier_post((unsigned*)(a.ws + WS_BAR), (volatile LAS unsigned*)(lds + MISC_OFF + 768));
    AP ap = (AP)__builtin_amdgcn_kernarg_segment_ptr();
#define PROBE(P, l) do { if (PROBE_MASK & (1 << (P))) { for (int _r = 0; _r < 2; ++_r) { xcd_barrier(bar); run_phase<P>(ap, smem, lds, l); } } } while (0)
    run_phase<0>(ap, smem, lds, 0); PROBE(0, 0); xcd_barrier(bar);
    run_phase<1>(ap, smem, lds, 0); PROBE(1, 0); xcd_barrier(bar);
    for (int l = 0; l < 2; ++l) {
        run_phase<2>(ap, smem, lds, l); PROBE(2, l); xcd_barrier(bar);
        run_phase<3>(ap, smem, lds, l); PROBE(3, l); xcd_barrier(bar);
        run_phase<4>(ap, smem, lds, l); PROBE(4, l); xcd_barrier(bar);
        run_phase<5>(ap, smem, lds, l); PROBE(5, l); xcd_barrier(bar);
        run_phase<6>(ap, smem, lds, l); PROBE(6, l); xcd_barrier(bar);
        run_phase<7>(ap, smem, lds, l); PROBE(7, l); xcd_barrier(bar);
        run_phase<8>(ap, smem, lds, l); PROBE(8, l); xcd_barrier(bar);
        run_phase<9>(ap, smem, lds, l); PROBE(9, l); if (l == 0) xcd_barrier(bar);
    }
}
#else
template <int P> __global__ void __launch_bounds__(NT, 2) k_phase(Args a) {
    extern __shared__ __attribute__((aligned(16))) unsigned char smem[];
    LAS unsigned char* lds = (LAS unsigned char*)smem;
    AP ap = (AP)__builtin_amdgcn_kernarg_segment_ptr();
    run_phase<P>(ap, smem, lds, ap->ph_lo);
}
template <int P> static void launch_phase(Args a, int l, int grid, hipStream_t stream) {
    static bool attr = false;
    if (!attr) { (void)hipFuncSetAttribute((const void*)k_phase<P>, hipFuncAttributeMaxDynamicSharedMemorySize, LDS_BYTES); attr = true; }
    a.ph_lo = l; a.ph_hi = P;
    hipLaunchKernelGGL(k_phase<P>, dim3(grid), dim3(NT), LDS_BYTES, stream, a);
}
#endif

extern "C" void kernel_launch(void* const* d_in, const int* in_sizes, int n_in, void* d_out, int out_size, void* d_ws, size_t ws_size, hipStream_t stream) {
    static int grid = 0;
    if (grid == 0) {
        if (n_in != 23 || out_size != NLAT * D || ws_size < WS_END) { fprintf(stderr, "kernel_launch: unexpected shapes (n_in %d, out %d, ws %zu, need %zu)\n", n_in, out_size, ws_size, (size_t)WS_END); grid = -1; return; }
        int dev = 0, cus = 0;
        if (hipGetDevice(&dev) != hipSuccess || hipDeviceGetAttribute(&cus, hipDeviceAttributeMultiprocessorCount, dev) != hipSuccess) { grid = -1; return; }
#if N_LAUNCH_MODE == 1
        int per_cu = 0;
        if (hipFuncSetAttribute((const void*)fwd, hipFuncAttributeMaxDynamicSharedMemorySize, LDS_BYTES) != hipSuccess) { fprintf(stderr, "kernel_launch: hipFuncSetAttribute failed\n"); grid = -1; return; }
        if (hipOccupancyMaxActiveBlocksPerMultiprocessor(&per_cu, (const void*)fwd, NT, LDS_BYTES) != hipSuccess || per_cu < 1) { fprintf(stderr, "kernel_launch: occupancy query says %d\n", per_cu); }
        (void)hipGetLastError();
#endif
        grid = cus; if (grid > MAXG) grid = MAXG;
    }
    if (grid < 0) return;
    (void)hipMemsetAsync((char*)d_ws + WS_BAR, 0, 16384 + 256, stream);
    Args a{};
    for (int i = 0; i < 23; ++i) a.in[i] = (const float*)d_in[i];
    a.out = (float*)d_out; a.ws = (unsigned char*)d_ws;
#if N_LAUNCH_MODE == 1
    a.ph_lo = 0; a.ph_hi = N_PHASES;
    hipLaunchKernelGGL(fwd, dim3(grid), dim3(NT), LDS_BYTES, stream, a);
#else
    launch_phase<0>(a, 0, grid, stream);
    launch_phase<1>(a, 0, grid, stream);
    for (int l = 0; l < 2; ++l) {
        launch_phase<2>(a, l, grid, stream); launch_phase<3>(a, l, grid, stream); launch_phase<4>(a, l, grid, stream); launch_phase<5>(a, l, grid, stream);
        launch_phase<6>(a, l, grid, stream); launch_phase<7>(a, l, grid, stream); launch_phase<8>(a, l, grid, stream); launch_phase<9>(a, l, grid, stream);
    }
#endif
}
```

```cpp
#include <hip/hip_runtime.h>
#include <stdint.h>
#include <stdio.h>

#ifndef NAIVE_GEMM
#define NAIVE_GEMM 0
#endif
#ifndef NAIVE_MIXER
#define NAIVE_MIXER 0
#endif
#ifndef PROBE_MASK
#define PROBE_MASK 0
#endif
#ifndef N_LAUNCH_MODE
#define N_LAUNCH_MODE 1
#endif

#define LAS __attribute__((address_space(3)))
typedef unsigned short bf16_t;
typedef short bf16x8 __attribute__((ext_vector_type(8)));
typedef float f32x4 __attribute__((ext_vector_type(4)));
typedef unsigned u32x4 __attribute__((ext_vector_type(4)));
typedef unsigned u32x2 __attribute__((ext_vector_type(2)));

constexpr int D = 1024, NBATCH = 4, SEQ = 4096, CTXL = 256;
constexpr int NLAT = NBATCH * SEQ, NCTX = NBATCH * CTXL, NTOK = NLAT + NCTX;
constexpr int ZC = 1792;
constexpr int NEXP = 32, DEXP = 512;
constexpr int NSLOT = 2 * NTOK + NEXP * 256;
constexpr int NT = 512;
constexpr int MAXG = 512;
constexpr float RES_ALPHA = 1.41421356237309515f;
constexpr int MISC_OFF = 155648;
constexpr int RIDX_OFF = 131072;
constexpr int LDS_BYTES = MISC_OFF + 1024;

constexpr size_t WS_BAR   = 0;
constexpr size_t WS_CNT   = 16384;
constexpr size_t WS_BCNT  = WS_CNT + 256;
constexpr size_t WS_MOD   = WS_BCNT + (size_t)2 * MAXG * 32 * 4;
constexpr size_t WS_ROPE  = WS_MOD + (size_t)2 * 5 * 6144 * 4;
constexpr size_t WS_TOKE  = WS_ROPE + 8192;
constexpr size_t WS_TOKR  = WS_TOKE + (size_t)NTOK * 8;
constexpr size_t WS_TOKS  = WS_TOKR + (size_t)NTOK * 8;
constexpr size_t WS_TOKG  = WS_TOKS + (size_t)NTOK * 8;
constexpr size_t WS_SLOTT = WS_TOKG + (size_t)NTOK * 8;
constexpr size_t WS_WIN   = WS_SLOTT + (size_t)NSLOT * 4;
constexpr size_t WS_WOUT  = WS_WIN + (size_t)2 * ZC * 1024 * 2;
constexpr size_t WS_WSGU  = WS_WOUT + (size_t)2 * 1024 * 1024 * 2;
constexpr size_t WS_DFT   = WS_WSGU + (size_t)2 * 4 * 128 * 128 * 2;
constexpr size_t WS_DFTC  = WS_DFT + (size_t)4096 * 8192 * 2;
constexpr size_t WS_WEXP  = WS_DFTC + (size_t)256 * 512 * 2;
constexpr size_t EXPMAT   = (size_t)NEXP * 512 * 1024;
constexpr size_t WS_X1    = WS_WEXP + 3 * EXPMAT * 2;
constexpr size_t WS_XC    = WS_X1 + (size_t)NTOK * D * 4;
constexpr size_t WS_H     = WS_XC + (size_t)NTOK * D * 4;
constexpr size_t WS_R     = WS_H + (size_t)NTOK * D * 2;
constexpr size_t WS_Z     = WS_R;
constexpr size_t WS_AT    = WS_Z + (size_t)NTOK * ZC * 2;
constexpr size_t WS_ATC   = WS_AT + (size_t)4 * 256 * 8192 * 2;
constexpr size_t WS_VT    = WS_ATC + (size_t)4 * 256 * 512 * 2;
constexpr size_t WS_VTC   = WS_VT + (size_t)4 * 2 * 64 * 4096 * 2;
constexpr size_t WS_CAT   = WS_VTC + (size_t)4 * 2 * 64 * 256 * 2;
constexpr size_t WS_REND  = WS_CAT + (size_t)NTOK * D * 2;
constexpr size_t WS_Y     = WS_R;
constexpr size_t WS_HID   = WS_R;
constexpr size_t WS_YS    = WS_HID + (size_t)NSLOT * DEXP * 2;
constexpr size_t WS_END   = (WS_YS + (size_t)NSLOT * D * 2 > WS_REND) ? WS_YS + (size_t)NSLOT * D * 2 : WS_REND;
static_assert(WS_Y + (size_t)NTOK * D * 4 <= WS_CAT, "Y must not reach CAT");
static_assert(WS_WIN % 256 == 0 && WS_DFT % 256 == 0 && WS_WEXP % 256 == 0 && WS_X1 % 256 == 0 && WS_H % 256 == 0 && WS_R % 256 == 0 && WS_AT % 256 == 0 && WS_CAT % 256 == 0 && WS_YS % 256 == 0, "alignment");

struct Args { const float* in[23]; float* out; unsigned char* ws; int ph_lo, ph_hi; };
#define CAS __attribute__((address_space(4)))
typedef const CAS Args* AP;

#define XB_TMO      128
#define XB_XCNT(j)  (256  + 64 * (j))
#define XB_XSUB(j)  (1280 + 64 * (j))
#define XB_XGEN(j)  (2304 + 64 * (j))
#define XB_TOP      3328
#define XB_TOPGEN   3392
#define XCD_BAR_WORDS 3456
#define XB_SPIN_CAP (1u << 18)

__device__ __forceinline__ unsigned xb_ld(unsigned* p)              { return __hip_atomic_load(p, __ATOMIC_RELAXED, __HIP_MEMORY_SCOPE_AGENT); }
__device__ __forceinline__ unsigned xb_add(unsigned* p, unsigned v) { return __hip_atomic_fetch_add(p, v, __ATOMIC_RELAXED, __HIP_MEMORY_SCOPE_AGENT); }
__device__ __forceinline__ unsigned xb_xcc_id() { return (unsigned)__builtin_amdgcn_s_getreg((3 << 11) | 20) & 0xFu; }
#define XB_SPIN(cond, bar) do { unsigned _sp = 0; while (cond) { __builtin_amdgcn_s_sleep(1); \
    if ((++_sp & 255u) == 0u) { if (xb_ld(&(bar)[XB_TMO])) break; if (_sp > XB_SPIN_CAP) { atomicAdd(&(bar)[XB_TMO], 1u); break; } } } } while (0)

struct XcdBarrier { unsigned* bar; unsigned x; volatile LAS unsigned* st; };

__device__ __forceinline__ XcdBarrier xcd_barrier_post(unsigned* bar, volatile LAS unsigned* st) {
    XcdBarrier b; b.bar = bar; b.x = (unsigned)__builtin_amdgcn_readfirstlane((int)xb_xcc_id()); b.st = st;
    if (threadIdx.x == 0) (void)xb_add(&bar[XB_XCNT(b.x)], 1u);
    return b;
}
__device__ __forceinline__ void xcd_barrier_complete(unsigned* bar, unsigned x, unsigned& nloc, unsigned& nx) {
    const unsigned G = gridDim.x * gridDim.y * gridDim.z;
    unsigned sum, cnt, mine, sp = 0u;
    for (;;) {
        sum = 0u; cnt = 0u; mine = 0u;
#pragma unroll
        for (unsigned j = 0; j < 16; ++j) { const unsigned c = xb_ld(&bar[XB_XCNT(j)]); sum += c; cnt += (c > 0u) ? 1u : 0u; mine = (j == x) ? c : mine; }
        if (sum == G) break;
        __builtin_amdgcn_s_sleep(1);
        if ((++sp & 255u) == 0u) { if (xb_ld(&bar[XB_TMO])) break; if (sp > XB_SPIN_CAP) { atomicAdd(&bar[XB_TMO], 1u); break; } }
    }
    nloc = mine > 0u ? mine : 1u; nx = cnt > 0u ? cnt : 1u;
}
__device__ __forceinline__ void xcd_barrier(const XcdBarrier& b) {
    asm volatile("s_waitcnt vmcnt(0)" ::: "memory");
    __syncthreads();
    if (threadIdx.x == 0) {
        unsigned* bar = b.bar;
        unsigned bx = b.x;
        asm volatile("" : "+s"(bar), "+s"(bx));
        __builtin_amdgcn_s_waitcnt(0);
        unsigned nloc = b.st[0], nx = b.st[1];
        if (nloc == 0u) { xcd_barrier_complete(bar, bx, nloc, nx); b.st[0] = nloc; b.st[1] = nx; }
        const unsigned old = xb_add(&bar[XB_XSUB(bx)], 1u);
        const unsigned gen = old / nloc;
        if (old + 1u == (gen + 1u) * nloc) {
            __builtin_amdgcn_fence(__ATOMIC_RELEASE, "agent");
            asm volatile("s_waitcnt vmcnt(0)" ::: "memory");
            const unsigned og = xb_add(&bar[XB_TOP], 1u);
            const unsigned tg = og / nx;
            if (og + 1u == (tg + 1u) * nx) xb_add(&bar[XB_TOPGEN], 1u);
            else XB_SPIN(xb_ld(&bar[XB_TOPGEN]) == tg, bar);
            __builtin_amdgcn_fence(__ATOMIC_ACQUIRE, "agent");
            xb_add(&bar[XB_XGEN(bx)], 1u);
            asm volatile("s_waitcnt vmcnt(0)" ::: "memory");
        } else {
            XB_SPIN(xb_ld(&bar[XB_XGEN(bx)]) == gen, bar);
            __builtin_amdgcn_fence(__ATOMIC_ACQUIRE, "agent");
            asm volatile("s_waitcnt vmcnt(0)" ::: "memory");
        }
    }
    __syncthreads();
}

__device__ __forceinline__ int tid_opaque() { int t = threadIdx.x; asm volatile("" : "+v"(t)); return t; }
__device__ __forceinline__ float bf2f(bf16_t v) { return __uint_as_float(((unsigned)v) << 16); }
__device__ __forceinline__ bf16_t f2bf(float f) { unsigned u = __float_as_uint(f); u += 0x7FFFu + ((u >> 16) & 1u); return (bf16_t)(u >> 16); }
__device__ __forceinline__ unsigned pack2(float a, float b) { return (unsigned)f2bf(a) | ((unsigned)f2bf(b) << 16); }
__device__ __forceinline__ float lo2f(unsigned w) { return __uint_as_float(w << 16); }
__device__ __forceinline__ float hi2f(unsigned w) { return __uint_as_float(w & 0xffff0000u); }
template <int CTRL> __device__ __forceinline__ float dpp_mov(float v) { return __builtin_bit_cast(float, __builtin_amdgcn_update_dpp(0, __builtin_bit_cast(int, v), CTRL, 0xf, 0xf, true)); }
__device__ __forceinline__ float row_sum16(float v) {
    v += dpp_mov<0xB1>(v);
    v += dpp_mov<0x4E>(v);
    v += dpp_mov<0x141>(v);
    v += dpp_mov<0x140>(v);
    return v;
}
__device__ __forceinline__ float row_max16(float v) {
    v = fmaxf(v, dpp_mov<0xB1>(v)); v = fmaxf(v, dpp_mov<0x4E>(v)); v = fmaxf(v, dpp_mov<0x141>(v)); v = fmaxf(v, dpp_mov<0x140>(v));
    return v;
}
__device__ __forceinline__ float wave_sum(float v) {
    v = row_sum16(v);
    const int iv = __builtin_bit_cast(int, v);
    const float a0 = __builtin_bit_cast(float, __builtin_amdgcn_readlane(iv, 0)), a1 = __builtin_bit_cast(float, __builtin_amdgcn_readlane(iv, 16));
    const float a2 = __builtin_bit_cast(float, __builtin_amdgcn_readlane(iv, 32)), a3 = __builtin_bit_cast(float, __builtin_amdgcn_readlane(iv, 48));
    return (a0 + a1) + (a2 + a3);
}
__device__ __forceinline__ float gelu_erf(float x) { return 0.5f * x * (1.0f + erff(x * 0.70710678118654752f)); }
__device__ __forceinline__ float silu_f(float x) { return x / (1.0f + __expf(-x)); }

__device__ __forceinline__ void ln_stats(const f32x4 (&v)[4], float& mean, float& rstd) {
    float s = 0.f;
#pragma unroll
    for (int i = 0; i < 4; ++i) s += (v[i][0] + v[i][1]) + (v[i][2] + v[i][3]);
    s = wave_sum(s); mean = s * (1.0f / 1024.0f);
    float q = 0.f;
#pragma unroll
    for (int i = 0; i < 4; ++i)
#pragma unroll
        for (int e = 0; e < 4; ++e) { const float d = v[i][e] - mean; q += d * d; }
    q = wave_sum(q); rstd = 1.0f / sqrtf(q * (1.0f / 1024.0f) + 1e-6f);
}

__device__ __forceinline__ void ln_stats16(const f32x4 (&v)[16], float& mean, float& rstd) {
    float s = 0.f;
#pragma unroll
    for (int k = 0; k < 16; ++k) s += (v[k][0] + v[k][1]) + (v[k][2] + v[k][3]);
    s = row_sum16(s); mean = s * (1.0f / 1024.0f);
    float q = 0.f;
#pragma unroll
    for (int k = 0; k < 16; ++k)
#pragma unroll
        for (int e = 0; e < 4; ++e) { const float d = v[k][e] - mean; q += d * d; }
    q = row_sum16(q); rstd = 1.0f / sqrtf(q * (1.0f / 1024.0f) + 1e-6f);
}

template <int BN> struct MfmaLayout {
    static constexpr int FG = BN / 128, NI = 4, NJ = 2 * FG;
    int rbase, cbase;
    __device__ __forceinline__ int row(int i) const { return rbase + 16 * i; }
    __device__ __forceinline__ int col(int jj) const { return (jj / FG) * (BN / 2) + (jj % FG) * 16 + cbase; }
};
template <int BN> struct NaiveLayout {
    static constexpr int TX = BN / 8, TY = NT / TX, NI = 128 / TY, NJ = 2;
    int ty, tx;
    __device__ __forceinline__ int row(int i) const { return ty + TY * i; }
    __device__ __forceinline__ int col(int jj) const { return jj * (BN / 2) + 4 * tx; }
};

__device__ __forceinline__ void glds16(const bf16_t* g, LAS unsigned char* l) {
    __builtin_amdgcn_global_load_lds((const unsigned*)g, (LAS unsigned*)l, 16, 0, 0);
}

template <int BN, bool GATHER, class Epi>
__device__ __forceinline__ void gemm_tile(LAS unsigned char* lds, const bf16_t* A, int lda, const int* rowidx, int valid_rows,
                                          const bf16_t* B0, const bf16_t* B1, int ldb, int K, const Epi& epi) {
    constexpr int A_B = 16384, B_B = BN * 128, STAGE = A_B + B_B, NBL = BN / 64;
    const int tid = tid_opaque(), lane = tid & 63, wid = __builtin_amdgcn_readfirstlane(tid >> 6);
    const bf16_t* ap[2]; const bf16_t* bp[NBL];
#pragma unroll
    for (int i = 0; i < 2; ++i) {
        const int P = i * 512 + tid, row = P >> 3, c = (P & 7) ^ ((row >> 1) & 7);
        size_t ro;
        if (GATHER) ro = (size_t)(row < valid_rows ? rowidx[row] : 0) * (size_t)lda; else ro = (size_t)row * (size_t)lda;
        ap[i] = A + ro + c * 8;
    }
#pragma unroll
    for (int i = 0; i < NBL; ++i) {
        const int P = i * 512 + tid, row = P >> 3, c = (P & 7) ^ ((row >> 1) & 7);
        const bf16_t* base = (row < BN / 2) ? (B0 + (size_t)row * ldb) : (B1 + (size_t)(row - BN / 2) * ldb);
        bp[i] = base + c * 8;
    }
    const int nk = K / 64;
#define GT_STAGE(buf, k0) do { \
        _Pragma("unroll") for (int _i = 0; _i < 2; ++_i) glds16(ap[_i] + (k0), lds + (buf) * STAGE + _i * 8192 + wid * 1024); \
        _Pragma("unroll") for (int _i = 0; _i < NBL; ++_i) glds16(bp[_i] + (k0), lds + (buf) * STAGE + A_B + _i * 8192 + wid * 1024); } while (0)

#if NAIVE_GEMM
    typedef NaiveLayout<BN> Lay;
    Lay lay; lay.tx = tid % Lay::TX; lay.ty = tid / Lay::TX;
    f32x4 acc[Lay::NI][Lay::NJ];
#pragma unroll
    for (int i = 0; i < Lay::NI; ++i)
#pragma unroll
        for (int j = 0; j < Lay::NJ; ++j) acc[i][j] = (f32x4){0.f, 0.f, 0.f, 0.f};
    GT_STAGE(0, 0);
    asm volatile("s_waitcnt vmcnt(0)" ::: "memory"); __syncthreads();
    for (int kt = 0; kt < nk; ++kt) {
        if (kt + 1 < nk) GT_STAGE((kt + 1) & 1, (kt + 1) * 64);
        const LAS unsigned char* sa = lds + (kt & 1) * STAGE; const LAS unsigned char* sb = sa + A_B;
#pragma unroll 1
        for (int kc = 0; kc < 8; ++kc)
#pragma unroll 1
            for (int hh = 0; hh < 2; ++hh) {
                float a[Lay::NI][4];
#pragma unroll
                for (int i = 0; i < Lay::NI; ++i) { const int row = lay.row(i);
                    const u32x2 w = *(const LAS u32x2*)(sa + row * 128 + ((kc ^ ((row >> 1) & 7)) << 4) + hh * 8);
                    a[i][0] = lo2f(w.x); a[i][1] = hi2f(w.x); a[i][2] = lo2f(w.y); a[i][3] = hi2f(w.y); }
#pragma unroll
                for (int j = 0; j < 2; ++j)
#pragma unroll
                    for (int e = 0; e < 4; ++e) { const int row = j * (BN / 2) + 4 * lay.tx + e;
                        const u32x2 w = *(const LAS u32x2*)(sb + row * 128 + ((kc ^ ((row >> 1) & 7)) << 4) + hh * 8);
                        const float b0 = lo2f(w.x), b1 = hi2f(w.x), b2 = lo2f(w.y), b3 = hi2f(w.y);
#pragma unroll
                        for (int i = 0; i < Lay::NI; ++i) acc[i][j][e] += (a[i][0] * b0 + a[i][1] * b1) + (a[i][2] * b2 + a[i][3] * b3); }
            }
        asm volatile("s_waitcnt vmcnt(0)" ::: "memory"); __syncthreads();
    }
    epi.run(acc, lay);
#else
    typedef MfmaLayout<BN> Lay;
    constexpr int FG = Lay::FG;
    const int fr = lane & 15, g = lane >> 4, wr = wid >> 2, wc = wid & 3;
    Lay lay; lay.rbase = wr * 64 + fr; lay.cbase = wc * 16 * FG + 4 * g;
    f32x4 acc[Lay::NI][Lay::NJ];
#pragma unroll
    for (int i = 0; i < Lay::NI; ++i)
#pragma unroll
        for (int j = 0; j < Lay::NJ; ++j) acc[i][j] = (f32x4){0.f, 0.f, 0.f, 0.f};
    int aoff[4], boff[Lay::NJ];
#pragma unroll
    for (int m = 0; m < 4; ++m) { const int row = wr * 64 + m * 16 + fr; aoff[m] = row * 128 + ((g ^ ((row >> 1) & 7)) << 4); }
#pragma unroll
    for (int jj = 0; jj < Lay::NJ; ++jj) { const int row = (jj / FG) * (BN / 2) + wc * 16 * FG + (jj % FG) * 16 + fr; boff[jj] = A_B + row * 128 + ((g ^ ((row >> 1) & 7)) << 4); }
    GT_STAGE(0, 0);
    asm volatile("s_waitcnt vmcnt(0)" ::: "memory"); __syncthreads();
    for (int kt = 0; kt < nk; ++kt) {
        if (kt + 1 < nk) GT_STAGE((kt + 1) & 1, (kt + 1) * 64);
        const LAS unsigned char* sa = lds + (kt & 1) * STAGE;
#pragma unroll
        for (int ks = 0; ks < 2; ++ks) {
            bf16x8 af[4], bfv[Lay::NJ];
#pragma unroll
            for (int m = 0; m < 4; ++m) af[m] = *(const LAS bf16x8*)(sa + (aoff[m] ^ (ks << 6)));
#pragma unroll
            for (int jj = 0; jj < Lay::NJ; ++jj) bfv[jj] = *(const LAS bf16x8*)(sa + (boff[jj] ^ (ks << 6)));
#pragma unroll
            for (int m = 0; m < 4; ++m)
#pragma unroll
                for (int jj = 0; jj < Lay::NJ; ++jj) acc[m][jj] = __builtin_amdgcn_mfma_f32_16x16x32_bf16(bfv[jj], af[m], acc[m][jj], 0, 0, 0);
        }
        asm volatile("s_waitcnt vmcnt(0)" ::: "memory"); __syncthreads();
    }
    epi.run(acc, lay);
#endif
#undef GT_STAGE
}

namespace g256 {
constexpr int BK = 64, HALF = 128, HTB = HALF * BK * 2, STAGE_BYTES = 8 * HTB;
__device__ __forceinline__ int lds_byte(int r, int c) { const int st = (r >> 4) * 2 + (c >> 5), rr = r & 15, cc = c & 31, ob = rr * 64 + cc * 2; return st * 1024 + (ob ^ (((ob >> 9) & 1) << 5)); }
__device__ __forceinline__ void stage_rc(int b, int& R, int& C) { const int st = b / 1024, sb = b % 1024, swz = sb ^ (((sb >> 9) & 1) << 5); R = (st >> 1) * 16 + swz / 64; C = (st & 1) * 32 + (swz % 64) / 2; }
struct Lay {
    static constexpr int NI = 8, NJ = 4;
    int rbase, cbase;
    __device__ __forceinline__ int row(int i) const { return (i >> 2) * 128 + (i & 3) * 16 + rbase; }
    __device__ __forceinline__ int col(int j) const { return (j >> 1) * 128 + (j & 1) * 16 + cbase; }
};
template <class Epi> struct Unit { const bf16_t* A; const bf16_t* B0; const bf16_t* B1; const LAS int* ridx; int valid; Epi epi; };

template <class Sched>
__device__ __forceinline__ void gemm_phase(LAS unsigned char* lds, const int K, const Sched& S) {
    typedef typename Sched::Epi Epi;
    const int tid = tid_opaque(), wid = __builtin_amdgcn_readfirstlane(tid >> 6), lane = tid & 63, wr = wid >> 2, wc = wid & 3, fr = lane & 15, fq = lane >> 4;
    const int nt = K / BK;
    int sR[2], sC[2];
#pragma unroll
    for (int i = 0; i < 2; ++i) stage_rc(tid * 16 + i * 8192, sR[i], sC[i]);
    unsigned voffB[2];
#pragma unroll
    for (int i = 0; i < 2; ++i) voffB[i] = (unsigned)(sR[i] * K + sC[i]) * 2u;
    const size_t kstep = (size_t)(BK * 2);
    const unsigned ldsw = (unsigned)wid * 1024u;
    const int aoff = lds_byte(wr * 64 + fr, fq * 8), boff = lds_byte(wc * 32 + fr, fq * 8);
#define G2_SA(b, h) (((b) * 2 + (h)) * HTB)
#define G2_SB(b, h) ((4 + (b) * 2 + (h)) * HTB)
#define G2_STAGE(bufoff, gbase, v0, v1) do { \
        __builtin_amdgcn_global_load_lds((const unsigned*)((const char*)(gbase) + (v0)), (LAS unsigned*)(lds + (bufoff) + ldsw), 16, 0, 0); \
        __builtin_amdgcn_global_load_lds((const unsigned*)((const char*)(gbase) + (v1)), (LAS unsigned*)(lds + (bufoff) + ldsw + 8192), 16, 0, 0); } while (0)
#define G2_LDA(dst, b, h) do { _Pragma("unroll") for (int m = 0; m < 4; ++m) _Pragma("unroll") for (int k = 0; k < 2; ++k) dst[m][k] = *(const LAS bf16x8*)(lds + G2_SA(b, h) + aoff + m * 2048 + k * 1024); } while (0)
#define G2_LDB(dst, b, h) do { _Pragma("unroll") for (int n = 0; n < 2; ++n) _Pragma("unroll") for (int k = 0; k < 2; ++k) dst[n][k] = *(const LAS bf16x8*)(lds + G2_SB(b, h) + boff + n * 2048 + k * 1024); } while (0)
#define G2_MMA(ai, bj, At, Bt) do { __builtin_amdgcn_s_setprio(1); _Pragma("unroll") for (int m = 0; m < 4; ++m) _Pragma("unroll") for (int n = 0; n < 2; ++n) _Pragma("unroll") for (int k = 0; k < 2; ++k) \
        acc[(ai) * 4 + m][(bj) * 2 + n] = __builtin_amdgcn_mfma_f32_16x16x32_bf16(Bt[n][k], At[m][k], acc[(ai) * 4 + m][(bj) * 2 + n], 0, 0, 0); __builtin_amdgcn_s_setprio(0); } while (0)
#define G2_WAIT_V(n) asm volatile("s_waitcnt vmcnt(" #n ")" ::: "memory")
#define G2_WAIT_L(n) asm volatile("s_waitcnt lgkmcnt(" #n ")" ::: "memory")
#define G2_BAR __builtin_amdgcn_s_barrier()
#define G2_SCHED __builtin_amdgcn_sched_barrier(0)
#define G2_VOFFA(U, dst) do { _Pragma("unroll") for (int _h = 0; _h < 2; ++_h) _Pragma("unroll") for (int _i = 0; _i < 2; ++_i) { const int _row = _h * 128 + sR[_i]; \
        int _tok = _row; if (Sched::GATHER) _tok = (_row < (U).valid) ? (U).ridx[_row] : 0; dst[_h][_i] = (unsigned)(_tok * K + sC[_i]) * 2u; } } while (0)
    Unit<Epi> cur, nxt; int ui = 0;
    if (!S.get(0, cur)) return;
    f32x4 acc[8][4];
#pragma unroll
    for (int i = 0; i < 8; ++i)
#pragma unroll
        for (int j = 0; j < 4; ++j) acc[i][j] = (f32x4){0.f, 0.f, 0.f, 0.f};
    bf16x8 At[4][2], B0[2][2], B1[2][2];
    unsigned cvA[2][2], nvA[2][2];
    G2_VOFFA(cur, cvA);
    const char* cA = (const char*)cur.A; const char* cB0 = (const char*)cur.B0; const char* cB1 = (const char*)cur.B1;
    G2_STAGE(G2_SB(0, 0), cB0, voffB[0], voffB[1]); G2_STAGE(G2_SA(0, 0), cA, cvA[0][0], cvA[0][1]); G2_STAGE(G2_SB(0, 1), cB1, voffB[0], voffB[1]); G2_STAGE(G2_SA(0, 1), cA, cvA[1][0], cvA[1][1]);
    if (wr == 1) G2_BAR;
    G2_WAIT_V(4); G2_BAR;
    G2_STAGE(G2_SB(1, 0), cB0 + kstep, voffB[0], voffB[1]); G2_STAGE(G2_SA(1, 0), cA + kstep, cvA[0][0], cvA[0][1]); G2_STAGE(G2_SB(1, 1), cB1 + kstep, voffB[0], voffB[1]);
    G2_WAIT_V(6); G2_BAR;
    for (;;) {
        const bool has_next = S.get(ui + 1, nxt);
        if (Sched::GATHER) {
            if (has_next) { G2_VOFFA(nxt, nvA); }
            else {
#pragma unroll
                for (int h = 0; h < 2; ++h) { nvA[h][0] = cvA[h][0]; nvA[h][1] = cvA[h][1]; } }
        }
        const char* nA = has_next ? (const char*)nxt.A : cA; const char* nB0 = has_next ? (const char*)nxt.B0 : cB0; const char* nB1 = has_next ? (const char*)nxt.B1 : cB1;
        for (int t = 0; t < nt; t += 2) {
            const bool last = (t == nt - 2);
            const char* a1 = cA + (size_t)(t + 1) * kstep;
            const char* a2 = last ? nA : cA + (size_t)(t + 2) * kstep;
            const char* b20 = last ? nB0 : cB0 + (size_t)(t + 2) * kstep; const char* b21 = last ? nB1 : cB1 + (size_t)(t + 2) * kstep;
#define x00 ((Sched::GATHER && last) ? nvA[0][0] : cvA[0][0])
#define x01 ((Sched::GATHER && last) ? nvA[0][1] : cvA[0][1])
#define x10 ((Sched::GATHER && last) ? nvA[1][0] : cvA[1][0])
#define x11 ((Sched::GATHER && last) ? nvA[1][1] : cvA[1][1])
            G2_LDB(B0, 0, 0); G2_SCHED; G2_LDA(At, 0, 0); G2_STAGE(G2_SA(1, 1), a1, cvA[1][0], cvA[1][1]);
            G2_WAIT_L(8); G2_BAR; G2_WAIT_L(0); G2_MMA(0, 0, At, B0); G2_BAR; G2_SCHED;
            G2_LDB(B1, 0, 1); G2_STAGE(G2_SB(0, 0), b20, voffB[0], voffB[1]);
            G2_BAR; G2_WAIT_L(0); G2_MMA(0, 1, At, B1); G2_BAR;
            G2_LDA(At, 0, 1); G2_STAGE(G2_SA(0, 0), a2, x00, x01);
            G2_BAR; G2_WAIT_L(0); G2_MMA(1, 0, At, B0); G2_BAR; G2_SCHED;
            G2_STAGE(G2_SB(0, 1), b21, voffB[0], voffB[1]);
            G2_WAIT_V(6); G2_BAR; G2_MMA(1, 1, At, B1); G2_BAR;
            G2_LDB(B0, 1, 0); G2_SCHED; G2_LDA(At, 1, 0); G2_STAGE(G2_SA(0, 1), a2, x10, x11);
            G2_WAIT_L(8); G2_BAR; G2_WAIT_L(0); G2_MMA(0, 0, At, B0); G2_BAR; G2_SCHED;
            G2_LDB(B1, 1, 1); G2_STAGE(G2_SB(1, 0), b20 + kstep, voffB[0], voffB[1]);
            G2_BAR; G2_WAIT_L(0); G2_MMA(0, 1, At, B1); G2_BAR;
            G2_LDA(At, 1, 1); G2_STAGE(G2_SA(1, 0), a2 + kstep, x00, x01);
            G2_BAR; G2_WAIT_L(0); G2_MMA(1, 0, At, B0); G2_BAR; G2_SCHED;
            G2_STAGE(G2_SB(1, 1), b21 + kstep, voffB[0], voffB[1]);
            G2_WAIT_V(6); G2_BAR; G2_MMA(1, 1, At, B1); G2_BAR;
        }
        { Lay lay; int rbv = wr * 64 + fr, cbv = wc * 32 + 4 * fq; asm volatile("" : "+v"(rbv), "+v"(cbv));
          lay.rbase = rbv; lay.cbase = cbv; cur.epi.run(acc, lay); }
        if (!has_next) break;
#pragma unroll
        for (int i = 0; i < 8; ++i)
#pragma unroll
            for (int j = 0; j < 4; ++j) acc[i][j] = (f32x4){0.f, 0.f, 0.f, 0.f};
        cur = nxt; cA = nA; cB0 = nB0; cB1 = nB1; ++ui;
        if (Sched::GATHER) {
#pragma unroll
            for (int h = 0; h < 2; ++h) { cvA[h][0] = nvA[h][0]; cvA[h][1] = nvA[h][1]; } }
    }
#undef x00
#undef x01
#undef x10
#undef x11
    G2_WAIT_V(0);
    if (wr == 0) G2_BAR;
    G2_BAR;
#undef G2_SA
#undef G2_SB
#undef G2_STAGE
#undef G2_LDA
#undef G2_LDB
#undef G2_MMA
#undef G2_WAIT_V
#undef G2_WAIT_L
#undef G2_BAR
#undef G2_SCHED
#undef G2_VOFFA
}
}

struct EpiF32 {
    float* C; int ld;
    template <class L> __device__ __forceinline__ void run(const f32x4 (&acc)[L::NI][L::NJ], const L& lay) const {
#pragma unroll
        for (int i = 0; i < L::NI; ++i)
#pragma unroll
            for (int j = 0; j < L::NJ; ++j) *(f32x4*)(C + (size_t)lay.row(i) * ld + lay.col(j)) = acc[i][j];
    }
};
struct EpiBf16 {
    bf16_t* C; int ld;
    template <class L> __device__ __forceinline__ void run(const f32x4 (&acc)[L::NI][L::NJ], const L& lay) const {
#pragma unroll
        for (int i = 0; i < L::NI; ++i)
#pragma unroll
            for (int j = 0; j < L::NJ; ++j) { u32x2 w; w.x = pack2(acc[i][j][0], acc[i][j][1]); w.y = pack2(acc[i][j][2], acc[i][j][3]);
                *(u32x2*)(C + (size_t)lay.row(i) * ld + lay.col(j)) = w; }
    }
};
struct EpiGateUp {
    bf16_t* C; int ld;
    template <class L> __device__ __forceinline__ void run(const f32x4 (&acc)[L::NI][L::NJ], const L& lay) const {
#pragma unroll
        for (int i = 0; i < L::NI; ++i)
#pragma unroll
            for (int j = 0; j < L::NJ / 2; ++j) { const f32x4 gt = acc[i][j], up = acc[i][j + L::NJ / 2];
                u32x2 w; w.x = pack2(silu_f(gt[0]) * up[0], silu_f(gt[1]) * up[1]); w.y = pack2(silu_f(gt[2]) * up[2], silu_f(gt[3]) * up[3]);
                *(u32x2*)(C + (size_t)lay.row(i) * ld + lay.col(j)) = w; }
    }
};
struct EpiInProj {
    bf16_t* Zt;
    bf16_t* tF;
    bf16_t* tV;
    int n0, pos0, n;
    template <class L> __device__ __forceinline__ void run(const f32x4 (&acc)[L::NI][L::NJ], const L& lay) const {
#pragma unroll
        for (int i = 0; i < L::NI; ++i)
#pragma unroll
            for (int j = 0; j < L::NJ; ++j) {
                const int r = lay.row(i), cl = lay.col(j), c = n0 + cl;
                const f32x4 v = acc[i][j];
                if (c < 512) {
                    const int part = c >> 8, ch = c & 255;
#pragma unroll
                    for (int e = 0; e < 4; ++e) tF[((size_t)(ch + e) * 2 + part) * n + pos0 + r] = f2bf(v[e]);
                } else {
                    u32x2 w; w.x = pack2(v[0], v[1]); w.y = pack2(v[2], v[3]);
                    *(u32x2*)(Zt + (size_t)r * ZC + cl) = w;
                    if (c >= 896 && c < 1024) {
#pragma unroll
                        for (int e = 0; e < 4; ++e) tV[(size_t)(c - 896 + e) * n + pos0 + r] = f2bf(v[e]);
                    }
                }
            }
    }
};

constexpr int U_ADA = 192, U_WIN = 2 * 16 * 28, U_WOUT = 2 * 16 * 16, U_SGU = 32, U_DFT = 256, U_ROPE = 1, U_EXP = 3 * 32 * 32;
constexpr int LDS_SIL = 0, LDS_RED = 20480, LDS_TILE = 32768, LDS_T64 = 49408, LDS_CTAB = 50176;

__device__ __forceinline__ void ada_unit(AP a, unsigned char* lds, int u) {
    float* sil = (float*)(lds + LDS_SIL); float* red = (float*)(lds + LDS_RED);
    const int tid = tid_opaque(), lane = tid & 63, w = tid >> 6;
    const int l = u / 96, cg = u % 96;
    for (int i = tid; i < 5120; i += NT) { const int r = i >> 10, k = i & 1023; const float v = (r < 4) ? a->in[1][r * 1024 + k] : a->in[3][k]; sil[i] = v / (1.0f + expf(-v)); }
    __syncthreads();
    const float* W = a->in[4] + (size_t)l * 1024 * 6144 + cg * 64 + lane;
    float acc[5] = {0.f, 0.f, 0.f, 0.f, 0.f};
#pragma unroll 32
    for (int k = w * 128; k < w * 128 + 128; ++k) { const float wv = W[(size_t)k * 6144];
#pragma unroll
        for (int r = 0; r < 5; ++r) acc[r] += sil[r * 1024 + k] * wv; }
#pragma unroll
    for (int r = 0; r < 5; ++r) red[(w * 5 + r) * 64 + lane] = acc[r];
    __syncthreads();
    if (tid < 320) { const int r = tid >> 6; float s = 0.f;
#pragma unroll
        for (int ww = 0; ww < 8; ++ww) s += red[(ww * 5 + r) * 64 + lane];
        const int j = cg * 64 + lane; ((float*)(a->ws + WS_MOD))[(size_t)(l * 5 + r) * 6144 + j] = s + a->in[5][l * 6144 + j]; }
    __syncthreads();
}

__device__ __forceinline__ void tile_store_T(const float* tile, bf16_t* dst, int ldd) {
    const int tid = tid_opaque(), n = tid >> 3, kc = tid & 7;
    u32x4 w;
    w.x = pack2(tile[(kc * 8 + 0) * 65 + n], tile[(kc * 8 + 1) * 65 + n]); w.y = pack2(tile[(kc * 8 + 2) * 65 + n], tile[(kc * 8 + 3) * 65 + n]);
    w.z = pack2(tile[(kc * 8 + 4) * 65 + n], tile[(kc * 8 + 5) * 65 + n]); w.w = pack2(tile[(kc * 8 + 6) * 65 + n], tile[(kc * 8 + 7) * 65 + n]);
    *(u32x4*)(dst + (size_t)n * ldd + kc * 8) = w;
}
__device__ __forceinline__ void tile_load(float* tile, const float* src, int lds_) {
    const int tid = tid_opaque();
#pragma unroll
    for (int i = 0; i < 2; ++i) { const int row = (tid >> 4) + 32 * i, c4 = (tid & 15) * 4; const f32x4 v = *(const f32x4*)(src + (size_t)row * lds_ + c4);
        tile[row * 65 + c4 + 0] = v[0]; tile[row * 65 + c4 + 1] = v[1]; tile[row * 65 + c4 + 2] = v[2]; tile[row * 65 + c4 + 3] = v[3]; }
}

__device__ __forceinline__ void win_unit(AP a, unsigned char* lds, int u) {
    float* tile = (float*)(lds + LDS_TILE); float* T = (float*)(lds + LDS_T64);
    const int tid = tid_opaque();
    const int l = u / 448, r = u % 448, kb = r / 28, nb = r % 28;
    const float* Win = a->in[6] + (size_t)l * 1024 * 1536;
    const int srccol = (nb >= 8) ? nb * 64 - 256 : (nb & 3) * 64;
    tile_load(tile, Win + (size_t)(kb * 64) * 1536 + srccol, 1536);
    if (nb < 8 && tid < 64) { T[tid] = cospif((float)tid / 32.0f); T[64 + tid] = sinpif((float)tid / 32.0f); }
    __syncthreads();
    bf16_t* dst = (bf16_t*)(a->ws + WS_WIN) + ((size_t)l * ZC + nb * 64) * 1024 + kb * 64;
    if (nb >= 8) tile_store_T(tile, dst, 1024);
    else {
        const int n = tid >> 3, kc = tid & 7, part = nb >> 2; float o[8];
#pragma unroll
        for (int e = 0; e < 8; ++e) { float s = 0.f;
#pragma unroll 4
            for (int c = 0; c < 64; ++c) s += tile[(kc * 8 + e) * 65 + c] * T[part * 64 + ((c * n) & 63)]; o[e] = (part ? -s : s) * 0.125f; }
        u32x4 w; w.x = pack2(o[0], o[1]); w.y = pack2(o[2], o[3]); w.z = pack2(o[4], o[5]); w.w = pack2(o[6], o[7]);
        *(u32x4*)(dst + (size_t)n * 1024 + kc * 8) = w;
    }
    __syncthreads();
}

__device__ __forceinline__ void wout_unit(AP a, unsigned char* lds, int u) {
    float* tile = (float*)(lds + LDS_TILE);
    const int tid = tid_opaque();
    const int l = u / 256, r = u % 256, kb = r / 16, nb = r % 16;
    const float* Wo = a->in[13] + (size_t)l * 1024 * 1024;
    const int n = tid & 63, kq = __builtin_amdgcn_readfirstlane(tid >> 6);
    if (kb < 4) {
        const float* wf = a->in[7] + (size_t)l * 256 * 256 + (size_t)(kb * 64 + kq * 8) * 256;
        float acc[8] = {0.f, 0.f, 0.f, 0.f, 0.f, 0.f, 0.f, 0.f};
#pragma unroll 16
        for (int j = 0; j < 256; ++j) { const float wv = Wo[(size_t)j * 1024 + nb * 64 + n];
#pragma unroll
            for (int e = 0; e < 8; ++e) acc[e] += wf[e * 256 + j] * wv; }
#pragma unroll
        for (int e = 0; e < 8; ++e) tile[(kq * 8 + e) * 65 + n] = acc[e];
    } else if (kb >= 8 && kb < 12) {
        const int g = kb - 8;
        const float* wp = a->in[9] + ((size_t)(l * 4 + g) * 64 + kq * 8) * 64;
        const float* ps = a->in[10] + l * 256 + g * 64;
        float acc[8] = {0.f, 0.f, 0.f, 0.f, 0.f, 0.f, 0.f, 0.f};
#pragma unroll 16
        for (int d = 0; d < 64; ++d) { const float wv = ps[d] * Wo[(size_t)(512 + g * 64 + d) * 1024 + nb * 64 + n];
#pragma unroll
            for (int e = 0; e < 8; ++e) acc[e] += wp[e * 64 + d] * wv; }
#pragma unroll
        for (int e = 0; e < 8; ++e) tile[(kq * 8 + e) * 65 + n] = acc[e];
    } else tile_load(tile, Wo + (size_t)(kb * 64) * 1024 + nb * 64, 1024);
    __syncthreads();
    tile_store_T(tile, (bf16_t*)(a->ws + WS_WOUT) + ((size_t)l * 1024 + nb * 64) * 1024 + kb * 64, 1024);
    __syncthreads();
}

__device__ __forceinline__ void exp_src_dst(AP a, int l, int u, const float*& src, int& srcld, bf16_t*& dst, int& dstld) {
    const int mat = u / 1024, e = (u % 1024) / 32, t = u % 32;
    const int kb = (mat < 2) ? t / 4 : t / 8, nb = (mat < 2) ? t % 4 : t % 8;
    srcld = (mat < 2) ? 512 : 1024; dstld = (mat < 2) ? 1024 : 512;
    src = a->in[18 + mat] + ((size_t)(l * 32 + e) * 512 * 1024) + (size_t)(kb * 128) * srcld + nb * 128;
    dst = (bf16_t*)(a->ws + WS_WEXP) + (size_t)mat * EXPMAT + (size_t)e * 512 * 1024 + (size_t)(nb * 128) * dstld + kb * 128;
}
__device__ __forceinline__ void exp_range(AP a, unsigned char* lds, int l, int u0) {
    float* tile = (float*)lds;
    const int tid = tid_opaque(), G = gridDim.x;
    __syncthreads();
    if (u0 >= U_EXP) return;
    const float* src; bf16_t* dst; int srcld, dstld;
    exp_src_dst(a, l, u0, src, srcld, dst, dstld);
    f32x4 v[8];
#pragma unroll
    for (int i = 0; i < 8; ++i) v[i] = *(const f32x4*)(src + (size_t)((tid >> 5) + 16 * i) * srcld + (tid & 31) * 4);
    for (int u = u0; u < U_EXP; u += G) {
#pragma unroll
        for (int i = 0; i < 8; ++i) { float* tp = tile + ((tid >> 5) + 16 * i) * 129 + (tid & 31) * 4; tp[0] = v[i][0]; tp[1] = v[i][1]; tp[2] = v[i][2]; tp[3] = v[i][3]; }
        __syncthreads();
        bf16_t* cdst = dst; const int cdstld = dstld;
        if (u + G < U_EXP) { exp_src_dst(a, l, u + G, src, srcld, dst, dstld);
#pragma unroll
            for (int i = 0; i < 8; ++i) v[i] = *(const f32x4*)(src + (size_t)((tid >> 5) + 16 * i) * srcld + (tid & 31) * 4); }
        const int n = tid >> 2, kq = tid & 3;
#pragma unroll
        for (int j = 0; j < 4; ++j) { const float* tp = tile + (kq * 32 + j * 8) * 129 + n; u32x4 w;
            w.x = pack2(tp[0], tp[129]); w.y = pack2(tp[2 * 129], tp[3 * 129]); w.z = pack2(tp[4 * 129], tp[5 * 129]); w.w = pack2(tp[6 * 129], tp[7 * 129]);
            *(u32x4*)(cdst + (size_t)n * cdstld + kq * 32 + j * 8) = w; }
        __syncthreads();
    }
}

__device__ __forceinline__ void p0_prologue(AP a, unsigned char* lds) {
    const int tid = tid_opaque();
    bool have_tab = false;
    constexpr int E0 = U_ADA, E1 = E0 + U_WIN, E2 = E1 + U_WOUT, E3 = E2 + U_SGU, E4 = E3 + U_DFT, E5 = E4 + U_ROPE;
    int u = blockIdx.x;
    for (; u < E5; u += gridDim.x) {
        if (u < E0) ada_unit(a, lds, u);
        else if (u < E1) win_unit(a, lds, u - E0);
        else if (u < E2) wout_unit(a, lds, u - E1);
        else if (u < E3) { const size_t i0 = (size_t)(u - E2) * 4096 + tid * 8; const float* s = a->in[11] + i0; bf16_t* d = (bf16_t*)(a->ws + WS_WSGU) + i0;
            const f32x4 v0 = *(const f32x4*)s, v1 = *(const f32x4*)(s + 4); u32x4 w; w.x = pack2(v0[0], v0[1]); w.y = pack2(v0[2], v0[3]); w.z = pack2(v1[0], v1[1]); w.w = pack2(v1[2], v1[3]); *(u32x4*)d = w; }
        else if (u < E4) {
            float* ctab = (float*)(lds + LDS_CTAB);
            if (!have_tab) { for (int i = tid; i < 4096; i += NT) ctab[i] = cospif((float)i / 2048.0f); __syncthreads(); have_tab = true; }
            const int k = u - E3 + 4096;
            if (tid < 32) {
                const int kk = k - 4096, n0 = tid * 8; float c[8], s[8];
#pragma unroll
                for (int e = 0; e < 8; ++e) { const int idx = ((kk * (n0 + e)) & 255) * 16; c[e] = ctab[idx] * (1.0f / 16.0f); s[e] = ctab[(idx - 1024) & 4095] * (1.0f / 16.0f); }
                bf16_t* d = (bf16_t*)(a->ws + WS_DFTC) + (size_t)kk * 512 + n0;
                u32x4 w; w.x = pack2(c[0], c[1]); w.y = pack2(c[2], c[3]); w.z = pack2(c[4], c[5]); w.w = pack2(c[6], c[7]); *(u32x4*)d = w;
                w.x = pack2(s[0], s[1]); w.y = pack2(s[2], s[3]); w.z = pack2(s[4], s[5]); w.w = pack2(s[6], s[7]); *(u32x4*)(d + 256) = w;
            }
        }
        else {
            for (int i = tid; i < 1024; i += NT) { const int pos = i >> 4, f = i & 15; const float freq = powf(10000.0f, -(float)f / 16.0f); const float ang = (float)pos * freq;
                ((float2*)(a->ws + WS_ROPE))[i] = make_float2(cosf(ang), sinf(ang)); }
        }
    }
    exp_range(a, lds, 0, u - E5);
}

__device__ __forceinline__ void p_lnmod0(AP a) {
    const int tid = tid_opaque(), lane = tid & 63, w = tid >> 6;
    const float* mod = (const float*)(a->ws + WS_MOD);
    bf16_t* H = (bf16_t*)(a->ws + WS_H);
    for (int t = blockIdx.x * 8 + w; t < NTOK; t += gridDim.x * 8) {
        const float* src = (t < NLAT) ? a->in[0] + (size_t)t * D : a->in[2] + (size_t)(t - NLAT) * D;
        const float* m = mod + (size_t)((t < NLAT) ? (t >> 12) : 4) * 6144;
        f32x4 v[4];
#pragma unroll
        for (int i = 0; i < 4; ++i) v[i] = *(const f32x4*)(src + 256 * i + 4 * lane);
        float mean, rstd; ln_stats(v, mean, rstd);
#pragma unroll
        for (int i = 0; i < 4; ++i) { const int c = 256 * i + 4 * lane; const f32x4 sh = *(const f32x4*)(m + c), sc = *(const f32x4*)(m + 1024 + c);
            f32x4 o;
#pragma unroll
            for (int e = 0; e < 4; ++e) o[e] = (v[i][e] - mean) * rstd * (1.0f + sc[e]) + sh[e];
            u32x2 pk; pk.x = pack2(o[0], o[1]); pk.y = pack2(o[2], o[3]); *(u32x2*)(H + (size_t)t * D + c) = pk; }
    }
}

__device__ __forceinline__ void p1_inproj(AP a, LAS unsigned char* lds, int l);
__device__ __forceinline__ void rope32(float (&t)[32], const float2* tab) {
#pragma unroll
    for (int f = 0; f < 16; ++f) { const float2 cs = tab[f]; const float t1 = t[f], t2 = t[16 + f]; t[f] = t1 * cs.x - t2 * cs.y; t[16 + f] = t1 * cs.y + t2 * cs.x; }
}
__device__ __forceinline__ void load32(float (&t)[32], const bf16_t* p) {
#pragma unroll
    for (int q = 0; q < 4; ++q) { const u32x4 w = *(const u32x4*)(p + 8 * q);
        t[8 * q + 0] = lo2f(w.x); t[8 * q + 1] = hi2f(w.x); t[8 * q + 2] = lo2f(w.y); t[8 * q + 3] = hi2f(w.y);
        t[8 * q + 4] = lo2f(w.z); t[8 * q + 5] = hi2f(w.z); t[8 * q + 6] = lo2f(w.w); t[8 * q + 7] = hi2f(w.w); }
}

__device__ __forceinline__ float kdot(const bf16_t* kp, const bf16_t* q, const float2* tab0, const float2* tab1, bool do_rope) {
    float dot = 0.f;
#pragma unroll 1
    for (int ax = 0; ax < 2; ++ax) {
        const float2* tab = ax ? tab1 : tab0;
#pragma unroll 1
        for (int h8 = 0; h8 < 2; ++h8) {
            const u32x4 wl = *(const u32x4*)(kp + ax * 32 + h8 * 8), wh = *(const u32x4*)(kp + ax * 32 + 16 + h8 * 8);
            const float tl[8] = {lo2f(wl.x), hi2f(wl.x), lo2f(wl.y), hi2f(wl.y), lo2f(wl.z), hi2f(wl.z), lo2f(wl.w), hi2f(wl.w)};
            const float th[8] = {lo2f(wh.x), hi2f(wh.x), lo2f(wh.y), hi2f(wh.y), lo2f(wh.z), hi2f(wh.z), lo2f(wh.w), hi2f(wh.w)};
#pragma unroll
            for (int j = 0; j < 8; ++j) {
                float r1 = tl[j], r2 = th[j];
                if (do_rope) { const float2 cs = tab[h8 * 8 + j]; r1 = tl[j] * cs.x - th[j] * cs.y; r2 = tl[j] * cs.y + th[j] * cs.x; }
                dot += bf2f(q[ax * 32 + h8 * 8 + j]) * r1 + bf2f(q[ax * 32 + 16 + h8 * 8 + j]) * r2;
            }
        }
    }
    return dot;
}

__device__ __forceinline__ void mixer_tile(AP a, unsigned char* lds, int l, int row0, int seq_row0, int pos0, int n, int b, bool is_ctx) {
    const int tid = tid_opaque(), lane = tid & 63, w = tid >> 6;
    const bf16_t* Z = (const bf16_t*)(a->ws + WS_Z);
    bf16_t* CAT = (bf16_t*)(a->ws + WS_CAT);
    {
        const int c = tid & 255, half = tid >> 8, g = c >> 6, hw = 1 << g;
        for (int tl = half * 64; tl < half * 64 + 64; ++tl) {
            const int pos = pos0 + tl; const int lo = max(pos - hw, 0), hi = min(pos + hw, n);
            float s = 0.f; for (int j = lo; j < hi; ++j) s += bf2f(Z[(size_t)(seq_row0 + j) * ZC + 1024 + c]);
            const float self = bf2f(Z[(size_t)(seq_row0 + pos) * ZC + 1024 + c]);
            CAT[(size_t)(row0 + tl) * D + 512 + c] = f2bf(s / (float)(hi - lo) - self);
        }
    }
    bf16_t* vT = (bf16_t*)lds;
    for (int q = w; q < 128; q += 8) {
        const u32x2 gw = *(const u32x2*)(Z + (size_t)(row0 + q) * ZC + 1536 + 4 * lane);
        float gv[4] = {gelu_erf(lo2f(gw.x)), gelu_erf(hi2f(gw.x)), gelu_erf(lo2f(gw.y)), gelu_erf(hi2f(gw.y))};
        float s = wave_sum((gv[0] + gv[1]) + (gv[2] + gv[3])); const float mean = s * (1.0f / 256.0f);
        float qq = 0.f;
#pragma unroll
        for (int e = 0; e < 4; ++e) { const float d = gv[e] - mean; qq += d * d; }
        qq = wave_sum(qq); const float rstd = 1.0f / sqrtf(qq * (1.0f / 256.0f) + 1e-6f);
#pragma unroll
        for (int e = 0; e < 4; ++e) vT[(4 * lane + e) * 128 + q] = f2bf((gv[e] - mean) * rstd);
    }
    __syncthreads();
    {
        const int c = tid & 255, ph = tid >> 8, h = c >> 6;
        const bf16_t* Ws = (const bf16_t*)(a->ws + WS_WSGU) + (size_t)(l * 4 + h) * 128 * 128;
        const float* bs = a->in[12] + (size_t)(l * 4 + h) * 128;
        for (int p = ph * 64; p < ph * 64 + 64; ++p) {
            float s = 0.f;
#pragma unroll 2
            for (int q8 = 0; q8 < 16; ++q8) {
                const u32x4 ww = *(const u32x4*)(Ws + (size_t)p * 128 + q8 * 8);
                const u32x4 vv = *(const u32x4*)(vT + c * 128 + q8 * 8);
                s += lo2f(ww.x) * lo2f(vv.x) + hi2f(ww.x) * hi2f(vv.x) + lo2f(ww.y) * lo2f(vv.y) + hi2f(ww.y) * hi2f(vv.y)
                   + lo2f(ww.z) * lo2f(vv.z) + hi2f(ww.z) * hi2f(vv.z) + lo2f(ww.w) * lo2f(vv.w) + hi2f(ww.w) * hi2f(vv.w);
            }
            const float uv = gelu_erf(bf2f(Z[(size_t)(row0 + p) * ZC + 1280 + c]));
            CAT[(size_t)(row0 + p) * D + 768 + c] = f2bf(uv * (s + bs[p]));
        }
    }
    __syncthreads();
    {
        const int i = tid & 127, h = tid >> 7, kvh = h >> 1;
        const float2* rope = (const float2*)(a->ws + WS_ROPE);
        const int qpos = pos0 + i;
        bf16_t* q = (bf16_t*)lds + tid * 66;
        {
            float t0[32];
            load32(t0, Z + (size_t)(row0 + i) * ZC + 512 + h * 64);
            if (!is_ctx) rope32(t0, rope + (qpos >> 6) * 16);
#pragma unroll
            for (int d = 0; d < 32; ++d) q[d] = f2bf(t0[d]);
            load32(t0, Z + (size_t)(row0 + i) * ZC + 512 + h * 64 + 32);
            if (!is_ctx) rope32(t0, rope + (qpos & 63) * 16);
#pragma unroll
            for (int d = 0; d < 32; ++d) q[32 + d] = f2bf(t0[d]);
        }
#pragma unroll 1
        for (int dh = 0; dh < 2; ++dh) {
        float m = a->in[8][l * 4 + h], den = 1.0f;
        float o[32];
#pragma unroll
        for (int d = 0; d < 32; ++d) o[d] = 0.f;
        if (!is_ctx) {
            const bf16_t* VT = (const bf16_t*)(a->ws + WS_VT) + ((size_t)(b * 2 + kvh) * 64 + dh * 32) * 4096;
            const int slo = max(qpos - 128, 0), shi = min(qpos + 128, n - 1);
#pragma unroll 1
            for (int s = slo; s <= shi; ++s) {
                const float dot = 0.125f * kdot(Z + (size_t)(seq_row0 + s) * ZC + 768 + kvh * 64, q, rope + (s >> 6) * 16, rope + (s & 63) * 16, true);
                const float mn = fmaxf(m, dot), corr = __expf(m - mn), p = __expf(dot - mn);
                den = den * corr + p; m = mn;
#pragma unroll
                for (int d = 0; d < 32; ++d) o[d] = o[d] * corr + p * bf2f(VT[(size_t)d * 4096 + s]);
            }
        }
        {
            const bf16_t* VTC = (const bf16_t*)(a->ws + WS_VTC) + ((size_t)(b * 2 + kvh) * 64 + dh * 32) * 256;
#pragma unroll 1
            for (int j = 0; j < 256; ++j) {
                const float dot = 0.125f * kdot(Z + (size_t)(NLAT + b * 256 + j) * ZC + 768 + kvh * 64, q, rope, rope, false);
                const float mn = fmaxf(m, dot), corr = __expf(m - mn), p = __expf(dot - mn);
                den = den * corr + p; m = mn;
#pragma unroll
                for (int d = 0; d < 32; ++d) o[d] = o[d] * corr + p * bf2f(VTC[(size_t)d * 256 + j]);
            }
        }
        const float inv = 1.0f / den;
        bf16_t* dst = CAT + (size_t)(row0 + i) * D + 256 + h * 64 + dh * 32;
#pragma unroll
        for (int d8 = 0; d8 < 4; ++d8) { u32x4 pk; pk.x = pack2(o[8 * d8] * inv, o[8 * d8 + 1] * inv); pk.y = pack2(o[8 * d8 + 2] * inv, o[8 * d8 + 3] * inv);
            pk.z = pack2(o[8 * d8 + 4] * inv, o[8 * d8 + 5] * inv); pk.w = pack2(o[8 * d8 + 6] * inv, o[8 * d8 + 7] * inv); *(u32x4*)(dst + 8 * d8) = pk; }
        }
    }
    __syncthreads();
}

__device__ __forceinline__ u32x4 ld16g(const bf16_t* p) { return *(const u32x4*)p; }
__device__ __forceinline__ void rope_pack8(u32x4& wl, u32x4& wh, const float2* tab, bool do_rope, float scale) {
    float tl[8] = {lo2f(wl.x), hi2f(wl.x), lo2f(wl.y), hi2f(wl.y), lo2f(wl.z), hi2f(wl.z), lo2f(wl.w), hi2f(wl.w)};
    float th[8] = {lo2f(wh.x), hi2f(wh.x), lo2f(wh.y), hi2f(wh.y), lo2f(wh.z), hi2f(wh.z), lo2f(wh.w), hi2f(wh.w)};
#pragma unroll
    for (int j = 0; j < 8; ++j) {
        float r1 = tl[j], r2 = th[j];
        if (do_rope) { const float2 cs = tab[j]; r1 = tl[j] * cs.x - th[j] * cs.y; r2 = tl[j] * cs.y + th[j] * cs.x; }
        tl[j] = r1 * scale; th[j] = r2 * scale;
    }
    wl.x = pack2(tl[0], tl[1]); wl.y = pack2(tl[2], tl[3]); wl.z = pack2(tl[4], tl[5]); wl.w = pack2(tl[6], tl[7]);
    wh.x = pack2(th[0], th[1]); wh.y = pack2(th[2], th[3]); wh.z = pack2(th[4], th[5]); wh.w = pack2(th[6], th[7]);
}

__device__ __forceinline__ void mixer_tile_fast(AP a, LAS unsigned char* lds, int l, int row0, int seq_row0, int pos0, int n, int b, bool is_ctx) {
    const int tid = tid_opaque(), lane = tid & 63, w = __builtin_amdgcn_readfirstlane(tid >> 6), fr = lane & 15, g = lane >> 4;
    const bf16_t* Z = (const bf16_t*)(a->ws + WS_Z);
    bf16_t* CAT = (bf16_t*)(a->ws + WS_CAT);
    {
#pragma unroll
        for (int it = 0; it < 9; ++it) { const int id = tid + 512 * it, rr = id >> 5, ch = id & 31, j = pos0 - 8 + rr;
            u32x4 v = (u32x4){0u, 0u, 0u, 0u};
            if (j >= 0 && j < n) v = ld16g(Z + (size_t)(seq_row0 + j) * ZC + 1024 + ch * 8);
            *(LAS u32x4*)(lds + rr * 512 + ch * 16) = v; }
        __syncthreads();
        const int c = tid & 255, half = tid >> 8, hw = 1 << (c >> 6);
        const LAS bf16_t* P = (const LAS bf16_t*)lds + c;
        const int t0 = half * 64;
        float s = 0.f;
        for (int j = t0 - hw; j < t0 + hw; ++j) s += bf2f(P[(8 + j) * 256]);
        for (int tl = t0; tl < t0 + 64; ++tl) {
            const int pos = pos0 + tl; const int lo = max(pos - hw, 0), hi = min(pos + hw, n);
            CAT[(size_t)(row0 + tl) * D + 512 + c] = f2bf(s / (float)(hi - lo) - bf2f(P[(8 + tl) * 256]));
            s += bf2f(P[(8 + tl + hw) * 256]) - bf2f(P[(8 + tl - hw) * 256]);
        }
        __syncthreads();
    }
    {
        const int i16 = lane & 15;
        u32x4 gw[4][2];
#pragma unroll
        for (int ps = 0; ps < 4; ++ps) { const int q = w * 16 + ps * 4 + g; const bf16_t* src = Z + (size_t)(row0 + q) * ZC + 1536 + 16 * i16; gw[ps][0] = ld16g(src); gw[ps][1] = ld16g(src + 8); }
#pragma unroll
        for (int ps = 0; ps < 4; ++ps) {
            const int q = w * 16 + ps * 4 + g;
            float gv[16];
#pragma unroll
            for (int hh = 0; hh < 2; ++hh) { const u32x4 x = gw[ps][hh];
                gv[8 * hh + 0] = gelu_erf(lo2f(x.x)); gv[8 * hh + 1] = gelu_erf(hi2f(x.x)); gv[8 * hh + 2] = gelu_erf(lo2f(x.y)); gv[8 * hh + 3] = gelu_erf(hi2f(x.y));
                gv[8 * hh + 4] = gelu_erf(lo2f(x.z)); gv[8 * hh + 5] = gelu_erf(hi2f(x.z)); gv[8 * hh + 6] = gelu_erf(lo2f(x.w)); gv[8 * hh + 7] = gelu_erf(hi2f(x.w)); }
            float sm = 0.f;
#pragma unroll
            for (int e = 0; e < 16; ++e) sm += gv[e];
            const float mean = row_sum16(sm) * (1.0f / 256.0f);
            float qq = 0.f;
#pragma unroll
            for (int e = 0; e < 16; ++e) { const float d = gv[e] - mean; qq += d * d; }
            const float rstd = 1.0f / sqrtf(row_sum16(qq) * (1.0f / 256.0f) + 1e-6f);
#pragma unroll
            for (int e = 0; e < 16; ++e) { const int c = 16 * i16 + e; *(LAS bf16_t*)(lds + c * 256 + ((((q >> 3) ^ (c & 15))) << 4) + (q & 7) * 2) = f2bf((gv[e] - mean) * rstd); }
        }
    }
    __syncthreads();
    {
        const int h = w >> 1, ph = w & 1;
        const bf16_t* Ws = (const bf16_t*)(a->ws + WS_WSGU) + (size_t)(l * 4 + h) * 128 * 128;
        const float* bs = a->in[12] + (size_t)(l * 4 + h) * 128;
        f32x4 acc[4][4];
#pragma unroll
        for (int i = 0; i < 4; ++i)
#pragma unroll
            for (int j = 0; j < 4; ++j) acc[i][j] = (f32x4){0.f, 0.f, 0.f, 0.f};
#pragma unroll
        for (int ks = 0; ks < 4; ++ks) {
            bf16x8 af[4], bfv[4];
#pragma unroll
            for (int cf = 0; cf < 4; ++cf) { const int c = h * 64 + 16 * cf + fr; af[cf] = *(const LAS bf16x8*)(lds + c * 256 + (((4 * ks + g) ^ (c & 15)) << 4)); }
#pragma unroll
            for (int pf = 0; pf < 4; ++pf) { const int p = ph * 64 + 16 * pf + fr; bfv[pf] = *(const bf16x8*)(Ws + (size_t)p * 128 + 32 * ks + 8 * g); }
#pragma unroll
            for (int cf = 0; cf < 4; ++cf)
#pragma unroll
                for (int pf = 0; pf < 4; ++pf) acc[cf][pf] = __builtin_amdgcn_mfma_f32_16x16x32_bf16(af[cf], bfv[pf], acc[cf][pf], 0, 0, 0);
        }
#pragma unroll
        for (int pf = 0; pf < 4; ++pf) { const int p = ph * 64 + 16 * pf + fr; const float bias = bs[p];
#pragma unroll
            for (int cf = 0; cf < 4; ++cf) { const int c0 = h * 64 + 16 * cf + 4 * g;
                const u32x2 uw = *(const u32x2*)(Z + (size_t)(row0 + p) * ZC + 1280 + c0);
                u32x2 o; o.x = pack2(gelu_erf(lo2f(uw.x)) * (acc[cf][pf][0] + bias), gelu_erf(hi2f(uw.x)) * (acc[cf][pf][1] + bias));
                o.y = pack2(gelu_erf(lo2f(uw.y)) * (acc[cf][pf][2] + bias), gelu_erf(hi2f(uw.y)) * (acc[cf][pf][3] + bias));
                *(u32x2*)(CAT + (size_t)(row0 + p) * D + 768 + c0) = o; } }
    }
    const float2* rope = (const float2*)(a->ws + WS_ROPE);
    constexpr float QS = 0.125f * 1.44269504088896341f;
    constexpr int QS_OFF = 0, KS_OFF = 32768, VS_OFF = 49152;
    const int nbq = pos0 >> 7;
#pragma unroll 1
    for (int kvh = 0; kvh < 2; ++kvh) {
        __syncthreads();
#pragma unroll
        for (int it = 0; it < 2; ++it) {
            const int item = tid + 512 * it, r = item >> 2, ax = (item >> 1) & 1, h8 = item & 1, i = r & 127, qpos = pos0 + i;
            const bf16_t* src = Z + (size_t)(row0 + i) * ZC + 512 + (2 * kvh + (r >> 7)) * 64 + ax * 32 + h8 * 8;
            u32x4 wl = ld16g(src), wh = ld16g(src + 16);
            rope_pack8(wl, wh, rope + (ax ? (qpos & 63) : (qpos >> 6)) * 16 + h8 * 8, !is_ctx, QS);
            const int ch = ax * 4 + h8, sw = (r >> 1) & 7;
            *(LAS u32x4*)(lds + QS_OFF + r * 128 + ((ch ^ sw) << 4)) = wl;
            *(LAS u32x4*)(lds + QS_OFF + r * 128 + (((ch + 2) ^ sw) << 4)) = wh;
        }
        const int hh = w >> 2, qb = (w & 3) * 32, h = 2 * kvh + hh;
        float m[2], lsum[2];
        m[0] = m[1] = a->in[8][l * 4 + h] * 1.44269504088896341f;
        lsum[0] = lsum[1] = (g == 0) ? 1.0f : 0.0f;
        f32x4 O[4][2];
#pragma unroll
        for (int i = 0; i < 4; ++i) { O[i][0] = (f32x4){0.f, 0.f, 0.f, 0.f}; O[i][1] = (f32x4){0.f, 0.f, 0.f, 0.f}; }
        bf16x8 Qf[2][2];
        bool have_q = false;
#pragma unroll 1
        for (int blk = 0; blk < 5; ++blk) {
            const int jb = blk - 1;
            const bool band = blk < 3;
            if (band && (is_ctx || nbq + jb < 0 || nbq + jb >= (n >> 7))) continue;
            const int key0 = band ? (nbq + jb) * 128 : (blk - 3) * 128;
            const int krow0 = band ? seq_row0 + key0 : NLAT + b * 256 + key0;
            {
                const int r = tid >> 2, ax = (tid >> 1) & 1, h8 = tid & 1, kpos = key0 + r;
                const bf16_t* src = Z + (size_t)(krow0 + r) * ZC + 768 + kvh * 64 + ax * 32 + h8 * 8;
                u32x4 wl = ld16g(src), wh = ld16g(src + 16);
                rope_pack8(wl, wh, rope + (ax ? (kpos & 63) : (kpos >> 6)) * 16 + h8 * 8, band, 1.0f);
                const int ch = ax * 4 + h8, sw = (r >> 1) & 7;
                *(LAS u32x4*)(lds + KS_OFF + r * 128 + ((ch ^ sw) << 4)) = wl;
                *(LAS u32x4*)(lds + KS_OFF + r * 128 + (((ch + 2) ^ sw) << 4)) = wh;
            }
            {
                const bf16_t* vsrc = band ? (const bf16_t*)(a->ws + WS_VT) + (size_t)(b * 2 + kvh) * 64 * 4096 + key0 : (const bf16_t*)(a->ws + WS_VTC) + (size_t)(b * 2 + kvh) * 64 * 256 + key0;
                const int vld = band ? 4096 : 256;
#pragma unroll
                for (int i = 0; i < 2; ++i) { const int P = i * 512 + tid, d = P >> 4, c = (P & 15) ^ (d & 15);
                    glds16(vsrc + (size_t)d * vld + c * 8, lds + VS_OFF + i * 8192 + w * 1024); }
            }
            asm volatile("s_waitcnt vmcnt(0)" ::: "memory");
            __syncthreads();
            if (!have_q) {
#pragma unroll
                for (int qf = 0; qf < 2; ++qf)
#pragma unroll
                    for (int ks = 0; ks < 2; ++ks) { const int r = hh * 128 + qb + 16 * qf + fr; Qf[qf][ks] = *(const LAS bf16x8*)(lds + QS_OFF + r * 128 + (((4 * ks + g) ^ ((r >> 1) & 7)) << 4)); }
                have_q = true;
            }
            f32x4 S[8][2];
#pragma unroll
            for (int kf = 0; kf < 8; ++kf) { S[kf][0] = (f32x4){0.f, 0.f, 0.f, 0.f}; S[kf][1] = (f32x4){0.f, 0.f, 0.f, 0.f}; }
#pragma unroll
            for (int kf = 0; kf < 8; ++kf)
#pragma unroll
                for (int ks = 0; ks < 2; ++ks) { const int r = 16 * kf + fr;
                    const bf16x8 kfr = *(const LAS bf16x8*)(lds + KS_OFF + r * 128 + (((4 * ks + g) ^ ((r >> 1) & 7)) << 4));
                    S[kf][0] = __builtin_amdgcn_mfma_f32_16x16x32_bf16(kfr, Qf[0][ks], S[kf][0], 0, 0, 0);
                    S[kf][1] = __builtin_amdgcn_mfma_f32_16x16x32_bf16(kfr, Qf[1][ks], S[kf][1], 0, 0, 0); }
            bf16x8 Pp[4][2];
#pragma unroll
            for (int qf = 0; qf < 2; ++qf) {
                const int qi = qb + 16 * qf + fr;
                if (band && jb != 0) {
#pragma unroll
                    for (int kf = 0; kf < 8; ++kf)
#pragma unroll
                        for (int r = 0; r < 4; ++r) { const int kk = 16 * kf + 4 * g + r; const bool ok = (jb < 0) ? (kk >= qi) : (kk <= qi); if (!ok) S[kf][qf][r] = -1.0e30f; }
                }
                float mx = S[0][qf][0];
#pragma unroll
                for (int kf = 0; kf < 8; ++kf)
#pragma unroll
                    for (int r = 0; r < 4; ++r) mx = fmaxf(mx, S[kf][qf][r]);
                mx = fmaxf(mx, __shfl_xor(mx, 16)); mx = fmaxf(mx, __shfl_xor(mx, 32));
                const float mn = fmaxf(m[qf], mx), corr = __builtin_amdgcn_exp2f(m[qf] - mn);
                m[qf] = mn;
                float ps = 0.f;
#pragma unroll
                for (int kf = 0; kf < 8; ++kf)
#pragma unroll
                    for (int r = 0; r < 4; ++r) { const float p = __builtin_amdgcn_exp2f(S[kf][qf][r] - mn); S[kf][qf][r] = p; ps += p; }
                lsum[qf] = lsum[qf] * corr + ps;
#pragma unroll
                for (int df = 0; df < 4; ++df) O[df][qf] *= corr;
#pragma unroll
                for (int t = 0; t < 4; ++t) { u32x4 pw; pw.x = pack2(S[2 * t][qf][0], S[2 * t][qf][1]); pw.y = pack2(S[2 * t][qf][2], S[2 * t][qf][3]);
                    pw.z = pack2(S[2 * t + 1][qf][0], S[2 * t + 1][qf][1]); pw.w = pack2(S[2 * t + 1][qf][2], S[2 * t + 1][qf][3]); Pp[t][qf] = __builtin_bit_cast(bf16x8, pw); }
            }
#pragma unroll
            for (int t = 0; t < 4; ++t)
#pragma unroll
                for (int df = 0; df < 4; ++df) { const int d = 16 * df + fr;
                    const u32x2 v0 = *(const LAS u32x2*)(lds + VS_OFF + d * 256 + (((4 * t + (g >> 1)) ^ (d & 15)) << 4) + (g & 1) * 8);
                    const u32x2 v1 = *(const LAS u32x2*)(lds + VS_OFF + d * 256 + (((4 * t + 2 + (g >> 1)) ^ (d & 15)) << 4) + (g & 1) * 8);
                    u32x4 vw; vw.x = v0.x; vw.y = v0.y; vw.z = v1.x; vw.w = v1.y; const bf16x8 vf = __builtin_bit_cast(bf16x8, vw);
                    O[df][0] = __builtin_amdgcn_mfma_f32_16x16x32_bf16(vf, Pp[t][0], O[df][0], 0, 0, 0);
                    O[df][1] = __builtin_amdgcn_mfma_f32_16x16x32_bf16(vf, Pp[t][1], O[df][1], 0, 0, 0); }
            __syncthreads();
        }
#pragma unroll
        for (int qf = 0; qf < 2; ++qf) {
            float lt = lsum[qf]; lt += __shfl_xor(lt, 16); lt += __shfl_xor(lt, 32);
            const float inv = 1.0f / lt;
            bf16_t* dst = CAT + (size_t)(row0 + qb + 16 * qf + fr) * D + 256 + h * 64 + 4 * g;
#pragma unroll
            for (int df = 0; df < 4; ++df) { u32x2 o; o.x = pack2(O[df][qf][0] * inv, O[df][qf][1] * inv); o.y = pack2(O[df][qf][2] * inv, O[df][qf][3] * inv); *(u32x2*)(dst + 16 * df) = o; }
        }
    }
    __syncthreads();
}

constexpr int FF_DA = 0, FF_DC = 32768, FF_TW = 49152, FF_XT = 65536, FF_Z2 = 81920, FF_OB = 98304;
__device__ __forceinline__ int ff_addr(int row, int k) { return row * 256 + ((((k >> 3) ^ (row & 15))) << 4) + (k & 7) * 2; }
__device__ __forceinline__ void fft_setup(LAS unsigned char* lds) {
    const int tid = tid_opaque();
    LAS float* TW = (LAS float*)(lds + FF_TW);
    for (int i = tid; i < 4096; i += NT) TW[i] = cospif((float)i / 2048.0f);
    __syncthreads();
    for (int idx = tid; idx < 16384; idx += NT) { const int i = idx >> 7, k = idx & 127, ro = i >> 6, k1 = i & 63, part = k >> 6, n1 = k & 63, j = ((k1 * n1) & 63) * 64;
        const float c = TW[j], sn = TW[(j - 1024) & 4095];
        const float v = (ro == 0) ? (part == 0 ? c : sn) : (part == 0 ? -sn : c);
        *(LAS bf16_t*)(lds + FF_DA + ff_addr(i, k)) = f2bf(v * 0.125f); }
    for (int idx = tid; idx < 8192; idx += NT) { const int k2 = idx >> 7, k = idx & 127, ri = k >> 6, n2 = k & 63, j = ((k2 * n2) & 63) * 64;
        const float v = (ri == 0) ? TW[j] : TW[(j - 1024) & 4095];
        *(LAS bf16_t*)(lds + FF_DC + ff_addr(k2, k)) = f2bf(v * 0.125f); }
    __syncthreads();
}
__device__ __forceinline__ void fft_unit(AP a, LAS unsigned char* lds, int b, int cg) {
    const int tid = tid_opaque(), lane = tid & 63, w = __builtin_amdgcn_readfirstlane(tid >> 6), fr = lane & 15, g = lane >> 4;
    const LAS float* TW = (const LAS float*)(lds + FF_TW);
    const int mf = w & 3, nh = w >> 2;
    const bf16_t* AT = (const bf16_t*)(a->ws + WS_AT) + (size_t)(b * 256 + cg * 4) * 8192;
    u32x4 xin[2];
#pragma unroll
    for (int it = 0; it < 2; ++it) xin[it] = ld16g(AT + (size_t)(tid + 512 * it) * 8);
#pragma unroll 1
    for (int cl = 0; cl < 4; ++cl) {
#pragma unroll
        for (int it = 0; it < 2; ++it) { const int q = tid + 512 * it, part = q >> 9, pos0 = (q & 511) * 8, n1 = pos0 >> 6, n2 = pos0 & 63, k = part * 64 + n1;
            const unsigned wv[4] = {xin[it].x, xin[it].y, xin[it].z, xin[it].w};
#pragma unroll
            for (int e = 0; e < 4; ++e) { *(LAS bf16_t*)(lds + FF_XT + ff_addr(n2 + 2 * e, k)) = (bf16_t)(wv[e] & 0xffffu); *(LAS bf16_t*)(lds + FF_XT + ff_addr(n2 + 2 * e + 1, k)) = (bf16_t)(wv[e] >> 16); } }
        if (cl < 3) {
#pragma unroll
            for (int it = 0; it < 2; ++it) xin[it] = ld16g(AT + (size_t)(cl + 1) * 8192 + (size_t)(tid + 512 * it) * 8); }
        __syncthreads();
        f32x4 acc[2][2];
#pragma unroll
        for (int x = 0; x < 2; ++x) { acc[x][0] = (f32x4){0.f, 0.f, 0.f, 0.f}; acc[x][1] = (f32x4){0.f, 0.f, 0.f, 0.f}; }
#pragma unroll
        for (int ks = 0; ks < 4; ++ks) {
            bf16x8 af[2], bfv[2];
#pragma unroll
            for (int x = 0; x < 2; ++x) { const int i = 16 * (mf + 4 * x) + fr; af[x] = *(const LAS bf16x8*)(lds + FF_DA + i * 256 + (((4 * ks + g) ^ (i & 15)) << 4)); }
#pragma unroll
            for (int n = 0; n < 2; ++n) { const int j = 16 * (2 * nh + n) + fr; bfv[n] = *(const LAS bf16x8*)(lds + FF_XT + j * 256 + (((4 * ks + g) ^ (j & 15)) << 4)); }
#pragma unroll
            for (int x = 0; x < 2; ++x)
#pragma unroll
                for (int n = 0; n < 2; ++n) acc[x][n] = __builtin_amdgcn_mfma_f32_16x16x32_bf16(af[x], bfv[n], acc[x][n], 0, 0, 0);
        }
#pragma unroll
        for (int n = 0; n < 2; ++n)
#pragma unroll
            for (int r = 0; r < 4; ++r) { const int k1 = 16 * mf + 4 * g + r, n2 = 16 * (2 * nh + n) + fr, idx = (k1 * n2) & 4095;
                const float c = TW[idx], sn = TW[(idx - 1024) & 4095], zr = acc[0][n][r], zi = acc[1][n][r];
                *(LAS bf16_t*)(lds + FF_Z2 + ff_addr(k1, n2)) = f2bf(zr * c + zi * sn);
                *(LAS bf16_t*)(lds + FF_Z2 + ff_addr(k1, 64 + n2)) = f2bf(zi * c - zr * sn); }
        __syncthreads();
        f32x4 acc2[2] = {(f32x4){0.f, 0.f, 0.f, 0.f}, (f32x4){0.f, 0.f, 0.f, 0.f}};
#pragma unroll
        for (int ks = 0; ks < 4; ++ks) {
            const int i = 16 * mf + fr; const bf16x8 af = *(const LAS bf16x8*)(lds + FF_DC + i * 256 + (((4 * ks + g) ^ (i & 15)) << 4));
#pragma unroll
            for (int n = 0; n < 2; ++n) { const int j = 16 * (2 * nh + n) + fr; const bf16x8 bfv = *(const LAS bf16x8*)(lds + FF_Z2 + j * 256 + (((4 * ks + g) ^ (j & 15)) << 4));
                acc2[n] = __builtin_amdgcn_mfma_f32_16x16x32_bf16(af, bfv, acc2[n], 0, 0, 0); }
        }
#pragma unroll
        for (int n = 0; n < 2; ++n)
#pragma unroll
            for (int r = 0; r < 4; ++r) { const int k = 16 * (2 * nh + n) + fr + 64 * (16 * mf + 4 * g + r); *(LAS bf16_t*)(lds + FF_OB + k * 8 + cl * 2) = f2bf(acc2[n][r]); }
    }
    __syncthreads();
    bf16_t* CAT = (bf16_t*)(a->ws + WS_CAT) + (size_t)(b * 4096) * D + cg * 4;
#pragma unroll
    for (int it = 0; it < 8; ++it) { const int k = tid + 512 * it; *(u32x2*)(CAT + (size_t)k * D) = *(const LAS u32x2*)(lds + FF_OB + k * 8); }
    __syncthreads();
}

__device__ __forceinline__ void p2_mix(AP a, unsigned char* ldsg, LAS unsigned char* lds, int l) {
    const int n_dft = 256, n_dftc = (l == 0) ? 16 : 0, n_mix = 128 + ((l == 0) ? 8 : 0);
    bf16_t* CAT = (bf16_t*)(a->ws + WS_CAT);
    bool fft_ready = false;
    for (int u = blockIdx.x; u < n_dft + n_dftc + n_mix; u += gridDim.x) {
        if (u < n_dft) {
            if (!fft_ready) { fft_setup(lds); fft_ready = true; }
            fft_unit(a, lds, u >> 6, u & 63);
        } else if (u < n_dft + n_dftc) {
            const int uu = u - n_dft, b = uu >> 2, mt = (uu >> 1) & 1, ch0 = (uu & 1) * 128;
            const bf16_t* A = (const bf16_t*)(a->ws + WS_DFTC) + (size_t)(mt * 128) * 512;
            const bf16_t* B0 = (const bf16_t*)(a->ws + WS_ATC) + ((size_t)b * 256 + ch0) * 512;
            EpiBf16 E; E.C = CAT + (size_t)(NLAT + b * 256 + mt * 128) * D + ch0; E.ld = D;
            gemm_tile<128, false, EpiBf16>(lds, A, 512, nullptr, 128, B0, B0 + (size_t)64 * 512, 512, 512, E);
        } else {
            const int t = u - n_dft - n_dftc;
#if NAIVE_MIXER
            if (t < 128) { const int b = t >> 5; mixer_tile(a, ldsg, l, t * 128, b * 4096, (t & 31) * 128, 4096, b, false); }
            else { const int tt = t - 128, b = tt >> 1; mixer_tile(a, ldsg, l, NLAT + tt * 128, NLAT + b * 256, (tt & 1) * 128, 256, b, true); }
#else
            const bool isc = t >= 128; const int tt = t - 128;
            const int b = isc ? (tt >> 1) : (t >> 5);
            mixer_tile_fast(a, lds, l, isc ? NLAT + tt * 128 : t * 128, isc ? NLAT + b * 256 : b * 4096, isc ? (tt & 1) * 128 : (t & 31) * 128, isc ? 256 : 4096, b, isc);
#endif
        }
    }
}

__device__ __forceinline__ int uni(int v) { return __builtin_amdgcn_readfirstlane(v); }
template <class T> __device__ __forceinline__ T* unip(T* p) { const unsigned long long v = (unsigned long long)p; const unsigned lo = __builtin_amdgcn_readfirstlane((unsigned)v), hi = __builtin_amdgcn_readfirstlane((unsigned)(v >> 32)); return (T*)(((unsigned long long)hi << 32) | lo); }
struct SchedInProj {
    typedef EpiInProj Epi; static constexpr bool GATHER = false;
    unsigned char* ws; int l, G, me;
    __device__ __forceinline__ bool get(int i, g256::Unit<Epi>& u) const {
        const int n_lat = 64 * 7, n_ctx = (l == 0) ? 4 * 7 : 4;
        const int idx = i * G + me; if (idx >= n_lat + n_ctx) return false;
        int row0, b, ct, n; bf16_t *tF, *tV;
        if (idx < n_lat) { const int rt = idx / 7; ct = idx % 7; row0 = rt * 256; b = row0 >> 12; n = 4096;
            tF = (bf16_t*)(ws + WS_AT) + (size_t)b * 256 * 2 * 4096; tV = (bf16_t*)(ws + WS_VT) + (size_t)b * 128 * 4096; }
        else { const int uu = idx - n_lat; int rt; if (l == 0) { rt = uu / 7; ct = uu % 7; } else { rt = uu; ct = 3; }
            row0 = NLAT + rt * 256; b = rt; n = 256;
            tF = (bf16_t*)(ws + WS_ATC) + (size_t)b * 256 * 2 * 256; tV = (bf16_t*)(ws + WS_VTC) + (size_t)b * 128 * 256; }
        u.A = (const bf16_t*)(ws + WS_H) + (size_t)row0 * D;
        u.B0 = (const bf16_t*)(ws + WS_WIN) + ((size_t)l * ZC + ct * 256) * 1024; u.B1 = u.B0 + (size_t)128 * 1024; u.ridx = nullptr; u.valid = 256;
        u.epi.Zt = (bf16_t*)(ws + WS_Z) + (size_t)row0 * ZC + ct * 256; u.epi.tF = tF; u.epi.tV = tV; u.epi.n0 = ct * 256; u.epi.pos0 = (idx < n_lat) ? (row0 & 4095) : 0; u.epi.n = n;
        return true;
    }
};
struct SchedOutProj {
    typedef EpiF32 Epi; static constexpr bool GATHER = false;
    unsigned char* ws; int l, G, me;
    __device__ __forceinline__ bool get(int i, g256::Unit<Epi>& u) const {
        const int nrt = (l == 0) ? NTOK / 256 : NLAT / 256;
        const int idx = i * G + me; if (idx >= nrt * 4) return false;
        const int rt = idx >> 2, ct = idx & 3;
        u.A = (const bf16_t*)(ws + WS_CAT) + (size_t)(rt * 256) * D;
        u.B0 = (const bf16_t*)(ws + WS_WOUT) + ((size_t)l * 1024 + ct * 256) * 1024; u.B1 = u.B0 + (size_t)128 * 1024; u.ridx = nullptr; u.valid = 256;
        u.epi.C = (float*)(ws + WS_Y) + (size_t)(rt * 256) * D + ct * 256; u.epi.ld = D;
        return true;
    }
};
struct SchedGateUp {
    typedef EpiGateUp Epi; static constexpr bool GATHER = true;
    unsigned char* ws; const LAS int* blk; const LAS int* tot; const LAS int* ridx_lds; int G, me;
    __device__ __forceinline__ bool get(int i, g256::Unit<Epi>& u) const {
        const int idx = i * G + me; if (idx >= uni(blk[32]) * 4) return false;
        const int rb = idx >> 2, ct = idx & 3;
        int e = 0;
#pragma unroll 1
        for (int q = 1; q < 32; ++q) if (uni(blk[q]) <= rb) e = q;
        u.A = (const bf16_t*)(ws + WS_H);
        u.B0 = (const bf16_t*)(ws + WS_WEXP) + ((size_t)e * 512 + ct * 128) * 1024; u.B1 = u.B0 + EXPMAT;
        u.ridx = ridx_lds + (i & 7) * 256; u.valid = uni(min(256, tot[e] - (rb - blk[e]) * 256));
        u.epi.C = (bf16_t*)(ws + WS_HID) + (size_t)(rb * 256) * DEXP + ct * 128; u.epi.ld = DEXP;
        return true;
    }
};
struct SchedDown {
    typedef EpiBf16 Epi; static constexpr bool GATHER = false;
    unsigned char* ws; const LAS int* blk; int G, me;
    __device__ __forceinline__ bool get(int i, g256::Unit<Epi>& u) const {
        const int idx = i * G + me; if (idx >= uni(blk[32]) * 4) return false;
        const int rb = idx >> 2, ct = idx & 3;
        int e = 0;
#pragma unroll 1
        for (int q = 1; q < 32; ++q) if (uni(blk[q]) <= rb) e = q;
        u.A = (const bf16_t*)(ws + WS_HID) + (size_t)(rb * 256) * DEXP;
        u.B0 = (const bf16_t*)(ws + WS_WEXP) + 2 * EXPMAT + ((size_t)e * 1024 + ct * 256) * 512; u.B1 = u.B0 + (size_t)128 * 512; u.ridx = nullptr; u.valid = 256;
        u.epi.C = (bf16_t*)(ws + WS_YS) + (size_t)(rb * 256) * D + ct * 256; u.epi.ld = D;
        return true;
    }
};

__device__ __forceinline__ void p4_ln1_router(AP a, unsigned char* lds, int l) {
    const int tid = tid_opaque(), lane = tid & 63, w = tid >> 6;
    const int ntok = (l == 0) ? NTOK : NLAT;
    int* cnt = (int*)(lds + MISC_OFF);
    if (tid < 32) cnt[tid] = 0;
    f32x4* Lg = (f32x4*)lds; f32x4* Le = (f32x4*)(lds + 16384); f32x4* Lgb = (f32x4*)(lds + 147456);
    {
        const float* wrg_ = a->in[16] + (size_t)l * 1024 * 4; const float* wre_ = a->in[17] + (size_t)l * 1024 * 32;
#pragma unroll
        for (int it = 0; it < 2; ++it) { const int c = tid + 512 * it, slot = (((c >> 8) * 4 + (c & 3)) << 6) + ((c >> 2) & 63);
            Lg[slot] = *(const f32x4*)(wrg_ + (size_t)c * 4);
#pragma unroll
            for (int q = 0; q < 8; ++q) Le[q * 1024 + slot] = *(const f32x4*)(wre_ + (size_t)c * 32 + q * 4); }
        Lgb[tid] = (tid < 256) ? *(const f32x4*)(a->in[14] + l * 1024 + tid * 4) : *(const f32x4*)(a->in[15] + l * 1024 + (tid - 256) * 4);
    }
    __syncthreads();
    const float* mod = (const float*)(a->ws + WS_MOD) + (size_t)l * 5 * 6144;
    const float* Y = (const float*)(a->ws + WS_Y);
    float* X1 = (float*)(a->ws + WS_X1);
    bf16_t* H = (bf16_t*)(a->ws + WS_H);
    int* tokE = (int*)(a->ws + WS_TOKE); int* tokR = (int*)(a->ws + WS_TOKR); float* tokG = (float*)(a->ws + WS_TOKG);
    const int tstep = gridDim.x * 8;
    f32x4 nx[4], ny[4];
    {   const int t = blockIdx.x * 8 + w;
        if (t < ntok) { const float* xs = (l == 0) ? ((t < NLAT) ? a->in[0] + (size_t)t * D : a->in[2] + (size_t)(t - NLAT) * D) : (const float*)(a->ws + WS_XC) + (size_t)t * D;
#pragma unroll
            for (int i = 0; i < 4; ++i) { nx[i] = *(const f32x4*)(xs + 256 * i + 4 * lane); ny[i] = *(const f32x4*)(Y + (size_t)t * D + 256 * i + 4 * lane); } } }
    int mrow = -1; f32x4 mg[4], msh[4], msc[4];
    for (int t = blockIdx.x * 8 + w; t < ntok; t += tstep) {
        const int mr = (t < NLAT) ? (t >> 12) : 4;
        if (mr != mrow) { mrow = mr; const float* m = mod + (size_t)mr * 6144;
#pragma unroll
            for (int i = 0; i < 4; ++i) { const int c = 256 * i + 4 * lane; mg[i] = *(const f32x4*)(m + 2048 + c); msh[i] = *(const f32x4*)(m + 3072 + c); msc[i] = *(const f32x4*)(m + 4096 + c); } }
        f32x4 v[4];
#pragma unroll
        for (int i = 0; i < 4; ++i) {
#pragma unroll
            for (int e = 0; e < 4; ++e) v[i][e] = RES_ALPHA * nx[i][e] + mg[i][e] * ny[i][e]; }
        {   const int tn = t + tstep;
            if (tn < ntok) { const float* xs = (l == 0) ? ((tn < NLAT) ? a->in[0] + (size_t)tn * D : a->in[2] + (size_t)(tn - NLAT) * D) : (const float*)(a->ws + WS_XC) + (size_t)tn * D;
#pragma unroll
                for (int i = 0; i < 4; ++i) { nx[i] = *(const f32x4*)(xs + 256 * i + 4 * lane); ny[i] = *(const f32x4*)(Y + (size_t)tn * D + 256 * i + 4 * lane); } } }
        float mean, rstd; ln_stats(v, mean, rstd);
#pragma unroll
        for (int i = 0; i < 4; ++i) { const int c = 256 * i + 4 * lane; const f32x4 gg = Lgb[64 * i + lane], bb = Lgb[256 + 64 * i + lane];
#pragma unroll
            for (int e = 0; e < 4; ++e) v[i][e] = (v[i][e] - mean) * rstd * gg[e] + bb[e];
            *(f32x4*)(X1 + (size_t)t * D + c) = v[i]; }
        ln_stats(v, mean, rstd);
#pragma unroll
        for (int i = 0; i < 4; ++i) { const int c = 256 * i + 4 * lane; const f32x4 sh = msh[i], sc = msc[i];
#pragma unroll
            for (int e = 0; e < 4; ++e) v[i][e] = (v[i][e] - mean) * rstd * (1.0f + sc[e]) + sh[e];
            u32x2 pk; pk.x = pack2(v[i][0], v[i][1]); pk.y = pack2(v[i][2], v[i][3]); *(u32x2*)(H + (size_t)t * D + c) = pk; }
        float lg[4] = {0.f, 0.f, 0.f, 0.f};
#pragma unroll
        for (int i = 0; i < 4; ++i)
#pragma unroll
            for (int e = 0; e < 4; ++e) { const f32x4 wv = Lg[((i * 4 + e) << 6) + lane];
                lg[0] += v[i][e] * wv[0]; lg[1] += v[i][e] * wv[1]; lg[2] += v[i][e] * wv[2]; lg[3] += v[i][e] * wv[3]; }
#pragma unroll
        for (int q = 0; q < 4; ++q) lg[q] = wave_sum(lg[q]);
        int grp = 0; float mx = lg[0];
#pragma unroll
        for (int q = 1; q < 4; ++q) if (lg[q] > mx) { mx = lg[q]; grp = q; }
        float se = 0.f;
#pragma unroll
        for (int q = 0; q < 4; ++q) se += expf(lg[q] - mx);
        const float gate_group = 1.0f / se;
        float le[8] = {0.f, 0.f, 0.f, 0.f, 0.f, 0.f, 0.f, 0.f};
#pragma unroll
        for (int i = 0; i < 4; ++i)
#pragma unroll
            for (int e = 0; e < 4; ++e) { const f32x4* wp = Le + grp * 2048 + ((i * 4 + e) << 6) + lane; const f32x4 w0 = wp[0], w1 = wp[1024];
                le[0] += v[i][e] * w0[0]; le[1] += v[i][e] * w0[1]; le[2] += v[i][e] * w0[2]; le[3] += v[i][e] * w0[3];
                le[4] += v[i][e] * w1[0]; le[5] += v[i][e] * w1[1]; le[6] += v[i][e] * w1[2]; le[7] += v[i][e] * w1[3]; }
#pragma unroll
        for (int q = 0; q < 8; ++q) le[q] = wave_sum(le[q]);
        int j1 = 0; float l1 = le[0];
#pragma unroll
        for (int q = 1; q < 8; ++q) if (le[q] > l1) { l1 = le[q]; j1 = q; }
        int j2 = -1; float l2 = -3.0e38f;
#pragma unroll
        for (int q = 0; q < 8; ++q) if (q != j1 && le[q] > l2) { l2 = le[q]; j2 = q; }
        const float e2 = expf(l2 - l1), p1 = 1.0f / (1.0f + e2), p2 = e2 / (1.0f + e2);
        if (lane == 0) {
            const int ex0 = grp * 8 + j1, ex1 = grp * 8 + j2;
            const int r0 = atomicAdd(&cnt[ex0], 1), r1 = atomicAdd(&cnt[ex1], 1);
            tokE[2 * t] = ex0; tokE[2 * t + 1] = ex1; tokR[2 * t] = r0; tokR[2 * t + 1] = r1;
            tokG[2 * t] = gate_group * p1; tokG[2 * t + 1] = gate_group * p2;
        }
    }
    __syncthreads();
    if (tid < 32) ((int*)(a->ws + WS_BCNT))[((size_t)l * MAXG + blockIdx.x) * 32 + tid] = cnt[tid];
    __syncthreads();
}

__device__ __forceinline__ void p5_dispatch(AP a, unsigned char* lds, int l) {
    const int tid = tid_opaque();
    const int ntok = (l == 0) ? NTOK : NLAT;
    int* part = (int*)lds;
    int* tot = (int*)(lds + 4096);
    int* off = (int*)(lds + 4096 + 128);
    int* pstart = (int*)(lds + 4096 + 256);
    const int* bc = (const int*)(a->ws + WS_BCNT) + (size_t)l * MAXG * 32;
    const int G = gridDim.x, me = blockIdx.x;
    { const int e = tid & 31, p = tid >> 5; int s = 0, so = 0; for (int bb = p; bb < G; bb += 16) { const int c = bc[bb * 32 + e]; s += c; if (bb < me) so += c; } part[p * 32 + e] = s; part[512 + p * 32 + e] = so; }
    __syncthreads();
    if (tid < 32) { int s = 0, so = 0; for (int p = 0; p < 16; ++p) { s += part[p * 32 + tid]; so += part[512 + p * 32 + tid]; } tot[tid] = s; off[tid] = so; }
    __syncthreads();
    if (tid == 0) { int acc = 0; for (int e = 0; e < 32; ++e) { pstart[e] = acc; acc += ((tot[e] + 255) >> 8) << 8; } }
    __syncthreads();
    if (me == 0 && tid < 32) ((int*)(a->ws + WS_CNT))[l * 32 + tid] = tot[tid];
    const int* tokE = (const int*)(a->ws + WS_TOKE); const int* tokR = (const int*)(a->ws + WS_TOKR);
    int* tokS = (int*)(a->ws + WS_TOKS); int* slotT = (int*)(a->ws + WS_SLOTT);
    for (int base = me * 8; base < ntok; base += G * 8) {
        if (tid < 16) { const int t = base + (tid >> 1); if (t < ntok) { const int idx = 2 * t + (tid & 1); const int e = tokE[idx]; const int slot = pstart[e] + off[e] + tokR[idx]; tokS[idx] = slot; slotT[slot] = t; } }
    }
    __syncthreads();
}

__device__ __forceinline__ void moe_table(AP a, int l, LAS int* blk) {
    const int* tot = (const int*)(a->ws + WS_CNT) + l * 32;
    if (threadIdx.x == 0) { int acc = 0; for (int e = 0; e < 32; ++e) { const int c = tot[e]; blk[e] = acc; blk[33 + e] = c; acc += (c + 255) >> 8; } blk[32] = acc; }
    __syncthreads();
}
__device__ __forceinline__ void p1_inproj(AP a, LAS unsigned char* lds, int l) {
    SchedInProj S; S.ws = a->ws; S.l = l; S.G = gridDim.x; S.me = blockIdx.x;
    g256::gemm_phase(lds, 1024, S);
}
__device__ __forceinline__ void p3_outproj(AP a, LAS unsigned char* lds, int l) {
    SchedOutProj S; S.ws = a->ws; S.l = l; S.G = gridDim.x; S.me = blockIdx.x;
    g256::gemm_phase(lds, 1024, S);
}
__device__ __forceinline__ void p6_gateup(AP a, LAS unsigned char* lds, int l) {
    LAS int* blk = (LAS int*)(lds + MISC_OFF + 256);
    moe_table(a, l, blk);
    LAS int* ridx = (LAS int*)(lds + RIDX_OFF);
    const int tid = tid_opaque(), G = gridDim.x, me = blockIdx.x, nu = blk[32] * 4;
    const int* slotT = (const int*)(a->ws + WS_SLOTT);
    for (int i = 0; i < 8; ++i) { const int idx = i * G + me; if (idx >= nu) break;
        const int rb = idx >> 2; int e = 0; for (int q = 1; q < 32; ++q) if (blk[q] <= rb) e = q;
        const int valid = min(256, blk[33 + e] - (rb - blk[e]) * 256);
        if (tid < 256) ridx[i * 256 + tid] = (tid < valid) ? slotT[rb * 256 + tid] : 0; }
    __syncthreads();
    SchedGateUp S; S.ws = a->ws; S.blk = blk; S.tot = blk + 33; S.ridx_lds = ridx; S.G = G; S.me = me;
    g256::gemm_phase(lds, 1024, S);
    __syncthreads();
}
__device__ __forceinline__ void p7_down(AP a, LAS unsigned char* lds, int l) {
    LAS int* blk = (LAS int*)(lds + MISC_OFF + 256);
    moe_table(a, l, blk);
    SchedDown S; S.ws = a->ws; S.blk = blk; S.G = gridDim.x; S.me = blockIdx.x;
    g256::gemm_phase(lds, 512, S);
    __syncthreads();
}

__device__ __forceinline__ void p8_ln2(AP a, unsigned char* lds, int l) {
    const int tid = tid_opaque(), lane = tid & 63, w = tid >> 6;
    const int ntok = (l == 0) ? NTOK : NLAT;
    const float* mod = (const float*)(a->ws + WS_MOD) + (size_t)l * 5 * 6144;
    const float* modn = (const float*)(a->ws + WS_MOD) + (size_t)5 * 6144;
    const float* X1 = (const float*)(a->ws + WS_X1);
    const bf16_t* YS = (const bf16_t*)(a->ws + WS_YS);
    const int* tokS = (const int*)(a->ws + WS_TOKS); const float* tokG = (const float*)(a->ws + WS_TOKG);
    f32x4* Lgb = (f32x4*)lds;
    __syncthreads();
    Lgb[tid] = (tid < 256) ? *(const f32x4*)(a->in[21] + l * 1024 + tid * 4) : *(const f32x4*)(a->in[22] + l * 1024 + (tid - 256) * 4);
    __syncthreads();
    int mrow = -1; f32x4 mg[4], nsh[4], nsc[4];
    const int tstep = gridDim.x * 8;
    int t = blockIdx.x * 8 + w;
    int ns0 = 0, ns1 = 0; float nga = 0.f, ngb = 0.f;
    f32x4 nx[4]; u32x2 nya[4], nyb[4];
    float cga = 0.f, cgb = 0.f;
    if (t < ntok) { const int s0 = tokS[2 * t], s1 = tokS[2 * t + 1]; cga = tokG[2 * t]; cgb = tokG[2 * t + 1];
#pragma unroll
        for (int i = 0; i < 4; ++i) { const int c = 256 * i + 4 * lane; nx[i] = *(const f32x4*)(X1 + (size_t)t * D + c); nya[i] = *(const u32x2*)(YS + (size_t)s0 * D + c); nyb[i] = *(const u32x2*)(YS + (size_t)s1 * D + c); } }
    if (t + tstep < ntok) { ns0 = tokS[2 * (t + tstep)]; ns1 = tokS[2 * (t + tstep) + 1]; nga = tokG[2 * (t + tstep)]; ngb = tokG[2 * (t + tstep) + 1]; }
    for (; t < ntok; t += tstep) {
        const int mr = (t < NLAT) ? (t >> 12) : 4;
        if (mr != mrow) { mrow = mr; const float* m = mod + (size_t)mr * 6144; const float* mn = modn + (size_t)mr * 6144;
#pragma unroll
            for (int i = 0; i < 4; ++i) { const int c = 256 * i + 4 * lane; mg[i] = *(const f32x4*)(m + 5120 + c); if (l == 0) { nsh[i] = *(const f32x4*)(mn + c); nsc[i] = *(const f32x4*)(mn + 1024 + c); } } }
        f32x4 v[4];
#pragma unroll
        for (int i = 0; i < 4; ++i) { const f32x4 gv = mg[i];
            const u32x2 ya = nya[i], yb = nyb[i];
            const float f0 = cga * lo2f(ya.x) + cgb * lo2f(yb.x), f1 = cga * hi2f(ya.x) + cgb * hi2f(yb.x), f2 = cga * lo2f(ya.y) + cgb * lo2f(yb.y), f3 = cga * hi2f(ya.y) + cgb * hi2f(yb.y);
            v[i][0] = RES_ALPHA * nx[i][0] + gv[0] * f0; v[i][1] = RES_ALPHA * nx[i][1] + gv[1] * f1; v[i][2] = RES_ALPHA * nx[i][2] + gv[2] * f2; v[i][3] = RES_ALPHA * nx[i][3] + gv[3] * f3; }
        {   const int tn = t + tstep, tn2 = t + 2 * tstep;
            if (tn < ntok) {
#pragma unroll
                for (int i = 0; i < 4; ++i) { const int c = 256 * i + 4 * lane; nx[i] = *(const f32x4*)(X1 + (size_t)tn * D + c); nya[i] = *(const u32x2*)(YS + (size_t)ns0 * D + c); nyb[i] = *(const u32x2*)(YS + (size_t)ns1 * D + c); }
                cga = nga; cgb = ngb; }
            if (tn2 < ntok) { ns0 = tokS[2 * tn2]; ns1 = tokS[2 * tn2 + 1]; nga = tokG[2 * tn2]; ngb = tokG[2 * tn2 + 1]; } }
        float mean, rstd; ln_stats(v, mean, rstd);
        float* dst = (l == 0) ? (float*)(a->ws + WS_XC) + (size_t)t * D : a->out + (size_t)t * D;
#pragma unroll
        for (int i = 0; i < 4; ++i) { const int c = 256 * i + 4 * lane; const f32x4 gg = Lgb[64 * i + lane], bb = Lgb[256 + 64 * i + lane];
#pragma unroll
            for (int e = 0; e < 4; ++e) v[i][e] = (v[i][e] - mean) * rstd * gg[e] + bb[e];
            *(f32x4*)(dst + c) = v[i]; }
        if (l == 0) {
            ln_stats(v, mean, rstd);
            bf16_t* H = (bf16_t*)(a->ws + WS_H);
#pragma unroll
            for (int i = 0; i < 4; ++i) { const int c = 256 * i + 4 * lane; const f32x4 sh = nsh[i], sc = nsc[i];
                f32x4 o;
#pragma unroll
                for (int e = 0; e < 4; ++e) o[e] = (v[i][e] - mean) * rstd * (1.0f + sc[e]) + sh[e];
                u32x2 pk; pk.x = pack2(o[0], o[1]); pk.y = pack2(o[2], o[3]); *(u32x2*)(H + (size_t)t * D + c) = pk; }
        }
    }
    if (l == 0) exp_range(a, lds, 1, blockIdx.x);
}

constexpr int N_PHASES = 18;
template <int P> __device__ __forceinline__ void run_phase(AP a, unsigned char* smem, LAS unsigned char* lds, int l) {
    asm volatile("" : "+s"(a));
    if (P == 0) p0_prologue(a, smem);
    if (P == 1) p_lnmod0(a);
    if (P == 2) p1_inproj(a, lds, l);
    if (P == 3) p2_mix(a, smem, lds, l);
    if (P == 4) p3_outproj(a, lds, l);
    if (P == 5) p4_ln1_router(a, smem, l);
    if (P == 6) p5_dispatch(a, smem, l);
    if (P == 7) p6_gateup(a, lds, l);
    if (P == 8) p7_down(a, lds, l);
    if (P == 9) p8_ln2(a, smem, l);
}
template <int P> __device__ __noinline__ void phase_fn(AP ap, int l) {
    extern __shared__ __attribute__((aligned(16))) unsigned char smem[];
    run_phase<P>(ap, smem, (LAS unsigned char*)smem, l);
}
#if N_LAUNCH_MODE == 1
__global__ void __launch_bounds__(NT, 2) fwd(Args a) {
    extern __shared__ __attribute__((aligned(16))) unsigned char smem[];
    LAS unsigned char* lds = (LAS unsigned char*)smem;
    if (threadIdx.x < 4) ((volatile LAS unsigned*)(lds + MISC_OFF + 768))[threadIdx.x] = 0u;
    __syncthreads();
    XcdBarrier bar = xcd_barrier_post((unsigned*)(a.ws + WS_BAR), (volatile LAS unsigned*)(lds + MISC_OFF + 768));
    AP ap = (AP)__builtin_amdgcn_kernarg_segment_ptr();
#define PROBE(P, l) do { if (PROBE_MASK & (1 << (P))) { for (int _r = 0; _r < 2; ++_r) { xcd_barrier(bar); run_phase<P>(ap, smem, lds, l); } } } while (0)
    run_phase<0>(ap, smem, lds, 0); PROBE(0, 0); xcd_barrier(bar);
    run_phase<1>(ap, smem, lds, 0); PROBE(1, 0); xcd_barrier(bar);
    for (int l = 0; l < 2; ++l) {
        run_phase<2>(ap, smem, lds, l); PROBE(2, l); xcd_barrier(bar);
        run_phase<3>(ap, smem, lds, l); PROBE(3, l); xcd_barrier(bar);
        run_phase<4>(ap, smem, lds, l); PROBE(4, l); xcd_barrier(bar);
        run_phase<5>(ap, smem, lds, l); PROBE(5, l); xcd_barrier(bar);
        run_phase<6>(ap, smem, lds, l); PROBE(6, l); xcd_barrier(bar);
        run_phase<7>(ap, smem, lds, l); PROBE(7, l); xcd_barrier(bar);
        run_phase<8>(ap, smem, lds, l); PROBE(8, l); xcd_barrier(bar);
        run_phase<9>(ap, smem, lds, l); PROBE(9, l); if (l == 0) xcd_barrier(bar);
    }
}
#else
template <int P> __global__ void __launch_bounds__(NT, 2) k_phase(Args a) {
    extern __shared__ __attribute__((aligned(16))) unsigned char smem[];
    LAS unsigned char* lds = (LAS unsigned char*)smem;
    AP ap = (AP)__builtin_amdgcn_kernarg_segment_ptr();
    run_phase<P>(ap, smem, lds, ap->ph_lo);
}
template <int P> static void launch_phase(Args a, int l, int grid, hipStream_t stream) {
    static bool attr = false;
    if (!attr) { (void)hipFuncSetAttribute((const void*)k_phase<P>, hipFuncAttributeMaxDynamicSharedMemorySize, LDS_BYTES); attr = true; }
    a.ph_lo = l; a.ph_hi = P;
    hipLaunchKernelGGL(k_phase<P>, dim3(grid), dim3(NT), LDS_BYTES, stream, a);
}
#endif

extern "C" void kernel_launch(void* const* d_in, const int* in_sizes, int n_in, void* d_out, int out_size, void* d_ws, size_t ws_size, hipStream_t stream) {
    static int grid = 0;
    if (grid == 0) {
        if (n_in != 23 || out_size != NLAT * D || ws_size < WS_END) { fprintf(stderr, "kernel_launch: unexpected shapes (n_in %d, out %d, ws %zu, need %zu)\n", n_in, out_size, ws_size, (size_t)WS_END); grid = -1; return; }
        int dev = 0, cus = 0;
        if (hipGetDevice(&dev) != hipSuccess || hipDeviceGetAttribute(&cus, hipDeviceAttributeMultiprocessorCount, dev) != hipSuccess) { grid = -1; return; }
#if N_LAUNCH_MODE == 1
        int per_cu = 0;
        if (hipFuncSetAttribute((const void*)fwd, hipFuncAttributeMaxDynamicSharedMemorySize, LDS_BYTES) != hipSuccess) { fprintf(stderr, "kernel_launch: hipFuncSetAttribute failed\n"); grid = -1; return; }
        if (hipOccupancyMaxActiveBlocksPerMultiprocessor(&per_cu, (const void*)fwd, NT, LDS_BYTES) != hipSuccess || per_cu < 1) { fprintf(stderr, "kernel_launch: occupancy query says %d\n", per_cu); }
        (void)hipGetLastError();
#endif
        grid = cus; if (grid > MAXG) grid = MAXG;
    }
    if (grid < 0) return;
    (void)hipMemsetAsync((char*)d_ws + WS_BAR, 0, 16384 + 256, stream);
    Args a{};
    for (int i = 0; i < 23; ++i) a.in[i] = (const float*)d_in[i];
    a.out = (float*)d_out; a.ws = (unsigned char*)d_ws;
#if N_LAUNCH_MODE == 1
    a.ph_lo = 0; a.ph_hi = N_PHASES;
    hipLaunchKernelGGL(fwd, dim3(grid), dim3(NT), LDS_BYTES, stream, a);
#else
    launch_phase<0>(a, 0, grid, stream);
    launch_phase<1>(a, 0, grid, stream);
    for (int l = 0; l < 2; ++l) {
        launch_phase<2>(a, l, grid, stream); launch_phase<3>(a, l, grid, stream); launch_phase<4>(a, l, grid, stream); launch_phase<5>(a, l, grid, stream);
        launch_phase<6>(a, l, grid, stream); launch_phase<7>(a, l, grid, stream); launch_phase<8>(a, l, grid, stream); launch_phase<9>(a, l, grid, stream);
    }
#endif
}
```

```cpp
#include <hip/hip_runtime.h>
#include <stdint.h>
#include <stdio.h>

#ifndef NAIVE_GEMM
#define NAIVE_GEMM 0
#endif
#ifndef NAIVE_MIXER
#define NAIVE_MIXER 0
#endif
#ifndef PROBE_MASK
#define PROBE_MASK 0
#endif
#ifndef PROBE_FFT_REP
#define PROBE_FFT_REP 1
#endif
#ifndef PROBE_MIX_REP
#define PROBE_MIX_REP 1
#endif
#ifndef N_LAUNCH_MODE
#define N_LAUNCH_MODE 1
#endif

#define LAS __attribute__((address_space(3)))
typedef unsigned short bf16_t;
typedef short bf16x8 __attribute__((ext_vector_type(8)));
typedef float f32x4 __attribute__((ext_vector_type(4)));
typedef unsigned u32x4 __attribute__((ext_vector_type(4)));
typedef unsigned u32x2 __attribute__((ext_vector_type(2)));
typedef float f32x2 __attribute__((ext_vector_type(2)));

constexpr int D = 1024, NBATCH = 4, SEQ = 4096, CTXL = 256;
constexpr int NLAT = NBATCH * SEQ, NCTX = NBATCH * CTXL, NTOK = NLAT + NCTX;
constexpr int ZC = 1792;
constexpr int NEXP = 32, DEXP = 512;
constexpr int NSLOT = 2 * NTOK + NEXP * 256;
constexpr int NT = 512;
constexpr int MAXG = 512;
constexpr float RES_ALPHA = 1.41421356237309515f;
constexpr int MISC_OFF = 155648;
constexpr int RIDX_OFF = 131072;
constexpr int LDS_BYTES = MISC_OFF + 1024;

constexpr size_t WS_BAR   = 0;
constexpr size_t WS_CNT   = 16384;
constexpr size_t WS_BCNT  = WS_CNT + 256;
constexpr size_t WS_MOD   = WS_BCNT + (size_t)2 * MAXG * 32 * 4;
constexpr size_t WS_ROPE  = WS_MOD + (size_t)2 * 5 * 6144 * 4;
constexpr size_t WS_TOKE  = WS_ROPE + 8192;
constexpr size_t WS_TOKR  = WS_TOKE + (size_t)NTOK * 8;
constexpr size_t WS_TOKS  = WS_TOKR + (size_t)NTOK * 8;
constexpr size_t WS_TOKG  = WS_TOKS + (size_t)NTOK * 8;
constexpr size_t WS_SLOTT = WS_TOKG + (size_t)NTOK * 8;
constexpr size_t WS_WIN   = WS_SLOTT + (size_t)NSLOT * 4;
constexpr size_t WS_WOUT  = WS_WIN + (size_t)2 * ZC * 1024 * 2;
constexpr size_t WS_WSGU  = WS_WOUT + (size_t)2 * 1024 * 1024 * 2;
constexpr size_t WS_DFT   = WS_WSGU + (size_t)2 * 4 * 128 * 128 * 2;
constexpr size_t WS_DFTC  = WS_DFT + (size_t)4096 * 8192 * 2;
constexpr size_t WS_WEXP  = WS_DFTC + (size_t)256 * 512 * 2;
constexpr size_t EXPMAT   = (size_t)NEXP * 512 * 1024;
constexpr size_t WS_X1    = WS_WEXP + 3 * EXPMAT * 2;
constexpr size_t WS_XC    = WS_X1 + (size_t)NTOK * D * 4;
constexpr size_t WS_H     = WS_XC + (size_t)NTOK * D * 4;
constexpr size_t WS_R     = WS_H + (size_t)NTOK * D * 2;
constexpr size_t WS_Z     = WS_R;
constexpr size_t WS_AT    = WS_Z + (size_t)NTOK * ZC * 2;
constexpr size_t WS_ATC   = WS_AT + (size_t)4 * 256 * 8192 * 2;
constexpr size_t WS_VT    = WS_ATC + (size_t)4 * 256 * 512 * 2;
constexpr size_t WS_VTC   = WS_VT + (size_t)4 * 2 * 64 * 4096 * 2;
constexpr size_t WS_CAT   = WS_VTC + (size_t)4 * 2 * 64 * 256 * 2;
constexpr size_t WS_REND  = WS_CAT + (size_t)NTOK * D * 2;
constexpr size_t WS_Y     = WS_R;
constexpr size_t WS_HID   = WS_R;
constexpr size_t WS_YS    = WS_HID + (size_t)NSLOT * DEXP * 2;
constexpr size_t WS_END   = (WS_YS + (size_t)NSLOT * D * 2 > WS_REND) ? WS_YS + (size_t)NSLOT * D * 2 : WS_REND;
static_assert(WS_Y + (size_t)NTOK * D * 4 <= WS_CAT, "Y must not reach CAT");
static_assert(WS_WIN % 256 == 0 && WS_DFT % 256 == 0 && WS_WEXP % 256 == 0 && WS_X1 % 256 == 0 && WS_H % 256 == 0 && WS_R % 256 == 0 && WS_AT % 256 == 0 && WS_CAT % 256 == 0 && WS_YS % 256 == 0, "alignment");

struct Args { const float* in[23]; float* out; unsigned char* ws; int ph_lo, ph_hi; };
#define CAS __attribute__((address_space(4)))
typedef const CAS Args* AP;

#define XB_TMO      128
#define XB_XCNT(j)  (256  + 64 * (j))
#define XB_XSUB(j)  (1280 + 64 * (j))
#define XB_XGEN(j)  (2304 + 64 * (j))
#define XB_TOP      3328
#define XB_TOPGEN   3392
#define XCD_BAR_WORDS 3456
#define XB_SPIN_CAP (1u << 18)

__device__ __forceinline__ unsigned xb_ld(unsigned* p)              { return __hip_atomic_load(p, __ATOMIC_RELAXED, __HIP_MEMORY_SCOPE_AGENT); }
__device__ __forceinline__ unsigned xb_add(unsigned* p, unsigned v) { return __hip_atomic_fetch_add(p, v, __ATOMIC_RELAXED, __HIP_MEMORY_SCOPE_AGENT); }
__device__ __forceinline__ unsigned xb_xcc_id() { return (unsigned)__builtin_amdgcn_s_getreg((3 << 11) | 20) & 0xFu; }
#define XB_SPIN(cond, bar) do { unsigned _sp = 0; while (cond) { __builtin_amdgcn_s_sleep(1); \
    if ((++_sp & 255u) == 0u) { if (xb_ld(&(bar)[XB_TMO])) break; if (_sp > XB_SPIN_CAP) { atomicAdd(&(bar)[XB_TMO], 1u); break; } } } } while (0)

struct XcdBarrier { unsigned* bar; unsigned x; volatile LAS unsigned* st; };

__device__ __forceinline__ XcdBarrier xcd_barrier_post(unsigned* bar, volatile LAS unsigned* st) {
    XcdBarrier b; b.bar = bar; b.x = (unsigned)__builtin_amdgcn_readfirstlane((int)xb_xcc_id()); b.st = st;
    if (threadIdx.x == 0) (void)xb_add(&bar[XB_XCNT(b.x)], 1u);
    return b;
}
__device__ __forceinline__ void xcd_barrier_complete(unsigned* bar, unsigned x, unsigned& nloc, unsigned& nx) {
    const unsigned G = gridDim.x * gridDim.y * gridDim.z;
    unsigned sum, cnt, mine, sp = 0u;
    for (;;) {
        sum = 0u; cnt = 0u; mine = 0u;
#pragma unroll
        for (unsigned j = 0; j < 16; ++j) { const unsigned c = xb_ld(&bar[XB_XCNT(j)]); sum += c; cnt += (c > 0u) ? 1u : 0u; mine = (j == x) ? c : mine; }
        if (sum == G) break;
        __builtin_amdgcn_s_sleep(1);
        if ((++sp & 255u) == 0u) { if (xb_ld(&bar[XB_TMO])) break; if (sp > XB_SPIN_CAP) { atomicAdd(&bar[XB_TMO], 1u); break; } }
    }
    nloc = mine > 0u ? mine : 1u; nx = cnt > 0u ? cnt : 1u;
}
__device__ __forceinline__ void xcd_barrier(const XcdBarrier& b) {
    asm volatile("s_waitcnt vmcnt(0)" ::: "memory");
    __syncthreads();
    if (threadIdx.x == 0) {
        unsigned* bar = b.bar;
        unsigned bx = b.x;
        asm volatile("" : "+s"(bar), "+s"(bx));
        __builtin_amdgcn_s_waitcnt(0);
        unsigned nloc = b.st[0], nx = b.st[1];
        if (nloc == 0u) { xcd_barrier_complete(bar, bx, nloc, nx); b.st[0] = nloc; b.st[1] = nx; }
        const unsigned old = xb_add(&bar[XB_XSUB(bx)], 1u);
        const unsigned gen = old / nloc;
        if (old + 1u == (gen + 1u) * nloc) {
            __builtin_amdgcn_fence(__ATOMIC_RELEASE, "agent");
            asm volatile("s_waitcnt vmcnt(0)" ::: "memory");
            const unsigned og = xb_add(&bar[XB_TOP], 1u);
            const unsigned tg = og / nx;
            if (og + 1u == (tg + 1u) * nx) xb_add(&bar[XB_TOPGEN], 1u);
            else XB_SPIN(xb_ld(&bar[XB_TOPGEN]) == tg, bar);
            __builtin_amdgcn_fence(__ATOMIC_ACQUIRE, "agent");
            xb_add(&bar[XB_XGEN(bx)], 1u);
            asm volatile("s_waitcnt vmcnt(0)" ::: "memory");
        } else {
            XB_SPIN(xb_ld(&bar[XB_XGEN(bx)]) == gen, bar);
            __builtin_amdgcn_fence(__ATOMIC_ACQUIRE, "agent");
            asm volatile("s_waitcnt vmcnt(0)" ::: "memory");
        }
    }
    __syncthreads();
}

__device__ __forceinline__ int tid_opaque() { int t = threadIdx.x; asm volatile("" : "+v"(t)); return t; }
__device__ __forceinline__ float bf2f(bf16_t v) { return __uint_as_float(((unsigned)v) << 16); }
__device__ __forceinline__ bf16_t f2bf(float f) { return __builtin_bit_cast(unsigned short, (__bf16)f); }
typedef __bf16 hwbf16x2 __attribute__((ext_vector_type(2)));
__device__ __forceinline__ unsigned pack2(float a, float b) { return __builtin_bit_cast(unsigned, __builtin_convertvector((f32x2){a, b}, hwbf16x2)); }
__device__ __forceinline__ float lo2f(unsigned w) { return __uint_as_float(w << 16); }
__device__ __forceinline__ float hi2f(unsigned w) { return __uint_as_float(w & 0xffff0000u); }
template <int CTRL> __device__ __forceinline__ float dpp_mov(float v) { return __builtin_bit_cast(float, __builtin_amdgcn_update_dpp(0, __builtin_bit_cast(int, v), CTRL, 0xf, 0xf, true)); }
__device__ __forceinline__ float row_sum16(float v) {
    v += dpp_mov<0xB1>(v);
    v += dpp_mov<0x4E>(v);
    v += dpp_mov<0x141>(v);
    v += dpp_mov<0x140>(v);
    return v;
}
__device__ __forceinline__ float row_max16(float v) {
    v = fmaxf(v, dpp_mov<0xB1>(v)); v = fmaxf(v, dpp_mov<0x4E>(v)); v = fmaxf(v, dpp_mov<0x141>(v)); v = fmaxf(v, dpp_mov<0x140>(v));
    return v;
}
__device__ __forceinline__ float wave_sum(float v) {
    v = row_sum16(v);
    const int iv = __builtin_bit_cast(int, v);
    const float a0 = __builtin_bit_cast(float, __builtin_amdgcn_readlane(iv, 0)), a1 = __builtin_bit_cast(float, __builtin_amdgcn_readlane(iv, 16));
    const float a2 = __builtin_bit_cast(float, __builtin_amdgcn_readlane(iv, 32)), a3 = __builtin_bit_cast(float, __builtin_amdgcn_readlane(iv, 48));
    return (a0 + a1) + (a2 + a3);
}
__device__ __forceinline__ float gelu_erf(float v) {
    const float t = __builtin_amdgcn_rcpf(fabsf(v) * 0.2316418882f + 1.0f);
    float q = t * 0.5307027145f + (-0.7265760135f); q = q * t + 0.7107068705f; q = q * t + (-0.142248368f); q = q * t + 0.127414796f; q = q * t;
    const float m = v * (q * __builtin_amdgcn_exp2f((v * v) * (-0.72134752044f)));
    return v < 0.f ? m : v - m;
}
__device__ __forceinline__ float silu_f(float x) { return x / (1.0f + __expf(-x)); }

__device__ __forceinline__ void ln_stats(const f32x4 (&v)[4], float& mean, float& rstd) {
    float s = 0.f;
#pragma unroll
    for (int i = 0; i < 4; ++i) s += (v[i][0] + v[i][1]) + (v[i][2] + v[i][3]);
    s = wave_sum(s); mean = s * (1.0f / 1024.0f);
    float q = 0.f;
#pragma unroll
    for (int i = 0; i < 4; ++i)
#pragma unroll
        for (int e = 0; e < 4; ++e) { const float d = v[i][e] - mean; q += d * d; }
    q = wave_sum(q); rstd = 1.0f / sqrtf(q * (1.0f / 1024.0f) + 1e-6f);
}

__device__ __forceinline__ void ln_stats16(const f32x4 (&v)[16], float& mean, float& rstd) {
    float s = 0.f;
#pragma unroll
    for (int k = 0; k < 16; ++k) s += (v[k][0] + v[k][1]) + (v[k][2] + v[k][3]);
    s = row_sum16(s); mean = s * (1.0f / 1024.0f);
    float q = 0.f;
#pragma unroll
    for (int k = 0; k < 16; ++k)
#pragma unroll
        for (int e = 0; e < 4; ++e) { const float d = v[k][e] - mean; q += d * d; }
    q = row_sum16(q); rstd = 1.0f / sqrtf(q * (1.0f / 1024.0f) + 1e-6f);
}

template <int BN> struct MfmaLayout {
    static constexpr int FG = BN / 128, NI = 4, NJ = 2 * FG;
    int rbase, cbase;
    __device__ __forceinline__ int row(int i) const { return rbase + 16 * i; }
    __device__ __forceinline__ int col(int jj) const { return (jj / FG) * (BN / 2) + (jj % FG) * 16 + cbase; }
};
template <int BN> struct NaiveLayout {
    static constexpr int TX = BN / 8, TY = NT / TX, NI = 128 / TY, NJ = 2;
    int ty, tx;
    __device__ __forceinline__ int row(int i) const { return ty + TY * i; }
    __device__ __forceinline__ int col(int jj) const { return jj * (BN / 2) + 4 * tx; }
};

__device__ __forceinline__ void glds16(const bf16_t* g, LAS unsigned char* l) {
    __builtin_amdgcn_global_load_lds((const unsigned*)g, (LAS unsigned*)l, 16, 0, 0);
}

template <int BN, bool GATHER, class Epi>
__device__ __forceinline__ void gemm_tile(LAS unsigned char* lds, const bf16_t* A, int lda, const int* rowidx, int valid_rows,
                                          const bf16_t* B0, const bf16_t* B1, int ldb, int K, const Epi& epi) {
    constexpr int A_B = 16384, B_B = BN * 128, STAGE = A_B + B_B, NBL = BN / 64;
    const int tid = tid_opaque(), lane = tid & 63, wid = __builtin_amdgcn_readfirstlane(tid >> 6);
    const bf16_t* ap[2]; const bf16_t* bp[NBL];
#pragma unroll
    for (int i = 0; i < 2; ++i) {
        const int P = i * 512 + tid, row = P >> 3, c = (P & 7) ^ ((row >> 1) & 7);
        size_t ro;
        if (GATHER) ro = (size_t)(row < valid_rows ? rowidx[row] : 0) * (size_t)lda; else ro = (size_t)row * (size_t)lda;
        ap[i] = A + ro + c * 8;
    }
#pragma unroll
    for (int i = 0; i < NBL; ++i) {
        const int P = i * 512 + tid, row = P >> 3, c = (P & 7) ^ ((row >> 1) & 7);
        const bf16_t* base = (row < BN / 2) ? (B0 + (size_t)row * ldb) : (B1 + (size_t)(row - BN / 2) * ldb);
        bp[i] = base + c * 8;
    }
    const int nk = K / 64;
#define GT_STAGE(buf, k0) do { \
        _Pragma("unroll") for (int _i = 0; _i < 2; ++_i) glds16(ap[_i] + (k0), lds + (buf) * STAGE + _i * 8192 + wid * 1024); \
        _Pragma("unroll") for (int _i = 0; _i < NBL; ++_i) glds16(bp[_i] + (k0), lds + (buf) * STAGE + A_B + _i * 8192 + wid * 1024); } while (0)

#if NAIVE_GEMM
    typedef NaiveLayout<BN> Lay;
    Lay lay; lay.tx = tid % Lay::TX; lay.ty = tid / Lay::TX;
    f32x4 acc[Lay::NI][Lay::NJ];
#pragma unroll
    for (int i = 0; i < Lay::NI; ++i)
#pragma unroll
        for (int j = 0; j < Lay::NJ; ++j) acc[i][j] = (f32x4){0.f, 0.f, 0.f, 0.f};
    GT_STAGE(0, 0);
    asm volatile("s_waitcnt vmcnt(0)" ::: "memory"); __syncthreads();
    for (int kt = 0; kt < nk; ++kt) {
        if (kt + 1 < nk) GT_STAGE((kt + 1) & 1, (kt + 1) * 64);
        const LAS unsigned char* sa = lds + (kt & 1) * STAGE; const LAS unsigned char* sb = sa + A_B;
#pragma unroll 1
        for (int kc = 0; kc < 8; ++kc)
#pragma unroll 1
            for (int hh = 0; hh < 2; ++hh) {
                float a[Lay::NI][4];
#pragma unroll
                for (int i = 0; i < Lay::NI; ++i) { const int row = lay.row(i);
                    const u32x2 w = *(const LAS u32x2*)(sa + row * 128 + ((kc ^ ((row >> 1) & 7)) << 4) + hh * 8);
                    a[i][0] = lo2f(w.x); a[i][1] = hi2f(w.x); a[i][2] = lo2f(w.y); a[i][3] = hi2f(w.y); }
#pragma unroll
                for (int j = 0; j < 2; ++j)
#pragma unroll
                    for (int e = 0; e < 4; ++e) { const int row = j * (BN / 2) + 4 * lay.tx + e;
                        const u32x2 w = *(const LAS u32x2*)(sb + row * 128 + ((kc ^ ((row >> 1) & 7)) << 4) + hh * 8);
                        const float b0 = lo2f(w.x), b1 = hi2f(w.x), b2 = lo2f(w.y), b3 = hi2f(w.y);
#pragma unroll
                        for (int i = 0; i < Lay::NI; ++i) acc[i][j][e] += (a[i][0] * b0 + a[i][1] * b1) + (a[i][2] * b2 + a[i][3] * b3); }
            }
        asm volatile("s_waitcnt vmcnt(0)" ::: "memory"); __syncthreads();
    }
    epi.run(acc, lay);
#else
    typedef MfmaLayout<BN> Lay;
    constexpr int FG = Lay::FG;
    const int fr = lane & 15, g = lane >> 4, wr = wid >> 2, wc = wid & 3;
    Lay lay; lay.rbase = wr * 64 + fr; lay.cbase = wc * 16 * FG + 4 * g;
    f32x4 acc[Lay::NI][Lay::NJ];
#pragma unroll
    for (int i = 0; i < Lay::NI; ++i)
#pragma unroll
        for (int j = 0; j < Lay::NJ; ++j) acc[i][j] = (f32x4){0.f, 0.f, 0.f, 0.f};
    int aoff[4], boff[Lay::NJ];
#pragma unroll
    for (int m = 0; m < 4; ++m) { const int row = wr * 64 + m * 16 + fr; aoff[m] = row * 128 + ((g ^ ((row >> 1) & 7)) << 4); }
#pragma unroll
    for (int jj = 0; jj < Lay::NJ; ++jj) { const int row = (jj / FG) * (BN / 2) + wc * 16 * FG + (jj % FG) * 16 + fr; boff[jj] = A_B + row * 128 + ((g ^ ((row >> 1) & 7)) << 4); }
    GT_STAGE(0, 0);
    asm volatile("s_waitcnt vmcnt(0)" ::: "memory"); __syncthreads();
    for (int kt = 0; kt < nk; ++kt) {
        if (kt + 1 < nk) GT_STAGE((kt + 1) & 1, (kt + 1) * 64);
        const LAS unsigned char* sa = lds + (kt & 1) * STAGE;
#pragma unroll
        for (int ks = 0; ks < 2; ++ks) {
            bf16x8 af[4], bfv[Lay::NJ];
#pragma unroll
            for (int m = 0; m < 4; ++m) af[m] = *(const LAS bf16x8*)(sa + (aoff[m] ^ (ks << 6)));
#pragma unroll
            for (int jj = 0; jj < Lay::NJ; ++jj) bfv[jj] = *(const LAS bf16x8*)(sa + (boff[jj] ^ (ks << 6)));
#pragma unroll
            for (int m = 0; m < 4; ++m)
#pragma unroll
                for (int jj = 0; jj < Lay::NJ; ++jj) acc[m][jj] = __builtin_amdgcn_mfma_f32_16x16x32_bf16(bfv[jj], af[m], acc[m][jj], 0, 0, 0);
        }
        asm volatile("s_waitcnt vmcnt(0)" ::: "memory"); __syncthreads();
    }
    epi.run(acc, lay);
#endif
#undef GT_STAGE
}

namespace g256 {
constexpr int BK = 64, HALF = 128, HTB = HALF * BK * 2, STAGE_BYTES = 8 * HTB;
__device__ __forceinline__ int lds_byte(int r, int c) { const int st = (r >> 4) * 2 + (c >> 5), rr = r & 15, cc = c & 31, ob = rr * 64 + cc * 2; return st * 1024 + (ob ^ (((ob >> 9) & 1) << 5)); }
__device__ __forceinline__ void stage_rc(int b, int& R, int& C) { const int st = b / 1024, sb = b % 1024, swz = sb ^ (((sb >> 9) & 1) << 5); R = (st >> 1) * 16 + swz / 64; C = (st & 1) * 32 + (swz % 64) / 2; }
struct Lay {
    static constexpr int NI = 8, NJ = 4;
    int rbase, cbase;
    __device__ __forceinline__ int row(int i) const { return (i >> 2) * 128 + (i & 3) * 16 + rbase; }
    __device__ __forceinline__ int col(int j) const { return (j >> 1) * 128 + (j & 1) * 16 + cbase; }
};
template <class Epi> struct Unit { const bf16_t* A; const bf16_t* B0; const bf16_t* B1; const LAS int* ridx; int valid; Epi epi; };

template <class Sched>
__device__ __forceinline__ void gemm_phase(LAS unsigned char* lds, const int K, const Sched& S) {
    typedef typename Sched::Epi Epi;
    const int tid = tid_opaque(), wid = __builtin_amdgcn_readfirstlane(tid >> 6), lane = tid & 63, wr = wid >> 2, wc = wid & 3, fr = lane & 15, fq = lane >> 4;
    const int nt = K / BK;
    int sR[2], sC[2];
#pragma unroll
    for (int i = 0; i < 2; ++i) stage_rc(tid * 16 + i * 8192, sR[i], sC[i]);
    unsigned voffB[2];
#pragma unroll
    for (int i = 0; i < 2; ++i) voffB[i] = (unsigned)(sR[i] * K + sC[i]) * 2u;
    const size_t kstep = (size_t)(BK * 2);
    const unsigned ldsw = (unsigned)wid * 1024u;
    const int aoff = lds_byte(wr * 64 + fr, fq * 8), boff = lds_byte(wc * 32 + fr, fq * 8);
#define G2_SA(b, h) (((b) * 2 + (h)) * HTB)
#define G2_SB(b, h) ((4 + (b) * 2 + (h)) * HTB)
#define G2_STAGE(bufoff, gbase, v0, v1) do { \
        __builtin_amdgcn_global_load_lds((const unsigned*)((const char*)(gbase) + (v0)), (LAS unsigned*)(lds + (bufoff) + ldsw), 16, 0, 0); \
        __builtin_amdgcn_global_load_lds((const unsigned*)((const char*)(gbase) + (v1)), (LAS unsigned*)(lds + (bufoff) + ldsw + 8192), 16, 0, 0); } while (0)
#define G2_LDA(dst, b, h) do { _Pragma("unroll") for (int m = 0; m < 4; ++m) _Pragma("unroll") for (int k = 0; k < 2; ++k) dst[m][k] = *(const LAS bf16x8*)(lds + G2_SA(b, h) + aoff + m * 2048 + k * 1024); } while (0)
#define G2_LDB(dst, b, h) do { _Pragma("unroll") for (int n = 0; n < 2; ++n) _Pragma("unroll") for (int k = 0; k < 2; ++k) dst[n][k] = *(const LAS bf16x8*)(lds + G2_SB(b, h) + boff + n * 2048 + k * 1024); } while (0)
#define G2_MMA(ai, bj, At, Bt) do { __builtin_amdgcn_s_setprio(1); _Pragma("unroll") for (int m = 0; m < 4; ++m) _Pragma("unroll") for (int n = 0; n < 2; ++n) _Pragma("unroll") for (int k = 0; k < 2; ++k) \
        acc[(ai) * 4 + m][(bj) * 2 + n] = __builtin_amdgcn_mfma_f32_16x16x32_bf16(Bt[n][k], At[m][k], acc[(ai) * 4 + m][(bj) * 2 + n], 0, 0, 0); __builtin_amdgcn_s_setprio(0); } while (0)
#define G2_WAIT_V(n) asm volatile("s_waitcnt vmcnt(" #n ")" ::: "memory")
#define G2_WAIT_L(n) asm volatile("s_waitcnt lgkmcnt(" #n ")" ::: "memory")
#define G2_BAR __builtin_amdgcn_s_barrier()
#define G2_SCHED __builtin_amdgcn_sched_barrier(0)
#define G2_VOFFA(U, dst) do { _Pragma("unroll") for (int _h = 0; _h < 2; ++_h) _Pragma("unroll") for (int _i = 0; _i < 2; ++_i) { const int _row = _h * 128 + sR[_i]; \
        int _tok = _row; if (Sched::GATHER) _tok = (_row < (U).valid) ? (U).ridx[_row] : 0; dst[_h][_i] = (unsigned)(_tok * K + sC[_i]) * 2u; } } while (0)
    Unit<Epi> cur, nxt; int ui = 0;
    if (!S.get(0, cur)) return;
    f32x4 acc[8][4];
#pragma unroll
    for (int i = 0; i < 8; ++i)
#pragma unroll
        for (int j = 0; j < 4; ++j) acc[i][j] = (f32x4){0.f, 0.f, 0.f, 0.f};
    bf16x8 At[4][2], B0[2][2], B1[2][2];
    unsigned cvA[2][2], nvA[2][2];
    G2_VOFFA(cur, cvA);
    const char* cA = (const char*)cur.A; const char* cB0 = (const char*)cur.B0; const char* cB1 = (const char*)cur.B1;
    G2_STAGE(G2_SB(0, 0), cB0, voffB[0], voffB[1]); G2_STAGE(G2_SA(0, 0), cA, cvA[0][0], cvA[0][1]); G2_STAGE(G2_SB(0, 1), cB1, voffB[0], voffB[1]); G2_STAGE(G2_SA(0, 1), cA, cvA[1][0], cvA[1][1]);
    if (wr == 1) G2_BAR;
    G2_WAIT_V(4); G2_BAR;
    G2_STAGE(G2_SB(1, 0), cB0 + kstep, voffB[0], voffB[1]); G2_STAGE(G2_SA(1, 0), cA + kstep, cvA[0][0], cvA[0][1]); G2_STAGE(G2_SB(1, 1), cB1 + kstep, voffB[0], voffB[1]);
    G2_WAIT_V(6); G2_BAR;
    for (;;) {
        const bool has_next = S.get(ui + 1, nxt);
        if (Sched::GATHER) {
            if (has_next) { G2_VOFFA(nxt, nvA); }
            else {
#pragma unroll
                for (int h = 0; h < 2; ++h) { nvA[h][0] = cvA[h][0]; nvA[h][1] = cvA[h][1]; } }
        }
        const char* nA = has_next ? (const char*)nxt.A : cA; const char* nB0 = has_next ? (const char*)nxt.B0 : cB0; const char* nB1 = has_next ? (const char*)nxt.B1 : cB1;
        for (int t = 0; t < nt; t += 2) {
            const bool last = (t == nt - 2);
            const char* a1 = cA + (size_t)(t + 1) * kstep;
            const char* a2 = last ? nA : cA + (size_t)(t + 2) * kstep;
            const char* b20 = last ? nB0 : cB0 + (size_t)(t + 2) * kstep; const char* b21 = last ? nB1 : cB1 + (size_t)(t + 2) * kstep;
#define x00 ((Sched::GATHER && last) ? nvA[0][0] : cvA[0][0])
#define x01 ((Sched::GATHER && last) ? nvA[0][1] : cvA[0][1])
#define x10 ((Sched::GATHER && last) ? nvA[1][0] : cvA[1][0])
#define x11 ((Sched::GATHER && last) ? nvA[1][1] : cvA[1][1])
            G2_LDB(B0, 0, 0); G2_SCHED; G2_LDA(At, 0, 0); G2_STAGE(G2_SA(1, 1), a1, cvA[1][0], cvA[1][1]);
            G2_WAIT_L(8); G2_BAR; G2_WAIT_L(0); G2_MMA(0, 0, At, B0); G2_BAR; G2_SCHED;
            G2_LDB(B1, 0, 1); G2_STAGE(G2_SB(0, 0), b20, voffB[0], voffB[1]);
            G2_BAR; G2_WAIT_L(0); G2_MMA(0, 1, At, B1); G2_BAR;
            G2_LDA(At, 0, 1); G2_STAGE(G2_SA(0, 0), a2, x00, x01);
            G2_BAR; G2_WAIT_L(0); G2_MMA(1, 0, At, B0); G2_BAR; G2_SCHED;
            G2_STAGE(G2_SB(0, 1), b21, voffB[0], voffB[1]);
            G2_WAIT_V(6); G2_BAR; G2_MMA(1, 1, At, B1); G2_BAR;
            G2_LDB(B0, 1, 0); G2_SCHED; G2_LDA(At, 1, 0); G2_STAGE(G2_SA(0, 1), a2, x10, x11);
            G2_WAIT_L(8); G2_BAR; G2_WAIT_L(0); G2_MMA(0, 0, At, B0); G2_BAR; G2_SCHED;
            G2_LDB(B1, 1, 1); G2_STAGE(G2_SB(1, 0), b20 + kstep, voffB[0], voffB[1]);
            G2_BAR; G2_WAIT_L(0); G2_MMA(0, 1, At, B1); G2_BAR;
            G2_LDA(At, 1, 1); G2_STAGE(G2_SA(1, 0), a2 + kstep, x00, x01);
            G2_BAR; G2_WAIT_L(0); G2_MMA(1, 0, At, B0); G2_BAR; G2_SCHED;
            G2_STAGE(G2_SB(1, 1), b21 + kstep, voffB[0], voffB[1]);
            G2_WAIT_V(6); G2_BAR; G2_MMA(1, 1, At, B1); G2_BAR;
        }
        { Lay lay; int rbv = wr * 64 + fr, cbv = wc * 32 + 4 * fq; asm volatile("" : "+v"(rbv), "+v"(cbv));
          lay.rbase = rbv; lay.cbase = cbv; cur.epi.run(acc, lay); }
        if (!has_next) break;
#pragma unroll
        for (int i = 0; i < 8; ++i)
#pragma unroll
            for (int j = 0; j < 4; ++j) acc[i][j] = (f32x4){0.f, 0.f, 0.f, 0.f};
        cur = nxt; cA = nA; cB0 = nB0; cB1 = nB1; ++ui;
        if (Sched::GATHER) {
#pragma unroll
            for (int h = 0; h < 2; ++h) { cvA[h][0] = nvA[h][0]; cvA[h][1] = nvA[h][1]; } }
    }
#undef x00
#undef x01
#undef x10
#undef x11
    G2_WAIT_V(0);
    if (wr == 0) G2_BAR;
    G2_BAR;
#undef G2_SA
#undef G2_SB
#undef G2_STAGE
#undef G2_LDA
#undef G2_LDB
#undef G2_MMA
#undef G2_WAIT_V
#undef G2_WAIT_L
#undef G2_BAR
#undef G2_SCHED
#undef G2_VOFFA
}
}

struct EpiF32 {
    float* C; int ld;
    template <class L> __device__ __forceinline__ void run(const f32x4 (&acc)[L::NI][L::NJ], const L& lay) const {
#pragma unroll
        for (int i = 0; i < L::NI; ++i)
#pragma unroll
            for (int j = 0; j < L::NJ; ++j) *(f32x4*)(C + (size_t)lay.row(i) * ld + lay.col(j)) = acc[i][j];
    }
};
struct EpiBf16 {
    bf16_t* C; int ld;
    template <class L> __device__ __forceinline__ void run(const f32x4 (&acc)[L::NI][L::NJ], const L& lay) const {
#pragma unroll
        for (int i = 0; i < L::NI; ++i)
#pragma unroll
            for (int j = 0; j < L::NJ; ++j) { u32x2 w; w.x = pack2(acc[i][j][0], acc[i][j][1]); w.y = pack2(acc[i][j][2], acc[i][j][3]);
                *(u32x2*)(C + (size_t)lay.row(i) * ld + lay.col(j)) = w; }
    }
};
struct EpiGateUp {
    bf16_t* C; int ld;
    template <class L> __device__ __forceinline__ void run(const f32x4 (&acc)[L::NI][L::NJ], const L& lay) const {
#pragma unroll
        for (int i = 0; i < L::NI; ++i)
#pragma unroll
            for (int j = 0; j < L::NJ / 2; ++j) { const f32x4 gt = acc[i][j], up = acc[i][j + L::NJ / 2];
                u32x2 w; w.x = pack2(silu_f(gt[0]) * up[0], silu_f(gt[1]) * up[1]); w.y = pack2(silu_f(gt[2]) * up[2], silu_f(gt[3]) * up[3]);
                *(u32x2*)(C + (size_t)lay.row(i) * ld + lay.col(j)) = w; }
    }
};
struct EpiInProj {
    bf16_t* Zt;
    bf16_t* tF;
    bf16_t* tV;
    int n0, pos0, n;
    template <class L> __device__ __forceinline__ void run(const f32x4 (&acc)[L::NI][L::NJ], const L& lay) const {
#pragma unroll
        for (int i = 0; i < L::NI; ++i)
#pragma unroll
            for (int j = 0; j < L::NJ; ++j) {
                const int r = lay.row(i), cl = lay.col(j), c = n0 + cl;
                const f32x4 v = acc[i][j];
                if (c < 512) {
                    const int part = c >> 8, ch = c & 255;
#pragma unroll
                    for (int e = 0; e < 4; ++e) tF[((size_t)(ch + e) * 2 + part) * n + pos0 + r] = f2bf(v[e]);
                } else {
                    u32x2 w; w.x = pack2(v[0], v[1]); w.y = pack2(v[2], v[3]);
                    *(u32x2*)(Zt + (size_t)r * ZC + cl) = w;
                    if (c >= 896 && c < 1024) {
#pragma unroll
                        for (int e = 0; e < 4; ++e) tV[(size_t)(c - 896 + e) * n + pos0 + r] = f2bf(v[e]);
                    }
                }
            }
    }
};

constexpr int U_ADA = 192, U_WIN = 2 * 16 * 28, U_WOUT = 2 * 16 * 16, U_SGU = 32, U_DFT = 256, U_ROPE = 1, U_EXP = 3 * 32 * 32;
constexpr int LDS_SIL = 0, LDS_RED = 20480, LDS_TILE = 32768, LDS_T64 = 49408, LDS_CTAB = 50176;

__device__ __forceinline__ void ada_unit(AP a, unsigned char* lds, int u) {
    float* sil = (float*)(lds + LDS_SIL); float* red = (float*)(lds + LDS_RED);
    const int tid = tid_opaque(), lane = tid & 63, w = tid >> 6;
    const int l = u / 96, cg = u % 96;
    for (int i = tid; i < 5120; i += NT) { const int r = i >> 10, k = i & 1023; const float v = (r < 4) ? a->in[1][r * 1024 + k] : a->in[3][k]; sil[i] = v / (1.0f + expf(-v)); }
    __syncthreads();
    const float* W = a->in[4] + (size_t)l * 1024 * 6144 + cg * 64 + lane;
    float acc[5] = {0.f, 0.f, 0.f, 0.f, 0.f};
#pragma unroll 32
    for (int k = w * 128; k < w * 128 + 128; ++k) { const float wv = W[(size_t)k * 6144];
#pragma unroll
        for (int r = 0; r < 5; ++r) acc[r] += sil[r * 1024 + k] * wv; }
#pragma unroll
    for (int r = 0; r < 5; ++r) red[(w * 5 + r) * 64 + lane] = acc[r];
    __syncthreads();
    if (tid < 320) { const int r = tid >> 6; float s = 0.f;
#pragma unroll
        for (int ww = 0; ww < 8; ++ww) s += red[(ww * 5 + r) * 64 + lane];
        const int j = cg * 64 + lane; ((float*)(a->ws + WS_MOD))[(size_t)(l * 5 + r) * 6144 + j] = s + a->in[5][l * 6144 + j]; }
    __syncthreads();
}

__device__ __forceinline__ void tile_store_T(const float* tile, bf16_t* dst, int ldd) {
    const int tid = tid_opaque(), n = tid >> 3, kc = tid & 7;
    u32x4 w;
    w.x = pack2(tile[(kc * 8 + 0) * 65 + n], tile[(kc * 8 + 1) * 65 + n]); w.y = pack2(tile[(kc * 8 + 2) * 65 + n], tile[(kc * 8 + 3) * 65 + n]);
    w.z = pack2(tile[(kc * 8 + 4) * 65 + n], tile[(kc * 8 + 5) * 65 + n]); w.w = pack2(tile[(kc * 8 + 6) * 65 + n], tile[(kc * 8 + 7) * 65 + n]);
    *(u32x4*)(dst + (size_t)n * ldd + kc * 8) = w;
}
__device__ __forceinline__ void tile_load(float* tile, const float* src, int lds_) {
    const int tid = tid_opaque();
#pragma unroll
    for (int i = 0; i < 2; ++i) { const int row = (tid >> 4) + 32 * i, c4 = (tid & 15) * 4; const f32x4 v = *(const f32x4*)(src + (size_t)row * lds_ + c4);
        tile[row * 65 + c4 + 0] = v[0]; tile[row * 65 + c4 + 1] = v[1]; tile[row * 65 + c4 + 2] = v[2]; tile[row * 65 + c4 + 3] = v[3]; }
}

__device__ __forceinline__ void win_unit(AP a, unsigned char* lds, int u) {
    float* tile = (float*)(lds + LDS_TILE); float* T = (float*)(lds + LDS_T64);
    const int tid = tid_opaque();
    const int l = u / 448, r = u % 448, kb = r / 28, nb = r % 28;
    const float* Win = a->in[6] + (size_t)l * 1024 * 1536;
    const int srccol = (nb >= 8) ? nb * 64 - 256 : (nb & 3) * 64;
    tile_load(tile, Win + (size_t)(kb * 64) * 1536 + srccol, 1536);
    if (nb < 8 && tid < 64) { T[tid] = cospif((float)tid / 32.0f); T[64 + tid] = sinpif((float)tid / 32.0f); }
    __syncthreads();
    bf16_t* dst = (bf16_t*)(a->ws + WS_WIN) + ((size_t)l * ZC + nb * 64) * 1024 + kb * 64;
    if (nb >= 8) tile_store_T(tile, dst, 1024);
    else {
        const int n = tid >> 3, kc = tid & 7, part = nb >> 2; float o[8];
#pragma unroll
        for (int e = 0; e < 8; ++e) { float s = 0.f;
#pragma unroll 4
            for (int c = 0; c < 64; ++c) s += tile[(kc * 8 + e) * 65 + c] * T[part * 64 + ((c * n) & 63)]; o[e] = (part ? -s : s) * 0.125f; }
        u32x4 w; w.x = pack2(o[0], o[1]); w.y = pack2(o[2], o[3]); w.z = pack2(o[4], o[5]); w.w = pack2(o[6], o[7]);
        *(u32x4*)(dst + (size_t)n * 1024 + kc * 8) = w;
    }
    __syncthreads();
}

__device__ __forceinline__ void wout_unit(AP a, unsigned char* lds, int u) {
    float* tile = (float*)(lds + LDS_TILE);
    const int tid = tid_opaque();
    const int l = u / 256, r = u % 256, kb = r / 16, nb = r % 16;
    const float* Wo = a->in[13] + (size_t)l * 1024 * 1024;
    const int n = tid & 63, kq = __builtin_amdgcn_readfirstlane(tid >> 6);
    if (kb < 4) {
        const float* wf = a->in[7] + (size_t)l * 256 * 256 + (size_t)(kb * 64 + kq * 8) * 256;
        float acc[8] = {0.f, 0.f, 0.f, 0.f, 0.f, 0.f, 0.f, 0.f};
#pragma unroll 16
        for (int j = 0; j < 256; ++j) { const float wv = Wo[(size_t)j * 1024 + nb * 64 + n];
#pragma unroll
            for (int e = 0; e < 8; ++e) acc[e] += wf[e * 256 + j] * wv; }
#pragma unroll
        for (int e = 0; e < 8; ++e) tile[(kq * 8 + e) * 65 + n] = acc[e];
    } else if (kb >= 8 && kb < 12) {
        const int g = kb - 8;
        const float* wp = a->in[9] + ((size_t)(l * 4 + g) * 64 + kq * 8) * 64;
        const float* ps = a->in[10] + l * 256 + g * 64;
        float acc[8] = {0.f, 0.f, 0.f, 0.f, 0.f, 0.f, 0.f, 0.f};
#pragma unroll 16
        for (int d = 0; d < 64; ++d) { const float wv = ps[d] * Wo[(size_t)(512 + g * 64 + d) * 1024 + nb * 64 + n];
#pragma unroll
            for (int e = 0; e < 8; ++e) acc[e] += wp[e * 64 + d] * wv; }
#pragma unroll
        for (int e = 0; e < 8; ++e) tile[(kq * 8 + e) * 65 + n] = acc[e];
    } else tile_load(tile, Wo + (size_t)(kb * 64) * 1024 + nb * 64, 1024);
    __syncthreads();
    tile_store_T(tile, (bf16_t*)(a->ws + WS_WOUT) + ((size_t)l * 1024 + nb * 64) * 1024 + kb * 64, 1024);
    __syncthreads();
}

__device__ __forceinline__ void exp_src_dst(AP a, int l, int u, const float*& src, int& srcld, bf16_t*& dst, int& dstld) {
    const int mat = u / 1024, e = (u % 1024) / 32, t = u % 32;
    const int kb = (mat < 2) ? t / 4 : t / 8, nb = (mat < 2) ? t % 4 : t % 8;
    srcld = (mat < 2) ? 512 : 1024; dstld = (mat < 2) ? 1024 : 512;
    src = a->in[18 + mat] + ((size_t)(l * 32 + e) * 512 * 1024) + (size_t)(kb * 128) * srcld + nb * 128;
    dst = (bf16_t*)(a->ws + WS_WEXP) + (size_t)mat * EXPMAT + (size_t)e * 512 * 1024 + (size_t)(nb * 128) * dstld + kb * 128;
}
__device__ __forceinline__ void exp_range(AP a, unsigned char* lds, int l, int u0, int u_end, int G) {
    float* tile = (float*)lds;
    const int tid = tid_opaque();
    __syncthreads();
    if (u0 >= u_end) return;
    const float* src; bf16_t* dst; int srcld, dstld;
    exp_src_dst(a, l, u0, src, srcld, dst, dstld);
    f32x4 v[8];
#pragma unroll
    for (int i = 0; i < 8; ++i) v[i] = *(const f32x4*)(src + (size_t)((tid >> 5) + 16 * i) * srcld + (tid & 31) * 4);
    for (int u = u0; u < u_end; u += G) {
#pragma unroll
        for (int i = 0; i < 8; ++i) { float* tp = tile + ((tid >> 5) + 16 * i) * 129 + (tid & 31) * 4; tp[0] = v[i][0]; tp[1] = v[i][1]; tp[2] = v[i][2]; tp[3] = v[i][3]; }
        __syncthreads();
        bf16_t* cdst = dst; const int cdstld = dstld;
        if (u + G < u_end) { exp_src_dst(a, l, u + G, src, srcld, dst, dstld);
#pragma unroll
            for (int i = 0; i < 8; ++i) v[i] = *(const f32x4*)(src + (size_t)((tid >> 5) + 16 * i) * srcld + (tid & 31) * 4); }
        const int n = tid >> 2, kq = tid & 3;
#pragma unroll
        for (int j = 0; j < 4; ++j) { const float* tp = tile + (kq * 32 + j * 8) * 129 + n; u32x4 w;
            w.x = pack2(tp[0], tp[129]); w.y = pack2(tp[2 * 129], tp[3 * 129]); w.z = pack2(tp[4 * 129], tp[5 * 129]); w.w = pack2(tp[6 * 129], tp[7 * 129]);
            *(u32x4*)(cdst + (size_t)n * cdstld + kq * 32 + j * 8) = w; }
        __syncthreads();
    }
}

__device__ __forceinline__ void exp_queue(AP a, unsigned char* lds, int l) {
    const int tid = tid_opaque();
    int* qslot = (int*)(lds + MISC_OFF + 128);
    unsigned* qc = (unsigned*)(a->ws + WS_BAR + 14336 + l * 256);
    for (;;) {
        __syncthreads();
        if (tid == 0) *qslot = (int)__hip_atomic_fetch_add(qc, 4u, __ATOMIC_RELAXED, __HIP_MEMORY_SCOPE_AGENT);
        __syncthreads();
        const int c0 = *qslot;
        if (c0 >= U_EXP) break;
        exp_range(a, lds, l, c0, c0 + 4, 1);
    }
}

__device__ __forceinline__ void p0_prologue(AP a, unsigned char* lds) {
    const int tid = tid_opaque();
    bool have_tab = false;
    constexpr int E0 = U_ADA, E1 = E0 + U_WIN, E2 = E1 + U_WOUT, E3 = E2 + U_SGU, E4 = E3 + U_DFT, E5 = E4 + U_ROPE;
    int u = blockIdx.x;
    for (; u < E5; u += gridDim.x) {
        if (u < E0) ada_unit(a, lds, u);
        else if (u < E1) win_unit(a, lds, u - E0);
        else if (u < E2) wout_unit(a, lds, u - E1);
        else if (u < E3) { const size_t i0 = (size_t)(u - E2) * 4096 + tid * 8; const float* s = a->in[11] + i0; bf16_t* d = (bf16_t*)(a->ws + WS_WSGU) + i0;
            const f32x4 v0 = *(const f32x4*)s, v1 = *(const f32x4*)(s + 4); u32x4 w; w.x = pack2(v0[0], v0[1]); w.y = pack2(v0[2], v0[3]); w.z = pack2(v1[0], v1[1]); w.w = pack2(v1[2], v1[3]); *(u32x4*)d = w; }
        else if (u < E4) {
            float* ctab = (float*)(lds + LDS_CTAB);
            if (!have_tab) { for (int i = tid; i < 4096; i += NT) ctab[i] = cospif((float)i / 2048.0f); __syncthreads(); have_tab = true; }
            const int k = u - E3 + 4096;
            if (tid < 32) {
                const int kk = k - 4096, n0 = tid * 8; float c[8], s[8];
#pragma unroll
                for (int e = 0; e < 8; ++e) { const int idx = ((kk * (n0 + e)) & 255) * 16; c[e] = ctab[idx] * (1.0f / 16.0f); s[e] = ctab[(idx - 1024) & 4095] * (1.0f / 16.0f); }
                bf16_t* d = (bf16_t*)(a->ws + WS_DFTC) + (size_t)kk * 512 + n0;
                u32x4 w; w.x = pack2(c[0], c[1]); w.y = pack2(c[2], c[3]); w.z = pack2(c[4], c[5]); w.w = pack2(c[6], c[7]); *(u32x4*)d = w;
                w.x = pack2(s[0], s[1]); w.y = pack2(s[2], s[3]); w.z = pack2(s[4], s[5]); w.w = pack2(s[6], s[7]); *(u32x4*)(d + 256) = w;
            }
        }
        else {
            for (int i = tid; i < 1024; i += NT) { const int pos = i >> 4, f = i & 15; const float freq = powf(10000.0f, -(float)f / 16.0f); const float ang = (float)pos * freq;
                ((float2*)(a->ws + WS_ROPE))[i] = make_float2(cosf(ang), sinf(ang)); }
        }
    }
}

__device__ __forceinline__ void p_lnmod0(AP a) {
    const int tid = tid_opaque(), lane = tid & 63, w = tid >> 6;
    const float* mod = (const float*)(a->ws + WS_MOD);
    bf16_t* H = (bf16_t*)(a->ws + WS_H);
    for (int t = blockIdx.x * 8 + w; t < NTOK; t += gridDim.x * 8) {
        const float* src = (t < NLAT) ? a->in[0] + (size_t)t * D : a->in[2] + (size_t)(t - NLAT) * D;
        const float* m = mod + (size_t)((t < NLAT) ? (t >> 12) : 4) * 6144;
        f32x4 v[4];
#pragma unroll
        for (int i = 0; i < 4; ++i) v[i] = *(const f32x4*)(src + 256 * i + 4 * lane);
        float mean, rstd; ln_stats(v, mean, rstd);
#pragma unroll
        for (int i = 0; i < 4; ++i) { const int c = 256 * i + 4 * lane; const f32x4 sh = *(const f32x4*)(m + c), sc = *(const f32x4*)(m + 1024 + c);
            f32x4 o;
#pragma unroll
            for (int e = 0; e < 4; ++e) o[e] = (v[i][e] - mean) * rstd * (1.0f + sc[e]) + sh[e];
            u32x2 pk; pk.x = pack2(o[0], o[1]); pk.y = pack2(o[2], o[3]); *(u32x2*)(H + (size_t)t * D + c) = pk; }
    }
}

__device__ __forceinline__ void p1_inproj(AP a, LAS unsigned char* lds, int l);
__device__ __forceinline__ void rope32(float (&t)[32], const float2* tab) {
#pragma unroll
    for (int f = 0; f < 16; ++f) { const float2 cs = tab[f]; const float t1 = t[f], t2 = t[16 + f]; t[f] = t1 * cs.x - t2 * cs.y; t[16 + f] = t1 * cs.y + t2 * cs.x; }
}
__device__ __forceinline__ void load32(float (&t)[32], const bf16_t* p) {
#pragma unroll
    for (int q = 0; q < 4; ++q) { const u32x4 w = *(const u32x4*)(p + 8 * q);
        t[8 * q + 0] = lo2f(w.x); t[8 * q + 1] = hi2f(w.x); t[8 * q + 2] = lo2f(w.y); t[8 * q + 3] = hi2f(w.y);
        t[8 * q + 4] = lo2f(w.z); t[8 * q + 5] = hi2f(w.z); t[8 * q + 6] = lo2f(w.w); t[8 * q + 7] = hi2f(w.w); }
}

__device__ __forceinline__ float kdot(const bf16_t* kp, const bf16_t* q, const float2* tab0, const float2* tab1, bool do_rope) {
    float dot = 0.f;
#pragma unroll 1
    for (int ax = 0; ax < 2; ++ax) {
        const float2* tab = ax ? tab1 : tab0;
#pragma unroll 1
        for (int h8 = 0; h8 < 2; ++h8) {
            const u32x4 wl = *(const u32x4*)(kp + ax * 32 + h8 * 8), wh = *(const u32x4*)(kp + ax * 32 + 16 + h8 * 8);
            const float tl[8] = {lo2f(wl.x), hi2f(wl.x), lo2f(wl.y), hi2f(wl.y), lo2f(wl.z), hi2f(wl.z), lo2f(wl.w), hi2f(wl.w)};
            const float th[8] = {lo2f(wh.x), hi2f(wh.x), lo2f(wh.y), hi2f(wh.y), lo2f(wh.z), hi2f(wh.z), lo2f(wh.w), hi2f(wh.w)};
#pragma unroll
            for (int j = 0; j < 8; ++j) {
                float r1 = tl[j], r2 = th[j];
                if (do_rope) { const float2 cs = tab[h8 * 8 + j]; r1 = tl[j] * cs.x - th[j] * cs.y; r2 = tl[j] * cs.y + th[j] * cs.x; }
                dot += bf2f(q[ax * 32 + h8 * 8 + j]) * r1 + bf2f(q[ax * 32 + 16 + h8 * 8 + j]) * r2;
            }
        }
    }
    return dot;
}

__device__ __forceinline__ void mixer_tile(AP a, unsigned char* lds, int l, int row0, int seq_row0, int pos0, int n, int b, bool is_ctx) {
    const int tid = tid_opaque(), lane = tid & 63, w = tid >> 6;
    const bf16_t* Z = (const bf16_t*)(a->ws + WS_Z);
    bf16_t* CAT = (bf16_t*)(a->ws + WS_CAT);
    {
        const int c = tid & 255, half = tid >> 8, g = c >> 6, hw = 1 << g;
        for (int tl = half * 64; tl < half * 64 + 64; ++tl) {
            const int pos = pos0 + tl; const int lo = max(pos - hw, 0), hi = min(pos + hw, n);
            float s = 0.f; for (int j = lo; j < hi; ++j) s += bf2f(Z[(size_t)(seq_row0 + j) * ZC + 1024 + c]);
            const float self = bf2f(Z[(size_t)(seq_row0 + pos) * ZC + 1024 + c]);
            CAT[(size_t)(row0 + tl) * D + 512 + c] = f2bf(s / (float)(hi - lo) - self);
        }
    }
    bf16_t* vT = (bf16_t*)lds;
    for (int q = w; q < 128; q += 8) {
        const u32x2 gw = *(const u32x2*)(Z + (size_t)(row0 + q) * ZC + 1536 + 4 * lane);
        float gv[4] = {gelu_erf(lo2f(gw.x)), gelu_erf(hi2f(gw.x)), gelu_erf(lo2f(gw.y)), gelu_erf(hi2f(gw.y))};
        float s = wave_sum((gv[0] + gv[1]) + (gv[2] + gv[3])); const float mean = s * (1.0f / 256.0f);
        float qq = 0.f;
#pragma unroll
        for (int e = 0; e < 4; ++e) { const float d = gv[e] - mean; qq += d * d; }
        qq = wave_sum(qq); const float rstd = 1.0f / sqrtf(qq * (1.0f / 256.0f) + 1e-6f);
#pragma unroll
        for (int e = 0; e < 4; ++e) vT[(4 * lane + e) * 128 + q] = f2bf((gv[e] - mean) * rstd);
    }
    __syncthreads();
    {
        const int c = tid & 255, ph = tid >> 8, h = c >> 6;
        const bf16_t* Ws = (const bf16_t*)(a->ws + WS_WSGU) + (size_t)(l * 4 + h) * 128 * 128;
        const float* bs = a->in[12] + (size_t)(l * 4 + h) * 128;
        for (int p = ph * 64; p < ph * 64 + 64; ++p) {
            float s = 0.f;
#pragma unroll 2
            for (int q8 = 0; q8 < 16; ++q8) {
                const u32x4 ww = *(const u32x4*)(Ws + (size_t)p * 128 + q8 * 8);
                const u32x4 vv = *(const u32x4*)(vT + c * 128 + q8 * 8);
                s += lo2f(ww.x) * lo2f(vv.x) + hi2f(ww.x) * hi2f(vv.x) + lo2f(ww.y) * lo2f(vv.y) + hi2f(ww.y) * hi2f(vv.y)
                   + lo2f(ww.z) * lo2f(vv.z) + hi2f(ww.z) * hi2f(vv.z) + lo2f(ww.w) * lo2f(vv.w) + hi2f(ww.w) * hi2f(vv.w);
            }
            const float uv = gelu_erf(bf2f(Z[(size_t)(row0 + p) * ZC + 1280 + c]));
            CAT[(size_t)(row0 + p) * D + 768 + c] = f2bf(uv * (s + bs[p]));
        }
    }
    __syncthreads();
    {
        const int i = tid & 127, h = tid >> 7, kvh = h >> 1;
        const float2* rope = (const float2*)(a->ws + WS_ROPE);
        const int qpos = pos0 + i;
        bf16_t* q = (bf16_t*)lds + tid * 66;
        {
            float t0[32];
            load32(t0, Z + (size_t)(row0 + i) * ZC + 512 + h * 64);
            if (!is_ctx) rope32(t0, rope + (qpos >> 6) * 16);
#pragma unroll
            for (int d = 0; d < 32; ++d) q[d] = f2bf(t0[d]);
            load32(t0, Z + (size_t)(row0 + i) * ZC + 512 + h * 64 + 32);
            if (!is_ctx) rope32(t0, rope + (qpos & 63) * 16);
#pragma unroll
            for (int d = 0; d < 32; ++d) q[32 + d] = f2bf(t0[d]);
        }
#pragma unroll 1
        for (int dh = 0; dh < 2; ++dh) {
        float m = a->in[8][l * 4 + h], den = 1.0f;
        float o[32];
#pragma unroll
        for (int d = 0; d < 32; ++d) o[d] = 0.f;
        if (!is_ctx) {
            const bf16_t* VT = (const bf16_t*)(a->ws + WS_VT) + ((size_t)(b * 2 + kvh) * 64 + dh * 32) * 4096;
            const int slo = max(qpos - 128, 0), shi = min(qpos + 128, n - 1);
#pragma unroll 1
            for (int s = slo; s <= shi; ++s) {
                const float dot = 0.125f * kdot(Z + (size_t)(seq_row0 + s) * ZC + 768 + kvh * 64, q, rope + (s >> 6) * 16, rope + (s & 63) * 16, true);
                const float mn = fmaxf(m, dot), corr = __expf(m - mn), p = __expf(dot - mn);
                den = den * corr + p; m = mn;
#pragma unroll
                for (int d = 0; d < 32; ++d) o[d] = o[d] * corr + p * bf2f(VT[(size_t)d * 4096 + s]);
            }
        }
        {
            const bf16_t* VTC = (const bf16_t*)(a->ws + WS_VTC) + ((size_t)(b * 2 + kvh) * 64 + dh * 32) * 256;
#pragma unroll 1
            for (int j = 0; j < 256; ++j) {
                const float dot = 0.125f * kdot(Z + (size_t)(NLAT + b * 256 + j) * ZC + 768 + kvh * 64, q, rope, rope, false);
                const float mn = fmaxf(m, dot), corr = __expf(m - mn), p = __expf(dot - mn);
                den = den * corr + p; m = mn;
#pragma unroll
                for (int d = 0; d < 32; ++d) o[d] = o[d] * corr + p * bf2f(VTC[(size_t)d * 256 + j]);
            }
        }
        const float inv = 1.0f / den;
        bf16_t* dst = CAT + (size_t)(row0 + i) * D + 256 + h * 64 + dh * 32;
#pragma unroll
        for (int d8 = 0; d8 < 4; ++d8) { u32x4 pk; pk.x = pack2(o[8 * d8] * inv, o[8 * d8 + 1] * inv); pk.y = pack2(o[8 * d8 + 2] * inv, o[8 * d8 + 3] * inv);
            pk.z = pack2(o[8 * d8 + 4] * inv, o[8 * d8 + 5] * inv); pk.w = pack2(o[8 * d8 + 6] * inv, o[8 * d8 + 7] * inv); *(u32x4*)(dst + 8 * d8) = pk; }
        }
    }
    __syncthreads();
}

__device__ __forceinline__ u32x4 ld16g(const bf16_t* p) { return *(const u32x4*)p; }
__device__ __forceinline__ void rope_pack8(u32x4& wl, u32x4& wh, const LAS f32x2* tab, bool do_rope, float scale) {
    float tl[8] = {lo2f(wl.x), hi2f(wl.x), lo2f(wl.y), hi2f(wl.y), lo2f(wl.z), hi2f(wl.z), lo2f(wl.w), hi2f(wl.w)};
    float th[8] = {lo2f(wh.x), hi2f(wh.x), lo2f(wh.y), hi2f(wh.y), lo2f(wh.z), hi2f(wh.z), lo2f(wh.w), hi2f(wh.w)};
#pragma unroll
    for (int j = 0; j < 8; ++j) {
        float r1 = tl[j], r2 = th[j];
        if (do_rope) { const f32x2 cs = tab[j]; r1 = tl[j] * cs.x - th[j] * cs.y; r2 = tl[j] * cs.y + th[j] * cs.x; }
        tl[j] = r1 * scale; th[j] = r2 * scale;
    }
    wl.x = pack2(tl[0], tl[1]); wl.y = pack2(tl[2], tl[3]); wl.z = pack2(tl[4], tl[5]); wl.w = pack2(tl[6], tl[7]);
    wh.x = pack2(th[0], th[1]); wh.y = pack2(th[2], th[3]); wh.z = pack2(th[4], th[5]); wh.w = pack2(th[6], th[7]);
}

__device__ __forceinline__ void mixer_tile_fast(AP a, LAS unsigned char* lds, int l, int row0, int seq_row0, int pos0, int n, int b, bool is_ctx) {
    const int tid = tid_opaque(), lane = tid & 63, w = __builtin_amdgcn_readfirstlane(tid >> 6), fr = lane & 15, g = lane >> 4;
    const bf16_t* Z = (const bf16_t*)(a->ws + WS_Z);
    bf16_t* CAT = (bf16_t*)(a->ws + WS_CAT);
    ((LAS u32x4*)(lds + 98304))[tid] = ((const u32x4*)(a->ws + WS_ROPE))[tid];
    {
#pragma unroll
        for (int it = 0; it < 9; ++it) { const int id = tid + 512 * it, rr = id >> 5, ch = id & 31, j = pos0 - 8 + rr;
            u32x4 v = (u32x4){0u, 0u, 0u, 0u};
            if (j >= 0 && j < n) v = ld16g(Z + (size_t)(seq_row0 + j) * ZC + 1024 + ch * 8);
            *(LAS u32x4*)(lds + rr * 512 + ch * 16) = v; }
        __syncthreads();
        const int c = tid & 255, half = tid >> 8, hw = 1 << (c >> 6);
        const LAS bf16_t* P = (const LAS bf16_t*)lds + c;
        const int t0 = half * 64;
        float s = 0.f;
        for (int j = t0 - hw; j < t0 + hw; ++j) s += bf2f(P[(8 + j) * 256]);
        for (int tl = t0; tl < t0 + 64; ++tl) {
            const int pos = pos0 + tl; const int lo = max(pos - hw, 0), hi = min(pos + hw, n);
            CAT[(size_t)(row0 + tl) * D + 512 + c] = f2bf(s / (float)(hi - lo) - bf2f(P[(8 + tl) * 256]));
            s += bf2f(P[(8 + tl + hw) * 256]) - bf2f(P[(8 + tl - hw) * 256]);
        }
        __syncthreads();
    }
    {
        const int i16 = lane & 15;
        u32x4 gw[4][2];
#pragma unroll
        for (int ps = 0; ps < 4; ++ps) { const int q = w * 16 + ps * 4 + g; const bf16_t* src = Z + (size_t)(row0 + q) * ZC + 1536 + 16 * i16; gw[ps][0] = ld16g(src); gw[ps][1] = ld16g(src + 8); }
#pragma unroll
        for (int ps = 0; ps < 4; ++ps) {
            const int q = w * 16 + ps * 4 + g;
            float gv[16];
#pragma unroll
            for (int hh = 0; hh < 2; ++hh) { const u32x4 x = gw[ps][hh];
                gv[8 * hh + 0] = gelu_erf(lo2f(x.x)); gv[8 * hh + 1] = gelu_erf(hi2f(x.x)); gv[8 * hh + 2] = gelu_erf(lo2f(x.y)); gv[8 * hh + 3] = gelu_erf(hi2f(x.y));
                gv[8 * hh + 4] = gelu_erf(lo2f(x.z)); gv[8 * hh + 5] = gelu_erf(hi2f(x.z)); gv[8 * hh + 6] = gelu_erf(lo2f(x.w)); gv[8 * hh + 7] = gelu_erf(hi2f(x.w)); }
            float sm = 0.f;
#pragma unroll
            for (int e = 0; e < 16; ++e) sm += gv[e];
            const float mean = row_sum16(sm) * (1.0f / 256.0f);
            float qq = 0.f;
#pragma unroll
            for (int e = 0; e < 16; ++e) { const float d = gv[e] - mean; qq += d * d; }
            const float rstd = 1.0f / sqrtf(row_sum16(qq) * (1.0f / 256.0f) + 1e-6f);
#pragma unroll
            for (int e = 0; e < 16; ++e) { const int c = 16 * i16 + e; *(LAS bf16_t*)(lds + c * 256 + ((((q >> 3) ^ (c & 15))) << 4) + (q & 7) * 2) = f2bf((gv[e] - mean) * rstd); }
        }
    }
    __syncthreads();
    {
        const int h = w >> 1, ph = w & 1;
        const bf16_t* Ws = (const bf16_t*)(a->ws + WS_WSGU) + (size_t)(l * 4 + h) * 128 * 128;
        const float* bs = a->in[12] + (size_t)(l * 4 + h) * 128;
        f32x4 acc[4][4];
#pragma unroll
        for (int i = 0; i < 4; ++i)
#pragma unroll
            for (int j = 0; j < 4; ++j) acc[i][j] = (f32x4){0.f, 0.f, 0.f, 0.f};
#pragma unroll
        for (int ks = 0; ks < 4; ++ks) {
            bf16x8 af[4], bfv[4];
#pragma unroll
            for (int cf = 0; cf < 4; ++cf) { const int c = h * 64 + 16 * cf + fr; af[cf] = *(const LAS bf16x8*)(lds + c * 256 + (((4 * ks + g) ^ (c & 15)) << 4)); }
#pragma unroll
            for (int pf = 0; pf < 4; ++pf) { const int p = ph * 64 + 16 * pf + fr; bfv[pf] = *(const bf16x8*)(Ws + (size_t)p * 128 + 32 * ks + 8 * g); }
#pragma unroll
            for (int cf = 0; cf < 4; ++cf)
#pragma unroll
                for (int pf = 0; pf < 4; ++pf) acc[cf][pf] = __builtin_amdgcn_mfma_f32_16x16x32_bf16(af[cf], bfv[pf], acc[cf][pf], 0, 0, 0);
        }
#pragma unroll
        for (int pf = 0; pf < 4; ++pf) { const int p = ph * 64 + 16 * pf + fr; const float bias = bs[p];
#pragma unroll
            for (int cf = 0; cf < 4; ++cf) { const int c0 = h * 64 + 16 * cf + 4 * g;
                const u32x2 uw = *(const u32x2*)(Z + (size_t)(row0 + p) * ZC + 1280 + c0);
                u32x2 o; o.x = pack2(gelu_erf(lo2f(uw.x)) * (acc[cf][pf][0] + bias), gelu_erf(hi2f(uw.x)) * (acc[cf][pf][1] + bias));
                o.y = pack2(gelu_erf(lo2f(uw.y)) * (acc[cf][pf][2] + bias), gelu_erf(hi2f(uw.y)) * (acc[cf][pf][3] + bias));
                *(u32x2*)(CAT + (size_t)(row0 + p) * D + 768 + c0) = o; } }
    }
    const LAS f32x2* rope = (const LAS f32x2*)(lds + 98304);
    constexpr float QS = 0.125f * 1.44269504088896341f;
    constexpr int QS_OFF = 0, KS_OFF = 32768, VS_OFF = 65536;
    const int nbq = pos0 >> 7;
    unsigned bmask = 0x18u;
    if (!is_ctx) { if (nbq > 0) bmask |= 1u; bmask |= 2u; if (nbq + 1 < (n >> 7)) bmask |= 4u; }
    const int kr = tid >> 2, kax = (tid >> 1) & 1, kh8 = tid & 1;
#define MX_KSRC(blk) (Z + (size_t)((((blk) < 3) ? seq_row0 + (nbq + (blk) - 1) * 128 : NLAT + b * 256 + ((blk) - 3) * 128) + kr) * ZC + 768 + kvh * 64 + kax * 32 + kh8 * 8)
#define MX_VSTAGE(blk, buf) do { const bool _band = (blk) < 3; const int _key0 = _band ? (nbq + (blk) - 1) * 128 : ((blk) - 3) * 128; \
        const bf16_t* _vs = _band ? (const bf16_t*)(a->ws + WS_VT) + (size_t)(b * 2 + kvh) * 64 * 4096 + _key0 : (const bf16_t*)(a->ws + WS_VTC) + (size_t)(b * 2 + kvh) * 64 * 256 + _key0; \
        const int _vld = _band ? 4096 : 256; \
        _Pragma("unroll") for (int _i = 0; _i < 2; ++_i) { const int _P = _i * 512 + tid, _d = _P >> 4, _c = (_P & 15) ^ (_d & 15); \
            glds16(_vs + (size_t)_d * _vld + _c * 8, lds + VS_OFF + (buf) * 16384 + _i * 8192 + w * 1024); } } while (0)
#pragma unroll 1
    for (int kvh = 0; kvh < 2; ++kvh) {
        __syncthreads();
#pragma unroll
        for (int it = 0; it < 2; ++it) {
            const int item = tid + 512 * it, r = item >> 2, ax = (item >> 1) & 1, h8 = item & 1, i = r & 127, qpos = pos0 + i;
            const bf16_t* src = Z + (size_t)(row0 + i) * ZC + 512 + (2 * kvh + (r >> 7)) * 64 + ax * 32 + h8 * 8;
            u32x4 wl = ld16g(src), wh = ld16g(src + 16);
            rope_pack8(wl, wh, rope + (ax ? (qpos & 63) : (qpos >> 6)) * 16 + h8 * 8, !is_ctx, QS);
            const int ch = ax * 4 + h8, sw = (r >> 1) & 7;
            *(LAS u32x4*)(lds + QS_OFF + r * 128 + ((ch ^ sw) << 4)) = wl;
            *(LAS u32x4*)(lds + QS_OFF + r * 128 + (((ch + 2) ^ sw) << 4)) = wh;
        }
        const int hh = w >> 2, qb = (w & 3) * 32, h = 2 * kvh + hh;
        float m[2], lsum[2];
        m[0] = m[1] = a->in[8][l * 4 + h] * 1.44269504088896341f;
        lsum[0] = lsum[1] = (g == 0) ? 1.0f : 0.0f;
        f32x4 O[4][2];
#pragma unroll
        for (int i = 0; i < 4; ++i) { O[i][0] = (f32x4){0.f, 0.f, 0.f, 0.f}; O[i][1] = (f32x4){0.f, 0.f, 0.f, 0.f}; }
        bf16x8 Qf[2][2];
        bool have_q = false;
        unsigned rem = bmask;
        int cur = __builtin_ctz(rem); rem &= rem - 1u;
        int buf = 0;
        u32x4 kl = ld16g(MX_KSRC(cur)), kh = ld16g(MX_KSRC(cur) + 16);
        MX_VSTAGE(cur, 0);
#pragma unroll 1
        for (;;) {
            const int jb = cur - 1; const bool band = cur < 3;
            {
                const int kpos = (nbq + jb) * 128 + kr;
                rope_pack8(kl, kh, rope + (kax ? (kpos & 63) : (kpos >> 6)) * 16 + kh8 * 8, band, 1.0f);
                const int ch = kax * 4 + kh8, sw = (kr >> 1) & 7;
                *(LAS u32x4*)(lds + KS_OFF + buf * 16384 + kr * 128 + ((ch ^ sw) << 4)) = kl;
                *(LAS u32x4*)(lds + KS_OFF + buf * 16384 + kr * 128 + (((ch + 2) ^ sw) << 4)) = kh;
            }
            asm volatile("s_waitcnt vmcnt(0)" ::: "memory");
            __syncthreads();
            const int nxt = rem ? __builtin_ctz(rem) : -1; rem &= rem - 1u;
            if (nxt >= 0) { kl = ld16g(MX_KSRC(nxt)); kh = ld16g(MX_KSRC(nxt) + 16); MX_VSTAGE(nxt, buf ^ 1); }
            if (!have_q) {
#pragma unroll
                for (int qf = 0; qf < 2; ++qf)
#pragma unroll
                    for (int ks = 0; ks < 2; ++ks) { const int r = hh * 128 + qb + 16 * qf + fr; Qf[qf][ks] = *(const LAS bf16x8*)(lds + QS_OFF + r * 128 + (((4 * ks + g) ^ ((r >> 1) & 7)) << 4)); }
                have_q = true;
            }
            const int kso = KS_OFF + buf * 16384, vso = VS_OFF + buf * 16384;
            f32x4 S[8][2];
#pragma unroll
            for (int kf = 0; kf < 8; ++kf) { S[kf][0] = (f32x4){0.f, 0.f, 0.f, 0.f}; S[kf][1] = (f32x4){0.f, 0.f, 0.f, 0.f}; }
#pragma unroll
            for (int kf = 0; kf < 8; ++kf)
#pragma unroll
                for (int ks = 0; ks < 2; ++ks) { const int r = 16 * kf + fr;
                    const bf16x8 kfr = *(const LAS bf16x8*)(lds + kso + r * 128 + (((4 * ks + g) ^ ((r >> 1) & 7)) << 4));
                    S[kf][0] = __builtin_amdgcn_mfma_f32_16x16x32_bf16(kfr, Qf[0][ks], S[kf][0], 0, 0, 0);
                    S[kf][1] = __builtin_amdgcn_mfma_f32_16x16x32_bf16(kfr, Qf[1][ks], S[kf][1], 0, 0, 0); }
            bf16x8 Pp[4][2];
#pragma unroll
            for (int qf = 0; qf < 2; ++qf) {
                const int qi = qb + 16 * qf + fr;
                if (band && jb != 0) {
#pragma unroll
                    for (int kf = 0; kf < 8; ++kf)
#pragma unroll
                        for (int r = 0; r < 4; ++r) { const int kk = 16 * kf + 4 * g + r; const bool ok = (jb < 0) ? (kk >= qi) : (kk <= qi); if (!ok) S[kf][qf][r] = -1.0e30f; }
                }
                float mx = S[0][qf][0];
#pragma unroll
                for (int kf = 0; kf < 8; ++kf)
#pragma unroll
                    for (int r = 0; r < 4; ++r) mx = fmaxf(mx, S[kf][qf][r]);
                mx = fmaxf(mx, __shfl_xor(mx, 16)); mx = fmaxf(mx, __shfl_xor(mx, 32));
                const float mn = fmaxf(m[qf], mx), corr = __builtin_amdgcn_exp2f(m[qf] - mn);
                m[qf] = mn;
                float ps = 0.f;
#pragma unroll
                for (int kf = 0; kf < 8; ++kf)
#pragma unroll
                    for (int r = 0; r < 4; ++r) { const float p = __builtin_amdgcn_exp2f(S[kf][qf][r] - mn); S[kf][qf][r] = p; ps += p; }
                lsum[qf] = lsum[qf] * corr + ps;
#pragma unroll
                for (int df = 0; df < 4; ++df) O[df][qf] *= corr;
#pragma unroll
                for (int t = 0; t < 4; ++t) { u32x4 pw; pw.x = pack2(S[2 * t][qf][0], S[2 * t][qf][1]); pw.y = pack2(S[2 * t][qf][2], S[2 * t][qf][3]);
                    pw.z = pack2(S[2 * t + 1][qf][0], S[2 * t + 1][qf][1]); pw.w = pack2(S[2 * t + 1][qf][2], S[2 * t + 1][qf][3]); Pp[t][qf] = __builtin_bit_cast(bf16x8, pw); }
            }
#pragma unroll
            for (int t = 0; t < 4; ++t)
#pragma unroll
                for (int df = 0; df < 4; ++df) { const int d = 16 * df + fr;
                    const u32x2 v0 = *(const LAS u32x2*)(lds + vso + d * 256 + (((4 * t + (g >> 1)) ^ (d & 15)) << 4) + (g & 1) * 8);
                    const u32x2 v1 = *(const LAS u32x2*)(lds + vso + d * 256 + (((4 * t + 2 + (g >> 1)) ^ (d & 15)) << 4) + (g & 1) * 8);
                    u32x4 vw; vw.x = v0.x; vw.y = v0.y; vw.z = v1.x; vw.w = v1.y; const bf16x8 vf = __builtin_bit_cast(bf16x8, vw);
                    O[df][0] = __builtin_amdgcn_mfma_f32_16x16x32_bf16(vf, Pp[t][0], O[df][0], 0, 0, 0);
                    O[df][1] = __builtin_amdgcn_mfma_f32_16x16x32_bf16(vf, Pp[t][1], O[df][1], 0, 0, 0); }
            if (nxt < 0) break;
            cur = nxt; buf ^= 1;
        }
#pragma unroll
        for (int qf = 0; qf < 2; ++qf) {
            float lt = lsum[qf]; lt += __shfl_xor(lt, 16); lt += __shfl_xor(lt, 32);
            const float inv = 1.0f / lt;
            bf16_t* dst = CAT + (size_t)(row0 + qb + 16 * qf + fr) * D + 256 + h * 64 + 4 * g;
#pragma unroll
            for (int df = 0; df < 4; ++df) { u32x2 o; o.x = pack2(O[df][qf][0] * inv, O[df][qf][1] * inv); o.y = pack2(O[df][qf][2] * inv, O[df][qf][3] * inv); *(u32x2*)(dst + 16 * df) = o; }
        }
    }
#undef MX_KSRC
#undef MX_VSTAGE
    __syncthreads();
}

constexpr int FF_DA = 0, FF_DC = 32768, FF_TW = 49152, FF_XT = 65536, FF_Z2 = 81920, FF_OB = 98304;
__device__ __forceinline__ int ff_addr(int row, int k) { return row * 256 + ((((k >> 3) ^ (row & 15))) << 4) + (k & 7) * 2; }
__device__ __forceinline__ void fft_setup(LAS unsigned char* lds) {
    const int tid = tid_opaque();
    LAS float* TW = (LAS float*)(lds + FF_TW);
    for (int i = tid; i < 4096; i += NT) TW[i] = cospif((float)i / 2048.0f);
    __syncthreads();
    for (int idx = tid; idx < 16384; idx += NT) { const int i = idx >> 7, k = idx & 127, ro = i >> 6, k1 = i & 63, part = k >> 6, n1 = k & 63, j = ((k1 * n1) & 63) * 64;
        const float c = TW[j], sn = TW[(j - 1024) & 4095];
        const float v = (ro == 0) ? (part == 0 ? c : sn) : (part == 0 ? -sn : c);
        *(LAS bf16_t*)(lds + FF_DA + ff_addr(i, k)) = f2bf(v * 0.125f); }
    for (int idx = tid; idx < 8192; idx += NT) { const int k2 = idx >> 7, k = idx & 127, ri = k >> 6, n2 = k & 63, j = ((k2 * n2) & 63) * 64;
        const float v = (ri == 0) ? TW[j] : TW[(j - 1024) & 4095];
        *(LAS bf16_t*)(lds + FF_DC + ff_addr(k2, k)) = f2bf(v * 0.125f); }
    __syncthreads();
}
__device__ __forceinline__ void fft_unit(AP a, LAS unsigned char* lds, int b, int cg) {
    const int tid = tid_opaque(), lane = tid & 63, w = __builtin_amdgcn_readfirstlane(tid >> 6), fr = lane & 15, g = lane >> 4;
    const LAS float* TW = (const LAS float*)(lds + FF_TW);
    const int mf = w & 3, nh = w >> 2;
    const bf16_t* AT = (const bf16_t*)(a->ws + WS_AT) + (size_t)(b * 256 + cg * 4) * 8192;
    u32x4 xin[2];
#pragma unroll
    for (int it = 0; it < 2; ++it) xin[it] = ld16g(AT + (size_t)(tid + 512 * it) * 8);
#pragma unroll 1
    for (int cl = 0; cl < 4; ++cl) {
#pragma unroll
        for (int it = 0; it < 2; ++it) { const int q = tid + 512 * it, part = q >> 9, pos0 = (q & 511) * 8, n1 = pos0 >> 6, n2 = pos0 & 63, k = part * 64 + n1;
            const unsigned wv[4] = {xin[it].x, xin[it].y, xin[it].z, xin[it].w};
#pragma unroll
            for (int e = 0; e < 4; ++e) { *(LAS bf16_t*)(lds + FF_XT + ff_addr(n2 + 2 * e, k)) = (bf16_t)(wv[e] & 0xffffu); *(LAS bf16_t*)(lds + FF_XT + ff_addr(n2 + 2 * e + 1, k)) = (bf16_t)(wv[e] >> 16); } }
        if (cl < 3) {
#pragma unroll
            for (int it = 0; it < 2; ++it) xin[it] = ld16g(AT + (size_t)(cl + 1) * 8192 + (size_t)(tid + 512 * it) * 8); }
        __syncthreads();
        f32x4 acc[2][2];
#pragma unroll
        for (int x = 0; x < 2; ++x) { acc[x][0] = (f32x4){0.f, 0.f, 0.f, 0.f}; acc[x][1] = (f32x4){0.f, 0.f, 0.f, 0.f}; }
#pragma unroll
        for (int ks = 0; ks < 4; ++ks) {
            bf16x8 af[2], bfv[2];
#pragma unroll
            for (int x = 0; x < 2; ++x) { const int i = 16 * (mf + 4 * x) + fr; af[x] = *(const LAS bf16x8*)(lds + FF_DA + i * 256 + (((4 * ks + g) ^ (i & 15)) << 4)); }
#pragma unroll
            for (int n = 0; n < 2; ++n) { const int j = 16 * (2 * nh + n) + fr; bfv[n] = *(const LAS bf16x8*)(lds + FF_XT + j * 256 + (((4 * ks + g) ^ (j & 15)) << 4)); }
#pragma unroll
            for (int x = 0; x < 2; ++x)
#pragma unroll
                for (int n = 0; n < 2; ++n) acc[x][n] = __builtin_amdgcn_mfma_f32_16x16x32_bf16(af[x], bfv[n], acc[x][n], 0, 0, 0);
        }
#pragma unroll
        for (int n = 0; n < 2; ++n)
#pragma unroll
            for (int r = 0; r < 4; ++r) { const int k1 = 16 * mf + 4 * g + r, n2 = 16 * (2 * nh + n) + fr, idx = (k1 * n2) & 4095;
                const float c = TW[idx], sn = TW[(idx - 1024) & 4095], zr = acc[0][n][r], zi = acc[1][n][r];
                *(LAS bf16_t*)(lds + FF_Z2 + ff_addr(k1, n2)) = f2bf(zr * c + zi * sn);
                *(LAS bf16_t*)(lds + FF_Z2 + ff_addr(k1, 64 + n2)) = f2bf(zi * c - zr * sn); }
        __syncthreads();
        f32x4 acc2[2] = {(f32x4){0.f, 0.f, 0.f, 0.f}, (f32x4){0.f, 0.f, 0.f, 0.f}};
#pragma unroll
        for (int ks = 0; ks < 4; ++ks) {
            const int i = 16 * mf + fr; const bf16x8 af = *(const LAS bf16x8*)(lds + FF_DC + i * 256 + (((4 * ks + g) ^ (i & 15)) << 4));
#pragma unroll
            for (int n = 0; n < 2; ++n) { const int j = 16 * (2 * nh + n) + fr; const bf16x8 bfv = *(const LAS bf16x8*)(lds + FF_Z2 + j * 256 + (((4 * ks + g) ^ (j & 15)) << 4));
                acc2[n] = __builtin_amdgcn_mfma_f32_16x16x32_bf16(af, bfv, acc2[n], 0, 0, 0); }
        }
#pragma unroll
        for (int n = 0; n < 2; ++n)
#pragma unroll
            for (int r = 0; r < 4; ++r) { const int k = 16 * (2 * nh + n) + fr + 64 * (16 * mf + 4 * g + r); *(LAS bf16_t*)(lds + FF_OB + k * 8 + cl * 2) = f2bf(acc2[n][r]); }
    }
    __syncthreads();
    bf16_t* CAT = (bf16_t*)(a->ws + WS_CAT) + (size_t)(b * 4096) * D + cg * 4;
#pragma unroll
    for (int it = 0; it < 8; ++it) { const int k = tid + 512 * it; *(u32x2*)(CAT + (size_t)k * D) = *(const LAS u32x2*)(lds + FF_OB + k * 8); }
    __syncthreads();
}

__device__ __forceinline__ void p2_mix(AP a, unsigned char* ldsg, LAS unsigned char* lds, int l) {
    const int n_dft = 256, n_dftc = (l == 0) ? 16 : 0, n_mix = 128 + ((l == 0) ? 8 : 0);
    bf16_t* CAT = (bf16_t*)(a->ws + WS_CAT);
    bool fft_ready = false;
    for (int u = blockIdx.x; u < n_dft + n_dftc + n_mix; u += gridDim.x) {
        if (u < n_dft) {
            if (!fft_ready) { fft_setup(lds); fft_ready = true; }
            for (int rep = 0; rep < PROBE_FFT_REP; ++rep) fft_unit(a, lds, u >> 6, u & 63);
        } else if (u < n_dft + n_dftc) {
            const int uu = u - n_dft, b = uu >> 2, mt = (uu >> 1) & 1, ch0 = (uu & 1) * 128;
            const bf16_t* A = (const bf16_t*)(a->ws + WS_DFTC) + (size_t)(mt * 128) * 512;
            const bf16_t* B0 = (const bf16_t*)(a->ws + WS_ATC) + ((size_t)b * 256 + ch0) * 512;
            EpiBf16 E; E.C = CAT + (size_t)(NLAT + b * 256 + mt * 128) * D + ch0; E.ld = D;
            gemm_tile<128, false, EpiBf16>(lds, A, 512, nullptr, 128, B0, B0 + (size_t)64 * 512, 512, 512, E);
        } else {
            const int t = u - n_dft - n_dftc;
#if NAIVE_MIXER
            if (t < 128) { const int b = t >> 5; mixer_tile(a, ldsg, l, t * 128, b * 4096, (t & 31) * 128, 4096, b, false); }
            else { const int tt = t - 128, b = tt >> 1; mixer_tile(a, ldsg, l, NLAT + tt * 128, NLAT + b * 256, (tt & 1) * 128, 256, b, true); }
#else
            const bool isc = t >= 128; const int tt = t - 128;
            const int b = isc ? (tt >> 1) : (t >> 5);
            for (int rep = 0; rep < PROBE_MIX_REP; ++rep) mixer_tile_fast(a, lds, l, isc ? NLAT + tt * 128 : t * 128, isc ? NLAT + b * 256 : b * 4096, isc ? (tt & 1) * 128 : (t & 31) * 128, isc ? 256 : 4096, b, isc);
#endif
        }
    }
    exp_queue(a, ldsg, l);
}

__device__ __forceinline__ int uni(int v) { return __builtin_amdgcn_readfirstlane(v); }
template <class T> __device__ __forceinline__ T* unip(T* p) { const unsigned long long v = (unsigned long long)p; const unsigned lo = __builtin_amdgcn_readfirstlane((unsigned)v), hi = __builtin_amdgcn_readfirstlane((unsigned)(v >> 32)); return (T*)(((unsigned long long)hi << 32) | lo); }
struct SchedInProj {
    typedef EpiInProj Epi; static constexpr bool GATHER = false;
    unsigned char* ws; int l, G, me;
    __device__ __forceinline__ bool get(int i, g256::Unit<Epi>& u) const {
        const int n_lat = 64 * 7, n_ctx = (l == 0) ? 4 * 7 : 4;
        const int idx = i * G + me; if (idx >= n_lat + n_ctx) return false;
        int row0, b, ct, n; bf16_t *tF, *tV;
        if (idx < n_lat) { const int rt = idx / 7; ct = idx % 7; row0 = rt * 256; b = row0 >> 12; n = 4096;
            tF = (bf16_t*)(ws + WS_AT) + (size_t)b * 256 * 2 * 4096; tV = (bf16_t*)(ws + WS_VT) + (size_t)b * 128 * 4096; }
        else { const int uu = idx - n_lat; int rt; if (l == 0) { rt = uu / 7; ct = uu % 7; } else { rt = uu; ct = 3; }
            row0 = NLAT + rt * 256; b = rt; n = 256;
            tF = (bf16_t*)(ws + WS_ATC) + (size_t)b * 256 * 2 * 256; tV = (bf16_t*)(ws + WS_VTC) + (size_t)b * 128 * 256; }
        u.A = (const bf16_t*)(ws + WS_H) + (size_t)row0 * D;
        u.B0 = (const bf16_t*)(ws + WS_WIN) + ((size_t)l * ZC + ct * 256) * 1024; u.B1 = u.B0 + (size_t)128 * 1024; u.ridx = nullptr; u.valid = 256;
        u.epi.Zt = (bf16_t*)(ws + WS_Z) + (size_t)row0 * ZC + ct * 256; u.epi.tF = tF; u.epi.tV = tV; u.epi.n0 = ct * 256; u.epi.pos0 = (idx < n_lat) ? (row0 & 4095) : 0; u.epi.n = n;
        return true;
    }
};
struct SchedOutProj {
    typedef EpiF32 Epi; static constexpr bool GATHER = false;
    unsigned char* ws; int l, G, me;
    __device__ __forceinline__ bool get(int i, g256::Unit<Epi>& u) const {
        const int nrt = (l == 0) ? NTOK / 256 : NLAT / 256;
        const int idx = i * G + me; if (idx >= nrt * 4) return false;
        const int rt = idx >> 2, ct = idx & 3;
        u.A = (const bf16_t*)(ws + WS_CAT) + (size_t)(rt * 256) * D;
        u.B0 = (const bf16_t*)(ws + WS_WOUT) + ((size_t)l * 1024 + ct * 256) * 1024; u.B1 = u.B0 + (size_t)128 * 1024; u.ridx = nullptr; u.valid = 256;
        u.epi.C = (float*)(ws + WS_Y) + (size_t)(rt * 256) * D + ct * 256; u.epi.ld = D;
        return true;
    }
};
struct SchedGateUp {
    typedef EpiGateUp Epi; static constexpr bool GATHER = true;
    unsigned char* ws; const LAS int* blk; const LAS int* tot; const LAS int* ridx_lds; int G, me;
    __device__ __forceinline__ bool get(int i, g256::Unit<Epi>& u) const {
        const int idx = i * G + me; if (idx >= uni(blk[32]) * 4) return false;
        const int rb = idx >> 2, ct = idx & 3;
        int e = 0;
#pragma unroll 1
        for (int q = 1; q < 32; ++q) if (uni(blk[q]) <= rb) e = q;
        u.A = (const bf16_t*)(ws + WS_H);
        u.B0 = (const bf16_t*)(ws + WS_WEXP) + ((size_t)e * 512 + ct * 128) * 1024; u.B1 = u.B0 + EXPMAT;
        u.ridx = ridx_lds + (i & 7) * 256; u.valid = uni(min(256, tot[e] - (rb - blk[e]) * 256));
        u.epi.C = (bf16_t*)(ws + WS_HID) + (size_t)(rb * 256) * DEXP + ct * 128; u.epi.ld = DEXP;
        return true;
    }
};
struct SchedDown {
    typedef EpiBf16 Epi; static constexpr bool GATHER = false;
    unsigned char* ws; const LAS int* blk; int G, me;
    __device__ __forceinline__ bool get(int i, g256::Unit<Epi>& u) const {
        const int idx = i * G + me; if (idx >= uni(blk[32]) * 4) return false;
        const int rb = idx >> 2, ct = idx & 3;
        int e = 0;
#pragma unroll 1
        for (int q = 1; q < 32; ++q) if (uni(blk[q]) <= rb) e = q;
        u.A = (const bf16_t*)(ws + WS_HID) + (size_t)(rb * 256) * DEXP;
        u.B0 = (const bf16_t*)(ws + WS_WEXP) + 2 * EXPMAT + ((size_t)e * 1024 + ct * 256) * 512; u.B1 = u.B0 + (size_t)128 * 512; u.ridx = nullptr; u.valid = 256;
        u.epi.C = (bf16_t*)(ws + WS_YS) + (size_t)(rb * 256) * D + ct * 256; u.epi.ld = D;
        return true;
    }
};

__device__ __forceinline__ void p4_ln1_router(AP a, unsigned char* lds, int l) {
    const int tid = tid_opaque(), lane = tid & 63, w = tid >> 6;
    const int ntok = (l == 0) ? NTOK : NLAT;
    int* cnt = (int*)(lds + MISC_OFF);
    if (tid < 32) cnt[tid] = 0;
    f32x4* Lg = (f32x4*)lds; f32x4* Le = (f32x4*)(lds + 16384); f32x4* Lgb = (f32x4*)(lds + 147456);
    {
        const float* wrg_ = a->in[16] + (size_t)l * 1024 * 4; const float* wre_ = a->in[17] + (size_t)l * 1024 * 32;
#pragma unroll
        for (int it = 0; it < 2; ++it) { const int c = tid + 512 * it, slot = (((c >> 8) * 4 + (c & 3)) << 6) + ((c >> 2) & 63);
            Lg[slot] = *(const f32x4*)(wrg_ + (size_t)c * 4);
#pragma unroll
            for (int q = 0; q < 8; ++q) Le[q * 1024 + slot] = *(const f32x4*)(wre_ + (size_t)c * 32 + q * 4); }
        Lgb[tid] = (tid < 256) ? *(const f32x4*)(a->in[14] + l * 1024 + tid * 4) : *(const f32x4*)(a->in[15] + l * 1024 + (tid - 256) * 4);
    }
    __syncthreads();
    const float* mod = (const float*)(a->ws + WS_MOD) + (size_t)l * 5 * 6144;
    const float* Y = (const float*)(a->ws + WS_Y);
    float* X1 = (float*)(a->ws + WS_X1);
    bf16_t* H = (bf16_t*)(a->ws + WS_H);
    int* tokE = (int*)(a->ws + WS_TOKE); int* tokR = (int*)(a->ws + WS_TOKR); float* tokG = (float*)(a->ws + WS_TOKG);
    const int tstep = gridDim.x * 8;
    f32x4 nx[4], ny[4];
    {   const int t = blockIdx.x * 8 + w;
        if (t < ntok) { const float* xs = (l == 0) ? ((t < NLAT) ? a->in[0] + (size_t)t * D : a->in[2] + (size_t)(t - NLAT) * D) : (const float*)(a->ws + WS_XC) + (size_t)t * D;
#pragma unroll
            for (int i = 0; i < 4; ++i) { nx[i] = *(const f32x4*)(xs + 256 * i + 4 * lane); ny[i] = *(const f32x4*)(Y + (size_t)t * D + 256 * i + 4 * lane); } } }
    int mrow = -1; f32x4 mg[4], msh[4], msc[4];
    for (int t = blockIdx.x * 8 + w; t < ntok; t += tstep) {
        const int mr = (t < NLAT) ? (t >> 12) : 4;
        if (mr != mrow) { mrow = mr; const float* m = mod + (size_t)mr * 6144;
#pragma unroll
            for (int i = 0; i < 4; ++i) { const int c = 256 * i + 4 * lane; mg[i] = *(const f32x4*)(m + 2048 + c); msh[i] = *(const f32x4*)(m + 3072 + c); msc[i] = *(const f32x4*)(m + 4096 + c); } }
        f32x4 v[4];
#pragma unroll
        for (int i = 0; i < 4; ++i) {
#pragma unroll
            for (int e = 0; e < 4; ++e) v[i][e] = RES_ALPHA * nx[i][e] + mg[i][e] * ny[i][e]; }
        {   const int tn = t + tstep;
            if (tn < ntok) { const float* xs = (l == 0) ? ((tn < NLAT) ? a->in[0] + (size_t)tn * D : a->in[2] + (size_t)(tn - NLAT) * D) : (const float*)(a->ws + WS_XC) + (size_t)tn * D;
#pragma unroll
                for (int i = 0; i < 4; ++i) { nx[i] = *(const f32x4*)(xs + 256 * i + 4 * lane); ny[i] = *(const f32x4*)(Y + (size_t)tn * D + 256 * i + 4 * lane); } } }
        float mean, rstd; ln_stats(v, mean, rstd);
#pragma unroll
        for (int i = 0; i < 4; ++i) { const int c = 256 * i + 4 * lane; const f32x4 gg = Lgb[64 * i + lane], bb = Lgb[256 + 64 * i + lane];
#pragma unroll
            for (int e = 0; e < 4; ++e) v[i][e] = (v[i][e] - mean) * rstd * gg[e] + bb[e];
            *(f32x4*)(X1 + (size_t)t * D + c) = v[i]; }
        ln_stats(v, mean, rstd);
#pragma unroll
        for (int i = 0; i < 4; ++i) { const int c = 256 * i + 4 * lane; const f32x4 sh = msh[i], sc = msc[i];
#pragma unroll
            for (int e = 0; e < 4; ++e) v[i][e] = (v[i][e] - mean) * rstd * (1.0f + sc[e]) + sh[e];
            u32x2 pk; pk.x = pack2(v[i][0], v[i][1]); pk.y = pack2(v[i][2], v[i][3]); *(u32x2*)(H + (size_t)t * D + c) = pk; }
        float lg[4] = {0.f, 0.f, 0.f, 0.f};
#pragma unroll
        for (int i = 0; i < 4; ++i)
#pragma unroll
            for (int e = 0; e < 4; ++e) { const f32x4 wv = Lg[((i * 4 + e) << 6) + lane];
                lg[0] += v[i][e] * wv[0]; lg[1] += v[i][e] * wv[1]; lg[2] += v[i][e] * wv[2]; lg[3] += v[i][e] * wv[3]; }
#pragma unroll
        for (int q = 0; q < 4; ++q) lg[q] = wave_sum(lg[q]);
        int grp = 0; float mx = lg[0];
#pragma unroll
        for (int q = 1; q < 4; ++q) if (lg[q] > mx) { mx = lg[q]; grp = q; }
        float se = 0.f;
#pragma unroll
        for (int q = 0; q < 4; ++q) se += expf(lg[q] - mx);
        const float gate_group = 1.0f / se;
        float le[8] = {0.f, 0.f, 0.f, 0.f, 0.f, 0.f, 0.f, 0.f};
#pragma unroll
        for (int i = 0; i < 4; ++i)
#pragma unroll
            for (int e = 0; e < 4; ++e) { const f32x4* wp = Le + grp * 2048 + ((i * 4 + e) << 6) + lane; const f32x4 w0 = wp[0], w1 = wp[1024];
                le[0] += v[i][e] * w0[0]; le[1] += v[i][e] * w0[1]; le[2] += v[i][e] * w0[2]; le[3] += v[i][e] * w0[3];
                le[4] += v[i][e] * w1[0]; le[5] += v[i][e] * w1[1]; le[6] += v[i][e] * w1[2]; le[7] += v[i][e] * w1[3]; }
#pragma unroll
        for (int q = 0; q < 8; ++q) le[q] = wave_sum(le[q]);
        int j1 = 0; float l1 = le[0];
#pragma unroll
        for (int q = 1; q < 8; ++q) if (le[q] > l1) { l1 = le[q]; j1 = q; }
        int j2 = -1; float l2 = -3.0e38f;
#pragma unroll
        for (int q = 0; q < 8; ++q) if (q != j1 && le[q] > l2) { l2 = le[q]; j2 = q; }
        const float e2 = expf(l2 - l1), p1 = 1.0f / (1.0f + e2), p2 = e2 / (1.0f + e2);
        if (lane == 0) {
            const int ex0 = grp * 8 + j1, ex1 = grp * 8 + j2;
            const int r0 = atomicAdd(&cnt[ex0], 1), r1 = atomicAdd(&cnt[ex1], 1);
            tokE[2 * t] = ex0; tokE[2 * t + 1] = ex1; tokR[2 * t] = r0; tokR[2 * t + 1] = r1;
            tokG[2 * t] = gate_group * p1; tokG[2 * t + 1] = gate_group * p2;
        }
    }
    __syncthreads();
    if (tid < 32) ((int*)(a->ws + WS_BCNT))[((size_t)l * MAXG + blockIdx.x) * 32 + tid] = cnt[tid];
    __syncthreads();
}

__device__ __forceinline__ void p5_dispatch(AP a, unsigned char* lds, int l) {
    const int tid = tid_opaque();
    const int ntok = (l == 0) ? NTOK : NLAT;
    int* part = (int*)lds;
    int* tot = (int*)(lds + 4096);
    int* off = (int*)(lds + 4096 + 128);
    int* pstart = (int*)(lds + 4096 + 256);
    const int* bc = (const int*)(a->ws + WS_BCNT) + (size_t)l * MAXG * 32;
    const int G = gridDim.x, me = blockIdx.x;
    { const int e = tid & 31, p = tid >> 5; int s = 0, so = 0; for (int bb = p; bb < G; bb += 16) { const int c = bc[bb * 32 + e]; s += c; if (bb < me) so += c; } part[p * 32 + e] = s; part[512 + p * 32 + e] = so; }
    __syncthreads();
    if (tid < 32) { int s = 0, so = 0; for (int p = 0; p < 16; ++p) { s += part[p * 32 + tid]; so += part[512 + p * 32 + tid]; } tot[tid] = s; off[tid] = so; }
    __syncthreads();
    if (tid == 0) { int acc = 0; for (int e = 0; e < 32; ++e) { pstart[e] = acc; acc += ((tot[e] + 255) >> 8) << 8; } }
    __syncthreads();
    if (me == 0 && tid < 32) ((int*)(a->ws + WS_CNT))[l * 32 + tid] = tot[tid];
    const int* tokE = (const int*)(a->ws + WS_TOKE); const int* tokR = (const int*)(a->ws + WS_TOKR);
    int* tokS = (int*)(a->ws + WS_TOKS); int* slotT = (int*)(a->ws + WS_SLOTT);
    for (int base = me * 8; base < ntok; base += G * 8) {
        if (tid < 16) { const int t = base + (tid >> 1); if (t < ntok) { const int idx = 2 * t + (tid & 1); const int e = tokE[idx]; const int slot = pstart[e] + off[e] + tokR[idx]; tokS[idx] = slot; slotT[slot] = t; } }
    }
    __syncthreads();
}

__device__ __forceinline__ void moe_table(AP a, int l, LAS int* blk) {
    const int* tot = (const int*)(a->ws + WS_CNT) + l * 32;
    if (threadIdx.x == 0) { int acc = 0; for (int e = 0; e < 32; ++e) { const int c = tot[e]; blk[e] = acc; blk[33 + e] = c; acc += (c + 255) >> 8; } blk[32] = acc; }
    __syncthreads();
}
__device__ __forceinline__ void p1_inproj(AP a, LAS unsigned char* lds, int l) {
    SchedInProj S; S.ws = a->ws; S.l = l; S.G = gridDim.x; S.me = blockIdx.x;
    g256::gemm_phase(lds, 1024, S);
}
__device__ __forceinline__ void p3_outproj(AP a, LAS unsigned char* lds, int l) {
    SchedOutProj S; S.ws = a->ws; S.l = l; S.G = gridDim.x; S.me = blockIdx.x;
    g256::gemm_phase(lds, 1024, S);
}
__device__ __forceinline__ void p6_gateup(AP a, LAS unsigned char* lds, int l) {
    LAS int* blk = (LAS int*)(lds + MISC_OFF + 256);
    moe_table(a, l, blk);
    LAS int* ridx = (LAS int*)(lds + RIDX_OFF);
    const int tid = tid_opaque(), G = gridDim.x, me = blockIdx.x, nu = blk[32] * 4;
    const int* slotT = (const int*)(a->ws + WS_SLOTT);
    for (int i = 0; i < 8; ++i) { const int idx = i * G + me; if (idx >= nu) break;
        const int rb = idx >> 2; int e = 0; for (int q = 1; q < 32; ++q) if (blk[q] <= rb) e = q;
        const int valid = min(256, blk[33 + e] - (rb - blk[e]) * 256);
        if (tid < 256) ridx[i * 256 + tid] = (tid < valid) ? slotT[rb * 256 + tid] : 0; }
    __syncthreads();
    SchedGateUp S; S.ws = a->ws; S.blk = blk; S.tot = blk + 33; S.ridx_lds = ridx; S.G = G; S.me = me;
    g256::gemm_phase(lds, 1024, S);
    __syncthreads();
}
__device__ __forceinline__ void p7_down(AP a, LAS unsigned char* lds, int l) {
    LAS int* blk = (LAS int*)(lds + MISC_OFF + 256);
    moe_table(a, l, blk);
    SchedDown S; S.ws = a->ws; S.blk = blk; S.G = gridDim.x; S.me = blockIdx.x;
    g256::gemm_phase(lds, 512, S);
    __syncthreads();
}

__device__ __forceinline__ void p8_ln2(AP a, unsigned char* lds, int l) {
    const int tid = tid_opaque(), lane = tid & 63, w = tid >> 6;
    const int ntok = (l == 0) ? NTOK : NLAT;
    const float* mod = (const float*)(a->ws + WS_MOD) + (size_t)l * 5 * 6144;
    const float* modn = (const float*)(a->ws + WS_MOD) + (size_t)5 * 6144;
    const float* X1 = (const float*)(a->ws + WS_X1);
    const bf16_t* YS = (const bf16_t*)(a->ws + WS_YS);
    const int* tokS = (const int*)(a->ws + WS_TOKS); const float* tokG = (const float*)(a->ws + WS_TOKG);
    f32x4* Lgb = (f32x4*)lds;
    __syncthreads();
    Lgb[tid] = (tid < 256) ? *(const f32x4*)(a->in[21] + l * 1024 + tid * 4) : *(const f32x4*)(a->in[22] + l * 1024 + (tid - 256) * 4);
    __syncthreads();
    int mrow = -1; f32x4 mg[4], nsh[4], nsc[4];
    const int tstep = gridDim.x * 8;
    int t = blockIdx.x * 8 + w;
    int ns0 = 0, ns1 = 0; float nga = 0.f, ngb = 0.f;
    f32x4 nx[4]; u32x2 nya[4], nyb[4];
    float cga = 0.f, cgb = 0.f;
    if (t < ntok) { const int s0 = tokS[2 * t], s1 = tokS[2 * t + 1]; cga = tokG[2 * t]; cgb = tokG[2 * t + 1];
#pragma unroll
        for (int i = 0; i < 4; ++i) { const int c = 256 * i + 4 * lane; nx[i] = *(const f32x4*)(X1 + (size_t)t * D + c); nya[i] = *(const u32x2*)(YS + (size_t)s0 * D + c); nyb[i] = *(const u32x2*)(YS + (size_t)s1 * D + c); } }
    if (t + tstep < ntok) { ns0 = tokS[2 * (t + tstep)]; ns1 = tokS[2 * (t + tstep) + 1]; nga = tokG[2 * (t + tstep)]; ngb = tokG[2 * (t + tstep) + 1]; }
    for (; t < ntok; t += tstep) {
        const int mr = (t < NLAT) ? (t >> 12) : 4;
        if (mr != mrow) { mrow = mr; const float* m = mod + (size_t)mr * 6144; const float* mn = modn + (size_t)mr * 6144;
#pragma unroll
            for (int i = 0; i < 4; ++i) { const int c = 256 * i + 4 * lane; mg[i] = *(const f32x4*)(m + 5120 + c); if (l == 0) { nsh[i] = *(const f32x4*)(mn + c); nsc[i] = *(const f32x4*)(mn + 1024 + c); } } }
        f32x4 v[4];
#pragma unroll
        for (int i = 0; i < 4; ++i) { const f32x4 gv = mg[i];
            const u32x2 ya = nya[i], yb = nyb[i];
            const float f0 = cga * lo2f(ya.x) + cgb * lo2f(yb.x), f1 = cga * hi2f(ya.x) + cgb * hi2f(yb.x), f2 = cga * lo2f(ya.y) + cgb * lo2f(yb.y), f3 = cga * hi2f(ya.y) + cgb * hi2f(yb.y);
            v[i][0] = RES_ALPHA * nx[i][0] + gv[0] * f0; v[i][1] = RES_ALPHA * nx[i][1] + gv[1] * f1; v[i][2] = RES_ALPHA * nx[i][2] + gv[2] * f2; v[i][3] = RES_ALPHA * nx[i][3] + gv[3] * f3; }
        {   const int tn = t + tstep, tn2 = t + 2 * tstep;
            if (tn < ntok) {
#pragma unroll
                for (int i = 0; i < 4; ++i) { const int c = 256 * i + 4 * lane; nx[i] = *(const f32x4*)(X1 + (size_t)tn * D + c); nya[i] = *(const u32x2*)(YS + (size_t)ns0 * D + c); nyb[i] = *(const u32x2*)(YS + (size_t)ns1 * D + c); }
                cga = nga; cgb = ngb; }
            if (tn2 < ntok) { ns0 = tokS[2 * tn2]; ns1 = tokS[2 * tn2 + 1]; nga = tokG[2 * tn2]; ngb = tokG[2 * tn2 + 1]; } }
        float mean, rstd; ln_stats(v, mean, rstd);
        float* dst = (l == 0) ? (float*)(a->ws + WS_XC) + (size_t)t * D : a->out + (size_t)t * D;
#pragma unroll
        for (int i = 0; i < 4; ++i) { const int c = 256 * i + 4 * lane; const f32x4 gg = Lgb[64 * i + lane], bb = Lgb[256 + 64 * i + lane];
#pragma unroll
            for (int e = 0; e < 4; ++e) v[i][e] = (v[i][e] - mean) * rstd * gg[e] + bb[e];
            *(f32x4*)(dst + c) = v[i]; }
        if (l == 0) {
            ln_stats(v, mean, rstd);
            bf16_t* H = (bf16_t*)(a->ws + WS_H);
#pragma unroll
            for (int i = 0; i < 4; ++i) { const int c = 256 * i + 4 * lane; const f32x4 sh = nsh[i], sc = nsc[i];
                f32x4 o;
#pragma unroll
                for (int e = 0; e < 4; ++e) o[e] = (v[i][e] - mean) * rstd * (1.0f + sc[e]) + sh[e];
                u32x2 pk; pk.x = pack2(o[0], o[1]); pk.y = pack2(o[2], o[3]); *(u32x2*)(H + (size_t)t * D + c) = pk; }
        }
    }
}

constexpr int N_PHASES = 18;
template <int P> __device__ __forceinline__ void run_phase(AP a, unsigned char* smem, LAS unsigned char* lds, int l) {
    asm volatile("" : "+s"(a));
    if (P == 0) p0_prologue(a, smem);
    if (P == 1) p_lnmod0(a);
    if (P == 2) p1_inproj(a, lds, l);
    if (P == 3) p2_mix(a, smem, lds, l);
    if (P == 4) p3_outproj(a, lds, l);
    if (P == 5) p4_ln1_router(a, smem, l);
    if (P == 6) p5_dispatch(a, smem, l);
    if (P == 7) p6_gateup(a, lds, l);
    if (P == 8) p7_down(a, lds, l);
    if (P == 9) p8_ln2(a, smem, l);
}
template <int P> __device__ __noinline__ void phase_fn(AP ap, int l) {
    extern __shared__ __attribute__((aligned(16))) unsigned char smem[];
    run_phase<P>(ap, smem, (LAS unsigned char*)smem, l);
}
#if N_LAUNCH_MODE == 1
__global__ void __launch_bounds__(NT, 2) fwd(Args a) {
    extern __shared__ __attribute__((aligned(16))) unsigned char smem[];
    LAS unsigned char* lds = (LAS unsigned char*)smem;
    if (threadIdx.x < 4) ((volatile LAS unsigned*)(lds + MISC_OFF + 768))[threadIdx.x] = 0u;
    __syncthreads();
    XcdBarrier bar = xcd_barrier_post((unsigned*)(a.ws + WS_BAR), (volatile LAS unsigned*)(lds + MISC_OFF + 768));
    AP ap = (AP)__builtin_amdgcn_kernarg_segment_ptr();
#define PROBE(P, l) do { if (PROBE_MASK & (1 << (P))) { for (int _r = 0; _r < 2; ++_r) { xcd_barrier(bar); run_phase<P>(ap, smem, lds, l); } } } while (0)
    run_phase<0>(ap, smem, lds, 0); PROBE(0, 0); xcd_barrier(bar);
    run_phase<1>(ap, smem, lds, 0); PROBE(1, 0); xcd_barrier(bar);
    for (int l = 0; l < 2; ++l) {
        run_phase<2>(ap, smem, lds, l); PROBE(2, l); xcd_barrier(bar);
        run_phase<3>(ap, smem, lds, l); PROBE(3, l); xcd_barrier(bar);
        run_phase<4>(ap, smem, lds, l); PROBE(4, l); xcd_barrier(bar);
        run_phase<5>(ap, smem, lds, l); PROBE(5, l); xcd_barrier(bar);
        run_phase<6>(ap, smem, lds, l); PROBE(6, l); xcd_barrier(bar);
        run_phase<7>(ap, smem, lds, l); PROBE(7, l); xcd_barrier(bar);
        run_phase<8>(ap, smem, lds, l); PROBE(8, l); xcd_barrier(bar);
        run_phase<9>(ap, smem, lds, l); PROBE(9, l); if (l == 0) xcd_barrier(bar);
    }
}
#else
template <int P> __global__ void __launch_bounds__(NT, 2) k_phase(Args a) {
    extern __shared__ __attribute__((aligned(16))) unsigned char smem[];
    LAS unsigned char* lds = (LAS unsigned char*)smem;
    AP ap = (AP)__builtin_amdgcn_kernarg_segment_ptr();
    run_phase<P>(ap, smem, lds, ap->ph_lo);
}
template <int P> static void launch_phase(Args a, int l, int grid, hipStream_t stream) {
    static bool attr = false;
    if (!attr) { (void)hipFuncSetAttribute((const void*)k_phase<P>, hipFuncAttributeMaxDynamicSharedMemorySize, LDS_BYTES); attr = true; }
    a.ph_lo = l; a.ph_hi = P;
    hipLaunchKernelGGL(k_phase<P>, dim3(grid), dim3(NT), LDS_BYTES, stream, a);
}
#endif

extern "C" void kernel_launch(void* const* d_in, const int* in_sizes, int n_in, void* d_out, int out_size, void* d_ws, size_t ws_size, hipStream_t stream) {
    static int grid = 0;
    if (grid == 0) {
        if (n_in != 23 || out_size != NLAT * D || ws_size < WS_END) { fprintf(stderr, "kernel_launch: unexpected shapes (n_in %d, out %d, ws %zu, need %zu)\n", n_in, out_size, ws_size, (size_t)WS_END); grid = -1; return; }
        int dev = 0, cus = 0;
        if (hipGetDevice(&dev) != hipSuccess || hipDeviceGetAttribute(&cus, hipDeviceAttributeMultiprocessorCount, dev) != hipSuccess) { grid = -1; return; }
#if N_LAUNCH_MODE == 1
        int per_cu = 0;
        if (hipFuncSetAttribute((const void*)fwd, hipFuncAttributeMaxDynamicSharedMemorySize, LDS_BYTES) != hipSuccess) { fprintf(stderr, "kernel_launch: hipFuncSetAttribute failed\n"); grid = -1; return; }
        if (hipOccupancyMaxActiveBlocksPerMultiprocessor(&per_cu, (const void*)fwd, NT, LDS_BYTES) != hipSuccess || per_cu < 1) { fprintf(stderr, "kernel_launch: occupancy query says %d\n", per_cu); }
        (void)hipGetLastError();
#endif
        grid = cus; if (grid > MAXG) grid = MAXG;
    }
    if (grid < 0) return;
    (void)hipMemsetAsync((char*)d_ws + WS_BAR, 0, 16384 + 256, stream);
    Args a{};
    for (int i = 0; i < 23; ++i) a.in[i] = (const float*)d_in[i];
    a.out = (float*)d_out; a.ws = (unsigned char*)d_ws;
#if N_LAUNCH_MODE == 1
    a.ph_lo = 0; a.ph_hi = N_PHASES;
    hipLaunchKernelGGL(fwd, dim3(grid), dim3(NT), LDS_BYTES, stream, a);
#else
    launch_phase<0>(a, 0, grid, stream);
    launch_phase<1>(a, 0, grid, stream);
    for (int l = 0; l < 2; ++l) {
        launch_phase<2>(a, l, grid, stream); launch_phase<3>(a, l, grid, stream); launch_phase<4>(a, l, grid, stream); launch_phase<5>(a, l, grid, stream);
        launch_phase<6>(a, l, grid, stream); launch_phase<7>(a, l, grid, stream); launch_phase<8>(a, l, grid, stream); launch_phase<9>(a, l, grid, stream);
    }
#endif
}
```

```cpp
#include <hip/hip_runtime.h>
#include <stdint.h>
#include <stdio.h>

#ifndef NAIVE_GEMM
#define NAIVE_GEMM 0
#endif
#ifndef NAIVE_MIXER
#define NAIVE_MIXER 0
#endif
#ifndef PROBE_MASK
#define PROBE_MASK 0
#endif
#ifndef PROBE_FFT_REP
#define PROBE_FFT_REP 1
#endif
#ifndef PROBE_MIX_REP
#define PROBE_MIX_REP 1
#endif
#ifndef N_LAUNCH_MODE
#define N_LAUNCH_MODE 1
#endif

#define LAS __attribute__((address_space(3)))
typedef unsigned short bf16_t;
typedef short bf16x8 __attribute__((ext_vector_type(8)));
typedef float f32x4 __attribute__((ext_vector_type(4)));
typedef unsigned u32x4 __attribute__((ext_vector_type(4)));
typedef unsigned u32x2 __attribute__((ext_vector_type(2)));
typedef float f32x2 __attribute__((ext_vector_type(2)));

constexpr int D = 1024, NBATCH = 4, SEQ = 4096, CTXL = 256;
constexpr int NLAT = NBATCH * SEQ, NCTX = NBATCH * CTXL, NTOK = NLAT + NCTX;
constexpr int ZC = 1792;
constexpr int NEXP = 32, DEXP = 512;
constexpr int NSLOT = 2 * NTOK + NEXP * 256;
constexpr int NT = 512;
constexpr int MAXG = 512;
constexpr float RES_ALPHA = 1.41421356237309515f;
constexpr int MISC_OFF = 155648;
constexpr int RIDX_OFF = 131072;
constexpr int LDS_BYTES = MISC_OFF + 1024;

constexpr size_t WS_BAR   = 0;
constexpr size_t WS_CNT   = 16384;
constexpr size_t WS_BCNT  = WS_CNT + 256;
constexpr size_t WS_MOD   = WS_BCNT + (size_t)2 * MAXG * 32 * 4;
constexpr size_t WS_ROPE  = WS_MOD + (size_t)2 * 5 * 6144 * 4;
constexpr size_t WS_TOKE  = WS_ROPE + 8192;
constexpr size_t WS_TOKR  = WS_TOKE + (size_t)NTOK * 8;
constexpr size_t WS_TOKS  = WS_TOKR + (size_t)NTOK * 8;
constexpr size_t WS_TOKG  = WS_TOKS + (size_t)NTOK * 8;
constexpr size_t WS_SLOTT = WS_TOKG + (size_t)NTOK * 8;
constexpr size_t WS_WIN   = WS_SLOTT + (size_t)NSLOT * 4;
constexpr size_t WS_WOUT  = WS_WIN + (size_t)2 * ZC * 1024 * 2;
constexpr size_t WS_WSGU  = WS_WOUT + (size_t)2 * 1024 * 1024 * 2;
constexpr size_t WS_DFT   = WS_WSGU + (size_t)2 * 4 * 128 * 128 * 2;
constexpr size_t WS_DFTC  = WS_DFT + (size_t)4096 * 8192 * 2;
constexpr size_t WS_WEXP  = WS_DFTC + (size_t)256 * 512 * 2;
constexpr size_t EXPMAT   = (size_t)NEXP * 512 * 1024;
constexpr size_t WS_X1    = WS_WEXP + 3 * EXPMAT * 2;
constexpr size_t WS_XC    = WS_X1 + (size_t)NTOK * D * 4;
constexpr size_t WS_H     = WS_XC + (size_t)NTOK * D * 4;
constexpr size_t WS_R     = WS_H + (size_t)NTOK * D * 2;
constexpr size_t WS_Z     = WS_R;
constexpr size_t WS_AT    = WS_Z + (size_t)NTOK * ZC * 2;
constexpr size_t WS_ATC   = WS_AT + (size_t)4 * 256 * 8192 * 2;
constexpr size_t WS_VT    = WS_ATC + (size_t)4 * 256 * 512 * 2;
constexpr size_t WS_VTC   = WS_VT + (size_t)4 * 2 * 64 * 4096 * 2;
constexpr size_t WS_CAT   = WS_VTC + (size_t)4 * 2 * 64 * 256 * 2;
constexpr size_t WS_REND  = WS_CAT + (size_t)NTOK * D * 2;
constexpr size_t WS_Y     = WS_R;
constexpr size_t WS_HID   = WS_R;
constexpr size_t WS_YS    = WS_HID + (size_t)NSLOT * DEXP * 2;
constexpr size_t WS_END   = (WS_YS + (size_t)NSLOT * D * 2 > WS_REND) ? WS_YS + (size_t)NSLOT * D * 2 : WS_REND;
static_assert(WS_Y + (size_t)NTOK * D * 4 <= WS_CAT, "Y must not reach CAT");
static_assert(WS_WIN % 256 == 0 && WS_DFT % 256 == 0 && WS_WEXP % 256 == 0 && WS_X1 % 256 == 0 && WS_H % 256 == 0 && WS_R % 256 == 0 && WS_AT % 256 == 0 && WS_CAT % 256 == 0 && WS_YS % 256 == 0, "alignment");

struct Args { const float* in[23]; float* out; unsigned char* ws; int ph_lo, ph_hi; };
#define CAS __attribute__((address_space(4)))
typedef const CAS Args* AP;

#define XB_TMO      128
#define XB_XCNT(j)  (256  + 64 * (j))
#define XB_XSUB(j)  (1280 + 64 * (j))
#define XB_XGEN(j)  (2304 + 64 * (j))
#define XB_TOP      3328
#define XB_TOPGEN   3392
#define XCD_BAR_WORDS 3456
#define XB_SPIN_CAP (1u << 18)

__device__ __forceinline__ unsigned xb_ld(unsigned* p)              { return __hip_atomic_load(p, __ATOMIC_RELAXED, __HIP_MEMORY_SCOPE_AGENT); }
__device__ __forceinline__ unsigned xb_add(unsigned* p, unsigned v) { return __hip_atomic_fetch_add(p, v, __ATOMIC_RELAXED, __HIP_MEMORY_SCOPE_AGENT); }
__device__ __forceinline__ unsigned xb_xcc_id() { return (unsigned)__builtin_amdgcn_s_getreg((3 << 11) | 20) & 0xFu; }
#define XB_SPIN(cond, bar) do { unsigned _sp = 0; while (cond) { __builtin_amdgcn_s_sleep(1); \
    if ((++_sp & 255u) == 0u) { if (xb_ld(&(bar)[XB_TMO])) break; if (_sp > XB_SPIN_CAP) { atomicAdd(&(bar)[XB_TMO], 1u); break; } } } } while (0)

struct XcdBarrier { unsigned* bar; unsigned x; volatile LAS unsigned* st; };

__device__ __forceinline__ XcdBarrier xcd_barrier_post(unsigned* bar, volatile LAS unsigned* st) {
    XcdBarrier b; b.bar = bar; b.x = (unsigned)__builtin_amdgcn_readfirstlane((int)xb_xcc_id()); b.st = st;
    if (threadIdx.x == 0) (void)xb_add(&bar[XB_XCNT(b.x)], 1u);
    return b;
}
__device__ __forceinline__ void xcd_barrier_complete(unsigned* bar, unsigned x, unsigned& nloc, unsigned& nx) {
    const unsigned G = gridDim.x * gridDim.y * gridDim.z;
    unsigned sum, cnt, mine, sp = 0u;
    for (;;) {
        sum = 0u; cnt = 0u; mine = 0u;
#pragma unroll
        for (unsigned j = 0; j < 16; ++j) { const unsigned c = xb_ld(&bar[XB_XCNT(j)]); sum += c; cnt += (c > 0u) ? 1u : 0u; mine = (j == x) ? c : mine; }
        if (sum == G) break;
        __builtin_amdgcn_s_sleep(1);
        if ((++sp & 255u) == 0u) { if (xb_ld(&bar[XB_TMO])) break; if (sp > XB_SPIN_CAP) { atomicAdd(&bar[XB_TMO], 1u); break; } }
    }
    nloc = mine > 0u ? mine : 1u; nx = cnt > 0u ? cnt : 1u;
}
__device__ __forceinline__ void xcd_barrier(const XcdBarrier& b) {
    asm volatile("s_waitcnt vmcnt(0)" ::: "memory");
    __syncthreads();
    if (threadIdx.x == 0) {
        unsigned* bar = b.bar;
        unsigned bx = b.x;
        asm volatile("" : "+s"(bar), "+s"(bx));
        __builtin_amdgcn_s_waitcnt(0);
        unsigned nloc = b.st[0], nx = b.st[1];
        if (nloc == 0u) { xcd_barrier_complete(bar, bx, nloc, nx); b.st[0] = nloc; b.st[1] = nx; }
        const unsigned old = xb_add(&bar[XB_XSUB(bx)], 1u);
        const unsigned gen = old / nloc;
        if (old + 1u == (gen + 1u) * nloc) {
            __builtin_amdgcn_fence(__ATOMIC_RELEASE, "agent");
            asm volatile("s_waitcnt vmcnt(0)" ::: "memory");
            const unsigned og = xb_add(&bar[XB_TOP], 1u);
            const unsigned tg = og / nx;
            if (og + 1u == (tg + 1u) * nx) xb_add(&bar[XB_TOPGEN], 1u);
            else XB_SPIN(xb_ld(&bar[XB_TOPGEN]) == tg, bar);
            __builtin_amdgcn_fence(__ATOMIC_ACQUIRE, "agent");
            xb_add(&bar[XB_XGEN(bx)], 1u);
            asm volatile("s_waitcnt vmcnt(0)" ::: "memory");
        } else {
            XB_SPIN(xb_ld(&bar[XB_XGEN(bx)]) == gen, bar);
            __builtin_amdgcn_fence(__ATOMIC_ACQUIRE, "agent");
            asm volatile("s_waitcnt vmcnt(0)" ::: "memory");
        }
    }
    __syncthreads();
}

__device__ __forceinline__ int tid_opaque() { int t = threadIdx.x; asm volatile("" : "+v"(t)); return t; }
__device__ __forceinline__ float bf2f(bf16_t v) { return __uint_as_float(((unsigned)v) << 16); }
__device__ __forceinline__ bf16_t f2bf(float f) { return __builtin_bit_cast(unsigned short, (__bf16)f); }
typedef __bf16 hwbf16x2 __attribute__((ext_vector_type(2)));
__device__ __forceinline__ unsigned pack2(float a, float b) { return __builtin_bit_cast(unsigned, __builtin_convertvector((f32x2){a, b}, hwbf16x2)); }
__device__ __forceinline__ float lo2f(unsigned w) { return __uint_as_float(w << 16); }
__device__ __forceinline__ float hi2f(unsigned w) { return __uint_as_float(w & 0xffff0000u); }
template <int CTRL> __device__ __forceinline__ float dpp_mov(float v) { return __builtin_bit_cast(float, __builtin_amdgcn_update_dpp(0, __builtin_bit_cast(int, v), CTRL, 0xf, 0xf, true)); }
__device__ __forceinline__ float row_sum16(float v) {
    v += dpp_mov<0xB1>(v);
    v += dpp_mov<0x4E>(v);
    v += dpp_mov<0x141>(v);
    v += dpp_mov<0x140>(v);
    return v;
}
__device__ __forceinline__ float row_max16(float v) {
    v = fmaxf(v, dpp_mov<0xB1>(v)); v = fmaxf(v, dpp_mov<0x4E>(v)); v = fmaxf(v, dpp_mov<0x141>(v)); v = fmaxf(v, dpp_mov<0x140>(v));
    return v;
}
__device__ __forceinline__ float wave_sum(float v) {
    v = row_sum16(v);
    const int iv = __builtin_bit_cast(int, v);
    const float a0 = __builtin_bit_cast(float, __builtin_amdgcn_readlane(iv, 0)), a1 = __builtin_bit_cast(float, __builtin_amdgcn_readlane(iv, 16));
    const float a2 = __builtin_bit_cast(float, __builtin_amdgcn_readlane(iv, 32)), a3 = __builtin_bit_cast(float, __builtin_amdgcn_readlane(iv, 48));
    return (a0 + a1) + (a2 + a3);
}
__device__ __forceinline__ float gelu_erf(float v) {
    const float t = __builtin_amdgcn_rcpf(fabsf(v) * 0.2316418882f + 1.0f);
    float q = t * 0.5307027145f + (-0.7265760135f); q = q * t + 0.7107068705f; q = q * t + (-0.142248368f); q = q * t + 0.127414796f; q = q * t;
    const float m = v * (q * __builtin_amdgcn_exp2f((v * v) * (-0.72134752044f)));
    return v < 0.f ? m : v - m;
}
__device__ __forceinline__ float silu_f(float x) { return x / (1.0f + __expf(-x)); }

__device__ __forceinline__ void ln_stats(const f32x4 (&v)[4], float& mean, float& rstd) {
    float s = 0.f;
#pragma unroll
    for (int i = 0; i < 4; ++i) s += (v[i][0] + v[i][1]) + (v[i][2] + v[i][3]);
    s = wave_sum(s); mean = s * (1.0f / 1024.0f);
    float q = 0.f;
#pragma unroll
    for (int i = 0; i < 4; ++i)
#pragma unroll
        for (int e = 0; e < 4; ++e) { const float d = v[i][e] - mean; q += d * d; }
    q = wave_sum(q); rstd = 1.0f / sqrtf(q * (1.0f / 1024.0f) + 1e-6f);
}

__device__ __forceinline__ void ln_stats16(const f32x4 (&v)[16], float& mean, float& rstd) {
    float s = 0.f;
#pragma unroll
    for (int k = 0; k < 16; ++k) s += (v[k][0] + v[k][1]) + (v[k][2] + v[k][3]);
    s = row_sum16(s); mean = s * (1.0f / 1024.0f);
    float q = 0.f;
#pragma unroll
    for (int k = 0; k < 16; ++k)
#pragma unroll
        for (int e = 0; e < 4; ++e) { const float d = v[k][e] - mean; q += d * d; }
    q = row_sum16(q); rstd = 1.0f / sqrtf(q * (1.0f / 1024.0f) + 1e-6f);
}

template <int BN> struct MfmaLayout {
    static constexpr int FG = BN / 128, NI = 4, NJ = 2 * FG;
    int rbase, cbase;
    __device__ __forceinline__ int row(int i) const { return rbase + 16 * i; }
    __device__ __forceinline__ int col(int jj) const { return (jj / FG) * (BN / 2) + (jj % FG) * 16 + cbase; }
};
template <int BN> struct NaiveLayout {
    static constexpr int TX = BN / 8, TY = NT / TX, NI = 128 / TY, NJ = 2;
    int ty, tx;
    __device__ __forceinline__ int row(int i) const { return ty + TY * i; }
    __device__ __forceinline__ int col(int jj) const { return jj * (BN / 2) + 4 * tx; }
};

__device__ __forceinline__ void glds16(const bf16_t* g, LAS unsigned char* l) {
    __builtin_amdgcn_global_load_lds((const unsigned*)g, (LAS unsigned*)l, 16, 0, 0);
}

template <int BN, bool GATHER, class Epi>
__device__ __forceinline__ void gemm_tile(LAS unsigned char* lds, const bf16_t* A, int lda, const int* rowidx, int valid_rows,
                                          const bf16_t* B0, const bf16_t* B1, int ldb, int K, const Epi& epi) {
    constexpr int A_B = 16384, B_B = BN * 128, STAGE = A_B + B_B, NBL = BN / 64;
    const int tid = tid_opaque(), lane = tid & 63, wid = __builtin_amdgcn_readfirstlane(tid >> 6);
    const bf16_t* ap[2]; const bf16_t* bp[NBL];
#pragma unroll
    for (int i = 0; i < 2; ++i) {
        const int P = i * 512 + tid, row = P >> 3, c = (P & 7) ^ ((row >> 1) & 7);
        size_t ro;
        if (GATHER) ro = (size_t)(row < valid_rows ? rowidx[row] : 0) * (size_t)lda; else ro = (size_t)row * (size_t)lda;
        ap[i] = A + ro + c * 8;
    }
#pragma unroll
    for (int i = 0; i < NBL; ++i) {
        const int P = i * 512 + tid, row = P >> 3, c = (P & 7) ^ ((row >> 1) & 7);
        const bf16_t* base = (row < BN / 2) ? (B0 + (size_t)row * ldb) : (B1 + (size_t)(row - BN / 2) * ldb);
        bp[i] = base + c * 8;
    }
    const int nk = K / 64;
#define GT_STAGE(buf, k0) do { \
        _Pragma("unroll") for (int _i = 0; _i < 2; ++_i) glds16(ap[_i] + (k0), lds + (buf) * STAGE + _i * 8192 + wid * 1024); \
        _Pragma("unroll") for (int _i = 0; _i < NBL; ++_i) glds16(bp[_i] + (k0), lds + (buf) * STAGE + A_B + _i * 8192 + wid * 1024); } while (0)

#if NAIVE_GEMM
    typedef NaiveLayout<BN> Lay;
    Lay lay; lay.tx = tid % Lay::TX; lay.ty = tid / Lay::TX;
    f32x4 acc[Lay::NI][Lay::NJ];
#pragma unroll
    for (int i = 0; i < Lay::NI; ++i)
#pragma unroll
        for (int j = 0; j < Lay::NJ; ++j) acc[i][j] = (f32x4){0.f, 0.f, 0.f, 0.f};
    GT_STAGE(0, 0);
    asm volatile("s_waitcnt vmcnt(0)" ::: "memory"); __syncthreads();
    for (int kt = 0; kt < nk; ++kt) {
        if (kt + 1 < nk) GT_STAGE((kt + 1) & 1, (kt + 1) * 64);
        const LAS unsigned char* sa = lds + (kt & 1) * STAGE; const LAS unsigned char* sb = sa + A_B;
#pragma unroll 1
        for (int kc = 0; kc < 8; ++kc)
#pragma unroll 1
            for (int hh = 0; hh < 2; ++hh) {
                float a[Lay::NI][4];
#pragma unroll
                for (int i = 0; i < Lay::NI; ++i) { const int row = lay.row(i);
                    const u32x2 w = *(const LAS u32x2*)(sa + row * 128 + ((kc ^ ((row >> 1) & 7)) << 4) + hh * 8);
                    a[i][0] = lo2f(w.x); a[i][1] = hi2f(w.x); a[i][2] = lo2f(w.y); a[i][3] = hi2f(w.y); }
#pragma unroll
                for (int j = 0; j < 2; ++j)
#pragma unroll
                    for (int e = 0; e < 4; ++e) { const int row = j * (BN / 2) + 4 * lay.tx + e;
                        const u32x2 w = *(const LAS u32x2*)(sb + row * 128 + ((kc ^ ((row >> 1) & 7)) << 4) + hh * 8);
                        const float b0 = lo2f(w.x), b1 = hi2f(w.x), b2 = lo2f(w.y), b3 = hi2f(w.y);
#pragma unroll
                        for (int i = 0; i < Lay::NI; ++i) acc[i][j][e] += (a[i][0] * b0 + a[i][1] * b1) + (a[i][2] * b2 + a[i][3] * b3); }
            }
        asm volatile("s_waitcnt vmcnt(0)" ::: "memory"); __syncthreads();
    }
    epi.run(acc, lay);
#else
    typedef MfmaLayout<BN> Lay;
    constexpr int FG = Lay::FG;
    const int fr = lane & 15, g = lane >> 4, wr = wid >> 2, wc = wid & 3;
    Lay lay; lay.rbase = wr * 64 + fr; lay.cbase = wc * 16 * FG + 4 * g;
    f32x4 acc[Lay::NI][Lay::NJ];
#pragma unroll
    for (int i = 0; i < Lay::NI; ++i)
#pragma unroll
        for (int j = 0; j < Lay::NJ; ++j) acc[i][j] = (f32x4){0.f, 0.f, 0.f, 0.f};
    int aoff[4], boff[Lay::NJ];
#pragma unroll
    for (int m = 0; m < 4; ++m) { const int row = wr * 64 + m * 16 + fr; aoff[m] = row * 128 + ((g ^ ((row >> 1) & 7)) << 4); }
#pragma unroll
    for (int jj = 0; jj < Lay::NJ; ++jj) { const int row = (jj / FG) * (BN / 2) + wc * 16 * FG + (jj % FG) * 16 + fr; boff[jj] = A_B + row * 128 + ((g ^ ((row >> 1) & 7)) << 4); }
    GT_STAGE(0, 0);
    asm volatile("s_waitcnt vmcnt(0)" ::: "memory"); __syncthreads();
    for (int kt = 0; kt < nk; ++kt) {
        if (kt + 1 < nk) GT_STAGE((kt + 1) & 1, (kt + 1) * 64);
        const LAS unsigned char* sa = lds + (kt & 1) * STAGE;
#pragma unroll
        for (int ks = 0; ks < 2; ++ks) {
            bf16x8 af[4], bfv[Lay::NJ];
#pragma unroll
            for (int m = 0; m < 4; ++m) af[m] = *(const LAS bf16x8*)(sa + (aoff[m] ^ (ks << 6)));
#pragma unroll
            for (int jj = 0; jj < Lay::NJ; ++jj) bfv[jj] = *(const LAS bf16x8*)(sa + (boff[jj] ^ (ks << 6)));
#pragma unroll
            for (int m = 0; m < 4; ++m)
#pragma unroll
                for (int jj = 0; jj < Lay::NJ; ++jj) acc[m][jj] = __builtin_amdgcn_mfma_f32_16x16x32_bf16(bfv[jj], af[m], acc[m][jj], 0, 0, 0);
        }
        asm volatile("s_waitcnt vmcnt(0)" ::: "memory"); __syncthreads();
    }
    epi.run(acc, lay);
#endif
#undef GT_STAGE
}

namespace g256 {
constexpr int BK = 64, HALF = 128, HTB = HALF * BK * 2, STAGE_BYTES = 8 * HTB;
__device__ __forceinline__ int lds_byte(int r, int c) { const int st = (r >> 4) * 2 + (c >> 5), rr = r & 15, cc = c & 31, ob = rr * 64 + cc * 2; return st * 1024 + (ob ^ (((ob >> 9) & 1) << 5)); }
__device__ __forceinline__ void stage_rc(int b, int& R, int& C) { const int st = b / 1024, sb = b % 1024, swz = sb ^ (((sb >> 9) & 1) << 5); R = (st >> 1) * 16 + swz / 64; C = (st & 1) * 32 + (swz % 64) / 2; }
struct Lay {
    static constexpr int NI = 8, NJ = 4;
    int rbase, cbase;
    __device__ __forceinline__ int row(int i) const { return (i >> 2) * 128 + (i & 3) * 16 + rbase; }
    __device__ __forceinline__ int col(int j) const { return (j >> 1) * 128 + (j & 1) * 16 + cbase; }
};
template <class Epi> struct Unit { const bf16_t* A; const bf16_t* B0; const bf16_t* B1; const LAS int* ridx; int valid; Epi epi; };

template <class Sched>
__device__ __forceinline__ void gemm_phase(LAS unsigned char* lds, const int K, const Sched& S) {
    typedef typename Sched::Epi Epi;
    const int tid = tid_opaque(), wid = __builtin_amdgcn_readfirstlane(tid >> 6), lane = tid & 63, wr = wid >> 2, wc = wid & 3, fr = lane & 15, fq = lane >> 4;
    const int nt = K / BK;
    int sR[2], sC[2];
#pragma unroll
    for (int i = 0; i < 2; ++i) stage_rc(tid * 16 + i * 8192, sR[i], sC[i]);
    unsigned voffB[2];
#pragma unroll
    for (int i = 0; i < 2; ++i) voffB[i] = (unsigned)(sR[i] * K + sC[i]) * 2u;
    const size_t kstep = (size_t)(BK * 2);
    const unsigned ldsw = (unsigned)wid * 1024u;
    const int aoff = lds_byte(wr * 64 + fr, fq * 8), boff = lds_byte(wc * 32 + fr, fq * 8);
#define G2_SA(b, h) (((b) * 2 + (h)) * HTB)
#define G2_SB(b, h) ((4 + (b) * 2 + (h)) * HTB)
#define G2_STAGE(bufoff, gbase, v0, v1) do { \
        __builtin_amdgcn_global_load_lds((const unsigned*)((const char*)(gbase) + (v0)), (LAS unsigned*)(lds + (bufoff) + ldsw), 16, 0, 0); \
        __builtin_amdgcn_global_load_lds((const unsigned*)((const char*)(gbase) + (v1)), (LAS unsigned*)(lds + (bufoff) + ldsw + 8192), 16, 0, 0); } while (0)
#define G2_LDA(dst, b, h) do { _Pragma("unroll") for (int m = 0; m < 4; ++m) _Pragma("unroll") for (int k = 0; k < 2; ++k) dst[m][k] = *(const LAS bf16x8*)(lds + G2_SA(b, h) + aoff + m * 2048 + k * 1024); } while (0)
#define G2_LDB(dst, b, h) do { _Pragma("unroll") for (int n = 0; n < 2; ++n) _Pragma("unroll") for (int k = 0; k < 2; ++k) dst[n][k] = *(const LAS bf16x8*)(lds + G2_SB(b, h) + boff + n * 2048 + k * 1024); } while (0)
#define G2_MMA(ai, bj, At, Bt) do { __builtin_amdgcn_s_setprio(1); _Pragma("unroll") for (int m = 0; m < 4; ++m) _Pragma("unroll") for (int n = 0; n < 2; ++n) _Pragma("unroll") for (int k = 0; k < 2; ++k) \
        acc[(ai) * 4 + m][(bj) * 2 + n] = __builtin_amdgcn_mfma_f32_16x16x32_bf16(Bt[n][k], At[m][k], acc[(ai) * 4 + m][(bj) * 2 + n], 0, 0, 0); __builtin_amdgcn_s_setprio(0); } while (0)
#define G2_WAIT_V(n) asm volatile("s_waitcnt vmcnt(" #n ")" ::: "memory")
#define G2_WAIT_L(n) asm volatile("s_waitcnt lgkmcnt(" #n ")" ::: "memory")
#define G2_BAR __builtin_amdgcn_s_barrier()
#define G2_SCHED __builtin_amdgcn_sched_barrier(0)
#define G2_VOFFA(U, dst) do { _Pragma("unroll") for (int _h = 0; _h < 2; ++_h) _Pragma("unroll") for (int _i = 0; _i < 2; ++_i) { const int _row = _h * 128 + sR[_i]; \
        int _tok = _row; if (Sched::GATHER) _tok = (_row < (U).valid) ? (U).ridx[_row] : 0; dst[_h][_i] = (unsigned)(_tok * K + sC[_i]) * 2u; } } while (0)
    Unit<Epi> cur, nxt; int ui = 0;
    if (!S.get(0, cur)) return;
    f32x4 acc[8][4];
#pragma unroll
    for (int i = 0; i < 8; ++i)
#pragma unroll
        for (int j = 0; j < 4; ++j) acc[i][j] = (f32x4){0.f, 0.f, 0.f, 0.f};
    bf16x8 At[4][2], B0[2][2], B1[2][2];
    unsigned cvA[2][2], nvA[2][2];
    G2_VOFFA(cur, cvA);
    const char* cA = (const char*)cur.A; const char* cB0 = (const char*)cur.B0; const char* cB1 = (const char*)cur.B1;
    G2_STAGE(G2_SB(0, 0), cB0, voffB[0], voffB[1]); G2_STAGE(G2_SA(0, 0), cA, cvA[0][0], cvA[0][1]); G2_STAGE(G2_SB(0, 1), cB1, voffB[0], voffB[1]); G2_STAGE(G2_SA(0, 1), cA, cvA[1][0], cvA[1][1]);
    if (wr == 1) G2_BAR;
    G2_WAIT_V(4); G2_BAR;
    G2_STAGE(G2_SB(1, 0), cB0 + kstep, voffB[0], voffB[1]); G2_STAGE(G2_SA(1, 0), cA + kstep, cvA[0][0], cvA[0][1]); G2_STAGE(G2_SB(1, 1), cB1 + kstep, voffB[0], voffB[1]);
    G2_WAIT_V(6); G2_BAR;
    for (;;) {
        const bool has_next = S.get(ui + 1, nxt);
        if (Sched::GATHER) {
            if (has_next) { G2_VOFFA(nxt, nvA); }
            else {
#pragma unroll
                for (int h = 0; h < 2; ++h) { nvA[h][0] = cvA[h][0]; nvA[h][1] = cvA[h][1]; } }
        }
        const char* nA = has_next ? (const char*)nxt.A : cA; const char* nB0 = has_next ? (const char*)nxt.B0 : cB0; const char* nB1 = has_next ? (const char*)nxt.B1 : cB1;
        for (int t = 0; t < nt; t += 2) {
            const bool last = (t == nt - 2);
            const char* a1 = cA + (size_t)(t + 1) * kstep;
            const char* a2 = last ? nA : cA + (size_t)(t + 2) * kstep;
            const char* b20 = last ? nB0 : cB0 + (size_t)(t + 2) * kstep; const char* b21 = last ? nB1 : cB1 + (size_t)(t + 2) * kstep;
#define x00 ((Sched::GATHER && last) ? nvA[0][0] : cvA[0][0])
#define x01 ((Sched::GATHER && last) ? nvA[0][1] : cvA[0][1])
#define x10 ((Sched::GATHER && last) ? nvA[1][0] : cvA[1][0])
#define x11 ((Sched::GATHER && last) ? nvA[1][1] : cvA[1][1])
            G2_LDB(B0, 0, 0); G2_SCHED; G2_LDA(At, 0, 0); G2_STAGE(G2_SA(1, 1), a1, cvA[1][0], cvA[1][1]);
            G2_WAIT_L(8); G2_BAR; G2_WAIT_L(0); G2_MMA(0, 0, At, B0); G2_BAR; G2_SCHED;
            G2_LDB(B1, 0, 1); G2_STAGE(G2_SB(0, 0), b20, voffB[0], voffB[1]);
            G2_BAR; G2_WAIT_L(0); G2_MMA(0, 1, At, B1); G2_BAR;
            G2_LDA(At, 0, 1); G2_STAGE(G2_SA(0, 0), a2, x00, x01);
            G2_BAR; G2_WAIT_L(0); G2_MMA(1, 0, At, B0); G2_BAR; G2_SCHED;
            G2_STAGE(G2_SB(0, 1), b21, voffB[0], voffB[1]);
            G2_WAIT_V(6); G2_BAR; G2_MMA(1, 1, At, B1); G2_BAR;
            G2_LDB(B0, 1, 0); G2_SCHED; G2_LDA(At, 1, 0); G2_STAGE(G2_SA(0, 1), a2, x10, x11);
            G2_WAIT_L(8); G2_BAR; G2_WAIT_L(0); G2_MMA(0, 0, At, B0); G2_BAR; G2_SCHED;
            G2_LDB(B1, 1, 1); G2_STAGE(G2_SB(1, 0), b20 + kstep, voffB[0], voffB[1]);
            G2_BAR; G2_WAIT_L(0); G2_MMA(0, 1, At, B1); G2_BAR;
            G2_LDA(At, 1, 1); G2_STAGE(G2_SA(1, 0), a2 + kstep, x00, x01);
            G2_BAR; G2_WAIT_L(0); G2_MMA(1, 0, At, B0); G2_BAR; G2_SCHED;
            G2_STAGE(G2_SB(1, 1), b21 + kstep, voffB[0], voffB[1]);
            G2_WAIT_V(6); G2_BAR; G2_MMA(1, 1, At, B1); G2_BAR;
        }
        { Lay lay; int rbv = wr * 64 + fr, cbv = wc * 32 + 4 * fq; asm volatile("" : "+v"(rbv), "+v"(cbv));
          lay.rbase = rbv; lay.cbase = cbv; cur.epi.run(acc, lay); }
        if (!has_next) break;
#pragma unroll
        for (int i = 0; i < 8; ++i)
#pragma unroll
            for (int j = 0; j < 4; ++j) acc[i][j] = (f32x4){0.f, 0.f, 0.f, 0.f};
        cur = nxt; cA = nA; cB0 = nB0; cB1 = nB1; ++ui;
        if (Sched::GATHER) {
#pragma unroll
            for (int h = 0; h < 2; ++h) { cvA[h][0] = nvA[h][0]; cvA[h][1] = nvA[h][1]; } }
    }
#undef x00
#undef x01
#undef x10
#undef x11
    G2_WAIT_V(0);
    if (wr == 0) G2_BAR;
    G2_BAR;
#undef G2_SA
#undef G2_SB
#undef G2_STAGE
#undef G2_LDA
#undef G2_LDB
#undef G2_MMA
#undef G2_WAIT_V
#undef G2_WAIT_L
#undef G2_BAR
#undef G2_SCHED
#undef G2_VOFFA
}
}

struct EpiF32 {
    float* C; int ld;
    template <class L> __device__ __forceinline__ void run(const f32x4 (&acc)[L::NI][L::NJ], const L& lay) const {
#pragma unroll
        for (int i = 0; i < L::NI; ++i)
#pragma unroll
            for (int j = 0; j < L::NJ; ++j) *(f32x4*)(C + (size_t)lay.row(i) * ld + lay.col(j)) = acc[i][j];
    }
};
struct EpiBf16 {
    bf16_t* C; int ld;
    template <class L> __device__ __forceinline__ void run(const f32x4 (&acc)[L::NI][L::NJ], const L& lay) const {
#pragma unroll
        for (int i = 0; i < L::NI; ++i)
#pragma unroll
            for (int j = 0; j < L::NJ; ++j) { u32x2 w; w.x = pack2(acc[i][j][0], acc[i][j][1]); w.y = pack2(acc[i][j][2], acc[i][j][3]);
                *(u32x2*)(C + (size_t)lay.row(i) * ld + lay.col(j)) = w; }
    }
};
struct EpiGateUp {
    bf16_t* C; int ld;
    template <class L> __device__ __forceinline__ void run(const f32x4 (&acc)[L::NI][L::NJ], const L& lay) const {
#pragma unroll
        for (int i = 0; i < L::NI; ++i)
#pragma unroll
            for (int j = 0; j < L::NJ / 2; ++j) { const f32x4 gt = acc[i][j], up = acc[i][j + L::NJ / 2];
                u32x2 w; w.x = pack2(silu_f(gt[0]) * up[0], silu_f(gt[1]) * up[1]); w.y = pack2(silu_f(gt[2]) * up[2], silu_f(gt[3]) * up[3]);
                *(u32x2*)(C + (size_t)lay.row(i) * ld + lay.col(j)) = w; }
    }
};
struct EpiInProj {
    bf16_t* Zt;
    bf16_t* tF;
    bf16_t* tV;
    int n0, pos0, n;
    template <class L> __device__ __forceinline__ void run(const f32x4 (&acc)[L::NI][L::NJ], const L& lay) const {
#pragma unroll
        for (int i = 0; i < L::NI; ++i)
#pragma unroll
            for (int j = 0; j < L::NJ; ++j) {
                const int r = lay.row(i), cl = lay.col(j), c = n0 + cl;
                const f32x4 v = acc[i][j];
                if (c < 512) {
                    const int part = c >> 8, ch = c & 255;
#pragma unroll
                    for (int e = 0; e < 4; ++e) tF[((size_t)(ch + e) * 2 + part) * n + pos0 + r] = f2bf(v[e]);
                } else {
                    u32x2 w; w.x = pack2(v[0], v[1]); w.y = pack2(v[2], v[3]);
                    *(u32x2*)(Zt + (size_t)r * ZC + cl) = w;
                    if (c >= 896 && c < 1024) {
#pragma unroll
                        for (int e = 0; e < 4; ++e) tV[(size_t)(c - 896 + e) * n + pos0 + r] = f2bf(v[e]);
                    }
                }
            }
    }
};

constexpr int U_ADA = 192, U_WIN = 2 * 16 * 28, U_WOUT = 2 * 16 * 16, U_SGU = 32, U_DFT = 256, U_ROPE = 1, U_EXP = 3 * 32 * 32;
constexpr int LDS_SIL = 0, LDS_RED = 20480, LDS_TILE = 32768, LDS_T64 = 49408, LDS_CTAB = 50176;

__device__ __forceinline__ void ada_unit(AP a, unsigned char* lds, int u) {
    float* sil = (float*)(lds + LDS_SIL); float* red = (float*)(lds + LDS_RED);
    const int tid = tid_opaque(), lane = tid & 63, w = tid >> 6;
    const int l = u / 96, cg = u % 96;
    for (int i = tid; i < 5120; i += NT) { const int r = i >> 10, k = i & 1023; const float v = (r < 4) ? a->in[1][r * 1024 + k] : a->in[3][k]; sil[i] = v / (1.0f + expf(-v)); }
    __syncthreads();
    const float* W = a->in[4] + (size_t)l * 1024 * 6144 + cg * 64 + lane;
    float acc[5] = {0.f, 0.f, 0.f, 0.f, 0.f};
#pragma unroll 32
    for (int k = w * 128; k < w * 128 + 128; ++k) { const float wv = W[(size_t)k * 6144];
#pragma unroll
        for (int r = 0; r < 5; ++r) acc[r] += sil[r * 1024 + k] * wv; }
#pragma unroll
    for (int r = 0; r < 5; ++r) red[(w * 5 + r) * 64 + lane] = acc[r];
    __syncthreads();
    if (tid < 320) { const int r = tid >> 6; float s = 0.f;
#pragma unroll
        for (int ww = 0; ww < 8; ++ww) s += red[(ww * 5 + r) * 64 + lane];
        const int j = cg * 64 + lane; ((float*)(a->ws + WS_MOD))[(size_t)(l * 5 + r) * 6144 + j] = s + a->in[5][l * 6144 + j]; }
    __syncthreads();
}

__device__ __forceinline__ void tile_store_T(const float* tile, bf16_t* dst, int ldd) {
    const int tid = tid_opaque(), n = tid >> 3, kc = tid & 7;
    u32x4 w;
    w.x = pack2(tile[(kc * 8 + 0) * 65 + n], tile[(kc * 8 + 1) * 65 + n]); w.y = pack2(tile[(kc * 8 + 2) * 65 + n], tile[(kc * 8 + 3) * 65 + n]);
    w.z = pack2(tile[(kc * 8 + 4) * 65 + n], tile[(kc * 8 + 5) * 65 + n]); w.w = pack2(tile[(kc * 8 + 6) * 65 + n], tile[(kc * 8 + 7) * 65 + n]);
    *(u32x4*)(dst + (size_t)n * ldd + kc * 8) = w;
}
__device__ __forceinline__ void tile_load(float* tile, const float* src, int lds_) {
    const int tid = tid_opaque();
#pragma unroll
    for (int i = 0; i < 2; ++i) { const int row = (tid >> 4) + 32 * i, c4 = (tid & 15) * 4; const f32x4 v = *(const f32x4*)(src + (size_t)row * lds_ + c4);
        tile[row * 65 + c4 + 0] = v[0]; tile[row * 65 + c4 + 1] = v[1]; tile[row * 65 + c4 + 2] = v[2]; tile[row * 65 + c4 + 3] = v[3]; }
}

__device__ __forceinline__ void mm64_f32(const float* tA, int lda, const float* tB, int ldb, int K, float* out) {
    const int tid = tid_opaque(), lane = tid & 63, w = tid >> 6, fr = lane & 15, g = lane >> 4, mi = w >> 1, nj = 2 * (w & 1);
    f32x4 acc0 = (f32x4){0.f, 0.f, 0.f, 0.f}, acc1 = (f32x4){0.f, 0.f, 0.f, 0.f};
    const float* pa = tA + (16 * mi + fr) * lda + g; const float* pb = tB + g * ldb + 16 * nj + fr;
#pragma unroll 4
    for (int k0 = 0; k0 < K; k0 += 4) { const float av = pa[k0], b0 = pb[k0 * ldb], b1 = pb[k0 * ldb + 16];
        acc0 = __builtin_amdgcn_mfma_f32_16x16x4f32(av, b0, acc0, 0, 0, 0); acc1 = __builtin_amdgcn_mfma_f32_16x16x4f32(av, b1, acc1, 0, 0, 0); }
#pragma unroll
    for (int r = 0; r < 4; ++r) { out[(16 * mi + 4 * g + r) * 65 + 16 * nj + fr] = acc0[r]; out[(16 * mi + 4 * g + r) * 65 + 16 * nj + 16 + fr] = acc1[r]; }
}

__device__ __forceinline__ void win_unit(AP a, unsigned char* lds, int u) {
    float* tile = (float*)(lds + LDS_TILE); float* T = (float*)(lds + LDS_T64);
    const int tid = tid_opaque();
    const int l = u / 448, r = u % 448, kb = r / 28, nb = r % 28;
    const float* Win = a->in[6] + (size_t)l * 1024 * 1536;
    const int srccol = (nb >= 8) ? nb * 64 - 256 : (nb & 3) * 64;
    tile_load(tile, Win + (size_t)(kb * 64) * 1536 + srccol, 1536);
    if (nb < 8 && tid < 64) { T[tid] = cospif((float)tid / 32.0f); T[64 + tid] = sinpif((float)tid / 32.0f); }
    __syncthreads();
    bf16_t* dst = (bf16_t*)(a->ws + WS_WIN) + ((size_t)l * ZC + nb * 64) * 1024 + kb * 64;
    if (nb >= 8) tile_store_T(tile, dst, 1024);
    else {
        const int part = nb >> 2;
        float* Tm = (float*)(lds + 65536); float* out = (float*)(lds + 98304);
        for (int i = tid; i < 4096; i += NT) { const int c = i >> 6, cp = i & 63; const float t = T[part * 64 + ((c * cp) & 63)]; Tm[i] = (part ? -t : t) * 0.125f; }
        __syncthreads();
        mm64_f32(tile, 65, Tm, 64, 64, out);
        __syncthreads();
        tile_store_T(out, dst, 1024);
    }
    __syncthreads();
}

__device__ __forceinline__ void wout_unit(AP a, unsigned char* lds, int u) {
    float* tile = (float*)(lds + LDS_TILE);
    __syncthreads();
    const int tid = tid_opaque();
    const int l = u / 256, r = u % 256, kb = r / 16, nb = r % 16;
    const float* Wo = a->in[13] + (size_t)l * 1024 * 1024;
    const int n = tid & 63, kq = __builtin_amdgcn_readfirstlane(tid >> 6);
    if (kb < 4) {
        float* tA = (float*)lds; float* tB = (float*)(lds + 65536);
        const float* wf = a->in[7] + (size_t)l * 256 * 256 + (size_t)(kb * 64) * 256;
        __syncthreads();
        f32x4 va[8], vb[8];
#pragma unroll
        for (int i = 0; i < 8; ++i) { const int q = tid + 512 * i; va[i] = *(const f32x4*)(wf + (size_t)q * 4); vb[i] = *(const f32x4*)(Wo + (size_t)(q >> 4) * 1024 + nb * 64 + (q & 15) * 4); }
#pragma unroll
        for (int i = 0; i < 8; ++i) { const int q = tid + 512 * i; *(f32x4*)(tA + (size_t)q * 4) = va[i]; *(f32x4*)(tB + (size_t)q * 4) = vb[i]; }
        __syncthreads();
        tile = (float*)(lds + 133120);
        mm64_f32(tA, 256, tB, 64, 256, tile);
    } else if (kb >= 8 && kb < 12) {
        const int g = kb - 8;
        float* tA = (float*)lds; float* tB = (float*)(lds + 65536);
        const float* wp = a->in[9] + (size_t)(l * 4 + g) * 64 * 64;
        const float* ps = a->in[10] + l * 256 + g * 64;
        f32x4 va[2], vb[2];
#pragma unroll
        for (int i = 0; i < 2; ++i) { const int q = tid + 512 * i; va[i] = *(const f32x4*)(wp + (size_t)q * 4); vb[i] = *(const f32x4*)(Wo + (size_t)(512 + g * 64 + (q >> 4)) * 1024 + nb * 64 + (q & 15) * 4) * ps[q >> 4]; }
#pragma unroll
        for (int i = 0; i < 2; ++i) { const int q = tid + 512 * i; *(f32x4*)(tA + (size_t)q * 4) = va[i]; *(f32x4*)(tB + (size_t)q * 4) = vb[i]; }
        __syncthreads();
        tile = (float*)(lds + 133120);
        mm64_f32(tA, 64, tB, 64, 64, tile);
    } else tile_load(tile, Wo + (size_t)(kb * 64) * 1024 + nb * 64, 1024);
    __syncthreads();
    tile_store_T(tile, (bf16_t*)(a->ws + WS_WOUT) + ((size_t)l * 1024 + nb * 64) * 1024 + kb * 64, 1024);
    __syncthreads();
}

__device__ __forceinline__ void exp_src_dst(AP a, int l, int u, const float*& src, int& srcld, bf16_t*& dst, int& dstld) {
    const int mat = u / 1024, e = (u % 1024) / 32, t = u % 32;
    const int kb = (mat < 2) ? t / 4 : t / 8, nb = (mat < 2) ? t % 4 : t % 8;
    srcld = (mat < 2) ? 512 : 1024; dstld = (mat < 2) ? 1024 : 512;
    src = a->in[18 + mat] + ((size_t)(l * 32 + e) * 512 * 1024) + (size_t)(kb * 128) * srcld + nb * 128;
    dst = (bf16_t*)(a->ws + WS_WEXP) + (size_t)mat * EXPMAT + (size_t)e * 512 * 1024 + (size_t)(nb * 128) * dstld + kb * 128;
}
__device__ __forceinline__ void exp_range(AP a, unsigned char* lds, int l, int u0, int u_end, int G) {
    float* tile = (float*)lds;
    const int tid = tid_opaque();
    __syncthreads();
    if (u0 >= u_end) return;
    const float* src; bf16_t* dst; int srcld, dstld;
    exp_src_dst(a, l, u0, src, srcld, dst, dstld);
    f32x4 v[8];
#pragma unroll
    for (int i = 0; i < 8; ++i) v[i] = *(const f32x4*)(src + (size_t)((tid >> 5) + 16 * i) * srcld + (tid & 31) * 4);
    for (int u = u0; u < u_end; u += G) {
#pragma unroll
        for (int i = 0; i < 8; ++i) { float* tp = tile + ((tid >> 5) + 16 * i) * 129 + (tid & 31) * 4; tp[0] = v[i][0]; tp[1] = v[i][1]; tp[2] = v[i][2]; tp[3] = v[i][3]; }
        __syncthreads();
        bf16_t* cdst = dst; const int cdstld = dstld;
        if (u + G < u_end) { exp_src_dst(a, l, u + G, src, srcld, dst, dstld);
#pragma unroll
            for (int i = 0; i < 8; ++i) v[i] = *(const f32x4*)(src + (size_t)((tid >> 5) + 16 * i) * srcld + (tid & 31) * 4); }
        const int n = tid >> 2, kq = tid & 3;
#pragma unroll
        for (int j = 0; j < 4; ++j) { const float* tp = tile + (kq * 32 + j * 8) * 129 + n; u32x4 w;
            w.x = pack2(tp[0], tp[129]); w.y = pack2(tp[2 * 129], tp[3 * 129]); w.z = pack2(tp[4 * 129], tp[5 * 129]); w.w = pack2(tp[6 * 129], tp[7 * 129]);
            *(u32x4*)(cdst + (size_t)n * cdstld + kq * 32 + j * 8) = w; }
        __syncthreads();
    }
}

__device__ __forceinline__ void exp_queue(AP a, unsigned char* lds, int l) {
    const int tid = tid_opaque();
    int* qslot = (int*)(lds + MISC_OFF + 128);
    unsigned* qc = (unsigned*)(a->ws + WS_BAR + 14336 + l * 256);
    for (;;) {
        __syncthreads();
        if (tid == 0) *qslot = (int)__hip_atomic_fetch_add(qc, 4u, __ATOMIC_RELAXED, __HIP_MEMORY_SCOPE_AGENT);
        __syncthreads();
        const int c0 = *qslot;
        if (c0 >= U_EXP) break;
        exp_range(a, lds, l, c0, c0 + 4, 1);
    }
}

__device__ __forceinline__ void p0_prologue(AP a, unsigned char* lds) {
    const int tid = tid_opaque();
    bool have_tab = false;
    constexpr int E0 = U_ADA, E1 = E0 + U_WIN, E2 = E1 + U_WOUT, E3 = E2 + U_SGU, E4 = E3 + U_DFT, E5 = E4 + U_ROPE;
    int u = blockIdx.x;
    for (; u < E5; u += gridDim.x) {
        if (u < E0) ada_unit(a, lds, u);
        else if (u < E1) win_unit(a, lds, u - E0);
        else if (u < E2) wout_unit(a, lds, u - E1);
        else if (u < E3) { const size_t i0 = (size_t)(u - E2) * 4096 + tid * 8; const float* s = a->in[11] + i0; bf16_t* d = (bf16_t*)(a->ws + WS_WSGU) + i0;
            const f32x4 v0 = *(const f32x4*)s, v1 = *(const f32x4*)(s + 4); u32x4 w; w.x = pack2(v0[0], v0[1]); w.y = pack2(v0[2], v0[3]); w.z = pack2(v1[0], v1[1]); w.w = pack2(v1[2], v1[3]); *(u32x4*)d = w; }
        else if (u < E4) {
            float* ctab = (float*)(lds + LDS_CTAB);
            if (!have_tab) { for (int i = tid; i < 4096; i += NT) ctab[i] = cospif((float)i / 2048.0f); __syncthreads(); have_tab = true; }
            const int k = u - E3 + 4096;
            if (tid < 32) {
                const int kk = k - 4096, n0 = tid * 8; float c[8], s[8];
#pragma unroll
                for (int e = 0; e < 8; ++e) { const int idx = ((kk * (n0 + e)) & 255) * 16; c[e] = ctab[idx] * (1.0f / 16.0f); s[e] = ctab[(idx - 1024) & 4095] * (1.0f / 16.0f); }
                bf16_t* d = (bf16_t*)(a->ws + WS_DFTC) + (size_t)kk * 512 + n0;
                u32x4 w; w.x = pack2(c[0], c[1]); w.y = pack2(c[2], c[3]); w.z = pack2(c[4], c[5]); w.w = pack2(c[6], c[7]); *(u32x4*)d = w;
                w.x = pack2(s[0], s[1]); w.y = pack2(s[2], s[3]); w.z = pack2(s[4], s[5]); w.w = pack2(s[6], s[7]); *(u32x4*)(d + 256) = w;
            }
        }
        else {
            for (int i = tid; i < 1024; i += NT) { const int pos = i >> 4, f = i & 15; const float freq = powf(10000.0f, -(float)f / 16.0f); const float ang = (float)pos * freq;
                ((float2*)(a->ws + WS_ROPE))[i] = make_float2(cosf(ang), sinf(ang)); }
        }
    }
}

__device__ __forceinline__ void p_lnmod0(AP a) {
    const int tid = tid_opaque(), lane = tid & 63, w = tid >> 6;
    const float* mod = (const float*)(a->ws + WS_MOD);
    bf16_t* H = (bf16_t*)(a->ws + WS_H);
    const int tstep = gridDim.x * 8;
    f32x4 nx[4];
    { const int t = blockIdx.x * 8 + w; if (t < NTOK) { const float* src = (t < NLAT) ? a->in[0] + (size_t)t * D : a->in[2] + (size_t)(t - NLAT) * D;
#pragma unroll
        for (int i = 0; i < 4; ++i) nx[i] = *(const f32x4*)(src + 256 * i + 4 * lane); } }
    int mrow = -1; f32x4 msh[4], msc[4];
    for (int t = blockIdx.x * 8 + w; t < NTOK; t += tstep) {
        const int mr = (t < NLAT) ? (t >> 12) : 4;
        if (mr != mrow) { mrow = mr; const float* m = mod + (size_t)mr * 6144;
#pragma unroll
            for (int i = 0; i < 4; ++i) { msh[i] = *(const f32x4*)(m + 256 * i + 4 * lane); msc[i] = *(const f32x4*)(m + 1024 + 256 * i + 4 * lane); } }
        f32x4 v[4];
#pragma unroll
        for (int i = 0; i < 4; ++i) v[i] = nx[i];
        { const int tn = t + tstep; if (tn < NTOK) { const float* src = (tn < NLAT) ? a->in[0] + (size_t)tn * D : a->in[2] + (size_t)(tn - NLAT) * D;
#pragma unroll
            for (int i = 0; i < 4; ++i) nx[i] = *(const f32x4*)(src + 256 * i + 4 * lane); } }
        float mean, rstd; ln_stats(v, mean, rstd);
#pragma unroll
        for (int i = 0; i < 4; ++i) { const int c = 256 * i + 4 * lane;
            f32x4 o;
#pragma unroll
            for (int e = 0; e < 4; ++e) o[e] = (v[i][e] - mean) * rstd * (1.0f + msc[i][e]) + msh[i][e];
            u32x2 pk; pk.x = pack2(o[0], o[1]); pk.y = pack2(o[2], o[3]); *(u32x2*)(H + (size_t)t * D + c) = pk; }
    }
}

__device__ __forceinline__ void p1_inproj(AP a, LAS unsigned char* lds, int l);
__device__ __forceinline__ void rope32(float (&t)[32], const float2* tab) {
#pragma unroll
    for (int f = 0; f < 16; ++f) { const float2 cs = tab[f]; const float t1 = t[f], t2 = t[16 + f]; t[f] = t1 * cs.x - t2 * cs.y; t[16 + f] = t1 * cs.y + t2 * cs.x; }
}
__device__ __forceinline__ void load32(float (&t)[32], const bf16_t* p) {
#pragma unroll
    for (int q = 0; q < 4; ++q) { const u32x4 w = *(const u32x4*)(p + 8 * q);
        t[8 * q + 0] = lo2f(w.x); t[8 * q + 1] = hi2f(w.x); t[8 * q + 2] = lo2f(w.y); t[8 * q + 3] = hi2f(w.y);
        t[8 * q + 4] = lo2f(w.z); t[8 * q + 5] = hi2f(w.z); t[8 * q + 6] = lo2f(w.w); t[8 * q + 7] = hi2f(w.w); }
}

__device__ __forceinline__ float kdot(const bf16_t* kp, const bf16_t* q, const float2* tab0, const float2* tab1, bool do_rope) {
    float dot = 0.f;
#pragma unroll 1
    for (int ax = 0; ax < 2; ++ax) {
        const float2* tab = ax ? tab1 : tab0;
#pragma unroll 1
        for (int h8 = 0; h8 < 2; ++h8) {
            const u32x4 wl = *(const u32x4*)(kp + ax * 32 + h8 * 8), wh = *(const u32x4*)(kp + ax * 32 + 16 + h8 * 8);
            const float tl[8] = {lo2f(wl.x), hi2f(wl.x), lo2f(wl.y), hi2f(wl.y), lo2f(wl.z), hi2f(wl.z), lo2f(wl.w), hi2f(wl.w)};
            const float th[8] = {lo2f(wh.x), hi2f(wh.x), lo2f(wh.y), hi2f(wh.y), lo2f(wh.z), hi2f(wh.z), lo2f(wh.w), hi2f(wh.w)};
#pragma unroll
            for (int j = 0; j < 8; ++j) {
                float r1 = tl[j], r2 = th[j];
                if (do_rope) { const float2 cs = tab[h8 * 8 + j]; r1 = tl[j] * cs.x - th[j] * cs.y; r2 = tl[j] * cs.y + th[j] * cs.x; }
                dot += bf2f(q[ax * 32 + h8 * 8 + j]) * r1 + bf2f(q[ax * 32 + 16 + h8 * 8 + j]) * r2;
            }
        }
    }
    return dot;
}

__device__ __forceinline__ void mixer_tile(AP a, unsigned char* lds, int l, int row0, int seq_row0, int pos0, int n, int b, bool is_ctx) {
    const int tid = tid_opaque(), lane = tid & 63, w = tid >> 6;
    const bf16_t* Z = (const bf16_t*)(a->ws + WS_Z);
    bf16_t* CAT = (bf16_t*)(a->ws + WS_CAT);
    {
        const int c = tid & 255, half = tid >> 8, g = c >> 6, hw = 1 << g;
        for (int tl = half * 64; tl < half * 64 + 64; ++tl) {
            const int pos = pos0 + tl; const int lo = max(pos - hw, 0), hi = min(pos + hw, n);
            float s = 0.f; for (int j = lo; j < hi; ++j) s += bf2f(Z[(size_t)(seq_row0 + j) * ZC + 1024 + c]);
            const float self = bf2f(Z[(size_t)(seq_row0 + pos) * ZC + 1024 + c]);
            CAT[(size_t)(row0 + tl) * D + 512 + c] = f2bf(s / (float)(hi - lo) - self);
        }
    }
    bf16_t* vT = (bf16_t*)lds;
    for (int q = w; q < 128; q += 8) {
        const u32x2 gw = *(const u32x2*)(Z + (size_t)(row0 + q) * ZC + 1536 + 4 * lane);
        float gv[4] = {gelu_erf(lo2f(gw.x)), gelu_erf(hi2f(gw.x)), gelu_erf(lo2f(gw.y)), gelu_erf(hi2f(gw.y))};
        float s = wave_sum((gv[0] + gv[1]) + (gv[2] + gv[3])); const float mean = s * (1.0f / 256.0f);
        float qq = 0.f;
#pragma unroll
        for (int e = 0; e < 4; ++e) { const float d = gv[e] - mean; qq += d * d; }
        qq = wave_sum(qq); const float rstd = 1.0f / sqrtf(qq * (1.0f / 256.0f) + 1e-6f);
#pragma unroll
        for (int e = 0; e < 4; ++e) vT[(4 * lane + e) * 128 + q] = f2bf((gv[e] - mean) * rstd);
    }
    __syncthreads();
    {
        const int c = tid & 255, ph = tid >> 8, h = c >> 6;
        const bf16_t* Ws = (const bf16_t*)(a->ws + WS_WSGU) + (size_t)(l * 4 + h) * 128 * 128;
        const float* bs = a->in[12] + (size_t)(l * 4 + h) * 128;
        for (int p = ph * 64; p < ph * 64 + 64; ++p) {
            float s = 0.f;
#pragma unroll 2
            for (int q8 = 0; q8 < 16; ++q8) {
                const u32x4 ww = *(const u32x4*)(Ws + (size_t)p * 128 + q8 * 8);
                const u32x4 vv = *(const u32x4*)(vT + c * 128 + q8 * 8);
                s += lo2f(ww.x) * lo2f(vv.x) + hi2f(ww.x) * hi2f(vv.x) + lo2f(ww.y) * lo2f(vv.y) + hi2f(ww.y) * hi2f(vv.y)
                   + lo2f(ww.z) * lo2f(vv.z) + hi2f(ww.z) * hi2f(vv.z) + lo2f(ww.w) * lo2f(vv.w) + hi2f(ww.w) * hi2f(vv.w);
            }
            const float uv = gelu_erf(bf2f(Z[(size_t)(row0 + p) * ZC + 1280 + c]));
            CAT[(size_t)(row0 + p) * D + 768 + c] = f2bf(uv * (s + bs[p]));
        }
    }
    __syncthreads();
    {
        const int i = tid & 127, h = tid >> 7, kvh = h >> 1;
        const float2* rope = (const float2*)(a->ws + WS_ROPE);
        const int qpos = pos0 + i;
        bf16_t* q = (bf16_t*)lds + tid * 66;
        {
            float t0[32];
            load32(t0, Z + (size_t)(row0 + i) * ZC + 512 + h * 64);
            if (!is_ctx) rope32(t0, rope + (qpos >> 6) * 16);
#pragma unroll
            for (int d = 0; d < 32; ++d) q[d] = f2bf(t0[d]);
            load32(t0, Z + (size_t)(row0 + i) * ZC + 512 + h * 64 + 32);
            if (!is_ctx) rope32(t0, rope + (qpos & 63) * 16);
#pragma unroll
            for (int d = 0; d < 32; ++d) q[32 + d] = f2bf(t0[d]);
        }
#pragma unroll 1
        for (int dh = 0; dh < 2; ++dh) {
        float m = a->in[8][l * 4 + h], den = 1.0f;
        float o[32];
#pragma unroll
        for (int d = 0; d < 32; ++d) o[d] = 0.f;
        if (!is_ctx) {
            const bf16_t* VT = (const bf16_t*)(a->ws + WS_VT) + ((size_t)(b * 2 + kvh) * 64 + dh * 32) * 4096;
            const int slo = max(qpos - 128, 0), shi = min(qpos + 128, n - 1);
#pragma unroll 1
            for (int s = slo; s <= shi; ++s) {
                const float dot = 0.125f * kdot(Z + (size_t)(seq_row0 + s) * ZC + 768 + kvh * 64, q, rope + (s >> 6) * 16, rope + (s & 63) * 16, true);
                const float mn = fmaxf(m, dot), corr = __expf(m - mn), p = __expf(dot - mn);
                den = den * corr + p; m = mn;
#pragma unroll
                for (int d = 0; d < 32; ++d) o[d] = o[d] * corr + p * bf2f(VT[(size_t)d * 4096 + s]);
            }
        }
        {
            const bf16_t* VTC = (const bf16_t*)(a->ws + WS_VTC) + ((size_t)(b * 2 + kvh) * 64 + dh * 32) * 256;
#pragma unroll 1
            for (int j = 0; j < 256; ++j) {
                const float dot = 0.125f * kdot(Z + (size_t)(NLAT + b * 256 + j) * ZC + 768 + kvh * 64, q, rope, rope, false);
                const float mn = fmaxf(m, dot), corr = __expf(m - mn), p = __expf(dot - mn);
                den = den * corr + p; m = mn;
#pragma unroll
                for (int d = 0; d < 32; ++d) o[d] = o[d] * corr + p * bf2f(VTC[(size_t)d * 256 + j]);
            }
        }
        const float inv = 1.0f / den;
        bf16_t* dst = CAT + (size_t)(row0 + i) * D + 256 + h * 64 + dh * 32;
#pragma unroll
        for (int d8 = 0; d8 < 4; ++d8) { u32x4 pk; pk.x = pack2(o[8 * d8] * inv, o[8 * d8 + 1] * inv); pk.y = pack2(o[8 * d8 + 2] * inv, o[8 * d8 + 3] * inv);
            pk.z = pack2(o[8 * d8 + 4] * inv, o[8 * d8 + 5] * inv); pk.w = pack2(o[8 * d8 + 6] * inv, o[8 * d8 + 7] * inv); *(u32x4*)(dst + 8 * d8) = pk; }
        }
    }
    __syncthreads();
}

__device__ __forceinline__ u32x4 ld16g(const bf16_t* p) { return *(const u32x4*)p; }
__device__ __forceinline__ void rope_pack8(u32x4& wl, u32x4& wh, const LAS f32x2* tab, bool do_rope, float scale) {
    float tl[8] = {lo2f(wl.x), hi2f(wl.x), lo2f(wl.y), hi2f(wl.y), lo2f(wl.z), hi2f(wl.z), lo2f(wl.w), hi2f(wl.w)};
    float th[8] = {lo2f(wh.x), hi2f(wh.x), lo2f(wh.y), hi2f(wh.y), lo2f(wh.z), hi2f(wh.z), lo2f(wh.w), hi2f(wh.w)};
#pragma unroll
    for (int j = 0; j < 8; ++j) {
        float r1 = tl[j], r2 = th[j];
        if (do_rope) { const f32x2 cs = tab[j]; r1 = tl[j] * cs.x - th[j] * cs.y; r2 = tl[j] * cs.y + th[j] * cs.x; }
        tl[j] = r1 * scale; th[j] = r2 * scale;
    }
    wl.x = pack2(tl[0], tl[1]); wl.y = pack2(tl[2], tl[3]); wl.z = pack2(tl[4], tl[5]); wl.w = pack2(tl[6], tl[7]);
    wh.x = pack2(th[0], th[1]); wh.y = pack2(th[2], th[3]); wh.z = pack2(th[4], th[5]); wh.w = pack2(th[6], th[7]);
}

__device__ __forceinline__ void mixer_tile_fast(AP a, LAS unsigned char* lds, int l, int row0, int seq_row0, int pos0, int n, int b, bool is_ctx) {
    const int tid = tid_opaque(), lane = tid & 63, w = __builtin_amdgcn_readfirstlane(tid >> 6), fr = lane & 15, g = lane >> 4;
    const bf16_t* Z = (const bf16_t*)(a->ws + WS_Z);
    bf16_t* CAT = (bf16_t*)(a->ws + WS_CAT);
    ((LAS u32x4*)(lds + 98304))[tid] = ((const u32x4*)(a->ws + WS_ROPE))[tid];
    {
#pragma unroll
        for (int it = 0; it < 9; ++it) { const int id = tid + 512 * it, rr = id >> 5, ch = id & 31, j = pos0 - 8 + rr;
            u32x4 v = (u32x4){0u, 0u, 0u, 0u};
            if (j >= 0 && j < n) v = ld16g(Z + (size_t)(seq_row0 + j) * ZC + 1024 + ch * 8);
            *(LAS u32x4*)(lds + rr * 512 + ch * 16) = v; }
        __syncthreads();
        const int c = tid & 255, half = tid >> 8, hw = 1 << (c >> 6);
        const LAS bf16_t* P = (const LAS bf16_t*)lds + c;
        const int t0 = half * 64;
        float s = 0.f;
        for (int j = t0 - hw; j < t0 + hw; ++j) s += bf2f(P[(8 + j) * 256]);
        for (int tl = t0; tl < t0 + 64; ++tl) {
            const int pos = pos0 + tl; const int lo = max(pos - hw, 0), hi = min(pos + hw, n);
            CAT[(size_t)(row0 + tl) * D + 512 + c] = f2bf(s / (float)(hi - lo) - bf2f(P[(8 + tl) * 256]));
            s += bf2f(P[(8 + tl + hw) * 256]) - bf2f(P[(8 + tl - hw) * 256]);
        }
        __syncthreads();
    }
    {
        const int i16 = lane & 15;
        u32x4 gw[4][2];
#pragma unroll
        for (int ps = 0; ps < 4; ++ps) { const int q = w * 16 + ps * 4 + g; const bf16_t* src = Z + (size_t)(row0 + q) * ZC + 1536 + 16 * i16; gw[ps][0] = ld16g(src); gw[ps][1] = ld16g(src + 8); }
#pragma unroll
        for (int ps = 0; ps < 4; ++ps) {
            const int q = w * 16 + ps * 4 + g;
            float gv[16];
#pragma unroll
            for (int hh = 0; hh < 2; ++hh) { const u32x4 x = gw[ps][hh];
                gv[8 * hh + 0] = gelu_erf(lo2f(x.x)); gv[8 * hh + 1] = gelu_erf(hi2f(x.x)); gv[8 * hh + 2] = gelu_erf(lo2f(x.y)); gv[8 * hh + 3] = gelu_erf(hi2f(x.y));
                gv[8 * hh + 4] = gelu_erf(lo2f(x.z)); gv[8 * hh + 5] = gelu_erf(hi2f(x.z)); gv[8 * hh + 6] = gelu_erf(lo2f(x.w)); gv[8 * hh + 7] = gelu_erf(hi2f(x.w)); }
            float sm = 0.f;
#pragma unroll
            for (int e = 0; e < 16; ++e) sm += gv[e];
            const float mean = row_sum16(sm) * (1.0f / 256.0f);
            float qq = 0.f;
#pragma unroll
            for (int e = 0; e < 16; ++e) { const float d = gv[e] - mean; qq += d * d; }
            const float rstd = 1.0f / sqrtf(row_sum16(qq) * (1.0f / 256.0f) + 1e-6f);
#pragma unroll
            for (int e = 0; e < 16; ++e) { const int c = 16 * i16 + e; *(LAS bf16_t*)(lds + c * 256 + ((((q >> 3) ^ (c & 15))) << 4) + (q & 7) * 2) = f2bf((gv[e] - mean) * rstd); }
        }
    }
    __syncthreads();
    {
        const int h = w >> 1, ph = w & 1;
        const bf16_t* Ws = (const bf16_t*)(a->ws + WS_WSGU) + (size_t)(l * 4 + h) * 128 * 128;
        const float* bs = a->in[12] + (size_t)(l * 4 + h) * 128;
        f32x4 acc[4][4];
#pragma unroll
        for (int i = 0; i < 4; ++i)
#pragma unroll
            for (int j = 0; j < 4; ++j) acc[i][j] = (f32x4){0.f, 0.f, 0.f, 0.f};
#pragma unroll
        for (int ks = 0; ks < 4; ++ks) {
            bf16x8 af[4], bfv[4];
#pragma unroll
            for (int cf = 0; cf < 4; ++cf) { const int c = h * 64 + 16 * cf + fr; af[cf] = *(const LAS bf16x8*)(lds + c * 256 + (((4 * ks + g) ^ (c & 15)) << 4)); }
#pragma unroll
            for (int pf = 0; pf < 4; ++pf) { const int p = ph * 64 + 16 * pf + fr; bfv[pf] = *(const bf16x8*)(Ws + (size_t)p * 128 + 32 * ks + 8 * g); }
#pragma unroll
            for (int cf = 0; cf < 4; ++cf)
#pragma unroll
                for (int pf = 0; pf < 4; ++pf) acc[cf][pf] = __builtin_amdgcn_mfma_f32_16x16x32_bf16(af[cf], bfv[pf], acc[cf][pf], 0, 0, 0);
        }
#pragma unroll
        for (int pf = 0; pf < 4; ++pf) { const int p = ph * 64 + 16 * pf + fr; const float bias = bs[p];
#pragma unroll
            for (int cf = 0; cf < 4; ++cf) { const int c0 = h * 64 + 16 * cf + 4 * g;
                const u32x2 uw = *(const u32x2*)(Z + (size_t)(row0 + p) * ZC + 1280 + c0);
                u32x2 o; o.x = pack2(gelu_erf(lo2f(uw.x)) * (acc[cf][pf][0] + bias), gelu_erf(hi2f(uw.x)) * (acc[cf][pf][1] + bias));
                o.y = pack2(gelu_erf(lo2f(uw.y)) * (acc[cf][pf][2] + bias), gelu_erf(hi2f(uw.y)) * (acc[cf][pf][3] + bias));
                *(u32x2*)(CAT + (size_t)(row0 + p) * D + 768 + c0) = o; } }
    }
    const LAS f32x2* rope = (const LAS f32x2*)(lds + 98304);
    constexpr float QS = 0.125f * 1.44269504088896341f;
    constexpr int QS_OFF = 0, KS_OFF = 32768, VS_OFF = 65536;
    const int nbq = pos0 >> 7;
    unsigned bmask = 0x18u;
    if (!is_ctx) { if (nbq > 0) bmask |= 1u; bmask |= 2u; if (nbq + 1 < (n >> 7)) bmask |= 4u; }
    const int kr = tid >> 2, kax = (tid >> 1) & 1, kh8 = tid & 1;
#define MX_KSRC(blk) (Z + (size_t)((((blk) < 3) ? seq_row0 + (nbq + (blk) - 1) * 128 : NLAT + b * 256 + ((blk) - 3) * 128) + kr) * ZC + 768 + kvh * 64 + kax * 32 + kh8 * 8)
#define MX_VSTAGE(blk, buf) do { const bool _band = (blk) < 3; const int _key0 = _band ? (nbq + (blk) - 1) * 128 : ((blk) - 3) * 128; \
        const bf16_t* _vs = _band ? (const bf16_t*)(a->ws + WS_VT) + (size_t)(b * 2 + kvh) * 64 * 4096 + _key0 : (const bf16_t*)(a->ws + WS_VTC) + (size_t)(b * 2 + kvh) * 64 * 256 + _key0; \
        const int _vld = _band ? 4096 : 256; \
        _Pragma("unroll") for (int _i = 0; _i < 2; ++_i) { const int _P = _i * 512 + tid, _d = _P >> 4, _c = (_P & 15) ^ (_d & 15); \
            glds16(_vs + (size_t)_d * _vld + _c * 8, lds + VS_OFF + (buf) * 16384 + _i * 8192 + w * 1024); } } while (0)
#pragma unroll 1
    for (int kvh = 0; kvh < 2; ++kvh) {
        __syncthreads();
#pragma unroll
        for (int it = 0; it < 2; ++it) {
            const int item = tid + 512 * it, r = item >> 2, ax = (item >> 1) & 1, h8 = item & 1, i = r & 127, qpos = pos0 + i;
            const bf16_t* src = Z + (size_t)(row0 + i) * ZC + 512 + (2 * kvh + (r >> 7)) * 64 + ax * 32 + h8 * 8;
            u32x4 wl = ld16g(src), wh = ld16g(src + 16);
            rope_pack8(wl, wh, rope + (ax ? (qpos & 63) : (qpos >> 6)) * 16 + h8 * 8, !is_ctx, QS);
            const int ch = ax * 4 + h8, sw = (r >> 1) & 7;
            *(LAS u32x4*)(lds + QS_OFF + r * 128 + ((ch ^ sw) << 4)) = wl;
            *(LAS u32x4*)(lds + QS_OFF + r * 128 + (((ch + 2) ^ sw) << 4)) = wh;
        }
        const int hh = w >> 2, qb = (w & 3) * 32, h = 2 * kvh + hh;
        float m[2], lsum[2];
        m[0] = m[1] = a->in[8][l * 4 + h] * 1.44269504088896341f;
        lsum[0] = lsum[1] = (g == 0) ? 1.0f : 0.0f;
        f32x4 O[4][2];
#pragma unroll
        for (int i = 0; i < 4; ++i) { O[i][0] = (f32x4){0.f, 0.f, 0.f, 0.f}; O[i][1] = (f32x4){0.f, 0.f, 0.f, 0.f}; }
        bf16x8 Qf[2][2];
        bool have_q = false;
        unsigned rem = bmask;
        int cur = __builtin_ctz(rem); rem &= rem - 1u;
        int buf = 0;
        u32x4 kl = ld16g(MX_KSRC(cur)), kh = ld16g(MX_KSRC(cur) + 16);
        MX_VSTAGE(cur, 0);
#pragma unroll 1
        for (;;) {
            const int jb = cur - 1; const bool band = cur < 3;
            {
                const int kpos = (nbq + jb) * 128 + kr;
                rope_pack8(kl, kh, rope + (kax ? (kpos & 63) : (kpos >> 6)) * 16 + kh8 * 8, band, 1.0f);
                const int ch = kax * 4 + kh8, sw = (kr >> 1) & 7;
                *(LAS u32x4*)(lds + KS_OFF + buf * 16384 + kr * 128 + ((ch ^ sw) << 4)) = kl;
                *(LAS u32x4*)(lds + KS_OFF + buf * 16384 + kr * 128 + (((ch + 2) ^ sw) << 4)) = kh;
            }
            asm volatile("s_waitcnt vmcnt(0)" ::: "memory");
            __syncthreads();
            const int nxt = rem ? __builtin_ctz(rem) : -1; rem &= rem - 1u;
            if (nxt >= 0) { kl = ld16g(MX_KSRC(nxt)); kh = ld16g(MX_KSRC(nxt) + 16); MX_VSTAGE(nxt, buf ^ 1); }
            if (!have_q) {
#pragma unroll
                for (int qf = 0; qf < 2; ++qf)
#pragma unroll
                    for (int ks = 0; ks < 2; ++ks) { const int r = hh * 128 + qb + 16 * qf + fr; Qf[qf][ks] = *(const LAS bf16x8*)(lds + QS_OFF + r * 128 + (((4 * ks + g) ^ ((r >> 1) & 7)) << 4)); }
                have_q = true;
            }
            const int kso = KS_OFF + buf * 16384, vso = VS_OFF + buf * 16384;
            f32x4 S[8][2];
#pragma unroll
            for (int kf = 0; kf < 8; ++kf) { S[kf][0] = (f32x4){0.f, 0.f, 0.f, 0.f}; S[kf][1] = (f32x4){0.f, 0.f, 0.f, 0.f}; }
#pragma unroll
            for (int kf = 0; kf < 8; ++kf)
#pragma unroll
                for (int ks = 0; ks < 2; ++ks) { const int r = 16 * kf + fr;
                    const bf16x8 kfr = *(const LAS bf16x8*)(lds + kso + r * 128 + (((4 * ks + g) ^ ((r >> 1) & 7)) << 4));
                    S[kf][0] = __builtin_amdgcn_mfma_f32_16x16x32_bf16(kfr, Qf[0][ks], S[kf][0], 0, 0, 0);
                    S[kf][1] = __builtin_amdgcn_mfma_f32_16x16x32_bf16(kfr, Qf[1][ks], S[kf][1], 0, 0, 0); }
            bf16x8 Pp[4][2];
#pragma unroll
            for (int qf = 0; qf < 2; ++qf) {
                const int qi = qb + 16 * qf + fr;
                if (band && jb != 0) {
#pragma unroll
                    for (int kf = 0; kf < 8; ++kf)
#pragma unroll
                        for (int r = 0; r < 4; ++r) { const int kk = 16 * kf + 4 * g + r; const bool ok = (jb < 0) ? (kk >= qi) : (kk <= qi); if (!ok) S[kf][qf][r] = -1.0e30f; }
                }
                float mx = S[0][qf][0];
#pragma unroll
                for (int kf = 0; kf < 8; ++kf)
#pragma unroll
                    for (int r = 0; r < 4; ++r) mx = fmaxf(mx, S[kf][qf][r]);
                mx = fmaxf(mx, __shfl_xor(mx, 16)); mx = fmaxf(mx, __shfl_xor(mx, 32));
                const float mn = fmaxf(m[qf], mx), corr = __builtin_amdgcn_exp2f(m[qf] - mn);
                m[qf] = mn;
                float ps = 0.f;
#pragma unroll
                for (int kf = 0; kf < 8; ++kf)
#pragma unroll
                    for (int r = 0; r < 4; ++r) { const float p = __builtin_amdgcn_exp2f(S[kf][qf][r] - mn); S[kf][qf][r] = p; ps += p; }
                lsum[qf] = lsum[qf] * corr + ps;
#pragma unroll
                for (int df = 0; df < 4; ++df) O[df][qf] *= corr;
#pragma unroll
                for (int t = 0; t < 4; ++t) { u32x4 pw; pw.x = pack2(S[2 * t][qf][0], S[2 * t][qf][1]); pw.y = pack2(S[2 * t][qf][2], S[2 * t][qf][3]);
                    pw.z = pack2(S[2 * t + 1][qf][0], S[2 * t + 1][qf][1]); pw.w = pack2(S[2 * t + 1][qf][2], S[2 * t + 1][qf][3]); Pp[t][qf] = __builtin_bit_cast(bf16x8, pw); }
            }
#pragma unroll
            for (int t = 0; t < 4; ++t)
#pragma unroll
                for (int df = 0; df < 4; ++df) { const int d = 16 * df + fr;
                    const u32x2 v0 = *(const LAS u32x2*)(lds + vso + d * 256 + (((4 * t + (g >> 1)) ^ (d & 15)) << 4) + (g & 1) * 8);
                    const u32x2 v1 = *(const LAS u32x2*)(lds + vso + d * 256 + (((4 * t + 2 + (g >> 1)) ^ (d & 15)) << 4) + (g & 1) * 8);
                    u32x4 vw; vw.x = v0.x; vw.y = v0.y; vw.z = v1.x; vw.w = v1.y; const bf16x8 vf = __builtin_bit_cast(bf16x8, vw);
                    O[df][0] = __builtin_amdgcn_mfma_f32_16x16x32_bf16(vf, Pp[t][0], O[df][0], 0, 0, 0);
                    O[df][1] = __builtin_amdgcn_mfma_f32_16x16x32_bf16(vf, Pp[t][1], O[df][1], 0, 0, 0); }
            if (nxt < 0) break;
            cur = nxt; buf ^= 1;
        }
#pragma unroll
        for (int qf = 0; qf < 2; ++qf) {
            float lt = lsum[qf]; lt += __shfl_xor(lt, 16); lt += __shfl_xor(lt, 32);
            const float inv = 1.0f / lt;
            bf16_t* dst = CAT + (size_t)(row0 + qb + 16 * qf + fr) * D + 256 + h * 64 + 4 * g;
#pragma unroll
            for (int df = 0; df < 4; ++df) { u32x2 o; o.x = pack2(O[df][qf][0] * inv, O[df][qf][1] * inv); o.y = pack2(O[df][qf][2] * inv, O[df][qf][3] * inv); *(u32x2*)(dst + 16 * df) = o; }
        }
    }
#undef MX_KSRC
#undef MX_VSTAGE
    __syncthreads();
}

constexpr int FF_DA = 0, FF_DC = 32768, FF_TW = 49152, FF_XT = 65536, FF_Z2 = 81920, FF_OB = 98304;
__device__ __forceinline__ int ff_addr(int row, int k) { return row * 256 + ((((k >> 3) ^ (row & 15))) << 4) + (k & 7) * 2; }
__device__ __forceinline__ void fft_setup(LAS unsigned char* lds) {
    const int tid = tid_opaque();
    LAS float* TW = (LAS float*)(lds + FF_TW);
    for (int i = tid; i < 4096; i += NT) TW[i] = cospif((float)i / 2048.0f);
    __syncthreads();
    for (int idx = tid; idx < 16384; idx += NT) { const int i = idx >> 7, k = idx & 127, ro = i >> 6, k1 = i & 63, part = k >> 6, n1 = k & 63, j = ((k1 * n1) & 63) * 64;
        const float c = TW[j], sn = TW[(j - 1024) & 4095];
        const float v = (ro == 0) ? (part == 0 ? c : sn) : (part == 0 ? -sn : c);
        *(LAS bf16_t*)(lds + FF_DA + ff_addr(i, k)) = f2bf(v * 0.125f); }
    for (int idx = tid; idx < 8192; idx += NT) { const int k2 = idx >> 7, k = idx & 127, ri = k >> 6, n2 = k & 63, j = ((k2 * n2) & 63) * 64;
        const float v = (ri == 0) ? TW[j] : TW[(j - 1024) & 4095];
        *(LAS bf16_t*)(lds + FF_DC + ff_addr(k2, k)) = f2bf(v * 0.125f); }
    __syncthreads();
}
__device__ __forceinline__ void fft_unit(AP a, LAS unsigned char* lds, int b, int cg) {
    const int tid = tid_opaque(), lane = tid & 63, w = __builtin_amdgcn_readfirstlane(tid >> 6), fr = lane & 15, g = lane >> 4;
    const LAS float* TW = (const LAS float*)(lds + FF_TW);
    const int mf = w & 3, nh = w >> 2;
    const bf16_t* AT = (const bf16_t*)(a->ws + WS_AT) + (size_t)(b * 256 + cg * 4) * 8192;
    u32x4 xin[2];
#pragma unroll
    for (int it = 0; it < 2; ++it) xin[it] = ld16g(AT + (size_t)(tid + 512 * it) * 8);
#pragma unroll 1
    for (int cl = 0; cl < 4; ++cl) {
#pragma unroll
        for (int it = 0; it < 2; ++it) { const int q = tid + 512 * it, part = q >> 9, pos0 = (q & 511) * 8, n1 = pos0 >> 6, n2 = pos0 & 63, k = part * 64 + n1;
            const unsigned wv[4] = {xin[it].x, xin[it].y, xin[it].z, xin[it].w};
#pragma unroll
            for (int e = 0; e < 4; ++e) { *(LAS bf16_t*)(lds + FF_XT + ff_addr(n2 + 2 * e, k)) = (bf16_t)(wv[e] & 0xffffu); *(LAS bf16_t*)(lds + FF_XT + ff_addr(n2 + 2 * e + 1, k)) = (bf16_t)(wv[e] >> 16); } }
        if (cl < 3) {
#pragma unroll
            for (int it = 0; it < 2; ++it) xin[it] = ld16g(AT + (size_t)(cl + 1) * 8192 + (size_t)(tid + 512 * it) * 8); }
        __syncthreads();
        f32x4 acc[2][2];
#pragma unroll
        for (int x = 0; x < 2; ++x) { acc[x][0] = (f32x4){0.f, 0.f, 0.f, 0.f}; acc[x][1] = (f32x4){0.f, 0.f, 0.f, 0.f}; }
#pragma unroll
        for (int ks = 0; ks < 4; ++ks) {
            bf16x8 af[2], bfv[2];
#pragma unroll
            for (int x = 0; x < 2; ++x) { const int i = 16 * (mf + 4 * x) + fr; af[x] = *(const LAS bf16x8*)(lds + FF_DA + i * 256 + (((4 * ks + g) ^ (i & 15)) << 4)); }
#pragma unroll
            for (int n = 0; n < 2; ++n) { const int j = 16 * (2 * nh + n) + fr; bfv[n] = *(const LAS bf16x8*)(lds + FF_XT + j * 256 + (((4 * ks + g) ^ (j & 15)) << 4)); }
#pragma unroll
            for (int x = 0; x < 2; ++x)
#pragma unroll
                for (int n = 0; n < 2; ++n) acc[x][n] = __builtin_amdgcn_mfma_f32_16x16x32_bf16(af[x], bfv[n], acc[x][n], 0, 0, 0);
        }
#pragma unroll
        for (int n = 0; n < 2; ++n)
#pragma unroll
            for (int r = 0; r < 4; ++r) { const int k1 = 16 * mf + 4 * g + r, n2 = 16 * (2 * nh + n) + fr, idx = (k1 * n2) & 4095;
                const float c = TW[idx], sn = TW[(idx - 1024) & 4095], zr = acc[0][n][r], zi = acc[1][n][r];
                *(LAS bf16_t*)(lds + FF_Z2 + ff_addr(k1, n2)) = f2bf(zr * c + zi * sn);
                *(LAS bf16_t*)(lds + FF_Z2 + ff_addr(k1, 64 + n2)) = f2bf(zi * c - zr * sn); }
        __syncthreads();
        f32x4 acc2[2] = {(f32x4){0.f, 0.f, 0.f, 0.f}, (f32x4){0.f, 0.f, 0.f, 0.f}};
#pragma unroll
        for (int ks = 0; ks < 4; ++ks) {
            const int i = 16 * mf + fr; const bf16x8 af = *(const LAS bf16x8*)(lds + FF_DC + i * 256 + (((4 * ks + g) ^ (i & 15)) << 4));
#pragma unroll
            for (int n = 0; n < 2; ++n) { const int j = 16 * (2 * nh + n) + fr; const bf16x8 bfv = *(const LAS bf16x8*)(lds + FF_Z2 + j * 256 + (((4 * ks + g) ^ (j & 15)) << 4));
                acc2[n] = __builtin_amdgcn_mfma_f32_16x16x32_bf16(af, bfv, acc2[n], 0, 0, 0); }
        }
#pragma unroll
        for (int n = 0; n < 2; ++n)
#pragma unroll
            for (int r = 0; r < 4; ++r) { const int k = 16 * (2 * nh + n) + fr + 64 * (16 * mf + 4 * g + r); *(LAS bf16_t*)(lds + FF_OB + k * 8 + cl * 2) = f2bf(acc2[n][r]); }
    }
    __syncthreads();
    bf16_t* CAT = (bf16_t*)(a->ws + WS_CAT) + (size_t)(b * 4096) * D + cg * 4;
#pragma unroll
    for (int it = 0; it < 8; ++it) { const int k = tid + 512 * it; *(u32x2*)(CAT + (size_t)k * D) = *(const LAS u32x2*)(lds + FF_OB + k * 8); }
    __syncthreads();
}

__device__ __forceinline__ void p2_mix(AP a, unsigned char* ldsg, LAS unsigned char* lds, int l) {
    const int n_dft = 256, n_dftc = (l == 0) ? 16 : 0, n_mix = 128 + ((l == 0) ? 8 : 0);
    bf16_t* CAT = (bf16_t*)(a->ws + WS_CAT);
    bool fft_ready = false;
    for (int u = blockIdx.x; u < n_dft + n_dftc + n_mix; u += gridDim.x) {
        if (u < n_dft) {
            if (!fft_ready) { fft_setup(lds); fft_ready = true; }
            for (int rep = 0; rep < PROBE_FFT_REP; ++rep) fft_unit(a, lds, u >> 6, u & 63);
        } else if (u < n_dft + n_dftc) {
            const int uu = u - n_dft, b = uu >> 2, mt = (uu >> 1) & 1, ch0 = (uu & 1) * 128;
            const bf16_t* A = (const bf16_t*)(a->ws + WS_DFTC) + (size_t)(mt * 128) * 512;
            const bf16_t* B0 = (const bf16_t*)(a->ws + WS_ATC) + ((size_t)b * 256 + ch0) * 512;
            EpiBf16 E; E.C = CAT + (size_t)(NLAT + b * 256 + mt * 128) * D + ch0; E.ld = D;
            gemm_tile<128, false, EpiBf16>(lds, A, 512, nullptr, 128, B0, B0 + (size_t)64 * 512, 512, 512, E);
        } else {
            const int t = u - n_dft - n_dftc;
#if NAIVE_MIXER
            if (t < 128) { const int b = t >> 5; mixer_tile(a, ldsg, l, t * 128, b * 4096, (t & 31) * 128, 4096, b, false); }
            else { const int tt = t - 128, b = tt >> 1; mixer_tile(a, ldsg, l, NLAT + tt * 128, NLAT + b * 256, (tt & 1) * 128, 256, b, true); }
#else
            const bool isc = t >= 128; const int tt = t - 128;
            const int b = isc ? (tt >> 1) : (t >> 5);
            for (int rep = 0; rep < PROBE_MIX_REP; ++rep) mixer_tile_fast(a, lds, l, isc ? NLAT + tt * 128 : t * 128, isc ? NLAT + b * 256 : b * 4096, isc ? (tt & 1) * 128 : (t & 31) * 128, isc ? 256 : 4096, b, isc);
#endif
        }
    }
    exp_queue(a, ldsg, l);
}

__device__ __forceinline__ int uni(int v) { return __builtin_amdgcn_readfirstlane(v); }
__device__ __forceinline__ int vblock() { const int G = gridDim.x, b = blockIdx.x; return (G % 8 == 0) ? (b % 8) * (G / 8) + b / 8 : b; }
template <class T> __device__ __forceinline__ T* unip(T* p) { const unsigned long long v = (unsigned long long)p; const unsigned lo = __builtin_amdgcn_readfirstlane((unsigned)v), hi = __builtin_amdgcn_readfirstlane((unsigned)(v >> 32)); return (T*)(((unsigned long long)hi << 32) | lo); }
struct SchedInProj {
    typedef EpiInProj Epi; static constexpr bool GATHER = false;
    unsigned char* ws; int l, G, me;
    __device__ __forceinline__ bool get(int i, g256::Unit<Epi>& u) const {
        const int n_lat = 64 * 7, n_ctx = (l == 0) ? 4 * 7 : 4;
        const int idx = i * G + me; if (idx >= n_lat + n_ctx) return false;
        int row0, b, ct, n; bf16_t *tF, *tV;
        if (idx < n_lat) { const int rt = idx / 7; ct = idx % 7; row0 = rt * 256; b = row0 >> 12; n = 4096;
            tF = (bf16_t*)(ws + WS_AT) + (size_t)b * 256 * 2 * 4096; tV = (bf16_t*)(ws + WS_VT) + (size_t)b * 128 * 4096; }
        else { const int uu = idx - n_lat; int rt; if (l == 0) { rt = uu / 7; ct = uu % 7; } else { rt = uu; ct = 3; }
            row0 = NLAT + rt * 256; b = rt; n = 256;
            tF = (bf16_t*)(ws + WS_ATC) + (size_t)b * 256 * 2 * 256; tV = (bf16_t*)(ws + WS_VTC) + (size_t)b * 128 * 256; }
        u.A = (const bf16_t*)(ws + WS_H) + (size_t)row0 * D;
        u.B0 = (const bf16_t*)(ws + WS_WIN) + ((size_t)l * ZC + ct * 256) * 1024; u.B1 = u.B0 + (size_t)128 * 1024; u.ridx = nullptr; u.valid = 256;
        u.epi.Zt = (bf16_t*)(ws + WS_Z) + (size_t)row0 * ZC + ct * 256; u.epi.tF = tF; u.epi.tV = tV; u.epi.n0 = ct * 256; u.epi.pos0 = (idx < n_lat) ? (row0 & 4095) : 0; u.epi.n = n;
        return true;
    }
};
struct SchedOutProj {
    typedef EpiF32 Epi; static constexpr bool GATHER = false;
    unsigned char* ws; int l, G, me;
    __device__ __forceinline__ bool get(int i, g256::Unit<Epi>& u) const {
        const int nrt = (l == 0) ? NTOK / 256 : NLAT / 256;
        const int idx = i * G + me; if (idx >= nrt * 4) return false;
        const int rt = idx >> 2, ct = idx & 3;
        u.A = (const bf16_t*)(ws + WS_CAT) + (size_t)(rt * 256) * D;
        u.B0 = (const bf16_t*)(ws + WS_WOUT) + ((size_t)l * 1024 + ct * 256) * 1024; u.B1 = u.B0 + (size_t)128 * 1024; u.ridx = nullptr; u.valid = 256;
        u.epi.C = (float*)(ws + WS_Y) + (size_t)(rt * 256) * D + ct * 256; u.epi.ld = D;
        return true;
    }
};
struct SchedGateUp {
    typedef EpiGateUp Epi; static constexpr bool GATHER = true;
    unsigned char* ws; const LAS int* blk; const LAS int* tot; const LAS int* ridx_lds; int G, me;
    __device__ __forceinline__ bool get(int i, g256::Unit<Epi>& u) const {
        const int idx = i * G + me; if (idx >= uni(blk[32]) * 4) return false;
        const int rb = idx >> 2, ct = idx & 3;
        int e = 0;
#pragma unroll 1
        for (int q = 1; q < 32; ++q) if (uni(blk[q]) <= rb) e = q;
        u.A = (const bf16_t*)(ws + WS_H);
        u.B0 = (const bf16_t*)(ws + WS_WEXP) + ((size_t)e * 512 + ct * 128) * 1024; u.B1 = u.B0 + EXPMAT;
        u.ridx = ridx_lds + (i & 7) * 256; u.valid = uni(min(256, tot[e] - (rb - blk[e]) * 256));
        u.epi.C = (bf16_t*)(ws + WS_HID) + (size_t)(rb * 256) * DEXP + ct * 128; u.epi.ld = DEXP;
        return true;
    }
};
struct SchedDown {
    typedef EpiBf16 Epi; static constexpr bool GATHER = false;
    unsigned char* ws; const LAS int* blk; int G, me;
    __device__ __forceinline__ bool get(int i, g256::Unit<Epi>& u) const {
        const int idx = i * G + me; if (idx >= uni(blk[32]) * 4) return false;
        const int rb = idx >> 2, ct = idx & 3;
        int e = 0;
#pragma unroll 1
        for (int q = 1; q < 32; ++q) if (uni(blk[q]) <= rb) e = q;
        u.A = (const bf16_t*)(ws + WS_HID) + (size_t)(rb * 256) * DEXP;
        u.B0 = (const bf16_t*)(ws + WS_WEXP) + 2 * EXPMAT + ((size_t)e * 1024 + ct * 256) * 512; u.B1 = u.B0 + (size_t)128 * 512; u.ridx = nullptr; u.valid = 256;
        u.epi.C = (bf16_t*)(ws + WS_YS) + (size_t)(rb * 256) * D + ct * 256; u.epi.ld = D;
        return true;
    }
};

__device__ __forceinline__ void p4_ln1_router(AP a, unsigned char* lds, int l) {
    const int tid = tid_opaque(), lane = tid & 63, w = tid >> 6;
    const int ntok = (l == 0) ? NTOK : NLAT;
    int* cnt = (int*)(lds + MISC_OFF);
    if (tid < 32) cnt[tid] = 0;
    f32x4* Lg = (f32x4*)lds; f32x4* Le = (f32x4*)(lds + 16384); f32x4* Lgb = (f32x4*)(lds + 147456);
    {
        const float* wrg_ = a->in[16] + (size_t)l * 1024 * 4; const float* wre_ = a->in[17] + (size_t)l * 1024 * 32;
#pragma unroll
        for (int it = 0; it < 2; ++it) { const int c = tid + 512 * it, slot = (((c >> 8) * 4 + (c & 3)) << 6) + ((c >> 2) & 63);
            Lg[slot] = *(const f32x4*)(wrg_ + (size_t)c * 4);
#pragma unroll
            for (int q = 0; q < 8; ++q) Le[q * 1024 + slot] = *(const f32x4*)(wre_ + (size_t)c * 32 + q * 4); }
        Lgb[tid] = (tid < 256) ? *(const f32x4*)(a->in[14] + l * 1024 + tid * 4) : *(const f32x4*)(a->in[15] + l * 1024 + (tid - 256) * 4);
    }
    __syncthreads();
    const float* mod = (const float*)(a->ws + WS_MOD) + (size_t)l * 5 * 6144;
    const float* Y = (const float*)(a->ws + WS_Y);
    float* X1 = (float*)(a->ws + WS_X1);
    bf16_t* H = (bf16_t*)(a->ws + WS_H);
    int* tokE = (int*)(a->ws + WS_TOKE); int* tokR = (int*)(a->ws + WS_TOKR); float* tokG = (float*)(a->ws + WS_TOKG);
    const int tstep = gridDim.x * 8;
    f32x4 nx[4], ny[4];
    {   const int t = blockIdx.x * 8 + w;
        if (t < ntok) { const float* xs = (l == 0) ? ((t < NLAT) ? a->in[0] + (size_t)t * D : a->in[2] + (size_t)(t - NLAT) * D) : (const float*)(a->ws + WS_XC) + (size_t)t * D;
#pragma unroll
            for (int i = 0; i < 4; ++i) { nx[i] = *(const f32x4*)(xs + 256 * i + 4 * lane); ny[i] = *(const f32x4*)(Y + (size_t)t * D + 256 * i + 4 * lane); } } }
    int mrow = -1; f32x4 mg[4], msh[4], msc[4];
    for (int t = blockIdx.x * 8 + w; t < ntok; t += tstep) {
        const int mr = (t < NLAT) ? (t >> 12) : 4;
        if (mr != mrow) { mrow = mr; const float* m = mod + (size_t)mr * 6144;
#pragma unroll
            for (int i = 0; i < 4; ++i) { const int c = 256 * i + 4 * lane; mg[i] = *(const f32x4*)(m + 2048 + c); msh[i] = *(const f32x4*)(m + 3072 + c); msc[i] = *(const f32x4*)(m + 4096 + c); } }
        f32x4 v[4];
#pragma unroll
        for (int i = 0; i < 4; ++i) {
#pragma unroll
            for (int e = 0; e < 4; ++e) v[i][e] = RES_ALPHA * nx[i][e] + mg[i][e] * ny[i][e]; }
        {   const int tn = t + tstep;
            if (tn < ntok) { const float* xs = (l == 0) ? ((tn < NLAT) ? a->in[0] + (size_t)tn * D : a->in[2] + (size_t)(tn - NLAT) * D) : (const float*)(a->ws + WS_XC) + (size_t)tn * D;
#pragma unroll
                for (int i = 0; i < 4; ++i) { nx[i] = *(const f32x4*)(xs + 256 * i + 4 * lane); ny[i] = *(const f32x4*)(Y + (size_t)tn * D + 256 * i + 4 * lane); } } }
        float mean, rstd; ln_stats(v, mean, rstd);
#pragma unroll
        for (int i = 0; i < 4; ++i) { const int c = 256 * i + 4 * lane; const f32x4 gg = Lgb[64 * i + lane], bb = Lgb[256 + 64 * i + lane];
#pragma unroll
            for (int e = 0; e < 4; ++e) v[i][e] = (v[i][e] - mean) * rstd * gg[e] + bb[e];
            *(f32x4*)(X1 + (size_t)t * D + c) = v[i]; }
        ln_stats(v, mean, rstd);
#pragma unroll
        for (int i = 0; i < 4; ++i) { const int c = 256 * i + 4 * lane; const f32x4 sh = msh[i], sc = msc[i];
#pragma unroll
            for (int e = 0; e < 4; ++e) v[i][e] = (v[i][e] - mean) * rstd * (1.0f + sc[e]) + sh[e];
            u32x2 pk; pk.x = pack2(v[i][0], v[i][1]); pk.y = pack2(v[i][2], v[i][3]); *(u32x2*)(H + (size_t)t * D + c) = pk; }
        float lg[4] = {0.f, 0.f, 0.f, 0.f};
#pragma unroll
        for (int i = 0; i < 4; ++i)
#pragma unroll
            for (int e = 0; e < 4; ++e) { const f32x4 wv = Lg[((i * 4 + e) << 6) + lane];
                lg[0] += v[i][e] * wv[0]; lg[1] += v[i][e] * wv[1]; lg[2] += v[i][e] * wv[2]; lg[3] += v[i][e] * wv[3]; }
#pragma unroll
        for (int q = 0; q < 4; ++q) lg[q] = wave_sum(lg[q]);
        int grp = 0; float mx = lg[0];
#pragma unroll
        for (int q = 1; q < 4; ++q) if (lg[q] > mx) { mx = lg[q]; grp = q; }
        float se = 0.f;
#pragma unroll
        for (int q = 0; q < 4; ++q) se += expf(lg[q] - mx);
        const float gate_group = 1.0f / se;
        float le[8] = {0.f, 0.f, 0.f, 0.f, 0.f, 0.f, 0.f, 0.f};
#pragma unroll
        for (int i = 0; i < 4; ++i)
#pragma unroll
            for (int e = 0; e < 4; ++e) { const f32x4* wp = Le + grp * 2048 + ((i * 4 + e) << 6) + lane; const f32x4 w0 = wp[0], w1 = wp[1024];
                le[0] += v[i][e] * w0[0]; le[1] += v[i][e] * w0[1]; le[2] += v[i][e] * w0[2]; le[3] += v[i][e] * w0[3];
                le[4] += v[i][e] * w1[0]; le[5] += v[i][e] * w1[1]; le[6] += v[i][e] * w1[2]; le[7] += v[i][e] * w1[3]; }
#pragma unroll
        for (int q = 0; q < 8; ++q) le[q] = wave_sum(le[q]);
        int j1 = 0; float l1 = le[0];
#pragma unroll
        for (int q = 1; q < 8; ++q) if (le[q] > l1) { l1 = le[q]; j1 = q; }
        int j2 = -1; float l2 = -3.0e38f;
#pragma unroll
        for (int q = 0; q < 8; ++q) if (q != j1 && le[q] > l2) { l2 = le[q]; j2 = q; }
        const float e2 = expf(l2 - l1), p1 = 1.0f / (1.0f + e2), p2 = e2 / (1.0f + e2);
        if (lane == 0) {
            const int ex0 = grp * 8 + j1, ex1 = grp * 8 + j2;
            const int r0 = atomicAdd(&cnt[ex0], 1), r1 = atomicAdd(&cnt[ex1], 1);
            tokE[2 * t] = ex0; tokE[2 * t + 1] = ex1; tokR[2 * t] = r0; tokR[2 * t + 1] = r1;
            tokG[2 * t] = gate_group * p1; tokG[2 * t + 1] = gate_group * p2;
        }
    }
    __syncthreads();
    if (tid < 32) ((int*)(a->ws + WS_BCNT))[((size_t)l * MAXG + blockIdx.x) * 32 + tid] = cnt[tid];
    __syncthreads();
}

__device__ __forceinline__ void p5_dispatch(AP a, unsigned char* lds, int l) {
    const int tid = tid_opaque();
    const int ntok = (l == 0) ? NTOK : NLAT;
    int* part = (int*)lds;
    int* tot = (int*)(lds + 4096);
    int* off = (int*)(lds + 4096 + 128);
    int* pstart = (int*)(lds + 4096 + 256);
    const int* bc = (const int*)(a->ws + WS_BCNT) + (size_t)l * MAXG * 32;
    const int G = gridDim.x, me = blockIdx.x;
    { const int e = tid & 31, p = tid >> 5; int s = 0, so = 0; for (int bb = p; bb < G; bb += 16) { const int c = bc[bb * 32 + e]; s += c; if (bb < me) so += c; } part[p * 32 + e] = s; part[512 + p * 32 + e] = so; }
    __syncthreads();
    if (tid < 32) { int s = 0, so = 0; for (int p = 0; p < 16; ++p) { s += part[p * 32 + tid]; so += part[512 + p * 32 + tid]; } tot[tid] = s; off[tid] = so; }
    __syncthreads();
    if (tid == 0) { int acc = 0; for (int e = 0; e < 32; ++e) { pstart[e] = acc; acc += ((tot[e] + 255) >> 8) << 8; } }
    __syncthreads();
    if (me == 0 && tid < 32) ((int*)(a->ws + WS_CNT))[l * 32 + tid] = tot[tid];
    const int* tokE = (const int*)(a->ws + WS_TOKE); const int* tokR = (const int*)(a->ws + WS_TOKR);
    int* tokS = (int*)(a->ws + WS_TOKS); int* slotT = (int*)(a->ws + WS_SLOTT);
    for (int base = me * 8; base < ntok; base += G * 8) {
        if (tid < 16) { const int t = base + (tid >> 1); if (t < ntok) { const int idx = 2 * t + (tid & 1); const int e = tokE[idx]; const int slot = pstart[e] + off[e] + tokR[idx]; tokS[idx] = slot; slotT[slot] = t; } }
    }
    __syncthreads();
}

__device__ __forceinline__ void moe_table(AP a, int l, LAS int* blk) {
    const int* tot = (const int*)(a->ws + WS_CNT) + l * 32;
    if (threadIdx.x == 0) { int acc = 0; for (int e = 0; e < 32; ++e) { const int c = tot[e]; blk[e] = acc; blk[33 + e] = c; acc += (c + 255) >> 8; } blk[32] = acc; }
    __syncthreads();
}
__device__ __forceinline__ void p1_inproj(AP a, LAS unsigned char* lds, int l) {
    SchedInProj S; S.ws = a->ws; S.l = l; S.G = gridDim.x; S.me = vblock();
    g256::gemm_phase(lds, 1024, S);
}
__device__ __forceinline__ void p3_outproj(AP a, LAS unsigned char* lds, int l) {
    SchedOutProj S; S.ws = a->ws; S.l = l; S.G = gridDim.x; S.me = vblock();
    g256::gemm_phase(lds, 1024, S);
}
__device__ __forceinline__ void p6_gateup(AP a, LAS unsigned char* lds, int l) {
    LAS int* blk = (LAS int*)(lds + MISC_OFF + 256);
    moe_table(a, l, blk);
    LAS int* ridx = (LAS int*)(lds + RIDX_OFF);
    const int tid = tid_opaque(), G = gridDim.x, me = vblock(), nu = blk[32] * 4;
    const int* slotT = (const int*)(a->ws + WS_SLOTT);
    for (int i = 0; i < 8; ++i) { const int idx = i * G + me; if (idx >= nu) break;
        const int rb = idx >> 2; int e = 0; for (int q = 1; q < 32; ++q) if (blk[q] <= rb) e = q;
        const int valid = min(256, blk[33 + e] - (rb - blk[e]) * 256);
        if (tid < 256) ridx[i * 256 + tid] = (tid < valid) ? slotT[rb * 256 + tid] : 0; }
    __syncthreads();
    SchedGateUp S; S.ws = a->ws; S.blk = blk; S.tot = blk + 33; S.ridx_lds = ridx; S.G = G; S.me = me;
    g256::gemm_phase(lds, 1024, S);
    __syncthreads();
}
__device__ __forceinline__ void p7_down(AP a, LAS unsigned char* lds, int l) {
    LAS int* blk = (LAS int*)(lds + MISC_OFF + 256);
    moe_table(a, l, blk);
    SchedDown S; S.ws = a->ws; S.blk = blk; S.G = gridDim.x; S.me = vblock();
    g256::gemm_phase(lds, 512, S);
    __syncthreads();
}

__device__ __forceinline__ void p8_ln2(AP a, unsigned char* lds, int l) {
    const int tid = tid_opaque(), lane = tid & 63, w = tid >> 6;
    const int ntok = (l == 0) ? NTOK : NLAT;
    const float* mod = (const float*)(a->ws + WS_MOD) + (size_t)l * 5 * 6144;
    const float* modn = (const float*)(a->ws + WS_MOD) + (size_t)5 * 6144;
    const float* X1 = (const float*)(a->ws + WS_X1);
    const bf16_t* YS = (const bf16_t*)(a->ws + WS_YS);
    const int* tokS = (const int*)(a->ws + WS_TOKS); const float* tokG = (const float*)(a->ws + WS_TOKG);
    f32x4* Lgb = (f32x4*)lds;
    __syncthreads();
    Lgb[tid] = (tid < 256) ? *(const f32x4*)(a->in[21] + l * 1024 + tid * 4) : *(const f32x4*)(a->in[22] + l * 1024 + (tid - 256) * 4);
    __syncthreads();
    int mrow = -1; f32x4 mg[4], nsh[4], nsc[4];
    const int tstep = gridDim.x * 8;
    int t = blockIdx.x * 8 + w;
    int ns0 = 0, ns1 = 0; float nga = 0.f, ngb = 0.f;
    f32x4 nx[4]; u32x2 nya[4], nyb[4];
    float cga = 0.f, cgb = 0.f;
    if (t < ntok) { const int s0 = tokS[2 * t], s1 = tokS[2 * t + 1]; cga = tokG[2 * t]; cgb = tokG[2 * t + 1];
#pragma unroll
        for (int i = 0; i < 4; ++i) { const int c = 256 * i + 4 * lane; nx[i] = *(const f32x4*)(X1 + (size_t)t * D + c); nya[i] = *(const u32x2*)(YS + (size_t)s0 * D + c); nyb[i] = *(const u32x2*)(YS + (size_t)s1 * D + c); } }
    if (t + tstep < ntok) { ns0 = tokS[2 * (t + tstep)]; ns1 = tokS[2 * (t + tstep) + 1]; nga = tokG[2 * (t + tstep)]; ngb = tokG[2 * (t + tstep) + 1]; }
    for (; t < ntok; t += tstep) {
        const int mr = (t < NLAT) ? (t >> 12) : 4;
        if (mr != mrow) { mrow = mr; const float* m = mod + (size_t)mr * 6144; const float* mn = modn + (size_t)mr * 6144;
#pragma unroll
            for (int i = 0; i < 4; ++i) { const int c = 256 * i + 4 * lane; mg[i] = *(const f32x4*)(m + 5120 + c); if (l == 0) { nsh[i] = *(const f32x4*)(mn + c); nsc[i] = *(const f32x4*)(mn + 1024 + c); } } }
        f32x4 v[4];
#pragma unroll
        for (int i = 0; i < 4; ++i) { const f32x4 gv = mg[i];
            const u32x2 ya = nya[i], yb = nyb[i];
            const float f0 = cga * lo2f(ya.x) + cgb * lo2f(yb.x), f1 = cga * hi2f(ya.x) + cgb * hi2f(yb.x), f2 = cga * lo2f(ya.y) + cgb * lo2f(yb.y), f3 = cga * hi2f(ya.y) + cgb * hi2f(yb.y);
            v[i][0] = RES_ALPHA * nx[i][0] + gv[0] * f0; v[i][1] = RES_ALPHA * nx[i][1] + gv[1] * f1; v[i][2] = RES_ALPHA * nx[i][2] + gv[2] * f2; v[i][3] = RES_ALPHA * nx[i][3] + gv[3] * f3; }
        {   const int tn = t + tstep, tn2 = t + 2 * tstep;
            if (tn < ntok) {
#pragma unroll
                for (int i = 0; i < 4; ++i) { const int c = 256 * i + 4 * lane; nx[i] = *(const f32x4*)(X1 + (size_t)tn * D + c); nya[i] = *(const u32x2*)(YS + (size_t)ns0 * D + c); nyb[i] = *(const u32x2*)(YS + (size_t)ns1 * D + c); }
                cga = nga; cgb = ngb; }
            if (tn2 < ntok) { ns0 = tokS[2 * tn2]; ns1 = tokS[2 * tn2 + 1]; nga = tokG[2 * tn2]; ngb = tokG[2 * tn2 + 1]; } }
        float mean, rstd; ln_stats(v, mean, rstd);
        float* dst = (l == 0) ? (float*)(a->ws + WS_XC) + (size_t)t * D : a->out + (size_t)t * D;
#pragma unroll
        for (int i = 0; i < 4; ++i) { const int c = 256 * i + 4 * lane; const f32x4 gg = Lgb[64 * i + lane], bb = Lgb[256 + 64 * i + lane];
#pragma unroll
            for (int e = 0; e < 4; ++e) v[i][e] = (v[i][e] - mean) * rstd * gg[e] + bb[e];
            *(f32x4*)(dst + c) = v[i]; }
        if (l == 0) {
            ln_stats(v, mean, rstd);
            bf16_t* H = (bf16_t*)(a->ws + WS_H);
#pragma unroll
            for (int i = 0; i < 4; ++i) { const int c = 256 * i + 4 * lane; const f32x4 sh = nsh[i], sc = nsc[i];
                f32x4 o;
#pragma unroll
                for (int e = 0; e < 4; ++e) o[e] = (v[i][e] - mean) * rstd * (1.0f + sc[e]) + sh[e];
                u32x2 pk; pk.x = pack2(o[0], o[1]); pk.y = pack2(o[2], o[3]); *(u32x2*)(H + (size_t)t * D + c) = pk; }
        }
    }
}

constexpr int N_PHASES = 18;
template <int P> __device__ __forceinline__ void run_phase(AP a, unsigned char* smem, LAS unsigned char* lds, int l) {
    asm volatile("" : "+s"(a));
    if (P == 0) p0_prologue(a, smem);
    if (P == 1) p_lnmod0(a);
    if (P == 2) p1_inproj(a, lds, l);
    if (P == 3) p2_mix(a, smem, lds, l);
    if (P == 4) p3_outproj(a, lds, l);
    if (P == 5) p4_ln1_router(a, smem, l);
    if (P == 6) p5_dispatch(a, smem, l);
    if (P == 7) p6_gateup(a, lds, l);
    if (P == 8) p7_down(a, lds, l);
    if (P == 9) p8_ln2(a, smem, l);
}
template <int P> __device__ __noinline__ void phase_fn(AP ap, int l) {
    extern __shared__ __attribute__((aligned(16))) unsigned char smem[];
    run_phase<P>(ap, smem, (LAS unsigned char*)smem, l);
}
#if N_LAUNCH_MODE == 1
__global__ void __launch_bounds__(NT, 2) fwd(Args a) {
    extern __shared__ __attribute__((aligned(16))) unsigned char smem[];
    LAS unsigned char* lds = (LAS unsigned char*)smem;
    if (threadIdx.x < 4) ((volatile LAS unsigned*)(lds + MISC_OFF + 768))[threadIdx.x] = 0u;
    __syncthreads();
    XcdBarrier bar = xcd_barrier_post((unsigned*)(a.ws + WS_BAR), (volatile LAS unsigned*)(lds + MISC_OFF + 768));
    AP ap = (AP)__builtin_amdgcn_kernarg_segment_ptr();
#define PROBE(P, l) do { if (PROBE_MASK & (1 << (P))) { for (int _r = 0; _r < 2; ++_r) { xcd_barrier(bar); run_phase<P>(ap, smem, lds, l); } } } while (0)
    run_phase<0>(ap, smem, lds, 0); PROBE(0, 0); xcd_barrier(bar);
    run_phase<1>(ap, smem, lds, 0); PROBE(1, 0); xcd_barrier(bar);
    for (int l = 0; l < 2; ++l) {
        run_phase<2>(ap, smem, lds, l); PROBE(2, l); xcd_barrier(bar);
        run_phase<3>(ap, smem, lds, l); PROBE(3, l); xcd_barrier(bar);
        run_phase<4>(ap, smem, lds, l); PROBE(4, l); xcd_barrier(bar);
        run_phase<5>(ap, smem, lds, l); PROBE(5, l); xcd_barrier(bar);
        run_phase<6>(ap, smem, lds, l); PROBE(6, l); xcd_barrier(bar);
        run_phase<7>(ap, smem, lds, l); PROBE(7, l); xcd_barrier(bar);
        run_phase<8>(ap, smem, lds, l); PROBE(8, l); xcd_barrier(bar);
        run_phase<9>(ap, smem, lds, l); PROBE(9, l); if (l == 0) xcd_barrier(bar);
    }
}
#else
template <int P> __global__ void __launch_bounds__(NT, 2) k_phase(Args a) {
    extern __shared__ __attribute__((aligned(16))) unsigned char smem[];
    LAS unsigned char* lds = (LAS unsigned char*)smem;
    AP ap = (AP)__builtin_amdgcn_kernarg_segment_ptr();
    run_phase<P>(ap, smem, lds, ap->ph_lo);
}
template <int P> static void launch_phase(Args a, int l, int grid, hipStream_t stream) {
    static bool attr = false;
    if (!attr) { (void)hipFuncSetAttribute((const void*)k_phase<P>, hipFuncAttributeMaxDynamicSharedMemorySize, LDS_BYTES); attr = true; }
    a.ph_lo = l; a.ph_hi = P;
    hipLaunchKernelGGL(k_phase<P>, dim3(grid), dim3(NT), LDS_BYTES, stream, a);
}
#endif

extern "C" void kernel_launch(void* const* d_in, const int* in_sizes, int n_in, void* d_out, int out_size, void* d_ws, size_t ws_size, hipStream_t stream) {
    static int grid = 0;
    if (grid == 0) {
        if (n_in != 23 || out_size != NLAT * D || ws_size < WS_END) { fprintf(stderr, "kernel_launch: unexpected shapes (n_in %d, out %d, ws %zu, need %zu)\n", n_in, out_size, ws_size, (size_t)WS_END); grid = -1; return; }
        int dev = 0, cus = 0;
        if (hipGetDevice(&dev) != hipSuccess || hipDeviceGetAttribute(&cus, hipDeviceAttributeMultiprocessorCount, dev) != hipSuccess) { grid = -1; return; }
#if N_LAUNCH_MODE == 1
        int per_cu = 0;
        if (hipFuncSetAttribute((const void*)fwd, hipFuncAttributeMaxDynamicSharedMemorySize, LDS_BYTES) != hipSuccess) { fprintf(stderr, "kernel_launch: hipFuncSetAttribute failed\n"); grid = -1; return; }
        if (hipOccupancyMaxActiveBlocksPerMultiprocessor(&per_cu, (const void*)fwd, NT, LDS_BYTES) != hipSuccess || per_cu < 1) { fprintf(stderr, "kernel_launch: occupancy query says %d\n", per_cu); }
        (void)hipGetLastError();
#endif
        grid = cus; if (grid > MAXG) grid = MAXG;
    }
    if (grid < 0) return;
    (void)hipMemsetAsync((char*)d_ws + WS_BAR, 0, 16384 + 256, stream);
    Args a{};
    for (int i = 0; i < 23; ++i) a.in[i] = (const float*)d_in[i];
    a.out = (float*)d_out; a.ws = (unsigned char*)d_ws;
#if N_LAUNCH_MODE == 1
    a.ph_lo = 0; a.ph_hi = N_PHASES;
    hipLaunchKernelGGL(fwd, dim3(grid), dim3(NT), LDS_BYTES, stream, a);
#else
    launch_phase<0>(a, 0, grid, stream);
    launch_phase<1>(a, 0, grid, stream);
    for (int l = 0; l < 2; ++l) {
        launch_phase<2>(a, l, grid, stream); launch_phase<3>(a, l, grid, stream); launch_phase<4>(a, l, grid, stream); launch_phase<5>(a, l, grid, stream);
        launch_phase<6>(a, l, grid, stream); launch_phase<7>(a, l, grid, stream); launch_phase<8>(a, l, grid, stream); launch_phase<9>(a, l, grid, stream);
    }
#endif
}
```

```cpp
#include <hip/hip_runtime.h>
#include <stdint.h>
#include <stdio.h>

#ifndef NAIVE_GEMM
#define NAIVE_GEMM 0
#endif
#ifndef NAIVE_MIXER
#define NAIVE_MIXER 0
#endif
#ifndef PROBE_MASK
#define PROBE_MASK 0
#endif
#ifndef PROBE_FFT_REP
#define PROBE_FFT_REP 1
#endif
#ifndef PROBE_MIX_REP
#define PROBE_MIX_REP 1
#endif
#ifndef PROBE_SGU_REP
#define PROBE_SGU_REP 1
#endif
#ifndef N_LAUNCH_MODE
#define N_LAUNCH_MODE 1
#endif

#define LAS __attribute__((address_space(3)))
typedef unsigned short bf16_t;
typedef short bf16x8 __attribute__((ext_vector_type(8)));
typedef float f32x4 __attribute__((ext_vector_type(4)));
typedef unsigned u32x4 __attribute__((ext_vector_type(4)));
typedef unsigned u32x2 __attribute__((ext_vector_type(2)));
typedef float f32x2 __attribute__((ext_vector_type(2)));

constexpr int D = 1024, NBATCH = 4, SEQ = 4096, CTXL = 256;
constexpr int NLAT = NBATCH * SEQ, NCTX = NBATCH * CTXL, NTOK = NLAT + NCTX;
constexpr int ZC = 1792;
constexpr int NEXP = 32, DEXP = 512;
constexpr int NSLOT = 2 * NTOK + NEXP * 256;
constexpr int NT = 512;
constexpr int MAXG = 512;
constexpr float RES_ALPHA = 1.41421356237309515f;
constexpr int MISC_OFF = 155648;
constexpr int RIDX_OFF = 131072;
constexpr int LDS_BYTES = MISC_OFF + 1024;

constexpr size_t WS_BAR   = 0;
constexpr size_t WS_CNT   = 16384;
constexpr size_t WS_BCNT  = WS_CNT + 256;
constexpr size_t WS_MOD   = WS_BCNT + (size_t)2 * MAXG * 32 * 4;
constexpr size_t WS_ROPE  = WS_MOD + (size_t)2 * 5 * 6144 * 4;
constexpr size_t WS_TOKE  = WS_ROPE + 8192;
constexpr size_t WS_TOKR  = WS_TOKE + (size_t)NTOK * 8;
constexpr size_t WS_TOKS  = WS_TOKR + (size_t)NTOK * 8;
constexpr size_t WS_TOKG  = WS_TOKS + (size_t)NTOK * 8;
constexpr size_t WS_SLOTT = WS_TOKG + (size_t)NTOK * 8;
constexpr size_t WS_WIN   = WS_SLOTT + (size_t)NSLOT * 4;
constexpr size_t WS_WOUT  = WS_WIN + (size_t)2 * ZC * 1024 * 2;
constexpr size_t WS_WSGU  = WS_WOUT + (size_t)2 * 1024 * 1024 * 2;
constexpr size_t WS_DFT   = WS_WSGU + (size_t)2 * 4 * 128 * 128 * 2;
constexpr size_t WS_DFTC  = WS_DFT + (size_t)4096 * 8192 * 2;
constexpr size_t WS_WEXP  = WS_DFTC + (size_t)256 * 512 * 2;
constexpr size_t EXPMAT   = (size_t)NEXP * 512 * 1024;
constexpr size_t WS_X1    = WS_WEXP + 3 * EXPMAT * 2;
constexpr size_t WS_XC    = WS_X1 + (size_t)NTOK * D * 4;
constexpr size_t WS_H     = WS_XC + (size_t)NTOK * D * 4;
constexpr size_t WS_R     = WS_H + (size_t)NTOK * D * 2;
constexpr size_t WS_Z     = WS_R;
constexpr size_t WS_AT    = WS_Z + (size_t)NTOK * ZC * 2;
constexpr size_t WS_ATC   = WS_AT + (size_t)4 * 256 * 8192 * 2;
constexpr size_t WS_VT    = WS_ATC + (size_t)4 * 256 * 512 * 2;
constexpr size_t WS_VTC   = WS_VT + (size_t)4 * 2 * 64 * 4096 * 2;
constexpr size_t WS_CAT   = WS_VTC + (size_t)4 * 2 * 64 * 256 * 2;
constexpr size_t WS_REND  = WS_CAT + (size_t)NTOK * D * 2;
constexpr size_t WS_Y     = WS_R;
constexpr size_t WS_HID   = WS_R;
constexpr size_t WS_YS    = WS_HID + (size_t)NSLOT * DEXP * 2;
constexpr size_t WS_END   = (WS_YS + (size_t)NSLOT * D * 2 > WS_REND) ? WS_YS + (size_t)NSLOT * D * 2 : WS_REND;
static_assert(WS_Y + (size_t)NTOK * D * 4 <= WS_CAT, "Y must not reach CAT");
static_assert(WS_WIN % 256 == 0 && WS_DFT % 256 == 0 && WS_WEXP % 256 == 0 && WS_X1 % 256 == 0 && WS_H % 256 == 0 && WS_R % 256 == 0 && WS_AT % 256 == 0 && WS_CAT % 256 == 0 && WS_YS % 256 == 0, "alignment");

struct Args { const float* in[23]; float* out; unsigned char* ws; int ph_lo, ph_hi; };
#define CAS __attribute__((address_space(4)))
typedef const CAS Args* AP;

#define XB_TMO      128
#define XB_XCNT(j)  (256  + 64 * (j))
#define XB_XSUB(j)  (1280 + 64 * (j))
#define XB_XGEN(j)  (2304 + 64 * (j))
#define XB_TOP      3328
#define XB_TOPGEN   3392
#define XCD_BAR_WORDS 3456
#define XB_SPIN_CAP (1u << 18)

__device__ __forceinline__ unsigned xb_ld(unsigned* p)              { return __hip_atomic_load(p, __ATOMIC_RELAXED, __HIP_MEMORY_SCOPE_AGENT); }
__device__ __forceinline__ unsigned xb_add(unsigned* p, unsigned v) { return __hip_atomic_fetch_add(p, v, __ATOMIC_RELAXED, __HIP_MEMORY_SCOPE_AGENT); }
__device__ __forceinline__ unsigned xb_xcc_id() { return (unsigned)__builtin_amdgcn_s_getreg((3 << 11) | 20) & 0xFu; }
#define XB_SPIN(cond, bar) do { unsigned _sp = 0; while (cond) { __builtin_amdgcn_s_sleep(1); \
    if ((++_sp & 255u) == 0u) { if (xb_ld(&(bar)[XB_TMO])) break; if (_sp > XB_SPIN_CAP) { atomicAdd(&(bar)[XB_TMO], 1u); break; } } } } while (0)

struct XcdBarrier { unsigned* bar; unsigned x; volatile LAS unsigned* st; };

__device__ __forceinline__ XcdBarrier xcd_barrier_post(unsigned* bar, volatile LAS unsigned* st) {
    XcdBarrier b; b.bar = bar; b.x = (unsigned)__builtin_amdgcn_readfirstlane((int)xb_xcc_id()); b.st = st;
    if (threadIdx.x == 0) (void)xb_add(&bar[XB_XCNT(b.x)], 1u);
    return b;
}
__device__ __forceinline__ void xcd_barrier_complete(unsigned* bar, unsigned x, unsigned& nloc, unsigned& nx) {
    const unsigned G = gridDim.x * gridDim.y * gridDim.z;
    unsigned sum, cnt, mine, sp = 0u;
    for (;;) {
        sum = 0u; cnt = 0u; mine = 0u;
#pragma unroll
        for (unsigned j = 0; j < 16; ++j) { const unsigned c = xb_ld(&bar[XB_XCNT(j)]); sum += c; cnt += (c > 0u) ? 1u : 0u; mine = (j == x) ? c : mine; }
        if (sum == G) break;
        __builtin_amdgcn_s_sleep(1);
        if ((++sp & 255u) == 0u) { if (xb_ld(&bar[XB_TMO])) break; if (sp > XB_SPIN_CAP) { atomicAdd(&bar[XB_TMO], 1u); break; } }
    }
    nloc = mine > 0u ? mine : 1u; nx = cnt > 0u ? cnt : 1u;
}
__device__ __forceinline__ void xcd_barrier(const XcdBarrier& b) {
    asm volatile("s_waitcnt vmcnt(0)" ::: "memory");
    __syncthreads();
    if (threadIdx.x == 0) {
        unsigned* bar = b.bar;
        unsigned bx = b.x;
        asm volatile("" : "+s"(bar), "+s"(bx));
        __builtin_amdgcn_s_waitcnt(0);
        unsigned nloc = b.st[0], nx = b.st[1];
        if (nloc == 0u) { xcd_barrier_complete(bar, bx, nloc, nx); b.st[0] = nloc; b.st[1] = nx; }
        const unsigned old = xb_add(&bar[XB_XSUB(bx)], 1u);
        const unsigned gen = old / nloc;
        if (old + 1u == (gen + 1u) * nloc) {
            __builtin_amdgcn_fence(__ATOMIC_RELEASE, "agent");
            asm volatile("s_waitcnt vmcnt(0)" ::: "memory");
            const unsigned og = xb_add(&bar[XB_TOP], 1u);
            const unsigned tg = og / nx;
            if (og + 1u == (tg + 1u) * nx) xb_add(&bar[XB_TOPGEN], 1u);
            else XB_SPIN(xb_ld(&bar[XB_TOPGEN]) == tg, bar);
            __builtin_amdgcn_fence(__ATOMIC_ACQUIRE, "agent");
            xb_add(&bar[XB_XGEN(bx)], 1u);
            asm volatile("s_waitcnt vmcnt(0)" ::: "memory");
        } else {
            XB_SPIN(xb_ld(&bar[XB_XGEN(bx)]) == gen, bar);
            __builtin_amdgcn_fence(__ATOMIC_ACQUIRE, "agent");
            asm volatile("s_waitcnt vmcnt(0)" ::: "memory");
        }
    }
    __syncthreads();
}

__device__ __forceinline__ int tid_opaque() { int t = threadIdx.x; asm volatile("" : "+v"(t)); return t; }
__device__ __forceinline__ float bf2f(bf16_t v) { return __uint_as_float(((unsigned)v) << 16); }
__device__ __forceinline__ bf16_t f2bf(float f) { return __builtin_bit_cast(unsigned short, (__bf16)f); }
typedef __bf16 hwbf16x2 __attribute__((ext_vector_type(2)));
__device__ __forceinline__ unsigned pack2(float a, float b) { return __builtin_bit_cast(unsigned, __builtin_convertvector((f32x2){a, b}, hwbf16x2)); }
__device__ __forceinline__ float lo2f(unsigned w) { return __uint_as_float(w << 16); }
__device__ __forceinline__ float hi2f(unsigned w) { return __uint_as_float(w & 0xffff0000u); }
template <int CTRL> __device__ __forceinline__ float dpp_mov(float v) { return __builtin_bit_cast(float, __builtin_amdgcn_update_dpp(0, __builtin_bit_cast(int, v), CTRL, 0xf, 0xf, true)); }
__device__ __forceinline__ float row_sum16(float v) {
    v += dpp_mov<0xB1>(v);
    v += dpp_mov<0x4E>(v);
    v += dpp_mov<0x141>(v);
    v += dpp_mov<0x140>(v);
    return v;
}
__device__ __forceinline__ float row_max16(float v) {
    v = fmaxf(v, dpp_mov<0xB1>(v)); v = fmaxf(v, dpp_mov<0x4E>(v)); v = fmaxf(v, dpp_mov<0x141>(v)); v = fmaxf(v, dpp_mov<0x140>(v));
    return v;
}
__device__ __forceinline__ float wave_sum(float v) {
    v = row_sum16(v);
    const int iv = __builtin_bit_cast(int, v);
    const float a0 = __builtin_bit_cast(float, __builtin_amdgcn_readlane(iv, 0)), a1 = __builtin_bit_cast(float, __builtin_amdgcn_readlane(iv, 16));
    const float a2 = __builtin_bit_cast(float, __builtin_amdgcn_readlane(iv, 32)), a3 = __builtin_bit_cast(float, __builtin_amdgcn_readlane(iv, 48));
    return (a0 + a1) + (a2 + a3);
}
__device__ __forceinline__ float gelu_erf(float v) {
    const float t = __builtin_amdgcn_rcpf(fabsf(v) * 0.2316418882f + 1.0f);
    float q = t * 0.5307027145f + (-0.7265760135f); q = q * t + 0.7107068705f; q = q * t + (-0.142248368f); q = q * t + 0.127414796f; q = q * t;
    const float m = v * (q * __builtin_amdgcn_exp2f((v * v) * (-0.72134752044f)));
    return v < 0.f ? m : v - m;
}
__device__ __forceinline__ float silu_f(float x) { return x / (1.0f + __expf(-x)); }

__device__ __forceinline__ void ln_stats(const f32x4 (&v)[4], float& mean, float& rstd) {
    float s = 0.f;
#pragma unroll
    for (int i = 0; i < 4; ++i) s += (v[i][0] + v[i][1]) + (v[i][2] + v[i][3]);
    s = wave_sum(s); mean = s * (1.0f / 1024.0f);
    float q = 0.f;
#pragma unroll
    for (int i = 0; i < 4; ++i)
#pragma unroll
        for (int e = 0; e < 4; ++e) { const float d = v[i][e] - mean; q += d * d; }
    q = wave_sum(q); rstd = 1.0f / sqrtf(q * (1.0f / 1024.0f) + 1e-6f);
}

__device__ __forceinline__ void ln_stats16(const f32x4 (&v)[16], float& mean, float& rstd) {
    float s = 0.f;
#pragma unroll
    for (int k = 0; k < 16; ++k) s += (v[k][0] + v[k][1]) + (v[k][2] + v[k][3]);
    s = row_sum16(s); mean = s * (1.0f / 1024.0f);
    float q = 0.f;
#pragma unroll
    for (int k = 0; k < 16; ++k)
#pragma unroll
        for (int e = 0; e < 4; ++e) { const float d = v[k][e] - mean; q += d * d; }
    q = row_sum16(q); rstd = 1.0f / sqrtf(q * (1.0f / 1024.0f) + 1e-6f);
}

template <int BN> struct MfmaLayout {
    static constexpr int FG = BN / 128, NI = 4, NJ = 2 * FG;
    int rbase, cbase;
    __device__ __forceinline__ int row(int i) const { return rbase + 16 * i; }
    __device__ __forceinline__ int col(int jj) const { return (jj / FG) * (BN / 2) + (jj % FG) * 16 + cbase; }
};
template <int BN> struct NaiveLayout {
    static constexpr int TX = BN / 8, TY = NT / TX, NI = 128 / TY, NJ = 2;
    int ty, tx;
    __device__ __forceinline__ int row(int i) const { return ty + TY * i; }
    __device__ __forceinline__ int col(int jj) const { return jj * (BN / 2) + 4 * tx; }
};

__device__ __forceinline__ void glds16(const bf16_t* g, LAS unsigned char* l) {
    __builtin_amdgcn_global_load_lds((const unsigned*)g, (LAS unsigned*)l, 16, 0, 0);
}

template <int BN, bool GATHER, class Epi>
__device__ __forceinline__ void gemm_tile(LAS unsigned char* lds, const bf16_t* A, int lda, const int* rowidx, int valid_rows,
                                          const bf16_t* B0, const bf16_t* B1, int ldb, int K, const Epi& epi) {
    constexpr int A_B = 16384, B_B = BN * 128, STAGE = A_B + B_B, NBL = BN / 64;
    const int tid = tid_opaque(), lane = tid & 63, wid = __builtin_amdgcn_readfirstlane(tid >> 6);
    const bf16_t* ap[2]; const bf16_t* bp[NBL];
#pragma unroll
    for (int i = 0; i < 2; ++i) {
        const int P = i * 512 + tid, row = P >> 3, c = (P & 7) ^ ((row >> 1) & 7);
        size_t ro;
        if (GATHER) ro = (size_t)(row < valid_rows ? rowidx[row] : 0) * (size_t)lda; else ro = (size_t)row * (size_t)lda;
        ap[i] = A + ro + c * 8;
    }
#pragma unroll
    for (int i = 0; i < NBL; ++i) {
        const int P = i * 512 + tid, row = P >> 3, c = (P & 7) ^ ((row >> 1) & 7);
        const bf16_t* base = (row < BN / 2) ? (B0 + (size_t)row * ldb) : (B1 + (size_t)(row - BN / 2) * ldb);
        bp[i] = base + c * 8;
    }
    const int nk = K / 64;
#define GT_STAGE(buf, k0) do { \
        _Pragma("unroll") for (int _i = 0; _i < 2; ++_i) glds16(ap[_i] + (k0), lds + (buf) * STAGE + _i * 8192 + wid * 1024); \
        _Pragma("unroll") for (int _i = 0; _i < NBL; ++_i) glds16(bp[_i] + (k0), lds + (buf) * STAGE + A_B + _i * 8192 + wid * 1024); } while (0)

#if NAIVE_GEMM
    typedef NaiveLayout<BN> Lay;
    Lay lay; lay.tx = tid % Lay::TX; lay.ty = tid / Lay::TX;
    f32x4 acc[Lay::NI][Lay::NJ];
#pragma unroll
    for (int i = 0; i < Lay::NI; ++i)
#pragma unroll
        for (int j = 0; j < Lay::NJ; ++j) acc[i][j] = (f32x4){0.f, 0.f, 0.f, 0.f};
    GT_STAGE(0, 0);
    asm volatile("s_waitcnt vmcnt(0)" ::: "memory"); __syncthreads();
    for (int kt = 0; kt < nk; ++kt) {
        if (kt + 1 < nk) GT_STAGE((kt + 1) & 1, (kt + 1) * 64);
        const LAS unsigned char* sa = lds + (kt & 1) * STAGE; const LAS unsigned char* sb = sa + A_B;
#pragma unroll 1
        for (int kc = 0; kc < 8; ++kc)
#pragma unroll 1
            for (int hh = 0; hh < 2; ++hh) {
                float a[Lay::NI][4];
#pragma unroll
                for (int i = 0; i < Lay::NI; ++i) { const int row = lay.row(i);
                    const u32x2 w = *(const LAS u32x2*)(sa + row * 128 + ((kc ^ ((row >> 1) & 7)) << 4) + hh * 8);
                    a[i][0] = lo2f(w.x); a[i][1] = hi2f(w.x); a[i][2] = lo2f(w.y); a[i][3] = hi2f(w.y); }
#pragma unroll
                for (int j = 0; j < 2; ++j)
#pragma unroll
                    for (int e = 0; e < 4; ++e) { const int row = j * (BN / 2) + 4 * lay.tx + e;
                        const u32x2 w = *(const LAS u32x2*)(sb + row * 128 + ((kc ^ ((row >> 1) & 7)) << 4) + hh * 8);
                        const float b0 = lo2f(w.x), b1 = hi2f(w.x), b2 = lo2f(w.y), b3 = hi2f(w.y);
#pragma unroll
                        for (int i = 0; i < Lay::NI; ++i) acc[i][j][e] += (a[i][0] * b0 + a[i][1] * b1) + (a[i][2] * b2 + a[i][3] * b3); }
            }
        asm volatile("s_waitcnt vmcnt(0)" ::: "memory"); __syncthreads();
    }
    epi.run(acc, lay);
#else
    typedef MfmaLayout<BN> Lay;
    constexpr int FG = Lay::FG;
    const int fr = lane & 15, g = lane >> 4, wr = wid >> 2, wc = wid & 3;
    Lay lay; lay.rbase = wr * 64 + fr; lay.cbase = wc * 16 * FG + 4 * g;
    f32x4 acc[Lay::NI][Lay::NJ];
#pragma unroll
    for (int i = 0; i < Lay::NI; ++i)
#pragma unroll
        for (int j = 0; j < Lay::NJ; ++j) acc[i][j] = (f32x4){0.f, 0.f, 0.f, 0.f};
    int aoff[4], boff[Lay::NJ];
#pragma unroll
    for (int m = 0; m < 4; ++m) { const int row = wr * 64 + m * 16 + fr; aoff[m] = row * 128 + ((g ^ ((row >> 1) & 7)) << 4); }
#pragma unroll
    for (int jj = 0; jj < Lay::NJ; ++jj) { const int row = (jj / FG) * (BN / 2) + wc * 16 * FG + (jj % FG) * 16 + fr; boff[jj] = A_B + row * 128 + ((g ^ ((row >> 1) & 7)) << 4); }
    GT_STAGE(0, 0);
    asm volatile("s_waitcnt vmcnt(0)" ::: "memory"); __syncthreads();
    for (int kt = 0; kt < nk; ++kt) {
        if (kt + 1 < nk) GT_STAGE((kt + 1) & 1, (kt + 1) * 64);
        const LAS unsigned char* sa = lds + (kt & 1) * STAGE;
#pragma unroll
        for (int ks = 0; ks < 2; ++ks) {
            bf16x8 af[4], bfv[Lay::NJ];
#pragma unroll
            for (int m = 0; m < 4; ++m) af[m] = *(const LAS bf16x8*)(sa + (aoff[m] ^ (ks << 6)));
#pragma unroll
            for (int jj = 0; jj < Lay::NJ; ++jj) bfv[jj] = *(const LAS bf16x8*)(sa + (boff[jj] ^ (ks << 6)));
#pragma unroll
            for (int m = 0; m < 4; ++m)
#pragma unroll
                for (int jj = 0; jj < Lay::NJ; ++jj) acc[m][jj] = __builtin_amdgcn_mfma_f32_16x16x32_bf16(bfv[jj], af[m], acc[m][jj], 0, 0, 0);
        }
        asm volatile("s_waitcnt vmcnt(0)" ::: "memory"); __syncthreads();
    }
    epi.run(acc, lay);
#endif
#undef GT_STAGE
}

namespace g256 {
constexpr int BK = 64, HALF = 128, HTB = HALF * BK * 2, STAGE_BYTES = 8 * HTB;
__device__ __forceinline__ int lds_byte(int r, int c) { const int st = (r >> 4) * 2 + (c >> 5), rr = r & 15, cc = c & 31, ob = rr * 64 + cc * 2; return st * 1024 + (ob ^ (((ob >> 9) & 1) << 5)); }
__device__ __forceinline__ void stage_rc(int b, int& R, int& C) { const int st = b / 1024, sb = b % 1024, swz = sb ^ (((sb >> 9) & 1) << 5); R = (st >> 1) * 16 + swz / 64; C = (st & 1) * 32 + (swz % 64) / 2; }
struct Lay {
    static constexpr int NI = 8, NJ = 4;
    int rbase, cbase;
    __device__ __forceinline__ int row(int i) const { return (i >> 2) * 128 + (i & 3) * 16 + rbase; }
    __device__ __forceinline__ int col(int j) const { return (j >> 1) * 128 + (j & 1) * 16 + cbase; }
};
template <class Epi> struct Unit { const bf16_t* A; const bf16_t* B0; const bf16_t* B1; const LAS int* ridx; int valid; Epi epi; };

template <class Sched>
__device__ __forceinline__ void gemm_phase(LAS unsigned char* lds, const int K, const Sched& S) {
    typedef typename Sched::Epi Epi;
    const int tid = tid_opaque(), wid = __builtin_amdgcn_readfirstlane(tid >> 6), lane = tid & 63, wr = wid >> 2, wc = wid & 3, fr = lane & 15, fq = lane >> 4;
    int nt = K / BK; asm volatile("" : "+s"(nt));
    int sR[2], sC[2];
#pragma unroll
    for (int i = 0; i < 2; ++i) stage_rc(tid * 16 + i * 8192, sR[i], sC[i]);
    unsigned voffB[2];
#pragma unroll
    for (int i = 0; i < 2; ++i) voffB[i] = (unsigned)(sR[i] * K + sC[i]) * 2u;
    const size_t kstep = (size_t)(BK * 2);
    const unsigned ldsw = (unsigned)wid * 1024u;
    const int aoff = lds_byte(wr * 64 + fr, fq * 8), boff = lds_byte(wc * 32 + fr, fq * 8);
#define G2_SA(b, h) (((b) * 2 + (h)) * HTB)
#define G2_SB(b, h) ((4 + (b) * 2 + (h)) * HTB)
#define G2_STAGE(bufoff, gbase, v0, v1) do { \
        __builtin_amdgcn_global_load_lds((const unsigned*)((const char*)(gbase) + (v0)), (LAS unsigned*)(lds + (bufoff) + ldsw), 16, 0, 0); \
        __builtin_amdgcn_global_load_lds((const unsigned*)((const char*)(gbase) + (v1)), (LAS unsigned*)(lds + (bufoff) + ldsw + 8192), 16, 0, 0); } while (0)
#define G2_LDA(dst, b, h) do { _Pragma("unroll") for (int m = 0; m < 4; ++m) _Pragma("unroll") for (int k = 0; k < 2; ++k) dst[m][k] = *(const LAS bf16x8*)(lds + G2_SA(b, h) + aoff + m * 2048 + k * 1024); } while (0)
#define G2_LDB(dst, b, h) do { _Pragma("unroll") for (int n = 0; n < 2; ++n) _Pragma("unroll") for (int k = 0; k < 2; ++k) dst[n][k] = *(const LAS bf16x8*)(lds + G2_SB(b, h) + boff + n * 2048 + k * 1024); } while (0)
#define G2_MMA(ai, bj, At, Bt) do { __builtin_amdgcn_s_setprio(1); _Pragma("unroll") for (int m = 0; m < 4; ++m) _Pragma("unroll") for (int n = 0; n < 2; ++n) _Pragma("unroll") for (int k = 0; k < 2; ++k) \
        acc[(ai) * 4 + m][(bj) * 2 + n] = __builtin_amdgcn_mfma_f32_16x16x32_bf16(Bt[n][k], At[m][k], acc[(ai) * 4 + m][(bj) * 2 + n], 0, 0, 0); __builtin_amdgcn_s_setprio(0); } while (0)
#define G2_WAIT_V(n) asm volatile("s_waitcnt vmcnt(" #n ")" ::: "memory")
#define G2_WAIT_L(n) asm volatile("s_waitcnt lgkmcnt(" #n ")" ::: "memory")
#define G2_BAR __builtin_amdgcn_s_barrier()
#define G2_SCHED __builtin_amdgcn_sched_barrier(0)
#define G2_VOFFA(U, dst) do { _Pragma("unroll") for (int _h = 0; _h < 2; ++_h) _Pragma("unroll") for (int _i = 0; _i < 2; ++_i) { const int _row = _h * 128 + sR[_i]; \
        int _tok = _row; if (Sched::GATHER) _tok = (_row < (U).valid) ? (U).ridx[_row] : 0; dst[_h][_i] = (unsigned)(_tok * K + sC[_i]) * 2u; } } while (0)
    Unit<Epi> cur, nxt; int ui = 0;
    if (!S.get(0, cur)) return;
    f32x4 acc[8][4];
#pragma unroll
    for (int i = 0; i < 8; ++i)
#pragma unroll
        for (int j = 0; j < 4; ++j) acc[i][j] = (f32x4){0.f, 0.f, 0.f, 0.f};
    bf16x8 At[4][2], B0[2][2], B1[2][2];
    unsigned cvA[2][2], nvA[2][2];
    G2_VOFFA(cur, cvA);
    const char* cA = (const char*)cur.A; const char* cB0 = (const char*)cur.B0; const char* cB1 = (const char*)cur.B1;
    G2_STAGE(G2_SB(0, 0), cB0, voffB[0], voffB[1]); G2_STAGE(G2_SA(0, 0), cA, cvA[0][0], cvA[0][1]); G2_STAGE(G2_SB(0, 1), cB1, voffB[0], voffB[1]); G2_STAGE(G2_SA(0, 1), cA, cvA[1][0], cvA[1][1]);
    if (wr == 1) G2_BAR;
    G2_WAIT_V(4); G2_BAR;
    G2_STAGE(G2_SB(1, 0), cB0 + kstep, voffB[0], voffB[1]); G2_STAGE(G2_SA(1, 0), cA + kstep, cvA[0][0], cvA[0][1]); G2_STAGE(G2_SB(1, 1), cB1 + kstep, voffB[0], voffB[1]);
    G2_WAIT_V(6); G2_BAR;
    for (;;) {
        const bool has_next = S.get(ui + 1, nxt);
        if (Sched::GATHER) {
            if (has_next) { G2_VOFFA(nxt, nvA); }
            else {
#pragma unroll
                for (int h = 0; h < 2; ++h) { nvA[h][0] = cvA[h][0]; nvA[h][1] = cvA[h][1]; } }
        }
        const char* nA = has_next ? (const char*)nxt.A : cA; const char* nB0 = has_next ? (const char*)nxt.B0 : cB0; const char* nB1 = has_next ? (const char*)nxt.B1 : cB1;
#pragma unroll 1
        for (int t = 0; t < nt; t += 2) {
            const bool last = (t == nt - 2);
            const char* a1 = cA + (size_t)(t + 1) * kstep;
            const char* a2 = last ? nA : cA + (size_t)(t + 2) * kstep;
            const char* b20 = last ? nB0 : cB0 + (size_t)(t + 2) * kstep; const char* b21 = last ? nB1 : cB1 + (size_t)(t + 2) * kstep;
#define x00 ((Sched::GATHER && last) ? nvA[0][0] : cvA[0][0])
#define x01 ((Sched::GATHER && last) ? nvA[0][1] : cvA[0][1])
#define x10 ((Sched::GATHER && last) ? nvA[1][0] : cvA[1][0])
#define x11 ((Sched::GATHER && last) ? nvA[1][1] : cvA[1][1])
            G2_LDB(B0, 0, 0); G2_SCHED; G2_LDA(At, 0, 0); G2_STAGE(G2_SA(1, 1), a1, cvA[1][0], cvA[1][1]);
            G2_WAIT_L(8); G2_BAR; G2_WAIT_L(0); G2_MMA(0, 0, At, B0); G2_BAR; G2_SCHED;
            G2_LDB(B1, 0, 1); G2_STAGE(G2_SB(0, 0), b20, voffB[0], voffB[1]);
            G2_BAR; G2_WAIT_L(0); G2_MMA(0, 1, At, B1); G2_BAR;
            G2_LDA(At, 0, 1); G2_STAGE(G2_SA(0, 0), a2, x00, x01);
            G2_BAR; G2_WAIT_L(0); G2_MMA(1, 0, At, B0); G2_BAR; G2_SCHED;
            G2_STAGE(G2_SB(0, 1), b21, voffB[0], voffB[1]);
            G2_WAIT_V(6); G2_BAR; G2_MMA(1, 1, At, B1); G2_BAR;
            G2_LDB(B0, 1, 0); G2_SCHED; G2_LDA(At, 1, 0); G2_STAGE(G2_SA(0, 1), a2, x10, x11);
            G2_WAIT_L(8); G2_BAR; G2_WAIT_L(0); G2_MMA(0, 0, At, B0); G2_BAR; G2_SCHED;
            G2_LDB(B1, 1, 1); G2_STAGE(G2_SB(1, 0), b20 + kstep, voffB[0], voffB[1]);
            G2_BAR; G2_WAIT_L(0); G2_MMA(0, 1, At, B1); G2_BAR;
            G2_LDA(At, 1, 1); G2_STAGE(G2_SA(1, 0), a2 + kstep, x00, x01);
            G2_BAR; G2_WAIT_L(0); G2_MMA(1, 0, At, B0); G2_BAR; G2_SCHED;
            G2_STAGE(G2_SB(1, 1), b21 + kstep, voffB[0], voffB[1]);
            G2_WAIT_V(6); G2_BAR; G2_MMA(1, 1, At, B1); G2_BAR;
        }
        { Lay lay; int rbv = wr * 64 + fr, cbv = wc * 32 + 4 * fq; asm volatile("" : "+v"(rbv), "+v"(cbv));
          lay.rbase = rbv; lay.cbase = cbv; cur.epi.run(acc, lay); }
        if (!has_next) break;
#pragma unroll
        for (int i = 0; i < 8; ++i)
#pragma unroll
            for (int j = 0; j < 4; ++j) acc[i][j] = (f32x4){0.f, 0.f, 0.f, 0.f};
        cur = nxt; cA = nA; cB0 = nB0; cB1 = nB1; ++ui;
        if (Sched::GATHER) {
#pragma unroll
            for (int h = 0; h < 2; ++h) { cvA[h][0] = nvA[h][0]; cvA[h][1] = nvA[h][1]; } }
    }
#undef x00
#undef x01
#undef x10
#undef x11
    G2_WAIT_V(0);
    if (wr == 0) G2_BAR;
    G2_BAR;
#undef G2_SA
#undef G2_SB
#undef G2_STAGE
#undef G2_LDA
#undef G2_LDB
#undef G2_MMA
#undef G2_WAIT_V
#undef G2_WAIT_L
#undef G2_BAR
#undef G2_SCHED
#undef G2_VOFFA
}
}

struct EpiF32 {
    float* C; int ld;
    template <class L> __device__ __forceinline__ void run(const f32x4 (&acc)[L::NI][L::NJ], const L& lay) const {
#pragma unroll
        for (int i = 0; i < L::NI; ++i)
#pragma unroll
            for (int j = 0; j < L::NJ; ++j) *(f32x4*)(C + (size_t)lay.row(i) * ld + lay.col(j)) = acc[i][j];
    }
};
struct EpiBf16 {
    bf16_t* C; int ld;
    template <class L> __device__ __forceinline__ void run(const f32x4 (&acc)[L::NI][L::NJ], const L& lay) const {
#pragma unroll
        for (int i = 0; i < L::NI; ++i)
#pragma unroll
            for (int j = 0; j < L::NJ; ++j) { u32x2 w; w.x = pack2(acc[i][j][0], acc[i][j][1]); w.y = pack2(acc[i][j][2], acc[i][j][3]);
                *(u32x2*)(C + (size_t)lay.row(i) * ld + lay.col(j)) = w; }
    }
};
struct EpiGateUp {
    bf16_t* C; int ld;
    template <class L> __device__ __forceinline__ void run(const f32x4 (&acc)[L::NI][L::NJ], const L& lay) const {
#pragma unroll
        for (int i = 0; i < L::NI; ++i)
#pragma unroll
            for (int j = 0; j < L::NJ / 2; ++j) { const f32x4 gt = acc[i][j], up = acc[i][j + L::NJ / 2];
                u32x2 w; w.x = pack2(silu_f(gt[0]) * up[0], silu_f(gt[1]) * up[1]); w.y = pack2(silu_f(gt[2]) * up[2], silu_f(gt[3]) * up[3]);
                *(u32x2*)(C + (size_t)lay.row(i) * ld + lay.col(j)) = w; }
    }
};
struct EpiInProj {
    bf16_t* Zt;
    bf16_t* tF;
    bf16_t* tV;
    int n0, pos0, n;
    template <class L> __device__ __forceinline__ void run(const f32x4 (&acc)[L::NI][L::NJ], const L& lay) const {
#pragma unroll
        for (int i = 0; i < L::NI; ++i)
#pragma unroll
            for (int j = 0; j < L::NJ; ++j) {
                const int r = lay.row(i), cl = lay.col(j), c = n0 + cl;
                const f32x4 v = acc[i][j];
                if (c < 512) {
                    const int part = c >> 8, ch = c & 255;
#pragma unroll
                    for (int e = 0; e < 4; ++e) tF[((size_t)(ch + e) * 2 + part) * n + pos0 + r] = f2bf(v[e]);
                } else {
                    u32x2 w; w.x = pack2(v[0], v[1]); w.y = pack2(v[2], v[3]);
                    *(u32x2*)(Zt + (size_t)r * ZC + cl) = w;
                    if (c >= 896 && c < 1024) {
#pragma unroll
                        for (int e = 0; e < 4; ++e) tV[(size_t)(c - 896 + e) * n + pos0 + r] = f2bf(v[e]);
                    }
                }
            }
    }
};

constexpr int U_ADA = 192, U_WIN = 2 * 16 * 28, U_WOUT = 2 * 16 * 16, U_SGU = 32, U_DFT = 256, U_ROPE = 1, U_EXP = 3 * 32 * 32;
constexpr int LDS_SIL = 0, LDS_RED = 20480, LDS_TILE = 32768, LDS_T64 = 49408, LDS_CTAB = 50176;

__device__ __forceinline__ void ada_unit(AP a, unsigned char* lds, int u) {
    float* sil = (float*)(lds + LDS_SIL); float* red = (float*)(lds + LDS_RED);
    const int tid = tid_opaque(), lane = tid & 63, w = tid >> 6;
    const int l = u / 96, cg = u % 96;
    for (int i = tid; i < 5120; i += NT) { const int r = i >> 10, k = i & 1023; const float v = (r < 4) ? a->in[1][r * 1024 + k] : a->in[3][k]; sil[i] = v / (1.0f + expf(-v)); }
    __syncthreads();
    const float* W = a->in[4] + (size_t)l * 1024 * 6144 + cg * 64 + lane;
    float acc[5] = {0.f, 0.f, 0.f, 0.f, 0.f};
#pragma unroll 32
    for (int k = w * 128; k < w * 128 + 128; ++k) { const float wv = W[(size_t)k * 6144];
#pragma unroll
        for (int r = 0; r < 5; ++r) acc[r] += sil[r * 1024 + k] * wv; }
#pragma unroll
    for (int r = 0; r < 5; ++r) red[(w * 5 + r) * 64 + lane] = acc[r];
    __syncthreads();
    if (tid < 320) { const int r = tid >> 6; float s = 0.f;
#pragma unroll
        for (int ww = 0; ww < 8; ++ww) s += red[(ww * 5 + r) * 64 + lane];
        const int j = cg * 64 + lane; ((float*)(a->ws + WS_MOD))[(size_t)(l * 5 + r) * 6144 + j] = s + a->in[5][l * 6144 + j]; }
    __syncthreads();
}

__device__ __forceinline__ void tile_store_T(const float* tile, bf16_t* dst, int ldd) {
    const int tid = tid_opaque(), n = tid >> 3, kc = tid & 7;
    u32x4 w;
    w.x = pack2(tile[(kc * 8 + 0) * 65 + n], tile[(kc * 8 + 1) * 65 + n]); w.y = pack2(tile[(kc * 8 + 2) * 65 + n], tile[(kc * 8 + 3) * 65 + n]);
    w.z = pack2(tile[(kc * 8 + 4) * 65 + n], tile[(kc * 8 + 5) * 65 + n]); w.w = pack2(tile[(kc * 8 + 6) * 65 + n], tile[(kc * 8 + 7) * 65 + n]);
    *(u32x4*)(dst + (size_t)n * ldd + kc * 8) = w;
}
__device__ __forceinline__ void tile_load(float* tile, const float* src, int lds_) {
    const int tid = tid_opaque();
#pragma unroll
    for (int i = 0; i < 2; ++i) { const int row = (tid >> 4) + 32 * i, c4 = (tid & 15) * 4; const f32x4 v = *(const f32x4*)(src + (size_t)row * lds_ + c4);
        tile[row * 65 + c4 + 0] = v[0]; tile[row * 65 + c4 + 1] = v[1]; tile[row * 65 + c4 + 2] = v[2]; tile[row * 65 + c4 + 3] = v[3]; }
}

__device__ __forceinline__ void mm64_f32(const float* tA, int lda, const float* tB, int ldb, int K, float* out) {
    const int tid = tid_opaque(), lane = tid & 63, w = tid >> 6, fr = lane & 15, g = lane >> 4, mi = w >> 1, nj = 2 * (w & 1);
    f32x4 acc0 = (f32x4){0.f, 0.f, 0.f, 0.f}, acc1 = (f32x4){0.f, 0.f, 0.f, 0.f};
    const float* pa = tA + (16 * mi + fr) * lda + g; const float* pb = tB + g * ldb + 16 * nj + fr;
#pragma unroll 4
    for (int k0 = 0; k0 < K; k0 += 4) { const float av = pa[k0], b0 = pb[k0 * ldb], b1 = pb[k0 * ldb + 16];
        acc0 = __builtin_amdgcn_mfma_f32_16x16x4f32(av, b0, acc0, 0, 0, 0); acc1 = __builtin_amdgcn_mfma_f32_16x16x4f32(av, b1, acc1, 0, 0, 0); }
#pragma unroll
    for (int r = 0; r < 4; ++r) { out[(16 * mi + 4 * g + r) * 65 + 16 * nj + fr] = acc0[r]; out[(16 * mi + 4 * g + r) * 65 + 16 * nj + 16 + fr] = acc1[r]; }
}

__device__ __forceinline__ void win_unit(AP a, unsigned char* lds, int u) {
    float* tile = (float*)(lds + LDS_TILE); float* T = (float*)(lds + LDS_T64);
    const int tid = tid_opaque();
    const int l = u / 448, r = u % 448, kb = r / 28, nb = r % 28;
    const float* Win = a->in[6] + (size_t)l * 1024 * 1536;
    const int srccol = (nb >= 8) ? nb * 64 - 256 : (nb & 3) * 64;
    tile_load(tile, Win + (size_t)(kb * 64) * 1536 + srccol, 1536);
    if (nb < 8 && tid < 64) { T[tid] = cospif((float)tid / 32.0f); T[64 + tid] = sinpif((float)tid / 32.0f); }
    __syncthreads();
    bf16_t* dst = (bf16_t*)(a->ws + WS_WIN) + ((size_t)l * ZC + nb * 64) * 1024 + kb * 64;
    if (nb >= 8) tile_store_T(tile, dst, 1024);
    else {
        const int part = nb >> 2;
        float* Tm = (float*)(lds + 65536); float* out = (float*)(lds + 98304);
        for (int i = tid; i < 4096; i += NT) { const int c = i >> 6, cp = i & 63; const float t = T[part * 64 + ((c * cp) & 63)]; Tm[i] = (part ? -t : t) * 0.125f; }
        __syncthreads();
        mm64_f32(tile, 65, Tm, 64, 64, out);
        __syncthreads();
        tile_store_T(out, dst, 1024);
    }
    __syncthreads();
}

__device__ __forceinline__ void wout_unit(AP a, unsigned char* lds, int u) {
    float* tile = (float*)(lds + LDS_TILE);
    __syncthreads();
    const int tid = tid_opaque();
    const int l = u / 256, r = u % 256, kb = r / 16, nb = r % 16;
    const float* Wo = a->in[13] + (size_t)l * 1024 * 1024;
    const int n = tid & 63, kq = __builtin_amdgcn_readfirstlane(tid >> 6);
    if (kb < 4) {
        float* tA = (float*)lds; float* tB = (float*)(lds + 65536);
        const float* wf = a->in[7] + (size_t)l * 256 * 256 + (size_t)(kb * 64) * 256;
        __syncthreads();
        f32x4 va[8], vb[8];
#pragma unroll
        for (int i = 0; i < 8; ++i) { const int q = tid + 512 * i; va[i] = *(const f32x4*)(wf + (size_t)q * 4); vb[i] = *(const f32x4*)(Wo + (size_t)(q >> 4) * 1024 + nb * 64 + (q & 15) * 4); }
#pragma unroll
        for (int i = 0; i < 8; ++i) { const int q = tid + 512 * i; *(f32x4*)(tA + (size_t)q * 4) = va[i]; *(f32x4*)(tB + (size_t)q * 4) = vb[i]; }
        __syncthreads();
        tile = (float*)(lds + 133120);
        mm64_f32(tA, 256, tB, 64, 256, tile);
    } else if (kb >= 8 && kb < 12) {
        const int g = kb - 8;
        float* tA = (float*)lds; float* tB = (float*)(lds + 65536);
        const float* wp = a->in[9] + (size_t)(l * 4 + g) * 64 * 64;
        const float* ps = a->in[10] + l * 256 + g * 64;
        f32x4 va[2], vb[2];
#pragma unroll
        for (int i = 0; i < 2; ++i) { const int q = tid + 512 * i; va[i] = *(const f32x4*)(wp + (size_t)q * 4); vb[i] = *(const f32x4*)(Wo + (size_t)(512 + g * 64 + (q >> 4)) * 1024 + nb * 64 + (q & 15) * 4) * ps[q >> 4]; }
#pragma unroll
        for (int i = 0; i < 2; ++i) { const int q = tid + 512 * i; *(f32x4*)(tA + (size_t)q * 4) = va[i]; *(f32x4*)(tB + (size_t)q * 4) = vb[i]; }
        __syncthreads();
        tile = (float*)(lds + 133120);
        mm64_f32(tA, 64, tB, 64, 64, tile);
    } else tile_load(tile, Wo + (size_t)(kb * 64) * 1024 + nb * 64, 1024);
    __syncthreads();
    tile_store_T(tile, (bf16_t*)(a->ws + WS_WOUT) + ((size_t)l * 1024 + nb * 64) * 1024 + kb * 64, 1024);
    __syncthreads();
}

__device__ __forceinline__ void exp_src_dst(AP a, int l, int u, const float*& src, int& srcld, bf16_t*& dst, int& dstld) {
    const int mat = u / 1024, e = (u % 1024) / 32, t = u % 32;
    const int kb = (mat < 2) ? t / 4 : t / 8, nb = (mat < 2) ? t % 4 : t % 8;
    srcld = (mat < 2) ? 512 : 1024; dstld = (mat < 2) ? 1024 : 512;
    src = a->in[18 + mat] + ((size_t)(l * 32 + e) * 512 * 1024) + (size_t)(kb * 128) * srcld + nb * 128;
    dst = (bf16_t*)(a->ws + WS_WEXP) + (size_t)mat * EXPMAT + (size_t)e * 512 * 1024 + (size_t)(nb * 128) * dstld + kb * 128;
}
#define EXP_LOAD(vv, uu) do { exp_src_dst(a, l, (uu), src, srcld, dst, dstld); _Pragma("unroll") for (int _i = 0; _i < 8; ++_i) vv[_i] = *(const f32x4*)(src + (size_t)((tid >> 5) + 16 * _i) * srcld + (tid & 31) * 4); } while (0)
#define EXP_PUT(vv) do { _Pragma("unroll") for (int _i = 0; _i < 8; ++_i) { float* tp = tile + ((tid >> 5) + 16 * _i) * 129 + (tid & 31) * 4; tp[0] = vv[_i][0]; tp[1] = vv[_i][1]; tp[2] = vv[_i][2]; tp[3] = vv[_i][3]; } } while (0)
#define EXP_STORE(dd, ld_) do { const int n = tid >> 2, kq = tid & 3; _Pragma("unroll") for (int j = 0; j < 4; ++j) { const float* tp = tile + (kq * 32 + j * 8) * 129 + n; u32x4 w; \
        w.x = pack2(tp[0], tp[129]); w.y = pack2(tp[2 * 129], tp[3 * 129]); w.z = pack2(tp[4 * 129], tp[5 * 129]); w.w = pack2(tp[6 * 129], tp[7 * 129]); \
        *(u32x4*)((dd) + (size_t)n * (ld_) + kq * 32 + j * 8) = w; } } while (0)
__device__ __forceinline__ void exp_range(AP a, unsigned char* lds, int l, int u0, int u_end) {
    float* tile = (float*)lds;
    const int tid = tid_opaque();
    __syncthreads();
    if (u0 >= u_end) return;
    const float* src; bf16_t* dst; int srcld, dstld;
    f32x4 va[8], vb[8];
    bf16_t *da, *db = nullptr; int lda_, ldb_ = 0;
    EXP_LOAD(va, u0); da = dst; lda_ = dstld;
    if (u0 + 1 < u_end) { EXP_LOAD(vb, u0 + 1); db = dst; ldb_ = dstld; }
    for (int u = u0; u < u_end; u += 2) {
        EXP_PUT(va);
        __syncthreads();
        { bf16_t* cd = da; const int cl = lda_; if (u + 2 < u_end) { EXP_LOAD(va, u + 2); da = dst; lda_ = dstld; } EXP_STORE(cd, cl); }
        __syncthreads();
        if (u + 1 < u_end) {
            EXP_PUT(vb);
            __syncthreads();
            { bf16_t* cd = db; const int cl = ldb_; if (u + 3 < u_end) { EXP_LOAD(vb, u + 3); db = dst; ldb_ = dstld; } EXP_STORE(cd, cl); }
            __syncthreads();
        }
    }
}
#undef EXP_LOAD
#undef EXP_PUT
#undef EXP_STORE
__device__ __forceinline__ void exp_queue(AP a, unsigned char* lds, int l) {
    const int tid = tid_opaque();
    int* qslot = (int*)(lds + MISC_OFF + 128);
    unsigned* qc = (unsigned*)(a->ws + WS_BAR + 14336 + l * 256);
    for (;;) {
        __syncthreads();
        if (tid == 0) *qslot = (int)__hip_atomic_fetch_add(qc, 4u, __ATOMIC_RELAXED, __HIP_MEMORY_SCOPE_AGENT);
        __syncthreads();
        const int c0 = *qslot;
        if (c0 >= U_EXP) break;
        exp_range(a, lds, l, c0, c0 + 4);
    }
}

__device__ __forceinline__ void p0_prologue(AP a, unsigned char* lds) {
    const int tid = tid_opaque();
    bool have_tab = false;
    constexpr int E0 = U_ADA, E1 = E0 + U_WIN, E2 = E1 + U_WOUT, E3 = E2 + U_SGU, E4 = E3 + U_DFT, E5 = E4 + U_ROPE;
    int u = blockIdx.x;
    for (; u < E5; u += gridDim.x) {
        if (u < E0) ada_unit(a, lds, u);
        else if (u < E1) win_unit(a, lds, u - E0);
        else if (u < E2) wout_unit(a, lds, u - E1);
        else if (u < E3) { const size_t i0 = (size_t)(u - E2) * 4096 + tid * 8; const float* s = a->in[11] + i0; bf16_t* d = (bf16_t*)(a->ws + WS_WSGU) + i0;
            const f32x4 v0 = *(const f32x4*)s, v1 = *(const f32x4*)(s + 4); u32x4 w; w.x = pack2(v0[0], v0[1]); w.y = pack2(v0[2], v0[3]); w.z = pack2(v1[0], v1[1]); w.w = pack2(v1[2], v1[3]); *(u32x4*)d = w; }
        else if (u < E4) {
            float* ctab = (float*)(lds + LDS_CTAB);
            if (!have_tab) { for (int i = tid; i < 4096; i += NT) ctab[i] = cospif((float)i / 2048.0f); __syncthreads(); have_tab = true; }
            const int k = u - E3 + 4096;
            if (tid < 32) {
                const int kk = k - 4096, n0 = tid * 8; float c[8], s[8];
#pragma unroll
                for (int e = 0; e < 8; ++e) { const int idx = ((kk * (n0 + e)) & 255) * 16; c[e] = ctab[idx] * (1.0f / 16.0f); s[e] = ctab[(idx - 1024) & 4095] * (1.0f / 16.0f); }
                bf16_t* d = (bf16_t*)(a->ws + WS_DFTC) + (size_t)kk * 512 + n0;
                u32x4 w; w.x = pack2(c[0], c[1]); w.y = pack2(c[2], c[3]); w.z = pack2(c[4], c[5]); w.w = pack2(c[6], c[7]); *(u32x4*)d = w;
                w.x = pack2(s[0], s[1]); w.y = pack2(s[2], s[3]); w.z = pack2(s[4], s[5]); w.w = pack2(s[6], s[7]); *(u32x4*)(d + 256) = w;
            }
        }
        else {
            for (int i = tid; i < 1024; i += NT) { const int pos = i >> 4, f = i & 15; const float freq = powf(10000.0f, -(float)f / 16.0f); const float ang = (float)pos * freq;
                ((float2*)(a->ws + WS_ROPE))[i] = make_float2(cosf(ang), sinf(ang)); }
        }
    }
}

__device__ __forceinline__ void p_lnmod0(AP a) {
    const int tid = tid_opaque(), lane = tid & 63, w = tid >> 6;
    const float* mod = (const float*)(a->ws + WS_MOD);
    bf16_t* H = (bf16_t*)(a->ws + WS_H);
    const int tstep = gridDim.x * 8;
    f32x4 nx[4];
    { const int t = blockIdx.x * 8 + w; if (t < NTOK) { const float* src = (t < NLAT) ? a->in[0] + (size_t)t * D : a->in[2] + (size_t)(t - NLAT) * D;
#pragma unroll
        for (int i = 0; i < 4; ++i) nx[i] = *(const f32x4*)(src + 256 * i + 4 * lane); } }
    int mrow = -1; f32x4 msh[4], msc[4];
    for (int t = blockIdx.x * 8 + w; t < NTOK; t += tstep) {
        const int mr = (t < NLAT) ? (t >> 12) : 4;
        if (mr != mrow) { mrow = mr; const float* m = mod + (size_t)mr * 6144;
#pragma unroll
            for (int i = 0; i < 4; ++i) { msh[i] = *(const f32x4*)(m + 256 * i + 4 * lane); msc[i] = *(const f32x4*)(m + 1024 + 256 * i + 4 * lane); } }
        f32x4 v[4];
#pragma unroll
        for (int i = 0; i < 4; ++i) v[i] = nx[i];
        { const int tn = t + tstep; if (tn < NTOK) { const float* src = (tn < NLAT) ? a->in[0] + (size_t)tn * D : a->in[2] + (size_t)(tn - NLAT) * D;
#pragma unroll
            for (int i = 0; i < 4; ++i) nx[i] = *(const f32x4*)(src + 256 * i + 4 * lane); } }
        float mean, rstd; ln_stats(v, mean, rstd);
#pragma unroll
        for (int i = 0; i < 4; ++i) { const int c = 256 * i + 4 * lane;
            f32x4 o;
#pragma unroll
            for (int e = 0; e < 4; ++e) o[e] = (v[i][e] - mean) * rstd * (1.0f + msc[i][e]) + msh[i][e];
            u32x2 pk; pk.x = pack2(o[0], o[1]); pk.y = pack2(o[2], o[3]); *(u32x2*)(H + (size_t)t * D + c) = pk; }
    }
}

__device__ __forceinline__ void p1_inproj(AP a, LAS unsigned char* lds, int l);
__device__ __forceinline__ void rope32(float (&t)[32], const float2* tab) {
#pragma unroll
    for (int f = 0; f < 16; ++f) { const float2 cs = tab[f]; const float t1 = t[f], t2 = t[16 + f]; t[f] = t1 * cs.x - t2 * cs.y; t[16 + f] = t1 * cs.y + t2 * cs.x; }
}
__device__ __forceinline__ void load32(float (&t)[32], const bf16_t* p) {
#pragma unroll
    for (int q = 0; q < 4; ++q) { const u32x4 w = *(const u32x4*)(p + 8 * q);
        t[8 * q + 0] = lo2f(w.x); t[8 * q + 1] = hi2f(w.x); t[8 * q + 2] = lo2f(w.y); t[8 * q + 3] = hi2f(w.y);
        t[8 * q + 4] = lo2f(w.z); t[8 * q + 5] = hi2f(w.z); t[8 * q + 6] = lo2f(w.w); t[8 * q + 7] = hi2f(w.w); }
}

__device__ __forceinline__ float kdot(const bf16_t* kp, const bf16_t* q, const float2* tab0, const float2* tab1, bool do_rope) {
    float dot = 0.f;
#pragma unroll 1
    for (int ax = 0; ax < 2; ++ax) {
        const float2* tab = ax ? tab1 : tab0;
#pragma unroll 1
        for (int h8 = 0; h8 < 2; ++h8) {
            const u32x4 wl = *(const u32x4*)(kp + ax * 32 + h8 * 8), wh = *(const u32x4*)(kp + ax * 32 + 16 + h8 * 8);
            const float tl[8] = {lo2f(wl.x), hi2f(wl.x), lo2f(wl.y), hi2f(wl.y), lo2f(wl.z), hi2f(wl.z), lo2f(wl.w), hi2f(wl.w)};
            const float th[8] = {lo2f(wh.x), hi2f(wh.x), lo2f(wh.y), hi2f(wh.y), lo2f(wh.z), hi2f(wh.z), lo2f(wh.w), hi2f(wh.w)};
#pragma unroll
            for (int j = 0; j < 8; ++j) {
                float r1 = tl[j], r2 = th[j];
                if (do_rope) { const float2 cs = tab[h8 * 8 + j]; r1 = tl[j] * cs.x - th[j] * cs.y; r2 = tl[j] * cs.y + th[j] * cs.x; }
                dot += bf2f(q[ax * 32 + h8 * 8 + j]) * r1 + bf2f(q[ax * 32 + 16 + h8 * 8 + j]) * r2;
            }
        }
    }
    return dot;
}

__device__ __forceinline__ void mixer_tile(AP a, unsigned char* lds, int l, int row0, int seq_row0, int pos0, int n, int b, bool is_ctx) {
    const int tid = tid_opaque(), lane = tid & 63, w = tid >> 6;
    const bf16_t* Z = (const bf16_t*)(a->ws + WS_Z);
    bf16_t* CAT = (bf16_t*)(a->ws + WS_CAT);
    {
        const int c = tid & 255, half = tid >> 8, g = c >> 6, hw = 1 << g;
        for (int tl = half * 64; tl < half * 64 + 64; ++tl) {
            const int pos = pos0 + tl; const int lo = max(pos - hw, 0), hi = min(pos + hw, n);
            float s = 0.f; for (int j = lo; j < hi; ++j) s += bf2f(Z[(size_t)(seq_row0 + j) * ZC + 1024 + c]);
            const float self = bf2f(Z[(size_t)(seq_row0 + pos) * ZC + 1024 + c]);
            CAT[(size_t)(row0 + tl) * D + 512 + c] = f2bf(s / (float)(hi - lo) - self);
        }
    }
    bf16_t* vT = (bf16_t*)lds;
    for (int q = w; q < 128; q += 8) {
        const u32x2 gw = *(const u32x2*)(Z + (size_t)(row0 + q) * ZC + 1536 + 4 * lane);
        float gv[4] = {gelu_erf(lo2f(gw.x)), gelu_erf(hi2f(gw.x)), gelu_erf(lo2f(gw.y)), gelu_erf(hi2f(gw.y))};
        float s = wave_sum((gv[0] + gv[1]) + (gv[2] + gv[3])); const float mean = s * (1.0f / 256.0f);
        float qq = 0.f;
#pragma unroll
        for (int e = 0; e < 4; ++e) { const float d = gv[e] - mean; qq += d * d; }
        qq = wave_sum(qq); const float rstd = 1.0f / sqrtf(qq * (1.0f / 256.0f) + 1e-6f);
#pragma unroll
        for (int e = 0; e < 4; ++e) vT[(4 * lane + e) * 128 + q] = f2bf((gv[e] - mean) * rstd);
    }
    __syncthreads();
    {
        const int c = tid & 255, ph = tid >> 8, h = c >> 6;
        const bf16_t* Ws = (const bf16_t*)(a->ws + WS_WSGU) + (size_t)(l * 4 + h) * 128 * 128;
        const float* bs = a->in[12] + (size_t)(l * 4 + h) * 128;
        for (int p = ph * 64; p < ph * 64 + 64; ++p) {
            float s = 0.f;
#pragma unroll 2
            for (int q8 = 0; q8 < 16; ++q8) {
                const u32x4 ww = *(const u32x4*)(Ws + (size_t)p * 128 + q8 * 8);
                const u32x4 vv = *(const u32x4*)(vT + c * 128 + q8 * 8);
                s += lo2f(ww.x) * lo2f(vv.x) + hi2f(ww.x) * hi2f(vv.x) + lo2f(ww.y) * lo2f(vv.y) + hi2f(ww.y) * hi2f(vv.y)
                   + lo2f(ww.z) * lo2f(vv.z) + hi2f(ww.z) * hi2f(vv.z) + lo2f(ww.w) * lo2f(vv.w) + hi2f(ww.w) * hi2f(vv.w);
            }
            const float uv = gelu_erf(bf2f(Z[(size_t)(row0 + p) * ZC + 1280 + c]));
            CAT[(size_t)(row0 + p) * D + 768 + c] = f2bf(uv * (s + bs[p]));
        }
    }
    __syncthreads();
    {
        const int i = tid & 127, h = tid >> 7, kvh = h >> 1;
        const float2* rope = (const float2*)(a->ws + WS_ROPE);
        const int qpos = pos0 + i;
        bf16_t* q = (bf16_t*)lds + tid * 66;
        {
            float t0[32];
            load32(t0, Z + (size_t)(row0 + i) * ZC + 512 + h * 64);
            if (!is_ctx) rope32(t0, rope + (qpos >> 6) * 16);
#pragma unroll
            for (int d = 0; d < 32; ++d) q[d] = f2bf(t0[d]);
            load32(t0, Z + (size_t)(row0 + i) * ZC + 512 + h * 64 + 32);
            if (!is_ctx) rope32(t0, rope + (qpos & 63) * 16);
#pragma unroll
            for (int d = 0; d < 32; ++d) q[32 + d] = f2bf(t0[d]);
        }
#pragma unroll 1
        for (int dh = 0; dh < 2; ++dh) {
        float m = a->in[8][l * 4 + h], den = 1.0f;
        float o[32];
#pragma unroll
        for (int d = 0; d < 32; ++d) o[d] = 0.f;
        if (!is_ctx) {
            const bf16_t* VT = (const bf16_t*)(a->ws + WS_VT) + ((size_t)(b * 2 + kvh) * 64 + dh * 32) * 4096;
            const int slo = max(qpos - 128, 0), shi = min(qpos + 128, n - 1);
#pragma unroll 1
            for (int s = slo; s <= shi; ++s) {
                const float dot = 0.125f * kdot(Z + (size_t)(seq_row0 + s) * ZC + 768 + kvh * 64, q, rope + (s >> 6) * 16, rope + (s & 63) * 16, true);
                const float mn = fmaxf(m, dot), corr = __expf(m - mn), p = __expf(dot - mn);
                den = den * corr + p; m = mn;
#pragma unroll
                for (int d = 0; d < 32; ++d) o[d] = o[d] * corr + p * bf2f(VT[(size_t)d * 4096 + s]);
            }
        }
        {
            const bf16_t* VTC = (const bf16_t*)(a->ws + WS_VTC) + ((size_t)(b * 2 + kvh) * 64 + dh * 32) * 256;
#pragma unroll 1
            for (int j = 0; j < 256; ++j) {
                const float dot = 0.125f * kdot(Z + (size_t)(NLAT + b * 256 + j) * ZC + 768 + kvh * 64, q, rope, rope, false);
                const float mn = fmaxf(m, dot), corr = __expf(m - mn), p = __expf(dot - mn);
                den = den * corr + p; m = mn;
#pragma unroll
                for (int d = 0; d < 32; ++d) o[d] = o[d] * corr + p * bf2f(VTC[(size_t)d * 256 + j]);
            }
        }
        const float inv = 1.0f / den;
        bf16_t* dst = CAT + (size_t)(row0 + i) * D + 256 + h * 64 + dh * 32;
#pragma unroll
        for (int d8 = 0; d8 < 4; ++d8) { u32x4 pk; pk.x = pack2(o[8 * d8] * inv, o[8 * d8 + 1] * inv); pk.y = pack2(o[8 * d8 + 2] * inv, o[8 * d8 + 3] * inv);
            pk.z = pack2(o[8 * d8 + 4] * inv, o[8 * d8 + 5] * inv); pk.w = pack2(o[8 * d8 + 6] * inv, o[8 * d8 + 7] * inv); *(u32x4*)(dst + 8 * d8) = pk; }
        }
    }
    __syncthreads();
}

__device__ __forceinline__ u32x4 ld16g(const bf16_t* p) { return *(const u32x4*)p; }
__device__ __forceinline__ void rope_pack8(u32x4& wl, u32x4& wh, const LAS f32x2* tab, bool do_rope, float scale) {
    float tl[8] = {lo2f(wl.x), hi2f(wl.x), lo2f(wl.y), hi2f(wl.y), lo2f(wl.z), hi2f(wl.z), lo2f(wl.w), hi2f(wl.w)};
    float th[8] = {lo2f(wh.x), hi2f(wh.x), lo2f(wh.y), hi2f(wh.y), lo2f(wh.z), hi2f(wh.z), lo2f(wh.w), hi2f(wh.w)};
#pragma unroll
    for (int j = 0; j < 8; ++j) {
        float r1 = tl[j], r2 = th[j];
        if (do_rope) { const f32x2 cs = tab[j]; r1 = tl[j] * cs.x - th[j] * cs.y; r2 = tl[j] * cs.y + th[j] * cs.x; }
        tl[j] = r1 * scale; th[j] = r2 * scale;
    }
    wl.x = pack2(tl[0], tl[1]); wl.y = pack2(tl[2], tl[3]); wl.z = pack2(tl[4], tl[5]); wl.w = pack2(tl[6], tl[7]);
    wh.x = pack2(th[0], th[1]); wh.y = pack2(th[2], th[3]); wh.z = pack2(th[4], th[5]); wh.w = pack2(th[6], th[7]);
}

__device__ __forceinline__ void mixer_sgu_pool(AP a, LAS unsigned char* lds, int l, int row0, int seq_row0, int pos0, int n) {
    const int tid = tid_opaque(), lane = tid & 63, w = __builtin_amdgcn_readfirstlane(tid >> 6), fr = lane & 15, g = lane >> 4;
    const bf16_t* Z = (const bf16_t*)(a->ws + WS_Z);
    bf16_t* CAT = (bf16_t*)(a->ws + WS_CAT);
    {
#pragma unroll
        for (int it = 0; it < 9; ++it) { const int id = tid + 512 * it, rr = id >> 5, ch = id & 31, j = pos0 - 8 + rr;
            u32x4 v = (u32x4){0u, 0u, 0u, 0u};
            if (j >= 0 && j < n) v = ld16g(Z + (size_t)(seq_row0 + j) * ZC + 1024 + ch * 8);
            *(LAS u32x4*)(lds + rr * 512 + ch * 16) = v; }
        __syncthreads();
        const int c = tid & 255, half = tid >> 8, hw = 1 << (c >> 6);
        const LAS bf16_t* P = (const LAS bf16_t*)lds + c;
        const int t0 = half * 64;
        float s = 0.f;
        for (int j = t0 - hw; j < t0 + hw; ++j) s += bf2f(P[(8 + j) * 256]);
        for (int tl = t0; tl < t0 + 64; ++tl) {
            const int pos = pos0 + tl; const int lo = max(pos - hw, 0), hi = min(pos + hw, n);
            CAT[(size_t)(row0 + tl) * D + 512 + c] = f2bf(s / (float)(hi - lo) - bf2f(P[(8 + tl) * 256]));
            s += bf2f(P[(8 + tl + hw) * 256]) - bf2f(P[(8 + tl - hw) * 256]);
        }
        __syncthreads();
    }
    {
        const int i16 = lane & 15;
        u32x4 gw[4][2];
#pragma unroll
        for (int ps = 0; ps < 4; ++ps) { const int q = w * 16 + ps * 4 + g; const bf16_t* src = Z + (size_t)(row0 + q) * ZC + 1536 + 16 * i16; gw[ps][0] = ld16g(src); gw[ps][1] = ld16g(src + 8); }
#pragma unroll
        for (int ps = 0; ps < 4; ++ps) {
            const int q = w * 16 + ps * 4 + g;
            float gv[16];
#pragma unroll
            for (int hh = 0; hh < 2; ++hh) { const u32x4 x = gw[ps][hh];
                gv[8 * hh + 0] = gelu_erf(lo2f(x.x)); gv[8 * hh + 1] = gelu_erf(hi2f(x.x)); gv[8 * hh + 2] = gelu_erf(lo2f(x.y)); gv[8 * hh + 3] = gelu_erf(hi2f(x.y));
                gv[8 * hh + 4] = gelu_erf(lo2f(x.z)); gv[8 * hh + 5] = gelu_erf(hi2f(x.z)); gv[8 * hh + 6] = gelu_erf(lo2f(x.w)); gv[8 * hh + 7] = gelu_erf(hi2f(x.w)); }
            float sm = 0.f;
#pragma unroll
            for (int e = 0; e < 16; ++e) sm += gv[e];
            const float mean = row_sum16(sm) * (1.0f / 256.0f);
            float qq = 0.f;
#pragma unroll
            for (int e = 0; e < 16; ++e) { const float d = gv[e] - mean; qq += d * d; }
            const float rstd = 1.0f / sqrtf(row_sum16(qq) * (1.0f / 256.0f) + 1e-6f);
#pragma unroll
            for (int e = 0; e < 16; ++e) { const int c = 16 * i16 + e; *(LAS bf16_t*)(lds + c * 256 + ((((q >> 3) ^ (c & 15))) << 4) + (q & 7) * 2) = f2bf((gv[e] - mean) * rstd); }
        }
    }
    __syncthreads();
    {
        const int h = w >> 1, ph = w & 1;
        const bf16_t* Ws = (const bf16_t*)(a->ws + WS_WSGU) + (size_t)(l * 4 + h) * 128 * 128;
        const float* bs = a->in[12] + (size_t)(l * 4 + h) * 128;
        f32x4 acc[4][4];
#pragma unroll
        for (int i = 0; i < 4; ++i)
#pragma unroll
            for (int j = 0; j < 4; ++j) acc[i][j] = (f32x4){0.f, 0.f, 0.f, 0.f};
#pragma unroll
        for (int ks = 0; ks < 4; ++ks) {
            bf16x8 af[4], bfv[4];
#pragma unroll
            for (int cf = 0; cf < 4; ++cf) { const int c = h * 64 + 16 * cf + fr; af[cf] = *(const LAS bf16x8*)(lds + c * 256 + (((4 * ks + g) ^ (c & 15)) << 4)); }
#pragma unroll
            for (int pf = 0; pf < 4; ++pf) { const int p = ph * 64 + 16 * pf + fr; bfv[pf] = *(const bf16x8*)(Ws + (size_t)p * 128 + 32 * ks + 8 * g); }
#pragma unroll
            for (int cf = 0; cf < 4; ++cf)
#pragma unroll
                for (int pf = 0; pf < 4; ++pf) acc[cf][pf] = __builtin_amdgcn_mfma_f32_16x16x32_bf16(af[cf], bfv[pf], acc[cf][pf], 0, 0, 0);
        }
#pragma unroll
        for (int pf = 0; pf < 4; ++pf) { const int p = ph * 64 + 16 * pf + fr; const float bias = bs[p];
#pragma unroll
            for (int cf = 0; cf < 4; ++cf) { const int c0 = h * 64 + 16 * cf + 4 * g;
                const u32x2 uw = *(const u32x2*)(Z + (size_t)(row0 + p) * ZC + 1280 + c0);
                u32x2 o; o.x = pack2(gelu_erf(lo2f(uw.x)) * (acc[cf][pf][0] + bias), gelu_erf(hi2f(uw.x)) * (acc[cf][pf][1] + bias));
                o.y = pack2(gelu_erf(lo2f(uw.y)) * (acc[cf][pf][2] + bias), gelu_erf(hi2f(uw.y)) * (acc[cf][pf][3] + bias));
                *(u32x2*)(CAT + (size_t)(row0 + p) * D + 768 + c0) = o; } }
    }
    __syncthreads();
}

__device__ __forceinline__ void mixer_attn(AP a, LAS unsigned char* lds, int l, int row0, int seq_row0, int pos0, int n, int b, bool is_ctx, int kvh) {
    const int tid = tid_opaque(), lane = tid & 63, w = __builtin_amdgcn_readfirstlane(tid >> 6), fr = lane & 15, g = lane >> 4;
    const bf16_t* Z = (const bf16_t*)(a->ws + WS_Z);
    bf16_t* CAT = (bf16_t*)(a->ws + WS_CAT);
    __syncthreads();
    ((LAS u32x4*)(lds + 98304))[tid] = ((const u32x4*)(a->ws + WS_ROPE))[tid];
    const LAS f32x2* rope = (const LAS f32x2*)(lds + 98304);
    constexpr float QS = 0.125f * 1.44269504088896341f;
    constexpr int QS_OFF = 0, KS_OFF = 32768, VS_OFF = 65536;
    const int nbq = pos0 >> 7;
    unsigned bmask = 0x18u;
    if (!is_ctx) { if (nbq > 0) bmask |= 1u; bmask |= 2u; if (nbq + 1 < (n >> 7)) bmask |= 4u; }
    const int kr = tid >> 2, kax = (tid >> 1) & 1, kh8 = tid & 1;
#define MX_KSRC(blk) (Z + (size_t)((((blk) < 3) ? seq_row0 + (nbq + (blk) - 1) * 128 : NLAT + b * 256 + ((blk) - 3) * 128) + kr) * ZC + 768 + kvh * 64 + kax * 32 + kh8 * 8)
#define MX_VSTAGE(blk, buf) do { const bool _band = (blk) < 3; const int _key0 = _band ? (nbq + (blk) - 1) * 128 : ((blk) - 3) * 128; \
        const bf16_t* _vs = _band ? (const bf16_t*)(a->ws + WS_VT) + (size_t)(b * 2 + kvh) * 64 * 4096 + _key0 : (const bf16_t*)(a->ws + WS_VTC) + (size_t)(b * 2 + kvh) * 64 * 256 + _key0; \
        const int _vld = _band ? 4096 : 256; \
        _Pragma("unroll") for (int _i = 0; _i < 2; ++_i) { const int _P = _i * 512 + tid, _d = _P >> 4, _c = (_P & 15) ^ (_d & 15); \
            glds16(_vs + (size_t)_d * _vld + _c * 8, lds + VS_OFF + (buf) * 16384 + _i * 8192 + w * 1024); } } while (0)
    {
        __syncthreads();
#pragma unroll
        for (int it = 0; it < 2; ++it) {
            const int item = tid + 512 * it, r = item >> 2, ax = (item >> 1) & 1, h8 = item & 1, i = r & 127, qpos = pos0 + i;
            const bf16_t* src = Z + (size_t)(row0 + i) * ZC + 512 + (2 * kvh + (r >> 7)) * 64 + ax * 32 + h8 * 8;
            u32x4 wl = ld16g(src), wh = ld16g(src + 16);
            rope_pack8(wl, wh, rope + (ax ? (qpos & 63) : (qpos >> 6)) * 16 + h8 * 8, !is_ctx, QS);
            const int ch = ax * 4 + h8, sw = (r >> 1) & 7;
            *(LAS u32x4*)(lds + QS_OFF + r * 128 + ((ch ^ sw) << 4)) = wl;
            *(LAS u32x4*)(lds + QS_OFF + r * 128 + (((ch + 2) ^ sw) << 4)) = wh;
        }
        const int hh = w >> 2, qb = (w & 3) * 32, h = 2 * kvh + hh;
        float m[2], lsum[2];
        m[0] = m[1] = a->in[8][l * 4 + h] * 1.44269504088896341f;
        lsum[0] = lsum[1] = (g == 0) ? 1.0f : 0.0f;
        f32x4 O[4][2];
#pragma unroll
        for (int i = 0; i < 4; ++i) { O[i][0] = (f32x4){0.f, 0.f, 0.f, 0.f}; O[i][1] = (f32x4){0.f, 0.f, 0.f, 0.f}; }
        bf16x8 Qf[2][2];
        bool have_q = false;
        unsigned rem = bmask;
        int cur = __builtin_ctz(rem); rem &= rem - 1u;
        int buf = 0;
        u32x4 kl = ld16g(MX_KSRC(cur)), kh = ld16g(MX_KSRC(cur) + 16);
        MX_VSTAGE(cur, 0);
#pragma unroll 1
        for (;;) {
            const int jb = cur - 1; const bool band = cur < 3;
            {
                const int kpos = (nbq + jb) * 128 + kr;
                rope_pack8(kl, kh, rope + (kax ? (kpos & 63) : (kpos >> 6)) * 16 + kh8 * 8, band, 1.0f);
                const int ch = kax * 4 + kh8, sw = (kr >> 1) & 7;
                *(LAS u32x4*)(lds + KS_OFF + buf * 16384 + kr * 128 + ((ch ^ sw) << 4)) = kl;
                *(LAS u32x4*)(lds + KS_OFF + buf * 16384 + kr * 128 + (((ch + 2) ^ sw) << 4)) = kh;
            }
            asm volatile("s_waitcnt vmcnt(0)" ::: "memory");
            __syncthreads();
            const int nxt = rem ? __builtin_ctz(rem) : -1; rem &= rem - 1u;
            if (nxt >= 0) { kl = ld16g(MX_KSRC(nxt)); kh = ld16g(MX_KSRC(nxt) + 16); MX_VSTAGE(nxt, buf ^ 1); }
            if (!have_q) {
#pragma unroll
                for (int qf = 0; qf < 2; ++qf)
#pragma unroll
                    for (int ks = 0; ks < 2; ++ks) { const int r = hh * 128 + qb + 16 * qf + fr; Qf[qf][ks] = *(const LAS bf16x8*)(lds + QS_OFF + r * 128 + (((4 * ks + g) ^ ((r >> 1) & 7)) << 4)); }
                have_q = true;
            }
            const int kso = KS_OFF + buf * 16384, vso = VS_OFF + buf * 16384;
            f32x4 S[8][2];
#pragma unroll
            for (int kf = 0; kf < 8; ++kf) { S[kf][0] = (f32x4){0.f, 0.f, 0.f, 0.f}; S[kf][1] = (f32x4){0.f, 0.f, 0.f, 0.f}; }
#pragma unroll
            for (int kf = 0; kf < 8; ++kf)
#pragma unroll
                for (int ks = 0; ks < 2; ++ks) { const int r = 16 * kf + fr;
                    const bf16x8 kfr = *(const LAS bf16x8*)(lds + kso + r * 128 + (((4 * ks + g) ^ ((r >> 1) & 7)) << 4));
                    S[kf][0] = __builtin_amdgcn_mfma_f32_16x16x32_bf16(kfr, Qf[0][ks], S[kf][0], 0, 0, 0);
                    S[kf][1] = __builtin_amdgcn_mfma_f32_16x16x32_bf16(kfr, Qf[1][ks], S[kf][1], 0, 0, 0); }
            bf16x8 Pp[4][2];
#pragma unroll
            for (int qf = 0; qf < 2; ++qf) {
                const int qi = qb + 16 * qf + fr;
                if (band && jb != 0) {
#pragma unroll
                    for (int kf = 0; kf < 8; ++kf)
#pragma unroll
                        for (int r = 0; r < 4; ++r) { const int kk = 16 * kf + 4 * g + r; const bool ok = (jb < 0) ? (kk >= qi) : (kk <= qi); if (!ok) S[kf][qf][r] = -1.0e30f; }
                }
                float mx = S[0][qf][0];
#pragma unroll
                for (int kf = 0; kf < 8; ++kf)
#pragma unroll
                    for (int r = 0; r < 4; ++r) mx = fmaxf(mx, S[kf][qf][r]);
                mx = fmaxf(mx, __shfl_xor(mx, 16)); mx = fmaxf(mx, __shfl_xor(mx, 32));
                const float mn = fmaxf(m[qf], mx), corr = __builtin_amdgcn_exp2f(m[qf] - mn);
                m[qf] = mn;
                float ps = 0.f;
#pragma unroll
                for (int kf = 0; kf < 8; ++kf)
#pragma unroll
                    for (int r = 0; r < 4; ++r) { const float p = __builtin_amdgcn_exp2f(S[kf][qf][r] - mn); S[kf][qf][r] = p; ps += p; }
                lsum[qf] = lsum[qf] * corr + ps;
#pragma unroll
                for (int df = 0; df < 4; ++df) O[df][qf] *= corr;
#pragma unroll
                for (int t = 0; t < 4; ++t) { u32x4 pw; pw.x = pack2(S[2 * t][qf][0], S[2 * t][qf][1]); pw.y = pack2(S[2 * t][qf][2], S[2 * t][qf][3]);
                    pw.z = pack2(S[2 * t + 1][qf][0], S[2 * t + 1][qf][1]); pw.w = pack2(S[2 * t + 1][qf][2], S[2 * t + 1][qf][3]); Pp[t][qf] = __builtin_bit_cast(bf16x8, pw); }
            }
#pragma unroll
            for (int t = 0; t < 4; ++t)
#pragma unroll
                for (int df = 0; df < 4; ++df) { const int d = 16 * df + fr;
                    const u32x2 v0 = *(const LAS u32x2*)(lds + vso + d * 256 + (((4 * t + (g >> 1)) ^ (d & 15)) << 4) + (g & 1) * 8);
                    const u32x2 v1 = *(const LAS u32x2*)(lds + vso + d * 256 + (((4 * t + 2 + (g >> 1)) ^ (d & 15)) << 4) + (g & 1) * 8);
                    u32x4 vw; vw.x = v0.x; vw.y = v0.y; vw.z = v1.x; vw.w = v1.y; const bf16x8 vf = __builtin_bit_cast(bf16x8, vw);
                    O[df][0] = __builtin_amdgcn_mfma_f32_16x16x32_bf16(vf, Pp[t][0], O[df][0], 0, 0, 0);
                    O[df][1] = __builtin_amdgcn_mfma_f32_16x16x32_bf16(vf, Pp[t][1], O[df][1], 0, 0, 0); }
            if (nxt < 0) break;
            cur = nxt; buf ^= 1;
        }
#pragma unroll
        for (int qf = 0; qf < 2; ++qf) {
            float lt = lsum[qf]; lt += __shfl_xor(lt, 16); lt += __shfl_xor(lt, 32);
            const float inv = 1.0f / lt;
            bf16_t* dst = CAT + (size_t)(row0 + qb + 16 * qf + fr) * D + 256 + h * 64 + 4 * g;
#pragma unroll
            for (int df = 0; df < 4; ++df) { u32x2 o; o.x = pack2(O[df][qf][0] * inv, O[df][qf][1] * inv); o.y = pack2(O[df][qf][2] * inv, O[df][qf][3] * inv); *(u32x2*)(dst + 16 * df) = o; }
        }
    }
#undef MX_KSRC
#undef MX_VSTAGE
    __syncthreads();
}

constexpr int FF_DA = 0, FF_DC = 32768, FF_TW = 49152, FF_XT = 65536, FF_Z2 = 81920, FF_OB = 98304;
__device__ __forceinline__ int ff_addr(int row, int k) { return row * 256 + ((((k >> 3) ^ (row & 15))) << 4) + (k & 7) * 2; }
__device__ __forceinline__ void fft_setup(LAS unsigned char* lds) {
    const int tid = tid_opaque();
    LAS float* TW = (LAS float*)(lds + FF_TW);
    for (int i = tid; i < 4096; i += NT) TW[i] = cospif((float)i / 2048.0f);
    __syncthreads();
    for (int idx = tid; idx < 16384; idx += NT) { const int i = idx >> 7, k = idx & 127, ro = i >> 6, k1 = i & 63, part = k >> 6, n1 = k & 63, j = ((k1 * n1) & 63) * 64;
        const float c = TW[j], sn = TW[(j - 1024) & 4095];
        const float v = (ro == 0) ? (part == 0 ? c : sn) : (part == 0 ? -sn : c);
        *(LAS bf16_t*)(lds + FF_DA + ff_addr(i, k)) = f2bf(v * 0.125f); }
    for (int idx = tid; idx < 8192; idx += NT) { const int k2 = idx >> 7, k = idx & 127, ri = k >> 6, n2 = k & 63, j = ((k2 * n2) & 63) * 64;
        const float v = (ri == 0) ? TW[j] : TW[(j - 1024) & 4095];
        *(LAS bf16_t*)(lds + FF_DC + ff_addr(k2, k)) = f2bf(v * 0.125f); }
    __syncthreads();
}
__device__ __forceinline__ void fft_unit(AP a, LAS unsigned char* lds, int b, int cg) {
    const int tid = tid_opaque(), lane = tid & 63, w = __builtin_amdgcn_readfirstlane(tid >> 6), fr = lane & 15, g = lane >> 4;
    const LAS float* TW = (const LAS float*)(lds + FF_TW);
    const int mf = w & 3, nh = w >> 2;
    const bf16_t* AT = (const bf16_t*)(a->ws + WS_AT) + (size_t)(b * 256 + cg * 4) * 8192;
    u32x4 xin[2];
#pragma unroll
    for (int it = 0; it < 2; ++it) xin[it] = ld16g(AT + (size_t)(tid + 512 * it) * 8);
#pragma unroll 1
    for (int cl = 0; cl < 4; ++cl) {
#pragma unroll
        for (int it = 0; it < 2; ++it) { const int q = tid + 512 * it, part = q >> 9, pos0 = (q & 511) * 8, n1 = pos0 >> 6, n2 = pos0 & 63, k = part * 64 + n1;
            const unsigned wv[4] = {xin[it].x, xin[it].y, xin[it].z, xin[it].w};
#pragma unroll
            for (int e = 0; e < 4; ++e) { *(LAS bf16_t*)(lds + FF_XT + ff_addr(n2 + 2 * e, k)) = (bf16_t)(wv[e] & 0xffffu); *(LAS bf16_t*)(lds + FF_XT + ff_addr(n2 + 2 * e + 1, k)) = (bf16_t)(wv[e] >> 16); } }
        if (cl < 3) {
#pragma unroll
            for (int it = 0; it < 2; ++it) xin[it] = ld16g(AT + (size_t)(cl + 1) * 8192 + (size_t)(tid + 512 * it) * 8); }
        __syncthreads();
        f32x4 acc[2][2];
#pragma unroll
        for (int x = 0; x < 2; ++x) { acc[x][0] = (f32x4){0.f, 0.f, 0.f, 0.f}; acc[x][1] = (f32x4){0.f, 0.f, 0.f, 0.f}; }
#pragma unroll
        for (int ks = 0; ks < 4; ++ks) {
            bf16x8 af[2], bfv[2];
#pragma unroll
            for (int x = 0; x < 2; ++x) { const int i = 16 * (mf + 4 * x) + fr; af[x] = *(const LAS bf16x8*)(lds + FF_DA + i * 256 + (((4 * ks + g) ^ (i & 15)) << 4)); }
#pragma unroll
            for (int n = 0; n < 2; ++n) { const int j = 16 * (2 * nh + n) + fr; bfv[n] = *(const LAS bf16x8*)(lds + FF_XT + j * 256 + (((4 * ks + g) ^ (j & 15)) << 4)); }
#pragma unroll
            for (int x = 0; x < 2; ++x)
#pragma unroll
                for (int n = 0; n < 2; ++n) acc[x][n] = __builtin_amdgcn_mfma_f32_16x16x32_bf16(af[x], bfv[n], acc[x][n], 0, 0, 0);
        }
#pragma unroll
        for (int n = 0; n < 2; ++n)
#pragma unroll
            for (int r = 0; r < 4; ++r) { const int k1 = 16 * mf + 4 * g + r, n2 = 16 * (2 * nh + n) + fr, idx = (k1 * n2) & 4095;
                const float c = TW[idx], sn = TW[(idx - 1024) & 4095], zr = acc[0][n][r], zi = acc[1][n][r];
                *(LAS bf16_t*)(lds + FF_Z2 + ff_addr(k1, n2)) = f2bf(zr * c + zi * sn);
                *(LAS bf16_t*)(lds + FF_Z2 + ff_addr(k1, 64 + n2)) = f2bf(zi * c - zr * sn); }
        __syncthreads();
        f32x4 acc2[2] = {(f32x4){0.f, 0.f, 0.f, 0.f}, (f32x4){0.f, 0.f, 0.f, 0.f}};
#pragma unroll
        for (int ks = 0; ks < 4; ++ks) {
            const int i = 16 * mf + fr; const bf16x8 af = *(const LAS bf16x8*)(lds + FF_DC + i * 256 + (((4 * ks + g) ^ (i & 15)) << 4));
#pragma unroll
            for (int n = 0; n < 2; ++n) { const int j = 16 * (2 * nh + n) + fr; const bf16x8 bfv = *(const LAS bf16x8*)(lds + FF_Z2 + j * 256 + (((4 * ks + g) ^ (j & 15)) << 4));
                acc2[n] = __builtin_amdgcn_mfma_f32_16x16x32_bf16(af, bfv, acc2[n], 0, 0, 0); }
        }
#pragma unroll
        for (int n = 0; n < 2; ++n)
#pragma unroll
            for (int r = 0; r < 4; ++r) { const int k = 16 * (2 * nh + n) + fr + 64 * (16 * mf + 4 * g + r); *(LAS bf16_t*)(lds + FF_OB + k * 8 + cl * 2) = f2bf(acc2[n][r]); }
    }
    __syncthreads();
    bf16_t* CAT = (bf16_t*)(a->ws + WS_CAT) + (size_t)(b * 4096) * D + cg * 4;
#pragma unroll
    for (int it = 0; it < 8; ++it) { const int k = tid + 512 * it; *(u32x2*)(CAT + (size_t)k * D) = *(const LAS u32x2*)(lds + FF_OB + k * 8); }
    __syncthreads();
}

__device__ __forceinline__ void p2_mix(AP a, unsigned char* ldsg, LAS unsigned char* lds, int l) {
    const int n_tile = 128 + ((l == 0) ? 8 : 0), n_att = 2 * n_tile, n_dft = 256, n_dftc = (l == 0) ? 16 : 0;
    bf16_t* CAT = (bf16_t*)(a->ws + WS_CAT);
    bool fft_ready = false;
    for (int u = blockIdx.x; u < n_att + n_dft + n_tile + n_dftc; u += gridDim.x) {
        if (u < n_att || (u >= n_att + n_dft && u < n_att + n_dft + n_tile)) {
            const bool att = u < n_att;
            const int t = att ? (u >> 1) : (u - n_att - n_dft);
            const bool isc = t >= 128; const int tt = t - 128;
            const int b = isc ? (tt >> 1) : (t >> 5);
            const int row0 = isc ? NLAT + tt * 128 : t * 128, seq_row0 = isc ? NLAT + b * 256 : b * 4096, pos0 = isc ? (tt & 1) * 128 : (t & 31) * 128, n = isc ? 256 : 4096;
            if (att) { for (int rep = 0; rep < PROBE_MIX_REP; ++rep) mixer_attn(a, lds, l, row0, seq_row0, pos0, n, b, isc, u & 1); }
            else { for (int rep = 0; rep < PROBE_SGU_REP; ++rep) mixer_sgu_pool(a, lds, l, row0, seq_row0, pos0, n); }
            fft_ready = false;
        } else if (u < n_att + n_dft) {
            const int uu = u - n_att;
            if (!fft_ready) { fft_setup(lds); fft_ready = true; }
            for (int rep = 0; rep < PROBE_FFT_REP; ++rep) fft_unit(a, lds, uu >> 6, uu & 63);
        } else {
            const int uu = u - n_att - n_dft - n_tile, b = uu >> 2, mt = (uu >> 1) & 1, ch0 = (uu & 1) * 128;
            const bf16_t* A = (const bf16_t*)(a->ws + WS_DFTC) + (size_t)(mt * 128) * 512;
            const bf16_t* B0 = (const bf16_t*)(a->ws + WS_ATC) + ((size_t)b * 256 + ch0) * 512;
            EpiBf16 E; E.C = CAT + (size_t)(NLAT + b * 256 + mt * 128) * D + ch0; E.ld = D;
            gemm_tile<128, false, EpiBf16>(lds, A, 512, nullptr, 128, B0, B0 + (size_t)64 * 512, 512, 512, E);
            fft_ready = false;
        }
    }
    exp_queue(a, ldsg, l);
}

__device__ __forceinline__ int uni(int v) { return __builtin_amdgcn_readfirstlane(v); }
__device__ __forceinline__ int vblock() { const int G = gridDim.x, b = blockIdx.x; return (G % 8 == 0) ? (b % 8) * (G / 8) + b / 8 : b; }
template <class T> __device__ __forceinline__ T* unip(T* p) { const unsigned long long v = (unsigned long long)p; const unsigned lo = __builtin_amdgcn_readfirstlane((unsigned)v), hi = __builtin_amdgcn_readfirstlane((unsigned)(v >> 32)); return (T*)(((unsigned long long)hi << 32) | lo); }
struct SchedInProj {
    typedef EpiInProj Epi; static constexpr bool GATHER = false;
    unsigned char* ws; int l, G, me;
    __device__ __forceinline__ bool get(int i, g256::Unit<Epi>& u) const {
        const int n_lat = 64 * 7, n_ctx = (l == 0) ? 4 * 7 : 4;
        const int idx = i * G + me; if (idx >= n_lat + n_ctx) return false;
        int row0, b, ct, n; bf16_t *tF, *tV;
        if (idx < n_lat) { const int rt = idx / 7; ct = idx % 7; row0 = rt * 256; b = row0 >> 12; n = 4096;
            tF = (bf16_t*)(ws + WS_AT) + (size_t)b * 256 * 2 * 4096; tV = (bf16_t*)(ws + WS_VT) + (size_t)b * 128 * 4096; }
        else { const int uu = idx - n_lat; int rt; if (l == 0) { rt = uu / 7; ct = uu % 7; } else { rt = uu; ct = 3; }
            row0 = NLAT + rt * 256; b = rt; n = 256;
            tF = (bf16_t*)(ws + WS_ATC) + (size_t)b * 256 * 2 * 256; tV = (bf16_t*)(ws + WS_VTC) + (size_t)b * 128 * 256; }
        u.A = (const bf16_t*)(ws + WS_H) + (size_t)row0 * D;
        u.B0 = (const bf16_t*)(ws + WS_WIN) + ((size_t)l * ZC + ct * 256) * 1024; u.B1 = u.B0 + (size_t)128 * 1024; u.ridx = nullptr; u.valid = 256;
        u.epi.Zt = (bf16_t*)(ws + WS_Z) + (size_t)row0 * ZC + ct * 256; u.epi.tF = tF; u.epi.tV = tV; u.epi.n0 = ct * 256; u.epi.pos0 = (idx < n_lat) ? (row0 & 4095) : 0; u.epi.n = n;
        return true;
    }
};
struct SchedOutProj {
    typedef EpiBf16 Epi; static constexpr bool GATHER = false;
    unsigned char* ws; int l, G, me;
    __device__ __forceinline__ bool get(int i, g256::Unit<Epi>& u) const {
        const int nrt = NLAT / 256;
        const int idx = i * G + me; if (idx >= nrt * 4) return false;
        const int rt = idx >> 2, ct = idx & 3;
        u.A = (const bf16_t*)(ws + WS_CAT) + (size_t)(rt * 256) * D;
        u.B0 = (const bf16_t*)(ws + WS_WOUT) + ((size_t)l * 1024 + ct * 256) * 1024; u.B1 = u.B0 + (size_t)128 * 1024; u.ridx = nullptr; u.valid = 256;
        u.epi.C = (bf16_t*)(ws + WS_Y) + (size_t)(rt * 256) * D + ct * 256; u.epi.ld = D;
        return true;
    }
};
struct SchedGateUp {
    typedef EpiGateUp Epi; static constexpr bool GATHER = true;
    unsigned char* ws; const LAS int* blk; const LAS int* tot; const LAS int* ridx_lds; int G, me;
    __device__ __forceinline__ bool get(int i, g256::Unit<Epi>& u) const {
        const int idx = i * G + me; if (idx >= uni(blk[32]) * 4) return false;
        const int rb = idx >> 2, ct = idx & 3;
        int e = 0;
#pragma unroll 1
        for (int q = 1; q < 32; ++q) if (uni(blk[q]) <= rb) e = q;
        u.A = (const bf16_t*)(ws + WS_H);
        u.B0 = (const bf16_t*)(ws + WS_WEXP) + ((size_t)e * 512 + ct * 128) * 1024; u.B1 = u.B0 + EXPMAT;
        u.ridx = ridx_lds + (i & 7) * 256; u.valid = uni(min(256, tot[e] - (rb - blk[e]) * 256));
        u.epi.C = (bf16_t*)(ws + WS_HID) + (size_t)(rb * 256) * DEXP + ct * 128; u.epi.ld = DEXP;
        return true;
    }
};
struct SchedDown {
    typedef EpiBf16 Epi; static constexpr bool GATHER = false;
    unsigned char* ws; const LAS int* blk; int G, me;
    __device__ __forceinline__ bool get(int i, g256::Unit<Epi>& u) const {
        const int idx = i * G + me; if (idx >= uni(blk[32]) * 4) return false;
        const int rb = idx >> 2, ct = idx & 3;
        int e = 0;
#pragma unroll 1
        for (int q = 1; q < 32; ++q) if (uni(blk[q]) <= rb) e = q;
        u.A = (const bf16_t*)(ws + WS_HID) + (size_t)(rb * 256) * DEXP;
        u.B0 = (const bf16_t*)(ws + WS_WEXP) + 2 * EXPMAT + ((size_t)e * 1024 + ct * 256) * 512; u.B1 = u.B0 + (size_t)128 * 512; u.ridx = nullptr; u.valid = 256;
        u.epi.C = (bf16_t*)(ws + WS_YS) + (size_t)(rb * 256) * D + ct * 256; u.epi.ld = D;
        return true;
    }
};

__device__ __forceinline__ void p4_ln1_router(AP a, unsigned char* lds, int l) {
    const int tid = tid_opaque(), lane = tid & 63, w = tid >> 6;
    const int ntok = (l == 0) ? NTOK : NLAT;
    int* cnt = (int*)(lds + MISC_OFF);
    if (tid < 32) cnt[tid] = 0;
    f32x4* Lg = (f32x4*)lds; f32x4* Le = (f32x4*)(lds + 16384); f32x4* Lgb = (f32x4*)(lds + 147456);
    {
        const float* wrg_ = a->in[16] + (size_t)l * 1024 * 4; const float* wre_ = a->in[17] + (size_t)l * 1024 * 32;
#pragma unroll
        for (int it = 0; it < 2; ++it) { const int c = tid + 512 * it, slot = (((c >> 8) * 4 + (c & 3)) << 6) + ((c >> 2) & 63);
            Lg[slot] = *(const f32x4*)(wrg_ + (size_t)c * 4);
#pragma unroll
            for (int q = 0; q < 8; ++q) Le[q * 1024 + slot] = *(const f32x4*)(wre_ + (size_t)c * 32 + q * 4); }
        Lgb[tid] = (tid < 256) ? *(const f32x4*)(a->in[14] + l * 1024 + tid * 4) : *(const f32x4*)(a->in[15] + l * 1024 + (tid - 256) * 4);
    }
    __syncthreads();
    const float* mod = (const float*)(a->ws + WS_MOD) + (size_t)l * 5 * 6144;
    const bf16_t* Y = (const bf16_t*)(a->ws + WS_Y);
    float* X1 = (float*)(a->ws + WS_X1);
    bf16_t* H = (bf16_t*)(a->ws + WS_H);
    int* tokE = (int*)(a->ws + WS_TOKE); int* tokR = (int*)(a->ws + WS_TOKR); float* tokG = (float*)(a->ws + WS_TOKG);
    const int tstep = gridDim.x * 8;
    f32x4 nx[4]; u32x2 ny[4];
    {   const int t = blockIdx.x * 8 + w;
        if (t < ntok) { const float* xs = (l == 0) ? ((t < NLAT) ? a->in[0] + (size_t)t * D : a->in[2] + (size_t)(t - NLAT) * D) : (const float*)(a->ws + WS_XC) + (size_t)t * D;
#pragma unroll
            for (int i = 0; i < 4; ++i) { nx[i] = *(const f32x4*)(xs + 256 * i + 4 * lane); ny[i] = *(const u32x2*)(Y + (size_t)t * D + 256 * i + 4 * lane); } } }
    int mrow = -1; f32x4 mg[4], msh[4], msc[4];
    for (int t = blockIdx.x * 8 + w; t < ntok; t += tstep) {
        const int mr = (t < NLAT) ? (t >> 12) : 4;
        if (mr != mrow) { mrow = mr; const float* m = mod + (size_t)mr * 6144;
#pragma unroll
            for (int i = 0; i < 4; ++i) { const int c = 256 * i + 4 * lane; mg[i] = *(const f32x4*)(m + 2048 + c); msh[i] = *(const f32x4*)(m + 3072 + c); msc[i] = *(const f32x4*)(m + 4096 + c); } }
        f32x4 v[4];
#pragma unroll
        for (int i = 0; i < 4; ++i) { const f32x4 yv = (f32x4){lo2f(ny[i].x), hi2f(ny[i].x), lo2f(ny[i].y), hi2f(ny[i].y)};
#pragma unroll
            for (int e = 0; e < 4; ++e) v[i][e] = RES_ALPHA * nx[i][e] + mg[i][e] * yv[e]; }
        {   const int tn = t + tstep;
            if (tn < ntok) { const float* xs = (l == 0) ? ((tn < NLAT) ? a->in[0] + (size_t)tn * D : a->in[2] + (size_t)(tn - NLAT) * D) : (const float*)(a->ws + WS_XC) + (size_t)tn * D;
#pragma unroll
                for (int i = 0; i < 4; ++i) { nx[i] = *(const f32x4*)(xs + 256 * i + 4 * lane); ny[i] = *(const u32x2*)(Y + (size_t)tn * D + 256 * i + 4 * lane); } } }
        float mean, rstd; ln_stats(v, mean, rstd);
#pragma unroll
        for (int i = 0; i < 4; ++i) { const int c = 256 * i + 4 * lane; const f32x4 gg = Lgb[64 * i + lane], bb = Lgb[256 + 64 * i + lane];
#pragma unroll
            for (int e = 0; e < 4; ++e) v[i][e] = (v[i][e] - mean) * rstd * gg[e] + bb[e];
            *(f32x4*)(X1 + (size_t)t * D + c) = v[i]; }
        ln_stats(v, mean, rstd);
#pragma unroll
        for (int i = 0; i < 4; ++i) { const int c = 256 * i + 4 * lane; const f32x4 sh = msh[i], sc = msc[i];
#pragma unroll
            for (int e = 0; e < 4; ++e) v[i][e] = (v[i][e] - mean) * rstd * (1.0f + sc[e]) + sh[e];
            u32x2 pk; pk.x = pack2(v[i][0], v[i][1]); pk.y = pack2(v[i][2], v[i][3]); *(u32x2*)(H + (size_t)t * D + c) = pk; }
        float lg[4] = {0.f, 0.f, 0.f, 0.f};
#pragma unroll
        for (int i = 0; i < 4; ++i)
#pragma unroll
            for (int e = 0; e < 4; ++e) { const f32x4 wv = Lg[((i * 4 + e) << 6) + lane];
                lg[0] += v[i][e] * wv[0]; lg[1] += v[i][e] * wv[1]; lg[2] += v[i][e] * wv[2]; lg[3] += v[i][e] * wv[3]; }
#pragma unroll
        for (int q = 0; q < 4; ++q) lg[q] = wave_sum(lg[q]);
        int grp = 0; float mx = lg[0];
#pragma unroll
        for (int q = 1; q < 4; ++q) if (lg[q] > mx) { mx = lg[q]; grp = q; }
        float se = 0.f;
#pragma unroll
        for (int q = 0; q < 4; ++q) se += expf(lg[q] - mx);
        const float gate_group = 1.0f / se;
        float le[8] = {0.f, 0.f, 0.f, 0.f, 0.f, 0.f, 0.f, 0.f};
#pragma unroll
        for (int i = 0; i < 4; ++i)
#pragma unroll
            for (int e = 0; e < 4; ++e) { const f32x4* wp = Le + grp * 2048 + ((i * 4 + e) << 6) + lane; const f32x4 w0 = wp[0], w1 = wp[1024];
                le[0] += v[i][e] * w0[0]; le[1] += v[i][e] * w0[1]; le[2] += v[i][e] * w0[2]; le[3] += v[i][e] * w0[3];
                le[4] += v[i][e] * w1[0]; le[5] += v[i][e] * w1[1]; le[6] += v[i][e] * w1[2]; le[7] += v[i][e] * w1[3]; }
#pragma unroll
        for (int q = 0; q < 8; ++q) le[q] = wave_sum(le[q]);
        int j1 = 0; float l1 = le[0];
#pragma unroll
        for (int q = 1; q < 8; ++q) if (le[q] > l1) { l1 = le[q]; j1 = q; }
        int j2 = -1; float l2 = -3.0e38f;
#pragma unroll
        for (int q = 0; q < 8; ++q) if (q != j1 && le[q] > l2) { l2 = le[q]; j2 = q; }
        const float e2 = expf(l2 - l1), p1 = 1.0f / (1.0f + e2), p2 = e2 / (1.0f + e2);
        if (lane == 0) {
            const int ex0 = grp * 8 + j1, ex1 = grp * 8 + j2;
            const int r0 = atomicAdd(&cnt[ex0], 1), r1 = atomicAdd(&cnt[ex1], 1);
            tokE[2 * t] = ex0; tokE[2 * t + 1] = ex1; tokR[2 * t] = r0; tokR[2 * t + 1] = r1;
            tokG[2 * t] = gate_group * p1; tokG[2 * t + 1] = gate_group * p2;
        }
    }
    __syncthreads();
    if (tid < 32) ((int*)(a->ws + WS_BCNT))[((size_t)l * MAXG + blockIdx.x) * 32 + tid] = cnt[tid];
    __syncthreads();
}

__device__ __forceinline__ void p5_dispatch(AP a, unsigned char* lds, int l) {
    const int tid = tid_opaque();
    const int ntok = (l == 0) ? NTOK : NLAT;
    int* part = (int*)lds;
    int* tot = (int*)(lds + 4096);
    int* off = (int*)(lds + 4096 + 128);
    int* pstart = (int*)(lds + 4096 + 256);
    const int* bc = (const int*)(a->ws + WS_BCNT) + (size_t)l * MAXG * 32;
    const int G = gridDim.x, me = blockIdx.x;
    { const int e = tid & 31, p = tid >> 5; int s = 0, so = 0; for (int bb = p; bb < G; bb += 16) { const int c = bc[bb * 32 + e]; s += c; if (bb < me) so += c; } part[p * 32 + e] = s; part[512 + p * 32 + e] = so; }
    __syncthreads();
    if (tid < 32) { int s = 0, so = 0; for (int p = 0; p < 16; ++p) { s += part[p * 32 + tid]; so += part[512 + p * 32 + tid]; } tot[tid] = s; off[tid] = so; }
    __syncthreads();
    if (tid == 0) { int acc = 0; for (int e = 0; e < 32; ++e) { pstart[e] = acc; acc += ((tot[e] + 255) >> 8) << 8; } }
    __syncthreads();
    if (me == 0 && tid < 32) ((int*)(a->ws + WS_CNT))[l * 32 + tid] = tot[tid];
    const int* tokE = (const int*)(a->ws + WS_TOKE); const int* tokR = (const int*)(a->ws + WS_TOKR);
    int* tokS = (int*)(a->ws + WS_TOKS); int* slotT = (int*)(a->ws + WS_SLOTT);
    for (int base = me * 8; base < ntok; base += G * 8) {
        if (tid < 16) { const int t = base + (tid >> 1); if (t < ntok) { const int idx = 2 * t + (tid & 1); const int e = tokE[idx]; const int slot = pstart[e] + off[e] + tokR[idx]; tokS[idx] = slot; slotT[slot] = t; } }
    }
    __syncthreads();
}

__device__ __forceinline__ void moe_table(AP a, int l, LAS int* blk) {
    const int* tot = (const int*)(a->ws + WS_CNT) + l * 32;
    if (threadIdx.x == 0) { int acc = 0; for (int e = 0; e < 32; ++e) { const int c = tot[e]; blk[e] = acc; blk[33 + e] = c; acc += (c + 255) >> 8; } blk[32] = acc; }
    __syncthreads();
}
__device__ __forceinline__ void p1_inproj(AP a, LAS unsigned char* lds, int l) {
    SchedInProj S; S.ws = a->ws; S.l = l; S.G = gridDim.x; S.me = vblock();
    g256::gemm_phase(lds, 1024, S);
}
__device__ __forceinline__ void p3_outproj(AP a, LAS unsigned char* lds, int l) {
    SchedOutProj S; S.ws = a->ws; S.l = l; S.G = gridDim.x; S.me = vblock();
    g256::gemm_phase(lds, 1024, S);
    if (l == 0) {
        const bf16_t* W = (const bf16_t*)(a->ws + WS_WOUT);
        for (int u = blockIdx.x; u < 64; u += gridDim.x) { const int rt = u >> 3, ct = u & 7;
            EpiBf16 E; E.C = (bf16_t*)(a->ws + WS_Y) + (size_t)(NLAT + rt * 128) * D + ct * 128; E.ld = D;
            const bf16_t* B0 = W + (size_t)(ct * 128) * 1024;
            gemm_tile<128, false, EpiBf16>(lds, (const bf16_t*)(a->ws + WS_CAT) + (size_t)(NLAT + rt * 128) * D, D, nullptr, 128, B0, B0 + (size_t)64 * 1024, 1024, 1024, E); }
    }
}
__device__ __forceinline__ void p6_gateup(AP a, LAS unsigned char* lds, int l) {
    LAS int* blk = (LAS int*)(lds + MISC_OFF + 256);
    moe_table(a, l, blk);
    LAS int* ridx = (LAS int*)(lds + RIDX_OFF);
    const int tid = tid_opaque(), G = gridDim.x, me = vblock(), nu = blk[32] * 4;
    const int* slotT = (const int*)(a->ws + WS_SLOTT);
    for (int i = 0; i < 8; ++i) { const int idx = i * G + me; if (idx >= nu) break;
        const int rb = idx >> 2; int e = 0; for (int q = 1; q < 32; ++q) if (blk[q] <= rb) e = q;
        const int valid = min(256, blk[33 + e] - (rb - blk[e]) * 256);
        if (tid < 256) ridx[i * 256 + tid] = (tid < valid) ? slotT[rb * 256 + tid] : 0; }
    __syncthreads();
    SchedGateUp S; S.ws = a->ws; S.blk = blk; S.tot = blk + 33; S.ridx_lds = ridx; S.G = G; S.me = me;
    g256::gemm_phase(lds, 1024, S);
    __syncthreads();
}
__device__ __forceinline__ void p7_down(AP a, LAS unsigned char* lds, int l) {
    LAS int* blk = (LAS int*)(lds + MISC_OFF + 256);
    moe_table(a, l, blk);
    SchedDown S; S.ws = a->ws; S.blk = blk; S.G = gridDim.x; S.me = vblock();
    g256::gemm_phase(lds, 512, S);
    __syncthreads();
}

__device__ __forceinline__ void p8_ln2(AP a, unsigned char* lds, int l) {
    const int tid = tid_opaque(), lane = tid & 63, w = tid >> 6;
    const int ntok = (l == 0) ? NTOK : NLAT;
    const float* mod = (const float*)(a->ws + WS_MOD) + (size_t)l * 5 * 6144;
    const float* modn = (const float*)(a->ws + WS_MOD) + (size_t)5 * 6144;
    const float* X1 = (const float*)(a->ws + WS_X1);
    const bf16_t* YS = (const bf16_t*)(a->ws + WS_YS);
    const int* tokS = (const int*)(a->ws + WS_TOKS); const float* tokG = (const float*)(a->ws + WS_TOKG);
    f32x4* Lgb = (f32x4*)lds;
    __syncthreads();
    Lgb[tid] = (tid < 256) ? *(const f32x4*)(a->in[21] + l * 1024 + tid * 4) : *(const f32x4*)(a->in[22] + l * 1024 + (tid - 256) * 4);
    __syncthreads();
    int mrow = -1; f32x4 mg[4], nsh[4], nsc[4];
    const int tstep = gridDim.x * 8;
    int t = blockIdx.x * 8 + w;
    int ns0 = 0, ns1 = 0; float nga = 0.f, ngb = 0.f;
    f32x4 nx[4]; u32x2 nya[4], nyb[4];
    float cga = 0.f, cgb = 0.f;
    if (t < ntok) { const int s0 = tokS[2 * t], s1 = tokS[2 * t + 1]; cga = tokG[2 * t]; cgb = tokG[2 * t + 1];
#pragma unroll
        for (int i = 0; i < 4; ++i) { const int c = 256 * i + 4 * lane; nx[i] = *(const f32x4*)(X1 + (size_t)t * D + c); nya[i] = *(const u32x2*)(YS + (size_t)s0 * D + c); nyb[i] = *(const u32x2*)(YS + (size_t)s1 * D + c); } }
    if (t + tstep < ntok) { ns0 = tokS[2 * (t + tstep)]; ns1 = tokS[2 * (t + tstep) + 1]; nga = tokG[2 * (t + tstep)]; ngb = tokG[2 * (t + tstep) + 1]; }
    for (; t < ntok; t += tstep) {
        const int mr = (t < NLAT) ? (t >> 12) : 4;
        if (mr != mrow) { mrow = mr; const float* m = mod + (size_t)mr * 6144; const float* mn = modn + (size_t)mr * 6144;
#pragma unroll
            for (int i = 0; i < 4; ++i) { const int c = 256 * i + 4 * lane; mg[i] = *(const f32x4*)(m + 5120 + c); if (l == 0) { nsh[i] = *(const f32x4*)(mn + c); nsc[i] = *(const f32x4*)(mn + 1024 + c); } } }
        f32x4 v[4];
#pragma unroll
        for (int i = 0; i < 4; ++i) { const f32x4 gv = mg[i];
            const u32x2 ya = nya[i], yb = nyb[i];
            const float f0 = cga * lo2f(ya.x) + cgb * lo2f(yb.x), f1 = cga * hi2f(ya.x) + cgb * hi2f(yb.x), f2 = cga * lo2f(ya.y) + cgb * lo2f(yb.y), f3 = cga * hi2f(ya.y) + cgb * hi2f(yb.y);
            v[i][0] = RES_ALPHA * nx[i][0] + gv[0] * f0; v[i][1] = RES_ALPHA * nx[i][1] + gv[1] * f1; v[i][2] = RES_ALPHA * nx[i][2] + gv[2] * f2; v[i][3] = RES_ALPHA * nx[i][3] + gv[3] * f3; }
        {   const int tn = t + tstep, tn2 = t + 2 * tstep;
            if (tn < ntok) {
#pragma unroll
                for (int i = 0; i < 4; ++i) { const int c = 256 * i + 4 * lane; nx[i] = *(const f32x4*)(X1 + (size_t)tn * D + c); nya[i] = *(const u32x2*)(YS + (size_t)ns0 * D + c); nyb[i] = *(const u32x2*)(YS + (size_t)ns1 * D + c); }
                cga = nga; cgb = ngb; }
            if (tn2 < ntok) { ns0 = tokS[2 * tn2]; ns1 = tokS[2 * tn2 + 1]; nga = tokG[2 * tn2]; ngb = tokG[2 * tn2 + 1]; } }
        float mean, rstd; ln_stats(v, mean, rstd);
        float* dst = (l == 0) ? (float*)(a->ws + WS_XC) + (size_t)t * D : a->out + (size_t)t * D;
#pragma unroll
        for (int i = 0; i < 4; ++i) { const int c = 256 * i + 4 * lane; const f32x4 gg = Lgb[64 * i + lane], bb = Lgb[256 + 64 * i + lane];
#pragma unroll
            for (int e = 0; e < 4; ++e) v[i][e] = (v[i][e] - mean) * rstd * gg[e] + bb[e];
            *(f32x4*)(dst + c) = v[i]; }
        if (l == 0) {
            ln_stats(v, mean, rstd);
            bf16_t* H = (bf16_t*)(a->ws + WS_H);
#pragma unroll
            for (int i = 0; i < 4; ++i) { const int c = 256 * i + 4 * lane; const f32x4 sh = nsh[i], sc = nsc[i];
                f32x4 o;
#pragma unroll
                for (int e = 0; e < 4; ++e) o[e] = (v[i][e] - mean) * rstd * (1.0f + sc[e]) + sh[e];
                u32x2 pk; pk.x = pack2(o[0], o[1]); pk.y = pack2(o[2], o[3]); *(u32x2*)(H + (size_t)t * D + c) = pk; }
        }
    }
}

constexpr int N_PHASES = 18;
template <int P> __device__ __forceinline__ void run_phase(AP a, unsigned char* smem, LAS unsigned char* lds, int l) {
    asm volatile("" : "+s"(a));
    if (P == 0) p0_prologue(a, smem);
    if (P == 1) p_lnmod0(a);
    if (P == 2) p1_inproj(a, lds, l);
    if (P == 3) p2_mix(a, smem, lds, l);
    if (P == 4) p3_outproj(a, lds, l);
    if (P == 5) p4_ln1_router(a, smem, l);
    if (P == 6) p5_dispatch(a, smem, l);
    if (P == 7) p6_gateup(a, lds, l);
    if (P == 8) p7_down(a, lds, l);
    if (P == 9) p8_ln2(a, smem, l);
}
template <int P> __device__ __noinline__ void phase_fn(AP ap, int l) {
    extern __shared__ __attribute__((aligned(16))) unsigned char smem[];
    run_phase<P>(ap, smem, (LAS unsigned char*)smem, l);
}
#if N_LAUNCH_MODE == 1
__global__ void __launch_bounds__(NT, 2) fwd(Args a) {
    extern __shared__ __attribute__((aligned(16))) unsigned char smem[];
    LAS unsigned char* lds = (LAS unsigned char*)smem;
    if (threadIdx.x < 4) ((volatile LAS unsigned*)(lds + MISC_OFF + 768))[threadIdx.x] = 0u;
    __syncthreads();
    XcdBarrier bar = xcd_barrier_post((unsigned*)(a.ws + WS_BAR), (volatile LAS unsigned*)(lds + MISC_OFF + 768));
    AP ap = (AP)__builtin_amdgcn_kernarg_segment_ptr();
#define PROBE(P, l) do { if (PROBE_MASK & (1 << (P))) { for (int _r = 0; _r < 2; ++_r) { xcd_barrier(bar); run_phase<P>(ap, smem, lds, l); } } } while (0)
    run_phase<0>(ap, smem, lds, 0); PROBE(0, 0); xcd_barrier(bar);
    run_phase<1>(ap, smem, lds, 0); PROBE(1, 0); xcd_barrier(bar);
    for (int l = 0; l < 2; ++l) {
        run_phase<2>(ap, smem, lds, l); PROBE(2, l); xcd_barrier(bar);
        run_phase<3>(ap, smem, lds, l); PROBE(3, l); xcd_barrier(bar);
        run_phase<4>(ap, smem, lds, l); PROBE(4, l); xcd_barrier(bar);
        run_phase<5>(ap, smem, lds, l); PROBE(5, l); xcd_barrier(bar);
        run_phase<6>(ap, smem, lds, l); PROBE(6, l); xcd_barrier(bar);
        run_phase<7>(ap, smem, lds, l); PROBE(7, l); xcd_barrier(bar);
        run_phase<8>(ap, smem, lds, l); PROBE(8, l); xcd_barrier(bar);
        run_phase<9>(ap, smem, lds, l); PROBE(9, l); if (l == 0) xcd_barrier(bar);
    }
}
#else
template <int P> __global__ void __launch_bounds__(NT, 2) k_phase(Args a) {
    extern __shared__ __attribute__((aligned(16))) unsigned char smem[];
    LAS unsigned char* lds = (LAS unsigned char*)smem;
    AP ap = (AP)__builtin_amdgcn_kernarg_segment_ptr();
    run_phase<P>(ap, smem, lds, ap->ph_lo);
}
template <int P> static void launch_phase(Args a, int l, int grid, hipStream_t stream) {
    static bool attr = false;
    if (!attr) { (void)hipFuncSetAttribute((const void*)k_phase<P>, hipFuncAttributeMaxDynamicSharedMemorySize, LDS_BYTES); attr = true; }
    a.ph_lo = l; a.ph_hi = P;
    hipLaunchKernelGGL(k_phase<P>, dim3(grid), dim3(NT), LDS_BYTES, stream, a);
}
#endif

extern "C" void kernel_launch(void* const* d_in, const int* in_sizes, int n_in, void* d_out, int out_size, void* d_ws, size_t ws_size, hipStream_t stream) {
    static int grid = 0;
    if (grid == 0) {
        if (n_in != 23 || out_size != NLAT * D || ws_size < WS_END) { fprintf(stderr, "kernel_launch: unexpected shapes (n_in %d, out %d, ws %zu, need %zu)\n", n_in, out_size, ws_size, (size_t)WS_END); grid = -1; return; }
        int dev = 0, cus = 0;
        if (hipGetDevice(&dev) != hipSuccess || hipDeviceGetAttribute(&cus, hipDeviceAttributeMultiprocessorCount, dev) != hipSuccess) { grid = -1; return; }
#if N_LAUNCH_MODE == 1
        int per_cu = 0;
        if (hipFuncSetAttribute((const void*)fwd, hipFuncAttributeMaxDynamicSharedMemorySize, LDS_BYTES) != hipSuccess) { fprintf(stderr, "kernel_launch: hipFuncSetAttribute failed\n"); grid = -1; return; }
        if (hipOccupancyMaxActiveBlocksPerMultiprocessor(&per_cu, (const void*)fwd, NT, LDS_BYTES) != hipSuccess || per_cu < 1) { fprintf(stderr, "kernel_launch: occupancy query says %d\n", per_cu); }
        (void)hipGetLastError();
#endif
        grid = cus; if (grid > MAXG) grid = MAXG;
    }
    if (grid < 0) return;
    (void)hipMemsetAsync((char*)d_ws + WS_BAR, 0, 16384 + 256, stream);
    Args a{};
    for (int i = 0; i < 23; ++i) a.in[i] = (const float*)d_in[i];
    a.out = (float*)d_out; a.ws = (unsigned char*)d_ws;
#if N_LAUNCH_MODE == 1
    a.ph_lo = 0; a.ph_hi = N_PHASES;
    hipLaunchKernelGGL(fwd, dim3(grid), dim3(NT), LDS_BYTES, stream, a);
#else
    launch_phase<0>(a, 0, grid, stream);
    launch_phase<1>(a, 0, grid, stream);
    for (int l = 0; l < 2; ++l) {
        launch_phase<2>(a, l, grid, stream); launch_phase<3>(a, l, grid, stream); launch_phase<4>(a, l, grid, stream); launch_phase<5>(a, l, grid, stream);
        launch_phase<6>(a, l, grid, stream); launch_phase<7>(a, l, grid, stream); launch_phase<8>(a, l, grid, stream); launch_phase<9>(a, l, grid, stream);
    }
#endif
}
```

```cpp
#include <hip/hip_runtime.h>
#include <stdint.h>
#include <stdio.h>

#ifndef NAIVE_GEMM
#define NAIVE_GEMM 0
#endif
#ifndef NAIVE_MIXER
#define NAIVE_MIXER 0
#endif
#ifndef PROBE_MASK
#define PROBE_MASK 0
#endif
#ifndef PROBE_FFT_REP
#define PROBE_FFT_REP 1
#endif
#ifndef PROBE_MIX_REP
#define PROBE_MIX_REP 1
#endif
#ifndef PROBE_SGU_REP
#define PROBE_SGU_REP 1
#endif
#ifndef N_LAUNCH_MODE
#define N_LAUNCH_MODE 1
#endif

#define LAS __attribute__((address_space(3)))
typedef unsigned short bf16_t;
typedef short bf16x8 __attribute__((ext_vector_type(8)));
typedef float f32x4 __attribute__((ext_vector_type(4)));
typedef unsigned u32x4 __attribute__((ext_vector_type(4)));
typedef unsigned u32x2 __attribute__((ext_vector_type(2)));
typedef float f32x2 __attribute__((ext_vector_type(2)));

constexpr int D = 1024, NBATCH = 4, SEQ = 4096, CTXL = 256;
constexpr int NLAT = NBATCH * SEQ, NCTX = NBATCH * CTXL, NTOK = NLAT + NCTX;
constexpr int ZC = 1792;
constexpr int NEXP = 32, DEXP = 512;
constexpr int NSLOT = 2 * NTOK + NEXP * 256;
constexpr int NT = 512;
constexpr int MAXG = 512;
constexpr float RES_ALPHA = 1.41421356237309515f;
constexpr int MISC_OFF = 155648;
constexpr int RIDX_OFF = 131072;
constexpr int LDS_BYTES = MISC_OFF + 1024;

constexpr size_t WS_BAR   = 0;
constexpr size_t WS_CNT   = 16384;
constexpr size_t WS_BCNT  = WS_CNT + 256;
constexpr size_t WS_MOD   = WS_BCNT + (size_t)2 * MAXG * 32 * 4;
constexpr size_t WS_ROPE  = WS_MOD + (size_t)2 * 5 * 6144 * 4;
constexpr size_t WS_TOKE  = WS_ROPE + 8192;
constexpr size_t WS_TOKR  = WS_TOKE + (size_t)NTOK * 8;
constexpr size_t WS_TOKS  = WS_TOKR + (size_t)NTOK * 8;
constexpr size_t WS_TOKG  = WS_TOKS + (size_t)NTOK * 8;
constexpr size_t WS_SLOTT = WS_TOKG + (size_t)NTOK * 8;
constexpr size_t WS_WIN   = WS_SLOTT + (size_t)NSLOT * 4;
constexpr size_t WS_WOUT  = WS_WIN + (size_t)2 * ZC * 1024 * 2;
constexpr size_t WS_WSGU  = WS_WOUT + (size_t)2 * 1024 * 1024 * 2;
constexpr size_t WS_DFTC  = WS_WSGU + (size_t)2 * 4 * 128 * 128 * 2;
constexpr size_t WS_WEXP  = WS_DFTC + (size_t)256 * 512 * 2;
constexpr size_t EXPMAT   = (size_t)NEXP * 512 * 1024;
constexpr size_t WEXP_LAYER = 3 * EXPMAT * 2;
constexpr size_t WS_X1    = WS_WEXP + 2 * WEXP_LAYER;
constexpr size_t WS_XC    = WS_X1 + (size_t)NTOK * D * 4;
constexpr size_t WS_H     = WS_XC + (size_t)NTOK * D * 4;
constexpr size_t WS_R     = WS_H + (size_t)NTOK * D * 2;
constexpr size_t WS_Z     = WS_R;
constexpr size_t WS_AT    = WS_Z + (size_t)NTOK * ZC * 2;
constexpr size_t WS_ATC   = WS_AT + (size_t)4 * 256 * 8192 * 2;
constexpr size_t WS_VT    = WS_ATC + (size_t)4 * 256 * 512 * 2;
constexpr size_t WS_VTC   = WS_VT + (size_t)4 * 2 * 64 * 4096 * 2;
constexpr size_t WS_CAT   = WS_VTC + (size_t)4 * 2 * 64 * 256 * 2;
constexpr size_t WS_REND  = WS_CAT + (size_t)NTOK * D * 2;
constexpr size_t WS_Y     = WS_R;
constexpr size_t WS_HID   = WS_R;
constexpr size_t WS_YS    = WS_HID + (size_t)NSLOT * DEXP * 2;
constexpr size_t WS_END   = (WS_YS + (size_t)NSLOT * D * 2 > WS_REND) ? WS_YS + (size_t)NSLOT * D * 2 : WS_REND;
static_assert(WS_Y + (size_t)NTOK * D * 4 <= WS_CAT, "Y must not reach CAT");
static_assert(WS_WIN % 256 == 0 && WS_DFTC % 256 == 0 && WS_WEXP % 256 == 0 && WS_X1 % 256 == 0 && WS_H % 256 == 0 && WS_R % 256 == 0 && WS_AT % 256 == 0 && WS_CAT % 256 == 0 && WS_YS % 256 == 0, "alignment");

struct Args { const float* in[23]; float* out; unsigned char* ws; int ph_lo, ph_hi; };
#define CAS __attribute__((address_space(4)))
typedef const CAS Args* AP;

#define XB_TMO      128
#define XB_XCNT(j)  (256  + 64 * (j))
#define XB_XSUB(j)  (1280 + 64 * (j))
#define XB_XGEN(j)  (2304 + 64 * (j))
#define XB_TOP      3328
#define XB_TOPGEN   3392
#define XCD_BAR_WORDS 3456
#define XB_SPIN_CAP (1u << 18)

__device__ __forceinline__ unsigned xb_ld(unsigned* p)              { return __hip_atomic_load(p, __ATOMIC_RELAXED, __HIP_MEMORY_SCOPE_AGENT); }
__device__ __forceinline__ unsigned xb_add(unsigned* p, unsigned v) { return __hip_atomic_fetch_add(p, v, __ATOMIC_RELAXED, __HIP_MEMORY_SCOPE_AGENT); }
__device__ __forceinline__ unsigned xb_xcc_id() { return (unsigned)__builtin_amdgcn_s_getreg((3 << 11) | 20) & 0xFu; }
#define XB_SPIN(cond, bar) do { unsigned _sp = 0; while (cond) { __builtin_amdgcn_s_sleep(1); \
    if ((++_sp & 255u) == 0u) { if (xb_ld(&(bar)[XB_TMO])) break; if (_sp > XB_SPIN_CAP) { atomicAdd(&(bar)[XB_TMO], 1u); break; } } } } while (0)

struct XcdBarrier { unsigned* bar; unsigned x; volatile LAS unsigned* st; };

__device__ __forceinline__ XcdBarrier xcd_barrier_post(unsigned* bar, volatile LAS unsigned* st) {
    XcdBarrier b; b.bar = bar; b.x = (unsigned)__builtin_amdgcn_readfirstlane((int)xb_xcc_id()); b.st = st;
    if (threadIdx.x == 0) (void)xb_add(&bar[XB_XCNT(b.x)], 1u);
    return b;
}
__device__ __forceinline__ void xcd_barrier_complete(unsigned* bar, unsigned x, unsigned& nloc, unsigned& nx) {
    const unsigned G = gridDim.x * gridDim.y * gridDim.z;
    unsigned sum, cnt, mine, sp = 0u;
    for (;;) {
        sum = 0u; cnt = 0u; mine = 0u;
#pragma unroll
        for (unsigned j = 0; j < 16; ++j) { const unsigned c = xb_ld(&bar[XB_XCNT(j)]); sum += c; cnt += (c > 0u) ? 1u : 0u; mine = (j == x) ? c : mine; }
        if (sum == G) break;
        __builtin_amdgcn_s_sleep(1);
        if ((++sp & 255u) == 0u) { if (xb_ld(&bar[XB_TMO])) break; if (sp > XB_SPIN_CAP) { atomicAdd(&bar[XB_TMO], 1u); break; } }
    }
    nloc = mine > 0u ? mine : 1u; nx = cnt > 0u ? cnt : 1u;
}
__device__ __forceinline__ void xcd_barrier(const XcdBarrier& b) {
    asm volatile("s_waitcnt vmcnt(0)" ::: "memory");
    __syncthreads();
    if (threadIdx.x == 0) {
        unsigned* bar = b.bar;
        unsigned bx = b.x;
        asm volatile("" : "+s"(bar), "+s"(bx));
        __builtin_amdgcn_s_waitcnt(0);
        unsigned nloc = b.st[0], nx = b.st[1];
        if (nloc == 0u) { xcd_barrier_complete(bar, bx, nloc, nx); b.st[0] = nloc; b.st[1] = nx; }
        const unsigned old = xb_add(&bar[XB_XSUB(bx)], 1u);
        const unsigned gen = old / nloc;
        if (old + 1u == (gen + 1u) * nloc) {
            __builtin_amdgcn_fence(__ATOMIC_RELEASE, "agent");
            asm volatile("s_waitcnt vmcnt(0)" ::: "memory");
            const unsigned og = xb_add(&bar[XB_TOP], 1u);
            const unsigned tg = og / nx;
            if (og + 1u == (tg + 1u) * nx) xb_add(&bar[XB_TOPGEN], 1u);
            else XB_SPIN(xb_ld(&bar[XB_TOPGEN]) == tg, bar);
            __builtin_amdgcn_fence(__ATOMIC_ACQUIRE, "agent");
            xb_add(&bar[XB_XGEN(bx)], 1u);
            asm volatile("s_waitcnt vmcnt(0)" ::: "memory");
        } else {
            XB_SPIN(xb_ld(&bar[XB_XGEN(bx)]) == gen, bar);
            __builtin_amdgcn_fence(__ATOMIC_ACQUIRE, "agent");
            asm volatile("s_waitcnt vmcnt(0)" ::: "memory");
        }
    }
    __syncthreads();
}

__device__ __forceinline__ int tid_opaque() { int t = threadIdx.x; asm volatile("" : "+v"(t)); return t; }
__device__ __forceinline__ float bf2f(bf16_t v) { return __uint_as_float(((unsigned)v) << 16); }
__device__ __forceinline__ bf16_t f2bf(float f) { return __builtin_bit_cast(unsigned short, (__bf16)f); }
typedef __bf16 hwbf16x2 __attribute__((ext_vector_type(2)));
__device__ __forceinline__ unsigned pack2(float a, float b) { return __builtin_bit_cast(unsigned, __builtin_convertvector((f32x2){a, b}, hwbf16x2)); }
__device__ __forceinline__ float lo2f(unsigned w) { return __uint_as_float(w << 16); }
__device__ __forceinline__ float hi2f(unsigned w) { return __uint_as_float(w & 0xffff0000u); }
template <int CTRL> __device__ __forceinline__ float dpp_mov(float v) { return __builtin_bit_cast(float, __builtin_amdgcn_update_dpp(0, __builtin_bit_cast(int, v), CTRL, 0xf, 0xf, true)); }
__device__ __forceinline__ float row_sum16(float v) {
    v += dpp_mov<0xB1>(v);
    v += dpp_mov<0x4E>(v);
    v += dpp_mov<0x141>(v);
    v += dpp_mov<0x140>(v);
    return v;
}
__device__ __forceinline__ float row_max16(float v) {
    v = fmaxf(v, dpp_mov<0xB1>(v)); v = fmaxf(v, dpp_mov<0x4E>(v)); v = fmaxf(v, dpp_mov<0x141>(v)); v = fmaxf(v, dpp_mov<0x140>(v));
    return v;
}
__device__ __forceinline__ float wave_sum(float v) {
    v = row_sum16(v);
    const int iv = __builtin_bit_cast(int, v);
    const float a0 = __builtin_bit_cast(float, __builtin_amdgcn_readlane(iv, 0)), a1 = __builtin_bit_cast(float, __builtin_amdgcn_readlane(iv, 16));
    const float a2 = __builtin_bit_cast(float, __builtin_amdgcn_readlane(iv, 32)), a3 = __builtin_bit_cast(float, __builtin_amdgcn_readlane(iv, 48));
    return (a0 + a1) + (a2 + a3);
}
__device__ __forceinline__ float gelu_erf(float v) {
    const float t = __builtin_amdgcn_rcpf(fabsf(v) * 0.2316418882f + 1.0f);
    float q = t * 0.5307027145f + (-0.7265760135f); q = q * t + 0.7107068705f; q = q * t + (-0.142248368f); q = q * t + 0.127414796f; q = q * t;
    const float m = v * (q * __builtin_amdgcn_exp2f((v * v) * (-0.72134752044f)));
    return v < 0.f ? m : v - m;
}
__device__ __forceinline__ float silu_f(float x) { return x / (1.0f + __expf(-x)); }

__device__ __forceinline__ void ln_stats(const f32x4 (&v)[4], float& mean, float& rstd) {
    float s = 0.f;
#pragma unroll
    for (int i = 0; i < 4; ++i) s += (v[i][0] + v[i][1]) + (v[i][2] + v[i][3]);
    s = wave_sum(s); mean = s * (1.0f / 1024.0f);
    float q = 0.f;
#pragma unroll
    for (int i = 0; i < 4; ++i)
#pragma unroll
        for (int e = 0; e < 4; ++e) { const float d = v[i][e] - mean; q += d * d; }
    q = wave_sum(q); rstd = 1.0f / sqrtf(q * (1.0f / 1024.0f) + 1e-6f);
}

__device__ __forceinline__ void ln_stats16(const f32x4 (&v)[16], float& mean, float& rstd) {
    float s = 0.f;
#pragma unroll
    for (int k = 0; k < 16; ++k) s += (v[k][0] + v[k][1]) + (v[k][2] + v[k][3]);
    s = row_sum16(s); mean = s * (1.0f / 1024.0f);
    float q = 0.f;
#pragma unroll
    for (int k = 0; k < 16; ++k)
#pragma unroll
        for (int e = 0; e < 4; ++e) { const float d = v[k][e] - mean; q += d * d; }
    q = row_sum16(q); rstd = 1.0f / sqrtf(q * (1.0f / 1024.0f) + 1e-6f);
}

template <int BN> struct MfmaLayout {
    static constexpr int FG = BN / 128, NI = 4, NJ = 2 * FG;
    int rbase, cbase;
    __device__ __forceinline__ int row(int i) const { return rbase + 16 * i; }
    __device__ __forceinline__ int col(int jj) const { return (jj / FG) * (BN / 2) + (jj % FG) * 16 + cbase; }
};
template <int BN> struct NaiveLayout {
    static constexpr int TX = BN / 8, TY = NT / TX, NI = 128 / TY, NJ = 2;
    int ty, tx;
    __device__ __forceinline__ int row(int i) const { return ty + TY * i; }
    __device__ __forceinline__ int col(int jj) const { return jj * (BN / 2) + 4 * tx; }
};

__device__ __forceinline__ void glds16(const bf16_t* g, LAS unsigned char* l) {
    __builtin_amdgcn_global_load_lds((const unsigned*)g, (LAS unsigned*)l, 16, 0, 0);
}

template <int BN, bool GATHER, class Epi>
__device__ __forceinline__ void gemm_tile(LAS unsigned char* lds, const bf16_t* A, int lda, const int* rowidx, int valid_rows,
                                          const bf16_t* B0, const bf16_t* B1, int ldb, int K, const Epi& epi) {
    constexpr int A_B = 16384, B_B = BN * 128, STAGE = A_B + B_B, NBL = BN / 64;
    const int tid = tid_opaque(), lane = tid & 63, wid = __builtin_amdgcn_readfirstlane(tid >> 6);
    const bf16_t* ap[2]; const bf16_t* bp[NBL];
#pragma unroll
    for (int i = 0; i < 2; ++i) {
        const int P = i * 512 + tid, row = P >> 3, c = (P & 7) ^ ((row >> 1) & 7);
        size_t ro;
        if (GATHER) ro = (size_t)(row < valid_rows ? rowidx[row] : 0) * (size_t)lda; else ro = (size_t)row * (size_t)lda;
        ap[i] = A + ro + c * 8;
    }
#pragma unroll
    for (int i = 0; i < NBL; ++i) {
        const int P = i * 512 + tid, row = P >> 3, c = (P & 7) ^ ((row >> 1) & 7);
        const bf16_t* base = (row < BN / 2) ? (B0 + (size_t)row * ldb) : (B1 + (size_t)(row - BN / 2) * ldb);
        bp[i] = base + c * 8;
    }
    const int nk = K / 64;
#define GT_STAGE(buf, k0) do { \
        _Pragma("unroll") for (int _i = 0; _i < 2; ++_i) glds16(ap[_i] + (k0), lds + (buf) * STAGE + _i * 8192 + wid * 1024); \
        _Pragma("unroll") for (int _i = 0; _i < NBL; ++_i) glds16(bp[_i] + (k0), lds + (buf) * STAGE + A_B + _i * 8192 + wid * 1024); } while (0)

#if NAIVE_GEMM
    typedef NaiveLayout<BN> Lay;
    Lay lay; lay.tx = tid % Lay::TX; lay.ty = tid / Lay::TX;
    f32x4 acc[Lay::NI][Lay::NJ];
#pragma unroll
    for (int i = 0; i < Lay::NI; ++i)
#pragma unroll
        for (int j = 0; j < Lay::NJ; ++j) acc[i][j] = (f32x4){0.f, 0.f, 0.f, 0.f};
    GT_STAGE(0, 0);
    asm volatile("s_waitcnt vmcnt(0)" ::: "memory"); __syncthreads();
    for (int kt = 0; kt < nk; ++kt) {
        if (kt + 1 < nk) GT_STAGE((kt + 1) & 1, (kt + 1) * 64);
        const LAS unsigned char* sa = lds + (kt & 1) * STAGE; const LAS unsigned char* sb = sa + A_B;
#pragma unroll 1
        for (int kc = 0; kc < 8; ++kc)
#pragma unroll 1
            for (int hh = 0; hh < 2; ++hh) {
                float a[Lay::NI][4];
#pragma unroll
                for (int i = 0; i < Lay::NI; ++i) { const int row = lay.row(i);
                    const u32x2 w = *(const LAS u32x2*)(sa + row * 128 + ((kc ^ ((row >> 1) & 7)) << 4) + hh * 8);
                    a[i][0] = lo2f(w.x); a[i][1] = hi2f(w.x); a[i][2] = lo2f(w.y); a[i][3] = hi2f(w.y); }
#pragma unroll
                for (int j = 0; j < 2; ++j)
#pragma unroll
                    for (int e = 0; e < 4; ++e) { const int row = j * (BN / 2) + 4 * lay.tx + e;
                        const u32x2 w = *(const LAS u32x2*)(sb + row * 128 + ((kc ^ ((row >> 1) & 7)) << 4) + hh * 8);
                        const float b0 = lo2f(w.x), b1 = hi2f(w.x), b2 = lo2f(w.y), b3 = hi2f(w.y);
#pragma unroll
                        for (int i = 0; i < Lay::NI; ++i) acc[i][j][e] += (a[i][0] * b0 + a[i][1] * b1) + (a[i][2] * b2 + a[i][3] * b3); }
            }
        asm volatile("s_waitcnt vmcnt(0)" ::: "memory"); __syncthreads();
    }
    epi.run(acc, lay);
#else
    typedef MfmaLayout<BN> Lay;
    constexpr int FG = Lay::FG;
    const int fr = lane & 15, g = lane >> 4, wr = wid >> 2, wc = wid & 3;
    Lay lay; lay.rbase = wr * 64 + fr; lay.cbase = wc * 16 * FG + 4 * g;
    f32x4 acc[Lay::NI][Lay::NJ];
#pragma unroll
    for (int i = 0; i < Lay::NI; ++i)
#pragma unroll
        for (int j = 0; j < Lay::NJ; ++j) acc[i][j] = (f32x4){0.f, 0.f, 0.f, 0.f};
    int aoff[4], boff[Lay::NJ];
#pragma unroll
    for (int m = 0; m < 4; ++m) { const int row = wr * 64 + m * 16 + fr; aoff[m] = row * 128 + ((g ^ ((row >> 1) & 7)) << 4); }
#pragma unroll
    for (int jj = 0; jj < Lay::NJ; ++jj) { const int row = (jj / FG) * (BN / 2) + wc * 16 * FG + (jj % FG) * 16 + fr; boff[jj] = A_B + row * 128 + ((g ^ ((row >> 1) & 7)) << 4); }
    GT_STAGE(0, 0);
    asm volatile("s_waitcnt vmcnt(0)" ::: "memory"); __syncthreads();
    for (int kt = 0; kt < nk; ++kt) {
        if (kt + 1 < nk) GT_STAGE((kt + 1) & 1, (kt + 1) * 64);
        const LAS unsigned char* sa = lds + (kt & 1) * STAGE;
#pragma unroll
        for (int ks = 0; ks < 2; ++ks) {
            bf16x8 af[4], bfv[Lay::NJ];
#pragma unroll
            for (int m = 0; m < 4; ++m) af[m] = *(const LAS bf16x8*)(sa + (aoff[m] ^ (ks << 6)));
#pragma unroll
            for (int jj = 0; jj < Lay::NJ; ++jj) bfv[jj] = *(const LAS bf16x8*)(sa + (boff[jj] ^ (ks << 6)));
#pragma unroll
            for (int m = 0; m < 4; ++m)
#pragma unroll
                for (int jj = 0; jj < Lay::NJ; ++jj) acc[m][jj] = __builtin_amdgcn_mfma_f32_16x16x32_bf16(bfv[jj], af[m], acc[m][jj], 0, 0, 0);
        }
        asm volatile("s_waitcnt vmcnt(0)" ::: "memory"); __syncthreads();
    }
    epi.run(acc, lay);
#endif
#undef GT_STAGE
}

namespace g256 {
constexpr int BK = 64, HALF = 128, HTB = HALF * BK * 2, STAGE_BYTES = 8 * HTB;
__device__ __forceinline__ int lds_byte(int r, int c) { const int st = (r >> 4) * 2 + (c >> 5), rr = r & 15, cc = c & 31, ob = rr * 64 + cc * 2; return st * 1024 + (ob ^ (((ob >> 9) & 1) << 5)); }
__device__ __forceinline__ void stage_rc(int b, int& R, int& C) { const int st = b / 1024, sb = b % 1024, swz = sb ^ (((sb >> 9) & 1) << 5); R = (st >> 1) * 16 + swz / 64; C = (st & 1) * 32 + (swz % 64) / 2; }
struct Lay {
    static constexpr int NI = 8, NJ = 4;
    int rbase, cbase;
    __device__ __forceinline__ int row(int i) const { return (i >> 2) * 128 + (i & 3) * 16 + rbase; }
    __device__ __forceinline__ int col(int j) const { return (j >> 1) * 128 + (j & 1) * 16 + cbase; }
};
template <class Epi> struct Unit { const bf16_t* A; const bf16_t* B0; const bf16_t* B1; const LAS int* ridx; int valid; Epi epi; };

template <class Sched>
__device__ __forceinline__ void gemm_phase(LAS unsigned char* lds, const int K, const Sched& S) {
    typedef typename Sched::Epi Epi;
    const int tid = tid_opaque(), wid = __builtin_amdgcn_readfirstlane(tid >> 6), lane = tid & 63, wr = wid >> 2, wc = wid & 3, fr = lane & 15, fq = lane >> 4;
    int nt = K / BK; asm volatile("" : "+s"(nt));
    int sR[2], sC[2];
#pragma unroll
    for (int i = 0; i < 2; ++i) stage_rc(tid * 16 + i * 8192, sR[i], sC[i]);
    unsigned voffB[2];
#pragma unroll
    for (int i = 0; i < 2; ++i) voffB[i] = (unsigned)(sR[i] * K + sC[i]) * 2u;
    const size_t kstep = (size_t)(BK * 2);
    const unsigned ldsw = (unsigned)wid * 1024u;
    const int aoff = lds_byte(wr * 64 + fr, fq * 8), boff = lds_byte(wc * 32 + fr, fq * 8);
#define G2_SA(b, h) (((b) * 2 + (h)) * HTB)
#define G2_SB(b, h) ((4 + (b) * 2 + (h)) * HTB)
#define G2_STAGE(bufoff, gbase, v0, v1) do { \
        __builtin_amdgcn_global_load_lds((const unsigned*)((const char*)(gbase) + (v0)), (LAS unsigned*)(lds + (bufoff) + ldsw), 16, 0, 0); \
        __builtin_amdgcn_global_load_lds((const unsigned*)((const char*)(gbase) + (v1)), (LAS unsigned*)(lds + (bufoff) + ldsw + 8192), 16, 0, 0); } while (0)
#define G2_LDA(dst, b, h) do { _Pragma("unroll") for (int m = 0; m < 4; ++m) _Pragma("unroll") for (int k = 0; k < 2; ++k) dst[m][k] = *(const LAS bf16x8*)(lds + G2_SA(b, h) + aoff + m * 2048 + k * 1024); } while (0)
#define G2_LDB(dst, b, h) do { _Pragma("unroll") for (int n = 0; n < 2; ++n) _Pragma("unroll") for (int k = 0; k < 2; ++k) dst[n][k] = *(const LAS bf16x8*)(lds + G2_SB(b, h) + boff + n * 2048 + k * 1024); } while (0)
#define G2_MMA(ai, bj, At, Bt) do { __builtin_amdgcn_s_setprio(1); _Pragma("unroll") for (int m = 0; m < 4; ++m) _Pragma("unroll") for (int n = 0; n < 2; ++n) _Pragma("unroll") for (int k = 0; k < 2; ++k) \
        acc[(ai) * 4 + m][(bj) * 2 + n] = __builtin_amdgcn_mfma_f32_16x16x32_bf16(Bt[n][k], At[m][k], acc[(ai) * 4 + m][(bj) * 2 + n], 0, 0, 0); __builtin_amdgcn_s_setprio(0); } while (0)
#define G2_WAIT_V(n) asm volatile("s_waitcnt vmcnt(" #n ")" ::: "memory")
#define G2_WAIT_L(n) asm volatile("s_waitcnt lgkmcnt(" #n ")" ::: "memory")
#define G2_BAR __builtin_amdgcn_s_barrier()
#define G2_SCHED __builtin_amdgcn_sched_barrier(0)
#define G2_VOFFA(U, dst) do { _Pragma("unroll") for (int _h = 0; _h < 2; ++_h) _Pragma("unroll") for (int _i = 0; _i < 2; ++_i) { const int _row = _h * 128 + sR[_i]; \
        int _tok = _row; if (Sched::GATHER) _tok = (_row < (U).valid) ? (U).ridx[_row] : 0; dst[_h][_i] = (unsigned)(_tok * K + sC[_i]) * 2u; } } while (0)
    Unit<Epi> cur, nxt; int ui = 0;
    if (!S.get(0, cur)) return;
    f32x4 acc[8][4];
#pragma unroll
    for (int i = 0; i < 8; ++i)
#pragma unroll
        for (int j = 0; j < 4; ++j) acc[i][j] = (f32x4){0.f, 0.f, 0.f, 0.f};
    bf16x8 At[4][2], B0[2][2], B1[2][2];
    unsigned cvA[2][2], nvA[2][2];
    G2_VOFFA(cur, cvA);
    const char* cA = (const char*)cur.A; const char* cB0 = (const char*)cur.B0; const char* cB1 = (const char*)cur.B1;
    G2_STAGE(G2_SB(0, 0), cB0, voffB[0], voffB[1]); G2_STAGE(G2_SA(0, 0), cA, cvA[0][0], cvA[0][1]); G2_STAGE(G2_SB(0, 1), cB1, voffB[0], voffB[1]); G2_STAGE(G2_SA(0, 1), cA, cvA[1][0], cvA[1][1]);
    if (wr == 1) G2_BAR;
    G2_WAIT_V(4); G2_BAR;
    G2_STAGE(G2_SB(1, 0), cB0 + kstep, voffB[0], voffB[1]); G2_STAGE(G2_SA(1, 0), cA + kstep, cvA[0][0], cvA[0][1]); G2_STAGE(G2_SB(1, 1), cB1 + kstep, voffB[0], voffB[1]);
    G2_WAIT_V(6); G2_BAR;
    for (;;) {
        const bool has_next = S.get(ui + 1, nxt);
        if (Sched::GATHER) {
            if (has_next) { G2_VOFFA(nxt, nvA); }
            else {
#pragma unroll
                for (int h = 0; h < 2; ++h) { nvA[h][0] = cvA[h][0]; nvA[h][1] = cvA[h][1]; } }
        }
        const char* nA = has_next ? (const char*)nxt.A : cA; const char* nB0 = has_next ? (const char*)nxt.B0 : cB0; const char* nB1 = has_next ? (const char*)nxt.B1 : cB1;
#pragma unroll 1
        for (int t = 0; t < nt; t += 2) {
            const bool last = (t == nt - 2);
            const char* a1 = cA + (size_t)(t + 1) * kstep;
            const char* a2 = last ? nA : cA + (size_t)(t + 2) * kstep;
            const char* b20 = last ? nB0 : cB0 + (size_t)(t + 2) * kstep; const char* b21 = last ? nB1 : cB1 + (size_t)(t + 2) * kstep;
#define x00 ((Sched::GATHER && last) ? nvA[0][0] : cvA[0][0])
#define x01 ((Sched::GATHER && last) ? nvA[0][1] : cvA[0][1])
#define x10 ((Sched::GATHER && last) ? nvA[1][0] : cvA[1][0])
#define x11 ((Sched::GATHER && last) ? nvA[1][1] : cvA[1][1])
            G2_LDB(B0, 0, 0); G2_SCHED; G2_LDA(At, 0, 0); G2_STAGE(G2_SA(1, 1), a1, cvA[1][0], cvA[1][1]);
            G2_WAIT_L(8); G2_BAR; G2_WAIT_L(0); G2_MMA(0, 0, At, B0); G2_BAR; G2_SCHED;
            G2_LDB(B1, 0, 1); G2_STAGE(G2_SB(0, 0), b20, voffB[0], voffB[1]);
            G2_BAR; G2_WAIT_L(0); G2_MMA(0, 1, At, B1); G2_BAR;
            G2_LDA(At, 0, 1); G2_STAGE(G2_SA(0, 0), a2, x00, x01);
            G2_BAR; G2_WAIT_L(0); G2_MMA(1, 0, At, B0); G2_BAR; G2_SCHED;
            G2_STAGE(G2_SB(0, 1), b21, voffB[0], voffB[1]);
            G2_WAIT_V(6); G2_BAR; G2_MMA(1, 1, At, B1); G2_BAR;
            G2_LDB(B0, 1, 0); G2_SCHED; G2_LDA(At, 1, 0); G2_STAGE(G2_SA(0, 1), a2, x10, x11);
            G2_WAIT_L(8); G2_BAR; G2_WAIT_L(0); G2_MMA(0, 0, At, B0); G2_BAR; G2_SCHED;
            G2_LDB(B1, 1, 1); G2_STAGE(G2_SB(1, 0), b20 + kstep, voffB[0], voffB[1]);
            G2_BAR; G2_WAIT_L(0); G2_MMA(0, 1, At, B1); G2_BAR;
            G2_LDA(At, 1, 1); G2_STAGE(G2_SA(1, 0), a2 + kstep, x00, x01);
            G2_BAR; G2_WAIT_L(0); G2_MMA(1, 0, At, B0); G2_BAR; G2_SCHED;
            G2_STAGE(G2_SB(1, 1), b21 + kstep, voffB[0], voffB[1]);
            G2_WAIT_V(6); G2_BAR; G2_MMA(1, 1, At, B1); G2_BAR;
        }
        { Lay lay; int rbv = wr * 64 + fr, cbv = wc * 32 + 4 * fq; asm volatile("" : "+v"(rbv), "+v"(cbv));
          lay.rbase = rbv; lay.cbase = cbv; cur.epi.run(acc, lay); }
        if (!has_next) break;
#pragma unroll
        for (int i = 0; i < 8; ++i)
#pragma unroll
            for (int j = 0; j < 4; ++j) acc[i][j] = (f32x4){0.f, 0.f, 0.f, 0.f};
        cur = nxt; cA = nA; cB0 = nB0; cB1 = nB1; ++ui;
        if (Sched::GATHER) {
#pragma unroll
            for (int h = 0; h < 2; ++h) { cvA[h][0] = nvA[h][0]; cvA[h][1] = nvA[h][1]; } }
    }
#undef x00
#undef x01
#undef x10
#undef x11
    G2_WAIT_V(0);
    if (wr == 0) G2_BAR;
    G2_BAR;
#undef G2_SA
#undef G2_SB
#undef G2_STAGE
#undef G2_LDA
#undef G2_LDB
#undef G2_MMA
#undef G2_WAIT_V
#undef G2_WAIT_L
#undef G2_BAR
#undef G2_SCHED
#undef G2_VOFFA
}
}

struct EpiF32 {
    float* C; int ld;
    template <class L> __device__ __forceinline__ void run(const f32x4 (&acc)[L::NI][L::NJ], const L& lay) const {
#pragma unroll
        for (int i = 0; i < L::NI; ++i)
#pragma unroll
            for (int j = 0; j < L::NJ; ++j) *(f32x4*)(C + (size_t)lay.row(i) * ld + lay.col(j)) = acc[i][j];
    }
};
struct EpiBf16 {
    bf16_t* C; int ld;
    template <class L> __device__ __forceinline__ void run(const f32x4 (&acc)[L::NI][L::NJ], const L& lay) const {
#pragma unroll
        for (int i = 0; i < L::NI; ++i)
#pragma unroll
            for (int j = 0; j < L::NJ; ++j) { u32x2 w; w.x = pack2(acc[i][j][0], acc[i][j][1]); w.y = pack2(acc[i][j][2], acc[i][j][3]);
                *(u32x2*)(C + (size_t)lay.row(i) * ld + lay.col(j)) = w; }
    }
};
struct EpiGateUp {
    bf16_t* C; int ld;
    template <class L> __device__ __forceinline__ void run(const f32x4 (&acc)[L::NI][L::NJ], const L& lay) const {
#pragma unroll
        for (int i = 0; i < L::NI; ++i)
#pragma unroll
            for (int j = 0; j < L::NJ / 2; ++j) { const f32x4 gt = acc[i][j], up = acc[i][j + L::NJ / 2];
                u32x2 w; w.x = pack2(silu_f(gt[0]) * up[0], silu_f(gt[1]) * up[1]); w.y = pack2(silu_f(gt[2]) * up[2], silu_f(gt[3]) * up[3]);
                *(u32x2*)(C + (size_t)lay.row(i) * ld + lay.col(j)) = w; }
    }
};
struct EpiInProj {
    bf16_t* Zt;
    bf16_t* tF;
    bf16_t* tV;
    int n0, pos0, n;
    template <class L> __device__ __forceinline__ void run(const f32x4 (&acc)[L::NI][L::NJ], const L& lay) const {
#pragma unroll
        for (int i = 0; i < L::NI; ++i)
#pragma unroll
            for (int j = 0; j < L::NJ; ++j) {
                const int r = lay.row(i), cl = lay.col(j), c = n0 + cl;
                const f32x4 v = acc[i][j];
                if (c < 512) {
                    const int part = c >> 8, ch = c & 255;
#pragma unroll
                    for (int e = 0; e < 4; ++e) tF[((size_t)(ch + e) * 2 + part) * n + pos0 + r] = f2bf(v[e]);
                } else {
                    u32x2 w; w.x = pack2(v[0], v[1]); w.y = pack2(v[2], v[3]);
                    *(u32x2*)(Zt + (size_t)r * ZC + cl) = w;
                    if (c >= 896 && c < 1024) {
#pragma unroll
                        for (int e = 0; e < 4; ++e) tV[(size_t)(c - 896 + e) * n + pos0 + r] = f2bf(v[e]);
                    }
                }
            }
    }
};

constexpr int U_ADA = 192, U_WIN = 2 * 16 * 28, U_WOUT = 2 * 16 * 16, U_SGU = 32, U_DFT = 256, U_ROPE = 1, U_EXP = 3 * 32 * 32;
constexpr int LDS_SIL = 0, LDS_RED = 20480, LDS_TILE = 32768, LDS_T64 = 49408, LDS_CTAB = 50176;

__device__ __forceinline__ void ada_unit(AP a, unsigned char* lds, int u) {
    float* sil = (float*)(lds + LDS_SIL); float* red = (float*)(lds + LDS_RED);
    const int tid = tid_opaque(), lane = tid & 63, w = tid >> 6;
    const int l = u / 96, cg = u % 96;
    for (int i = tid; i < 5120; i += NT) { const int r = i >> 10, k = i & 1023; const float v = (r < 4) ? a->in[1][r * 1024 + k] : a->in[3][k]; sil[i] = v / (1.0f + expf(-v)); }
    __syncthreads();
    const float* W = a->in[4] + (size_t)l * 1024 * 6144 + cg * 64 + lane;
    float acc[5] = {0.f, 0.f, 0.f, 0.f, 0.f};
#pragma unroll 32
    for (int k = w * 128; k < w * 128 + 128; ++k) { const float wv = W[(size_t)k * 6144];
#pragma unroll
        for (int r = 0; r < 5; ++r) acc[r] += sil[r * 1024 + k] * wv; }
#pragma unroll
    for (int r = 0; r < 5; ++r) red[(w * 5 + r) * 64 + lane] = acc[r];
    __syncthreads();
    if (tid < 320) { const int r = tid >> 6; float s = 0.f;
#pragma unroll
        for (int ww = 0; ww < 8; ++ww) s += red[(ww * 5 + r) * 64 + lane];
        const int j = cg * 64 + lane; ((float*)(a->ws + WS_MOD))[(size_t)(l * 5 + r) * 6144 + j] = s + a->in[5][l * 6144 + j]; }
    __syncthreads();
}

__device__ __forceinline__ void tile_store_T(const float* tile, bf16_t* dst, int ldd) {
    const int tid = tid_opaque(), n = tid >> 3, kc = tid & 7;
    u32x4 w;
    w.x = pack2(tile[(kc * 8 + 0) * 65 + n], tile[(kc * 8 + 1) * 65 + n]); w.y = pack2(tile[(kc * 8 + 2) * 65 + n], tile[(kc * 8 + 3) * 65 + n]);
    w.z = pack2(tile[(kc * 8 + 4) * 65 + n], tile[(kc * 8 + 5) * 65 + n]); w.w = pack2(tile[(kc * 8 + 6) * 65 + n], tile[(kc * 8 + 7) * 65 + n]);
    *(u32x4*)(dst + (size_t)n * ldd + kc * 8) = w;
}
__device__ __forceinline__ void tile_load(float* tile, const float* src, int lds_) {
    const int tid = tid_opaque();
#pragma unroll
    for (int i = 0; i < 2; ++i) { const int row = (tid >> 4) + 32 * i, c4 = (tid & 15) * 4; const f32x4 v = *(const f32x4*)(src + (size_t)row * lds_ + c4);
        tile[row * 65 + c4 + 0] = v[0]; tile[row * 65 + c4 + 1] = v[1]; tile[row * 65 + c4 + 2] = v[2]; tile[row * 65 + c4 + 3] = v[3]; }
}

__device__ __forceinline__ void mm64_f32(const float* tA, int lda, const float* tB, int ldb, int K, float* out) {
    const int tid = tid_opaque(), lane = tid & 63, w = tid >> 6, fr = lane & 15, g = lane >> 4, mi = w >> 1, nj = 2 * (w & 1);
    f32x4 acc0 = (f32x4){0.f, 0.f, 0.f, 0.f}, acc1 = (f32x4){0.f, 0.f, 0.f, 0.f};
    const float* pa = tA + (16 * mi + fr) * lda + g; const float* pb = tB + g * ldb + 16 * nj + fr;
#pragma unroll 4
    for (int k0 = 0; k0 < K; k0 += 4) { const float av = pa[k0], b0 = pb[k0 * ldb], b1 = pb[k0 * ldb + 16];
        acc0 = __builtin_amdgcn_mfma_f32_16x16x4f32(av, b0, acc0, 0, 0, 0); acc1 = __builtin_amdgcn_mfma_f32_16x16x4f32(av, b1, acc1, 0, 0, 0); }
#pragma unroll
    for (int r = 0; r < 4; ++r) { out[(16 * mi + 4 * g + r) * 65 + 16 * nj + fr] = acc0[r]; out[(16 * mi + 4 * g + r) * 65 + 16 * nj + 16 + fr] = acc1[r]; }
}

__device__ __forceinline__ void win_unit(AP a, unsigned char* lds, int u) {
    float* tile = (float*)(lds + LDS_TILE); float* T = (float*)(lds + LDS_T64);
    const int tid = tid_opaque();
    const int l = u / 448, r = u % 448, kb = r / 28, nb = r % 28;
    const float* Win = a->in[6] + (size_t)l * 1024 * 1536;
    const int srccol = (nb >= 8) ? nb * 64 - 256 : (nb & 3) * 64;
    tile_load(tile, Win + (size_t)(kb * 64) * 1536 + srccol, 1536);
    if (nb < 8 && tid < 64) { T[tid] = cospif((float)tid / 32.0f); T[64 + tid] = sinpif((float)tid / 32.0f); }
    __syncthreads();
    bf16_t* dst = (bf16_t*)(a->ws + WS_WIN) + ((size_t)l * ZC + nb * 64) * 1024 + kb * 64;
    if (nb >= 8) tile_store_T(tile, dst, 1024);
    else {
        const int part = nb >> 2;
        float* Tm = (float*)(lds + 65536); float* out = (float*)(lds + 98304);
        for (int i = tid; i < 4096; i += NT) { const int c = i >> 6, cp = i & 63; const float t = T[part * 64 + ((c * cp) & 63)]; Tm[i] = (part ? -t : t) * 0.125f; }
        __syncthreads();
        mm64_f32(tile, 65, Tm, 64, 64, out);
        __syncthreads();
        tile_store_T(out, dst, 1024);
    }
    __syncthreads();
}

__device__ __forceinline__ void wout_unit(AP a, unsigned char* lds, int u) {
    float* tile = (float*)(lds + LDS_TILE);
    __syncthreads();
    const int tid = tid_opaque();
    const int l = u / 256, r = u % 256, kb = r / 16, nb = r % 16;
    const float* Wo = a->in[13] + (size_t)l * 1024 * 1024;
    const int n = tid & 63, kq = __builtin_amdgcn_readfirstlane(tid >> 6);
    if (kb < 4) {
        float* tA = (float*)lds; float* tB = (float*)(lds + 65536);
        const float* wf = a->in[7] + (size_t)l * 256 * 256 + (size_t)(kb * 64) * 256;
        __syncthreads();
        f32x4 va[8], vb[8];
#pragma unroll
        for (int i = 0; i < 8; ++i) { const int q = tid + 512 * i; va[i] = *(const f32x4*)(wf + (size_t)q * 4); vb[i] = *(const f32x4*)(Wo + (size_t)(q >> 4) * 1024 + nb * 64 + (q & 15) * 4); }
#pragma unroll
        for (int i = 0; i < 8; ++i) { const int q = tid + 512 * i; *(f32x4*)(tA + (size_t)q * 4) = va[i]; *(f32x4*)(tB + (size_t)q * 4) = vb[i]; }
        __syncthreads();
        tile = (float*)(lds + 133120);
        mm64_f32(tA, 256, tB, 64, 256, tile);
    } else if (kb >= 8 && kb < 12) {
        const int g = kb - 8;
        float* tA = (float*)lds; float* tB = (float*)(lds + 65536);
        const float* wp = a->in[9] + (size_t)(l * 4 + g) * 64 * 64;
        const float* ps = a->in[10] + l * 256 + g * 64;
        f32x4 va[2], vb[2];
#pragma unroll
        for (int i = 0; i < 2; ++i) { const int q = tid + 512 * i; va[i] = *(const f32x4*)(wp + (size_t)q * 4); vb[i] = *(const f32x4*)(Wo + (size_t)(512 + g * 64 + (q >> 4)) * 1024 + nb * 64 + (q & 15) * 4) * ps[q >> 4]; }
#pragma unroll
        for (int i = 0; i < 2; ++i) { const int q = tid + 512 * i; *(f32x4*)(tA + (size_t)q * 4) = va[i]; *(f32x4*)(tB + (size_t)q * 4) = vb[i]; }
        __syncthreads();
        tile = (float*)(lds + 133120);
        mm64_f32(tA, 64, tB, 64, 64, tile);
    } else tile_load(tile, Wo + (size_t)(kb * 64) * 1024 + nb * 64, 1024);
    __syncthreads();
    tile_store_T(tile, (bf16_t*)(a->ws + WS_WOUT) + ((size_t)l * 1024 + nb * 64) * 1024 + kb * 64, 1024);
    __syncthreads();
}

__device__ __forceinline__ void exp_src_dst(AP a, int l, int u, const float*& src, int& srcld, bf16_t*& dst, int& dstld) {
    const int mat = u / 1024, e = (u % 1024) / 32, t = u % 32;
    const int kb = (mat < 2) ? t / 4 : t / 8, nb = (mat < 2) ? t % 4 : t % 8;
    srcld = (mat < 2) ? 512 : 1024; dstld = (mat < 2) ? 1024 : 512;
    src = a->in[18 + mat] + ((size_t)(l * 32 + e) * 512 * 1024) + (size_t)(kb * 128) * srcld + nb * 128;
    dst = (bf16_t*)(a->ws + WS_WEXP + (size_t)l * WEXP_LAYER) + (size_t)mat * EXPMAT + (size_t)e * 512 * 1024 + (size_t)(nb * 128) * dstld + kb * 128;
}
#define EXP_LOAD(vv, uu) do { exp_src_dst(a, l, (uu), src, srcld, dst, dstld); _Pragma("unroll") for (int _i = 0; _i < 8; ++_i) vv[_i] = *(const f32x4*)(src + (size_t)((tid >> 5) + 16 * _i) * srcld + (tid & 31) * 4); } while (0)
#define EXP_PUT(vv) do { _Pragma("unroll") for (int _i = 0; _i < 8; ++_i) { float* tp = tile + ((tid >> 5) + 16 * _i) * 129 + (tid & 31) * 4; tp[0] = vv[_i][0]; tp[1] = vv[_i][1]; tp[2] = vv[_i][2]; tp[3] = vv[_i][3]; } } while (0)
#define EXP_STORE(dd, ld_) do { const int n = tid >> 2, kq = tid & 3; _Pragma("unroll") for (int j = 0; j < 4; ++j) { const float* tp = tile + (kq * 32 + j * 8) * 129 + n; u32x4 w; \
        w.x = pack2(tp[0], tp[129]); w.y = pack2(tp[2 * 129], tp[3 * 129]); w.z = pack2(tp[4 * 129], tp[5 * 129]); w.w = pack2(tp[6 * 129], tp[7 * 129]); \
        *(u32x4*)((dd) + (size_t)n * (ld_) + kq * 32 + j * 8) = w; } } while (0)
__device__ __forceinline__ void exp_range(AP a, unsigned char* lds, int l, int u0, int u_end) {
    float* tile = (float*)lds;
    const int tid = tid_opaque();
    __syncthreads();
    if (u0 >= u_end) return;
    const float* src; bf16_t* dst; int srcld, dstld;
    f32x4 va[8], vb[8];
    bf16_t *da, *db = nullptr; int lda_, ldb_ = 0;
    EXP_LOAD(va, u0); da = dst; lda_ = dstld;
    if (u0 + 1 < u_end) { EXP_LOAD(vb, u0 + 1); db = dst; ldb_ = dstld; }
    for (int u = u0; u < u_end; u += 2) {
        EXP_PUT(va);
        __syncthreads();
        { bf16_t* cd = da; const int cl = lda_; if (u + 2 < u_end) { EXP_LOAD(va, u + 2); da = dst; lda_ = dstld; } EXP_STORE(cd, cl); }
        __syncthreads();
        if (u + 1 < u_end) {
            EXP_PUT(vb);
            __syncthreads();
            { bf16_t* cd = db; const int cl = ldb_; if (u + 3 < u_end) { EXP_LOAD(vb, u + 3); db = dst; ldb_ = dstld; } EXP_STORE(cd, cl); }
            __syncthreads();
        }
    }
}
#undef EXP_LOAD
#undef EXP_PUT
#undef EXP_STORE
__device__ __forceinline__ void exp_queue(AP a, unsigned char* lds, int l) {
    const int tid = tid_opaque();
    int* qslot = (int*)(lds + MISC_OFF + 128);
    unsigned* qc = (unsigned*)(a->ws + WS_BAR + 14336 + l * 256);
    for (;;) {
        __syncthreads();
        if (tid == 0) *qslot = (int)__hip_atomic_fetch_add(qc, 4u, __ATOMIC_RELAXED, __HIP_MEMORY_SCOPE_AGENT);
        __syncthreads();
        const int c0 = *qslot;
        if (c0 >= U_EXP) break;
        exp_range(a, lds, l, c0, c0 + 4);
    }
}

__device__ __forceinline__ void exp_fill(AP a, unsigned char* lds, int ql, int budget) {
    const int tid = tid_opaque();
    int* qslot = (int*)(lds + MISC_OFF + 128);
    unsigned* qc = (unsigned*)(a->ws + WS_BAR + 14336 + ql * 256);
    for (int done = 0; done < budget; done += 2) {
        __syncthreads();
        if (tid == 0) *qslot = (int)__hip_atomic_fetch_add(qc, 2u, __ATOMIC_RELAXED, __HIP_MEMORY_SCOPE_AGENT);
        __syncthreads();
        const int c0 = *qslot;
        if (c0 >= U_EXP) break;
        exp_range(a, lds, ql, c0, c0 + 2);
    }
    __syncthreads();
}

__device__ __forceinline__ void p0_prologue(AP a, unsigned char* lds) {
    const int tid = tid_opaque();
    bool have_tab = false;
    constexpr int E0 = U_ADA, E1 = E0 + U_WIN, E2 = E1 + U_WOUT, E3 = E2 + U_SGU, E4 = E3 + U_DFT, E5 = E4 + U_ROPE;
    int u = blockIdx.x;
    for (; u < E5; u += gridDim.x) {
        if (u < E0) ada_unit(a, lds, u);
        else if (u < E1) win_unit(a, lds, u - E0);
        else if (u < E2) wout_unit(a, lds, u - E1);
        else if (u < E3) { const size_t i0 = (size_t)(u - E2) * 4096 + tid * 8; const float* s = a->in[11] + i0; bf16_t* d = (bf16_t*)(a->ws + WS_WSGU) + i0;
            const f32x4 v0 = *(const f32x4*)s, v1 = *(const f32x4*)(s + 4); u32x4 w; w.x = pack2(v0[0], v0[1]); w.y = pack2(v0[2], v0[3]); w.z = pack2(v1[0], v1[1]); w.w = pack2(v1[2], v1[3]); *(u32x4*)d = w; }
        else if (u < E4) {
            float* ctab = (float*)(lds + LDS_CTAB);
            if (!have_tab) { for (int i = tid; i < 4096; i += NT) ctab[i] = cospif((float)i / 2048.0f); __syncthreads(); have_tab = true; }
            const int k = u - E3 + 4096;
            if (tid < 32) {
                const int kk = k - 4096, n0 = tid * 8; float c[8], s[8];
#pragma unroll
                for (int e = 0; e < 8; ++e) { const int idx = ((kk * (n0 + e)) & 255) * 16; c[e] = ctab[idx] * (1.0f / 16.0f); s[e] = ctab[(idx - 1024) & 4095] * (1.0f / 16.0f); }
                bf16_t* d = (bf16_t*)(a->ws + WS_DFTC) + (size_t)kk * 512 + n0;
                u32x4 w; w.x = pack2(c[0], c[1]); w.y = pack2(c[2], c[3]); w.z = pack2(c[4], c[5]); w.w = pack2(c[6], c[7]); *(u32x4*)d = w;
                w.x = pack2(s[0], s[1]); w.y = pack2(s[2], s[3]); w.z = pack2(s[4], s[5]); w.w = pack2(s[6], s[7]); *(u32x4*)(d + 256) = w;
            }
        }
        else {
            for (int i = tid; i < 1024; i += NT) { const int pos = i >> 4, f = i & 15; const float freq = powf(10000.0f, -(float)f / 16.0f); const float ang = (float)pos * freq;
                ((float2*)(a->ws + WS_ROPE))[i] = make_float2(cosf(ang), sinf(ang)); }
        }
    }
}

__device__ __forceinline__ void p_lnmod0(AP a) {
    const int tid = tid_opaque(), lane = tid & 63, w = tid >> 6;
    const float* mod = (const float*)(a->ws + WS_MOD);
    bf16_t* H = (bf16_t*)(a->ws + WS_H);
    const int tstep = gridDim.x * 8;
    f32x4 nx[4];
    { const int t = blockIdx.x * 8 + w; if (t < NTOK) { const float* src = (t < NLAT) ? a->in[0] + (size_t)t * D : a->in[2] + (size_t)(t - NLAT) * D;
#pragma unroll
        for (int i = 0; i < 4; ++i) nx[i] = *(const f32x4*)(src + 256 * i + 4 * lane); } }
    int mrow = -1; f32x4 msh[4], msc[4];
    for (int t = blockIdx.x * 8 + w; t < NTOK; t += tstep) {
        const int mr = (t < NLAT) ? (t >> 12) : 4;
        if (mr != mrow) { mrow = mr; const float* m = mod + (size_t)mr * 6144;
#pragma unroll
            for (int i = 0; i < 4; ++i) { msh[i] = *(const f32x4*)(m + 256 * i + 4 * lane); msc[i] = *(const f32x4*)(m + 1024 + 256 * i + 4 * lane); } }
        f32x4 v[4];
#pragma unroll
        for (int i = 0; i < 4; ++i) v[i] = nx[i];
        { const int tn = t + tstep; if (tn < NTOK) { const float* src = (tn < NLAT) ? a->in[0] + (size_t)tn * D : a->in[2] + (size_t)(tn - NLAT) * D;
#pragma unroll
            for (int i = 0; i < 4; ++i) nx[i] = *(const f32x4*)(src + 256 * i + 4 * lane); } }
        float mean, rstd; ln_stats(v, mean, rstd);
#pragma unroll
        for (int i = 0; i < 4; ++i) { const int c = 256 * i + 4 * lane;
            f32x4 o;
#pragma unroll
            for (int e = 0; e < 4; ++e) o[e] = (v[i][e] - mean) * rstd * (1.0f + msc[i][e]) + msh[i][e];
            u32x2 pk; pk.x = pack2(o[0], o[1]); pk.y = pack2(o[2], o[3]); *(u32x2*)(H + (size_t)t * D + c) = pk; }
    }
}

__device__ __forceinline__ void p1_inproj(AP a, unsigned char* smem, LAS unsigned char* lds, int l);
__device__ __forceinline__ void rope32(float (&t)[32], const float2* tab) {
#pragma unroll
    for (int f = 0; f < 16; ++f) { const float2 cs = tab[f]; const float t1 = t[f], t2 = t[16 + f]; t[f] = t1 * cs.x - t2 * cs.y; t[16 + f] = t1 * cs.y + t2 * cs.x; }
}
__device__ __forceinline__ void load32(float (&t)[32], const bf16_t* p) {
#pragma unroll
    for (int q = 0; q < 4; ++q) { const u32x4 w = *(const u32x4*)(p + 8 * q);
        t[8 * q + 0] = lo2f(w.x); t[8 * q + 1] = hi2f(w.x); t[8 * q + 2] = lo2f(w.y); t[8 * q + 3] = hi2f(w.y);
        t[8 * q + 4] = lo2f(w.z); t[8 * q + 5] = hi2f(w.z); t[8 * q + 6] = lo2f(w.w); t[8 * q + 7] = hi2f(w.w); }
}

__device__ __forceinline__ float kdot(const bf16_t* kp, const bf16_t* q, const float2* tab0, const float2* tab1, bool do_rope) {
    float dot = 0.f;
#pragma unroll 1
    for (int ax = 0; ax < 2; ++ax) {
        const float2* tab = ax ? tab1 : tab0;
#pragma unroll 1
        for (int h8 = 0; h8 < 2; ++h8) {
            const u32x4 wl = *(const u32x4*)(kp + ax * 32 + h8 * 8), wh = *(const u32x4*)(kp + ax * 32 + 16 + h8 * 8);
            const float tl[8] = {lo2f(wl.x), hi2f(wl.x), lo2f(wl.y), hi2f(wl.y), lo2f(wl.z), hi2f(wl.z), lo2f(wl.w), hi2f(wl.w)};
            const float th[8] = {lo2f(wh.x), hi2f(wh.x), lo2f(wh.y), hi2f(wh.y), lo2f(wh.z), hi2f(wh.z), lo2f(wh.w), hi2f(wh.w)};
#pragma unroll
            for (int j = 0; j < 8; ++j) {
                float r1 = tl[j], r2 = th[j];
                if (do_rope) { const float2 cs = tab[h8 * 8 + j]; r1 = tl[j] * cs.x - th[j] * cs.y; r2 = tl[j] * cs.y + th[j] * cs.x; }
                dot += bf2f(q[ax * 32 + h8 * 8 + j]) * r1 + bf2f(q[ax * 32 + 16 + h8 * 8 + j]) * r2;
            }
        }
    }
    return dot;
}

__device__ __forceinline__ void mixer_tile(AP a, unsigned char* lds, int l, int row0, int seq_row0, int pos0, int n, int b, bool is_ctx) {
    const int tid = tid_opaque(), lane = tid & 63, w = tid >> 6;
    const bf16_t* Z = (const bf16_t*)(a->ws + WS_Z);
    bf16_t* CAT = (bf16_t*)(a->ws + WS_CAT);
    {
        const int c = tid & 255, half = tid >> 8, g = c >> 6, hw = 1 << g;
        for (int tl = half * 64; tl < half * 64 + 64; ++tl) {
            const int pos = pos0 + tl; const int lo = max(pos - hw, 0), hi = min(pos + hw, n);
            float s = 0.f; for (int j = lo; j < hi; ++j) s += bf2f(Z[(size_t)(seq_row0 + j) * ZC + 1024 + c]);
            const float self = bf2f(Z[(size_t)(seq_row0 + pos) * ZC + 1024 + c]);
            CAT[(size_t)(row0 + tl) * D + 512 + c] = f2bf(s / (float)(hi - lo) - self);
        }
    }
    bf16_t* vT = (bf16_t*)lds;
    for (int q = w; q < 128; q += 8) {
        const u32x2 gw = *(const u32x2*)(Z + (size_t)(row0 + q) * ZC + 1536 + 4 * lane);
        float gv[4] = {gelu_erf(lo2f(gw.x)), gelu_erf(hi2f(gw.x)), gelu_erf(lo2f(gw.y)), gelu_erf(hi2f(gw.y))};
        float s = wave_sum((gv[0] + gv[1]) + (gv[2] + gv[3])); const float mean = s * (1.0f / 256.0f);
        float qq = 0.f;
#pragma unroll
        for (int e = 0; e < 4; ++e) { const float d = gv[e] - mean; qq += d * d; }
        qq = wave_sum(qq); const float rstd = 1.0f / sqrtf(qq * (1.0f / 256.0f) + 1e-6f);
#pragma unroll
        for (int e = 0; e < 4; ++e) vT[(4 * lane + e) * 128 + q] = f2bf((gv[e] - mean) * rstd);
    }
    __syncthreads();
    {
        const int c = tid & 255, ph = tid >> 8, h = c >> 6;
        const bf16_t* Ws = (const bf16_t*)(a->ws + WS_WSGU) + (size_t)(l * 4 + h) * 128 * 128;
        const float* bs = a->in[12] + (size_t)(l * 4 + h) * 128;
        for (int p = ph * 64; p < ph * 64 + 64; ++p) {
            float s = 0.f;
#pragma unroll 2
            for (int q8 = 0; q8 < 16; ++q8) {
                const u32x4 ww = *(const u32x4*)(Ws + (size_t)p * 128 + q8 * 8);
                const u32x4 vv = *(const u32x4*)(vT + c * 128 + q8 * 8);
                s += lo2f(ww.x) * lo2f(vv.x) + hi2f(ww.x) * hi2f(vv.x) + lo2f(ww.y) * lo2f(vv.y) + hi2f(ww.y) * hi2f(vv.y)
                   + lo2f(ww.z) * lo2f(vv.z) + hi2f(ww.z) * hi2f(vv.z) + lo2f(ww.w) * lo2f(vv.w) + hi2f(ww.w) * hi2f(vv.w);
            }
            const float uv = gelu_erf(bf2f(Z[(size_t)(row0 + p) * ZC + 1280 + c]));
            CAT[(size_t)(row0 + p) * D + 768 + c] = f2bf(uv * (s + bs[p]));
        }
    }
    __syncthreads();
    {
        const int i = tid & 127, h = tid >> 7, kvh = h >> 1;
        const float2* rope = (const float2*)(a->ws + WS_ROPE);
        const int qpos = pos0 + i;
        bf16_t* q = (bf16_t*)lds + tid * 66;
        {
            float t0[32];
            load32(t0, Z + (size_t)(row0 + i) * ZC + 512 + h * 64);
            if (!is_ctx) rope32(t0, rope + (qpos >> 6) * 16);
#pragma unroll
            for (int d = 0; d < 32; ++d) q[d] = f2bf(t0[d]);
            load32(t0, Z + (size_t)(row0 + i) * ZC + 512 + h * 64 + 32);
            if (!is_ctx) rope32(t0, rope + (qpos & 63) * 16);
#pragma unroll
            for (int d = 0; d < 32; ++d) q[32 + d] = f2bf(t0[d]);
        }
#pragma unroll 1
        for (int dh = 0; dh < 2; ++dh) {
        float m = a->in[8][l * 4 + h], den = 1.0f;
        float o[32];
#pragma unroll
        for (int d = 0; d < 32; ++d) o[d] = 0.f;
        if (!is_ctx) {
            const bf16_t* VT = (const bf16_t*)(a->ws + WS_VT) + ((size_t)(b * 2 + kvh) * 64 + dh * 32) * 4096;
            const int slo = max(qpos - 128, 0), shi = min(qpos + 128, n - 1);
#pragma unroll 1
            for (int s = slo; s <= shi; ++s) {
                const float dot = 0.125f * kdot(Z + (size_t)(seq_row0 + s) * ZC + 768 + kvh * 64, q, rope + (s >> 6) * 16, rope + (s & 63) * 16, true);
                const float mn = fmaxf(m, dot), corr = __expf(m - mn), p = __expf(dot - mn);
                den = den * corr + p; m = mn;
#pragma unroll
                for (int d = 0; d < 32; ++d) o[d] = o[d] * corr + p * bf2f(VT[(size_t)d * 4096 + s]);
            }
        }
        {
            const bf16_t* VTC = (const bf16_t*)(a->ws + WS_VTC) + ((size_t)(b * 2 + kvh) * 64 + dh * 32) * 256;
#pragma unroll 1
            for (int j = 0; j < 256; ++j) {
                const float dot = 0.125f * kdot(Z + (size_t)(NLAT + b * 256 + j) * ZC + 768 + kvh * 64, q, rope, rope, false);
                const float mn = fmaxf(m, dot), corr = __expf(m - mn), p = __expf(dot - mn);
                den = den * corr + p; m = mn;
#pragma unroll
                for (int d = 0; d < 32; ++d) o[d] = o[d] * corr + p * bf2f(VTC[(size_t)d * 256 + j]);
            }
        }
        const float inv = 1.0f / den;
        bf16_t* dst = CAT + (size_t)(row0 + i) * D + 256 + h * 64 + dh * 32;
#pragma unroll
        for (int d8 = 0; d8 < 4; ++d8) { u32x4 pk; pk.x = pack2(o[8 * d8] * inv, o[8 * d8 + 1] * inv); pk.y = pack2(o[8 * d8 + 2] * inv, o[8 * d8 + 3] * inv);
            pk.z = pack2(o[8 * d8 + 4] * inv, o[8 * d8 + 5] * inv); pk.w = pack2(o[8 * d8 + 6] * inv, o[8 * d8 + 7] * inv); *(u32x4*)(dst + 8 * d8) = pk; }
        }
    }
    __syncthreads();
}

__device__ __forceinline__ u32x4 ld16g(const bf16_t* p) { return *(const u32x4*)p; }
__device__ __forceinline__ void rope_pack8(u32x4& wl, u32x4& wh, const LAS f32x2* tab, bool do_rope, float scale) {
    float tl[8] = {lo2f(wl.x), hi2f(wl.x), lo2f(wl.y), hi2f(wl.y), lo2f(wl.z), hi2f(wl.z), lo2f(wl.w), hi2f(wl.w)};
    float th[8] = {lo2f(wh.x), hi2f(wh.x), lo2f(wh.y), hi2f(wh.y), lo2f(wh.z), hi2f(wh.z), lo2f(wh.w), hi2f(wh.w)};
#pragma unroll
    for (int j = 0; j < 8; ++j) {
        float r1 = tl[j], r2 = th[j];
        if (do_rope) { const f32x2 cs = tab[j]; r1 = tl[j] * cs.x - th[j] * cs.y; r2 = tl[j] * cs.y + th[j] * cs.x; }
        tl[j] = r1 * scale; th[j] = r2 * scale;
    }
    wl.x = pack2(tl[0], tl[1]); wl.y = pack2(tl[2], tl[3]); wl.z = pack2(tl[4], tl[5]); wl.w = pack2(tl[6], tl[7]);
    wh.x = pack2(th[0], th[1]); wh.y = pack2(th[2], th[3]); wh.z = pack2(th[4], th[5]); wh.w = pack2(th[6], th[7]);
}

__device__ __forceinline__ void mixer_sgu_pool(AP a, LAS unsigned char* lds, int l, int row0, int seq_row0, int pos0, int n) {
    const int tid = tid_opaque(), lane = tid & 63, w = __builtin_amdgcn_readfirstlane(tid >> 6), fr = lane & 15, g = lane >> 4;
    const bf16_t* Z = (const bf16_t*)(a->ws + WS_Z);
    bf16_t* CAT = (bf16_t*)(a->ws + WS_CAT);
    {
#pragma unroll
        for (int it = 0; it < 9; ++it) { const int id = tid + 512 * it, rr = id >> 5, ch = id & 31, j = pos0 - 8 + rr;
            u32x4 v = (u32x4){0u, 0u, 0u, 0u};
            if (j >= 0 && j < n) v = ld16g(Z + (size_t)(seq_row0 + j) * ZC + 1024 + ch * 8);
            *(LAS u32x4*)(lds + rr * 512 + ch * 16) = v; }
        __syncthreads();
        const int c = tid & 255, half = tid >> 8, hw = 1 << (c >> 6);
        const LAS bf16_t* P = (const LAS bf16_t*)lds + c;
        const int t0 = half * 64;
        float s = 0.f;
        for (int j = t0 - hw; j < t0 + hw; ++j) s += bf2f(P[(8 + j) * 256]);
        for (int tl = t0; tl < t0 + 64; ++tl) {
            const int pos = pos0 + tl; const int lo = max(pos - hw, 0), hi = min(pos + hw, n);
            CAT[(size_t)(row0 + tl) * D + 512 + c] = f2bf(s / (float)(hi - lo) - bf2f(P[(8 + tl) * 256]));
            s += bf2f(P[(8 + tl + hw) * 256]) - bf2f(P[(8 + tl - hw) * 256]);
        }
        __syncthreads();
    }
    {
        const int i16 = lane & 15;
        u32x4 gw[4][2];
#pragma unroll
        for (int ps = 0; ps < 4; ++ps) { const int q = w * 16 + ps * 4 + g; const bf16_t* src = Z + (size_t)(row0 + q) * ZC + 1536 + 16 * i16; gw[ps][0] = ld16g(src); gw[ps][1] = ld16g(src + 8); }
#pragma unroll
        for (int ps = 0; ps < 4; ++ps) {
            const int q = w * 16 + ps * 4 + g;
            float gv[16];
#pragma unroll
            for (int hh = 0; hh < 2; ++hh) { const u32x4 x = gw[ps][hh];
                gv[8 * hh + 0] = gelu_erf(lo2f(x.x)); gv[8 * hh + 1] = gelu_erf(hi2f(x.x)); gv[8 * hh + 2] = gelu_erf(lo2f(x.y)); gv[8 * hh + 3] = gelu_erf(hi2f(x.y));
                gv[8 * hh + 4] = gelu_erf(lo2f(x.z)); gv[8 * hh + 5] = gelu_erf(hi2f(x.z)); gv[8 * hh + 6] = gelu_erf(lo2f(x.w)); gv[8 * hh + 7] = gelu_erf(hi2f(x.w)); }
            float sm = 0.f;
#pragma unroll
            for (int e = 0; e < 16; ++e) sm += gv[e];
            const float mean = row_sum16(sm) * (1.0f / 256.0f);
            float qq = 0.f;
#pragma unroll
            for (int e = 0; e < 16; ++e) { const float d = gv[e] - mean; qq += d * d; }
            const float rstd = 1.0f / sqrtf(row_sum16(qq) * (1.0f / 256.0f) + 1e-6f);
#pragma unroll
            for (int e = 0; e < 16; ++e) { const int c = 16 * i16 + e; *(LAS bf16_t*)(lds + c * 256 + ((((q >> 3) ^ (c & 15))) << 4) + (q & 7) * 2) = f2bf((gv[e] - mean) * rstd); }
        }
    }
    __syncthreads();
    {
        const int h = w >> 1, ph = w & 1;
        const bf16_t* Ws = (const bf16_t*)(a->ws + WS_WSGU) + (size_t)(l * 4 + h) * 128 * 128;
        const float* bs = a->in[12] + (size_t)(l * 4 + h) * 128;
        f32x4 acc[4][4];
#pragma unroll
        for (int i = 0; i < 4; ++i)
#pragma unroll
            for (int j = 0; j < 4; ++j) acc[i][j] = (f32x4){0.f, 0.f, 0.f, 0.f};
#pragma unroll
        for (int ks = 0; ks < 4; ++ks) {
            bf16x8 af[4], bfv[4];
#pragma unroll
            for (int cf = 0; cf < 4; ++cf) { const int c = h * 64 + 16 * cf + fr; af[cf] = *(const LAS bf16x8*)(lds + c * 256 + (((4 * ks + g) ^ (c & 15)) << 4)); }
#pragma unroll
            for (int pf = 0; pf < 4; ++pf) { const int p = ph * 64 + 16 * pf + fr; bfv[pf] = *(const bf16x8*)(Ws + (size_t)p * 128 + 32 * ks + 8 * g); }
#pragma unroll
            for (int cf = 0; cf < 4; ++cf)
#pragma unroll
                for (int pf = 0; pf < 4; ++pf) acc[cf][pf] = __builtin_amdgcn_mfma_f32_16x16x32_bf16(af[cf], bfv[pf], acc[cf][pf], 0, 0, 0);
        }
#pragma unroll
        for (int pf = 0; pf < 4; ++pf) { const int p = ph * 64 + 16 * pf + fr; const float bias = bs[p];
#pragma unroll
            for (int cf = 0; cf < 4; ++cf) { const int c0 = h * 64 + 16 * cf + 4 * g;
                const u32x2 uw = *(const u32x2*)(Z + (size_t)(row0 + p) * ZC + 1280 + c0);
                u32x2 o; o.x = pack2(gelu_erf(lo2f(uw.x)) * (acc[cf][pf][0] + bias), gelu_erf(hi2f(uw.x)) * (acc[cf][pf][1] + bias));
                o.y = pack2(gelu_erf(lo2f(uw.y)) * (acc[cf][pf][2] + bias), gelu_erf(hi2f(uw.y)) * (acc[cf][pf][3] + bias));
                *(u32x2*)(CAT + (size_t)(row0 + p) * D + 768 + c0) = o; } }
    }
    __syncthreads();
}

__device__ __forceinline__ void mixer_attn(AP a, LAS unsigned char* lds, int l, int row0, int seq_row0, int pos0, int n, int b, bool is_ctx, int kvh) {
    const int tid = tid_opaque(), lane = tid & 63, w = __builtin_amdgcn_readfirstlane(tid >> 6), fr = lane & 15, g = lane >> 4;
    const bf16_t* Z = (const bf16_t*)(a->ws + WS_Z);
    bf16_t* CAT = (bf16_t*)(a->ws + WS_CAT);
    __syncthreads();
    ((LAS u32x4*)(lds + 98304))[tid] = ((const u32x4*)(a->ws + WS_ROPE))[tid];
    const LAS f32x2* rope = (const LAS f32x2*)(lds + 98304);
    constexpr float QS = 0.125f * 1.44269504088896341f;
    constexpr int QS_OFF = 0, KS_OFF = 32768, VS_OFF = 65536;
    const int nbq = pos0 >> 7;
    unsigned bmask = 0x18u;
    if (!is_ctx) { if (nbq > 0) bmask |= 1u; bmask |= 2u; if (nbq + 1 < (n >> 7)) bmask |= 4u; }
    const int kr = tid >> 2, kax = (tid >> 1) & 1, kh8 = tid & 1;
#define MX_KSRC(blk) (Z + (size_t)((((blk) < 3) ? seq_row0 + (nbq + (blk) - 1) * 128 : NLAT + b * 256 + ((blk) - 3) * 128) + kr) * ZC + 768 + kvh * 64 + kax * 32 + kh8 * 8)
#define MX_VSTAGE(blk, buf) do { const bool _band = (blk) < 3; const int _key0 = _band ? (nbq + (blk) - 1) * 128 : ((blk) - 3) * 128; \
        const bf16_t* _vs = _band ? (const bf16_t*)(a->ws + WS_VT) + (size_t)(b * 2 + kvh) * 64 * 4096 + _key0 : (const bf16_t*)(a->ws + WS_VTC) + (size_t)(b * 2 + kvh) * 64 * 256 + _key0; \
        const int _vld = _band ? 4096 : 256; \
        _Pragma("unroll") for (int _i = 0; _i < 2; ++_i) { const int _P = _i * 512 + tid, _d = _P >> 4, _c = (_P & 15) ^ (_d & 15); \
            glds16(_vs + (size_t)_d * _vld + _c * 8, lds + VS_OFF + (buf) * 16384 + _i * 8192 + w * 1024); } } while (0)
    {
        __syncthreads();
#pragma unroll
        for (int it = 0; it < 2; ++it) {
            const int item = tid + 512 * it, r = item >> 2, ax = (item >> 1) & 1, h8 = item & 1, i = r & 127, qpos = pos0 + i;
            const bf16_t* src = Z + (size_t)(row0 + i) * ZC + 512 + (2 * kvh + (r >> 7)) * 64 + ax * 32 + h8 * 8;
            u32x4 wl = ld16g(src), wh = ld16g(src + 16);
            rope_pack8(wl, wh, rope + (ax ? (qpos & 63) : (qpos >> 6)) * 16 + h8 * 8, !is_ctx, QS);
            const int ch = ax * 4 + h8, sw = (r >> 1) & 7;
            *(LAS u32x4*)(lds + QS_OFF + r * 128 + ((ch ^ sw) << 4)) = wl;
            *(LAS u32x4*)(lds + QS_OFF + r * 128 + (((ch + 2) ^ sw) << 4)) = wh;
        }
        const int hh = w >> 2, qb = (w & 3) * 32, h = 2 * kvh + hh;
        float m[2], lsum[2];
        m[0] = m[1] = a->in[8][l * 4 + h] * 1.44269504088896341f;
        lsum[0] = lsum[1] = (g == 0) ? 1.0f : 0.0f;
        f32x4 O[4][2];
#pragma unroll
        for (int i = 0; i < 4; ++i) { O[i][0] = (f32x4){0.f, 0.f, 0.f, 0.f}; O[i][1] = (f32x4){0.f, 0.f, 0.f, 0.f}; }
        bf16x8 Qf[2][2];
        bool have_q = false;
        unsigned rem = bmask;
        int cur = __builtin_ctz(rem); rem &= rem - 1u;
        int buf = 0;
        u32x4 kl = ld16g(MX_KSRC(cur)), kh = ld16g(MX_KSRC(cur) + 16);
        MX_VSTAGE(cur, 0);
#pragma unroll 1
        for (;;) {
            const int jb = cur - 1; const bool band = cur < 3;
            {
                const int kpos = (nbq + jb) * 128 + kr;
                rope_pack8(kl, kh, rope + (kax ? (kpos & 63) : (kpos >> 6)) * 16 + kh8 * 8, band, 1.0f);
                const int ch = kax * 4 + kh8, sw = (kr >> 1) & 7;
                *(LAS u32x4*)(lds + KS_OFF + buf * 16384 + kr * 128 + ((ch ^ sw) << 4)) = kl;
                *(LAS u32x4*)(lds + KS_OFF + buf * 16384 + kr * 128 + (((ch + 2) ^ sw) << 4)) = kh;
            }
            asm volatile("s_waitcnt vmcnt(0)" ::: "memory");
            __syncthreads();
            const int nxt = rem ? __builtin_ctz(rem) : -1; rem &= rem - 1u;
            if (nxt >= 0) { kl = ld16g(MX_KSRC(nxt)); kh = ld16g(MX_KSRC(nxt) + 16); MX_VSTAGE(nxt, buf ^ 1); }
            if (!have_q) {
#pragma unroll
                for (int qf = 0; qf < 2; ++qf)
#pragma unroll
                    for (int ks = 0; ks < 2; ++ks) { const int r = hh * 128 + qb + 16 * qf + fr; Qf[qf][ks] = *(const LAS bf16x8*)(lds + QS_OFF + r * 128 + (((4 * ks + g) ^ ((r >> 1) & 7)) << 4)); }
                have_q = true;
            }
            const int kso = KS_OFF + buf * 16384, vso = VS_OFF + buf * 16384;
            f32x4 S[8][2];
#pragma unroll
            for (int kf = 0; kf < 8; ++kf) { S[kf][0] = (f32x4){0.f, 0.f, 0.f, 0.f}; S[kf][1] = (f32x4){0.f, 0.f, 0.f, 0.f}; }
#pragma unroll
            for (int kf = 0; kf < 8; ++kf)
#pragma unroll
                for (int ks = 0; ks < 2; ++ks) { const int r = 16 * kf + fr;
                    const bf16x8 kfr = *(const LAS bf16x8*)(lds + kso + r * 128 + (((4 * ks + g) ^ ((r >> 1) & 7)) << 4));
                    S[kf][0] = __builtin_amdgcn_mfma_f32_16x16x32_bf16(kfr, Qf[0][ks], S[kf][0], 0, 0, 0);
                    S[kf][1] = __builtin_amdgcn_mfma_f32_16x16x32_bf16(kfr, Qf[1][ks], S[kf][1], 0, 0, 0); }
            bf16x8 Pp[4][2];
#pragma unroll
            for (int qf = 0; qf < 2; ++qf) {
                const int qi = qb + 16 * qf + fr;
                if (band && jb != 0) {
#pragma unroll
                    for (int kf = 0; kf < 8; ++kf)
#pragma unroll
                        for (int r = 0; r < 4; ++r) { const int kk = 16 * kf + 4 * g + r; const bool ok = (jb < 0) ? (kk >= qi) : (kk <= qi); if (!ok) S[kf][qf][r] = -1.0e30f; }
                }
                float mx = S[0][qf][0];
#pragma unroll
                for (int kf = 0; kf < 8; ++kf)
#pragma unroll
                    for (int r = 0; r < 4; ++r) mx = fmaxf(mx, S[kf][qf][r]);
                mx = fmaxf(mx, __shfl_xor(mx, 16)); mx = fmaxf(mx, __shfl_xor(mx, 32));
                const float mn = fmaxf(m[qf], mx), corr = __builtin_amdgcn_exp2f(m[qf] - mn);
                m[qf] = mn;
                float ps = 0.f;
#pragma unroll
                for (int kf = 0; kf < 8; ++kf)
#pragma unroll
                    for (int r = 0; r < 4; ++r) { const float p = __builtin_amdgcn_exp2f(S[kf][qf][r] - mn); S[kf][qf][r] = p; ps += p; }
                lsum[qf] = lsum[qf] * corr + ps;
#pragma unroll
                for (int df = 0; df < 4; ++df) O[df][qf] *= corr;
#pragma unroll
                for (int t = 0; t < 4; ++t) { u32x4 pw; pw.x = pack2(S[2 * t][qf][0], S[2 * t][qf][1]); pw.y = pack2(S[2 * t][qf][2], S[2 * t][qf][3]);
                    pw.z = pack2(S[2 * t + 1][qf][0], S[2 * t + 1][qf][1]); pw.w = pack2(S[2 * t + 1][qf][2], S[2 * t + 1][qf][3]); Pp[t][qf] = __builtin_bit_cast(bf16x8, pw); }
            }
#pragma unroll
            for (int t = 0; t < 4; ++t)
#pragma unroll
                for (int df = 0; df < 4; ++df) { const int d = 16 * df + fr;
                    const u32x2 v0 = *(const LAS u32x2*)(lds + vso + d * 256 + (((4 * t + (g >> 1)) ^ (d & 15)) << 4) + (g & 1) * 8);
                    const u32x2 v1 = *(const LAS u32x2*)(lds + vso + d * 256 + (((4 * t + 2 + (g >> 1)) ^ (d & 15)) << 4) + (g & 1) * 8);
                    u32x4 vw; vw.x = v0.x; vw.y = v0.y; vw.z = v1.x; vw.w = v1.y; const bf16x8 vf = __builtin_bit_cast(bf16x8, vw);
                    O[df][0] = __builtin_amdgcn_mfma_f32_16x16x32_bf16(vf, Pp[t][0], O[df][0], 0, 0, 0);
                    O[df][1] = __builtin_amdgcn_mfma_f32_16x16x32_bf16(vf, Pp[t][1], O[df][1], 0, 0, 0); }
            if (nxt < 0) break;
            cur = nxt; buf ^= 1;
        }
#pragma unroll
        for (int qf = 0; qf < 2; ++qf) {
            float lt = lsum[qf]; lt += __shfl_xor(lt, 16); lt += __shfl_xor(lt, 32);
            const float inv = 1.0f / lt;
            bf16_t* dst = CAT + (size_t)(row0 + qb + 16 * qf + fr) * D + 256 + h * 64 + 4 * g;
#pragma unroll
            for (int df = 0; df < 4; ++df) { u32x2 o; o.x = pack2(O[df][qf][0] * inv, O[df][qf][1] * inv); o.y = pack2(O[df][qf][2] * inv, O[df][qf][3] * inv); *(u32x2*)(dst + 16 * df) = o; }
        }
    }
#undef MX_KSRC
#undef MX_VSTAGE
    __syncthreads();
}

constexpr int FF_DA = 0, FF_DC = 32768, FF_TW = 49152, FF_XT = 65536, FF_Z2 = 81920, FF_OB = 98304;
__device__ __forceinline__ int ff_addr(int row, int k) { return row * 256 + ((((k >> 3) ^ (row & 15))) << 4) + (k & 7) * 2; }
__device__ __forceinline__ void fft_setup(LAS unsigned char* lds) {
    const int tid = tid_opaque();
    LAS float* TW = (LAS float*)(lds + FF_TW);
    for (int i = tid; i < 4096; i += NT) TW[i] = cospif((float)i / 2048.0f);
    __syncthreads();
    for (int idx = tid; idx < 16384; idx += NT) { const int i = idx >> 7, k = idx & 127, ro = i >> 6, k1 = i & 63, part = k >> 6, n1 = k & 63, j = ((k1 * n1) & 63) * 64;
        const float c = TW[j], sn = TW[(j - 1024) & 4095];
        const float v = (ro == 0) ? (part == 0 ? c : sn) : (part == 0 ? -sn : c);
        *(LAS bf16_t*)(lds + FF_DA + ff_addr(i, k)) = f2bf(v * 0.125f); }
    for (int idx = tid; idx < 8192; idx += NT) { const int k2 = idx >> 7, k = idx & 127, ri = k >> 6, n2 = k & 63, j = ((k2 * n2) & 63) * 64;
        const float v = (ri == 0) ? TW[j] : TW[(j - 1024) & 4095];
        *(LAS bf16_t*)(lds + FF_DC + ff_addr(k2, k)) = f2bf(v * 0.125f); }
    __syncthreads();
}
__device__ __forceinline__ void fft_unit(AP a, LAS unsigned char* lds, int b, int cg) {
    const int tid = tid_opaque(), lane = tid & 63, w = __builtin_amdgcn_readfirstlane(tid >> 6), fr = lane & 15, g = lane >> 4;
    const LAS float* TW = (const LAS float*)(lds + FF_TW);
    const int mf = w & 3, nh = w >> 2;
    const bf16_t* AT = (const bf16_t*)(a->ws + WS_AT) + (size_t)(b * 256 + cg * 4) * 8192;
    u32x4 xin[2];
#pragma unroll
    for (int it = 0; it < 2; ++it) xin[it] = ld16g(AT + (size_t)(tid + 512 * it) * 8);
#pragma unroll 1
    for (int cl = 0; cl < 4; ++cl) {
#pragma unroll
        for (int it = 0; it < 2; ++it) { const int q = tid + 512 * it, part = q >> 9, pos0 = (q & 511) * 8, n1 = pos0 >> 6, n2 = pos0 & 63, k = part * 64 + n1;
            const unsigned wv[4] = {xin[it].x, xin[it].y, xin[it].z, xin[it].w};
#pragma unroll
            for (int e = 0; e < 4; ++e) { *(LAS bf16_t*)(lds + FF_XT + ff_addr(n2 + 2 * e, k)) = (bf16_t)(wv[e] & 0xffffu); *(LAS bf16_t*)(lds + FF_XT + ff_addr(n2 + 2 * e + 1, k)) = (bf16_t)(wv[e] >> 16); } }
        if (cl < 3) {
#pragma unroll
            for (int it = 0; it < 2; ++it) xin[it] = ld16g(AT + (size_t)(cl + 1) * 8192 + (size_t)(tid + 512 * it) * 8); }
        __syncthreads();
        f32x4 acc[2][2];
#pragma unroll
        for (int x = 0; x < 2; ++x) { acc[x][0] = (f32x4){0.f, 0.f, 0.f, 0.f}; acc[x][1] = (f32x4){0.f, 0.f, 0.f, 0.f}; }
#pragma unroll
        for (int ks = 0; ks < 4; ++ks) {
            bf16x8 af[2], bfv[2];
#pragma unroll
            for (int x = 0; x < 2; ++x) { const int i = 16 * (mf + 4 * x) + fr; af[x] = *(const LAS bf16x8*)(lds + FF_DA + i * 256 + (((4 * ks + g) ^ (i & 15)) << 4)); }
#pragma unroll
            for (int n = 0; n < 2; ++n) { const int j = 16 * (2 * nh + n) + fr; bfv[n] = *(const LAS bf16x8*)(lds + FF_XT + j * 256 + (((4 * ks + g) ^ (j & 15)) << 4)); }
#pragma unroll
            for (int x = 0; x < 2; ++x)
#pragma unroll
                for (int n = 0; n < 2; ++n) acc[x][n] = __builtin_amdgcn_mfma_f32_16x16x32_bf16(af[x], bfv[n], acc[x][n], 0, 0, 0);
        }
#pragma unroll
        for (int n = 0; n < 2; ++n)
#pragma unroll
            for (int r = 0; r < 4; ++r) { const int k1 = 16 * mf + 4 * g + r, n2 = 16 * (2 * nh + n) + fr, idx = (k1 * n2) & 4095;
                const float c = TW[idx], sn = TW[(idx - 1024) & 4095], zr = acc[0][n][r], zi = acc[1][n][r];
                *(LAS bf16_t*)(lds + FF_Z2 + ff_addr(k1, n2)) = f2bf(zr * c + zi * sn);
                *(LAS bf16_t*)(lds + FF_Z2 + ff_addr(k1, 64 + n2)) = f2bf(zi * c - zr * sn); }
        __syncthreads();
        f32x4 acc2[2] = {(f32x4){0.f, 0.f, 0.f, 0.f}, (f32x4){0.f, 0.f, 0.f, 0.f}};
#pragma unroll
        for (int ks = 0; ks < 4; ++ks) {
            const int i = 16 * mf + fr; const bf16x8 af = *(const LAS bf16x8*)(lds + FF_DC + i * 256 + (((4 * ks + g) ^ (i & 15)) << 4));
#pragma unroll
            for (int n = 0; n < 2; ++n) { const int j = 16 * (2 * nh + n) + fr; const bf16x8 bfv = *(const LAS bf16x8*)(lds + FF_Z2 + j * 256 + (((4 * ks + g) ^ (j & 15)) << 4));
                acc2[n] = __builtin_amdgcn_mfma_f32_16x16x32_bf16(af, bfv, acc2[n], 0, 0, 0); }
        }
#pragma unroll
        for (int n = 0; n < 2; ++n)
#pragma unroll
            for (int r = 0; r < 4; ++r) { const int k = 16 * (2 * nh + n) + fr + 64 * (16 * mf + 4 * g + r); *(LAS bf16_t*)(lds + FF_OB + k * 8 + cl * 2) = f2bf(acc2[n][r]); }
    }
    __syncthreads();
    bf16_t* CAT = (bf16_t*)(a->ws + WS_CAT) + (size_t)(b * 4096) * D + cg * 4;
#pragma unroll
    for (int it = 0; it < 8; ++it) { const int k = tid + 512 * it; *(u32x2*)(CAT + (size_t)k * D) = *(const LAS u32x2*)(lds + FF_OB + k * 8); }
    __syncthreads();
}

__device__ __forceinline__ void p2_mix(AP a, unsigned char* ldsg, LAS unsigned char* lds, int l) {
    const int n_tile = 128 + ((l == 0) ? 8 : 0), n_att = 2 * n_tile, n_dft = 256, n_dftc = (l == 0) ? 16 : 0;
    bf16_t* CAT = (bf16_t*)(a->ws + WS_CAT);
    bool fft_ready = false;
    for (int u = blockIdx.x; u < n_att + n_dft + n_tile + n_dftc; u += gridDim.x) {
        if (u < n_att || (u >= n_att + n_dft && u < n_att + n_dft + n_tile)) {
            const bool att = u < n_att;
            const int t = att ? (u >> 1) : (u - n_att - n_dft);
            const bool isc = t >= 128; const int tt = t - 128;
            const int b = isc ? (tt >> 1) : (t >> 5);
            const int row0 = isc ? NLAT + tt * 128 : t * 128, seq_row0 = isc ? NLAT + b * 256 : b * 4096, pos0 = isc ? (tt & 1) * 128 : (t & 31) * 128, n = isc ? 256 : 4096;
            if (att) { for (int rep = 0; rep < PROBE_MIX_REP; ++rep) mixer_attn(a, lds, l, row0, seq_row0, pos0, n, b, isc, u & 1); }
            else { for (int rep = 0; rep < PROBE_SGU_REP; ++rep) mixer_sgu_pool(a, lds, l, row0, seq_row0, pos0, n); }
            fft_ready = false;
        } else if (u < n_att + n_dft) {
            const int uu = u - n_att;
            if (!fft_ready) { fft_setup(lds); fft_ready = true; }
            for (int rep = 0; rep < PROBE_FFT_REP; ++rep) fft_unit(a, lds, uu >> 6, uu & 63);
        } else {
            const int uu = u - n_att - n_dft - n_tile, b = uu >> 2, mt = (uu >> 1) & 1, ch0 = (uu & 1) * 128;
            const bf16_t* A = (const bf16_t*)(a->ws + WS_DFTC) + (size_t)(mt * 128) * 512;
            const bf16_t* B0 = (const bf16_t*)(a->ws + WS_ATC) + ((size_t)b * 256 + ch0) * 512;
            EpiBf16 E; E.C = CAT + (size_t)(NLAT + b * 256 + mt * 128) * D + ch0; E.ld = D;
            gemm_tile<128, false, EpiBf16>(lds, A, 512, nullptr, 128, B0, B0 + (size_t)64 * 512, 512, 512, E);
            fft_ready = false;
        }
    }
    exp_queue(a, ldsg, l);
}

__device__ __forceinline__ int uni(int v) { return __builtin_amdgcn_readfirstlane(v); }
__device__ __forceinline__ int vblock() { const int G = gridDim.x, b = blockIdx.x; return (G % 8 == 0) ? (b % 8) * (G / 8) + b / 8 : b; }
template <class T> __device__ __forceinline__ T* unip(T* p) { const unsigned long long v = (unsigned long long)p; const unsigned lo = __builtin_amdgcn_readfirstlane((unsigned)v), hi = __builtin_amdgcn_readfirstlane((unsigned)(v >> 32)); return (T*)(((unsigned long long)hi << 32) | lo); }
struct SchedInProj {
    typedef EpiInProj Epi; static constexpr bool GATHER = false;
    unsigned char* ws; int l, G, me;
    __device__ __forceinline__ bool get(int i, g256::Unit<Epi>& u) const {
        const int n_lat = 64 * 7, n_ctx = (l == 0) ? 4 * 7 : 4;
        const int idx = i * G + me; if (idx >= n_lat + n_ctx) return false;
        int row0, b, ct, n; bf16_t *tF, *tV;
        if (idx < n_lat) { const int rt = idx / 7; ct = idx % 7; row0 = rt * 256; b = row0 >> 12; n = 4096;
            tF = (bf16_t*)(ws + WS_AT) + (size_t)b * 256 * 2 * 4096; tV = (bf16_t*)(ws + WS_VT) + (size_t)b * 128 * 4096; }
        else { const int uu = idx - n_lat; int rt; if (l == 0) { rt = uu / 7; ct = uu % 7; } else { rt = uu; ct = 3; }
            row0 = NLAT + rt * 256; b = rt; n = 256;
            tF = (bf16_t*)(ws + WS_ATC) + (size_t)b * 256 * 2 * 256; tV = (bf16_t*)(ws + WS_VTC) + (size_t)b * 128 * 256; }
        u.A = (const bf16_t*)(ws + WS_H) + (size_t)row0 * D;
        u.B0 = (const bf16_t*)(ws + WS_WIN) + ((size_t)l * ZC + ct * 256) * 1024; u.B1 = u.B0 + (size_t)128 * 1024; u.ridx = nullptr; u.valid = 256;
        u.epi.Zt = (bf16_t*)(ws + WS_Z) + (size_t)row0 * ZC + ct * 256; u.epi.tF = tF; u.epi.tV = tV; u.epi.n0 = ct * 256; u.epi.pos0 = (idx < n_lat) ? (row0 & 4095) : 0; u.epi.n = n;
        return true;
    }
};
struct SchedOutProj {
    typedef EpiBf16 Epi; static constexpr bool GATHER = false;
    unsigned char* ws; int l, G, me;
    __device__ __forceinline__ bool get(int i, g256::Unit<Epi>& u) const {
        const int nrt = NLAT / 256;
        const int idx = i * G + me; if (idx >= nrt * 4) return false;
        const int rt = idx >> 2, ct = idx & 3;
        u.A = (const bf16_t*)(ws + WS_CAT) + (size_t)(rt * 256) * D;
        u.B0 = (const bf16_t*)(ws + WS_WOUT) + ((size_t)l * 1024 + ct * 256) * 1024; u.B1 = u.B0 + (size_t)128 * 1024; u.ridx = nullptr; u.valid = 256;
        u.epi.C = (bf16_t*)(ws + WS_Y) + (size_t)(rt * 256) * D + ct * 256; u.epi.ld = D;
        return true;
    }
};
struct SchedGateUp {
    typedef EpiGateUp Epi; static constexpr bool GATHER = true;
    unsigned char* ws; const LAS int* blk; const LAS int* tot; const LAS int* ridx_lds; int G, me, l;
    __device__ __forceinline__ bool get(int i, g256::Unit<Epi>& u) const {
        const int idx = i * G + me; if (idx >= uni(blk[32]) * 4) return false;
        const int rb = idx >> 2, ct = idx & 3;
        int e = 0;
#pragma unroll 1
        for (int q = 1; q < 32; ++q) if (uni(blk[q]) <= rb) e = q;
        u.A = (const bf16_t*)(ws + WS_H);
        u.B0 = (const bf16_t*)(ws + WS_WEXP + (size_t)l * WEXP_LAYER) + ((size_t)e * 512 + ct * 128) * 1024; u.B1 = u.B0 + EXPMAT;
        u.ridx = ridx_lds + (i & 7) * 256; u.valid = uni(min(256, tot[e] - (rb - blk[e]) * 256));
        u.epi.C = (bf16_t*)(ws + WS_HID) + (size_t)(rb * 256) * DEXP + ct * 128; u.epi.ld = DEXP;
        return true;
    }
};
struct SchedDown {
    typedef EpiBf16 Epi; static constexpr bool GATHER = false;
    unsigned char* ws; const LAS int* blk; int G, me, l;
    __device__ __forceinline__ bool get(int i, g256::Unit<Epi>& u) const {
        const int idx = i * G + me; if (idx >= uni(blk[32]) * 4) return false;
        const int rb = idx >> 2, ct = idx & 3;
        int e = 0;
#pragma unroll 1
        for (int q = 1; q < 32; ++q) if (uni(blk[q]) <= rb) e = q;
        u.A = (const bf16_t*)(ws + WS_HID) + (size_t)(rb * 256) * DEXP;
        u.B0 = (const bf16_t*)(ws + WS_WEXP + (size_t)l * WEXP_LAYER) + 2 * EXPMAT + ((size_t)e * 1024 + ct * 256) * 512; u.B1 = u.B0 + (size_t)128 * 512; u.ridx = nullptr; u.valid = 256;
        u.epi.C = (bf16_t*)(ws + WS_YS) + (size_t)(rb * 256) * D + ct * 256; u.epi.ld = D;
        return true;
    }
};

__device__ __forceinline__ void p4_ln1_router(AP a, unsigned char* lds, int l) {
    const int tid = tid_opaque(), lane = tid & 63, w = tid >> 6;
    const int ntok = (l == 0) ? NTOK : NLAT;
    int* cnt = (int*)(lds + MISC_OFF);
    if (tid < 32) cnt[tid] = 0;
    f32x4* Lg = (f32x4*)lds; f32x4* Le = (f32x4*)(lds + 16384); f32x4* Lgb = (f32x4*)(lds + 147456);
    {
        const float* wrg_ = a->in[16] + (size_t)l * 1024 * 4; const float* wre_ = a->in[17] + (size_t)l * 1024 * 32;
#pragma unroll
        for (int it = 0; it < 2; ++it) { const int c = tid + 512 * it, slot = (((c >> 8) * 4 + (c & 3)) << 6) + ((c >> 2) & 63);
            Lg[slot] = *(const f32x4*)(wrg_ + (size_t)c * 4);
#pragma unroll
            for (int q = 0; q < 8; ++q) Le[q * 1024 + slot] = *(const f32x4*)(wre_ + (size_t)c * 32 + q * 4); }
        Lgb[tid] = (tid < 256) ? *(const f32x4*)(a->in[14] + l * 1024 + tid * 4) : *(const f32x4*)(a->in[15] + l * 1024 + (tid - 256) * 4);
    }
    __syncthreads();
    const float* mod = (const float*)(a->ws + WS_MOD) + (size_t)l * 5 * 6144;
    const bf16_t* Y = (const bf16_t*)(a->ws + WS_Y);
    float* X1 = (float*)(a->ws + WS_X1);
    bf16_t* H = (bf16_t*)(a->ws + WS_H);
    int* tokE = (int*)(a->ws + WS_TOKE); int* tokR = (int*)(a->ws + WS_TOKR); float* tokG = (float*)(a->ws + WS_TOKG);
    const int tstep = gridDim.x * 8;
    f32x4 nx[4]; u32x2 ny[4];
    {   const int t = blockIdx.x * 8 + w;
        if (t < ntok) { const float* xs = (l == 0) ? ((t < NLAT) ? a->in[0] + (size_t)t * D : a->in[2] + (size_t)(t - NLAT) * D) : (const float*)(a->ws + WS_XC) + (size_t)t * D;
#pragma unroll
            for (int i = 0; i < 4; ++i) { nx[i] = *(const f32x4*)(xs + 256 * i + 4 * lane); ny[i] = *(const u32x2*)(Y + (size_t)t * D + 256 * i + 4 * lane); } } }
    int mrow = -1; f32x4 mg[4], msh[4], msc[4];
    for (int t = blockIdx.x * 8 + w; t < ntok; t += tstep) {
        const int mr = (t < NLAT) ? (t >> 12) : 4;
        if (mr != mrow) { mrow = mr; const float* m = mod + (size_t)mr * 6144;
#pragma unroll
            for (int i = 0; i < 4; ++i) { const int c = 256 * i + 4 * lane; mg[i] = *(const f32x4*)(m + 2048 + c); msh[i] = *(const f32x4*)(m + 3072 + c); msc[i] = *(const f32x4*)(m + 4096 + c); } }
        f32x4 v[4];
#pragma unroll
        for (int i = 0; i < 4; ++i) { const f32x4 yv = (f32x4){lo2f(ny[i].x), hi2f(ny[i].x), lo2f(ny[i].y), hi2f(ny[i].y)};
#pragma unroll
            for (int e = 0; e < 4; ++e) v[i][e] = RES_ALPHA * nx[i][e] + mg[i][e] * yv[e]; }
        {   const int tn = t + tstep;
            if (tn < ntok) { const float* xs = (l == 0) ? ((tn < NLAT) ? a->in[0] + (size_t)tn * D : a->in[2] + (size_t)(tn - NLAT) * D) : (const float*)(a->ws + WS_XC) + (size_t)tn * D;
#pragma unroll
                for (int i = 0; i < 4; ++i) { nx[i] = *(const f32x4*)(xs + 256 * i + 4 * lane); ny[i] = *(const u32x2*)(Y + (size_t)tn * D + 256 * i + 4 * lane); } } }
        float mean, rstd; ln_stats(v, mean, rstd);
#pragma unroll
        for (int i = 0; i < 4; ++i) { const int c = 256 * i + 4 * lane; const f32x4 gg = Lgb[64 * i + lane], bb = Lgb[256 + 64 * i + lane];
#pragma unroll
            for (int e = 0; e < 4; ++e) v[i][e] = (v[i][e] - mean) * rstd * gg[e] + bb[e];
            *(f32x4*)(X1 + (size_t)t * D + c) = v[i]; }
        ln_stats(v, mean, rstd);
#pragma unroll
        for (int i = 0; i < 4; ++i) { const int c = 256 * i + 4 * lane; const f32x4 sh = msh[i], sc = msc[i];
#pragma unroll
            for (int e = 0; e < 4; ++e) v[i][e] = (v[i][e] - mean) * rstd * (1.0f + sc[e]) + sh[e];
            u32x2 pk; pk.x = pack2(v[i][0], v[i][1]); pk.y = pack2(v[i][2], v[i][3]); *(u32x2*)(H + (size_t)t * D + c) = pk; }
        float lg[4] = {0.f, 0.f, 0.f, 0.f};
#pragma unroll
        for (int i = 0; i < 4; ++i)
#pragma unroll
            for (int e = 0; e < 4; ++e) { const f32x4 wv = Lg[((i * 4 + e) << 6) + lane];
                lg[0] += v[i][e] * wv[0]; lg[1] += v[i][e] * wv[1]; lg[2] += v[i][e] * wv[2]; lg[3] += v[i][e] * wv[3]; }
#pragma unroll
        for (int q = 0; q < 4; ++q) lg[q] = wave_sum(lg[q]);
        int grp = 0; float mx = lg[0];
#pragma unroll
        for (int q = 1; q < 4; ++q) if (lg[q] > mx) { mx = lg[q]; grp = q; }
        float se = 0.f;
#pragma unroll
        for (int q = 0; q < 4; ++q) se += expf(lg[q] - mx);
        const float gate_group = 1.0f / se;
        float le[8] = {0.f, 0.f, 0.f, 0.f, 0.f, 0.f, 0.f, 0.f};
#pragma unroll
        for (int i = 0; i < 4; ++i)
#pragma unroll
            for (int e = 0; e < 4; ++e) { const f32x4* wp = Le + grp * 2048 + ((i * 4 + e) << 6) + lane; const f32x4 w0 = wp[0], w1 = wp[1024];
                le[0] += v[i][e] * w0[0]; le[1] += v[i][e] * w0[1]; le[2] += v[i][e] * w0[2]; le[3] += v[i][e] * w0[3];
                le[4] += v[i][e] * w1[0]; le[5] += v[i][e] * w1[1]; le[6] += v[i][e] * w1[2]; le[7] += v[i][e] * w1[3]; }
#pragma unroll
        for (int q = 0; q < 8; ++q) le[q] = wave_sum(le[q]);
        int j1 = 0; float l1 = le[0];
#pragma unroll
        for (int q = 1; q < 8; ++q) if (le[q] > l1) { l1 = le[q]; j1 = q; }
        int j2 = -1; float l2 = -3.0e38f;
#pragma unroll
        for (int q = 0; q < 8; ++q) if (q != j1 && le[q] > l2) { l2 = le[q]; j2 = q; }
        const float e2 = expf(l2 - l1), p1 = 1.0f / (1.0f + e2), p2 = e2 / (1.0f + e2);
        if (lane == 0) {
            const int ex0 = grp * 8 + j1, ex1 = grp * 8 + j2;
            const int r0 = atomicAdd(&cnt[ex0], 1), r1 = atomicAdd(&cnt[ex1], 1);
            tokE[2 * t] = ex0; tokE[2 * t + 1] = ex1; tokR[2 * t] = r0; tokR[2 * t + 1] = r1;
            tokG[2 * t] = gate_group * p1; tokG[2 * t + 1] = gate_group * p2;
        }
    }
    __syncthreads();
    if (tid < 32) ((int*)(a->ws + WS_BCNT))[((size_t)l * MAXG + blockIdx.x) * 32 + tid] = cnt[tid];
    __syncthreads();
}

__device__ __forceinline__ void p5_dispatch(AP a, unsigned char* lds, int l) {
    const int tid = tid_opaque();
    const int ntok = (l == 0) ? NTOK : NLAT;
    int* part = (int*)lds;
    int* tot = (int*)(lds + 4096);
    int* off = (int*)(lds + 4096 + 128);
    int* pstart = (int*)(lds + 4096 + 256);
    const int* bc = (const int*)(a->ws + WS_BCNT) + (size_t)l * MAXG * 32;
    const int G = gridDim.x, me = blockIdx.x;
    { const int e = tid & 31, p = tid >> 5; int s = 0, so = 0; for (int bb = p; bb < G; bb += 16) { const int c = bc[bb * 32 + e]; s += c; if (bb < me) so += c; } part[p * 32 + e] = s; part[512 + p * 32 + e] = so; }
    __syncthreads();
    if (tid < 32) { int s = 0, so = 0; for (int p = 0; p < 16; ++p) { s += part[p * 32 + tid]; so += part[512 + p * 32 + tid]; } tot[tid] = s; off[tid] = so; }
    __syncthreads();
    if (tid == 0) { int acc = 0; for (int e = 0; e < 32; ++e) { pstart[e] = acc; acc += ((tot[e] + 255) >> 8) << 8; } }
    __syncthreads();
    if (me == 0 && tid < 32) ((int*)(a->ws + WS_CNT))[l * 32 + tid] = tot[tid];
    const int* tokE = (const int*)(a->ws + WS_TOKE); const int* tokR = (const int*)(a->ws + WS_TOKR);
    int* tokS = (int*)(a->ws + WS_TOKS); int* slotT = (int*)(a->ws + WS_SLOTT);
    for (int q = tid; ; q += NT) { const int it = q >> 4, j = q & 15, t = (it * G + me) * 8 + (j >> 1); if (t >= ntok) break;
        const int idx = 2 * t + (j & 1); const int e = tokE[idx]; const int slot = pstart[e] + off[e] + tokR[idx]; tokS[idx] = slot; slotT[slot] = t; }
    __syncthreads();
}

__device__ __forceinline__ void moe_table(AP a, int l, LAS int* blk) {
    const int* tot = (const int*)(a->ws + WS_CNT) + l * 32;
    if (threadIdx.x == 0) { int acc = 0; for (int e = 0; e < 32; ++e) { const int c = tot[e]; blk[e] = acc; blk[33 + e] = c; acc += (c + 255) >> 8; } blk[32] = acc; }
    __syncthreads();
}
__device__ __forceinline__ int units_of(int nu, int v, int G) { return (v < nu) ? (nu - v + G - 1) / G : 0; }
__device__ __forceinline__ void p1_inproj(AP a, unsigned char* smem, LAS unsigned char* lds, int l) {
    SchedInProj S; S.ws = a->ws; S.l = l; S.G = gridDim.x; S.me = vblock();
    g256::gemm_phase(lds, 1024, S);
    if (l == 0) { const int nu = 64 * 7 + 4 * 7, G = gridDim.x; if (units_of(nu, S.me, G) < (nu + G - 1) / G) exp_fill(a, smem, 0, 8); }
}
__device__ __forceinline__ void p3_outproj(AP a, unsigned char* smem, LAS unsigned char* lds, int l) {
    SchedOutProj S; S.ws = a->ws; S.l = l; S.G = gridDim.x; S.me = vblock();
    g256::gemm_phase(lds, 1024, S);
    if (l == 0) {
        const bf16_t* W = (const bf16_t*)(a->ws + WS_WOUT);
        for (int u = blockIdx.x; u < 64; u += gridDim.x) { const int rt = u >> 3, ct = u & 7;
            EpiBf16 E; E.C = (bf16_t*)(a->ws + WS_Y) + (size_t)(NLAT + rt * 128) * D + ct * 128; E.ld = D;
            const bf16_t* B0 = W + (size_t)(ct * 128) * 1024;
            gemm_tile<128, false, EpiBf16>(lds, (const bf16_t*)(a->ws + WS_CAT) + (size_t)(NLAT + rt * 128) * D, D, nullptr, 128, B0, B0 + (size_t)64 * 1024, 1024, 1024, E); }
        if (blockIdx.x >= 64) exp_fill(a, smem, 0, 3);
    }
}
__device__ __forceinline__ void p6_gateup(AP a, unsigned char* smem, LAS unsigned char* lds, int l) {
    LAS int* blk = (LAS int*)(lds + MISC_OFF + 256);
    moe_table(a, l, blk);
    LAS int* ridx = (LAS int*)(lds + RIDX_OFF);
    const int tid = tid_opaque(), G = gridDim.x, me = vblock(), nu = blk[32] * 4;
    const int* slotT = (const int*)(a->ws + WS_SLOTT);
    for (int i = 0; i < 8; ++i) { const int idx = i * G + me; if (idx >= nu) break;
        const int rb = idx >> 2; int e = 0; for (int q = 1; q < 32; ++q) if (blk[q] <= rb) e = q;
        const int valid = min(256, blk[33 + e] - (rb - blk[e]) * 256);
        if (tid < 256) ridx[i * 256 + tid] = (tid < valid) ? slotT[rb * 256 + tid] : 0; }
    __syncthreads();
    SchedGateUp S; S.ws = a->ws; S.blk = blk; S.tot = blk + 33; S.ridx_lds = ridx; S.G = G; S.me = me; S.l = l;
    g256::gemm_phase(lds, 1024, S);
    __syncthreads();
    if (l == 0 && units_of(nu, me, G) < (nu + G - 1) / G) exp_fill(a, smem, 1, 8);
}
__device__ __forceinline__ void p7_down(AP a, unsigned char* smem, LAS unsigned char* lds, int l) {
    LAS int* blk = (LAS int*)(lds + MISC_OFF + 256);
    moe_table(a, l, blk);
    SchedDown S; S.ws = a->ws; S.blk = blk; S.G = gridDim.x; S.me = vblock(); S.l = l;
    g256::gemm_phase(lds, 512, S);
    __syncthreads();
    { const int nu = uni(blk[32]) * 4, G = gridDim.x; if (l == 0 && units_of(nu, S.me, G) < (nu + G - 1) / G) exp_fill(a, smem, 1, 5); }
}

__device__ __forceinline__ void p8_ln2(AP a, unsigned char* lds, int l) {
    const int tid = tid_opaque(), lane = tid & 63, w = tid >> 6;
    const int ntok = (l == 0) ? NTOK : NLAT;
    const float* mod = (const float*)(a->ws + WS_MOD) + (size_t)l * 5 * 6144;
    const float* modn = (const float*)(a->ws + WS_MOD) + (size_t)5 * 6144;
    const float* X1 = (const float*)(a->ws + WS_X1);
    const bf16_t* YS = (const bf16_t*)(a->ws + WS_YS);
    const int* tokS = (const int*)(a->ws + WS_TOKS); const float* tokG = (const float*)(a->ws + WS_TOKG);
    f32x4* Lgb = (f32x4*)lds;
    __syncthreads();
    Lgb[tid] = (tid < 256) ? *(const f32x4*)(a->in[21] + l * 1024 + tid * 4) : *(const f32x4*)(a->in[22] + l * 1024 + (tid - 256) * 4);
    __syncthreads();
    int mrow = -1; f32x4 mg[4], nsh[4], nsc[4];
    const int tstep = gridDim.x * 8;
    int t = blockIdx.x * 8 + w;
    int ns0 = 0, ns1 = 0; float nga = 0.f, ngb = 0.f;
    f32x4 nx[4]; u32x2 nya[4], nyb[4];
    float cga = 0.f, cgb = 0.f;
    if (t < ntok) { const int s0 = tokS[2 * t], s1 = tokS[2 * t + 1]; cga = tokG[2 * t]; cgb = tokG[2 * t + 1];
#pragma unroll
        for (int i = 0; i < 4; ++i) { const int c = 256 * i + 4 * lane; nx[i] = *(const f32x4*)(X1 + (size_t)t * D + c); nya[i] = *(const u32x2*)(YS + (size_t)s0 * D + c); nyb[i] = *(const u32x2*)(YS + (size_t)s1 * D + c); } }
    if (t + tstep < ntok) { ns0 = tokS[2 * (t + tstep)]; ns1 = tokS[2 * (t + tstep) + 1]; nga = tokG[2 * (t + tstep)]; ngb = tokG[2 * (t + tstep) + 1]; }
    for (; t < ntok; t += tstep) {
        const int mr = (t < NLAT) ? (t >> 12) : 4;
        if (mr != mrow) { mrow = mr; const float* m = mod + (size_t)mr * 6144; const float* mn = modn + (size_t)mr * 6144;
#pragma unroll
            for (int i = 0; i < 4; ++i) { const int c = 256 * i + 4 * lane; mg[i] = *(const f32x4*)(m + 5120 + c); if (l == 0) { nsh[i] = *(const f32x4*)(mn + c); nsc[i] = *(const f32x4*)(mn + 1024 + c); } } }
        f32x4 v[4];
#pragma unroll
        for (int i = 0; i < 4; ++i) { const f32x4 gv = mg[i];
            const u32x2 ya = nya[i], yb = nyb[i];
            const float f0 = cga * lo2f(ya.x) + cgb * lo2f(yb.x), f1 = cga * hi2f(ya.x) + cgb * hi2f(yb.x), f2 = cga * lo2f(ya.y) + cgb * lo2f(yb.y), f3 = cga * hi2f(ya.y) + cgb * hi2f(yb.y);
            v[i][0] = RES_ALPHA * nx[i][0] + gv[0] * f0; v[i][1] = RES_ALPHA * nx[i][1] + gv[1] * f1; v[i][2] = RES_ALPHA * nx[i][2] + gv[2] * f2; v[i][3] = RES_ALPHA * nx[i][3] + gv[3] * f3; }
        {   const int tn = t + tstep, tn2 = t + 2 * tstep;
            if (tn < ntok) {
#pragma unroll
                for (int i = 0; i < 4; ++i) { const int c = 256 * i + 4 * lane; nx[i] = *(const f32x4*)(X1 + (size_t)tn * D + c); nya[i] = *(const u32x2*)(YS + (size_t)ns0 * D + c); nyb[i] = *(const u32x2*)(YS + (size_t)ns1 * D + c); }
                cga = nga; cgb = ngb; }
            if (tn2 < ntok) { ns0 = tokS[2 * tn2]; ns1 = tokS[2 * tn2 + 1]; nga = tokG[2 * tn2]; ngb = tokG[2 * tn2 + 1]; } }
        float mean, rstd; ln_stats(v, mean, rstd);
        float* dst = (l == 0) ? (float*)(a->ws + WS_XC) + (size_t)t * D : a->out + (size_t)t * D;
#pragma unroll
        for (int i = 0; i < 4; ++i) { const int c = 256 * i + 4 * lane; const f32x4 gg = Lgb[64 * i + lane], bb = Lgb[256 + 64 * i + lane];
#pragma unroll
            for (int e = 0; e < 4; ++e) v[i][e] = (v[i][e] - mean) * rstd * gg[e] + bb[e];
            *(f32x4*)(dst + c) = v[i]; }
        if (l == 0) {
            ln_stats(v, mean, rstd);
            bf16_t* H = (bf16_t*)(a->ws + WS_H);
#pragma unroll
            for (int i = 0; i < 4; ++i) { const int c = 256 * i + 4 * lane; const f32x4 sh = nsh[i], sc = nsc[i];
                f32x4 o;
#pragma unroll
                for (int e = 0; e < 4; ++e) o[e] = (v[i][e] - mean) * rstd * (1.0f + sc[e]) + sh[e];
                u32x2 pk; pk.x = pack2(o[0], o[1]); pk.y = pack2(o[2], o[3]); *(u32x2*)(H + (size_t)t * D + c) = pk; }
        }
    }
}

constexpr int N_PHASES = 18;
template <int P> __device__ __forceinline__ void run_phase(AP a, unsigned char* smem, LAS unsigned char* lds, int l) {
    asm volatile("" : "+s"(a));
    if (P == 0) p0_prologue(a, smem);
    if (P == 1) p_lnmod0(a);
    if (P == 2) p1_inproj(a, smem, lds, l);
    if (P == 3) p2_mix(a, smem, lds, l);
    if (P == 4) p3_outproj(a, smem, lds, l);
    if (P == 5) p4_ln1_router(a, smem, l);
    if (P == 6) p5_dispatch(a, smem, l);
    if (P == 7) p6_gateup(a, smem, lds, l);
    if (P == 8) p7_down(a, smem, lds, l);
    if (P == 9) p8_ln2(a, smem, l);
}
template <int P> __device__ __noinline__ void phase_fn(AP ap, int l) {
    extern __shared__ __attribute__((aligned(16))) unsigned char smem[];
    run_phase<P>(ap, smem, (LAS unsigned char*)smem, l);
}
#if N_LAUNCH_MODE == 1
__global__ void __launch_bounds__(NT, 2) fwd(Args a) {
    extern __shared__ __attribute__((aligned(16))) unsigned char smem[];
    LAS unsigned char* lds = (LAS unsigned char*)smem;
    if (threadIdx.x < 4) ((volatile LAS unsigned*)(lds + MISC_OFF + 768))[threadIdx.x] = 0u;
    __syncthreads();
    XcdBarrier bar = xcd_barrier_post((unsigned*)(a.ws + WS_BAR), (volatile LAS unsigned*)(lds + MISC_OFF + 768));
    AP ap = (AP)__builtin_amdgcn_kernarg_segment_ptr();
#define PROBE(P, l) do { if (PROBE_MASK & (1 << (P))) { for (int _r = 0; _r < 2; ++_r) { xcd_barrier(bar); run_phase<P>(ap, smem, lds, l); } } } while (0)
    run_phase<0>(ap, smem, lds, 0); PROBE(0, 0); xcd_barrier(bar);
    run_phase<1>(ap, smem, lds, 0); PROBE(1, 0); xcd_barrier(bar);
    for (int l = 0; l < 2; ++l) {
        run_phase<2>(ap, smem, lds, l); PROBE(2, l); xcd_barrier(bar);
        run_phase<3>(ap, smem, lds, l); PROBE(3, l); xcd_barrier(bar);
        run_phase<4>(ap, smem, lds, l); PROBE(4, l); xcd_barrier(bar);
        run_phase<5>(ap, smem, lds, l); PROBE(5, l); xcd_barrier(bar);
        run_phase<6>(ap, smem, lds, l); PROBE(6, l); xcd_barrier(bar);
        run_phase<7>(ap, smem, lds, l); PROBE(7, l); xcd_barrier(bar);
        run_phase<8>(ap, smem, lds, l); PROBE(8, l); xcd_barrier(bar);
        run_phase<9>(ap, smem, lds, l); PROBE(9, l); if (l == 0) xcd_barrier(bar);
    }
}
#else
template <int P> __global__ void __launch_bounds__(NT, 2) k_phase(Args a) {
    extern __shared__ __attribute__((aligned(16))) unsigned char smem[];
    LAS unsigned char* lds = (LAS unsigned char*)smem;
    AP ap = (AP)__builtin_amdgcn_kernarg_segment_ptr();
    run_phase<P>(ap, smem, lds, ap->ph_lo);
}
template <int P> static void launch_phase(Args a, int l, int grid, hipStream_t stream) {
    static bool attr = false;
    if (!attr) { (void)hipFuncSetAttribute((const void*)k_phase<P>, hipFuncAttributeMaxDynamicSharedMemorySize, LDS_BYTES); attr = true; }
    a.ph_lo = l; a.ph_hi = P;
    hipLaunchKernelGGL(k_phase<P>, dim3(grid), dim3(NT), LDS_BYTES, stream, a);
}
#endif

extern "C" void kernel_launch(void* const* d_in, const int* in_sizes, int n_in, void* d_out, int out_size, void* d_ws, size_t ws_size, hipStream_t stream) {
    static int grid = 0;
    if (grid == 0) {
        if (n_in != 23 || out_size != NLAT * D || ws_size < WS_END) { fprintf(stderr, "kernel_launch: unexpected shapes (n_in %d, out %d, ws %zu, need %zu)\n", n_in, out_size, ws_size, (size_t)WS_END); grid = -1; return; }
        int dev = 0, cus = 0;
        if (hipGetDevice(&dev) != hipSuccess || hipDeviceGetAttribute(&cus, hipDeviceAttributeMultiprocessorCount, dev) != hipSuccess) { grid = -1; return; }
#if N_LAUNCH_MODE == 1
        int per_cu = 0;
        if (hipFuncSetAttribute((const void*)fwd, hipFuncAttributeMaxDynamicSharedMemorySize, LDS_BYTES) != hipSuccess) { fprintf(stderr, "kernel_launch: hipFuncSetAttribute failed\n"); grid = -1; return; }
        if (hipOccupancyMaxActiveBlocksPerMultiprocessor(&per_cu, (const void*)fwd, NT, LDS_BYTES) != hipSuccess || per_cu < 1) { fprintf(stderr, "kernel_launch: occupancy query says %d\n", per_cu); }
        (void)hipGetLastError();
#endif
        grid = cus; if (grid > MAXG) grid = MAXG;
    }
    if (grid < 0) return;
    (void)hipMemsetAsync((char*)d_ws + WS_BAR, 0, 16384 + 256, stream);
    Args a{};
    for (int i = 0; i < 23; ++i) a.in[i] = (const float*)d_in[i];
    a.out = (float*)d_out; a.ws = (unsigned char*)d_ws;
#if N_LAUNCH_MODE == 1
    a.ph_lo = 0; a.ph_hi = N_PHASES;
    hipLaunchKernelGGL(fwd, dim3(grid), dim3(NT), LDS_BYTES, stream, a);
#else
    launch_phase<0>(a, 0, grid, stream);
    launch_phase<1>(a, 0, grid, stream);
    for (int l = 0; l < 2; ++l) {
        launch_phase<2>(a, l, grid, stream); launch_phase<3>(a, l, grid, stream); launch_phase<4>(a, l, grid, stream); launch_phase<5>(a, l, grid, stream);
        launch_phase<6>(a, l, grid, stream); launch_phase<7>(a, l, grid, stream); launch_phase<8>(a, l, grid, stream); launch_phase<9>(a, l, grid, stream);
    }
#endif
}
```

```cpp
#include <hip/hip_runtime.h>
#include <stdint.h>
#include <stdio.h>

#ifndef NAIVE_GEMM
#define NAIVE_GEMM 0
#endif
#ifndef NAIVE_MIXER
#define NAIVE_MIXER 0
#endif
#ifndef PROBE_MASK
#define PROBE_MASK 0
#endif
#ifndef PROBE_FFT_REP
#define PROBE_FFT_REP 1
#endif
#ifndef PROBE_MIX_REP
#define PROBE_MIX_REP 1
#endif
#ifndef PROBE_SGU_REP
#define PROBE_SGU_REP 1
#endif
#ifndef N_LAUNCH_MODE
#define N_LAUNCH_MODE 1
#endif

#define LAS __attribute__((address_space(3)))
typedef unsigned short bf16_t;
typedef short bf16x8 __attribute__((ext_vector_type(8)));
typedef float f32x4 __attribute__((ext_vector_type(4)));
typedef unsigned u32x4 __attribute__((ext_vector_type(4)));
typedef unsigned u32x2 __attribute__((ext_vector_type(2)));
typedef float f32x2 __attribute__((ext_vector_type(2)));

constexpr int D = 1024, NBATCH = 4, SEQ = 4096, CTXL = 256;
constexpr int NLAT = NBATCH * SEQ, NCTX = NBATCH * CTXL, NTOK = NLAT + NCTX;
constexpr int ZC = 1792;
constexpr int NEXP = 32, DEXP = 512;
constexpr int NSLOT = 2 * NTOK + NEXP * 256;
constexpr int NT = 512;
constexpr int MAXG = 512;
constexpr float RES_ALPHA = 1.41421356237309515f;
constexpr int MISC_OFF = 155648;
constexpr int RIDX_OFF = 131072;
constexpr int LDS_BYTES = MISC_OFF + 1024;

constexpr size_t WS_BAR   = 0;
constexpr size_t WS_CNT   = 16384;
constexpr size_t WS_BCNT  = WS_CNT + 256;
constexpr size_t WS_MOD   = WS_BCNT + (size_t)2 * MAXG * 32 * 4;
constexpr size_t WS_ROPE  = WS_MOD + (size_t)2 * 5 * 6144 * 4;
constexpr size_t WS_TOKE  = WS_ROPE + 8192;
constexpr size_t WS_TOKR  = WS_TOKE + (size_t)NTOK * 8;
constexpr size_t WS_TOKS  = WS_TOKR + (size_t)NTOK * 8;
constexpr size_t WS_TOKG  = WS_TOKS + (size_t)NTOK * 8;
constexpr size_t WS_SLOTT = WS_TOKG + (size_t)NTOK * 8;
constexpr size_t WS_WIN   = WS_SLOTT + (size_t)NSLOT * 4;
constexpr size_t WS_WOUT  = WS_WIN + (size_t)2 * ZC * 1024 * 2;
constexpr size_t WS_WSGU  = WS_WOUT + (size_t)2 * 1024 * 1024 * 2;
constexpr size_t WS_DFTC  = WS_WSGU + (size_t)2 * 4 * 128 * 128 * 2;
constexpr size_t WS_WEXP  = WS_DFTC + (size_t)256 * 512 * 2;
constexpr size_t EXPMAT   = (size_t)NEXP * 512 * 1024;
constexpr size_t WEXP_LAYER = 3 * EXPMAT * 2;
constexpr size_t WS_X1    = WS_WEXP + 2 * WEXP_LAYER;
constexpr size_t WS_XC    = WS_X1 + (size_t)NTOK * D * 4;
constexpr size_t WS_H     = WS_XC + (size_t)NTOK * D * 4;
constexpr size_t WS_R     = WS_H + (size_t)NTOK * D * 2;
constexpr size_t WS_Z     = WS_R;
constexpr size_t WS_AT    = WS_Z + (size_t)NTOK * ZC * 2;
constexpr size_t WS_ATC   = WS_AT + (size_t)4 * 256 * 8192 * 2;
constexpr size_t WS_VT    = WS_ATC + (size_t)4 * 256 * 512 * 2;
constexpr size_t WS_VTC   = WS_VT + (size_t)4 * 2 * 64 * 4096 * 2;
constexpr size_t WS_CAT   = WS_VTC + (size_t)4 * 2 * 64 * 256 * 2;
constexpr size_t WS_REND  = WS_CAT + (size_t)NTOK * D * 2;
constexpr size_t WS_Y     = WS_R;
constexpr size_t WS_HID   = WS_R;
constexpr size_t WS_YS    = WS_HID + (size_t)NSLOT * DEXP * 2;
constexpr size_t WS_END   = (WS_YS + (size_t)NSLOT * D * 2 > WS_REND) ? WS_YS + (size_t)NSLOT * D * 2 : WS_REND;
static_assert(WS_Y + (size_t)NTOK * D * 4 <= WS_CAT, "Y must not reach CAT");
static_assert(WS_WIN % 256 == 0 && WS_DFTC % 256 == 0 && WS_WEXP % 256 == 0 && WS_X1 % 256 == 0 && WS_H % 256 == 0 && WS_R % 256 == 0 && WS_AT % 256 == 0 && WS_CAT % 256 == 0 && WS_YS % 256 == 0, "alignment");

struct Args { const float* in[23]; float* out; unsigned char* ws; int ph_lo, ph_hi; };
#define CAS __attribute__((address_space(4)))
typedef const CAS Args* AP;

#define XB_TMO      128
#define XB_XCNT(j)  (256  + 64 * (j))
#define XB_XSUB(j)  (1280 + 64 * (j))
#define XB_XGEN(j)  (2304 + 64 * (j))
#define XB_TOP      3328
#define XB_TOPGEN   3392
#define XCD_BAR_WORDS 3456
#define XB_SPIN_CAP (1u << 18)

__device__ __forceinline__ unsigned xb_ld(unsigned* p)              { return __hip_atomic_load(p, __ATOMIC_RELAXED, __HIP_MEMORY_SCOPE_AGENT); }
__device__ __forceinline__ unsigned xb_add(unsigned* p, unsigned v) { return __hip_atomic_fetch_add(p, v, __ATOMIC_RELAXED, __HIP_MEMORY_SCOPE_AGENT); }
__device__ __forceinline__ unsigned xb_xcc_id() { return (unsigned)__builtin_amdgcn_s_getreg((3 << 11) | 20) & 0xFu; }
#define XB_SPIN(cond, bar) do { unsigned _sp = 0; while (cond) { __builtin_amdgcn_s_sleep(1); \
    if ((++_sp & 255u) == 0u) { if (xb_ld(&(bar)[XB_TMO])) break; if (_sp > XB_SPIN_CAP) { atomicAdd(&(bar)[XB_TMO], 1u); break; } } } } while (0)

struct XcdBarrier { unsigned* bar; unsigned x; volatile LAS unsigned* st; };

__device__ __forceinline__ XcdBarrier xcd_barrier_post(unsigned* bar, volatile LAS unsigned* st) {
    XcdBarrier b; b.bar = bar; b.x = (unsigned)__builtin_amdgcn_readfirstlane((int)xb_xcc_id()); b.st = st;
    if (threadIdx.x == 0) (void)xb_add(&bar[XB_XCNT(b.x)], 1u);
    return b;
}
__device__ __forceinline__ void xcd_barrier_complete(unsigned* bar, unsigned x, unsigned& nloc, unsigned& nx) {
    const unsigned G = gridDim.x * gridDim.y * gridDim.z;
    unsigned sum, cnt, mine, sp = 0u;
    for (;;) {
        sum = 0u; cnt = 0u; mine = 0u;
#pragma unroll
        for (unsigned j = 0; j < 16; ++j) { const unsigned c = xb_ld(&bar[XB_XCNT(j)]); sum += c; cnt += (c > 0u) ? 1u : 0u; mine = (j == x) ? c : mine; }
        if (sum == G) break;
        __builtin_amdgcn_s_sleep(1);
        if ((++sp & 255u) == 0u) { if (xb_ld(&bar[XB_TMO])) break; if (sp > XB_SPIN_CAP) { atomicAdd(&bar[XB_TMO], 1u); break; } }
    }
    nloc = mine > 0u ? mine : 1u; nx = cnt > 0u ? cnt : 1u;
}
__device__ __forceinline__ void xcd_barrier(const XcdBarrier& b) {
    asm volatile("s_waitcnt vmcnt(0)" ::: "memory");
    __syncthreads();
    if (threadIdx.x == 0) {
        unsigned* bar = b.bar;
        unsigned bx = b.x;
        asm volatile("" : "+s"(bar), "+s"(bx));
        __builtin_amdgcn_s_waitcnt(0);
        unsigned nloc = b.st[0], nx = b.st[1];
        if (nloc == 0u) { xcd_barrier_complete(bar, bx, nloc, nx); b.st[0] = nloc; b.st[1] = nx; }
        const unsigned old = xb_add(&bar[XB_XSUB(bx)], 1u);
        const unsigned gen = old / nloc;
        if (old + 1u == (gen + 1u) * nloc) {
            __builtin_amdgcn_fence(__ATOMIC_RELEASE, "agent");
            asm volatile("s_waitcnt vmcnt(0)" ::: "memory");
            const unsigned og = xb_add(&bar[XB_TOP], 1u);
            const unsigned tg = og / nx;
            if (og + 1u == (tg + 1u) * nx) xb_add(&bar[XB_TOPGEN], 1u);
            else XB_SPIN(xb_ld(&bar[XB_TOPGEN]) == tg, bar);
            __builtin_amdgcn_fence(__ATOMIC_ACQUIRE, "agent");
            xb_add(&bar[XB_XGEN(bx)], 1u);
            asm volatile("s_waitcnt vmcnt(0)" ::: "memory");
        } else {
            XB_SPIN(xb_ld(&bar[XB_XGEN(bx)]) == gen, bar);
            __builtin_amdgcn_fence(__ATOMIC_ACQUIRE, "agent");
            asm volatile("s_waitcnt vmcnt(0)" ::: "memory");
        }
    }
    __syncthreads();
}

__device__ __forceinline__ int tid_opaque() { int t = threadIdx.x; asm volatile("" : "+v"(t)); return t; }
__device__ __forceinline__ float bf2f(bf16_t v) { return __uint_as_float(((unsigned)v) << 16); }
__device__ __forceinline__ bf16_t f2bf(float f) { return __builtin_bit_cast(unsigned short, (__bf16)f); }
typedef __bf16 hwbf16x2 __attribute__((ext_vector_type(2)));
__device__ __forceinline__ unsigned pack2(float a, float b) { return __builtin_bit_cast(unsigned, __builtin_convertvector((f32x2){a, b}, hwbf16x2)); }
__device__ __forceinline__ float lo2f(unsigned w) { return __uint_as_float(w << 16); }
__device__ __forceinline__ float hi2f(unsigned w) { return __uint_as_float(w & 0xffff0000u); }
template <int CTRL> __device__ __forceinline__ float dpp_mov(float v) { return __builtin_bit_cast(float, __builtin_amdgcn_update_dpp(0, __builtin_bit_cast(int, v), CTRL, 0xf, 0xf, true)); }
__device__ __forceinline__ float row_sum16(float v) {
    v += dpp_mov<0xB1>(v);
    v += dpp_mov<0x4E>(v);
    v += dpp_mov<0x141>(v);
    v += dpp_mov<0x140>(v);
    return v;
}
__device__ __forceinline__ float row_max16(float v) {
    v = fmaxf(v, dpp_mov<0xB1>(v)); v = fmaxf(v, dpp_mov<0x4E>(v)); v = fmaxf(v, dpp_mov<0x141>(v)); v = fmaxf(v, dpp_mov<0x140>(v));
    return v;
}
__device__ __forceinline__ float wave_sum(float v) {
    v = row_sum16(v);
    const int iv = __builtin_bit_cast(int, v);
    const float a0 = __builtin_bit_cast(float, __builtin_amdgcn_readlane(iv, 0)), a1 = __builtin_bit_cast(float, __builtin_amdgcn_readlane(iv, 16));
    const float a2 = __builtin_bit_cast(float, __builtin_amdgcn_readlane(iv, 32)), a3 = __builtin_bit_cast(float, __builtin_amdgcn_readlane(iv, 48));
    return (a0 + a1) + (a2 + a3);
}
__device__ __forceinline__ float gelu_erf(float v) {
    const float t = __builtin_amdgcn_rcpf(fabsf(v) * 0.2316418882f + 1.0f);
    float q = t * 0.5307027145f + (-0.7265760135f); q = q * t + 0.7107068705f; q = q * t + (-0.142248368f); q = q * t + 0.127414796f; q = q * t;
    const float m = v * (q * __builtin_amdgcn_exp2f((v * v) * (-0.72134752044f)));
    return v < 0.f ? m : v - m;
}
__device__ __forceinline__ float silu_f(float x) { return x / (1.0f + __expf(-x)); }

__device__ __forceinline__ void ln_stats(const f32x4 (&v)[4], float& mean, float& rstd) {
    float s = 0.f;
#pragma unroll
    for (int i = 0; i < 4; ++i) s += (v[i][0] + v[i][1]) + (v[i][2] + v[i][3]);
    s = wave_sum(s); mean = s * (1.0f / 1024.0f);
    float q = 0.f;
#pragma unroll
    for (int i = 0; i < 4; ++i)
#pragma unroll
        for (int e = 0; e < 4; ++e) { const float d = v[i][e] - mean; q += d * d; }
    q = wave_sum(q); rstd = 1.0f / sqrtf(q * (1.0f / 1024.0f) + 1e-6f);
}

__device__ __forceinline__ void ln_stats16(const f32x4 (&v)[16], float& mean, float& rstd) {
    float s = 0.f;
#pragma unroll
    for (int k = 0; k < 16; ++k) s += (v[k][0] + v[k][1]) + (v[k][2] + v[k][3]);
    s = row_sum16(s); mean = s * (1.0f / 1024.0f);
    float q = 0.f;
#pragma unroll
    for (int k = 0; k < 16; ++k)
#pragma unroll
        for (int e = 0; e < 4; ++e) { const float d = v[k][e] - mean; q += d * d; }
    q = row_sum16(q); rstd = 1.0f / sqrtf(q * (1.0f / 1024.0f) + 1e-6f);
}

template <int BN> struct MfmaLayout {
    static constexpr int FG = BN / 128, NI = 4, NJ = 2 * FG;
    int rbase, cbase;
    __device__ __forceinline__ int row(int i) const { return rbase + 16 * i; }
    __device__ __forceinline__ int col(int jj) const { return (jj / FG) * (BN / 2) + (jj % FG) * 16 + cbase; }
};
template <int BN> struct NaiveLayout {
    static constexpr int TX = BN / 8, TY = NT / TX, NI = 128 / TY, NJ = 2;
    int ty, tx;
    __device__ __forceinline__ int row(int i) const { return ty + TY * i; }
    __device__ __forceinline__ int col(int jj) const { return jj * (BN / 2) + 4 * tx; }
};

__device__ __forceinline__ void glds16(const bf16_t* g, LAS unsigned char* l) {
    __builtin_amdgcn_global_load_lds((const unsigned*)g, (LAS unsigned*)l, 16, 0, 0);
}

template <int BN, bool GATHER, class Epi>
__device__ __forceinline__ void gemm_tile(LAS unsigned char* lds, const bf16_t* A, int lda, const int* rowidx, int valid_rows,
                                          const bf16_t* B0, const bf16_t* B1, int ldb, int K, const Epi& epi) {
    constexpr int A_B = 16384, B_B = BN * 128, STAGE = A_B + B_B, NBL = BN / 64;
    const int tid = tid_opaque(), lane = tid & 63, wid = __builtin_amdgcn_readfirstlane(tid >> 6);
    const bf16_t* ap[2]; const bf16_t* bp[NBL];
#pragma unroll
    for (int i = 0; i < 2; ++i) {
        const int P = i * 512 + tid, row = P >> 3, c = (P & 7) ^ ((row >> 1) & 7);
        size_t ro;
        if (GATHER) ro = (size_t)(row < valid_rows ? rowidx[row] : 0) * (size_t)lda; else ro = (size_t)row * (size_t)lda;
        ap[i] = A + ro + c * 8;
    }
#pragma unroll
    for (int i = 0; i < NBL; ++i) {
        const int P = i * 512 + tid, row = P >> 3, c = (P & 7) ^ ((row >> 1) & 7);
        const bf16_t* base = (row < BN / 2) ? (B0 + (size_t)row * ldb) : (B1 + (size_t)(row - BN / 2) * ldb);
        bp[i] = base + c * 8;
    }
    const int nk = K / 64;
#define GT_STAGE(buf, k0) do { \
        _Pragma("unroll") for (int _i = 0; _i < 2; ++_i) glds16(ap[_i] + (k0), lds + (buf) * STAGE + _i * 8192 + wid * 1024); \
        _Pragma("unroll") for (int _i = 0; _i < NBL; ++_i) glds16(bp[_i] + (k0), lds + (buf) * STAGE + A_B + _i * 8192 + wid * 1024); } while (0)

#if NAIVE_GEMM
    typedef NaiveLayout<BN> Lay;
    Lay lay; lay.tx = tid % Lay::TX; lay.ty = tid / Lay::TX;
    f32x4 acc[Lay::NI][Lay::NJ];
#pragma unroll
    for (int i = 0; i < Lay::NI; ++i)
#pragma unroll
        for (int j = 0; j < Lay::NJ; ++j) acc[i][j] = (f32x4){0.f, 0.f, 0.f, 0.f};
    GT_STAGE(0, 0);
    asm volatile("s_waitcnt vmcnt(0)" ::: "memory"); __syncthreads();
    for (int kt = 0; kt < nk; ++kt) {
        if (kt + 1 < nk) GT_STAGE((kt + 1) & 1, (kt + 1) * 64);
        const LAS unsigned char* sa = lds + (kt & 1) * STAGE; const LAS unsigned char* sb = sa + A_B;
#pragma unroll 1
        for (int kc = 0; kc < 8; ++kc)
#pragma unroll 1
            for (int hh = 0; hh < 2; ++hh) {
                float a[Lay::NI][4];
#pragma unroll
                for (int i = 0; i < Lay::NI; ++i) { const int row = lay.row(i);
                    const u32x2 w = *(const LAS u32x2*)(sa + row * 128 + ((kc ^ ((row >> 1) & 7)) << 4) + hh * 8);
                    a[i][0] = lo2f(w.x); a[i][1] = hi2f(w.x); a[i][2] = lo2f(w.y); a[i][3] = hi2f(w.y); }
#pragma unroll
                for (int j = 0; j < 2; ++j)
#pragma unroll
                    for (int e = 0; e < 4; ++e) { const int row = j * (BN / 2) + 4 * lay.tx + e;
                        const u32x2 w = *(const LAS u32x2*)(sb + row * 128 + ((kc ^ ((row >> 1) & 7)) << 4) + hh * 8);
                        const float b0 = lo2f(w.x), b1 = hi2f(w.x), b2 = lo2f(w.y), b3 = hi2f(w.y);
#pragma unroll
                        for (int i = 0; i < Lay::NI; ++i) acc[i][j][e] += (a[i][0] * b0 + a[i][1] * b1) + (a[i][2] * b2 + a[i][3] * b3); }
            }
        asm volatile("s_waitcnt vmcnt(0)" ::: "memory"); __syncthreads();
    }
    epi.run(acc, lay);
#else
    typedef MfmaLayout<BN> Lay;
    constexpr int FG = Lay::FG;
    const int fr = lane & 15, g = lane >> 4, wr = wid >> 2, wc = wid & 3;
    Lay lay; lay.rbase = wr * 64 + fr; lay.cbase = wc * 16 * FG + 4 * g;
    f32x4 acc[Lay::NI][Lay::NJ];
#pragma unroll
    for (int i = 0; i < Lay::NI; ++i)
#pragma unroll
        for (int j = 0; j < Lay::NJ; ++j) acc[i][j] = (f32x4){0.f, 0.f, 0.f, 0.f};
    int aoff[4], boff[Lay::NJ];
#pragma unroll
    for (int m = 0; m < 4; ++m) { const int row = wr * 64 + m * 16 + fr; aoff[m] = row * 128 + ((g ^ ((row >> 1) & 7)) << 4); }
#pragma unroll
    for (int jj = 0; jj < Lay::NJ; ++jj) { const int row = (jj / FG) * (BN / 2) + wc * 16 * FG + (jj % FG) * 16 + fr; boff[jj] = A_B + row * 128 + ((g ^ ((row >> 1) & 7)) << 4); }
    GT_STAGE(0, 0);
    asm volatile("s_waitcnt vmcnt(0)" ::: "memory"); __syncthreads();
    for (int kt = 0; kt < nk; ++kt) {
        if (kt + 1 < nk) GT_STAGE((kt + 1) & 1, (kt + 1) * 64);
        const LAS unsigned char* sa = lds + (kt & 1) * STAGE;
#pragma unroll
        for (int ks = 0; ks < 2; ++ks) {
            bf16x8 af[4], bfv[Lay::NJ];
#pragma unroll
            for (int m = 0; m < 4; ++m) af[m] = *(const LAS bf16x8*)(sa + (aoff[m] ^ (ks << 6)));
#pragma unroll
            for (int jj = 0; jj < Lay::NJ; ++jj) bfv[jj] = *(const LAS bf16x8*)(sa + (boff[jj] ^ (ks << 6)));
#pragma unroll
            for (int m = 0; m < 4; ++m)
#pragma unroll
                for (int jj = 0; jj < Lay::NJ; ++jj) acc[m][jj] = __builtin_amdgcn_mfma_f32_16x16x32_bf16(bfv[jj], af[m], acc[m][jj], 0, 0, 0);
        }
        asm volatile("s_waitcnt vmcnt(0)" ::: "memory"); __syncthreads();
    }
    epi.run(acc, lay);
#endif
#undef GT_STAGE
}

namespace g256 {
constexpr int BK = 64, HALF = 128, HTB = HALF * BK * 2, STAGE_BYTES = 8 * HTB;
__device__ __forceinline__ int lds_byte(int r, int c) { const int st = (r >> 4) * 2 + (c >> 5), rr = r & 15, cc = c & 31, ob = rr * 64 + cc * 2; return st * 1024 + (ob ^ (((ob >> 9) & 1) << 5)); }
__device__ __forceinline__ void stage_rc(int b, int& R, int& C) { const int st = b / 1024, sb = b % 1024, swz = sb ^ (((sb >> 9) & 1) << 5); R = (st >> 1) * 16 + swz / 64; C = (st & 1) * 32 + (swz % 64) / 2; }
struct Lay {
    static constexpr int NI = 8, NJ = 4;
    int rbase, cbase;
    __device__ __forceinline__ int row(int i) const { return (i >> 2) * 128 + (i & 3) * 16 + rbase; }
    __device__ __forceinline__ int col(int j) const { return (j >> 1) * 128 + (j & 1) * 16 + cbase; }
};
template <class Epi> struct Unit { const bf16_t* A; const bf16_t* B0; const bf16_t* B1; const LAS int* ridx; int valid; Epi epi; };

template <class Sched>
__device__ __forceinline__ void gemm_phase(LAS unsigned char* lds, const int K, const Sched& S) {
    typedef typename Sched::Epi Epi;
    const int tid = tid_opaque(), wid = __builtin_amdgcn_readfirstlane(tid >> 6), lane = tid & 63, wr = wid >> 2, wc = wid & 3, fr = lane & 15, fq = lane >> 4;
    int nt = K / BK; asm volatile("" : "+s"(nt));
    int sR[2], sC[2];
#pragma unroll
    for (int i = 0; i < 2; ++i) stage_rc(tid * 16 + i * 8192, sR[i], sC[i]);
    unsigned voffB[2];
#pragma unroll
    for (int i = 0; i < 2; ++i) voffB[i] = (unsigned)(sR[i] * K + sC[i]) * 2u;
    const size_t kstep = (size_t)(BK * 2);
    const unsigned ldsw = (unsigned)wid * 1024u;
    const int aoff = lds_byte(wr * 64 + fr, fq * 8), boff = lds_byte(wc * 32 + fr, fq * 8);
#define G2_SA(b, h) (((b) * 2 + (h)) * HTB)
#define G2_SB(b, h) ((4 + (b) * 2 + (h)) * HTB)
#define G2_STAGE(bufoff, gbase, v0, v1) do { \
        __builtin_amdgcn_global_load_lds((const unsigned*)((const char*)(gbase) + (v0)), (LAS unsigned*)(lds + (bufoff) + ldsw), 16, 0, 0); \
        __builtin_amdgcn_global_load_lds((const unsigned*)((const char*)(gbase) + (v1)), (LAS unsigned*)(lds + (bufoff) + ldsw + 8192), 16, 0, 0); } while (0)
#define G2_LDA(dst, b, h) do { _Pragma("unroll") for (int m = 0; m < 4; ++m) _Pragma("unroll") for (int k = 0; k < 2; ++k) dst[m][k] = *(const LAS bf16x8*)(lds + G2_SA(b, h) + aoff + m * 2048 + k * 1024); } while (0)
#define G2_LDB(dst, b, h) do { _Pragma("unroll") for (int n = 0; n < 2; ++n) _Pragma("unroll") for (int k = 0; k < 2; ++k) dst[n][k] = *(const LAS bf16x8*)(lds + G2_SB(b, h) + boff + n * 2048 + k * 1024); } while (0)
#define G2_MMA(ai, bj, At, Bt) do { __builtin_amdgcn_s_setprio(1); _Pragma("unroll") for (int m = 0; m < 4; ++m) _Pragma("unroll") for (int n = 0; n < 2; ++n) _Pragma("unroll") for (int k = 0; k < 2; ++k) \
        acc[(ai) * 4 + m][(bj) * 2 + n] = __builtin_amdgcn_mfma_f32_16x16x32_bf16(Bt[n][k], At[m][k], acc[(ai) * 4 + m][(bj) * 2 + n], 0, 0, 0); __builtin_amdgcn_s_setprio(0); } while (0)
#define G2_WAIT_V(n) asm volatile("s_waitcnt vmcnt(" #n ")" ::: "memory")
#define G2_WAIT_L(n) asm volatile("s_waitcnt lgkmcnt(" #n ")" ::: "memory")
#define G2_BAR __builtin_amdgcn_s_barrier()
#define G2_SCHED __builtin_amdgcn_sched_barrier(0)
#define G2_VOFFA(U, dst) do { _Pragma("unroll") for (int _h = 0; _h < 2; ++_h) _Pragma("unroll") for (int _i = 0; _i < 2; ++_i) { const int _row = _h * 128 + sR[_i]; \
        int _tok = _row; if (Sched::GATHER) _tok = (_row < (U).valid) ? (U).ridx[_row] : 0; dst[_h][_i] = (unsigned)(_tok * K + sC[_i]) * 2u; } } while (0)
    Unit<Epi> cur, nxt; int ui = 0;
    if (!S.get(0, cur)) return;
    f32x4 acc[8][4];
#pragma unroll
    for (int i = 0; i < 8; ++i)
#pragma unroll
        for (int j = 0; j < 4; ++j) acc[i][j] = (f32x4){0.f, 0.f, 0.f, 0.f};
    bf16x8 At[4][2], B0[2][2], B1[2][2];
    unsigned cvA[2][2], nvA[2][2];
    G2_VOFFA(cur, cvA);
    const char* cA = (const char*)cur.A; const char* cB0 = (const char*)cur.B0; const char* cB1 = (const char*)cur.B1;
    G2_STAGE(G2_SB(0, 0), cB0, voffB[0], voffB[1]); G2_STAGE(G2_SA(0, 0), cA, cvA[0][0], cvA[0][1]); G2_STAGE(G2_SB(0, 1), cB1, voffB[0], voffB[1]); G2_STAGE(G2_SA(0, 1), cA, cvA[1][0], cvA[1][1]);
    if (wr == 1) G2_BAR;
    G2_WAIT_V(4); G2_BAR;
    G2_STAGE(G2_SB(1, 0), cB0 + kstep, voffB[0], voffB[1]); G2_STAGE(G2_SA(1, 0), cA + kstep, cvA[0][0], cvA[0][1]); G2_STAGE(G2_SB(1, 1), cB1 + kstep, voffB[0], voffB[1]);
    G2_WAIT_V(6); G2_BAR;
    for (;;) {
        const bool has_next = S.get(ui + 1, nxt);
        if (Sched::GATHER) {
            if (has_next) { G2_VOFFA(nxt, nvA); }
            else {
#pragma unroll
                for (int h = 0; h < 2; ++h) { nvA[h][0] = cvA[h][0]; nvA[h][1] = cvA[h][1]; } }
        }
        const char* nA = has_next ? (const char*)nxt.A : cA; const char* nB0 = has_next ? (const char*)nxt.B0 : cB0; const char* nB1 = has_next ? (const char*)nxt.B1 : cB1;
#pragma unroll 1
        for (int t = 0; t < nt; t += 2) {
            const bool last = (t == nt - 2);
            const char* a1 = cA + (size_t)(t + 1) * kstep;
            const char* a2 = last ? nA : cA + (size_t)(t + 2) * kstep;
            const char* b20 = last ? nB0 : cB0 + (size_t)(t + 2) * kstep; const char* b21 = last ? nB1 : cB1 + (size_t)(t + 2) * kstep;
#define x00 ((Sched::GATHER && last) ? nvA[0][0] : cvA[0][0])
#define x01 ((Sched::GATHER && last) ? nvA[0][1] : cvA[0][1])
#define x10 ((Sched::GATHER && last) ? nvA[1][0] : cvA[1][0])
#define x11 ((Sched::GATHER && last) ? nvA[1][1] : cvA[1][1])
            G2_LDB(B0, 0, 0); G2_SCHED; G2_LDA(At, 0, 0); G2_STAGE(G2_SA(1, 1), a1, cvA[1][0], cvA[1][1]);
            G2_WAIT_L(8); G2_BAR; G2_WAIT_L(0); G2_MMA(0, 0, At, B0); G2_BAR; G2_SCHED;
            G2_LDB(B1, 0, 1); G2_STAGE(G2_SB(0, 0), b20, voffB[0], voffB[1]);
            G2_BAR; G2_WAIT_L(0); G2_MMA(0, 1, At, B1); G2_BAR;
            G2_LDA(At, 0, 1); G2_STAGE(G2_SA(0, 0), a2, x00, x01);
            G2_BAR; G2_WAIT_L(0); G2_MMA(1, 0, At, B0); G2_BAR; G2_SCHED;
            G2_STAGE(G2_SB(0, 1), b21, voffB[0], voffB[1]);
            G2_WAIT_V(6); G2_BAR; G2_MMA(1, 1, At, B1); G2_BAR;
            G2_LDB(B0, 1, 0); G2_SCHED; G2_LDA(At, 1, 0); G2_STAGE(G2_SA(0, 1), a2, x10, x11);
            G2_WAIT_L(8); G2_BAR; G2_WAIT_L(0); G2_MMA(0, 0, At, B0); G2_BAR; G2_SCHED;
            G2_LDB(B1, 1, 1); G2_STAGE(G2_SB(1, 0), b20 + kstep, voffB[0], voffB[1]);
            G2_BAR; G2_WAIT_L(0); G2_MMA(0, 1, At, B1); G2_BAR;
            G2_LDA(At, 1, 1); G2_STAGE(G2_SA(1, 0), a2 + kstep, x00, x01);
            G2_BAR; G2_WAIT_L(0); G2_MMA(1, 0, At, B0); G2_BAR; G2_SCHED;
            G2_STAGE(G2_SB(1, 1), b21 + kstep, voffB[0], voffB[1]);
            G2_WAIT_V(6); G2_BAR; G2_MMA(1, 1, At, B1); G2_BAR;
        }
        { Lay lay; int rbv = wr * 64 + fr, cbv = wc * 32 + 4 * fq; asm volatile("" : "+v"(rbv), "+v"(cbv));
          lay.rbase = rbv; lay.cbase = cbv; cur.epi.run(acc, lay); }
        if (!has_next) break;
#pragma unroll
        for (int i = 0; i < 8; ++i)
#pragma unroll
            for (int j = 0; j < 4; ++j) acc[i][j] = (f32x4){0.f, 0.f, 0.f, 0.f};
        cur = nxt; cA = nA; cB0 = nB0; cB1 = nB1; ++ui;
        if (Sched::GATHER) {
#pragma unroll
            for (int h = 0; h < 2; ++h) { cvA[h][0] = nvA[h][0]; cvA[h][1] = nvA[h][1]; } }
    }
#undef x00
#undef x01
#undef x10
#undef x11
    G2_WAIT_V(0);
    if (wr == 0) G2_BAR;
    G2_BAR;
#undef G2_SA
#undef G2_SB
#undef G2_STAGE
#undef G2_LDA
#undef G2_LDB
#undef G2_MMA
#undef G2_WAIT_V
#undef G2_WAIT_L
#undef G2_BAR
#undef G2_SCHED
#undef G2_VOFFA
}
}

struct EpiF32 {
    float* C; int ld;
    template <class L> __device__ __forceinline__ void run(const f32x4 (&acc)[L::NI][L::NJ], const L& lay) const {
#pragma unroll
        for (int i = 0; i < L::NI; ++i)
#pragma unroll
            for (int j = 0; j < L::NJ; ++j) *(f32x4*)(C + (size_t)lay.row(i) * ld + lay.col(j)) = acc[i][j];
    }
};
struct EpiBf16 {
    bf16_t* C; int ld;
    template <class L> __device__ __forceinline__ void run(const f32x4 (&acc)[L::NI][L::NJ], const L& lay) const {
#pragma unroll
        for (int i = 0; i < L::NI; ++i)
#pragma unroll
            for (int j = 0; j < L::NJ; ++j) { u32x2 w; w.x = pack2(acc[i][j][0], acc[i][j][1]); w.y = pack2(acc[i][j][2], acc[i][j][3]);
                *(u32x2*)(C + (size_t)lay.row(i) * ld + lay.col(j)) = w; }
    }
};
struct EpiGateUp {
    bf16_t* C; int ld;
    template <class L> __device__ __forceinline__ void run(const f32x4 (&acc)[L::NI][L::NJ], const L& lay) const {
#pragma unroll
        for (int i = 0; i < L::NI; ++i)
#pragma unroll
            for (int j = 0; j < L::NJ / 2; ++j) { const f32x4 gt = acc[i][j], up = acc[i][j + L::NJ / 2];
                u32x2 w; w.x = pack2(silu_f(gt[0]) * up[0], silu_f(gt[1]) * up[1]); w.y = pack2(silu_f(gt[2]) * up[2], silu_f(gt[3]) * up[3]);
                *(u32x2*)(C + (size_t)lay.row(i) * ld + lay.col(j)) = w; }
    }
};
struct EpiInProj {
    bf16_t* Zt;
    bf16_t* tF;
    bf16_t* tV;
    int n0, pos0, n;
    template <class L> __device__ __forceinline__ void run(const f32x4 (&acc)[L::NI][L::NJ], const L& lay) const {
#pragma unroll
        for (int i = 0; i < L::NI; ++i)
#pragma unroll
            for (int j = 0; j < L::NJ; ++j) {
                const int r = lay.row(i), cl = lay.col(j), c = n0 + cl;
                const f32x4 v = acc[i][j];
                if (c < 512) {
                    const int part = c >> 8, ch = c & 255;
#pragma unroll
                    for (int e = 0; e < 4; ++e) tF[((size_t)(ch + e) * 2 + part) * n + pos0 + r] = f2bf(v[e]);
                } else {
                    u32x2 w; w.x = pack2(v[0], v[1]); w.y = pack2(v[2], v[3]);
                    *(u32x2*)(Zt + (size_t)r * ZC + cl) = w;
                    if (c >= 896 && c < 1024) {
#pragma unroll
                        for (int e = 0; e < 4; ++e) tV[(size_t)(c - 896 + e) * n + pos0 + r] = f2bf(v[e]);
                    }
                }
            }
    }
};

constexpr int U_ADA = 192, U_WIN = 2 * 16 * 28, U_WOUT = 2 * 16 * 16, U_SGU = 32, U_DFT = 256, U_ROPE = 1, U_EXP = 3 * 32 * 32;
constexpr int LDS_SIL = 0, LDS_RED = 20480, LDS_TILE = 32768, LDS_T64 = 49408, LDS_CTAB = 50176;

__device__ __forceinline__ void ada_unit(AP a, unsigned char* lds, int u) {
    float* sil = (float*)(lds + LDS_SIL); float* red = (float*)(lds + LDS_RED);
    const int tid = tid_opaque(), lane = tid & 63, w = tid >> 6;
    const int l = u / 96, cg = u % 96;
    for (int i = tid; i < 5120; i += NT) { const int r = i >> 10, k = i & 1023; const float v = (r < 4) ? a->in[1][r * 1024 + k] : a->in[3][k]; sil[i] = v / (1.0f + expf(-v)); }
    __syncthreads();
    const float* W = a->in[4] + (size_t)l * 1024 * 6144 + cg * 64 + lane;
    float acc[5] = {0.f, 0.f, 0.f, 0.f, 0.f};
#pragma unroll 32
    for (int k = w * 128; k < w * 128 + 128; ++k) { const float wv = W[(size_t)k * 6144];
#pragma unroll
        for (int r = 0; r < 5; ++r) acc[r] += sil[r * 1024 + k] * wv; }
#pragma unroll
    for (int r = 0; r < 5; ++r) red[(w * 5 + r) * 64 + lane] = acc[r];
    __syncthreads();
    if (tid < 320) { const int r = tid >> 6; float s = 0.f;
#pragma unroll
        for (int ww = 0; ww < 8; ++ww) s += red[(ww * 5 + r) * 64 + lane];
        const int j = cg * 64 + lane; ((float*)(a->ws + WS_MOD))[(size_t)(l * 5 + r) * 6144 + j] = s + a->in[5][l * 6144 + j]; }
    __syncthreads();
}

__device__ __forceinline__ void tile_store_T(const float* tile, bf16_t* dst, int ldd) {
    const int tid = tid_opaque(), n = tid >> 3, kc = tid & 7;
    u32x4 w;
    w.x = pack2(tile[(kc * 8 + 0) * 65 + n], tile[(kc * 8 + 1) * 65 + n]); w.y = pack2(tile[(kc * 8 + 2) * 65 + n], tile[(kc * 8 + 3) * 65 + n]);
    w.z = pack2(tile[(kc * 8 + 4) * 65 + n], tile[(kc * 8 + 5) * 65 + n]); w.w = pack2(tile[(kc * 8 + 6) * 65 + n], tile[(kc * 8 + 7) * 65 + n]);
    *(u32x4*)(dst + (size_t)n * ldd + kc * 8) = w;
}
__device__ __forceinline__ void tile_load(float* tile, const float* src, int lds_) {
    const int tid = tid_opaque();
#pragma unroll
    for (int i = 0; i < 2; ++i) { const int row = (tid >> 4) + 32 * i, c4 = (tid & 15) * 4; const f32x4 v = *(const f32x4*)(src + (size_t)row * lds_ + c4);
        tile[row * 65 + c4 + 0] = v[0]; tile[row * 65 + c4 + 1] = v[1]; tile[row * 65 + c4 + 2] = v[2]; tile[row * 65 + c4 + 3] = v[3]; }
}

__device__ __forceinline__ void mm64_f32(const float* tA, int lda, const float* tB, int ldb, int K, float* out) {
    const int tid = tid_opaque(), lane = tid & 63, w = tid >> 6, fr = lane & 15, g = lane >> 4, mi = w >> 1, nj = 2 * (w & 1);
    f32x4 acc0 = (f32x4){0.f, 0.f, 0.f, 0.f}, acc1 = (f32x4){0.f, 0.f, 0.f, 0.f};
    const float* pa = tA + (16 * mi + fr) * lda + g; const float* pb = tB + g * ldb + 16 * nj + fr;
#pragma unroll 4
    for (int k0 = 0; k0 < K; k0 += 4) { const float av = pa[k0], b0 = pb[k0 * ldb], b1 = pb[k0 * ldb + 16];
        acc0 = __builtin_amdgcn_mfma_f32_16x16x4f32(av, b0, acc0, 0, 0, 0); acc1 = __builtin_amdgcn_mfma_f32_16x16x4f32(av, b1, acc1, 0, 0, 0); }
#pragma unroll
    for (int r = 0; r < 4; ++r) { out[(16 * mi + 4 * g + r) * 65 + 16 * nj + fr] = acc0[r]; out[(16 * mi + 4 * g + r) * 65 + 16 * nj + 16 + fr] = acc1[r]; }
}

__device__ __forceinline__ void win_unit(AP a, unsigned char* lds, int u) {
    float* tile = (float*)(lds + LDS_TILE); float* T = (float*)(lds + LDS_T64);
    const int tid = tid_opaque();
    const int l = u / 448, r = u % 448, kb = r / 28, nb = r % 28;
    const float* Win = a->in[6] + (size_t)l * 1024 * 1536;
    const int srccol = (nb >= 8) ? nb * 64 - 256 : (nb & 3) * 64;
    tile_load(tile, Win + (size_t)(kb * 64) * 1536 + srccol, 1536);
    if (nb < 8 && tid < 64) { T[tid] = cospif((float)tid / 32.0f); T[64 + tid] = sinpif((float)tid / 32.0f); }
    __syncthreads();
    bf16_t* dst = (bf16_t*)(a->ws + WS_WIN) + ((size_t)l * ZC + nb * 64) * 1024 + kb * 64;
    if (nb >= 8) tile_store_T(tile, dst, 1024);
    else {
        const int part = nb >> 2;
        float* Tm = (float*)(lds + 65536); float* out = (float*)(lds + 98304);
        for (int i = tid; i < 4096; i += NT) { const int c = i >> 6, cp = i & 63; const float t = T[part * 64 + ((c * cp) & 63)]; Tm[i] = (part ? -t : t) * 0.125f; }
        __syncthreads();
        mm64_f32(tile, 65, Tm, 64, 64, out);
        __syncthreads();
        tile_store_T(out, dst, 1024);
    }
    __syncthreads();
}

__device__ __forceinline__ void wout_unit(AP a, unsigned char* lds, int u) {
    float* tile = (float*)(lds + LDS_TILE);
    __syncthreads();
    const int tid = tid_opaque();
    const int l = u / 256, r = u % 256, kb = r / 16, nb = r % 16;
    const float* Wo = a->in[13] + (size_t)l * 1024 * 1024;
    const int n = tid & 63, kq = __builtin_amdgcn_readfirstlane(tid >> 6);
    if (kb < 4) {
        float* tA = (float*)lds; float* tB = (float*)(lds + 65536);
        const float* wf = a->in[7] + (size_t)l * 256 * 256 + (size_t)(kb * 64) * 256;
        __syncthreads();
        f32x4 va[8], vb[8];
#pragma unroll
        for (int i = 0; i < 8; ++i) { const int q = tid + 512 * i; va[i] = *(const f32x4*)(wf + (size_t)q * 4); vb[i] = *(const f32x4*)(Wo + (size_t)(q >> 4) * 1024 + nb * 64 + (q & 15) * 4); }
#pragma unroll
        for (int i = 0; i < 8; ++i) { const int q = tid + 512 * i; *(f32x4*)(tA + (size_t)q * 4) = va[i]; *(f32x4*)(tB + (size_t)q * 4) = vb[i]; }
        __syncthreads();
        tile = (float*)(lds + 133120);
        mm64_f32(tA, 256, tB, 64, 256, tile);
    } else if (kb >= 8 && kb < 12) {
        const int g = kb - 8;
        float* tA = (float*)lds; float* tB = (float*)(lds + 65536);
        const float* wp = a->in[9] + (size_t)(l * 4 + g) * 64 * 64;
        const float* ps = a->in[10] + l * 256 + g * 64;
        f32x4 va[2], vb[2];
#pragma unroll
        for (int i = 0; i < 2; ++i) { const int q = tid + 512 * i; va[i] = *(const f32x4*)(wp + (size_t)q * 4); vb[i] = *(const f32x4*)(Wo + (size_t)(512 + g * 64 + (q >> 4)) * 1024 + nb * 64 + (q & 15) * 4) * ps[q >> 4]; }
#pragma unroll
        for (int i = 0; i < 2; ++i) { const int q = tid + 512 * i; *(f32x4*)(tA + (size_t)q * 4) = va[i]; *(f32x4*)(tB + (size_t)q * 4) = vb[i]; }
        __syncthreads();
        tile = (float*)(lds + 133120);
        mm64_f32(tA, 64, tB, 64, 64, tile);
    } else tile_load(tile, Wo + (size_t)(kb * 64) * 1024 + nb * 64, 1024);
    __syncthreads();
    tile_store_T(tile, (bf16_t*)(a->ws + WS_WOUT) + ((size_t)l * 1024 + nb * 64) * 1024 + kb * 64, 1024);
    __syncthreads();
}

__device__ __forceinline__ void exp_src_dst(AP a, int l, int u, const float*& src, int& srcld, bf16_t*& dst, int& dstld) {
    const int mat = u / 1024, e = (u % 1024) / 32, t = u % 32;
    const int kb = (mat < 2) ? t / 4 : t / 8, nb = (mat < 2) ? t % 4 : t % 8;
    srcld = (mat < 2) ? 512 : 1024; dstld = (mat < 2) ? 1024 : 512;
    src = a->in[18 + mat] + ((size_t)(l * 32 + e) * 512 * 1024) + (size_t)(kb * 128) * srcld + nb * 128;
    dst = (bf16_t*)(a->ws + WS_WEXP + (size_t)l * WEXP_LAYER) + (size_t)mat * EXPMAT + (size_t)e * 512 * 1024 + (size_t)(nb * 128) * dstld + kb * 128;
}
#define EXP_LOAD(vv, uu) do { exp_src_dst(a, l, (uu), src, srcld, dst, dstld); _Pragma("unroll") for (int _i = 0; _i < 8; ++_i) vv[_i] = *(const f32x4*)(src + (size_t)((tid >> 5) + 16 * _i) * srcld + (tid & 31) * 4); } while (0)
#define EXP_PUT(vv) do { _Pragma("unroll") for (int _i = 0; _i < 8; ++_i) { float* tp = tile + ((tid >> 5) + 16 * _i) * 129 + (tid & 31) * 4; tp[0] = vv[_i][0]; tp[1] = vv[_i][1]; tp[2] = vv[_i][2]; tp[3] = vv[_i][3]; } } while (0)
#define EXP_STORE(dd, ld_) do { const int n = tid >> 2, kq = tid & 3; _Pragma("unroll") for (int j = 0; j < 4; ++j) { const float* tp = tile + (kq * 32 + j * 8) * 129 + n; u32x4 w; \
        w.x = pack2(tp[0], tp[129]); w.y = pack2(tp[2 * 129], tp[3 * 129]); w.z = pack2(tp[4 * 129], tp[5 * 129]); w.w = pack2(tp[6 * 129], tp[7 * 129]); \
        *(u32x4*)((dd) + (size_t)n * (ld_) + kq * 32 + j * 8) = w; } } while (0)
__device__ __forceinline__ void exp_range(AP a, unsigned char* lds, int l, int u0, int u_end) {
    float* tile = (float*)lds;
    const int tid = tid_opaque();
    __syncthreads();
    if (u0 >= u_end) return;
    const float* src; bf16_t* dst; int srcld, dstld;
    f32x4 va[8], vb[8];
    bf16_t *da, *db = nullptr; int lda_, ldb_ = 0;
    EXP_LOAD(va, u0); da = dst; lda_ = dstld;
    if (u0 + 1 < u_end) { EXP_LOAD(vb, u0 + 1); db = dst; ldb_ = dstld; }
    for (int u = u0; u < u_end; u += 2) {
        EXP_PUT(va);
        __syncthreads();
        { bf16_t* cd = da; const int cl = lda_; if (u + 2 < u_end) { EXP_LOAD(va, u + 2); da = dst; lda_ = dstld; } EXP_STORE(cd, cl); }
        __syncthreads();
        if (u + 1 < u_end) {
            EXP_PUT(vb);
            __syncthreads();
            { bf16_t* cd = db; const int cl = ldb_; if (u + 3 < u_end) { EXP_LOAD(vb, u + 3); db = dst; ldb_ = dstld; } EXP_STORE(cd, cl); }
            __syncthreads();
        }
    }
}
#undef EXP_LOAD
#undef EXP_PUT
#undef EXP_STORE
__device__ __forceinline__ void exp_queue(AP a, unsigned char* lds, int l) {
    const int tid = tid_opaque();
    int* qslot = (int*)(lds + MISC_OFF + 128);
    unsigned* qc = (unsigned*)(a->ws + WS_BAR + 14336 + l * 256);
    for (;;) {
        __syncthreads();
        if (tid == 0) *qslot = (int)__hip_atomic_fetch_add(qc, 4u, __ATOMIC_RELAXED, __HIP_MEMORY_SCOPE_AGENT);
        __syncthreads();
        const int c0 = *qslot;
        if (c0 >= U_EXP) break;
        exp_range(a, lds, l, c0, c0 + 4);
    }
}

__device__ __forceinline__ void exp_fill(AP a, unsigned char* lds, int ql, int budget) {
    const int tid = tid_opaque();
    int* qslot = (int*)(lds + MISC_OFF + 128);
    unsigned* qc = (unsigned*)(a->ws + WS_BAR + 14336 + ql * 256);
    for (int done = 0; done < budget; done += 2) {
        __syncthreads();
        if (tid == 0) *qslot = (int)__hip_atomic_fetch_add(qc, 2u, __ATOMIC_RELAXED, __HIP_MEMORY_SCOPE_AGENT);
        __syncthreads();
        const int c0 = *qslot;
        if (c0 >= U_EXP) break;
        exp_range(a, lds, ql, c0, c0 + 2);
    }
    __syncthreads();
}

__device__ __forceinline__ void p0_prologue(AP a, unsigned char* lds) {
    const int tid = tid_opaque();
    bool have_tab = false;
    constexpr int E0 = U_ADA, E1 = E0 + U_WIN, E2 = E1 + U_WOUT, E3 = E2 + U_SGU, E4 = E3 + U_DFT, E5 = E4 + U_ROPE;
    int u = blockIdx.x;
    for (; u < E5; u += gridDim.x) {
        if (u < E0) ada_unit(a, lds, u);
        else if (u < E1) win_unit(a, lds, u - E0);
        else if (u < E2) wout_unit(a, lds, u - E1);
        else if (u < E3) { const size_t i0 = (size_t)(u - E2) * 4096 + tid * 8; const float* s = a->in[11] + i0; bf16_t* d = (bf16_t*)(a->ws + WS_WSGU) + i0;
            const f32x4 v0 = *(const f32x4*)s, v1 = *(const f32x4*)(s + 4); u32x4 w; w.x = pack2(v0[0], v0[1]); w.y = pack2(v0[2], v0[3]); w.z = pack2(v1[0], v1[1]); w.w = pack2(v1[2], v1[3]); *(u32x4*)d = w; }
        else if (u < E4) {
            float* ctab = (float*)(lds + LDS_CTAB);
            if (!have_tab) { for (int i = tid; i < 4096; i += NT) ctab[i] = cospif((float)i / 2048.0f); __syncthreads(); have_tab = true; }
            const int k = u - E3 + 4096;
            if (tid < 32) {
                const int kk = k - 4096, n0 = tid * 8; float c[8], s[8];
#pragma unroll
                for (int e = 0; e < 8; ++e) { const int idx = ((kk * (n0 + e)) & 255) * 16; c[e] = ctab[idx] * (1.0f / 16.0f); s[e] = ctab[(idx - 1024) & 4095] * (1.0f / 16.0f); }
                bf16_t* d = (bf16_t*)(a->ws + WS_DFTC) + (size_t)kk * 512 + n0;
                u32x4 w; w.x = pack2(c[0], c[1]); w.y = pack2(c[2], c[3]); w.z = pack2(c[4], c[5]); w.w = pack2(c[6], c[7]); *(u32x4*)d = w;
                w.x = pack2(s[0], s[1]); w.y = pack2(s[2], s[3]); w.z = pack2(s[4], s[5]); w.w = pack2(s[6], s[7]); *(u32x4*)(d + 256) = w;
            }
        }
        else {
            for (int i = tid; i < 1024; i += NT) { const int pos = i >> 4, f = i & 15; const float freq = powf(10000.0f, -(float)f / 16.0f); const float ang = (float)pos * freq;
                ((float2*)(a->ws + WS_ROPE))[i] = make_float2(cosf(ang), sinf(ang)); }
        }
    }
}

__device__ __forceinline__ void p_lnmod0(AP a) {
    const int tid = tid_opaque(), lane = tid & 63, w = tid >> 6;
    const float* mod = (const float*)(a->ws + WS_MOD);
    bf16_t* H = (bf16_t*)(a->ws + WS_H);
    const int tstep = gridDim.x * 8;
    f32x4 nx[4];
    { const int t = blockIdx.x * 8 + w; if (t < NTOK) { const float* src = (t < NLAT) ? a->in[0] + (size_t)t * D : a->in[2] + (size_t)(t - NLAT) * D;
#pragma unroll
        for (int i = 0; i < 4; ++i) nx[i] = *(const f32x4*)(src + 256 * i + 4 * lane); } }
    int mrow = -1; f32x4 msh[4], msc[4];
    for (int t = blockIdx.x * 8 + w; t < NTOK; t += tstep) {
        const int mr = (t < NLAT) ? (t >> 12) : 4;
        if (mr != mrow) { mrow = mr; const float* m = mod + (size_t)mr * 6144;
#pragma unroll
            for (int i = 0; i < 4; ++i) { msh[i] = *(const f32x4*)(m + 256 * i + 4 * lane); msc[i] = *(const f32x4*)(m + 1024 + 256 * i + 4 * lane); } }
        f32x4 v[4];
#pragma unroll
        for (int i = 0; i < 4; ++i) v[i] = nx[i];
        { const int tn = t + tstep; if (tn < NTOK) { const float* src = (tn < NLAT) ? a->in[0] + (size_t)tn * D : a->in[2] + (size_t)(tn - NLAT) * D;
#pragma unroll
            for (int i = 0; i < 4; ++i) nx[i] = *(const f32x4*)(src + 256 * i + 4 * lane); } }
        float mean, rstd; ln_stats(v, mean, rstd);
#pragma unroll
        for (int i = 0; i < 4; ++i) { const int c = 256 * i + 4 * lane;
            f32x4 o;
#pragma unroll
            for (int e = 0; e < 4; ++e) o[e] = (v[i][e] - mean) * rstd * (1.0f + msc[i][e]) + msh[i][e];
            u32x2 pk; pk.x = pack2(o[0], o[1]); pk.y = pack2(o[2], o[3]); *(u32x2*)(H + (size_t)t * D + c) = pk; }
    }
}

__device__ __forceinline__ void p1_inproj(AP a, unsigned char* smem, LAS unsigned char* lds, int l);
__device__ __forceinline__ void rope32(float (&t)[32], const float2* tab) {
#pragma unroll
    for (int f = 0; f < 16; ++f) { const float2 cs = tab[f]; const float t1 = t[f], t2 = t[16 + f]; t[f] = t1 * cs.x - t2 * cs.y; t[16 + f] = t1 * cs.y + t2 * cs.x; }
}
__device__ __forceinline__ void load32(float (&t)[32], const bf16_t* p) {
#pragma unroll
    for (int q = 0; q < 4; ++q) { const u32x4 w = *(const u32x4*)(p + 8 * q);
        t[8 * q + 0] = lo2f(w.x); t[8 * q + 1] = hi2f(w.x); t[8 * q + 2] = lo2f(w.y); t[8 * q + 3] = hi2f(w.y);
        t[8 * q + 4] = lo2f(w.z); t[8 * q + 5] = hi2f(w.z); t[8 * q + 6] = lo2f(w.w); t[8 * q + 7] = hi2f(w.w); }
}

__device__ __forceinline__ float kdot(const bf16_t* kp, const bf16_t* q, const float2* tab0, const float2* tab1, bool do_rope) {
    float dot = 0.f;
#pragma unroll 1
    for (int ax = 0; ax < 2; ++ax) {
        const float2* tab = ax ? tab1 : tab0;
#pragma unroll 1
        for (int h8 = 0; h8 < 2; ++h8) {
            const u32x4 wl = *(const u32x4*)(kp + ax * 32 + h8 * 8), wh = *(const u32x4*)(kp + ax * 32 + 16 + h8 * 8);
            const float tl[8] = {lo2f(wl.x), hi2f(wl.x), lo2f(wl.y), hi2f(wl.y), lo2f(wl.z), hi2f(wl.z), lo2f(wl.w), hi2f(wl.w)};
            const float th[8] = {lo2f(wh.x), hi2f(wh.x), lo2f(wh.y), hi2f(wh.y), lo2f(wh.z), hi2f(wh.z), lo2f(wh.w), hi2f(wh.w)};
#pragma unroll
            for (int j = 0; j < 8; ++j) {
                float r1 = tl[j], r2 = th[j];
                if (do_rope) { const float2 cs = tab[h8 * 8 + j]; r1 = tl[j] * cs.x - th[j] * cs.y; r2 = tl[j] * cs.y + th[j] * cs.x; }
                dot += bf2f(q[ax * 32 + h8 * 8 + j]) * r1 + bf2f(q[ax * 32 + 16 + h8 * 8 + j]) * r2;
            }
        }
    }
    return dot;
}

__device__ __forceinline__ void mixer_tile(AP a, unsigned char* lds, int l, int row0, int seq_row0, int pos0, int n, int b, bool is_ctx) {
    const int tid = tid_opaque(), lane = tid & 63, w = tid >> 6;
    const bf16_t* Z = (const bf16_t*)(a->ws + WS_Z);
    bf16_t* CAT = (bf16_t*)(a->ws + WS_CAT);
    {
        const int c = tid & 255, half = tid >> 8, g = c >> 6, hw = 1 << g;
        for (int tl = half * 64; tl < half * 64 + 64; ++tl) {
            const int pos = pos0 + tl; const int lo = max(pos - hw, 0), hi = min(pos + hw, n);
            float s = 0.f; for (int j = lo; j < hi; ++j) s += bf2f(Z[(size_t)(seq_row0 + j) * ZC + 1024 + c]);
            const float self = bf2f(Z[(size_t)(seq_row0 + pos) * ZC + 1024 + c]);
            CAT[(size_t)(row0 + tl) * D + 512 + c] = f2bf(s / (float)(hi - lo) - self);
        }
    }
    bf16_t* vT = (bf16_t*)lds;
    for (int q = w; q < 128; q += 8) {
        const u32x2 gw = *(const u32x2*)(Z + (size_t)(row0 + q) * ZC + 1536 + 4 * lane);
        float gv[4] = {gelu_erf(lo2f(gw.x)), gelu_erf(hi2f(gw.x)), gelu_erf(lo2f(gw.y)), gelu_erf(hi2f(gw.y))};
        float s = wave_sum((gv[0] + gv[1]) + (gv[2] + gv[3])); const float mean = s * (1.0f / 256.0f);
        float qq = 0.f;
#pragma unroll
        for (int e = 0; e < 4; ++e) { const float d = gv[e] - mean; qq += d * d; }
        qq = wave_sum(qq); const float rstd = 1.0f / sqrtf(qq * (1.0f / 256.0f) + 1e-6f);
#pragma unroll
        for (int e = 0; e < 4; ++e) vT[(4 * lane + e) * 128 + q] = f2bf((gv[e] - mean) * rstd);
    }
    __syncthreads();
    {
        const int c = tid & 255, ph = tid >> 8, h = c >> 6;
        const bf16_t* Ws = (const bf16_t*)(a->ws + WS_WSGU) + (size_t)(l * 4 + h) * 128 * 128;
        const float* bs = a->in[12] + (size_t)(l * 4 + h) * 128;
        for (int p = ph * 64; p < ph * 64 + 64; ++p) {
            float s = 0.f;
#pragma unroll 2
            for (int q8 = 0; q8 < 16; ++q8) {
                const u32x4 ww = *(const u32x4*)(Ws + (size_t)p * 128 + q8 * 8);
                const u32x4 vv = *(const u32x4*)(vT + c * 128 + q8 * 8);
                s += lo2f(ww.x) * lo2f(vv.x) + hi2f(ww.x) * hi2f(vv.x) + lo2f(ww.y) * lo2f(vv.y) + hi2f(ww.y) * hi2f(vv.y)
                   + lo2f(ww.z) * lo2f(vv.z) + hi2f(ww.z) * hi2f(vv.z) + lo2f(ww.w) * lo2f(vv.w) + hi2f(ww.w) * hi2f(vv.w);
            }
            const float uv = gelu_erf(bf2f(Z[(size_t)(row0 + p) * ZC + 1280 + c]));
            CAT[(size_t)(row0 + p) * D + 768 + c] = f2bf(uv * (s + bs[p]));
        }
    }
    __syncthreads();
    {
        const int i = tid & 127, h = tid >> 7, kvh = h >> 1;
        const float2* rope = (const float2*)(a->ws + WS_ROPE);
        const int qpos = pos0 + i;
        bf16_t* q = (bf16_t*)lds + tid * 66;
        {
            float t0[32];
            load32(t0, Z + (size_t)(row0 + i) * ZC + 512 + h * 64);
            if (!is_ctx) rope32(t0, rope + (qpos >> 6) * 16);
#pragma unroll
            for (int d = 0; d < 32; ++d) q[d] = f2bf(t0[d]);
            load32(t0, Z + (size_t)(row0 + i) * ZC + 512 + h * 64 + 32);
            if (!is_ctx) rope32(t0, rope + (qpos & 63) * 16);
#pragma unroll
            for (int d = 0; d < 32; ++d) q[32 + d] = f2bf(t0[d]);
        }
#pragma unroll 1
        for (int dh = 0; dh < 2; ++dh) {
        float m = a->in[8][l * 4 + h], den = 1.0f;
        float o[32];
#pragma unroll
        for (int d = 0; d < 32; ++d) o[d] = 0.f;
        if (!is_ctx) {
            const bf16_t* VT = (const bf16_t*)(a->ws + WS_VT) + ((size_t)(b * 2 + kvh) * 64 + dh * 32) * 4096;
            const int slo = max(qpos - 128, 0), shi = min(qpos + 128, n - 1);
#pragma unroll 1
            for (int s = slo; s <= shi; ++s) {
                const float dot = 0.125f * kdot(Z + (size_t)(seq_row0 + s) * ZC + 768 + kvh * 64, q, rope + (s >> 6) * 16, rope + (s & 63) * 16, true);
                const float mn = fmaxf(m, dot), corr = __expf(m - mn), p = __expf(dot - mn);
                den = den * corr + p; m = mn;
#pragma unroll
                for (int d = 0; d < 32; ++d) o[d] = o[d] * corr + p * bf2f(VT[(size_t)d * 4096 + s]);
            }
        }
        {
            const bf16_t* VTC = (const bf16_t*)(a->ws + WS_VTC) + ((size_t)(b * 2 + kvh) * 64 + dh * 32) * 256;
#pragma unroll 1
            for (int j = 0; j < 256; ++j) {
                const float dot = 0.125f * kdot(Z + (size_t)(NLAT + b * 256 + j) * ZC + 768 + kvh * 64, q, rope, rope, false);
                const float mn = fmaxf(m, dot), corr = __expf(m - mn), p = __expf(dot - mn);
                den = den * corr + p; m = mn;
#pragma unroll
                for (int d = 0; d < 32; ++d) o[d] = o[d] * corr + p * bf2f(VTC[(size_t)d * 256 + j]);
            }
        }
        const float inv = 1.0f / den;
        bf16_t* dst = CAT + (size_t)(row0 + i) * D + 256 + h * 64 + dh * 32;
#pragma unroll
        for (int d8 = 0; d8 < 4; ++d8) { u32x4 pk; pk.x = pack2(o[8 * d8] * inv, o[8 * d8 + 1] * inv); pk.y = pack2(o[8 * d8 + 2] * inv, o[8 * d8 + 3] * inv);
            pk.z = pack2(o[8 * d8 + 4] * inv, o[8 * d8 + 5] * inv); pk.w = pack2(o[8 * d8 + 6] * inv, o[8 * d8 + 7] * inv); *(u32x4*)(dst + 8 * d8) = pk; }
        }
    }
    __syncthreads();
}

__device__ __forceinline__ u32x4 ld16g(const bf16_t* p) { return *(const u32x4*)p; }
__device__ __forceinline__ void rope_pack8(u32x4& wl, u32x4& wh, const LAS f32x2* tab, bool do_rope, float scale) {
    float tl[8] = {lo2f(wl.x), hi2f(wl.x), lo2f(wl.y), hi2f(wl.y), lo2f(wl.z), hi2f(wl.z), lo2f(wl.w), hi2f(wl.w)};
    float th[8] = {lo2f(wh.x), hi2f(wh.x), lo2f(wh.y), hi2f(wh.y), lo2f(wh.z), hi2f(wh.z), lo2f(wh.w), hi2f(wh.w)};
#pragma unroll
    for (int j = 0; j < 8; ++j) {
        float r1 = tl[j], r2 = th[j];
        if (do_rope) { const f32x2 cs = tab[j]; r1 = tl[j] * cs.x - th[j] * cs.y; r2 = tl[j] * cs.y + th[j] * cs.x; }
        tl[j] = r1 * scale; th[j] = r2 * scale;
    }
    wl.x = pack2(tl[0], tl[1]); wl.y = pack2(tl[2], tl[3]); wl.z = pack2(tl[4], tl[5]); wl.w = pack2(tl[6], tl[7]);
    wh.x = pack2(th[0], th[1]); wh.y = pack2(th[2], th[3]); wh.z = pack2(th[4], th[5]); wh.w = pack2(th[6], th[7]);
}

__device__ __forceinline__ void mixer_sgu_pool(AP a, LAS unsigned char* lds, int l, int row0, int seq_row0, int pos0, int n) {
    const int tid = tid_opaque(), lane = tid & 63, w = __builtin_amdgcn_readfirstlane(tid >> 6), fr = lane & 15, g = lane >> 4;
    const bf16_t* Z = (const bf16_t*)(a->ws + WS_Z);
    bf16_t* CAT = (bf16_t*)(a->ws + WS_CAT);
    {
#pragma unroll
        for (int it = 0; it < 9; ++it) { const int id = tid + 512 * it, rr = id >> 5, ch = id & 31, j = pos0 - 8 + rr;
            u32x4 v = (u32x4){0u, 0u, 0u, 0u};
            if (j >= 0 && j < n) v = ld16g(Z + (size_t)(seq_row0 + j) * ZC + 1024 + ch * 8);
            *(LAS u32x4*)(lds + rr * 512 + ch * 16) = v; }
        __syncthreads();
        const int c = tid & 255, half = tid >> 8, hw = 1 << (c >> 6);
        const LAS bf16_t* P = (const LAS bf16_t*)lds + c;
        const int t0 = half * 64;
        float s = 0.f;
        for (int j = t0 - hw; j < t0 + hw; ++j) s += bf2f(P[(8 + j) * 256]);
        for (int tl = t0; tl < t0 + 64; ++tl) {
            const int pos = pos0 + tl; const int lo = max(pos - hw, 0), hi = min(pos + hw, n);
            CAT[(size_t)(row0 + tl) * D + 512 + c] = f2bf(s / (float)(hi - lo) - bf2f(P[(8 + tl) * 256]));
            s += bf2f(P[(8 + tl + hw) * 256]) - bf2f(P[(8 + tl - hw) * 256]);
        }
        __syncthreads();
    }
    {
        const int i16 = lane & 15;
        u32x4 gw[4][2];
#pragma unroll
        for (int ps = 0; ps < 4; ++ps) { const int q = w * 16 + ps * 4 + g; const bf16_t* src = Z + (size_t)(row0 + q) * ZC + 1536 + 16 * i16; gw[ps][0] = ld16g(src); gw[ps][1] = ld16g(src + 8); }
#pragma unroll
        for (int ps = 0; ps < 4; ++ps) {
            const int q = w * 16 + ps * 4 + g;
            float gv[16];
#pragma unroll
            for (int hh = 0; hh < 2; ++hh) { const u32x4 x = gw[ps][hh];
                gv[8 * hh + 0] = gelu_erf(lo2f(x.x)); gv[8 * hh + 1] = gelu_erf(hi2f(x.x)); gv[8 * hh + 2] = gelu_erf(lo2f(x.y)); gv[8 * hh + 3] = gelu_erf(hi2f(x.y));
                gv[8 * hh + 4] = gelu_erf(lo2f(x.z)); gv[8 * hh + 5] = gelu_erf(hi2f(x.z)); gv[8 * hh + 6] = gelu_erf(lo2f(x.w)); gv[8 * hh + 7] = gelu_erf(hi2f(x.w)); }
            float sm = 0.f;
#pragma unroll
            for (int e = 0; e < 16; ++e) sm += gv[e];
            const float mean = row_sum16(sm) * (1.0f / 256.0f);
            float qq = 0.f;
#pragma unroll
            for (int e = 0; e < 16; ++e) { const float d = gv[e] - mean; qq += d * d; }
            const float rstd = 1.0f / sqrtf(row_sum16(qq) * (1.0f / 256.0f) + 1e-6f);
#pragma unroll
            for (int e = 0; e < 16; ++e) { const int c = 16 * i16 + e; *(LAS bf16_t*)(lds + c * 256 + ((((q >> 3) ^ (c & 15))) << 4) + (q & 7) * 2) = f2bf((gv[e] - mean) * rstd); }
        }
    }
    __syncthreads();
    {
        const int h = w >> 1, ph = w & 1;
        const bf16_t* Ws = (const bf16_t*)(a->ws + WS_WSGU) + (size_t)(l * 4 + h) * 128 * 128;
        const float* bs = a->in[12] + (size_t)(l * 4 + h) * 128;
        f32x4 acc[4][4];
#pragma unroll
        for (int i = 0; i < 4; ++i)
#pragma unroll
            for (int j = 0; j < 4; ++j) acc[i][j] = (f32x4){0.f, 0.f, 0.f, 0.f};
#pragma unroll
        for (int ks = 0; ks < 4; ++ks) {
            bf16x8 af[4], bfv[4];
#pragma unroll
            for (int cf = 0; cf < 4; ++cf) { const int c = h * 64 + 16 * cf + fr; af[cf] = *(const LAS bf16x8*)(lds + c * 256 + (((4 * ks + g) ^ (c & 15)) << 4)); }
#pragma unroll
            for (int pf = 0; pf < 4; ++pf) { const int p = ph * 64 + 16 * pf + fr; bfv[pf] = *(const bf16x8*)(Ws + (size_t)p * 128 + 32 * ks + 8 * g); }
#pragma unroll
            for (int cf = 0; cf < 4; ++cf)
#pragma unroll
                for (int pf = 0; pf < 4; ++pf) acc[cf][pf] = __builtin_amdgcn_mfma_f32_16x16x32_bf16(af[cf], bfv[pf], acc[cf][pf], 0, 0, 0);
        }
#pragma unroll
        for (int pf = 0; pf < 4; ++pf) { const int p = ph * 64 + 16 * pf + fr; const float bias = bs[p];
#pragma unroll
            for (int cf = 0; cf < 4; ++cf) { const int c0 = h * 64 + 16 * cf + 4 * g;
                const u32x2 uw = *(const u32x2*)(Z + (size_t)(row0 + p) * ZC + 1280 + c0);
                u32x2 o; o.x = pack2(gelu_erf(lo2f(uw.x)) * (acc[cf][pf][0] + bias), gelu_erf(hi2f(uw.x)) * (acc[cf][pf][1] + bias));
                o.y = pack2(gelu_erf(lo2f(uw.y)) * (acc[cf][pf][2] + bias), gelu_erf(hi2f(uw.y)) * (acc[cf][pf][3] + bias));
                *(u32x2*)(CAT + (size_t)(row0 + p) * D + 768 + c0) = o; } }
    }
    __syncthreads();
}

__device__ __forceinline__ void mixer_attn(AP a, LAS unsigned char* lds, int l, int row0, int seq_row0, int pos0, int n, int b, bool is_ctx, int kvh) {
    const int tid = tid_opaque(), lane = tid & 63, w = __builtin_amdgcn_readfirstlane(tid >> 6), fr = lane & 15, g = lane >> 4;
    const bf16_t* Z = (const bf16_t*)(a->ws + WS_Z);
    bf16_t* CAT = (bf16_t*)(a->ws + WS_CAT);
    __syncthreads();
    ((LAS u32x4*)(lds + 98304))[tid] = ((const u32x4*)(a->ws + WS_ROPE))[tid];
    const LAS f32x2* rope = (const LAS f32x2*)(lds + 98304);
    constexpr float QS = 0.125f * 1.44269504088896341f;
    constexpr int QS_OFF = 0, KS_OFF = 32768, VS_OFF = 65536;
    const int nbq = pos0 >> 7;
    unsigned bmask = 0x18u;
    if (!is_ctx) { if (nbq > 0) bmask |= 1u; bmask |= 2u; if (nbq + 1 < (n >> 7)) bmask |= 4u; }
    const int kr = tid >> 2, kax = (tid >> 1) & 1, kh8 = tid & 1;
#define MX_KSRC(blk) (Z + (size_t)((((blk) < 3) ? seq_row0 + (nbq + (blk) - 1) * 128 : NLAT + b * 256 + ((blk) - 3) * 128) + kr) * ZC + 768 + kvh * 64 + kax * 32 + kh8 * 8)
#define MX_VSTAGE(blk, buf) do { const bool _band = (blk) < 3; const int _key0 = _band ? (nbq + (blk) - 1) * 128 : ((blk) - 3) * 128; \
        const bf16_t* _vs = _band ? (const bf16_t*)(a->ws + WS_VT) + (size_t)(b * 2 + kvh) * 64 * 4096 + _key0 : (const bf16_t*)(a->ws + WS_VTC) + (size_t)(b * 2 + kvh) * 64 * 256 + _key0; \
        const int _vld = _band ? 4096 : 256; \
        _Pragma("unroll") for (int _i = 0; _i < 2; ++_i) { const int _P = _i * 512 + tid, _d = _P >> 4, _c = (_P & 15) ^ (_d & 15); \
            glds16(_vs + (size_t)_d * _vld + _c * 8, lds + VS_OFF + (buf) * 16384 + _i * 8192 + w * 1024); } } while (0)
    {
        __syncthreads();
#pragma unroll
        for (int it = 0; it < 2; ++it) {
            const int item = tid + 512 * it, r = item >> 2, ax = (item >> 1) & 1, h8 = item & 1, i = r & 127, qpos = pos0 + i;
            const bf16_t* src = Z + (size_t)(row0 + i) * ZC + 512 + (2 * kvh + (r >> 7)) * 64 + ax * 32 + h8 * 8;
            u32x4 wl = ld16g(src), wh = ld16g(src + 16);
            rope_pack8(wl, wh, rope + (ax ? (qpos & 63) : (qpos >> 6)) * 16 + h8 * 8, !is_ctx, QS);
            const int ch = ax * 4 + h8, sw = (r >> 1) & 7;
            *(LAS u32x4*)(lds + QS_OFF + r * 128 + ((ch ^ sw) << 4)) = wl;
            *(LAS u32x4*)(lds + QS_OFF + r * 128 + (((ch + 2) ^ sw) << 4)) = wh;
        }
        const int hh = w >> 2, qb = (w & 3) * 32, h = 2 * kvh + hh;
        float m[2], lsum[2];
        m[0] = m[1] = a->in[8][l * 4 + h] * 1.44269504088896341f;
        lsum[0] = lsum[1] = (g == 0) ? 1.0f : 0.0f;
        f32x4 O[4][2];
#pragma unroll
        for (int i = 0; i < 4; ++i) { O[i][0] = (f32x4){0.f, 0.f, 0.f, 0.f}; O[i][1] = (f32x4){0.f, 0.f, 0.f, 0.f}; }
        bf16x8 Qf[2][2];
        bool have_q = false;
        unsigned rem = bmask;
        int cur = __builtin_ctz(rem); rem &= rem - 1u;
        int buf = 0;
        u32x4 kl = ld16g(MX_KSRC(cur)), kh = ld16g(MX_KSRC(cur) + 16);
        MX_VSTAGE(cur, 0);
#pragma unroll 1
        for (;;) {
            const int jb = cur - 1; const bool band = cur < 3;
            {
                const int kpos = (nbq + jb) * 128 + kr;
                rope_pack8(kl, kh, rope + (kax ? (kpos & 63) : (kpos >> 6)) * 16 + kh8 * 8, band, 1.0f);
                const int ch = kax * 4 + kh8, sw = (kr >> 1) & 7;
                *(LAS u32x4*)(lds + KS_OFF + buf * 16384 + kr * 128 + ((ch ^ sw) << 4)) = kl;
                *(LAS u32x4*)(lds + KS_OFF + buf * 16384 + kr * 128 + (((ch + 2) ^ sw) << 4)) = kh;
            }
            asm volatile("s_waitcnt vmcnt(0)" ::: "memory");
            __syncthreads();
            const int nxt = rem ? __builtin_ctz(rem) : -1; rem &= rem - 1u;
            if (nxt >= 0) { kl = ld16g(MX_KSRC(nxt)); kh = ld16g(MX_KSRC(nxt) + 16); MX_VSTAGE(nxt, buf ^ 1); }
            if (!have_q) {
#pragma unroll
                for (int qf = 0; qf < 2; ++qf)
#pragma unroll
                    for (int ks = 0; ks < 2; ++ks) { const int r = hh * 128 + qb + 16 * qf + fr; Qf[qf][ks] = *(const LAS bf16x8*)(lds + QS_OFF + r * 128 + (((4 * ks + g) ^ ((r >> 1) & 7)) << 4)); }
                have_q = true;
            }
            const int kso = KS_OFF + buf * 16384, vso = VS_OFF + buf * 16384;
            f32x4 S[8][2];
#pragma unroll
            for (int kf = 0; kf < 8; ++kf) { S[kf][0] = (f32x4){0.f, 0.f, 0.f, 0.f}; S[kf][1] = (f32x4){0.f, 0.f, 0.f, 0.f}; }
#pragma unroll
            for (int kf = 0; kf < 8; ++kf)
#pragma unroll
                for (int ks = 0; ks < 2; ++ks) { const int r = 16 * kf + fr;
                    const bf16x8 kfr = *(const LAS bf16x8*)(lds + kso + r * 128 + (((4 * ks + g) ^ ((r >> 1) & 7)) << 4));
                    S[kf][0] = __builtin_amdgcn_mfma_f32_16x16x32_bf16(kfr, Qf[0][ks], S[kf][0], 0, 0, 0);
                    S[kf][1] = __builtin_amdgcn_mfma_f32_16x16x32_bf16(kfr, Qf[1][ks], S[kf][1], 0, 0, 0); }
            bf16x8 Pp[4][2];
#pragma unroll
            for (int qf = 0; qf < 2; ++qf) {
                const int qi = qb + 16 * qf + fr;
                if (band && jb != 0) {
#pragma unroll
                    for (int kf = 0; kf < 8; ++kf)
#pragma unroll
                        for (int r = 0; r < 4; ++r) { const int kk = 16 * kf + 4 * g + r; const bool ok = (jb < 0) ? (kk >= qi) : (kk <= qi); if (!ok) S[kf][qf][r] = -1.0e30f; }
                }
                float mx = S[0][qf][0];
#pragma unroll
                for (int kf = 0; kf < 8; ++kf)
#pragma unroll
                    for (int r = 0; r < 4; ++r) mx = fmaxf(mx, S[kf][qf][r]);
                mx = fmaxf(mx, __shfl_xor(mx, 16)); mx = fmaxf(mx, __shfl_xor(mx, 32));
                const float mn = fmaxf(m[qf], mx), corr = __builtin_amdgcn_exp2f(m[qf] - mn);
                m[qf] = mn;
                float ps = 0.f;
#pragma unroll
                for (int kf = 0; kf < 8; ++kf)
#pragma unroll
                    for (int r = 0; r < 4; ++r) { const float p = __builtin_amdgcn_exp2f(S[kf][qf][r] - mn); S[kf][qf][r] = p; ps += p; }
                lsum[qf] = lsum[qf] * corr + ps;
#pragma unroll
                for (int df = 0; df < 4; ++df) O[df][qf] *= corr;
#pragma unroll
                for (int t = 0; t < 4; ++t) { u32x4 pw; pw.x = pack2(S[2 * t][qf][0], S[2 * t][qf][1]); pw.y = pack2(S[2 * t][qf][2], S[2 * t][qf][3]);
                    pw.z = pack2(S[2 * t + 1][qf][0], S[2 * t + 1][qf][1]); pw.w = pack2(S[2 * t + 1][qf][2], S[2 * t + 1][qf][3]); Pp[t][qf] = __builtin_bit_cast(bf16x8, pw); }
            }
#pragma unroll
            for (int t = 0; t < 4; ++t)
#pragma unroll
                for (int df = 0; df < 4; ++df) { const int d = 16 * df + fr;
                    const u32x2 v0 = *(const LAS u32x2*)(lds + vso + d * 256 + (((4 * t + (g >> 1)) ^ (d & 15)) << 4) + (g & 1) * 8);
                    const u32x2 v1 = *(const LAS u32x2*)(lds + vso + d * 256 + (((4 * t + 2 + (g >> 1)) ^ (d & 15)) << 4) + (g & 1) * 8);
                    u32x4 vw; vw.x = v0.x; vw.y = v0.y; vw.z = v1.x; vw.w = v1.y; const bf16x8 vf = __builtin_bit_cast(bf16x8, vw);
                    O[df][0] = __builtin_amdgcn_mfma_f32_16x16x32_bf16(vf, Pp[t][0], O[df][0], 0, 0, 0);
                    O[df][1] = __builtin_amdgcn_mfma_f32_16x16x32_bf16(vf, Pp[t][1], O[df][1], 0, 0, 0); }
            if (nxt < 0) break;
            cur = nxt; buf ^= 1;
        }
#pragma unroll
        for (int qf = 0; qf < 2; ++qf) {
            float lt = lsum[qf]; lt += __shfl_xor(lt, 16); lt += __shfl_xor(lt, 32);
            const float inv = 1.0f / lt;
            bf16_t* dst = CAT + (size_t)(row0 + qb + 16 * qf + fr) * D + 256 + h * 64 + 4 * g;
#pragma unroll
            for (int df = 0; df < 4; ++df) { u32x2 o; o.x = pack2(O[df][qf][0] * inv, O[df][qf][1] * inv); o.y = pack2(O[df][qf][2] * inv, O[df][qf][3] * inv); *(u32x2*)(dst + 16 * df) = o; }
        }
    }
#undef MX_KSRC
#undef MX_VSTAGE
    __syncthreads();
}

constexpr int FF_DA = 0, FF_DC = 32768, FF_XT = 49152  , FF_Z2 = 81920  , FF_OB = 114688  ;
__device__ __forceinline__ int ff_addr(int row, int k) { return row * 256 + ((((k >> 3) ^ (row & 15))) << 4) + (k & 7) * 2; }
__device__ __forceinline__ float cos_turns(float x) { return __builtin_amdgcn_cosf(x); }
__device__ __forceinline__ float sin_turns(float x) { return __builtin_amdgcn_sinf(x); }
__device__ __forceinline__ void fft_setup(LAS unsigned char* lds) {
    const int tid = tid_opaque();
    __syncthreads();
    for (int idx = tid; idx < 16384; idx += NT) { const int i = idx >> 7, k = idx & 127, ro = i >> 6, k1 = i & 63, part = k >> 6, n1 = k & 63; const float t = (float)((k1 * n1) & 63) * (1.0f / 64.0f);
        const float c = cos_turns(t), sn = sin_turns(t);
        const float v = (ro == 0) ? (part == 0 ? c : sn) : (part == 0 ? -sn : c);
        *(LAS bf16_t*)(lds + FF_DA + ff_addr(i, k)) = f2bf(v * 0.125f); }
    for (int idx = tid; idx < 8192; idx += NT) { const int k2 = idx >> 7, k = idx & 127, ri = k >> 6, n2 = k & 63; const float t = (float)((k2 * n2) & 63) * (1.0f / 64.0f);
        const float v = (ri == 0) ? cos_turns(t) : sin_turns(t);
        *(LAS bf16_t*)(lds + FF_DC + ff_addr(k2, k)) = f2bf(v * 0.125f); }
    __syncthreads();
}
__device__ __forceinline__ void fft_unit(AP a, LAS unsigned char* lds, int b, int cg) {
    const int tid = tid_opaque(), lane = tid & 63, w = __builtin_amdgcn_readfirstlane(tid >> 6), fr = lane & 15, g = lane >> 4;
    const int mf = w & 3, nh = w >> 2;
    const bf16_t* AT = (const bf16_t*)(a->ws + WS_AT) + (size_t)(b * 256 + cg * 4) * 8192;
    u32x4 xin[2][2];
#pragma unroll
    for (int h = 0; h < 2; ++h)
#pragma unroll
        for (int it = 0; it < 2; ++it) xin[h][it] = ld16g(AT + (size_t)h * 8192 + (size_t)(tid + 512 * it) * 8);
#pragma unroll 1
    for (int cp = 0; cp < 2; ++cp) {
#pragma unroll
        for (int h = 0; h < 2; ++h)
#pragma unroll
            for (int it = 0; it < 2; ++it) { const int q = tid + 512 * it, part = q >> 9, pos0 = (q & 511) * 8, n1 = pos0 >> 6, n2 = pos0 & 63, k = part * 64 + n1;
                const unsigned wv[4] = {xin[h][it].x, xin[h][it].y, xin[h][it].z, xin[h][it].w};
#pragma unroll
                for (int e = 0; e < 4; ++e) { *(LAS bf16_t*)(lds + FF_XT + h * 16384 + ff_addr(n2 + 2 * e, k)) = (bf16_t)(wv[e] & 0xffffu); *(LAS bf16_t*)(lds + FF_XT + h * 16384 + ff_addr(n2 + 2 * e + 1, k)) = (bf16_t)(wv[e] >> 16); } }
        if (cp == 0) {
#pragma unroll
            for (int h = 0; h < 2; ++h)
#pragma unroll
                for (int it = 0; it < 2; ++it) xin[h][it] = ld16g(AT + (size_t)(2 + h) * 8192 + (size_t)(tid + 512 * it) * 8); }
        __syncthreads();
        f32x4 acc[2][2][2];
#pragma unroll
        for (int h = 0; h < 2; ++h)
#pragma unroll
            for (int x = 0; x < 2; ++x) { acc[h][x][0] = (f32x4){0.f, 0.f, 0.f, 0.f}; acc[h][x][1] = (f32x4){0.f, 0.f, 0.f, 0.f}; }
#pragma unroll
        for (int ks = 0; ks < 4; ++ks) {
            bf16x8 af[2];
#pragma unroll
            for (int x = 0; x < 2; ++x) { const int i = 16 * (mf + 4 * x) + fr; af[x] = *(const LAS bf16x8*)(lds + FF_DA + i * 256 + (((4 * ks + g) ^ (i & 15)) << 4)); }
#pragma unroll
            for (int h = 0; h < 2; ++h)
#pragma unroll
                for (int n = 0; n < 2; ++n) { const int j = 16 * (2 * nh + n) + fr; const bf16x8 bfv = *(const LAS bf16x8*)(lds + FF_XT + h * 16384 + j * 256 + (((4 * ks + g) ^ (j & 15)) << 4));
                    acc[h][0][n] = __builtin_amdgcn_mfma_f32_16x16x32_bf16(af[0], bfv, acc[h][0][n], 0, 0, 0);
                    acc[h][1][n] = __builtin_amdgcn_mfma_f32_16x16x32_bf16(af[1], bfv, acc[h][1][n], 0, 0, 0); }
        }
#pragma unroll
        for (int n = 0; n < 2; ++n)
#pragma unroll
            for (int r = 0; r < 4; ++r) { const int k1 = 16 * mf + 4 * g + r, n2 = 16 * (2 * nh + n) + fr; const float t = (float)((k1 * n2) & 4095) * (1.0f / 4096.0f);
                const float c = cos_turns(t), sn = sin_turns(t);
#pragma unroll
                for (int h = 0; h < 2; ++h) { const float zr = acc[h][0][n][r], zi = acc[h][1][n][r];
                    *(LAS bf16_t*)(lds + FF_Z2 + h * 16384 + ff_addr(k1, n2)) = f2bf(zr * c + zi * sn);
                    *(LAS bf16_t*)(lds + FF_Z2 + h * 16384 + ff_addr(k1, 64 + n2)) = f2bf(zi * c - zr * sn); } }
        __syncthreads();
        f32x4 acc2[2][2];
#pragma unroll
        for (int h = 0; h < 2; ++h) { acc2[h][0] = (f32x4){0.f, 0.f, 0.f, 0.f}; acc2[h][1] = (f32x4){0.f, 0.f, 0.f, 0.f}; }
#pragma unroll
        for (int ks = 0; ks < 4; ++ks) {
            const int i = 16 * mf + fr; const bf16x8 af = *(const LAS bf16x8*)(lds + FF_DC + i * 256 + (((4 * ks + g) ^ (i & 15)) << 4));
#pragma unroll
            for (int h = 0; h < 2; ++h)
#pragma unroll
                for (int n = 0; n < 2; ++n) { const int j = 16 * (2 * nh + n) + fr; const bf16x8 bfv = *(const LAS bf16x8*)(lds + FF_Z2 + h * 16384 + j * 256 + (((4 * ks + g) ^ (j & 15)) << 4));
                    acc2[h][n] = __builtin_amdgcn_mfma_f32_16x16x32_bf16(af, bfv, acc2[h][n], 0, 0, 0); }
        }
#pragma unroll
        for (int n = 0; n < 2; ++n)
#pragma unroll
            for (int r = 0; r < 4; ++r) { const int k = 16 * (2 * nh + n) + fr + 64 * (16 * mf + 4 * g + r);
                *(LAS unsigned*)(lds + FF_OB + k * 8 + cp * 4) = pack2(acc2[0][n][r], acc2[1][n][r]); }
    }
    __syncthreads();
    bf16_t* CAT = (bf16_t*)(a->ws + WS_CAT) + (size_t)(b * 4096) * D + cg * 4;
#pragma unroll
    for (int it = 0; it < 8; ++it) { const int k = tid + 512 * it; *(u32x2*)(CAT + (size_t)k * D) = *(const LAS u32x2*)(lds + FF_OB + k * 8); }
    __syncthreads();
}

__device__ __forceinline__ void p2_mix(AP a, unsigned char* ldsg, LAS unsigned char* lds, int l) {
    const int n_tile = 128 + ((l == 0) ? 8 : 0), n_att = 2 * n_tile, n_dft = 256, n_dftc = (l == 0) ? 16 : 0;
    bf16_t* CAT = (bf16_t*)(a->ws + WS_CAT);
    bool fft_ready = false;
    for (int u = blockIdx.x; u < n_att + n_dft + n_tile + n_dftc; u += gridDim.x) {
        if (u < n_att || (u >= n_att + n_dft && u < n_att + n_dft + n_tile)) {
            const bool att = u < n_att;
            const int t = att ? (u >> 1) : (u - n_att - n_dft);
            const bool isc = t >= 128; const int tt = t - 128;
            const int b = isc ? (tt >> 1) : (t >> 5);
            const int row0 = isc ? NLAT + tt * 128 : t * 128, seq_row0 = isc ? NLAT + b * 256 : b * 4096, pos0 = isc ? (tt & 1) * 128 : (t & 31) * 128, n = isc ? 256 : 4096;
            if (att) { for (int rep = 0; rep < PROBE_MIX_REP; ++rep) mixer_attn(a, lds, l, row0, seq_row0, pos0, n, b, isc, u & 1); }
            else { for (int rep = 0; rep < PROBE_SGU_REP; ++rep) mixer_sgu_pool(a, lds, l, row0, seq_row0, pos0, n); }
            fft_ready = false;
        } else if (u < n_att + n_dft) {
            const int uu = u - n_att;
            if (!fft_ready) { fft_setup(lds); fft_ready = true; }
            for (int rep = 0; rep < PROBE_FFT_REP; ++rep) fft_unit(a, lds, uu >> 6, uu & 63);
        } else {
            const int uu = u - n_att - n_dft - n_tile, b = uu >> 2, mt = (uu >> 1) & 1, ch0 = (uu & 1) * 128;
            const bf16_t* A = (const bf16_t*)(a->ws + WS_DFTC) + (size_t)(mt * 128) * 512;
            const bf16_t* B0 = (const bf16_t*)(a->ws + WS_ATC) + ((size_t)b * 256 + ch0) * 512;
            EpiBf16 E; E.C = CAT + (size_t)(NLAT + b * 256 + mt * 128) * D + ch0; E.ld = D;
            gemm_tile<128, false, EpiBf16>(lds, A, 512, nullptr, 128, B0, B0 + (size_t)64 * 512, 512, 512, E);
            fft_ready = false;
        }
    }
    exp_queue(a, ldsg, l);
}

__device__ __forceinline__ int uni(int v) { return __builtin_amdgcn_readfirstlane(v); }
__device__ __forceinline__ int vblock() { const int G = gridDim.x, b = blockIdx.x; return (G % 8 == 0) ? (b % 8) * (G / 8) + b / 8 : b; }
template <class T> __device__ __forceinline__ T* unip(T* p) { const unsigned long long v = (unsigned long long)p; const unsigned lo = __builtin_amdgcn_readfirstlane((unsigned)v), hi = __builtin_amdgcn_readfirstlane((unsigned)(v >> 32)); return (T*)(((unsigned long long)hi << 32) | lo); }
struct SchedInProj {
    typedef EpiInProj Epi; static constexpr bool GATHER = false;
    unsigned char* ws; int l, G, me;
    __device__ __forceinline__ bool get(int i, g256::Unit<Epi>& u) const {
        const int n_lat = 64 * 7, n_ctx = (l == 0) ? 4 * 7 : 4;
        const int idx = i * G + me; if (idx >= n_lat + n_ctx) return false;
        int row0, b, ct, n; bf16_t *tF, *tV;
        if (idx < n_lat) { const int rt = idx / 7; ct = idx % 7; row0 = rt * 256; b = row0 >> 12; n = 4096;
            tF = (bf16_t*)(ws + WS_AT) + (size_t)b * 256 * 2 * 4096; tV = (bf16_t*)(ws + WS_VT) + (size_t)b * 128 * 4096; }
        else { const int uu = idx - n_lat; int rt; if (l == 0) { rt = uu / 7; ct = uu % 7; } else { rt = uu; ct = 3; }
            row0 = NLAT + rt * 256; b = rt; n = 256;
            tF = (bf16_t*)(ws + WS_ATC) + (size_t)b * 256 * 2 * 256; tV = (bf16_t*)(ws + WS_VTC) + (size_t)b * 128 * 256; }
        u.A = (const bf16_t*)(ws + WS_H) + (size_t)row0 * D;
        u.B0 = (const bf16_t*)(ws + WS_WIN) + ((size_t)l * ZC + ct * 256) * 1024; u.B1 = u.B0 + (size_t)128 * 1024; u.ridx = nullptr; u.valid = 256;
        u.epi.Zt = (bf16_t*)(ws + WS_Z) + (size_t)row0 * ZC + ct * 256; u.epi.tF = tF; u.epi.tV = tV; u.epi.n0 = ct * 256; u.epi.pos0 = (idx < n_lat) ? (row0 & 4095) : 0; u.epi.n = n;
        return true;
    }
};
struct SchedOutProj {
    typedef EpiBf16 Epi; static constexpr bool GATHER = false;
    unsigned char* ws; int l, G, me;
    __device__ __forceinline__ bool get(int i, g256::Unit<Epi>& u) const {
        const int nrt = NLAT / 256;
        const int idx = i * G + me; if (idx >= nrt * 4) return false;
        const int rt = idx >> 2, ct = idx & 3;
        u.A = (const bf16_t*)(ws + WS_CAT) + (size_t)(rt * 256) * D;
        u.B0 = (const bf16_t*)(ws + WS_WOUT) + ((size_t)l * 1024 + ct * 256) * 1024; u.B1 = u.B0 + (size_t)128 * 1024; u.ridx = nullptr; u.valid = 256;
        u.epi.C = (bf16_t*)(ws + WS_Y) + (size_t)(rt * 256) * D + ct * 256; u.epi.ld = D;
        return true;
    }
};
struct SchedGateUp {
    typedef EpiGateUp Epi; static constexpr bool GATHER = true;
    unsigned char* ws; const LAS int* blk; const LAS int* tot; const LAS int* ridx_lds; int G, me, l;
    __device__ __forceinline__ bool get(int i, g256::Unit<Epi>& u) const {
        const int idx = i * G + me; if (idx >= uni(blk[32]) * 4) return false;
        const int rb = idx >> 2, ct = idx & 3;
        int e = 0;
#pragma unroll 1
        for (int q = 1; q < 32; ++q) if (uni(blk[q]) <= rb) e = q;
        u.A = (const bf16_t*)(ws + WS_H);
        u.B0 = (const bf16_t*)(ws + WS_WEXP + (size_t)l * WEXP_LAYER) + ((size_t)e * 512 + ct * 128) * 1024; u.B1 = u.B0 + EXPMAT;
        u.ridx = ridx_lds + (i & 7) * 256; u.valid = uni(min(256, tot[e] - (rb - blk[e]) * 256));
        u.epi.C = (bf16_t*)(ws + WS_HID) + (size_t)(rb * 256) * DEXP + ct * 128; u.epi.ld = DEXP;
        return true;
    }
};
struct SchedDown {
    typedef EpiBf16 Epi; static constexpr bool GATHER = false;
    unsigned char* ws; const LAS int* blk; int G, me, l;
    __device__ __forceinline__ bool get(int i, g256::Unit<Epi>& u) const {
        const int idx = i * G + me; if (idx >= uni(blk[32]) * 4) return false;
        const int rb = idx >> 2, ct = idx & 3;
        int e = 0;
#pragma unroll 1
        for (int q = 1; q < 32; ++q) if (uni(blk[q]) <= rb) e = q;
        u.A = (const bf16_t*)(ws + WS_HID) + (size_t)(rb * 256) * DEXP;
        u.B0 = (const bf16_t*)(ws + WS_WEXP + (size_t)l * WEXP_LAYER) + 2 * EXPMAT + ((size_t)e * 1024 + ct * 256) * 512; u.B1 = u.B0 + (size_t)128 * 512; u.ridx = nullptr; u.valid = 256;
        u.epi.C = (bf16_t*)(ws + WS_YS) + (size_t)(rb * 256) * D + ct * 256; u.epi.ld = D;
        return true;
    }
};

__device__ __forceinline__ void p4_ln1_router(AP a, unsigned char* lds, int l) {
    const int tid = tid_opaque(), lane = tid & 63, w = tid >> 6;
    const int ntok = (l == 0) ? NTOK : NLAT;
    int* cnt = (int*)(lds + MISC_OFF);
    if (tid < 32) cnt[tid] = 0;
    f32x4* Lg = (f32x4*)lds; f32x4* Le = (f32x4*)(lds + 16384); f32x4* Lgb = (f32x4*)(lds + 147456);
    {
        const float* wrg_ = a->in[16] + (size_t)l * 1024 * 4; const float* wre_ = a->in[17] + (size_t)l * 1024 * 32;
#pragma unroll
        for (int it = 0; it < 2; ++it) { const int c = tid + 512 * it, slot = (((c >> 8) * 4 + (c & 3)) << 6) + ((c >> 2) & 63);
            Lg[slot] = *(const f32x4*)(wrg_ + (size_t)c * 4);
#pragma unroll
            for (int q = 0; q < 8; ++q) Le[q * 1024 + slot] = *(const f32x4*)(wre_ + (size_t)c * 32 + q * 4); }
        Lgb[tid] = (tid < 256) ? *(const f32x4*)(a->in[14] + l * 1024 + tid * 4) : *(const f32x4*)(a->in[15] + l * 1024 + (tid - 256) * 4);
    }
    __syncthreads();
    const float* mod = (const float*)(a->ws + WS_MOD) + (size_t)l * 5 * 6144;
    const bf16_t* Y = (const bf16_t*)(a->ws + WS_Y);
    float* X1 = (float*)(a->ws + WS_X1);
    bf16_t* H = (bf16_t*)(a->ws + WS_H);
    int* tokE = (int*)(a->ws + WS_TOKE); int* tokR = (int*)(a->ws + WS_TOKR); float* tokG = (float*)(a->ws + WS_TOKG);
    const int tstep = gridDim.x * 8;
    f32x4 nx[4]; u32x2 ny[4];
    {   const int t = blockIdx.x * 8 + w;
        if (t < ntok) { const float* xs = (l == 0) ? ((t < NLAT) ? a->in[0] + (size_t)t * D : a->in[2] + (size_t)(t - NLAT) * D) : (const float*)(a->ws + WS_XC) + (size_t)t * D;
#pragma unroll
            for (int i = 0; i < 4; ++i) { nx[i] = *(const f32x4*)(xs + 256 * i + 4 * lane); ny[i] = *(const u32x2*)(Y + (size_t)t * D + 256 * i + 4 * lane); } } }
    int mrow = -1; f32x4 mg[4], msh[4], msc[4];
    for (int t = blockIdx.x * 8 + w; t < ntok; t += tstep) {
        const int mr = (t < NLAT) ? (t >> 12) : 4;
        if (mr != mrow) { mrow = mr; const float* m = mod + (size_t)mr * 6144;
#pragma unroll
            for (int i = 0; i < 4; ++i) { const int c = 256 * i + 4 * lane; mg[i] = *(const f32x4*)(m + 2048 + c); msh[i] = *(const f32x4*)(m + 3072 + c); msc[i] = *(const f32x4*)(m + 4096 + c); } }
        f32x4 v[4];
#pragma unroll
        for (int i = 0; i < 4; ++i) { const f32x4 yv = (f32x4){lo2f(ny[i].x), hi2f(ny[i].x), lo2f(ny[i].y), hi2f(ny[i].y)};
#pragma unroll
            for (int e = 0; e < 4; ++e) v[i][e] = RES_ALPHA * nx[i][e] + mg[i][e] * yv[e]; }
        {   const int tn = t + tstep;
            if (tn < ntok) { const float* xs = (l == 0) ? ((tn < NLAT) ? a->in[0] + (size_t)tn * D : a->in[2] + (size_t)(tn - NLAT) * D) : (const float*)(a->ws + WS_XC) + (size_t)tn * D;
#pragma unroll
                for (int i = 0; i < 4; ++i) { nx[i] = *(const f32x4*)(xs + 256 * i + 4 * lane); ny[i] = *(const u32x2*)(Y + (size_t)tn * D + 256 * i + 4 * lane); } } }
        float mean, rstd; ln_stats(v, mean, rstd);
#pragma unroll
        for (int i = 0; i < 4; ++i) { const int c = 256 * i + 4 * lane; const f32x4 gg = Lgb[64 * i + lane], bb = Lgb[256 + 64 * i + lane];
#pragma unroll
            for (int e = 0; e < 4; ++e) v[i][e] = (v[i][e] - mean) * rstd * gg[e] + bb[e];
            *(f32x4*)(X1 + (size_t)t * D + c) = v[i]; }
        ln_stats(v, mean, rstd);
#pragma unroll
        for (int i = 0; i < 4; ++i) { const int c = 256 * i + 4 * lane; const f32x4 sh = msh[i], sc = msc[i];
#pragma unroll
            for (int e = 0; e < 4; ++e) v[i][e] = (v[i][e] - mean) * rstd * (1.0f + sc[e]) + sh[e];
            u32x2 pk; pk.x = pack2(v[i][0], v[i][1]); pk.y = pack2(v[i][2], v[i][3]); *(u32x2*)(H + (size_t)t * D + c) = pk; }
        f32x2 lg01 = (f32x2){0.f, 0.f}, lg23 = (f32x2){0.f, 0.f};
#pragma unroll
        for (int i = 0; i < 4; ++i)
#pragma unroll
            for (int e = 0; e < 4; ++e) { const f32x4 wv = Lg[((i * 4 + e) << 6) + lane]; const f32x2 vv = (f32x2){v[i][e], v[i][e]};
                lg01 += vv * (f32x2){wv[0], wv[1]}; lg23 += vv * (f32x2){wv[2], wv[3]}; }
        float lg[4] = {wave_sum(lg01[0]), wave_sum(lg01[1]), wave_sum(lg23[0]), wave_sum(lg23[1])};
        int grp = 0; float mx = lg[0];
#pragma unroll
        for (int q = 1; q < 4; ++q) if (lg[q] > mx) { mx = lg[q]; grp = q; }
        float se = 0.f;
#pragma unroll
        for (int q = 0; q < 4; ++q) se += expf(lg[q] - mx);
        const float gate_group = 1.0f / se;
        f32x2 le01 = (f32x2){0.f, 0.f}, le23 = (f32x2){0.f, 0.f}, le45 = (f32x2){0.f, 0.f}, le67 = (f32x2){0.f, 0.f};
#pragma unroll
        for (int i = 0; i < 4; ++i)
#pragma unroll
            for (int e = 0; e < 4; ++e) { const f32x4* wp = Le + grp * 2048 + ((i * 4 + e) << 6) + lane; const f32x4 w0 = wp[0], w1 = wp[1024]; const f32x2 vv = (f32x2){v[i][e], v[i][e]};
                le01 += vv * (f32x2){w0[0], w0[1]}; le23 += vv * (f32x2){w0[2], w0[3]}; le45 += vv * (f32x2){w1[0], w1[1]}; le67 += vv * (f32x2){w1[2], w1[3]}; }
        float le[8] = {wave_sum(le01[0]), wave_sum(le01[1]), wave_sum(le23[0]), wave_sum(le23[1]), wave_sum(le45[0]), wave_sum(le45[1]), wave_sum(le67[0]), wave_sum(le67[1])};
        int j1 = 0; float l1 = le[0];
#pragma unroll
        for (int q = 1; q < 8; ++q) if (le[q] > l1) { l1 = le[q]; j1 = q; }
        int j2 = -1; float l2 = -3.0e38f;
#pragma unroll
        for (int q = 0; q < 8; ++q) if (q != j1 && le[q] > l2) { l2 = le[q]; j2 = q; }
        const float e2 = expf(l2 - l1), p1 = 1.0f / (1.0f + e2), p2 = e2 / (1.0f + e2);
        if (lane == 0) {
            const int ex0 = grp * 8 + j1, ex1 = grp * 8 + j2;
            const int r0 = atomicAdd(&cnt[ex0], 1), r1 = atomicAdd(&cnt[ex1], 1);
            tokE[2 * t] = ex0; tokE[2 * t + 1] = ex1; tokR[2 * t] = r0; tokR[2 * t + 1] = r1;
            tokG[2 * t] = gate_group * p1; tokG[2 * t + 1] = gate_group * p2;
        }
    }
    __syncthreads();
    if (tid < 32) ((int*)(a->ws + WS_BCNT))[((size_t)l * MAXG + blockIdx.x) * 32 + tid] = cnt[tid];
    __syncthreads();
}

__device__ __forceinline__ void p5_dispatch(AP a, unsigned char* lds, int l) {
    const int tid = tid_opaque();
    const int ntok = (l == 0) ? NTOK : NLAT;
    int* part = (int*)lds;
    int* tot = (int*)(lds + 4096);
    int* off = (int*)(lds + 4096 + 128);
    int* pstart = (int*)(lds + 4096 + 256);
    const int* bc = (const int*)(a->ws + WS_BCNT) + (size_t)l * MAXG * 32;
    const int G = gridDim.x, me = blockIdx.x;
    { const int e = tid & 31, p = tid >> 5; int s = 0, so = 0; for (int bb = p; bb < G; bb += 16) { const int c = bc[bb * 32 + e]; s += c; if (bb < me) so += c; } part[p * 32 + e] = s; part[512 + p * 32 + e] = so; }
    __syncthreads();
    if (tid < 32) { int s = 0, so = 0; for (int p = 0; p < 16; ++p) { s += part[p * 32 + tid]; so += part[512 + p * 32 + tid]; } tot[tid] = s; off[tid] = so; }
    __syncthreads();
    if (tid == 0) { int acc = 0; for (int e = 0; e < 32; ++e) { pstart[e] = acc; acc += ((tot[e] + 255) >> 8) << 8; } }
    __syncthreads();
    if (me == 0 && tid < 32) ((int*)(a->ws + WS_CNT))[l * 32 + tid] = tot[tid];
    const int* tokE = (const int*)(a->ws + WS_TOKE); const int* tokR = (const int*)(a->ws + WS_TOKR);
    int* tokS = (int*)(a->ws + WS_TOKS); int* slotT = (int*)(a->ws + WS_SLOTT);
    for (int q = tid; ; q += NT) { const int it = q >> 4, j = q & 15, t = (it * G + me) * 8 + (j >> 1); if (t >= ntok) break;
        const int idx = 2 * t + (j & 1); const int e = tokE[idx]; const int slot = pstart[e] + off[e] + tokR[idx]; tokS[idx] = slot; slotT[slot] = t; }
    __syncthreads();
}

__device__ __forceinline__ void moe_table(AP a, int l, LAS int* blk) {
    const int* tot = (const int*)(a->ws + WS_CNT) + l * 32;
    if (threadIdx.x == 0) { int acc = 0; for (int e = 0; e < 32; ++e) { const int c = tot[e]; blk[e] = acc; blk[33 + e] = c; acc += (c + 255) >> 8; } blk[32] = acc; }
    __syncthreads();
}
__device__ __forceinline__ int units_of(int nu, int v, int G) { return (v < nu) ? (nu - v + G - 1) / G : 0; }
__device__ __forceinline__ void p1_inproj(AP a, unsigned char* smem, LAS unsigned char* lds, int l) {
    SchedInProj S; S.ws = a->ws; S.l = l; S.G = gridDim.x; S.me = vblock();
    g256::gemm_phase(lds, 1024, S);
    if (l == 0) { const int nu = 64 * 7 + 4 * 7, G = gridDim.x; if (units_of(nu, S.me, G) < (nu + G - 1) / G) exp_fill(a, smem, 0, 8); }
}
__device__ __forceinline__ void p3_outproj(AP a, unsigned char* smem, LAS unsigned char* lds, int l) {
    SchedOutProj S; S.ws = a->ws; S.l = l; S.G = gridDim.x; S.me = vblock();
    g256::gemm_phase(lds, 1024, S);
    if (l == 0) {
        const bf16_t* W = (const bf16_t*)(a->ws + WS_WOUT);
        for (int u = blockIdx.x; u < 64; u += gridDim.x) { const int rt = u >> 3, ct = u & 7;
            EpiBf16 E; E.C = (bf16_t*)(a->ws + WS_Y) + (size_t)(NLAT + rt * 128) * D + ct * 128; E.ld = D;
            const bf16_t* B0 = W + (size_t)(ct * 128) * 1024;
            gemm_tile<128, false, EpiBf16>(lds, (const bf16_t*)(a->ws + WS_CAT) + (size_t)(NLAT + rt * 128) * D, D, nullptr, 128, B0, B0 + (size_t)64 * 1024, 1024, 1024, E); }
        if (blockIdx.x >= 64) exp_fill(a, smem, 0, 3);
    }
}
__device__ __forceinline__ void p6_gateup(AP a, unsigned char* smem, LAS unsigned char* lds, int l) {
    LAS int* blk = (LAS int*)(lds + MISC_OFF + 256);
    moe_table(a, l, blk);
    LAS int* ridx = (LAS int*)(lds + RIDX_OFF);
    const int tid = tid_opaque(), G = gridDim.x, me = vblock(), nu = blk[32] * 4;
    const int* slotT = (const int*)(a->ws + WS_SLOTT);
    for (int i = 0; i < 8; ++i) { const int idx = i * G + me; if (idx >= nu) break;
        const int rb = idx >> 2; int e = 0; for (int q = 1; q < 32; ++q) if (blk[q] <= rb) e = q;
        const int valid = min(256, blk[33 + e] - (rb - blk[e]) * 256);
        if (tid < 256) ridx[i * 256 + tid] = (tid < valid) ? slotT[rb * 256 + tid] : 0; }
    __syncthreads();
    SchedGateUp S; S.ws = a->ws; S.blk = blk; S.tot = blk + 33; S.ridx_lds = ridx; S.G = G; S.me = me; S.l = l;
    g256::gemm_phase(lds, 1024, S);
    __syncthreads();
    if (l == 0 && units_of(nu, me, G) < (nu + G - 1) / G) exp_fill(a, smem, 1, 8);
}
__device__ __forceinline__ void p7_down(AP a, unsigned char* smem, LAS unsigned char* lds, int l) {
    LAS int* blk = (LAS int*)(lds + MISC_OFF + 256);
    moe_table(a, l, blk);
    SchedDown S; S.ws = a->ws; S.blk = blk; S.G = gridDim.x; S.me = vblock(); S.l = l;
    g256::gemm_phase(lds, 512, S);
    __syncthreads();
    { const int nu = uni(blk[32]) * 4, G = gridDim.x; if (l == 0 && units_of(nu, S.me, G) < (nu + G - 1) / G) exp_fill(a, smem, 1, 5); }
}

__device__ __forceinline__ void p8_ln2(AP a, unsigned char* lds, int l) {
    const int tid = tid_opaque(), lane = tid & 63, w = tid >> 6;
    const int ntok = (l == 0) ? NTOK : NLAT;
    const float* mod = (const float*)(a->ws + WS_MOD) + (size_t)l * 5 * 6144;
    const float* modn = (const float*)(a->ws + WS_MOD) + (size_t)5 * 6144;
    const float* X1 = (const float*)(a->ws + WS_X1);
    const bf16_t* YS = (const bf16_t*)(a->ws + WS_YS);
    const int* tokS = (const int*)(a->ws + WS_TOKS); const float* tokG = (const float*)(a->ws + WS_TOKG);
    f32x4* Lgb = (f32x4*)lds;
    __syncthreads();
    Lgb[tid] = (tid < 256) ? *(const f32x4*)(a->in[21] + l * 1024 + tid * 4) : *(const f32x4*)(a->in[22] + l * 1024 + (tid - 256) * 4);
    __syncthreads();
    int mrow = -1; f32x4 mg[4], nsh[4], nsc[4];
    const int tstep = gridDim.x * 8;
    int t = blockIdx.x * 8 + w;
    int ns0 = 0, ns1 = 0; float nga = 0.f, ngb = 0.f;
    f32x4 nx[4]; u32x2 nya[4], nyb[4];
    float cga = 0.f, cgb = 0.f;
    if (t < ntok) { const int s0 = tokS[2 * t], s1 = tokS[2 * t + 1]; cga = tokG[2 * t]; cgb = tokG[2 * t + 1];
#pragma unroll
        for (int i = 0; i < 4; ++i) { const int c = 256 * i + 4 * lane; nx[i] = *(const f32x4*)(X1 + (size_t)t * D + c); nya[i] = *(const u32x2*)(YS + (size_t)s0 * D + c); nyb[i] = *(const u32x2*)(YS + (size_t)s1 * D + c); } }
    if (t + tstep < ntok) { ns0 = tokS[2 * (t + tstep)]; ns1 = tokS[2 * (t + tstep) + 1]; nga = tokG[2 * (t + tstep)]; ngb = tokG[2 * (t + tstep) + 1]; }
    for (; t < ntok; t += tstep) {
        const int mr = (t < NLAT) ? (t >> 12) : 4;
        if (mr != mrow) { mrow = mr; const float* m = mod + (size_t)mr * 6144; const float* mn = modn + (size_t)mr * 6144;
#pragma unroll
            for (int i = 0; i < 4; ++i) { const int c = 256 * i + 4 * lane; mg[i] = *(const f32x4*)(m + 5120 + c); if (l == 0) { nsh[i] = *(const f32x4*)(mn + c); nsc[i] = *(const f32x4*)(mn + 1024 + c); } } }
        f32x4 v[4];
#pragma unroll
        for (int i = 0; i < 4; ++i) { const f32x4 gv = mg[i];
            const u32x2 ya = nya[i], yb = nyb[i];
            const float f0 = cga * lo2f(ya.x) + cgb * lo2f(yb.x), f1 = cga * hi2f(ya.x) + cgb * hi2f(yb.x), f2 = cga * lo2f(ya.y) + cgb * lo2f(yb.y), f3 = cga * hi2f(ya.y) + cgb * hi2f(yb.y);
            v[i][0] = RES_ALPHA * nx[i][0] + gv[0] * f0; v[i][1] = RES_ALPHA * nx[i][1] + gv[1] * f1; v[i][2] = RES_ALPHA * nx[i][2] + gv[2] * f2; v[i][3] = RES_ALPHA * nx[i][3] + gv[3] * f3; }
        {   const int tn = t + tstep, tn2 = t + 2 * tstep;
            if (tn < ntok) {
#pragma unroll
                for (int i = 0; i < 4; ++i) { const int c = 256 * i + 4 * lane; nx[i] = *(const f32x4*)(X1 + (size_t)tn * D + c); nya[i] = *(const u32x2*)(YS + (size_t)ns0 * D + c); nyb[i] = *(const u32x2*)(YS + (size_t)ns1 * D + c); }
                cga = nga; cgb = ngb; }
            if (tn2 < ntok) { ns0 = tokS[2 * tn2]; ns1 = tokS[2 * tn2 + 1]; nga = tokG[2 * tn2]; ngb = tokG[2 * tn2 + 1]; } }
        float mean, rstd; ln_stats(v, mean, rstd);
        float* dst = (l == 0) ? (float*)(a->ws + WS_XC) + (size_t)t * D : a->out + (size_t)t * D;
#pragma unroll
        for (int i = 0; i < 4; ++i) { const int c = 256 * i + 4 * lane; const f32x4 gg = Lgb[64 * i + lane], bb = Lgb[256 + 64 * i + lane];
#pragma unroll
            for (int e = 0; e < 4; ++e) v[i][e] = (v[i][e] - mean) * rstd * gg[e] + bb[e];
            *(f32x4*)(dst + c) = v[i]; }
        if (l == 0) {
            ln_stats(v, mean, rstd);
            bf16_t* H = (bf16_t*)(a->ws + WS_H);
#pragma unroll
            for (int i = 0; i < 4; ++i) { const int c = 256 * i + 4 * lane; const f32x4 sh = nsh[i], sc = nsc[i];
                f32x4 o;
#pragma unroll
                for (int e = 0; e < 4; ++e) o[e] = (v[i][e] - mean) * rstd * (1.0f + sc[e]) + sh[e];
                u32x2 pk; pk.x = pack2(o[0], o[1]); pk.y = pack2(o[2], o[3]); *(u32x2*)(H + (size_t)t * D + c) = pk; }
        }
    }
}

constexpr int N_PHASES = 18;
template <int P> __device__ __forceinline__ void run_phase(AP a, unsigned char* smem, LAS unsigned char* lds, int l) {
    asm volatile("" : "+s"(a));
    if (P == 0) p0_prologue(a, smem);
    if (P == 1) p_lnmod0(a);
    if (P == 2) p1_inproj(a, smem, lds, l);
    if (P == 3) p2_mix(a, smem, lds, l);
    if (P == 4) p3_outproj(a, smem, lds, l);
    if (P == 5) p4_ln1_router(a, smem, l);
    if (P == 6) p5_dispatch(a, smem, l);
    if (P == 7) p6_gateup(a, smem, lds, l);
    if (P == 8) p7_down(a, smem, lds, l);
    if (P == 9) p8_ln2(a, smem, l);
}
template <int P> __device__ __noinline__ void phase_fn(AP ap, int l) {
    extern __shared__ __attribute__((aligned(16))) unsigned char smem[];
    run_phase<P>(ap, smem, (LAS unsigned char*)smem, l);
}
#if N_LAUNCH_MODE == 1
__global__ void __launch_bounds__(NT, 2) fwd(Args a) {
    extern __shared__ __attribute__((aligned(16))) unsigned char smem[];
    LAS unsigned char* lds = (LAS unsigned char*)smem;
    if (threadIdx.x < 4) ((volatile LAS unsigned*)(lds + MISC_OFF + 768))[threadIdx.x] = 0u;
    __syncthreads();
    XcdBarrier bar = xcd_barrier_post((unsigned*)(a.ws + WS_BAR), (volatile LAS unsigned*)(lds + MISC_OFF + 768));
    AP ap = (AP)__builtin_amdgcn_kernarg_segment_ptr();
#define PROBE(P, l) do { if (PROBE_MASK & (1 << (P))) { for (int _r = 0; _r < 2; ++_r) { xcd_barrier(bar); run_phase<P>(ap, smem, lds, l); } } } while (0)
    run_phase<0>(ap, smem, lds, 0); PROBE(0, 0); xcd_barrier(bar);
    run_phase<1>(ap, smem, lds, 0); PROBE(1, 0); xcd_barrier(bar);
    for (int l = 0; l < 2; ++l) {
        run_phase<2>(ap, smem, lds, l); PROBE(2, l); xcd_barrier(bar);
        run_phase<3>(ap, smem, lds, l); PROBE(3, l); xcd_barrier(bar);
        run_phase<4>(ap, smem, lds, l); PROBE(4, l); xcd_barrier(bar);
        run_phase<5>(ap, smem, lds, l); PROBE(5, l); xcd_barrier(bar);
        run_phase<6>(ap, smem, lds, l); PROBE(6, l); xcd_barrier(bar);
        run_phase<7>(ap, smem, lds, l); PROBE(7, l); xcd_barrier(bar);
        run_phase<8>(ap, smem, lds, l); PROBE(8, l); xcd_barrier(bar);
        run_phase<9>(ap, smem, lds, l); PROBE(9, l); if (l == 0) xcd_barrier(bar);
    }
}
#else
template <int P> __global__ void __launch_bounds__(NT, 2) k_phase(Args a) {
    extern __shared__ __attribute__((aligned(16))) unsigned char smem[];
    LAS unsigned char* lds = (LAS unsigned char*)smem;
    AP ap = (AP)__builtin_amdgcn_kernarg_segment_ptr();
    run_phase<P>(ap, smem, lds, ap->ph_lo);
}
template <int P> static void launch_phase(Args a, int l, int grid, hipStream_t stream) {
    static bool attr = false;
    if (!attr) { (void)hipFuncSetAttribute((const void*)k_phase<P>, hipFuncAttributeMaxDynamicSharedMemorySize, LDS_BYTES); attr = true; }
    a.ph_lo = l; a.ph_hi = P;
    hipLaunchKernelGGL(k_phase<P>, dim3(grid), dim3(NT), LDS_BYTES, stream, a);
}
#endif

extern "C" void kernel_launch(void* const* d_in, const int* in_sizes, int n_in, void* d_out, int out_size, void* d_ws, size_t ws_size, hipStream_t stream) {
    static int grid = 0;
    if (grid == 0) {
        if (n_in != 23 || out_size != NLAT * D || ws_size < WS_END) { fprintf(stderr, "kernel_launch: unexpected shapes (n_in %d, out %d, ws %zu, need %zu)\n", n_in, out_size, ws_size, (size_t)WS_END); grid = -1; return; }
        int dev = 0, cus = 0;
        if (hipGetDevice(&dev) != hipSuccess || hipDeviceGetAttribute(&cus, hipDeviceAttributeMultiprocessorCount, dev) != hipSuccess) { grid = -1; return; }
#if N_LAUNCH_MODE == 1
        int per_cu = 0;
        if (hipFuncSetAttribute((const void*)fwd, hipFuncAttributeMaxDynamicSharedMemorySize, LDS_BYTES) != hipSuccess) { fprintf(stderr, "kernel_launch: hipFuncSetAttribute failed\n"); grid = -1; return; }
        if (hipOccupancyMaxActiveBlocksPerMultiprocessor(&per_cu, (const void*)fwd, NT, LDS_BYTES) != hipSuccess || per_cu < 1) { fprintf(stderr, "kernel_launch: occupancy query says %d\n", per_cu); }
        (void)hipGetLastError();
#endif
        grid = cus; if (grid > MAXG) grid = MAXG;
    }
    if (grid < 0) return;
    (void)hipMemsetAsync((char*)d_ws + WS_BAR, 0, 16384 + 256, stream);
    Args a{};
    for (int i = 0; i < 23; ++i) a.in[i] = (const float*)d_in[i];
    a.out = (float*)d_out; a.ws = (unsigned char*)d_ws;
#if N_LAUNCH_MODE == 1
    a.ph_lo = 0; a.ph_hi = N_PHASES;
    hipLaunchKernelGGL(fwd, dim3(grid), dim3(NT), LDS_BYTES, stream, a);
#else
    launch_phase<0>(a, 0, grid, stream);
    launch_phase<1>(a, 0, grid, stream);
    for (int l = 0; l < 2; ++l) {
        launch_phase<2>(a, l, grid, stream); launch_phase<3>(a, l, grid, stream); launch_phase<4>(a, l, grid, stream); launch_phase<5>(a, l, grid, stream);
        launch_phase<6>(a, l, grid, stream); launch_phase<7>(a, l, grid, stream); launch_phase<8>(a, l, grid, stream); launch_phase<9>(a, l, grid, stream);
    }
#endif
}
```

```cpp
#include <hip/hip_runtime.h>
#include <stdint.h>
#include <stdio.h>

#ifndef PROBE_MASK
#define PROBE_MASK 0
#endif
#ifndef PROBE_FFT_REP
#define PROBE_FFT_REP 1
#endif
#ifndef PROBE_MIX_REP
#define PROBE_MIX_REP 1
#endif
#ifndef PROBE_SGU_REP
#define PROBE_SGU_REP 1
#endif
#ifndef N_LAUNCH_MODE
#define N_LAUNCH_MODE 1
#endif

#define LAS __attribute__((address_space(3)))
typedef unsigned short bf16_t;
typedef short bf16x8 __attribute__((ext_vector_type(8)));
typedef float f32x4 __attribute__((ext_vector_type(4)));
typedef unsigned u32x4 __attribute__((ext_vector_type(4)));
typedef unsigned u32x2 __attribute__((ext_vector_type(2)));
typedef float f32x2 __attribute__((ext_vector_type(2)));

constexpr int D = 1024, NBATCH = 4, SEQ = 4096, CTXL = 256;
constexpr int NLAT = NBATCH * SEQ, NCTX = NBATCH * CTXL, NTOK = NLAT + NCTX;
constexpr int ZC = 1792;
constexpr int NEXP = 32, DEXP = 512;
constexpr int NSLOT = 2 * NTOK + NEXP * 256;
constexpr int NT = 512;
constexpr int MAXG = 512;
constexpr float RES_ALPHA = 1.41421356237309515f;
constexpr int MISC_OFF = 155648;
constexpr int RIDX_OFF = 131072;
constexpr int LDS_BYTES = MISC_OFF + 1024;

constexpr size_t WS_BAR   = 0;
constexpr size_t WS_CNT   = 16384;
constexpr size_t WS_BCNT  = WS_CNT + 256;
constexpr size_t WS_MOD   = WS_BCNT + (size_t)2 * MAXG * 32 * 4;
constexpr size_t WS_ROPE  = WS_MOD + (size_t)2 * 5 * 6144 * 4;
constexpr size_t WS_TOKE  = WS_ROPE + 8192;
constexpr size_t WS_TOKR  = WS_TOKE + (size_t)NTOK * 8;
constexpr size_t WS_TOKS  = WS_TOKR + (size_t)NTOK * 8;
constexpr size_t WS_TOKG  = WS_TOKS + (size_t)NTOK * 8;
constexpr size_t WS_SLOTT = WS_TOKG + (size_t)NTOK * 8;
constexpr size_t WS_WIN   = WS_SLOTT + (size_t)NSLOT * 4;
constexpr size_t WS_WOUT  = WS_WIN + (size_t)2 * ZC * 1024 * 2;
constexpr size_t WS_WSGU  = WS_WOUT + (size_t)2 * 1024 * 1024 * 2;
constexpr size_t WS_DFTC  = WS_WSGU + (size_t)2 * 4 * 128 * 128 * 2;
constexpr size_t WS_WEXP  = WS_DFTC + (size_t)256 * 512 * 2;
constexpr size_t EXPMAT   = (size_t)NEXP * 512 * 1024;
constexpr size_t WEXP_LAYER = 3 * EXPMAT * 2;
constexpr size_t WS_X1    = WS_WEXP + 2 * WEXP_LAYER;
constexpr size_t WS_XC    = WS_X1 + (size_t)NTOK * D * 4;
constexpr size_t WS_H     = WS_XC + (size_t)NTOK * D * 4;
constexpr size_t WS_R     = WS_H + (size_t)NTOK * D * 2;
constexpr size_t WS_Z     = WS_R;
constexpr size_t WS_AT    = WS_Z + (size_t)NTOK * ZC * 2;
constexpr size_t WS_ATC   = WS_AT + (size_t)4 * 256 * 8192 * 2;
constexpr size_t WS_VT    = WS_ATC + (size_t)4 * 256 * 512 * 2;
constexpr size_t WS_VTC   = WS_VT + (size_t)4 * 2 * 64 * 4096 * 2;
constexpr size_t WS_CAT   = WS_VTC + (size_t)4 * 2 * 64 * 256 * 2;
constexpr size_t WS_REND  = WS_CAT + (size_t)NTOK * D * 2;
constexpr size_t WS_Y     = WS_R;
constexpr size_t WS_HID   = WS_R;
constexpr size_t WS_YS    = WS_HID + (size_t)NSLOT * DEXP * 2;
constexpr size_t WS_END   = (WS_YS + (size_t)NSLOT * D * 2 > WS_REND) ? WS_YS + (size_t)NSLOT * D * 2 : WS_REND;
static_assert(WS_Y + (size_t)NTOK * D * 4 <= WS_CAT, "Y must not reach CAT");
static_assert(WS_WIN % 256 == 0 && WS_DFTC % 256 == 0 && WS_WEXP % 256 == 0 && WS_X1 % 256 == 0 && WS_H % 256 == 0 && WS_R % 256 == 0 && WS_AT % 256 == 0 && WS_CAT % 256 == 0 && WS_YS % 256 == 0, "alignment");

struct Args { const float* in[23]; float* out; unsigned char* ws; int ph_lo, ph_hi; };
#define CAS __attribute__((address_space(4)))
typedef const CAS Args* AP;

#define XB_TMO      128
#define XB_XCNT(j)  (256  + 64 * (j))
#define XB_XSUB(j)  (1280 + 64 * (j))
#define XB_XGEN(j)  (2304 + 64 * (j))
#define XB_TOP      3328
#define XB_TOPGEN   3392
#define XCD_BAR_WORDS 3456
#define XB_SPIN_CAP (1u << 18)

__device__ __forceinline__ unsigned xb_ld(unsigned* p)              { return __hip_atomic_load(p, __ATOMIC_RELAXED, __HIP_MEMORY_SCOPE_AGENT); }
__device__ __forceinline__ unsigned xb_add(unsigned* p, unsigned v) { return __hip_atomic_fetch_add(p, v, __ATOMIC_RELAXED, __HIP_MEMORY_SCOPE_AGENT); }
__device__ __forceinline__ unsigned xb_xcc_id() { return (unsigned)__builtin_amdgcn_s_getreg((3 << 11) | 20) & 0xFu; }
#define XB_SPIN(cond, bar) do { unsigned _sp = 0; while (cond) { __builtin_amdgcn_s_sleep(1); \
    if ((++_sp & 255u) == 0u) { if (xb_ld(&(bar)[XB_TMO])) break; if (_sp > XB_SPIN_CAP) { atomicAdd(&(bar)[XB_TMO], 1u); break; } } } } while (0)

struct XcdBarrier { unsigned* bar; unsigned x; volatile LAS unsigned* st; };

__device__ __forceinline__ XcdBarrier xcd_barrier_post(unsigned* bar, volatile LAS unsigned* st) {
    XcdBarrier b; b.bar = bar; b.x = (unsigned)__builtin_amdgcn_readfirstlane((int)xb_xcc_id()); b.st = st;
    if (threadIdx.x == 0) (void)xb_add(&bar[XB_XCNT(b.x)], 1u);
    return b;
}
__device__ __forceinline__ void xcd_barrier_complete(unsigned* bar, unsigned x, unsigned& nloc, unsigned& nx) {
    const unsigned G = gridDim.x * gridDim.y * gridDim.z;
    unsigned sum, cnt, mine, sp = 0u;
    for (;;) {
        sum = 0u; cnt = 0u; mine = 0u;
#pragma unroll
        for (unsigned j = 0; j < 16; ++j) { const unsigned c = xb_ld(&bar[XB_XCNT(j)]); sum += c; cnt += (c > 0u) ? 1u : 0u; mine = (j == x) ? c : mine; }
        if (sum == G) break;
        __builtin_amdgcn_s_sleep(1);
        if ((++sp & 255u) == 0u) { if (xb_ld(&bar[XB_TMO])) break; if (sp > XB_SPIN_CAP) { atomicAdd(&bar[XB_TMO], 1u); break; } }
    }
    nloc = mine > 0u ? mine : 1u; nx = cnt > 0u ? cnt : 1u;
}
__device__ __forceinline__ void xcd_barrier(const XcdBarrier& b) {
    asm volatile("s_waitcnt vmcnt(0)" ::: "memory");
    __syncthreads();
    if (threadIdx.x == 0) {
        unsigned* bar = b.bar;
        unsigned bx = b.x;
        asm volatile("" : "+s"(bar), "+s"(bx));
        __builtin_amdgcn_s_waitcnt(0);
        unsigned nloc = b.st[0], nx = b.st[1];
        if (nloc == 0u) { xcd_barrier_complete(bar, bx, nloc, nx); b.st[0] = nloc; b.st[1] = nx; }
        const unsigned old = xb_add(&bar[XB_XSUB(bx)], 1u);
        const unsigned gen = old / nloc;
        if (old + 1u == (gen + 1u) * nloc) {
            __builtin_amdgcn_fence(__ATOMIC_RELEASE, "agent");
            asm volatile("s_waitcnt vmcnt(0)" ::: "memory");
            const unsigned og = xb_add(&bar[XB_TOP], 1u);
            const unsigned tg = og / nx;
            if (og + 1u == (tg + 1u) * nx) xb_add(&bar[XB_TOPGEN], 1u);
            else XB_SPIN(xb_ld(&bar[XB_TOPGEN]) == tg, bar);
            __builtin_amdgcn_fence(__ATOMIC_ACQUIRE, "agent");
            xb_add(&bar[XB_XGEN(bx)], 1u);
            asm volatile("s_waitcnt vmcnt(0)" ::: "memory");
        } else {
            XB_SPIN(xb_ld(&bar[XB_XGEN(bx)]) == gen, bar);
            __builtin_amdgcn_fence(__ATOMIC_ACQUIRE, "agent");
            asm volatile("s_waitcnt vmcnt(0)" ::: "memory");
        }
    }
    __syncthreads();
}

__device__ __forceinline__ int tid_opaque() { int t = threadIdx.x; asm volatile("" : "+v"(t)); return t; }
__device__ __forceinline__ float bf2f(bf16_t v) { return __uint_as_float(((unsigned)v) << 16); }
__device__ __forceinline__ bf16_t f2bf(float f) { return __builtin_bit_cast(unsigned short, (__bf16)f); }
typedef __bf16 hwbf16x2 __attribute__((ext_vector_type(2)));
__device__ __forceinline__ unsigned pack2(float a, float b) { return __builtin_bit_cast(unsigned, __builtin_convertvector((f32x2){a, b}, hwbf16x2)); }
__device__ __forceinline__ float lo2f(unsigned w) { return __uint_as_float(w << 16); }
__device__ __forceinline__ float hi2f(unsigned w) { return __uint_as_float(w & 0xffff0000u); }
template <int CTRL> __device__ __forceinline__ float dpp_mov(float v) { return __builtin_bit_cast(float, __builtin_amdgcn_update_dpp(0, __builtin_bit_cast(int, v), CTRL, 0xf, 0xf, true)); }
__device__ __forceinline__ float row_sum16(float v) {
    v += dpp_mov<0xB1>(v);
    v += dpp_mov<0x4E>(v);
    v += dpp_mov<0x141>(v);
    v += dpp_mov<0x140>(v);
    return v;
}
__device__ __forceinline__ float row_max16(float v) {
    v = fmaxf(v, dpp_mov<0xB1>(v)); v = fmaxf(v, dpp_mov<0x4E>(v)); v = fmaxf(v, dpp_mov<0x141>(v)); v = fmaxf(v, dpp_mov<0x140>(v));
    return v;
}
__device__ __forceinline__ float wave_sum(float v) {
    v = row_sum16(v);
    const int iv = __builtin_bit_cast(int, v);
    const float a0 = __builtin_bit_cast(float, __builtin_amdgcn_readlane(iv, 0)), a1 = __builtin_bit_cast(float, __builtin_amdgcn_readlane(iv, 16));
    const float a2 = __builtin_bit_cast(float, __builtin_amdgcn_readlane(iv, 32)), a3 = __builtin_bit_cast(float, __builtin_amdgcn_readlane(iv, 48));
    return (a0 + a1) + (a2 + a3);
}
__device__ __forceinline__ float gelu_erf(float v) {
    const float t = __builtin_amdgcn_rcpf(fabsf(v) * 0.2316418882f + 1.0f);
    float q = t * 0.5307027145f + (-0.7265760135f); q = q * t + 0.7107068705f; q = q * t + (-0.142248368f); q = q * t + 0.127414796f; q = q * t;
    const float m = v * (q * __builtin_amdgcn_exp2f((v * v) * (-0.72134752044f)));
    return v < 0.f ? m : v - m;
}
__device__ __forceinline__ float silu_f(float x) { return x / (1.0f + __expf(-x)); }

__device__ __forceinline__ void ln_stats(const f32x4 (&v)[4], float& mean, float& rstd) {
    float s = 0.f;
#pragma unroll
    for (int i = 0; i < 4; ++i) s += (v[i][0] + v[i][1]) + (v[i][2] + v[i][3]);
    s = wave_sum(s); mean = s * (1.0f / 1024.0f);
    float q = 0.f;
#pragma unroll
    for (int i = 0; i < 4; ++i)
#pragma unroll
        for (int e = 0; e < 4; ++e) { const float d = v[i][e] - mean; q += d * d; }
    q = wave_sum(q); rstd = 1.0f / sqrtf(q * (1.0f / 1024.0f) + 1e-6f);
}

template <int BN> struct MfmaLayout {
    static constexpr int FG = BN / 128, NI = 4, NJ = 2 * FG;
    int rbase, cbase;
    __device__ __forceinline__ int row(int i) const { return rbase + 16 * i; }
    __device__ __forceinline__ int col(int jj) const { return (jj / FG) * (BN / 2) + (jj % FG) * 16 + cbase; }
};

__device__ __forceinline__ void glds16(const bf16_t* g, LAS unsigned char* l) {
    __builtin_amdgcn_global_load_lds((const unsigned*)g, (LAS unsigned*)l, 16, 0, 0);
}

template <int BN, bool GATHER, class Epi>
__device__ __forceinline__ void gemm_tile(LAS unsigned char* lds, const bf16_t* A, int lda, const int* rowidx, int valid_rows,
                                          const bf16_t* B0, const bf16_t* B1, int ldb, int K, const Epi& epi) {
    constexpr int A_B = 16384, B_B = BN * 128, STAGE = A_B + B_B, NBL = BN / 64;
    const int tid = tid_opaque(), lane = tid & 63, wid = __builtin_amdgcn_readfirstlane(tid >> 6);
    const bf16_t* ap[2]; const bf16_t* bp[NBL];
#pragma unroll
    for (int i = 0; i < 2; ++i) {
        const int P = i * 512 + tid, row = P >> 3, c = (P & 7) ^ ((row >> 1) & 7);
        size_t ro;
        if (GATHER) ro = (size_t)(row < valid_rows ? rowidx[row] : 0) * (size_t)lda; else ro = (size_t)row * (size_t)lda;
        ap[i] = A + ro + c * 8;
    }
#pragma unroll
    for (int i = 0; i < NBL; ++i) {
        const int P = i * 512 + tid, row = P >> 3, c = (P & 7) ^ ((row >> 1) & 7);
        const bf16_t* base = (row < BN / 2) ? (B0 + (size_t)row * ldb) : (B1 + (size_t)(row - BN / 2) * ldb);
        bp[i] = base + c * 8;
    }
    const int nk = K / 64;
#define GT_STAGE(buf, k0) do { \
        _Pragma("unroll") for (int _i = 0; _i < 2; ++_i) glds16(ap[_i] + (k0), lds + (buf) * STAGE + _i * 8192 + wid * 1024); \
        _Pragma("unroll") for (int _i = 0; _i < NBL; ++_i) glds16(bp[_i] + (k0), lds + (buf) * STAGE + A_B + _i * 8192 + wid * 1024); } while (0)

    typedef MfmaLayout<BN> Lay;
    constexpr int FG = Lay::FG;
    const int fr = lane & 15, g = lane >> 4, wr = wid >> 2, wc = wid & 3;
    Lay lay; lay.rbase = wr * 64 + fr; lay.cbase = wc * 16 * FG + 4 * g;
    f32x4 acc[Lay::NI][Lay::NJ];
#pragma unroll
    for (int i = 0; i < Lay::NI; ++i)
#pragma unroll
        for (int j = 0; j < Lay::NJ; ++j) acc[i][j] = (f32x4){0.f, 0.f, 0.f, 0.f};
    int aoff[4], boff[Lay::NJ];
#pragma unroll
    for (int m = 0; m < 4; ++m) { const int row = wr * 64 + m * 16 + fr; aoff[m] = row * 128 + ((g ^ ((row >> 1) & 7)) << 4); }
#pragma unroll
    for (int jj = 0; jj < Lay::NJ; ++jj) { const int row = (jj / FG) * (BN / 2) + wc * 16 * FG + (jj % FG) * 16 + fr; boff[jj] = A_B + row * 128 + ((g ^ ((row >> 1) & 7)) << 4); }
    GT_STAGE(0, 0);
    asm volatile("s_waitcnt vmcnt(0)" ::: "memory"); __syncthreads();
    for (int kt = 0; kt < nk; ++kt) {
        if (kt + 1 < nk) GT_STAGE((kt + 1) & 1, (kt + 1) * 64);
        const LAS unsigned char* sa = lds + (kt & 1) * STAGE;
#pragma unroll
        for (int ks = 0; ks < 2; ++ks) {
            bf16x8 af[4], bfv[Lay::NJ];
#pragma unroll
            for (int m = 0; m < 4; ++m) af[m] = *(const LAS bf16x8*)(sa + (aoff[m] ^ (ks << 6)));
#pragma unroll
            for (int jj = 0; jj < Lay::NJ; ++jj) bfv[jj] = *(const LAS bf16x8*)(sa + (boff[jj] ^ (ks << 6)));
#pragma unroll
            for (int m = 0; m < 4; ++m)
#pragma unroll
                for (int jj = 0; jj < Lay::NJ; ++jj) acc[m][jj] = __builtin_amdgcn_mfma_f32_16x16x32_bf16(bfv[jj], af[m], acc[m][jj], 0, 0, 0);
        }
        asm volatile("s_waitcnt vmcnt(0)" ::: "memory"); __syncthreads();
    }
    epi.run(acc, lay);
#undef GT_STAGE
}

namespace g256 {
constexpr int BK = 64, HALF = 128, HTB = HALF * BK * 2, STAGE_BYTES = 8 * HTB;
__device__ __forceinline__ int lds_byte(int r, int c) { const int st = (r >> 4) * 2 + (c >> 5), rr = r & 15, cc = c & 31, ob = rr * 64 + cc * 2; return st * 1024 + (ob ^ (((ob >> 9) & 1) << 5)); }
__device__ __forceinline__ void stage_rc(int b, int& R, int& C) { const int st = b / 1024, sb = b % 1024, swz = sb ^ (((sb >> 9) & 1) << 5); R = (st >> 1) * 16 + swz / 64; C = (st & 1) * 32 + (swz % 64) / 2; }
struct Lay {
    static constexpr int NI = 8, NJ = 4;
    int rbase, cbase;
    __device__ __forceinline__ int row(int i) const { return (i >> 2) * 128 + (i & 3) * 16 + rbase; }
    __device__ __forceinline__ int col(int j) const { return (j >> 1) * 128 + (j & 1) * 16 + cbase; }
};
template <class Epi> struct Unit { const bf16_t* A; const bf16_t* B0; const bf16_t* B1; const LAS int* ridx; int valid; Epi epi; };

template <class Sched>
__device__ __forceinline__ void gemm_phase(LAS unsigned char* lds, const int K, const Sched& S) {
    typedef typename Sched::Epi Epi;
    const int tid = tid_opaque(), wid = __builtin_amdgcn_readfirstlane(tid >> 6), lane = tid & 63, wr = wid >> 2, wc = wid & 3, fr = lane & 15, fq = lane >> 4;
    int nt = K / BK; asm volatile("" : "+s"(nt));
    int sR[2], sC[2];
#pragma unroll
    for (int i = 0; i < 2; ++i) stage_rc(tid * 16 + i * 8192, sR[i], sC[i]);
    unsigned voffB[2];
#pragma unroll
    for (int i = 0; i < 2; ++i) voffB[i] = (unsigned)(sR[i] * K + sC[i]) * 2u;
    const size_t kstep = (size_t)(BK * 2);
    const unsigned ldsw = (unsigned)wid * 1024u;
    const int aoff = lds_byte(wr * 64 + fr, fq * 8), boff = lds_byte(wc * 32 + fr, fq * 8);
#define G2_SA(b, h) (((b) * 2 + (h)) * HTB)
#define G2_SB(b, h) ((4 + (b) * 2 + (h)) * HTB)
#define G2_STAGE(bufoff, gbase, v0, v1) do { \
        __builtin_amdgcn_global_load_lds((const unsigned*)((const char*)(gbase) + (v0)), (LAS unsigned*)(lds + (bufoff) + ldsw), 16, 0, 0); \
        __builtin_amdgcn_global_load_lds((const unsigned*)((const char*)(gbase) + (v1)), (LAS unsigned*)(lds + (bufoff) + ldsw + 8192), 16, 0, 0); } while (0)
#define G2_LDA(dst, b, h) do { _Pragma("unroll") for (int m = 0; m < 4; ++m) _Pragma("unroll") for (int k = 0; k < 2; ++k) dst[m][k] = *(const LAS bf16x8*)(lds + G2_SA(b, h) + aoff + m * 2048 + k * 1024); } while (0)
#define G2_LDB(dst, b, h) do { _Pragma("unroll") for (int n = 0; n < 2; ++n) _Pragma("unroll") for (int k = 0; k < 2; ++k) dst[n][k] = *(const LAS bf16x8*)(lds + G2_SB(b, h) + boff + n * 2048 + k * 1024); } while (0)
#define G2_MMA(ai, bj, At, Bt) do { __builtin_amdgcn_s_setprio(1); _Pragma("unroll") for (int m = 0; m < 4; ++m) _Pragma("unroll") for (int n = 0; n < 2; ++n) _Pragma("unroll") for (int k = 0; k < 2; ++k) \
        acc[(ai) * 4 + m][(bj) * 2 + n] = __builtin_amdgcn_mfma_f32_16x16x32_bf16(Bt[n][k], At[m][k], acc[(ai) * 4 + m][(bj) * 2 + n], 0, 0, 0); __builtin_amdgcn_s_setprio(0); } while (0)
#define G2_WAIT_V(n) asm volatile("s_waitcnt vmcnt(" #n ")" ::: "memory")
#define G2_WAIT_L(n) asm volatile("s_waitcnt lgkmcnt(" #n ")" ::: "memory")
#define G2_BAR __builtin_amdgcn_s_barrier()
#define G2_SCHED __builtin_amdgcn_sched_barrier(0)
#define G2_VOFFA(U, dst) do { _Pragma("unroll") for (int _h = 0; _h < 2; ++_h) _Pragma("unroll") for (int _i = 0; _i < 2; ++_i) { const int _row = _h * 128 + sR[_i]; \
        int _tok = _row; if (Sched::GATHER) _tok = (_row < (U).valid) ? (U).ridx[_row] : 0; dst[_h][_i] = (unsigned)(_tok * K + sC[_i]) * 2u; } } while (0)
    Unit<Epi> cur, nxt; int ui = 0;
    if (!S.get(0, cur)) return;
    f32x4 acc[8][4];
#pragma unroll
    for (int i = 0; i < 8; ++i)
#pragma unroll
        for (int j = 0; j < 4; ++j) acc[i][j] = (f32x4){0.f, 0.f, 0.f, 0.f};
    bf16x8 At[4][2], B0[2][2], B1[2][2];
    unsigned cvA[2][2], nvA[2][2];
    G2_VOFFA(cur, cvA);
    const char* cA = (const char*)cur.A; const char* cB0 = (const char*)cur.B0; const char* cB1 = (const char*)cur.B1;
    G2_STAGE(G2_SB(0, 0), cB0, voffB[0], voffB[1]); G2_STAGE(G2_SA(0, 0), cA, cvA[0][0], cvA[0][1]); G2_STAGE(G2_SB(0, 1), cB1, voffB[0], voffB[1]); G2_STAGE(G2_SA(0, 1), cA, cvA[1][0], cvA[1][1]);
    if (wr == 1) G2_BAR;
    G2_WAIT_V(4); G2_BAR;
    G2_STAGE(G2_SB(1, 0), cB0 + kstep, voffB[0], voffB[1]); G2_STAGE(G2_SA(1, 0), cA + kstep, cvA[0][0], cvA[0][1]); G2_STAGE(G2_SB(1, 1), cB1 + kstep, voffB[0], voffB[1]);
    G2_WAIT_V(6); G2_BAR;
    for (;;) {
        const bool has_next = S.get(ui + 1, nxt);
        if (Sched::GATHER) {
            if (has_next) { G2_VOFFA(nxt, nvA); }
            else {
#pragma unroll
                for (int h = 0; h < 2; ++h) { nvA[h][0] = cvA[h][0]; nvA[h][1] = cvA[h][1]; } }
        }
        const char* nA = has_next ? (const char*)nxt.A : cA; const char* nB0 = has_next ? (const char*)nxt.B0 : cB0; const char* nB1 = has_next ? (const char*)nxt.B1 : cB1;
#pragma unroll 1
        for (int t = 0; t < nt; t += 2) {
            const bool last = (t == nt - 2);
            const char* a1 = cA + (size_t)(t + 1) * kstep;
            const char* a2 = last ? nA : cA + (size_t)(t + 2) * kstep;
            const char* b20 = last ? nB0 : cB0 + (size_t)(t + 2) * kstep; const char* b21 = last ? nB1 : cB1 + (size_t)(t + 2) * kstep;
#define x00 ((Sched::GATHER && last) ? nvA[0][0] : cvA[0][0])
#define x01 ((Sched::GATHER && last) ? nvA[0][1] : cvA[0][1])
#define x10 ((Sched::GATHER && last) ? nvA[1][0] : cvA[1][0])
#define x11 ((Sched::GATHER && last) ? nvA[1][1] : cvA[1][1])
            G2_LDB(B0, 0, 0); G2_SCHED; G2_LDA(At, 0, 0); G2_STAGE(G2_SA(1, 1), a1, cvA[1][0], cvA[1][1]);
            G2_WAIT_L(8); G2_BAR; G2_WAIT_L(0); G2_MMA(0, 0, At, B0); G2_BAR; G2_SCHED;
            G2_LDB(B1, 0, 1); G2_STAGE(G2_SB(0, 0), b20, voffB[0], voffB[1]);
            G2_BAR; G2_WAIT_L(0); G2_MMA(0, 1, At, B1); G2_BAR;
            G2_LDA(At, 0, 1); G2_STAGE(G2_SA(0, 0), a2, x00, x01);
            G2_BAR; G2_WAIT_L(0); G2_MMA(1, 0, At, B0); G2_BAR; G2_SCHED;
            G2_STAGE(G2_SB(0, 1), b21, voffB[0], voffB[1]);
            G2_WAIT_V(6); G2_BAR; G2_MMA(1, 1, At, B1); G2_BAR;
            G2_LDB(B0, 1, 0); G2_SCHED; G2_LDA(At, 1, 0); G2_STAGE(G2_SA(0, 1), a2, x10, x11);
            G2_WAIT_L(8); G2_BAR; G2_WAIT_L(0); G2_MMA(0, 0, At, B0); G2_BAR; G2_SCHED;
            G2_LDB(B1, 1, 1); G2_STAGE(G2_SB(1, 0), b20 + kstep, voffB[0], voffB[1]);
            G2_BAR; G2_WAIT_L(0); G2_MMA(0, 1, At, B1); G2_BAR;
            G2_LDA(At, 1, 1); G2_STAGE(G2_SA(1, 0), a2 + kstep, x00, x01);
            G2_BAR; G2_WAIT_L(0); G2_MMA(1, 0, At, B0); G2_BAR; G2_SCHED;
            G2_STAGE(G2_SB(1, 1), b21 + kstep, voffB[0], voffB[1]);
            G2_WAIT_V(6); G2_BAR; G2_MMA(1, 1, At, B1); G2_BAR;
        }
        { Lay lay; int rbv = wr * 64 + fr, cbv = wc * 32 + 4 * fq; asm volatile("" : "+v"(rbv), "+v"(cbv));
          lay.rbase = rbv; lay.cbase = cbv; cur.epi.run(acc, lay); }
        if (!has_next) break;
#pragma unroll
        for (int i = 0; i < 8; ++i)
#pragma unroll
            for (int j = 0; j < 4; ++j) acc[i][j] = (f32x4){0.f, 0.f, 0.f, 0.f};
        cur = nxt; cA = nA; cB0 = nB0; cB1 = nB1; ++ui;
        if (Sched::GATHER) {
#pragma unroll
            for (int h = 0; h < 2; ++h) { cvA[h][0] = nvA[h][0]; cvA[h][1] = nvA[h][1]; } }
    }
#undef x00
#undef x01
#undef x10
#undef x11
    G2_WAIT_V(0);
    if (wr == 0) G2_BAR;
    G2_BAR;
#undef G2_SA
#undef G2_SB
#undef G2_STAGE
#undef G2_LDA
#undef G2_LDB
#undef G2_MMA
#undef G2_WAIT_V
#undef G2_WAIT_L
#undef G2_BAR
#undef G2_SCHED
#undef G2_VOFFA
}
}

struct EpiF32 {
    float* C; int ld;
    template <class L> __device__ __forceinline__ void run(const f32x4 (&acc)[L::NI][L::NJ], const L& lay) const {
#pragma unroll
        for (int i = 0; i < L::NI; ++i)
#pragma unroll
            for (int j = 0; j < L::NJ; ++j) *(f32x4*)(C + (size_t)lay.row(i) * ld + lay.col(j)) = acc[i][j];
    }
};
struct EpiBf16 {
    bf16_t* C; int ld;
    template <class L> __device__ __forceinline__ void run(const f32x4 (&acc)[L::NI][L::NJ], const L& lay) const {
#pragma unroll
        for (int i = 0; i < L::NI; ++i)
#pragma unroll
            for (int j = 0; j < L::NJ; ++j) { u32x2 w; w.x = pack2(acc[i][j][0], acc[i][j][1]); w.y = pack2(acc[i][j][2], acc[i][j][3]);
                *(u32x2*)(C + (size_t)lay.row(i) * ld + lay.col(j)) = w; }
    }
};
struct EpiGateUp {
    bf16_t* C; int ld;
    template <class L> __device__ __forceinline__ void run(const f32x4 (&acc)[L::NI][L::NJ], const L& lay) const {
#pragma unroll
        for (int i = 0; i < L::NI; ++i)
#pragma unroll
            for (int j = 0; j < L::NJ / 2; ++j) { const f32x4 gt = acc[i][j], up = acc[i][j + L::NJ / 2];
                u32x2 w; w.x = pack2(silu_f(gt[0]) * up[0], silu_f(gt[1]) * up[1]); w.y = pack2(silu_f(gt[2]) * up[2], silu_f(gt[3]) * up[3]);
                *(u32x2*)(C + (size_t)lay.row(i) * ld + lay.col(j)) = w; }
    }
};
struct EpiInProj {
    bf16_t* Zt;
    bf16_t* tF;
    bf16_t* tV;
    int n0, pos0, n;
    template <class L> __device__ __forceinline__ void run(const f32x4 (&acc)[L::NI][L::NJ], const L& lay) const {
#pragma unroll
        for (int i = 0; i < L::NI; ++i)
#pragma unroll
            for (int j = 0; j < L::NJ; ++j) {
                const int r = lay.row(i), cl = lay.col(j), c = n0 + cl;
                const f32x4 v = acc[i][j];
                if (c < 512) {
                    const int part = c >> 8, ch = c & 255;
#pragma unroll
                    for (int e = 0; e < 4; ++e) tF[((size_t)(ch + e) * 2 + part) * n + pos0 + r] = f2bf(v[e]);
                } else {
                    u32x2 w; w.x = pack2(v[0], v[1]); w.y = pack2(v[2], v[3]);
                    *(u32x2*)(Zt + (size_t)r * ZC + cl) = w;
                    if (c >= 896 && c < 1024) {
#pragma unroll
                        for (int e = 0; e < 4; ++e) tV[(size_t)(c - 896 + e) * n + pos0 + r] = f2bf(v[e]);
                    }
                }
            }
    }
};

constexpr int U_ADA = 192, U_WIN = 2 * 16 * 28, U_WOUT = 2 * 16 * 16, U_SGU = 32, U_DFT = 256, U_ROPE = 1, U_EXP = 3 * 32 * 32;
constexpr int LDS_SIL = 0, LDS_RED = 20480, LDS_TILE = 32768, LDS_T64 = 49408, LDS_CTAB = 50176;

__device__ __forceinline__ void ada_unit(AP a, unsigned char* lds, int u) {
    float* sil = (float*)(lds + LDS_SIL); float* red = (float*)(lds + LDS_RED);
    const int tid = tid_opaque(), lane = tid & 63, w = tid >> 6;
    const int l = u / 96, cg = u % 96;
    for (int i = tid; i < 5120; i += NT) { const int r = i >> 10, k = i & 1023; const float v = (r < 4) ? a->in[1][r * 1024 + k] : a->in[3][k]; sil[i] = v / (1.0f + expf(-v)); }
    __syncthreads();
    const float* W = a->in[4] + (size_t)l * 1024 * 6144 + cg * 64 + lane;
    float acc[5] = {0.f, 0.f, 0.f, 0.f, 0.f};
#pragma unroll 32
    for (int k = w * 128; k < w * 128 + 128; ++k) { const float wv = W[(size_t)k * 6144];
#pragma unroll
        for (int r = 0; r < 5; ++r) acc[r] += sil[r * 1024 + k] * wv; }
#pragma unroll
    for (int r = 0; r < 5; ++r) red[(w * 5 + r) * 64 + lane] = acc[r];
    __syncthreads();
    if (tid < 320) { const int r = tid >> 6; float s = 0.f;
#pragma unroll
        for (int ww = 0; ww < 8; ++ww) s += red[(ww * 5 + r) * 64 + lane];
        const int j = cg * 64 + lane; ((float*)(a->ws + WS_MOD))[(size_t)(l * 5 + r) * 6144 + j] = s + a->in[5][l * 6144 + j]; }
    __syncthreads();
}

__device__ __forceinline__ void tile_store_T(const float* tile, bf16_t* dst, int ldd) {
    const int tid = tid_opaque(), n = tid >> 3, kc = tid & 7;
    u32x4 w;
    w.x = pack2(tile[(kc * 8 + 0) * 65 + n], tile[(kc * 8 + 1) * 65 + n]); w.y = pack2(tile[(kc * 8 + 2) * 65 + n], tile[(kc * 8 + 3) * 65 + n]);
    w.z = pack2(tile[(kc * 8 + 4) * 65 + n], tile[(kc * 8 + 5) * 65 + n]); w.w = pack2(tile[(kc * 8 + 6) * 65 + n], tile[(kc * 8 + 7) * 65 + n]);
    *(u32x4*)(dst + (size_t)n * ldd + kc * 8) = w;
}
__device__ __forceinline__ void tile_load(float* tile, const float* src, int lds_) {
    const int tid = tid_opaque();
#pragma unroll
    for (int i = 0; i < 2; ++i) { const int row = (tid >> 4) + 32 * i, c4 = (tid & 15) * 4; const f32x4 v = *(const f32x4*)(src + (size_t)row * lds_ + c4);
        tile[row * 65 + c4 + 0] = v[0]; tile[row * 65 + c4 + 1] = v[1]; tile[row * 65 + c4 + 2] = v[2]; tile[row * 65 + c4 + 3] = v[3]; }
}

__device__ __forceinline__ void mm64_f32(const float* tA, int lda, const float* tB, int ldb, int K, float* out) {
    const int tid = tid_opaque(), lane = tid & 63, w = tid >> 6, fr = lane & 15, g = lane >> 4, mi = w >> 1, nj = 2 * (w & 1);
    f32x4 acc0 = (f32x4){0.f, 0.f, 0.f, 0.f}, acc1 = (f32x4){0.f, 0.f, 0.f, 0.f};
    const float* pa = tA + (16 * mi + fr) * lda + g; const float* pb = tB + g * ldb + 16 * nj + fr;
#pragma unroll 4
    for (int k0 = 0; k0 < K; k0 += 4) { const float av = pa[k0], b0 = pb[k0 * ldb], b1 = pb[k0 * ldb + 16];
        acc0 = __builtin_amdgcn_mfma_f32_16x16x4f32(av, b0, acc0, 0, 0, 0); acc1 = __builtin_amdgcn_mfma_f32_16x16x4f32(av, b1, acc1, 0, 0, 0); }
#pragma unroll
    for (int r = 0; r < 4; ++r) { out[(16 * mi + 4 * g + r) * 65 + 16 * nj + fr] = acc0[r]; out[(16 * mi + 4 * g + r) * 65 + 16 * nj + 16 + fr] = acc1[r]; }
}

__device__ __forceinline__ void win_unit(AP a, unsigned char* lds, int u) {
    float* tile = (float*)(lds + LDS_TILE); float* T = (float*)(lds + LDS_T64);
    const int tid = tid_opaque();
    const int l = u / 448, r = u % 448, kb = r / 28, nb = r % 28;
    const float* Win = a->in[6] + (size_t)l * 1024 * 1536;
    const int srccol = (nb >= 8) ? nb * 64 - 256 : (nb & 3) * 64;
    tile_load(tile, Win + (size_t)(kb * 64) * 1536 + srccol, 1536);
    if (nb < 8 && tid < 64) { T[tid] = cospif((float)tid / 32.0f); T[64 + tid] = sinpif((float)tid / 32.0f); }
    __syncthreads();
    bf16_t* dst = (bf16_t*)(a->ws + WS_WIN) + ((size_t)l * ZC + nb * 64) * 1024 + kb * 64;
    if (nb >= 8) tile_store_T(tile, dst, 1024);
    else {
        const int part = nb >> 2;
        float* Tm = (float*)(lds + 65536); float* out = (float*)(lds + 98304);
        for (int i = tid; i < 4096; i += NT) { const int c = i >> 6, cp = i & 63; const float t = T[part * 64 + ((c * cp) & 63)]; Tm[i] = (part ? -t : t) * 0.125f; }
        __syncthreads();
        mm64_f32(tile, 65, Tm, 64, 64, out);
        __syncthreads();
        tile_store_T(out, dst, 1024);
    }
    __syncthreads();
}

__device__ __forceinline__ void wout_unit(AP a, unsigned char* lds, int u) {
    float* tile = (float*)(lds + LDS_TILE);
    __syncthreads();
    const int tid = tid_opaque();
    const int l = u / 256, r = u % 256, kb = r / 16, nb = r % 16;
    const float* Wo = a->in[13] + (size_t)l * 1024 * 1024;
    const int n = tid & 63, kq = __builtin_amdgcn_readfirstlane(tid >> 6);
    if (kb < 4) {
        float* tA = (float*)lds; float* tB = (float*)(lds + 65536);
        const float* wf = a->in[7] + (size_t)l * 256 * 256 + (size_t)(kb * 64) * 256;
        __syncthreads();
        f32x4 va[8], vb[8];
#pragma unroll
        for (int i = 0; i < 8; ++i) { const int q = tid + 512 * i; va[i] = *(const f32x4*)(wf + (size_t)q * 4); vb[i] = *(const f32x4*)(Wo + (size_t)(q >> 4) * 1024 + nb * 64 + (q & 15) * 4); }
#pragma unroll
        for (int i = 0; i < 8; ++i) { const int q = tid + 512 * i; *(f32x4*)(tA + (size_t)q * 4) = va[i]; *(f32x4*)(tB + (size_t)q * 4) = vb[i]; }
        __syncthreads();
        tile = (float*)(lds + 133120);
        mm64_f32(tA, 256, tB, 64, 256, tile);
    } else if (kb >= 8 && kb < 12) {
        const int g = kb - 8;
        float* tA = (float*)lds; float* tB = (float*)(lds + 65536);
        const float* wp = a->in[9] + (size_t)(l * 4 + g) * 64 * 64;
        const float* ps = a->in[10] + l * 256 + g * 64;
        f32x4 va[2], vb[2];
#pragma unroll
        for (int i = 0; i < 2; ++i) { const int q = tid + 512 * i; va[i] = *(const f32x4*)(wp + (size_t)q * 4); vb[i] = *(const f32x4*)(Wo + (size_t)(512 + g * 64 + (q >> 4)) * 1024 + nb * 64 + (q & 15) * 4) * ps[q >> 4]; }
#pragma unroll
        for (int i = 0; i < 2; ++i) { const int q = tid + 512 * i; *(f32x4*)(tA + (size_t)q * 4) = va[i]; *(f32x4*)(tB + (size_t)q * 4) = vb[i]; }
        __syncthreads();
        tile = (float*)(lds + 133120);
        mm64_f32(tA, 64, tB, 64, 64, tile);
    } else tile_load(tile, Wo + (size_t)(kb * 64) * 1024 + nb * 64, 1024);
    __syncthreads();
    tile_store_T(tile, (bf16_t*)(a->ws + WS_WOUT) + ((size_t)l * 1024 + nb * 64) * 1024 + kb * 64, 1024);
    __syncthreads();
}

__device__ __forceinline__ void exp_src_dst(AP a, int l, int u, const float*& src, int& srcld, bf16_t*& dst, int& dstld) {
    const int mat = u / 1024, e = (u % 1024) / 32, t = u % 32;
    const int kb = (mat < 2) ? t / 4 : t / 8, nb = (mat < 2) ? t % 4 : t % 8;
    srcld = (mat < 2) ? 512 : 1024; dstld = (mat < 2) ? 1024 : 512;
    src = a->in[18 + mat] + ((size_t)(l * 32 + e) * 512 * 1024) + (size_t)(kb * 128) * srcld + nb * 128;
    dst = (bf16_t*)(a->ws + WS_WEXP + (size_t)l * WEXP_LAYER) + (size_t)mat * EXPMAT + (size_t)e * 512 * 1024 + (size_t)(nb * 128) * dstld + kb * 128;
}
#define EXP_LOAD(vv, uu) do { exp_src_dst(a, l, (uu), src, srcld, dst, dstld); _Pragma("unroll") for (int _i = 0; _i < 8; ++_i) vv[_i] = *(const f32x4*)(src + (size_t)((tid >> 5) + 16 * _i) * srcld + (tid & 31) * 4); } while (0)
#define EXP_PUT(vv) do { _Pragma("unroll") for (int _i = 0; _i < 8; ++_i) { float* tp = tile + ((tid >> 5) + 16 * _i) * 129 + (tid & 31) * 4; tp[0] = vv[_i][0]; tp[1] = vv[_i][1]; tp[2] = vv[_i][2]; tp[3] = vv[_i][3]; } } while (0)
#define EXP_STORE(dd, ld_) do { const int n = tid >> 2, kq = tid & 3; _Pragma("unroll") for (int j = 0; j < 4; ++j) { const float* tp = tile + (kq * 32 + j * 8) * 129 + n; u32x4 w; \
        w.x = pack2(tp[0], tp[129]); w.y = pack2(tp[2 * 129], tp[3 * 129]); w.z = pack2(tp[4 * 129], tp[5 * 129]); w.w = pack2(tp[6 * 129], tp[7 * 129]); \
        *(u32x4*)((dd) + (size_t)n * (ld_) + kq * 32 + j * 8) = w; } } while (0)
__device__ __forceinline__ void exp_range(AP a, unsigned char* lds, int l, int u0, int u_end) {
    float* tile = (float*)lds;
    const int tid = tid_opaque();
    __syncthreads();
    if (u0 >= u_end) return;
    const float* src; bf16_t* dst; int srcld, dstld;
    f32x4 va[8], vb[8];
    bf16_t *da, *db = nullptr; int lda_, ldb_ = 0;
    EXP_LOAD(va, u0); da = dst; lda_ = dstld;
    if (u0 + 1 < u_end) { EXP_LOAD(vb, u0 + 1); db = dst; ldb_ = dstld; }
    for (int u = u0; u < u_end; u += 2) {
        EXP_PUT(va);
        __syncthreads();
        { bf16_t* cd = da; const int cl = lda_; if (u + 2 < u_end) { EXP_LOAD(va, u + 2); da = dst; lda_ = dstld; } EXP_STORE(cd, cl); }
        __syncthreads();
        if (u + 1 < u_end) {
            EXP_PUT(vb);
            __syncthreads();
            { bf16_t* cd = db; const int cl = ldb_; if (u + 3 < u_end) { EXP_LOAD(vb, u + 3); db = dst; ldb_ = dstld; } EXP_STORE(cd, cl); }
            __syncthreads();
        }
    }
}
#undef EXP_LOAD
#undef EXP_PUT
#undef EXP_STORE
__device__ __forceinline__ void exp_queue(AP a, unsigned char* lds, int l) {
    const int tid = tid_opaque();
    int* qslot = (int*)(lds + MISC_OFF + 128);
    unsigned* qc = (unsigned*)(a->ws + WS_BAR + 14336 + l * 256);
    for (;;) {
        __syncthreads();
        if (tid == 0) *qslot = (int)__hip_atomic_fetch_add(qc, 4u, __ATOMIC_RELAXED, __HIP_MEMORY_SCOPE_AGENT);
        __syncthreads();
        const int c0 = *qslot;
        if (c0 >= U_EXP) break;
        exp_range(a, lds, l, c0, c0 + 4);
    }
}

__device__ __forceinline__ void exp_fill(AP a, unsigned char* lds, int ql, int budget) {
    const int tid = tid_opaque();
    int* qslot = (int*)(lds + MISC_OFF + 128);
    unsigned* qc = (unsigned*)(a->ws + WS_BAR + 14336 + ql * 256);
    for (int done = 0; done < budget; done += 2) {
        __syncthreads();
        if (tid == 0) *qslot = (int)__hip_atomic_fetch_add(qc, 2u, __ATOMIC_RELAXED, __HIP_MEMORY_SCOPE_AGENT);
        __syncthreads();
        const int c0 = *qslot;
        if (c0 >= U_EXP) break;
        exp_range(a, lds, ql, c0, c0 + 2);
    }
    __syncthreads();
}

__device__ __forceinline__ void p0_prologue(AP a, unsigned char* lds) {
    const int tid = tid_opaque();
    bool have_tab = false;
    constexpr int E0 = U_ADA, E1 = E0 + U_WIN, E2 = E1 + U_WOUT, E3 = E2 + U_SGU, E4 = E3 + U_DFT, E5 = E4 + U_ROPE;
    int u = blockIdx.x;
    for (; u < E5; u += gridDim.x) {
        if (u < E0) ada_unit(a, lds, u);
        else if (u < E1) win_unit(a, lds, u - E0);
        else if (u < E2) wout_unit(a, lds, u - E1);
        else if (u < E3) { const size_t i0 = (size_t)(u - E2) * 4096 + tid * 8; const float* s = a->in[11] + i0; bf16_t* d = (bf16_t*)(a->ws + WS_WSGU) + i0;
            const f32x4 v0 = *(const f32x4*)s, v1 = *(const f32x4*)(s + 4); u32x4 w; w.x = pack2(v0[0], v0[1]); w.y = pack2(v0[2], v0[3]); w.z = pack2(v1[0], v1[1]); w.w = pack2(v1[2], v1[3]); *(u32x4*)d = w; }
        else if (u < E4) {
            float* ctab = (float*)(lds + LDS_CTAB);
            if (!have_tab) { for (int i = tid; i < 4096; i += NT) ctab[i] = cospif((float)i / 2048.0f); __syncthreads(); have_tab = true; }
            const int k = u - E3 + 4096;
            if (tid < 32) {
                const int kk = k - 4096, n0 = tid * 8; float c[8], s[8];
#pragma unroll
                for (int e = 0; e < 8; ++e) { const int idx = ((kk * (n0 + e)) & 255) * 16; c[e] = ctab[idx] * (1.0f / 16.0f); s[e] = ctab[(idx - 1024) & 4095] * (1.0f / 16.0f); }
                bf16_t* d = (bf16_t*)(a->ws + WS_DFTC) + (size_t)kk * 512 + n0;
                u32x4 w; w.x = pack2(c[0], c[1]); w.y = pack2(c[2], c[3]); w.z = pack2(c[4], c[5]); w.w = pack2(c[6], c[7]); *(u32x4*)d = w;
                w.x = pack2(s[0], s[1]); w.y = pack2(s[2], s[3]); w.z = pack2(s[4], s[5]); w.w = pack2(s[6], s[7]); *(u32x4*)(d + 256) = w;
            }
        }
        else {
            for (int i = tid; i < 1024; i += NT) { const int pos = i >> 4, f = i & 15; const float freq = powf(10000.0f, -(float)f / 16.0f); const float ang = (float)pos * freq;
                ((float2*)(a->ws + WS_ROPE))[i] = make_float2(cosf(ang), sinf(ang)); }
        }
    }
}

__device__ __forceinline__ void p_lnmod0(AP a) {
    const int tid = tid_opaque(), lane = tid & 63, w = tid >> 6;
    const float* mod = (const float*)(a->ws + WS_MOD);
    bf16_t* H = (bf16_t*)(a->ws + WS_H);
    const int tstep = gridDim.x * 8;
    f32x4 nx[4];
    { const int t = blockIdx.x * 8 + w; if (t < NTOK) { const float* src = (t < NLAT) ? a->in[0] + (size_t)t * D : a->in[2] + (size_t)(t - NLAT) * D;
#pragma unroll
        for (int i = 0; i < 4; ++i) nx[i] = *(const f32x4*)(src + 256 * i + 4 * lane); } }
    int mrow = -1; f32x4 msh[4], msc[4];
    for (int t = blockIdx.x * 8 + w; t < NTOK; t += tstep) {
        const int mr = (t < NLAT) ? (t >> 12) : 4;
        if (mr != mrow) { mrow = mr; const float* m = mod + (size_t)mr * 6144;
#pragma unroll
            for (int i = 0; i < 4; ++i) { msh[i] = *(const f32x4*)(m + 256 * i + 4 * lane); msc[i] = *(const f32x4*)(m + 1024 + 256 * i + 4 * lane); } }
        f32x4 v[4];
#pragma unroll
        for (int i = 0; i < 4; ++i) v[i] = nx[i];
        { const int tn = t + tstep; if (tn < NTOK) { const float* src = (tn < NLAT) ? a->in[0] + (size_t)tn * D : a->in[2] + (size_t)(tn - NLAT) * D;
#pragma unroll
            for (int i = 0; i < 4; ++i) nx[i] = *(const f32x4*)(src + 256 * i + 4 * lane); } }
        float mean, rstd; ln_stats(v, mean, rstd);
#pragma unroll
        for (int i = 0; i < 4; ++i) { const int c = 256 * i + 4 * lane;
            f32x4 o;
#pragma unroll
            for (int e = 0; e < 4; ++e) o[e] = (v[i][e] - mean) * rstd * (1.0f + msc[i][e]) + msh[i][e];
            u32x2 pk; pk.x = pack2(o[0], o[1]); pk.y = pack2(o[2], o[3]); *(u32x2*)(H + (size_t)t * D + c) = pk; }
    }
}

__device__ __forceinline__ void p1_inproj(AP a, unsigned char* smem, LAS unsigned char* lds, int l);
__device__ __forceinline__ u32x4 ld16g(const bf16_t* p) { return *(const u32x4*)p; }
__device__ __forceinline__ void rope_pack8(u32x4& wl, u32x4& wh, const LAS f32x2* tab, bool do_rope, float scale) {
    float tl[8] = {lo2f(wl.x), hi2f(wl.x), lo2f(wl.y), hi2f(wl.y), lo2f(wl.z), hi2f(wl.z), lo2f(wl.w), hi2f(wl.w)};
    float th[8] = {lo2f(wh.x), hi2f(wh.x), lo2f(wh.y), hi2f(wh.y), lo2f(wh.z), hi2f(wh.z), lo2f(wh.w), hi2f(wh.w)};
#pragma unroll
    for (int j = 0; j < 8; ++j) {
        float r1 = tl[j], r2 = th[j];
        if (do_rope) { const f32x2 cs = tab[j]; r1 = tl[j] * cs.x - th[j] * cs.y; r2 = tl[j] * cs.y + th[j] * cs.x; }
        tl[j] = r1 * scale; th[j] = r2 * scale;
    }
    wl.x = pack2(tl[0], tl[1]); wl.y = pack2(tl[2], tl[3]); wl.z = pack2(tl[4], tl[5]); wl.w = pack2(tl[6], tl[7]);
    wh.x = pack2(th[0], th[1]); wh.y = pack2(th[2], th[3]); wh.z = pack2(th[4], th[5]); wh.w = pack2(th[6], th[7]);
}

__device__ __forceinline__ void mixer_sgu_pool(AP a, LAS unsigned char* lds, int l, int row0, int seq_row0, int pos0, int n) {
    const int tid = tid_opaque(), lane = tid & 63, w = __builtin_amdgcn_readfirstlane(tid >> 6), fr = lane & 15, g = lane >> 4;
    const bf16_t* Z = (const bf16_t*)(a->ws + WS_Z);
    bf16_t* CAT = (bf16_t*)(a->ws + WS_CAT);
    {
#pragma unroll
        for (int it = 0; it < 9; ++it) { const int id = tid + 512 * it, rr = id >> 5, ch = id & 31, j = pos0 - 8 + rr;
            u32x4 v = (u32x4){0u, 0u, 0u, 0u};
            if (j >= 0 && j < n) v = ld16g(Z + (size_t)(seq_row0 + j) * ZC + 1024 + ch * 8);
            *(LAS u32x4*)(lds + rr * 512 + ch * 16) = v; }
        __syncthreads();
        const int c = tid & 255, half = tid >> 8, hw = 1 << (c >> 6);
        const LAS bf16_t* P = (const LAS bf16_t*)lds + c;
        const int t0 = half * 64;
        float s = 0.f;
        for (int j = t0 - hw; j < t0 + hw; ++j) s += bf2f(P[(8 + j) * 256]);
        for (int tl = t0; tl < t0 + 64; ++tl) {
            const int pos = pos0 + tl; const int lo = max(pos - hw, 0), hi = min(pos + hw, n);
            CAT[(size_t)(row0 + tl) * D + 512 + c] = f2bf(s / (float)(hi - lo) - bf2f(P[(8 + tl) * 256]));
            s += bf2f(P[(8 + tl + hw) * 256]) - bf2f(P[(8 + tl - hw) * 256]);
        }
        __syncthreads();
    }
    {
        const int i16 = lane & 15;
        u32x4 gw[4][2];
#pragma unroll
        for (int ps = 0; ps < 4; ++ps) { const int q = w * 16 + ps * 4 + g; const bf16_t* src = Z + (size_t)(row0 + q) * ZC + 1536 + 16 * i16; gw[ps][0] = ld16g(src); gw[ps][1] = ld16g(src + 8); }
#pragma unroll
        for (int ps = 0; ps < 4; ++ps) {
            const int q = w * 16 + ps * 4 + g;
            float gv[16];
#pragma unroll
            for (int hh = 0; hh < 2; ++hh) { const u32x4 x = gw[ps][hh];
                gv[8 * hh + 0] = gelu_erf(lo2f(x.x)); gv[8 * hh + 1] = gelu_erf(hi2f(x.x)); gv[8 * hh + 2] = gelu_erf(lo2f(x.y)); gv[8 * hh + 3] = gelu_erf(hi2f(x.y));
                gv[8 * hh + 4] = gelu_erf(lo2f(x.z)); gv[8 * hh + 5] = gelu_erf(hi2f(x.z)); gv[8 * hh + 6] = gelu_erf(lo2f(x.w)); gv[8 * hh + 7] = gelu_erf(hi2f(x.w)); }
            float sm = 0.f;
#pragma unroll
            for (int e = 0; e < 16; ++e) sm += gv[e];
            const float mean = row_sum16(sm) * (1.0f / 256.0f);
            float qq = 0.f;
#pragma unroll
            for (int e = 0; e < 16; ++e) { const float d = gv[e] - mean; qq += d * d; }
            const float rstd = 1.0f / sqrtf(row_sum16(qq) * (1.0f / 256.0f) + 1e-6f);
#pragma unroll
            for (int e = 0; e < 16; ++e) { const int c = 16 * i16 + e; *(LAS bf16_t*)(lds + c * 256 + ((((q >> 3) ^ (c & 15))) << 4) + (q & 7) * 2) = f2bf((gv[e] - mean) * rstd); }
        }
    }
    __syncthreads();
    {
        const int h = w >> 1, ph = w & 1;
        const bf16_t* Ws = (const bf16_t*)(a->ws + WS_WSGU) + (size_t)(l * 4 + h) * 128 * 128;
        const float* bs = a->in[12] + (size_t)(l * 4 + h) * 128;
        f32x4 acc[4][4];
#pragma unroll
        for (int i = 0; i < 4; ++i)
#pragma unroll
            for (int j = 0; j < 4; ++j) acc[i][j] = (f32x4){0.f, 0.f, 0.f, 0.f};
#pragma unroll
        for (int ks = 0; ks < 4; ++ks) {
            bf16x8 af[4], bfv[4];
#pragma unroll
            for (int cf = 0; cf < 4; ++cf) { const int c = h * 64 + 16 * cf + fr; af[cf] = *(const LAS bf16x8*)(lds + c * 256 + (((4 * ks + g) ^ (c & 15)) << 4)); }
#pragma unroll
            for (int pf = 0; pf < 4; ++pf) { const int p = ph * 64 + 16 * pf + fr; bfv[pf] = *(const bf16x8*)(Ws + (size_t)p * 128 + 32 * ks + 8 * g); }
#pragma unroll
            for (int cf = 0; cf < 4; ++cf)
#pragma unroll
                for (int pf = 0; pf < 4; ++pf) acc[cf][pf] = __builtin_amdgcn_mfma_f32_16x16x32_bf16(af[cf], bfv[pf], acc[cf][pf], 0, 0, 0);
        }
#pragma unroll
        for (int pf = 0; pf < 4; ++pf) { const int p = ph * 64 + 16 * pf + fr; const float bias = bs[p];
#pragma unroll
            for (int cf = 0; cf < 4; ++cf) { const int c0 = h * 64 + 16 * cf + 4 * g;
                const u32x2 uw = *(const u32x2*)(Z + (size_t)(row0 + p) * ZC + 1280 + c0);
                u32x2 o; o.x = pack2(gelu_erf(lo2f(uw.x)) * (acc[cf][pf][0] + bias), gelu_erf(hi2f(uw.x)) * (acc[cf][pf][1] + bias));
                o.y = pack2(gelu_erf(lo2f(uw.y)) * (acc[cf][pf][2] + bias), gelu_erf(hi2f(uw.y)) * (acc[cf][pf][3] + bias));
                *(u32x2*)(CAT + (size_t)(row0 + p) * D + 768 + c0) = o; } }
    }
    __syncthreads();
}

__device__ __forceinline__ void mixer_attn(AP a, LAS unsigned char* lds, int l, int row0, int seq_row0, int pos0, int n, int b, bool is_ctx, int kvh) {
    const int tid = tid_opaque(), lane = tid & 63, w = __builtin_amdgcn_readfirstlane(tid >> 6), fr = lane & 15, g = lane >> 4;
    const bf16_t* Z = (const bf16_t*)(a->ws + WS_Z);
    bf16_t* CAT = (bf16_t*)(a->ws + WS_CAT);
    __syncthreads();
    ((LAS u32x4*)(lds + 98304))[tid] = ((const u32x4*)(a->ws + WS_ROPE))[tid];
    const LAS f32x2* rope = (const LAS f32x2*)(lds + 98304);
    constexpr float QS = 0.125f * 1.44269504088896341f;
    constexpr int QS_OFF = 0, KS_OFF = 32768, VS_OFF = 65536;
    const int nbq = pos0 >> 7;
    unsigned bmask = 0x18u;
    if (!is_ctx) { if (nbq > 0) bmask |= 1u; bmask |= 2u; if (nbq + 1 < (n >> 7)) bmask |= 4u; }
    const int kr = tid >> 2, kax = (tid >> 1) & 1, kh8 = tid & 1;
#define MX_KSRC(blk) (Z + (size_t)((((blk) < 3) ? seq_row0 + (nbq + (blk) - 1) * 128 : NLAT + b * 256 + ((blk) - 3) * 128) + kr) * ZC + 768 + kvh * 64 + kax * 32 + kh8 * 8)
#define MX_VSTAGE(blk, buf) do { const bool _band = (blk) < 3; const int _key0 = _band ? (nbq + (blk) - 1) * 128 : ((blk) - 3) * 128; \
        const bf16_t* _vs = _band ? (const bf16_t*)(a->ws + WS_VT) + (size_t)(b * 2 + kvh) * 64 * 4096 + _key0 : (const bf16_t*)(a->ws + WS_VTC) + (size_t)(b * 2 + kvh) * 64 * 256 + _key0; \
        const int _vld = _band ? 4096 : 256; \
        _Pragma("unroll") for (int _i = 0; _i < 2; ++_i) { const int _P = _i * 512 + tid, _d = _P >> 4, _c = (_P & 15) ^ (_d & 15); \
            glds16(_vs + (size_t)_d * _vld + _c * 8, lds + VS_OFF + (buf) * 16384 + _i * 8192 + w * 1024); } } while (0)
    {
        __syncthreads();
#pragma unroll
        for (int it = 0; it < 2; ++it) {
            const int item = tid + 512 * it, r = item >> 2, ax = (item >> 1) & 1, h8 = item & 1, i = r & 127, qpos = pos0 + i;
            const bf16_t* src = Z + (size_t)(row0 + i) * ZC + 512 + (2 * kvh + (r >> 7)) * 64 + ax * 32 + h8 * 8;
            u32x4 wl = ld16g(src), wh = ld16g(src + 16);
            rope_pack8(wl, wh, rope + (ax ? (qpos & 63) : (qpos >> 6)) * 16 + h8 * 8, !is_ctx, QS);
            const int ch = ax * 4 + h8, sw = (r >> 1) & 7;
            *(LAS u32x4*)(lds + QS_OFF + r * 128 + ((ch ^ sw) << 4)) = wl;
            *(LAS u32x4*)(lds + QS_OFF + r * 128 + (((ch + 2) ^ sw) << 4)) = wh;
        }
        const int hh = w >> 2, qb = (w & 3) * 32, h = 2 * kvh + hh;
        float m[2], lsum[2];
        m[0] = m[1] = a->in[8][l * 4 + h] * 1.44269504088896341f;
        lsum[0] = lsum[1] = (g == 0) ? 1.0f : 0.0f;
        f32x4 O[4][2];
#pragma unroll
        for (int i = 0; i < 4; ++i) { O[i][0] = (f32x4){0.f, 0.f, 0.f, 0.f}; O[i][1] = (f32x4){0.f, 0.f, 0.f, 0.f}; }
        bf16x8 Qf[2][2];
        bool have_q = false;
        unsigned rem = bmask;
        int cur = __builtin_ctz(rem); rem &= rem - 1u;
        int buf = 0;
        u32x4 kl = ld16g(MX_KSRC(cur)), kh = ld16g(MX_KSRC(cur) + 16);
        MX_VSTAGE(cur, 0);
#pragma unroll 1
        for (;;) {
            const int jb = cur - 1; const bool band = cur < 3;
            {
                const int kpos = (nbq + jb) * 128 + kr;
                rope_pack8(kl, kh, rope + (kax ? (kpos & 63) : (kpos >> 6)) * 16 + kh8 * 8, band, 1.0f);
                const int ch = kax * 4 + kh8, sw = (kr >> 1) & 7;
                *(LAS u32x4*)(lds + KS_OFF + buf * 16384 + kr * 128 + ((ch ^ sw) << 4)) = kl;
                *(LAS u32x4*)(lds + KS_OFF + buf * 16384 + kr * 128 + (((ch + 2) ^ sw) << 4)) = kh;
            }
            asm volatile("s_waitcnt vmcnt(0)" ::: "memory");
            __syncthreads();
            const int nxt = rem ? __builtin_ctz(rem) : -1; rem &= rem - 1u;
            if (nxt >= 0) { kl = ld16g(MX_KSRC(nxt)); kh = ld16g(MX_KSRC(nxt) + 16); MX_VSTAGE(nxt, buf ^ 1); }
            if (!have_q) {
#pragma unroll
                for (int qf = 0; qf < 2; ++qf)
#pragma unroll
                    for (int ks = 0; ks < 2; ++ks) { const int r = hh * 128 + qb + 16 * qf + fr; Qf[qf][ks] = *(const LAS bf16x8*)(lds + QS_OFF + r * 128 + (((4 * ks + g) ^ ((r >> 1) & 7)) << 4)); }
                have_q = true;
            }
            const int kso = KS_OFF + buf * 16384, vso = VS_OFF + buf * 16384;
            f32x4 S[8][2];
#pragma unroll
            for (int kf = 0; kf < 8; ++kf) { S[kf][0] = (f32x4){0.f, 0.f, 0.f, 0.f}; S[kf][1] = (f32x4){0.f, 0.f, 0.f, 0.f}; }
#pragma unroll
            for (int kf = 0; kf < 8; ++kf)
#pragma unroll
                for (int ks = 0; ks < 2; ++ks) { const int r = 16 * kf + fr;
                    const bf16x8 kfr = *(const LAS bf16x8*)(lds + kso + r * 128 + (((4 * ks + g) ^ ((r >> 1) & 7)) << 4));
                    S[kf][0] = __builtin_amdgcn_mfma_f32_16x16x32_bf16(kfr, Qf[0][ks], S[kf][0], 0, 0, 0);
                    S[kf][1] = __builtin_amdgcn_mfma_f32_16x16x32_bf16(kfr, Qf[1][ks], S[kf][1], 0, 0, 0); }
            bf16x8 Pp[4][2];
#pragma unroll
            for (int qf = 0; qf < 2; ++qf) {
                const int qi = qb + 16 * qf + fr;
                if (band && jb != 0) {
#pragma unroll
                    for (int kf = 0; kf < 8; ++kf)
#pragma unroll
                        for (int r = 0; r < 4; ++r) { const int kk = 16 * kf + 4 * g + r; const bool ok = (jb < 0) ? (kk >= qi) : (kk <= qi); if (!ok) S[kf][qf][r] = -1.0e30f; }
                }
                float mx = S[0][qf][0];
#pragma unroll
                for (int kf = 0; kf < 8; ++kf)
#pragma unroll
                    for (int r = 0; r < 4; ++r) mx = fmaxf(mx, S[kf][qf][r]);
                mx = fmaxf(mx, __shfl_xor(mx, 16)); mx = fmaxf(mx, __shfl_xor(mx, 32));
                const float mn = fmaxf(m[qf], mx), corr = __builtin_amdgcn_exp2f(m[qf] - mn);
                m[qf] = mn;
                float ps = 0.f;
#pragma unroll
                for (int kf = 0; kf < 8; ++kf)
#pragma unroll
                    for (int r = 0; r < 4; ++r) { const float p = __builtin_amdgcn_exp2f(S[kf][qf][r] - mn); S[kf][qf][r] = p; ps += p; }
                lsum[qf] = lsum[qf] * corr + ps;
#pragma unroll
                for (int df = 0; df < 4; ++df) O[df][qf] *= corr;
#pragma unroll
                for (int t = 0; t < 4; ++t) { u32x4 pw; pw.x = pack2(S[2 * t][qf][0], S[2 * t][qf][1]); pw.y = pack2(S[2 * t][qf][2], S[2 * t][qf][3]);
                    pw.z = pack2(S[2 * t + 1][qf][0], S[2 * t + 1][qf][1]); pw.w = pack2(S[2 * t + 1][qf][2], S[2 * t + 1][qf][3]); Pp[t][qf] = __builtin_bit_cast(bf16x8, pw); }
            }
#pragma unroll
            for (int t = 0; t < 4; ++t)
#pragma unroll
                for (int df = 0; df < 4; ++df) { const int d = 16 * df + fr;
                    const u32x2 v0 = *(const LAS u32x2*)(lds + vso + d * 256 + (((4 * t + (g >> 1)) ^ (d & 15)) << 4) + (g & 1) * 8);
                    const u32x2 v1 = *(const LAS u32x2*)(lds + vso + d * 256 + (((4 * t + 2 + (g >> 1)) ^ (d & 15)) << 4) + (g & 1) * 8);
                    u32x4 vw; vw.x = v0.x; vw.y = v0.y; vw.z = v1.x; vw.w = v1.y; const bf16x8 vf = __builtin_bit_cast(bf16x8, vw);
                    O[df][0] = __builtin_amdgcn_mfma_f32_16x16x32_bf16(vf, Pp[t][0], O[df][0], 0, 0, 0);
                    O[df][1] = __builtin_amdgcn_mfma_f32_16x16x32_bf16(vf, Pp[t][1], O[df][1], 0, 0, 0); }
            if (nxt < 0) break;
            cur = nxt; buf ^= 1;
        }
#pragma unroll
        for (int qf = 0; qf < 2; ++qf) {
            float lt = lsum[qf]; lt += __shfl_xor(lt, 16); lt += __shfl_xor(lt, 32);
            const float inv = 1.0f / lt;
            bf16_t* dst = CAT + (size_t)(row0 + qb + 16 * qf + fr) * D + 256 + h * 64 + 4 * g;
#pragma unroll
            for (int df = 0; df < 4; ++df) { u32x2 o; o.x = pack2(O[df][qf][0] * inv, O[df][qf][1] * inv); o.y = pack2(O[df][qf][2] * inv, O[df][qf][3] * inv); *(u32x2*)(dst + 16 * df) = o; }
        }
    }
#undef MX_KSRC
#undef MX_VSTAGE
    __syncthreads();
}

constexpr int FF_DA = 0, FF_DC = 32768, FF_XT = 49152  , FF_Z2 = 81920  , FF_OB = 114688  ;
__device__ __forceinline__ int ff_addr(int row, int k) { return row * 256 + ((((k >> 3) ^ (row & 15))) << 4) + (k & 7) * 2; }
__device__ __forceinline__ float cos_turns(float x) { return __builtin_amdgcn_cosf(x); }
__device__ __forceinline__ float sin_turns(float x) { return __builtin_amdgcn_sinf(x); }
__device__ __forceinline__ void fft_setup(LAS unsigned char* lds) {
    const int tid = tid_opaque();
    __syncthreads();
    for (int idx = tid; idx < 16384; idx += NT) { const int i = idx >> 7, k = idx & 127, ro = i >> 6, k1 = i & 63, part = k >> 6, n1 = k & 63; const float t = (float)((k1 * n1) & 63) * (1.0f / 64.0f);
        const float c = cos_turns(t), sn = sin_turns(t);
        const float v = (ro == 0) ? (part == 0 ? c : sn) : (part == 0 ? -sn : c);
        *(LAS bf16_t*)(lds + FF_DA + ff_addr(i, k)) = f2bf(v * 0.125f); }
    for (int idx = tid; idx < 8192; idx += NT) { const int k2 = idx >> 7, k = idx & 127, ri = k >> 6, n2 = k & 63; const float t = (float)((k2 * n2) & 63) * (1.0f / 64.0f);
        const float v = (ri == 0) ? cos_turns(t) : sin_turns(t);
        *(LAS bf16_t*)(lds + FF_DC + ff_addr(k2, k)) = f2bf(v * 0.125f); }
    __syncthreads();
}
__device__ __forceinline__ void fft_unit(AP a, LAS unsigned char* lds, int b, int cg) {
    const int tid = tid_opaque(), lane = tid & 63, w = __builtin_amdgcn_readfirstlane(tid >> 6), fr = lane & 15, g = lane >> 4;
    const int mf = w & 3, nh = w >> 2;
    const bf16_t* AT = (const bf16_t*)(a->ws + WS_AT) + (size_t)(b * 256 + cg * 4) * 8192;
    u32x4 xin[2][2];
#pragma unroll
    for (int h = 0; h < 2; ++h)
#pragma unroll
        for (int it = 0; it < 2; ++it) xin[h][it] = ld16g(AT + (size_t)h * 8192 + (size_t)(tid + 512 * it) * 8);
#pragma unroll 1
    for (int cp = 0; cp < 2; ++cp) {
#pragma unroll
        for (int h = 0; h < 2; ++h)
#pragma unroll
            for (int it = 0; it < 2; ++it) { const int q = tid + 512 * it, part = q >> 9, pos0 = (q & 511) * 8, n1 = pos0 >> 6, n2 = pos0 & 63, k = part * 64 + n1;
                const unsigned wv[4] = {xin[h][it].x, xin[h][it].y, xin[h][it].z, xin[h][it].w};
#pragma unroll
                for (int e = 0; e < 4; ++e) { *(LAS bf16_t*)(lds + FF_XT + h * 16384 + ff_addr(n2 + 2 * e, k)) = (bf16_t)(wv[e] & 0xffffu); *(LAS bf16_t*)(lds + FF_XT + h * 16384 + ff_addr(n2 + 2 * e + 1, k)) = (bf16_t)(wv[e] >> 16); } }
        if (cp == 0) {
#pragma unroll
            for (int h = 0; h < 2; ++h)
#pragma unroll
                for (int it = 0; it < 2; ++it) xin[h][it] = ld16g(AT + (size_t)(2 + h) * 8192 + (size_t)(tid + 512 * it) * 8); }
        __syncthreads();
        f32x4 acc[2][2][2];
#pragma unroll
        for (int h = 0; h < 2; ++h)
#pragma unroll
            for (int x = 0; x < 2; ++x) { acc[h][x][0] = (f32x4){0.f, 0.f, 0.f, 0.f}; acc[h][x][1] = (f32x4){0.f, 0.f, 0.f, 0.f}; }
#pragma unroll
        for (int ks = 0; ks < 4; ++ks) {
            bf16x8 af[2];
#pragma unroll
            for (int x = 0; x < 2; ++x) { const int i = 16 * (mf + 4 * x) + fr; af[x] = *(const LAS bf16x8*)(lds + FF_DA + i * 256 + (((4 * ks + g) ^ (i & 15)) << 4)); }
#pragma unroll
            for (int h = 0; h < 2; ++h)
#pragma unroll
                for (int n = 0; n < 2; ++n) { const int j = 16 * (2 * nh + n) + fr; const bf16x8 bfv = *(const LAS bf16x8*)(lds + FF_XT + h * 16384 + j * 256 + (((4 * ks + g) ^ (j & 15)) << 4));
                    acc[h][0][n] = __builtin_amdgcn_mfma_f32_16x16x32_bf16(af[0], bfv, acc[h][0][n], 0, 0, 0);
                    acc[h][1][n] = __builtin_amdgcn_mfma_f32_16x16x32_bf16(af[1], bfv, acc[h][1][n], 0, 0, 0); }
        }
#pragma unroll
        for (int n = 0; n < 2; ++n)
#pragma unroll
            for (int r = 0; r < 4; ++r) { const int k1 = 16 * mf + 4 * g + r, n2 = 16 * (2 * nh + n) + fr; const float t = (float)((k1 * n2) & 4095) * (1.0f / 4096.0f);
                const float c = cos_turns(t), sn = sin_turns(t);
#pragma unroll
                for (int h = 0; h < 2; ++h) { const float zr = acc[h][0][n][r], zi = acc[h][1][n][r];
                    *(LAS bf16_t*)(lds + FF_Z2 + h * 16384 + ff_addr(k1, n2)) = f2bf(zr * c + zi * sn);
                    *(LAS bf16_t*)(lds + FF_Z2 + h * 16384 + ff_addr(k1, 64 + n2)) = f2bf(zi * c - zr * sn); } }
        __syncthreads();
        f32x4 acc2[2][2];
#pragma unroll
        for (int h = 0; h < 2; ++h) { acc2[h][0] = (f32x4){0.f, 0.f, 0.f, 0.f}; acc2[h][1] = (f32x4){0.f, 0.f, 0.f, 0.f}; }
#pragma unroll
        for (int ks = 0; ks < 4; ++ks) {
            const int i = 16 * mf + fr; const bf16x8 af = *(const LAS bf16x8*)(lds + FF_DC + i * 256 + (((4 * ks + g) ^ (i & 15)) << 4));
#pragma unroll
            for (int h = 0; h < 2; ++h)
#pragma unroll
                for (int n = 0; n < 2; ++n) { const int j = 16 * (2 * nh + n) + fr; const bf16x8 bfv = *(const LAS bf16x8*)(lds + FF_Z2 + h * 16384 + j * 256 + (((4 * ks + g) ^ (j & 15)) << 4));
                    acc2[h][n] = __builtin_amdgcn_mfma_f32_16x16x32_bf16(af, bfv, acc2[h][n], 0, 0, 0); }
        }
#pragma unroll
        for (int n = 0; n < 2; ++n)
#pragma unroll
            for (int r = 0; r < 4; ++r) { const int k = 16 * (2 * nh + n) + fr + 64 * (16 * mf + 4 * g + r);
                *(LAS unsigned*)(lds + FF_OB + k * 8 + cp * 4) = pack2(acc2[0][n][r], acc2[1][n][r]); }
    }
    __syncthreads();
    bf16_t* CAT = (bf16_t*)(a->ws + WS_CAT) + (size_t)(b * 4096) * D + cg * 4;
#pragma unroll
    for (int it = 0; it < 8; ++it) { const int k = tid + 512 * it; *(u32x2*)(CAT + (size_t)k * D) = *(const LAS u32x2*)(lds + FF_OB + k * 8); }
    __syncthreads();
}

__device__ __forceinline__ void p2_mix(AP a, unsigned char* ldsg, LAS unsigned char* lds, int l) {
    const int n_tile = 128 + ((l == 0) ? 8 : 0), n_att = 2 * n_tile, n_dft = 256, n_dftc = (l == 0) ? 16 : 0;
    bf16_t* CAT = (bf16_t*)(a->ws + WS_CAT);
    bool fft_ready = false;
    for (int u = blockIdx.x; u < n_att + n_dft + n_tile + n_dftc; u += gridDim.x) {
        if (u < n_att || (u >= n_att + n_dft && u < n_att + n_dft + n_tile)) {
            const bool att = u < n_att;
            const int t = att ? (u >> 1) : (u - n_att - n_dft);
            const bool isc = t >= 128; const int tt = t - 128;
            const int b = isc ? (tt >> 1) : (t >> 5);
            const int row0 = isc ? NLAT + tt * 128 : t * 128, seq_row0 = isc ? NLAT + b * 256 : b * 4096, pos0 = isc ? (tt & 1) * 128 : (t & 31) * 128, n = isc ? 256 : 4096;
            if (att) { for (int rep = 0; rep < PROBE_MIX_REP; ++rep) mixer_attn(a, lds, l, row0, seq_row0, pos0, n, b, isc, u & 1); }
            else { for (int rep = 0; rep < PROBE_SGU_REP; ++rep) mixer_sgu_pool(a, lds, l, row0, seq_row0, pos0, n); }
            fft_ready = false;
        } else if (u < n_att + n_dft) {
            const int uu = u - n_att;
            if (!fft_ready) { fft_setup(lds); fft_ready = true; }
            for (int rep = 0; rep < PROBE_FFT_REP; ++rep) fft_unit(a, lds, uu >> 6, uu & 63);
        } else {
            const int uu = u - n_att - n_dft - n_tile, b = uu >> 2, mt = (uu >> 1) & 1, ch0 = (uu & 1) * 128;
            const bf16_t* A = (const bf16_t*)(a->ws + WS_DFTC) + (size_t)(mt * 128) * 512;
            const bf16_t* B0 = (const bf16_t*)(a->ws + WS_ATC) + ((size_t)b * 256 + ch0) * 512;
            EpiBf16 E; E.C = CAT + (size_t)(NLAT + b * 256 + mt * 128) * D + ch0; E.ld = D;
            gemm_tile<128, false, EpiBf16>(lds, A, 512, nullptr, 128, B0, B0 + (size_t)64 * 512, 512, 512, E);
            fft_ready = false;
        }
    }
    exp_queue(a, ldsg, l);
}

__device__ __forceinline__ int uni(int v) { return __builtin_amdgcn_readfirstlane(v); }
__device__ __forceinline__ int vblock() { const int G = gridDim.x, b = blockIdx.x; return (G % 8 == 0) ? (b % 8) * (G / 8) + b / 8 : b; }
template <class T> __device__ __forceinline__ T* unip(T* p) { const unsigned long long v = (unsigned long long)p; const unsigned lo = __builtin_amdgcn_readfirstlane((unsigned)v), hi = __builtin_amdgcn_readfirstlane((unsigned)(v >> 32)); return (T*)(((unsigned long long)hi << 32) | lo); }
struct SchedInProj {
    typedef EpiInProj Epi; static constexpr bool GATHER = false;
    unsigned char* ws; int l, G, me;
    __device__ __forceinline__ bool get(int i, g256::Unit<Epi>& u) const {
        const int n_lat = 64 * 7, n_ctx = (l == 0) ? 4 * 7 : 4;
        const int idx = i * G + me; if (idx >= n_lat + n_ctx) return false;
        int row0, b, ct, n; bf16_t *tF, *tV;
        if (idx < n_lat) { const int rt = idx / 7; ct = idx % 7; row0 = rt * 256; b = row0 >> 12; n = 4096;
            tF = (bf16_t*)(ws + WS_AT) + (size_t)b * 256 * 2 * 4096; tV = (bf16_t*)(ws + WS_VT) + (size_t)b * 128 * 4096; }
        else { const int uu = idx - n_lat; int rt; if (l == 0) { rt = uu / 7; ct = uu % 7; } else { rt = uu; ct = 3; }
            row0 = NLAT + rt * 256; b = rt; n = 256;
            tF = (bf16_t*)(ws + WS_ATC) + (size_t)b * 256 * 2 * 256; tV = (bf16_t*)(ws + WS_VTC) + (size_t)b * 128 * 256; }
        u.A = (const bf16_t*)(ws + WS_H) + (size_t)row0 * D;
        u.B0 = (const bf16_t*)(ws + WS_WIN) + ((size_t)l * ZC + ct * 256) * 1024; u.B1 = u.B0 + (size_t)128 * 1024; u.ridx = nullptr; u.valid = 256;
        u.epi.Zt = (bf16_t*)(ws + WS_Z) + (size_t)row0 * ZC + ct * 256; u.epi.tF = tF; u.epi.tV = tV; u.epi.n0 = ct * 256; u.epi.pos0 = (idx < n_lat) ? (row0 & 4095) : 0; u.epi.n = n;
        return true;
    }
};
struct SchedOutProj {
    typedef EpiBf16 Epi; static constexpr bool GATHER = false;
    unsigned char* ws; int l, G, me;
    __device__ __forceinline__ bool get(int i, g256::Unit<Epi>& u) const {
        const int nrt = NLAT / 256;
        const int idx = i * G + me; if (idx >= nrt * 4) return false;
        const int rt = idx >> 2, ct = idx & 3;
        u.A = (const bf16_t*)(ws + WS_CAT) + (size_t)(rt * 256) * D;
        u.B0 = (const bf16_t*)(ws + WS_WOUT) + ((size_t)l * 1024 + ct * 256) * 1024; u.B1 = u.B0 + (size_t)128 * 1024; u.ridx = nullptr; u.valid = 256;
        u.epi.C = (bf16_t*)(ws + WS_Y) + (size_t)(rt * 256) * D + ct * 256; u.epi.ld = D;
        return true;
    }
};
struct SchedGateUp {
    typedef EpiGateUp Epi; static constexpr bool GATHER = true;
    unsigned char* ws; const LAS int* blk; const LAS int* tot; const LAS int* ridx_lds; int G, me, l;
    __device__ __forceinline__ bool get(int i, g256::Unit<Epi>& u) const {
        const int idx = i * G + me; if (idx >= uni(blk[32]) * 4) return false;
        const int rb = idx >> 2, ct = idx & 3;
        int e = 0;
#pragma unroll 1
        for (int q = 1; q < 32; ++q) if (uni(blk[q]) <= rb) e = q;
        u.A = (const bf16_t*)(ws + WS_H);
        u.B0 = (const bf16_t*)(ws + WS_WEXP + (size_t)l * WEXP_LAYER) + ((size_t)e * 512 + ct * 128) * 1024; u.B1 = u.B0 + EXPMAT;
        u.ridx = ridx_lds + (i & 7) * 256; u.valid = uni(min(256, tot[e] - (rb - blk[e]) * 256));
        u.epi.C = (bf16_t*)(ws + WS_HID) + (size_t)(rb * 256) * DEXP + ct * 128; u.epi.ld = DEXP;
        return true;
    }
};
struct SchedDown {
    typedef EpiBf16 Epi; static constexpr bool GATHER = false;
    unsigned char* ws; const LAS int* blk; int G, me, l;
    __device__ __forceinline__ bool get(int i, g256::Unit<Epi>& u) const {
        const int idx = i * G + me; if (idx >= uni(blk[32]) * 4) return false;
        const int rb = idx >> 2, ct = idx & 3;
        int e = 0;
#pragma unroll 1
        for (int q = 1; q < 32; ++q) if (uni(blk[q]) <= rb) e = q;
        u.A = (const bf16_t*)(ws + WS_HID) + (size_t)(rb * 256) * DEXP;
        u.B0 = (const bf16_t*)(ws + WS_WEXP + (size_t)l * WEXP_LAYER) + 2 * EXPMAT + ((size_t)e * 1024 + ct * 256) * 512; u.B1 = u.B0 + (size_t)128 * 512; u.ridx = nullptr; u.valid = 256;
        u.epi.C = (bf16_t*)(ws + WS_YS) + (size_t)(rb * 256) * D + ct * 256; u.epi.ld = D;
        return true;
    }
};

__device__ __forceinline__ void p4_ln1_router(AP a, unsigned char* lds, int l) {
    const int tid = tid_opaque(), lane = tid & 63, w = tid >> 6;
    const int ntok = (l == 0) ? NTOK : NLAT;
    int* cnt = (int*)(lds + MISC_OFF);
    if (tid < 32) cnt[tid] = 0;
    f32x4* Lg = (f32x4*)lds; f32x4* Le = (f32x4*)(lds + 16384); f32x4* Lgb = (f32x4*)(lds + 147456);
    {
        const float* wrg_ = a->in[16] + (size_t)l * 1024 * 4; const float* wre_ = a->in[17] + (size_t)l * 1024 * 32;
#pragma unroll
        for (int it = 0; it < 2; ++it) { const int c = tid + 512 * it, slot = (((c >> 8) * 4 + (c & 3)) << 6) + ((c >> 2) & 63);
            Lg[slot] = *(const f32x4*)(wrg_ + (size_t)c * 4);
#pragma unroll
            for (int q = 0; q < 8; ++q) Le[q * 1024 + slot] = *(const f32x4*)(wre_ + (size_t)c * 32 + q * 4); }
        Lgb[tid] = (tid < 256) ? *(const f32x4*)(a->in[14] + l * 1024 + tid * 4) : *(const f32x4*)(a->in[15] + l * 1024 + (tid - 256) * 4);
    }
    __syncthreads();
    const float* mod = (const float*)(a->ws + WS_MOD) + (size_t)l * 5 * 6144;
    const bf16_t* Y = (const bf16_t*)(a->ws + WS_Y);
    float* X1 = (float*)(a->ws + WS_X1);
    bf16_t* H = (bf16_t*)(a->ws + WS_H);
    int* tokE = (int*)(a->ws + WS_TOKE); int* tokR = (int*)(a->ws + WS_TOKR); float* tokG = (float*)(a->ws + WS_TOKG);
    const int tstep = gridDim.x * 8;
    f32x4 nx[4]; u32x2 ny[4];
    {   const int t = blockIdx.x * 8 + w;
        if (t < ntok) { const float* xs = (l == 0) ? ((t < NLAT) ? a->in[0] + (size_t)t * D : a->in[2] + (size_t)(t - NLAT) * D) : (const float*)(a->ws + WS_XC) + (size_t)t * D;
#pragma unroll
            for (int i = 0; i < 4; ++i) { nx[i] = *(const f32x4*)(xs + 256 * i + 4 * lane); ny[i] = *(const u32x2*)(Y + (size_t)t * D + 256 * i + 4 * lane); } } }
    int mrow = -1; f32x4 mg[4], msh[4], msc[4];
    for (int t = blockIdx.x * 8 + w; t < ntok; t += tstep) {
        const int mr = (t < NLAT) ? (t >> 12) : 4;
        if (mr != mrow) { mrow = mr; const float* m = mod + (size_t)mr * 6144;
#pragma unroll
            for (int i = 0; i < 4; ++i) { const int c = 256 * i + 4 * lane; mg[i] = *(const f32x4*)(m + 2048 + c); msh[i] = *(const f32x4*)(m + 3072 + c); msc[i] = *(const f32x4*)(m + 4096 + c); } }
        f32x4 v[4];
#pragma unroll
        for (int i = 0; i < 4; ++i) { const f32x4 yv = (f32x4){lo2f(ny[i].x), hi2f(ny[i].x), lo2f(ny[i].y), hi2f(ny[i].y)};
#pragma unroll
            for (int e = 0; e < 4; ++e) v[i][e] = RES_ALPHA * nx[i][e] + mg[i][e] * yv[e]; }
        {   const int tn = t + tstep;
            if (tn < ntok) { const float* xs = (l == 0) ? ((tn < NLAT) ? a->in[0] + (size_t)tn * D : a->in[2] + (size_t)(tn - NLAT) * D) : (const float*)(a->ws + WS_XC) + (size_t)tn * D;
#pragma unroll
                for (int i = 0; i < 4; ++i) { nx[i] = *(const f32x4*)(xs + 256 * i + 4 * lane); ny[i] = *(const u32x2*)(Y + (size_t)tn * D + 256 * i + 4 * lane); } } }
        float mean, rstd; ln_stats(v, mean, rstd);
#pragma unroll
        for (int i = 0; i < 4; ++i) { const int c = 256 * i + 4 * lane; const f32x4 gg = Lgb[64 * i + lane], bb = Lgb[256 + 64 * i + lane];
#pragma unroll
            for (int e = 0; e < 4; ++e) v[i][e] = (v[i][e] - mean) * rstd * gg[e] + bb[e];
            *(f32x4*)(X1 + (size_t)t * D + c) = v[i]; }
        ln_stats(v, mean, rstd);
#pragma unroll
        for (int i = 0; i < 4; ++i) { const int c = 256 * i + 4 * lane; const f32x4 sh = msh[i], sc = msc[i];
#pragma unroll
            for (int e = 0; e < 4; ++e) v[i][e] = (v[i][e] - mean) * rstd * (1.0f + sc[e]) + sh[e];
            u32x2 pk; pk.x = pack2(v[i][0], v[i][1]); pk.y = pack2(v[i][2], v[i][3]); *(u32x2*)(H + (size_t)t * D + c) = pk; }
        f32x2 lg01 = (f32x2){0.f, 0.f}, lg23 = (f32x2){0.f, 0.f};
#pragma unroll
        for (int i = 0; i < 4; ++i)
#pragma unroll
            for (int e = 0; e < 4; ++e) { const f32x4 wv = Lg[((i * 4 + e) << 6) + lane]; const f32x2 vv = (f32x2){v[i][e], v[i][e]};
                lg01 += vv * (f32x2){wv[0], wv[1]}; lg23 += vv * (f32x2){wv[2], wv[3]}; }
        float lg[4] = {wave_sum(lg01[0]), wave_sum(lg01[1]), wave_sum(lg23[0]), wave_sum(lg23[1])};
        int grp = 0; float mx = lg[0];
#pragma unroll
        for (int q = 1; q < 4; ++q) if (lg[q] > mx) { mx = lg[q]; grp = q; }
        float se = 0.f;
#pragma unroll
        for (int q = 0; q < 4; ++q) se += expf(lg[q] - mx);
        const float gate_group = 1.0f / se;
        f32x2 le01 = (f32x2){0.f, 0.f}, le23 = (f32x2){0.f, 0.f}, le45 = (f32x2){0.f, 0.f}, le67 = (f32x2){0.f, 0.f};
#pragma unroll
        for (int i = 0; i < 4; ++i)
#pragma unroll
            for (int e = 0; e < 4; ++e) { const f32x4* wp = Le + grp * 2048 + ((i * 4 + e) << 6) + lane; const f32x4 w0 = wp[0], w1 = wp[1024]; const f32x2 vv = (f32x2){v[i][e], v[i][e]};
                le01 += vv * (f32x2){w0[0], w0[1]}; le23 += vv * (f32x2){w0[2], w0[3]}; le45 += vv * (f32x2){w1[0], w1[1]}; le67 += vv * (f32x2){w1[2], w1[3]}; }
        float le[8] = {wave_sum(le01[0]), wave_sum(le01[1]), wave_sum(le23[0]), wave_sum(le23[1]), wave_sum(le45[0]), wave_sum(le45[1]), wave_sum(le67[0]), wave_sum(le67[1])};
        int j1 = 0; float l1 = le[0];
#pragma unroll
        for (int q = 1; q < 8; ++q) if (le[q] > l1) { l1 = le[q]; j1 = q; }
        int j2 = -1; float l2 = -3.0e38f;
#pragma unroll
        for (int q = 0; q < 8; ++q) if (q != j1 && le[q] > l2) { l2 = le[q]; j2 = q; }
        const float e2 = expf(l2 - l1), p1 = 1.0f / (1.0f + e2), p2 = e2 / (1.0f + e2);
        if (lane == 0) {
            const int ex0 = grp * 8 + j1, ex1 = grp * 8 + j2;
            const int r0 = atomicAdd(&cnt[ex0], 1), r1 = atomicAdd(&cnt[ex1], 1);
            tokE[2 * t] = ex0; tokE[2 * t + 1] = ex1; tokR[2 * t] = r0; tokR[2 * t + 1] = r1;
            tokG[2 * t] = gate_group * p1; tokG[2 * t + 1] = gate_group * p2;
        }
    }
    __syncthreads();
    if (tid < 32) ((int*)(a->ws + WS_BCNT))[((size_t)l * MAXG + blockIdx.x) * 32 + tid] = cnt[tid];
    __syncthreads();
}

__device__ __forceinline__ void p5_dispatch(AP a, unsigned char* lds, int l) {
    const int tid = tid_opaque();
    const int ntok = (l == 0) ? NTOK : NLAT;
    int* part = (int*)lds;
    int* tot = (int*)(lds + 4096);
    int* off = (int*)(lds + 4096 + 128);
    int* pstart = (int*)(lds + 4096 + 256);
    const int* bc = (const int*)(a->ws + WS_BCNT) + (size_t)l * MAXG * 32;
    const int G = gridDim.x, me = blockIdx.x;
    { const int e = tid & 31, p = tid >> 5; int s = 0, so = 0; for (int bb = p; bb < G; bb += 16) { const int c = bc[bb * 32 + e]; s += c; if (bb < me) so += c; } part[p * 32 + e] = s; part[512 + p * 32 + e] = so; }
    __syncthreads();
    if (tid < 32) { int s = 0, so = 0; for (int p = 0; p < 16; ++p) { s += part[p * 32 + tid]; so += part[512 + p * 32 + tid]; } tot[tid] = s; off[tid] = so; }
    __syncthreads();
    if (tid == 0) { int acc = 0; for (int e = 0; e < 32; ++e) { pstart[e] = acc; acc += ((tot[e] + 255) >> 8) << 8; } }
    __syncthreads();
    if (me == 0 && tid < 32) ((int*)(a->ws + WS_CNT))[l * 32 + tid] = tot[tid];
    const int* tokE = (const int*)(a->ws + WS_TOKE); const int* tokR = (const int*)(a->ws + WS_TOKR);
    int* tokS = (int*)(a->ws + WS_TOKS); int* slotT = (int*)(a->ws + WS_SLOTT);
    for (int q = tid; ; q += NT) { const int it = q >> 4, j = q & 15, t = (it * G + me) * 8 + (j >> 1); if (t >= ntok) break;
        const int idx = 2 * t + (j & 1); const int e = tokE[idx]; const int slot = pstart[e] + off[e] + tokR[idx]; tokS[idx] = slot; slotT[slot] = t; }
    __syncthreads();
}

__device__ __forceinline__ void moe_table(AP a, int l, LAS int* blk) {
    const int* tot = (const int*)(a->ws + WS_CNT) + l * 32;
    if (threadIdx.x == 0) { int acc = 0; for (int e = 0; e < 32; ++e) { const int c = tot[e]; blk[e] = acc; blk[33 + e] = c; acc += (c + 255) >> 8; } blk[32] = acc; }
    __syncthreads();
}
__device__ __forceinline__ int units_of(int nu, int v, int G) { return (v < nu) ? (nu - v + G - 1) / G : 0; }
__device__ __forceinline__ void p1_inproj(AP a, unsigned char* smem, LAS unsigned char* lds, int l) {
    SchedInProj S; S.ws = a->ws; S.l = l; S.G = gridDim.x; S.me = vblock();
    g256::gemm_phase(lds, 1024, S);
    if (l == 0) { const int nu = 64 * 7 + 4 * 7, G = gridDim.x; if (units_of(nu, S.me, G) < (nu + G - 1) / G) exp_fill(a, smem, 0, 8); }
}
__device__ __forceinline__ void p3_outproj(AP a, unsigned char* smem, LAS unsigned char* lds, int l) {
    SchedOutProj S; S.ws = a->ws; S.l = l; S.G = gridDim.x; S.me = vblock();
    g256::gemm_phase(lds, 1024, S);
    if (l == 0) {
        const bf16_t* W = (const bf16_t*)(a->ws + WS_WOUT);
        for (int u = blockIdx.x; u < 64; u += gridDim.x) { const int rt = u >> 3, ct = u & 7;
            EpiBf16 E; E.C = (bf16_t*)(a->ws + WS_Y) + (size_t)(NLAT + rt * 128) * D + ct * 128; E.ld = D;
            const bf16_t* B0 = W + (size_t)(ct * 128) * 1024;
            gemm_tile<128, false, EpiBf16>(lds, (const bf16_t*)(a->ws + WS_CAT) + (size_t)(NLAT + rt * 128) * D, D, nullptr, 128, B0, B0 + (size_t)64 * 1024, 1024, 1024, E); }
        if (blockIdx.x >= 64) exp_fill(a, smem, 0, 3);
    }
}
__device__ __forceinline__ void p6_gateup(AP a, unsigned char* smem, LAS unsigned char* lds, int l) {
    LAS int* blk = (LAS int*)(lds + MISC_OFF + 256);
    moe_table(a, l, blk);
    LAS int* ridx = (LAS int*)(lds + RIDX_OFF);
    const int tid = tid_opaque(), G = gridDim.x, me = vblock(), nu = blk[32] * 4;
    const int* slotT = (const int*)(a->ws + WS_SLOTT);
    for (int i = 0; i < 8; ++i) { const int idx = i * G + me; if (idx >= nu) break;
        const int rb = idx >> 2; int e = 0; for (int q = 1; q < 32; ++q) if (blk[q] <= rb) e = q;
        const int valid = min(256, blk[33 + e] - (rb - blk[e]) * 256);
        if (tid < 256) ridx[i * 256 + tid] = (tid < valid) ? slotT[rb * 256 + tid] : 0; }
    __syncthreads();
    SchedGateUp S; S.ws = a->ws; S.blk = blk; S.tot = blk + 33; S.ridx_lds = ridx; S.G = G; S.me = me; S.l = l;
    g256::gemm_phase(lds, 1024, S);
    __syncthreads();
    if (l == 0 && units_of(nu, me, G) < (nu + G - 1) / G) exp_fill(a, smem, 1, 8);
}
__device__ __forceinline__ void p7_down(AP a, unsigned char* smem, LAS unsigned char* lds, int l) {
    LAS int* blk = (LAS int*)(lds + MISC_OFF + 256);
    moe_table(a, l, blk);
    SchedDown S; S.ws = a->ws; S.blk = blk; S.G = gridDim.x; S.me = vblock(); S.l = l;
    g256::gemm_phase(lds, 512, S);
    __syncthreads();
    { const int nu = uni(blk[32]) * 4, G = gridDim.x; if (l == 0 && units_of(nu, S.me, G) < (nu + G - 1) / G) exp_fill(a, smem, 1, 5); }
}

__device__ __forceinline__ void p8_ln2(AP a, unsigned char* lds, int l) {
    const int tid = tid_opaque(), lane = tid & 63, w = tid >> 6;
    const int ntok = (l == 0) ? NTOK : NLAT;
    const float* mod = (const float*)(a->ws + WS_MOD) + (size_t)l * 5 * 6144;
    const float* modn = (const float*)(a->ws + WS_MOD) + (size_t)5 * 6144;
    const float* X1 = (const float*)(a->ws + WS_X1);
    const bf16_t* YS = (const bf16_t*)(a->ws + WS_YS);
    const int* tokS = (const int*)(a->ws + WS_TOKS); const float* tokG = (const float*)(a->ws + WS_TOKG);
    f32x4* Lgb = (f32x4*)lds;
    __syncthreads();
    Lgb[tid] = (tid < 256) ? *(const f32x4*)(a->in[21] + l * 1024 + tid * 4) : *(const f32x4*)(a->in[22] + l * 1024 + (tid - 256) * 4);
    __syncthreads();
    int mrow = -1; f32x4 mg[4], nsh[4], nsc[4];
    const int tstep = gridDim.x * 8;
    int t = blockIdx.x * 8 + w;
    int ns0 = 0, ns1 = 0; float nga = 0.f, ngb = 0.f;
    f32x4 nx[4]; u32x2 nya[4], nyb[4];
    float cga = 0.f, cgb = 0.f;
    if (t < ntok) { const int s0 = tokS[2 * t], s1 = tokS[2 * t + 1]; cga = tokG[2 * t]; cgb = tokG[2 * t + 1];
#pragma unroll
        for (int i = 0; i < 4; ++i) { const int c = 256 * i + 4 * lane; nx[i] = *(const f32x4*)(X1 + (size_t)t * D + c); nya[i] = *(const u32x2*)(YS + (size_t)s0 * D + c); nyb[i] = *(const u32x2*)(YS + (size_t)s1 * D + c); } }
    if (t + tstep < ntok) { ns0 = tokS[2 * (t + tstep)]; ns1 = tokS[2 * (t + tstep) + 1]; nga = tokG[2 * (t + tstep)]; ngb = tokG[2 * (t + tstep) + 1]; }
    for (; t < ntok; t += tstep) {
        const int mr = (t < NLAT) ? (t >> 12) : 4;
        if (mr != mrow) { mrow = mr; const float* m = mod + (size_t)mr * 6144; const float* mn = modn + (size_t)mr * 6144;
#pragma unroll
            for (int i = 0; i < 4; ++i) { const int c = 256 * i + 4 * lane; mg[i] = *(const f32x4*)(m + 5120 + c); if (l == 0) { nsh[i] = *(const f32x4*)(mn + c); nsc[i] = *(const f32x4*)(mn + 1024 + c); } } }
        f32x4 v[4];
#pragma unroll
        for (int i = 0; i < 4; ++i) { const f32x4 gv = mg[i];
            const u32x2 ya = nya[i], yb = nyb[i];
            const float f0 = cga * lo2f(ya.x) + cgb * lo2f(yb.x), f1 = cga * hi2f(ya.x) + cgb * hi2f(yb.x), f2 = cga * lo2f(ya.y) + cgb * lo2f(yb.y), f3 = cga * hi2f(ya.y) + cgb * hi2f(yb.y);
            v[i][0] = RES_ALPHA * nx[i][0] + gv[0] * f0; v[i][1] = RES_ALPHA * nx[i][1] + gv[1] * f1; v[i][2] = RES_ALPHA * nx[i][2] + gv[2] * f2; v[i][3] = RES_ALPHA * nx[i][3] + gv[3] * f3; }
        {   const int tn = t + tstep, tn2 = t + 2 * tstep;
            if (tn < ntok) {
#pragma unroll
                for (int i = 0; i < 4; ++i) { const int c = 256 * i + 4 * lane; nx[i] = *(const f32x4*)(X1 + (size_t)tn * D + c); nya[i] = *(const u32x2*)(YS + (size_t)ns0 * D + c); nyb[i] = *(const u32x2*)(YS + (size_t)ns1 * D + c); }
                cga = nga; cgb = ngb; }
            if (tn2 < ntok) { ns0 = tokS[2 * tn2]; ns1 = tokS[2 * tn2 + 1]; nga = tokG[2 * tn2]; ngb = tokG[2 * tn2 + 1]; } }
        float mean, rstd; ln_stats(v, mean, rstd);
        float* dst = (l == 0) ? (float*)(a->ws + WS_XC) + (size_t)t * D : a->out + (size_t)t * D;
#pragma unroll
        for (int i = 0; i < 4; ++i) { const int c = 256 * i + 4 * lane; const f32x4 gg = Lgb[64 * i + lane], bb = Lgb[256 + 64 * i + lane];
#pragma unroll
            for (int e = 0; e < 4; ++e) v[i][e] = (v[i][e] - mean) * rstd * gg[e] + bb[e];
            *(f32x4*)(dst + c) = v[i]; }
        if (l == 0) {
            ln_stats(v, mean, rstd);
            bf16_t* H = (bf16_t*)(a->ws + WS_H);
#pragma unroll
            for (int i = 0; i < 4; ++i) { const int c = 256 * i + 4 * lane; const f32x4 sh = nsh[i], sc = nsc[i];
                f32x4 o;
#pragma unroll
                for (int e = 0; e < 4; ++e) o[e] = (v[i][e] - mean) * rstd * (1.0f + sc[e]) + sh[e];
                u32x2 pk; pk.x = pack2(o[0], o[1]); pk.y = pack2(o[2], o[3]); *(u32x2*)(H + (size_t)t * D + c) = pk; }
        }
    }
}

constexpr int N_PHASES = 18;
template <int P> __device__ __forceinline__ void run_phase(AP a, unsigned char* smem, LAS unsigned char* lds, int l) {
    asm volatile("" : "+s"(a));
    if (P == 0) p0_prologue(a, smem);
    if (P == 1) p_lnmod0(a);
    if (P == 2) p1_inproj(a, smem, lds, l);
    if (P == 3) p2_mix(a, smem, lds, l);
    if (P == 4) p3_outproj(a, smem, lds, l);
    if (P == 5) p4_ln1_router(a, smem, l);
    if (P == 6) p5_dispatch(a, smem, l);
    if (P == 7) p6_gateup(a, smem, lds, l);
    if (P == 8) p7_down(a, smem, lds, l);
    if (P == 9) p8_ln2(a, smem, l);
}
#if N_LAUNCH_MODE == 1
__global__ void __launch_bounds__(NT, 2) fwd(Args a) {
    extern __shared__ __attribute__((aligned(16))) unsigned char smem[];
    LAS unsigned char* lds = (LAS unsigned char*)smem;
    if (threadIdx.x < 4) ((volatile LAS unsigned*)(lds + MISC_OFF + 768))[threadIdx.x] = 0u;
    __syncthreads();
    XcdBarrier bar = xcd_barrier_post((unsigned*)(a.ws + WS_BAR), (volatile LAS unsigned*)(lds + MISC_OFF + 768));
    AP ap = (AP)__builtin_amdgcn_kernarg_segment_ptr();
#define PROBE(P, l) do { if (PROBE_MASK & (1 << (P))) { for (int _r = 0; _r < 2; ++_r) { xcd_barrier(bar); run_phase<P>(ap, smem, lds, l); } } } while (0)
    run_phase<0>(ap, smem, lds, 0); PROBE(0, 0); xcd_barrier(bar);
    run_phase<1>(ap, smem, lds, 0); PROBE(1, 0); xcd_barrier(bar);
    for (int l = 0; l < 2; ++l) {
        run_phase<2>(ap, smem, lds, l); PROBE(2, l); xcd_barrier(bar);
        run_phase<3>(ap, smem, lds, l); PROBE(3, l); xcd_barrier(bar);
        run_phase<4>(ap, smem, lds, l); PROBE(4, l); xcd_barrier(bar);
        run_phase<5>(ap, smem, lds, l); PROBE(5, l); xcd_barrier(bar);
        run_phase<6>(ap, smem, lds, l); PROBE(6, l); xcd_barrier(bar);
        run_phase<7>(ap, smem, lds, l); PROBE(7, l); xcd_barrier(bar);
        run_phase<8>(ap, smem, lds, l); PROBE(8, l); xcd_barrier(bar);
        run_phase<9>(ap, smem, lds, l); PROBE(9, l); if (l == 0) xcd_barrier(bar);
    }
}
#else
template <int P> __global__ void __launch_bounds__(NT, 2) k_phase(Args a) {
    extern __shared__ __attribute__((aligned(16))) unsigned char smem[];
    LAS unsigned char* lds = (LAS unsigned char*)smem;
    AP ap = (AP)__builtin_amdgcn_kernarg_segment_ptr();
    run_phase<P>(ap, smem, lds, ap->ph_lo);
}
template <int P> static void launch_phase(Args a, int l, int grid, hipStream_t stream) {
    static bool attr = false;
    if (!attr) { (void)hipFuncSetAttribute((const void*)k_phase<P>, hipFuncAttributeMaxDynamicSharedMemorySize, LDS_BYTES); attr = true; }
    a.ph_lo = l; a.ph_hi = P;
    hipLaunchKernelGGL(k_phase<P>, dim3(grid), dim3(NT), LDS_BYTES, stream, a);
}
#endif

extern "C" void kernel_launch(void* const* d_in, const int* in_sizes, int n_in, void* d_out, int out_size, void* d_ws, size_t ws_size, hipStream_t stream) {
    static int grid = 0;
    if (grid == 0) {
        if (n_in != 23 || out_size != NLAT * D || ws_size < WS_END) { fprintf(stderr, "kernel_launch: unexpected shapes (n_in %d, out %d, ws %zu, need %zu)\n", n_in, out_size, ws_size, (size_t)WS_END); grid = -1; return; }
        int dev = 0, cus = 0;
        if (hipGetDevice(&dev) != hipSuccess || hipDeviceGetAttribute(&cus, hipDeviceAttributeMultiprocessorCount, dev) != hipSuccess) { grid = -1; return; }
#if N_LAUNCH_MODE == 1
        int per_cu = 0;
        if (hipFuncSetAttribute((const void*)fwd, hipFuncAttributeMaxDynamicSharedMemorySize, LDS_BYTES) != hipSuccess) { fprintf(stderr, "kernel_launch: hipFuncSetAttribute failed\n"); grid = -1; return; }
        if (hipOccupancyMaxActiveBlocksPerMultiprocessor(&per_cu, (const void*)fwd, NT, LDS_BYTES) != hipSuccess || per_cu < 1) { fprintf(stderr, "kernel_launch: occupancy query says %d\n", per_cu); }
        (void)hipGetLastError();
#endif
        grid = cus; if (grid > MAXG) grid = MAXG;
    }
    if (grid < 0) return;
    (void)hipMemsetAsync((char*)d_ws + WS_BAR, 0, 16384 + 256, stream);
    Args a{};
    for (int i = 0; i < 23; ++i) a.in[i] = (const float*)d_in[i];
    a.out = (float*)d_out; a.ws = (unsigned char*)d_ws;
#if N_LAUNCH_MODE == 1
    a.ph_lo = 0; a.ph_hi = N_PHASES;
    hipLaunchKernelGGL(fwd, dim3(grid), dim3(NT), LDS_BYTES, stream, a);
#else
    launch_phase<0>(a, 0, grid, stream);
    launch_phase<1>(a, 0, grid, stream);
    for (int l = 0; l < 2; ++l) {
        launch_phase<2>(a, l, grid, stream); launch_phase<3>(a, l, grid, stream); launch_phase<4>(a, l, grid, stream); launch_phase<5>(a, l, grid, stream);
        launch_phase<6>(a, l, grid, stream); launch_phase<7>(a, l, grid, stream); launch_phase<8>(a, l, grid, stream); launch_phase<9>(a, l, grid, stream);
    }
#endif
}
```

```cpp
#include <hip/hip_runtime.h>
#include <stdint.h>
#include <stdio.h>

#ifndef PROBE_MASK
#define PROBE_MASK 0
#endif
#ifndef PROBE_FFT_REP
#define PROBE_FFT_REP 1
#endif
#ifndef PROBE_MIX_REP
#define PROBE_MIX_REP 1
#endif
#ifndef PROBE_SGU_REP
#define PROBE_SGU_REP 1
#endif
#ifndef N_LAUNCH_MODE
#define N_LAUNCH_MODE 1
#endif

#define LAS __attribute__((address_space(3)))
typedef unsigned short bf16_t;
typedef short bf16x8 __attribute__((ext_vector_type(8)));
typedef float f32x4 __attribute__((ext_vector_type(4)));
typedef unsigned u32x4 __attribute__((ext_vector_type(4)));
typedef unsigned u32x2 __attribute__((ext_vector_type(2)));
typedef float f32x2 __attribute__((ext_vector_type(2)));

constexpr int D = 1024, NBATCH = 4, SEQ = 4096, CTXL = 256;
constexpr int NLAT = NBATCH * SEQ, NCTX = NBATCH * CTXL, NTOK = NLAT + NCTX;
constexpr int ZC = 1792;
constexpr int NEXP = 32, DEXP = 512;
constexpr int NSLOT = 2 * NTOK + NEXP * 256;
constexpr int NT = 512;
constexpr int MAXG = 512;
constexpr float RES_ALPHA = 1.41421356237309515f;
constexpr int MISC_OFF = 155648;
constexpr int RIDX_OFF = 131072;
constexpr int LDS_BYTES = MISC_OFF + 1024;

constexpr size_t WS_BAR   = 0;
constexpr size_t WS_CNT   = 16384;
constexpr size_t WS_BCNT  = WS_CNT + 256;
constexpr size_t WS_MOD   = WS_BCNT + (size_t)2 * MAXG * 32 * 4;
constexpr size_t WS_ROPE  = WS_MOD + (size_t)2 * 5 * 6144 * 4;
constexpr size_t WS_TOKE  = WS_ROPE + 8192;
constexpr size_t WS_TOKR  = WS_TOKE + (size_t)NTOK * 8;
constexpr size_t WS_TOKS  = WS_TOKR + (size_t)NTOK * 8;
constexpr size_t WS_TOKG  = WS_TOKS + (size_t)NTOK * 8;
constexpr size_t WS_SLOTT = WS_TOKG + (size_t)NTOK * 8;
constexpr size_t WS_WIN   = WS_SLOTT + (size_t)NSLOT * 4;
constexpr size_t WS_WOUT  = WS_WIN + (size_t)2 * ZC * 1024 * 2;
constexpr size_t WS_WSGU  = WS_WOUT + (size_t)2 * 1024 * 1024 * 2;
constexpr size_t WS_DFTC  = WS_WSGU + (size_t)2 * 4 * 128 * 128 * 2;
constexpr size_t WS_WEXP  = WS_DFTC + (size_t)256 * 512 * 2;
constexpr size_t EXPMAT   = (size_t)NEXP * 512 * 1024;
constexpr size_t WEXP_LAYER = 3 * EXPMAT * 2;
constexpr size_t WS_X1    = WS_WEXP + 2 * WEXP_LAYER;
constexpr size_t WS_XC    = WS_X1 + (size_t)NTOK * D * 4;
constexpr size_t WS_H     = WS_XC + (size_t)NTOK * D * 4;
constexpr size_t WS_R     = WS_H + (size_t)NTOK * D * 2;
constexpr size_t WS_Z     = WS_R;
constexpr size_t WS_AT    = WS_Z + (size_t)NTOK * ZC * 2;
constexpr size_t WS_ATC   = WS_AT + (size_t)4 * 256 * 8192 * 2;
constexpr size_t WS_VT    = WS_ATC + (size_t)4 * 256 * 512 * 2;
constexpr size_t WS_VTC   = WS_VT + (size_t)4 * 2 * 64 * 4096 * 2;
constexpr size_t WS_CAT   = WS_VTC + (size_t)4 * 2 * 64 * 256 * 2;
constexpr size_t WS_REND  = WS_CAT + (size_t)NTOK * D * 2;
constexpr size_t WS_Y     = WS_R;
constexpr size_t WS_HID   = WS_R;
constexpr size_t WS_YS    = WS_HID + (size_t)NSLOT * DEXP * 2;
constexpr size_t WS_END   = (WS_YS + (size_t)NSLOT * D * 2 > WS_REND) ? WS_YS + (size_t)NSLOT * D * 2 : WS_REND;
static_assert(WS_Y + (size_t)NTOK * D * 4 <= WS_CAT, "Y must not reach CAT");
static_assert(WS_WIN % 256 == 0 && WS_DFTC % 256 == 0 && WS_WEXP % 256 == 0 && WS_X1 % 256 == 0 && WS_H % 256 == 0 && WS_R % 256 == 0 && WS_AT % 256 == 0 && WS_CAT % 256 == 0 && WS_YS % 256 == 0, "alignment");

struct Args { const float* in[23]; float* out; unsigned char* ws; int ph_lo, ph_hi; };
#define CAS __attribute__((address_space(4)))
typedef const CAS Args* AP;

#define XB_TMO      128
#define XB_XCNT(j)  (256  + 64 * (j))
#define XB_XSUB(j)  (1280 + 64 * (j))
#define XB_XGEN(j)  (2304 + 64 * (j))
#define XB_TOP      3328
#define XB_TOPGEN   3392
#define XCD_BAR_WORDS 3456
#define XB_SPIN_CAP (1u << 18)

__device__ __forceinline__ unsigned xb_ld(unsigned* p)              { return __hip_atomic_load(p, __ATOMIC_RELAXED, __HIP_MEMORY_SCOPE_AGENT); }
__device__ __forceinline__ unsigned xb_add(unsigned* p, unsigned v) { return __hip_atomic_fetch_add(p, v, __ATOMIC_RELAXED, __HIP_MEMORY_SCOPE_AGENT); }
__device__ __forceinline__ unsigned xb_xcc_id() { return (unsigned)__builtin_amdgcn_s_getreg((3 << 11) | 20) & 0xFu; }
#define XB_SPIN(cond, bar) do { unsigned _sp = 0; while (cond) { __builtin_amdgcn_s_sleep(1); \
    if ((++_sp & 255u) == 0u) { if (xb_ld(&(bar)[XB_TMO])) break; if (_sp > XB_SPIN_CAP) { atomicAdd(&(bar)[XB_TMO], 1u); break; } } } } while (0)

struct XcdBarrier { unsigned* bar; unsigned x; volatile LAS unsigned* st; };

__device__ __forceinline__ XcdBarrier xcd_barrier_post(unsigned* bar, volatile LAS unsigned* st) {
    XcdBarrier b; b.bar = bar; b.x = (unsigned)__builtin_amdgcn_readfirstlane((int)xb_xcc_id()); b.st = st;
    if (threadIdx.x == 0) (void)xb_add(&bar[XB_XCNT(b.x)], 1u);
    return b;
}
__device__ __forceinline__ void xcd_barrier_complete(unsigned* bar, unsigned x, unsigned& nloc, unsigned& nx) {
    const unsigned G = gridDim.x * gridDim.y * gridDim.z;
    unsigned sum, cnt, mine, sp = 0u;
    for (;;) {
        sum = 0u; cnt = 0u; mine = 0u;
#pragma unroll
        for (unsigned j = 0; j < 16; ++j) { const unsigned c = xb_ld(&bar[XB_XCNT(j)]); sum += c; cnt += (c > 0u) ? 1u : 0u; mine = (j == x) ? c : mine; }
        if (sum == G) break;
        __builtin_amdgcn_s_sleep(1);
        if ((++sp & 255u) == 0u) { if (xb_ld(&bar[XB_TMO])) break; if (sp > XB_SPIN_CAP) { atomicAdd(&bar[XB_TMO], 1u); break; } }
    }
    nloc = mine > 0u ? mine : 1u; nx = cnt > 0u ? cnt : 1u;
}
__device__ __forceinline__ void xcd_barrier(const XcdBarrier& b) {
    asm volatile("s_waitcnt vmcnt(0)" ::: "memory");
    __syncthreads();
    if (threadIdx.x == 0) {
        unsigned* bar = b.bar;
        unsigned bx = b.x;
        asm volatile("" : "+s"(bar), "+s"(bx));
        __builtin_amdgcn_s_waitcnt(0);
        unsigned nloc = b.st[0], nx = b.st[1];
        if (nloc == 0u) { xcd_barrier_complete(bar, bx, nloc, nx); b.st[0] = nloc; b.st[1] = nx; }
        const unsigned old = xb_add(&bar[XB_XSUB(bx)], 1u);
        const unsigned gen = old / nloc;
        if (old + 1u == (gen + 1u) * nloc) {
            __builtin_amdgcn_fence(__ATOMIC_RELEASE, "agent");
            asm volatile("s_waitcnt vmcnt(0)" ::: "memory");
            const unsigned og = xb_add(&bar[XB_TOP], 1u);
            const unsigned tg = og / nx;
            if (og + 1u == (tg + 1u) * nx) xb_add(&bar[XB_TOPGEN], 1u);
            else XB_SPIN(xb_ld(&bar[XB_TOPGEN]) == tg, bar);
            __builtin_amdgcn_fence(__ATOMIC_ACQUIRE, "agent");
            xb_add(&bar[XB_XGEN(bx)], 1u);
            asm volatile("s_waitcnt vmcnt(0)" ::: "memory");
        } else {
            XB_SPIN(xb_ld(&bar[XB_XGEN(bx)]) == gen, bar);
            __builtin_amdgcn_fence(__ATOMIC_ACQUIRE, "agent");
            asm volatile("s_waitcnt vmcnt(0)" ::: "memory");
        }
    }
    __syncthreads();
}

__device__ __forceinline__ int tid_opaque() { int t = threadIdx.x; asm volatile("" : "+v"(t)); return t; }
__device__ __forceinline__ float bf2f(bf16_t v) { return __uint_as_float(((unsigned)v) << 16); }
__device__ __forceinline__ bf16_t f2bf(float f) { return __builtin_bit_cast(unsigned short, (__bf16)f); }
typedef __bf16 hwbf16x2 __attribute__((ext_vector_type(2)));
__device__ __forceinline__ unsigned pack2(float a, float b) { return __builtin_bit_cast(unsigned, __builtin_convertvector((f32x2){a, b}, hwbf16x2)); }
__device__ __forceinline__ float lo2f(unsigned w) { return __uint_as_float(w << 16); }
__device__ __forceinline__ float hi2f(unsigned w) { return __uint_as_float(w & 0xffff0000u); }
template <int CTRL> __device__ __forceinline__ float dpp_mov(float v) { return __builtin_bit_cast(float, __builtin_amdgcn_update_dpp(0, __builtin_bit_cast(int, v), CTRL, 0xf, 0xf, true)); }
__device__ __forceinline__ float row_sum16(float v) {
    v += dpp_mov<0xB1>(v);
    v += dpp_mov<0x4E>(v);
    v += dpp_mov<0x141>(v);
    v += dpp_mov<0x140>(v);
    return v;
}
__device__ __forceinline__ float row_max16(float v) {
    v = fmaxf(v, dpp_mov<0xB1>(v)); v = fmaxf(v, dpp_mov<0x4E>(v)); v = fmaxf(v, dpp_mov<0x141>(v)); v = fmaxf(v, dpp_mov<0x140>(v));
    return v;
}
__device__ __forceinline__ float wave_sum(float v) {
    v = row_sum16(v);
    const int iv = __builtin_bit_cast(int, v);
    const float a0 = __builtin_bit_cast(float, __builtin_amdgcn_readlane(iv, 0)), a1 = __builtin_bit_cast(float, __builtin_amdgcn_readlane(iv, 16));
    const float a2 = __builtin_bit_cast(float, __builtin_amdgcn_readlane(iv, 32)), a3 = __builtin_bit_cast(float, __builtin_amdgcn_readlane(iv, 48));
    return (a0 + a1) + (a2 + a3);
}
__device__ __forceinline__ float gelu_erf(float v) {
    const float t = __builtin_amdgcn_rcpf(fabsf(v) * 0.2316418882f + 1.0f);
    float q = t * 0.5307027145f + (-0.7265760135f); q = q * t + 0.7107068705f; q = q * t + (-0.142248368f); q = q * t + 0.127414796f; q = q * t;
    const float m = v * (q * __builtin_amdgcn_exp2f((v * v) * (-0.72134752044f)));
    return v < 0.f ? m : v - m;
}
__device__ __forceinline__ float silu_f(float x) { return x / (1.0f + __expf(-x)); }

__device__ __forceinline__ void ln_stats(const f32x4 (&v)[4], float& mean, float& rstd) {
    float s = 0.f;
#pragma unroll
    for (int i = 0; i < 4; ++i) s += (v[i][0] + v[i][1]) + (v[i][2] + v[i][3]);
    s = wave_sum(s); mean = s * (1.0f / 1024.0f);
    float q = 0.f;
#pragma unroll
    for (int i = 0; i < 4; ++i)
#pragma unroll
        for (int e = 0; e < 4; ++e) { const float d = v[i][e] - mean; q += d * d; }
    q = wave_sum(q); rstd = 1.0f / sqrtf(q * (1.0f / 1024.0f) + 1e-6f);
}

template <int BN> struct MfmaLayout {
    static constexpr int FG = BN / 128, NI = 4, NJ = 2 * FG;
    static constexpr bool PAIR8 = false;
    int rbase, cbase;
    __device__ __forceinline__ int row(int i) const { return rbase + 16 * i; }
    __device__ __forceinline__ int col(int jj) const { return (jj / FG) * (BN / 2) + (jj % FG) * 16 + cbase; }
};

__device__ __forceinline__ void glds16(const bf16_t* g, LAS unsigned char* l) {
    __builtin_amdgcn_global_load_lds((const unsigned*)g, (LAS unsigned*)l, 16, 0, 0);
}

template <int BN, bool GATHER, class Epi>
__device__ __forceinline__ void gemm_tile(LAS unsigned char* lds, const bf16_t* A, int lda, const int* rowidx, int valid_rows,
                                          const bf16_t* B0, const bf16_t* B1, int ldb, int K, const Epi& epi) {
    constexpr int A_B = 16384, B_B = BN * 128, STAGE = A_B + B_B, NBL = BN / 64;
    const int tid = tid_opaque(), lane = tid & 63, wid = __builtin_amdgcn_readfirstlane(tid >> 6);
    const bf16_t* ap[2]; const bf16_t* bp[NBL];
#pragma unroll
    for (int i = 0; i < 2; ++i) {
        const int P = i * 512 + tid, row = P >> 3, c = (P & 7) ^ ((row >> 1) & 7);
        size_t ro;
        if (GATHER) ro = (size_t)(row < valid_rows ? rowidx[row] : 0) * (size_t)lda; else ro = (size_t)row * (size_t)lda;
        ap[i] = A + ro + c * 8;
    }
#pragma unroll
    for (int i = 0; i < NBL; ++i) {
        const int P = i * 512 + tid, row = P >> 3, c = (P & 7) ^ ((row >> 1) & 7);
        const bf16_t* base = (row < BN / 2) ? (B0 + (size_t)row * ldb) : (B1 + (size_t)(row - BN / 2) * ldb);
        bp[i] = base + c * 8;
    }
    const int nk = K / 64;
#define GT_STAGE(buf, k0) do { \
        _Pragma("unroll") for (int _i = 0; _i < 2; ++_i) glds16(ap[_i] + (k0), lds + (buf) * STAGE + _i * 8192 + wid * 1024); \
        _Pragma("unroll") for (int _i = 0; _i < NBL; ++_i) glds16(bp[_i] + (k0), lds + (buf) * STAGE + A_B + _i * 8192 + wid * 1024); } while (0)

    typedef MfmaLayout<BN> Lay;
    constexpr int FG = Lay::FG;
    const int fr = lane & 15, g = lane >> 4, wr = wid >> 2, wc = wid & 3;
    Lay lay; lay.rbase = wr * 64 + fr; lay.cbase = wc * 16 * FG + 4 * g;
    f32x4 acc[Lay::NI][Lay::NJ];
#pragma unroll
    for (int i = 0; i < Lay::NI; ++i)
#pragma unroll
        for (int j = 0; j < Lay::NJ; ++j) acc[i][j] = (f32x4){0.f, 0.f, 0.f, 0.f};
    int aoff[4], boff[Lay::NJ];
#pragma unroll
    for (int m = 0; m < 4; ++m) { const int row = wr * 64 + m * 16 + fr; aoff[m] = row * 128 + ((g ^ ((row >> 1) & 7)) << 4); }
#pragma unroll
    for (int jj = 0; jj < Lay::NJ; ++jj) { const int row = (jj / FG) * (BN / 2) + wc * 16 * FG + (jj % FG) * 16 + fr; boff[jj] = A_B + row * 128 + ((g ^ ((row >> 1) & 7)) << 4); }
    GT_STAGE(0, 0);
    asm volatile("s_waitcnt vmcnt(0)" ::: "memory"); __syncthreads();
    for (int kt = 0; kt < nk; ++kt) {
        if (kt + 1 < nk) GT_STAGE((kt + 1) & 1, (kt + 1) * 64);
        const LAS unsigned char* sa = lds + (kt & 1) * STAGE;
#pragma unroll
        for (int ks = 0; ks < 2; ++ks) {
            bf16x8 af[4], bfv[Lay::NJ];
#pragma unroll
            for (int m = 0; m < 4; ++m) af[m] = *(const LAS bf16x8*)(sa + (aoff[m] ^ (ks << 6)));
#pragma unroll
            for (int jj = 0; jj < Lay::NJ; ++jj) bfv[jj] = *(const LAS bf16x8*)(sa + (boff[jj] ^ (ks << 6)));
#pragma unroll
            for (int m = 0; m < 4; ++m)
#pragma unroll
                for (int jj = 0; jj < Lay::NJ; ++jj) acc[m][jj] = __builtin_amdgcn_mfma_f32_16x16x32_bf16(bfv[jj], af[m], acc[m][jj], 0, 0, 0);
        }
        asm volatile("s_waitcnt vmcnt(0)" ::: "memory"); __syncthreads();
    }
    epi.run(acc, lay);
#undef GT_STAGE
}

namespace g256 {
constexpr int BK = 64, HALF = 128, HTB = HALF * BK * 2, STAGE_BYTES = 8 * HTB;
__device__ __forceinline__ int lds_byte(int r, int c) { const int st = (r >> 4) * 2 + (c >> 5), rr = r & 15, cc = c & 31, ob = rr * 64 + cc * 2; return st * 1024 + (ob ^ (((ob >> 9) & 1) << 5)); }
__device__ __forceinline__ int perm32(int rho) { const int n = rho >> 4, i = rho & 15; return 8 * (i >> 2) + 4 * n + (i & 3); }
__device__ __forceinline__ void stage_rc(int b, int& R, int& C) { const int st = b / 1024, sb = b % 1024, swz = sb ^ (((sb >> 9) & 1) << 5); R = (st >> 1) * 16 + swz / 64; C = (st & 1) * 32 + (swz % 64) / 2; }
struct Lay {
    static constexpr int NI = 8, NJ = 4;
    static constexpr bool PAIR8 = true;
    int rbase, cbase;
    __device__ __forceinline__ int row(int i) const { return (i >> 2) * 128 + (i & 3) * 16 + rbase; }
    __device__ __forceinline__ int col(int j) const { return (j >> 1) * 128 + (j & 1) * 4 + cbase; }
};
template <class Epi> struct Unit { const bf16_t* A; const bf16_t* B0; const bf16_t* B1; const LAS int* ridx; int valid; Epi epi; };

template <class Sched>
__device__ __forceinline__ void gemm_phase(LAS unsigned char* lds, const int K, const Sched& S) {
    typedef typename Sched::Epi Epi;
    const int tid = tid_opaque(), wid = __builtin_amdgcn_readfirstlane(tid >> 6), lane = tid & 63, wr = wid >> 2, wc = wid & 3, fr = lane & 15, fq = lane >> 4;
    int nt = K / BK; asm volatile("" : "+s"(nt));
    int sR[2], sC[2];
#pragma unroll
    for (int i = 0; i < 2; ++i) stage_rc(tid * 16 + i * 8192, sR[i], sC[i]);
    unsigned voffB[2];
#pragma unroll
    for (int i = 0; i < 2; ++i) voffB[i] = (unsigned)(((sR[i] & ~31) + perm32(sR[i] & 31)) * K + sC[i]) * 2u;
    const size_t kstep = (size_t)(BK * 2);
    const unsigned ldsw = (unsigned)wid * 1024u;
    const int aoff = lds_byte(wr * 64 + fr, fq * 8), boff = lds_byte(wc * 32 + fr, fq * 8);
#define G2_SA(b, h) (((b) * 2 + (h)) * HTB)
#define G2_SB(b, h) ((4 + (b) * 2 + (h)) * HTB)
#define G2_STAGE(bufoff, gbase, v0, v1) do { \
        __builtin_amdgcn_global_load_lds((const unsigned*)((const char*)(gbase) + (v0)), (LAS unsigned*)(lds + (bufoff) + ldsw), 16, 0, 0); \
        __builtin_amdgcn_global_load_lds((const unsigned*)((const char*)(gbase) + (v1)), (LAS unsigned*)(lds + (bufoff) + ldsw + 8192), 16, 0, 0); } while (0)
#define G2_LDA(dst, b, h) do { _Pragma("unroll") for (int m = 0; m < 4; ++m) _Pragma("unroll") for (int k = 0; k < 2; ++k) dst[m][k] = *(const LAS bf16x8*)(lds + G2_SA(b, h) + aoff + m * 2048 + k * 1024); } while (0)
#define G2_LDB(dst, b, h) do { _Pragma("unroll") for (int n = 0; n < 2; ++n) _Pragma("unroll") for (int k = 0; k < 2; ++k) dst[n][k] = *(const LAS bf16x8*)(lds + G2_SB(b, h) + boff + n * 2048 + k * 1024); } while (0)
#define G2_MMA(ai, bj, At, Bt) do { __builtin_amdgcn_s_setprio(1); _Pragma("unroll") for (int m = 0; m < 4; ++m) _Pragma("unroll") for (int n = 0; n < 2; ++n) _Pragma("unroll") for (int k = 0; k < 2; ++k) \
        acc[(ai) * 4 + m][(bj) * 2 + n] = __builtin_amdgcn_mfma_f32_16x16x32_bf16(Bt[n][k], At[m][k], acc[(ai) * 4 + m][(bj) * 2 + n], 0, 0, 0); __builtin_amdgcn_s_setprio(0); } while (0)
#define G2_WAIT_V(n) asm volatile("s_waitcnt vmcnt(" #n ")" ::: "memory")
#define G2_WAIT_L(n) asm volatile("s_waitcnt lgkmcnt(" #n ")" ::: "memory")
#define G2_BAR __builtin_amdgcn_s_barrier()
#define G2_SCHED __builtin_amdgcn_sched_barrier(0)
#define G2_VOFFA(U, dst) do { _Pragma("unroll") for (int _h = 0; _h < 2; ++_h) _Pragma("unroll") for (int _i = 0; _i < 2; ++_i) { const int _row = _h * 128 + sR[_i]; \
        int _tok = _row; if (Sched::GATHER) _tok = (_row < (U).valid) ? (U).ridx[_row] : 0; dst[_h][_i] = (unsigned)(_tok * K + sC[_i]) * 2u; } } while (0)
    Unit<Epi> cur, nxt; int ui = 0;
    if (!S.get(0, cur)) return;
    f32x4 acc[8][4];
#pragma unroll
    for (int i = 0; i < 8; ++i)
#pragma unroll
        for (int j = 0; j < 4; ++j) acc[i][j] = (f32x4){0.f, 0.f, 0.f, 0.f};
    bf16x8 At[4][2], B0[2][2], B1[2][2];
    unsigned cvA[2][2], nvA[2][2];
    G2_VOFFA(cur, cvA);
    const char* cA = (const char*)cur.A; const char* cB0 = (const char*)cur.B0; const char* cB1 = (const char*)cur.B1;
    G2_STAGE(G2_SB(0, 0), cB0, voffB[0], voffB[1]); G2_STAGE(G2_SA(0, 0), cA, cvA[0][0], cvA[0][1]); G2_STAGE(G2_SB(0, 1), cB1, voffB[0], voffB[1]); G2_STAGE(G2_SA(0, 1), cA, cvA[1][0], cvA[1][1]);
    if (wr == 1) G2_BAR;
    G2_WAIT_V(4); G2_BAR;
    G2_STAGE(G2_SB(1, 0), cB0 + kstep, voffB[0], voffB[1]); G2_STAGE(G2_SA(1, 0), cA + kstep, cvA[0][0], cvA[0][1]); G2_STAGE(G2_SB(1, 1), cB1 + kstep, voffB[0], voffB[1]);
    G2_WAIT_V(6); G2_BAR;
    for (;;) {
        const bool has_next = S.get(ui + 1, nxt);
        if (Sched::GATHER) {
            if (has_next) { G2_VOFFA(nxt, nvA); }
            else {
#pragma unroll
                for (int h = 0; h < 2; ++h) { nvA[h][0] = cvA[h][0]; nvA[h][1] = cvA[h][1]; } }
        }
        const char* nA = has_next ? (const char*)nxt.A : cA; const char* nB0 = has_next ? (const char*)nxt.B0 : cB0; const char* nB1 = has_next ? (const char*)nxt.B1 : cB1;
#pragma unroll 1
        for (int t = 0; t < nt; t += 2) {
            const bool last = (t == nt - 2);
            const char* a1 = cA + (size_t)(t + 1) * kstep;
            const char* a2 = last ? nA : cA + (size_t)(t + 2) * kstep;
            const char* b20 = last ? nB0 : cB0 + (size_t)(t + 2) * kstep; const char* b21 = last ? nB1 : cB1 + (size_t)(t + 2) * kstep;
#define x00 ((Sched::GATHER && last) ? nvA[0][0] : cvA[0][0])
#define x01 ((Sched::GATHER && last) ? nvA[0][1] : cvA[0][1])
#define x10 ((Sched::GATHER && last) ? nvA[1][0] : cvA[1][0])
#define x11 ((Sched::GATHER && last) ? nvA[1][1] : cvA[1][1])
            G2_LDB(B0, 0, 0); G2_SCHED; G2_LDA(At, 0, 0); G2_STAGE(G2_SA(1, 1), a1, cvA[1][0], cvA[1][1]);
            G2_WAIT_L(8); G2_BAR; G2_WAIT_L(0); G2_MMA(0, 0, At, B0); G2_BAR; G2_SCHED;
            G2_LDB(B1, 0, 1); G2_STAGE(G2_SB(0, 0), b20, voffB[0], voffB[1]);
            G2_BAR; G2_WAIT_L(0); G2_MMA(0, 1, At, B1); G2_BAR;
            G2_LDA(At, 0, 1); G2_STAGE(G2_SA(0, 0), a2, x00, x01);
            G2_BAR; G2_WAIT_L(0); G2_MMA(1, 0, At, B0); G2_BAR; G2_SCHED;
            G2_STAGE(G2_SB(0, 1), b21, voffB[0], voffB[1]);
            G2_WAIT_V(6); G2_BAR; G2_MMA(1, 1, At, B1); G2_BAR;
            G2_LDB(B0, 1, 0); G2_SCHED; G2_LDA(At, 1, 0); G2_STAGE(G2_SA(0, 1), a2, x10, x11);
            G2_WAIT_L(8); G2_BAR; G2_WAIT_L(0); G2_MMA(0, 0, At, B0); G2_BAR; G2_SCHED;
            G2_LDB(B1, 1, 1); G2_STAGE(G2_SB(1, 0), b20 + kstep, voffB[0], voffB[1]);
            G2_BAR; G2_WAIT_L(0); G2_MMA(0, 1, At, B1); G2_BAR;
            G2_LDA(At, 1, 1); G2_STAGE(G2_SA(1, 0), a2 + kstep, x00, x01);
            G2_BAR; G2_WAIT_L(0); G2_MMA(1, 0, At, B0); G2_BAR; G2_SCHED;
            G2_STAGE(G2_SB(1, 1), b21 + kstep, voffB[0], voffB[1]);
            G2_WAIT_V(6); G2_BAR; G2_MMA(1, 1, At, B1); G2_BAR;
        }
        { Lay lay; int rbv = wr * 64 + fr, cbv = wc * 32 + 8 * fq; asm volatile("" : "+v"(rbv), "+v"(cbv));
          lay.rbase = rbv; lay.cbase = cbv; cur.epi.run(acc, lay); }
        if (!has_next) break;
#pragma unroll
        for (int i = 0; i < 8; ++i)
#pragma unroll
            for (int j = 0; j < 4; ++j) acc[i][j] = (f32x4){0.f, 0.f, 0.f, 0.f};
        cur = nxt; cA = nA; cB0 = nB0; cB1 = nB1; ++ui;
        if (Sched::GATHER) {
#pragma unroll
            for (int h = 0; h < 2; ++h) { cvA[h][0] = nvA[h][0]; cvA[h][1] = nvA[h][1]; } }
    }
#undef x00
#undef x01
#undef x10
#undef x11
    G2_WAIT_V(0);
    if (wr == 0) G2_BAR;
    G2_BAR;
#undef G2_SA
#undef G2_SB
#undef G2_STAGE
#undef G2_LDA
#undef G2_LDB
#undef G2_MMA
#undef G2_WAIT_V
#undef G2_WAIT_L
#undef G2_BAR
#undef G2_SCHED
#undef G2_VOFFA
}
}

struct EpiF32 {
    float* C; int ld;
    template <class L> __device__ __forceinline__ void run(const f32x4 (&acc)[L::NI][L::NJ], const L& lay) const {
#pragma unroll
        for (int i = 0; i < L::NI; ++i)
#pragma unroll
            for (int j = 0; j < L::NJ; ++j) *(f32x4*)(C + (size_t)lay.row(i) * ld + lay.col(j)) = acc[i][j];
    }
};
struct EpiBf16 {
    bf16_t* C; int ld;
    template <class L> __device__ __forceinline__ void run(const f32x4 (&acc)[L::NI][L::NJ], const L& lay) const {
#pragma unroll
        for (int i = 0; i < L::NI; ++i) {
            if (L::PAIR8) {
#pragma unroll
                for (int j = 0; j < L::NJ; j += 2) { u32x4 w; w.x = pack2(acc[i][j][0], acc[i][j][1]); w.y = pack2(acc[i][j][2], acc[i][j][3]); w.z = pack2(acc[i][j + 1][0], acc[i][j + 1][1]); w.w = pack2(acc[i][j + 1][2], acc[i][j + 1][3]);
                    *(u32x4*)(C + (size_t)lay.row(i) * ld + lay.col(j)) = w; }
            } else {
#pragma unroll
                for (int j = 0; j < L::NJ; ++j) { u32x2 w; w.x = pack2(acc[i][j][0], acc[i][j][1]); w.y = pack2(acc[i][j][2], acc[i][j][3]);
                    *(u32x2*)(C + (size_t)lay.row(i) * ld + lay.col(j)) = w; }
            }
        }
    }
};
struct EpiGateUp {
    bf16_t* C; int ld;
    template <class L> __device__ __forceinline__ void run(const f32x4 (&acc)[L::NI][L::NJ], const L& lay) const {
#pragma unroll
        for (int i = 0; i < L::NI; ++i) {
            if (L::PAIR8 && L::NJ == 4) {
                const f32x4 g0 = acc[i][0], g1 = acc[i][1], u0 = acc[i][2], u1 = acc[i][3];
                u32x4 w; w.x = pack2(silu_f(g0[0]) * u0[0], silu_f(g0[1]) * u0[1]); w.y = pack2(silu_f(g0[2]) * u0[2], silu_f(g0[3]) * u0[3]);
                w.z = pack2(silu_f(g1[0]) * u1[0], silu_f(g1[1]) * u1[1]); w.w = pack2(silu_f(g1[2]) * u1[2], silu_f(g1[3]) * u1[3]);
                *(u32x4*)(C + (size_t)lay.row(i) * ld + lay.col(0)) = w;
            } else {
#pragma unroll
                for (int j = 0; j < L::NJ / 2; ++j) { const f32x4 gt = acc[i][j], up = acc[i][j + L::NJ / 2];
                    u32x2 w; w.x = pack2(silu_f(gt[0]) * up[0], silu_f(gt[1]) * up[1]); w.y = pack2(silu_f(gt[2]) * up[2], silu_f(gt[3]) * up[3]);
                    *(u32x2*)(C + (size_t)lay.row(i) * ld + lay.col(j)) = w; }
            }
        }
    }
};
struct EpiInProj {
    bf16_t* Zt;
    bf16_t* tF;
    bf16_t* tV;
    int n0, pos0, n;
    template <class L> __device__ __forceinline__ void run(const f32x4 (&acc)[L::NI][L::NJ], const L& lay) const {
        static_assert(L::PAIR8, "written for the paired-column layout");
#pragma unroll
        for (int i = 0; i < L::NI; ++i)
#pragma unroll
            for (int j = 0; j < L::NJ; j += 2) {
                const int r = lay.row(i), cl = lay.col(j), c = n0 + cl;
                const f32x4 v0 = acc[i][j], v1 = acc[i][j + 1];
                if (c < 512) {
                    const int part = c >> 8, ch = c & 255;
#pragma unroll
                    for (int e = 0; e < 4; ++e) { tF[((size_t)(ch + e) * 2 + part) * n + pos0 + r] = f2bf(v0[e]); tF[((size_t)(ch + 4 + e) * 2 + part) * n + pos0 + r] = f2bf(v1[e]); }
                } else {
                    u32x4 w; w.x = pack2(v0[0], v0[1]); w.y = pack2(v0[2], v0[3]); w.z = pack2(v1[0], v1[1]); w.w = pack2(v1[2], v1[3]);
                    *(u32x4*)(Zt + (size_t)r * ZC + cl) = w;
                    if (c >= 896 && c < 1024) {
#pragma unroll
                        for (int e = 0; e < 4; ++e) { tV[(size_t)(c - 896 + e) * n + pos0 + r] = f2bf(v0[e]); tV[(size_t)(c - 896 + 4 + e) * n + pos0 + r] = f2bf(v1[e]); }
                    }
                }
            }
    }
};

constexpr int U_ADA = 192, U_WIN = 2 * 16 * 28, U_WOUT = 2 * 16 * 16, U_SGU = 32, U_DFT = 256, U_ROPE = 1, U_EXP = 3 * 32 * 32;
constexpr int LDS_SIL = 0, LDS_RED = 20480, LDS_TILE = 32768, LDS_T64 = 49408, LDS_CTAB = 50176;

__device__ __forceinline__ void ada_unit(AP a, unsigned char* lds, int u) {
    float* sil = (float*)(lds + LDS_SIL); float* red = (float*)(lds + LDS_RED);
    const int tid = tid_opaque(), lane = tid & 63, w = tid >> 6;
    const int l = u / 96, cg = u % 96;
    for (int i = tid; i < 5120; i += NT) { const int r = i >> 10, k = i & 1023; const float v = (r < 4) ? a->in[1][r * 1024 + k] : a->in[3][k]; sil[i] = v / (1.0f + expf(-v)); }
    __syncthreads();
    const float* W = a->in[4] + (size_t)l * 1024 * 6144 + cg * 64 + lane;
    float acc[5] = {0.f, 0.f, 0.f, 0.f, 0.f};
#pragma unroll 32
    for (int k = w * 128; k < w * 128 + 128; ++k) { const float wv = W[(size_t)k * 6144];
#pragma unroll
        for (int r = 0; r < 5; ++r) acc[r] += sil[r * 1024 + k] * wv; }
#pragma unroll
    for (int r = 0; r < 5; ++r) red[(w * 5 + r) * 64 + lane] = acc[r];
    __syncthreads();
    if (tid < 320) { const int r = tid >> 6; float s = 0.f;
#pragma unroll
        for (int ww = 0; ww < 8; ++ww) s += red[(ww * 5 + r) * 64 + lane];
        const int j = cg * 64 + lane; ((float*)(a->ws + WS_MOD))[(size_t)(l * 5 + r) * 6144 + j] = s + a->in[5][l * 6144 + j]; }
    __syncthreads();
}

__device__ __forceinline__ void tile_store_T(const float* tile, bf16_t* dst, int ldd) {
    const int tid = tid_opaque(), n = tid >> 3, kc = tid & 7;
    u32x4 w;
    w.x = pack2(tile[(kc * 8 + 0) * 65 + n], tile[(kc * 8 + 1) * 65 + n]); w.y = pack2(tile[(kc * 8 + 2) * 65 + n], tile[(kc * 8 + 3) * 65 + n]);
    w.z = pack2(tile[(kc * 8 + 4) * 65 + n], tile[(kc * 8 + 5) * 65 + n]); w.w = pack2(tile[(kc * 8 + 6) * 65 + n], tile[(kc * 8 + 7) * 65 + n]);
    *(u32x4*)(dst + (size_t)n * ldd + kc * 8) = w;
}
__device__ __forceinline__ void tile_load(float* tile, const float* src, int lds_) {
    const int tid = tid_opaque();
#pragma unroll
    for (int i = 0; i < 2; ++i) { const int row = (tid >> 4) + 32 * i, c4 = (tid & 15) * 4; const f32x4 v = *(const f32x4*)(src + (size_t)row * lds_ + c4);
        tile[row * 65 + c4 + 0] = v[0]; tile[row * 65 + c4 + 1] = v[1]; tile[row * 65 + c4 + 2] = v[2]; tile[row * 65 + c4 + 3] = v[3]; }
}

__device__ __forceinline__ void mm64_f32(const float* tA, int lda, const float* tB, int ldb, int K, float* out) {
    const int tid = tid_opaque(), lane = tid & 63, w = tid >> 6, fr = lane & 15, g = lane >> 4, mi = w >> 1, nj = 2 * (w & 1);
    f32x4 acc0 = (f32x4){0.f, 0.f, 0.f, 0.f}, acc1 = (f32x4){0.f, 0.f, 0.f, 0.f};
    const float* pa = tA + (16 * mi + fr) * lda + g; const float* pb = tB + g * ldb + 16 * nj + fr;
#pragma unroll 4
    for (int k0 = 0; k0 < K; k0 += 4) { const float av = pa[k0], b0 = pb[k0 * ldb], b1 = pb[k0 * ldb + 16];
        acc0 = __builtin_amdgcn_mfma_f32_16x16x4f32(av, b0, acc0, 0, 0, 0); acc1 = __builtin_amdgcn_mfma_f32_16x16x4f32(av, b1, acc1, 0, 0, 0); }
#pragma unroll
    for (int r = 0; r < 4; ++r) { out[(16 * mi + 4 * g + r) * 65 + 16 * nj + fr] = acc0[r]; out[(16 * mi + 4 * g + r) * 65 + 16 * nj + 16 + fr] = acc1[r]; }
}

__device__ __forceinline__ void win_unit(AP a, unsigned char* lds, int u) {
    float* tile = (float*)(lds + LDS_TILE); float* T = (float*)(lds + LDS_T64);
    const int tid = tid_opaque();
    const int l = u / 448, r = u % 448, kb = r / 28, nb = r % 28;
    const float* Win = a->in[6] + (size_t)l * 1024 * 1536;
    const int srccol = (nb >= 8) ? nb * 64 - 256 : (nb & 3) * 64;
    tile_load(tile, Win + (size_t)(kb * 64) * 1536 + srccol, 1536);
    if (nb < 8 && tid < 64) { T[tid] = cospif((float)tid / 32.0f); T[64 + tid] = sinpif((float)tid / 32.0f); }
    __syncthreads();
    bf16_t* dst = (bf16_t*)(a->ws + WS_WIN) + ((size_t)l * ZC + nb * 64) * 1024 + kb * 64;
    if (nb >= 8) tile_store_T(tile, dst, 1024);
    else {
        const int part = nb >> 2;
        float* Tm = (float*)(lds + 65536); float* out = (float*)(lds + 98304);
        for (int i = tid; i < 4096; i += NT) { const int c = i >> 6, cp = i & 63; const float t = T[part * 64 + ((c * cp) & 63)]; Tm[i] = (part ? -t : t) * 0.125f; }
        __syncthreads();
        mm64_f32(tile, 65, Tm, 64, 64, out);
        __syncthreads();
        tile_store_T(out, dst, 1024);
    }
    __syncthreads();
}

__device__ __forceinline__ void wout_unit(AP a, unsigned char* lds, int u) {
    float* tile = (float*)(lds + LDS_TILE);
    __syncthreads();
    const int tid = tid_opaque();
    const int l = u / 256, r = u % 256, kb = r / 16, nb = r % 16;
    const float* Wo = a->in[13] + (size_t)l * 1024 * 1024;
    const int n = tid & 63, kq = __builtin_amdgcn_readfirstlane(tid >> 6);
    if (kb < 4) {
        float* tA = (float*)lds; float* tB = (float*)(lds + 65536);
        const float* wf = a->in[7] + (size_t)l * 256 * 256 + (size_t)(kb * 64) * 256;
        __syncthreads();
        f32x4 va[8], vb[8];
#pragma unroll
        for (int i = 0; i < 8; ++i) { const int q = tid + 512 * i; va[i] = *(const f32x4*)(wf + (size_t)q * 4); vb[i] = *(const f32x4*)(Wo + (size_t)(q >> 4) * 1024 + nb * 64 + (q & 15) * 4); }
#pragma unroll
        for (int i = 0; i < 8; ++i) { const int q = tid + 512 * i; *(f32x4*)(tA + (size_t)q * 4) = va[i]; *(f32x4*)(tB + (size_t)q * 4) = vb[i]; }
        __syncthreads();
        tile = (float*)(lds + 133120);
        mm64_f32(tA, 256, tB, 64, 256, tile);
    } else if (kb >= 8 && kb < 12) {
        const int g = kb - 8;
        float* tA = (float*)lds; float* tB = (float*)(lds + 65536);
        const float* wp = a->in[9] + (size_t)(l * 4 + g) * 64 * 64;
        const float* ps = a->in[10] + l * 256 + g * 64;
        f32x4 va[2], vb[2];
#pragma unroll
        for (int i = 0; i < 2; ++i) { const int q = tid + 512 * i; va[i] = *(const f32x4*)(wp + (size_t)q * 4); vb[i] = *(const f32x4*)(Wo + (size_t)(512 + g * 64 + (q >> 4)) * 1024 + nb * 64 + (q & 15) * 4) * ps[q >> 4]; }
#pragma unroll
        for (int i = 0; i < 2; ++i) { const int q = tid + 512 * i; *(f32x4*)(tA + (size_t)q * 4) = va[i]; *(f32x4*)(tB + (size_t)q * 4) = vb[i]; }
        __syncthreads();
        tile = (float*)(lds + 133120);
        mm64_f32(tA, 64, tB, 64, 64, tile);
    } else tile_load(tile, Wo + (size_t)(kb * 64) * 1024 + nb * 64, 1024);
    __syncthreads();
    tile_store_T(tile, (bf16_t*)(a->ws + WS_WOUT) + ((size_t)l * 1024 + nb * 64) * 1024 + kb * 64, 1024);
    __syncthreads();
}

__device__ __forceinline__ void exp_src_dst(AP a, int l, int u, const float*& src, int& srcld, bf16_t*& dst, int& dstld) {
    const int mat = u / 1024, e = (u % 1024) / 32, t = u % 32;
    const int kb = (mat < 2) ? t / 4 : t / 8, nb = (mat < 2) ? t % 4 : t % 8;
    srcld = (mat < 2) ? 512 : 1024; dstld = (mat < 2) ? 1024 : 512;
    src = a->in[18 + mat] + ((size_t)(l * 32 + e) * 512 * 1024) + (size_t)(kb * 128) * srcld + nb * 128;
    dst = (bf16_t*)(a->ws + WS_WEXP + (size_t)l * WEXP_LAYER) + (size_t)mat * EXPMAT + (size_t)e * 512 * 1024 + (size_t)(nb * 128) * dstld + kb * 128;
}
#define EXP_LOAD(vv, uu) do { exp_src_dst(a, l, (uu), src, srcld, dst, dstld); _Pragma("unroll") for (int _i = 0; _i < 8; ++_i) vv[_i] = *(const f32x4*)(src + (size_t)((tid >> 5) + 16 * _i) * srcld + (tid & 31) * 4); } while (0)
#define EXP_PUT(vv) do { _Pragma("unroll") for (int _i = 0; _i < 8; ++_i) { float* tp = tile + ((tid >> 5) + 16 * _i) * 129 + (tid & 31) * 4; tp[0] = vv[_i][0]; tp[1] = vv[_i][1]; tp[2] = vv[_i][2]; tp[3] = vv[_i][3]; } } while (0)
#define EXP_STORE(dd, ld_) do { const int n = tid >> 2, kq = tid & 3; _Pragma("unroll") for (int j = 0; j < 4; ++j) { const float* tp = tile + (kq * 32 + j * 8) * 129 + n; u32x4 w; \
        w.x = pack2(tp[0], tp[129]); w.y = pack2(tp[2 * 129], tp[3 * 129]); w.z = pack2(tp[4 * 129], tp[5 * 129]); w.w = pack2(tp[6 * 129], tp[7 * 129]); \
        *(u32x4*)((dd) + (size_t)n * (ld_) + kq * 32 + j * 8) = w; } } while (0)
__device__ __forceinline__ void exp_range(AP a, unsigned char* lds, int l, int u0, int u_end) {
    float* tile = (float*)lds;
    const int tid = tid_opaque();
    __syncthreads();
    if (u0 >= u_end) return;
    const float* src; bf16_t* dst; int srcld, dstld;
    f32x4 va[8], vb[8];
    bf16_t *da, *db = nullptr; int lda_, ldb_ = 0;
    EXP_LOAD(va, u0); da = dst; lda_ = dstld;
    if (u0 + 1 < u_end) { EXP_LOAD(vb, u0 + 1); db = dst; ldb_ = dstld; }
    for (int u = u0; u < u_end; u += 2) {
        EXP_PUT(va);
        __syncthreads();
        { bf16_t* cd = da; const int cl = lda_; if (u + 2 < u_end) { EXP_LOAD(va, u + 2); da = dst; lda_ = dstld; } EXP_STORE(cd, cl); }
        __syncthreads();
        if (u + 1 < u_end) {
            EXP_PUT(vb);
            __syncthreads();
            { bf16_t* cd = db; const int cl = ldb_; if (u + 3 < u_end) { EXP_LOAD(vb, u + 3); db = dst; ldb_ = dstld; } EXP_STORE(cd, cl); }
            __syncthreads();
        }
    }
}
#undef EXP_LOAD
#undef EXP_PUT
#undef EXP_STORE
__device__ __forceinline__ void exp_queue(AP a, unsigned char* lds, int l) {
    const int tid = tid_opaque();
    int* qslot = (int*)(lds + MISC_OFF + 128);
    unsigned* qc = (unsigned*)(a->ws + WS_BAR + 14336 + l * 256);
    for (;;) {
        __syncthreads();
        if (tid == 0) *qslot = (int)__hip_atomic_fetch_add(qc, 4u, __ATOMIC_RELAXED, __HIP_MEMORY_SCOPE_AGENT);
        __syncthreads();
        const int c0 = *qslot;
        if (c0 >= U_EXP) break;
        exp_range(a, lds, l, c0, c0 + 4);
    }
}

__device__ __forceinline__ void exp_fill(AP a, unsigned char* lds, int ql, int budget) {
    const int tid = tid_opaque();
    int* qslot = (int*)(lds + MISC_OFF + 128);
    unsigned* qc = (unsigned*)(a->ws + WS_BAR + 14336 + ql * 256);
    for (int done = 0; done < budget; done += 2) {
        __syncthreads();
        if (tid == 0) *qslot = (int)__hip_atomic_fetch_add(qc, 2u, __ATOMIC_RELAXED, __HIP_MEMORY_SCOPE_AGENT);
        __syncthreads();
        const int c0 = *qslot;
        if (c0 >= U_EXP) break;
        exp_range(a, lds, ql, c0, c0 + 2);
    }
    __syncthreads();
}

__device__ __forceinline__ void p0_prologue(AP a, unsigned char* lds) {
    const int tid = tid_opaque();
    bool have_tab = false;
    constexpr int E0 = U_ADA, E1 = E0 + U_WIN, E2 = E1 + U_WOUT, E3 = E2 + U_SGU, E4 = E3 + U_DFT, E5 = E4 + U_ROPE;
    int u = blockIdx.x;
    for (; u < E5; u += gridDim.x) {
        if (u < E0) ada_unit(a, lds, u);
        else if (u < E1) win_unit(a, lds, u - E0);
        else if (u < E2) wout_unit(a, lds, u - E1);
        else if (u < E3) { const size_t i0 = (size_t)(u - E2) * 4096 + tid * 8; const float* s = a->in[11] + i0; bf16_t* d = (bf16_t*)(a->ws + WS_WSGU) + i0;
            const f32x4 v0 = *(const f32x4*)s, v1 = *(const f32x4*)(s + 4); u32x4 w; w.x = pack2(v0[0], v0[1]); w.y = pack2(v0[2], v0[3]); w.z = pack2(v1[0], v1[1]); w.w = pack2(v1[2], v1[3]); *(u32x4*)d = w; }
        else if (u < E4) {
            float* ctab = (float*)(lds + LDS_CTAB);
            if (!have_tab) { for (int i = tid; i < 4096; i += NT) ctab[i] = cospif((float)i / 2048.0f); __syncthreads(); have_tab = true; }
            const int k = u - E3 + 4096;
            if (tid < 32) {
                const int kk = k - 4096, n0 = tid * 8; float c[8], s[8];
#pragma unroll
                for (int e = 0; e < 8; ++e) { const int idx = ((kk * (n0 + e)) & 255) * 16; c[e] = ctab[idx] * (1.0f / 16.0f); s[e] = ctab[(idx - 1024) & 4095] * (1.0f / 16.0f); }
                bf16_t* d = (bf16_t*)(a->ws + WS_DFTC) + (size_t)kk * 512 + n0;
                u32x4 w; w.x = pack2(c[0], c[1]); w.y = pack2(c[2], c[3]); w.z = pack2(c[4], c[5]); w.w = pack2(c[6], c[7]); *(u32x4*)d = w;
                w.x = pack2(s[0], s[1]); w.y = pack2(s[2], s[3]); w.z = pack2(s[4], s[5]); w.w = pack2(s[6], s[7]); *(u32x4*)(d + 256) = w;
            }
        }
        else {
            for (int i = tid; i < 1024; i += NT) { const int pos = i >> 4, f = i & 15; const float freq = powf(10000.0f, -(float)f / 16.0f); const float ang = (float)pos * freq;
                ((float2*)(a->ws + WS_ROPE))[i] = make_float2(cosf(ang), sinf(ang)); }
        }
    }
}

__device__ __forceinline__ void p_lnmod0(AP a) {
    const int tid = tid_opaque(), lane = tid & 63, w = tid >> 6;
    const float* mod = (const float*)(a->ws + WS_MOD);
    bf16_t* H = (bf16_t*)(a->ws + WS_H);
    const int tstep = gridDim.x * 8;
    f32x4 nx[4];
    { const int t = blockIdx.x * 8 + w; if (t < NTOK) { const float* src = (t < NLAT) ? a->in[0] + (size_t)t * D : a->in[2] + (size_t)(t - NLAT) * D;
#pragma unroll
        for (int i = 0; i < 4; ++i) nx[i] = *(const f32x4*)(src + 256 * i + 4 * lane); } }
    int mrow = -1; f32x4 msh[4], msc[4];
    for (int t = blockIdx.x * 8 + w; t < NTOK; t += tstep) {
        const int mr = (t < NLAT) ? (t >> 12) : 4;
        if (mr != mrow) { mrow = mr; const float* m = mod + (size_t)mr * 6144;
#pragma unroll
            for (int i = 0; i < 4; ++i) { msh[i] = *(const f32x4*)(m + 256 * i + 4 * lane); msc[i] = *(const f32x4*)(m + 1024 + 256 * i + 4 * lane); } }
        f32x4 v[4];
#pragma unroll
        for (int i = 0; i < 4; ++i) v[i] = nx[i];
        { const int tn = t + tstep; if (tn < NTOK) { const float* src = (tn < NLAT) ? a->in[0] + (size_t)tn * D : a->in[2] + (size_t)(tn - NLAT) * D;
#pragma unroll
            for (int i = 0; i < 4; ++i) nx[i] = *(const f32x4*)(src + 256 * i + 4 * lane); } }
        float mean, rstd; ln_stats(v, mean, rstd);
#pragma unroll
        for (int i = 0; i < 4; ++i) { const int c = 256 * i + 4 * lane;
            f32x4 o;
#pragma unroll
            for (int e = 0; e < 4; ++e) o[e] = (v[i][e] - mean) * rstd * (1.0f + msc[i][e]) + msh[i][e];
            u32x2 pk; pk.x = pack2(o[0], o[1]); pk.y = pack2(o[2], o[3]); *(u32x2*)(H + (size_t)t * D + c) = pk; }
    }
}

__device__ __forceinline__ void p1_inproj(AP a, unsigned char* smem, LAS unsigned char* lds, int l);
__device__ __forceinline__ u32x4 ld16g(const bf16_t* p) { return *(const u32x4*)p; }
__device__ __forceinline__ void rope_pack8(u32x4& wl, u32x4& wh, const LAS f32x2* tab, bool do_rope, float scale) {
    float tl[8] = {lo2f(wl.x), hi2f(wl.x), lo2f(wl.y), hi2f(wl.y), lo2f(wl.z), hi2f(wl.z), lo2f(wl.w), hi2f(wl.w)};
    float th[8] = {lo2f(wh.x), hi2f(wh.x), lo2f(wh.y), hi2f(wh.y), lo2f(wh.z), hi2f(wh.z), lo2f(wh.w), hi2f(wh.w)};
#pragma unroll
    for (int j = 0; j < 8; ++j) {
        float r1 = tl[j], r2 = th[j];
        if (do_rope) { const f32x2 cs = tab[j]; r1 = tl[j] * cs.x - th[j] * cs.y; r2 = tl[j] * cs.y + th[j] * cs.x; }
        tl[j] = r1 * scale; th[j] = r2 * scale;
    }
    wl.x = pack2(tl[0], tl[1]); wl.y = pack2(tl[2], tl[3]); wl.z = pack2(tl[4], tl[5]); wl.w = pack2(tl[6], tl[7]);
    wh.x = pack2(th[0], th[1]); wh.y = pack2(th[2], th[3]); wh.z = pack2(th[4], th[5]); wh.w = pack2(th[6], th[7]);
}

__device__ __forceinline__ void mixer_sgu_pool(AP a, LAS unsigned char* lds, int l, int row0, int seq_row0, int pos0, int n) {
    const int tid = tid_opaque(), lane = tid & 63, w = __builtin_amdgcn_readfirstlane(tid >> 6), fr = lane & 15, g = lane >> 4;
    const bf16_t* Z = (const bf16_t*)(a->ws + WS_Z);
    bf16_t* CAT = (bf16_t*)(a->ws + WS_CAT);
    {
#pragma unroll
        for (int it = 0; it < 9; ++it) { const int id = tid + 512 * it, rr = id >> 5, ch = id & 31, j = pos0 - 8 + rr;
            u32x4 v = (u32x4){0u, 0u, 0u, 0u};
            if (j >= 0 && j < n) v = ld16g(Z + (size_t)(seq_row0 + j) * ZC + 1024 + ch * 8);
            *(LAS u32x4*)(lds + rr * 512 + ch * 16) = v; }
        __syncthreads();
        const int c = tid & 255, half = tid >> 8, hw = 1 << (c >> 6);
        const LAS bf16_t* P = (const LAS bf16_t*)lds + c;
        const int t0 = half * 64;
        float s = 0.f;
        for (int j = t0 - hw; j < t0 + hw; ++j) s += bf2f(P[(8 + j) * 256]);
        for (int tl = t0; tl < t0 + 64; ++tl) {
            const int pos = pos0 + tl; const int lo = max(pos - hw, 0), hi = min(pos + hw, n);
            CAT[(size_t)(row0 + tl) * D + 512 + c] = f2bf(s / (float)(hi - lo) - bf2f(P[(8 + tl) * 256]));
            s += bf2f(P[(8 + tl + hw) * 256]) - bf2f(P[(8 + tl - hw) * 256]);
        }
        __syncthreads();
    }
    {
        const int i16 = lane & 15;
        u32x4 gw[4][2];
#pragma unroll
        for (int ps = 0; ps < 4; ++ps) { const int q = w * 16 + ps * 4 + g; const bf16_t* src = Z + (size_t)(row0 + q) * ZC + 1536 + 16 * i16; gw[ps][0] = ld16g(src); gw[ps][1] = ld16g(src + 8); }
#pragma unroll
        for (int ps = 0; ps < 4; ++ps) {
            const int q = w * 16 + ps * 4 + g;
            float gv[16];
#pragma unroll
            for (int hh = 0; hh < 2; ++hh) { const u32x4 x = gw[ps][hh];
                gv[8 * hh + 0] = gelu_erf(lo2f(x.x)); gv[8 * hh + 1] = gelu_erf(hi2f(x.x)); gv[8 * hh + 2] = gelu_erf(lo2f(x.y)); gv[8 * hh + 3] = gelu_erf(hi2f(x.y));
                gv[8 * hh + 4] = gelu_erf(lo2f(x.z)); gv[8 * hh + 5] = gelu_erf(hi2f(x.z)); gv[8 * hh + 6] = gelu_erf(lo2f(x.w)); gv[8 * hh + 7] = gelu_erf(hi2f(x.w)); }
            float sm = 0.f;
#pragma unroll
            for (int e = 0; e < 16; ++e) sm += gv[e];
            const float mean = row_sum16(sm) * (1.0f / 256.0f);
            float qq = 0.f;
#pragma unroll
            for (int e = 0; e < 16; ++e) { const float d = gv[e] - mean; qq += d * d; }
            const float rstd = 1.0f / sqrtf(row_sum16(qq) * (1.0f / 256.0f) + 1e-6f);
#pragma unroll
            for (int e = 0; e < 16; ++e) { const int c = 16 * i16 + e; *(LAS bf16_t*)(lds + c * 256 + ((((q >> 3) ^ (c & 15))) << 4) + (q & 7) * 2) = f2bf((gv[e] - mean) * rstd); }
        }
    }
    __syncthreads();
    {
        const int h = w >> 1, ph = w & 1;
        const bf16_t* Ws = (const bf16_t*)(a->ws + WS_WSGU) + (size_t)(l * 4 + h) * 128 * 128;
        const float* bs = a->in[12] + (size_t)(l * 4 + h) * 128;
        f32x4 acc[4][4];
#pragma unroll
        for (int i = 0; i < 4; ++i)
#pragma unroll
            for (int j = 0; j < 4; ++j) acc[i][j] = (f32x4){0.f, 0.f, 0.f, 0.f};
#pragma unroll
        for (int ks = 0; ks < 4; ++ks) {
            bf16x8 af[4], bfv[4];
#pragma unroll
            for (int cf = 0; cf < 4; ++cf) { const int c = h * 64 + 16 * cf + fr; af[cf] = *(const LAS bf16x8*)(lds + c * 256 + (((4 * ks + g) ^ (c & 15)) << 4)); }
#pragma unroll
            for (int pf = 0; pf < 4; ++pf) { const int p = ph * 64 + 16 * pf + fr; bfv[pf] = *(const bf16x8*)(Ws + (size_t)p * 128 + 32 * ks + 8 * g); }
#pragma unroll
            for (int cf = 0; cf < 4; ++cf)
#pragma unroll
                for (int pf = 0; pf < 4; ++pf) acc[cf][pf] = __builtin_amdgcn_mfma_f32_16x16x32_bf16(af[cf], bfv[pf], acc[cf][pf], 0, 0, 0);
        }
#pragma unroll
        for (int pf = 0; pf < 4; ++pf) { const int p = ph * 64 + 16 * pf + fr; const float bias = bs[p];
#pragma unroll
            for (int cf = 0; cf < 4; ++cf) { const int c0 = h * 64 + 16 * cf + 4 * g;
                const u32x2 uw = *(const u32x2*)(Z + (size_t)(row0 + p) * ZC + 1280 + c0);
                u32x2 o; o.x = pack2(gelu_erf(lo2f(uw.x)) * (acc[cf][pf][0] + bias), gelu_erf(hi2f(uw.x)) * (acc[cf][pf][1] + bias));
                o.y = pack2(gelu_erf(lo2f(uw.y)) * (acc[cf][pf][2] + bias), gelu_erf(hi2f(uw.y)) * (acc[cf][pf][3] + bias));
                *(u32x2*)(CAT + (size_t)(row0 + p) * D + 768 + c0) = o; } }
    }
    __syncthreads();
}

__device__ __forceinline__ void mixer_attn(AP a, LAS unsigned char* lds, int l, int row0, int seq_row0, int pos0, int n, int b, bool is_ctx, int kvh) {
    const int tid = tid_opaque(), lane = tid & 63, w = __builtin_amdgcn_readfirstlane(tid >> 6), fr = lane & 15, g = lane >> 4;
    const bf16_t* Z = (const bf16_t*)(a->ws + WS_Z);
    bf16_t* CAT = (bf16_t*)(a->ws + WS_CAT);
    __syncthreads();
    ((LAS u32x4*)(lds + 98304))[tid] = ((const u32x4*)(a->ws + WS_ROPE))[tid];
    const LAS f32x2* rope = (const LAS f32x2*)(lds + 98304);
    constexpr float QS = 0.125f * 1.44269504088896341f;
    constexpr int QS_OFF = 0, KS_OFF = 32768, VS_OFF = 65536;
    const int nbq = pos0 >> 7;
    unsigned bmask = 0x18u;
    if (!is_ctx) { if (nbq > 0) bmask |= 1u; bmask |= 2u; if (nbq + 1 < (n >> 7)) bmask |= 4u; }
    const int kr = tid >> 2, kax = (tid >> 1) & 1, kh8 = tid & 1;
#define MX_KSRC(blk) (Z + (size_t)((((blk) < 3) ? seq_row0 + (nbq + (blk) - 1) * 128 : NLAT + b * 256 + ((blk) - 3) * 128) + kr) * ZC + 768 + kvh * 64 + kax * 32 + kh8 * 8)
#define MX_VSTAGE(blk, buf) do { const bool _band = (blk) < 3; const int _key0 = _band ? (nbq + (blk) - 1) * 128 : ((blk) - 3) * 128; \
        const bf16_t* _vs = _band ? (const bf16_t*)(a->ws + WS_VT) + (size_t)(b * 2 + kvh) * 64 * 4096 + _key0 : (const bf16_t*)(a->ws + WS_VTC) + (size_t)(b * 2 + kvh) * 64 * 256 + _key0; \
        const int _vld = _band ? 4096 : 256; \
        _Pragma("unroll") for (int _i = 0; _i < 2; ++_i) { const int _P = _i * 512 + tid, _d = _P >> 4, _c = (_P & 15) ^ (_d & 15); \
            glds16(_vs + (size_t)_d * _vld + _c * 8, lds + VS_OFF + (buf) * 16384 + _i * 8192 + w * 1024); } } while (0)
    {
        __syncthreads();
#pragma unroll
        for (int it = 0; it < 2; ++it) {
            const int item = tid + 512 * it, r = item >> 2, ax = (item >> 1) & 1, h8 = item & 1, i = r & 127, qpos = pos0 + i;
            const bf16_t* src = Z + (size_t)(row0 + i) * ZC + 512 + (2 * kvh + (r >> 7)) * 64 + ax * 32 + h8 * 8;
            u32x4 wl = ld16g(src), wh = ld16g(src + 16);
            rope_pack8(wl, wh, rope + (ax ? (qpos & 63) : (qpos >> 6)) * 16 + h8 * 8, !is_ctx, QS);
            const int ch = ax * 4 + h8, sw = (r >> 1) & 7;
            *(LAS u32x4*)(lds + QS_OFF + r * 128 + ((ch ^ sw) << 4)) = wl;
            *(LAS u32x4*)(lds + QS_OFF + r * 128 + (((ch + 2) ^ sw) << 4)) = wh;
        }
        const int hh = w >> 2, qb = (w & 3) * 32, h = 2 * kvh + hh;
        float m[2], lsum[2];
        m[0] = m[1] = a->in[8][l * 4 + h] * 1.44269504088896341f;
        lsum[0] = lsum[1] = (g == 0) ? 1.0f : 0.0f;
        f32x4 O[4][2];
#pragma unroll
        for (int i = 0; i < 4; ++i) { O[i][0] = (f32x4){0.f, 0.f, 0.f, 0.f}; O[i][1] = (f32x4){0.f, 0.f, 0.f, 0.f}; }
        bf16x8 Qf[2][2];
        bool have_q = false;
        unsigned rem = bmask;
        int cur = __builtin_ctz(rem); rem &= rem - 1u;
        int buf = 0;
        u32x4 kl = ld16g(MX_KSRC(cur)), kh = ld16g(MX_KSRC(cur) + 16);
        MX_VSTAGE(cur, 0);
#pragma unroll 1
        for (;;) {
            const int jb = cur - 1; const bool band = cur < 3;
            {
                const int kpos = (nbq + jb) * 128 + kr;
                rope_pack8(kl, kh, rope + (kax ? (kpos & 63) : (kpos >> 6)) * 16 + kh8 * 8, band, 1.0f);
                const int ch = kax * 4 + kh8, sw = (kr >> 1) & 7;
                *(LAS u32x4*)(lds + KS_OFF + buf * 16384 + kr * 128 + ((ch ^ sw) << 4)) = kl;
                *(LAS u32x4*)(lds + KS_OFF + buf * 16384 + kr * 128 + (((ch + 2) ^ sw) << 4)) = kh;
            }
            asm volatile("s_waitcnt vmcnt(0)" ::: "memory");
            __syncthreads();
            const int nxt = rem ? __builtin_ctz(rem) : -1; rem &= rem - 1u;
            if (nxt >= 0) { kl = ld16g(MX_KSRC(nxt)); kh = ld16g(MX_KSRC(nxt) + 16); MX_VSTAGE(nxt, buf ^ 1); }
            if (!have_q) {
#pragma unroll
                for (int qf = 0; qf < 2; ++qf)
#pragma unroll
                    for (int ks = 0; ks < 2; ++ks) { const int r = hh * 128 + qb + 16 * qf + fr; Qf[qf][ks] = *(const LAS bf16x8*)(lds + QS_OFF + r * 128 + (((4 * ks + g) ^ ((r >> 1) & 7)) << 4)); }
                have_q = true;
            }
            const int kso = KS_OFF + buf * 16384, vso = VS_OFF + buf * 16384;
            f32x4 S[8][2];
#pragma unroll
            for (int kf = 0; kf < 8; ++kf) { S[kf][0] = (f32x4){0.f, 0.f, 0.f, 0.f}; S[kf][1] = (f32x4){0.f, 0.f, 0.f, 0.f}; }
#pragma unroll
            for (int kf = 0; kf < 8; ++kf)
#pragma unroll
                for (int ks = 0; ks < 2; ++ks) { const int r = 16 * kf + fr;
                    const bf16x8 kfr = *(const LAS bf16x8*)(lds + kso + r * 128 + (((4 * ks + g) ^ ((r >> 1) & 7)) << 4));
                    S[kf][0] = __builtin_amdgcn_mfma_f32_16x16x32_bf16(kfr, Qf[0][ks], S[kf][0], 0, 0, 0);
                    S[kf][1] = __builtin_amdgcn_mfma_f32_16x16x32_bf16(kfr, Qf[1][ks], S[kf][1], 0, 0, 0); }
            bf16x8 Pp[4][2];
#pragma unroll
            for (int qf = 0; qf < 2; ++qf) {
                const int qi = qb + 16 * qf + fr;
                if (band && jb != 0) {
#pragma unroll
                    for (int kf = 0; kf < 8; ++kf)
#pragma unroll
                        for (int r = 0; r < 4; ++r) { const int kk = 16 * kf + 4 * g + r; const bool ok = (jb < 0) ? (kk >= qi) : (kk <= qi); if (!ok) S[kf][qf][r] = -1.0e30f; }
                }
                float mx = S[0][qf][0];
#pragma unroll
                for (int kf = 0; kf < 8; ++kf)
#pragma unroll
                    for (int r = 0; r < 4; ++r) mx = fmaxf(mx, S[kf][qf][r]);
                mx = fmaxf(mx, __shfl_xor(mx, 16)); mx = fmaxf(mx, __shfl_xor(mx, 32));
                const float mn = fmaxf(m[qf], mx), corr = __builtin_amdgcn_exp2f(m[qf] - mn);
                m[qf] = mn;
                float ps = 0.f;
#pragma unroll
                for (int kf = 0; kf < 8; ++kf)
#pragma unroll
                    for (int r = 0; r < 4; ++r) { const float p = __builtin_amdgcn_exp2f(S[kf][qf][r] - mn); S[kf][qf][r] = p; ps += p; }
                lsum[qf] = lsum[qf] * corr + ps;
#pragma unroll
                for (int df = 0; df < 4; ++df) O[df][qf] *= corr;
#pragma unroll
                for (int t = 0; t < 4; ++t) { u32x4 pw; pw.x = pack2(S[2 * t][qf][0], S[2 * t][qf][1]); pw.y = pack2(S[2 * t][qf][2], S[2 * t][qf][3]);
                    pw.z = pack2(S[2 * t + 1][qf][0], S[2 * t + 1][qf][1]); pw.w = pack2(S[2 * t + 1][qf][2], S[2 * t + 1][qf][3]); Pp[t][qf] = __builtin_bit_cast(bf16x8, pw); }
            }
#pragma unroll
            for (int t = 0; t < 4; ++t)
#pragma unroll
                for (int df = 0; df < 4; ++df) { const int d = 16 * df + fr;
                    const u32x2 v0 = *(const LAS u32x2*)(lds + vso + d * 256 + (((4 * t + (g >> 1)) ^ (d & 15)) << 4) + (g & 1) * 8);
                    const u32x2 v1 = *(const LAS u32x2*)(lds + vso + d * 256 + (((4 * t + 2 + (g >> 1)) ^ (d & 15)) << 4) + (g & 1) * 8);
                    u32x4 vw; vw.x = v0.x; vw.y = v0.y; vw.z = v1.x; vw.w = v1.y; const bf16x8 vf = __builtin_bit_cast(bf16x8, vw);
                    O[df][0] = __builtin_amdgcn_mfma_f32_16x16x32_bf16(vf, Pp[t][0], O[df][0], 0, 0, 0);
                    O[df][1] = __builtin_amdgcn_mfma_f32_16x16x32_bf16(vf, Pp[t][1], O[df][1], 0, 0, 0); }
            if (nxt < 0) break;
            cur = nxt; buf ^= 1;
        }
#pragma unroll
        for (int qf = 0; qf < 2; ++qf) {
            float lt = lsum[qf]; lt += __shfl_xor(lt, 16); lt += __shfl_xor(lt, 32);
            const float inv = 1.0f / lt;
            bf16_t* dst = CAT + (size_t)(row0 + qb + 16 * qf + fr) * D + 256 + h * 64 + 4 * g;
#pragma unroll
            for (int df = 0; df < 4; ++df) { u32x2 o; o.x = pack2(O[df][qf][0] * inv, O[df][qf][1] * inv); o.y = pack2(O[df][qf][2] * inv, O[df][qf][3] * inv); *(u32x2*)(dst + 16 * df) = o; }
        }
    }
#undef MX_KSRC
#undef MX_VSTAGE
    __syncthreads();
}

constexpr int FF_DA = 0, FF_DC = 32768, FF_XT = 49152  , FF_Z2 = 81920  , FF_OB = 114688  ;
__device__ __forceinline__ int ff_addr(int row, int k) { return row * 256 + ((((k >> 3) ^ (row & 15))) << 4) + (k & 7) * 2; }
__device__ __forceinline__ float cos_turns(float x) { return __builtin_amdgcn_cosf(x); }
__device__ __forceinline__ float sin_turns(float x) { return __builtin_amdgcn_sinf(x); }
__device__ __forceinline__ void fft_setup(LAS unsigned char* lds) {
    const int tid = tid_opaque();
    __syncthreads();
    for (int idx = tid; idx < 16384; idx += NT) { const int i = idx >> 7, k = idx & 127, ro = i >> 6, k1 = i & 63, part = k >> 6, n1 = k & 63; const float t = (float)((k1 * n1) & 63) * (1.0f / 64.0f);
        const float c = cos_turns(t), sn = sin_turns(t);
        const float v = (ro == 0) ? (part == 0 ? c : sn) : (part == 0 ? -sn : c);
        *(LAS bf16_t*)(lds + FF_DA + ff_addr(i, k)) = f2bf(v * 0.125f); }
    for (int idx = tid; idx < 8192; idx += NT) { const int k2 = idx >> 7, k = idx & 127, ri = k >> 6, n2 = k & 63; const float t = (float)((k2 * n2) & 63) * (1.0f / 64.0f);
        const float v = (ri == 0) ? cos_turns(t) : sin_turns(t);
        *(LAS bf16_t*)(lds + FF_DC + ff_addr(k2, k)) = f2bf(v * 0.125f); }
    __syncthreads();
}
__device__ __forceinline__ void fft_unit(AP a, LAS unsigned char* lds, int b, int cg) {
    const int tid = tid_opaque(), lane = tid & 63, w = __builtin_amdgcn_readfirstlane(tid >> 6), fr = lane & 15, g = lane >> 4;
    const int mf = w & 3, nh = w >> 2;
    const bf16_t* AT = (const bf16_t*)(a->ws + WS_AT) + (size_t)(b * 256 + cg * 4) * 8192;
    u32x4 xin[2][2];
#pragma unroll
    for (int h = 0; h < 2; ++h)
#pragma unroll
        for (int it = 0; it < 2; ++it) xin[h][it] = ld16g(AT + (size_t)h * 8192 + (size_t)(tid + 512 * it) * 8);
#pragma unroll 1
    for (int cp = 0; cp < 2; ++cp) {
#pragma unroll
        for (int h = 0; h < 2; ++h)
#pragma unroll
            for (int it = 0; it < 2; ++it) { const int q = tid + 512 * it, part = q >> 9, pos0 = (q & 511) * 8, n1 = pos0 >> 6, n2 = pos0 & 63, k = part * 64 + n1;
                const unsigned wv[4] = {xin[h][it].x, xin[h][it].y, xin[h][it].z, xin[h][it].w};
#pragma unroll
                for (int e = 0; e < 4; ++e) { *(LAS bf16_t*)(lds + FF_XT + h * 16384 + ff_addr(n2 + 2 * e, k)) = (bf16_t)(wv[e] & 0xffffu); *(LAS bf16_t*)(lds + FF_XT + h * 16384 + ff_addr(n2 + 2 * e + 1, k)) = (bf16_t)(wv[e] >> 16); } }
        if (cp == 0) {
#pragma unroll
            for (int h = 0; h < 2; ++h)
#pragma unroll
                for (int it = 0; it < 2; ++it) xin[h][it] = ld16g(AT + (size_t)(2 + h) * 8192 + (size_t)(tid + 512 * it) * 8); }
        __syncthreads();
        f32x4 acc[2][2][2];
#pragma unroll
        for (int h = 0; h < 2; ++h)
#pragma unroll
            for (int x = 0; x < 2; ++x) { acc[h][x][0] = (f32x4){0.f, 0.f, 0.f, 0.f}; acc[h][x][1] = (f32x4){0.f, 0.f, 0.f, 0.f}; }
#pragma unroll
        for (int ks = 0; ks < 4; ++ks) {
            bf16x8 af[2];
#pragma unroll
            for (int x = 0; x < 2; ++x) { const int i = 16 * (mf + 4 * x) + fr; af[x] = *(const LAS bf16x8*)(lds + FF_DA + i * 256 + (((4 * ks + g) ^ (i & 15)) << 4)); }
#pragma unroll
            for (int h = 0; h < 2; ++h)
#pragma unroll
                for (int n = 0; n < 2; ++n) { const int j = 16 * (2 * nh + n) + fr; const bf16x8 bfv = *(const LAS bf16x8*)(lds + FF_XT + h * 16384 + j * 256 + (((4 * ks + g) ^ (j & 15)) << 4));
                    acc[h][0][n] = __builtin_amdgcn_mfma_f32_16x16x32_bf16(af[0], bfv, acc[h][0][n], 0, 0, 0);
                    acc[h][1][n] = __builtin_amdgcn_mfma_f32_16x16x32_bf16(af[1], bfv, acc[h][1][n], 0, 0, 0); }
        }
#pragma unroll
        for (int n = 0; n < 2; ++n)
#pragma unroll
            for (int r = 0; r < 4; ++r) { const int k1 = 16 * mf + 4 * g + r, n2 = 16 * (2 * nh + n) + fr; const float t = (float)((k1 * n2) & 4095) * (1.0f / 4096.0f);
                const float c = cos_turns(t), sn = sin_turns(t);
#pragma unroll
                for (int h = 0; h < 2; ++h) { const float zr = acc[h][0][n][r], zi = acc[h][1][n][r];
                    *(LAS bf16_t*)(lds + FF_Z2 + h * 16384 + ff_addr(k1, n2)) = f2bf(zr * c + zi * sn);
                    *(LAS bf16_t*)(lds + FF_Z2 + h * 16384 + ff_addr(k1, 64 + n2)) = f2bf(zi * c - zr * sn); } }
        __syncthreads();
        f32x4 acc2[2][2];
#pragma unroll
        for (int h = 0; h < 2; ++h) { acc2[h][0] = (f32x4){0.f, 0.f, 0.f, 0.f}; acc2[h][1] = (f32x4){0.f, 0.f, 0.f, 0.f}; }
#pragma unroll
        for (int ks = 0; ks < 4; ++ks) {
            const int i = 16 * mf + fr; const bf16x8 af = *(const LAS bf16x8*)(lds + FF_DC + i * 256 + (((4 * ks + g) ^ (i & 15)) << 4));
#pragma unroll
            for (int h = 0; h < 2; ++h)
#pragma unroll
                for (int n = 0; n < 2; ++n) { const int j = 16 * (2 * nh + n) + fr; const bf16x8 bfv = *(const LAS bf16x8*)(lds + FF_Z2 + h * 16384 + j * 256 + (((4 * ks + g) ^ (j & 15)) << 4));
                    acc2[h][n] = __builtin_amdgcn_mfma_f32_16x16x32_bf16(af, bfv, acc2[h][n], 0, 0, 0); }
        }
#pragma unroll
        for (int n = 0; n < 2; ++n)
#pragma unroll
            for (int r = 0; r < 4; ++r) { const int k = 16 * (2 * nh + n) + fr + 64 * (16 * mf + 4 * g + r);
                *(LAS unsigned*)(lds + FF_OB + k * 8 + cp * 4) = pack2(acc2[0][n][r], acc2[1][n][r]); }
    }
    __syncthreads();
    bf16_t* CAT = (bf16_t*)(a->ws + WS_CAT) + (size_t)(b * 4096) * D + cg * 4;
#pragma unroll
    for (int it = 0; it < 8; ++it) { const int k = tid + 512 * it; *(u32x2*)(CAT + (size_t)k * D) = *(const LAS u32x2*)(lds + FF_OB + k * 8); }
    __syncthreads();
}

__device__ __forceinline__ void p2_mix(AP a, unsigned char* ldsg, LAS unsigned char* lds, int l) {
    const int n_tile = 128 + ((l == 0) ? 8 : 0), n_att = 2 * n_tile, n_dft = 256, n_dftc = (l == 0) ? 16 : 0;
    bf16_t* CAT = (bf16_t*)(a->ws + WS_CAT);
    bool fft_ready = false;
    for (int u = blockIdx.x; u < n_att + n_dft + n_tile + n_dftc; u += gridDim.x) {
        if (u < n_att || (u >= n_att + n_dft && u < n_att + n_dft + n_tile)) {
            const bool att = u < n_att;
            const int t = att ? (u >> 1) : (u - n_att - n_dft);
            const bool isc = t >= 128; const int tt = t - 128;
            const int b = isc ? (tt >> 1) : (t >> 5);
            const int row0 = isc ? NLAT + tt * 128 : t * 128, seq_row0 = isc ? NLAT + b * 256 : b * 4096, pos0 = isc ? (tt & 1) * 128 : (t & 31) * 128, n = isc ? 256 : 4096;
            if (att) { for (int rep = 0; rep < PROBE_MIX_REP; ++rep) mixer_attn(a, lds, l, row0, seq_row0, pos0, n, b, isc, u & 1); }
            else { for (int rep = 0; rep < PROBE_SGU_REP; ++rep) mixer_sgu_pool(a, lds, l, row0, seq_row0, pos0, n); }
            fft_ready = false;
        } else if (u < n_att + n_dft) {
            const int uu = u - n_att;
            if (!fft_ready) { fft_setup(lds); fft_ready = true; }
            for (int rep = 0; rep < PROBE_FFT_REP; ++rep) fft_unit(a, lds, uu >> 6, uu & 63);
        } else {
            const int uu = u - n_att - n_dft - n_tile, b = uu >> 2, mt = (uu >> 1) & 1, ch0 = (uu & 1) * 128;
            const bf16_t* A = (const bf16_t*)(a->ws + WS_DFTC) + (size_t)(mt * 128) * 512;
            const bf16_t* B0 = (const bf16_t*)(a->ws + WS_ATC) + ((size_t)b * 256 + ch0) * 512;
            EpiBf16 E; E.C = CAT + (size_t)(NLAT + b * 256 + mt * 128) * D + ch0; E.ld = D;
            gemm_tile<128, false, EpiBf16>(lds, A, 512, nullptr, 128, B0, B0 + (size_t)64 * 512, 512, 512, E);
            fft_ready = false;
        }
    }
    exp_queue(a, ldsg, l);
}

__device__ __forceinline__ int uni(int v) { return __builtin_amdgcn_readfirstlane(v); }
__device__ __forceinline__ int vblock() { const int G = gridDim.x, b = blockIdx.x; return (G % 8 == 0) ? (b % 8) * (G / 8) + b / 8 : b; }
template <class T> __device__ __forceinline__ T* unip(T* p) { const unsigned long long v = (unsigned long long)p; const unsigned lo = __builtin_amdgcn_readfirstlane((unsigned)v), hi = __builtin_amdgcn_readfirstlane((unsigned)(v >> 32)); return (T*)(((unsigned long long)hi << 32) | lo); }
struct SchedInProj {
    typedef EpiInProj Epi; static constexpr bool GATHER = false;
    unsigned char* ws; int l, G, me;
    __device__ __forceinline__ bool get(int i, g256::Unit<Epi>& u) const {
        const int n_lat = 64 * 7, n_ctx = (l == 0) ? 4 * 7 : 4;
        const int idx = i * G + me; if (idx >= n_lat + n_ctx) return false;
        int row0, b, ct, n; bf16_t *tF, *tV;
        if (idx < n_lat) { const int rt = idx / 7; ct = idx % 7; row0 = rt * 256; b = row0 >> 12; n = 4096;
            tF = (bf16_t*)(ws + WS_AT) + (size_t)b * 256 * 2 * 4096; tV = (bf16_t*)(ws + WS_VT) + (size_t)b * 128 * 4096; }
        else { const int uu = idx - n_lat; int rt; if (l == 0) { rt = uu / 7; ct = uu % 7; } else { rt = uu; ct = 3; }
            row0 = NLAT + rt * 256; b = rt; n = 256;
            tF = (bf16_t*)(ws + WS_ATC) + (size_t)b * 256 * 2 * 256; tV = (bf16_t*)(ws + WS_VTC) + (size_t)b * 128 * 256; }
        u.A = (const bf16_t*)(ws + WS_H) + (size_t)row0 * D;
        u.B0 = (const bf16_t*)(ws + WS_WIN) + ((size_t)l * ZC + ct * 256) * 1024; u.B1 = u.B0 + (size_t)128 * 1024; u.ridx = nullptr; u.valid = 256;
        u.epi.Zt = (bf16_t*)(ws + WS_Z) + (size_t)row0 * ZC + ct * 256; u.epi.tF = tF; u.epi.tV = tV; u.epi.n0 = ct * 256; u.epi.pos0 = (idx < n_lat) ? (row0 & 4095) : 0; u.epi.n = n;
        return true;
    }
};
struct SchedOutProj {
    typedef EpiBf16 Epi; static constexpr bool GATHER = false;
    unsigned char* ws; int l, G, me;
    __device__ __forceinline__ bool get(int i, g256::Unit<Epi>& u) const {
        const int nrt = NLAT / 256;
        const int idx = i * G + me; if (idx >= nrt * 4) return false;
        const int rt = idx >> 2, ct = idx & 3;
        u.A = (const bf16_t*)(ws + WS_CAT) + (size_t)(rt * 256) * D;
        u.B0 = (const bf16_t*)(ws + WS_WOUT) + ((size_t)l * 1024 + ct * 256) * 1024; u.B1 = u.B0 + (size_t)128 * 1024; u.ridx = nullptr; u.valid = 256;
        u.epi.C = (bf16_t*)(ws + WS_Y) + (size_t)(rt * 256) * D + ct * 256; u.epi.ld = D;
        return true;
    }
};
struct SchedGateUp {
    typedef EpiGateUp Epi; static constexpr bool GATHER = true;
    unsigned char* ws; const LAS int* blk; const LAS int* tot; const LAS int* ridx_lds; int G, me, l;
    __device__ __forceinline__ bool get(int i, g256::Unit<Epi>& u) const {
        const int idx = i * G + me; if (idx >= uni(blk[32]) * 4) return false;
        const int rb = idx >> 2, ct = idx & 3;
        int e = 0;
#pragma unroll 1
        for (int q = 1; q < 32; ++q) if (uni(blk[q]) <= rb) e = q;
        u.A = (const bf16_t*)(ws + WS_H);
        u.B0 = (const bf16_t*)(ws + WS_WEXP + (size_t)l * WEXP_LAYER) + ((size_t)e * 512 + ct * 128) * 1024; u.B1 = u.B0 + EXPMAT;
        u.ridx = ridx_lds + (i & 7) * 256; u.valid = uni(min(256, tot[e] - (rb - blk[e]) * 256));
        u.epi.C = (bf16_t*)(ws + WS_HID) + (size_t)(rb * 256) * DEXP + ct * 128; u.epi.ld = DEXP;
        return true;
    }
};
struct SchedDown {
    typedef EpiBf16 Epi; static constexpr bool GATHER = false;
    unsigned char* ws; const LAS int* blk; int G, me, l;
    __device__ __forceinline__ bool get(int i, g256::Unit<Epi>& u) const {
        const int idx = i * G + me; if (idx >= uni(blk[32]) * 4) return false;
        const int rb = idx >> 2, ct = idx & 3;
        int e = 0;
#pragma unroll 1
        for (int q = 1; q < 32; ++q) if (uni(blk[q]) <= rb) e = q;
        u.A = (const bf16_t*)(ws + WS_HID) + (size_t)(rb * 256) * DEXP;
        u.B0 = (const bf16_t*)(ws + WS_WEXP + (size_t)l * WEXP_LAYER) + 2 * EXPMAT + ((size_t)e * 1024 + ct * 256) * 512; u.B1 = u.B0 + (size_t)128 * 512; u.ridx = nullptr; u.valid = 256;
        u.epi.C = (bf16_t*)(ws + WS_YS) + (size_t)(rb * 256) * D + ct * 256; u.epi.ld = D;
        return true;
    }
};

__device__ __forceinline__ void p4_ln1_router(AP a, unsigned char* lds, int l) {
    const int tid = tid_opaque(), lane = tid & 63, w = tid >> 6;
    const int ntok = (l == 0) ? NTOK : NLAT;
    int* cnt = (int*)(lds + MISC_OFF);
    if (tid < 32) cnt[tid] = 0;
    f32x4* Lg = (f32x4*)lds; f32x4* Le = (f32x4*)(lds + 16384); f32x4* Lgb = (f32x4*)(lds + 147456);
    {
        const float* wrg_ = a->in[16] + (size_t)l * 1024 * 4; const float* wre_ = a->in[17] + (size_t)l * 1024 * 32;
#pragma unroll
        for (int it = 0; it < 2; ++it) { const int c = tid + 512 * it, slot = (((c >> 8) * 4 + (c & 3)) << 6) + ((c >> 2) & 63);
            Lg[slot] = *(const f32x4*)(wrg_ + (size_t)c * 4);
#pragma unroll
            for (int q = 0; q < 8; ++q) Le[q * 1024 + slot] = *(const f32x4*)(wre_ + (size_t)c * 32 + q * 4); }
        Lgb[tid] = (tid < 256) ? *(const f32x4*)(a->in[14] + l * 1024 + tid * 4) : *(const f32x4*)(a->in[15] + l * 1024 + (tid - 256) * 4);
    }
    __syncthreads();
    const float* mod = (const float*)(a->ws + WS_MOD) + (size_t)l * 5 * 6144;
    const bf16_t* Y = (const bf16_t*)(a->ws + WS_Y);
    float* X1 = (float*)(a->ws + WS_X1);
    bf16_t* H = (bf16_t*)(a->ws + WS_H);
    int* tokE = (int*)(a->ws + WS_TOKE); int* tokR = (int*)(a->ws + WS_TOKR); float* tokG = (float*)(a->ws + WS_TOKG);
    const int tstep = gridDim.x * 8;
    f32x4 nx[4]; u32x2 ny[4];
    {   const int t = blockIdx.x * 8 + w;
        if (t < ntok) { const float* xs = (l == 0) ? ((t < NLAT) ? a->in[0] + (size_t)t * D : a->in[2] + (size_t)(t - NLAT) * D) : (const float*)(a->ws + WS_XC) + (size_t)t * D;
#pragma unroll
            for (int i = 0; i < 4; ++i) { nx[i] = *(const f32x4*)(xs + 256 * i + 4 * lane); ny[i] = *(const u32x2*)(Y + (size_t)t * D + 256 * i + 4 * lane); } } }
    int mrow = -1; f32x4 mg[4], msh[4], msc[4];
    for (int t = blockIdx.x * 8 + w; t < ntok; t += tstep) {
        const int mr = (t < NLAT) ? (t >> 12) : 4;
        if (mr != mrow) { mrow = mr; const float* m = mod + (size_t)mr * 6144;
#pragma unroll
            for (int i = 0; i < 4; ++i) { const int c = 256 * i + 4 * lane; mg[i] = *(const f32x4*)(m + 2048 + c); msh[i] = *(const f32x4*)(m + 3072 + c); msc[i] = *(const f32x4*)(m + 4096 + c); } }
        f32x4 v[4];
#pragma unroll
        for (int i = 0; i < 4; ++i) { const f32x4 yv = (f32x4){lo2f(ny[i].x), hi2f(ny[i].x), lo2f(ny[i].y), hi2f(ny[i].y)};
#pragma unroll
            for (int e = 0; e < 4; ++e) v[i][e] = RES_ALPHA * nx[i][e] + mg[i][e] * yv[e]; }
        {   const int tn = t + tstep;
            if (tn < ntok) { const float* xs = (l == 0) ? ((tn < NLAT) ? a->in[0] + (size_t)tn * D : a->in[2] + (size_t)(tn - NLAT) * D) : (const float*)(a->ws + WS_XC) + (size_t)tn * D;
#pragma unroll
                for (int i = 0; i < 4; ++i) { nx[i] = *(const f32x4*)(xs + 256 * i + 4 * lane); ny[i] = *(const u32x2*)(Y + (size_t)tn * D + 256 * i + 4 * lane); } } }
        float mean, rstd; ln_stats(v, mean, rstd);
#pragma unroll
        for (int i = 0; i < 4; ++i) { const int c = 256 * i + 4 * lane; const f32x4 gg = Lgb[64 * i + lane], bb = Lgb[256 + 64 * i + lane];
#pragma unroll
            for (int e = 0; e < 4; ++e) v[i][e] = (v[i][e] - mean) * rstd * gg[e] + bb[e];
            *(f32x4*)(X1 + (size_t)t * D + c) = v[i]; }
        ln_stats(v, mean, rstd);
#pragma unroll
        for (int i = 0; i < 4; ++i) { const int c = 256 * i + 4 * lane; const f32x4 sh = msh[i], sc = msc[i];
#pragma unroll
            for (int e = 0; e < 4; ++e) v[i][e] = (v[i][e] - mean) * rstd * (1.0f + sc[e]) + sh[e];
            u32x2 pk; pk.x = pack2(v[i][0], v[i][1]); pk.y = pack2(v[i][2], v[i][3]); *(u32x2*)(H + (size_t)t * D + c) = pk; }
        f32x2 lg01 = (f32x2){0.f, 0.f}, lg23 = (f32x2){0.f, 0.f};
#pragma unroll
        for (int i = 0; i < 4; ++i)
#pragma unroll
            for (int e = 0; e < 4; ++e) { const f32x4 wv = Lg[((i * 4 + e) << 6) + lane]; const f32x2 vv = (f32x2){v[i][e], v[i][e]};
                lg01 += vv * (f32x2){wv[0], wv[1]}; lg23 += vv * (f32x2){wv[2], wv[3]}; }
        float lg[4] = {wave_sum(lg01[0]), wave_sum(lg01[1]), wave_sum(lg23[0]), wave_sum(lg23[1])};
        int grp = 0; float mx = lg[0];
#pragma unroll
        for (int q = 1; q < 4; ++q) if (lg[q] > mx) { mx = lg[q]; grp = q; }
        float se = 0.f;
#pragma unroll
        for (int q = 0; q < 4; ++q) se += expf(lg[q] - mx);
        const float gate_group = 1.0f / se;
        f32x2 le01 = (f32x2){0.f, 0.f}, le23 = (f32x2){0.f, 0.f}, le45 = (f32x2){0.f, 0.f}, le67 = (f32x2){0.f, 0.f};
#pragma unroll
        for (int i = 0; i < 4; ++i)
#pragma unroll
            for (int e = 0; e < 4; ++e) { const f32x4* wp = Le + grp * 2048 + ((i * 4 + e) << 6) + lane; const f32x4 w0 = wp[0], w1 = wp[1024]; const f32x2 vv = (f32x2){v[i][e], v[i][e]};
                le01 += vv * (f32x2){w0[0], w0[1]}; le23 += vv * (f32x2){w0[2], w0[3]}; le45 += vv * (f32x2){w1[0], w1[1]}; le67 += vv * (f32x2){w1[2], w1[3]}; }
        float le[8] = {wave_sum(le01[0]), wave_sum(le01[1]), wave_sum(le23[0]), wave_sum(le23[1]), wave_sum(le45[0]), wave_sum(le45[1]), wave_sum(le67[0]), wave_sum(le67[1])};
        int j1 = 0; float l1 = le[0];
#pragma unroll
        for (int q = 1; q < 8; ++q) if (le[q] > l1) { l1 = le[q]; j1 = q; }
        int j2 = -1; float l2 = -3.0e38f;
#pragma unroll
        for (int q = 0; q < 8; ++q) if (q != j1 && le[q] > l2) { l2 = le[q]; j2 = q; }
        const float e2 = expf(l2 - l1), p1 = 1.0f / (1.0f + e2), p2 = e2 / (1.0f + e2);
        if (lane == 0) {
            const int ex0 = grp * 8 + j1, ex1 = grp * 8 + j2;
            const int r0 = atomicAdd(&cnt[ex0], 1), r1 = atomicAdd(&cnt[ex1], 1);
            tokE[2 * t] = ex0; tokE[2 * t + 1] = ex1; tokR[2 * t] = r0; tokR[2 * t + 1] = r1;
            tokG[2 * t] = gate_group * p1; tokG[2 * t + 1] = gate_group * p2;
        }
    }
    __syncthreads();
    if (tid < 32) ((int*)(a->ws + WS_BCNT))[((size_t)l * MAXG + blockIdx.x) * 32 + tid] = cnt[tid];
    __syncthreads();
}

__device__ __forceinline__ void p5_dispatch(AP a, unsigned char* lds, int l) {
    const int tid = tid_opaque();
    const int ntok = (l == 0) ? NTOK : NLAT;
    int* part = (int*)lds;
    int* tot = (int*)(lds + 4096);
    int* off = (int*)(lds + 4096 + 128);
    int* pstart = (int*)(lds + 4096 + 256);
    const int* bc = (const int*)(a->ws + WS_BCNT) + (size_t)l * MAXG * 32;
    const int G = gridDim.x, me = blockIdx.x;
    { const int e = tid & 31, p = tid >> 5; int s = 0, so = 0; for (int bb = p; bb < G; bb += 16) { const int c = bc[bb * 32 + e]; s += c; if (bb < me) so += c; } part[p * 32 + e] = s; part[512 + p * 32 + e] = so; }
    __syncthreads();
    if (tid < 32) { int s = 0, so = 0; for (int p = 0; p < 16; ++p) { s += part[p * 32 + tid]; so += part[512 + p * 32 + tid]; } tot[tid] = s; off[tid] = so; }
    __syncthreads();
    if (tid == 0) { int acc = 0; for (int e = 0; e < 32; ++e) { pstart[e] = acc; acc += ((tot[e] + 255) >> 8) << 8; } }
    __syncthreads();
    if (me == 0 && tid < 32) ((int*)(a->ws + WS_CNT))[l * 32 + tid] = tot[tid];
    const int* tokE = (const int*)(a->ws + WS_TOKE); const int* tokR = (const int*)(a->ws + WS_TOKR);
    int* tokS = (int*)(a->ws + WS_TOKS); int* slotT = (int*)(a->ws + WS_SLOTT);
    for (int q = tid; ; q += NT) { const int it = q >> 4, j = q & 15, t = (it * G + me) * 8 + (j >> 1); if (t >= ntok) break;
        const int idx = 2 * t + (j & 1); const int e = tokE[idx]; const int slot = pstart[e] + off[e] + tokR[idx]; tokS[idx] = slot; slotT[slot] = t; }
    __syncthreads();
}

__device__ __forceinline__ void moe_table(AP a, int l, LAS int* blk) {
    const int* tot = (const int*)(a->ws + WS_CNT) + l * 32;
    if (threadIdx.x == 0) { int acc = 0; for (int e = 0; e < 32; ++e) { const int c = tot[e]; blk[e] = acc; blk[33 + e] = c; acc += (c + 255) >> 8; } blk[32] = acc; }
    __syncthreads();
}
__device__ __forceinline__ int units_of(int nu, int v, int G) { return (v < nu) ? (nu - v + G - 1) / G : 0; }
__device__ __forceinline__ void p1_inproj(AP a, unsigned char* smem, LAS unsigned char* lds, int l) {
    SchedInProj S; S.ws = a->ws; S.l = l; S.G = gridDim.x; S.me = vblock();
    g256::gemm_phase(lds, 1024, S);
    if (l == 0) { const int nu = 64 * 7 + 4 * 7, G = gridDim.x; if (units_of(nu, S.me, G) < (nu + G - 1) / G) exp_fill(a, smem, 0, 8); }
}
__device__ __forceinline__ void p3_outproj(AP a, unsigned char* smem, LAS unsigned char* lds, int l) {
    SchedOutProj S; S.ws = a->ws; S.l = l; S.G = gridDim.x; S.me = vblock();
    g256::gemm_phase(lds, 1024, S);
    if (l == 0) {
        const bf16_t* W = (const bf16_t*)(a->ws + WS_WOUT);
        for (int u = blockIdx.x; u < 64; u += gridDim.x) { const int rt = u >> 3, ct = u & 7;
            EpiBf16 E; E.C = (bf16_t*)(a->ws + WS_Y) + (size_t)(NLAT + rt * 128) * D + ct * 128; E.ld = D;
            const bf16_t* B0 = W + (size_t)(ct * 128) * 1024;
            gemm_tile<128, false, EpiBf16>(lds, (const bf16_t*)(a->ws + WS_CAT) + (size_t)(NLAT + rt * 128) * D, D, nullptr, 128, B0, B0 + (size_t)64 * 1024, 1024, 1024, E); }
        if (blockIdx.x >= 64) exp_fill(a, smem, 0, 3);
    }
}
__device__ __forceinline__ void p6_gateup(AP a, unsigned char* smem, LAS unsigned char* lds, int l) {
    LAS int* blk = (LAS int*)(lds + MISC_OFF + 256);
    moe_table(a, l, blk);
    LAS int* ridx = (LAS int*)(lds + RIDX_OFF);
    const int tid = tid_opaque(), G = gridDim.x, me = vblock(), nu = blk[32] * 4;
    const int* slotT = (const int*)(a->ws + WS_SLOTT);
    for (int i = 0; i < 8; ++i) { const int idx = i * G + me; if (idx >= nu) break;
        const int rb = idx >> 2; int e = 0; for (int q = 1; q < 32; ++q) if (blk[q] <= rb) e = q;
        const int valid = min(256, blk[33 + e] - (rb - blk[e]) * 256);
        if (tid < 256) ridx[i * 256 + tid] = (tid < valid) ? slotT[rb * 256 + tid] : 0; }
    __syncthreads();
    SchedGateUp S; S.ws = a->ws; S.blk = blk; S.tot = blk + 33; S.ridx_lds = ridx; S.G = G; S.me = me; S.l = l;
    g256::gemm_phase(lds, 1024, S);
    __syncthreads();
    if (l == 0 && units_of(nu, me, G) < (nu + G - 1) / G) exp_fill(a, smem, 1, 8);
}
__device__ __forceinline__ void p7_down(AP a, unsigned char* smem, LAS unsigned char* lds, int l) {
    LAS int* blk = (LAS int*)(lds + MISC_OFF + 256);
    moe_table(a, l, blk);
    SchedDown S; S.ws = a->ws; S.blk = blk; S.G = gridDim.x; S.me = vblock(); S.l = l;
    g256::gemm_phase(lds, 512, S);
    __syncthreads();
    { const int nu = uni(blk[32]) * 4, G = gridDim.x; if (l == 0 && units_of(nu, S.me, G) < (nu + G - 1) / G) exp_fill(a, smem, 1, 5); }
}

__device__ __forceinline__ void p8_ln2(AP a, unsigned char* lds, int l) {
    const int tid = tid_opaque(), lane = tid & 63, w = tid >> 6;
    const int ntok = (l == 0) ? NTOK : NLAT;
    const float* mod = (const float*)(a->ws + WS_MOD) + (size_t)l * 5 * 6144;
    const float* modn = (const float*)(a->ws + WS_MOD) + (size_t)5 * 6144;
    const float* X1 = (const float*)(a->ws + WS_X1);
    const bf16_t* YS = (const bf16_t*)(a->ws + WS_YS);
    const int* tokS = (const int*)(a->ws + WS_TOKS); const float* tokG = (const float*)(a->ws + WS_TOKG);
    f32x4* Lgb = (f32x4*)lds;
    __syncthreads();
    Lgb[tid] = (tid < 256) ? *(const f32x4*)(a->in[21] + l * 1024 + tid * 4) : *(const f32x4*)(a->in[22] + l * 1024 + (tid - 256) * 4);
    __syncthreads();
    int mrow = -1; f32x4 mg[4], nsh[4], nsc[4];
    const int tstep = gridDim.x * 8;
    int t = blockIdx.x * 8 + w;
    int ns0 = 0, ns1 = 0; float nga = 0.f, ngb = 0.f;
    f32x4 nx[4]; u32x2 nya[4], nyb[4];
    float cga = 0.f, cgb = 0.f;
    if (t < ntok) { const int s0 = tokS[2 * t], s1 = tokS[2 * t + 1]; cga = tokG[2 * t]; cgb = tokG[2 * t + 1];
#pragma unroll
        for (int i = 0; i < 4; ++i) { const int c = 256 * i + 4 * lane; nx[i] = *(const f32x4*)(X1 + (size_t)t * D + c); nya[i] = *(const u32x2*)(YS + (size_t)s0 * D + c); nyb[i] = *(const u32x2*)(YS + (size_t)s1 * D + c); } }
    if (t + tstep < ntok) { ns0 = tokS[2 * (t + tstep)]; ns1 = tokS[2 * (t + tstep) + 1]; nga = tokG[2 * (t + tstep)]; ngb = tokG[2 * (t + tstep) + 1]; }
    for (; t < ntok; t += tstep) {
        const int mr = (t < NLAT) ? (t >> 12) : 4;
        if (mr != mrow) { mrow = mr; const float* m = mod + (size_t)mr * 6144; const float* mn = modn + (size_t)mr * 6144;
#pragma unroll
            for (int i = 0; i < 4; ++i) { const int c = 256 * i + 4 * lane; mg[i] = *(const f32x4*)(m + 5120 + c); if (l == 0) { nsh[i] = *(const f32x4*)(mn + c); nsc[i] = *(const f32x4*)(mn + 1024 + c); } } }
        f32x4 v[4];
#pragma unroll
        for (int i = 0; i < 4; ++i) { const f32x4 gv = mg[i];
            const u32x2 ya = nya[i], yb = nyb[i];
            const float f0 = cga * lo2f(ya.x) + cgb * lo2f(yb.x), f1 = cga * hi2f(ya.x) + cgb * hi2f(yb.x), f2 = cga * lo2f(ya.y) + cgb * lo2f(yb.y), f3 = cga * hi2f(ya.y) + cgb * hi2f(yb.y);
            v[i][0] = RES_ALPHA * nx[i][0] + gv[0] * f0; v[i][1] = RES_ALPHA * nx[i][1] + gv[1] * f1; v[i][2] = RES_ALPHA * nx[i][2] + gv[2] * f2; v[i][3] = RES_ALPHA * nx[i][3] + gv[3] * f3; }
        {   const int tn = t + tstep, tn2 = t + 2 * tstep;
            if (tn < ntok) {
#pragma unroll
                for (int i = 0; i < 4; ++i) { const int c = 256 * i + 4 * lane; nx[i] = *(const f32x4*)(X1 + (size_t)tn * D + c); nya[i] = *(const u32x2*)(YS + (size_t)ns0 * D + c); nyb[i] = *(const u32x2*)(YS + (size_t)ns1 * D + c); }
                cga = nga; cgb = ngb; }
            if (tn2 < ntok) { ns0 = tokS[2 * tn2]; ns1 = tokS[2 * tn2 + 1]; nga = tokG[2 * tn2]; ngb = tokG[2 * tn2 + 1]; } }
        float mean, rstd; ln_stats(v, mean, rstd);
        float* dst = (l == 0) ? (float*)(a->ws + WS_XC) + (size_t)t * D : a->out + (size_t)t * D;
#pragma unroll
        for (int i = 0; i < 4; ++i) { const int c = 256 * i + 4 * lane; const f32x4 gg = Lgb[64 * i + lane], bb = Lgb[256 + 64 * i + lane];
#pragma unroll
            for (int e = 0; e < 4; ++e) v[i][e] = (v[i][e] - mean) * rstd * gg[e] + bb[e];
            *(f32x4*)(dst + c) = v[i]; }
        if (l == 0) {
            ln_stats(v, mean, rstd);
            bf16_t* H = (bf16_t*)(a->ws + WS_H);
#pragma unroll
            for (int i = 0; i < 4; ++i) { const int c = 256 * i + 4 * lane; const f32x4 sh = nsh[i], sc = nsc[i];
                f32x4 o;
#pragma unroll
                for (int e = 0; e < 4; ++e) o[e] = (v[i][e] - mean) * rstd * (1.0f + sc[e]) + sh[e];
                u32x2 pk; pk.x = pack2(o[0], o[1]); pk.y = pack2(o[2], o[3]); *(u32x2*)(H + (size_t)t * D + c) = pk; }
        }
    }
}

constexpr int N_PHASES = 18;
template <int P> __device__ __forceinline__ void run_phase(AP a, unsigned char* smem, LAS unsigned char* lds, int l) {
    asm volatile("" : "+s"(a));
    if (P == 0) p0_prologue(a, smem);
    if (P == 1) p_lnmod0(a);
    if (P == 2) p1_inproj(a, smem, lds, l);
    if (P == 3) p2_mix(a, smem, lds, l);
    if (P == 4) p3_outproj(a, smem, lds, l);
    if (P == 5) p4_ln1_router(a, smem, l);
    if (P == 6) p5_dispatch(a, smem, l);
    if (P == 7) p6_gateup(a, smem, lds, l);
    if (P == 8) p7_down(a, smem, lds, l);
    if (P == 9) p8_ln2(a, smem, l);
}
#if N_LAUNCH_MODE == 1
__global__ void __launch_bounds__(NT, 2) fwd(Args a) {
    extern __shared__ __attribute__((aligned(16))) unsigned char smem[];
    LAS unsigned char* lds = (LAS unsigned char*)smem;
    if (threadIdx.x < 4) ((volatile LAS unsigned*)(lds + MISC_OFF + 768))[threadIdx.x] = 0u;
    __syncthreads();
    XcdBarrier bar = xcd_barrier_post((unsigned*)(a.ws + WS_BAR), (volatile LAS unsigned*)(lds + MISC_OFF + 768));
    AP ap = (AP)__builtin_amdgcn_kernarg_segment_ptr();
#define PROBE(P, l) do { if (PROBE_MASK & (1 << (P))) { for (int _r = 0; _r < 2; ++_r) { xcd_barrier(bar); run_phase<P>(ap, smem, lds, l); } } } while (0)
    run_phase<0>(ap, smem, lds, 0); PROBE(0, 0); xcd_barrier(bar);
    run_phase<1>(ap, smem, lds, 0); PROBE(1, 0); xcd_barrier(bar);
    for (int l = 0; l < 2; ++l) {
        run_phase<2>(ap, smem, lds, l); PROBE(2, l); xcd_barrier(bar);
        run_phase<3>(ap, smem, lds, l); PROBE(3, l); xcd_barrier(bar);
        run_phase<4>(ap, smem, lds, l); PROBE(4, l); xcd_barrier(bar);
        run_phase<5>(ap, smem, lds, l); PROBE(5, l); xcd_barrier(bar);
        run_phase<6>(ap, smem, lds, l); PROBE(6, l); xcd_barrier(bar);
        run_phase<7>(ap, smem, lds, l); PROBE(7, l); xcd_barrier(bar);
        run_phase<8>(ap, smem, lds, l); PROBE(8, l); xcd_barrier(bar);
        run_phase<9>(ap, smem, lds, l); PROBE(9, l); if (l == 0) xcd_barrier(bar);
    }
}
#else
template <int P> __global__ void __launch_bounds__(NT, 2) k_phase(Args a) {
    extern __shared__ __attribute__((aligned(16))) unsigned char smem[];
    LAS unsigned char* lds = (LAS unsigned char*)smem;
    AP ap = (AP)__builtin_amdgcn_kernarg_segment_ptr();
    run_phase<P>(ap, smem, lds, ap->ph_lo);
}
template <int P> static void launch_phase(Args a, int l, int grid, hipStream_t stream) {
    static bool attr = false;
    if (!attr) { (void)hipFuncSetAttribute((const void*)k_phase<P>, hipFuncAttributeMaxDynamicSharedMemorySize, LDS_BYTES); attr = true; }
    a.ph_lo = l; a.ph_hi = P;
    hipLaunchKernelGGL(k_phase<P>, dim3(grid), dim3(NT), LDS_BYTES, stream, a);
}
#endif

extern "C" void kernel_launch(void* const* d_in, const int* in_sizes, int n_in, void* d_out, int out_size, void* d_ws, size_t ws_size, hipStream_t stream) {
    static int grid = 0;
    if (grid == 0) {
        if (n_in != 23 || out_size != NLAT * D || ws_size < WS_END) { fprintf(stderr, "kernel_launch: unexpected shapes (n_in %d, out %d, ws %zu, need %zu)\n", n_in, out_size, ws_size, (size_t)WS_END); grid = -1; return; }
        int dev = 0, cus = 0;
        if (hipGetDevice(&dev) != hipSuccess || hipDeviceGetAttribute(&cus, hipDeviceAttributeMultiprocessorCount, dev) != hipSuccess) { grid = -1; return; }
#if N_LAUNCH_MODE == 1
        int per_cu = 0;
        if (hipFuncSetAttribute((const void*)fwd, hipFuncAttributeMaxDynamicSharedMemorySize, LDS_BYTES) != hipSuccess) { fprintf(stderr, "kernel_launch: hipFuncSetAttribute failed\n"); grid = -1; return; }
        if (hipOccupancyMaxActiveBlocksPerMultiprocessor(&per_cu, (const void*)fwd, NT, LDS_BYTES) != hipSuccess || per_cu < 1) { fprintf(stderr, "kernel_launch: occupancy query says %d\n", per_cu); }
        (void)hipGetLastError();
#endif
        grid = cus; if (grid > MAXG) grid = MAXG;
    }
    if (grid < 0) return;
    (void)hipMemsetAsync((char*)d_ws + WS_BAR, 0, 16384 + 256, stream);
    Args a{};
    for (int i = 0; i < 23; ++i) a.in[i] = (const float*)d_in[i];
    a.out = (float*)d_out; a.ws = (unsigned char*)d_ws;
#if N_LAUNCH_MODE == 1
    a.ph_lo = 0; a.ph_hi = N_PHASES;
    hipLaunchKernelGGL(fwd, dim3(grid), dim3(NT), LDS_BYTES, stream, a);
#else
    launch_phase<0>(a, 0, grid, stream);
    launch_phase<1>(a, 0, grid, stream);
    for (int l = 0; l < 2; ++l) {
        launch_phase<2>(a, l, grid, stream); launch_phase<3>(a, l, grid, stream); launch_phase<4>(a, l, grid, stream); launch_phase<5>(a, l, grid, stream);
        launch_phase<6>(a, l, grid, stream); launch_phase<7>(a, l, grid, stream); launch_phase<8>(a, l, grid, stream); launch_phase<9>(a, l, grid, stream);
    }
#endif
}
```

```cpp
#include <hip/hip_runtime.h>
#include <stdint.h>
#include <stdio.h>

#ifndef PROBE_MASK
#define PROBE_MASK 0
#endif
#ifndef PROBE_FFT_REP
#define PROBE_FFT_REP 1
#endif
#ifndef PROBE_MIX_REP
#define PROBE_MIX_REP 1
#endif
#ifndef PROBE_SGU_REP
#define PROBE_SGU_REP 1
#endif
#ifndef N_LAUNCH_MODE
#define N_LAUNCH_MODE 1
#endif

#define LAS __attribute__((address_space(3)))
typedef unsigned short bf16_t;
typedef short bf16x8 __attribute__((ext_vector_type(8)));
typedef float f32x4 __attribute__((ext_vector_type(4)));
typedef unsigned u32x4 __attribute__((ext_vector_type(4)));
typedef unsigned u32x2 __attribute__((ext_vector_type(2)));
typedef float f32x2 __attribute__((ext_vector_type(2)));

constexpr int D = 1024, NBATCH = 4, SEQ = 4096, CTXL = 256;
constexpr int NLAT = NBATCH * SEQ, NCTX = NBATCH * CTXL, NTOK = NLAT + NCTX;
constexpr int ZC = 1792;
constexpr int NEXP = 32, DEXP = 512;
constexpr int NSLOT = 2 * NTOK + NEXP * 256;
constexpr int NT = 512;
constexpr int MAXG = 512;
constexpr float RES_ALPHA = 1.41421356237309515f;
constexpr int MISC_OFF = 155648;
constexpr int RIDX_OFF = 131072;
constexpr int LDS_BYTES = MISC_OFF + 1024;

constexpr size_t WS_BAR   = 0;
constexpr size_t WS_CNT   = 16384;
constexpr size_t WS_BCNT  = WS_CNT + 256;
constexpr size_t WS_MOD   = WS_BCNT + (size_t)2 * MAXG * 32 * 4;
constexpr size_t WS_ROPE  = WS_MOD + (size_t)2 * 5 * 6144 * 4;
constexpr size_t WS_TOKE  = WS_ROPE + 8192;
constexpr size_t WS_TOKR  = WS_TOKE + (size_t)NTOK * 8;
constexpr size_t WS_TOKS  = WS_TOKR + (size_t)NTOK * 8;
constexpr size_t WS_TOKG  = WS_TOKS + (size_t)NTOK * 8;
constexpr size_t WS_SLOTT = WS_TOKG + (size_t)NTOK * 8;
constexpr size_t WS_WIN   = WS_SLOTT + (size_t)NSLOT * 4;
constexpr size_t WS_WOUT  = WS_WIN + (size_t)2 * ZC * 1024 * 2;
constexpr size_t WS_WSGU  = WS_WOUT + (size_t)2 * 1024 * 1024 * 2;
constexpr size_t WS_DFTC  = WS_WSGU + (size_t)2 * 4 * 128 * 128 * 2;
constexpr size_t WS_WEXP  = WS_DFTC + (size_t)256 * 512 * 2;
constexpr size_t EXPMAT   = (size_t)NEXP * 512 * 1024;
constexpr size_t WEXP_LAYER = 3 * EXPMAT * 2;
constexpr size_t WS_X1    = WS_WEXP + 2 * WEXP_LAYER;
constexpr size_t WS_XC    = WS_X1 + (size_t)NTOK * D * 4;
constexpr size_t WS_H     = WS_XC + (size_t)NTOK * D * 4;
constexpr size_t WS_R     = WS_H + (size_t)NTOK * D * 2;
constexpr size_t WS_Z     = WS_R;
constexpr size_t WS_AT    = WS_Z + (size_t)NTOK * ZC * 2;
constexpr size_t WS_ATC   = WS_AT + (size_t)4 * 256 * 8192 * 2;
constexpr size_t WS_VT    = WS_ATC + (size_t)4 * 256 * 512 * 2;
constexpr size_t WS_VTC   = WS_VT + (size_t)4 * 2 * 64 * 4096 * 2;
constexpr size_t WS_CAT   = WS_VTC + (size_t)4 * 2 * 64 * 256 * 2;
constexpr size_t WS_REND  = WS_CAT + (size_t)NTOK * D * 2;
constexpr size_t WS_Y     = WS_R;
constexpr size_t WS_HID   = WS_R;
constexpr size_t WS_YS    = WS_HID + (size_t)NSLOT * DEXP * 2;
constexpr size_t WS_END   = (WS_YS + (size_t)NSLOT * D * 2 > WS_REND) ? WS_YS + (size_t)NSLOT * D * 2 : WS_REND;
static_assert(WS_Y + (size_t)NTOK * D * 4 <= WS_CAT, "Y must not reach CAT");
static_assert(WS_WIN % 256 == 0 && WS_DFTC % 256 == 0 && WS_WEXP % 256 == 0 && WS_X1 % 256 == 0 && WS_H % 256 == 0 && WS_R % 256 == 0 && WS_AT % 256 == 0 && WS_CAT % 256 == 0 && WS_YS % 256 == 0, "alignment");

struct Args { const float* in[23]; float* out; unsigned char* ws; int ph_lo, ph_hi; };
#define CAS __attribute__((address_space(4)))
typedef const CAS Args* AP;

#define XB_TMO      128
#define XB_XCNT(j)  (256  + 64 * (j))
#define XB_XSUB(j)  (1280 + 64 * (j))
#define XB_XGEN(j)  (2304 + 64 * (j))
#define XB_TOP      3328
#define XB_TOPGEN   3392
#define XCD_BAR_WORDS 3456
#define XB_SPIN_CAP (1u << 18)

__device__ __forceinline__ unsigned xb_ld(unsigned* p)              { return __hip_atomic_load(p, __ATOMIC_RELAXED, __HIP_MEMORY_SCOPE_AGENT); }
__device__ __forceinline__ unsigned xb_add(unsigned* p, unsigned v) { return __hip_atomic_fetch_add(p, v, __ATOMIC_RELAXED, __HIP_MEMORY_SCOPE_AGENT); }
__device__ __forceinline__ unsigned xb_xcc_id() { return (unsigned)__builtin_amdgcn_s_getreg((3 << 11) | 20) & 0xFu; }
#define XB_SPIN(cond, bar) do { unsigned _sp = 0; while (cond) { __builtin_amdgcn_s_sleep(1); \
    if ((++_sp & 255u) == 0u) { if (xb_ld(&(bar)[XB_TMO])) break; if (_sp > XB_SPIN_CAP) { atomicAdd(&(bar)[XB_TMO], 1u); break; } } } } while (0)

struct XcdBarrier { unsigned* bar; unsigned x; volatile LAS unsigned* st; };

__device__ __forceinline__ XcdBarrier xcd_barrier_post(unsigned* bar, volatile LAS unsigned* st) {
    XcdBarrier b; b.bar = bar; b.x = (unsigned)__builtin_amdgcn_readfirstlane((int)xb_xcc_id()); b.st = st;
    if (threadIdx.x == 0) (void)xb_add(&bar[XB_XCNT(b.x)], 1u);
    return b;
}
__device__ __forceinline__ void xcd_barrier_complete(unsigned* bar, unsigned x, unsigned& nloc, unsigned& nx) {
    const unsigned G = gridDim.x * gridDim.y * gridDim.z;
    unsigned sum, cnt, mine, sp = 0u;
    for (;;) {
        sum = 0u; cnt = 0u; mine = 0u;
#pragma unroll
        for (unsigned j = 0; j < 16; ++j) { const unsigned c = xb_ld(&bar[XB_XCNT(j)]); sum += c; cnt += (c > 0u) ? 1u : 0u; mine = (j == x) ? c : mine; }
        if (sum == G) break;
        __builtin_amdgcn_s_sleep(1);
        if ((++sp & 255u) == 0u) { if (xb_ld(&bar[XB_TMO])) break; if (sp > XB_SPIN_CAP) { atomicAdd(&bar[XB_TMO], 1u); break; } }
    }
    nloc = mine > 0u ? mine : 1u; nx = cnt > 0u ? cnt : 1u;
}
__device__ __forceinline__ void xcd_barrier(const XcdBarrier& b) {
    asm volatile("s_waitcnt vmcnt(0)" ::: "memory");
    __syncthreads();
    if (threadIdx.x == 0) {
        unsigned* bar = b.bar;
        unsigned bx = b.x;
        asm volatile("" : "+s"(bar), "+s"(bx));
        __builtin_amdgcn_s_waitcnt(0);
        unsigned nloc = b.st[0], nx = b.st[1];
        if (nloc == 0u) { xcd_barrier_complete(bar, bx, nloc, nx); b.st[0] = nloc; b.st[1] = nx; }
        const unsigned old = xb_add(&bar[XB_XSUB(bx)], 1u);
        const unsigned gen = old / nloc;
        if (old + 1u == (gen + 1u) * nloc) {
            __builtin_amdgcn_fence(__ATOMIC_RELEASE, "agent");
            asm volatile("s_waitcnt vmcnt(0)" ::: "memory");
            const unsigned og = xb_add(&bar[XB_TOP], 1u);
            const unsigned tg = og / nx;
            if (og + 1u == (tg + 1u) * nx) xb_add(&bar[XB_TOPGEN], 1u);
            else XB_SPIN(xb_ld(&bar[XB_TOPGEN]) == tg, bar);
            __builtin_amdgcn_fence(__ATOMIC_ACQUIRE, "agent");
            xb_add(&bar[XB_XGEN(bx)], 1u);
            asm volatile("s_waitcnt vmcnt(0)" ::: "memory");
        } else {
            XB_SPIN(xb_ld(&bar[XB_XGEN(bx)]) == gen, bar);
            __builtin_amdgcn_fence(__ATOMIC_ACQUIRE, "agent");
            asm volatile("s_waitcnt vmcnt(0)" ::: "memory");
        }
    }
    __syncthreads();
}

__device__ __forceinline__ int tid_opaque() { int t = threadIdx.x; asm volatile("" : "+v"(t)); return t; }
__device__ __forceinline__ float bf2f(bf16_t v) { return __uint_as_float(((unsigned)v) << 16); }
__device__ __forceinline__ bf16_t f2bf(float f) { return __builtin_bit_cast(unsigned short, (__bf16)f); }
typedef __bf16 hwbf16x2 __attribute__((ext_vector_type(2)));
__device__ __forceinline__ unsigned pack2(float a, float b) { return __builtin_bit_cast(unsigned, __builtin_convertvector((f32x2){a, b}, hwbf16x2)); }
__device__ __forceinline__ float lo2f(unsigned w) { return __uint_as_float(w << 16); }
__device__ __forceinline__ float hi2f(unsigned w) { return __uint_as_float(w & 0xffff0000u); }
template <int CTRL> __device__ __forceinline__ float dpp_mov(float v) { return __builtin_bit_cast(float, __builtin_amdgcn_update_dpp(0, __builtin_bit_cast(int, v), CTRL, 0xf, 0xf, true)); }
__device__ __forceinline__ float row_sum16(float v) {
    v += dpp_mov<0xB1>(v);
    v += dpp_mov<0x4E>(v);
    v += dpp_mov<0x141>(v);
    v += dpp_mov<0x140>(v);
    return v;
}
__device__ __forceinline__ float row_max16(float v) {
    v = fmaxf(v, dpp_mov<0xB1>(v)); v = fmaxf(v, dpp_mov<0x4E>(v)); v = fmaxf(v, dpp_mov<0x141>(v)); v = fmaxf(v, dpp_mov<0x140>(v));
    return v;
}
__device__ __forceinline__ float wave_sum(float v) {
    v = row_sum16(v);
    const int iv = __builtin_bit_cast(int, v);
    const float a0 = __builtin_bit_cast(float, __builtin_amdgcn_readlane(iv, 0)), a1 = __builtin_bit_cast(float, __builtin_amdgcn_readlane(iv, 16));
    const float a2 = __builtin_bit_cast(float, __builtin_amdgcn_readlane(iv, 32)), a3 = __builtin_bit_cast(float, __builtin_amdgcn_readlane(iv, 48));
    return (a0 + a1) + (a2 + a3);
}
__device__ __forceinline__ float gelu_erf(float v) {
    const float t = __builtin_amdgcn_rcpf(fabsf(v) * 0.2316418882f + 1.0f);
    float q = t * 0.5307027145f + (-0.7265760135f); q = q * t + 0.7107068705f; q = q * t + (-0.142248368f); q = q * t + 0.127414796f; q = q * t;
    const float m = v * (q * __builtin_amdgcn_exp2f((v * v) * (-0.72134752044f)));
    return v < 0.f ? m : v - m;
}
__device__ __forceinline__ float silu_f(float x) { return x / (1.0f + __expf(-x)); }

__device__ __forceinline__ void ln_stats(const f32x4 (&v)[4], float& mean, float& rstd) {
    float s = 0.f;
#pragma unroll
    for (int i = 0; i < 4; ++i) s += (v[i][0] + v[i][1]) + (v[i][2] + v[i][3]);
    s = wave_sum(s); mean = s * (1.0f / 1024.0f);
    float q = 0.f;
#pragma unroll
    for (int i = 0; i < 4; ++i)
#pragma unroll
        for (int e = 0; e < 4; ++e) { const float d = v[i][e] - mean; q += d * d; }
    q = wave_sum(q); rstd = 1.0f / sqrtf(q * (1.0f / 1024.0f) + 1e-6f);
}

template <int BN> struct MfmaLayout {
    static constexpr int FG = BN / 128, NI = 4, NJ = 2 * FG;
    static constexpr bool PAIR8 = false;
    int rbase, cbase;
    __device__ __forceinline__ int row(int i) const { return rbase + 16 * i; }
    __device__ __forceinline__ int col(int jj) const { return (jj / FG) * (BN / 2) + (jj % FG) * 16 + cbase; }
};

__device__ __forceinline__ void glds16(const bf16_t* g, LAS unsigned char* l) {
    __builtin_amdgcn_global_load_lds((const unsigned*)g, (LAS unsigned*)l, 16, 0, 0);
}

template <int BN, bool GATHER, class Epi>
__device__ __forceinline__ void gemm_tile(LAS unsigned char* lds, const bf16_t* A, int lda, const int* rowidx, int valid_rows,
                                          const bf16_t* B0, const bf16_t* B1, int ldb, int K, const Epi& epi) {
    constexpr int A_B = 16384, B_B = BN * 128, STAGE = A_B + B_B, NBL = BN / 64;
    const int tid = tid_opaque(), lane = tid & 63, wid = __builtin_amdgcn_readfirstlane(tid >> 6);
    const bf16_t* ap[2]; const bf16_t* bp[NBL];
#pragma unroll
    for (int i = 0; i < 2; ++i) {
        const int P = i * 512 + tid, row = P >> 3, c = (P & 7) ^ ((row >> 1) & 7);
        size_t ro;
        if (GATHER) ro = (size_t)(row < valid_rows ? rowidx[row] : 0) * (size_t)lda; else ro = (size_t)row * (size_t)lda;
        ap[i] = A + ro + c * 8;
    }
#pragma unroll
    for (int i = 0; i < NBL; ++i) {
        const int P = i * 512 + tid, row = P >> 3, c = (P & 7) ^ ((row >> 1) & 7);
        const bf16_t* base = (row < BN / 2) ? (B0 + (size_t)row * ldb) : (B1 + (size_t)(row - BN / 2) * ldb);
        bp[i] = base + c * 8;
    }
    const int nk = K / 64;
#define GT_STAGE(buf, k0) do { \
        _Pragma("unroll") for (int _i = 0; _i < 2; ++_i) glds16(ap[_i] + (k0), lds + (buf) * STAGE + _i * 8192 + wid * 1024); \
        _Pragma("unroll") for (int _i = 0; _i < NBL; ++_i) glds16(bp[_i] + (k0), lds + (buf) * STAGE + A_B + _i * 8192 + wid * 1024); } while (0)

    typedef MfmaLayout<BN> Lay;
    constexpr int FG = Lay::FG;
    const int fr = lane & 15, g = lane >> 4, wr = wid >> 2, wc = wid & 3;
    Lay lay; lay.rbase = wr * 64 + fr; lay.cbase = wc * 16 * FG + 4 * g;
    f32x4 acc[Lay::NI][Lay::NJ];
#pragma unroll
    for (int i = 0; i < Lay::NI; ++i)
#pragma unroll
        for (int j = 0; j < Lay::NJ; ++j) acc[i][j] = (f32x4){0.f, 0.f, 0.f, 0.f};
    int aoff[4], boff[Lay::NJ];
#pragma unroll
    for (int m = 0; m < 4; ++m) { const int row = wr * 64 + m * 16 + fr; aoff[m] = row * 128 + ((g ^ ((row >> 1) & 7)) << 4); }
#pragma unroll
    for (int jj = 0; jj < Lay::NJ; ++jj) { const int row = (jj / FG) * (BN / 2) + wc * 16 * FG + (jj % FG) * 16 + fr; boff[jj] = A_B + row * 128 + ((g ^ ((row >> 1) & 7)) << 4); }
    GT_STAGE(0, 0);
    asm volatile("s_waitcnt vmcnt(0)" ::: "memory"); __syncthreads();
    for (int kt = 0; kt < nk; ++kt) {
        if (kt + 1 < nk) GT_STAGE((kt + 1) & 1, (kt + 1) * 64);
        const LAS unsigned char* sa = lds + (kt & 1) * STAGE;
#pragma unroll
        for (int ks = 0; ks < 2; ++ks) {
            bf16x8 af[4], bfv[Lay::NJ];
#pragma unroll
            for (int m = 0; m < 4; ++m) af[m] = *(const LAS bf16x8*)(sa + (aoff[m] ^ (ks << 6)));
#pragma unroll
            for (int jj = 0; jj < Lay::NJ; ++jj) bfv[jj] = *(const LAS bf16x8*)(sa + (boff[jj] ^ (ks << 6)));
#pragma unroll
            for (int m = 0; m < 4; ++m)
#pragma unroll
                for (int jj = 0; jj < Lay::NJ; ++jj) acc[m][jj] = __builtin_amdgcn_mfma_f32_16x16x32_bf16(bfv[jj], af[m], acc[m][jj], 0, 0, 0);
        }
        asm volatile("s_waitcnt vmcnt(0)" ::: "memory"); __syncthreads();
    }
    epi.run(acc, lay);
#undef GT_STAGE
}

namespace g256 {
constexpr int BK = 64, HALF = 128, HTB = HALF * BK * 2, STAGE_BYTES = 8 * HTB;
__device__ __forceinline__ int lds_byte(int r, int c) { const int st = (r >> 4) * 2 + (c >> 5), rr = r & 15, cc = c & 31, ob = rr * 64 + cc * 2; return st * 1024 + (ob ^ (((ob >> 9) & 1) << 5)); }
__device__ __forceinline__ int perm32(int rho) { const int n = rho >> 4, i = rho & 15; return 8 * (i >> 2) + 4 * n + (i & 3); }
__device__ __forceinline__ void stage_rc(int b, int& R, int& C) { const int st = b / 1024, sb = b % 1024, swz = sb ^ (((sb >> 9) & 1) << 5); R = (st >> 1) * 16 + swz / 64; C = (st & 1) * 32 + (swz % 64) / 2; }
struct Lay {
    static constexpr int NI = 8, NJ = 4;
    static constexpr bool PAIR8 = true;
    int rbase, cbase;
    __device__ __forceinline__ int row(int i) const { return (i >> 2) * 128 + (i & 3) * 16 + rbase; }
    __device__ __forceinline__ int col(int j) const { return (j >> 1) * 128 + (j & 1) * 4 + cbase; }
};
template <class Epi> struct Unit { const bf16_t* A; const bf16_t* B0; const bf16_t* B1; const LAS int* ridx; int valid; Epi epi; };

template <class Sched>
__device__ __forceinline__ void gemm_phase(LAS unsigned char* lds, const int K, const Sched& S) {
    typedef typename Sched::Epi Epi;
    const int tid = tid_opaque(), wid = __builtin_amdgcn_readfirstlane(tid >> 6), lane = tid & 63, wr = wid >> 2, wc = wid & 3, fr = lane & 15, fq = lane >> 4;
    int nt = K / BK; asm volatile("" : "+s"(nt));
    int sR[2], sC[2];
#pragma unroll
    for (int i = 0; i < 2; ++i) stage_rc(tid * 16 + i * 8192, sR[i], sC[i]);
    unsigned voffB[2];
#pragma unroll
    for (int i = 0; i < 2; ++i) voffB[i] = (unsigned)(((sR[i] & ~31) + perm32(sR[i] & 31)) * K + sC[i]) * 2u;
    const size_t kstep = (size_t)(BK * 2);
    const unsigned ldsw = (unsigned)wid * 1024u;
    const int aoff = lds_byte(wr * 64 + fr, fq * 8), boff = lds_byte(wc * 32 + fr, fq * 8);
#define G2_SA(b, h) (((b) * 2 + (h)) * HTB)
#define G2_SB(b, h) ((4 + (b) * 2 + (h)) * HTB)
#define G2_STAGE(bufoff, gbase, v0, v1) do { \
        __builtin_amdgcn_global_load_lds((const unsigned*)((const char*)(gbase) + (v0)), (LAS unsigned*)(lds + (bufoff) + ldsw), 16, 0, 0); \
        __builtin_amdgcn_global_load_lds((const unsigned*)((const char*)(gbase) + (v1)), (LAS unsigned*)(lds + (bufoff) + ldsw + 8192), 16, 0, 0); } while (0)
#define G2_LDA(dst, b, h) do { _Pragma("unroll") for (int m = 0; m < 4; ++m) _Pragma("unroll") for (int k = 0; k < 2; ++k) dst[m][k] = *(const LAS bf16x8*)(lds + G2_SA(b, h) + aoff + m * 2048 + k * 1024); } while (0)
#define G2_LDB(dst, b, h) do { _Pragma("unroll") for (int n = 0; n < 2; ++n) _Pragma("unroll") for (int k = 0; k < 2; ++k) dst[n][k] = *(const LAS bf16x8*)(lds + G2_SB(b, h) + boff + n * 2048 + k * 1024); } while (0)
#define G2_MMA(ai, bj, At, Bt) do { __builtin_amdgcn_s_setprio(1); _Pragma("unroll") for (int m = 0; m < 4; ++m) _Pragma("unroll") for (int n = 0; n < 2; ++n) _Pragma("unroll") for (int k = 0; k < 2; ++k) \
        acc[(ai) * 4 + m][(bj) * 2 + n] = __builtin_amdgcn_mfma_f32_16x16x32_bf16(Bt[n][k], At[m][k], acc[(ai) * 4 + m][(bj) * 2 + n], 0, 0, 0); __builtin_amdgcn_s_setprio(0); } while (0)
#define G2_WAIT_V(n) asm volatile("s_waitcnt vmcnt(" #n ")" ::: "memory")
#define G2_WAIT_L(n) asm volatile("s_waitcnt lgkmcnt(" #n ")" ::: "memory")
#define G2_BAR __builtin_amdgcn_s_barrier()
#define G2_SCHED __builtin_amdgcn_sched_barrier(0)
#define G2_VOFFA(U, dst) do { _Pragma("unroll") for (int _h = 0; _h < 2; ++_h) _Pragma("unroll") for (int _i = 0; _i < 2; ++_i) { const int _row = _h * 128 + sR[_i]; \
        int _tok = _row; if (Sched::GATHER) _tok = (_row < (U).valid) ? (U).ridx[_row] : 0; dst[_h][_i] = (unsigned)(_tok * K + sC[_i]) * 2u; } } while (0)
    Unit<Epi> cur, nxt; int ui = 0;
    if (!S.get(0, cur)) return;
    f32x4 acc[8][4];
#pragma unroll
    for (int i = 0; i < 8; ++i)
#pragma unroll
        for (int j = 0; j < 4; ++j) acc[i][j] = (f32x4){0.f, 0.f, 0.f, 0.f};
    bf16x8 At[4][2], B0[2][2], B1[2][2];
    unsigned cvA[2][2], nvA[2][2];
    G2_VOFFA(cur, cvA);
    const char* cA = (const char*)cur.A; const char* cB0 = (const char*)cur.B0; const char* cB1 = (const char*)cur.B1;
    G2_STAGE(G2_SB(0, 0), cB0, voffB[0], voffB[1]); G2_STAGE(G2_SB(0, 1), cB1, voffB[0], voffB[1]); G2_STAGE(G2_SA(0, 0), cA, cvA[0][0], cvA[0][1]); G2_STAGE(G2_SA(0, 1), cA, cvA[1][0], cvA[1][1]);
    if (wr == 1) G2_BAR;
    G2_WAIT_V(2); G2_BAR;
    G2_STAGE(G2_SB(1, 0), cB0 + kstep, voffB[0], voffB[1]); G2_STAGE(G2_SA(1, 0), cA + kstep, cvA[0][0], cvA[0][1]); G2_STAGE(G2_SB(1, 1), cB1 + kstep, voffB[0], voffB[1]);
    G2_WAIT_V(6); G2_BAR;
    for (;;) {
        const bool has_next = S.get(ui + 1, nxt);
        if (Sched::GATHER) {
            if (has_next) { G2_VOFFA(nxt, nvA); }
            else {
#pragma unroll
                for (int h = 0; h < 2; ++h) { nvA[h][0] = cvA[h][0]; nvA[h][1] = cvA[h][1]; } }
        }
        const char* nA = has_next ? (const char*)nxt.A : cA; const char* nB0 = has_next ? (const char*)nxt.B0 : cB0; const char* nB1 = has_next ? (const char*)nxt.B1 : cB1;
#pragma unroll 1
        for (int t = 0; t < nt; t += 2) {
            const bool last = (t == nt - 2);
            const char* a1 = cA + (size_t)(t + 1) * kstep;
            const char* a2 = last ? nA : cA + (size_t)(t + 2) * kstep;
            const char* b20 = last ? nB0 : cB0 + (size_t)(t + 2) * kstep; const char* b21 = last ? nB1 : cB1 + (size_t)(t + 2) * kstep;
#define x00 ((Sched::GATHER && last) ? nvA[0][0] : cvA[0][0])
#define x01 ((Sched::GATHER && last) ? nvA[0][1] : cvA[0][1])
#define x10 ((Sched::GATHER && last) ? nvA[1][0] : cvA[1][0])
#define x11 ((Sched::GATHER && last) ? nvA[1][1] : cvA[1][1])
            G2_LDB(B0, 0, 0); G2_LDB(B1, 0, 1); G2_SCHED; G2_LDA(At, 0, 0); G2_STAGE(G2_SA(1, 1), a1, cvA[1][0], cvA[1][1]);
            G2_WAIT_V(8); G2_WAIT_L(0); G2_BAR; G2_MMA(0, 0, At, B0); G2_MMA(0, 1, At, B1); G2_BAR; G2_SCHED;
            G2_LDA(At, 0, 1); G2_STAGE(G2_SB(0, 0), b20, voffB[0], voffB[1]); G2_STAGE(G2_SB(0, 1), b21, voffB[0], voffB[1]); G2_STAGE(G2_SA(0, 0), a2, x00, x01);
            G2_WAIT_V(8); G2_WAIT_L(0); G2_BAR; G2_MMA(1, 0, At, B0); G2_MMA(1, 1, At, B1); G2_BAR; G2_SCHED;
            G2_LDB(B0, 1, 0); G2_LDB(B1, 1, 1); G2_SCHED; G2_LDA(At, 1, 0); G2_STAGE(G2_SA(0, 1), a2, x10, x11);
            G2_WAIT_V(8); G2_WAIT_L(0); G2_BAR; G2_MMA(0, 0, At, B0); G2_MMA(0, 1, At, B1); G2_BAR; G2_SCHED;
            G2_LDA(At, 1, 1); G2_STAGE(G2_SB(1, 0), b20 + kstep, voffB[0], voffB[1]); G2_STAGE(G2_SB(1, 1), b21 + kstep, voffB[0], voffB[1]); G2_STAGE(G2_SA(1, 0), a2 + kstep, x00, x01);
            G2_WAIT_V(8); G2_WAIT_L(0); G2_BAR; G2_MMA(1, 0, At, B0); G2_MMA(1, 1, At, B1); G2_BAR; G2_SCHED;
        }
        if (wr == 0) G2_BAR;
        { Lay lay; int rbv = wr * 64 + fr, cbv = wc * 32 + 8 * fq; asm volatile("" : "+v"(rbv), "+v"(cbv));
          lay.rbase = rbv; lay.cbase = cbv; cur.epi.run(acc, lay); }
        if (!has_next) break;
#pragma unroll
        for (int i = 0; i < 8; ++i)
#pragma unroll
            for (int j = 0; j < 4; ++j) acc[i][j] = (f32x4){0.f, 0.f, 0.f, 0.f};
        cur = nxt; cA = nA; cB0 = nB0; cB1 = nB1; ++ui;
        if (wr == 1) G2_BAR;
        if (Sched::GATHER) {
#pragma unroll
            for (int h = 0; h < 2; ++h) { cvA[h][0] = nvA[h][0]; cvA[h][1] = nvA[h][1]; } }
    }
#undef x00
#undef x01
#undef x10
#undef x11
    G2_WAIT_V(0);
    G2_BAR;
#undef G2_SA
#undef G2_SB
#undef G2_STAGE
#undef G2_LDA
#undef G2_LDB
#undef G2_MMA
#undef G2_WAIT_V
#undef G2_WAIT_L
#undef G2_BAR
#undef G2_SCHED
#undef G2_VOFFA
}
}

struct EpiF32 {
    float* C; int ld;
    template <class L> __device__ __forceinline__ void run(const f32x4 (&acc)[L::NI][L::NJ], const L& lay) const {
#pragma unroll
        for (int i = 0; i < L::NI; ++i)
#pragma unroll
            for (int j = 0; j < L::NJ; ++j) *(f32x4*)(C + (size_t)lay.row(i) * ld + lay.col(j)) = acc[i][j];
    }
};
struct EpiBf16 {
    bf16_t* C; int ld;
    template <class L> __device__ __forceinline__ void run(const f32x4 (&acc)[L::NI][L::NJ], const L& lay) const {
#pragma unroll
        for (int i = 0; i < L::NI; ++i) {
            if (L::PAIR8) {
#pragma unroll
                for (int j = 0; j < L::NJ; j += 2) { u32x4 w; w.x = pack2(acc[i][j][0], acc[i][j][1]); w.y = pack2(acc[i][j][2], acc[i][j][3]); w.z = pack2(acc[i][j + 1][0], acc[i][j + 1][1]); w.w = pack2(acc[i][j + 1][2], acc[i][j + 1][3]);
                    *(u32x4*)(C + (size_t)lay.row(i) * ld + lay.col(j)) = w; }
            } else {
#pragma unroll
                for (int j = 0; j < L::NJ; ++j) { u32x2 w; w.x = pack2(acc[i][j][0], acc[i][j][1]); w.y = pack2(acc[i][j][2], acc[i][j][3]);
                    *(u32x2*)(C + (size_t)lay.row(i) * ld + lay.col(j)) = w; }
            }
        }
    }
};
struct EpiGateUp {
    bf16_t* C; int ld;
    template <class L> __device__ __forceinline__ void run(const f32x4 (&acc)[L::NI][L::NJ], const L& lay) const {
#pragma unroll
        for (int i = 0; i < L::NI; ++i) {
            if (L::PAIR8 && L::NJ == 4) {
                const f32x4 g0 = acc[i][0], g1 = acc[i][1], u0 = acc[i][2], u1 = acc[i][3];
                u32x4 w; w.x = pack2(silu_f(g0[0]) * u0[0], silu_f(g0[1]) * u0[1]); w.y = pack2(silu_f(g0[2]) * u0[2], silu_f(g0[3]) * u0[3]);
                w.z = pack2(silu_f(g1[0]) * u1[0], silu_f(g1[1]) * u1[1]); w.w = pack2(silu_f(g1[2]) * u1[2], silu_f(g1[3]) * u1[3]);
                *(u32x4*)(C + (size_t)lay.row(i) * ld + lay.col(0)) = w;
            } else {
#pragma unroll
                for (int j = 0; j < L::NJ / 2; ++j) { const f32x4 gt = acc[i][j], up = acc[i][j + L::NJ / 2];
                    u32x2 w; w.x = pack2(silu_f(gt[0]) * up[0], silu_f(gt[1]) * up[1]); w.y = pack2(silu_f(gt[2]) * up[2], silu_f(gt[3]) * up[3]);
                    *(u32x2*)(C + (size_t)lay.row(i) * ld + lay.col(j)) = w; }
            }
        }
    }
};
struct EpiInProj {
    bf16_t* Zt;
    bf16_t* tF;
    bf16_t* tV;
    int n0, pos0, n;
    template <class L> __device__ __forceinline__ void run(const f32x4 (&acc)[L::NI][L::NJ], const L& lay) const {
        static_assert(L::PAIR8, "written for the paired-column layout");
#pragma unroll
        for (int i = 0; i < L::NI; ++i)
#pragma unroll
            for (int j = 0; j < L::NJ; j += 2) {
                const int r = lay.row(i), cl = lay.col(j), c = n0 + cl;
                const f32x4 v0 = acc[i][j], v1 = acc[i][j + 1];
                if (c < 512) {
                    const int part = c >> 8, ch = c & 255;
#pragma unroll
                    for (int e = 0; e < 4; ++e) { tF[((size_t)(ch + e) * 2 + part) * n + pos0 + r] = f2bf(v0[e]); tF[((size_t)(ch + 4 + e) * 2 + part) * n + pos0 + r] = f2bf(v1[e]); }
                } else {
                    u32x4 w; w.x = pack2(v0[0], v0[1]); w.y = pack2(v0[2], v0[3]); w.z = pack2(v1[0], v1[1]); w.w = pack2(v1[2], v1[3]);
                    *(u32x4*)(Zt + (size_t)r * ZC + cl) = w;
                    if (c >= 896 && c < 1024) {
#pragma unroll
                        for (int e = 0; e < 4; ++e) { tV[(size_t)(c - 896 + e) * n + pos0 + r] = f2bf(v0[e]); tV[(size_t)(c - 896 + 4 + e) * n + pos0 + r] = f2bf(v1[e]); }
                    }
                }
            }
    }
};

constexpr int U_ADA = 192, U_WIN = 2 * 16 * 28, U_WOUT = 2 * 16 * 16, U_SGU = 32, U_DFT = 256, U_ROPE = 1, U_EXP = 3 * 32 * 32;
constexpr int LDS_SIL = 0, LDS_RED = 20480, LDS_TILE = 32768, LDS_T64 = 49408, LDS_CTAB = 50176;

__device__ __forceinline__ void ada_unit(AP a, unsigned char* lds, int u) {
    float* sil = (float*)(lds + LDS_SIL); float* red = (float*)(lds + LDS_RED);
    const int tid = tid_opaque(), lane = tid & 63, w = tid >> 6;
    const int l = u / 96, cg = u % 96;
    for (int i = tid; i < 5120; i += NT) { const int r = i >> 10, k = i & 1023; const float v = (r < 4) ? a->in[1][r * 1024 + k] : a->in[3][k]; sil[i] = v / (1.0f + expf(-v)); }
    __syncthreads();
    const float* W = a->in[4] + (size_t)l * 1024 * 6144 + cg * 64 + lane;
    float acc[5] = {0.f, 0.f, 0.f, 0.f, 0.f};
#pragma unroll 32
    for (int k = w * 128; k < w * 128 + 128; ++k) { const float wv = W[(size_t)k * 6144];
#pragma unroll
        for (int r = 0; r < 5; ++r) acc[r] += sil[r * 1024 + k] * wv; }
#pragma unroll
    for (int r = 0; r < 5; ++r) red[(w * 5 + r) * 64 + lane] = acc[r];
    __syncthreads();
    if (tid < 320) { const int r = tid >> 6; float s = 0.f;
#pragma unroll
        for (int ww = 0; ww < 8; ++ww) s += red[(ww * 5 + r) * 64 + lane];
        const int j = cg * 64 + lane; ((float*)(a->ws + WS_MOD))[(size_t)(l * 5 + r) * 6144 + j] = s + a->in[5][l * 6144 + j]; }
    __syncthreads();
}

__device__ __forceinline__ void tile_store_T(const float* tile, bf16_t* dst, int ldd) {
    const int tid = tid_opaque(), n = tid >> 3, kc = tid & 7;
    u32x4 w;
    w.x = pack2(tile[(kc * 8 + 0) * 65 + n], tile[(kc * 8 + 1) * 65 + n]); w.y = pack2(tile[(kc * 8 + 2) * 65 + n], tile[(kc * 8 + 3) * 65 + n]);
    w.z = pack2(tile[(kc * 8 + 4) * 65 + n], tile[(kc * 8 + 5) * 65 + n]); w.w = pack2(tile[(kc * 8 + 6) * 65 + n], tile[(kc * 8 + 7) * 65 + n]);
    *(u32x4*)(dst + (size_t)n * ldd + kc * 8) = w;
}
__device__ __forceinline__ void tile_load(float* tile, const float* src, int lds_) {
    const int tid = tid_opaque();
#pragma unroll
    for (int i = 0; i < 2; ++i) { const int row = (tid >> 4) + 32 * i, c4 = (tid & 15) * 4; const f32x4 v = *(const f32x4*)(src + (size_t)row * lds_ + c4);
        tile[row * 65 + c4 + 0] = v[0]; tile[row * 65 + c4 + 1] = v[1]; tile[row * 65 + c4 + 2] = v[2]; tile[row * 65 + c4 + 3] = v[3]; }
}

__device__ __forceinline__ void mm64_f32(const float* tA, int lda, const float* tB, int ldb, int K, float* out) {
    const int tid = tid_opaque(), lane = tid & 63, w = tid >> 6, fr = lane & 15, g = lane >> 4, mi = w >> 1, nj = 2 * (w & 1);
    f32x4 acc0 = (f32x4){0.f, 0.f, 0.f, 0.f}, acc1 = (f32x4){0.f, 0.f, 0.f, 0.f};
    const float* pa = tA + (16 * mi + fr) * lda + g; const float* pb = tB + g * ldb + 16 * nj + fr;
#pragma unroll 4
    for (int k0 = 0; k0 < K; k0 += 4) { const float av = pa[k0], b0 = pb[k0 * ldb], b1 = pb[k0 * ldb + 16];
        acc0 = __builtin_amdgcn_mfma_f32_16x16x4f32(av, b0, acc0, 0, 0, 0); acc1 = __builtin_amdgcn_mfma_f32_16x16x4f32(av, b1, acc1, 0, 0, 0); }
#pragma unroll
    for (int r = 0; r < 4; ++r) { out[(16 * mi + 4 * g + r) * 65 + 16 * nj + fr] = acc0[r]; out[(16 * mi + 4 * g + r) * 65 + 16 * nj + 16 + fr] = acc1[r]; }
}

__device__ __forceinline__ void win_unit(AP a, unsigned char* lds, int u) {
    float* tile = (float*)(lds + LDS_TILE); float* T = (float*)(lds + LDS_T64);
    const int tid = tid_opaque();
    const int l = u / 448, r = u % 448, kb = r / 28, nb = r % 28;
    const float* Win = a->in[6] + (size_t)l * 1024 * 1536;
    const int srccol = (nb >= 8) ? nb * 64 - 256 : (nb & 3) * 64;
    tile_load(tile, Win + (size_t)(kb * 64) * 1536 + srccol, 1536);
    if (nb < 8 && tid < 64) { T[tid] = cospif((float)tid / 32.0f); T[64 + tid] = sinpif((float)tid / 32.0f); }
    __syncthreads();
    bf16_t* dst = (bf16_t*)(a->ws + WS_WIN) + ((size_t)l * ZC + nb * 64) * 1024 + kb * 64;
    if (nb >= 8) tile_store_T(tile, dst, 1024);
    else {
        const int part = nb >> 2;
        float* Tm = (float*)(lds + 65536); float* out = (float*)(lds + 98304);
        for (int i = tid; i < 4096; i += NT) { const int c = i >> 6, cp = i & 63; const float t = T[part * 64 + ((c * cp) & 63)]; Tm[i] = (part ? -t : t) * 0.125f; }
        __syncthreads();
        mm64_f32(tile, 65, Tm, 64, 64, out);
        __syncthreads();
        tile_store_T(out, dst, 1024);
    }
    __syncthreads();
}

__device__ __forceinline__ void wout_unit(AP a, unsigned char* lds, int u) {
    float* tile = (float*)(lds + LDS_TILE);
    __syncthreads();
    const int tid = tid_opaque();
    const int l = u / 256, r = u % 256, kb = r / 16, nb = r % 16;
    const float* Wo = a->in[13] + (size_t)l * 1024 * 1024;
    const int n = tid & 63, kq = __builtin_amdgcn_readfirstlane(tid >> 6);
    if (kb < 4) {
        float* tA = (float*)lds; float* tB = (float*)(lds + 65536);
        const float* wf = a->in[7] + (size_t)l * 256 * 256 + (size_t)(kb * 64) * 256;
        __syncthreads();
        f32x4 va[8], vb[8];
#pragma unroll
        for (int i = 0; i < 8; ++i) { const int q = tid + 512 * i; va[i] = *(const f32x4*)(wf + (size_t)q * 4); vb[i] = *(const f32x4*)(Wo + (size_t)(q >> 4) * 1024 + nb * 64 + (q & 15) * 4); }
#pragma unroll
        for (int i = 0; i < 8; ++i) { const int q = tid + 512 * i; *(f32x4*)(tA + (size_t)q * 4) = va[i]; *(f32x4*)(tB + (size_t)q * 4) = vb[i]; }
        __syncthreads();
        tile = (float*)(lds + 133120);
        mm64_f32(tA, 256, tB, 64, 256, tile);
    } else if (kb >= 8 && kb < 12) {
        const int g = kb - 8;
        float* tA = (float*)lds; float* tB = (float*)(lds + 65536);
        const float* wp = a->in[9] + (size_t)(l * 4 + g) * 64 * 64;
        const float* ps = a->in[10] + l * 256 + g * 64;
        f32x4 va[2], vb[2];
#pragma unroll
        for (int i = 0; i < 2; ++i) { const int q = tid + 512 * i; va[i] = *(const f32x4*)(wp + (size_t)q * 4); vb[i] = *(const f32x4*)(Wo + (size_t)(512 + g * 64 + (q >> 4)) * 1024 + nb * 64 + (q & 15) * 4) * ps[q >> 4]; }
#pragma unroll
        for (int i = 0; i < 2; ++i) { const int q = tid + 512 * i; *(f32x4*)(tA + (size_t)q * 4) = va[i]; *(f32x4*)(tB + (size_t)q * 4) = vb[i]; }
        __syncthreads();
        tile = (float*)(lds + 133120);
        mm64_f32(tA, 64, tB, 64, 64, tile);
    } else tile_load(tile, Wo + (size_t)(kb * 64) * 1024 + nb * 64, 1024);
    __syncthreads();
    tile_store_T(tile, (bf16_t*)(a->ws + WS_WOUT) + ((size_t)l * 1024 + nb * 64) * 1024 + kb * 64, 1024);
    __syncthreads();
}

__device__ __forceinline__ void exp_src_dst(AP a, int l, int u, const float*& src, int& srcld, bf16_t*& dst, int& dstld) {
    const int mat = u / 1024, e = (u % 1024) / 32, t = u % 32;
    const int kb = (mat < 2) ? t / 4 : t / 8, nb = (mat < 2) ? t % 4 : t % 8;
    srcld = (mat < 2) ? 512 : 1024; dstld = (mat < 2) ? 1024 : 512;
    src = a->in[18 + mat] + ((size_t)(l * 32 + e) * 512 * 1024) + (size_t)(kb * 128) * srcld + nb * 128;
    dst = (bf16_t*)(a->ws + WS_WEXP + (size_t)l * WEXP_LAYER) + (size_t)mat * EXPMAT + (size_t)e * 512 * 1024 + (size_t)(nb * 128) * dstld + kb * 128;
}
#define EXP_LOAD(vv, uu) do { exp_src_dst(a, l, (uu), src, srcld, dst, dstld); _Pragma("unroll") for (int _i = 0; _i < 8; ++_i) vv[_i] = *(const f32x4*)(src + (size_t)((tid >> 5) + 16 * _i) * srcld + (tid & 31) * 4); } while (0)
#define EXP_PUT(vv) do { _Pragma("unroll") for (int _i = 0; _i < 8; ++_i) { float* tp = tile + ((tid >> 5) + 16 * _i) * 129 + (tid & 31) * 4; tp[0] = vv[_i][0]; tp[1] = vv[_i][1]; tp[2] = vv[_i][2]; tp[3] = vv[_i][3]; } } while (0)
#define EXP_STORE(dd, ld_) do { const int n = tid >> 2, kq = tid & 3; _Pragma("unroll") for (int j = 0; j < 4; ++j) { const float* tp = tile + (kq * 32 + j * 8) * 129 + n; u32x4 w; \
        w.x = pack2(tp[0], tp[129]); w.y = pack2(tp[2 * 129], tp[3 * 129]); w.z = pack2(tp[4 * 129], tp[5 * 129]); w.w = pack2(tp[6 * 129], tp[7 * 129]); \
        *(u32x4*)((dd) + (size_t)n * (ld_) + kq * 32 + j * 8) = w; } } while (0)
__device__ __forceinline__ void exp_range(AP a, unsigned char* lds, int l, int u0, int u_end) {
    float* tile = (float*)lds;
    const int tid = tid_opaque();
    __syncthreads();
    if (u0 >= u_end) return;
    const float* src; bf16_t* dst; int srcld, dstld;
    f32x4 va[8], vb[8];
    bf16_t *da, *db = nullptr; int lda_, ldb_ = 0;
    EXP_LOAD(va, u0); da = dst; lda_ = dstld;
    if (u0 + 1 < u_end) { EXP_LOAD(vb, u0 + 1); db = dst; ldb_ = dstld; }
    for (int u = u0; u < u_end; u += 2) {
        EXP_PUT(va);
        __syncthreads();
        { bf16_t* cd = da; const int cl = lda_; if (u + 2 < u_end) { EXP_LOAD(va, u + 2); da = dst; lda_ = dstld; } EXP_STORE(cd, cl); }
        __syncthreads();
        if (u + 1 < u_end) {
            EXP_PUT(vb);
            __syncthreads();
            { bf16_t* cd = db; const int cl = ldb_; if (u + 3 < u_end) { EXP_LOAD(vb, u + 3); db = dst; ldb_ = dstld; } EXP_STORE(cd, cl); }
            __syncthreads();
        }
    }
}
#undef EXP_LOAD
#undef EXP_PUT
#undef EXP_STORE
__device__ __forceinline__ void exp_queue(AP a, unsigned char* lds, int l) {
    const int tid = tid_opaque();
    int* qslot = (int*)(lds + MISC_OFF + 128);
    unsigned* qc = (unsigned*)(a->ws + WS_BAR + 14336 + l * 256);
    for (;;) {
        __syncthreads();
        if (tid == 0) *qslot = (int)__hip_atomic_fetch_add(qc, 4u, __ATOMIC_RELAXED, __HIP_MEMORY_SCOPE_AGENT);
        __syncthreads();
        const int c0 = *qslot;
        if (c0 >= U_EXP) break;
        exp_range(a, lds, l, c0, c0 + 4);
    }
}

__device__ __forceinline__ void exp_fill(AP a, unsigned char* lds, int ql, int budget) {
    const int tid = tid_opaque();
    int* qslot = (int*)(lds + MISC_OFF + 128);
    unsigned* qc = (unsigned*)(a->ws + WS_BAR + 14336 + ql * 256);
    for (int done = 0; done < budget; done += 2) {
        __syncthreads();
        if (tid == 0) *qslot = (int)__hip_atomic_fetch_add(qc, 2u, __ATOMIC_RELAXED, __HIP_MEMORY_SCOPE_AGENT);
        __syncthreads();
        const int c0 = *qslot;
        if (c0 >= U_EXP) break;
        exp_range(a, lds, ql, c0, c0 + 2);
    }
    __syncthreads();
}

__device__ __forceinline__ void p0_prologue(AP a, unsigned char* lds) {
    const int tid = tid_opaque();
    bool have_tab = false;
    constexpr int E0 = U_ADA, E1 = E0 + U_WIN, E2 = E1 + U_WOUT, E3 = E2 + U_SGU, E4 = E3 + U_DFT, E5 = E4 + U_ROPE;
    int u = blockIdx.x;
    for (; u < E5; u += gridDim.x) {
        if (u < E0) ada_unit(a, lds, u);
        else if (u < E1) win_unit(a, lds, u - E0);
        else if (u < E2) wout_unit(a, lds, u - E1);
        else if (u < E3) { const size_t i0 = (size_t)(u - E2) * 4096 + tid * 8; const float* s = a->in[11] + i0; bf16_t* d = (bf16_t*)(a->ws + WS_WSGU) + i0;
            const f32x4 v0 = *(const f32x4*)s, v1 = *(const f32x4*)(s + 4); u32x4 w; w.x = pack2(v0[0], v0[1]); w.y = pack2(v0[2], v0[3]); w.z = pack2(v1[0], v1[1]); w.w = pack2(v1[2], v1[3]); *(u32x4*)d = w; }
        else if (u < E4) {
            float* ctab = (float*)(lds + LDS_CTAB);
            if (!have_tab) { for (int i = tid; i < 4096; i += NT) ctab[i] = cospif((float)i / 2048.0f); __syncthreads(); have_tab = true; }
            const int k = u - E3 + 4096;
            if (tid < 32) {
                const int kk = k - 4096, n0 = tid * 8; float c[8], s[8];
#pragma unroll
                for (int e = 0; e < 8; ++e) { const int idx = ((kk * (n0 + e)) & 255) * 16; c[e] = ctab[idx] * (1.0f / 16.0f); s[e] = ctab[(idx - 1024) & 4095] * (1.0f / 16.0f); }
                bf16_t* d = (bf16_t*)(a->ws + WS_DFTC) + (size_t)kk * 512 + n0;
                u32x4 w; w.x = pack2(c[0], c[1]); w.y = pack2(c[2], c[3]); w.z = pack2(c[4], c[5]); w.w = pack2(c[6], c[7]); *(u32x4*)d = w;
                w.x = pack2(s[0], s[1]); w.y = pack2(s[2], s[3]); w.z = pack2(s[4], s[5]); w.w = pack2(s[6], s[7]); *(u32x4*)(d + 256) = w;
            }
        }
        else {
            for (int i = tid; i < 1024; i += NT) { const int pos = i >> 4, f = i & 15; const float freq = powf(10000.0f, -(float)f / 16.0f); const float ang = (float)pos * freq;
                ((float2*)(a->ws + WS_ROPE))[i] = make_float2(cosf(ang), sinf(ang)); }
        }
    }
}

__device__ __forceinline__ void p_lnmod0(AP a) {
    const int tid = tid_opaque(), lane = tid & 63, w = tid >> 6;
    const float* mod = (const float*)(a->ws + WS_MOD);
    bf16_t* H = (bf16_t*)(a->ws + WS_H);
    const int tstep = gridDim.x * 8;
    f32x4 nx[4];
    { const int t = blockIdx.x * 8 + w; if (t < NTOK) { const float* src = (t < NLAT) ? a->in[0] + (size_t)t * D : a->in[2] + (size_t)(t - NLAT) * D;
#pragma unroll
        for (int i = 0; i < 4; ++i) nx[i] = *(const f32x4*)(src + 256 * i + 4 * lane); } }
    int mrow = -1; f32x4 msh[4], msc[4];
    for (int t = blockIdx.x * 8 + w; t < NTOK; t += tstep) {
        const int mr = (t < NLAT) ? (t >> 12) : 4;
        if (mr != mrow) { mrow = mr; const float* m = mod + (size_t)mr * 6144;
#pragma unroll
            for (int i = 0; i < 4; ++i) { msh[i] = *(const f32x4*)(m + 256 * i + 4 * lane); msc[i] = *(const f32x4*)(m + 1024 + 256 * i + 4 * lane); } }
        f32x4 v[4];
#pragma unroll
        for (int i = 0; i < 4; ++i) v[i] = nx[i];
        { const int tn = t + tstep; if (tn < NTOK) { const float* src = (tn < NLAT) ? a->in[0] + (size_t)tn * D : a->in[2] + (size_t)(tn - NLAT) * D;
#pragma unroll
            for (int i = 0; i < 4; ++i) nx[i] = *(const f32x4*)(src + 256 * i + 4 * lane); } }
        float mean, rstd; ln_stats(v, mean, rstd);
#pragma unroll
        for (int i = 0; i < 4; ++i) { const int c = 256 * i + 4 * lane;
            f32x4 o;
#pragma unroll
            for (int e = 0; e < 4; ++e) o[e] = (v[i][e] - mean) * rstd * (1.0f + msc[i][e]) + msh[i][e];
            u32x2 pk; pk.x = pack2(o[0], o[1]); pk.y = pack2(o[2], o[3]); *(u32x2*)(H + (size_t)t * D + c) = pk; }
    }
}

__device__ __forceinline__ void p1_inproj(AP a, unsigned char* smem, LAS unsigned char* lds, int l);
__device__ __forceinline__ u32x4 ld16g(const bf16_t* p) { return *(const u32x4*)p; }
__device__ __forceinline__ void rope_pack8(u32x4& wl, u32x4& wh, const LAS f32x2* tab, bool do_rope, float scale) {
    float tl[8] = {lo2f(wl.x), hi2f(wl.x), lo2f(wl.y), hi2f(wl.y), lo2f(wl.z), hi2f(wl.z), lo2f(wl.w), hi2f(wl.w)};
    float th[8] = {lo2f(wh.x), hi2f(wh.x), lo2f(wh.y), hi2f(wh.y), lo2f(wh.z), hi2f(wh.z), lo2f(wh.w), hi2f(wh.w)};
#pragma unroll
    for (int j = 0; j < 8; ++j) {
        float r1 = tl[j], r2 = th[j];
        if (do_rope) { const f32x2 cs = tab[j]; r1 = tl[j] * cs.x - th[j] * cs.y; r2 = tl[j] * cs.y + th[j] * cs.x; }
        tl[j] = r1 * scale; th[j] = r2 * scale;
    }
    wl.x = pack2(tl[0], tl[1]); wl.y = pack2(tl[2], tl[3]); wl.z = pack2(tl[4], tl[5]); wl.w = pack2(tl[6], tl[7]);
    wh.x = pack2(th[0], th[1]); wh.y = pack2(th[2], th[3]); wh.z = pack2(th[4], th[5]); wh.w = pack2(th[6], th[7]);
}

__device__ __forceinline__ void mixer_sgu_pool(AP a, LAS unsigned char* lds, int l, int row0, int seq_row0, int pos0, int n) {
    const int tid = tid_opaque(), lane = tid & 63, w = __builtin_amdgcn_readfirstlane(tid >> 6), fr = lane & 15, g = lane >> 4;
    const bf16_t* Z = (const bf16_t*)(a->ws + WS_Z);
    bf16_t* CAT = (bf16_t*)(a->ws + WS_CAT);
    {
#pragma unroll
        for (int it = 0; it < 9; ++it) { const int id = tid + 512 * it, rr = id >> 5, ch = id & 31, j = pos0 - 8 + rr;
            u32x4 v = (u32x4){0u, 0u, 0u, 0u};
            if (j >= 0 && j < n) v = ld16g(Z + (size_t)(seq_row0 + j) * ZC + 1024 + ch * 8);
            *(LAS u32x4*)(lds + rr * 512 + ch * 16) = v; }
        __syncthreads();
        const int c = tid & 255, half = tid >> 8, hw = 1 << (c >> 6);
        const LAS bf16_t* P = (const LAS bf16_t*)lds + c;
        const int t0 = half * 64;
        float s = 0.f;
        for (int j = t0 - hw; j < t0 + hw; ++j) s += bf2f(P[(8 + j) * 256]);
        for (int tl = t0; tl < t0 + 64; ++tl) {
            const int pos = pos0 + tl; const int lo = max(pos - hw, 0), hi = min(pos + hw, n);
            CAT[(size_t)(row0 + tl) * D + 512 + c] = f2bf(s / (float)(hi - lo) - bf2f(P[(8 + tl) * 256]));
            s += bf2f(P[(8 + tl + hw) * 256]) - bf2f(P[(8 + tl - hw) * 256]);
        }
        __syncthreads();
    }
    {
        const int i16 = lane & 15;
        u32x4 gw[4][2];
#pragma unroll
        for (int ps = 0; ps < 4; ++ps) { const int q = w * 16 + ps * 4 + g; const bf16_t* src = Z + (size_t)(row0 + q) * ZC + 1536 + 16 * i16; gw[ps][0] = ld16g(src); gw[ps][1] = ld16g(src + 8); }
#pragma unroll
        for (int ps = 0; ps < 4; ++ps) {
            const int q = w * 16 + ps * 4 + g;
            float gv[16];
#pragma unroll
            for (int hh = 0; hh < 2; ++hh) { const u32x4 x = gw[ps][hh];
                gv[8 * hh + 0] = gelu_erf(lo2f(x.x)); gv[8 * hh + 1] = gelu_erf(hi2f(x.x)); gv[8 * hh + 2] = gelu_erf(lo2f(x.y)); gv[8 * hh + 3] = gelu_erf(hi2f(x.y));
                gv[8 * hh + 4] = gelu_erf(lo2f(x.z)); gv[8 * hh + 5] = gelu_erf(hi2f(x.z)); gv[8 * hh + 6] = gelu_erf(lo2f(x.w)); gv[8 * hh + 7] = gelu_erf(hi2f(x.w)); }
            float sm = 0.f;
#pragma unroll
            for (int e = 0; e < 16; ++e) sm += gv[e];
            const float mean = row_sum16(sm) * (1.0f / 256.0f);
            float qq = 0.f;
#pragma unroll
            for (int e = 0; e < 16; ++e) { const float d = gv[e] - mean; qq += d * d; }
            const float rstd = 1.0f / sqrtf(row_sum16(qq) * (1.0f / 256.0f) + 1e-6f);
#pragma unroll
            for (int e = 0; e < 16; ++e) { const int c = 16 * i16 + e; *(LAS bf16_t*)(lds + c * 256 + ((((q >> 3) ^ (c & 15))) << 4) + (q & 7) * 2) = f2bf((gv[e] - mean) * rstd); }
        }
    }
    __syncthreads();
    {
        const int h = w >> 1, ph = w & 1;
        const bf16_t* Ws = (const bf16_t*)(a->ws + WS_WSGU) + (size_t)(l * 4 + h) * 128 * 128;
        const float* bs = a->in[12] + (size_t)(l * 4 + h) * 128;
        f32x4 acc[4][4];
#pragma unroll
        for (int i = 0; i < 4; ++i)
#pragma unroll
            for (int j = 0; j < 4; ++j) acc[i][j] = (f32x4){0.f, 0.f, 0.f, 0.f};
#pragma unroll
        for (int ks = 0; ks < 4; ++ks) {
            bf16x8 af[4], bfv[4];
#pragma unroll
            for (int cf = 0; cf < 4; ++cf) { const int c = h * 64 + 16 * cf + fr; af[cf] = *(const LAS bf16x8*)(lds + c * 256 + (((4 * ks + g) ^ (c & 15)) << 4)); }
#pragma unroll
            for (int pf = 0; pf < 4; ++pf) { const int p = ph * 64 + 16 * pf + fr; bfv[pf] = *(const bf16x8*)(Ws + (size_t)p * 128 + 32 * ks + 8 * g); }
#pragma unroll
            for (int cf = 0; cf < 4; ++cf)
#pragma unroll
                for (int pf = 0; pf < 4; ++pf) acc[cf][pf] = __builtin_amdgcn_mfma_f32_16x16x32_bf16(af[cf], bfv[pf], acc[cf][pf], 0, 0, 0);
        }
#pragma unroll
        for (int pf = 0; pf < 4; ++pf) { const int p = ph * 64 + 16 * pf + fr; const float bias = bs[p];
#pragma unroll
            for (int cf = 0; cf < 4; ++cf) { const int c0 = h * 64 + 16 * cf + 4 * g;
                const u32x2 uw = *(const u32x2*)(Z + (size_t)(row0 + p) * ZC + 1280 + c0);
                u32x2 o; o.x = pack2(gelu_erf(lo2f(uw.x)) * (acc[cf][pf][0] + bias), gelu_erf(hi2f(uw.x)) * (acc[cf][pf][1] + bias));
                o.y = pack2(gelu_erf(lo2f(uw.y)) * (acc[cf][pf][2] + bias), gelu_erf(hi2f(uw.y)) * (acc[cf][pf][3] + bias));
                *(u32x2*)(CAT + (size_t)(row0 + p) * D + 768 + c0) = o; } }
    }
    __syncthreads();
}

__device__ __forceinline__ void mixer_attn(AP a, LAS unsigned char* lds, int l, int row0, int seq_row0, int pos0, int n, int b, bool is_ctx, int kvh) {
    const int tid = tid_opaque(), lane = tid & 63, w = __builtin_amdgcn_readfirstlane(tid >> 6), fr = lane & 15, g = lane >> 4;
    const bf16_t* Z = (const bf16_t*)(a->ws + WS_Z);
    bf16_t* CAT = (bf16_t*)(a->ws + WS_CAT);
    __syncthreads();
    ((LAS u32x4*)(lds + 98304))[tid] = ((const u32x4*)(a->ws + WS_ROPE))[tid];
    const LAS f32x2* rope = (const LAS f32x2*)(lds + 98304);
    constexpr float QS = 0.125f * 1.44269504088896341f;
    constexpr int QS_OFF = 0, KS_OFF = 32768, VS_OFF = 65536;
    const int nbq = pos0 >> 7;
    unsigned bmask = 0x18u;
    if (!is_ctx) { if (nbq > 0) bmask |= 1u; bmask |= 2u; if (nbq + 1 < (n >> 7)) bmask |= 4u; }
    const int kr = tid >> 2, kax = (tid >> 1) & 1, kh8 = tid & 1;
#define MX_KSRC(blk) (Z + (size_t)((((blk) < 3) ? seq_row0 + (nbq + (blk) - 1) * 128 : NLAT + b * 256 + ((blk) - 3) * 128) + kr) * ZC + 768 + kvh * 64 + kax * 32 + kh8 * 8)
#define MX_VSTAGE(blk, buf) do { const bool _band = (blk) < 3; const int _key0 = _band ? (nbq + (blk) - 1) * 128 : ((blk) - 3) * 128; \
        const bf16_t* _vs = _band ? (const bf16_t*)(a->ws + WS_VT) + (size_t)(b * 2 + kvh) * 64 * 4096 + _key0 : (const bf16_t*)(a->ws + WS_VTC) + (size_t)(b * 2 + kvh) * 64 * 256 + _key0; \
        const int _vld = _band ? 4096 : 256; \
        _Pragma("unroll") for (int _i = 0; _i < 2; ++_i) { const int _P = _i * 512 + tid, _d = _P >> 4, _c = (_P & 15) ^ (_d & 15); \
            glds16(_vs + (size_t)_d * _vld + _c * 8, lds + VS_OFF + (buf) * 16384 + _i * 8192 + w * 1024); } } while (0)
    {
        __syncthreads();
#pragma unroll
        for (int it = 0; it < 2; ++it) {
            const int item = tid + 512 * it, r = item >> 2, ax = (item >> 1) & 1, h8 = item & 1, i = r & 127, qpos = pos0 + i;
            const bf16_t* src = Z + (size_t)(row0 + i) * ZC + 512 + (2 * kvh + (r >> 7)) * 64 + ax * 32 + h8 * 8;
            u32x4 wl = ld16g(src), wh = ld16g(src + 16);
            rope_pack8(wl, wh, rope + (ax ? (qpos & 63) : (qpos >> 6)) * 16 + h8 * 8, !is_ctx, QS);
            const int ch = ax * 4 + h8, sw = (r >> 1) & 7;
            *(LAS u32x4*)(lds + QS_OFF + r * 128 + ((ch ^ sw) << 4)) = wl;
            *(LAS u32x4*)(lds + QS_OFF + r * 128 + (((ch + 2) ^ sw) << 4)) = wh;
        }
        const int hh = w >> 2, qb = (w & 3) * 32, h = 2 * kvh + hh;
        float m[2], lsum[2];
        m[0] = m[1] = a->in[8][l * 4 + h] * 1.44269504088896341f;
        lsum[0] = lsum[1] = (g == 0) ? 1.0f : 0.0f;
        f32x4 O[4][2];
#pragma unroll
        for (int i = 0; i < 4; ++i) { O[i][0] = (f32x4){0.f, 0.f, 0.f, 0.f}; O[i][1] = (f32x4){0.f, 0.f, 0.f, 0.f}; }
        bf16x8 Qf[2][2];
        bool have_q = false;
        unsigned rem = bmask;
        int cur = __builtin_ctz(rem); rem &= rem - 1u;
        int buf = 0;
        u32x4 kl = ld16g(MX_KSRC(cur)), kh = ld16g(MX_KSRC(cur) + 16);
        MX_VSTAGE(cur, 0);
#pragma unroll 1
        for (;;) {
            const int jb = cur - 1; const bool band = cur < 3;
            {
                const int kpos = (nbq + jb) * 128 + kr;
                rope_pack8(kl, kh, rope + (kax ? (kpos & 63) : (kpos >> 6)) * 16 + kh8 * 8, band, 1.0f);
                const int ch = kax * 4 + kh8, sw = (kr >> 1) & 7;
                *(LAS u32x4*)(lds + KS_OFF + buf * 16384 + kr * 128 + ((ch ^ sw) << 4)) = kl;
                *(LAS u32x4*)(lds + KS_OFF + buf * 16384 + kr * 128 + (((ch + 2) ^ sw) << 4)) = kh;
            }
            asm volatile("s_waitcnt vmcnt(0)" ::: "memory");
            __syncthreads();
            const int nxt = rem ? __builtin_ctz(rem) : -1; rem &= rem - 1u;
            if (nxt >= 0) { kl = ld16g(MX_KSRC(nxt)); kh = ld16g(MX_KSRC(nxt) + 16); MX_VSTAGE(nxt, buf ^ 1); }
            if (!have_q) {
#pragma unroll
                for (int qf = 0; qf < 2; ++qf)
#pragma unroll
                    for (int ks = 0; ks < 2; ++ks) { const int r = hh * 128 + qb + 16 * qf + fr; Qf[qf][ks] = *(const LAS bf16x8*)(lds + QS_OFF + r * 128 + (((4 * ks + g) ^ ((r >> 1) & 7)) << 4)); }
                have_q = true;
            }
            const int kso = KS_OFF + buf * 16384, vso = VS_OFF + buf * 16384;
            f32x4 S[8][2];
#pragma unroll
            for (int kf = 0; kf < 8; ++kf) { S[kf][0] = (f32x4){0.f, 0.f, 0.f, 0.f}; S[kf][1] = (f32x4){0.f, 0.f, 0.f, 0.f}; }
#pragma unroll
            for (int kf = 0; kf < 8; ++kf)
#pragma unroll
                for (int ks = 0; ks < 2; ++ks) { const int r = 16 * kf + fr;
                    const bf16x8 kfr = *(const LAS bf16x8*)(lds + kso + r * 128 + (((4 * ks + g) ^ ((r >> 1) & 7)) << 4));
                    S[kf][0] = __builtin_amdgcn_mfma_f32_16x16x32_bf16(kfr, Qf[0][ks], S[kf][0], 0, 0, 0);
                    S[kf][1] = __builtin_amdgcn_mfma_f32_16x16x32_bf16(kfr, Qf[1][ks], S[kf][1], 0, 0, 0); }
            bf16x8 Pp[4][2];
#pragma unroll
            for (int qf = 0; qf < 2; ++qf) {
                const int qi = qb + 16 * qf + fr;
                if (band && jb != 0) {
#pragma unroll
                    for (int kf = 0; kf < 8; ++kf)
#pragma unroll
                        for (int r = 0; r < 4; ++r) { const int kk = 16 * kf + 4 * g + r; const bool ok = (jb < 0) ? (kk >= qi) : (kk <= qi); if (!ok) S[kf][qf][r] = -1.0e30f; }
                }
                float mx = S[0][qf][0];
#pragma unroll
                for (int kf = 0; kf < 8; ++kf)
#pragma unroll
                    for (int r = 0; r < 4; ++r) mx = fmaxf(mx, S[kf][qf][r]);
                mx = fmaxf(mx, __shfl_xor(mx, 16)); mx = fmaxf(mx, __shfl_xor(mx, 32));
                const float mn = fmaxf(m[qf], mx), corr = __builtin_amdgcn_exp2f(m[qf] - mn);
                m[qf] = mn;
                float ps = 0.f;
#pragma unroll
                for (int kf = 0; kf < 8; ++kf)
#pragma unroll
                    for (int r = 0; r < 4; ++r) { const float p = __builtin_amdgcn_exp2f(S[kf][qf][r] - mn); S[kf][qf][r] = p; ps += p; }
                lsum[qf] = lsum[qf] * corr + ps;
#pragma unroll
                for (int df = 0; df < 4; ++df) O[df][qf] *= corr;
#pragma unroll
                for (int t = 0; t < 4; ++t) { u32x4 pw; pw.x = pack2(S[2 * t][qf][0], S[2 * t][qf][1]); pw.y = pack2(S[2 * t][qf][2], S[2 * t][qf][3]);
                    pw.z = pack2(S[2 * t + 1][qf][0], S[2 * t + 1][qf][1]); pw.w = pack2(S[2 * t + 1][qf][2], S[2 * t + 1][qf][3]); Pp[t][qf] = __builtin_bit_cast(bf16x8, pw); }
            }
#pragma unroll
            for (int t = 0; t < 4; ++t)
#pragma unroll
                for (int df = 0; df < 4; ++df) { const int d = 16 * df + fr;
                    const u32x2 v0 = *(const LAS u32x2*)(lds + vso + d * 256 + (((4 * t + (g >> 1)) ^ (d & 15)) << 4) + (g & 1) * 8);
                    const u32x2 v1 = *(const LAS u32x2*)(lds + vso + d * 256 + (((4 * t + 2 + (g >> 1)) ^ (d & 15)) << 4) + (g & 1) * 8);
                    u32x4 vw; vw.x = v0.x; vw.y = v0.y; vw.z = v1.x; vw.w = v1.y; const bf16x8 vf = __builtin_bit_cast(bf16x8, vw);
                    O[df][0] = __builtin_amdgcn_mfma_f32_16x16x32_bf16(vf, Pp[t][0], O[df][0], 0, 0, 0);
                    O[df][1] = __builtin_amdgcn_mfma_f32_16x16x32_bf16(vf, Pp[t][1], O[df][1], 0, 0, 0); }
            if (nxt < 0) break;
            cur = nxt; buf ^= 1;
        }
#pragma unroll
        for (int qf = 0; qf < 2; ++qf) {
            float lt = lsum[qf]; lt += __shfl_xor(lt, 16); lt += __shfl_xor(lt, 32);
            const float inv = 1.0f / lt;
            bf16_t* dst = CAT + (size_t)(row0 + qb + 16 * qf + fr) * D + 256 + h * 64 + 4 * g;
#pragma unroll
            for (int df = 0; df < 4; ++df) { u32x2 o; o.x = pack2(O[df][qf][0] * inv, O[df][qf][1] * inv); o.y = pack2(O[df][qf][2] * inv, O[df][qf][3] * inv); *(u32x2*)(dst + 16 * df) = o; }
        }
    }
#undef MX_KSRC
#undef MX_VSTAGE
    __syncthreads();
}

constexpr int FF_DA = 0, FF_DC = 32768, FF_XT = 49152  , FF_Z2 = 81920  , FF_OB = 114688  ;
__device__ __forceinline__ int ff_addr(int row, int k) { return row * 256 + ((((k >> 3) ^ (row & 15))) << 4) + (k & 7) * 2; }
__device__ __forceinline__ float cos_turns(float x) { return __builtin_amdgcn_cosf(x); }
__device__ __forceinline__ float sin_turns(float x) { return __builtin_amdgcn_sinf(x); }
__device__ __forceinline__ void fft_setup(LAS unsigned char* lds) {
    const int tid = tid_opaque();
    __syncthreads();
    for (int idx = tid; idx < 16384; idx += NT) { const int i = idx >> 7, k = idx & 127, ro = i >> 6, k1 = i & 63, part = k >> 6, n1 = k & 63; const float t = (float)((k1 * n1) & 63) * (1.0f / 64.0f);
        const float c = cos_turns(t), sn = sin_turns(t);
        const float v = (ro == 0) ? (part == 0 ? c : sn) : (part == 0 ? -sn : c);
        *(LAS bf16_t*)(lds + FF_DA + ff_addr(i, k)) = f2bf(v * 0.125f); }
    for (int idx = tid; idx < 8192; idx += NT) { const int k2 = idx >> 7, k = idx & 127, ri = k >> 6, n2 = k & 63; const float t = (float)((k2 * n2) & 63) * (1.0f / 64.0f);
        const float v = (ri == 0) ? cos_turns(t) : sin_turns(t);
        *(LAS bf16_t*)(lds + FF_DC + ff_addr(k2, k)) = f2bf(v * 0.125f); }
    __syncthreads();
}
__device__ __forceinline__ void fft_unit(AP a, LAS unsigned char* lds, int b, int cg) {
    const int tid = tid_opaque(), lane = tid & 63, w = __builtin_amdgcn_readfirstlane(tid >> 6), fr = lane & 15, g = lane >> 4;
    const int mf = w & 3, nh = w >> 2;
    const bf16_t* AT = (const bf16_t*)(a->ws + WS_AT) + (size_t)(b * 256 + cg * 4) * 8192;
    u32x4 xin[2][2];
#pragma unroll
    for (int h = 0; h < 2; ++h)
#pragma unroll
        for (int it = 0; it < 2; ++it) xin[h][it] = ld16g(AT + (size_t)h * 8192 + (size_t)(tid + 512 * it) * 8);
#pragma unroll 1
    for (int cp = 0; cp < 2; ++cp) {
#pragma unroll
        for (int h = 0; h < 2; ++h)
#pragma unroll
            for (int it = 0; it < 2; ++it) { const int q = tid + 512 * it, part = q >> 9, pos0 = (q & 511) * 8, n1 = pos0 >> 6, n2 = pos0 & 63, k = part * 64 + n1;
                const unsigned wv[4] = {xin[h][it].x, xin[h][it].y, xin[h][it].z, xin[h][it].w};
#pragma unroll
                for (int e = 0; e < 4; ++e) { *(LAS bf16_t*)(lds + FF_XT + h * 16384 + ff_addr(n2 + 2 * e, k)) = (bf16_t)(wv[e] & 0xffffu); *(LAS bf16_t*)(lds + FF_XT + h * 16384 + ff_addr(n2 + 2 * e + 1, k)) = (bf16_t)(wv[e] >> 16); } }
        if (cp == 0) {
#pragma unroll
            for (int h = 0; h < 2; ++h)
#pragma unroll
                for (int it = 0; it < 2; ++it) xin[h][it] = ld16g(AT + (size_t)(2 + h) * 8192 + (size_t)(tid + 512 * it) * 8); }
        __syncthreads();
        f32x4 acc[2][2][2];
#pragma unroll
        for (int h = 0; h < 2; ++h)
#pragma unroll
            for (int x = 0; x < 2; ++x) { acc[h][x][0] = (f32x4){0.f, 0.f, 0.f, 0.f}; acc[h][x][1] = (f32x4){0.f, 0.f, 0.f, 0.f}; }
#pragma unroll
        for (int ks = 0; ks < 4; ++ks) {
            bf16x8 af[2];
#pragma unroll
            for (int x = 0; x < 2; ++x) { const int i = 16 * (mf + 4 * x) + fr; af[x] = *(const LAS bf16x8*)(lds + FF_DA + i * 256 + (((4 * ks + g) ^ (i & 15)) << 4)); }
#pragma unroll
            for (int h = 0; h < 2; ++h)
#pragma unroll
                for (int n = 0; n < 2; ++n) { const int j = 16 * (2 * nh + n) + fr; const bf16x8 bfv = *(const LAS bf16x8*)(lds + FF_XT + h * 16384 + j * 256 + (((4 * ks + g) ^ (j & 15)) << 4));
                    acc[h][0][n] = __builtin_amdgcn_mfma_f32_16x16x32_bf16(af[0], bfv, acc[h][0][n], 0, 0, 0);
                    acc[h][1][n] = __builtin_amdgcn_mfma_f32_16x16x32_bf16(af[1], bfv, acc[h][1][n], 0, 0, 0); }
        }
#pragma unroll
        for (int n = 0; n < 2; ++n)
#pragma unroll
            for (int r = 0; r < 4; ++r) { const int k1 = 16 * mf + 4 * g + r, n2 = 16 * (2 * nh + n) + fr; const float t = (float)((k1 * n2) & 4095) * (1.0f / 4096.0f);
                const float c = cos_turns(t), sn = sin_turns(t);
#pragma unroll
                for (int h = 0; h < 2; ++h) { const float zr = acc[h][0][n][r], zi = acc[h][1][n][r];
                    *(LAS bf16_t*)(lds + FF_Z2 + h * 16384 + ff_addr(k1, n2)) = f2bf(zr * c + zi * sn);
                    *(LAS bf16_t*)(lds + FF_Z2 + h * 16384 + ff_addr(k1, 64 + n2)) = f2bf(zi * c - zr * sn); } }
        __syncthreads();
        f32x4 acc2[2][2];
#pragma unroll
        for (int h = 0; h < 2; ++h) { acc2[h][0] = (f32x4){0.f, 0.f, 0.f, 0.f}; acc2[h][1] = (f32x4){0.f, 0.f, 0.f, 0.f}; }
#pragma unroll
        for (int ks = 0; ks < 4; ++ks) {
            const int i = 16 * mf + fr; const bf16x8 af = *(const LAS bf16x8*)(lds + FF_DC + i * 256 + (((4 * ks + g) ^ (i & 15)) << 4));
#pragma unroll
            for (int h = 0; h < 2; ++h)
#pragma unroll
                for (int n = 0; n < 2; ++n) { const int j = 16 * (2 * nh + n) + fr; const bf16x8 bfv = *(const LAS bf16x8*)(lds + FF_Z2 + h * 16384 + j * 256 + (((4 * ks + g) ^ (j & 15)) << 4));
                    acc2[h][n] = __builtin_amdgcn_mfma_f32_16x16x32_bf16(af, bfv, acc2[h][n], 0, 0, 0); }
        }
#pragma unroll
        for (int n = 0; n < 2; ++n)
#pragma unroll
            for (int r = 0; r < 4; ++r) { const int k = 16 * (2 * nh + n) + fr + 64 * (16 * mf + 4 * g + r);
                *(LAS unsigned*)(lds + FF_OB + k * 8 + cp * 4) = pack2(acc2[0][n][r], acc2[1][n][r]); }
    }
    __syncthreads();
    bf16_t* CAT = (bf16_t*)(a->ws + WS_CAT) + (size_t)(b * 4096) * D + cg * 4;
#pragma unroll
    for (int it = 0; it < 8; ++it) { const int k = tid + 512 * it; *(u32x2*)(CAT + (size_t)k * D) = *(const LAS u32x2*)(lds + FF_OB + k * 8); }
    __syncthreads();
}

__device__ __forceinline__ void p2_mix(AP a, unsigned char* ldsg, LAS unsigned char* lds, int l) {
    const int n_tile = 128 + ((l == 0) ? 8 : 0), n_att = 2 * n_tile, n_dft = 256, n_dftc = (l == 0) ? 16 : 0;
    bf16_t* CAT = (bf16_t*)(a->ws + WS_CAT);
    bool fft_ready = false;
    for (int u = blockIdx.x; u < n_att + n_dft + n_tile + n_dftc; u += gridDim.x) {
        if (u < n_att || (u >= n_att + n_dft && u < n_att + n_dft + n_tile)) {
            const bool att = u < n_att;
            const int t = att ? (u >> 1) : (u - n_att - n_dft);
            const bool isc = t >= 128; const int tt = t - 128;
            const int b = isc ? (tt >> 1) : (t >> 5);
            const int row0 = isc ? NLAT + tt * 128 : t * 128, seq_row0 = isc ? NLAT + b * 256 : b * 4096, pos0 = isc ? (tt & 1) * 128 : (t & 31) * 128, n = isc ? 256 : 4096;
            if (att) { for (int rep = 0; rep < PROBE_MIX_REP; ++rep) mixer_attn(a, lds, l, row0, seq_row0, pos0, n, b, isc, u & 1); }
            else { for (int rep = 0; rep < PROBE_SGU_REP; ++rep) mixer_sgu_pool(a, lds, l, row0, seq_row0, pos0, n); }
            fft_ready = false;
        } else if (u < n_att + n_dft) {
            const int uu = u - n_att;
            if (!fft_ready) { fft_setup(lds); fft_ready = true; }
            for (int rep = 0; rep < PROBE_FFT_REP; ++rep) fft_unit(a, lds, uu >> 6, uu & 63);
        } else {
            const int uu = u - n_att - n_dft - n_tile, b = uu >> 2, mt = (uu >> 1) & 1, ch0 = (uu & 1) * 128;
            const bf16_t* A = (const bf16_t*)(a->ws + WS_DFTC) + (size_t)(mt * 128) * 512;
            const bf16_t* B0 = (const bf16_t*)(a->ws + WS_ATC) + ((size_t)b * 256 + ch0) * 512;
            EpiBf16 E; E.C = CAT + (size_t)(NLAT + b * 256 + mt * 128) * D + ch0; E.ld = D;
            gemm_tile<128, false, EpiBf16>(lds, A, 512, nullptr, 128, B0, B0 + (size_t)64 * 512, 512, 512, E);
            fft_ready = false;
        }
    }
    exp_queue(a, ldsg, l);
}

__device__ __forceinline__ int uni(int v) { return __builtin_amdgcn_readfirstlane(v); }
__device__ __forceinline__ int vblock() { const int G = gridDim.x, b = blockIdx.x; return (G % 8 == 0) ? (b % 8) * (G / 8) + b / 8 : b; }
template <class T> __device__ __forceinline__ T* unip(T* p) { const unsigned long long v = (unsigned long long)p; const unsigned lo = __builtin_amdgcn_readfirstlane((unsigned)v), hi = __builtin_amdgcn_readfirstlane((unsigned)(v >> 32)); return (T*)(((unsigned long long)hi << 32) | lo); }
struct SchedInProj {
    typedef EpiInProj Epi; static constexpr bool GATHER = false;
    unsigned char* ws; int l, G, me;
    __device__ __forceinline__ bool get(int i, g256::Unit<Epi>& u) const {
        const int n_lat = 64 * 7, n_ctx = (l == 0) ? 4 * 7 : 4;
        const int idx = i * G + me; if (idx >= n_lat + n_ctx) return false;
        int row0, b, ct, n; bf16_t *tF, *tV;
        if (idx < n_lat) { const int rt = idx / 7; ct = idx % 7; row0 = rt * 256; b = row0 >> 12; n = 4096;
            tF = (bf16_t*)(ws + WS_AT) + (size_t)b * 256 * 2 * 4096; tV = (bf16_t*)(ws + WS_VT) + (size_t)b * 128 * 4096; }
        else { const int uu = idx - n_lat; int rt; if (l == 0) { rt = uu / 7; ct = uu % 7; } else { rt = uu; ct = 3; }
            row0 = NLAT + rt * 256; b = rt; n = 256;
            tF = (bf16_t*)(ws + WS_ATC) + (size_t)b * 256 * 2 * 256; tV = (bf16_t*)(ws + WS_VTC) + (size_t)b * 128 * 256; }
        u.A = (const bf16_t*)(ws + WS_H) + (size_t)row0 * D;
        u.B0 = (const bf16_t*)(ws + WS_WIN) + ((size_t)l * ZC + ct * 256) * 1024; u.B1 = u.B0 + (size_t)128 * 1024; u.ridx = nullptr; u.valid = 256;
        u.epi.Zt = (bf16_t*)(ws + WS_Z) + (size_t)row0 * ZC + ct * 256; u.epi.tF = tF; u.epi.tV = tV; u.epi.n0 = ct * 256; u.epi.pos0 = (idx < n_lat) ? (row0 & 4095) : 0; u.epi.n = n;
        return true;
    }
};
struct SchedOutProj {
    typedef EpiBf16 Epi; static constexpr bool GATHER = false;
    unsigned char* ws; int l, G, me;
    __device__ __forceinline__ bool get(int i, g256::Unit<Epi>& u) const {
        const int nrt = NLAT / 256;
        const int idx = i * G + me; if (idx >= nrt * 4) return false;
        const int rt = idx >> 2, ct = idx & 3;
        u.A = (const bf16_t*)(ws + WS_CAT) + (size_t)(rt * 256) * D;
        u.B0 = (const bf16_t*)(ws + WS_WOUT) + ((size_t)l * 1024 + ct * 256) * 1024; u.B1 = u.B0 + (size_t)128 * 1024; u.ridx = nullptr; u.valid = 256;
        u.epi.C = (bf16_t*)(ws + WS_Y) + (size_t)(rt * 256) * D + ct * 256; u.epi.ld = D;
        return true;
    }
};
struct SchedGateUp {
    typedef EpiGateUp Epi; static constexpr bool GATHER = true;
    unsigned char* ws; const LAS int* blk; const LAS int* tot; const LAS int* ridx_lds; int G, me, l;
    __device__ __forceinline__ bool get(int i, g256::Unit<Epi>& u) const {
        const int idx = i * G + me; if (idx >= uni(blk[32]) * 4) return false;
        const int rb = idx >> 2, ct = idx & 3;
        int e = 0;
#pragma unroll 1
        for (int q = 1; q < 32; ++q) if (uni(blk[q]) <= rb) e = q;
        u.A = (const bf16_t*)(ws + WS_H);
        u.B0 = (const bf16_t*)(ws + WS_WEXP + (size_t)l * WEXP_LAYER) + ((size_t)e * 512 + ct * 128) * 1024; u.B1 = u.B0 + EXPMAT;
        u.ridx = ridx_lds + (i & 7) * 256; u.valid = uni(min(256, tot[e] - (rb - blk[e]) * 256));
        u.epi.C = (bf16_t*)(ws + WS_HID) + (size_t)(rb * 256) * DEXP + ct * 128; u.epi.ld = DEXP;
        return true;
    }
};
struct SchedDown {
    typedef EpiBf16 Epi; static constexpr bool GATHER = false;
    unsigned char* ws; const LAS int* blk; int G, me, l;
    __device__ __forceinline__ bool get(int i, g256::Unit<Epi>& u) const {
        const int idx = i * G + me; if (idx >= uni(blk[32]) * 4) return false;
        const int rb = idx >> 2, ct = idx & 3;
        int e = 0;
#pragma unroll 1
        for (int q = 1; q < 32; ++q) if (uni(blk[q]) <= rb) e = q;
        u.A = (const bf16_t*)(ws + WS_HID) + (size_t)(rb * 256) * DEXP;
        u.B0 = (const bf16_t*)(ws + WS_WEXP + (size_t)l * WEXP_LAYER) + 2 * EXPMAT + ((size_t)e * 1024 + ct * 256) * 512; u.B1 = u.B0 + (size_t)128 * 512; u.ridx = nullptr; u.valid = 256;
        u.epi.C = (bf16_t*)(ws + WS_YS) + (size_t)(rb * 256) * D + ct * 256; u.epi.ld = D;
        return true;
    }
};

__device__ __forceinline__ void p4_ln1_router(AP a, unsigned char* lds, int l) {
    const int tid = tid_opaque(), lane = tid & 63, w = tid >> 6;
    const int ntok = (l == 0) ? NTOK : NLAT;
    int* cnt = (int*)(lds + MISC_OFF);
    if (tid < 32) cnt[tid] = 0;
    f32x4* Lg = (f32x4*)lds; f32x4* Le = (f32x4*)(lds + 16384); f32x4* Lgb = (f32x4*)(lds + 147456);
    {
        const float* wrg_ = a->in[16] + (size_t)l * 1024 * 4; const float* wre_ = a->in[17] + (size_t)l * 1024 * 32;
#pragma unroll
        for (int it = 0; it < 2; ++it) { const int c = tid + 512 * it, slot = (((c >> 8) * 4 + (c & 3)) << 6) + ((c >> 2) & 63);
            Lg[slot] = *(const f32x4*)(wrg_ + (size_t)c * 4);
#pragma unroll
            for (int q = 0; q < 8; ++q) Le[q * 1024 + slot] = *(const f32x4*)(wre_ + (size_t)c * 32 + q * 4); }
        Lgb[tid] = (tid < 256) ? *(const f32x4*)(a->in[14] + l * 1024 + tid * 4) : *(const f32x4*)(a->in[15] + l * 1024 + (tid - 256) * 4);
    }
    __syncthreads();
    const float* mod = (const float*)(a->ws + WS_MOD) + (size_t)l * 5 * 6144;
    const bf16_t* Y = (const bf16_t*)(a->ws + WS_Y);
    float* X1 = (float*)(a->ws + WS_X1);
    bf16_t* H = (bf16_t*)(a->ws + WS_H);
    int* tokE = (int*)(a->ws + WS_TOKE); int* tokR = (int*)(a->ws + WS_TOKR); float* tokG = (float*)(a->ws + WS_TOKG);
    const int tstep = gridDim.x * 8;
    f32x4 nx[4]; u32x2 ny[4];
    {   const int t = blockIdx.x * 8 + w;
        if (t < ntok) { const float* xs = (l == 0) ? ((t < NLAT) ? a->in[0] + (size_t)t * D : a->in[2] + (size_t)(t - NLAT) * D) : (const float*)(a->ws + WS_XC) + (size_t)t * D;
#pragma unroll
            for (int i = 0; i < 4; ++i) { nx[i] = *(const f32x4*)(xs + 256 * i + 4 * lane); ny[i] = *(const u32x2*)(Y + (size_t)t * D + 256 * i + 4 * lane); } } }
    int mrow = -1; f32x4 mg[4], msh[4], msc[4];
    for (int t = blockIdx.x * 8 + w; t < ntok; t += tstep) {
        const int mr = (t < NLAT) ? (t >> 12) : 4;
        if (mr != mrow) { mrow = mr; const float* m = mod + (size_t)mr * 6144;
#pragma unroll
            for (int i = 0; i < 4; ++i) { const int c = 256 * i + 4 * lane; mg[i] = *(const f32x4*)(m + 2048 + c); msh[i] = *(const f32x4*)(m + 3072 + c); msc[i] = *(const f32x4*)(m + 4096 + c); } }
        f32x4 v[4];
#pragma unroll
        for (int i = 0; i < 4; ++i) { const f32x4 yv = (f32x4){lo2f(ny[i].x), hi2f(ny[i].x), lo2f(ny[i].y), hi2f(ny[i].y)};
#pragma unroll
            for (int e = 0; e < 4; ++e) v[i][e] = RES_ALPHA * nx[i][e] + mg[i][e] * yv[e]; }
        {   const int tn = t + tstep;
            if (tn < ntok) { const float* xs = (l == 0) ? ((tn < NLAT) ? a->in[0] + (size_t)tn * D : a->in[2] + (size_t)(tn - NLAT) * D) : (const float*)(a->ws + WS_XC) + (size_t)tn * D;
#pragma unroll
                for (int i = 0; i < 4; ++i) { nx[i] = *(const f32x4*)(xs + 256 * i + 4 * lane); ny[i] = *(const u32x2*)(Y + (size_t)tn * D + 256 * i + 4 * lane); } } }
        float mean, rstd; ln_stats(v, mean, rstd);
#pragma unroll
        for (int i = 0; i < 4; ++i) { const int c = 256 * i + 4 * lane; const f32x4 gg = Lgb[64 * i + lane], bb = Lgb[256 + 64 * i + lane];
#pragma unroll
            for (int e = 0; e < 4; ++e) v[i][e] = (v[i][e] - mean) * rstd * gg[e] + bb[e];
            *(f32x4*)(X1 + (size_t)t * D + c) = v[i]; }
        ln_stats(v, mean, rstd);
#pragma unroll
        for (int i = 0; i < 4; ++i) { const int c = 256 * i + 4 * lane; const f32x4 sh = msh[i], sc = msc[i];
#pragma unroll
            for (int e = 0; e < 4; ++e) v[i][e] = (v[i][e] - mean) * rstd * (1.0f + sc[e]) + sh[e];
            u32x2 pk; pk.x = pack2(v[i][0], v[i][1]); pk.y = pack2(v[i][2], v[i][3]); *(u32x2*)(H + (size_t)t * D + c) = pk; }
        f32x2 lg01 = (f32x2){0.f, 0.f}, lg23 = (f32x2){0.f, 0.f};
#pragma unroll
        for (int i = 0; i < 4; ++i)
#pragma unroll
            for (int e = 0; e < 4; ++e) { const f32x4 wv = Lg[((i * 4 + e) << 6) + lane]; const f32x2 vv = (f32x2){v[i][e], v[i][e]};
                lg01 += vv * (f32x2){wv[0], wv[1]}; lg23 += vv * (f32x2){wv[2], wv[3]}; }
        float lg[4] = {wave_sum(lg01[0]), wave_sum(lg01[1]), wave_sum(lg23[0]), wave_sum(lg23[1])};
        int grp = 0; float mx = lg[0];
#pragma unroll
        for (int q = 1; q < 4; ++q) if (lg[q] > mx) { mx = lg[q]; grp = q; }
        float se = 0.f;
#pragma unroll
        for (int q = 0; q < 4; ++q) se += expf(lg[q] - mx);
        const float gate_group = 1.0f / se;
        f32x2 le01 = (f32x2){0.f, 0.f}, le23 = (f32x2){0.f, 0.f}, le45 = (f32x2){0.f, 0.f}, le67 = (f32x2){0.f, 0.f};
#pragma unroll
        for (int i = 0; i < 4; ++i)
#pragma unroll
            for (int e = 0; e < 4; ++e) { const f32x4* wp = Le + grp * 2048 + ((i * 4 + e) << 6) + lane; const f32x4 w0 = wp[0], w1 = wp[1024]; const f32x2 vv = (f32x2){v[i][e], v[i][e]};
                le01 += vv * (f32x2){w0[0], w0[1]}; le23 += vv * (f32x2){w0[2], w0[3]}; le45 += vv * (f32x2){w1[0], w1[1]}; le67 += vv * (f32x2){w1[2], w1[3]}; }
        float le[8] = {wave_sum(le01[0]), wave_sum(le01[1]), wave_sum(le23[0]), wave_sum(le23[1]), wave_sum(le45[0]), wave_sum(le45[1]), wave_sum(le67[0]), wave_sum(le67[1])};
        int j1 = 0; float l1 = le[0];
#pragma unroll
        for (int q = 1; q < 8; ++q) if (le[q] > l1) { l1 = le[q]; j1 = q; }
        int j2 = -1; float l2 = -3.0e38f;
#pragma unroll
        for (int q = 0; q < 8; ++q) if (q != j1 && le[q] > l2) { l2 = le[q]; j2 = q; }
        const float e2 = expf(l2 - l1), p1 = 1.0f / (1.0f + e2), p2 = e2 / (1.0f + e2);
        if (lane == 0) {
            const int ex0 = grp * 8 + j1, ex1 = grp * 8 + j2;
            const int r0 = atomicAdd(&cnt[ex0], 1), r1 = atomicAdd(&cnt[ex1], 1);
            tokE[2 * t] = ex0; tokE[2 * t + 1] = ex1; tokR[2 * t] = r0; tokR[2 * t + 1] = r1;
            tokG[2 * t] = gate_group * p1; tokG[2 * t + 1] = gate_group * p2;
        }
    }
    __syncthreads();
    if (tid < 32) ((int*)(a->ws + WS_BCNT))[((size_t)l * MAXG + blockIdx.x) * 32 + tid] = cnt[tid];
    __syncthreads();
}

__device__ __forceinline__ void p5_dispatch(AP a, unsigned char* lds, int l) {
    const int tid = tid_opaque();
    const int ntok = (l == 0) ? NTOK : NLAT;
    int* part = (int*)lds;
    int* tot = (int*)(lds + 4096);
    int* off = (int*)(lds + 4096 + 128);
    int* pstart = (int*)(lds + 4096 + 256);
    const int* bc = (const int*)(a->ws + WS_BCNT) + (size_t)l * MAXG * 32;
    const int G = gridDim.x, me = blockIdx.x;
    { const int e = tid & 31, p = tid >> 5; int s = 0, so = 0; for (int bb = p; bb < G; bb += 16) { const int c = bc[bb * 32 + e]; s += c; if (bb < me) so += c; } part[p * 32 + e] = s; part[512 + p * 32 + e] = so; }
    __syncthreads();
    if (tid < 32) { int s = 0, so = 0; for (int p = 0; p < 16; ++p) { s += part[p * 32 + tid]; so += part[512 + p * 32 + tid]; } tot[tid] = s; off[tid] = so; }
    __syncthreads();
    if (tid == 0) { int acc = 0; for (int e = 0; e < 32; ++e) { pstart[e] = acc; acc += ((tot[e] + 255) >> 8) << 8; } }
    __syncthreads();
    if (me == 0 && tid < 32) ((int*)(a->ws + WS_CNT))[l * 32 + tid] = tot[tid];
    const int* tokE = (const int*)(a->ws + WS_TOKE); const int* tokR = (const int*)(a->ws + WS_TOKR);
    int* tokS = (int*)(a->ws + WS_TOKS); int* slotT = (int*)(a->ws + WS_SLOTT);
    for (int q = tid; ; q += NT) { const int it = q >> 4, j = q & 15, t = (it * G + me) * 8 + (j >> 1); if (t >= ntok) break;
        const int idx = 2 * t + (j & 1); const int e = tokE[idx]; const int slot = pstart[e] + off[e] + tokR[idx]; tokS[idx] = slot; slotT[slot] = t; }
    __syncthreads();
}

__device__ __forceinline__ void moe_table(AP a, int l, LAS int* blk) {
    const int* tot = (const int*)(a->ws + WS_CNT) + l * 32;
    if (threadIdx.x == 0) { int acc = 0; for (int e = 0; e < 32; ++e) { const int c = tot[e]; blk[e] = acc; blk[33 + e] = c; acc += (c + 255) >> 8; } blk[32] = acc; }
    __syncthreads();
}
__device__ __forceinline__ int units_of(int nu, int v, int G) { return (v < nu) ? (nu - v + G - 1) / G : 0; }
__device__ __forceinline__ void p1_inproj(AP a, unsigned char* smem, LAS unsigned char* lds, int l) {
    SchedInProj S; S.ws = a->ws; S.l = l; S.G = gridDim.x; S.me = vblock();
    g256::gemm_phase(lds, 1024, S);
    if (l == 0) { const int nu = 64 * 7 + 4 * 7, G = gridDim.x; if (units_of(nu, S.me, G) < (nu + G - 1) / G) exp_fill(a, smem, 0, 8); }
}
__device__ __forceinline__ void p3_outproj(AP a, unsigned char* smem, LAS unsigned char* lds, int l) {
    SchedOutProj S; S.ws = a->ws; S.l = l; S.G = gridDim.x; S.me = vblock();
    g256::gemm_phase(lds, 1024, S);
    if (l == 0) {
        const bf16_t* W = (const bf16_t*)(a->ws + WS_WOUT);
        for (int u = blockIdx.x; u < 64; u += gridDim.x) { const int rt = u >> 3, ct = u & 7;
            EpiBf16 E; E.C = (bf16_t*)(a->ws + WS_Y) + (size_t)(NLAT + rt * 128) * D + ct * 128; E.ld = D;
            const bf16_t* B0 = W + (size_t)(ct * 128) * 1024;
            gemm_tile<128, false, EpiBf16>(lds, (const bf16_t*)(a->ws + WS_CAT) + (size_t)(NLAT + rt * 128) * D, D, nullptr, 128, B0, B0 + (size_t)64 * 1024, 1024, 1024, E); }
        if (blockIdx.x >= 64) exp_fill(a, smem, 0, 3);
    }
}
__device__ __forceinline__ void p6_gateup(AP a, unsigned char* smem, LAS unsigned char* lds, int l) {
    LAS int* blk = (LAS int*)(lds + MISC_OFF + 256);
    moe_table(a, l, blk);
    LAS int* ridx = (LAS int*)(lds + RIDX_OFF);
    const int tid = tid_opaque(), G = gridDim.x, me = vblock(), nu = blk[32] * 4;
    const int* slotT = (const int*)(a->ws + WS_SLOTT);
    for (int i = 0; i < 8; ++i) { const int idx = i * G + me; if (idx >= nu) break;
        const int rb = idx >> 2; int e = 0; for (int q = 1; q < 32; ++q) if (blk[q] <= rb) e = q;
        const int valid = min(256, blk[33 + e] - (rb - blk[e]) * 256);
        if (tid < 256) ridx[i * 256 + tid] = (tid < valid) ? slotT[rb * 256 + tid] : 0; }
    __syncthreads();
    SchedGateUp S; S.ws = a->ws; S.blk = blk; S.tot = blk + 33; S.ridx_lds = ridx; S.G = G; S.me = me; S.l = l;
    g256::gemm_phase(lds, 1024, S);
    __syncthreads();
    if (l == 0 && units_of(nu, me, G) < (nu + G - 1) / G) exp_fill(a, smem, 1, 8);
}
__device__ __forceinline__ void p7_down(AP a, unsigned char* smem, LAS unsigned char* lds, int l) {
    LAS int* blk = (LAS int*)(lds + MISC_OFF + 256);
    moe_table(a, l, blk);
    SchedDown S; S.ws = a->ws; S.blk = blk; S.G = gridDim.x; S.me = vblock(); S.l = l;
    g256::gemm_phase(lds, 512, S);
    __syncthreads();
    { const int nu = uni(blk[32]) * 4, G = gridDim.x; if (l == 0 && units_of(nu, S.me, G) < (nu + G - 1) / G) exp_fill(a, smem, 1, 5); }
}

__device__ __forceinline__ void p8_ln2(AP a, unsigned char* lds, int l) {
    const int tid = tid_opaque(), lane = tid & 63, w = tid >> 6;
    const int ntok = (l == 0) ? NTOK : NLAT;
    const float* mod = (const float*)(a->ws + WS_MOD) + (size_t)l * 5 * 6144;
    const float* modn = (const float*)(a->ws + WS_MOD) + (size_t)5 * 6144;
    const float* X1 = (const float*)(a->ws + WS_X1);
    const bf16_t* YS = (const bf16_t*)(a->ws + WS_YS);
    const int* tokS = (const int*)(a->ws + WS_TOKS); const float* tokG = (const float*)(a->ws + WS_TOKG);
    f32x4* Lgb = (f32x4*)lds;
    __syncthreads();
    Lgb[tid] = (tid < 256) ? *(const f32x4*)(a->in[21] + l * 1024 + tid * 4) : *(const f32x4*)(a->in[22] + l * 1024 + (tid - 256) * 4);
    __syncthreads();
    int mrow = -1; f32x4 mg[4], nsh[4], nsc[4];
    const int tstep = gridDim.x * 8;
    int t = blockIdx.x * 8 + w;
    int ns0 = 0, ns1 = 0; float nga = 0.f, ngb = 0.f;
    f32x4 nx[4]; u32x2 nya[4], nyb[4];
    float cga = 0.f, cgb = 0.f;
    if (t < ntok) { const int s0 = tokS[2 * t], s1 = tokS[2 * t + 1]; cga = tokG[2 * t]; cgb = tokG[2 * t + 1];
#pragma unroll
        for (int i = 0; i < 4; ++i) { const int c = 256 * i + 4 * lane; nx[i] = *(const f32x4*)(X1 + (size_t)t * D + c); nya[i] = *(const u32x2*)(YS + (size_t)s0 * D + c); nyb[i] = *(const u32x2*)(YS + (size_t)s1 * D + c); } }
    if (t + tstep < ntok) { ns0 = tokS[2 * (t + tstep)]; ns1 = tokS[2 * (t + tstep) + 1]; nga = tokG[2 * (t + tstep)]; ngb = tokG[2 * (t + tstep) + 1]; }
    for (; t < ntok; t += tstep) {
        const int mr = (t < NLAT) ? (t >> 12) : 4;
        if (mr != mrow) { mrow = mr; const float* m = mod + (size_t)mr * 6144; const float* mn = modn + (size_t)mr * 6144;
#pragma unroll
            for (int i = 0; i < 4; ++i) { const int c = 256 * i + 4 * lane; mg[i] = *(const f32x4*)(m + 5120 + c); if (l == 0) { nsh[i] = *(const f32x4*)(mn + c); nsc[i] = *(const f32x4*)(mn + 1024 + c); } } }
        f32x4 v[4];
#pragma unroll
        for (int i = 0; i < 4; ++i) { const f32x4 gv = mg[i];
            const u32x2 ya = nya[i], yb = nyb[i];
            const float f0 = cga * lo2f(ya.x) + cgb * lo2f(yb.x), f1 = cga * hi2f(ya.x) + cgb * hi2f(yb.x), f2 = cga * lo2f(ya.y) + cgb * lo2f(yb.y), f3 = cga * hi2f(ya.y) + cgb * hi2f(yb.y);
            v[i][0] = RES_ALPHA * nx[i][0] + gv[0] * f0; v[i][1] = RES_ALPHA * nx[i][1] + gv[1] * f1; v[i][2] = RES_ALPHA * nx[i][2] + gv[2] * f2; v[i][3] = RES_ALPHA * nx[i][3] + gv[3] * f3; }
        {   const int tn = t + tstep, tn2 = t + 2 * tstep;
            if (tn < ntok) {
#pragma unroll
                for (int i = 0; i < 4; ++i) { const int c = 256 * i + 4 * lane; nx[i] = *(const f32x4*)(X1 + (size_t)tn * D + c); nya[i] = *(const u32x2*)(YS + (size_t)ns0 * D + c); nyb[i] = *(const u32x2*)(YS + (size_t)ns1 * D + c); }
                cga = nga; cgb = ngb; }
            if (tn2 < ntok) { ns0 = tokS[2 * tn2]; ns1 = tokS[2 * tn2 + 1]; nga = tokG[2 * tn2]; ngb = tokG[2 * tn2 + 1]; } }
        float mean, rstd; ln_stats(v, mean, rstd);
        float* dst = (l == 0) ? (float*)(a->ws + WS_XC) + (size_t)t * D : a->out + (size_t)t * D;
#pragma unroll
        for (int i = 0; i < 4; ++i) { const int c = 256 * i + 4 * lane; const f32x4 gg = Lgb[64 * i + lane], bb = Lgb[256 + 64 * i + lane];
#pragma unroll
            for (int e = 0; e < 4; ++e) v[i][e] = (v[i][e] - mean) * rstd * gg[e] + bb[e];
            *(f32x4*)(dst + c) = v[i]; }
        if (l == 0) {
            ln_stats(v, mean, rstd);
            bf16_t* H = (bf16_t*)(a->ws + WS_H);
#pragma unroll
            for (int i = 0; i < 4; ++i) { const int c = 256 * i + 4 * lane; const f32x4 sh = nsh[i], sc = nsc[i];
                f32x4 o;
#pragma unroll
                for (int e = 0; e < 4; ++e) o[e] = (v[i][e] - mean) * rstd * (1.0f + sc[e]) + sh[e];
                u32x2 pk; pk.x = pack2(o[0], o[1]); pk.y = pack2(o[2], o[3]); *(u32x2*)(H + (size_t)t * D + c) = pk; }
        }
    }
}

constexpr int N_PHASES = 18;
template <int P> __device__ __forceinline__ void run_phase(AP a, unsigned char* smem, LAS unsigned char* lds, int l) {
    asm volatile("" : "+s"(a));
    if (P == 0) p0_prologue(a, smem);
    if (P == 1) p_lnmod0(a);
    if (P == 2) p1_inproj(a, smem, lds, l);
    if (P == 3) p2_mix(a, smem, lds, l);
    if (P == 4) p3_outproj(a, smem, lds, l);
    if (P == 5) p4_ln1_router(a, smem, l);
    if (P == 6) p5_dispatch(a, smem, l);
    if (P == 7) p6_gateup(a, smem, lds, l);
    if (P == 8) p7_down(a, smem, lds, l);
    if (P == 9) p8_ln2(a, smem, l);
}
#if N_LAUNCH_MODE == 1
__global__ void __launch_bounds__(NT, 2) fwd(Args a) {
    extern __shared__ __attribute__((aligned(16))) unsigned char smem[];
    LAS unsigned char* lds = (LAS unsigned char*)smem;
    if (threadIdx.x < 4) ((volatile LAS unsigned*)(lds + MISC_OFF + 768))[threadIdx.x] = 0u;
    __syncthreads();
    XcdBarrier bar = xcd_barrier_post((unsigned*)(a.ws + WS_BAR), (volatile LAS unsigned*)(lds + MISC_OFF + 768));
    AP ap = (AP)__builtin_amdgcn_kernarg_segment_ptr();
#define PROBE(P, l) do { if (PROBE_MASK & (1 << (P))) { for (int _r = 0; _r < 2; ++_r) { xcd_barrier(bar); run_phase<P>(ap, smem, lds, l); } } } while (0)
    run_phase<0>(ap, smem, lds, 0); PROBE(0, 0); xcd_barrier(bar);
    run_phase<1>(ap, smem, lds, 0); PROBE(1, 0); xcd_barrier(bar);
    for (int l = 0; l < 2; ++l) {
        run_phase<2>(ap, smem, lds, l); PROBE(2, l); xcd_barrier(bar);
        run_phase<3>(ap, smem, lds, l); PROBE(3, l); xcd_barrier(bar);
        run_phase<4>(ap, smem, lds, l); PROBE(4, l); xcd_barrier(bar);
        run_phase<5>(ap, smem, lds, l); PROBE(5, l); xcd_barrier(bar);
        run_phase<6>(ap, smem, lds, l); PROBE(6, l); xcd_barrier(bar);
        run_phase<7>(ap, smem, lds, l); PROBE(7, l); xcd_barrier(bar);
        run_phase<8>(ap, smem, lds, l); PROBE(8, l); xcd_barrier(bar);
        run_phase<9>(ap, smem, lds, l); PROBE(9, l); if (l == 0) xcd_barrier(bar);
    }
}
#else
template <int P> __global__ void __launch_bounds__(NT, 2) k_phase(Args a) {
    extern __shared__ __attribute__((aligned(16))) unsigned char smem[];
    LAS unsigned char* lds = (LAS unsigned char*)smem;
    AP ap = (AP)__builtin_amdgcn_kernarg_segment_ptr();
    run_phase<P>(ap, smem, lds, ap->ph_lo);
}
template <int P> static void launch_phase(Args a, int l, int grid, hipStream_t stream) {
    static bool attr = false;
    if (!attr) { (void)hipFuncSetAttribute((const void*)k_phase<P>, hipFuncAttributeMaxDynamicSharedMemorySize, LDS_BYTES); attr = true; }
    a.ph_lo = l; a.ph_hi = P;
    hipLaunchKernelGGL(k_phase<P>, dim3(grid), dim3(NT), LDS_BYTES, stream, a);
}
#endif

extern "C" void kernel_launch(void* const* d_in, const int* in_sizes, int n_in, void* d_out, int out_size, void* d_ws, size_t ws_size, hipStream_t stream) {
    static int grid = 0;
    if (grid == 0) {
        if (n_in != 23 || out_size != NLAT * D || ws_size < WS_END) { fprintf(stderr, "kernel_launch: unexpected shapes (n_in %d, out %d, ws %zu, need %zu)\n", n_in, out_size, ws_size, (size_t)WS_END); grid = -1; return; }
        int dev = 0, cus = 0;
        if (hipGetDevice(&dev) != hipSuccess || hipDeviceGetAttribute(&cus, hipDeviceAttributeMultiprocessorCount, dev) != hipSuccess) { grid = -1; return; }
#if N_LAUNCH_MODE == 1
        int per_cu = 0;
        if (hipFuncSetAttribute((const void*)fwd, hipFuncAttributeMaxDynamicSharedMemorySize, LDS_BYTES) != hipSuccess) { fprintf(stderr, "kernel_launch: hipFuncSetAttribute failed\n"); grid = -1; return; }
        if (hipOccupancyMaxActiveBlocksPerMultiprocessor(&per_cu, (const void*)fwd, NT, LDS_BYTES) != hipSuccess || per_cu < 1) { fprintf(stderr, "kernel_launch: occupancy query says %d\n", per_cu); }
        (void)hipGetLastError();
#endif
        grid = cus; if (grid > MAXG) grid = MAXG;
    }
    if (grid < 0) return;
    (void)hipMemsetAsync((char*)d_ws + WS_BAR, 0, 16384 + 256, stream);
    Args a{};
    for (int i = 0; i < 23; ++i) a.in[i] = (const float*)d_in[i];
    a.out = (float*)d_out; a.ws = (unsigned char*)d_ws;
#if N_LAUNCH_MODE == 1
    a.ph_lo = 0; a.ph_hi = N_PHASES;
    hipLaunchKernelGGL(fwd, dim3(grid), dim3(NT), LDS_BYTES, stream, a);
#else
    launch_phase<0>(a, 0, grid, stream);
    launch_phase<1>(a, 0, grid, stream);
    for (int l = 0; l < 2; ++l) {
        launch_phase<2>(a, l, grid, stream); launch_phase<3>(a, l, grid, stream); launch_phase<4>(a, l, grid, stream); launch_phase<5>(a, l, grid, stream);
        launch_phase<6>(a, l, grid, stream); launch_phase<7>(a, l, grid, stream); launch_phase<8>(a, l, grid, stream); launch_phase<9>(a, l, grid, stream);
    }
#endif
}
```

```cpp
#include <hip/hip_runtime.h>
#include <stdint.h>
#include <stdio.h>

#ifndef PROBE_MASK
#define PROBE_MASK 0
#endif
#ifndef PROBE_FFT_REP
#define PROBE_FFT_REP 1
#endif
#ifndef PROBE_MIX_REP
#define PROBE_MIX_REP 1
#endif
#ifndef PROBE_SGU_REP
#define PROBE_SGU_REP 1
#endif
#ifndef N_LAUNCH_MODE
#define N_LAUNCH_MODE 1
#endif

#define LAS __attribute__((address_space(3)))
typedef unsigned short bf16_t;
typedef short bf16x8 __attribute__((ext_vector_type(8)));
typedef float f32x4 __attribute__((ext_vector_type(4)));
typedef unsigned u32x4 __attribute__((ext_vector_type(4)));
typedef unsigned u32x2 __attribute__((ext_vector_type(2)));
typedef float f32x2 __attribute__((ext_vector_type(2)));
typedef int i32x4 __attribute__((ext_vector_type(4)));

constexpr int D = 1024, NBATCH = 4, SEQ = 4096, CTXL = 256;
constexpr int NLAT = NBATCH * SEQ, NCTX = NBATCH * CTXL, NTOK = NLAT + NCTX;
constexpr int ZC = 1792;
constexpr int NEXP = 32, DEXP = 512;
constexpr int NSLOT = 2 * NTOK + NEXP * 256;
constexpr int NT = 512;
constexpr int MAXG = 512;
constexpr float RES_ALPHA = 1.41421356237309515f;
constexpr int MISC_OFF = 155648;
constexpr int RIDX_OFF = 131072;
constexpr int LDS_BYTES = MISC_OFF + 1024;

constexpr size_t WS_BAR   = 0;
constexpr size_t WS_CNT   = 16384;
constexpr size_t WS_BCNT  = WS_CNT + 256;
constexpr size_t WS_MOD   = WS_BCNT + (size_t)2 * MAXG * 32 * 4;
constexpr size_t WS_ROPE  = WS_MOD + (size_t)2 * 5 * 6144 * 4;
constexpr size_t WS_TOKE  = WS_ROPE + 8192;
constexpr size_t WS_TOKR  = WS_TOKE + (size_t)NTOK * 8;
constexpr size_t WS_TOKS  = WS_TOKR + (size_t)NTOK * 8;
constexpr size_t WS_TOKG  = WS_TOKS + (size_t)NTOK * 8;
constexpr size_t WS_SLOTT = WS_TOKG + (size_t)NTOK * 8;
constexpr size_t WS_WIN   = WS_SLOTT + (size_t)NSLOT * 4;
constexpr size_t WS_WOUT  = WS_WIN + (size_t)2 * ZC * 1024 * 2;
constexpr size_t WS_WSGU  = WS_WOUT + (size_t)2 * 1024 * 1024 * 2;
constexpr size_t WS_DFTC  = WS_WSGU + (size_t)2 * 4 * 128 * 128 * 2;
constexpr size_t WS_WEXP  = WS_DFTC + (size_t)256 * 512 * 2;
constexpr size_t EXPMAT   = (size_t)NEXP * 512 * 1024;
constexpr size_t WEXP_LAYER = 3 * EXPMAT;
constexpr size_t WS_X1    = WS_WEXP + 2 * WEXP_LAYER;
constexpr size_t WS_XC    = WS_X1 + (size_t)NTOK * D * 4;
constexpr size_t WS_H     = WS_XC + (size_t)NTOK * D * 4;
constexpr size_t WS_R     = WS_H + (size_t)NTOK * D * 2;
constexpr size_t WS_Z     = WS_R;
constexpr size_t WS_AT    = WS_Z + (size_t)NTOK * ZC * 2;
constexpr size_t WS_ATC   = WS_AT + (size_t)4 * 256 * 8192 * 2;
constexpr size_t WS_VT    = WS_ATC + (size_t)4 * 256 * 512 * 2;
constexpr size_t WS_VTC   = WS_VT + (size_t)4 * 2 * 64 * 4096 * 2;
constexpr size_t WS_CAT   = WS_VTC + (size_t)4 * 2 * 64 * 256 * 2;
constexpr size_t WS_REND  = WS_CAT + (size_t)NTOK * D * 2;
constexpr size_t WS_Y     = WS_R;
constexpr size_t WS_HID   = WS_R;
constexpr size_t WS_YS    = WS_HID + (size_t)NSLOT * DEXP * 2;
constexpr size_t WS_REND2 = (WS_YS + (size_t)NSLOT * D * 2 > WS_REND) ? WS_YS + (size_t)NSLOT * D * 2 : WS_REND;
constexpr size_t WS_H8    = (WS_REND2 + 255) & ~(size_t)255;
constexpr size_t WS_END   = WS_H8 + (size_t)NTOK * D;
static_assert(WS_Y + (size_t)NTOK * D * 4 <= WS_CAT, "Y must not reach CAT");
static_assert(WS_WIN % 256 == 0 && WS_DFTC % 256 == 0 && WS_WEXP % 256 == 0 && WS_X1 % 256 == 0 && WS_H % 256 == 0 && WS_R % 256 == 0 && WS_AT % 256 == 0 && WS_CAT % 256 == 0 && WS_YS % 256 == 0, "alignment");

struct Args { const float* in[23]; float* out; unsigned char* ws; int ph_lo, ph_hi; };
#define CAS __attribute__((address_space(4)))
typedef const CAS Args* AP;

#define XB_TMO      128
#define XB_XCNT(j)  (256  + 64 * (j))
#define XB_XSUB(j)  (1280 + 64 * (j))
#define XB_XGEN(j)  (2304 + 64 * (j))
#define XB_TOP      3328
#define XB_TOPGEN   3392
#define XCD_BAR_WORDS 3456
#define XB_SPIN_CAP (1u << 18)

__device__ __forceinline__ unsigned xb_ld(unsigned* p)              { return __hip_atomic_load(p, __ATOMIC_RELAXED, __HIP_MEMORY_SCOPE_AGENT); }
__device__ __forceinline__ unsigned xb_add(unsigned* p, unsigned v) { return __hip_atomic_fetch_add(p, v, __ATOMIC_RELAXED, __HIP_MEMORY_SCOPE_AGENT); }
__device__ __forceinline__ unsigned xb_xcc_id() { return (unsigned)__builtin_amdgcn_s_getreg((3 << 11) | 20) & 0xFu; }
#define XB_SPIN(cond, bar) do { unsigned _sp = 0; while (cond) { __builtin_amdgcn_s_sleep(1); \
    if ((++_sp & 255u) == 0u) { if (xb_ld(&(bar)[XB_TMO])) break; if (_sp > XB_SPIN_CAP) { atomicAdd(&(bar)[XB_TMO], 1u); break; } } } } while (0)

struct XcdBarrier { unsigned* bar; unsigned x; volatile LAS unsigned* st; };

__device__ __forceinline__ XcdBarrier xcd_barrier_post(unsigned* bar, volatile LAS unsigned* st) {
    XcdBarrier b; b.bar = bar; b.x = (unsigned)__builtin_amdgcn_readfirstlane((int)xb_xcc_id()); b.st = st;
    if (threadIdx.x == 0) (void)xb_add(&bar[XB_XCNT(b.x)], 1u);
    return b;
}
__device__ __forceinline__ void xcd_barrier_complete(unsigned* bar, unsigned x, unsigned& nloc, unsigned& nx) {
    const unsigned G = gridDim.x * gridDim.y * gridDim.z;
    unsigned sum, cnt, mine, sp = 0u;
    for (;;) {
        sum = 0u; cnt = 0u; mine = 0u;
#pragma unroll
        for (unsigned j = 0; j < 16; ++j) { const unsigned c = xb_ld(&bar[XB_XCNT(j)]); sum += c; cnt += (c > 0u) ? 1u : 0u; mine = (j == x) ? c : mine; }
        if (sum == G) break;
        __builtin_amdgcn_s_sleep(1);
        if ((++sp & 255u) == 0u) { if (xb_ld(&bar[XB_TMO])) break; if (sp > XB_SPIN_CAP) { atomicAdd(&bar[XB_TMO], 1u); break; } }
    }
    nloc = mine > 0u ? mine : 1u; nx = cnt > 0u ? cnt : 1u;
}
__device__ __forceinline__ void xcd_barrier(const XcdBarrier& b) {
    asm volatile("s_waitcnt vmcnt(0)" ::: "memory");
    __syncthreads();
    if (threadIdx.x == 0) {
        unsigned* bar = b.bar;
        unsigned bx = b.x;
        asm volatile("" : "+s"(bar), "+s"(bx));
        __builtin_amdgcn_s_waitcnt(0);
        unsigned nloc = b.st[0], nx = b.st[1];
        if (nloc == 0u) { xcd_barrier_complete(bar, bx, nloc, nx); b.st[0] = nloc; b.st[1] = nx; }
        const unsigned old = xb_add(&bar[XB_XSUB(bx)], 1u);
        const unsigned gen = old / nloc;
        if (old + 1u == (gen + 1u) * nloc) {
            __builtin_amdgcn_fence(__ATOMIC_RELEASE, "agent");
            asm volatile("s_waitcnt vmcnt(0)" ::: "memory");
            const unsigned og = xb_add(&bar[XB_TOP], 1u);
            const unsigned tg = og / nx;
            if (og + 1u == (tg + 1u) * nx) xb_add(&bar[XB_TOPGEN], 1u);
            else XB_SPIN(xb_ld(&bar[XB_TOPGEN]) == tg, bar);
            __builtin_amdgcn_fence(__ATOMIC_ACQUIRE, "agent");
            xb_add(&bar[XB_XGEN(bx)], 1u);
            asm volatile("s_waitcnt vmcnt(0)" ::: "memory");
        } else {
            XB_SPIN(xb_ld(&bar[XB_XGEN(bx)]) == gen, bar);
            __builtin_amdgcn_fence(__ATOMIC_ACQUIRE, "agent");
            asm volatile("s_waitcnt vmcnt(0)" ::: "memory");
        }
    }
    __syncthreads();
}

__device__ __forceinline__ int tid_opaque() { int t = threadIdx.x; asm volatile("" : "+v"(t)); return t; }
__device__ __forceinline__ float bf2f(bf16_t v) { return __uint_as_float(((unsigned)v) << 16); }
__device__ __forceinline__ bf16_t f2bf(float f) { return __builtin_bit_cast(unsigned short, (__bf16)f); }
typedef __bf16 hwbf16x2 __attribute__((ext_vector_type(2)));
__device__ __forceinline__ unsigned pack2(float a, float b) { return __builtin_bit_cast(unsigned, __builtin_convertvector((f32x2){a, b}, hwbf16x2)); }
__device__ __forceinline__ unsigned pack4_fp8(float a, float b, float c, float d) {
    a = __builtin_amdgcn_fmed3f(a, -448.f, 448.f); b = __builtin_amdgcn_fmed3f(b, -448.f, 448.f); c = __builtin_amdgcn_fmed3f(c, -448.f, 448.f); d = __builtin_amdgcn_fmed3f(d, -448.f, 448.f);
    int p = __builtin_amdgcn_cvt_pk_fp8_f32(a, b, 0, false); p = __builtin_amdgcn_cvt_pk_fp8_f32(c, d, p, true); return (unsigned)p; }
__device__ __forceinline__ float lo2f(unsigned w) { return __uint_as_float(w << 16); }
__device__ __forceinline__ float hi2f(unsigned w) { return __uint_as_float(w & 0xffff0000u); }
template <int CTRL> __device__ __forceinline__ float dpp_mov(float v) { return __builtin_bit_cast(float, __builtin_amdgcn_update_dpp(0, __builtin_bit_cast(int, v), CTRL, 0xf, 0xf, true)); }
__device__ __forceinline__ float row_sum16(float v) {
    v += dpp_mov<0xB1>(v);
    v += dpp_mov<0x4E>(v);
    v += dpp_mov<0x141>(v);
    v += dpp_mov<0x140>(v);
    return v;
}
__device__ __forceinline__ float row_max16(float v) {
    v = fmaxf(v, dpp_mov<0xB1>(v)); v = fmaxf(v, dpp_mov<0x4E>(v)); v = fmaxf(v, dpp_mov<0x141>(v)); v = fmaxf(v, dpp_mov<0x140>(v));
    return v;
}
__device__ __forceinline__ float wave_sum(float v) {
    v = row_sum16(v);
    const int iv = __builtin_bit_cast(int, v);
    const float a0 = __builtin_bit_cast(float, __builtin_amdgcn_readlane(iv, 0)), a1 = __builtin_bit_cast(float, __builtin_amdgcn_readlane(iv, 16));
    const float a2 = __builtin_bit_cast(float, __builtin_amdgcn_readlane(iv, 32)), a3 = __builtin_bit_cast(float, __builtin_amdgcn_readlane(iv, 48));
    return (a0 + a1) + (a2 + a3);
}
__device__ __forceinline__ float gelu_erf(float v) {
    const float t = __builtin_amdgcn_rcpf(fabsf(v) * 0.2316418882f + 1.0f);
    float q = t * 0.5307027145f + (-0.7265760135f); q = q * t + 0.7107068705f; q = q * t + (-0.142248368f); q = q * t + 0.127414796f; q = q * t;
    const float m = v * (q * __builtin_amdgcn_exp2f((v * v) * (-0.72134752044f)));
    return v < 0.f ? m : v - m;
}
__device__ __forceinline__ float silu_f(float x) { return x / (1.0f + __expf(-x)); }

__device__ __forceinline__ void ln_stats(const f32x4 (&v)[4], float& mean, float& rstd) {
    float s = 0.f;
#pragma unroll
    for (int i = 0; i < 4; ++i) s += (v[i][0] + v[i][1]) + (v[i][2] + v[i][3]);
    s = wave_sum(s); mean = s * (1.0f / 1024.0f);
    float q = 0.f;
#pragma unroll
    for (int i = 0; i < 4; ++i)
#pragma unroll
        for (int e = 0; e < 4; ++e) { const float d = v[i][e] - mean; q += d * d; }
    q = wave_sum(q); rstd = 1.0f / sqrtf(q * (1.0f / 1024.0f) + 1e-6f);
}

template <int BN> struct MfmaLayout {
    static constexpr int FG = BN / 128, NI = 4, NJ = 2 * FG;
    static constexpr bool PAIR8 = false;
    int rbase, cbase;
    __device__ __forceinline__ int row(int i) const { return rbase + 16 * i; }
    __device__ __forceinline__ int col(int jj) const { return (jj / FG) * (BN / 2) + (jj % FG) * 16 + cbase; }
};

__device__ __forceinline__ void glds16(const bf16_t* g, LAS unsigned char* l) {
    __builtin_amdgcn_global_load_lds((const unsigned*)g, (LAS unsigned*)l, 16, 0, 0);
}

template <int BN, bool GATHER, class Epi>
__device__ __forceinline__ void gemm_tile(LAS unsigned char* lds, const bf16_t* A, int lda, const int* rowidx, int valid_rows,
                                          const bf16_t* B0, const bf16_t* B1, int ldb, int K, const Epi& epi) {
    constexpr int A_B = 16384, B_B = BN * 128, STAGE = A_B + B_B, NBL = BN / 64;
    const int tid = tid_opaque(), lane = tid & 63, wid = __builtin_amdgcn_readfirstlane(tid >> 6);
    const bf16_t* ap[2]; const bf16_t* bp[NBL];
#pragma unroll
    for (int i = 0; i < 2; ++i) {
        const int P = i * 512 + tid, row = P >> 3, c = (P & 7) ^ ((row >> 1) & 7);
        size_t ro;
        if (GATHER) ro = (size_t)(row < valid_rows ? rowidx[row] : 0) * (size_t)lda; else ro = (size_t)row * (size_t)lda;
        ap[i] = A + ro + c * 8;
    }
#pragma unroll
    for (int i = 0; i < NBL; ++i) {
        const int P = i * 512 + tid, row = P >> 3, c = (P & 7) ^ ((row >> 1) & 7);
        const bf16_t* base = (row < BN / 2) ? (B0 + (size_t)row * ldb) : (B1 + (size_t)(row - BN / 2) * ldb);
        bp[i] = base + c * 8;
    }
    const int nk = K / 64;
#define GT_STAGE(buf, k0) do { \
        _Pragma("unroll") for (int _i = 0; _i < 2; ++_i) glds16(ap[_i] + (k0), lds + (buf) * STAGE + _i * 8192 + wid * 1024); \
        _Pragma("unroll") for (int _i = 0; _i < NBL; ++_i) glds16(bp[_i] + (k0), lds + (buf) * STAGE + A_B + _i * 8192 + wid * 1024); } while (0)

    typedef MfmaLayout<BN> Lay;
    constexpr int FG = Lay::FG;
    const int fr = lane & 15, g = lane >> 4, wr = wid >> 2, wc = wid & 3;
    Lay lay; lay.rbase = wr * 64 + fr; lay.cbase = wc * 16 * FG + 4 * g;
    f32x4 acc[Lay::NI][Lay::NJ];
#pragma unroll
    for (int i = 0; i < Lay::NI; ++i)
#pragma unroll
        for (int j = 0; j < Lay::NJ; ++j) acc[i][j] = (f32x4){0.f, 0.f, 0.f, 0.f};
    int aoff[4], boff[Lay::NJ];
#pragma unroll
    for (int m = 0; m < 4; ++m) { const int row = wr * 64 + m * 16 + fr; aoff[m] = row * 128 + ((g ^ ((row >> 1) & 7)) << 4); }
#pragma unroll
    for (int jj = 0; jj < Lay::NJ; ++jj) { const int row = (jj / FG) * (BN / 2) + wc * 16 * FG + (jj % FG) * 16 + fr; boff[jj] = A_B + row * 128 + ((g ^ ((row >> 1) & 7)) << 4); }
    GT_STAGE(0, 0);
    asm volatile("s_waitcnt vmcnt(0)" ::: "memory"); __syncthreads();
    for (int kt = 0; kt < nk; ++kt) {
        if (kt + 1 < nk) GT_STAGE((kt + 1) & 1, (kt + 1) * 64);
        const LAS unsigned char* sa = lds + (kt & 1) * STAGE;
#pragma unroll
        for (int ks = 0; ks < 2; ++ks) {
            bf16x8 af[4], bfv[Lay::NJ];
#pragma unroll
            for (int m = 0; m < 4; ++m) af[m] = *(const LAS bf16x8*)(sa + (aoff[m] ^ (ks << 6)));
#pragma unroll
            for (int jj = 0; jj < Lay::NJ; ++jj) bfv[jj] = *(const LAS bf16x8*)(sa + (boff[jj] ^ (ks << 6)));
#pragma unroll
            for (int m = 0; m < 4; ++m)
#pragma unroll
                for (int jj = 0; jj < Lay::NJ; ++jj) acc[m][jj] = __builtin_amdgcn_mfma_f32_16x16x32_bf16(bfv[jj], af[m], acc[m][jj], 0, 0, 0);
        }
        asm volatile("s_waitcnt vmcnt(0)" ::: "memory"); __syncthreads();
    }
    epi.run(acc, lay);
#undef GT_STAGE
}

namespace g256 {
constexpr int BK = 64, HALF = 128, HTB = HALF * BK * 2, STAGE_BYTES = 8 * HTB;
__device__ __forceinline__ int lds_byte(int r, int c) { const int st = (r >> 4) * 2 + (c >> 5), rr = r & 15, cc = c & 31, ob = rr * 64 + cc * 2; return st * 1024 + (ob ^ (((ob >> 9) & 1) << 5)); }
__device__ __forceinline__ int perm32(int rho) { const int n = rho >> 4, i = rho & 15; return 8 * (i >> 2) + 4 * n + (i & 3); }
__device__ __forceinline__ void stage_rc(int b, int& R, int& C) { const int st = b / 1024, sb = b % 1024, swz = sb ^ (((sb >> 9) & 1) << 5); R = (st >> 1) * 16 + swz / 64; C = (st & 1) * 32 + (swz % 64) / 2; }
struct Lay {
    static constexpr int NI = 8, NJ = 4;
    static constexpr bool PAIR8 = true;
    int rbase, cbase;
    __device__ __forceinline__ int row(int i) const { return (i >> 2) * 128 + (i & 3) * 16 + rbase; }
    __device__ __forceinline__ int col(int j) const { return (j >> 1) * 128 + (j & 1) * 4 + cbase; }
};
template <class Epi> struct Unit { const bf16_t* A; const bf16_t* B0; const bf16_t* B1; const LAS int* ridx; int valid; Epi epi; };

template <class Sched>
__device__ __forceinline__ void gemm_phase(LAS unsigned char* lds, const int K, const Sched& S) {
    typedef typename Sched::Epi Epi;
    const int tid = tid_opaque(), wid = __builtin_amdgcn_readfirstlane(tid >> 6), lane = tid & 63, wr = wid >> 2, wc = wid & 3, fr = lane & 15, fq = lane >> 4;
    int nt = K / BK; asm volatile("" : "+s"(nt));
    int sR[2], sC[2];
#pragma unroll
    for (int i = 0; i < 2; ++i) stage_rc(tid * 16 + i * 8192, sR[i], sC[i]);
    unsigned voffB[2];
#pragma unroll
    for (int i = 0; i < 2; ++i) voffB[i] = (unsigned)(((sR[i] & ~31) + perm32(sR[i] & 31)) * K + sC[i]) * 2u;
    const size_t kstep = (size_t)(BK * 2);
    const unsigned ldsw = (unsigned)wid * 1024u;
    const int aoff = lds_byte(wr * 64 + fr, fq * 8), boff = lds_byte(wc * 32 + fr, fq * 8);
#define G2_SA(b, h) (((b) * 2 + (h)) * HTB)
#define G2_SB(b, h) ((4 + (b) * 2 + (h)) * HTB)
#define G2_STAGE(bufoff, gbase, v0, v1) do { \
        __builtin_amdgcn_global_load_lds((const unsigned*)((const char*)(gbase) + (v0)), (LAS unsigned*)(lds + (bufoff) + ldsw), 16, 0, 0); \
        __builtin_amdgcn_global_load_lds((const unsigned*)((const char*)(gbase) + (v1)), (LAS unsigned*)(lds + (bufoff) + ldsw + 8192), 16, 0, 0); } while (0)
#define G2_LDA(dst, b, h) do { _Pragma("unroll") for (int m = 0; m < 4; ++m) _Pragma("unroll") for (int k = 0; k < 2; ++k) dst[m][k] = *(const LAS bf16x8*)(lds + G2_SA(b, h) + aoff + m * 2048 + k * 1024); } while (0)
#define G2_LDB(dst, b, h) do { _Pragma("unroll") for (int n = 0; n < 2; ++n) _Pragma("unroll") for (int k = 0; k < 2; ++k) dst[n][k] = *(const LAS bf16x8*)(lds + G2_SB(b, h) + boff + n * 2048 + k * 1024); } while (0)
#define G2_MMA(ai, bj, At, Bt) do { __builtin_amdgcn_s_setprio(1); _Pragma("unroll") for (int m = 0; m < 4; ++m) _Pragma("unroll") for (int n = 0; n < 2; ++n) _Pragma("unroll") for (int k = 0; k < 2; ++k) { \
        if (Sched::FP8) { const i32x4 _b = __builtin_bit_cast(i32x4, Bt[n][k]), _a = __builtin_bit_cast(i32x4, At[m][k]);     \
            acc[(ai) * 4 + m][(bj) * 2 + n] = __builtin_amdgcn_mfma_f32_16x16x32_fp8_fp8(((long)(unsigned)_b[1] << 32) | (unsigned)_b[0], ((long)(unsigned)_a[1] << 32) | (unsigned)_a[0], acc[(ai) * 4 + m][(bj) * 2 + n], 0, 0, 0); \
            acc[(ai) * 4 + m][(bj) * 2 + n] = __builtin_amdgcn_mfma_f32_16x16x32_fp8_fp8(((long)(unsigned)_b[3] << 32) | (unsigned)_b[2], ((long)(unsigned)_a[3] << 32) | (unsigned)_a[2], acc[(ai) * 4 + m][(bj) * 2 + n], 0, 0, 0); } \
        else acc[(ai) * 4 + m][(bj) * 2 + n] = __builtin_amdgcn_mfma_f32_16x16x32_bf16(Bt[n][k], At[m][k], acc[(ai) * 4 + m][(bj) * 2 + n], 0, 0, 0); } __builtin_amdgcn_s_setprio(0); } while (0)
#define G2_WAIT_V(n) asm volatile("s_waitcnt vmcnt(" #n ")" ::: "memory")
#define G2_WAIT_L(n) asm volatile("s_waitcnt lgkmcnt(" #n ")" ::: "memory")
#define G2_BAR __builtin_amdgcn_s_barrier()
#define G2_SCHED __builtin_amdgcn_sched_barrier(0)
#define G2_VOFFA(U, dst) do { _Pragma("unroll") for (int _h = 0; _h < 2; ++_h) _Pragma("unroll") for (int _i = 0; _i < 2; ++_i) { const int _row = _h * 128 + sR[_i]; \
        int _tok = _row; if (Sched::GATHER) _tok = (_row < (U).valid) ? (U).ridx[_row] : 0; dst[_h][_i] = (unsigned)(_tok * K + sC[_i]) * 2u; } } while (0)
    Unit<Epi> cur, nxt; int ui = 0;
    if (!S.get(0, cur)) return;
    f32x4 acc[8][4];
#pragma unroll
    for (int i = 0; i < 8; ++i)
#pragma unroll
        for (int j = 0; j < 4; ++j) acc[i][j] = (f32x4){0.f, 0.f, 0.f, 0.f};
    bf16x8 At[4][2], B0[2][2], B1[2][2];
    unsigned cvA[2][2], nvA[2][2];
    G2_VOFFA(cur, cvA);
    const char* cA = (const char*)cur.A; const char* cB0 = (const char*)cur.B0; const char* cB1 = (const char*)cur.B1;
    G2_STAGE(G2_SB(0, 0), cB0, voffB[0], voffB[1]); G2_STAGE(G2_SB(0, 1), cB1, voffB[0], voffB[1]); G2_STAGE(G2_SA(0, 0), cA, cvA[0][0], cvA[0][1]); G2_STAGE(G2_SA(0, 1), cA, cvA[1][0], cvA[1][1]);
    if (wr == 1) G2_BAR;
    G2_WAIT_V(2); G2_BAR;
    G2_STAGE(G2_SB(1, 0), cB0 + kstep, voffB[0], voffB[1]); G2_STAGE(G2_SA(1, 0), cA + kstep, cvA[0][0], cvA[0][1]); G2_STAGE(G2_SB(1, 1), cB1 + kstep, voffB[0], voffB[1]);
    G2_WAIT_V(6); G2_BAR;
    for (;;) {
        const bool has_next = S.get(ui + 1, nxt);
        if (Sched::GATHER) {
            if (has_next) { G2_VOFFA(nxt, nvA); }
            else {
#pragma unroll
                for (int h = 0; h < 2; ++h) { nvA[h][0] = cvA[h][0]; nvA[h][1] = cvA[h][1]; } }
        }
        const char* nA = has_next ? (const char*)nxt.A : cA; const char* nB0 = has_next ? (const char*)nxt.B0 : cB0; const char* nB1 = has_next ? (const char*)nxt.B1 : cB1;
#pragma unroll 1
        for (int t = 0; t < nt; t += 2) {
            const bool last = (t == nt - 2);
            const char* a1 = cA + (size_t)(t + 1) * kstep;
            const char* a2 = last ? nA : cA + (size_t)(t + 2) * kstep;
            const char* b20 = last ? nB0 : cB0 + (size_t)(t + 2) * kstep; const char* b21 = last ? nB1 : cB1 + (size_t)(t + 2) * kstep;
#define x00 ((Sched::GATHER && last) ? nvA[0][0] : cvA[0][0])
#define x01 ((Sched::GATHER && last) ? nvA[0][1] : cvA[0][1])
#define x10 ((Sched::GATHER && last) ? nvA[1][0] : cvA[1][0])
#define x11 ((Sched::GATHER && last) ? nvA[1][1] : cvA[1][1])
            G2_LDB(B0, 0, 0); G2_LDB(B1, 0, 1); G2_SCHED; G2_LDA(At, 0, 0); G2_STAGE(G2_SA(1, 1), a1, cvA[1][0], cvA[1][1]);
            G2_WAIT_V(8); G2_WAIT_L(0); G2_BAR; G2_MMA(0, 0, At, B0); G2_MMA(0, 1, At, B1); G2_BAR; G2_SCHED;
            G2_LDA(At, 0, 1); G2_STAGE(G2_SB(0, 0), b20, voffB[0], voffB[1]); G2_STAGE(G2_SB(0, 1), b21, voffB[0], voffB[1]); G2_STAGE(G2_SA(0, 0), a2, x00, x01);
            G2_WAIT_V(8); G2_WAIT_L(0); G2_BAR; G2_MMA(1, 0, At, B0); G2_MMA(1, 1, At, B1); G2_BAR; G2_SCHED;
            G2_LDB(B0, 1, 0); G2_LDB(B1, 1, 1); G2_SCHED; G2_LDA(At, 1, 0); G2_STAGE(G2_SA(0, 1), a2, x10, x11);
            G2_WAIT_V(8); G2_WAIT_L(0); G2_BAR; G2_MMA(0, 0, At, B0); G2_MMA(0, 1, At, B1); G2_BAR; G2_SCHED;
            G2_LDA(At, 1, 1); G2_STAGE(G2_SB(1, 0), b20 + kstep, voffB[0], voffB[1]); G2_STAGE(G2_SB(1, 1), b21 + kstep, voffB[0], voffB[1]); G2_STAGE(G2_SA(1, 0), a2 + kstep, x00, x01);
            G2_WAIT_V(8); G2_WAIT_L(0); G2_BAR; G2_MMA(1, 0, At, B0); G2_MMA(1, 1, At, B1); G2_BAR; G2_SCHED;
        }
        if (wr == 0) G2_BAR;
        { Lay lay; int rbv = wr * 64 + fr, cbv = wc * 32 + 8 * fq; asm volatile("" : "+v"(rbv), "+v"(cbv));
          lay.rbase = rbv; lay.cbase = cbv; cur.epi.run(acc, lay); }
        if (!has_next) break;
#pragma unroll
        for (int i = 0; i < 8; ++i)
#pragma unroll
            for (int j = 0; j < 4; ++j) acc[i][j] = (f32x4){0.f, 0.f, 0.f, 0.f};
        cur = nxt; cA = nA; cB0 = nB0; cB1 = nB1; ++ui;
        if (wr == 1) G2_BAR;
        if (Sched::GATHER) {
#pragma unroll
            for (int h = 0; h < 2; ++h) { cvA[h][0] = nvA[h][0]; cvA[h][1] = nvA[h][1]; } }
    }
#undef x00
#undef x01
#undef x10
#undef x11
    G2_WAIT_V(0);
    G2_BAR;
#undef G2_SA
#undef G2_SB
#undef G2_STAGE
#undef G2_LDA
#undef G2_LDB
#undef G2_MMA
#undef G2_WAIT_V
#undef G2_WAIT_L
#undef G2_BAR
#undef G2_SCHED
#undef G2_VOFFA
}
}

struct EpiF32 {
    float* C; int ld;
    template <class L> __device__ __forceinline__ void run(const f32x4 (&acc)[L::NI][L::NJ], const L& lay) const {
#pragma unroll
        for (int i = 0; i < L::NI; ++i)
#pragma unroll
            for (int j = 0; j < L::NJ; ++j) *(f32x4*)(C + (size_t)lay.row(i) * ld + lay.col(j)) = acc[i][j];
    }
};
struct EpiBf16 {
    bf16_t* C; int ld; float scale;
    template <class L> __device__ __forceinline__ void run(const f32x4 (&acc)[L::NI][L::NJ], const L& lay) const {
#pragma unroll
        for (int i = 0; i < L::NI; ++i) {
            if (L::PAIR8) {
#pragma unroll
                for (int j = 0; j < L::NJ; j += 2) { const f32x4 p = acc[i][j] * scale, q = acc[i][j + 1] * scale; u32x4 w; w.x = pack2(p[0], p[1]); w.y = pack2(p[2], p[3]); w.z = pack2(q[0], q[1]); w.w = pack2(q[2], q[3]);
                    *(u32x4*)(C + (size_t)lay.row(i) * ld + lay.col(j)) = w; }
            } else {
#pragma unroll
                for (int j = 0; j < L::NJ; ++j) { const f32x4 p = acc[i][j] * scale; u32x2 w; w.x = pack2(p[0], p[1]); w.y = pack2(p[2], p[3]);
                    *(u32x2*)(C + (size_t)lay.row(i) * ld + lay.col(j)) = w; }
            }
        }
    }
};
struct EpiGateUp8 {
    unsigned char* C; int ld;
    template <class L> __device__ __forceinline__ void run(const f32x4 (&acc)[L::NI][L::NJ], const L& lay) const {
        static_assert(L::PAIR8 && L::NJ == 4, "written for the paired-column 256x256 layout");
#pragma unroll
        for (int i = 0; i < L::NI; ++i) {
            const f32x4 g0 = acc[i][0] * (1.0f / 32.0f), g1 = acc[i][1] * (1.0f / 32.0f), u0 = acc[i][2] * (1.0f / 32.0f), u1 = acc[i][3] * (1.0f / 32.0f);
            u32x2 w; w.x = pack4_fp8(silu_f(g0[0]) * u0[0], silu_f(g0[1]) * u0[1], silu_f(g0[2]) * u0[2], silu_f(g0[3]) * u0[3]);
            w.y = pack4_fp8(silu_f(g1[0]) * u1[0], silu_f(g1[1]) * u1[1], silu_f(g1[2]) * u1[2], silu_f(g1[3]) * u1[3]);
            *(u32x2*)(C + (size_t)lay.row(i) * ld + lay.col(0)) = w;
        }
    }
};
struct EpiGateUp {
    bf16_t* C; int ld;
    template <class L> __device__ __forceinline__ void run(const f32x4 (&acc)[L::NI][L::NJ], const L& lay) const {
#pragma unroll
        for (int i = 0; i < L::NI; ++i) {
            if (L::PAIR8 && L::NJ == 4) {
                const f32x4 g0 = acc[i][0], g1 = acc[i][1], u0 = acc[i][2], u1 = acc[i][3];
                u32x4 w; w.x = pack2(silu_f(g0[0]) * u0[0], silu_f(g0[1]) * u0[1]); w.y = pack2(silu_f(g0[2]) * u0[2], silu_f(g0[3]) * u0[3]);
                w.z = pack2(silu_f(g1[0]) * u1[0], silu_f(g1[1]) * u1[1]); w.w = pack2(silu_f(g1[2]) * u1[2], silu_f(g1[3]) * u1[3]);
                *(u32x4*)(C + (size_t)lay.row(i) * ld + lay.col(0)) = w;
            } else {
#pragma unroll
                for (int j = 0; j < L::NJ / 2; ++j) { const f32x4 gt = acc[i][j], up = acc[i][j + L::NJ / 2];
                    u32x2 w; w.x = pack2(silu_f(gt[0]) * up[0], silu_f(gt[1]) * up[1]); w.y = pack2(silu_f(gt[2]) * up[2], silu_f(gt[3]) * up[3]);
                    *(u32x2*)(C + (size_t)lay.row(i) * ld + lay.col(j)) = w; }
            }
        }
    }
};
struct EpiInProj {
    bf16_t* Zt;
    bf16_t* tF;
    bf16_t* tV;
    int n0, pos0, n;
    template <class L> __device__ __forceinline__ void run(const f32x4 (&acc)[L::NI][L::NJ], const L& lay) const {
        static_assert(L::PAIR8, "written for the paired-column layout");
#pragma unroll
        for (int i = 0; i < L::NI; ++i)
#pragma unroll
            for (int j = 0; j < L::NJ; j += 2) {
                const int r = lay.row(i), cl = lay.col(j), c = n0 + cl;
                const f32x4 v0 = acc[i][j], v1 = acc[i][j + 1];
                if (c < 512) {
                    const int part = c >> 8, ch = c & 255;
#pragma unroll
                    for (int e = 0; e < 4; ++e) { tF[((size_t)(ch + e) * 2 + part) * n + pos0 + r] = f2bf(v0[e]); tF[((size_t)(ch + 4 + e) * 2 + part) * n + pos0 + r] = f2bf(v1[e]); }
                } else {
                    u32x4 w; w.x = pack2(v0[0], v0[1]); w.y = pack2(v0[2], v0[3]); w.z = pack2(v1[0], v1[1]); w.w = pack2(v1[2], v1[3]);
                    *(u32x4*)(Zt + (size_t)r * ZC + cl) = w;
                    if (c >= 896 && c < 1024) {
#pragma unroll
                        for (int e = 0; e < 4; ++e) { tV[(size_t)(c - 896 + e) * n + pos0 + r] = f2bf(v0[e]); tV[(size_t)(c - 896 + 4 + e) * n + pos0 + r] = f2bf(v1[e]); }
                    }
                }
            }
    }
};

constexpr int U_ADA = 192, U_WIN = 2 * 16 * 28, U_WOUT = 2 * 16 * 16, U_SGU = 32, U_DFT = 256, U_ROPE = 1, U_EXP = 3 * 32 * 32;
constexpr int LDS_SIL = 0, LDS_RED = 20480, LDS_TILE = 32768, LDS_T64 = 49408, LDS_CTAB = 50176;

__device__ __forceinline__ void ada_unit(AP a, unsigned char* lds, int u) {
    float* sil = (float*)(lds + LDS_SIL); float* red = (float*)(lds + LDS_RED);
    const int tid = tid_opaque(), lane = tid & 63, w = tid >> 6;
    const int l = u / 96, cg = u % 96;
    for (int i = tid; i < 5120; i += NT) { const int r = i >> 10, k = i & 1023; const float v = (r < 4) ? a->in[1][r * 1024 + k] : a->in[3][k]; sil[i] = v / (1.0f + expf(-v)); }
    __syncthreads();
    const float* W = a->in[4] + (size_t)l * 1024 * 6144 + cg * 64 + lane;
    float acc[5] = {0.f, 0.f, 0.f, 0.f, 0.f};
#pragma unroll 32
    for (int k = w * 128; k < w * 128 + 128; ++k) { const float wv = W[(size_t)k * 6144];
#pragma unroll
        for (int r = 0; r < 5; ++r) acc[r] += sil[r * 1024 + k] * wv; }
#pragma unroll
    for (int r = 0; r < 5; ++r) red[(w * 5 + r) * 64 + lane] = acc[r];
    __syncthreads();
    if (tid < 320) { const int r = tid >> 6; float s = 0.f;
#pragma unroll
        for (int ww = 0; ww < 8; ++ww) s += red[(ww * 5 + r) * 64 + lane];
        const int j = cg * 64 + lane; ((float*)(a->ws + WS_MOD))[(size_t)(l * 5 + r) * 6144 + j] = s + a->in[5][l * 6144 + j]; }
    __syncthreads();
}

__device__ __forceinline__ void tile_store_T(const float* tile, bf16_t* dst, int ldd) {
    const int tid = tid_opaque(), n = tid >> 3, kc = tid & 7;
    u32x4 w;
    w.x = pack2(tile[(kc * 8 + 0) * 65 + n], tile[(kc * 8 + 1) * 65 + n]); w.y = pack2(tile[(kc * 8 + 2) * 65 + n], tile[(kc * 8 + 3) * 65 + n]);
    w.z = pack2(tile[(kc * 8 + 4) * 65 + n], tile[(kc * 8 + 5) * 65 + n]); w.w = pack2(tile[(kc * 8 + 6) * 65 + n], tile[(kc * 8 + 7) * 65 + n]);
    *(u32x4*)(dst + (size_t)n * ldd + kc * 8) = w;
}
__device__ __forceinline__ void tile_load(float* tile, const float* src, int lds_) {
    const int tid = tid_opaque();
#pragma unroll
    for (int i = 0; i < 2; ++i) { const int row = (tid >> 4) + 32 * i, c4 = (tid & 15) * 4; const f32x4 v = *(const f32x4*)(src + (size_t)row * lds_ + c4);
        tile[row * 65 + c4 + 0] = v[0]; tile[row * 65 + c4 + 1] = v[1]; tile[row * 65 + c4 + 2] = v[2]; tile[row * 65 + c4 + 3] = v[3]; }
}

__device__ __forceinline__ void mm64_f32(const float* tA, int lda, const float* tB, int ldb, int K, float* out) {
    const int tid = tid_opaque(), lane = tid & 63, w = tid >> 6, fr = lane & 15, g = lane >> 4, mi = w >> 1, nj = 2 * (w & 1);
    f32x4 acc0 = (f32x4){0.f, 0.f, 0.f, 0.f}, acc1 = (f32x4){0.f, 0.f, 0.f, 0.f};
    const float* pa = tA + (16 * mi + fr) * lda + g; const float* pb = tB + g * ldb + 16 * nj + fr;
#pragma unroll 4
    for (int k0 = 0; k0 < K; k0 += 4) { const float av = pa[k0], b0 = pb[k0 * ldb], b1 = pb[k0 * ldb + 16];
        acc0 = __builtin_amdgcn_mfma_f32_16x16x4f32(av, b0, acc0, 0, 0, 0); acc1 = __builtin_amdgcn_mfma_f32_16x16x4f32(av, b1, acc1, 0, 0, 0); }
#pragma unroll
    for (int r = 0; r < 4; ++r) { out[(16 * mi + 4 * g + r) * 65 + 16 * nj + fr] = acc0[r]; out[(16 * mi + 4 * g + r) * 65 + 16 * nj + 16 + fr] = acc1[r]; }
}

__device__ __forceinline__ void win_unit(AP a, unsigned char* lds, int u) {
    float* tile = (float*)(lds + LDS_TILE); float* T = (float*)(lds + LDS_T64);
    const int tid = tid_opaque();
    const int l = u / 448, r = u % 448, kb = r / 28, nb = r % 28;
    const float* Win = a->in[6] + (size_t)l * 1024 * 1536;
    const int srccol = (nb >= 8) ? nb * 64 - 256 : (nb & 3) * 64;
    tile_load(tile, Win + (size_t)(kb * 64) * 1536 + srccol, 1536);
    if (nb < 8 && tid < 64) { T[tid] = cospif((float)tid / 32.0f); T[64 + tid] = sinpif((float)tid / 32.0f); }
    __syncthreads();
    bf16_t* dst = (bf16_t*)(a->ws + WS_WIN) + ((size_t)l * ZC + nb * 64) * 1024 + kb * 64;
    if (nb >= 8) tile_store_T(tile, dst, 1024);
    else {
        const int part = nb >> 2;
        float* Tm = (float*)(lds + 65536); float* out = (float*)(lds + 98304);
        for (int i = tid; i < 4096; i += NT) { const int c = i >> 6, cp = i & 63; const float t = T[part * 64 + ((c * cp) & 63)]; Tm[i] = (part ? -t : t) * 0.125f; }
        __syncthreads();
        mm64_f32(tile, 65, Tm, 64, 64, out);
        __syncthreads();
        tile_store_T(out, dst, 1024);
    }
    __syncthreads();
}

__device__ __forceinline__ void wout_unit(AP a, unsigned char* lds, int u) {
    float* tile = (float*)(lds + LDS_TILE);
    __syncthreads();
    const int tid = tid_opaque();
    const int l = u / 256, r = u % 256, kb = r / 16, nb = r % 16;
    const float* Wo = a->in[13] + (size_t)l * 1024 * 1024;
    const int n = tid & 63, kq = __builtin_amdgcn_readfirstlane(tid >> 6);
    if (kb < 4) {
        float* tA = (float*)lds; float* tB = (float*)(lds + 65536);
        const float* wf = a->in[7] + (size_t)l * 256 * 256 + (size_t)(kb * 64) * 256;
        __syncthreads();
        f32x4 va[8], vb[8];
#pragma unroll
        for (int i = 0; i < 8; ++i) { const int q = tid + 512 * i; va[i] = *(const f32x4*)(wf + (size_t)q * 4); vb[i] = *(const f32x4*)(Wo + (size_t)(q >> 4) * 1024 + nb * 64 + (q & 15) * 4); }
#pragma unroll
        for (int i = 0; i < 8; ++i) { const int q = tid + 512 * i; *(f32x4*)(tA + (size_t)q * 4) = va[i]; *(f32x4*)(tB + (size_t)q * 4) = vb[i]; }
        __syncthreads();
        tile = (float*)(lds + 133120);
        mm64_f32(tA, 256, tB, 64, 256, tile);
    } else if (kb >= 8 && kb < 12) {
        const int g = kb - 8;
        float* tA = (float*)lds; float* tB = (float*)(lds + 65536);
        const float* wp = a->in[9] + (size_t)(l * 4 + g) * 64 * 64;
        const float* ps = a->in[10] + l * 256 + g * 64;
        f32x4 va[2], vb[2];
#pragma unroll
        for (int i = 0; i < 2; ++i) { const int q = tid + 512 * i; va[i] = *(const f32x4*)(wp + (size_t)q * 4); vb[i] = *(const f32x4*)(Wo + (size_t)(512 + g * 64 + (q >> 4)) * 1024 + nb * 64 + (q & 15) * 4) * ps[q >> 4]; }
#pragma unroll
        for (int i = 0; i < 2; ++i) { const int q = tid + 512 * i; *(f32x4*)(tA + (size_t)q * 4) = va[i]; *(f32x4*)(tB + (size_t)q * 4) = vb[i]; }
        __syncthreads();
        tile = (float*)(lds + 133120);
        mm64_f32(tA, 64, tB, 64, 64, tile);
    } else tile_load(tile, Wo + (size_t)(kb * 64) * 1024 + nb * 64, 1024);
    __syncthreads();
    tile_store_T(tile, (bf16_t*)(a->ws + WS_WOUT) + ((size_t)l * 1024 + nb * 64) * 1024 + kb * 64, 1024);
    __syncthreads();
}

__device__ __forceinline__ void exp_src_dst(AP a, int l, int u, const float*& src, int& srcld, unsigned char*& dst, int& dstld) {
    const int mat = u / 1024, e = (u % 1024) / 32, t = u % 32;
    const int kb = (mat < 2) ? t / 4 : t / 8, nb = (mat < 2) ? t % 4 : t % 8;
    srcld = (mat < 2) ? 512 : 1024; dstld = (mat < 2) ? 1024 : 512;
    src = a->in[18 + mat] + ((size_t)(l * 32 + e) * 512 * 1024) + (size_t)(kb * 128) * srcld + nb * 128;
    dst = a->ws + WS_WEXP + (size_t)l * WEXP_LAYER + (size_t)mat * EXPMAT + (size_t)e * 512 * 1024 + (size_t)(nb * 128) * dstld + kb * 128;
}
#define EXP_LOAD(vv, uu) do { exp_src_dst(a, l, (uu), src, srcld, dst, dstld); _Pragma("unroll") for (int _i = 0; _i < 8; ++_i) vv[_i] = *(const f32x4*)(src + (size_t)((tid >> 5) + 16 * _i) * srcld + (tid & 31) * 4); } while (0)
#define EXP_PUT(vv) do { _Pragma("unroll") for (int _i = 0; _i < 8; ++_i) { float* tp = tile + ((tid >> 5) + 16 * _i) * 129 + (tid & 31) * 4; tp[0] = vv[_i][0] * 32.0f; tp[1] = vv[_i][1] * 32.0f; tp[2] = vv[_i][2] * 32.0f; tp[3] = vv[_i][3] * 32.0f; } } while (0)
#define EXP_STORE(dd, ld_) do { const int n = tid >> 2, kq = tid & 3; _Pragma("unroll") for (int j = 0; j < 2; ++j) { const float* tp = tile + (kq * 32 + j * 16) * 129 + n; u32x4 w; \
        w.x = pack4_fp8(tp[0], tp[129], tp[2 * 129], tp[3 * 129]); w.y = pack4_fp8(tp[4 * 129], tp[5 * 129], tp[6 * 129], tp[7 * 129]); \
        w.z = pack4_fp8(tp[8 * 129], tp[9 * 129], tp[10 * 129], tp[11 * 129]); w.w = pack4_fp8(tp[12 * 129], tp[13 * 129], tp[14 * 129], tp[15 * 129]); \
        *(u32x4*)((dd) + (size_t)n * (ld_) + kq * 32 + j * 16) = w; } } while (0)
__device__ __forceinline__ void exp_range(AP a, unsigned char* lds, int l, int u0, int u_end) {
    float* tile = (float*)lds;
    const int tid = tid_opaque();
    __syncthreads();
    if (u0 >= u_end) return;
    const float* src; unsigned char* dst; int srcld, dstld;
    f32x4 va[8], vb[8];
    unsigned char *da, *db = nullptr; int lda_, ldb_ = 0;
    EXP_LOAD(va, u0); da = dst; lda_ = dstld;
    if (u0 + 1 < u_end) { EXP_LOAD(vb, u0 + 1); db = dst; ldb_ = dstld; }
    for (int u = u0; u < u_end; u += 2) {
        EXP_PUT(va);
        __syncthreads();
        { unsigned char* cd = da; const int cl = lda_; if (u + 2 < u_end) { EXP_LOAD(va, u + 2); da = dst; lda_ = dstld; } EXP_STORE(cd, cl); }
        __syncthreads();
        if (u + 1 < u_end) {
            EXP_PUT(vb);
            __syncthreads();
            { unsigned char* cd = db; const int cl = ldb_; if (u + 3 < u_end) { EXP_LOAD(vb, u + 3); db = dst; ldb_ = dstld; } EXP_STORE(cd, cl); }
            __syncthreads();
        }
    }
}
#undef EXP_LOAD
#undef EXP_PUT
#undef EXP_STORE
__device__ __forceinline__ void exp_queue(AP a, unsigned char* lds, int l) {
    const int tid = tid_opaque();
    int* qslot = (int*)(lds + MISC_OFF + 128);
    unsigned* qc = (unsigned*)(a->ws + WS_BAR + 14336 + l * 256);
    for (;;) {
        __syncthreads();
        if (tid == 0) *qslot = (int)__hip_atomic_fetch_add(qc, 4u, __ATOMIC_RELAXED, __HIP_MEMORY_SCOPE_AGENT);
        __syncthreads();
        const int c0 = *qslot;
        if (c0 >= U_EXP) break;
        exp_range(a, lds, l, c0, c0 + 4);
    }
}

__device__ __forceinline__ void exp_fill(AP a, unsigned char* lds, int ql, int budget) {
    const int tid = tid_opaque();
    int* qslot = (int*)(lds + MISC_OFF + 128);
    unsigned* qc = (unsigned*)(a->ws + WS_BAR + 14336 + ql * 256);
    for (int done = 0; done < budget; done += 2) {
        __syncthreads();
        if (tid == 0) *qslot = (int)__hip_atomic_fetch_add(qc, 2u, __ATOMIC_RELAXED, __HIP_MEMORY_SCOPE_AGENT);
        __syncthreads();
        const int c0 = *qslot;
        if (c0 >= U_EXP) break;
        exp_range(a, lds, ql, c0, c0 + 2);
    }
    __syncthreads();
}

__device__ __forceinline__ void p0_prologue(AP a, unsigned char* lds) {
    const int tid = tid_opaque();
    bool have_tab = false;
    constexpr int E0 = U_ADA, E1 = E0 + U_WIN, E2 = E1 + U_WOUT, E3 = E2 + U_SGU, E4 = E3 + U_DFT, E5 = E4 + U_ROPE;
    int u = blockIdx.x;
    for (; u < E5; u += gridDim.x) {
        if (u < E0) ada_unit(a, lds, u);
        else if (u < E1) win_unit(a, lds, u - E0);
        else if (u < E2) wout_unit(a, lds, u - E1);
        else if (u < E3) { const size_t i0 = (size_t)(u - E2) * 4096 + tid * 8; const float* s = a->in[11] + i0; bf16_t* d = (bf16_t*)(a->ws + WS_WSGU) + i0;
            const f32x4 v0 = *(const f32x4*)s, v1 = *(const f32x4*)(s + 4); u32x4 w; w.x = pack2(v0[0], v0[1]); w.y = pack2(v0[2], v0[3]); w.z = pack2(v1[0], v1[1]); w.w = pack2(v1[2], v1[3]); *(u32x4*)d = w; }
        else if (u < E4) {
            float* ctab = (float*)(lds + LDS_CTAB);
            if (!have_tab) { for (int i = tid; i < 4096; i += NT) ctab[i] = cospif((float)i / 2048.0f); __syncthreads(); have_tab = true; }
            const int k = u - E3 + 4096;
            if (tid < 32) {
                const int kk = k - 4096, n0 = tid * 8; float c[8], s[8];
#pragma unroll
                for (int e = 0; e < 8; ++e) { const int idx = ((kk * (n0 + e)) & 255) * 16; c[e] = ctab[idx] * (1.0f / 16.0f); s[e] = ctab[(idx - 1024) & 4095] * (1.0f / 16.0f); }
                bf16_t* d = (bf16_t*)(a->ws + WS_DFTC) + (size_t)kk * 512 + n0;
                u32x4 w; w.x = pack2(c[0], c[1]); w.y = pack2(c[2], c[3]); w.z = pack2(c[4], c[5]); w.w = pack2(c[6], c[7]); *(u32x4*)d = w;
                w.x = pack2(s[0], s[1]); w.y = pack2(s[2], s[3]); w.z = pack2(s[4], s[5]); w.w = pack2(s[6], s[7]); *(u32x4*)(d + 256) = w;
            }
        }
        else {
            for (int i = tid; i < 1024; i += NT) { const int pos = i >> 4, f = i & 15; const float freq = powf(10000.0f, -(float)f / 16.0f); const float ang = (float)pos * freq;
                ((float2*)(a->ws + WS_ROPE))[i] = make_float2(cosf(ang), sinf(ang)); }
        }
    }
}

__device__ __forceinline__ void p_lnmod0(AP a) {
    const int tid = tid_opaque(), lane = tid & 63, w = tid >> 6;
    const float* mod = (const float*)(a->ws + WS_MOD);
    bf16_t* H = (bf16_t*)(a->ws + WS_H);
    const int tstep = gridDim.x * 8;
    f32x4 nx[4];
    { const int t = blockIdx.x * 8 + w; if (t < NTOK) { const float* src = (t < NLAT) ? a->in[0] + (size_t)t * D : a->in[2] + (size_t)(t - NLAT) * D;
#pragma unroll
        for (int i = 0; i < 4; ++i) nx[i] = *(const f32x4*)(src + 256 * i + 4 * lane); } }
    int mrow = -1; f32x4 msh[4], msc[4];
    for (int t = blockIdx.x * 8 + w; t < NTOK; t += tstep) {
        const int mr = (t < NLAT) ? (t >> 12) : 4;
        if (mr != mrow) { mrow = mr; const float* m = mod + (size_t)mr * 6144;
#pragma unroll
            for (int i = 0; i < 4; ++i) { msh[i] = *(const f32x4*)(m + 256 * i + 4 * lane); msc[i] = *(const f32x4*)(m + 1024 + 256 * i + 4 * lane); } }
        f32x4 v[4];
#pragma unroll
        for (int i = 0; i < 4; ++i) v[i] = nx[i];
        { const int tn = t + tstep; if (tn < NTOK) { const float* src = (tn < NLAT) ? a->in[0] + (size_t)tn * D : a->in[2] + (size_t)(tn - NLAT) * D;
#pragma unroll
            for (int i = 0; i < 4; ++i) nx[i] = *(const f32x4*)(src + 256 * i + 4 * lane); } }
        float mean, rstd; ln_stats(v, mean, rstd);
#pragma unroll
        for (int i = 0; i < 4; ++i) { const int c = 256 * i + 4 * lane;
            f32x4 o;
#pragma unroll
            for (int e = 0; e < 4; ++e) o[e] = (v[i][e] - mean) * rstd * (1.0f + msc[i][e]) + msh[i][e];
            u32x2 pk; pk.x = pack2(o[0], o[1]); pk.y = pack2(o[2], o[3]); *(u32x2*)(H + (size_t)t * D + c) = pk; }
    }
}

__device__ __forceinline__ void p1_inproj(AP a, unsigned char* smem, LAS unsigned char* lds, int l);
__device__ __forceinline__ u32x4 ld16g(const bf16_t* p) { return *(const u32x4*)p; }
__device__ __forceinline__ void rope_pack8(u32x4& wl, u32x4& wh, const LAS f32x2* tab, bool do_rope, float scale) {
    float tl[8] = {lo2f(wl.x), hi2f(wl.x), lo2f(wl.y), hi2f(wl.y), lo2f(wl.z), hi2f(wl.z), lo2f(wl.w), hi2f(wl.w)};
    float th[8] = {lo2f(wh.x), hi2f(wh.x), lo2f(wh.y), hi2f(wh.y), lo2f(wh.z), hi2f(wh.z), lo2f(wh.w), hi2f(wh.w)};
#pragma unroll
    for (int j = 0; j < 8; ++j) {
        float r1 = tl[j], r2 = th[j];
        if (do_rope) { const f32x2 cs = tab[j]; r1 = tl[j] * cs.x - th[j] * cs.y; r2 = tl[j] * cs.y + th[j] * cs.x; }
        tl[j] = r1 * scale; th[j] = r2 * scale;
    }
    wl.x = pack2(tl[0], tl[1]); wl.y = pack2(tl[2], tl[3]); wl.z = pack2(tl[4], tl[5]); wl.w = pack2(tl[6], tl[7]);
    wh.x = pack2(th[0], th[1]); wh.y = pack2(th[2], th[3]); wh.z = pack2(th[4], th[5]); wh.w = pack2(th[6], th[7]);
}

__device__ __forceinline__ void mixer_sgu_pool(AP a, LAS unsigned char* lds, int l, int row0, int seq_row0, int pos0, int n) {
    const int tid = tid_opaque(), lane = tid & 63, w = __builtin_amdgcn_readfirstlane(tid >> 6), fr = lane & 15, g = lane >> 4;
    const bf16_t* Z = (const bf16_t*)(a->ws + WS_Z);
    bf16_t* CAT = (bf16_t*)(a->ws + WS_CAT);
    {
#pragma unroll
        for (int it = 0; it < 9; ++it) { const int id = tid + 512 * it, rr = id >> 5, ch = id & 31, j = pos0 - 8 + rr;
            u32x4 v = (u32x4){0u, 0u, 0u, 0u};
            if (j >= 0 && j < n) v = ld16g(Z + (size_t)(seq_row0 + j) * ZC + 1024 + ch * 8);
            *(LAS u32x4*)(lds + rr * 512 + ch * 16) = v; }
        __syncthreads();
        const int c = tid & 255, half = tid >> 8, hw = 1 << (c >> 6);
        const LAS bf16_t* P = (const LAS bf16_t*)lds + c;
        const int t0 = half * 64;
        float s = 0.f;
        for (int j = t0 - hw; j < t0 + hw; ++j) s += bf2f(P[(8 + j) * 256]);
        for (int tl = t0; tl < t0 + 64; ++tl) {
            const int pos = pos0 + tl; const int lo = max(pos - hw, 0), hi = min(pos + hw, n);
            CAT[(size_t)(row0 + tl) * D + 512 + c] = f2bf(s / (float)(hi - lo) - bf2f(P[(8 + tl) * 256]));
            s += bf2f(P[(8 + tl + hw) * 256]) - bf2f(P[(8 + tl - hw) * 256]);
        }
        __syncthreads();
    }
    {
        const int i16 = lane & 15;
        u32x4 gw[4][2];
#pragma unroll
        for (int ps = 0; ps < 4; ++ps) { const int q = w * 16 + ps * 4 + g; const bf16_t* src = Z + (size_t)(row0 + q) * ZC + 1536 + 16 * i16; gw[ps][0] = ld16g(src); gw[ps][1] = ld16g(src + 8); }
#pragma unroll
        for (int ps = 0; ps < 4; ++ps) {
            const int q = w * 16 + ps * 4 + g;
            float gv[16];
#pragma unroll
            for (int hh = 0; hh < 2; ++hh) { const u32x4 x = gw[ps][hh];
                gv[8 * hh + 0] = gelu_erf(lo2f(x.x)); gv[8 * hh + 1] = gelu_erf(hi2f(x.x)); gv[8 * hh + 2] = gelu_erf(lo2f(x.y)); gv[8 * hh + 3] = gelu_erf(hi2f(x.y));
                gv[8 * hh + 4] = gelu_erf(lo2f(x.z)); gv[8 * hh + 5] = gelu_erf(hi2f(x.z)); gv[8 * hh + 6] = gelu_erf(lo2f(x.w)); gv[8 * hh + 7] = gelu_erf(hi2f(x.w)); }
            float sm = 0.f;
#pragma unroll
            for (int e = 0; e < 16; ++e) sm += gv[e];
            const float mean = row_sum16(sm) * (1.0f / 256.0f);
            float qq = 0.f;
#pragma unroll
            for (int e = 0; e < 16; ++e) { const float d = gv[e] - mean; qq += d * d; }
            const float rstd = 1.0f / sqrtf(row_sum16(qq) * (1.0f / 256.0f) + 1e-6f);
#pragma unroll
            for (int e = 0; e < 16; ++e) { const int c = 16 * i16 + e; *(LAS bf16_t*)(lds + c * 256 + ((((q >> 3) ^ (c & 15))) << 4) + (q & 7) * 2) = f2bf((gv[e] - mean) * rstd); }
        }
    }
    __syncthreads();
    {
        const int h = w >> 1, ph = w & 1;
        const bf16_t* Ws = (const bf16_t*)(a->ws + WS_WSGU) + (size_t)(l * 4 + h) * 128 * 128;
        const float* bs = a->in[12] + (size_t)(l * 4 + h) * 128;
        f32x4 acc[4][4];
#pragma unroll
        for (int i = 0; i < 4; ++i)
#pragma unroll
            for (int j = 0; j < 4; ++j) acc[i][j] = (f32x4){0.f, 0.f, 0.f, 0.f};
#pragma unroll
        for (int ks = 0; ks < 4; ++ks) {
            bf16x8 af[4], bfv[4];
#pragma unroll
            for (int cf = 0; cf < 4; ++cf) { const int c = h * 64 + 16 * cf + fr; af[cf] = *(const LAS bf16x8*)(lds + c * 256 + (((4 * ks + g) ^ (c & 15)) << 4)); }
#pragma unroll
            for (int pf = 0; pf < 4; ++pf) { const int p = ph * 64 + 16 * pf + fr; bfv[pf] = *(const bf16x8*)(Ws + (size_t)p * 128 + 32 * ks + 8 * g); }
#pragma unroll
            for (int cf = 0; cf < 4; ++cf)
#pragma unroll
                for (int pf = 0; pf < 4; ++pf) acc[cf][pf] = __builtin_amdgcn_mfma_f32_16x16x32_bf16(af[cf], bfv[pf], acc[cf][pf], 0, 0, 0);
        }
#pragma unroll
        for (int pf = 0; pf < 4; ++pf) { const int p = ph * 64 + 16 * pf + fr; const float bias = bs[p];
#pragma unroll
            for (int cf = 0; cf < 4; ++cf) { const int c0 = h * 64 + 16 * cf + 4 * g;
                const u32x2 uw = *(const u32x2*)(Z + (size_t)(row0 + p) * ZC + 1280 + c0);
                u32x2 o; o.x = pack2(gelu_erf(lo2f(uw.x)) * (acc[cf][pf][0] + bias), gelu_erf(hi2f(uw.x)) * (acc[cf][pf][1] + bias));
                o.y = pack2(gelu_erf(lo2f(uw.y)) * (acc[cf][pf][2] + bias), gelu_erf(hi2f(uw.y)) * (acc[cf][pf][3] + bias));
                *(u32x2*)(CAT + (size_t)(row0 + p) * D + 768 + c0) = o; } }
    }
    __syncthreads();
}

__device__ __forceinline__ void mixer_attn(AP a, LAS unsigned char* lds, int l, int row0, int seq_row0, int pos0, int n, int b, bool is_ctx, int kvh) {
    const int tid = tid_opaque(), lane = tid & 63, w = __builtin_amdgcn_readfirstlane(tid >> 6), fr = lane & 15, g = lane >> 4;
    const bf16_t* Z = (const bf16_t*)(a->ws + WS_Z);
    bf16_t* CAT = (bf16_t*)(a->ws + WS_CAT);
    __syncthreads();
    ((LAS u32x4*)(lds + 98304))[tid] = ((const u32x4*)(a->ws + WS_ROPE))[tid];
    const LAS f32x2* rope = (const LAS f32x2*)(lds + 98304);
    constexpr float QS = 0.125f * 1.44269504088896341f;
    constexpr int QS_OFF = 0, KS_OFF = 32768, VS_OFF = 65536;
    const int nbq = pos0 >> 7;
    unsigned bmask = 0x18u;
    if (!is_ctx) { if (nbq > 0) bmask |= 1u; bmask |= 2u; if (nbq + 1 < (n >> 7)) bmask |= 4u; }
    const int kr = tid >> 2, kax = (tid >> 1) & 1, kh8 = tid & 1;
#define MX_KSRC(blk) (Z + (size_t)((((blk) < 3) ? seq_row0 + (nbq + (blk) - 1) * 128 : NLAT + b * 256 + ((blk) - 3) * 128) + kr) * ZC + 768 + kvh * 64 + kax * 32 + kh8 * 8)
#define MX_VSTAGE(blk, buf) do { const bool _band = (blk) < 3; const int _key0 = _band ? (nbq + (blk) - 1) * 128 : ((blk) - 3) * 128; \
        const bf16_t* _vs = _band ? (const bf16_t*)(a->ws + WS_VT) + (size_t)(b * 2 + kvh) * 64 * 4096 + _key0 : (const bf16_t*)(a->ws + WS_VTC) + (size_t)(b * 2 + kvh) * 64 * 256 + _key0; \
        const int _vld = _band ? 4096 : 256; \
        _Pragma("unroll") for (int _i = 0; _i < 2; ++_i) { const int _P = _i * 512 + tid, _d = _P >> 4, _c = (_P & 15) ^ (_d & 15); \
            glds16(_vs + (size_t)_d * _vld + _c * 8, lds + VS_OFF + (buf) * 16384 + _i * 8192 + w * 1024); } } while (0)
    {
        __syncthreads();
#pragma unroll
        for (int it = 0; it < 2; ++it) {
            const int item = tid + 512 * it, r = item >> 2, ax = (item >> 1) & 1, h8 = item & 1, i = r & 127, qpos = pos0 + i;
            const bf16_t* src = Z + (size_t)(row0 + i) * ZC + 512 + (2 * kvh + (r >> 7)) * 64 + ax * 32 + h8 * 8;
            u32x4 wl = ld16g(src), wh = ld16g(src + 16);
            rope_pack8(wl, wh, rope + (ax ? (qpos & 63) : (qpos >> 6)) * 16 + h8 * 8, !is_ctx, QS);
            const int ch = ax * 4 + h8, sw = (r >> 1) & 7;
            *(LAS u32x4*)(lds + QS_OFF + r * 128 + ((ch ^ sw) << 4)) = wl;
            *(LAS u32x4*)(lds + QS_OFF + r * 128 + (((ch + 2) ^ sw) << 4)) = wh;
        }
        const int hh = w >> 2, qb = (w & 3) * 32, h = 2 * kvh + hh;
        float m[2], lsum[2];
        m[0] = m[1] = a->in[8][l * 4 + h] * 1.44269504088896341f;
        lsum[0] = lsum[1] = (g == 0) ? 1.0f : 0.0f;
        f32x4 O[4][2];
#pragma unroll
        for (int i = 0; i < 4; ++i) { O[i][0] = (f32x4){0.f, 0.f, 0.f, 0.f}; O[i][1] = (f32x4){0.f, 0.f, 0.f, 0.f}; }
        bf16x8 Qf[2][2];
        bool have_q = false;
        unsigned rem = bmask;
        int cur = __builtin_ctz(rem); rem &= rem - 1u;
        int buf = 0;
        u32x4 kl = ld16g(MX_KSRC(cur)), kh = ld16g(MX_KSRC(cur) + 16);
        MX_VSTAGE(cur, 0);
#pragma unroll 1
        for (;;) {
            const int jb = cur - 1; const bool band = cur < 3;
            {
                const int kpos = (nbq + jb) * 128 + kr;
                rope_pack8(kl, kh, rope + (kax ? (kpos & 63) : (kpos >> 6)) * 16 + kh8 * 8, band, 1.0f);
                const int ch = kax * 4 + kh8, sw = (kr >> 1) & 7;
                *(LAS u32x4*)(lds + KS_OFF + buf * 16384 + kr * 128 + ((ch ^ sw) << 4)) = kl;
                *(LAS u32x4*)(lds + KS_OFF + buf * 16384 + kr * 128 + (((ch + 2) ^ sw) << 4)) = kh;
            }
            asm volatile("s_waitcnt vmcnt(0)" ::: "memory");
            __syncthreads();
            const int nxt = rem ? __builtin_ctz(rem) : -1; rem &= rem - 1u;
            if (nxt >= 0) { kl = ld16g(MX_KSRC(nxt)); kh = ld16g(MX_KSRC(nxt) + 16); MX_VSTAGE(nxt, buf ^ 1); }
            if (!have_q) {
#pragma unroll
                for (int qf = 0; qf < 2; ++qf)
#pragma unroll
                    for (int ks = 0; ks < 2; ++ks) { const int r = hh * 128 + qb + 16 * qf + fr; Qf[qf][ks] = *(const LAS bf16x8*)(lds + QS_OFF + r * 128 + (((4 * ks + g) ^ ((r >> 1) & 7)) << 4)); }
                have_q = true;
            }
            const int kso = KS_OFF + buf * 16384, vso = VS_OFF + buf * 16384;
            f32x4 S[8][2];
#pragma unroll
            for (int kf = 0; kf < 8; ++kf) { S[kf][0] = (f32x4){0.f, 0.f, 0.f, 0.f}; S[kf][1] = (f32x4){0.f, 0.f, 0.f, 0.f}; }
#pragma unroll
            for (int kf = 0; kf < 8; ++kf)
#pragma unroll
                for (int ks = 0; ks < 2; ++ks) { const int r = 16 * kf + fr;
                    const bf16x8 kfr = *(const LAS bf16x8*)(lds + kso + r * 128 + (((4 * ks + g) ^ ((r >> 1) & 7)) << 4));
                    S[kf][0] = __builtin_amdgcn_mfma_f32_16x16x32_bf16(kfr, Qf[0][ks], S[kf][0], 0, 0, 0);
                    S[kf][1] = __builtin_amdgcn_mfma_f32_16x16x32_bf16(kfr, Qf[1][ks], S[kf][1], 0, 0, 0); }
            bf16x8 Pp[4][2];
#pragma unroll
            for (int qf = 0; qf < 2; ++qf) {
                const int qi = qb + 16 * qf + fr;
                if (band && jb != 0) {
#pragma unroll
                    for (int kf = 0; kf < 8; ++kf)
#pragma unroll
                        for (int r = 0; r < 4; ++r) { const int kk = 16 * kf + 4 * g + r; const bool ok = (jb < 0) ? (kk >= qi) : (kk <= qi); if (!ok) S[kf][qf][r] = -1.0e30f; }
                }
                float mx = S[0][qf][0];
#pragma unroll
                for (int kf = 0; kf < 8; ++kf)
#pragma unroll
                    for (int r = 0; r < 4; ++r) mx = fmaxf(mx, S[kf][qf][r]);
                mx = fmaxf(mx, __shfl_xor(mx, 16)); mx = fmaxf(mx, __shfl_xor(mx, 32));
                const float mn = fmaxf(m[qf], mx), corr = __builtin_amdgcn_exp2f(m[qf] - mn);
                m[qf] = mn;
                float ps = 0.f;
#pragma unroll
                for (int kf = 0; kf < 8; ++kf)
#pragma unroll
                    for (int r = 0; r < 4; ++r) { const float p = __builtin_amdgcn_exp2f(S[kf][qf][r] - mn); S[kf][qf][r] = p; ps += p; }
                lsum[qf] = lsum[qf] * corr + ps;
#pragma unroll
                for (int df = 0; df < 4; ++df) O[df][qf] *= corr;
#pragma unroll
                for (int t = 0; t < 4; ++t) { u32x4 pw; pw.x = pack2(S[2 * t][qf][0], S[2 * t][qf][1]); pw.y = pack2(S[2 * t][qf][2], S[2 * t][qf][3]);
                    pw.z = pack2(S[2 * t + 1][qf][0], S[2 * t + 1][qf][1]); pw.w = pack2(S[2 * t + 1][qf][2], S[2 * t + 1][qf][3]); Pp[t][qf] = __builtin_bit_cast(bf16x8, pw); }
            }
#pragma unroll
            for (int t = 0; t < 4; ++t)
#pragma unroll
                for (int df = 0; df < 4; ++df) { const int d = 16 * df + fr;
                    const u32x2 v0 = *(const LAS u32x2*)(lds + vso + d * 256 + (((4 * t + (g >> 1)) ^ (d & 15)) << 4) + (g & 1) * 8);
                    const u32x2 v1 = *(const LAS u32x2*)(lds + vso + d * 256 + (((4 * t + 2 + (g >> 1)) ^ (d & 15)) << 4) + (g & 1) * 8);
                    u32x4 vw; vw.x = v0.x; vw.y = v0.y; vw.z = v1.x; vw.w = v1.y; const bf16x8 vf = __builtin_bit_cast(bf16x8, vw);
                    O[df][0] = __builtin_amdgcn_mfma_f32_16x16x32_bf16(vf, Pp[t][0], O[df][0], 0, 0, 0);
                    O[df][1] = __builtin_amdgcn_mfma_f32_16x16x32_bf16(vf, Pp[t][1], O[df][1], 0, 0, 0); }
            if (nxt < 0) break;
            cur = nxt; buf ^= 1;
        }
#pragma unroll
        for (int qf = 0; qf < 2; ++qf) {
            float lt = lsum[qf]; lt += __shfl_xor(lt, 16); lt += __shfl_xor(lt, 32);
            const float inv = 1.0f / lt;
            bf16_t* dst = CAT + (size_t)(row0 + qb + 16 * qf + fr) * D + 256 + h * 64 + 4 * g;
#pragma unroll
            for (int df = 0; df < 4; ++df) { u32x2 o; o.x = pack2(O[df][qf][0] * inv, O[df][qf][1] * inv); o.y = pack2(O[df][qf][2] * inv, O[df][qf][3] * inv); *(u32x2*)(dst + 16 * df) = o; }
        }
    }
#undef MX_KSRC
#undef MX_VSTAGE
    __syncthreads();
}

constexpr int FF_DA = 0, FF_DC = 32768, FF_XT = 49152  , FF_Z2 = 81920  , FF_OB = 114688  ;
__device__ __forceinline__ int ff_addr(int row, int k) { return row * 256 + ((((k >> 3) ^ (row & 15))) << 4) + (k & 7) * 2; }
__device__ __forceinline__ float cos_turns(float x) { return __builtin_amdgcn_cosf(x); }
__device__ __forceinline__ float sin_turns(float x) { return __builtin_amdgcn_sinf(x); }
__device__ __forceinline__ void fft_setup(LAS unsigned char* lds) {
    const int tid = tid_opaque();
    __syncthreads();
    for (int idx = tid; idx < 16384; idx += NT) { const int i = idx >> 7, k = idx & 127, ro = i >> 6, k1 = i & 63, part = k >> 6, n1 = k & 63; const float t = (float)((k1 * n1) & 63) * (1.0f / 64.0f);
        const float c = cos_turns(t), sn = sin_turns(t);
        const float v = (ro == 0) ? (part == 0 ? c : sn) : (part == 0 ? -sn : c);
        *(LAS bf16_t*)(lds + FF_DA + ff_addr(i, k)) = f2bf(v * 0.125f); }
    for (int idx = tid; idx < 8192; idx += NT) { const int k2 = idx >> 7, k = idx & 127, ri = k >> 6, n2 = k & 63; const float t = (float)((k2 * n2) & 63) * (1.0f / 64.0f);
        const float v = (ri == 0) ? cos_turns(t) : sin_turns(t);
        *(LAS bf16_t*)(lds + FF_DC + ff_addr(k2, k)) = f2bf(v * 0.125f); }
    __syncthreads();
}
__device__ __forceinline__ void fft_unit(AP a, LAS unsigned char* lds, int b, int cg) {
    const int tid = tid_opaque(), lane = tid & 63, w = __builtin_amdgcn_readfirstlane(tid >> 6), fr = lane & 15, g = lane >> 4;
    const int mf = w & 3, nh = w >> 2;
    const bf16_t* AT = (const bf16_t*)(a->ws + WS_AT) + (size_t)(b * 256 + cg * 4) * 8192;
    u32x4 xin[2][2];
#pragma unroll
    for (int h = 0; h < 2; ++h)
#pragma unroll
        for (int it = 0; it < 2; ++it) xin[h][it] = ld16g(AT + (size_t)h * 8192 + (size_t)(tid + 512 * it) * 8);
#pragma unroll 1
    for (int cp = 0; cp < 2; ++cp) {
#pragma unroll
        for (int h = 0; h < 2; ++h)
#pragma unroll
            for (int it = 0; it < 2; ++it) { const int q = tid + 512 * it, part = q >> 9, pos0 = (q & 511) * 8, n1 = pos0 >> 6, n2 = pos0 & 63, k = part * 64 + n1;
                const unsigned wv[4] = {xin[h][it].x, xin[h][it].y, xin[h][it].z, xin[h][it].w};
#pragma unroll
                for (int e = 0; e < 4; ++e) { *(LAS bf16_t*)(lds + FF_XT + h * 16384 + ff_addr(n2 + 2 * e, k)) = (bf16_t)(wv[e] & 0xffffu); *(LAS bf16_t*)(lds + FF_XT + h * 16384 + ff_addr(n2 + 2 * e + 1, k)) = (bf16_t)(wv[e] >> 16); } }
        if (cp == 0) {
#pragma unroll
            for (int h = 0; h < 2; ++h)
#pragma unroll
                for (int it = 0; it < 2; ++it) xin[h][it] = ld16g(AT + (size_t)(2 + h) * 8192 + (size_t)(tid + 512 * it) * 8); }
        __syncthreads();
        f32x4 acc[2][2][2];
#pragma unroll
        for (int h = 0; h < 2; ++h)
#pragma unroll
            for (int x = 0; x < 2; ++x) { acc[h][x][0] = (f32x4){0.f, 0.f, 0.f, 0.f}; acc[h][x][1] = (f32x4){0.f, 0.f, 0.f, 0.f}; }
#pragma unroll
        for (int ks = 0; ks < 4; ++ks) {
            bf16x8 af[2];
#pragma unroll
            for (int x = 0; x < 2; ++x) { const int i = 16 * (mf + 4 * x) + fr; af[x] = *(const LAS bf16x8*)(lds + FF_DA + i * 256 + (((4 * ks + g) ^ (i & 15)) << 4)); }
#pragma unroll
            for (int h = 0; h < 2; ++h)
#pragma unroll
                for (int n = 0; n < 2; ++n) { const int j = 16 * (2 * nh + n) + fr; const bf16x8 bfv = *(const LAS bf16x8*)(lds + FF_XT + h * 16384 + j * 256 + (((4 * ks + g) ^ (j & 15)) << 4));
                    acc[h][0][n] = __builtin_amdgcn_mfma_f32_16x16x32_bf16(af[0], bfv, acc[h][0][n], 0, 0, 0);
                    acc[h][1][n] = __builtin_amdgcn_mfma_f32_16x16x32_bf16(af[1], bfv, acc[h][1][n], 0, 0, 0); }
        }
#pragma unroll
        for (int n = 0; n < 2; ++n)
#pragma unroll
            for (int r = 0; r < 4; ++r) { const int k1 = 16 * mf + 4 * g + r, n2 = 16 * (2 * nh + n) + fr; const float t = (float)((k1 * n2) & 4095) * (1.0f / 4096.0f);
                const float c = cos_turns(t), sn = sin_turns(t);
#pragma unroll
                for (int h = 0; h < 2; ++h) { const float zr = acc[h][0][n][r], zi = acc[h][1][n][r];
                    *(LAS bf16_t*)(lds + FF_Z2 + h * 16384 + ff_addr(k1, n2)) = f2bf(zr * c + zi * sn);
                    *(LAS bf16_t*)(lds + FF_Z2 + h * 16384 + ff_addr(k1, 64 + n2)) = f2bf(zi * c - zr * sn); } }
        __syncthreads();
        f32x4 acc2[2][2];
#pragma unroll
        for (int h = 0; h < 2; ++h) { acc2[h][0] = (f32x4){0.f, 0.f, 0.f, 0.f}; acc2[h][1] = (f32x4){0.f, 0.f, 0.f, 0.f}; }
#pragma unroll
        for (int ks = 0; ks < 4; ++ks) {
            const int i = 16 * mf + fr; const bf16x8 af = *(const LAS bf16x8*)(lds + FF_DC + i * 256 + (((4 * ks + g) ^ (i & 15)) << 4));
#pragma unroll
            for (int h = 0; h < 2; ++h)
#pragma unroll
                for (int n = 0; n < 2; ++n) { const int j = 16 * (2 * nh + n) + fr; const bf16x8 bfv = *(const LAS bf16x8*)(lds + FF_Z2 + h * 16384 + j * 256 + (((4 * ks + g) ^ (j & 15)) << 4));
                    acc2[h][n] = __builtin_amdgcn_mfma_f32_16x16x32_bf16(af, bfv, acc2[h][n], 0, 0, 0); }
        }
#pragma unroll
        for (int n = 0; n < 2; ++n)
#pragma unroll
            for (int r = 0; r < 4; ++r) { const int k = 16 * (2 * nh + n) + fr + 64 * (16 * mf + 4 * g + r);
                *(LAS unsigned*)(lds + FF_OB + k * 8 + cp * 4) = pack2(acc2[0][n][r], acc2[1][n][r]); }
    }
    __syncthreads();
    bf16_t* CAT = (bf16_t*)(a->ws + WS_CAT) + (size_t)(b * 4096) * D + cg * 4;
#pragma unroll
    for (int it = 0; it < 8; ++it) { const int k = tid + 512 * it; *(u32x2*)(CAT + (size_t)k * D) = *(const LAS u32x2*)(lds + FF_OB + k * 8); }
    __syncthreads();
}

__device__ __forceinline__ void p2_mix(AP a, unsigned char* ldsg, LAS unsigned char* lds, int l) {
    const int n_tile = 128 + ((l == 0) ? 8 : 0), n_att = 2 * n_tile, n_dft = 256, n_dftc = (l == 0) ? 16 : 0;
    bf16_t* CAT = (bf16_t*)(a->ws + WS_CAT);
    bool fft_ready = false;
    for (int u = blockIdx.x; u < n_att + n_dft + n_tile + n_dftc; u += gridDim.x) {
        if (u < n_att || (u >= n_att + n_dft && u < n_att + n_dft + n_tile)) {
            const bool att = u < n_att;
            const int t = att ? (u >> 1) : (u - n_att - n_dft);
            const bool isc = t >= 128; const int tt = t - 128;
            const int b = isc ? (tt >> 1) : (t >> 5);
            const int row0 = isc ? NLAT + tt * 128 : t * 128, seq_row0 = isc ? NLAT + b * 256 : b * 4096, pos0 = isc ? (tt & 1) * 128 : (t & 31) * 128, n = isc ? 256 : 4096;
            if (att) { for (int rep = 0; rep < PROBE_MIX_REP; ++rep) mixer_attn(a, lds, l, row0, seq_row0, pos0, n, b, isc, u & 1); }
            else { for (int rep = 0; rep < PROBE_SGU_REP; ++rep) mixer_sgu_pool(a, lds, l, row0, seq_row0, pos0, n); }
            fft_ready = false;
        } else if (u < n_att + n_dft) {
            const int uu = u - n_att;
            if (!fft_ready) { fft_setup(lds); fft_ready = true; }
            for (int rep = 0; rep < PROBE_FFT_REP; ++rep) fft_unit(a, lds, uu >> 6, uu & 63);
        } else {
            const int uu = u - n_att - n_dft - n_tile, b = uu >> 2, mt = (uu >> 1) & 1, ch0 = (uu & 1) * 128;
            const bf16_t* A = (const bf16_t*)(a->ws + WS_DFTC) + (size_t)(mt * 128) * 512;
            const bf16_t* B0 = (const bf16_t*)(a->ws + WS_ATC) + ((size_t)b * 256 + ch0) * 512;
            EpiBf16 E; E.C = CAT + (size_t)(NLAT + b * 256 + mt * 128) * D + ch0; E.ld = D; E.scale = 1.0f;
            gemm_tile<128, false, EpiBf16>(lds, A, 512, nullptr, 128, B0, B0 + (size_t)64 * 512, 512, 512, E);
            fft_ready = false;
        }
    }
    exp_queue(a, ldsg, l);
}

__device__ __forceinline__ int uni(int v) { return __builtin_amdgcn_readfirstlane(v); }
__device__ __forceinline__ int vblock() { const int G = gridDim.x, b = blockIdx.x; return (G % 8 == 0) ? (b % 8) * (G / 8) + b / 8 : b; }
template <class T> __device__ __forceinline__ T* unip(T* p) { const unsigned long long v = (unsigned long long)p; const unsigned lo = __builtin_amdgcn_readfirstlane((unsigned)v), hi = __builtin_amdgcn_readfirstlane((unsigned)(v >> 32)); return (T*)(((unsigned long long)hi << 32) | lo); }
struct SchedInProj {
    typedef EpiInProj Epi; static constexpr bool GATHER = false, FP8 = false;
    unsigned char* ws; int l, G, me;
    __device__ __forceinline__ bool get(int i, g256::Unit<Epi>& u) const {
        const int n_lat = 64 * 7, n_ctx = (l == 0) ? 4 * 7 : 4;
        const int idx = i * G + me; if (idx >= n_lat + n_ctx) return false;
        int row0, b, ct, n; bf16_t *tF, *tV;
        if (idx < n_lat) { const int rt = idx / 7; ct = idx % 7; row0 = rt * 256; b = row0 >> 12; n = 4096;
            tF = (bf16_t*)(ws + WS_AT) + (size_t)b * 256 * 2 * 4096; tV = (bf16_t*)(ws + WS_VT) + (size_t)b * 128 * 4096; }
        else { const int uu = idx - n_lat; int rt; if (l == 0) { rt = uu / 7; ct = uu % 7; } else { rt = uu; ct = 3; }
            row0 = NLAT + rt * 256; b = rt; n = 256;
            tF = (bf16_t*)(ws + WS_ATC) + (size_t)b * 256 * 2 * 256; tV = (bf16_t*)(ws + WS_VTC) + (size_t)b * 128 * 256; }
        u.A = (const bf16_t*)(ws + WS_H) + (size_t)row0 * D;
        u.B0 = (const bf16_t*)(ws + WS_WIN) + ((size_t)l * ZC + ct * 256) * 1024; u.B1 = u.B0 + (size_t)128 * 1024; u.ridx = nullptr; u.valid = 256;
        u.epi.Zt = (bf16_t*)(ws + WS_Z) + (size_t)row0 * ZC + ct * 256; u.epi.tF = tF; u.epi.tV = tV; u.epi.n0 = ct * 256; u.epi.pos0 = (idx < n_lat) ? (row0 & 4095) : 0; u.epi.n = n;
        return true;
    }
};
struct SchedOutProj {
    typedef EpiBf16 Epi; static constexpr bool GATHER = false, FP8 = false;
    unsigned char* ws; int l, G, me;
    __device__ __forceinline__ bool get(int i, g256::Unit<Epi>& u) const {
        const int nrt = NLAT / 256;
        const int idx = i * G + me; if (idx >= nrt * 4) return false;
        const int rt = idx >> 2, ct = idx & 3;
        u.A = (const bf16_t*)(ws + WS_CAT) + (size_t)(rt * 256) * D;
        u.B0 = (const bf16_t*)(ws + WS_WOUT) + ((size_t)l * 1024 + ct * 256) * 1024; u.B1 = u.B0 + (size_t)128 * 1024; u.ridx = nullptr; u.valid = 256;
        u.epi.C = (bf16_t*)(ws + WS_Y) + (size_t)(rt * 256) * D + ct * 256; u.epi.ld = D; u.epi.scale = 1.0f;
        return true;
    }
};
struct SchedGateUp {
    typedef EpiGateUp8 Epi; static constexpr bool GATHER = true, FP8 = true;
    unsigned char* ws; const LAS int* blk; const LAS int* tot; const LAS int* ridx_lds; int G, me, l;
    __device__ __forceinline__ bool get(int i, g256::Unit<Epi>& u) const {
        const int idx = i * G + me; if (idx >= uni(blk[32]) * 4) return false;
        const int rb = idx >> 2, ct = idx & 3;
        int e = 0;
#pragma unroll 1
        for (int q = 1; q < 32; ++q) if (uni(blk[q]) <= rb) e = q;
        u.A = (const bf16_t*)(ws + WS_H8);
        { const unsigned char* b0 = ws + WS_WEXP + (size_t)l * WEXP_LAYER + ((size_t)e * 512 + ct * 128) * 1024; u.B0 = (const bf16_t*)b0; u.B1 = (const bf16_t*)(b0 + EXPMAT); }
        u.ridx = ridx_lds + (i & 7) * 256; u.valid = uni(min(256, tot[e] - (rb - blk[e]) * 256));
        u.epi.C = ws + WS_HID + (size_t)(rb * 256) * DEXP + ct * 128; u.epi.ld = DEXP;
        return true;
    }
};
struct SchedDown {
    typedef EpiBf16 Epi; static constexpr bool GATHER = false, FP8 = true;
    unsigned char* ws; const LAS int* blk; int G, me, l;
    __device__ __forceinline__ bool get(int i, g256::Unit<Epi>& u) const {
        const int idx = i * G + me; if (idx >= uni(blk[32]) * 4) return false;
        const int rb = idx >> 2, ct = idx & 3;
        int e = 0;
#pragma unroll 1
        for (int q = 1; q < 32; ++q) if (uni(blk[q]) <= rb) e = q;
        u.A = (const bf16_t*)(ws + WS_HID + (size_t)(rb * 256) * DEXP);
        { const unsigned char* b0 = ws + WS_WEXP + (size_t)l * WEXP_LAYER + 2 * EXPMAT + ((size_t)e * 1024 + ct * 256) * 512; u.B0 = (const bf16_t*)b0; u.B1 = (const bf16_t*)(b0 + (size_t)128 * 512); } u.ridx = nullptr; u.valid = 256;
        u.epi.C = (bf16_t*)(ws + WS_YS) + (size_t)(rb * 256) * D + ct * 256; u.epi.ld = D; u.epi.scale = 1.0f / 32.0f;
        return true;
    }
};

__device__ __forceinline__ void p4_ln1_router(AP a, unsigned char* lds, int l) {
    const int tid = tid_opaque(), lane = tid & 63, w = tid >> 6;
    const int ntok = (l == 0) ? NTOK : NLAT;
    int* cnt = (int*)(lds + MISC_OFF);
    if (tid < 32) cnt[tid] = 0;
    f32x4* Lg = (f32x4*)lds; f32x4* Le = (f32x4*)(lds + 16384); f32x4* Lgb = (f32x4*)(lds + 147456);
    {
        const float* wrg_ = a->in[16] + (size_t)l * 1024 * 4; const float* wre_ = a->in[17] + (size_t)l * 1024 * 32;
#pragma unroll
        for (int it = 0; it < 2; ++it) { const int c = tid + 512 * it, slot = (((c >> 8) * 4 + (c & 3)) << 6) + ((c >> 2) & 63);
            Lg[slot] = *(const f32x4*)(wrg_ + (size_t)c * 4);
#pragma unroll
            for (int q = 0; q < 8; ++q) Le[q * 1024 + slot] = *(const f32x4*)(wre_ + (size_t)c * 32 + q * 4); }
        Lgb[tid] = (tid < 256) ? *(const f32x4*)(a->in[14] + l * 1024 + tid * 4) : *(const f32x4*)(a->in[15] + l * 1024 + (tid - 256) * 4);
    }
    __syncthreads();
    const float* mod = (const float*)(a->ws + WS_MOD) + (size_t)l * 5 * 6144;
    const bf16_t* Y = (const bf16_t*)(a->ws + WS_Y);
    float* X1 = (float*)(a->ws + WS_X1);
    unsigned char* H8 = a->ws + WS_H8;
    int* tokE = (int*)(a->ws + WS_TOKE); int* tokR = (int*)(a->ws + WS_TOKR); float* tokG = (float*)(a->ws + WS_TOKG);
    const int tstep = gridDim.x * 8;
    f32x4 nx[4]; u32x2 ny[4];
    {   const int t = blockIdx.x * 8 + w;
        if (t < ntok) { const float* xs = (l == 0) ? ((t < NLAT) ? a->in[0] + (size_t)t * D : a->in[2] + (size_t)(t - NLAT) * D) : (const float*)(a->ws + WS_XC) + (size_t)t * D;
#pragma unroll
            for (int i = 0; i < 4; ++i) { nx[i] = *(const f32x4*)(xs + 256 * i + 4 * lane); ny[i] = *(const u32x2*)(Y + (size_t)t * D + 256 * i + 4 * lane); } } }
    int mrow = -1; f32x4 mg[4], msh[4], msc[4];
    for (int t = blockIdx.x * 8 + w; t < ntok; t += tstep) {
        const int mr = (t < NLAT) ? (t >> 12) : 4;
        if (mr != mrow) { mrow = mr; const float* m = mod + (size_t)mr * 6144;
#pragma unroll
            for (int i = 0; i < 4; ++i) { const int c = 256 * i + 4 * lane; mg[i] = *(const f32x4*)(m + 2048 + c); msh[i] = *(const f32x4*)(m + 3072 + c); msc[i] = *(const f32x4*)(m + 4096 + c); } }
        f32x4 v[4];
#pragma unroll
        for (int i = 0; i < 4; ++i) { const f32x4 yv = (f32x4){lo2f(ny[i].x), hi2f(ny[i].x), lo2f(ny[i].y), hi2f(ny[i].y)};
#pragma unroll
            for (int e = 0; e < 4; ++e) v[i][e] = RES_ALPHA * nx[i][e] + mg[i][e] * yv[e]; }
        {   const int tn = t + tstep;
            if (tn < ntok) { const float* xs = (l == 0) ? ((tn < NLAT) ? a->in[0] + (size_t)tn * D : a->in[2] + (size_t)(tn - NLAT) * D) : (const float*)(a->ws + WS_XC) + (size_t)tn * D;
#pragma unroll
                for (int i = 0; i < 4; ++i) { nx[i] = *(const f32x4*)(xs + 256 * i + 4 * lane); ny[i] = *(const u32x2*)(Y + (size_t)tn * D + 256 * i + 4 * lane); } } }
        float mean, rstd; ln_stats(v, mean, rstd);
#pragma unroll
        for (int i = 0; i < 4; ++i) { const int c = 256 * i + 4 * lane; const f32x4 gg = Lgb[64 * i + lane], bb = Lgb[256 + 64 * i + lane];
#pragma unroll
            for (int e = 0; e < 4; ++e) v[i][e] = (v[i][e] - mean) * rstd * gg[e] + bb[e];
            *(f32x4*)(X1 + (size_t)t * D + c) = v[i]; }
        ln_stats(v, mean, rstd);
#pragma unroll
        for (int i = 0; i < 4; ++i) { const int c = 256 * i + 4 * lane; const f32x4 sh = msh[i], sc = msc[i];
#pragma unroll
            for (int e = 0; e < 4; ++e) v[i][e] = (v[i][e] - mean) * rstd * (1.0f + sc[e]) + sh[e];
            *(unsigned*)(H8 + (size_t)t * D + c) = pack4_fp8(v[i][0], v[i][1], v[i][2], v[i][3]); }
        f32x2 lg01 = (f32x2){0.f, 0.f}, lg23 = (f32x2){0.f, 0.f};
#pragma unroll
        for (int i = 0; i < 4; ++i)
#pragma unroll
            for (int e = 0; e < 4; ++e) { const f32x4 wv = Lg[((i * 4 + e) << 6) + lane]; const f32x2 vv = (f32x2){v[i][e], v[i][e]};
                lg01 += vv * (f32x2){wv[0], wv[1]}; lg23 += vv * (f32x2){wv[2], wv[3]}; }
        float lg[4] = {wave_sum(lg01[0]), wave_sum(lg01[1]), wave_sum(lg23[0]), wave_sum(lg23[1])};
        int grp = 0; float mx = lg[0];
#pragma unroll
        for (int q = 1; q < 4; ++q) if (lg[q] > mx) { mx = lg[q]; grp = q; }
        float se = 0.f;
#pragma unroll
        for (int q = 0; q < 4; ++q) se += expf(lg[q] - mx);
        const float gate_group = 1.0f / se;
        f32x2 le01 = (f32x2){0.f, 0.f}, le23 = (f32x2){0.f, 0.f}, le45 = (f32x2){0.f, 0.f}, le67 = (f32x2){0.f, 0.f};
#pragma unroll
        for (int i = 0; i < 4; ++i)
#pragma unroll
            for (int e = 0; e < 4; ++e) { const f32x4* wp = Le + grp * 2048 + ((i * 4 + e) << 6) + lane; const f32x4 w0 = wp[0], w1 = wp[1024]; const f32x2 vv = (f32x2){v[i][e], v[i][e]};
                le01 += vv * (f32x2){w0[0], w0[1]}; le23 += vv * (f32x2){w0[2], w0[3]}; le45 += vv * (f32x2){w1[0], w1[1]}; le67 += vv * (f32x2){w1[2], w1[3]}; }
        float le[8] = {wave_sum(le01[0]), wave_sum(le01[1]), wave_sum(le23[0]), wave_sum(le23[1]), wave_sum(le45[0]), wave_sum(le45[1]), wave_sum(le67[0]), wave_sum(le67[1])};
        int j1 = 0; float l1 = le[0];
#pragma unroll
        for (int q = 1; q < 8; ++q) if (le[q] > l1) { l1 = le[q]; j1 = q; }
        int j2 = -1; float l2 = -3.0e38f;
#pragma unroll
        for (int q = 0; q < 8; ++q) if (q != j1 && le[q] > l2) { l2 = le[q]; j2 = q; }
        const float e2 = expf(l2 - l1), p1 = 1.0f / (1.0f + e2), p2 = e2 / (1.0f + e2);
        if (lane == 0) {
            const int ex0 = grp * 8 + j1, ex1 = grp * 8 + j2;
            const int r0 = atomicAdd(&cnt[ex0], 1), r1 = atomicAdd(&cnt[ex1], 1);
            tokE[2 * t] = ex0; tokE[2 * t + 1] = ex1; tokR[2 * t] = r0; tokR[2 * t + 1] = r1;
            tokG[2 * t] = gate_group * p1; tokG[2 * t + 1] = gate_group * p2;
        }
    }
    __syncthreads();
    if (tid < 32) ((int*)(a->ws + WS_BCNT))[((size_t)l * MAXG + blockIdx.x) * 32 + tid] = cnt[tid];
    __syncthreads();
}

__device__ __forceinline__ void p5_dispatch(AP a, unsigned char* lds, int l) {
    const int tid = tid_opaque();
    const int ntok = (l == 0) ? NTOK : NLAT;
    int* part = (int*)lds;
    int* tot = (int*)(lds + 4096);
    int* off = (int*)(lds + 4096 + 128);
    int* pstart = (int*)(lds + 4096 + 256);
    const int* bc = (const int*)(a->ws + WS_BCNT) + (size_t)l * MAXG * 32;
    const int G = gridDim.x, me = blockIdx.x;
    { const int e = tid & 31, p = tid >> 5; int s = 0, so = 0; for (int bb = p; bb < G; bb += 16) { const int c = bc[bb * 32 + e]; s += c; if (bb < me) so += c; } part[p * 32 + e] = s; part[512 + p * 32 + e] = so; }
    __syncthreads();
    if (tid < 32) { int s = 0, so = 0; for (int p = 0; p < 16; ++p) { s += part[p * 32 + tid]; so += part[512 + p * 32 + tid]; } tot[tid] = s; off[tid] = so; }
    __syncthreads();
    if (tid == 0) { int acc = 0; for (int e = 0; e < 32; ++e) { pstart[e] = acc; acc += ((tot[e] + 255) >> 8) << 8; } }
    __syncthreads();
    if (me == 0 && tid < 32) ((int*)(a->ws + WS_CNT))[l * 32 + tid] = tot[tid];
    const int* tokE = (const int*)(a->ws + WS_TOKE); const int* tokR = (const int*)(a->ws + WS_TOKR);
    int* tokS = (int*)(a->ws + WS_TOKS); int* slotT = (int*)(a->ws + WS_SLOTT);
    for (int q = tid; ; q += NT) { const int it = q >> 4, j = q & 15, t = (it * G + me) * 8 + (j >> 1); if (t >= ntok) break;
        const int idx = 2 * t + (j & 1); const int e = tokE[idx]; const int slot = pstart[e] + off[e] + tokR[idx]; tokS[idx] = slot; slotT[slot] = t; }
    __syncthreads();
}

__device__ __forceinline__ void moe_table(AP a, int l, LAS int* blk) {
    const int* tot = (const int*)(a->ws + WS_CNT) + l * 32;
    if (threadIdx.x == 0) { int acc = 0; for (int e = 0; e < 32; ++e) { const int c = tot[e]; blk[e] = acc; blk[33 + e] = c; acc += (c + 255) >> 8; } blk[32] = acc; }
    __syncthreads();
}
__device__ __forceinline__ int units_of(int nu, int v, int G) { return (v < nu) ? (nu - v + G - 1) / G : 0; }
__device__ __forceinline__ void p1_inproj(AP a, unsigned char* smem, LAS unsigned char* lds, int l) {
    SchedInProj S; S.ws = a->ws; S.l = l; S.G = gridDim.x; S.me = vblock();
    g256::gemm_phase(lds, 1024, S);
    if (l == 0) { const int nu = 64 * 7 + 4 * 7, G = gridDim.x; if (units_of(nu, S.me, G) < (nu + G - 1) / G) exp_fill(a, smem, 0, 8); }
}
__device__ __forceinline__ void p3_outproj(AP a, unsigned char* smem, LAS unsigned char* lds, int l) {
    SchedOutProj S; S.ws = a->ws; S.l = l; S.G = gridDim.x; S.me = vblock();
    g256::gemm_phase(lds, 1024, S);
    if (l == 0) {
        const bf16_t* W = (const bf16_t*)(a->ws + WS_WOUT);
        for (int u = blockIdx.x; u < 64; u += gridDim.x) { const int rt = u >> 3, ct = u & 7;
            EpiBf16 E; E.C = (bf16_t*)(a->ws + WS_Y) + (size_t)(NLAT + rt * 128) * D + ct * 128; E.ld = D; E.scale = 1.0f;
            const bf16_t* B0 = W + (size_t)(ct * 128) * 1024;
            gemm_tile<128, false, EpiBf16>(lds, (const bf16_t*)(a->ws + WS_CAT) + (size_t)(NLAT + rt * 128) * D, D, nullptr, 128, B0, B0 + (size_t)64 * 1024, 1024, 1024, E); }
        if (blockIdx.x >= 64) exp_fill(a, smem, 0, 3);
    }
}
__device__ __forceinline__ void p6_gateup(AP a, unsigned char* smem, LAS unsigned char* lds, int l) {
    LAS int* blk = (LAS int*)(lds + MISC_OFF + 256);
    moe_table(a, l, blk);
    LAS int* ridx = (LAS int*)(lds + RIDX_OFF);
    const int tid = tid_opaque(), G = gridDim.x, me = vblock(), nu = blk[32] * 4;
    const int* slotT = (const int*)(a->ws + WS_SLOTT);
    for (int i = 0; i < 8; ++i) { const int idx = i * G + me; if (idx >= nu) break;
        const int rb = idx >> 2; int e = 0; for (int q = 1; q < 32; ++q) if (blk[q] <= rb) e = q;
        const int valid = min(256, blk[33 + e] - (rb - blk[e]) * 256);
        if (tid < 256) ridx[i * 256 + tid] = (tid < valid) ? slotT[rb * 256 + tid] : 0; }
    __syncthreads();
    SchedGateUp S; S.ws = a->ws; S.blk = blk; S.tot = blk + 33; S.ridx_lds = ridx; S.G = G; S.me = me; S.l = l;
    g256::gemm_phase(lds, 512, S);
    __syncthreads();
    if (l == 0 && units_of(nu, me, G) < (nu + G - 1) / G) exp_fill(a, smem, 1, 8);
}
__device__ __forceinline__ void p7_down(AP a, unsigned char* smem, LAS unsigned char* lds, int l) {
    LAS int* blk = (LAS int*)(lds + MISC_OFF + 256);
    moe_table(a, l, blk);
    SchedDown S; S.ws = a->ws; S.blk = blk; S.G = gridDim.x; S.me = vblock(); S.l = l;
    g256::gemm_phase(lds, 256, S);
    __syncthreads();
    { const int nu = uni(blk[32]) * 4, G = gridDim.x; if (l == 0 && units_of(nu, S.me, G) < (nu + G - 1) / G) exp_fill(a, smem, 1, 5); }
}

__device__ __forceinline__ void p8_ln2(AP a, unsigned char* lds, int l) {
    const int tid = tid_opaque(), lane = tid & 63, w = tid >> 6;
    const int ntok = (l == 0) ? NTOK : NLAT;
    const float* mod = (const float*)(a->ws + WS_MOD) + (size_t)l * 5 * 6144;
    const float* modn = (const float*)(a->ws + WS_MOD) + (size_t)5 * 6144;
    const float* X1 = (const float*)(a->ws + WS_X1);
    const bf16_t* YS = (const bf16_t*)(a->ws + WS_YS);
    const int* tokS = (const int*)(a->ws + WS_TOKS); const float* tokG = (const float*)(a->ws + WS_TOKG);
    f32x4* Lgb = (f32x4*)lds;
    __syncthreads();
    Lgb[tid] = (tid < 256) ? *(const f32x4*)(a->in[21] + l * 1024 + tid * 4) : *(const f32x4*)(a->in[22] + l * 1024 + (tid - 256) * 4);
    __syncthreads();
    int mrow = -1; f32x4 mg[4], nsh[4], nsc[4];
    const int tstep = gridDim.x * 8;
    int t = blockIdx.x * 8 + w;
    int ns0 = 0, ns1 = 0; float nga = 0.f, ngb = 0.f;
    f32x4 nx[4]; u32x2 nya[4], nyb[4];
    float cga = 0.f, cgb = 0.f;
    if (t < ntok) { const int s0 = tokS[2 * t], s1 = tokS[2 * t + 1]; cga = tokG[2 * t]; cgb = tokG[2 * t + 1];
#pragma unroll
        for (int i = 0; i < 4; ++i) { const int c = 256 * i + 4 * lane; nx[i] = *(const f32x4*)(X1 + (size_t)t * D + c); nya[i] = *(const u32x2*)(YS + (size_t)s0 * D + c); nyb[i] = *(const u32x2*)(YS + (size_t)s1 * D + c); } }
    if (t + tstep < ntok) { ns0 = tokS[2 * (t + tstep)]; ns1 = tokS[2 * (t + tstep) + 1]; nga = tokG[2 * (t + tstep)]; ngb = tokG[2 * (t + tstep) + 1]; }
    for (; t < ntok; t += tstep) {
        const int mr = (t < NLAT) ? (t >> 12) : 4;
        if (mr != mrow) { mrow = mr; const float* m = mod + (size_t)mr * 6144; const float* mn = modn + (size_t)mr * 6144;
#pragma unroll
            for (int i = 0; i < 4; ++i) { const int c = 256 * i + 4 * lane; mg[i] = *(const f32x4*)(m + 5120 + c); if (l == 0) { nsh[i] = *(const f32x4*)(mn + c); nsc[i] = *(const f32x4*)(mn + 1024 + c); } } }
        f32x4 v[4];
#pragma unroll
        for (int i = 0; i < 4; ++i) { const f32x4 gv = mg[i];
            const u32x2 ya = nya[i], yb = nyb[i];
            const float f0 = cga * lo2f(ya.x) + cgb * lo2f(yb.x), f1 = cga * hi2f(ya.x) + cgb * hi2f(yb.x), f2 = cga * lo2f(ya.y) + cgb * lo2f(yb.y), f3 = cga * hi2f(ya.y) + cgb * hi2f(yb.y);
            v[i][0] = RES_ALPHA * nx[i][0] + gv[0] * f0; v[i][1] = RES_ALPHA * nx[i][1] + gv[1] * f1; v[i][2] = RES_ALPHA * nx[i][2] + gv[2] * f2; v[i][3] = RES_ALPHA * nx[i][3] + gv[3] * f3; }
        {   const int tn = t + tstep, tn2 = t + 2 * tstep;
            if (tn < ntok) {
#pragma unroll
                for (int i = 0; i < 4; ++i) { const int c = 256 * i + 4 * lane; nx[i] = *(const f32x4*)(X1 + (size_t)tn * D + c); nya[i] = *(const u32x2*)(YS + (size_t)ns0 * D + c); nyb[i] = *(const u32x2*)(YS + (size_t)ns1 * D + c); }
                cga = nga; cgb = ngb; }
            if (tn2 < ntok) { ns0 = tokS[2 * tn2]; ns1 = tokS[2 * tn2 + 1]; nga = tokG[2 * tn2]; ngb = tokG[2 * tn2 + 1]; } }
        float mean, rstd; ln_stats(v, mean, rstd);
        float* dst = (l == 0) ? (float*)(a->ws + WS_XC) + (size_t)t * D : a->out + (size_t)t * D;
#pragma unroll
        for (int i = 0; i < 4; ++i) { const int c = 256 * i + 4 * lane; const f32x4 gg = Lgb[64 * i + lane], bb = Lgb[256 + 64 * i + lane];
#pragma unroll
            for (int e = 0; e < 4; ++e) v[i][e] = (v[i][e] - mean) * rstd * gg[e] + bb[e];
            *(f32x4*)(dst + c) = v[i]; }
        if (l == 0) {
            ln_stats(v, mean, rstd);
            bf16_t* H = (bf16_t*)(a->ws + WS_H);
#pragma unroll
            for (int i = 0; i < 4; ++i) { const int c = 256 * i + 4 * lane; const f32x4 sh = nsh[i], sc = nsc[i];
                f32x4 o;
#pragma unroll
                for (int e = 0; e < 4; ++e) o[e] = (v[i][e] - mean) * rstd * (1.0f + sc[e]) + sh[e];
                u32x2 pk; pk.x = pack2(o[0], o[1]); pk.y = pack2(o[2], o[3]); *(u32x2*)(H + (size_t)t * D + c) = pk; }
        }
    }
}

constexpr int N_PHASES = 18;
template <int P> __device__ __forceinline__ void run_phase(AP a, unsigned char* smem, LAS unsigned char* lds, int l) {
    asm volatile("" : "+s"(a));
    if (P == 0) p0_prologue(a, smem);
    if (P == 1) p_lnmod0(a);
    if (P == 2) p1_inproj(a, smem, lds, l);
    if (P == 3) p2_mix(a, smem, lds, l);
    if (P == 4) p3_outproj(a, smem, lds, l);
    if (P == 5) p4_ln1_router(a, smem, l);
    if (P == 6) p5_dispatch(a, smem, l);
    if (P == 7) p6_gateup(a, smem, lds, l);
    if (P == 8) p7_down(a, smem, lds, l);
    if (P == 9) p8_ln2(a, smem, l);
}
#if N_LAUNCH_MODE == 1
__global__ void __launch_bounds__(NT, 2) fwd(Args a) {
    extern __shared__ __attribute__((aligned(16))) unsigned char smem[];
    LAS unsigned char* lds = (LAS unsigned char*)smem;
    if (threadIdx.x < 4) ((volatile LAS unsigned*)(lds + MISC_OFF + 768))[threadIdx.x] = 0u;
    __syncthreads();
    XcdBarrier bar = xcd_barrier_post((unsigned*)(a.ws + WS_BAR), (volatile LAS unsigned*)(lds + MISC_OFF + 768));
    AP ap = (AP)__builtin_amdgcn_kernarg_segment_ptr();
#define PROBE(P, l) do { if (PROBE_MASK & (1 << (P))) { for (int _r = 0; _r < 2; ++_r) { xcd_barrier(bar); run_phase<P>(ap, smem, lds, l); } } } while (0)
    run_phase<0>(ap, smem, lds, 0); PROBE(0, 0); xcd_barrier(bar);
    run_phase<1>(ap, smem, lds, 0); PROBE(1, 0); xcd_barrier(bar);
    for (int l = 0; l < 2; ++l) {
        run_phase<2>(ap, smem, lds, l); PROBE(2, l); xcd_barrier(bar);
        run_phase<3>(ap, smem, lds, l); PROBE(3, l); xcd_barrier(bar);
        run_phase<4>(ap, smem, lds, l); PROBE(4, l); xcd_barrier(bar);
        run_phase<5>(ap, smem, lds, l); PROBE(5, l); xcd_barrier(bar);
        run_phase<6>(ap, smem, lds, l); PROBE(6, l); xcd_barrier(bar);
        run_phase<7>(ap, smem, lds, l); PROBE(7, l); xcd_barrier(bar);
        run_phase<8>(ap, smem, lds, l); PROBE(8, l); xcd_barrier(bar);
        run_phase<9>(ap, smem, lds, l); PROBE(9, l); if (l == 0) xcd_barrier(bar);
    }
}
#else
template <int P> __global__ void __launch_bounds__(NT, 2) k_phase(Args a) {
    extern __shared__ __attribute__((aligned(16))) unsigned char smem[];
    LAS unsigned char* lds = (LAS unsigned char*)smem;
    AP ap = (AP)__builtin_amdgcn_kernarg_segment_ptr();
    run_phase<P>(ap, smem, lds, ap->ph_lo);
}
template <int P> static void launch_phase(Args a, int l, int grid, hipStream_t stream) {
    static bool attr = false;
    if (!attr) { (void)hipFuncSetAttribute((const void*)k_phase<P>, hipFuncAttributeMaxDynamicSharedMemorySize, LDS_BYTES); attr = true; }
    a.ph_lo = l; a.ph_hi = P;
    hipLaunchKernelGGL(k_phase<P>, dim3(grid), dim3(NT), LDS_BYTES, stream, a);
}
#endif

extern "C" void kernel_launch(void* const* d_in, const int* in_sizes, int n_in, void* d_out, int out_size, void* d_ws, size_t ws_size, hipStream_t stream) {
    static int grid = 0;
    if (grid == 0) {
        if (n_in != 23 || out_size != NLAT * D || ws_size < WS_END) { fprintf(stderr, "kernel_launch: unexpected shapes (n_in %d, out %d, ws %zu, need %zu)\n", n_in, out_size, ws_size, (size_t)WS_END); grid = -1; return; }
        int dev = 0, cus = 0;
        if (hipGetDevice(&dev) != hipSuccess || hipDeviceGetAttribute(&cus, hipDeviceAttributeMultiprocessorCount, dev) != hipSuccess) { grid = -1; return; }
#if N_LAUNCH_MODE == 1
        int per_cu = 0;
        if (hipFuncSetAttribute((const void*)fwd, hipFuncAttributeMaxDynamicSharedMemorySize, LDS_BYTES) != hipSuccess) { fprintf(stderr, "kernel_launch: hipFuncSetAttribute failed\n"); grid = -1; return; }
        if (hipOccupancyMaxActiveBlocksPerMultiprocessor(&per_cu, (const void*)fwd, NT, LDS_BYTES) != hipSuccess || per_cu < 1) { fprintf(stderr, "kernel_launch: occupancy query says %d\n", per_cu); }
        (void)hipGetLastError();
#endif
        grid = cus; if (grid > MAXG) grid = MAXG;
    }
    if (grid < 0) return;
    (void)hipMemsetAsync((char*)d_ws + WS_BAR, 0, 16384 + 256, stream);
    Args a{};
    for (int i = 0; i < 23; ++i) a.in[i] = (const float*)d_in[i];
    a.out = (float*)d_out; a.ws = (unsigned char*)d_ws;
#if N_LAUNCH_MODE == 1
    a.ph_lo = 0; a.ph_hi = N_PHASES;
    hipLaunchKernelGGL(fwd, dim3(grid), dim3(NT), LDS_BYTES, stream, a);
#else
    launch_phase<0>(a, 0, grid, stream);
    launch_phase<1>(a, 0, grid, stream);
    for (int l = 0; l < 2; ++l) {
        launch_phase<2>(a, l, grid, stream); launch_phase<3>(a, l, grid, stream); launch_phase<4>(a, l, grid, stream); launch_phase<5>(a, l, grid, stream);
        launch_phase<6>(a, l, grid, stream); launch_phase<7>(a, l, grid, stream); launch_phase<8>(a, l, grid, stream); launch_phase<9>(a, l, grid, stream);
    }
#endif
}
```

```cpp
#include <hip/hip_runtime.h>
#include <stdint.h>
#include <stdio.h>

#ifndef PROBE_MASK
#define PROBE_MASK 0
#endif
#ifndef PROBE_FFT_REP
#define PROBE_FFT_REP 1
#endif
#ifndef PROBE_MIX_REP
#define PROBE_MIX_REP 1
#endif
#ifndef PROBE_SGU_REP
#define PROBE_SGU_REP 1
#endif
#ifndef N_LAUNCH_MODE
#define N_LAUNCH_MODE 1
#endif

#define LAS __attribute__((address_space(3)))
typedef unsigned short bf16_t;
typedef short bf16x8 __attribute__((ext_vector_type(8)));
typedef float f32x4 __attribute__((ext_vector_type(4)));
typedef unsigned u32x4 __attribute__((ext_vector_type(4)));
typedef unsigned u32x2 __attribute__((ext_vector_type(2)));
typedef float f32x2 __attribute__((ext_vector_type(2)));
typedef int i32x4 __attribute__((ext_vector_type(4)));

constexpr int D = 1024, NBATCH = 4, SEQ = 4096, CTXL = 256;
constexpr int NLAT = NBATCH * SEQ, NCTX = NBATCH * CTXL, NTOK = NLAT + NCTX;
constexpr int ZC = 1792;
constexpr int NEXP = 32, DEXP = 512;
constexpr int NSLOT = 2 * NTOK + NEXP * 256;
constexpr int NT = 512;
constexpr int MAXG = 512;
constexpr float RES_ALPHA = 1.41421356237309515f;
constexpr int MISC_OFF = 155648;
constexpr int RIDX_OFF = 131072;
constexpr int LDS_BYTES = MISC_OFF + 1024;

constexpr size_t WS_BAR   = 0;
constexpr size_t WS_CNT   = 16384;
constexpr size_t WS_BCNT  = WS_CNT + 256;
constexpr size_t WS_MOD   = WS_BCNT + (size_t)2 * MAXG * 32 * 4;
constexpr size_t WS_ROPE  = WS_MOD + (size_t)2 * 5 * 6144 * 4;
constexpr size_t WS_TOKE  = WS_ROPE + 8192;
constexpr size_t WS_TOKR  = WS_TOKE + (size_t)NTOK * 8;
constexpr size_t WS_TOKS  = WS_TOKR + (size_t)NTOK * 8;
constexpr size_t WS_TOKG  = WS_TOKS + (size_t)NTOK * 8;
constexpr size_t WS_SLOTT = WS_TOKG + (size_t)NTOK * 8;
constexpr size_t WS_WIN   = WS_SLOTT + (size_t)NSLOT * 4;
constexpr size_t WS_WOUT  = WS_WIN + (size_t)2 * ZC * 1024 * 2;
constexpr size_t WS_WSGU  = WS_WOUT + (size_t)2 * 1024 * 1024 * 2;
constexpr size_t WS_DFTC  = WS_WSGU + (size_t)2 * 4 * 128 * 128 * 2;
constexpr size_t WS_WEXP  = WS_DFTC + (size_t)256 * 512 * 2;
constexpr size_t EXPMAT   = (size_t)NEXP * 512 * 1024;
constexpr size_t WEXP_LAYER = 3 * EXPMAT;
constexpr size_t WS_X1    = WS_WEXP + 2 * WEXP_LAYER;
constexpr size_t WS_XC    = WS_X1 + (size_t)NTOK * D * 4;
constexpr size_t WS_H     = WS_XC + (size_t)NTOK * D * 4;
constexpr size_t WS_R     = WS_H + (size_t)NTOK * D * 2;
constexpr size_t WS_Z     = WS_R;
constexpr size_t WS_AT    = WS_Z + (size_t)NTOK * ZC * 2;
constexpr size_t WS_ATC   = WS_AT + (size_t)4 * 256 * 8192 * 2;
constexpr size_t WS_VT    = WS_ATC + (size_t)4 * 256 * 512 * 2;
constexpr size_t WS_VTC   = WS_VT + (size_t)4 * 2 * 64 * 4096 * 2;
constexpr size_t WS_CAT   = WS_VTC + (size_t)4 * 2 * 64 * 256 * 2;
constexpr size_t WS_REND  = WS_CAT + (size_t)NTOK * D * 2;
constexpr size_t WS_Y     = WS_R;
constexpr size_t WS_HID   = WS_R;
constexpr size_t WS_YS    = WS_HID + (size_t)NSLOT * DEXP * 2;
constexpr size_t WS_REND2 = (WS_YS + (size_t)NSLOT * D * 2 > WS_REND) ? WS_YS + (size_t)NSLOT * D * 2 : WS_REND;
constexpr size_t WS_H8    = (WS_REND2 + 255) & ~(size_t)255;
constexpr size_t WS_END   = WS_H8 + (size_t)NTOK * D;
static_assert(WS_Y + (size_t)NTOK * D * 4 <= WS_CAT, "Y must not reach CAT");
static_assert(WS_WIN % 256 == 0 && WS_DFTC % 256 == 0 && WS_WEXP % 256 == 0 && WS_X1 % 256 == 0 && WS_H % 256 == 0 && WS_R % 256 == 0 && WS_AT % 256 == 0 && WS_CAT % 256 == 0 && WS_YS % 256 == 0, "alignment");

struct Args { const float* in[23]; float* out; unsigned char* ws; int ph_lo, ph_hi; };
#define CAS __attribute__((address_space(4)))
typedef const CAS Args* AP;

#define XB_TMO      128
#define XB_XCNT(j)  (256  + 64 * (j))
#define XB_XSUB(j)  (1280 + 64 * (j))
#define XB_XGEN(j)  (2304 + 64 * (j))
#define XB_TOP      3328
#define XB_TOPGEN   3392
#define XCD_BAR_WORDS 3456
#define XB_SPIN_CAP (1u << 18)

__device__ __forceinline__ unsigned xb_ld(unsigned* p)              { return __hip_atomic_load(p, __ATOMIC_RELAXED, __HIP_MEMORY_SCOPE_AGENT); }
__device__ __forceinline__ unsigned xb_add(unsigned* p, unsigned v) { return __hip_atomic_fetch_add(p, v, __ATOMIC_RELAXED, __HIP_MEMORY_SCOPE_AGENT); }
__device__ __forceinline__ unsigned xb_xcc_id() { return (unsigned)__builtin_amdgcn_s_getreg((3 << 11) | 20) & 0xFu; }
#define XB_SPIN(cond, bar) do { unsigned _sp = 0; while (cond) { __builtin_amdgcn_s_sleep(1); \
    if ((++_sp & 255u) == 0u) { if (xb_ld(&(bar)[XB_TMO])) break; if (_sp > XB_SPIN_CAP) { atomicAdd(&(bar)[XB_TMO], 1u); break; } } } } while (0)

struct XcdBarrier { unsigned* bar; unsigned x; volatile LAS unsigned* st; };

__device__ __forceinline__ XcdBarrier xcd_barrier_post(unsigned* bar, volatile LAS unsigned* st) {
    XcdBarrier b; b.bar = bar; b.x = (unsigned)__builtin_amdgcn_readfirstlane((int)xb_xcc_id()); b.st = st;
    if (threadIdx.x == 0) (void)xb_add(&bar[XB_XCNT(b.x)], 1u);
    return b;
}
__device__ __forceinline__ void xcd_barrier_complete(unsigned* bar, unsigned x, unsigned& nloc, unsigned& nx) {
    const unsigned G = gridDim.x * gridDim.y * gridDim.z;
    unsigned sum, cnt, mine, sp = 0u;
    for (;;) {
        sum = 0u; cnt = 0u; mine = 0u;
#pragma unroll
        for (unsigned j = 0; j < 16; ++j) { const unsigned c = xb_ld(&bar[XB_XCNT(j)]); sum += c; cnt += (c > 0u) ? 1u : 0u; mine = (j == x) ? c : mine; }
        if (sum == G) break;
        __builtin_amdgcn_s_sleep(1);
        if ((++sp & 255u) == 0u) { if (xb_ld(&bar[XB_TMO])) break; if (sp > XB_SPIN_CAP) { atomicAdd(&bar[XB_TMO], 1u); break; } }
    }
    nloc = mine > 0u ? mine : 1u; nx = cnt > 0u ? cnt : 1u;
}
__device__ __forceinline__ void xcd_barrier(const XcdBarrier& b) {
    asm volatile("s_waitcnt vmcnt(0)" ::: "memory");
    __syncthreads();
    if (threadIdx.x == 0) {
        unsigned* bar = b.bar;
        unsigned bx = b.x;
        asm volatile("" : "+s"(bar), "+s"(bx));
        __builtin_amdgcn_s_waitcnt(0);
        unsigned nloc = b.st[0], nx = b.st[1];
        if (nloc == 0u) { xcd_barrier_complete(bar, bx, nloc, nx); b.st[0] = nloc; b.st[1] = nx; }
        const unsigned old = xb_add(&bar[XB_XSUB(bx)], 1u);
        const unsigned gen = old / nloc;
        if (old + 1u == (gen + 1u) * nloc) {
            __builtin_amdgcn_fence(__ATOMIC_RELEASE, "agent");
            asm volatile("s_waitcnt vmcnt(0)" ::: "memory");
            const unsigned og = xb_add(&bar[XB_TOP], 1u);
            const unsigned tg = og / nx;
            if (og + 1u == (tg + 1u) * nx) xb_add(&bar[XB_TOPGEN], 1u);
            else XB_SPIN(xb_ld(&bar[XB_TOPGEN]) == tg, bar);
            __builtin_amdgcn_fence(__ATOMIC_ACQUIRE, "agent");
            xb_add(&bar[XB_XGEN(bx)], 1u);
            asm volatile("s_waitcnt vmcnt(0)" ::: "memory");
        } else {
            XB_SPIN(xb_ld(&bar[XB_XGEN(bx)]) == gen, bar);
            __builtin_amdgcn_fence(__ATOMIC_ACQUIRE, "agent");
            asm volatile("s_waitcnt vmcnt(0)" ::: "memory");
        }
    }
    __syncthreads();
}

__device__ __forceinline__ int tid_opaque() { int t = threadIdx.x; asm volatile("" : "+v"(t)); return t; }
__device__ __forceinline__ float bf2f(bf16_t v) { return __uint_as_float(((unsigned)v) << 16); }
__device__ __forceinline__ bf16_t f2bf(float f) { return __builtin_bit_cast(unsigned short, (__bf16)f); }
typedef __bf16 hwbf16x2 __attribute__((ext_vector_type(2)));
__device__ __forceinline__ unsigned pack2(float a, float b) { return __builtin_bit_cast(unsigned, __builtin_convertvector((f32x2){a, b}, hwbf16x2)); }
__device__ __forceinline__ unsigned pack4_fp8(float a, float b, float c, float d) {
    a = __builtin_amdgcn_fmed3f(a, -448.f, 448.f); b = __builtin_amdgcn_fmed3f(b, -448.f, 448.f); c = __builtin_amdgcn_fmed3f(c, -448.f, 448.f); d = __builtin_amdgcn_fmed3f(d, -448.f, 448.f);
    int p = __builtin_amdgcn_cvt_pk_fp8_f32(a, b, 0, false); p = __builtin_amdgcn_cvt_pk_fp8_f32(c, d, p, true); return (unsigned)p; }
__device__ __forceinline__ float lo2f(unsigned w) { return __uint_as_float(w << 16); }
__device__ __forceinline__ float hi2f(unsigned w) { return __uint_as_float(w & 0xffff0000u); }
template <int CTRL> __device__ __forceinline__ float dpp_mov(float v) { return __builtin_bit_cast(float, __builtin_amdgcn_update_dpp(0, __builtin_bit_cast(int, v), CTRL, 0xf, 0xf, true)); }
__device__ __forceinline__ float row_sum16(float v) {
    v += dpp_mov<0xB1>(v);
    v += dpp_mov<0x4E>(v);
    v += dpp_mov<0x141>(v);
    v += dpp_mov<0x140>(v);
    return v;
}
__device__ __forceinline__ float row_max16(float v) {
    v = fmaxf(v, dpp_mov<0xB1>(v)); v = fmaxf(v, dpp_mov<0x4E>(v)); v = fmaxf(v, dpp_mov<0x141>(v)); v = fmaxf(v, dpp_mov<0x140>(v));
    return v;
}
__device__ __forceinline__ float wave_sum(float v) {
    v = row_sum16(v);
    const int iv = __builtin_bit_cast(int, v);
    const float a0 = __builtin_bit_cast(float, __builtin_amdgcn_readlane(iv, 0)), a1 = __builtin_bit_cast(float, __builtin_amdgcn_readlane(iv, 16));
    const float a2 = __builtin_bit_cast(float, __builtin_amdgcn_readlane(iv, 32)), a3 = __builtin_bit_cast(float, __builtin_amdgcn_readlane(iv, 48));
    return (a0 + a1) + (a2 + a3);
}
__device__ __forceinline__ float gelu_erf(float v) {
    const float t = __builtin_amdgcn_rcpf(fabsf(v) * 0.2316418882f + 1.0f);
    float q = t * 0.5307027145f + (-0.7265760135f); q = q * t + 0.7107068705f; q = q * t + (-0.142248368f); q = q * t + 0.127414796f; q = q * t;
    const float m = v * (q * __builtin_amdgcn_exp2f((v * v) * (-0.72134752044f)));
    return v < 0.f ? m : v - m;
}
__device__ __forceinline__ float silu_f(float x) { return x * __builtin_amdgcn_rcpf(1.0f + __expf(-x)); }

__device__ __forceinline__ void ln_stats(const f32x4 (&v)[4], float& mean, float& rstd) {
    float s = 0.f;
#pragma unroll
    for (int i = 0; i < 4; ++i) s += (v[i][0] + v[i][1]) + (v[i][2] + v[i][3]);
    s = wave_sum(s); mean = s * (1.0f / 1024.0f);
    float q = 0.f;
#pragma unroll
    for (int i = 0; i < 4; ++i)
#pragma unroll
        for (int e = 0; e < 4; ++e) { const float d = v[i][e] - mean; q += d * d; }
    q = wave_sum(q); rstd = 1.0f / sqrtf(q * (1.0f / 1024.0f) + 1e-6f);
}

template <int BN> struct MfmaLayout {
    static constexpr int FG = BN / 128, NI = 4, NJ = 2 * FG;
    static constexpr bool PAIR8 = false;
    int rbase, cbase;
    __device__ __forceinline__ int row(int i) const { return rbase + 16 * i; }
    __device__ __forceinline__ int col(int jj) const { return (jj / FG) * (BN / 2) + (jj % FG) * 16 + cbase; }
};

__device__ __forceinline__ void glds16(const bf16_t* g, LAS unsigned char* l) {
    __builtin_amdgcn_global_load_lds((const unsigned*)g, (LAS unsigned*)l, 16, 0, 0);
}

template <int BN, bool GATHER, class Epi>
__device__ __forceinline__ void gemm_tile(LAS unsigned char* lds, const bf16_t* A, int lda, const int* rowidx, int valid_rows,
                                          const bf16_t* B0, const bf16_t* B1, int ldb, int K, const Epi& epi) {
    constexpr int A_B = 16384, B_B = BN * 128, STAGE = A_B + B_B, NBL = BN / 64;
    const int tid = tid_opaque(), lane = tid & 63, wid = __builtin_amdgcn_readfirstlane(tid >> 6);
    const bf16_t* ap[2]; const bf16_t* bp[NBL];
#pragma unroll
    for (int i = 0; i < 2; ++i) {
        const int P = i * 512 + tid, row = P >> 3, c = (P & 7) ^ ((row >> 1) & 7);
        size_t ro;
        if (GATHER) ro = (size_t)(row < valid_rows ? rowidx[row] : 0) * (size_t)lda; else ro = (size_t)row * (size_t)lda;
        ap[i] = A + ro + c * 8;
    }
#pragma unroll
    for (int i = 0; i < NBL; ++i) {
        const int P = i * 512 + tid, row = P >> 3, c = (P & 7) ^ ((row >> 1) & 7);
        const bf16_t* base = (row < BN / 2) ? (B0 + (size_t)row * ldb) : (B1 + (size_t)(row - BN / 2) * ldb);
        bp[i] = base + c * 8;
    }
    const int nk = K / 64;
#define GT_STAGE(buf, k0) do { \
        _Pragma("unroll") for (int _i = 0; _i < 2; ++_i) glds16(ap[_i] + (k0), lds + (buf) * STAGE + _i * 8192 + wid * 1024); \
        _Pragma("unroll") for (int _i = 0; _i < NBL; ++_i) glds16(bp[_i] + (k0), lds + (buf) * STAGE + A_B + _i * 8192 + wid * 1024); } while (0)

    typedef MfmaLayout<BN> Lay;
    constexpr int FG = Lay::FG;
    const int fr = lane & 15, g = lane >> 4, wr = wid >> 2, wc = wid & 3;
    Lay lay; lay.rbase = wr * 64 + fr; lay.cbase = wc * 16 * FG + 4 * g;
    f32x4 acc[Lay::NI][Lay::NJ];
#pragma unroll
    for (int i = 0; i < Lay::NI; ++i)
#pragma unroll
        for (int j = 0; j < Lay::NJ; ++j) acc[i][j] = (f32x4){0.f, 0.f, 0.f, 0.f};
    int aoff[4], boff[Lay::NJ];
#pragma unroll
    for (int m = 0; m < 4; ++m) { const int row = wr * 64 + m * 16 + fr; aoff[m] = row * 128 + ((g ^ ((row >> 1) & 7)) << 4); }
#pragma unroll
    for (int jj = 0; jj < Lay::NJ; ++jj) { const int row = (jj / FG) * (BN / 2) + wc * 16 * FG + (jj % FG) * 16 + fr; boff[jj] = A_B + row * 128 + ((g ^ ((row >> 1) & 7)) << 4); }
    GT_STAGE(0, 0);
    asm volatile("s_waitcnt vmcnt(0)" ::: "memory"); __syncthreads();
    for (int kt = 0; kt < nk; ++kt) {
        if (kt + 1 < nk) GT_STAGE((kt + 1) & 1, (kt + 1) * 64);
        const LAS unsigned char* sa = lds + (kt & 1) * STAGE;
#pragma unroll
        for (int ks = 0; ks < 2; ++ks) {
            bf16x8 af[4], bfv[Lay::NJ];
#pragma unroll
            for (int m = 0; m < 4; ++m) af[m] = *(const LAS bf16x8*)(sa + (aoff[m] ^ (ks << 6)));
#pragma unroll
            for (int jj = 0; jj < Lay::NJ; ++jj) bfv[jj] = *(const LAS bf16x8*)(sa + (boff[jj] ^ (ks << 6)));
#pragma unroll
            for (int m = 0; m < 4; ++m)
#pragma unroll
                for (int jj = 0; jj < Lay::NJ; ++jj) acc[m][jj] = __builtin_amdgcn_mfma_f32_16x16x32_bf16(bfv[jj], af[m], acc[m][jj], 0, 0, 0);
        }
        asm volatile("s_waitcnt vmcnt(0)" ::: "memory"); __syncthreads();
    }
    epi.run(acc, lay);
#undef GT_STAGE
}

namespace g256 {
constexpr int BK = 64, HALF = 128, HTB = HALF * BK * 2, STAGE_BYTES = 8 * HTB;
__device__ __forceinline__ int lds_byte(int r, int c) { const int st = (r >> 4) * 2 + (c >> 5), rr = r & 15, cc = c & 31, ob = rr * 64 + cc * 2; return st * 1024 + (ob ^ (((ob >> 9) & 1) << 5)); }
__device__ __forceinline__ int perm32(int rho) { const int n = rho >> 4, i = rho & 15; return 8 * (i >> 2) + 4 * n + (i & 3); }
__device__ __forceinline__ void stage_rc(int b, int& R, int& C) { const int st = b / 1024, sb = b % 1024, swz = sb ^ (((sb >> 9) & 1) << 5); R = (st >> 1) * 16 + swz / 64; C = (st & 1) * 32 + (swz % 64) / 2; }
struct Lay {
    static constexpr int NI = 8, NJ = 4;
    static constexpr bool PAIR8 = true;
    int rbase, cbase;
    __device__ __forceinline__ int row(int i) const { return (i >> 2) * 128 + (i & 3) * 16 + rbase; }
    __device__ __forceinline__ int col(int j) const { return (j >> 1) * 128 + (j & 1) * 4 + cbase; }
};
template <class Epi> struct Unit { const bf16_t* A; const bf16_t* B0; const bf16_t* B1; const LAS int* ridx; int valid; Epi epi; };

template <class Sched>
__device__ __forceinline__ void gemm_phase(LAS unsigned char* lds, const int K, const Sched& S) {
    typedef typename Sched::Epi Epi;
    const int tid = tid_opaque(), wid = __builtin_amdgcn_readfirstlane(tid >> 6), lane = tid & 63, wr = wid >> 2, wc = wid & 3, fr = lane & 15, fq = lane >> 4;
    int nt = K / BK; asm volatile("" : "+s"(nt));
    int sR[2], sC[2];
#pragma unroll
    for (int i = 0; i < 2; ++i) stage_rc(tid * 16 + i * 8192, sR[i], sC[i]);
    unsigned voffB[2];
#pragma unroll
    for (int i = 0; i < 2; ++i) voffB[i] = (unsigned)(((sR[i] & ~31) + perm32(sR[i] & 31)) * K + sC[i]) * 2u;
    const size_t kstep = (size_t)(BK * 2);
    const unsigned ldsw = (unsigned)wid * 1024u;
    const int aoff = lds_byte(wr * 64 + fr, fq * 8), boff = lds_byte(wc * 32 + fr, fq * 8);
#define G2_SA(b, h) (((b) * 2 + (h)) * HTB)
#define G2_SB(b, h) ((4 + (b) * 2 + (h)) * HTB)
#define G2_STAGE(bufoff, gbase, v0, v1) do { \
        __builtin_amdgcn_global_load_lds((const unsigned*)((const char*)(gbase) + (v0)), (LAS unsigned*)(lds + (bufoff) + ldsw), 16, 0, 0); \
        __builtin_amdgcn_global_load_lds((const unsigned*)((const char*)(gbase) + (v1)), (LAS unsigned*)(lds + (bufoff) + ldsw + 8192), 16, 0, 0); } while (0)
#define G2_LDA(dst, b, h) do { _Pragma("unroll") for (int m = 0; m < 4; ++m) _Pragma("unroll") for (int k = 0; k < 2; ++k) dst[m][k] = *(const LAS bf16x8*)(lds + G2_SA(b, h) + aoff + m * 2048 + k * 1024); } while (0)
#define G2_LDB(dst, b, h) do { _Pragma("unroll") for (int n = 0; n < 2; ++n) _Pragma("unroll") for (int k = 0; k < 2; ++k) dst[n][k] = *(const LAS bf16x8*)(lds + G2_SB(b, h) + boff + n * 2048 + k * 1024); } while (0)
#define G2_MMA(ai, bj, At, Bt) do { __builtin_amdgcn_s_setprio(1); _Pragma("unroll") for (int m = 0; m < 4; ++m) _Pragma("unroll") for (int n = 0; n < 2; ++n) _Pragma("unroll") for (int k = 0; k < 2; ++k) { \
        if (Sched::FP8) { const i32x4 _b = __builtin_bit_cast(i32x4, Bt[n][k]), _a = __builtin_bit_cast(i32x4, At[m][k]);     \
            acc[(ai) * 4 + m][(bj) * 2 + n] = __builtin_amdgcn_mfma_f32_16x16x32_fp8_fp8(((long)(unsigned)_b[1] << 32) | (unsigned)_b[0], ((long)(unsigned)_a[1] << 32) | (unsigned)_a[0], acc[(ai) * 4 + m][(bj) * 2 + n], 0, 0, 0); \
            acc[(ai) * 4 + m][(bj) * 2 + n] = __builtin_amdgcn_mfma_f32_16x16x32_fp8_fp8(((long)(unsigned)_b[3] << 32) | (unsigned)_b[2], ((long)(unsigned)_a[3] << 32) | (unsigned)_a[2], acc[(ai) * 4 + m][(bj) * 2 + n], 0, 0, 0); } \
        else acc[(ai) * 4 + m][(bj) * 2 + n] = __builtin_amdgcn_mfma_f32_16x16x32_bf16(Bt[n][k], At[m][k], acc[(ai) * 4 + m][(bj) * 2 + n], 0, 0, 0); } __builtin_amdgcn_s_setprio(0); } while (0)
#define G2_WAIT_V(n) asm volatile("s_waitcnt vmcnt(" #n ")" ::: "memory")
#define G2_WAIT_L(n) asm volatile("s_waitcnt lgkmcnt(" #n ")" ::: "memory")
#define G2_BAR __builtin_amdgcn_s_barrier()
#define G2_SCHED __builtin_amdgcn_sched_barrier(0)
#define G2_VOFFA(U, dst) do { _Pragma("unroll") for (int _h = 0; _h < 2; ++_h) _Pragma("unroll") for (int _i = 0; _i < 2; ++_i) { const int _row = _h * 128 + sR[_i]; \
        int _tok = _row; if (Sched::GATHER) _tok = (_row < (U).valid) ? (U).ridx[_row] : 0; dst[_h][_i] = (unsigned)(_tok * K + sC[_i]) * 2u; } } while (0)
    Unit<Epi> cur, nxt; int ui = 0;
    if (!S.get(0, cur)) return;
    f32x4 acc[8][4];
#pragma unroll
    for (int i = 0; i < 8; ++i)
#pragma unroll
        for (int j = 0; j < 4; ++j) acc[i][j] = (f32x4){0.f, 0.f, 0.f, 0.f};
    bf16x8 At[4][2], B0[2][2], B1[2][2];
    unsigned cvA[2][2], nvA[2][2];
    G2_VOFFA(cur, cvA);
    const char* cA = (const char*)cur.A; const char* cB0 = (const char*)cur.B0; const char* cB1 = (const char*)cur.B1;
    G2_STAGE(G2_SB(0, 0), cB0, voffB[0], voffB[1]); G2_STAGE(G2_SB(0, 1), cB1, voffB[0], voffB[1]); G2_STAGE(G2_SA(0, 0), cA, cvA[0][0], cvA[0][1]); G2_STAGE(G2_SA(0, 1), cA, cvA[1][0], cvA[1][1]);
    if (wr == 1) G2_BAR;
    G2_WAIT_V(2); G2_BAR;
    G2_STAGE(G2_SB(1, 0), cB0 + kstep, voffB[0], voffB[1]); G2_STAGE(G2_SA(1, 0), cA + kstep, cvA[0][0], cvA[0][1]); G2_STAGE(G2_SB(1, 1), cB1 + kstep, voffB[0], voffB[1]);
    G2_WAIT_V(6); G2_BAR;
    for (;;) {
        const bool has_next = S.get(ui + 1, nxt);
        if (Sched::GATHER) {
            if (has_next) { G2_VOFFA(nxt, nvA); }
            else {
#pragma unroll
                for (int h = 0; h < 2; ++h) { nvA[h][0] = cvA[h][0]; nvA[h][1] = cvA[h][1]; } }
        }
        const char* nA = has_next ? (const char*)nxt.A : cA; const char* nB0 = has_next ? (const char*)nxt.B0 : cB0; const char* nB1 = has_next ? (const char*)nxt.B1 : cB1;
#pragma unroll 1
        for (int t = 0; t < nt; t += 2) {
            const bool last = (t == nt - 2);
            const char* a1 = cA + (size_t)(t + 1) * kstep;
            const char* a2 = last ? nA : cA + (size_t)(t + 2) * kstep;
            const char* b20 = last ? nB0 : cB0 + (size_t)(t + 2) * kstep; const char* b21 = last ? nB1 : cB1 + (size_t)(t + 2) * kstep;
#define x00 ((Sched::GATHER && last) ? nvA[0][0] : cvA[0][0])
#define x01 ((Sched::GATHER && last) ? nvA[0][1] : cvA[0][1])
#define x10 ((Sched::GATHER && last) ? nvA[1][0] : cvA[1][0])
#define x11 ((Sched::GATHER && last) ? nvA[1][1] : cvA[1][1])
            G2_LDB(B0, 0, 0); G2_LDB(B1, 0, 1); G2_SCHED; G2_LDA(At, 0, 0); G2_STAGE(G2_SA(1, 1), a1, cvA[1][0], cvA[1][1]);
            G2_WAIT_V(8); G2_WAIT_L(0); G2_BAR; G2_MMA(0, 0, At, B0); G2_MMA(0, 1, At, B1); G2_BAR; G2_SCHED;
            G2_LDA(At, 0, 1); G2_STAGE(G2_SB(0, 0), b20, voffB[0], voffB[1]); G2_STAGE(G2_SB(0, 1), b21, voffB[0], voffB[1]); G2_STAGE(G2_SA(0, 0), a2, x00, x01);
            G2_WAIT_V(8); G2_WAIT_L(0); G2_BAR; G2_MMA(1, 0, At, B0); G2_MMA(1, 1, At, B1); G2_BAR; G2_SCHED;
            G2_LDB(B0, 1, 0); G2_LDB(B1, 1, 1); G2_SCHED; G2_LDA(At, 1, 0); G2_STAGE(G2_SA(0, 1), a2, x10, x11);
            G2_WAIT_V(8); G2_WAIT_L(0); G2_BAR; G2_MMA(0, 0, At, B0); G2_MMA(0, 1, At, B1); G2_BAR; G2_SCHED;
            G2_LDA(At, 1, 1); G2_STAGE(G2_SB(1, 0), b20 + kstep, voffB[0], voffB[1]); G2_STAGE(G2_SB(1, 1), b21 + kstep, voffB[0], voffB[1]); G2_STAGE(G2_SA(1, 0), a2 + kstep, x00, x01);
            G2_WAIT_V(8); G2_WAIT_L(0); G2_BAR; G2_MMA(1, 0, At, B0); G2_MMA(1, 1, At, B1); G2_BAR; G2_SCHED;
        }
        if (wr == 0) G2_BAR;
        { Lay lay; int rbv = wr * 64 + fr, cbv = wc * 32 + 8 * fq; asm volatile("" : "+v"(rbv), "+v"(cbv));
          lay.rbase = rbv; lay.cbase = cbv; cur.epi.run(acc, lay); }
        if (!has_next) break;
#pragma unroll
        for (int i = 0; i < 8; ++i)
#pragma unroll
            for (int j = 0; j < 4; ++j) acc[i][j] = (f32x4){0.f, 0.f, 0.f, 0.f};
        cur = nxt; cA = nA; cB0 = nB0; cB1 = nB1; ++ui;
        if (wr == 1) G2_BAR;
        if (Sched::GATHER) {
#pragma unroll
            for (int h = 0; h < 2; ++h) { cvA[h][0] = nvA[h][0]; cvA[h][1] = nvA[h][1]; } }
    }
#undef x00
#undef x01
#undef x10
#undef x11
    G2_WAIT_V(0);
    G2_BAR;
#undef G2_SA
#undef G2_SB
#undef G2_STAGE
#undef G2_LDA
#undef G2_LDB
#undef G2_MMA
#undef G2_WAIT_V
#undef G2_WAIT_L
#undef G2_BAR
#undef G2_SCHED
#undef G2_VOFFA
}
}

struct EpiF32 {
    float* C; int ld;
    template <class L> __device__ __forceinline__ void run(const f32x4 (&acc)[L::NI][L::NJ], const L& lay) const {
#pragma unroll
        for (int i = 0; i < L::NI; ++i)
#pragma unroll
            for (int j = 0; j < L::NJ; ++j) *(f32x4*)(C + (size_t)lay.row(i) * ld + lay.col(j)) = acc[i][j];
    }
};
struct EpiBf16 {
    bf16_t* C; int ld; float scale;
    template <class L> __device__ __forceinline__ void run(const f32x4 (&acc)[L::NI][L::NJ], const L& lay) const {
#pragma unroll
        for (int i = 0; i < L::NI; ++i) {
            if (L::PAIR8) {
#pragma unroll
                for (int j = 0; j < L::NJ; j += 2) { const f32x4 p = acc[i][j] * scale, q = acc[i][j + 1] * scale; u32x4 w; w.x = pack2(p[0], p[1]); w.y = pack2(p[2], p[3]); w.z = pack2(q[0], q[1]); w.w = pack2(q[2], q[3]);
                    *(u32x4*)(C + (size_t)lay.row(i) * ld + lay.col(j)) = w; }
            } else {
#pragma unroll
                for (int j = 0; j < L::NJ; ++j) { const f32x4 p = acc[i][j] * scale; u32x2 w; w.x = pack2(p[0], p[1]); w.y = pack2(p[2], p[3]);
                    *(u32x2*)(C + (size_t)lay.row(i) * ld + lay.col(j)) = w; }
            }
        }
    }
};
struct EpiGateUp8 {
    unsigned char* C; int ld;
    template <class L> __device__ __forceinline__ void run(const f32x4 (&acc)[L::NI][L::NJ], const L& lay) const {
        static_assert(L::PAIR8 && L::NJ == 4, "written for the paired-column 256x256 layout");
#pragma unroll
        for (int i = 0; i < L::NI; ++i) {
            const f32x4 g0 = acc[i][0] * (1.0f / 32.0f), g1 = acc[i][1] * (1.0f / 32.0f), u0 = acc[i][2] * (1.0f / 32.0f), u1 = acc[i][3] * (1.0f / 32.0f);
            u32x2 w; w.x = pack4_fp8(silu_f(g0[0]) * u0[0], silu_f(g0[1]) * u0[1], silu_f(g0[2]) * u0[2], silu_f(g0[3]) * u0[3]);
            w.y = pack4_fp8(silu_f(g1[0]) * u1[0], silu_f(g1[1]) * u1[1], silu_f(g1[2]) * u1[2], silu_f(g1[3]) * u1[3]);
            *(u32x2*)(C + (size_t)lay.row(i) * ld + lay.col(0)) = w;
        }
    }
};
struct EpiGateUp {
    bf16_t* C; int ld;
    template <class L> __device__ __forceinline__ void run(const f32x4 (&acc)[L::NI][L::NJ], const L& lay) const {
#pragma unroll
        for (int i = 0; i < L::NI; ++i) {
            if (L::PAIR8 && L::NJ == 4) {
                const f32x4 g0 = acc[i][0], g1 = acc[i][1], u0 = acc[i][2], u1 = acc[i][3];
                u32x4 w; w.x = pack2(silu_f(g0[0]) * u0[0], silu_f(g0[1]) * u0[1]); w.y = pack2(silu_f(g0[2]) * u0[2], silu_f(g0[3]) * u0[3]);
                w.z = pack2(silu_f(g1[0]) * u1[0], silu_f(g1[1]) * u1[1]); w.w = pack2(silu_f(g1[2]) * u1[2], silu_f(g1[3]) * u1[3]);
                *(u32x4*)(C + (size_t)lay.row(i) * ld + lay.col(0)) = w;
            } else {
#pragma unroll
                for (int j = 0; j < L::NJ / 2; ++j) { const f32x4 gt = acc[i][j], up = acc[i][j + L::NJ / 2];
                    u32x2 w; w.x = pack2(silu_f(gt[0]) * up[0], silu_f(gt[1]) * up[1]); w.y = pack2(silu_f(gt[2]) * up[2], silu_f(gt[3]) * up[3]);
                    *(u32x2*)(C + (size_t)lay.row(i) * ld + lay.col(j)) = w; }
            }
        }
    }
};
struct EpiInProj {
    bf16_t* Zt;
    bf16_t* tF;
    bf16_t* tV;
    int n0, pos0, n;
    template <class L> __device__ __forceinline__ void run(const f32x4 (&acc)[L::NI][L::NJ], const L& lay) const {
        static_assert(L::PAIR8, "written for the paired-column layout");
#pragma unroll
        for (int i = 0; i < L::NI; ++i)
#pragma unroll
            for (int j = 0; j < L::NJ; j += 2) {
                const int r = lay.row(i), cl = lay.col(j), c = n0 + cl;
                const f32x4 v0 = acc[i][j], v1 = acc[i][j + 1];
                if (c < 512) {
                    const int part = c >> 8, ch = c & 255;
#pragma unroll
                    for (int e = 0; e < 4; ++e) { tF[((size_t)(ch + e) * 2 + part) * n + pos0 + r] = f2bf(v0[e]); tF[((size_t)(ch + 4 + e) * 2 + part) * n + pos0 + r] = f2bf(v1[e]); }
                } else {
                    u32x4 w; w.x = pack2(v0[0], v0[1]); w.y = pack2(v0[2], v0[3]); w.z = pack2(v1[0], v1[1]); w.w = pack2(v1[2], v1[3]);
                    *(u32x4*)(Zt + (size_t)r * ZC + cl) = w;
                    if (c >= 896 && c < 1024) {
#pragma unroll
                        for (int e = 0; e < 4; ++e) { tV[(size_t)(c - 896 + e) * n + pos0 + r] = f2bf(v0[e]); tV[(size_t)(c - 896 + 4 + e) * n + pos0 + r] = f2bf(v1[e]); }
                    }
                }
            }
    }
};

constexpr int U_ADA = 192, U_WIN = 2 * 16 * 28, U_WOUT = 2 * 16 * 16, U_SGU = 32, U_DFT = 256, U_ROPE = 1, U_EXP = 3 * 32 * 32;
constexpr int LDS_SIL = 0, LDS_RED = 20480, LDS_TILE = 32768, LDS_T64 = 49408, LDS_CTAB = 50176;

__device__ __forceinline__ void ada_unit(AP a, unsigned char* lds, int u) {
    float* sil = (float*)(lds + LDS_SIL); float* red = (float*)(lds + LDS_RED);
    const int tid = tid_opaque(), lane = tid & 63, w = tid >> 6;
    const int l = u / 96, cg = u % 96;
    for (int i = tid; i < 5120; i += NT) { const int r = i >> 10, k = i & 1023; const float v = (r < 4) ? a->in[1][r * 1024 + k] : a->in[3][k]; sil[i] = v / (1.0f + expf(-v)); }
    __syncthreads();
    const float* W = a->in[4] + (size_t)l * 1024 * 6144 + cg * 64 + lane;
    float acc[5] = {0.f, 0.f, 0.f, 0.f, 0.f};
#pragma unroll 32
    for (int k = w * 128; k < w * 128 + 128; ++k) { const float wv = W[(size_t)k * 6144];
#pragma unroll
        for (int r = 0; r < 5; ++r) acc[r] += sil[r * 1024 + k] * wv; }
#pragma unroll
    for (int r = 0; r < 5; ++r) red[(w * 5 + r) * 64 + lane] = acc[r];
    __syncthreads();
    if (tid < 320) { const int r = tid >> 6; float s = 0.f;
#pragma unroll
        for (int ww = 0; ww < 8; ++ww) s += red[(ww * 5 + r) * 64 + lane];
        const int j = cg * 64 + lane; ((float*)(a->ws + WS_MOD))[(size_t)(l * 5 + r) * 6144 + j] = s + a->in[5][l * 6144 + j]; }
    __syncthreads();
}

__device__ __forceinline__ void tile_store_T(const float* tile, bf16_t* dst, int ldd) {
    const int tid = tid_opaque(), n = tid >> 3, kc = tid & 7;
    u32x4 w;
    w.x = pack2(tile[(kc * 8 + 0) * 65 + n], tile[(kc * 8 + 1) * 65 + n]); w.y = pack2(tile[(kc * 8 + 2) * 65 + n], tile[(kc * 8 + 3) * 65 + n]);
    w.z = pack2(tile[(kc * 8 + 4) * 65 + n], tile[(kc * 8 + 5) * 65 + n]); w.w = pack2(tile[(kc * 8 + 6) * 65 + n], tile[(kc * 8 + 7) * 65 + n]);
    *(u32x4*)(dst + (size_t)n * ldd + kc * 8) = w;
}
__device__ __forceinline__ void tile_load(float* tile, const float* src, int lds_) {
    const int tid = tid_opaque();
#pragma unroll
    for (int i = 0; i < 2; ++i) { const int row = (tid >> 4) + 32 * i, c4 = (tid & 15) * 4; const f32x4 v = *(const f32x4*)(src + (size_t)row * lds_ + c4);
        tile[row * 65 + c4 + 0] = v[0]; tile[row * 65 + c4 + 1] = v[1]; tile[row * 65 + c4 + 2] = v[2]; tile[row * 65 + c4 + 3] = v[3]; }
}

__device__ __forceinline__ void mm64_f32(const float* tA, int lda, const float* tB, int ldb, int K, float* out) {
    const int tid = tid_opaque(), lane = tid & 63, w = tid >> 6, fr = lane & 15, g = lane >> 4, mi = w >> 1, nj = 2 * (w & 1);
    f32x4 acc0 = (f32x4){0.f, 0.f, 0.f, 0.f}, acc1 = (f32x4){0.f, 0.f, 0.f, 0.f};
    const float* pa = tA + (16 * mi + fr) * lda + g; const float* pb = tB + g * ldb + 16 * nj + fr;
#pragma unroll 4
    for (int k0 = 0; k0 < K; k0 += 4) { const float av = pa[k0], b0 = pb[k0 * ldb], b1 = pb[k0 * ldb + 16];
        acc0 = __builtin_amdgcn_mfma_f32_16x16x4f32(av, b0, acc0, 0, 0, 0); acc1 = __builtin_amdgcn_mfma_f32_16x16x4f32(av, b1, acc1, 0, 0, 0); }
#pragma unroll
    for (int r = 0; r < 4; ++r) { out[(16 * mi + 4 * g + r) * 65 + 16 * nj + fr] = acc0[r]; out[(16 * mi + 4 * g + r) * 65 + 16 * nj + 16 + fr] = acc1[r]; }
}

__device__ __forceinline__ void win_unit(AP a, unsigned char* lds, int u) {
    float* tile = (float*)(lds + LDS_TILE); float* T = (float*)(lds + LDS_T64);
    const int tid = tid_opaque();
    const int l = u / 448, r = u % 448, kb = r / 28, nb = r % 28;
    const float* Win = a->in[6] + (size_t)l * 1024 * 1536;
    const int srccol = (nb >= 8) ? nb * 64 - 256 : (nb & 3) * 64;
    tile_load(tile, Win + (size_t)(kb * 64) * 1536 + srccol, 1536);
    if (nb < 8 && tid < 64) { T[tid] = cospif((float)tid / 32.0f); T[64 + tid] = sinpif((float)tid / 32.0f); }
    __syncthreads();
    bf16_t* dst = (bf16_t*)(a->ws + WS_WIN) + ((size_t)l * ZC + nb * 64) * 1024 + kb * 64;
    if (nb >= 8) tile_store_T(tile, dst, 1024);
    else {
        const int part = nb >> 2;
        float* Tm = (float*)(lds + 65536); float* out = (float*)(lds + 98304);
        for (int i = tid; i < 4096; i += NT) { const int c = i >> 6, cp = i & 63; const float t = T[part * 64 + ((c * cp) & 63)]; Tm[i] = (part ? -t : t) * 0.125f; }
        __syncthreads();
        mm64_f32(tile, 65, Tm, 64, 64, out);
        __syncthreads();
        tile_store_T(out, dst, 1024);
    }
    __syncthreads();
}

__device__ __forceinline__ void wout_unit(AP a, unsigned char* lds, int u) {
    float* tile = (float*)(lds + LDS_TILE);
    __syncthreads();
    const int tid = tid_opaque();
    const int l = u / 256, r = u % 256, kb = r / 16, nb = r % 16;
    const float* Wo = a->in[13] + (size_t)l * 1024 * 1024;
    const int n = tid & 63, kq = __builtin_amdgcn_readfirstlane(tid >> 6);
    if (kb < 4) {
        float* tA = (float*)lds; float* tB = (float*)(lds + 65536);
        const float* wf = a->in[7] + (size_t)l * 256 * 256 + (size_t)(kb * 64) * 256;
        __syncthreads();
        f32x4 va[8], vb[8];
#pragma unroll
        for (int i = 0; i < 8; ++i) { const int q = tid + 512 * i; va[i] = *(const f32x4*)(wf + (size_t)q * 4); vb[i] = *(const f32x4*)(Wo + (size_t)(q >> 4) * 1024 + nb * 64 + (q & 15) * 4); }
#pragma unroll
        for (int i = 0; i < 8; ++i) { const int q = tid + 512 * i; *(f32x4*)(tA + (size_t)q * 4) = va[i]; *(f32x4*)(tB + (size_t)q * 4) = vb[i]; }
        __syncthreads();
        tile = (float*)(lds + 133120);
        mm64_f32(tA, 256, tB, 64, 256, tile);
    } else if (kb >= 8 && kb < 12) {
        const int g = kb - 8;
        float* tA = (float*)lds; float* tB = (float*)(lds + 65536);
        const float* wp = a->in[9] + (size_t)(l * 4 + g) * 64 * 64;
        const float* ps = a->in[10] + l * 256 + g * 64;
        f32x4 va[2], vb[2];
#pragma unroll
        for (int i = 0; i < 2; ++i) { const int q = tid + 512 * i; va[i] = *(const f32x4*)(wp + (size_t)q * 4); vb[i] = *(const f32x4*)(Wo + (size_t)(512 + g * 64 + (q >> 4)) * 1024 + nb * 64 + (q & 15) * 4) * ps[q >> 4]; }
#pragma unroll
        for (int i = 0; i < 2; ++i) { const int q = tid + 512 * i; *(f32x4*)(tA + (size_t)q * 4) = va[i]; *(f32x4*)(tB + (size_t)q * 4) = vb[i]; }
        __syncthreads();
        tile = (float*)(lds + 133120);
        mm64_f32(tA, 64, tB, 64, 64, tile);
    } else tile_load(tile, Wo + (size_t)(kb * 64) * 1024 + nb * 64, 1024);
    __syncthreads();
    tile_store_T(tile, (bf16_t*)(a->ws + WS_WOUT) + ((size_t)l * 1024 + nb * 64) * 1024 + kb * 64, 1024);
    __syncthreads();
}

__device__ __forceinline__ void exp_src_dst(AP a, int l, int u, const float*& src, int& srcld, unsigned char*& dst, int& dstld) {
    const int mat = u / 1024, e = (u % 1024) / 32, t = u % 32;
    const int kb = (mat < 2) ? t / 4 : t / 8, nb = (mat < 2) ? t % 4 : t % 8;
    srcld = (mat < 2) ? 512 : 1024; dstld = (mat < 2) ? 1024 : 512;
    src = a->in[18 + mat] + ((size_t)(l * 32 + e) * 512 * 1024) + (size_t)(kb * 128) * srcld + nb * 128;
    dst = a->ws + WS_WEXP + (size_t)l * WEXP_LAYER + (size_t)mat * EXPMAT + (size_t)e * 512 * 1024 + (size_t)(nb * 128) * dstld + kb * 128;
}
#define EXP_LOAD(vv, uu) do { exp_src_dst(a, l, (uu), src, srcld, dst, dstld); _Pragma("unroll") for (int _i = 0; _i < 8; ++_i) vv[_i] = *(const f32x4*)(src + (size_t)((tid >> 5) + 16 * _i) * srcld + (tid & 31) * 4); } while (0)
#define EXP_PUT(vv) do { _Pragma("unroll") for (int _i = 0; _i < 8; ++_i) { float* tp = tile + ((tid >> 5) + 16 * _i) * 129 + (tid & 31) * 4; tp[0] = vv[_i][0] * 32.0f; tp[1] = vv[_i][1] * 32.0f; tp[2] = vv[_i][2] * 32.0f; tp[3] = vv[_i][3] * 32.0f; } } while (0)
#define EXP_STORE(dd, ld_) do { const int n = tid >> 2, kq = tid & 3; _Pragma("unroll") for (int j = 0; j < 2; ++j) { const float* tp = tile + (kq * 32 + j * 16) * 129 + n; u32x4 w; \
        w.x = pack4_fp8(tp[0], tp[129], tp[2 * 129], tp[3 * 129]); w.y = pack4_fp8(tp[4 * 129], tp[5 * 129], tp[6 * 129], tp[7 * 129]); \
        w.z = pack4_fp8(tp[8 * 129], tp[9 * 129], tp[10 * 129], tp[11 * 129]); w.w = pack4_fp8(tp[12 * 129], tp[13 * 129], tp[14 * 129], tp[15 * 129]); \
        *(u32x4*)((dd) + (size_t)n * (ld_) + kq * 32 + j * 16) = w; } } while (0)
__device__ __forceinline__ void exp_range(AP a, unsigned char* lds, int l, int u0, int u_end) {
    float* tile = (float*)lds;
    const int tid = tid_opaque();
    __syncthreads();
    if (u0 >= u_end) return;
    const float* src; unsigned char* dst; int srcld, dstld;
    f32x4 va[8], vb[8];
    unsigned char *da, *db = nullptr; int lda_, ldb_ = 0;
    EXP_LOAD(va, u0); da = dst; lda_ = dstld;
    if (u0 + 1 < u_end) { EXP_LOAD(vb, u0 + 1); db = dst; ldb_ = dstld; }
    for (int u = u0; u < u_end; u += 2) {
        EXP_PUT(va);
        __syncthreads();
        { unsigned char* cd = da; const int cl = lda_; if (u + 2 < u_end) { EXP_LOAD(va, u + 2); da = dst; lda_ = dstld; } EXP_STORE(cd, cl); }
        __syncthreads();
        if (u + 1 < u_end) {
            EXP_PUT(vb);
            __syncthreads();
            { unsigned char* cd = db; const int cl = ldb_; if (u + 3 < u_end) { EXP_LOAD(vb, u + 3); db = dst; ldb_ = dstld; } EXP_STORE(cd, cl); }
            __syncthreads();
        }
    }
}
#undef EXP_LOAD
#undef EXP_PUT
#undef EXP_STORE
__device__ __forceinline__ void exp_queue(AP a, unsigned char* lds, int l) {
    const int tid = tid_opaque();
    int* qslot = (int*)(lds + MISC_OFF + 128);
    unsigned* qc = (unsigned*)(a->ws + WS_BAR + 14336 + l * 256);
    for (;;) {
        __syncthreads();
        if (tid == 0) *qslot = (int)__hip_atomic_fetch_add(qc, 4u, __ATOMIC_RELAXED, __HIP_MEMORY_SCOPE_AGENT);
        __syncthreads();
        const int c0 = *qslot;
        if (c0 >= U_EXP) break;
        exp_range(a, lds, l, c0, c0 + 4);
    }
}

__device__ __forceinline__ void exp_fill(AP a, unsigned char* lds, int ql, int budget) {
    const int tid = tid_opaque();
    int* qslot = (int*)(lds + MISC_OFF + 128);
    unsigned* qc = (unsigned*)(a->ws + WS_BAR + 14336 + ql * 256);
    for (int done = 0; done < budget; done += 2) {
        __syncthreads();
        if (tid == 0) *qslot = (int)__hip_atomic_fetch_add(qc, 2u, __ATOMIC_RELAXED, __HIP_MEMORY_SCOPE_AGENT);
        __syncthreads();
        const int c0 = *qslot;
        if (c0 >= U_EXP) break;
        exp_range(a, lds, ql, c0, c0 + 2);
    }
    __syncthreads();
}

__device__ __forceinline__ void p0_prologue(AP a, unsigned char* lds) {
    const int tid = tid_opaque();
    bool have_tab = false;
    constexpr int E0 = U_ADA, E1 = E0 + U_WIN, E2 = E1 + U_WOUT, E3 = E2 + U_SGU, E4 = E3 + U_DFT, E5 = E4 + U_ROPE;
    int u = blockIdx.x;
    for (; u < E5; u += gridDim.x) {
        if (u < E0) ada_unit(a, lds, u);
        else if (u < E1) win_unit(a, lds, u - E0);
        else if (u < E2) wout_unit(a, lds, u - E1);
        else if (u < E3) { const size_t i0 = (size_t)(u - E2) * 4096 + tid * 8; const float* s = a->in[11] + i0; bf16_t* d = (bf16_t*)(a->ws + WS_WSGU) + i0;
            const f32x4 v0 = *(const f32x4*)s, v1 = *(const f32x4*)(s + 4); u32x4 w; w.x = pack2(v0[0], v0[1]); w.y = pack2(v0[2], v0[3]); w.z = pack2(v1[0], v1[1]); w.w = pack2(v1[2], v1[3]); *(u32x4*)d = w; }
        else if (u < E4) {
            float* ctab = (float*)(lds + LDS_CTAB);
            if (!have_tab) { for (int i = tid; i < 4096; i += NT) ctab[i] = cospif((float)i / 2048.0f); __syncthreads(); have_tab = true; }
            const int k = u - E3 + 4096;
            if (tid < 32) {
                const int kk = k - 4096, n0 = tid * 8; float c[8], s[8];
#pragma unroll
                for (int e = 0; e < 8; ++e) { const int idx = ((kk * (n0 + e)) & 255) * 16; c[e] = ctab[idx] * (1.0f / 16.0f); s[e] = ctab[(idx - 1024) & 4095] * (1.0f / 16.0f); }
                bf16_t* d = (bf16_t*)(a->ws + WS_DFTC) + (size_t)kk * 512 + n0;
                u32x4 w; w.x = pack2(c[0], c[1]); w.y = pack2(c[2], c[3]); w.z = pack2(c[4], c[5]); w.w = pack2(c[6], c[7]); *(u32x4*)d = w;
                w.x = pack2(s[0], s[1]); w.y = pack2(s[2], s[3]); w.z = pack2(s[4], s[5]); w.w = pack2(s[6], s[7]); *(u32x4*)(d + 256) = w;
            }
        }
        else {
            for (int i = tid; i < 1024; i += NT) { const int pos = i >> 4, f = i & 15; const float freq = powf(10000.0f, -(float)f / 16.0f); const float ang = (float)pos * freq;
                ((float2*)(a->ws + WS_ROPE))[i] = make_float2(cosf(ang), sinf(ang)); }
        }
    }
}

__device__ __forceinline__ void p_lnmod0(AP a) {
    const int tid = tid_opaque(), lane = tid & 63, w = tid >> 6;
    const float* mod = (const float*)(a->ws + WS_MOD);
    bf16_t* H = (bf16_t*)(a->ws + WS_H);
    const int tstep = gridDim.x * 8;
    f32x4 nx[4];
    { const int t = blockIdx.x * 8 + w; if (t < NTOK) { const float* src = (t < NLAT) ? a->in[0] + (size_t)t * D : a->in[2] + (size_t)(t - NLAT) * D;
#pragma unroll
        for (int i = 0; i < 4; ++i) nx[i] = *(const f32x4*)(src + 256 * i + 4 * lane); } }
    int mrow = -1; f32x4 msh[4], msc[4];
    for (int t = blockIdx.x * 8 + w; t < NTOK; t += tstep) {
        const int mr = (t < NLAT) ? (t >> 12) : 4;
        if (mr != mrow) { mrow = mr; const float* m = mod + (size_t)mr * 6144;
#pragma unroll
            for (int i = 0; i < 4; ++i) { msh[i] = *(const f32x4*)(m + 256 * i + 4 * lane); msc[i] = *(const f32x4*)(m + 1024 + 256 * i + 4 * lane); } }
        f32x4 v[4];
#pragma unroll
        for (int i = 0; i < 4; ++i) v[i] = nx[i];
        { const int tn = t + tstep; if (tn < NTOK) { const float* src = (tn < NLAT) ? a->in[0] + (size_t)tn * D : a->in[2] + (size_t)(tn - NLAT) * D;
#pragma unroll
            for (int i = 0; i < 4; ++i) nx[i] = *(const f32x4*)(src + 256 * i + 4 * lane); } }
        float mean, rstd; ln_stats(v, mean, rstd);
#pragma unroll
        for (int i = 0; i < 4; ++i) { const int c = 256 * i + 4 * lane;
            f32x4 o;
#pragma unroll
            for (int e = 0; e < 4; ++e) o[e] = (v[i][e] - mean) * rstd * (1.0f + msc[i][e]) + msh[i][e];
            u32x2 pk; pk.x = pack2(o[0], o[1]); pk.y = pack2(o[2], o[3]); *(u32x2*)(H + (size_t)t * D + c) = pk; }
    }
}

__device__ __forceinline__ void p1_inproj(AP a, unsigned char* smem, LAS unsigned char* lds, int l);
__device__ __forceinline__ u32x4 ld16g(const bf16_t* p) { return *(const u32x4*)p; }
__device__ __forceinline__ void rope_pack8(u32x4& wl, u32x4& wh, const LAS f32x2* tab, bool do_rope, float scale) {
    float tl[8] = {lo2f(wl.x), hi2f(wl.x), lo2f(wl.y), hi2f(wl.y), lo2f(wl.z), hi2f(wl.z), lo2f(wl.w), hi2f(wl.w)};
    float th[8] = {lo2f(wh.x), hi2f(wh.x), lo2f(wh.y), hi2f(wh.y), lo2f(wh.z), hi2f(wh.z), lo2f(wh.w), hi2f(wh.w)};
#pragma unroll
    for (int j = 0; j < 8; ++j) {
        float r1 = tl[j], r2 = th[j];
        if (do_rope) { const f32x2 cs = tab[j]; r1 = tl[j] * cs.x - th[j] * cs.y; r2 = tl[j] * cs.y + th[j] * cs.x; }
        tl[j] = r1 * scale; th[j] = r2 * scale;
    }
    wl.x = pack2(tl[0], tl[1]); wl.y = pack2(tl[2], tl[3]); wl.z = pack2(tl[4], tl[5]); wl.w = pack2(tl[6], tl[7]);
    wh.x = pack2(th[0], th[1]); wh.y = pack2(th[2], th[3]); wh.z = pack2(th[4], th[5]); wh.w = pack2(th[6], th[7]);
}

__device__ __forceinline__ void mixer_sgu_pool(AP a, LAS unsigned char* lds, int l, int row0, int seq_row0, int pos0, int n) {
    const int tid = tid_opaque(), lane = tid & 63, w = __builtin_amdgcn_readfirstlane(tid >> 6), fr = lane & 15, g = lane >> 4;
    const bf16_t* Z = (const bf16_t*)(a->ws + WS_Z);
    bf16_t* CAT = (bf16_t*)(a->ws + WS_CAT);
    {
#pragma unroll
        for (int it = 0; it < 9; ++it) { const int id = tid + 512 * it, rr = id >> 5, ch = id & 31, j = pos0 - 8 + rr;
            u32x4 v = (u32x4){0u, 0u, 0u, 0u};
            if (j >= 0 && j < n) v = ld16g(Z + (size_t)(seq_row0 + j) * ZC + 1024 + ch * 8);
            *(LAS u32x4*)(lds + rr * 512 + ch * 16) = v; }
        __syncthreads();
        const int c = tid & 255, half = tid >> 8, hw = 1 << (c >> 6);
        const LAS bf16_t* P = (const LAS bf16_t*)lds + c;
        const int t0 = half * 64;
        float s = 0.f;
        for (int j = t0 - hw; j < t0 + hw; ++j) s += bf2f(P[(8 + j) * 256]);
        for (int tl = t0; tl < t0 + 64; ++tl) {
            const int pos = pos0 + tl; const int lo = max(pos - hw, 0), hi = min(pos + hw, n);
            CAT[(size_t)(row0 + tl) * D + 512 + c] = f2bf(s / (float)(hi - lo) - bf2f(P[(8 + tl) * 256]));
            s += bf2f(P[(8 + tl + hw) * 256]) - bf2f(P[(8 + tl - hw) * 256]);
        }
        __syncthreads();
    }
    {
        const int i16 = lane & 15;
        u32x4 gw[4][2];
#pragma unroll
        for (int ps = 0; ps < 4; ++ps) { const int q = w * 16 + ps * 4 + g; const bf16_t* src = Z + (size_t)(row0 + q) * ZC + 1536 + 16 * i16; gw[ps][0] = ld16g(src); gw[ps][1] = ld16g(src + 8); }
#pragma unroll
        for (int ps = 0; ps < 4; ++ps) {
            const int q = w * 16 + ps * 4 + g;
            float gv[16];
#pragma unroll
            for (int hh = 0; hh < 2; ++hh) { const u32x4 x = gw[ps][hh];
                gv[8 * hh + 0] = gelu_erf(lo2f(x.x)); gv[8 * hh + 1] = gelu_erf(hi2f(x.x)); gv[8 * hh + 2] = gelu_erf(lo2f(x.y)); gv[8 * hh + 3] = gelu_erf(hi2f(x.y));
                gv[8 * hh + 4] = gelu_erf(lo2f(x.z)); gv[8 * hh + 5] = gelu_erf(hi2f(x.z)); gv[8 * hh + 6] = gelu_erf(lo2f(x.w)); gv[8 * hh + 7] = gelu_erf(hi2f(x.w)); }
            float sm = 0.f;
#pragma unroll
            for (int e = 0; e < 16; ++e) sm += gv[e];
            const float mean = row_sum16(sm) * (1.0f / 256.0f);
            float qq = 0.f;
#pragma unroll
            for (int e = 0; e < 16; ++e) { const float d = gv[e] - mean; qq += d * d; }
            const float rstd = 1.0f / sqrtf(row_sum16(qq) * (1.0f / 256.0f) + 1e-6f);
#pragma unroll
            for (int e = 0; e < 16; ++e) { const int c = 16 * i16 + e; *(LAS bf16_t*)(lds + c * 256 + ((((q >> 3) ^ (c & 15))) << 4) + (q & 7) * 2) = f2bf((gv[e] - mean) * rstd); }
        }
    }
    __syncthreads();
    {
        const int h = w >> 1, ph = w & 1;
        const bf16_t* Ws = (const bf16_t*)(a->ws + WS_WSGU) + (size_t)(l * 4 + h) * 128 * 128;
        const float* bs = a->in[12] + (size_t)(l * 4 + h) * 128;
        f32x4 acc[4][4];
#pragma unroll
        for (int i = 0; i < 4; ++i)
#pragma unroll
            for (int j = 0; j < 4; ++j) acc[i][j] = (f32x4){0.f, 0.f, 0.f, 0.f};
#pragma unroll
        for (int ks = 0; ks < 4; ++ks) {
            bf16x8 af[4], bfv[4];
#pragma unroll
            for (int cf = 0; cf < 4; ++cf) { const int c = h * 64 + 16 * cf + fr; af[cf] = *(const LAS bf16x8*)(lds + c * 256 + (((4 * ks + g) ^ (c & 15)) << 4)); }
#pragma unroll
            for (int pf = 0; pf < 4; ++pf) { const int p = ph * 64 + 16 * pf + fr; bfv[pf] = *(const bf16x8*)(Ws + (size_t)p * 128 + 32 * ks + 8 * g); }
#pragma unroll
            for (int cf = 0; cf < 4; ++cf)
#pragma unroll
                for (int pf = 0; pf < 4; ++pf) acc[cf][pf] = __builtin_amdgcn_mfma_f32_16x16x32_bf16(af[cf], bfv[pf], acc[cf][pf], 0, 0, 0);
        }
#pragma unroll
        for (int pf = 0; pf < 4; ++pf) { const int p = ph * 64 + 16 * pf + fr; const float bias = bs[p];
#pragma unroll
            for (int cf = 0; cf < 4; ++cf) { const int c0 = h * 64 + 16 * cf + 4 * g;
                const u32x2 uw = *(const u32x2*)(Z + (size_t)(row0 + p) * ZC + 1280 + c0);
                u32x2 o; o.x = pack2(gelu_erf(lo2f(uw.x)) * (acc[cf][pf][0] + bias), gelu_erf(hi2f(uw.x)) * (acc[cf][pf][1] + bias));
                o.y = pack2(gelu_erf(lo2f(uw.y)) * (acc[cf][pf][2] + bias), gelu_erf(hi2f(uw.y)) * (acc[cf][pf][3] + bias));
                *(u32x2*)(CAT + (size_t)(row0 + p) * D + 768 + c0) = o; } }
    }
    __syncthreads();
}

__device__ __forceinline__ void mixer_attn(AP a, LAS unsigned char* lds, int l, int row0, int seq_row0, int pos0, int n, int b, bool is_ctx, int kvh) {
    const int tid = tid_opaque(), lane = tid & 63, w = __builtin_amdgcn_readfirstlane(tid >> 6), fr = lane & 15, g = lane >> 4;
    const bf16_t* Z = (const bf16_t*)(a->ws + WS_Z);
    bf16_t* CAT = (bf16_t*)(a->ws + WS_CAT);
    __syncthreads();
    ((LAS u32x4*)(lds + 98304))[tid] = ((const u32x4*)(a->ws + WS_ROPE))[tid];
    const LAS f32x2* rope = (const LAS f32x2*)(lds + 98304);
    constexpr float QS = 0.125f * 1.44269504088896341f;
    constexpr int QS_OFF = 0, KS_OFF = 32768, VS_OFF = 65536;
    const int nbq = pos0 >> 7;
    unsigned bmask = 0x18u;
    if (!is_ctx) { if (nbq > 0) bmask |= 1u; bmask |= 2u; if (nbq + 1 < (n >> 7)) bmask |= 4u; }
    const int kr = tid >> 2, kax = (tid >> 1) & 1, kh8 = tid & 1;
#define MX_KSRC(blk) (Z + (size_t)((((blk) < 3) ? seq_row0 + (nbq + (blk) - 1) * 128 : NLAT + b * 256 + ((blk) - 3) * 128) + kr) * ZC + 768 + kvh * 64 + kax * 32 + kh8 * 8)
#define MX_VSTAGE(blk, buf) do { const bool _band = (blk) < 3; const int _key0 = _band ? (nbq + (blk) - 1) * 128 : ((blk) - 3) * 128; \
        const bf16_t* _vs = _band ? (const bf16_t*)(a->ws + WS_VT) + (size_t)(b * 2 + kvh) * 64 * 4096 + _key0 : (const bf16_t*)(a->ws + WS_VTC) + (size_t)(b * 2 + kvh) * 64 * 256 + _key0; \
        const int _vld = _band ? 4096 : 256; \
        _Pragma("unroll") for (int _i = 0; _i < 2; ++_i) { const int _P = _i * 512 + tid, _d = _P >> 4, _c = (_P & 15) ^ (_d & 15); \
            glds16(_vs + (size_t)_d * _vld + _c * 8, lds + VS_OFF + (buf) * 16384 + _i * 8192 + w * 1024); } } while (0)
    {
        __syncthreads();
#pragma unroll
        for (int it = 0; it < 2; ++it) {
            const int item = tid + 512 * it, r = item >> 2, ax = (item >> 1) & 1, h8 = item & 1, i = r & 127, qpos = pos0 + i;
            const bf16_t* src = Z + (size_t)(row0 + i) * ZC + 512 + (2 * kvh + (r >> 7)) * 64 + ax * 32 + h8 * 8;
            u32x4 wl = ld16g(src), wh = ld16g(src + 16);
            rope_pack8(wl, wh, rope + (ax ? (qpos & 63) : (qpos >> 6)) * 16 + h8 * 8, !is_ctx, QS);
            const int ch = ax * 4 + h8, sw = (r >> 1) & 7;
            *(LAS u32x4*)(lds + QS_OFF + r * 128 + ((ch ^ sw) << 4)) = wl;
            *(LAS u32x4*)(lds + QS_OFF + r * 128 + (((ch + 2) ^ sw) << 4)) = wh;
        }
        const int hh = w >> 2, qb = (w & 3) * 32, h = 2 * kvh + hh;
        float m[2], lsum[2];
        m[0] = m[1] = a->in[8][l * 4 + h] * 1.44269504088896341f;
        lsum[0] = lsum[1] = (g == 0) ? 1.0f : 0.0f;
        f32x4 O[4][2];
#pragma unroll
        for (int i = 0; i < 4; ++i) { O[i][0] = (f32x4){0.f, 0.f, 0.f, 0.f}; O[i][1] = (f32x4){0.f, 0.f, 0.f, 0.f}; }
        bf16x8 Qf[2][2];
        bool have_q = false;
        unsigned rem = bmask;
        int cur = __builtin_ctz(rem); rem &= rem - 1u;
        int buf = 0;
        u32x4 kl = ld16g(MX_KSRC(cur)), kh = ld16g(MX_KSRC(cur) + 16);
        MX_VSTAGE(cur, 0);
#pragma unroll 1
        for (;;) {
            const int jb = cur - 1; const bool band = cur < 3;
            {
                const int kpos = (nbq + jb) * 128 + kr;
                rope_pack8(kl, kh, rope + (kax ? (kpos & 63) : (kpos >> 6)) * 16 + kh8 * 8, band, 1.0f);
                const int ch = kax * 4 + kh8, sw = (kr >> 1) & 7;
                *(LAS u32x4*)(lds + KS_OFF + buf * 16384 + kr * 128 + ((ch ^ sw) << 4)) = kl;
                *(LAS u32x4*)(lds + KS_OFF + buf * 16384 + kr * 128 + (((ch + 2) ^ sw) << 4)) = kh;
            }
            asm volatile("s_waitcnt vmcnt(0)" ::: "memory");
            __syncthreads();
            const int nxt = rem ? __builtin_ctz(rem) : -1; rem &= rem - 1u;
            if (nxt >= 0) { kl = ld16g(MX_KSRC(nxt)); kh = ld16g(MX_KSRC(nxt) + 16); MX_VSTAGE(nxt, buf ^ 1); }
            if (!have_q) {
#pragma unroll
                for (int qf = 0; qf < 2; ++qf)
#pragma unroll
                    for (int ks = 0; ks < 2; ++ks) { const int r = hh * 128 + qb + 16 * qf + fr; Qf[qf][ks] = *(const LAS bf16x8*)(lds + QS_OFF + r * 128 + (((4 * ks + g) ^ ((r >> 1) & 7)) << 4)); }
                have_q = true;
            }
            const int kso = KS_OFF + buf * 16384, vso = VS_OFF + buf * 16384;
            f32x4 S[8][2];
#pragma unroll
            for (int kf = 0; kf < 8; ++kf) { S[kf][0] = (f32x4){0.f, 0.f, 0.f, 0.f}; S[kf][1] = (f32x4){0.f, 0.f, 0.f, 0.f}; }
#pragma unroll
            for (int kf = 0; kf < 8; ++kf)
#pragma unroll
                for (int ks = 0; ks < 2; ++ks) { const int r = 16 * kf + fr;
                    const bf16x8 kfr = *(const LAS bf16x8*)(lds + kso + r * 128 + (((4 * ks + g) ^ ((r >> 1) & 7)) << 4));
                    S[kf][0] = __builtin_amdgcn_mfma_f32_16x16x32_bf16(kfr, Qf[0][ks], S[kf][0], 0, 0, 0);
                    S[kf][1] = __builtin_amdgcn_mfma_f32_16x16x32_bf16(kfr, Qf[1][ks], S[kf][1], 0, 0, 0); }
            bf16x8 Pp[4][2];
#pragma unroll
            for (int qf = 0; qf < 2; ++qf) {
                const int qi = qb + 16 * qf + fr;
                if (band && jb != 0) {
#pragma unroll
                    for (int kf = 0; kf < 8; ++kf)
#pragma unroll
                        for (int r = 0; r < 4; ++r) { const int kk = 16 * kf + 4 * g + r; const bool ok = (jb < 0) ? (kk >= qi) : (kk <= qi); if (!ok) S[kf][qf][r] = -1.0e30f; }
                }
                float mx = S[0][qf][0];
#pragma unroll
                for (int kf = 0; kf < 8; ++kf)
#pragma unroll
                    for (int r = 0; r < 4; ++r) mx = fmaxf(mx, S[kf][qf][r]);
                mx = fmaxf(mx, __shfl_xor(mx, 16)); mx = fmaxf(mx, __shfl_xor(mx, 32));
                const float mn = fmaxf(m[qf], mx), corr = __builtin_amdgcn_exp2f(m[qf] - mn);
                m[qf] = mn;
                float ps = 0.f;
#pragma unroll
                for (int kf = 0; kf < 8; ++kf)
#pragma unroll
                    for (int r = 0; r < 4; ++r) { const float p = __builtin_amdgcn_exp2f(S[kf][qf][r] - mn); S[kf][qf][r] = p; ps += p; }
                lsum[qf] = lsum[qf] * corr + ps;
#pragma unroll
                for (int df = 0; df < 4; ++df) O[df][qf] *= corr;
#pragma unroll
                for (int t = 0; t < 4; ++t) { u32x4 pw; pw.x = pack2(S[2 * t][qf][0], S[2 * t][qf][1]); pw.y = pack2(S[2 * t][qf][2], S[2 * t][qf][3]);
                    pw.z = pack2(S[2 * t + 1][qf][0], S[2 * t + 1][qf][1]); pw.w = pack2(S[2 * t + 1][qf][2], S[2 * t + 1][qf][3]); Pp[t][qf] = __builtin_bit_cast(bf16x8, pw); }
            }
#pragma unroll
            for (int t = 0; t < 4; ++t)
#pragma unroll
                for (int df = 0; df < 4; ++df) { const int d = 16 * df + fr;
                    const u32x2 v0 = *(const LAS u32x2*)(lds + vso + d * 256 + (((4 * t + (g >> 1)) ^ (d & 15)) << 4) + (g & 1) * 8);
                    const u32x2 v1 = *(const LAS u32x2*)(lds + vso + d * 256 + (((4 * t + 2 + (g >> 1)) ^ (d & 15)) << 4) + (g & 1) * 8);
                    u32x4 vw; vw.x = v0.x; vw.y = v0.y; vw.z = v1.x; vw.w = v1.y; const bf16x8 vf = __builtin_bit_cast(bf16x8, vw);
                    O[df][0] = __builtin_amdgcn_mfma_f32_16x16x32_bf16(vf, Pp[t][0], O[df][0], 0, 0, 0);
                    O[df][1] = __builtin_amdgcn_mfma_f32_16x16x32_bf16(vf, Pp[t][1], O[df][1], 0, 0, 0); }
            if (nxt < 0) break;
            cur = nxt; buf ^= 1;
        }
#pragma unroll
        for (int qf = 0; qf < 2; ++qf) {
            float lt = lsum[qf]; lt += __shfl_xor(lt, 16); lt += __shfl_xor(lt, 32);
            const float inv = 1.0f / lt;
            bf16_t* dst = CAT + (size_t)(row0 + qb + 16 * qf + fr) * D + 256 + h * 64 + 4 * g;
#pragma unroll
            for (int df = 0; df < 4; ++df) { u32x2 o; o.x = pack2(O[df][qf][0] * inv, O[df][qf][1] * inv); o.y = pack2(O[df][qf][2] * inv, O[df][qf][3] * inv); *(u32x2*)(dst + 16 * df) = o; }
        }
    }
#undef MX_KSRC
#undef MX_VSTAGE
    __syncthreads();
}

constexpr int FF_DA = 0, FF_DC = 32768, FF_XT = 49152  , FF_Z2 = 81920  , FF_OB = 114688  ;
__device__ __forceinline__ int ff_addr(int row, int k) { return row * 256 + ((((k >> 3) ^ (row & 15))) << 4) + (k & 7) * 2; }
__device__ __forceinline__ float cos_turns(float x) { return __builtin_amdgcn_cosf(x); }
__device__ __forceinline__ float sin_turns(float x) { return __builtin_amdgcn_sinf(x); }
__device__ __forceinline__ void fft_setup(LAS unsigned char* lds) {
    const int tid = tid_opaque();
    __syncthreads();
    for (int idx = tid; idx < 16384; idx += NT) { const int i = idx >> 7, k = idx & 127, ro = i >> 6, k1 = i & 63, part = k >> 6, n1 = k & 63; const float t = (float)((k1 * n1) & 63) * (1.0f / 64.0f);
        const float c = cos_turns(t), sn = sin_turns(t);
        const float v = (ro == 0) ? (part == 0 ? c : sn) : (part == 0 ? -sn : c);
        *(LAS bf16_t*)(lds + FF_DA + ff_addr(i, k)) = f2bf(v * 0.125f); }
    for (int idx = tid; idx < 8192; idx += NT) { const int k2 = idx >> 7, k = idx & 127, ri = k >> 6, n2 = k & 63; const float t = (float)((k2 * n2) & 63) * (1.0f / 64.0f);
        const float v = (ri == 0) ? cos_turns(t) : sin_turns(t);
        *(LAS bf16_t*)(lds + FF_DC + ff_addr(k2, k)) = f2bf(v * 0.125f); }
    __syncthreads();
}
__device__ __forceinline__ void fft_unit(AP a, LAS unsigned char* lds, int b, int cg) {
    const int tid = tid_opaque(), lane = tid & 63, w = __builtin_amdgcn_readfirstlane(tid >> 6), fr = lane & 15, g = lane >> 4;
    const int mf = w & 3, nh = w >> 2;
    const bf16_t* AT = (const bf16_t*)(a->ws + WS_AT) + (size_t)(b * 256 + cg * 4) * 8192;
    u32x4 xin[2][2];
#pragma unroll
    for (int h = 0; h < 2; ++h)
#pragma unroll
        for (int it = 0; it < 2; ++it) xin[h][it] = ld16g(AT + (size_t)h * 8192 + (size_t)(tid + 512 * it) * 8);
#pragma unroll 1
    for (int cp = 0; cp < 2; ++cp) {
#pragma unroll
        for (int h = 0; h < 2; ++h)
#pragma unroll
            for (int it = 0; it < 2; ++it) { const int q = tid + 512 * it, part = q >> 9, pos0 = (q & 511) * 8, n1 = pos0 >> 6, n2 = pos0 & 63, k = part * 64 + n1;
                const unsigned wv[4] = {xin[h][it].x, xin[h][it].y, xin[h][it].z, xin[h][it].w};
#pragma unroll
                for (int e = 0; e < 4; ++e) { *(LAS bf16_t*)(lds + FF_XT + h * 16384 + ff_addr(n2 + 2 * e, k)) = (bf16_t)(wv[e] & 0xffffu); *(LAS bf16_t*)(lds + FF_XT + h * 16384 + ff_addr(n2 + 2 * e + 1, k)) = (bf16_t)(wv[e] >> 16); } }
        if (cp == 0) {
#pragma unroll
            for (int h = 0; h < 2; ++h)
#pragma unroll
                for (int it = 0; it < 2; ++it) xin[h][it] = ld16g(AT + (size_t)(2 + h) * 8192 + (size_t)(tid + 512 * it) * 8); }
        __syncthreads();
        f32x4 acc[2][2][2];
#pragma unroll
        for (int h = 0; h < 2; ++h)
#pragma unroll
            for (int x = 0; x < 2; ++x) { acc[h][x][0] = (f32x4){0.f, 0.f, 0.f, 0.f}; acc[h][x][1] = (f32x4){0.f, 0.f, 0.f, 0.f}; }
#pragma unroll
        for (int ks = 0; ks < 4; ++ks) {
            bf16x8 af[2];
#pragma unroll
            for (int x = 0; x < 2; ++x) { const int i = 16 * (mf + 4 * x) + fr; af[x] = *(const LAS bf16x8*)(lds + FF_DA + i * 256 + (((4 * ks + g) ^ (i & 15)) << 4)); }
#pragma unroll
            for (int h = 0; h < 2; ++h)
#pragma unroll
                for (int n = 0; n < 2; ++n) { const int j = 16 * (2 * nh + n) + fr; const bf16x8 bfv = *(const LAS bf16x8*)(lds + FF_XT + h * 16384 + j * 256 + (((4 * ks + g) ^ (j & 15)) << 4));
                    acc[h][0][n] = __builtin_amdgcn_mfma_f32_16x16x32_bf16(af[0], bfv, acc[h][0][n], 0, 0, 0);
                    acc[h][1][n] = __builtin_amdgcn_mfma_f32_16x16x32_bf16(af[1], bfv, acc[h][1][n], 0, 0, 0); }
        }
#pragma unroll
        for (int n = 0; n < 2; ++n)
#pragma unroll
            for (int r = 0; r < 4; ++r) { const int k1 = 16 * mf + 4 * g + r, n2 = 16 * (2 * nh + n) + fr; const float t = (float)((k1 * n2) & 4095) * (1.0f / 4096.0f);
                const float c = cos_turns(t), sn = sin_turns(t);
#pragma unroll
                for (int h = 0; h < 2; ++h) { const float zr = acc[h][0][n][r], zi = acc[h][1][n][r];
                    *(LAS bf16_t*)(lds + FF_Z2 + h * 16384 + ff_addr(k1, n2)) = f2bf(zr * c + zi * sn);
                    *(LAS bf16_t*)(lds + FF_Z2 + h * 16384 + ff_addr(k1, 64 + n2)) = f2bf(zi * c - zr * sn); } }
        __syncthreads();
        f32x4 acc2[2][2];
#pragma unroll
        for (int h = 0; h < 2; ++h) { acc2[h][0] = (f32x4){0.f, 0.f, 0.f, 0.f}; acc2[h][1] = (f32x4){0.f, 0.f, 0.f, 0.f}; }
#pragma unroll
        for (int ks = 0; ks < 4; ++ks) {
            const int i = 16 * mf + fr; const bf16x8 af = *(const LAS bf16x8*)(lds + FF_DC + i * 256 + (((4 * ks + g) ^ (i & 15)) << 4));
#pragma unroll
            for (int h = 0; h < 2; ++h)
#pragma unroll
                for (int n = 0; n < 2; ++n) { const int j = 16 * (2 * nh + n) + fr; const bf16x8 bfv = *(const LAS bf16x8*)(lds + FF_Z2 + h * 16384 + j * 256 + (((4 * ks + g) ^ (j & 15)) << 4));
                    acc2[h][n] = __builtin_amdgcn_mfma_f32_16x16x32_bf16(af, bfv, acc2[h][n], 0, 0, 0); }
        }
#pragma unroll
        for (int n = 0; n < 2; ++n)
#pragma unroll
            for (int r = 0; r < 4; ++r) { const int k = 16 * (2 * nh + n) + fr + 64 * (16 * mf + 4 * g + r);
                *(LAS unsigned*)(lds + FF_OB + k * 8 + cp * 4) = pack2(acc2[0][n][r], acc2[1][n][r]); }
    }
    __syncthreads();
    bf16_t* CAT = (bf16_t*)(a->ws + WS_CAT) + (size_t)(b * 4096) * D + cg * 4;
#pragma unroll
    for (int it = 0; it < 8; ++it) { const int k = tid + 512 * it; *(u32x2*)(CAT + (size_t)k * D) = *(const LAS u32x2*)(lds + FF_OB + k * 8); }
    __syncthreads();
}

__device__ __forceinline__ void p2_mix(AP a, unsigned char* ldsg, LAS unsigned char* lds, int l) {
    const int n_tile = 128 + ((l == 0) ? 8 : 0), n_att = 2 * n_tile, n_dft = 256, n_dftc = (l == 0) ? 16 : 0;
    bf16_t* CAT = (bf16_t*)(a->ws + WS_CAT);
    bool fft_ready = false;
    for (int u = blockIdx.x; u < n_att + n_dft + n_tile + n_dftc; u += gridDim.x) {
        if (u < n_att || (u >= n_att + n_dft && u < n_att + n_dft + n_tile)) {
            const bool att = u < n_att;
            const int t = att ? (u >> 1) : (u - n_att - n_dft);
            const bool isc = t >= 128; const int tt = t - 128;
            const int b = isc ? (tt >> 1) : (t >> 5);
            const int row0 = isc ? NLAT + tt * 128 : t * 128, seq_row0 = isc ? NLAT + b * 256 : b * 4096, pos0 = isc ? (tt & 1) * 128 : (t & 31) * 128, n = isc ? 256 : 4096;
            if (att) { for (int rep = 0; rep < PROBE_MIX_REP; ++rep) mixer_attn(a, lds, l, row0, seq_row0, pos0, n, b, isc, u & 1); }
            else { for (int rep = 0; rep < PROBE_SGU_REP; ++rep) mixer_sgu_pool(a, lds, l, row0, seq_row0, pos0, n); }
            fft_ready = false;
        } else if (u < n_att + n_dft) {
            const int uu = u - n_att;
            if (!fft_ready) { fft_setup(lds); fft_ready = true; }
            for (int rep = 0; rep < PROBE_FFT_REP; ++rep) fft_unit(a, lds, uu >> 6, uu & 63);
        } else {
            const int uu = u - n_att - n_dft - n_tile, b = uu >> 2, mt = (uu >> 1) & 1, ch0 = (uu & 1) * 128;
            const bf16_t* A = (const bf16_t*)(a->ws + WS_DFTC) + (size_t)(mt * 128) * 512;
            const bf16_t* B0 = (const bf16_t*)(a->ws + WS_ATC) + ((size_t)b * 256 + ch0) * 512;
            EpiBf16 E; E.C = CAT + (size_t)(NLAT + b * 256 + mt * 128) * D + ch0; E.ld = D; E.scale = 1.0f;
            gemm_tile<128, false, EpiBf16>(lds, A, 512, nullptr, 128, B0, B0 + (size_t)64 * 512, 512, 512, E);
            fft_ready = false;
        }
    }
    exp_queue(a, ldsg, l);
}

__device__ __forceinline__ int uni(int v) { return __builtin_amdgcn_readfirstlane(v); }
__device__ __forceinline__ int vblock() { const int G = gridDim.x, b = blockIdx.x; return (G % 8 == 0) ? (b % 8) * (G / 8) + b / 8 : b; }
template <class T> __device__ __forceinline__ T* unip(T* p) { const unsigned long long v = (unsigned long long)p; const unsigned lo = __builtin_amdgcn_readfirstlane((unsigned)v), hi = __builtin_amdgcn_readfirstlane((unsigned)(v >> 32)); return (T*)(((unsigned long long)hi << 32) | lo); }
struct SchedInProj {
    typedef EpiInProj Epi; static constexpr bool GATHER = false, FP8 = false;
    unsigned char* ws; int l, G, me;
    __device__ __forceinline__ bool get(int i, g256::Unit<Epi>& u) const {
        const int n_lat = 64 * 7, n_ctx = (l == 0) ? 4 * 7 : 4;
        const int idx = i * G + me; if (idx >= n_lat + n_ctx) return false;
        int row0, b, ct, n; bf16_t *tF, *tV;
        if (idx < n_lat) { const int rt = idx / 7; ct = idx % 7; row0 = rt * 256; b = row0 >> 12; n = 4096;
            tF = (bf16_t*)(ws + WS_AT) + (size_t)b * 256 * 2 * 4096; tV = (bf16_t*)(ws + WS_VT) + (size_t)b * 128 * 4096; }
        else { const int uu = idx - n_lat; int rt; if (l == 0) { rt = uu / 7; ct = uu % 7; } else { rt = uu; ct = 3; }
            row0 = NLAT + rt * 256; b = rt; n = 256;
            tF = (bf16_t*)(ws + WS_ATC) + (size_t)b * 256 * 2 * 256; tV = (bf16_t*)(ws + WS_VTC) + (size_t)b * 128 * 256; }
        u.A = (const bf16_t*)(ws + WS_H) + (size_t)row0 * D;
        u.B0 = (const bf16_t*)(ws + WS_WIN) + ((size_t)l * ZC + ct * 256) * 1024; u.B1 = u.B0 + (size_t)128 * 1024; u.ridx = nullptr; u.valid = 256;
        u.epi.Zt = (bf16_t*)(ws + WS_Z) + (size_t)row0 * ZC + ct * 256; u.epi.tF = tF; u.epi.tV = tV; u.epi.n0 = ct * 256; u.epi.pos0 = (idx < n_lat) ? (row0 & 4095) : 0; u.epi.n = n;
        return true;
    }
};
struct SchedOutProj {
    typedef EpiBf16 Epi; static constexpr bool GATHER = false, FP8 = false;
    unsigned char* ws; int l, G, me;
    __device__ __forceinline__ bool get(int i, g256::Unit<Epi>& u) const {
        const int nrt = NLAT / 256;
        const int idx = i * G + me; if (idx >= nrt * 4) return false;
        const int rt = idx >> 2, ct = idx & 3;
        u.A = (const bf16_t*)(ws + WS_CAT) + (size_t)(rt * 256) * D;
        u.B0 = (const bf16_t*)(ws + WS_WOUT) + ((size_t)l * 1024 + ct * 256) * 1024; u.B1 = u.B0 + (size_t)128 * 1024; u.ridx = nullptr; u.valid = 256;
        u.epi.C = (bf16_t*)(ws + WS_Y) + (size_t)(rt * 256) * D + ct * 256; u.epi.ld = D; u.epi.scale = 1.0f;
        return true;
    }
};
struct SchedGateUp {
    typedef EpiGateUp8 Epi; static constexpr bool GATHER = true, FP8 = true;
    unsigned char* ws; const LAS int* blk; const LAS int* tot; const LAS int* ridx_lds; int G, me, l;
    __device__ __forceinline__ bool get(int i, g256::Unit<Epi>& u) const {
        const int idx = i * G + me; if (idx >= uni(blk[32]) * 4) return false;
        const int rb = idx >> 2, ct = idx & 3;
        int e = 0;
#pragma unroll 1
        for (int q = 1; q < 32; ++q) if (uni(blk[q]) <= rb) e = q;
        u.A = (const bf16_t*)(ws + WS_H8);
        { const unsigned char* b0 = ws + WS_WEXP + (size_t)l * WEXP_LAYER + ((size_t)e * 512 + ct * 128) * 1024; u.B0 = (const bf16_t*)b0; u.B1 = (const bf16_t*)(b0 + EXPMAT); }
        u.ridx = ridx_lds + (i & 7) * 256; u.valid = uni(min(256, tot[e] - (rb - blk[e]) * 256));
        u.epi.C = ws + WS_HID + (size_t)(rb * 256) * DEXP + ct * 128; u.epi.ld = DEXP;
        return true;
    }
};
struct SchedDown {
    typedef EpiBf16 Epi; static constexpr bool GATHER = false, FP8 = true;
    unsigned char* ws; const LAS int* blk; int G, me, l;
    __device__ __forceinline__ bool get(int i, g256::Unit<Epi>& u) const {
        const int idx = i * G + me; if (idx >= uni(blk[32]) * 4) return false;
        const int rb = idx >> 2, ct = idx & 3;
        int e = 0;
#pragma unroll 1
        for (int q = 1; q < 32; ++q) if (uni(blk[q]) <= rb) e = q;
        u.A = (const bf16_t*)(ws + WS_HID + (size_t)(rb * 256) * DEXP);
        { const unsigned char* b0 = ws + WS_WEXP + (size_t)l * WEXP_LAYER + 2 * EXPMAT + ((size_t)e * 1024 + ct * 256) * 512; u.B0 = (const bf16_t*)b0; u.B1 = (const bf16_t*)(b0 + (size_t)128 * 512); } u.ridx = nullptr; u.valid = 256;
        u.epi.C = (bf16_t*)(ws + WS_YS) + (size_t)(rb * 256) * D + ct * 256; u.epi.ld = D; u.epi.scale = 1.0f / 32.0f;
        return true;
    }
};

__device__ __forceinline__ void p4_ln1_router(AP a, unsigned char* lds, int l) {
    const int tid = tid_opaque(), lane = tid & 63, w = tid >> 6;
    const int ntok = (l == 0) ? NTOK : NLAT;
    int* cnt = (int*)(lds + MISC_OFF);
    if (tid < 32) cnt[tid] = 0;
    f32x4* Lg = (f32x4*)lds; f32x4* Le = (f32x4*)(lds + 16384); f32x4* Lgb = (f32x4*)(lds + 147456);
    {
        const float* wrg_ = a->in[16] + (size_t)l * 1024 * 4; const float* wre_ = a->in[17] + (size_t)l * 1024 * 32;
#pragma unroll
        for (int it = 0; it < 2; ++it) { const int c = tid + 512 * it, slot = (((c >> 8) * 4 + (c & 3)) << 6) + ((c >> 2) & 63);
            Lg[slot] = *(const f32x4*)(wrg_ + (size_t)c * 4);
#pragma unroll
            for (int q = 0; q < 8; ++q) Le[q * 1024 + slot] = *(const f32x4*)(wre_ + (size_t)c * 32 + q * 4); }
        Lgb[tid] = (tid < 256) ? *(const f32x4*)(a->in[14] + l * 1024 + tid * 4) : *(const f32x4*)(a->in[15] + l * 1024 + (tid - 256) * 4);
    }
    __syncthreads();
    const float* mod = (const float*)(a->ws + WS_MOD) + (size_t)l * 5 * 6144;
    const bf16_t* Y = (const bf16_t*)(a->ws + WS_Y);
    float* X1 = (float*)(a->ws + WS_X1);
    unsigned char* H8 = a->ws + WS_H8;
    int* tokE = (int*)(a->ws + WS_TOKE); int* tokR = (int*)(a->ws + WS_TOKR); float* tokG = (float*)(a->ws + WS_TOKG);
    const int tstep = gridDim.x * 8;
    f32x4 nx[4]; u32x2 ny[4];
    {   const int t = blockIdx.x * 8 + w;
        if (t < ntok) { const float* xs = (l == 0) ? ((t < NLAT) ? a->in[0] + (size_t)t * D : a->in[2] + (size_t)(t - NLAT) * D) : (const float*)(a->ws + WS_XC) + (size_t)t * D;
#pragma unroll
            for (int i = 0; i < 4; ++i) { nx[i] = *(const f32x4*)(xs + 256 * i + 4 * lane); ny[i] = *(const u32x2*)(Y + (size_t)t * D + 256 * i + 4 * lane); } } }
    int mrow = -1; f32x4 mg[4], msh[4], msc[4];
    for (int t = blockIdx.x * 8 + w; t < ntok; t += tstep) {
        const int mr = (t < NLAT) ? (t >> 12) : 4;
        if (mr != mrow) { mrow = mr; const float* m = mod + (size_t)mr * 6144;
#pragma unroll
            for (int i = 0; i < 4; ++i) { const int c = 256 * i + 4 * lane; mg[i] = *(const f32x4*)(m + 2048 + c); msh[i] = *(const f32x4*)(m + 3072 + c); msc[i] = *(const f32x4*)(m + 4096 + c); } }
        f32x4 v[4];
#pragma unroll
        for (int i = 0; i < 4; ++i) { const f32x4 yv = (f32x4){lo2f(ny[i].x), hi2f(ny[i].x), lo2f(ny[i].y), hi2f(ny[i].y)};
#pragma unroll
            for (int e = 0; e < 4; ++e) v[i][e] = RES_ALPHA * nx[i][e] + mg[i][e] * yv[e]; }
        {   const int tn = t + tstep;
            if (tn < ntok) { const float* xs = (l == 0) ? ((tn < NLAT) ? a->in[0] + (size_t)tn * D : a->in[2] + (size_t)(tn - NLAT) * D) : (const float*)(a->ws + WS_XC) + (size_t)tn * D;
#pragma unroll
                for (int i = 0; i < 4; ++i) { nx[i] = *(const f32x4*)(xs + 256 * i + 4 * lane); ny[i] = *(const u32x2*)(Y + (size_t)tn * D + 256 * i + 4 * lane); } } }
        float mean, rstd; ln_stats(v, mean, rstd);
#pragma unroll
        for (int i = 0; i < 4; ++i) { const int c = 256 * i + 4 * lane; const f32x4 gg = Lgb[64 * i + lane], bb = Lgb[256 + 64 * i + lane];
#pragma unroll
            for (int e = 0; e < 4; ++e) v[i][e] = (v[i][e] - mean) * rstd * gg[e] + bb[e];
            *(f32x4*)(X1 + (size_t)t * D + c) = v[i]; }
        ln_stats(v, mean, rstd);
#pragma unroll
        for (int i = 0; i < 4; ++i) { const int c = 256 * i + 4 * lane; const f32x4 sh = msh[i], sc = msc[i];
#pragma unroll
            for (int e = 0; e < 4; ++e) v[i][e] = (v[i][e] - mean) * rstd * (1.0f + sc[e]) + sh[e];
            *(unsigned*)(H8 + (size_t)t * D + c) = pack4_fp8(v[i][0], v[i][1], v[i][2], v[i][3]); }
        f32x2 lg01 = (f32x2){0.f, 0.f}, lg23 = (f32x2){0.f, 0.f};
#pragma unroll
        for (int i = 0; i < 4; ++i)
#pragma unroll
            for (int e = 0; e < 4; ++e) { const f32x4 wv = Lg[((i * 4 + e) << 6) + lane]; const f32x2 vv = (f32x2){v[i][e], v[i][e]};
                lg01 += vv * (f32x2){wv[0], wv[1]}; lg23 += vv * (f32x2){wv[2], wv[3]}; }
        float lg[4] = {wave_sum(lg01[0]), wave_sum(lg01[1]), wave_sum(lg23[0]), wave_sum(lg23[1])};
        int grp = 0; float mx = lg[0];
#pragma unroll
        for (int q = 1; q < 4; ++q) if (lg[q] > mx) { mx = lg[q]; grp = q; }
        float se = 0.f;
#pragma unroll
        for (int q = 0; q < 4; ++q) se += expf(lg[q] - mx);
        const float gate_group = 1.0f / se;
        f32x2 le01 = (f32x2){0.f, 0.f}, le23 = (f32x2){0.f, 0.f}, le45 = (f32x2){0.f, 0.f}, le67 = (f32x2){0.f, 0.f};
#pragma unroll
        for (int i = 0; i < 4; ++i)
#pragma unroll
            for (int e = 0; e < 4; ++e) { const f32x4* wp = Le + grp * 2048 + ((i * 4 + e) << 6) + lane; const f32x4 w0 = wp[0], w1 = wp[1024]; const f32x2 vv = (f32x2){v[i][e], v[i][e]};
                le01 += vv * (f32x2){w0[0], w0[1]}; le23 += vv * (f32x2){w0[2], w0[3]}; le45 += vv * (f32x2){w1[0], w1[1]}; le67 += vv * (f32x2){w1[2], w1[3]}; }
        float le[8] = {wave_sum(le01[0]), wave_sum(le01[1]), wave_sum(le23[0]), wave_sum(le23[1]), wave_sum(le45[0]), wave_sum(le45[1]), wave_sum(le67[0]), wave_sum(le67[1])};
        int j1 = 0; float l1 = le[0];
#pragma unroll
        for (int q = 1; q < 8; ++q) if (le[q] > l1) { l1 = le[q]; j1 = q; }
        int j2 = -1; float l2 = -3.0e38f;
#pragma unroll
        for (int q = 0; q < 8; ++q) if (q != j1 && le[q] > l2) { l2 = le[q]; j2 = q; }
        const float e2 = expf(l2 - l1), p1 = 1.0f / (1.0f + e2), p2 = e2 / (1.0f + e2);
        if (lane == 0) {
            const int ex0 = grp * 8 + j1, ex1 = grp * 8 + j2;
            const int r0 = atomicAdd(&cnt[ex0], 1), r1 = atomicAdd(&cnt[ex1], 1);
            tokE[2 * t] = ex0; tokE[2 * t + 1] = ex1; tokR[2 * t] = r0; tokR[2 * t + 1] = r1;
            tokG[2 * t] = gate_group * p1; tokG[2 * t + 1] = gate_group * p2;
        }
    }
    __syncthreads();
    if (tid < 32) ((int*)(a->ws + WS_BCNT))[((size_t)l * MAXG + blockIdx.x) * 32 + tid] = cnt[tid];
    __syncthreads();
}

__device__ __forceinline__ void p5_dispatch(AP a, unsigned char* lds, int l) {
    const int tid = tid_opaque();
    const int ntok = (l == 0) ? NTOK : NLAT;
    int* part = (int*)lds;
    int* tot = (int*)(lds + 4096);
    int* off = (int*)(lds + 4096 + 128);
    int* pstart = (int*)(lds + 4096 + 256);
    const int* bc = (const int*)(a->ws + WS_BCNT) + (size_t)l * MAXG * 32;
    const int G = gridDim.x, me = blockIdx.x;
    { const int e = tid & 31, p = tid >> 5; int s = 0, so = 0; for (int bb = p; bb < G; bb += 16) { const int c = bc[bb * 32 + e]; s += c; if (bb < me) so += c; } part[p * 32 + e] = s; part[512 + p * 32 + e] = so; }
    __syncthreads();
    if (tid < 32) { int s = 0, so = 0; for (int p = 0; p < 16; ++p) { s += part[p * 32 + tid]; so += part[512 + p * 32 + tid]; } tot[tid] = s; off[tid] = so; }
    __syncthreads();
    if (tid == 0) { int acc = 0; for (int e = 0; e < 32; ++e) { pstart[e] = acc; acc += ((tot[e] + 255) >> 8) << 8; } }
    __syncthreads();
    if (me == 0 && tid < 32) ((int*)(a->ws + WS_CNT))[l * 32 + tid] = tot[tid];
    const int* tokE = (const int*)(a->ws + WS_TOKE); const int* tokR = (const int*)(a->ws + WS_TOKR);
    int* tokS = (int*)(a->ws + WS_TOKS); int* slotT = (int*)(a->ws + WS_SLOTT);
    for (int q = tid; ; q += NT) { const int it = q >> 4, j = q & 15, t = (it * G + me) * 8 + (j >> 1); if (t >= ntok) break;
        const int idx = 2 * t + (j & 1); const int e = tokE[idx]; const int slot = pstart[e] + off[e] + tokR[idx]; tokS[idx] = slot; slotT[slot] = t; }
    __syncthreads();
}

__device__ __forceinline__ void moe_table(AP a, int l, LAS int* blk) {
    const int* tot = (const int*)(a->ws + WS_CNT) + l * 32;
    if (threadIdx.x == 0) { int acc = 0; for (int e = 0; e < 32; ++e) { const int c = tot[e]; blk[e] = acc; blk[33 + e] = c; acc += (c + 255) >> 8; } blk[32] = acc; }
    __syncthreads();
}
__device__ __forceinline__ int units_of(int nu, int v, int G) { return (v < nu) ? (nu - v + G - 1) / G : 0; }
__device__ __forceinline__ void p1_inproj(AP a, unsigned char* smem, LAS unsigned char* lds, int l) {
    SchedInProj S; S.ws = a->ws; S.l = l; S.G = gridDim.x; S.me = vblock();
    g256::gemm_phase(lds, 1024, S);
    if (l == 0) { const int nu = 64 * 7 + 4 * 7, G = gridDim.x; if (units_of(nu, S.me, G) < (nu + G - 1) / G) exp_fill(a, smem, 0, 8); }
}
__device__ __forceinline__ void p3_outproj(AP a, unsigned char* smem, LAS unsigned char* lds, int l) {
    SchedOutProj S; S.ws = a->ws; S.l = l; S.G = gridDim.x; S.me = vblock();
    g256::gemm_phase(lds, 1024, S);
    if (l == 0) {
        const bf16_t* W = (const bf16_t*)(a->ws + WS_WOUT);
        for (int u = blockIdx.x; u < 64; u += gridDim.x) { const int rt = u >> 3, ct = u & 7;
            EpiBf16 E; E.C = (bf16_t*)(a->ws + WS_Y) + (size_t)(NLAT + rt * 128) * D + ct * 128; E.ld = D; E.scale = 1.0f;
            const bf16_t* B0 = W + (size_t)(ct * 128) * 1024;
            gemm_tile<128, false, EpiBf16>(lds, (const bf16_t*)(a->ws + WS_CAT) + (size_t)(NLAT + rt * 128) * D, D, nullptr, 128, B0, B0 + (size_t)64 * 1024, 1024, 1024, E); }
        if (blockIdx.x >= 64) exp_fill(a, smem, 0, 3);
    }
}
__device__ __forceinline__ void p6_gateup(AP a, unsigned char* smem, LAS unsigned char* lds, int l) {
    LAS int* blk = (LAS int*)(lds + MISC_OFF + 256);
    moe_table(a, l, blk);
    LAS int* ridx = (LAS int*)(lds + RIDX_OFF);
    const int tid = tid_opaque(), G = gridDim.x, me = vblock(), nu = blk[32] * 4;
    const int* slotT = (const int*)(a->ws + WS_SLOTT);
    for (int i = 0; i < 8; ++i) { const int idx = i * G + me; if (idx >= nu) break;
        const int rb = idx >> 2; int e = 0; for (int q = 1; q < 32; ++q) if (blk[q] <= rb) e = q;
        const int valid = min(256, blk[33 + e] - (rb - blk[e]) * 256);
        if (tid < 256) ridx[i * 256 + tid] = (tid < valid) ? slotT[rb * 256 + tid] : 0; }
    __syncthreads();
    SchedGateUp S; S.ws = a->ws; S.blk = blk; S.tot = blk + 33; S.ridx_lds = ridx; S.G = G; S.me = me; S.l = l;
    g256::gemm_phase(lds, 512, S);
    __syncthreads();
    if (l == 0 && units_of(nu, me, G) < (nu + G - 1) / G) exp_fill(a, smem, 1, 4);
}
__device__ __forceinline__ void p7_down(AP a, unsigned char* smem, LAS unsigned char* lds, int l) {
    LAS int* blk = (LAS int*)(lds + MISC_OFF + 256);
    moe_table(a, l, blk);
    SchedDown S; S.ws = a->ws; S.blk = blk; S.G = gridDim.x; S.me = vblock(); S.l = l;
    g256::gemm_phase(lds, 256, S);
    __syncthreads();
    { const int nu = uni(blk[32]) * 4, G = gridDim.x; if (l == 0 && units_of(nu, S.me, G) < (nu + G - 1) / G) exp_fill(a, smem, 1, 2); }
}

__device__ __forceinline__ void p8_ln2(AP a, unsigned char* lds, int l) {
    const int tid = tid_opaque(), lane = tid & 63, w = tid >> 6;
    const int ntok = (l == 0) ? NTOK : NLAT;
    const float* mod = (const float*)(a->ws + WS_MOD) + (size_t)l * 5 * 6144;
    const float* modn = (const float*)(a->ws + WS_MOD) + (size_t)5 * 6144;
    const float* X1 = (const float*)(a->ws + WS_X1);
    const bf16_t* YS = (const bf16_t*)(a->ws + WS_YS);
    const int* tokS = (const int*)(a->ws + WS_TOKS); const float* tokG = (const float*)(a->ws + WS_TOKG);
    f32x4* Lgb = (f32x4*)lds;
    __syncthreads();
    Lgb[tid] = (tid < 256) ? *(const f32x4*)(a->in[21] + l * 1024 + tid * 4) : *(const f32x4*)(a->in[22] + l * 1024 + (tid - 256) * 4);
    __syncthreads();
    int mrow = -1; f32x4 mg[4], nsh[4], nsc[4];
    const int tstep = gridDim.x * 8;
    int t = blockIdx.x * 8 + w;
    int ns0 = 0, ns1 = 0; float nga = 0.f, ngb = 0.f;
    f32x4 nx[4]; u32x2 nya[4], nyb[4];
    float cga = 0.f, cgb = 0.f;
    if (t < ntok) { const int s0 = tokS[2 * t], s1 = tokS[2 * t + 1]; cga = tokG[2 * t]; cgb = tokG[2 * t + 1];
#pragma unroll
        for (int i = 0; i < 4; ++i) { const int c = 256 * i + 4 * lane; nx[i] = *(const f32x4*)(X1 + (size_t)t * D + c); nya[i] = *(const u32x2*)(YS + (size_t)s0 * D + c); nyb[i] = *(const u32x2*)(YS + (size_t)s1 * D + c); } }
    if (t + tstep < ntok) { ns0 = tokS[2 * (t + tstep)]; ns1 = tokS[2 * (t + tstep) + 1]; nga = tokG[2 * (t + tstep)]; ngb = tokG[2 * (t + tstep) + 1]; }
    for (; t < ntok; t += tstep) {
        const int mr = (t < NLAT) ? (t >> 12) : 4;
        if (mr != mrow) { mrow = mr; const float* m = mod + (size_t)mr * 6144; const float* mn = modn + (size_t)mr * 6144;
#pragma unroll
            for (int i = 0; i < 4; ++i) { const int c = 256 * i + 4 * lane; mg[i] = *(const f32x4*)(m + 5120 + c); if (l == 0) { nsh[i] = *(const f32x4*)(mn + c); nsc[i] = *(const f32x4*)(mn + 1024 + c); } } }
        f32x4 v[4];
#pragma unroll
        for (int i = 0; i < 4; ++i) { const f32x4 gv = mg[i];
            const u32x2 ya = nya[i], yb = nyb[i];
            const float f0 = cga * lo2f(ya.x) + cgb * lo2f(yb.x), f1 = cga * hi2f(ya.x) + cgb * hi2f(yb.x), f2 = cga * lo2f(ya.y) + cgb * lo2f(yb.y), f3 = cga * hi2f(ya.y) + cgb * hi2f(yb.y);
            v[i][0] = RES_ALPHA * nx[i][0] + gv[0] * f0; v[i][1] = RES_ALPHA * nx[i][1] + gv[1] * f1; v[i][2] = RES_ALPHA * nx[i][2] + gv[2] * f2; v[i][3] = RES_ALPHA * nx[i][3] + gv[3] * f3; }
        {   const int tn = t + tstep, tn2 = t + 2 * tstep;
            if (tn < ntok) {
#pragma unroll
                for (int i = 0; i < 4; ++i) { const int c = 256 * i + 4 * lane; nx[i] = *(const f32x4*)(X1 + (size_t)tn * D + c); nya[i] = *(const u32x2*)(YS + (size_t)ns0 * D + c); nyb[i] = *(const u32x2*)(YS + (size_t)ns1 * D + c); }
                cga = nga; cgb = ngb; }
            if (tn2 < ntok) { ns0 = tokS[2 * tn2]; ns1 = tokS[2 * tn2 + 1]; nga = tokG[2 * tn2]; ngb = tokG[2 * tn2 + 1]; } }
        float mean, rstd; ln_stats(v, mean, rstd);
        float* dst = (l == 0) ? (float*)(a->ws + WS_XC) + (size_t)t * D : a->out + (size_t)t * D;
#pragma unroll
        for (int i = 0; i < 4; ++i) { const int c = 256 * i + 4 * lane; const f32x4 gg = Lgb[64 * i + lane], bb = Lgb[256 + 64 * i + lane];
#pragma unroll
            for (int e = 0; e < 4; ++e) v[i][e] = (v[i][e] - mean) * rstd * gg[e] + bb[e];
            *(f32x4*)(dst + c) = v[i]; }
        if (l == 0) {
            ln_stats(v, mean, rstd);
            bf16_t* H = (bf16_t*)(a->ws + WS_H);
#pragma unroll
            for (int i = 0; i < 4; ++i) { const int c = 256 * i + 4 * lane; const f32x4 sh = nsh[i], sc = nsc[i];
                f32x4 o;
#pragma unroll
                for (int e = 0; e < 4; ++e) o[e] = (v[i][e] - mean) * rstd * (1.0f + sc[e]) + sh[e];
                u32x2 pk; pk.x = pack2(o[0], o[1]); pk.y = pack2(o[2], o[3]); *(u32x2*)(H + (size_t)t * D + c) = pk; }
        }
    }
}

constexpr int N_PHASES = 18;
template <int P> __device__ __forceinline__ void run_phase(AP a, unsigned char* smem, LAS unsigned char* lds, int l) {
    asm volatile("" : "+s"(a));
    if (P == 0) p0_prologue(a, smem);
    if (P == 1) p_lnmod0(a);
    if (P == 2) p1_inproj(a, smem, lds, l);
    if (P == 3) p2_mix(a, smem, lds, l);
    if (P == 4) p3_outproj(a, smem, lds, l);
    if (P == 5) p4_ln1_router(a, smem, l);
    if (P == 6) p5_dispatch(a, smem, l);
    if (P == 7) p6_gateup(a, smem, lds, l);
    if (P == 8) p7_down(a, smem, lds, l);
    if (P == 9) p8_ln2(a, smem, l);
}
#if N_LAUNCH_MODE == 1
__global__ void __launch_bounds__(NT, 2) fwd(Args a) {
    extern __shared__ __attribute__((aligned(16))) unsigned char smem[];
    LAS unsigned char* lds = (LAS unsigned char*)smem;
    if (threadIdx.x < 4) ((volatile LAS unsigned*)(lds + MISC_OFF + 768))[threadIdx.x] = 0u;
    __syncthreads();
    XcdBarrier bar = xcd_barrier_post((unsigned*)(a.ws + WS_BAR), (volatile LAS unsigned*)(lds + MISC_OFF + 768));
    AP ap = (AP)__builtin_amdgcn_kernarg_segment_ptr();
#define PROBE(P, l) do { if (PROBE_MASK & (1 << (P))) { for (int _r = 0; _r < 2; ++_r) { xcd_barrier(bar); run_phase<P>(ap, smem, lds, l); } } } while (0)
    run_phase<0>(ap, smem, lds, 0); PROBE(0, 0); xcd_barrier(bar);
    run_phase<1>(ap, smem, lds, 0); PROBE(1, 0); xcd_barrier(bar);
    for (int l = 0; l < 2; ++l) {
        run_phase<2>(ap, smem, lds, l); PROBE(2, l); xcd_barrier(bar);
        run_phase<3>(ap, smem, lds, l); PROBE(3, l); xcd_barrier(bar);
        run_phase<4>(ap, smem, lds, l); PROBE(4, l); xcd_barrier(bar);
        run_phase<5>(ap, smem, lds, l); PROBE(5, l); xcd_barrier(bar);
        run_phase<6>(ap, smem, lds, l); PROBE(6, l); xcd_barrier(bar);
        run_phase<7>(ap, smem, lds, l); PROBE(7, l); xcd_barrier(bar);
        run_phase<8>(ap, smem, lds, l); PROBE(8, l); xcd_barrier(bar);
        run_phase<9>(ap, smem, lds, l); PROBE(9, l); if (l == 0) xcd_barrier(bar);
    }
}
#else
template <int P> __global__ void __launch_bounds__(NT, 2) k_phase(Args a) {
    extern __shared__ __attribute__((aligned(16))) unsigned char smem[];
    LAS unsigned char* lds = (LAS unsigned char*)smem;
    AP ap = (AP)__builtin_amdgcn_kernarg_segment_ptr();
    run_phase<P>(ap, smem, lds, ap->ph_lo);
}
template <int P> static void launch_phase(Args a, int l, int grid, hipStream_t stream) {
    static bool attr = false;
    if (!attr) { (void)hipFuncSetAttribute((const void*)k_phase<P>, hipFuncAttributeMaxDynamicSharedMemorySize, LDS_BYTES); attr = true; }
    a.ph_lo = l; a.ph_hi = P;
    hipLaunchKernelGGL(k_phase<P>, dim3(grid), dim3(NT), LDS_BYTES, stream, a);
}
#endif

extern "C" void kernel_launch(void* const* d_in, const int* in_sizes, int n_in, void* d_out, int out_size, void* d_ws, size_t ws_size, hipStream_t stream) {
    static int grid = 0;
    if (grid == 0) {
        if (n_in != 23 || out_size != NLAT * D || ws_size < WS_END) { fprintf(stderr, "kernel_launch: unexpected shapes (n_in %d, out %d, ws %zu, need %zu)\n", n_in, out_size, ws_size, (size_t)WS_END); grid = -1; return; }
        int dev = 0, cus = 0;
        if (hipGetDevice(&dev) != hipSuccess || hipDeviceGetAttribute(&cus, hipDeviceAttributeMultiprocessorCount, dev) != hipSuccess) { grid = -1; return; }
#if N_LAUNCH_MODE == 1
        int per_cu = 0;
        if (hipFuncSetAttribute((const void*)fwd, hipFuncAttributeMaxDynamicSharedMemorySize, LDS_BYTES) != hipSuccess) { fprintf(stderr, "kernel_launch: hipFuncSetAttribute failed\n"); grid = -1; return; }
        if (hipOccupancyMaxActiveBlocksPerMultiprocessor(&per_cu, (const void*)fwd, NT, LDS_BYTES) != hipSuccess || per_cu < 1) { fprintf(stderr, "kernel_launch: occupancy query says %d\n", per_cu); }
        (void)hipGetLastError();
#endif
        grid = cus; if (grid > MAXG) grid = MAXG;
    }
    if (grid < 0) return;
    (void)hipMemsetAsync((char*)d_ws + WS_BAR, 0, 16384 + 256, stream);
    Args a{};
    for (int i = 0; i < 23; ++i) a.in[i] = (const float*)d_in[i];
    a.out = (float*)d_out; a.ws = (unsigned char*)d_ws;
#if N_LAUNCH_MODE == 1
    a.ph_lo = 0; a.ph_hi = N_PHASES;
    hipLaunchKernelGGL(fwd, dim3(grid), dim3(NT), LDS_BYTES, stream, a);
#else
    launch_phase<0>(a, 0, grid, stream);
    launch_phase<1>(a, 0, grid, stream);
    for (int l = 0; l < 2; ++l) {
        launch_phase<2>(a, l, grid, stream); launch_phase<3>(a, l, grid, stream); launch_phase<4>(a, l, grid, stream); launch_phase<5>(a, l, grid, stream);
        launch_phase<6>(a, l, grid, stream); launch_phase<7>(a, l, grid, stream); launch_phase<8>(a, l, grid, stream); launch_phase<9>(a, l, grid, stream);
    }
#endif
}
```

```cpp
#include <hip/hip_runtime.h>
#include <stdint.h>
#include <stdio.h>

#ifndef PROBE_MASK
#define PROBE_MASK 0
#endif
#ifndef PROBE_FFT_REP
#define PROBE_FFT_REP 1
#endif
#ifndef PROBE_MIX_REP
#define PROBE_MIX_REP 1
#endif
#ifndef PROBE_SGU_REP
#define PROBE_SGU_REP 1
#endif
#ifndef N_LAUNCH_MODE
#define N_LAUNCH_MODE 1
#endif

#define LAS __attribute__((address_space(3)))
typedef unsigned short bf16_t;
typedef short bf16x8 __attribute__((ext_vector_type(8)));
typedef float f32x4 __attribute__((ext_vector_type(4)));
typedef unsigned u32x4 __attribute__((ext_vector_type(4)));
typedef unsigned u32x2 __attribute__((ext_vector_type(2)));
typedef float f32x2 __attribute__((ext_vector_type(2)));
typedef int i32x4 __attribute__((ext_vector_type(4)));

constexpr int D = 1024, NBATCH = 4, SEQ = 4096, CTXL = 256;
constexpr int NLAT = NBATCH * SEQ, NCTX = NBATCH * CTXL, NTOK = NLAT + NCTX;
constexpr int ZC = 1792;
constexpr int NEXP = 32, DEXP = 512;
constexpr int NSLOT = 2 * NTOK + NEXP * 256;
constexpr int NT = 512;
constexpr int MAXG = 512;
constexpr float RES_ALPHA = 1.41421356237309515f;
constexpr int MISC_OFF = 155648;
constexpr int RIDX_OFF = 131072;
constexpr int LDS_BYTES = MISC_OFF + 1024;

constexpr size_t WS_BAR   = 0;
constexpr size_t WS_CNT   = 16384;
constexpr size_t WS_BCNT  = WS_CNT + 256;
constexpr size_t WS_MOD   = WS_BCNT + (size_t)2 * MAXG * 32 * 4;
constexpr size_t WS_ROPE  = WS_MOD + (size_t)2 * 5 * 6144 * 4;
constexpr size_t WS_TOKE  = WS_ROPE + 8192;
constexpr size_t WS_TOKR  = WS_TOKE + (size_t)NTOK * 8;
constexpr size_t WS_TOKS  = WS_TOKR + (size_t)NTOK * 8;
constexpr size_t WS_TOKG  = WS_TOKS + (size_t)NTOK * 8;
constexpr size_t WS_SLOTT = WS_TOKG + (size_t)NTOK * 8;
constexpr size_t WS_WIN   = WS_SLOTT + (size_t)NSLOT * 4;
constexpr size_t WS_WOUT  = WS_WIN + (size_t)2 * ZC * 1024 * 2;
constexpr size_t WS_WSGU  = WS_WOUT + (size_t)2 * 1024 * 1024 * 2;
constexpr size_t WS_DFTC  = WS_WSGU + (size_t)2 * 4 * 128 * 128 * 2;
constexpr size_t WS_WEXP  = WS_DFTC + (size_t)256 * 512 * 2;
constexpr size_t EXPMAT   = (size_t)NEXP * 512 * 1024;
constexpr size_t WEXP_LAYER = 3 * EXPMAT;
constexpr size_t WS_X1    = WS_WEXP + 2 * WEXP_LAYER;
constexpr size_t WS_XC    = WS_X1 + (size_t)NTOK * D * 4;
constexpr size_t WS_H     = WS_XC + (size_t)NTOK * D * 4;
constexpr size_t WS_R     = WS_H + (size_t)NTOK * D * 2;
constexpr size_t WS_Z     = WS_R;
constexpr size_t WS_AT    = WS_Z + (size_t)NTOK * ZC * 2;
constexpr size_t WS_ATC   = WS_AT + (size_t)4 * 256 * 8192 * 2;
constexpr size_t WS_VT    = WS_ATC + (size_t)4 * 256 * 512 * 2;
constexpr size_t WS_VTC   = WS_VT + (size_t)4 * 2 * 64 * 4096 * 2;
constexpr size_t WS_CAT   = WS_VTC + (size_t)4 * 2 * 64 * 256 * 2;
constexpr size_t WS_REND  = WS_CAT + (size_t)NTOK * D * 2;
constexpr size_t WS_Y     = WS_R;
constexpr size_t WS_HID   = WS_R;
constexpr size_t WS_YS    = WS_HID + (size_t)NSLOT * DEXP * 2;
constexpr size_t WS_REND2 = (WS_YS + (size_t)NSLOT * D * 2 > WS_REND) ? WS_YS + (size_t)NSLOT * D * 2 : WS_REND;
constexpr size_t WS_H8    = (WS_REND2 + 255) & ~(size_t)255;
constexpr size_t WS_END   = WS_H8 + (size_t)NTOK * D;
static_assert(WS_Y + (size_t)NTOK * D * 4 <= WS_CAT, "Y must not reach CAT");
static_assert(WS_WIN % 256 == 0 && WS_DFTC % 256 == 0 && WS_WEXP % 256 == 0 && WS_X1 % 256 == 0 && WS_H % 256 == 0 && WS_R % 256 == 0 && WS_AT % 256 == 0 && WS_CAT % 256 == 0 && WS_YS % 256 == 0, "alignment");

struct Args { const float* in[23]; float* out; unsigned char* ws; int ph_lo, ph_hi; };
#define CAS __attribute__((address_space(4)))
typedef const CAS Args* AP;

#define XB_TMO      128
#define XB_XCNT(j)  (256  + 64 * (j))
#define XB_XSUB(j)  (1280 + 64 * (j))
#define XB_XGEN(j)  (2304 + 64 * (j))
#define XB_TOP      3328
#define XB_TOPGEN   3392
#define XCD_BAR_WORDS 3456
#define XB_SPIN_CAP (1u << 18)

__device__ __forceinline__ unsigned xb_ld(unsigned* p)              { return __hip_atomic_load(p, __ATOMIC_RELAXED, __HIP_MEMORY_SCOPE_AGENT); }
__device__ __forceinline__ unsigned xb_add(unsigned* p, unsigned v) { return __hip_atomic_fetch_add(p, v, __ATOMIC_RELAXED, __HIP_MEMORY_SCOPE_AGENT); }
__device__ __forceinline__ unsigned xb_xcc_id() { return (unsigned)__builtin_amdgcn_s_getreg((3 << 11) | 20) & 0xFu; }
#define XB_SPIN(cond, bar) do { unsigned _sp = 0; while (cond) { __builtin_amdgcn_s_sleep(1); \
    if ((++_sp & 255u) == 0u) { if (xb_ld(&(bar)[XB_TMO])) break; if (_sp > XB_SPIN_CAP) { atomicAdd(&(bar)[XB_TMO], 1u); break; } } } } while (0)

struct XcdBarrier { unsigned* bar; unsigned x; volatile LAS unsigned* st; };

__device__ __forceinline__ XcdBarrier xcd_barrier_post(unsigned* bar, volatile LAS unsigned* st) {
    XcdBarrier b; b.bar = bar; b.x = (unsigned)__builtin_amdgcn_readfirstlane((int)xb_xcc_id()); b.st = st;
    if (threadIdx.x == 0) (void)xb_add(&bar[XB_XCNT(b.x)], 1u);
    return b;
}
__device__ __forceinline__ void xcd_barrier_complete(unsigned* bar, unsigned x, unsigned& nloc, unsigned& nx) {
    const unsigned G = gridDim.x * gridDim.y * gridDim.z;
    unsigned sum, cnt, mine, sp = 0u;
    for (;;) {
        sum = 0u; cnt = 0u; mine = 0u;
#pragma unroll
        for (unsigned j = 0; j < 16; ++j) { const unsigned c = xb_ld(&bar[XB_XCNT(j)]); sum += c; cnt += (c > 0u) ? 1u : 0u; mine = (j == x) ? c : mine; }
        if (sum == G) break;
        __builtin_amdgcn_s_sleep(1);
        if ((++sp & 255u) == 0u) { if (xb_ld(&bar[XB_TMO])) break; if (sp > XB_SPIN_CAP) { atomicAdd(&bar[XB_TMO], 1u); break; } }
    }
    nloc = mine > 0u ? mine : 1u; nx = cnt > 0u ? cnt : 1u;
}
__device__ __forceinline__ void xcd_barrier(const XcdBarrier& b) {
    asm volatile("s_waitcnt vmcnt(0)" ::: "memory");
    __syncthreads();
    if (threadIdx.x == 0) {
        unsigned* bar = b.bar;
        unsigned bx = b.x;
        asm volatile("" : "+s"(bar), "+s"(bx));
        __builtin_amdgcn_s_waitcnt(0);
        unsigned nloc = b.st[0], nx = b.st[1];
        if (nloc == 0u) { xcd_barrier_complete(bar, bx, nloc, nx); b.st[0] = nloc; b.st[1] = nx; }
        const unsigned old = xb_add(&bar[XB_XSUB(bx)], 1u);
        const unsigned gen = old / nloc;
        if (old + 1u == (gen + 1u) * nloc) {
            __builtin_amdgcn_fence(__ATOMIC_RELEASE, "agent");
            asm volatile("s_waitcnt vmcnt(0)" ::: "memory");
            const unsigned og = xb_add(&bar[XB_TOP], 1u);
            const unsigned tg = og / nx;
            if (og + 1u == (tg + 1u) * nx) xb_add(&bar[XB_TOPGEN], 1u);
            else XB_SPIN(xb_ld(&bar[XB_TOPGEN]) == tg, bar);
            __builtin_amdgcn_fence(__ATOMIC_ACQUIRE, "agent");
            xb_add(&bar[XB_XGEN(bx)], 1u);
            asm volatile("s_waitcnt vmcnt(0)" ::: "memory");
        } else {
            XB_SPIN(xb_ld(&bar[XB_XGEN(bx)]) == gen, bar);
            __builtin_amdgcn_fence(__ATOMIC_ACQUIRE, "agent");
            asm volatile("s_waitcnt vmcnt(0)" ::: "memory");
        }
    }
    __syncthreads();
}

__device__ __forceinline__ int tid_opaque() { int t = threadIdx.x; asm volatile("" : "+v"(t)); return t; }
__device__ __forceinline__ float bf2f(bf16_t v) { return __uint_as_float(((unsigned)v) << 16); }
__device__ __forceinline__ bf16_t f2bf(float f) { return __builtin_bit_cast(unsigned short, (__bf16)f); }
typedef __bf16 hwbf16x2 __attribute__((ext_vector_type(2)));
__device__ __forceinline__ unsigned pack2(float a, float b) { return __builtin_bit_cast(unsigned, __builtin_convertvector((f32x2){a, b}, hwbf16x2)); }
__device__ __forceinline__ unsigned pack4_fp8(float a, float b, float c, float d) {
    a = __builtin_amdgcn_fmed3f(a, -448.f, 448.f); b = __builtin_amdgcn_fmed3f(b, -448.f, 448.f); c = __builtin_amdgcn_fmed3f(c, -448.f, 448.f); d = __builtin_amdgcn_fmed3f(d, -448.f, 448.f);
    int p = __builtin_amdgcn_cvt_pk_fp8_f32(a, b, 0, false); p = __builtin_amdgcn_cvt_pk_fp8_f32(c, d, p, true); return (unsigned)p; }
__device__ __forceinline__ float lo2f(unsigned w) { return __uint_as_float(w << 16); }
__device__ __forceinline__ float hi2f(unsigned w) { return __uint_as_float(w & 0xffff0000u); }
template <int CTRL> __device__ __forceinline__ float dpp_mov(float v) { return __builtin_bit_cast(float, __builtin_amdgcn_update_dpp(0, __builtin_bit_cast(int, v), CTRL, 0xf, 0xf, true)); }
__device__ __forceinline__ float row_sum16(float v) {
    v += dpp_mov<0xB1>(v);
    v += dpp_mov<0x4E>(v);
    v += dpp_mov<0x141>(v);
    v += dpp_mov<0x140>(v);
    return v;
}
__device__ __forceinline__ float row_max16(float v) {
    v = fmaxf(v, dpp_mov<0xB1>(v)); v = fmaxf(v, dpp_mov<0x4E>(v)); v = fmaxf(v, dpp_mov<0x141>(v)); v = fmaxf(v, dpp_mov<0x140>(v));
    return v;
}
__device__ __forceinline__ float wave_sum(float v) {
    v = row_sum16(v);
    const int iv = __builtin_bit_cast(int, v);
    const float a0 = __builtin_bit_cast(float, __builtin_amdgcn_readlane(iv, 0)), a1 = __builtin_bit_cast(float, __builtin_amdgcn_readlane(iv, 16));
    const float a2 = __builtin_bit_cast(float, __builtin_amdgcn_readlane(iv, 32)), a3 = __builtin_bit_cast(float, __builtin_amdgcn_readlane(iv, 48));
    return (a0 + a1) + (a2 + a3);
}
__device__ __forceinline__ float gelu_erf(float v) {
    const float t = __builtin_amdgcn_rcpf(fabsf(v) * 0.2316418882f + 1.0f);
    float q = t * 0.5307027145f + (-0.7265760135f); q = q * t + 0.7107068705f; q = q * t + (-0.142248368f); q = q * t + 0.127414796f; q = q * t;
    const float m = v * (q * __builtin_amdgcn_exp2f((v * v) * (-0.72134752044f)));
    return v < 0.f ? m : v - m;
}
__device__ __forceinline__ float silu_f(float x) { return x * __builtin_amdgcn_rcpf(1.0f + __expf(-x)); }

__device__ __forceinline__ void ln_stats(const f32x4 (&v)[4], float& mean, float& rstd) {
    float s = 0.f;
#pragma unroll
    for (int i = 0; i < 4; ++i) s += (v[i][0] + v[i][1]) + (v[i][2] + v[i][3]);
    s = wave_sum(s); mean = s * (1.0f / 1024.0f);
    float q = 0.f;
#pragma unroll
    for (int i = 0; i < 4; ++i)
#pragma unroll
        for (int e = 0; e < 4; ++e) { const float d = v[i][e] - mean; q += d * d; }
    q = wave_sum(q); rstd = 1.0f / sqrtf(q * (1.0f / 1024.0f) + 1e-6f);
}

template <int BN> struct MfmaLayout {
    static constexpr int FG = BN / 128, NI = 4, NJ = 2 * FG;
    static constexpr bool PAIR8 = false;
    int rbase, cbase;
    __device__ __forceinline__ int row(int i) const { return rbase + 16 * i; }
    __device__ __forceinline__ int col(int jj) const { return (jj / FG) * (BN / 2) + (jj % FG) * 16 + cbase; }
};

__device__ __forceinline__ void glds16(const bf16_t* g, LAS unsigned char* l) {
    __builtin_amdgcn_global_load_lds((const unsigned*)g, (LAS unsigned*)l, 16, 0, 0);
}

template <int BN, bool GATHER, class Epi>
__device__ __forceinline__ void gemm_tile(LAS unsigned char* lds, const bf16_t* A, int lda, const int* rowidx, int valid_rows,
                                          const bf16_t* B0, const bf16_t* B1, int ldb, int K, const Epi& epi) {
    constexpr int A_B = 16384, B_B = BN * 128, STAGE = A_B + B_B, NBL = BN / 64;
    const int tid = tid_opaque(), lane = tid & 63, wid = __builtin_amdgcn_readfirstlane(tid >> 6);
    const bf16_t* ap[2]; const bf16_t* bp[NBL];
#pragma unroll
    for (int i = 0; i < 2; ++i) {
        const int P = i * 512 + tid, row = P >> 3, c = (P & 7) ^ ((row >> 1) & 7);
        size_t ro;
        if (GATHER) ro = (size_t)(row < valid_rows ? rowidx[row] : 0) * (size_t)lda; else ro = (size_t)row * (size_t)lda;
        ap[i] = A + ro + c * 8;
    }
#pragma unroll
    for (int i = 0; i < NBL; ++i) {
        const int P = i * 512 + tid, row = P >> 3, c = (P & 7) ^ ((row >> 1) & 7);
        const bf16_t* base = (row < BN / 2) ? (B0 + (size_t)row * ldb) : (B1 + (size_t)(row - BN / 2) * ldb);
        bp[i] = base + c * 8;
    }
    const int nk = K / 64;
#define GT_STAGE(buf, k0) do { \
        _Pragma("unroll") for (int _i = 0; _i < 2; ++_i) glds16(ap[_i] + (k0), lds + (buf) * STAGE + _i * 8192 + wid * 1024); \
        _Pragma("unroll") for (int _i = 0; _i < NBL; ++_i) glds16(bp[_i] + (k0), lds + (buf) * STAGE + A_B + _i * 8192 + wid * 1024); } while (0)

    typedef MfmaLayout<BN> Lay;
    constexpr int FG = Lay::FG;
    const int fr = lane & 15, g = lane >> 4, wr = wid >> 2, wc = wid & 3;
    Lay lay; lay.rbase = wr * 64 + fr; lay.cbase = wc * 16 * FG + 4 * g;
    f32x4 acc[Lay::NI][Lay::NJ];
#pragma unroll
    for (int i = 0; i < Lay::NI; ++i)
#pragma unroll
        for (int j = 0; j < Lay::NJ; ++j) acc[i][j] = (f32x4){0.f, 0.f, 0.f, 0.f};
    int aoff[4], boff[Lay::NJ];
#pragma unroll
    for (int m = 0; m < 4; ++m) { const int row = wr * 64 + m * 16 + fr; aoff[m] = row * 128 + ((g ^ ((row >> 1) & 7)) << 4); }
#pragma unroll
    for (int jj = 0; jj < Lay::NJ; ++jj) { const int row = (jj / FG) * (BN / 2) + wc * 16 * FG + (jj % FG) * 16 + fr; boff[jj] = A_B + row * 128 + ((g ^ ((row >> 1) & 7)) << 4); }
    GT_STAGE(0, 0);
    asm volatile("s_waitcnt vmcnt(0)" ::: "memory"); __syncthreads();
    for (int kt = 0; kt < nk; ++kt) {
        if (kt + 1 < nk) GT_STAGE((kt + 1) & 1, (kt + 1) * 64);
        const LAS unsigned char* sa = lds + (kt & 1) * STAGE;
#pragma unroll
        for (int ks = 0; ks < 2; ++ks) {
            bf16x8 af[4], bfv[Lay::NJ];
#pragma unroll
            for (int m = 0; m < 4; ++m) af[m] = *(const LAS bf16x8*)(sa + (aoff[m] ^ (ks << 6)));
#pragma unroll
            for (int jj = 0; jj < Lay::NJ; ++jj) bfv[jj] = *(const LAS bf16x8*)(sa + (boff[jj] ^ (ks << 6)));
#pragma unroll
            for (int m = 0; m < 4; ++m)
#pragma unroll
                for (int jj = 0; jj < Lay::NJ; ++jj) acc[m][jj] = __builtin_amdgcn_mfma_f32_16x16x32_bf16(bfv[jj], af[m], acc[m][jj], 0, 0, 0);
        }
        asm volatile("s_waitcnt vmcnt(0)" ::: "memory"); __syncthreads();
    }
    epi.run(acc, lay);
#undef GT_STAGE
}

namespace g256 {
constexpr int BK = 64, HALF = 128, HTB = HALF * BK * 2, STAGE_BYTES = 8 * HTB;
__device__ __forceinline__ int lds_byte(int r, int c) { const int st = (r >> 4) * 2 + (c >> 5), rr = r & 15, cc = c & 31, ob = rr * 64 + cc * 2; return st * 1024 + (ob ^ (((ob >> 9) & 1) << 5)); }
__device__ __forceinline__ int perm32(int rho) { const int n = rho >> 4, i = rho & 15; return 8 * (i >> 2) + 4 * n + (i & 3); }
__device__ __forceinline__ void stage_rc(int b, int& R, int& C) { const int st = b / 1024, sb = b % 1024, swz = sb ^ (((sb >> 9) & 1) << 5); R = (st >> 1) * 16 + swz / 64; C = (st & 1) * 32 + (swz % 64) / 2; }
struct Lay {
    static constexpr int NI = 8, NJ = 4;
    static constexpr bool PAIR8 = true;
    int rbase, cbase;
    __device__ __forceinline__ int row(int i) const { return (i >> 2) * 128 + (i & 3) * 16 + rbase; }
    __device__ __forceinline__ int col(int j) const { return (j >> 1) * 128 + (j & 1) * 4 + cbase; }
};
template <class Epi> struct Unit { const bf16_t* A; const bf16_t* B0; const bf16_t* B1; const LAS int* ridx; int valid; Epi epi; };

template <class Sched>
__device__ __forceinline__ void gemm_phase(LAS unsigned char* lds, const int K, const Sched& S) {
    typedef typename Sched::Epi Epi;
    const int tid = tid_opaque(), wid = __builtin_amdgcn_readfirstlane(tid >> 6), lane = tid & 63, wr = wid >> 2, wc = wid & 3, fr = lane & 15, fq = lane >> 4;
    int nt = K / BK; asm volatile("" : "+s"(nt));
    int sR[2], sC[2];
#pragma unroll
    for (int i = 0; i < 2; ++i) stage_rc(tid * 16 + i * 8192, sR[i], sC[i]);
    unsigned voffB[2];
#pragma unroll
    for (int i = 0; i < 2; ++i) voffB[i] = (unsigned)(((sR[i] & ~31) + perm32(sR[i] & 31)) * K + sC[i]) * 2u;
    const size_t kstep = (size_t)(BK * 2);
    const unsigned ldsw = (unsigned)wid * 1024u;
    const int aoff = lds_byte(wr * 64 + fr, fq * 8), boff = lds_byte(wc * 32 + fr, fq * 8);
#define G2_SA(b, h) (((b) * 2 + (h)) * HTB)
#define G2_SB(b, h) ((4 + (b) * 2 + (h)) * HTB)
#define G2_STAGE(bufoff, gbase, v0, v1) do { \
        __builtin_amdgcn_global_load_lds((const unsigned*)((const char*)(gbase) + (v0)), (LAS unsigned*)(lds + (bufoff) + ldsw), 16, 0, 0); \
        __builtin_amdgcn_global_load_lds((const unsigned*)((const char*)(gbase) + (v1)), (LAS unsigned*)(lds + (bufoff) + ldsw + 8192), 16, 0, 0); } while (0)
#define G2_LDA(dst, b, h) do { _Pragma("unroll") for (int m = 0; m < 4; ++m) _Pragma("unroll") for (int k = 0; k < 2; ++k) dst[m][k] = *(const LAS bf16x8*)(lds + G2_SA(b, h) + aoff + m * 2048 + k * 1024); } while (0)
#define G2_LDB(dst, b, h) do { _Pragma("unroll") for (int n = 0; n < 2; ++n) _Pragma("unroll") for (int k = 0; k < 2; ++k) dst[n][k] = *(const LAS bf16x8*)(lds + G2_SB(b, h) + boff + n * 2048 + k * 1024); } while (0)
#define G2_MMA(ai, bj, At, Bt) do { __builtin_amdgcn_s_setprio(1); _Pragma("unroll") for (int m = 0; m < 4; ++m) _Pragma("unroll") for (int n = 0; n < 2; ++n) _Pragma("unroll") for (int k = 0; k < 2; ++k) { \
        if (Sched::FP8) { const i32x4 _b = __builtin_bit_cast(i32x4, Bt[n][k]), _a = __builtin_bit_cast(i32x4, At[m][k]);     \
            acc[(ai) * 4 + m][(bj) * 2 + n] = __builtin_amdgcn_mfma_f32_16x16x32_fp8_fp8(((long)(unsigned)_b[1] << 32) | (unsigned)_b[0], ((long)(unsigned)_a[1] << 32) | (unsigned)_a[0], acc[(ai) * 4 + m][(bj) * 2 + n], 0, 0, 0); \
            acc[(ai) * 4 + m][(bj) * 2 + n] = __builtin_amdgcn_mfma_f32_16x16x32_fp8_fp8(((long)(unsigned)_b[3] << 32) | (unsigned)_b[2], ((long)(unsigned)_a[3] << 32) | (unsigned)_a[2], acc[(ai) * 4 + m][(bj) * 2 + n], 0, 0, 0); } \
        else acc[(ai) * 4 + m][(bj) * 2 + n] = __builtin_amdgcn_mfma_f32_16x16x32_bf16(Bt[n][k], At[m][k], acc[(ai) * 4 + m][(bj) * 2 + n], 0, 0, 0); } __builtin_amdgcn_s_setprio(0); } while (0)
#define G2_WAIT_V(n) asm volatile("s_waitcnt vmcnt(" #n ")" ::: "memory")
#define G2_WAIT_L(n) asm volatile("s_waitcnt lgkmcnt(" #n ")" ::: "memory")
#define G2_BAR __builtin_amdgcn_s_barrier()
#define G2_SCHED __builtin_amdgcn_sched_barrier(0)
#define G2_VOFFA(U, dst) do { _Pragma("unroll") for (int _h = 0; _h < 2; ++_h) _Pragma("unroll") for (int _i = 0; _i < 2; ++_i) { const int _row = _h * 128 + sR[_i]; \
        int _tok = _row; if (Sched::GATHER) _tok = (_row < (U).valid) ? (U).ridx[_row] : 0; dst[_h][_i] = (unsigned)(_tok * K + sC[_i]) * 2u; } } while (0)
    Unit<Epi> cur, nxt; int ui = 0;
    if (!S.get(0, cur)) return;
    f32x4 acc[8][4];
#pragma unroll
    for (int i = 0; i < 8; ++i)
#pragma unroll
        for (int j = 0; j < 4; ++j) acc[i][j] = (f32x4){0.f, 0.f, 0.f, 0.f};
    bf16x8 At[4][2], B0[2][2], B1[2][2];
    unsigned cvA[2][2], nvA[2][2];
    G2_VOFFA(cur, cvA);
    const char* cA = (const char*)cur.A; const char* cB0 = (const char*)cur.B0; const char* cB1 = (const char*)cur.B1;
    G2_STAGE(G2_SB(0, 0), cB0, voffB[0], voffB[1]); G2_STAGE(G2_SB(0, 1), cB1, voffB[0], voffB[1]); G2_STAGE(G2_SA(0, 0), cA, cvA[0][0], cvA[0][1]); G2_STAGE(G2_SA(0, 1), cA, cvA[1][0], cvA[1][1]);
    if (wr == 1) G2_BAR;
    G2_WAIT_V(2); G2_BAR;
    G2_STAGE(G2_SB(1, 0), cB0 + kstep, voffB[0], voffB[1]); G2_STAGE(G2_SA(1, 0), cA + kstep, cvA[0][0], cvA[0][1]); G2_STAGE(G2_SB(1, 1), cB1 + kstep, voffB[0], voffB[1]);
    G2_WAIT_V(6); G2_BAR;
    for (;;) {
        const bool has_next = S.get(ui + 1, nxt);
        if (Sched::GATHER) {
            if (has_next) { G2_VOFFA(nxt, nvA); }
            else {
#pragma unroll
                for (int h = 0; h < 2; ++h) { nvA[h][0] = cvA[h][0]; nvA[h][1] = cvA[h][1]; } }
        }
        const char* nA = has_next ? (const char*)nxt.A : cA; const char* nB0 = has_next ? (const char*)nxt.B0 : cB0; const char* nB1 = has_next ? (const char*)nxt.B1 : cB1;
#pragma unroll 1
        for (int t = 0; t < nt; t += 2) {
            const bool last = (t == nt - 2);
            const char* a1 = cA + (size_t)(t + 1) * kstep;
            const char* a2 = last ? nA : cA + (size_t)(t + 2) * kstep;
            const char* b20 = last ? nB0 : cB0 + (size_t)(t + 2) * kstep; const char* b21 = last ? nB1 : cB1 + (size_t)(t + 2) * kstep;
#define x00 ((Sched::GATHER && last) ? nvA[0][0] : cvA[0][0])
#define x01 ((Sched::GATHER && last) ? nvA[0][1] : cvA[0][1])
#define x10 ((Sched::GATHER && last) ? nvA[1][0] : cvA[1][0])
#define x11 ((Sched::GATHER && last) ? nvA[1][1] : cvA[1][1])
            G2_LDB(B0, 0, 0); G2_LDB(B1, 0, 1); G2_SCHED; G2_LDA(At, 0, 0); G2_STAGE(G2_SA(1, 1), a1, cvA[1][0], cvA[1][1]);
            G2_WAIT_V(8); G2_WAIT_L(0); G2_BAR; G2_MMA(0, 0, At, B0); G2_MMA(0, 1, At, B1); G2_BAR; G2_SCHED;
            G2_LDA(At, 0, 1); G2_STAGE(G2_SB(0, 0), b20, voffB[0], voffB[1]); G2_STAGE(G2_SB(0, 1), b21, voffB[0], voffB[1]); G2_STAGE(G2_SA(0, 0), a2, x00, x01);
            G2_WAIT_V(8); G2_WAIT_L(0); G2_BAR; G2_MMA(1, 0, At, B0); G2_MMA(1, 1, At, B1); G2_BAR; G2_SCHED;
            G2_LDB(B0, 1, 0); G2_LDB(B1, 1, 1); G2_SCHED; G2_LDA(At, 1, 0); G2_STAGE(G2_SA(0, 1), a2, x10, x11);
            G2_WAIT_V(8); G2_WAIT_L(0); G2_BAR; G2_MMA(0, 0, At, B0); G2_MMA(0, 1, At, B1); G2_BAR; G2_SCHED;
            G2_LDA(At, 1, 1); G2_STAGE(G2_SB(1, 0), b20 + kstep, voffB[0], voffB[1]); G2_STAGE(G2_SB(1, 1), b21 + kstep, voffB[0], voffB[1]); G2_STAGE(G2_SA(1, 0), a2 + kstep, x00, x01);
            G2_WAIT_V(8); G2_WAIT_L(0); G2_BAR; G2_MMA(1, 0, At, B0); G2_MMA(1, 1, At, B1); G2_BAR; G2_SCHED;
        }
        if (wr == 0) G2_BAR;
        { Lay lay; int rbv = wr * 64 + fr, cbv = wc * 32 + 8 * fq; asm volatile("" : "+v"(rbv), "+v"(cbv));
          lay.rbase = rbv; lay.cbase = cbv; cur.epi.run(acc, lay); }
        if (!has_next) break;
#pragma unroll
        for (int i = 0; i < 8; ++i)
#pragma unroll
            for (int j = 0; j < 4; ++j) acc[i][j] = (f32x4){0.f, 0.f, 0.f, 0.f};
        cur = nxt; cA = nA; cB0 = nB0; cB1 = nB1; ++ui;
        if (wr == 1) G2_BAR;
        if (Sched::GATHER) {
#pragma unroll
            for (int h = 0; h < 2; ++h) { cvA[h][0] = nvA[h][0]; cvA[h][1] = nvA[h][1]; } }
    }
#undef x00
#undef x01
#undef x10
#undef x11
    G2_WAIT_V(0);
    G2_BAR;
#undef G2_SA
#undef G2_SB
#undef G2_STAGE
#undef G2_LDA
#undef G2_LDB
#undef G2_MMA
#undef G2_WAIT_V
#undef G2_WAIT_L
#undef G2_BAR
#undef G2_SCHED
#undef G2_VOFFA
}
}

struct EpiF32 {
    float* C; int ld;
    template <class L> __device__ __forceinline__ void run(const f32x4 (&acc)[L::NI][L::NJ], const L& lay) const {
#pragma unroll
        for (int i = 0; i < L::NI; ++i)
#pragma unroll
            for (int j = 0; j < L::NJ; ++j) *(f32x4*)(C + (size_t)lay.row(i) * ld + lay.col(j)) = acc[i][j];
    }
};
struct EpiBf16 {
    bf16_t* C; int ld; float scale;
    template <class L> __device__ __forceinline__ void run(const f32x4 (&acc)[L::NI][L::NJ], const L& lay) const {
#pragma unroll
        for (int i = 0; i < L::NI; ++i) {
            if (L::PAIR8) {
#pragma unroll
                for (int j = 0; j < L::NJ; j += 2) { const f32x4 p = acc[i][j] * scale, q = acc[i][j + 1] * scale; u32x4 w; w.x = pack2(p[0], p[1]); w.y = pack2(p[2], p[3]); w.z = pack2(q[0], q[1]); w.w = pack2(q[2], q[3]);
                    *(u32x4*)(C + (size_t)lay.row(i) * ld + lay.col(j)) = w; }
            } else {
#pragma unroll
                for (int j = 0; j < L::NJ; ++j) { const f32x4 p = acc[i][j] * scale; u32x2 w; w.x = pack2(p[0], p[1]); w.y = pack2(p[2], p[3]);
                    *(u32x2*)(C + (size_t)lay.row(i) * ld + lay.col(j)) = w; }
            }
        }
    }
};
struct EpiGateUp8 {
    unsigned char* C; int ld;
    template <class L> __device__ __forceinline__ void run(const f32x4 (&acc)[L::NI][L::NJ], const L& lay) const {
        static_assert(L::PAIR8 && L::NJ == 4, "written for the paired-column 256x256 layout");
#pragma unroll
        for (int i = 0; i < L::NI; ++i) {
            const f32x4 g0 = acc[i][0] * (1.0f / 32.0f), g1 = acc[i][1] * (1.0f / 32.0f), u0 = acc[i][2] * (1.0f / 32.0f), u1 = acc[i][3] * (1.0f / 32.0f);
            u32x2 w; w.x = pack4_fp8(silu_f(g0[0]) * u0[0], silu_f(g0[1]) * u0[1], silu_f(g0[2]) * u0[2], silu_f(g0[3]) * u0[3]);
            w.y = pack4_fp8(silu_f(g1[0]) * u1[0], silu_f(g1[1]) * u1[1], silu_f(g1[2]) * u1[2], silu_f(g1[3]) * u1[3]);
            *(u32x2*)(C + (size_t)lay.row(i) * ld + lay.col(0)) = w;
        }
    }
};
struct EpiGateUp {
    bf16_t* C; int ld;
    template <class L> __device__ __forceinline__ void run(const f32x4 (&acc)[L::NI][L::NJ], const L& lay) const {
#pragma unroll
        for (int i = 0; i < L::NI; ++i) {
            if (L::PAIR8 && L::NJ == 4) {
                const f32x4 g0 = acc[i][0], g1 = acc[i][1], u0 = acc[i][2], u1 = acc[i][3];
                u32x4 w; w.x = pack2(silu_f(g0[0]) * u0[0], silu_f(g0[1]) * u0[1]); w.y = pack2(silu_f(g0[2]) * u0[2], silu_f(g0[3]) * u0[3]);
                w.z = pack2(silu_f(g1[0]) * u1[0], silu_f(g1[1]) * u1[1]); w.w = pack2(silu_f(g1[2]) * u1[2], silu_f(g1[3]) * u1[3]);
                *(u32x4*)(C + (size_t)lay.row(i) * ld + lay.col(0)) = w;
            } else {
#pragma unroll
                for (int j = 0; j < L::NJ / 2; ++j) { const f32x4 gt = acc[i][j], up = acc[i][j + L::NJ / 2];
                    u32x2 w; w.x = pack2(silu_f(gt[0]) * up[0], silu_f(gt[1]) * up[1]); w.y = pack2(silu_f(gt[2]) * up[2], silu_f(gt[3]) * up[3]);
                    *(u32x2*)(C + (size_t)lay.row(i) * ld + lay.col(j)) = w; }
            }
        }
    }
};
struct EpiInProj {
    bf16_t* Zt;
    bf16_t* tF;
    bf16_t* tV;
    int n0, pos0, n;
    template <class L> __device__ __forceinline__ void run(const f32x4 (&acc)[L::NI][L::NJ], const L& lay) const {
        static_assert(L::PAIR8, "written for the paired-column layout");
#pragma unroll
        for (int i = 0; i < L::NI; ++i)
#pragma unroll
            for (int j = 0; j < L::NJ; j += 2) {
                const int r = lay.row(i), cl = lay.col(j), c = n0 + cl;
                const f32x4 v0 = acc[i][j], v1 = acc[i][j + 1];
                if (c < 512) {
                    const int part = c >> 8, ch = c & 255;
#pragma unroll
                    for (int e = 0; e < 4; ++e) { tF[((size_t)(ch + e) * 2 + part) * n + pos0 + r] = f2bf(v0[e]); tF[((size_t)(ch + 4 + e) * 2 + part) * n + pos0 + r] = f2bf(v1[e]); }
                } else {
                    u32x4 w; w.x = pack2(v0[0], v0[1]); w.y = pack2(v0[2], v0[3]); w.z = pack2(v1[0], v1[1]); w.w = pack2(v1[2], v1[3]);
                    *(u32x4*)(Zt + (size_t)r * ZC + cl) = w;
                    if (c >= 896 && c < 1024) {
#pragma unroll
                        for (int e = 0; e < 4; ++e) { tV[(size_t)(c - 896 + e) * n + pos0 + r] = f2bf(v0[e]); tV[(size_t)(c - 896 + 4 + e) * n + pos0 + r] = f2bf(v1[e]); }
                    }
                }
            }
    }
};

constexpr int U_ADA = 192, U_WIN = 2 * 16 * 28, U_WOUT = 2 * 16 * 16, U_SGU = 32, U_DFT = 256, U_ROPE = 1, U_EXP = 3 * 32 * 32;
constexpr int LDS_SIL = 0, LDS_RED = 20480, LDS_TILE = 32768, LDS_T64 = 49408, LDS_CTAB = 50176;

__device__ __forceinline__ void ada_unit(AP a, unsigned char* lds, int u) {
    float* sil = (float*)(lds + LDS_SIL); float* red = (float*)(lds + LDS_RED);
    const int tid = tid_opaque(), lane = tid & 63, w = tid >> 6;
    const int l = u / 96, cg = u % 96;
    for (int i = tid; i < 5120; i += NT) { const int r = i >> 10, k = i & 1023; const float v = (r < 4) ? a->in[1][r * 1024 + k] : a->in[3][k]; sil[i] = v / (1.0f + expf(-v)); }
    __syncthreads();
    const float* W = a->in[4] + (size_t)l * 1024 * 6144 + cg * 64 + lane;
    float acc[5] = {0.f, 0.f, 0.f, 0.f, 0.f};
#pragma unroll 32
    for (int k = w * 128; k < w * 128 + 128; ++k) { const float wv = W[(size_t)k * 6144];
#pragma unroll
        for (int r = 0; r < 5; ++r) acc[r] += sil[r * 1024 + k] * wv; }
#pragma unroll
    for (int r = 0; r < 5; ++r) red[(w * 5 + r) * 64 + lane] = acc[r];
    __syncthreads();
    if (tid < 320) { const int r = tid >> 6; float s = 0.f;
#pragma unroll
        for (int ww = 0; ww < 8; ++ww) s += red[(ww * 5 + r) * 64 + lane];
        const int j = cg * 64 + lane; ((float*)(a->ws + WS_MOD))[(size_t)(l * 5 + r) * 6144 + j] = s + a->in[5][l * 6144 + j]; }
    __syncthreads();
}

__device__ __forceinline__ void tile_store_T(const float* tile, bf16_t* dst, int ldd) {
    const int tid = tid_opaque(), n = tid >> 3, kc = tid & 7;
    u32x4 w;
    w.x = pack2(tile[(kc * 8 + 0) * 65 + n], tile[(kc * 8 + 1) * 65 + n]); w.y = pack2(tile[(kc * 8 + 2) * 65 + n], tile[(kc * 8 + 3) * 65 + n]);
    w.z = pack2(tile[(kc * 8 + 4) * 65 + n], tile[(kc * 8 + 5) * 65 + n]); w.w = pack2(tile[(kc * 8 + 6) * 65 + n], tile[(kc * 8 + 7) * 65 + n]);
    *(u32x4*)(dst + (size_t)n * ldd + kc * 8) = w;
}
__device__ __forceinline__ void tile_load(float* tile, const float* src, int lds_) {
    const int tid = tid_opaque();
#pragma unroll
    for (int i = 0; i < 2; ++i) { const int row = (tid >> 4) + 32 * i, c4 = (tid & 15) * 4; const f32x4 v = *(const f32x4*)(src + (size_t)row * lds_ + c4);
        tile[row * 65 + c4 + 0] = v[0]; tile[row * 65 + c4 + 1] = v[1]; tile[row * 65 + c4 + 2] = v[2]; tile[row * 65 + c4 + 3] = v[3]; }
}

__device__ __forceinline__ void mm64_f32(const float* tA, int lda, const float* tB, int ldb, int K, float* out) {
    const int tid = tid_opaque(), lane = tid & 63, w = tid >> 6, fr = lane & 15, g = lane >> 4, mi = w >> 1, nj = 2 * (w & 1);
    f32x4 acc0 = (f32x4){0.f, 0.f, 0.f, 0.f}, acc1 = (f32x4){0.f, 0.f, 0.f, 0.f};
    const float* pa = tA + (16 * mi + fr) * lda + g; const float* pb = tB + g * ldb + 16 * nj + fr;
#pragma unroll 4
    for (int k0 = 0; k0 < K; k0 += 4) { const float av = pa[k0], b0 = pb[k0 * ldb], b1 = pb[k0 * ldb + 16];
        acc0 = __builtin_amdgcn_mfma_f32_16x16x4f32(av, b0, acc0, 0, 0, 0); acc1 = __builtin_amdgcn_mfma_f32_16x16x4f32(av, b1, acc1, 0, 0, 0); }
#pragma unroll
    for (int r = 0; r < 4; ++r) { out[(16 * mi + 4 * g + r) * 65 + 16 * nj + fr] = acc0[r]; out[(16 * mi + 4 * g + r) * 65 + 16 * nj + 16 + fr] = acc1[r]; }
}

__device__ __forceinline__ void win_unit(AP a, unsigned char* lds, int u) {
    float* tile = (float*)(lds + LDS_TILE); float* T = (float*)(lds + LDS_T64);
    const int tid = tid_opaque();
    const int l = u / 448, r = u % 448, kb = r / 28, nb = r % 28;
    const float* Win = a->in[6] + (size_t)l * 1024 * 1536;
    const int srccol = (nb >= 8) ? nb * 64 - 256 : (nb & 3) * 64;
    tile_load(tile, Win + (size_t)(kb * 64) * 1536 + srccol, 1536);
    if (nb < 8 && tid < 64) { T[tid] = cospif((float)tid / 32.0f); T[64 + tid] = sinpif((float)tid / 32.0f); }
    __syncthreads();
    bf16_t* dst = (bf16_t*)(a->ws + WS_WIN) + ((size_t)l * ZC + nb * 64) * 1024 + kb * 64;
    if (nb >= 8) tile_store_T(tile, dst, 1024);
    else {
        const int part = nb >> 2;
        float* Tm = (float*)(lds + 65536); float* out = (float*)(lds + 98304);
        for (int i = tid; i < 4096; i += NT) { const int c = i >> 6, cp = i & 63; const float t = T[part * 64 + ((c * cp) & 63)]; Tm[i] = (part ? -t : t) * 0.125f; }
        __syncthreads();
        mm64_f32(tile, 65, Tm, 64, 64, out);
        __syncthreads();
        tile_store_T(out, dst, 1024);
    }
    __syncthreads();
}

__device__ __forceinline__ void wout_unit(AP a, unsigned char* lds, int u) {
    float* tile = (float*)(lds + LDS_TILE);
    __syncthreads();
    const int tid = tid_opaque();
    const int l = u / 256, r = u % 256, kb = r / 16, nb = r % 16;
    const float* Wo = a->in[13] + (size_t)l * 1024 * 1024;
    const int n = tid & 63, kq = __builtin_amdgcn_readfirstlane(tid >> 6);
    if (kb < 4) {
        float* tA = (float*)lds; float* tB = (float*)(lds + 65536);
        const float* wf = a->in[7] + (size_t)l * 256 * 256 + (size_t)(kb * 64) * 256;
        __syncthreads();
        f32x4 va[8], vb[8];
#pragma unroll
        for (int i = 0; i < 8; ++i) { const int q = tid + 512 * i; va[i] = *(const f32x4*)(wf + (size_t)q * 4); vb[i] = *(const f32x4*)(Wo + (size_t)(q >> 4) * 1024 + nb * 64 + (q & 15) * 4); }
#pragma unroll
        for (int i = 0; i < 8; ++i) { const int q = tid + 512 * i; *(f32x4*)(tA + (size_t)q * 4) = va[i]; *(f32x4*)(tB + (size_t)q * 4) = vb[i]; }
        __syncthreads();
        tile = (float*)(lds + 133120);
        mm64_f32(tA, 256, tB, 64, 256, tile);
    } else if (kb >= 8 && kb < 12) {
        const int g = kb - 8;
        float* tA = (float*)lds; float* tB = (float*)(lds + 65536);
        const float* wp = a->in[9] + (size_t)(l * 4 + g) * 64 * 64;
        const float* ps = a->in[10] + l * 256 + g * 64;
        f32x4 va[2], vb[2];
#pragma unroll
        for (int i = 0; i < 2; ++i) { const int q = tid + 512 * i; va[i] = *(const f32x4*)(wp + (size_t)q * 4); vb[i] = *(const f32x4*)(Wo + (size_t)(512 + g * 64 + (q >> 4)) * 1024 + nb * 64 + (q & 15) * 4) * ps[q >> 4]; }
#pragma unroll
        for (int i = 0; i < 2; ++i) { const int q = tid + 512 * i; *(f32x4*)(tA + (size_t)q * 4) = va[i]; *(f32x4*)(tB + (size_t)q * 4) = vb[i]; }
        __syncthreads();
        tile = (float*)(lds + 133120);
        mm64_f32(tA, 64, tB, 64, 64, tile);
    } else tile_load(tile, Wo + (size_t)(kb * 64) * 1024 + nb * 64, 1024);
    __syncthreads();
    tile_store_T(tile, (bf16_t*)(a->ws + WS_WOUT) + ((size_t)l * 1024 + nb * 64) * 1024 + kb * 64, 1024);
    __syncthreads();
}

__device__ __forceinline__ void exp_src_dst(AP a, int l, int u, const float*& src, int& srcld, unsigned char*& dst, int& dstld) {
    const int mat = u / 1024, e = (u % 1024) / 32, t = u % 32;
    const int kb = (mat < 2) ? t / 4 : t / 8, nb = (mat < 2) ? t % 4 : t % 8;
    srcld = (mat < 2) ? 512 : 1024; dstld = (mat < 2) ? 1024 : 512;
    src = a->in[18 + mat] + ((size_t)(l * 32 + e) * 512 * 1024) + (size_t)(kb * 128) * srcld + nb * 128;
    dst = a->ws + WS_WEXP + (size_t)l * WEXP_LAYER + (size_t)mat * EXPMAT + (size_t)e * 512 * 1024 + (size_t)(nb * 128) * dstld + kb * 128;
}
#define EXP_LOAD(vv, uu) do { exp_src_dst(a, l, (uu), src, srcld, dst, dstld); _Pragma("unroll") for (int _i = 0; _i < 8; ++_i) vv[_i] = *(const f32x4*)(src + (size_t)((tid >> 5) + 16 * _i) * srcld + (tid & 31) * 4); } while (0)
#define EXP_PUT(vv) do { _Pragma("unroll") for (int _i = 0; _i < 8; ++_i) { float* tp = tile + ((tid >> 5) + 16 * _i) * 129 + (tid & 31) * 4; tp[0] = vv[_i][0] * 32.0f; tp[1] = vv[_i][1] * 32.0f; tp[2] = vv[_i][2] * 32.0f; tp[3] = vv[_i][3] * 32.0f; } } while (0)
#define EXP_STORE(dd, ld_) do { const int n = tid >> 2, kq = tid & 3; _Pragma("unroll") for (int j = 0; j < 2; ++j) { const float* tp = tile + (kq * 32 + j * 16) * 129 + n; u32x4 w; \
        w.x = pack4_fp8(tp[0], tp[129], tp[2 * 129], tp[3 * 129]); w.y = pack4_fp8(tp[4 * 129], tp[5 * 129], tp[6 * 129], tp[7 * 129]); \
        w.z = pack4_fp8(tp[8 * 129], tp[9 * 129], tp[10 * 129], tp[11 * 129]); w.w = pack4_fp8(tp[12 * 129], tp[13 * 129], tp[14 * 129], tp[15 * 129]); \
        *(u32x4*)((dd) + (size_t)n * (ld_) + kq * 32 + j * 16) = w; } } while (0)
__device__ __forceinline__ void exp_range(AP a, unsigned char* lds, int l, int u0, int u_end) {
    float* tile = (float*)lds;
    const int tid = tid_opaque();
    __syncthreads();
    if (u0 >= u_end) return;
    const float* src; unsigned char* dst; int srcld, dstld;
    f32x4 va[8], vb[8];
    unsigned char *da, *db = nullptr; int lda_, ldb_ = 0;
    EXP_LOAD(va, u0); da = dst; lda_ = dstld;
    if (u0 + 1 < u_end) { EXP_LOAD(vb, u0 + 1); db = dst; ldb_ = dstld; }
    for (int u = u0; u < u_end; u += 2) {
        EXP_PUT(va);
        __syncthreads();
        { unsigned char* cd = da; const int cl = lda_; if (u + 2 < u_end) { EXP_LOAD(va, u + 2); da = dst; lda_ = dstld; } EXP_STORE(cd, cl); }
        __syncthreads();
        if (u + 1 < u_end) {
            EXP_PUT(vb);
            __syncthreads();
            { unsigned char* cd = db; const int cl = ldb_; if (u + 3 < u_end) { EXP_LOAD(vb, u + 3); db = dst; ldb_ = dstld; } EXP_STORE(cd, cl); }
            __syncthreads();
        }
    }
}
#undef EXP_LOAD
#undef EXP_PUT
#undef EXP_STORE
__device__ __forceinline__ void exp_queue(AP a, unsigned char* lds, int l) {
    const int tid = tid_opaque();
    int* qslot = (int*)(lds + MISC_OFF + 128);
    unsigned* qc = (unsigned*)(a->ws + WS_BAR + 14336 + l * 256);
    for (;;) {
        __syncthreads();
        if (tid == 0) *qslot = (int)__hip_atomic_fetch_add(qc, 2u, __ATOMIC_RELAXED, __HIP_MEMORY_SCOPE_AGENT);
        __syncthreads();
        const int c0 = *qslot;
        if (c0 >= U_EXP) break;
        exp_range(a, lds, l, c0, c0 + 2);
    }
}

__device__ __forceinline__ void exp_fill(AP a, unsigned char* lds, int ql, int budget) {
    const int tid = tid_opaque();
    int* qslot = (int*)(lds + MISC_OFF + 128);
    unsigned* qc = (unsigned*)(a->ws + WS_BAR + 14336 + ql * 256);
    for (int done = 0; done < budget; done += 2) {
        __syncthreads();
        if (tid == 0) *qslot = (int)__hip_atomic_fetch_add(qc, 2u, __ATOMIC_RELAXED, __HIP_MEMORY_SCOPE_AGENT);
        __syncthreads();
        const int c0 = *qslot;
        if (c0 >= U_EXP) break;
        exp_range(a, lds, ql, c0, c0 + 2);
    }
    __syncthreads();
}

__device__ __forceinline__ void p0_prologue(AP a, unsigned char* lds) {
    const int tid = tid_opaque();
    bool have_tab = false;
    constexpr int E0 = U_ADA, E1 = E0 + U_WIN, E2 = E1 + U_WOUT, E3 = E2 + U_SGU, E4 = E3 + U_DFT, E5 = E4 + U_ROPE;
    int u = blockIdx.x;
    for (; u < E5; u += gridDim.x) {
        if (u < E0) ada_unit(a, lds, u);
        else if (u < E1) win_unit(a, lds, u - E0);
        else if (u < E2) wout_unit(a, lds, u - E1);
        else if (u < E3) { const size_t i0 = (size_t)(u - E2) * 4096 + tid * 8; const float* s = a->in[11] + i0; bf16_t* d = (bf16_t*)(a->ws + WS_WSGU) + i0;
            const f32x4 v0 = *(const f32x4*)s, v1 = *(const f32x4*)(s + 4); u32x4 w; w.x = pack2(v0[0], v0[1]); w.y = pack2(v0[2], v0[3]); w.z = pack2(v1[0], v1[1]); w.w = pack2(v1[2], v1[3]); *(u32x4*)d = w; }
        else if (u < E4) {
            float* ctab = (float*)(lds + LDS_CTAB);
            if (!have_tab) { for (int i = tid; i < 4096; i += NT) ctab[i] = cospif((float)i / 2048.0f); __syncthreads(); have_tab = true; }
            const int k = u - E3 + 4096;
            if (tid < 32) {
                const int kk = k - 4096, n0 = tid * 8; float c[8], s[8];
#pragma unroll
                for (int e = 0; e < 8; ++e) { const int idx = ((kk * (n0 + e)) & 255) * 16; c[e] = ctab[idx] * (1.0f / 16.0f); s[e] = ctab[(idx - 1024) & 4095] * (1.0f / 16.0f); }
                bf16_t* d = (bf16_t*)(a->ws + WS_DFTC) + (size_t)kk * 512 + n0;
                u32x4 w; w.x = pack2(c[0], c[1]); w.y = pack2(c[2], c[3]); w.z = pack2(c[4], c[5]); w.w = pack2(c[6], c[7]); *(u32x4*)d = w;
                w.x = pack2(s[0], s[1]); w.y = pack2(s[2], s[3]); w.z = pack2(s[4], s[5]); w.w = pack2(s[6], s[7]); *(u32x4*)(d + 256) = w;
            }
        }
        else {
            for (int i = tid; i < 1024; i += NT) { const int pos = i >> 4, f = i & 15; const float freq = powf(10000.0f, -(float)f / 16.0f); const float ang = (float)pos * freq;
                ((float2*)(a->ws + WS_ROPE))[i] = make_float2(cosf(ang), sinf(ang)); }
        }
    }
}

__device__ __forceinline__ void p_lnmod0(AP a) {
    const int tid = tid_opaque(), lane = tid & 63, w = tid >> 6;
    const float* mod = (const float*)(a->ws + WS_MOD);
    bf16_t* H = (bf16_t*)(a->ws + WS_H);
    const int tstep = gridDim.x * 8;
    f32x4 nx[4];
    { const int t = blockIdx.x * 8 + w; if (t < NTOK) { const float* src = (t < NLAT) ? a->in[0] + (size_t)t * D : a->in[2] + (size_t)(t - NLAT) * D;
#pragma unroll
        for (int i = 0; i < 4; ++i) nx[i] = *(const f32x4*)(src + 256 * i + 4 * lane); } }
    int mrow = -1; f32x4 msh[4], msc[4];
    for (int t = blockIdx.x * 8 + w; t < NTOK; t += tstep) {
        const int mr = (t < NLAT) ? (t >> 12) : 4;
        if (mr != mrow) { mrow = mr; const float* m = mod + (size_t)mr * 6144;
#pragma unroll
            for (int i = 0; i < 4; ++i) { msh[i] = *(const f32x4*)(m + 256 * i + 4 * lane); msc[i] = *(const f32x4*)(m + 1024 + 256 * i + 4 * lane); } }
        f32x4 v[4];
#pragma unroll
        for (int i = 0; i < 4; ++i) v[i] = nx[i];
        { const int tn = t + tstep; if (tn < NTOK) { const float* src = (tn < NLAT) ? a->in[0] + (size_t)tn * D : a->in[2] + (size_t)(tn - NLAT) * D;
#pragma unroll
            for (int i = 0; i < 4; ++i) nx[i] = *(const f32x4*)(src + 256 * i + 4 * lane); } }
        float mean, rstd; ln_stats(v, mean, rstd);
#pragma unroll
        for (int i = 0; i < 4; ++i) { const int c = 256 * i + 4 * lane;
            f32x4 o;
#pragma unroll
            for (int e = 0; e < 4; ++e) o[e] = (v[i][e] - mean) * rstd * (1.0f + msc[i][e]) + msh[i][e];
            u32x2 pk; pk.x = pack2(o[0], o[1]); pk.y = pack2(o[2], o[3]); *(u32x2*)(H + (size_t)t * D + c) = pk; }
    }
}

__device__ __forceinline__ void p1_inproj(AP a, unsigned char* smem, LAS unsigned char* lds, int l);
__device__ __forceinline__ u32x4 ld16g(const bf16_t* p) { return *(const u32x4*)p; }
__device__ __forceinline__ void rope_pack8(u32x4& wl, u32x4& wh, const LAS f32x2* tab, bool do_rope, float scale) {
    float tl[8] = {lo2f(wl.x), hi2f(wl.x), lo2f(wl.y), hi2f(wl.y), lo2f(wl.z), hi2f(wl.z), lo2f(wl.w), hi2f(wl.w)};
    float th[8] = {lo2f(wh.x), hi2f(wh.x), lo2f(wh.y), hi2f(wh.y), lo2f(wh.z), hi2f(wh.z), lo2f(wh.w), hi2f(wh.w)};
#pragma unroll
    for (int j = 0; j < 8; ++j) {
        float r1 = tl[j], r2 = th[j];
        if (do_rope) { const f32x2 cs = tab[j]; r1 = tl[j] * cs.x - th[j] * cs.y; r2 = tl[j] * cs.y + th[j] * cs.x; }
        tl[j] = r1 * scale; th[j] = r2 * scale;
    }
    wl.x = pack2(tl[0], tl[1]); wl.y = pack2(tl[2], tl[3]); wl.z = pack2(tl[4], tl[5]); wl.w = pack2(tl[6], tl[7]);
    wh.x = pack2(th[0], th[1]); wh.y = pack2(th[2], th[3]); wh.z = pack2(th[4], th[5]); wh.w = pack2(th[6], th[7]);
}

__device__ __forceinline__ void mixer_sgu_pool(AP a, LAS unsigned char* lds, int l, int row0, int seq_row0, int pos0, int n) {
    const int tid = tid_opaque(), lane = tid & 63, w = __builtin_amdgcn_readfirstlane(tid >> 6), fr = lane & 15, g = lane >> 4;
    const bf16_t* Z = (const bf16_t*)(a->ws + WS_Z);
    bf16_t* CAT = (bf16_t*)(a->ws + WS_CAT);
    {
#pragma unroll
        for (int it = 0; it < 9; ++it) { const int id = tid + 512 * it, rr = id >> 5, ch = id & 31, j = pos0 - 8 + rr;
            u32x4 v = (u32x4){0u, 0u, 0u, 0u};
            if (j >= 0 && j < n) v = ld16g(Z + (size_t)(seq_row0 + j) * ZC + 1024 + ch * 8);
            *(LAS u32x4*)(lds + rr * 512 + ch * 16) = v; }
        __syncthreads();
        const int c = tid & 255, half = tid >> 8, hw = 1 << (c >> 6);
        const LAS bf16_t* P = (const LAS bf16_t*)lds + c;
        const int t0 = half * 64;
        float s = 0.f;
        for (int j = t0 - hw; j < t0 + hw; ++j) s += bf2f(P[(8 + j) * 256]);
        for (int tl = t0; tl < t0 + 64; ++tl) {
            const int pos = pos0 + tl; const int lo = max(pos - hw, 0), hi = min(pos + hw, n);
            CAT[(size_t)(row0 + tl) * D + 512 + c] = f2bf(s / (float)(hi - lo) - bf2f(P[(8 + tl) * 256]));
            s += bf2f(P[(8 + tl + hw) * 256]) - bf2f(P[(8 + tl - hw) * 256]);
        }
        __syncthreads();
    }
    {
        const int i16 = lane & 15;
        u32x4 gw[4][2];
#pragma unroll
        for (int ps = 0; ps < 4; ++ps) { const int q = w * 16 + ps * 4 + g; const bf16_t* src = Z + (size_t)(row0 + q) * ZC + 1536 + 16 * i16; gw[ps][0] = ld16g(src); gw[ps][1] = ld16g(src + 8); }
#pragma unroll
        for (int ps = 0; ps < 4; ++ps) {
            const int q = w * 16 + ps * 4 + g;
            float gv[16];
#pragma unroll
            for (int hh = 0; hh < 2; ++hh) { const u32x4 x = gw[ps][hh];
                gv[8 * hh + 0] = gelu_erf(lo2f(x.x)); gv[8 * hh + 1] = gelu_erf(hi2f(x.x)); gv[8 * hh + 2] = gelu_erf(lo2f(x.y)); gv[8 * hh + 3] = gelu_erf(hi2f(x.y));
                gv[8 * hh + 4] = gelu_erf(lo2f(x.z)); gv[8 * hh + 5] = gelu_erf(hi2f(x.z)); gv[8 * hh + 6] = gelu_erf(lo2f(x.w)); gv[8 * hh + 7] = gelu_erf(hi2f(x.w)); }
            float sm = 0.f;
#pragma unroll
            for (int e = 0; e < 16; ++e) sm += gv[e];
            const float mean = row_sum16(sm) * (1.0f / 256.0f);
            float qq = 0.f;
#pragma unroll
            for (int e = 0; e < 16; ++e) { const float d = gv[e] - mean; qq += d * d; }
            const float rstd = 1.0f / sqrtf(row_sum16(qq) * (1.0f / 256.0f) + 1e-6f);
#pragma unroll
            for (int e = 0; e < 16; ++e) { const int c = 16 * i16 + e; *(LAS bf16_t*)(lds + c * 256 + ((((q >> 3) ^ (c & 15))) << 4) + (q & 7) * 2) = f2bf((gv[e] - mean) * rstd); }
        }
    }
    __syncthreads();
    {
        const int h = w >> 1, ph = w & 1;
        const bf16_t* Ws = (const bf16_t*)(a->ws + WS_WSGU) + (size_t)(l * 4 + h) * 128 * 128;
        const float* bs = a->in[12] + (size_t)(l * 4 + h) * 128;
        f32x4 acc[4][4];
#pragma unroll
        for (int i = 0; i < 4; ++i)
#pragma unroll
            for (int j = 0; j < 4; ++j) acc[i][j] = (f32x4){0.f, 0.f, 0.f, 0.f};
#pragma unroll
        for (int ks = 0; ks < 4; ++ks) {
            bf16x8 af[4], bfv[4];
#pragma unroll
            for (int cf = 0; cf < 4; ++cf) { const int c = h * 64 + 16 * cf + fr; af[cf] = *(const LAS bf16x8*)(lds + c * 256 + (((4 * ks + g) ^ (c & 15)) << 4)); }
#pragma unroll
            for (int pf = 0; pf < 4; ++pf) { const int p = ph * 64 + 16 * pf + fr; bfv[pf] = *(const bf16x8*)(Ws + (size_t)p * 128 + 32 * ks + 8 * g); }
#pragma unroll
            for (int cf = 0; cf < 4; ++cf)
#pragma unroll
                for (int pf = 0; pf < 4; ++pf) acc[cf][pf] = __builtin_amdgcn_mfma_f32_16x16x32_bf16(af[cf], bfv[pf], acc[cf][pf], 0, 0, 0);
        }
#pragma unroll
        for (int pf = 0; pf < 4; ++pf) { const int p = ph * 64 + 16 * pf + fr; const float bias = bs[p];
#pragma unroll
            for (int cf = 0; cf < 4; ++cf) { const int c0 = h * 64 + 16 * cf + 4 * g;
                const u32x2 uw = *(const u32x2*)(Z + (size_t)(row0 + p) * ZC + 1280 + c0);
                u32x2 o; o.x = pack2(gelu_erf(lo2f(uw.x)) * (acc[cf][pf][0] + bias), gelu_erf(hi2f(uw.x)) * (acc[cf][pf][1] + bias));
                o.y = pack2(gelu_erf(lo2f(uw.y)) * (acc[cf][pf][2] + bias), gelu_erf(hi2f(uw.y)) * (acc[cf][pf][3] + bias));
                *(u32x2*)(CAT + (size_t)(row0 + p) * D + 768 + c0) = o; } }
    }
    __syncthreads();
}

__device__ __forceinline__ void mixer_attn(AP a, LAS unsigned char* lds, int l, int row0, int seq_row0, int pos0, int n, int b, bool is_ctx, int kvh) {
    const int tid = tid_opaque(), lane = tid & 63, w = __builtin_amdgcn_readfirstlane(tid >> 6), fr = lane & 15, g = lane >> 4;
    const bf16_t* Z = (const bf16_t*)(a->ws + WS_Z);
    bf16_t* CAT = (bf16_t*)(a->ws + WS_CAT);
    __syncthreads();
    ((LAS u32x4*)(lds + 98304))[tid] = ((const u32x4*)(a->ws + WS_ROPE))[tid];
    const LAS f32x2* rope = (const LAS f32x2*)(lds + 98304);
    constexpr float QS = 0.125f * 1.44269504088896341f;
    constexpr int QS_OFF = 0, KS_OFF = 32768, VS_OFF = 65536;
    const int nbq = pos0 >> 7;
    unsigned bmask = 0x18u;
    if (!is_ctx) { if (nbq > 0) bmask |= 1u; bmask |= 2u; if (nbq + 1 < (n >> 7)) bmask |= 4u; }
    const int kr = tid >> 2, kax = (tid >> 1) & 1, kh8 = tid & 1;
#define MX_KSRC(blk) (Z + (size_t)((((blk) < 3) ? seq_row0 + (nbq + (blk) - 1) * 128 : NLAT + b * 256 + ((blk) - 3) * 128) + kr) * ZC + 768 + kvh * 64 + kax * 32 + kh8 * 8)
#define MX_VSTAGE(blk, buf) do { const bool _band = (blk) < 3; const int _key0 = _band ? (nbq + (blk) - 1) * 128 : ((blk) - 3) * 128; \
        const bf16_t* _vs = _band ? (const bf16_t*)(a->ws + WS_VT) + (size_t)(b * 2 + kvh) * 64 * 4096 + _key0 : (const bf16_t*)(a->ws + WS_VTC) + (size_t)(b * 2 + kvh) * 64 * 256 + _key0; \
        const int _vld = _band ? 4096 : 256; \
        _Pragma("unroll") for (int _i = 0; _i < 2; ++_i) { const int _P = _i * 512 + tid, _d = _P >> 4, _c = (_P & 15) ^ (_d & 15); \
            glds16(_vs + (size_t)_d * _vld + _c * 8, lds + VS_OFF + (buf) * 16384 + _i * 8192 + w * 1024); } } while (0)
    {
        __syncthreads();
#pragma unroll
        for (int it = 0; it < 2; ++it) {
            const int item = tid + 512 * it, r = item >> 2, ax = (item >> 1) & 1, h8 = item & 1, i = r & 127, qpos = pos0 + i;
            const bf16_t* src = Z + (size_t)(row0 + i) * ZC + 512 + (2 * kvh + (r >> 7)) * 64 + ax * 32 + h8 * 8;
            u32x4 wl = ld16g(src), wh = ld16g(src + 16);
            rope_pack8(wl, wh, rope + (ax ? (qpos & 63) : (qpos >> 6)) * 16 + h8 * 8, !is_ctx, QS);
            const int ch = ax * 4 + h8, sw = (r >> 1) & 7;
            *(LAS u32x4*)(lds + QS_OFF + r * 128 + ((ch ^ sw) << 4)) = wl;
            *(LAS u32x4*)(lds + QS_OFF + r * 128 + (((ch + 2) ^ sw) << 4)) = wh;
        }
        const int hh = w >> 2, qb = (w & 3) * 32, h = 2 * kvh + hh;
        float m[2], lsum[2];
        m[0] = m[1] = a->in[8][l * 4 + h] * 1.44269504088896341f;
        lsum[0] = lsum[1] = (g == 0) ? 1.0f : 0.0f;
        f32x4 O[4][2];
#pragma unroll
        for (int i = 0; i < 4; ++i) { O[i][0] = (f32x4){0.f, 0.f, 0.f, 0.f}; O[i][1] = (f32x4){0.f, 0.f, 0.f, 0.f}; }
        bf16x8 Qf[2][2];
        bool have_q = false;
        unsigned rem = bmask;
        int cur = __builtin_ctz(rem); rem &= rem - 1u;
        int buf = 0;
        u32x4 kl = ld16g(MX_KSRC(cur)), kh = ld16g(MX_KSRC(cur) + 16);
        MX_VSTAGE(cur, 0);
#pragma unroll 1
        for (;;) {
            const int jb = cur - 1; const bool band = cur < 3;
            {
                const int kpos = (nbq + jb) * 128 + kr;
                rope_pack8(kl, kh, rope + (kax ? (kpos & 63) : (kpos >> 6)) * 16 + kh8 * 8, band, 1.0f);
                const int ch = kax * 4 + kh8, sw = (kr >> 1) & 7;
                *(LAS u32x4*)(lds + KS_OFF + buf * 16384 + kr * 128 + ((ch ^ sw) << 4)) = kl;
                *(LAS u32x4*)(lds + KS_OFF + buf * 16384 + kr * 128 + (((ch + 2) ^ sw) << 4)) = kh;
            }
            asm volatile("s_waitcnt vmcnt(0)" ::: "memory");
            __syncthreads();
            const int nxt = rem ? __builtin_ctz(rem) : -1; rem &= rem - 1u;
            if (nxt >= 0) { kl = ld16g(MX_KSRC(nxt)); kh = ld16g(MX_KSRC(nxt) + 16); MX_VSTAGE(nxt, buf ^ 1); }
            if (!have_q) {
#pragma unroll
                for (int qf = 0; qf < 2; ++qf)
#pragma unroll
                    for (int ks = 0; ks < 2; ++ks) { const int r = hh * 128 + qb + 16 * qf + fr; Qf[qf][ks] = *(const LAS bf16x8*)(lds + QS_OFF + r * 128 + (((4 * ks + g) ^ ((r >> 1) & 7)) << 4)); }
                have_q = true;
            }
            const int kso = KS_OFF + buf * 16384, vso = VS_OFF + buf * 16384;
            f32x4 S[8][2];
#pragma unroll
            for (int kf = 0; kf < 8; ++kf) { S[kf][0] = (f32x4){0.f, 0.f, 0.f, 0.f}; S[kf][1] = (f32x4){0.f, 0.f, 0.f, 0.f}; }
#pragma unroll
            for (int kf = 0; kf < 8; ++kf)
#pragma unroll
                for (int ks = 0; ks < 2; ++ks) { const int r = 16 * kf + fr;
                    const bf16x8 kfr = *(const LAS bf16x8*)(lds + kso + r * 128 + (((4 * ks + g) ^ ((r >> 1) & 7)) << 4));
                    S[kf][0] = __builtin_amdgcn_mfma_f32_16x16x32_bf16(kfr, Qf[0][ks], S[kf][0], 0, 0, 0);
                    S[kf][1] = __builtin_amdgcn_mfma_f32_16x16x32_bf16(kfr, Qf[1][ks], S[kf][1], 0, 0, 0); }
            bf16x8 Pp[4][2];
#pragma unroll
            for (int qf = 0; qf < 2; ++qf) {
                const int qi = qb + 16 * qf + fr;
                if (band && jb != 0) {
#pragma unroll
                    for (int kf = 0; kf < 8; ++kf)
#pragma unroll
                        for (int r = 0; r < 4; ++r) { const int kk = 16 * kf + 4 * g + r; const bool ok = (jb < 0) ? (kk >= qi) : (kk <= qi); if (!ok) S[kf][qf][r] = -1.0e30f; }
                }
                float mx = S[0][qf][0];
#pragma unroll
                for (int kf = 0; kf < 8; ++kf)
#pragma unroll
                    for (int r = 0; r < 4; ++r) mx = fmaxf(mx, S[kf][qf][r]);
                mx = fmaxf(mx, __shfl_xor(mx, 16)); mx = fmaxf(mx, __shfl_xor(mx, 32));
                const float mn = fmaxf(m[qf], mx), corr = __builtin_amdgcn_exp2f(m[qf] - mn);
                m[qf] = mn;
                float ps = 0.f;
#pragma unroll
                for (int kf = 0; kf < 8; ++kf)
#pragma unroll
                    for (int r = 0; r < 4; ++r) { const float p = __builtin_amdgcn_exp2f(S[kf][qf][r] - mn); S[kf][qf][r] = p; ps += p; }
                lsum[qf] = lsum[qf] * corr + ps;
#pragma unroll
                for (int df = 0; df < 4; ++df) O[df][qf] *= corr;
#pragma unroll
                for (int t = 0; t < 4; ++t) { u32x4 pw; pw.x = pack2(S[2 * t][qf][0], S[2 * t][qf][1]); pw.y = pack2(S[2 * t][qf][2], S[2 * t][qf][3]);
                    pw.z = pack2(S[2 * t + 1][qf][0], S[2 * t + 1][qf][1]); pw.w = pack2(S[2 * t + 1][qf][2], S[2 * t + 1][qf][3]); Pp[t][qf] = __builtin_bit_cast(bf16x8, pw); }
            }
#pragma unroll
            for (int t = 0; t < 4; ++t)
#pragma unroll
                for (int df = 0; df < 4; ++df) { const int d = 16 * df + fr;
                    const u32x2 v0 = *(const LAS u32x2*)(lds + vso + d * 256 + (((4 * t + (g >> 1)) ^ (d & 15)) << 4) + (g & 1) * 8);
                    const u32x2 v1 = *(const LAS u32x2*)(lds + vso + d * 256 + (((4 * t + 2 + (g >> 1)) ^ (d & 15)) << 4) + (g & 1) * 8);
                    u32x4 vw; vw.x = v0.x; vw.y = v0.y; vw.z = v1.x; vw.w = v1.y; const bf16x8 vf = __builtin_bit_cast(bf16x8, vw);
                    O[df][0] = __builtin_amdgcn_mfma_f32_16x16x32_bf16(vf, Pp[t][0], O[df][0], 0, 0, 0);
                    O[df][1] = __builtin_amdgcn_mfma_f32_16x16x32_bf16(vf, Pp[t][1], O[df][1], 0, 0, 0); }
            if (nxt < 0) break;
            cur = nxt; buf ^= 1;
        }
#pragma unroll
        for (int qf = 0; qf < 2; ++qf) {
            float lt = lsum[qf]; lt += __shfl_xor(lt, 16); lt += __shfl_xor(lt, 32);
            const float inv = 1.0f / lt;
            bf16_t* dst = CAT + (size_t)(row0 + qb + 16 * qf + fr) * D + 256 + h * 64 + 4 * g;
#pragma unroll
            for (int df = 0; df < 4; ++df) { u32x2 o; o.x = pack2(O[df][qf][0] * inv, O[df][qf][1] * inv); o.y = pack2(O[df][qf][2] * inv, O[df][qf][3] * inv); *(u32x2*)(dst + 16 * df) = o; }
        }
    }
#undef MX_KSRC
#undef MX_VSTAGE
    __syncthreads();
}

constexpr int FF_DA = 0, FF_DC = 32768, FF_XT = 49152  , FF_Z2 = 81920  , FF_OB = 114688  ;
__device__ __forceinline__ int ff_addr(int row, int k) { return row * 256 + ((((k >> 3) ^ (row & 15))) << 4) + (k & 7) * 2; }
__device__ __forceinline__ float cos_turns(float x) { return __builtin_amdgcn_cosf(x); }
__device__ __forceinline__ float sin_turns(float x) { return __builtin_amdgcn_sinf(x); }
__device__ __forceinline__ void fft_setup(LAS unsigned char* lds) {
    const int tid = tid_opaque();
    __syncthreads();
    for (int idx = tid; idx < 16384; idx += NT) { const int i = idx >> 7, k = idx & 127, ro = i >> 6, k1 = i & 63, part = k >> 6, n1 = k & 63; const float t = (float)((k1 * n1) & 63) * (1.0f / 64.0f);
        const float c = cos_turns(t), sn = sin_turns(t);
        const float v = (ro == 0) ? (part == 0 ? c : sn) : (part == 0 ? -sn : c);
        *(LAS bf16_t*)(lds + FF_DA + ff_addr(i, k)) = f2bf(v * 0.125f); }
    for (int idx = tid; idx < 8192; idx += NT) { const int k2 = idx >> 7, k = idx & 127, ri = k >> 6, n2 = k & 63; const float t = (float)((k2 * n2) & 63) * (1.0f / 64.0f);
        const float v = (ri == 0) ? cos_turns(t) : sin_turns(t);
        *(LAS bf16_t*)(lds + FF_DC + ff_addr(k2, k)) = f2bf(v * 0.125f); }
    __syncthreads();
}
__device__ __forceinline__ void fft_unit(AP a, LAS unsigned char* lds, int b, int cg) {
    const int tid = tid_opaque(), lane = tid & 63, w = __builtin_amdgcn_readfirstlane(tid >> 6), fr = lane & 15, g = lane >> 4;
    const int mf = w & 3, nh = w >> 2;
    const bf16_t* AT = (const bf16_t*)(a->ws + WS_AT) + (size_t)(b * 256 + cg * 4) * 8192;
    u32x4 xin[2][2];
#pragma unroll
    for (int h = 0; h < 2; ++h)
#pragma unroll
        for (int it = 0; it < 2; ++it) xin[h][it] = ld16g(AT + (size_t)h * 8192 + (size_t)(tid + 512 * it) * 8);
#pragma unroll 1
    for (int cp = 0; cp < 2; ++cp) {
#pragma unroll
        for (int h = 0; h < 2; ++h)
#pragma unroll
            for (int it = 0; it < 2; ++it) { const int q = tid + 512 * it, part = q >> 9, pos0 = (q & 511) * 8, n1 = pos0 >> 6, n2 = pos0 & 63, k = part * 64 + n1;
                const unsigned wv[4] = {xin[h][it].x, xin[h][it].y, xin[h][it].z, xin[h][it].w};
#pragma unroll
                for (int e = 0; e < 4; ++e) { *(LAS bf16_t*)(lds + FF_XT + h * 16384 + ff_addr(n2 + 2 * e, k)) = (bf16_t)(wv[e] & 0xffffu); *(LAS bf16_t*)(lds + FF_XT + h * 16384 + ff_addr(n2 + 2 * e + 1, k)) = (bf16_t)(wv[e] >> 16); } }
        if (cp == 0) {
#pragma unroll
            for (int h = 0; h < 2; ++h)
#pragma unroll
                for (int it = 0; it < 2; ++it) xin[h][it] = ld16g(AT + (size_t)(2 + h) * 8192 + (size_t)(tid + 512 * it) * 8); }
        __syncthreads();
        f32x4 acc[2][2][2];
#pragma unroll
        for (int h = 0; h < 2; ++h)
#pragma unroll
            for (int x = 0; x < 2; ++x) { acc[h][x][0] = (f32x4){0.f, 0.f, 0.f, 0.f}; acc[h][x][1] = (f32x4){0.f, 0.f, 0.f, 0.f}; }
#pragma unroll
        for (int ks = 0; ks < 4; ++ks) {
            bf16x8 af[2];
#pragma unroll
            for (int x = 0; x < 2; ++x) { const int i = 16 * (mf + 4 * x) + fr; af[x] = *(const LAS bf16x8*)(lds + FF_DA + i * 256 + (((4 * ks + g) ^ (i & 15)) << 4)); }
#pragma unroll
            for (int h = 0; h < 2; ++h)
#pragma unroll
                for (int n = 0; n < 2; ++n) { const int j = 16 * (2 * nh + n) + fr; const bf16x8 bfv = *(const LAS bf16x8*)(lds + FF_XT + h * 16384 + j * 256 + (((4 * ks + g) ^ (j & 15)) << 4));
                    acc[h][0][n] = __builtin_amdgcn_mfma_f32_16x16x32_bf16(af[0], bfv, acc[h][0][n], 0, 0, 0);
                    acc[h][1][n] = __builtin_amdgcn_mfma_f32_16x16x32_bf16(af[1], bfv, acc[h][1][n], 0, 0, 0); }
        }
#pragma unroll
        for (int n = 0; n < 2; ++n)
#pragma unroll
            for (int r = 0; r < 4; ++r) { const int k1 = 16 * mf + 4 * g + r, n2 = 16 * (2 * nh + n) + fr; const float t = (float)((k1 * n2) & 4095) * (1.0f / 4096.0f);
                const float c = cos_turns(t), sn = sin_turns(t);
#pragma unroll
                for (int h = 0; h < 2; ++h) { const float zr = acc[h][0][n][r], zi = acc[h][1][n][r];
                    *(LAS bf16_t*)(lds + FF_Z2 + h * 16384 + ff_addr(k1, n2)) = f2bf(zr * c + zi * sn);
                    *(LAS bf16_t*)(lds + FF_Z2 + h * 16384 + ff_addr(k1, 64 + n2)) = f2bf(zi * c - zr * sn); } }
        __syncthreads();
        f32x4 acc2[2][2];
#pragma unroll
        for (int h = 0; h < 2; ++h) { acc2[h][0] = (f32x4){0.f, 0.f, 0.f, 0.f}; acc2[h][1] = (f32x4){0.f, 0.f, 0.f, 0.f}; }
#pragma unroll
        for (int ks = 0; ks < 4; ++ks) {
            const int i = 16 * mf + fr; const bf16x8 af = *(const LAS bf16x8*)(lds + FF_DC + i * 256 + (((4 * ks + g) ^ (i & 15)) << 4));
#pragma unroll
            for (int h = 0; h < 2; ++h)
#pragma unroll
                for (int n = 0; n < 2; ++n) { const int j = 16 * (2 * nh + n) + fr; const bf16x8 bfv = *(const LAS bf16x8*)(lds + FF_Z2 + h * 16384 + j * 256 + (((4 * ks + g) ^ (j & 15)) << 4));
                    acc2[h][n] = __builtin_amdgcn_mfma_f32_16x16x32_bf16(af, bfv, acc2[h][n], 0, 0, 0); }
        }
#pragma unroll
        for (int n = 0; n < 2; ++n)
#pragma unroll
            for (int r = 0; r < 4; ++r) { const int k = 16 * (2 * nh + n) + fr + 64 * (16 * mf + 4 * g + r);
                *(LAS unsigned*)(lds + FF_OB + k * 8 + cp * 4) = pack2(acc2[0][n][r], acc2[1][n][r]); }
    }
    __syncthreads();
    bf16_t* CAT = (bf16_t*)(a->ws + WS_CAT) + (size_t)(b * 4096) * D + cg * 4;
#pragma unroll
    for (int it = 0; it < 8; ++it) { const int k = tid + 512 * it; *(u32x2*)(CAT + (size_t)k * D) = *(const LAS u32x2*)(lds + FF_OB + k * 8); }
    __syncthreads();
}

__device__ __forceinline__ void p2_mix(AP a, unsigned char* ldsg, LAS unsigned char* lds, int l) {
    const int n_tile = 128 + ((l == 0) ? 8 : 0), n_att = 2 * n_tile, n_dft = 256, n_dftc = (l == 0) ? 16 : 0;
    bf16_t* CAT = (bf16_t*)(a->ws + WS_CAT);
    bool fft_ready = false;
    for (int u = blockIdx.x; u < n_att + n_dft + n_tile + n_dftc; u += gridDim.x) {
        if (u < n_att || (u >= n_att + n_dft && u < n_att + n_dft + n_tile)) {
            const bool att = u < n_att;
            const int t = att ? (u >> 1) : (u - n_att - n_dft);
            const bool isc = t >= 128; const int tt = t - 128;
            const int b = isc ? (tt >> 1) : (t >> 5);
            const int row0 = isc ? NLAT + tt * 128 : t * 128, seq_row0 = isc ? NLAT + b * 256 : b * 4096, pos0 = isc ? (tt & 1) * 128 : (t & 31) * 128, n = isc ? 256 : 4096;
            if (att) { for (int rep = 0; rep < PROBE_MIX_REP; ++rep) mixer_attn(a, lds, l, row0, seq_row0, pos0, n, b, isc, u & 1); }
            else { for (int rep = 0; rep < PROBE_SGU_REP; ++rep) mixer_sgu_pool(a, lds, l, row0, seq_row0, pos0, n); }
            fft_ready = false;
        } else if (u < n_att + n_dft) {
            const int uu = u - n_att;
            if (!fft_ready) { fft_setup(lds); fft_ready = true; }
            for (int rep = 0; rep < PROBE_FFT_REP; ++rep) fft_unit(a, lds, uu >> 6, uu & 63);
        } else {
            const int uu = u - n_att - n_dft - n_tile, b = uu >> 2, mt = (uu >> 1) & 1, ch0 = (uu & 1) * 128;
            const bf16_t* A = (const bf16_t*)(a->ws + WS_DFTC) + (size_t)(mt * 128) * 512;
            const bf16_t* B0 = (const bf16_t*)(a->ws + WS_ATC) + ((size_t)b * 256 + ch0) * 512;
            EpiBf16 E; E.C = CAT + (size_t)(NLAT + b * 256 + mt * 128) * D + ch0; E.ld = D; E.scale = 1.0f;
            gemm_tile<128, false, EpiBf16>(lds, A, 512, nullptr, 128, B0, B0 + (size_t)64 * 512, 512, 512, E);
            fft_ready = false;
        }
    }
    exp_queue(a, ldsg, l);
}

__device__ __forceinline__ int uni(int v) { return __builtin_amdgcn_readfirstlane(v); }
__device__ __forceinline__ int vblock() { const int G = gridDim.x, b = blockIdx.x; return (G % 8 == 0) ? (b % 8) * (G / 8) + b / 8 : b; }
template <class T> __device__ __forceinline__ T* unip(T* p) { const unsigned long long v = (unsigned long long)p; const unsigned lo = __builtin_amdgcn_readfirstlane((unsigned)v), hi = __builtin_amdgcn_readfirstlane((unsigned)(v >> 32)); return (T*)(((unsigned long long)hi << 32) | lo); }
struct SchedInProj {
    typedef EpiInProj Epi; static constexpr bool GATHER = false, FP8 = false;
    unsigned char* ws; int l, G, me;
    __device__ __forceinline__ bool get(int i, g256::Unit<Epi>& u) const {
        const int n_lat = 64 * 7, n_ctx = (l == 0) ? 4 * 7 : 4;
        const int idx = i * G + me; if (idx >= n_lat + n_ctx) return false;
        int row0, b, ct, n; bf16_t *tF, *tV;
        if (idx < n_lat) { const int rt = idx / 7; ct = idx % 7; row0 = rt * 256; b = row0 >> 12; n = 4096;
            tF = (bf16_t*)(ws + WS_AT) + (size_t)b * 256 * 2 * 4096; tV = (bf16_t*)(ws + WS_VT) + (size_t)b * 128 * 4096; }
        else { const int uu = idx - n_lat; int rt; if (l == 0) { rt = uu / 7; ct = uu % 7; } else { rt = uu; ct = 3; }
            row0 = NLAT + rt * 256; b = rt; n = 256;
            tF = (bf16_t*)(ws + WS_ATC) + (size_t)b * 256 * 2 * 256; tV = (bf16_t*)(ws + WS_VTC) + (size_t)b * 128 * 256; }
        u.A = (const bf16_t*)(ws + WS_H) + (size_t)row0 * D;
        u.B0 = (const bf16_t*)(ws + WS_WIN) + ((size_t)l * ZC + ct * 256) * 1024; u.B1 = u.B0 + (size_t)128 * 1024; u.ridx = nullptr; u.valid = 256;
        u.epi.Zt = (bf16_t*)(ws + WS_Z) + (size_t)row0 * ZC + ct * 256; u.epi.tF = tF; u.epi.tV = tV; u.epi.n0 = ct * 256; u.epi.pos0 = (idx < n_lat) ? (row0 & 4095) : 0; u.epi.n = n;
        return true;
    }
};
struct SchedOutProj {
    typedef EpiBf16 Epi; static constexpr bool GATHER = false, FP8 = false;
    unsigned char* ws; int l, G, me;
    __device__ __forceinline__ bool get(int i, g256::Unit<Epi>& u) const {
        const int nrt = NLAT / 256;
        const int idx = i * G + me; if (idx >= nrt * 4) return false;
        const int rt = idx >> 2, ct = idx & 3;
        u.A = (const bf16_t*)(ws + WS_CAT) + (size_t)(rt * 256) * D;
        u.B0 = (const bf16_t*)(ws + WS_WOUT) + ((size_t)l * 1024 + ct * 256) * 1024; u.B1 = u.B0 + (size_t)128 * 1024; u.ridx = nullptr; u.valid = 256;
        u.epi.C = (bf16_t*)(ws + WS_Y) + (size_t)(rt * 256) * D + ct * 256; u.epi.ld = D; u.epi.scale = 1.0f;
        return true;
    }
};
struct SchedGateUp {
    typedef EpiGateUp8 Epi; static constexpr bool GATHER = true, FP8 = true;
    unsigned char* ws; const LAS int* blk; const LAS int* tot; const LAS int* ridx_lds; int G, me, l;
    __device__ __forceinline__ bool get(int i, g256::Unit<Epi>& u) const {
        const int idx = i * G + me; if (idx >= uni(blk[32]) * 4) return false;
        const int rb = idx >> 2, ct = idx & 3;
        int e = 0;
#pragma unroll 1
        for (int q = 1; q < 32; ++q) if (uni(blk[q]) <= rb) e = q;
        u.A = (const bf16_t*)(ws + WS_H8);
        { const unsigned char* b0 = ws + WS_WEXP + (size_t)l * WEXP_LAYER + ((size_t)e * 512 + ct * 128) * 1024; u.B0 = (const bf16_t*)b0; u.B1 = (const bf16_t*)(b0 + EXPMAT); }
        u.ridx = ridx_lds + (i & 7) * 256; u.valid = uni(min(256, tot[e] - (rb - blk[e]) * 256));
        u.epi.C = ws + WS_HID + (size_t)(rb * 256) * DEXP + ct * 128; u.epi.ld = DEXP;
        return true;
    }
};
struct SchedDown {
    typedef EpiBf16 Epi; static constexpr bool GATHER = false, FP8 = true;
    unsigned char* ws; const LAS int* blk; int G, me, l;
    __device__ __forceinline__ bool get(int i, g256::Unit<Epi>& u) const {
        const int idx = i * G + me; if (idx >= uni(blk[32]) * 4) return false;
        const int rb = idx >> 2, ct = idx & 3;
        int e = 0;
#pragma unroll 1
        for (int q = 1; q < 32; ++q) if (uni(blk[q]) <= rb) e = q;
        u.A = (const bf16_t*)(ws + WS_HID + (size_t)(rb * 256) * DEXP);
        { const unsigned char* b0 = ws + WS_WEXP + (size_t)l * WEXP_LAYER + 2 * EXPMAT + ((size_t)e * 1024 + ct * 256) * 512; u.B0 = (const bf16_t*)b0; u.B1 = (const bf16_t*)(b0 + (size_t)128 * 512); } u.ridx = nullptr; u.valid = 256;
        u.epi.C = (bf16_t*)(ws + WS_YS) + (size_t)(rb * 256) * D + ct * 256; u.epi.ld = D; u.epi.scale = 1.0f / 32.0f;
        return true;
    }
};

__device__ __forceinline__ void p4_ln1_router(AP a, unsigned char* lds, int l) {
    const int tid = tid_opaque(), lane = tid & 63, w = tid >> 6;
    const int ntok = (l == 0) ? NTOK : NLAT;
    int* cnt = (int*)(lds + MISC_OFF);
    if (tid < 32) cnt[tid] = 0;
    f32x4* Lg = (f32x4*)lds; f32x4* Le = (f32x4*)(lds + 16384); f32x4* Lgb = (f32x4*)(lds + 147456);
    {
        const float* wrg_ = a->in[16] + (size_t)l * 1024 * 4; const float* wre_ = a->in[17] + (size_t)l * 1024 * 32;
#pragma unroll
        for (int it = 0; it < 2; ++it) { const int c = tid + 512 * it, slot = (((c >> 8) * 4 + (c & 3)) << 6) + ((c >> 2) & 63);
            Lg[slot] = *(const f32x4*)(wrg_ + (size_t)c * 4);
#pragma unroll
            for (int q = 0; q < 8; ++q) Le[q * 1024 + slot] = *(const f32x4*)(wre_ + (size_t)c * 32 + q * 4); }
        Lgb[tid] = (tid < 256) ? *(const f32x4*)(a->in[14] + l * 1024 + tid * 4) : *(const f32x4*)(a->in[15] + l * 1024 + (tid - 256) * 4);
    }
    __syncthreads();
    const float* mod = (const float*)(a->ws + WS_MOD) + (size_t)l * 5 * 6144;
    const bf16_t* Y = (const bf16_t*)(a->ws + WS_Y);
    float* X1 = (float*)(a->ws + WS_X1);
    unsigned char* H8 = a->ws + WS_H8;
    int* tokE = (int*)(a->ws + WS_TOKE); int* tokR = (int*)(a->ws + WS_TOKR); float* tokG = (float*)(a->ws + WS_TOKG);
    const int tstep = gridDim.x * 8;
    f32x4 nx[4]; u32x2 ny[4];
    {   const int t = blockIdx.x * 8 + w;
        if (t < ntok) { const float* xs = (l == 0) ? ((t < NLAT) ? a->in[0] + (size_t)t * D : a->in[2] + (size_t)(t - NLAT) * D) : (const float*)(a->ws + WS_XC) + (size_t)t * D;
#pragma unroll
            for (int i = 0; i < 4; ++i) { nx[i] = *(const f32x4*)(xs + 256 * i + 4 * lane); ny[i] = *(const u32x2*)(Y + (size_t)t * D + 256 * i + 4 * lane); } } }
    int mrow = -1; f32x4 mg[4], msh[4], msc[4];
    for (int t = blockIdx.x * 8 + w; t < ntok; t += tstep) {
        const int mr = (t < NLAT) ? (t >> 12) : 4;
        if (mr != mrow) { mrow = mr; const float* m = mod + (size_t)mr * 6144;
#pragma unroll
            for (int i = 0; i < 4; ++i) { const int c = 256 * i + 4 * lane; mg[i] = *(const f32x4*)(m + 2048 + c); msh[i] = *(const f32x4*)(m + 3072 + c); msc[i] = *(const f32x4*)(m + 4096 + c); } }
        f32x4 v[4];
#pragma unroll
        for (int i = 0; i < 4; ++i) { const f32x4 yv = (f32x4){lo2f(ny[i].x), hi2f(ny[i].x), lo2f(ny[i].y), hi2f(ny[i].y)};
#pragma unroll
            for (int e = 0; e < 4; ++e) v[i][e] = RES_ALPHA * nx[i][e] + mg[i][e] * yv[e]; }
        {   const int tn = t + tstep;
            if (tn < ntok) { const float* xs = (l == 0) ? ((tn < NLAT) ? a->in[0] + (size_t)tn * D : a->in[2] + (size_t)(tn - NLAT) * D) : (const float*)(a->ws + WS_XC) + (size_t)tn * D;
#pragma unroll
                for (int i = 0; i < 4; ++i) { nx[i] = *(const f32x4*)(xs + 256 * i + 4 * lane); ny[i] = *(const u32x2*)(Y + (size_t)tn * D + 256 * i + 4 * lane); } } }
        float mean, rstd; ln_stats(v, mean, rstd);
#pragma unroll
        for (int i = 0; i < 4; ++i) { const int c = 256 * i + 4 * lane; const f32x4 gg = Lgb[64 * i + lane], bb = Lgb[256 + 64 * i + lane];
#pragma unroll
            for (int e = 0; e < 4; ++e) v[i][e] = (v[i][e] - mean) * rstd * gg[e] + bb[e];
            *(f32x4*)(X1 + (size_t)t * D + c) = v[i]; }
        ln_stats(v, mean, rstd);
#pragma unroll
        for (int i = 0; i < 4; ++i) { const int c = 256 * i + 4 * lane; const f32x4 sh = msh[i], sc = msc[i];
#pragma unroll
            for (int e = 0; e < 4; ++e) v[i][e] = (v[i][e] - mean) * rstd * (1.0f + sc[e]) + sh[e];
            *(unsigned*)(H8 + (size_t)t * D + c) = pack4_fp8(v[i][0], v[i][1], v[i][2], v[i][3]); }
        f32x2 lg01 = (f32x2){0.f, 0.f}, lg23 = (f32x2){0.f, 0.f};
#pragma unroll
        for (int i = 0; i < 4; ++i)
#pragma unroll
            for (int e = 0; e < 4; ++e) { const f32x4 wv = Lg[((i * 4 + e) << 6) + lane]; const f32x2 vv = (f32x2){v[i][e], v[i][e]};
                lg01 += vv * (f32x2){wv[0], wv[1]}; lg23 += vv * (f32x2){wv[2], wv[3]}; }
        float lg[4] = {wave_sum(lg01[0]), wave_sum(lg01[1]), wave_sum(lg23[0]), wave_sum(lg23[1])};
        int grp = 0; float mx = lg[0];
#pragma unroll
        for (int q = 1; q < 4; ++q) if (lg[q] > mx) { mx = lg[q]; grp = q; }
        float se = 0.f;
#pragma unroll
        for (int q = 0; q < 4; ++q) se += expf(lg[q] - mx);
        const float gate_group = 1.0f / se;
        f32x2 le01 = (f32x2){0.f, 0.f}, le23 = (f32x2){0.f, 0.f}, le45 = (f32x2){0.f, 0.f}, le67 = (f32x2){0.f, 0.f};
#pragma unroll
        for (int i = 0; i < 4; ++i)
#pragma unroll
            for (int e = 0; e < 4; ++e) { const f32x4* wp = Le + grp * 2048 + ((i * 4 + e) << 6) + lane; const f32x4 w0 = wp[0], w1 = wp[1024]; const f32x2 vv = (f32x2){v[i][e], v[i][e]};
                le01 += vv * (f32x2){w0[0], w0[1]}; le23 += vv * (f32x2){w0[2], w0[3]}; le45 += vv * (f32x2){w1[0], w1[1]}; le67 += vv * (f32x2){w1[2], w1[3]}; }
        float le[8] = {wave_sum(le01[0]), wave_sum(le01[1]), wave_sum(le23[0]), wave_sum(le23[1]), wave_sum(le45[0]), wave_sum(le45[1]), wave_sum(le67[0]), wave_sum(le67[1])};
        int j1 = 0; float l1 = le[0];
#pragma unroll
        for (int q = 1; q < 8; ++q) if (le[q] > l1) { l1 = le[q]; j1 = q; }
        int j2 = -1; float l2 = -3.0e38f;
#pragma unroll
        for (int q = 0; q < 8; ++q) if (q != j1 && le[q] > l2) { l2 = le[q]; j2 = q; }
        const float e2 = expf(l2 - l1), p1 = 1.0f / (1.0f + e2), p2 = e2 / (1.0f + e2);
        if (lane == 0) {
            const int ex0 = grp * 8 + j1, ex1 = grp * 8 + j2;
            const int r0 = atomicAdd(&cnt[ex0], 1), r1 = atomicAdd(&cnt[ex1], 1);
            tokE[2 * t] = ex0; tokE[2 * t + 1] = ex1; tokR[2 * t] = r0; tokR[2 * t + 1] = r1;
            tokG[2 * t] = gate_group * p1; tokG[2 * t + 1] = gate_group * p2;
        }
    }
    __syncthreads();
    if (tid < 32) ((int*)(a->ws + WS_BCNT))[((size_t)l * MAXG + blockIdx.x) * 32 + tid] = cnt[tid];
    __syncthreads();
}

__device__ __forceinline__ void p5_dispatch(AP a, unsigned char* lds, int l) {
    const int tid = tid_opaque();
    const int ntok = (l == 0) ? NTOK : NLAT;
    int* part = (int*)lds;
    int* tot = (int*)(lds + 4096);
    int* off = (int*)(lds + 4096 + 128);
    int* pstart = (int*)(lds + 4096 + 256);
    const int* bc = (const int*)(a->ws + WS_BCNT) + (size_t)l * MAXG * 32;
    const int G = gridDim.x, me = blockIdx.x;
    { const int e = tid & 31, p = tid >> 5; int s = 0, so = 0; for (int bb = p; bb < G; bb += 16) { const int c = bc[bb * 32 + e]; s += c; if (bb < me) so += c; } part[p * 32 + e] = s; part[512 + p * 32 + e] = so; }
    __syncthreads();
    if (tid < 32) { int s = 0, so = 0; for (int p = 0; p < 16; ++p) { s += part[p * 32 + tid]; so += part[512 + p * 32 + tid]; } tot[tid] = s; off[tid] = so; }
    __syncthreads();
    if (tid == 0) { int acc = 0; for (int e = 0; e < 32; ++e) { pstart[e] = acc; acc += ((tot[e] + 255) >> 8) << 8; } }
    __syncthreads();
    if (me == 0 && tid < 32) ((int*)(a->ws + WS_CNT))[l * 32 + tid] = tot[tid];
    const int* tokE = (const int*)(a->ws + WS_TOKE); const int* tokR = (const int*)(a->ws + WS_TOKR);
    int* tokS = (int*)(a->ws + WS_TOKS); int* slotT = (int*)(a->ws + WS_SLOTT);
    for (int q = tid; ; q += NT) { const int it = q >> 4, j = q & 15, t = (it * G + me) * 8 + (j >> 1); if (t >= ntok) break;
        const int idx = 2 * t + (j & 1); const int e = tokE[idx]; const int slot = pstart[e] + off[e] + tokR[idx]; tokS[idx] = slot; slotT[slot] = t; }
    __syncthreads();
}

__device__ __forceinline__ void moe_table(AP a, int l, LAS int* blk) {
    const int* tot = (const int*)(a->ws + WS_CNT) + l * 32;
    if (threadIdx.x == 0) { int acc = 0; for (int e = 0; e < 32; ++e) { const int c = tot[e]; blk[e] = acc; blk[33 + e] = c; acc += (c + 255) >> 8; } blk[32] = acc; }
    __syncthreads();
}
__device__ __forceinline__ int units_of(int nu, int v, int G) { return (v < nu) ? (nu - v + G - 1) / G : 0; }
__device__ __forceinline__ void p1_inproj(AP a, unsigned char* smem, LAS unsigned char* lds, int l) {
    SchedInProj S; S.ws = a->ws; S.l = l; S.G = gridDim.x; S.me = vblock();
    g256::gemm_phase(lds, 1024, S);
    if (l == 0) { const int nu = 64 * 7 + 4 * 7, G = gridDim.x; if (units_of(nu, S.me, G) < (nu + G - 1) / G) exp_fill(a, smem, 0, 8); }
}
__device__ __forceinline__ void p3_outproj(AP a, unsigned char* smem, LAS unsigned char* lds, int l) {
    SchedOutProj S; S.ws = a->ws; S.l = l; S.G = gridDim.x; S.me = vblock();
    g256::gemm_phase(lds, 1024, S);
    if (l == 0) {
        const bf16_t* W = (const bf16_t*)(a->ws + WS_WOUT);
        for (int u = blockIdx.x; u < 64; u += gridDim.x) { const int rt = u >> 3, ct = u & 7;
            EpiBf16 E; E.C = (bf16_t*)(a->ws + WS_Y) + (size_t)(NLAT + rt * 128) * D + ct * 128; E.ld = D; E.scale = 1.0f;
            const bf16_t* B0 = W + (size_t)(ct * 128) * 1024;
            gemm_tile<128, false, EpiBf16>(lds, (const bf16_t*)(a->ws + WS_CAT) + (size_t)(NLAT + rt * 128) * D, D, nullptr, 128, B0, B0 + (size_t)64 * 1024, 1024, 1024, E); }
        if (blockIdx.x >= 64) exp_fill(a, smem, 0, 3);
    }
}
__device__ __forceinline__ void p6_gateup(AP a, unsigned char* smem, LAS unsigned char* lds, int l) {
    LAS int* blk = (LAS int*)(lds + MISC_OFF + 256);
    moe_table(a, l, blk);
    LAS int* ridx = (LAS int*)(lds + RIDX_OFF);
    const int tid = tid_opaque(), G = gridDim.x, me = vblock(), nu = blk[32] * 4;
    const int* slotT = (const int*)(a->ws + WS_SLOTT);
    for (int i = 0; i < 8; ++i) { const int idx = i * G + me; if (idx >= nu) break;
        const int rb = idx >> 2; int e = 0; for (int q = 1; q < 32; ++q) if (blk[q] <= rb) e = q;
        const int valid = min(256, blk[33 + e] - (rb - blk[e]) * 256);
        if (tid < 256) ridx[i * 256 + tid] = (tid < valid) ? slotT[rb * 256 + tid] : 0; }
    __syncthreads();
    SchedGateUp S; S.ws = a->ws; S.blk = blk; S.tot = blk + 33; S.ridx_lds = ridx; S.G = G; S.me = me; S.l = l;
    g256::gemm_phase(lds, 512, S);
    __syncthreads();
    if (l == 0 && units_of(nu, me, G) < (nu + G - 1) / G) exp_fill(a, smem, 1, 4);
}
__device__ __forceinline__ void p7_down(AP a, unsigned char* smem, LAS unsigned char* lds, int l) {
    LAS int* blk = (LAS int*)(lds + MISC_OFF + 256);
    moe_table(a, l, blk);
    SchedDown S; S.ws = a->ws; S.blk = blk; S.G = gridDim.x; S.me = vblock(); S.l = l;
    g256::gemm_phase(lds, 256, S);
    __syncthreads();
    { const int nu = uni(blk[32]) * 4, G = gridDim.x; if (l == 0 && units_of(nu, S.me, G) < (nu + G - 1) / G) exp_fill(a, smem, 1, 2); }
}

__device__ __forceinline__ void p8_ln2(AP a, unsigned char* lds, int l) {
    const int tid = tid_opaque(), lane = tid & 63, w = tid >> 6;
    const int ntok = (l == 0) ? NTOK : NLAT;
    const float* mod = (const float*)(a->ws + WS_MOD) + (size_t)l * 5 * 6144;
    const float* modn = (const float*)(a->ws + WS_MOD) + (size_t)5 * 6144;
    const float* X1 = (const float*)(a->ws + WS_X1);
    const bf16_t* YS = (const bf16_t*)(a->ws + WS_YS);
    const int* tokS = (const int*)(a->ws + WS_TOKS); const float* tokG = (const float*)(a->ws + WS_TOKG);
    f32x4* Lgb = (f32x4*)lds;
    __syncthreads();
    Lgb[tid] = (tid < 256) ? *(const f32x4*)(a->in[21] + l * 1024 + tid * 4) : *(const f32x4*)(a->in[22] + l * 1024 + (tid - 256) * 4);
    __syncthreads();
    int mrow = -1; f32x4 mg[4], nsh[4], nsc[4];
    const int tstep = gridDim.x * 8;
    int t = blockIdx.x * 8 + w;
    int ns0 = 0, ns1 = 0; float nga = 0.f, ngb = 0.f;
    f32x4 nx[4]; u32x2 nya[4], nyb[4];
    float cga = 0.f, cgb = 0.f;
    if (t < ntok) { const int s0 = tokS[2 * t], s1 = tokS[2 * t + 1]; cga = tokG[2 * t]; cgb = tokG[2 * t + 1];
#pragma unroll
        for (int i = 0; i < 4; ++i) { const int c = 256 * i + 4 * lane; nx[i] = *(const f32x4*)(X1 + (size_t)t * D + c); nya[i] = *(const u32x2*)(YS + (size_t)s0 * D + c); nyb[i] = *(const u32x2*)(YS + (size_t)s1 * D + c); } }
    if (t + tstep < ntok) { ns0 = tokS[2 * (t + tstep)]; ns1 = tokS[2 * (t + tstep) + 1]; nga = tokG[2 * (t + tstep)]; ngb = tokG[2 * (t + tstep) + 1]; }
    for (; t < ntok; t += tstep) {
        const int mr = (t < NLAT) ? (t >> 12) : 4;
        if (mr != mrow) { mrow = mr; const float* m = mod + (size_t)mr * 6144; const float* mn = modn + (size_t)mr * 6144;
#pragma unroll
            for (int i = 0; i < 4; ++i) { const int c = 256 * i + 4 * lane; mg[i] = *(const f32x4*)(m + 5120 + c); if (l == 0) { nsh[i] = *(const f32x4*)(mn + c); nsc[i] = *(const f32x4*)(mn + 1024 + c); } } }
        f32x4 v[4];
#pragma unroll
        for (int i = 0; i < 4; ++i) { const f32x4 gv = mg[i];
            const u32x2 ya = nya[i], yb = nyb[i];
            const float f0 = cga * lo2f(ya.x) + cgb * lo2f(yb.x), f1 = cga * hi2f(ya.x) + cgb * hi2f(yb.x), f2 = cga * lo2f(ya.y) + cgb * lo2f(yb.y), f3 = cga * hi2f(ya.y) + cgb * hi2f(yb.y);
            v[i][0] = RES_ALPHA * nx[i][0] + gv[0] * f0; v[i][1] = RES_ALPHA * nx[i][1] + gv[1] * f1; v[i][2] = RES_ALPHA * nx[i][2] + gv[2] * f2; v[i][3] = RES_ALPHA * nx[i][3] + gv[3] * f3; }
        {   const int tn = t + tstep, tn2 = t + 2 * tstep;
            if (tn < ntok) {
#pragma unroll
                for (int i = 0; i < 4; ++i) { const int c = 256 * i + 4 * lane; nx[i] = *(const f32x4*)(X1 + (size_t)tn * D + c); nya[i] = *(const u32x2*)(YS + (size_t)ns0 * D + c); nyb[i] = *(const u32x2*)(YS + (size_t)ns1 * D + c); }
                cga = nga; cgb = ngb; }
            if (tn2 < ntok) { ns0 = tokS[2 * tn2]; ns1 = tokS[2 * tn2 + 1]; nga = tokG[2 * tn2]; ngb = tokG[2 * tn2 + 1]; } }
        float mean, rstd; ln_stats(v, mean, rstd);
        float* dst = (l == 0) ? (float*)(a->ws + WS_XC) + (size_t)t * D : a->out + (size_t)t * D;
#pragma unroll
        for (int i = 0; i < 4; ++i) { const int c = 256 * i + 4 * lane; const f32x4 gg = Lgb[64 * i + lane], bb = Lgb[256 + 64 * i + lane];
#pragma unroll
            for (int e = 0; e < 4; ++e) v[i][e] = (v[i][e] - mean) * rstd * gg[e] + bb[e];
            *(f32x4*)(dst + c) = v[i]; }
        if (l == 0) {
            ln_stats(v, mean, rstd);
            bf16_t* H = (bf16_t*)(a->ws + WS_H);
#pragma unroll
            for (int i = 0; i < 4; ++i) { const int c = 256 * i + 4 * lane; const f32x4 sh = nsh[i], sc = nsc[i];
                f32x4 o;
#pragma unroll
                for (int e = 0; e < 4; ++e) o[e] = (v[i][e] - mean) * rstd * (1.0f + sc[e]) + sh[e];
                u32x2 pk; pk.x = pack2(o[0], o[1]); pk.y = pack2(o[2], o[3]); *(u32x2*)(H + (size_t)t * D + c) = pk; }
        }
    }
}

constexpr int N_PHASES = 18;
template <int P> __device__ __forceinline__ void run_phase(AP a, unsigned char* smem, LAS unsigned char* lds, int l) {
    asm volatile("" : "+s"(a));
    if (P == 0) p0_prologue(a, smem);
    if (P == 1) p_lnmod0(a);
    if (P == 2) p1_inproj(a, smem, lds, l);
    if (P == 3) p2_mix(a, smem, lds, l);
    if (P == 4) p3_outproj(a, smem, lds, l);
    if (P == 5) p4_ln1_router(a, smem, l);
    if (P == 6) p5_dispatch(a, smem, l);
    if (P == 7) p6_gateup(a, smem, lds, l);
    if (P == 8) p7_down(a, smem, lds, l);
    if (P == 9) p8_ln2(a, smem, l);
}
#if N_LAUNCH_MODE == 1
__global__ void __launch_bounds__(NT, 2) fwd(Args a) {
    extern __shared__ __attribute__((aligned(16))) unsigned char smem[];
    LAS unsigned char* lds = (LAS unsigned char*)smem;
    if (threadIdx.x < 4) ((volatile LAS unsigned*)(lds + MISC_OFF + 768))[threadIdx.x] = 0u;
    __syncthreads();
    XcdBarrier bar = xcd_barrier_post((unsigned*)(a.ws + WS_BAR), (volatile LAS unsigned*)(lds + MISC_OFF + 768));
    AP ap = (AP)__builtin_amdgcn_kernarg_segment_ptr();
#define PROBE(P, l) do { if (PROBE_MASK & (1 << (P))) { for (int _r = 0; _r < 2; ++_r) { xcd_barrier(bar); run_phase<P>(ap, smem, lds, l); } } } while (0)
    run_phase<0>(ap, smem, lds, 0); PROBE(0, 0); xcd_barrier(bar);
    run_phase<1>(ap, smem, lds, 0); PROBE(1, 0); xcd_barrier(bar);
    for (int l = 0; l < 2; ++l) {
        run_phase<2>(ap, smem, lds, l); PROBE(2, l); xcd_barrier(bar);
        run_phase<3>(ap, smem, lds, l); PROBE(3, l); xcd_barrier(bar);
        run_phase<4>(ap, smem, lds, l); PROBE(4, l); xcd_barrier(bar);
        run_phase<5>(ap, smem, lds, l); PROBE(5, l); xcd_barrier(bar);
        run_phase<6>(ap, smem, lds, l); PROBE(6, l); xcd_barrier(bar);
        run_phase<7>(ap, smem, lds, l); PROBE(7, l); xcd_barrier(bar);
        run_phase<8>(ap, smem, lds, l); PROBE(8, l); xcd_barrier(bar);
        run_phase<9>(ap, smem, lds, l); PROBE(9, l); if (l == 0) xcd_barrier(bar);
    }
}
#else
template <int P> __global__ void __launch_bounds__(NT, 2) k_phase(Args a) {
    extern __shared__ __attribute__((aligned(16))) unsigned char smem[];
    LAS unsigned char* lds = (LAS unsigned char*)smem;
    AP ap = (AP)__builtin_amdgcn_kernarg_segment_ptr();
    run_phase<P>(ap, smem, lds, ap->ph_lo);
}
template <int P> static void launch_phase(Args a, int l, int grid, hipStream_t stream) {
    static bool attr = false;
    if (!attr) { (void)hipFuncSetAttribute((const void*)k_phase<P>, hipFuncAttributeMaxDynamicSharedMemorySize, LDS_BYTES); attr = true; }
    a.ph_lo = l; a.ph_hi = P;
    hipLaunchKernelGGL(k_phase<P>, dim3(grid), dim3(NT), LDS_BYTES, stream, a);
}
#endif

extern "C" void kernel_launch(void* const* d_in, const int* in_sizes, int n_in, void* d_out, int out_size, void* d_ws, size_t ws_size, hipStream_t stream) {
    static int grid = 0;
    if (grid == 0) {
        if (n_in != 23 || out_size != NLAT * D || ws_size < WS_END) { fprintf(stderr, "kernel_launch: unexpected shapes (n_in %d, out %d, ws %zu, need %zu)\n", n_in, out_size, ws_size, (size_t)WS_END); grid = -1; return; }
        int dev = 0, cus = 0;
        if (hipGetDevice(&dev) != hipSuccess || hipDeviceGetAttribute(&cus, hipDeviceAttributeMultiprocessorCount, dev) != hipSuccess) { grid = -1; return; }
#if N_LAUNCH_MODE == 1
        int per_cu = 0;
        if (hipFuncSetAttribute((const void*)fwd, hipFuncAttributeMaxDynamicSharedMemorySize, LDS_BYTES) != hipSuccess) { fprintf(stderr, "kernel_launch: hipFuncSetAttribute failed\n"); grid = -1; return; }
        if (hipOccupancyMaxActiveBlocksPerMultiprocessor(&per_cu, (const void*)fwd, NT, LDS_BYTES) != hipSuccess || per_cu < 1) { fprintf(stderr, "kernel_launch: occupancy query says %d\n", per_cu); }
        (void)hipGetLastError();
#endif
        grid = cus; if (grid > MAXG) grid = MAXG;
    }
    if (grid < 0) return;
    (void)hipMemsetAsync((char*)d_ws + WS_BAR, 0, 16384 + 256, stream);
    Args a{};
    for (int i = 0; i < 23; ++i) a.in[i] = (const float*)d_in[i];
    a.out = (float*)d_out; a.ws = (unsigned char*)d_ws;
#if N_LAUNCH_MODE == 1
    a.ph_lo = 0; a.ph_hi = N_PHASES;
    hipLaunchKernelGGL(fwd, dim3(grid), dim3(NT), LDS_BYTES, stream, a);
#else
    launch_phase<0>(a, 0, grid, stream);
    launch_phase<1>(a, 0, grid, stream);
    for (int l = 0; l < 2; ++l) {
        launch_phase<2>(a, l, grid, stream); launch_phase<3>(a, l, grid, stream); launch_phase<4>(a, l, grid, stream); launch_phase<5>(a, l, grid, stream);
        launch_phase<6>(a, l, grid, stream); launch_phase<7>(a, l, grid, stream); launch_phase<8>(a, l, grid, stream); launch_phase<9>(a, l, grid, stream);
    }
#endif
}
```

```cpp
#include <hip/hip_runtime.h>
#include <stdint.h>
#include <stdio.h>

#ifndef PROBE_MASK
#define PROBE_MASK 0
#endif
#ifndef PROBE_FFT_REP
#define PROBE_FFT_REP 1
#endif
#ifndef PROBE_MIX_REP
#define PROBE_MIX_REP 1
#endif
#ifndef PROBE_SGU_REP
#define PROBE_SGU_REP 1
#endif
#ifndef N_LAUNCH_MODE
#define N_LAUNCH_MODE 1
#endif

#define LAS __attribute__((address_space(3)))
typedef unsigned short bf16_t;
typedef short bf16x8 __attribute__((ext_vector_type(8)));
typedef float f32x4 __attribute__((ext_vector_type(4)));
typedef unsigned u32x4 __attribute__((ext_vector_type(4)));
typedef unsigned u32x2 __attribute__((ext_vector_type(2)));
typedef float f32x2 __attribute__((ext_vector_type(2)));
typedef int i32x4 __attribute__((ext_vector_type(4)));

constexpr int D = 1024, NBATCH = 4, SEQ = 4096, CTXL = 256;
constexpr int NLAT = NBATCH * SEQ, NCTX = NBATCH * CTXL, NTOK = NLAT + NCTX;
constexpr int ZC = 1792;
constexpr int NEXP = 32, DEXP = 512;
constexpr int NSLOT = 2 * NTOK + NEXP * 256;
constexpr int NT = 512;
constexpr int MAXG = 512;
constexpr float RES_ALPHA = 1.41421356237309515f;
constexpr int MISC_OFF = 155648;
constexpr int RIDX_OFF = 131072;
constexpr int LDS_BYTES = MISC_OFF + 1024;

constexpr size_t WS_BAR   = 0;
constexpr size_t WS_CNT   = 16384;
constexpr size_t WS_BCNT  = WS_CNT + 256;
constexpr size_t WS_MOD   = WS_BCNT + (size_t)2 * MAXG * 32 * 4;
constexpr size_t WS_ROPE  = WS_MOD + (size_t)2 * 5 * 6144 * 4;
constexpr size_t WS_TOKE  = WS_ROPE + 8192;
constexpr size_t WS_TOKR  = WS_TOKE + (size_t)NTOK * 8;
constexpr size_t WS_TOKS  = WS_TOKR + (size_t)NTOK * 8;
constexpr size_t WS_TOKG  = WS_TOKS + (size_t)NTOK * 8;
constexpr size_t WS_SLOTT = WS_TOKG + (size_t)NTOK * 8;
constexpr size_t WS_WIN   = WS_SLOTT + (size_t)NSLOT * 4;
constexpr size_t WS_WOUT  = WS_WIN + (size_t)2 * ZC * 1024 * 2;
constexpr size_t WS_WSGU  = WS_WOUT + (size_t)2 * 1024 * 1024 * 2;
constexpr size_t WS_DFTC  = WS_WSGU + (size_t)2 * 4 * 128 * 128 * 2;
constexpr size_t WS_WEXP  = WS_DFTC + (size_t)256 * 512 * 2;
constexpr size_t EXPMAT   = (size_t)NEXP * 512 * 1024;
constexpr size_t WEXP_LAYER = 3 * EXPMAT;
constexpr size_t WS_X1    = WS_WEXP + 2 * WEXP_LAYER;
constexpr size_t WS_XC    = WS_X1 + (size_t)NTOK * D * 4;
constexpr size_t WS_H     = WS_XC + (size_t)NTOK * D * 4;
constexpr size_t WS_R     = WS_H + (size_t)NTOK * D * 2;
constexpr size_t WS_Z     = WS_R;
constexpr size_t WS_AT    = WS_Z + (size_t)NTOK * ZC * 2;
constexpr size_t WS_ATC   = WS_AT + (size_t)4 * 256 * 8192 * 2;
constexpr size_t WS_VT    = WS_ATC + (size_t)4 * 256 * 512 * 2;
constexpr size_t WS_VTC   = WS_VT + (size_t)4 * 2 * 64 * 4096 * 2;
constexpr size_t WS_CAT   = WS_VTC + (size_t)4 * 2 * 64 * 256 * 2;
constexpr size_t WS_REND  = WS_CAT + (size_t)NTOK * D * 2;
constexpr size_t WS_Y     = WS_R;
constexpr size_t WS_HID   = WS_R;
constexpr size_t WS_YS    = WS_HID + (size_t)NSLOT * DEXP * 2;
constexpr size_t WS_REND2 = (WS_YS + (size_t)NSLOT * D * 2 > WS_REND) ? WS_YS + (size_t)NSLOT * D * 2 : WS_REND;
constexpr size_t WS_H8    = (WS_REND2 + 255) & ~(size_t)255;
constexpr size_t WS_END   = WS_H8 + (size_t)NTOK * D;
static_assert(WS_Y + (size_t)NTOK * D * 4 <= WS_CAT, "Y must not reach CAT");
static_assert(WS_WIN % 256 == 0 && WS_DFTC % 256 == 0 && WS_WEXP % 256 == 0 && WS_X1 % 256 == 0 && WS_H % 256 == 0 && WS_R % 256 == 0 && WS_AT % 256 == 0 && WS_CAT % 256 == 0 && WS_YS % 256 == 0, "alignment");

struct Args { const float* in[23]; float* out; unsigned char* ws; int ph_lo, ph_hi; };
#define CAS __attribute__((address_space(4)))
typedef const CAS Args* AP;

#define XB_TMO      128
#define XB_XCNT(j)  (256  + 64 * (j))
#define XB_XSUB(j)  (1280 + 64 * (j))
#define XB_XGEN(j)  (2304 + 64 * (j))
#define XB_TOP      3328
#define XB_TOPGEN   3392
#define XCD_BAR_WORDS 3456
#define XB_SPIN_CAP (1u << 18)

__device__ __forceinline__ unsigned xb_ld(unsigned* p)              { return __hip_atomic_load(p, __ATOMIC_RELAXED, __HIP_MEMORY_SCOPE_AGENT); }
__device__ __forceinline__ unsigned xb_add(unsigned* p, unsigned v) { return __hip_atomic_fetch_add(p, v, __ATOMIC_RELAXED, __HIP_MEMORY_SCOPE_AGENT); }
__device__ __forceinline__ unsigned xb_xcc_id() { return (unsigned)__builtin_amdgcn_s_getreg((3 << 11) | 20) & 0xFu; }
#define XB_SPIN(cond, bar) do { unsigned _sp = 0; while (cond) { __builtin_amdgcn_s_sleep(1); \
    if ((++_sp & 255u) == 0u) { if (xb_ld(&(bar)[XB_TMO])) break; if (_sp > XB_SPIN_CAP) { atomicAdd(&(bar)[XB_TMO], 1u); break; } } } } while (0)

struct XcdBarrier { unsigned* bar; unsigned x; volatile LAS unsigned* st; };

__device__ __forceinline__ XcdBarrier xcd_barrier_post(unsigned* bar, volatile LAS unsigned* st) {
    XcdBarrier b; b.bar = bar; b.x = (unsigned)__builtin_amdgcn_readfirstlane((int)xb_xcc_id()); b.st = st;
    if (threadIdx.x == 0) (void)xb_add(&bar[XB_XCNT(b.x)], 1u);
    return b;
}
__device__ __forceinline__ void xcd_barrier_complete(unsigned* bar, unsigned x, unsigned& nloc, unsigned& nx) {
    const unsigned G = gridDim.x * gridDim.y * gridDim.z;
    unsigned sum, cnt, mine, sp = 0u;
    for (;;) {
        sum = 0u; cnt = 0u; mine = 0u;
#pragma unroll
        for (unsigned j = 0; j < 16; ++j) { const unsigned c = xb_ld(&bar[XB_XCNT(j)]); sum += c; cnt += (c > 0u) ? 1u : 0u; mine = (j == x) ? c : mine; }
        if (sum == G) break;
        __builtin_amdgcn_s_sleep(1);
        if ((++sp & 255u) == 0u) { if (xb_ld(&bar[XB_TMO])) break; if (sp > XB_SPIN_CAP) { atomicAdd(&bar[XB_TMO], 1u); break; } }
    }
    nloc = mine > 0u ? mine : 1u; nx = cnt > 0u ? cnt : 1u;
}
__device__ __forceinline__ void xcd_barrier(const XcdBarrier& b) {
    asm volatile("s_waitcnt vmcnt(0)" ::: "memory");
    __syncthreads();
    if (threadIdx.x == 0) {
        unsigned* bar = b.bar;
        unsigned bx = b.x;
        asm volatile("" : "+s"(bar), "+s"(bx));
        __builtin_amdgcn_s_waitcnt(0);
        unsigned nloc = b.st[0], nx = b.st[1];
        if (nloc == 0u) { xcd_barrier_complete(bar, bx, nloc, nx); b.st[0] = nloc; b.st[1] = nx; }
        const unsigned old = xb_add(&bar[XB_XSUB(bx)], 1u);
        const unsigned gen = old / nloc;
        if (old + 1u == (gen + 1u) * nloc) {
            __builtin_amdgcn_fence(__ATOMIC_RELEASE, "agent");
            asm volatile("s_waitcnt vmcnt(0)" ::: "memory");
            const unsigned og = xb_add(&bar[XB_TOP], 1u);
            const unsigned tg = og / nx;
            if (og + 1u == (tg + 1u) * nx) xb_add(&bar[XB_TOPGEN], 1u);
            else XB_SPIN(xb_ld(&bar[XB_TOPGEN]) == tg, bar);
            __builtin_amdgcn_fence(__ATOMIC_ACQUIRE, "agent");
            xb_add(&bar[XB_XGEN(bx)], 1u);
            asm volatile("s_waitcnt vmcnt(0)" ::: "memory");
        } else {
            XB_SPIN(xb_ld(&bar[XB_XGEN(bx)]) == gen, bar);
            __builtin_amdgcn_fence(__ATOMIC_ACQUIRE, "agent");
            asm volatile("s_waitcnt vmcnt(0)" ::: "memory");
        }
    }
    __syncthreads();
}

__device__ __forceinline__ int tid_opaque() { int t = threadIdx.x; asm volatile("" : "+v"(t)); return t; }
__device__ __forceinline__ float bf2f(bf16_t v) { return __uint_as_float(((unsigned)v) << 16); }
__device__ __forceinline__ bf16_t f2bf(float f) { return __builtin_bit_cast(unsigned short, (__bf16)f); }
typedef __bf16 hwbf16x2 __attribute__((ext_vector_type(2)));
__device__ __forceinline__ unsigned pack2(float a, float b) { return __builtin_bit_cast(unsigned, __builtin_convertvector((f32x2){a, b}, hwbf16x2)); }
__device__ __forceinline__ unsigned pack4_fp8(float a, float b, float c, float d) {
    a = __builtin_amdgcn_fmed3f(a, -448.f, 448.f); b = __builtin_amdgcn_fmed3f(b, -448.f, 448.f); c = __builtin_amdgcn_fmed3f(c, -448.f, 448.f); d = __builtin_amdgcn_fmed3f(d, -448.f, 448.f);
    int p = __builtin_amdgcn_cvt_pk_fp8_f32(a, b, 0, false); p = __builtin_amdgcn_cvt_pk_fp8_f32(c, d, p, true); return (unsigned)p; }
__device__ __forceinline__ float lo2f(unsigned w) { return __uint_as_float(w << 16); }
__device__ __forceinline__ float hi2f(unsigned w) { return __uint_as_float(w & 0xffff0000u); }
template <int CTRL> __device__ __forceinline__ float dpp_mov(float v) { return __builtin_bit_cast(float, __builtin_amdgcn_update_dpp(0, __builtin_bit_cast(int, v), CTRL, 0xf, 0xf, true)); }
__device__ __forceinline__ float row_sum16(float v) {
    v += dpp_mov<0xB1>(v);
    v += dpp_mov<0x4E>(v);
    v += dpp_mov<0x141>(v);
    v += dpp_mov<0x140>(v);
    return v;
}
__device__ __forceinline__ float row_max16(float v) {
    v = fmaxf(v, dpp_mov<0xB1>(v)); v = fmaxf(v, dpp_mov<0x4E>(v)); v = fmaxf(v, dpp_mov<0x141>(v)); v = fmaxf(v, dpp_mov<0x140>(v));
    return v;
}
__device__ __forceinline__ float wave_sum(float v) {
    v = row_sum16(v);
    const int iv = __builtin_bit_cast(int, v);
    const float a0 = __builtin_bit_cast(float, __builtin_amdgcn_readlane(iv, 0)), a1 = __builtin_bit_cast(float, __builtin_amdgcn_readlane(iv, 16));
    const float a2 = __builtin_bit_cast(float, __builtin_amdgcn_readlane(iv, 32)), a3 = __builtin_bit_cast(float, __builtin_amdgcn_readlane(iv, 48));
    return (a0 + a1) + (a2 + a3);
}
__device__ __forceinline__ float gelu_erf(float v) {
    const float t = __builtin_amdgcn_rcpf(fabsf(v) * 0.2316418882f + 1.0f);
    float q = t * 0.5307027145f + (-0.7265760135f); q = q * t + 0.7107068705f; q = q * t + (-0.142248368f); q = q * t + 0.127414796f; q = q * t;
    const float m = v * (q * __builtin_amdgcn_exp2f((v * v) * (-0.72134752044f)));
    return v < 0.f ? m : v - m;
}
__device__ __forceinline__ float silu_f(float x) { return x * __builtin_amdgcn_rcpf(1.0f + __expf(-x)); }

__device__ __forceinline__ void ln_stats(const f32x4 (&v)[4], float& mean, float& rstd) {
    float s = 0.f;
#pragma unroll
    for (int i = 0; i < 4; ++i) s += (v[i][0] + v[i][1]) + (v[i][2] + v[i][3]);
    s = wave_sum(s); mean = s * (1.0f / 1024.0f);
    float q = 0.f;
#pragma unroll
    for (int i = 0; i < 4; ++i)
#pragma unroll
        for (int e = 0; e < 4; ++e) { const float d = v[i][e] - mean; q += d * d; }
    q = wave_sum(q); rstd = 1.0f / sqrtf(q * (1.0f / 1024.0f) + 1e-6f);
}

template <int BN> struct MfmaLayout {
    static constexpr int FG = BN / 128, NI = 4, NJ = 2 * FG;
    static constexpr bool PAIR8 = false;
    int rbase, cbase;
    __device__ __forceinline__ int row(int i) const { return rbase + 16 * i; }
    __device__ __forceinline__ int col(int jj) const { return (jj / FG) * (BN / 2) + (jj % FG) * 16 + cbase; }
};

__device__ __forceinline__ void glds16(const bf16_t* g, LAS unsigned char* l) {
    __builtin_amdgcn_global_load_lds((const unsigned*)g, (LAS unsigned*)l, 16, 0, 0);
}

template <int BN, bool GATHER, class Epi>
__device__ __forceinline__ void gemm_tile(LAS unsigned char* lds, const bf16_t* A, int lda, const int* rowidx, int valid_rows,
                                          const bf16_t* B0, const bf16_t* B1, int ldb, int K, const Epi& epi) {
    constexpr int A_B = 16384, B_B = BN * 128, STAGE = A_B + B_B, NBL = BN / 64;
    const int tid = tid_opaque(), lane = tid & 63, wid = __builtin_amdgcn_readfirstlane(tid >> 6);
    const bf16_t* ap[2]; const bf16_t* bp[NBL];
#pragma unroll
    for (int i = 0; i < 2; ++i) {
        const int P = i * 512 + tid, row = P >> 3, c = (P & 7) ^ ((row >> 1) & 7);
        size_t ro;
        if (GATHER) ro = (size_t)(row < valid_rows ? rowidx[row] : 0) * (size_t)lda; else ro = (size_t)row * (size_t)lda;
        ap[i] = A + ro + c * 8;
    }
#pragma unroll
    for (int i = 0; i < NBL; ++i) {
        const int P = i * 512 + tid, row = P >> 3, c = (P & 7) ^ ((row >> 1) & 7);
        const bf16_t* base = (row < BN / 2) ? (B0 + (size_t)row * ldb) : (B1 + (size_t)(row - BN / 2) * ldb);
        bp[i] = base + c * 8;
    }
    const int nk = K / 64;
#define GT_STAGE(buf, k0) do { \
        _Pragma("unroll") for (int _i = 0; _i < 2; ++_i) glds16(ap[_i] + (k0), lds + (buf) * STAGE + _i * 8192 + wid * 1024); \
        _Pragma("unroll") for (int _i = 0; _i < NBL; ++_i) glds16(bp[_i] + (k0), lds + (buf) * STAGE + A_B + _i * 8192 + wid * 1024); } while (0)

    typedef MfmaLayout<BN> Lay;
    constexpr int FG = Lay::FG;
    const int fr = lane & 15, g = lane >> 4, wr = wid >> 2, wc = wid & 3;
    Lay lay; lay.rbase = wr * 64 + fr; lay.cbase = wc * 16 * FG + 4 * g;
    f32x4 acc[Lay::NI][Lay::NJ];
#pragma unroll
    for (int i = 0; i < Lay::NI; ++i)
#pragma unroll
        for (int j = 0; j < Lay::NJ; ++j) acc[i][j] = (f32x4){0.f, 0.f, 0.f, 0.f};
    int aoff[4], boff[Lay::NJ];
#pragma unroll
    for (int m = 0; m < 4; ++m) { const int row = wr * 64 + m * 16 + fr; aoff[m] = row * 128 + ((g ^ ((row >> 1) & 7)) << 4); }
#pragma unroll
    for (int jj = 0; jj < Lay::NJ; ++jj) { const int row = (jj / FG) * (BN / 2) + wc * 16 * FG + (jj % FG) * 16 + fr; boff[jj] = A_B + row * 128 + ((g ^ ((row >> 1) & 7)) << 4); }
    GT_STAGE(0, 0);
    asm volatile("s_waitcnt vmcnt(0)" ::: "memory"); __syncthreads();
    for (int kt = 0; kt < nk; ++kt) {
        if (kt + 1 < nk) GT_STAGE((kt + 1) & 1, (kt + 1) * 64);
        const LAS unsigned char* sa = lds + (kt & 1) * STAGE;
#pragma unroll
        for (int ks = 0; ks < 2; ++ks) {
            bf16x8 af[4], bfv[Lay::NJ];
#pragma unroll
            for (int m = 0; m < 4; ++m) af[m] = *(const LAS bf16x8*)(sa + (aoff[m] ^ (ks << 6)));
#pragma unroll
            for (int jj = 0; jj < Lay::NJ; ++jj) bfv[jj] = *(const LAS bf16x8*)(sa + (boff[jj] ^ (ks << 6)));
#pragma unroll
            for (int m = 0; m < 4; ++m)
#pragma unroll
                for (int jj = 0; jj < Lay::NJ; ++jj) acc[m][jj] = __builtin_amdgcn_mfma_f32_16x16x32_bf16(bfv[jj], af[m], acc[m][jj], 0, 0, 0);
        }
        asm volatile("s_waitcnt vmcnt(0)" ::: "memory"); __syncthreads();
    }
    epi.run(acc, lay);
#undef GT_STAGE
}

namespace g256 {
constexpr int BK = 64, HALF = 128, HTB = HALF * BK * 2, STAGE_BYTES = 8 * HTB;
__device__ __forceinline__ int lds_byte(int r, int c) { const int st = (r >> 4) * 2 + (c >> 5), rr = r & 15, cc = c & 31, ob = rr * 64 + cc * 2; return st * 1024 + (ob ^ (((ob >> 9) & 1) << 5)); }
__device__ __forceinline__ int perm32(int rho) { const int n = rho >> 4, i = rho & 15; return 8 * (i >> 2) + 4 * n + (i & 3); }
__device__ __forceinline__ void stage_rc(int b, int& R, int& C) { const int st = b / 1024, sb = b % 1024, swz = sb ^ (((sb >> 9) & 1) << 5); R = (st >> 1) * 16 + swz / 64; C = (st & 1) * 32 + (swz % 64) / 2; }
struct Lay {
    static constexpr int NI = 8, NJ = 4;
    static constexpr bool PAIR8 = true;
    int rbase, cbase;
    __device__ __forceinline__ int row(int i) const { return (i >> 2) * 128 + (i & 3) * 16 + rbase; }
    __device__ __forceinline__ int col(int j) const { return (j >> 1) * 128 + (j & 1) * 4 + cbase; }
};
template <class Epi> struct Unit { const bf16_t* A; const bf16_t* B0; const bf16_t* B1; const LAS int* ridx; int valid; Epi epi; };

template <class Sched>
__device__ __forceinline__ void gemm_phase(LAS unsigned char* lds, const int K, const Sched& S) {
    typedef typename Sched::Epi Epi;
    const int tid = tid_opaque(), wid = __builtin_amdgcn_readfirstlane(tid >> 6), lane = tid & 63, wr = wid >> 2, wc = wid & 3, fr = lane & 15, fq = lane >> 4;
    int nt = K / BK; asm volatile("" : "+s"(nt));
    int sR[2], sC[2];
#pragma unroll
    for (int i = 0; i < 2; ++i) stage_rc(tid * 16 + i * 8192, sR[i], sC[i]);
    unsigned voffB[2];
#pragma unroll
    for (int i = 0; i < 2; ++i) voffB[i] = (unsigned)(((sR[i] & ~31) + perm32(sR[i] & 31)) * K + sC[i]) * 2u;
    const size_t kstep = (size_t)(BK * 2);
    const unsigned ldsw = (unsigned)wid * 1024u;
    const int aoff = lds_byte(wr * 64 + fr, fq * 8), boff = lds_byte(wc * 32 + fr, fq * 8);
#define G2_SA(b, h) (((b) * 2 + (h)) * HTB)
#define G2_SB(b, h) ((4 + (b) * 2 + (h)) * HTB)
#define G2_STAGE(bufoff, gbase, v0, v1) do { \
        __builtin_amdgcn_global_load_lds((const unsigned*)((const char*)(gbase) + (v0)), (LAS unsigned*)(lds + (bufoff) + ldsw), 16, 0, 0); \
        __builtin_amdgcn_global_load_lds((const unsigned*)((const char*)(gbase) + (v1)), (LAS unsigned*)(lds + (bufoff) + ldsw + 8192), 16, 0, 0); } while (0)
#define G2_LDA(dst, b, h) do { _Pragma("unroll") for (int m = 0; m < 4; ++m) _Pragma("unroll") for (int k = 0; k < 2; ++k) dst[m][k] = *(const LAS bf16x8*)(lds + G2_SA(b, h) + aoff + m * 2048 + k * 1024); } while (0)
#define G2_LDB(dst, b, h) do { _Pragma("unroll") for (int n = 0; n < 2; ++n) _Pragma("unroll") for (int k = 0; k < 2; ++k) dst[n][k] = *(const LAS bf16x8*)(lds + G2_SB(b, h) + boff + n * 2048 + k * 1024); } while (0)
#define G2_MMA(ai, bj, At, Bt) do { __builtin_amdgcn_s_setprio(1); _Pragma("unroll") for (int m = 0; m < 4; ++m) _Pragma("unroll") for (int n = 0; n < 2; ++n) _Pragma("unroll") for (int k = 0; k < 2; ++k) { \
        if (Sched::FP8) { const i32x4 _b = __builtin_bit_cast(i32x4, Bt[n][k]), _a = __builtin_bit_cast(i32x4, At[m][k]);     \
            acc[(ai) * 4 + m][(bj) * 2 + n] = __builtin_amdgcn_mfma_f32_16x16x32_fp8_fp8(((long)(unsigned)_b[1] << 32) | (unsigned)_b[0], ((long)(unsigned)_a[1] << 32) | (unsigned)_a[0], acc[(ai) * 4 + m][(bj) * 2 + n], 0, 0, 0); \
            acc[(ai) * 4 + m][(bj) * 2 + n] = __builtin_amdgcn_mfma_f32_16x16x32_fp8_fp8(((long)(unsigned)_b[3] << 32) | (unsigned)_b[2], ((long)(unsigned)_a[3] << 32) | (unsigned)_a[2], acc[(ai) * 4 + m][(bj) * 2 + n], 0, 0, 0); } \
        else acc[(ai) * 4 + m][(bj) * 2 + n] = __builtin_amdgcn_mfma_f32_16x16x32_bf16(Bt[n][k], At[m][k], acc[(ai) * 4 + m][(bj) * 2 + n], 0, 0, 0); } __builtin_amdgcn_s_setprio(0); } while (0)
#define G2_WAIT_V(n) asm volatile("s_waitcnt vmcnt(" #n ")" ::: "memory")
#define G2_WAIT_L(n) asm volatile("s_waitcnt lgkmcnt(" #n ")" ::: "memory")
#define G2_BAR __builtin_amdgcn_s_barrier()
#define G2_SCHED __builtin_amdgcn_sched_barrier(0)
#define G2_VOFFA(U, dst) do { _Pragma("unroll") for (int _h = 0; _h < 2; ++_h) _Pragma("unroll") for (int _i = 0; _i < 2; ++_i) { const int _row = _h * 128 + sR[_i]; \
        int _tok = _row; if (Sched::GATHER) _tok = (_row < (U).valid) ? (U).ridx[_row] : 0; dst[_h][_i] = (unsigned)(_tok * K + sC[_i]) * 2u; } } while (0)
    Unit<Epi> cur, nxt; int ui = 0;
    if (!S.get(0, cur)) return;
    f32x4 acc[8][4];
#pragma unroll
    for (int i = 0; i < 8; ++i)
#pragma unroll
        for (int j = 0; j < 4; ++j) acc[i][j] = (f32x4){0.f, 0.f, 0.f, 0.f};
    bf16x8 At[4][2], B0[2][2], B1[2][2];
    unsigned cvA[2][2], nvA[2][2];
    G2_VOFFA(cur, cvA);
    const char* cA = (const char*)cur.A; const char* cB0 = (const char*)cur.B0; const char* cB1 = (const char*)cur.B1;
    G2_STAGE(G2_SB(0, 0), cB0, voffB[0], voffB[1]); G2_STAGE(G2_SB(0, 1), cB1, voffB[0], voffB[1]); G2_STAGE(G2_SA(0, 0), cA, cvA[0][0], cvA[0][1]); G2_STAGE(G2_SA(0, 1), cA, cvA[1][0], cvA[1][1]);
    if (wr == 1) G2_BAR;
    G2_WAIT_V(2); G2_BAR;
    G2_STAGE(G2_SB(1, 0), cB0 + kstep, voffB[0], voffB[1]); G2_STAGE(G2_SA(1, 0), cA + kstep, cvA[0][0], cvA[0][1]); G2_STAGE(G2_SB(1, 1), cB1 + kstep, voffB[0], voffB[1]);
    G2_WAIT_V(6); G2_BAR;
    for (;;) {
        const bool has_next = S.get(ui + 1, nxt);
        if (Sched::GATHER) {
            if (has_next) { G2_VOFFA(nxt, nvA); }
            else {
#pragma unroll
                for (int h = 0; h < 2; ++h) { nvA[h][0] = cvA[h][0]; nvA[h][1] = cvA[h][1]; } }
        }
        const char* nA = has_next ? (const char*)nxt.A : cA; const char* nB0 = has_next ? (const char*)nxt.B0 : cB0; const char* nB1 = has_next ? (const char*)nxt.B1 : cB1;
#pragma unroll 1
        for (int t = 0; t < nt; t += 2) {
            const bool last = (t == nt - 2);
            const char* a1 = cA + (size_t)(t + 1) * kstep;
            const char* a2 = last ? nA : cA + (size_t)(t + 2) * kstep;
            const char* b20 = last ? nB0 : cB0 + (size_t)(t + 2) * kstep; const char* b21 = last ? nB1 : cB1 + (size_t)(t + 2) * kstep;
#define x00 ((Sched::GATHER && last) ? nvA[0][0] : cvA[0][0])
#define x01 ((Sched::GATHER && last) ? nvA[0][1] : cvA[0][1])
#define x10 ((Sched::GATHER && last) ? nvA[1][0] : cvA[1][0])
#define x11 ((Sched::GATHER && last) ? nvA[1][1] : cvA[1][1])
            G2_LDB(B0, 0, 0); G2_LDB(B1, 0, 1); G2_SCHED; G2_LDA(At, 0, 0); G2_STAGE(G2_SA(1, 1), a1, cvA[1][0], cvA[1][1]);
            G2_WAIT_V(8); G2_WAIT_L(0); G2_BAR; G2_MMA(0, 0, At, B0); G2_MMA(0, 1, At, B1); G2_BAR; G2_SCHED;
            G2_LDA(At, 0, 1); G2_STAGE(G2_SB(0, 0), b20, voffB[0], voffB[1]); G2_STAGE(G2_SB(0, 1), b21, voffB[0], voffB[1]); G2_STAGE(G2_SA(0, 0), a2, x00, x01);
            G2_WAIT_V(8); G2_WAIT_L(0); G2_BAR; G2_MMA(1, 0, At, B0); G2_MMA(1, 1, At, B1); G2_BAR; G2_SCHED;
            G2_LDB(B0, 1, 0); G2_LDB(B1, 1, 1); G2_SCHED; G2_LDA(At, 1, 0); G2_STAGE(G2_SA(0, 1), a2, x10, x11);
            G2_WAIT_V(8); G2_WAIT_L(0); G2_BAR; G2_MMA(0, 0, At, B0); G2_MMA(0, 1, At, B1); G2_BAR; G2_SCHED;
            G2_LDA(At, 1, 1); G2_STAGE(G2_SB(1, 0), b20 + kstep, voffB[0], voffB[1]); G2_STAGE(G2_SB(1, 1), b21 + kstep, voffB[0], voffB[1]); G2_STAGE(G2_SA(1, 0), a2 + kstep, x00, x01);
            G2_WAIT_V(8); G2_WAIT_L(0); G2_BAR; G2_MMA(1, 0, At, B0); G2_MMA(1, 1, At, B1); G2_BAR; G2_SCHED;
        }
        if (wr == 0) G2_BAR;
        { Lay lay; int rbv = wr * 64 + fr, cbv = wc * 32 + 8 * fq; asm volatile("" : "+v"(rbv), "+v"(cbv));
          lay.rbase = rbv; lay.cbase = cbv; cur.epi.run(acc, lay); }
        if (!has_next) break;
#pragma unroll
        for (int i = 0; i < 8; ++i)
#pragma unroll
            for (int j = 0; j < 4; ++j) acc[i][j] = (f32x4){0.f, 0.f, 0.f, 0.f};
        cur = nxt; cA = nA; cB0 = nB0; cB1 = nB1; ++ui;
        if (wr == 1) G2_BAR;
        if (Sched::GATHER) {
#pragma unroll
            for (int h = 0; h < 2; ++h) { cvA[h][0] = nvA[h][0]; cvA[h][1] = nvA[h][1]; } }
    }
#undef x00
#undef x01
#undef x10
#undef x11
    G2_WAIT_V(0);
    G2_BAR;
#undef G2_SA
#undef G2_SB
#undef G2_STAGE
#undef G2_LDA
#undef G2_LDB
#undef G2_MMA
#undef G2_WAIT_V
#undef G2_WAIT_L
#undef G2_BAR
#undef G2_SCHED
#undef G2_VOFFA
}
}

struct EpiF32 {
    float* C; int ld;
    template <class L> __device__ __forceinline__ void run(const f32x4 (&acc)[L::NI][L::NJ], const L& lay) const {
#pragma unroll
        for (int i = 0; i < L::NI; ++i)
#pragma unroll
            for (int j = 0; j < L::NJ; ++j) *(f32x4*)(C + (size_t)lay.row(i) * ld + lay.col(j)) = acc[i][j];
    }
};
struct EpiBf16 {
    bf16_t* C; int ld; float scale;
    template <class L> __device__ __forceinline__ void run(const f32x4 (&acc)[L::NI][L::NJ], const L& lay) const {
#pragma unroll
        for (int i = 0; i < L::NI; ++i) {
            if (L::PAIR8) {
#pragma unroll
                for (int j = 0; j < L::NJ; j += 2) { const f32x4 p = acc[i][j] * scale, q = acc[i][j + 1] * scale; u32x4 w; w.x = pack2(p[0], p[1]); w.y = pack2(p[2], p[3]); w.z = pack2(q[0], q[1]); w.w = pack2(q[2], q[3]);
                    *(u32x4*)(C + (size_t)lay.row(i) * ld + lay.col(j)) = w; }
            } else {
#pragma unroll
                for (int j = 0; j < L::NJ; ++j) { const f32x4 p = acc[i][j] * scale; u32x2 w; w.x = pack2(p[0], p[1]); w.y = pack2(p[2], p[3]);
                    *(u32x2*)(C + (size_t)lay.row(i) * ld + lay.col(j)) = w; }
            }
        }
    }
};
struct EpiFp8 {
    unsigned char* C; int ld; float scale;
    template <class L> __device__ __forceinline__ void run(const f32x4 (&acc)[L::NI][L::NJ], const L& lay) const {
        static_assert(L::PAIR8, "written for the paired-column layout");
#pragma unroll
        for (int i = 0; i < L::NI; ++i)
#pragma unroll
            for (int j = 0; j < L::NJ; j += 2) { const f32x4 p = acc[i][j] * scale, q = acc[i][j + 1] * scale; u32x2 w; w.x = pack4_fp8(p[0], p[1], p[2], p[3]); w.y = pack4_fp8(q[0], q[1], q[2], q[3]);
                *(u32x2*)(C + (size_t)lay.row(i) * ld + lay.col(j)) = w; }
    }
};
struct EpiGateUp8 {
    unsigned char* C; int ld;
    template <class L> __device__ __forceinline__ void run(const f32x4 (&acc)[L::NI][L::NJ], const L& lay) const {
        static_assert(L::PAIR8 && L::NJ == 4, "written for the paired-column 256x256 layout");
#pragma unroll
        for (int i = 0; i < L::NI; ++i) {
            const f32x4 g0 = acc[i][0] * (1.0f / 32.0f), g1 = acc[i][1] * (1.0f / 32.0f), u0 = acc[i][2] * (1.0f / 32.0f), u1 = acc[i][3] * (1.0f / 32.0f);
            u32x2 w; w.x = pack4_fp8(silu_f(g0[0]) * u0[0], silu_f(g0[1]) * u0[1], silu_f(g0[2]) * u0[2], silu_f(g0[3]) * u0[3]);
            w.y = pack4_fp8(silu_f(g1[0]) * u1[0], silu_f(g1[1]) * u1[1], silu_f(g1[2]) * u1[2], silu_f(g1[3]) * u1[3]);
            *(u32x2*)(C + (size_t)lay.row(i) * ld + lay.col(0)) = w;
        }
    }
};
struct EpiGateUp {
    bf16_t* C; int ld;
    template <class L> __device__ __forceinline__ void run(const f32x4 (&acc)[L::NI][L::NJ], const L& lay) const {
#pragma unroll
        for (int i = 0; i < L::NI; ++i) {
            if (L::PAIR8 && L::NJ == 4) {
                const f32x4 g0 = acc[i][0], g1 = acc[i][1], u0 = acc[i][2], u1 = acc[i][3];
                u32x4 w; w.x = pack2(silu_f(g0[0]) * u0[0], silu_f(g0[1]) * u0[1]); w.y = pack2(silu_f(g0[2]) * u0[2], silu_f(g0[3]) * u0[3]);
                w.z = pack2(silu_f(g1[0]) * u1[0], silu_f(g1[1]) * u1[1]); w.w = pack2(silu_f(g1[2]) * u1[2], silu_f(g1[3]) * u1[3]);
                *(u32x4*)(C + (size_t)lay.row(i) * ld + lay.col(0)) = w;
            } else {
#pragma unroll
                for (int j = 0; j < L::NJ / 2; ++j) { const f32x4 gt = acc[i][j], up = acc[i][j + L::NJ / 2];
                    u32x2 w; w.x = pack2(silu_f(gt[0]) * up[0], silu_f(gt[1]) * up[1]); w.y = pack2(silu_f(gt[2]) * up[2], silu_f(gt[3]) * up[3]);
                    *(u32x2*)(C + (size_t)lay.row(i) * ld + lay.col(j)) = w; }
            }
        }
    }
};
struct EpiInProj {
    bf16_t* Zt;
    bf16_t* tF;
    bf16_t* tV;
    int n0, pos0, n;
    template <class L> __device__ __forceinline__ void run(const f32x4 (&acc)[L::NI][L::NJ], const L& lay) const {
        static_assert(L::PAIR8, "written for the paired-column layout");
#pragma unroll
        for (int i = 0; i < L::NI; ++i)
#pragma unroll
            for (int j = 0; j < L::NJ; j += 2) {
                const int r = lay.row(i), cl = lay.col(j), c = n0 + cl;
                const f32x4 v0 = acc[i][j], v1 = acc[i][j + 1];
                if (c < 512) {
                    const int part = c >> 8, ch = c & 255;
#pragma unroll
                    for (int e = 0; e < 4; ++e) { tF[((size_t)(ch + e) * 2 + part) * n + pos0 + r] = f2bf(v0[e]); tF[((size_t)(ch + 4 + e) * 2 + part) * n + pos0 + r] = f2bf(v1[e]); }
                } else {
                    u32x4 w; w.x = pack2(v0[0], v0[1]); w.y = pack2(v0[2], v0[3]); w.z = pack2(v1[0], v1[1]); w.w = pack2(v1[2], v1[3]);
                    *(u32x4*)(Zt + (size_t)r * ZC + cl) = w;
                    if (c >= 896 && c < 1024) {
#pragma unroll
                        for (int e = 0; e < 4; ++e) { tV[(size_t)(c - 896 + e) * n + pos0 + r] = f2bf(v0[e]); tV[(size_t)(c - 896 + 4 + e) * n + pos0 + r] = f2bf(v1[e]); }
                    }
                }
            }
    }
};

constexpr int U_ADA = 192, U_WIN = 2 * 16 * 28, U_WOUT = 2 * 16 * 16, U_SGU = 32, U_DFT = 256, U_ROPE = 1, U_EXP = 3 * 32 * 32;
constexpr int LDS_SIL = 0, LDS_RED = 20480, LDS_TILE = 32768, LDS_T64 = 49408, LDS_CTAB = 50176;

__device__ __forceinline__ void ada_unit(AP a, unsigned char* lds, int u) {
    float* sil = (float*)(lds + LDS_SIL); float* red = (float*)(lds + LDS_RED);
    const int tid = tid_opaque(), lane = tid & 63, w = tid >> 6;
    const int l = u / 96, cg = u % 96;
    for (int i = tid; i < 5120; i += NT) { const int r = i >> 10, k = i & 1023; const float v = (r < 4) ? a->in[1][r * 1024 + k] : a->in[3][k]; sil[i] = v / (1.0f + expf(-v)); }
    __syncthreads();
    const float* W = a->in[4] + (size_t)l * 1024 * 6144 + cg * 64 + lane;
    float acc[5] = {0.f, 0.f, 0.f, 0.f, 0.f};
#pragma unroll 32
    for (int k = w * 128; k < w * 128 + 128; ++k) { const float wv = W[(size_t)k * 6144];
#pragma unroll
        for (int r = 0; r < 5; ++r) acc[r] += sil[r * 1024 + k] * wv; }
#pragma unroll
    for (int r = 0; r < 5; ++r) red[(w * 5 + r) * 64 + lane] = acc[r];
    __syncthreads();
    if (tid < 320) { const int r = tid >> 6; float s = 0.f;
#pragma unroll
        for (int ww = 0; ww < 8; ++ww) s += red[(ww * 5 + r) * 64 + lane];
        const int j = cg * 64 + lane; ((float*)(a->ws + WS_MOD))[(size_t)(l * 5 + r) * 6144 + j] = s + a->in[5][l * 6144 + j]; }
    __syncthreads();
}

__device__ __forceinline__ void tile_store_T(const float* tile, bf16_t* dst, int ldd) {
    const int tid = tid_opaque(), n = tid >> 3, kc = tid & 7;
    u32x4 w;
    w.x = pack2(tile[(kc * 8 + 0) * 65 + n], tile[(kc * 8 + 1) * 65 + n]); w.y = pack2(tile[(kc * 8 + 2) * 65 + n], tile[(kc * 8 + 3) * 65 + n]);
    w.z = pack2(tile[(kc * 8 + 4) * 65 + n], tile[(kc * 8 + 5) * 65 + n]); w.w = pack2(tile[(kc * 8 + 6) * 65 + n], tile[(kc * 8 + 7) * 65 + n]);
    *(u32x4*)(dst + (size_t)n * ldd + kc * 8) = w;
}
__device__ __forceinline__ void tile_load(float* tile, const float* src, int lds_) {
    const int tid = tid_opaque();
#pragma unroll
    for (int i = 0; i < 2; ++i) { const int row = (tid >> 4) + 32 * i, c4 = (tid & 15) * 4; const f32x4 v = *(const f32x4*)(src + (size_t)row * lds_ + c4);
        tile[row * 65 + c4 + 0] = v[0]; tile[row * 65 + c4 + 1] = v[1]; tile[row * 65 + c4 + 2] = v[2]; tile[row * 65 + c4 + 3] = v[3]; }
}

__device__ __forceinline__ void mm64_f32(const float* tA, int lda, const float* tB, int ldb, int K, float* out) {
    const int tid = tid_opaque(), lane = tid & 63, w = tid >> 6, fr = lane & 15, g = lane >> 4, mi = w >> 1, nj = 2 * (w & 1);
    f32x4 acc0 = (f32x4){0.f, 0.f, 0.f, 0.f}, acc1 = (f32x4){0.f, 0.f, 0.f, 0.f};
    const float* pa = tA + (16 * mi + fr) * lda + g; const float* pb = tB + g * ldb + 16 * nj + fr;
#pragma unroll 4
    for (int k0 = 0; k0 < K; k0 += 4) { const float av = pa[k0], b0 = pb[k0 * ldb], b1 = pb[k0 * ldb + 16];
        acc0 = __builtin_amdgcn_mfma_f32_16x16x4f32(av, b0, acc0, 0, 0, 0); acc1 = __builtin_amdgcn_mfma_f32_16x16x4f32(av, b1, acc1, 0, 0, 0); }
#pragma unroll
    for (int r = 0; r < 4; ++r) { out[(16 * mi + 4 * g + r) * 65 + 16 * nj + fr] = acc0[r]; out[(16 * mi + 4 * g + r) * 65 + 16 * nj + 16 + fr] = acc1[r]; }
}

__device__ __forceinline__ void win_unit(AP a, unsigned char* lds, int u) {
    float* tile = (float*)(lds + LDS_TILE); float* T = (float*)(lds + LDS_T64);
    const int tid = tid_opaque();
    const int l = u / 448, r = u % 448, kb = r / 28, nb = r % 28;
    const float* Win = a->in[6] + (size_t)l * 1024 * 1536;
    const int srccol = (nb >= 8) ? nb * 64 - 256 : (nb & 3) * 64;
    tile_load(tile, Win + (size_t)(kb * 64) * 1536 + srccol, 1536);
    if (nb < 8 && tid < 64) { T[tid] = cospif((float)tid / 32.0f); T[64 + tid] = sinpif((float)tid / 32.0f); }
    __syncthreads();
    bf16_t* dst = (bf16_t*)(a->ws + WS_WIN) + ((size_t)l * ZC + nb * 64) * 1024 + kb * 64;
    if (nb >= 8) tile_store_T(tile, dst, 1024);
    else {
        const int part = nb >> 2;
        float* Tm = (float*)(lds + 65536); float* out = (float*)(lds + 98304);
        for (int i = tid; i < 4096; i += NT) { const int c = i >> 6, cp = i & 63; const float t = T[part * 64 + ((c * cp) & 63)]; Tm[i] = (part ? -t : t) * 0.125f; }
        __syncthreads();
        mm64_f32(tile, 65, Tm, 64, 64, out);
        __syncthreads();
        tile_store_T(out, dst, 1024);
    }
    __syncthreads();
}

__device__ __forceinline__ void wout_unit(AP a, unsigned char* lds, int u) {
    float* tile = (float*)(lds + LDS_TILE);
    __syncthreads();
    const int tid = tid_opaque();
    const int l = u / 256, r = u % 256, kb = r / 16, nb = r % 16;
    const float* Wo = a->in[13] + (size_t)l * 1024 * 1024;
    const int n = tid & 63, kq = __builtin_amdgcn_readfirstlane(tid >> 6);
    if (kb < 4) {
        float* tA = (float*)lds; float* tB = (float*)(lds + 65536);
        const float* wf = a->in[7] + (size_t)l * 256 * 256 + (size_t)(kb * 64) * 256;
        __syncthreads();
        f32x4 va[8], vb[8];
#pragma unroll
        for (int i = 0; i < 8; ++i) { const int q = tid + 512 * i; va[i] = *(const f32x4*)(wf + (size_t)q * 4); vb[i] = *(const f32x4*)(Wo + (size_t)(q >> 4) * 1024 + nb * 64 + (q & 15) * 4); }
#pragma unroll
        for (int i = 0; i < 8; ++i) { const int q = tid + 512 * i; *(f32x4*)(tA + (size_t)q * 4) = va[i]; *(f32x4*)(tB + (size_t)q * 4) = vb[i]; }
        __syncthreads();
        tile = (float*)(lds + 133120);
        mm64_f32(tA, 256, tB, 64, 256, tile);
    } else if (kb >= 8 && kb < 12) {
        const int g = kb - 8;
        float* tA = (float*)lds; float* tB = (float*)(lds + 65536);
        const float* wp = a->in[9] + (size_t)(l * 4 + g) * 64 * 64;
        const float* ps = a->in[10] + l * 256 + g * 64;
        f32x4 va[2], vb[2];
#pragma unroll
        for (int i = 0; i < 2; ++i) { const int q = tid + 512 * i; va[i] = *(const f32x4*)(wp + (size_t)q * 4); vb[i] = *(const f32x4*)(Wo + (size_t)(512 + g * 64 + (q >> 4)) * 1024 + nb * 64 + (q & 15) * 4) * ps[q >> 4]; }
#pragma unroll
        for (int i = 0; i < 2; ++i) { const int q = tid + 512 * i; *(f32x4*)(tA + (size_t)q * 4) = va[i]; *(f32x4*)(tB + (size_t)q * 4) = vb[i]; }
        __syncthreads();
        tile = (float*)(lds + 133120);
        mm64_f32(tA, 64, tB, 64, 64, tile);
    } else tile_load(tile, Wo + (size_t)(kb * 64) * 1024 + nb * 64, 1024);
    __syncthreads();
    tile_store_T(tile, (bf16_t*)(a->ws + WS_WOUT) + ((size_t)l * 1024 + nb * 64) * 1024 + kb * 64, 1024);
    __syncthreads();
}

__device__ __forceinline__ void exp_src_dst(AP a, int l, int u, const float*& src, int& srcld, unsigned char*& dst, int& dstld) {
    const int mat = u / 1024, e = (u % 1024) / 32, t = u % 32;
    const int kb = (mat < 2) ? t / 4 : t / 8, nb = (mat < 2) ? t % 4 : t % 8;
    srcld = (mat < 2) ? 512 : 1024; dstld = (mat < 2) ? 1024 : 512;
    src = a->in[18 + mat] + ((size_t)(l * 32 + e) * 512 * 1024) + (size_t)(kb * 128) * srcld + nb * 128;
    dst = a->ws + WS_WEXP + (size_t)l * WEXP_LAYER + (size_t)mat * EXPMAT + (size_t)e * 512 * 1024 + (size_t)(nb * 128) * dstld + kb * 128;
}
#define EXP_LOAD(vv, uu) do { exp_src_dst(a, l, (uu), src, srcld, dst, dstld); _Pragma("unroll") for (int _i = 0; _i < 8; ++_i) vv[_i] = *(const f32x4*)(src + (size_t)((tid >> 5) + 16 * _i) * srcld + (tid & 31) * 4); } while (0)
#define EXP_PUT(vv) do { _Pragma("unroll") for (int _i = 0; _i < 8; ++_i) { float* tp = tile + ((tid >> 5) + 16 * _i) * 129 + (tid & 31) * 4; tp[0] = vv[_i][0] * 32.0f; tp[1] = vv[_i][1] * 32.0f; tp[2] = vv[_i][2] * 32.0f; tp[3] = vv[_i][3] * 32.0f; } } while (0)
#define EXP_STORE(dd, ld_) do { const int n = tid >> 2, kq = tid & 3; _Pragma("unroll") for (int j = 0; j < 2; ++j) { const float* tp = tile + (kq * 32 + j * 16) * 129 + n; u32x4 w; \
        w.x = pack4_fp8(tp[0], tp[129], tp[2 * 129], tp[3 * 129]); w.y = pack4_fp8(tp[4 * 129], tp[5 * 129], tp[6 * 129], tp[7 * 129]); \
        w.z = pack4_fp8(tp[8 * 129], tp[9 * 129], tp[10 * 129], tp[11 * 129]); w.w = pack4_fp8(tp[12 * 129], tp[13 * 129], tp[14 * 129], tp[15 * 129]); \
        *(u32x4*)((dd) + (size_t)n * (ld_) + kq * 32 + j * 16) = w; } } while (0)
__device__ __forceinline__ void exp_range(AP a, unsigned char* lds, int l, int u0, int u_end) {
    float* tile = (float*)lds;
    const int tid = tid_opaque();
    __syncthreads();
    if (u0 >= u_end) return;
    const float* src; unsigned char* dst; int srcld, dstld;
    f32x4 va[8], vb[8];
    unsigned char *da, *db = nullptr; int lda_, ldb_ = 0;
    EXP_LOAD(va, u0); da = dst; lda_ = dstld;
    if (u0 + 1 < u_end) { EXP_LOAD(vb, u0 + 1); db = dst; ldb_ = dstld; }
    for (int u = u0; u < u_end; u += 2) {
        EXP_PUT(va);
        __syncthreads();
        { unsigned char* cd = da; const int cl = lda_; if (u + 2 < u_end) { EXP_LOAD(va, u + 2); da = dst; lda_ = dstld; } EXP_STORE(cd, cl); }
        __syncthreads();
        if (u + 1 < u_end) {
            EXP_PUT(vb);
            __syncthreads();
            { unsigned char* cd = db; const int cl = ldb_; if (u + 3 < u_end) { EXP_LOAD(vb, u + 3); db = dst; ldb_ = dstld; } EXP_STORE(cd, cl); }
            __syncthreads();
        }
    }
}
#undef EXP_LOAD
#undef EXP_PUT
#undef EXP_STORE
__device__ __forceinline__ void exp_queue(AP a, unsigned char* lds, int l) {
    const int tid = tid_opaque();
    int* qslot = (int*)(lds + MISC_OFF + 128);
    unsigned* qc = (unsigned*)(a->ws + WS_BAR + 14336 + l * 256);
    for (;;) {
        __syncthreads();
        if (tid == 0) *qslot = (int)__hip_atomic_fetch_add(qc, 2u, __ATOMIC_RELAXED, __HIP_MEMORY_SCOPE_AGENT);
        __syncthreads();
        const int c0 = *qslot;
        if (c0 >= U_EXP) break;
        exp_range(a, lds, l, c0, c0 + 2);
    }
}

__device__ __forceinline__ void exp_fill(AP a, unsigned char* lds, int ql, int budget) {
    const int tid = tid_opaque();
    int* qslot = (int*)(lds + MISC_OFF + 128);
    unsigned* qc = (unsigned*)(a->ws + WS_BAR + 14336 + ql * 256);
    for (int done = 0; done < budget; done += 2) {
        __syncthreads();
        if (tid == 0) *qslot = (int)__hip_atomic_fetch_add(qc, 2u, __ATOMIC_RELAXED, __HIP_MEMORY_SCOPE_AGENT);
        __syncthreads();
        const int c0 = *qslot;
        if (c0 >= U_EXP) break;
        exp_range(a, lds, ql, c0, c0 + 2);
    }
    __syncthreads();
}

__device__ __forceinline__ void p0_prologue(AP a, unsigned char* lds) {
    const int tid = tid_opaque();
    bool have_tab = false;
    constexpr int E0 = U_ADA, E1 = E0 + U_WIN, E2 = E1 + U_WOUT, E3 = E2 + U_SGU, E4 = E3 + U_DFT, E5 = E4 + U_ROPE;
    int u = blockIdx.x;
    for (; u < E5; u += gridDim.x) {
        if (u < E0) ada_unit(a, lds, u);
        else if (u < E1) win_unit(a, lds, u - E0);
        else if (u < E2) wout_unit(a, lds, u - E1);
        else if (u < E3) { const size_t i0 = (size_t)(u - E2) * 4096 + tid * 8; const float* s = a->in[11] + i0; bf16_t* d = (bf16_t*)(a->ws + WS_WSGU) + i0;
            const f32x4 v0 = *(const f32x4*)s, v1 = *(const f32x4*)(s + 4); u32x4 w; w.x = pack2(v0[0], v0[1]); w.y = pack2(v0[2], v0[3]); w.z = pack2(v1[0], v1[1]); w.w = pack2(v1[2], v1[3]); *(u32x4*)d = w; }
        else if (u < E4) {
            float* ctab = (float*)(lds + LDS_CTAB);
            if (!have_tab) { for (int i = tid; i < 4096; i += NT) ctab[i] = cospif((float)i / 2048.0f); __syncthreads(); have_tab = true; }
            const int k = u - E3 + 4096;
            if (tid < 32) {
                const int kk = k - 4096, n0 = tid * 8; float c[8], s[8];
#pragma unroll
                for (int e = 0; e < 8; ++e) { const int idx = ((kk * (n0 + e)) & 255) * 16; c[e] = ctab[idx] * (1.0f / 16.0f); s[e] = ctab[(idx - 1024) & 4095] * (1.0f / 16.0f); }
                bf16_t* d = (bf16_t*)(a->ws + WS_DFTC) + (size_t)kk * 512 + n0;
                u32x4 w; w.x = pack2(c[0], c[1]); w.y = pack2(c[2], c[3]); w.z = pack2(c[4], c[5]); w.w = pack2(c[6], c[7]); *(u32x4*)d = w;
                w.x = pack2(s[0], s[1]); w.y = pack2(s[2], s[3]); w.z = pack2(s[4], s[5]); w.w = pack2(s[6], s[7]); *(u32x4*)(d + 256) = w;
            }
        }
        else {
            for (int i = tid; i < 1024; i += NT) { const int pos = i >> 4, f = i & 15; const float freq = powf(10000.0f, -(float)f / 16.0f); const float ang = (float)pos * freq;
                ((float2*)(a->ws + WS_ROPE))[i] = make_float2(cosf(ang), sinf(ang)); }
        }
    }
}

__device__ __forceinline__ void p_lnmod0(AP a) {
    const int tid = tid_opaque(), lane = tid & 63, w = tid >> 6;
    const float* mod = (const float*)(a->ws + WS_MOD);
    bf16_t* H = (bf16_t*)(a->ws + WS_H);
    const int tstep = gridDim.x * 8;
    f32x4 nx[4];
    { const int t = blockIdx.x * 8 + w; if (t < NTOK) { const float* src = (t < NLAT) ? a->in[0] + (size_t)t * D : a->in[2] + (size_t)(t - NLAT) * D;
#pragma unroll
        for (int i = 0; i < 4; ++i) nx[i] = *(const f32x4*)(src + 256 * i + 4 * lane); } }
    int mrow = -1; f32x4 msh[4], msc[4];
    for (int t = blockIdx.x * 8 + w; t < NTOK; t += tstep) {
        const int mr = (t < NLAT) ? (t >> 12) : 4;
        if (mr != mrow) { mrow = mr; const float* m = mod + (size_t)mr * 6144;
#pragma unroll
            for (int i = 0; i < 4; ++i) { msh[i] = *(const f32x4*)(m + 256 * i + 4 * lane); msc[i] = *(const f32x4*)(m + 1024 + 256 * i + 4 * lane); } }
        f32x4 v[4];
#pragma unroll
        for (int i = 0; i < 4; ++i) v[i] = nx[i];
        { const int tn = t + tstep; if (tn < NTOK) { const float* src = (tn < NLAT) ? a->in[0] + (size_t)tn * D : a->in[2] + (size_t)(tn - NLAT) * D;
#pragma unroll
            for (int i = 0; i < 4; ++i) nx[i] = *(const f32x4*)(src + 256 * i + 4 * lane); } }
        float mean, rstd; ln_stats(v, mean, rstd);
#pragma unroll
        for (int i = 0; i < 4; ++i) { const int c = 256 * i + 4 * lane;
            f32x4 o;
#pragma unroll
            for (int e = 0; e < 4; ++e) o[e] = (v[i][e] - mean) * rstd * (1.0f + msc[i][e]) + msh[i][e];
            u32x2 pk; pk.x = pack2(o[0], o[1]); pk.y = pack2(o[2], o[3]); *(u32x2*)(H + (size_t)t * D + c) = pk; }
    }
}

__device__ __forceinline__ void p1_inproj(AP a, unsigned char* smem, LAS unsigned char* lds, int l);
__device__ __forceinline__ u32x4 ld16g(const bf16_t* p) { return *(const u32x4*)p; }
__device__ __forceinline__ void rope_pack8(u32x4& wl, u32x4& wh, const LAS f32x2* tab, bool do_rope, float scale) {
    float tl[8] = {lo2f(wl.x), hi2f(wl.x), lo2f(wl.y), hi2f(wl.y), lo2f(wl.z), hi2f(wl.z), lo2f(wl.w), hi2f(wl.w)};
    float th[8] = {lo2f(wh.x), hi2f(wh.x), lo2f(wh.y), hi2f(wh.y), lo2f(wh.z), hi2f(wh.z), lo2f(wh.w), hi2f(wh.w)};
#pragma unroll
    for (int j = 0; j < 8; ++j) {
        float r1 = tl[j], r2 = th[j];
        if (do_rope) { const f32x2 cs = tab[j]; r1 = tl[j] * cs.x - th[j] * cs.y; r2 = tl[j] * cs.y + th[j] * cs.x; }
        tl[j] = r1 * scale; th[j] = r2 * scale;
    }
    wl.x = pack2(tl[0], tl[1]); wl.y = pack2(tl[2], tl[3]); wl.z = pack2(tl[4], tl[5]); wl.w = pack2(tl[6], tl[7]);
    wh.x = pack2(th[0], th[1]); wh.y = pack2(th[2], th[3]); wh.z = pack2(th[4], th[5]); wh.w = pack2(th[6], th[7]);
}

__device__ __forceinline__ void mixer_sgu_pool(AP a, LAS unsigned char* lds, int l, int row0, int seq_row0, int pos0, int n) {
    const int tid = tid_opaque(), lane = tid & 63, w = __builtin_amdgcn_readfirstlane(tid >> 6), fr = lane & 15, g = lane >> 4;
    const bf16_t* Z = (const bf16_t*)(a->ws + WS_Z);
    bf16_t* CAT = (bf16_t*)(a->ws + WS_CAT);
    {
#pragma unroll
        for (int it = 0; it < 9; ++it) { const int id = tid + 512 * it, rr = id >> 5, ch = id & 31, j = pos0 - 8 + rr;
            u32x4 v = (u32x4){0u, 0u, 0u, 0u};
            if (j >= 0 && j < n) v = ld16g(Z + (size_t)(seq_row0 + j) * ZC + 1024 + ch * 8);
            *(LAS u32x4*)(lds + rr * 512 + ch * 16) = v; }
        __syncthreads();
        const int c = tid & 255, half = tid >> 8, hw = 1 << (c >> 6);
        const LAS bf16_t* P = (const LAS bf16_t*)lds + c;
        const int t0 = half * 64;
        float s = 0.f;
        for (int j = t0 - hw; j < t0 + hw; ++j) s += bf2f(P[(8 + j) * 256]);
        for (int tl = t0; tl < t0 + 64; ++tl) {
            const int pos = pos0 + tl; const int lo = max(pos - hw, 0), hi = min(pos + hw, n);
            CAT[(size_t)(row0 + tl) * D + 512 + c] = f2bf(s / (float)(hi - lo) - bf2f(P[(8 + tl) * 256]));
            s += bf2f(P[(8 + tl + hw) * 256]) - bf2f(P[(8 + tl - hw) * 256]);
        }
        __syncthreads();
    }
    {
        const int i16 = lane & 15;
        u32x4 gw[4][2];
#pragma unroll
        for (int ps = 0; ps < 4; ++ps) { const int q = w * 16 + ps * 4 + g; const bf16_t* src = Z + (size_t)(row0 + q) * ZC + 1536 + 16 * i16; gw[ps][0] = ld16g(src); gw[ps][1] = ld16g(src + 8); }
#pragma unroll
        for (int ps = 0; ps < 4; ++ps) {
            const int q = w * 16 + ps * 4 + g;
            float gv[16];
#pragma unroll
            for (int hh = 0; hh < 2; ++hh) { const u32x4 x = gw[ps][hh];
                gv[8 * hh + 0] = gelu_erf(lo2f(x.x)); gv[8 * hh + 1] = gelu_erf(hi2f(x.x)); gv[8 * hh + 2] = gelu_erf(lo2f(x.y)); gv[8 * hh + 3] = gelu_erf(hi2f(x.y));
                gv[8 * hh + 4] = gelu_erf(lo2f(x.z)); gv[8 * hh + 5] = gelu_erf(hi2f(x.z)); gv[8 * hh + 6] = gelu_erf(lo2f(x.w)); gv[8 * hh + 7] = gelu_erf(hi2f(x.w)); }
            float sm = 0.f;
#pragma unroll
            for (int e = 0; e < 16; ++e) sm += gv[e];
            const float mean = row_sum16(sm) * (1.0f / 256.0f);
            float qq = 0.f;
#pragma unroll
            for (int e = 0; e < 16; ++e) { const float d = gv[e] - mean; qq += d * d; }
            const float rstd = 1.0f / sqrtf(row_sum16(qq) * (1.0f / 256.0f) + 1e-6f);
#pragma unroll
            for (int e = 0; e < 16; ++e) { const int c = 16 * i16 + e; *(LAS bf16_t*)(lds + c * 256 + ((((q >> 3) ^ (c & 15))) << 4) + (q & 7) * 2) = f2bf((gv[e] - mean) * rstd); }
        }
    }
    __syncthreads();
    {
        const int h = w >> 1, ph = w & 1;
        const bf16_t* Ws = (const bf16_t*)(a->ws + WS_WSGU) + (size_t)(l * 4 + h) * 128 * 128;
        const float* bs = a->in[12] + (size_t)(l * 4 + h) * 128;
        f32x4 acc[4][4];
#pragma unroll
        for (int i = 0; i < 4; ++i)
#pragma unroll
            for (int j = 0; j < 4; ++j) acc[i][j] = (f32x4){0.f, 0.f, 0.f, 0.f};
#pragma unroll
        for (int ks = 0; ks < 4; ++ks) {
            bf16x8 af[4], bfv[4];
#pragma unroll
            for (int cf = 0; cf < 4; ++cf) { const int c = h * 64 + 16 * cf + fr; af[cf] = *(const LAS bf16x8*)(lds + c * 256 + (((4 * ks + g) ^ (c & 15)) << 4)); }
#pragma unroll
            for (int pf = 0; pf < 4; ++pf) { const int p = ph * 64 + 16 * pf + fr; bfv[pf] = *(const bf16x8*)(Ws + (size_t)p * 128 + 32 * ks + 8 * g); }
#pragma unroll
            for (int cf = 0; cf < 4; ++cf)
#pragma unroll
                for (int pf = 0; pf < 4; ++pf) acc[cf][pf] = __builtin_amdgcn_mfma_f32_16x16x32_bf16(af[cf], bfv[pf], acc[cf][pf], 0, 0, 0);
        }
#pragma unroll
        for (int pf = 0; pf < 4; ++pf) { const int p = ph * 64 + 16 * pf + fr; const float bias = bs[p];
#pragma unroll
            for (int cf = 0; cf < 4; ++cf) { const int c0 = h * 64 + 16 * cf + 4 * g;
                const u32x2 uw = *(const u32x2*)(Z + (size_t)(row0 + p) * ZC + 1280 + c0);
                u32x2 o; o.x = pack2(gelu_erf(lo2f(uw.x)) * (acc[cf][pf][0] + bias), gelu_erf(hi2f(uw.x)) * (acc[cf][pf][1] + bias));
                o.y = pack2(gelu_erf(lo2f(uw.y)) * (acc[cf][pf][2] + bias), gelu_erf(hi2f(uw.y)) * (acc[cf][pf][3] + bias));
                *(u32x2*)(CAT + (size_t)(row0 + p) * D + 768 + c0) = o; } }
    }
    __syncthreads();
}

__device__ __forceinline__ void mixer_attn(AP a, LAS unsigned char* lds, int l, int row0, int seq_row0, int pos0, int n, int b, bool is_ctx, int kvh) {
    const int tid = tid_opaque(), lane = tid & 63, w = __builtin_amdgcn_readfirstlane(tid >> 6), fr = lane & 15, g = lane >> 4;
    const bf16_t* Z = (const bf16_t*)(a->ws + WS_Z);
    bf16_t* CAT = (bf16_t*)(a->ws + WS_CAT);
    __syncthreads();
    ((LAS u32x4*)(lds + 98304))[tid] = ((const u32x4*)(a->ws + WS_ROPE))[tid];
    const LAS f32x2* rope = (const LAS f32x2*)(lds + 98304);
    constexpr float QS = 0.125f * 1.44269504088896341f;
    constexpr int QS_OFF = 0, KS_OFF = 32768, VS_OFF = 65536;
    const int nbq = pos0 >> 7;
    unsigned bmask = 0x18u;
    if (!is_ctx) { if (nbq > 0) bmask |= 1u; bmask |= 2u; if (nbq + 1 < (n >> 7)) bmask |= 4u; }
    const int kr = tid >> 2, kax = (tid >> 1) & 1, kh8 = tid & 1;
#define MX_KSRC(blk) (Z + (size_t)((((blk) < 3) ? seq_row0 + (nbq + (blk) - 1) * 128 : NLAT + b * 256 + ((blk) - 3) * 128) + kr) * ZC + 768 + kvh * 64 + kax * 32 + kh8 * 8)
#define MX_VSTAGE(blk, buf) do { const bool _band = (blk) < 3; const int _key0 = _band ? (nbq + (blk) - 1) * 128 : ((blk) - 3) * 128; \
        const bf16_t* _vs = _band ? (const bf16_t*)(a->ws + WS_VT) + (size_t)(b * 2 + kvh) * 64 * 4096 + _key0 : (const bf16_t*)(a->ws + WS_VTC) + (size_t)(b * 2 + kvh) * 64 * 256 + _key0; \
        const int _vld = _band ? 4096 : 256; \
        _Pragma("unroll") for (int _i = 0; _i < 2; ++_i) { const int _P = _i * 512 + tid, _d = _P >> 4, _c = (_P & 15) ^ (_d & 15); \
            glds16(_vs + (size_t)_d * _vld + _c * 8, lds + VS_OFF + (buf) * 16384 + _i * 8192 + w * 1024); } } while (0)
    {
        __syncthreads();
#pragma unroll
        for (int it = 0; it < 2; ++it) {
            const int item = tid + 512 * it, r = item >> 2, ax = (item >> 1) & 1, h8 = item & 1, i = r & 127, qpos = pos0 + i;
            const bf16_t* src = Z + (size_t)(row0 + i) * ZC + 512 + (2 * kvh + (r >> 7)) * 64 + ax * 32 + h8 * 8;
            u32x4 wl = ld16g(src), wh = ld16g(src + 16);
            rope_pack8(wl, wh, rope + (ax ? (qpos & 63) : (qpos >> 6)) * 16 + h8 * 8, !is_ctx, QS);
            const int ch = ax * 4 + h8, sw = (r >> 1) & 7;
            *(LAS u32x4*)(lds + QS_OFF + r * 128 + ((ch ^ sw) << 4)) = wl;
            *(LAS u32x4*)(lds + QS_OFF + r * 128 + (((ch + 2) ^ sw) << 4)) = wh;
        }
        const int hh = w >> 2, qb = (w & 3) * 32, h = 2 * kvh + hh;
        float m[2], lsum[2];
        m[0] = m[1] = a->in[8][l * 4 + h] * 1.44269504088896341f;
        lsum[0] = lsum[1] = (g == 0) ? 1.0f : 0.0f;
        f32x4 O[4][2];
#pragma unroll
        for (int i = 0; i < 4; ++i) { O[i][0] = (f32x4){0.f, 0.f, 0.f, 0.f}; O[i][1] = (f32x4){0.f, 0.f, 0.f, 0.f}; }
        bf16x8 Qf[2][2];
        bool have_q = false;
        unsigned rem = bmask;
        int cur = __builtin_ctz(rem); rem &= rem - 1u;
        int buf = 0;
        u32x4 kl = ld16g(MX_KSRC(cur)), kh = ld16g(MX_KSRC(cur) + 16);
        MX_VSTAGE(cur, 0);
#pragma unroll 1
        for (;;) {
            const int jb = cur - 1; const bool band = cur < 3;
            {
                const int kpos = (nbq + jb) * 128 + kr;
                rope_pack8(kl, kh, rope + (kax ? (kpos & 63) : (kpos >> 6)) * 16 + kh8 * 8, band, 1.0f);
                const int ch = kax * 4 + kh8, sw = (kr >> 1) & 7;
                *(LAS u32x4*)(lds + KS_OFF + buf * 16384 + kr * 128 + ((ch ^ sw) << 4)) = kl;
                *(LAS u32x4*)(lds + KS_OFF + buf * 16384 + kr * 128 + (((ch + 2) ^ sw) << 4)) = kh;
            }
            asm volatile("s_waitcnt vmcnt(0)" ::: "memory");
            __syncthreads();
            const int nxt = rem ? __builtin_ctz(rem) : -1; rem &= rem - 1u;
            if (nxt >= 0) { kl = ld16g(MX_KSRC(nxt)); kh = ld16g(MX_KSRC(nxt) + 16); MX_VSTAGE(nxt, buf ^ 1); }
            if (!have_q) {
#pragma unroll
                for (int qf = 0; qf < 2; ++qf)
#pragma unroll
                    for (int ks = 0; ks < 2; ++ks) { const int r = hh * 128 + qb + 16 * qf + fr; Qf[qf][ks] = *(const LAS bf16x8*)(lds + QS_OFF + r * 128 + (((4 * ks + g) ^ ((r >> 1) & 7)) << 4)); }
                have_q = true;
            }
            const int kso = KS_OFF + buf * 16384, vso = VS_OFF + buf * 16384;
            f32x4 S[8][2];
#pragma unroll
            for (int kf = 0; kf < 8; ++kf) { S[kf][0] = (f32x4){0.f, 0.f, 0.f, 0.f}; S[kf][1] = (f32x4){0.f, 0.f, 0.f, 0.f}; }
#pragma unroll
            for (int kf = 0; kf < 8; ++kf)
#pragma unroll
                for (int ks = 0; ks < 2; ++ks) { const int r = 16 * kf + fr;
                    const bf16x8 kfr = *(const LAS bf16x8*)(lds + kso + r * 128 + (((4 * ks + g) ^ ((r >> 1) & 7)) << 4));
                    S[kf][0] = __builtin_amdgcn_mfma_f32_16x16x32_bf16(kfr, Qf[0][ks], S[kf][0], 0, 0, 0);
                    S[kf][1] = __builtin_amdgcn_mfma_f32_16x16x32_bf16(kfr, Qf[1][ks], S[kf][1], 0, 0, 0); }
            bf16x8 Pp[4][2];
#pragma unroll
            for (int qf = 0; qf < 2; ++qf) {
                const int qi = qb + 16 * qf + fr;
                if (band && jb != 0) {
#pragma unroll
                    for (int kf = 0; kf < 8; ++kf)
#pragma unroll
                        for (int r = 0; r < 4; ++r) { const int kk = 16 * kf + 4 * g + r; const bool ok = (jb < 0) ? (kk >= qi) : (kk <= qi); if (!ok) S[kf][qf][r] = -1.0e30f; }
                }
                float mx = S[0][qf][0];
#pragma unroll
                for (int kf = 0; kf < 8; ++kf)
#pragma unroll
                    for (int r = 0; r < 4; ++r) mx = fmaxf(mx, S[kf][qf][r]);
                mx = fmaxf(mx, __shfl_xor(mx, 16)); mx = fmaxf(mx, __shfl_xor(mx, 32));
                const float mn = fmaxf(m[qf], mx), corr = __builtin_amdgcn_exp2f(m[qf] - mn);
                m[qf] = mn;
                float ps = 0.f;
#pragma unroll
                for (int kf = 0; kf < 8; ++kf)
#pragma unroll
                    for (int r = 0; r < 4; ++r) { const float p = __builtin_amdgcn_exp2f(S[kf][qf][r] - mn); S[kf][qf][r] = p; ps += p; }
                lsum[qf] = lsum[qf] * corr + ps;
#pragma unroll
                for (int df = 0; df < 4; ++df) O[df][qf] *= corr;
#pragma unroll
                for (int t = 0; t < 4; ++t) { u32x4 pw; pw.x = pack2(S[2 * t][qf][0], S[2 * t][qf][1]); pw.y = pack2(S[2 * t][qf][2], S[2 * t][qf][3]);
                    pw.z = pack2(S[2 * t + 1][qf][0], S[2 * t + 1][qf][1]); pw.w = pack2(S[2 * t + 1][qf][2], S[2 * t + 1][qf][3]); Pp[t][qf] = __builtin_bit_cast(bf16x8, pw); }
            }
#pragma unroll
            for (int t = 0; t < 4; ++t)
#pragma unroll
                for (int df = 0; df < 4; ++df) { const int d = 16 * df + fr;
                    const u32x2 v0 = *(const LAS u32x2*)(lds + vso + d * 256 + (((4 * t + (g >> 1)) ^ (d & 15)) << 4) + (g & 1) * 8);
                    const u32x2 v1 = *(const LAS u32x2*)(lds + vso + d * 256 + (((4 * t + 2 + (g >> 1)) ^ (d & 15)) << 4) + (g & 1) * 8);
                    u32x4 vw; vw.x = v0.x; vw.y = v0.y; vw.z = v1.x; vw.w = v1.y; const bf16x8 vf = __builtin_bit_cast(bf16x8, vw);
                    O[df][0] = __builtin_amdgcn_mfma_f32_16x16x32_bf16(vf, Pp[t][0], O[df][0], 0, 0, 0);
                    O[df][1] = __builtin_amdgcn_mfma_f32_16x16x32_bf16(vf, Pp[t][1], O[df][1], 0, 0, 0); }
            if (nxt < 0) break;
            cur = nxt; buf ^= 1;
        }
#pragma unroll
        for (int qf = 0; qf < 2; ++qf) {
            float lt = lsum[qf]; lt += __shfl_xor(lt, 16); lt += __shfl_xor(lt, 32);
            const float inv = 1.0f / lt;
            bf16_t* dst = CAT + (size_t)(row0 + qb + 16 * qf + fr) * D + 256 + h * 64 + 4 * g;
#pragma unroll
            for (int df = 0; df < 4; ++df) { u32x2 o; o.x = pack2(O[df][qf][0] * inv, O[df][qf][1] * inv); o.y = pack2(O[df][qf][2] * inv, O[df][qf][3] * inv); *(u32x2*)(dst + 16 * df) = o; }
        }
    }
#undef MX_KSRC
#undef MX_VSTAGE
    __syncthreads();
}

constexpr int FF_DA = 0, FF_DC = 32768, FF_XT = 49152  , FF_Z2 = 81920  , FF_OB = 114688  ;
__device__ __forceinline__ int ff_addr(int row, int k) { return row * 256 + ((((k >> 3) ^ (row & 15))) << 4) + (k & 7) * 2; }
__device__ __forceinline__ float cos_turns(float x) { return __builtin_amdgcn_cosf(x); }
__device__ __forceinline__ float sin_turns(float x) { return __builtin_amdgcn_sinf(x); }
__device__ __forceinline__ void fft_setup(LAS unsigned char* lds) {
    const int tid = tid_opaque();
    __syncthreads();
    for (int idx = tid; idx < 16384; idx += NT) { const int i = idx >> 7, k = idx & 127, ro = i >> 6, k1 = i & 63, part = k >> 6, n1 = k & 63; const float t = (float)((k1 * n1) & 63) * (1.0f / 64.0f);
        const float c = cos_turns(t), sn = sin_turns(t);
        const float v = (ro == 0) ? (part == 0 ? c : sn) : (part == 0 ? -sn : c);
        *(LAS bf16_t*)(lds + FF_DA + ff_addr(i, k)) = f2bf(v * 0.125f); }
    for (int idx = tid; idx < 8192; idx += NT) { const int k2 = idx >> 7, k = idx & 127, ri = k >> 6, n2 = k & 63; const float t = (float)((k2 * n2) & 63) * (1.0f / 64.0f);
        const float v = (ri == 0) ? cos_turns(t) : sin_turns(t);
        *(LAS bf16_t*)(lds + FF_DC + ff_addr(k2, k)) = f2bf(v * 0.125f); }
    __syncthreads();
}
__device__ __forceinline__ void fft_unit(AP a, LAS unsigned char* lds, int b, int cg) {
    const int tid = tid_opaque(), lane = tid & 63, w = __builtin_amdgcn_readfirstlane(tid >> 6), fr = lane & 15, g = lane >> 4;
    const int mf = w & 3, nh = w >> 2;
    const bf16_t* AT = (const bf16_t*)(a->ws + WS_AT) + (size_t)(b * 256 + cg * 4) * 8192;
    u32x4 xin[2][2];
#pragma unroll
    for (int h = 0; h < 2; ++h)
#pragma unroll
        for (int it = 0; it < 2; ++it) xin[h][it] = ld16g(AT + (size_t)h * 8192 + (size_t)(tid + 512 * it) * 8);
#pragma unroll 1
    for (int cp = 0; cp < 2; ++cp) {
#pragma unroll
        for (int h = 0; h < 2; ++h)
#pragma unroll
            for (int it = 0; it < 2; ++it) { const int q = tid + 512 * it, part = q >> 9, pos0 = (q & 511) * 8, n1 = pos0 >> 6, n2 = pos0 & 63, k = part * 64 + n1;
                const unsigned wv[4] = {xin[h][it].x, xin[h][it].y, xin[h][it].z, xin[h][it].w};
#pragma unroll
                for (int e = 0; e < 4; ++e) { *(LAS bf16_t*)(lds + FF_XT + h * 16384 + ff_addr(n2 + 2 * e, k)) = (bf16_t)(wv[e] & 0xffffu); *(LAS bf16_t*)(lds + FF_XT + h * 16384 + ff_addr(n2 + 2 * e + 1, k)) = (bf16_t)(wv[e] >> 16); } }
        if (cp == 0) {
#pragma unroll
            for (int h = 0; h < 2; ++h)
#pragma unroll
                for (int it = 0; it < 2; ++it) xin[h][it] = ld16g(AT + (size_t)(2 + h) * 8192 + (size_t)(tid + 512 * it) * 8); }
        __syncthreads();
        f32x4 acc[2][2][2];
#pragma unroll
        for (int h = 0; h < 2; ++h)
#pragma unroll
            for (int x = 0; x < 2; ++x) { acc[h][x][0] = (f32x4){0.f, 0.f, 0.f, 0.f}; acc[h][x][1] = (f32x4){0.f, 0.f, 0.f, 0.f}; }
#pragma unroll
        for (int ks = 0; ks < 4; ++ks) {
            bf16x8 af[2];
#pragma unroll
            for (int x = 0; x < 2; ++x) { const int i = 16 * (mf + 4 * x) + fr; af[x] = *(const LAS bf16x8*)(lds + FF_DA + i * 256 + (((4 * ks + g) ^ (i & 15)) << 4)); }
#pragma unroll
            for (int h = 0; h < 2; ++h)
#pragma unroll
                for (int n = 0; n < 2; ++n) { const int j = 16 * (2 * nh + n) + fr; const bf16x8 bfv = *(const LAS bf16x8*)(lds + FF_XT + h * 16384 + j * 256 + (((4 * ks + g) ^ (j & 15)) << 4));
                    acc[h][0][n] = __builtin_amdgcn_mfma_f32_16x16x32_bf16(af[0], bfv, acc[h][0][n], 0, 0, 0);
                    acc[h][1][n] = __builtin_amdgcn_mfma_f32_16x16x32_bf16(af[1], bfv, acc[h][1][n], 0, 0, 0); }
        }
#pragma unroll
        for (int n = 0; n < 2; ++n)
#pragma unroll
            for (int r = 0; r < 4; ++r) { const int k1 = 16 * mf + 4 * g + r, n2 = 16 * (2 * nh + n) + fr; const float t = (float)((k1 * n2) & 4095) * (1.0f / 4096.0f);
                const float c = cos_turns(t), sn = sin_turns(t);
#pragma unroll
                for (int h = 0; h < 2; ++h) { const float zr = acc[h][0][n][r], zi = acc[h][1][n][r];
                    *(LAS bf16_t*)(lds + FF_Z2 + h * 16384 + ff_addr(k1, n2)) = f2bf(zr * c + zi * sn);
                    *(LAS bf16_t*)(lds + FF_Z2 + h * 16384 + ff_addr(k1, 64 + n2)) = f2bf(zi * c - zr * sn); } }
        __syncthreads();
        f32x4 acc2[2][2];
#pragma unroll
        for (int h = 0; h < 2; ++h) { acc2[h][0] = (f32x4){0.f, 0.f, 0.f, 0.f}; acc2[h][1] = (f32x4){0.f, 0.f, 0.f, 0.f}; }
#pragma unroll
        for (int ks = 0; ks < 4; ++ks) {
            const int i = 16 * mf + fr; const bf16x8 af = *(const LAS bf16x8*)(lds + FF_DC + i * 256 + (((4 * ks + g) ^ (i & 15)) << 4));
#pragma unroll
            for (int h = 0; h < 2; ++h)
#pragma unroll
                for (int n = 0; n < 2; ++n) { const int j = 16 * (2 * nh + n) + fr; const bf16x8 bfv = *(const LAS bf16x8*)(lds + FF_Z2 + h * 16384 + j * 256 + (((4 * ks + g) ^ (j & 15)) << 4));
                    acc2[h][n] = __builtin_amdgcn_mfma_f32_16x16x32_bf16(af, bfv, acc2[h][n], 0, 0, 0); }
        }
#pragma unroll
        for (int n = 0; n < 2; ++n)
#pragma unroll
            for (int r = 0; r < 4; ++r) { const int k = 16 * (2 * nh + n) + fr + 64 * (16 * mf + 4 * g + r);
                *(LAS unsigned*)(lds + FF_OB + k * 8 + cp * 4) = pack2(acc2[0][n][r], acc2[1][n][r]); }
    }
    __syncthreads();
    bf16_t* CAT = (bf16_t*)(a->ws + WS_CAT) + (size_t)(b * 4096) * D + cg * 4;
#pragma unroll
    for (int it = 0; it < 8; ++it) { const int k = tid + 512 * it; *(u32x2*)(CAT + (size_t)k * D) = *(const LAS u32x2*)(lds + FF_OB + k * 8); }
    __syncthreads();
}

__device__ __forceinline__ void p2_mix(AP a, unsigned char* ldsg, LAS unsigned char* lds, int l) {
    const int n_tile = 128 + ((l == 0) ? 8 : 0), n_att = 2 * n_tile, n_dft = 256, n_dftc = (l == 0) ? 16 : 0;
    bf16_t* CAT = (bf16_t*)(a->ws + WS_CAT);
    bool fft_ready = false;
    for (int u = blockIdx.x; u < n_att + n_dft + n_tile + n_dftc; u += gridDim.x) {
        if (u < n_att || (u >= n_att + n_dft && u < n_att + n_dft + n_tile)) {
            const bool att = u < n_att;
            const int t = att ? (u >> 1) : (u - n_att - n_dft);
            const bool isc = t >= 128; const int tt = t - 128;
            const int b = isc ? (tt >> 1) : (t >> 5);
            const int row0 = isc ? NLAT + tt * 128 : t * 128, seq_row0 = isc ? NLAT + b * 256 : b * 4096, pos0 = isc ? (tt & 1) * 128 : (t & 31) * 128, n = isc ? 256 : 4096;
            if (att) { for (int rep = 0; rep < PROBE_MIX_REP; ++rep) mixer_attn(a, lds, l, row0, seq_row0, pos0, n, b, isc, u & 1); }
            else { for (int rep = 0; rep < PROBE_SGU_REP; ++rep) mixer_sgu_pool(a, lds, l, row0, seq_row0, pos0, n); }
            fft_ready = false;
        } else if (u < n_att + n_dft) {
            const int uu = u - n_att;
            if (!fft_ready) { fft_setup(lds); fft_ready = true; }
            for (int rep = 0; rep < PROBE_FFT_REP; ++rep) fft_unit(a, lds, uu >> 6, uu & 63);
        } else {
            const int uu = u - n_att - n_dft - n_tile, b = uu >> 2, mt = (uu >> 1) & 1, ch0 = (uu & 1) * 128;
            const bf16_t* A = (const bf16_t*)(a->ws + WS_DFTC) + (size_t)(mt * 128) * 512;
            const bf16_t* B0 = (const bf16_t*)(a->ws + WS_ATC) + ((size_t)b * 256 + ch0) * 512;
            EpiBf16 E; E.C = CAT + (size_t)(NLAT + b * 256 + mt * 128) * D + ch0; E.ld = D; E.scale = 1.0f;
            gemm_tile<128, false, EpiBf16>(lds, A, 512, nullptr, 128, B0, B0 + (size_t)64 * 512, 512, 512, E);
            fft_ready = false;
        }
    }
    exp_queue(a, ldsg, l);
}

__device__ __forceinline__ int uni(int v) { return __builtin_amdgcn_readfirstlane(v); }
__device__ __forceinline__ int vblock() { const int G = gridDim.x, b = blockIdx.x; return (G % 8 == 0) ? (b % 8) * (G / 8) + b / 8 : b; }
template <class T> __device__ __forceinline__ T* unip(T* p) { const unsigned long long v = (unsigned long long)p; const unsigned lo = __builtin_amdgcn_readfirstlane((unsigned)v), hi = __builtin_amdgcn_readfirstlane((unsigned)(v >> 32)); return (T*)(((unsigned long long)hi << 32) | lo); }
struct SchedInProj {
    typedef EpiInProj Epi; static constexpr bool GATHER = false, FP8 = false;
    unsigned char* ws; int l, G, me;
    __device__ __forceinline__ bool get(int i, g256::Unit<Epi>& u) const {
        const int n_lat = 64 * 7, n_ctx = (l == 0) ? 4 * 7 : 4;
        const int idx = i * G + me; if (idx >= n_lat + n_ctx) return false;
        int row0, b, ct, n; bf16_t *tF, *tV;
        if (idx < n_lat) { const int rt = idx / 7; ct = idx % 7; row0 = rt * 256; b = row0 >> 12; n = 4096;
            tF = (bf16_t*)(ws + WS_AT) + (size_t)b * 256 * 2 * 4096; tV = (bf16_t*)(ws + WS_VT) + (size_t)b * 128 * 4096; }
        else { const int uu = idx - n_lat; int rt; if (l == 0) { rt = uu / 7; ct = uu % 7; } else { rt = uu; ct = 3; }
            row0 = NLAT + rt * 256; b = rt; n = 256;
            tF = (bf16_t*)(ws + WS_ATC) + (size_t)b * 256 * 2 * 256; tV = (bf16_t*)(ws + WS_VTC) + (size_t)b * 128 * 256; }
        u.A = (const bf16_t*)(ws + WS_H) + (size_t)row0 * D;
        u.B0 = (const bf16_t*)(ws + WS_WIN) + ((size_t)l * ZC + ct * 256) * 1024; u.B1 = u.B0 + (size_t)128 * 1024; u.ridx = nullptr; u.valid = 256;
        u.epi.Zt = (bf16_t*)(ws + WS_Z) + (size_t)row0 * ZC + ct * 256; u.epi.tF = tF; u.epi.tV = tV; u.epi.n0 = ct * 256; u.epi.pos0 = (idx < n_lat) ? (row0 & 4095) : 0; u.epi.n = n;
        return true;
    }
};
struct SchedOutProj {
    typedef EpiBf16 Epi; static constexpr bool GATHER = false, FP8 = false;
    unsigned char* ws; int l, G, me;
    __device__ __forceinline__ bool get(int i, g256::Unit<Epi>& u) const {
        const int nrt = NLAT / 256;
        const int idx = i * G + me; if (idx >= nrt * 4) return false;
        const int rt = idx >> 2, ct = idx & 3;
        u.A = (const bf16_t*)(ws + WS_CAT) + (size_t)(rt * 256) * D;
        u.B0 = (const bf16_t*)(ws + WS_WOUT) + ((size_t)l * 1024 + ct * 256) * 1024; u.B1 = u.B0 + (size_t)128 * 1024; u.ridx = nullptr; u.valid = 256;
        u.epi.C = (bf16_t*)(ws + WS_Y) + (size_t)(rt * 256) * D + ct * 256; u.epi.ld = D; u.epi.scale = 1.0f;
        return true;
    }
};
struct SchedGateUp {
    typedef EpiGateUp8 Epi; static constexpr bool GATHER = true, FP8 = true;
    unsigned char* ws; const LAS int* blk; const LAS int* tot; const LAS int* ridx_lds; int G, me, l;
    __device__ __forceinline__ bool get(int i, g256::Unit<Epi>& u) const {
        const int idx = i * G + me; if (idx >= uni(blk[32]) * 4) return false;
        const int rb = idx >> 2, ct = idx & 3;
        int e = 0;
#pragma unroll 1
        for (int q = 1; q < 32; ++q) if (uni(blk[q]) <= rb) e = q;
        u.A = (const bf16_t*)(ws + WS_H8);
        { const unsigned char* b0 = ws + WS_WEXP + (size_t)l * WEXP_LAYER + ((size_t)e * 512 + ct * 128) * 1024; u.B0 = (const bf16_t*)b0; u.B1 = (const bf16_t*)(b0 + EXPMAT); }
        u.ridx = ridx_lds + (i & 7) * 256; u.valid = uni(min(256, tot[e] - (rb - blk[e]) * 256));
        u.epi.C = ws + WS_HID + (size_t)(rb * 256) * DEXP + ct * 128; u.epi.ld = DEXP;
        return true;
    }
};
struct SchedDown {
    typedef EpiFp8 Epi; static constexpr bool GATHER = false, FP8 = true;
    unsigned char* ws; const LAS int* blk; int G, me, l;
    __device__ __forceinline__ bool get(int i, g256::Unit<Epi>& u) const {
        const int idx = i * G + me; if (idx >= uni(blk[32]) * 4) return false;
        const int rb = idx >> 2, ct = idx & 3;
        int e = 0;
#pragma unroll 1
        for (int q = 1; q < 32; ++q) if (uni(blk[q]) <= rb) e = q;
        u.A = (const bf16_t*)(ws + WS_HID + (size_t)(rb * 256) * DEXP);
        { const unsigned char* b0 = ws + WS_WEXP + (size_t)l * WEXP_LAYER + 2 * EXPMAT + ((size_t)e * 1024 + ct * 256) * 512; u.B0 = (const bf16_t*)b0; u.B1 = (const bf16_t*)(b0 + (size_t)128 * 512); } u.ridx = nullptr; u.valid = 256;
        u.epi.C = ws + WS_YS + (size_t)(rb * 256) * D + ct * 256; u.epi.ld = D; u.epi.scale = 1.0f / 32.0f;
        return true;
    }
};

__device__ __forceinline__ void p4_ln1_router(AP a, unsigned char* lds, int l) {
    const int tid = tid_opaque(), lane = tid & 63, w = tid >> 6;
    const int ntok = (l == 0) ? NTOK : NLAT;
    int* cnt = (int*)(lds + MISC_OFF);
    if (tid < 32) cnt[tid] = 0;
    f32x4* Lg = (f32x4*)lds; f32x4* Le = (f32x4*)(lds + 16384); f32x4* Lgb = (f32x4*)(lds + 147456);
    {
        const float* wrg_ = a->in[16] + (size_t)l * 1024 * 4; const float* wre_ = a->in[17] + (size_t)l * 1024 * 32;
#pragma unroll
        for (int it = 0; it < 2; ++it) { const int c = tid + 512 * it, slot = (((c >> 8) * 4 + (c & 3)) << 6) + ((c >> 2) & 63);
            Lg[slot] = *(const f32x4*)(wrg_ + (size_t)c * 4);
#pragma unroll
            for (int q = 0; q < 8; ++q) Le[q * 1024 + slot] = *(const f32x4*)(wre_ + (size_t)c * 32 + q * 4); }
        Lgb[tid] = (tid < 256) ? *(const f32x4*)(a->in[14] + l * 1024 + tid * 4) : *(const f32x4*)(a->in[15] + l * 1024 + (tid - 256) * 4);
    }
    __syncthreads();
    const float* mod = (const float*)(a->ws + WS_MOD) + (size_t)l * 5 * 6144;
    const bf16_t* Y = (const bf16_t*)(a->ws + WS_Y);
    float* X1 = (float*)(a->ws + WS_X1);
    unsigned char* H8 = a->ws + WS_H8;
    int* tokE = (int*)(a->ws + WS_TOKE); int* tokR = (int*)(a->ws + WS_TOKR); float* tokG = (float*)(a->ws + WS_TOKG);
    const int tstep = gridDim.x * 8;
    f32x4 nx[4]; u32x2 ny[4];
    {   const int t = blockIdx.x * 8 + w;
        if (t < ntok) { const float* xs = (l == 0) ? ((t < NLAT) ? a->in[0] + (size_t)t * D : a->in[2] + (size_t)(t - NLAT) * D) : (const float*)(a->ws + WS_XC) + (size_t)t * D;
#pragma unroll
            for (int i = 0; i < 4; ++i) { nx[i] = *(const f32x4*)(xs + 256 * i + 4 * lane); ny[i] = *(const u32x2*)(Y + (size_t)t * D + 256 * i + 4 * lane); } } }
    int mrow = -1; f32x4 mg[4], msh[4], msc[4];
    for (int t = blockIdx.x * 8 + w; t < ntok; t += tstep) {
        const int mr = (t < NLAT) ? (t >> 12) : 4;
        if (mr != mrow) { mrow = mr; const float* m = mod + (size_t)mr * 6144;
#pragma unroll
            for (int i = 0; i < 4; ++i) { const int c = 256 * i + 4 * lane; mg[i] = *(const f32x4*)(m + 2048 + c); msh[i] = *(const f32x4*)(m + 3072 + c); msc[i] = *(const f32x4*)(m + 4096 + c); } }
        f32x4 v[4];
#pragma unroll
        for (int i = 0; i < 4; ++i) { const f32x4 yv = (f32x4){lo2f(ny[i].x), hi2f(ny[i].x), lo2f(ny[i].y), hi2f(ny[i].y)};
#pragma unroll
            for (int e = 0; e < 4; ++e) v[i][e] = RES_ALPHA * nx[i][e] + mg[i][e] * yv[e]; }
        {   const int tn = t + tstep;
            if (tn < ntok) { const float* xs = (l == 0) ? ((tn < NLAT) ? a->in[0] + (size_t)tn * D : a->in[2] + (size_t)(tn - NLAT) * D) : (const float*)(a->ws + WS_XC) + (size_t)tn * D;
#pragma unroll
                for (int i = 0; i < 4; ++i) { nx[i] = *(const f32x4*)(xs + 256 * i + 4 * lane); ny[i] = *(const u32x2*)(Y + (size_t)tn * D + 256 * i + 4 * lane); } } }
        float mean, rstd; ln_stats(v, mean, rstd);
#pragma unroll
        for (int i = 0; i < 4; ++i) { const int c = 256 * i + 4 * lane; const f32x4 gg = Lgb[64 * i + lane], bb = Lgb[256 + 64 * i + lane];
#pragma unroll
            for (int e = 0; e < 4; ++e) v[i][e] = (v[i][e] - mean) * rstd * gg[e] + bb[e];
            *(f32x4*)(X1 + (size_t)t * D + c) = v[i]; }
        ln_stats(v, mean, rstd);
#pragma unroll
        for (int i = 0; i < 4; ++i) { const int c = 256 * i + 4 * lane; const f32x4 sh = msh[i], sc = msc[i];
#pragma unroll
            for (int e = 0; e < 4; ++e) v[i][e] = (v[i][e] - mean) * rstd * (1.0f + sc[e]) + sh[e];
            *(unsigned*)(H8 + (size_t)t * D + c) = pack4_fp8(v[i][0], v[i][1], v[i][2], v[i][3]); }
        f32x2 lg01 = (f32x2){0.f, 0.f}, lg23 = (f32x2){0.f, 0.f};
#pragma unroll
        for (int i = 0; i < 4; ++i)
#pragma unroll
            for (int e = 0; e < 4; ++e) { const f32x4 wv = Lg[((i * 4 + e) << 6) + lane]; const f32x2 vv = (f32x2){v[i][e], v[i][e]};
                lg01 += vv * (f32x2){wv[0], wv[1]}; lg23 += vv * (f32x2){wv[2], wv[3]}; }
        float lg[4] = {wave_sum(lg01[0]), wave_sum(lg01[1]), wave_sum(lg23[0]), wave_sum(lg23[1])};
        int grp = 0; float mx = lg[0];
#pragma unroll
        for (int q = 1; q < 4; ++q) if (lg[q] > mx) { mx = lg[q]; grp = q; }
        float se = 0.f;
#pragma unroll
        for (int q = 0; q < 4; ++q) se += expf(lg[q] - mx);
        const float gate_group = 1.0f / se;
        f32x2 le01 = (f32x2){0.f, 0.f}, le23 = (f32x2){0.f, 0.f}, le45 = (f32x2){0.f, 0.f}, le67 = (f32x2){0.f, 0.f};
#pragma unroll
        for (int i = 0; i < 4; ++i)
#pragma unroll
            for (int e = 0; e < 4; ++e) { const f32x4* wp = Le + grp * 2048 + ((i * 4 + e) << 6) + lane; const f32x4 w0 = wp[0], w1 = wp[1024]; const f32x2 vv = (f32x2){v[i][e], v[i][e]};
                le01 += vv * (f32x2){w0[0], w0[1]}; le23 += vv * (f32x2){w0[2], w0[3]}; le45 += vv * (f32x2){w1[0], w1[1]}; le67 += vv * (f32x2){w1[2], w1[3]}; }
        float le[8] = {wave_sum(le01[0]), wave_sum(le01[1]), wave_sum(le23[0]), wave_sum(le23[1]), wave_sum(le45[0]), wave_sum(le45[1]), wave_sum(le67[0]), wave_sum(le67[1])};
        int j1 = 0; float l1 = le[0];
#pragma unroll
        for (int q = 1; q < 8; ++q) if (le[q] > l1) { l1 = le[q]; j1 = q; }
        int j2 = -1; float l2 = -3.0e38f;
#pragma unroll
        for (int q = 0; q < 8; ++q) if (q != j1 && le[q] > l2) { l2 = le[q]; j2 = q; }
        const float e2 = expf(l2 - l1), p1 = 1.0f / (1.0f + e2), p2 = e2 / (1.0f + e2);
        if (lane == 0) {
            const int ex0 = grp * 8 + j1, ex1 = grp * 8 + j2;
            const int r0 = atomicAdd(&cnt[ex0], 1), r1 = atomicAdd(&cnt[ex1], 1);
            tokE[2 * t] = ex0; tokE[2 * t + 1] = ex1; tokR[2 * t] = r0; tokR[2 * t + 1] = r1;
            tokG[2 * t] = gate_group * p1; tokG[2 * t + 1] = gate_group * p2;
        }
    }
    __syncthreads();
    if (tid < 32) ((int*)(a->ws + WS_BCNT))[((size_t)l * MAXG + blockIdx.x) * 32 + tid] = cnt[tid];
    __syncthreads();
}

__device__ __forceinline__ void p5_dispatch(AP a, unsigned char* lds, int l) {
    const int tid = tid_opaque();
    const int ntok = (l == 0) ? NTOK : NLAT;
    int* part = (int*)lds;
    int* tot = (int*)(lds + 4096);
    int* off = (int*)(lds + 4096 + 128);
    int* pstart = (int*)(lds + 4096 + 256);
    const int* bc = (const int*)(a->ws + WS_BCNT) + (size_t)l * MAXG * 32;
    const int G = gridDim.x, me = blockIdx.x;
    { const int e = tid & 31, p = tid >> 5; int s = 0, so = 0; for (int bb = p; bb < G; bb += 16) { const int c = bc[bb * 32 + e]; s += c; if (bb < me) so += c; } part[p * 32 + e] = s; part[512 + p * 32 + e] = so; }
    __syncthreads();
    if (tid < 32) { int s = 0, so = 0; for (int p = 0; p < 16; ++p) { s += part[p * 32 + tid]; so += part[512 + p * 32 + tid]; } tot[tid] = s; off[tid] = so; }
    __syncthreads();
    if (tid == 0) { int acc = 0; for (int e = 0; e < 32; ++e) { pstart[e] = acc; acc += ((tot[e] + 255) >> 8) << 8; } }
    __syncthreads();
    if (me == 0 && tid < 32) ((int*)(a->ws + WS_CNT))[l * 32 + tid] = tot[tid];
    const int* tokE = (const int*)(a->ws + WS_TOKE); const int* tokR = (const int*)(a->ws + WS_TOKR);
    int* tokS = (int*)(a->ws + WS_TOKS); int* slotT = (int*)(a->ws + WS_SLOTT);
    for (int q = tid; ; q += NT) { const int it = q >> 4, j = q & 15, t = (it * G + me) * 8 + (j >> 1); if (t >= ntok) break;
        const int idx = 2 * t + (j & 1); const int e = tokE[idx]; const int slot = pstart[e] + off[e] + tokR[idx]; tokS[idx] = slot; slotT[slot] = t; }
    __syncthreads();
}

__device__ __forceinline__ void moe_table(AP a, int l, LAS int* blk) {
    const int* tot = (const int*)(a->ws + WS_CNT) + l * 32;
    if (threadIdx.x == 0) { int acc = 0; for (int e = 0; e < 32; ++e) { const int c = tot[e]; blk[e] = acc; blk[33 + e] = c; acc += (c + 255) >> 8; } blk[32] = acc; }
    __syncthreads();
}
__device__ __forceinline__ int units_of(int nu, int v, int G) { return (v < nu) ? (nu - v + G - 1) / G : 0; }
__device__ __forceinline__ void p1_inproj(AP a, unsigned char* smem, LAS unsigned char* lds, int l) {
    SchedInProj S; S.ws = a->ws; S.l = l; S.G = gridDim.x; S.me = vblock();
    g256::gemm_phase(lds, 1024, S);
    if (l == 0) { const int nu = 64 * 7 + 4 * 7, G = gridDim.x; if (units_of(nu, S.me, G) < (nu + G - 1) / G) exp_fill(a, smem, 0, 8); }
}
__device__ __forceinline__ void p3_outproj(AP a, unsigned char* smem, LAS unsigned char* lds, int l) {
    SchedOutProj S; S.ws = a->ws; S.l = l; S.G = gridDim.x; S.me = vblock();
    g256::gemm_phase(lds, 1024, S);
    if (l == 0) {
        const bf16_t* W = (const bf16_t*)(a->ws + WS_WOUT);
        for (int u = blockIdx.x; u < 64; u += gridDim.x) { const int rt = u >> 3, ct = u & 7;
            EpiBf16 E; E.C = (bf16_t*)(a->ws + WS_Y) + (size_t)(NLAT + rt * 128) * D + ct * 128; E.ld = D; E.scale = 1.0f;
            const bf16_t* B0 = W + (size_t)(ct * 128) * 1024;
            gemm_tile<128, false, EpiBf16>(lds, (const bf16_t*)(a->ws + WS_CAT) + (size_t)(NLAT + rt * 128) * D, D, nullptr, 128, B0, B0 + (size_t)64 * 1024, 1024, 1024, E); }
        if (blockIdx.x >= 64) exp_fill(a, smem, 0, 3);
    }
}
__device__ __forceinline__ void p6_gateup(AP a, unsigned char* smem, LAS unsigned char* lds, int l) {
    LAS int* blk = (LAS int*)(lds + MISC_OFF + 256);
    moe_table(a, l, blk);
    LAS int* ridx = (LAS int*)(lds + RIDX_OFF);
    const int tid = tid_opaque(), G = gridDim.x, me = vblock(), nu = blk[32] * 4;
    const int* slotT = (const int*)(a->ws + WS_SLOTT);
    for (int i = 0; i < 8; ++i) { const int idx = i * G + me; if (idx >= nu) break;
        const int rb = idx >> 2; int e = 0; for (int q = 1; q < 32; ++q) if (blk[q] <= rb) e = q;
        const int valid = min(256, blk[33 + e] - (rb - blk[e]) * 256);
        if (tid < 256) ridx[i * 256 + tid] = (tid < valid) ? slotT[rb * 256 + tid] : 0; }
    __syncthreads();
    SchedGateUp S; S.ws = a->ws; S.blk = blk; S.tot = blk + 33; S.ridx_lds = ridx; S.G = G; S.me = me; S.l = l;
    g256::gemm_phase(lds, 512, S);
    __syncthreads();
    if (l == 0 && units_of(nu, me, G) < (nu + G - 1) / G) exp_fill(a, smem, 1, 4);
}
__device__ __forceinline__ void p7_down(AP a, unsigned char* smem, LAS unsigned char* lds, int l) {
    LAS int* blk = (LAS int*)(lds + MISC_OFF + 256);
    moe_table(a, l, blk);
    SchedDown S; S.ws = a->ws; S.blk = blk; S.G = gridDim.x; S.me = vblock(); S.l = l;
    g256::gemm_phase(lds, 256, S);
    __syncthreads();
    { const int nu = uni(blk[32]) * 4, G = gridDim.x; if (l == 0 && units_of(nu, S.me, G) < (nu + G - 1) / G) exp_fill(a, smem, 1, 2); }
}

__device__ __forceinline__ void p8_ln2(AP a, unsigned char* lds, int l) {
    const int tid = tid_opaque(), lane = tid & 63, w = tid >> 6;
    const int ntok = (l == 0) ? NTOK : NLAT;
    const float* mod = (const float*)(a->ws + WS_MOD) + (size_t)l * 5 * 6144;
    const float* modn = (const float*)(a->ws + WS_MOD) + (size_t)5 * 6144;
    const float* X1 = (const float*)(a->ws + WS_X1);
    const unsigned char* YS = a->ws + WS_YS;
    const int* tokS = (const int*)(a->ws + WS_TOKS); const float* tokG = (const float*)(a->ws + WS_TOKG);
    f32x4* Lgb = (f32x4*)lds;
    __syncthreads();
    Lgb[tid] = (tid < 256) ? *(const f32x4*)(a->in[21] + l * 1024 + tid * 4) : *(const f32x4*)(a->in[22] + l * 1024 + (tid - 256) * 4);
    __syncthreads();
    int mrow = -1; f32x4 mg[4], nsh[4], nsc[4];
    const int tstep = gridDim.x * 8;
    int t = blockIdx.x * 8 + w;
    int ns0 = 0, ns1 = 0; float nga = 0.f, ngb = 0.f;
    f32x4 nx[4]; unsigned nya[4], nyb[4];
    float cga = 0.f, cgb = 0.f;
    if (t < ntok) { const int s0 = tokS[2 * t], s1 = tokS[2 * t + 1]; cga = tokG[2 * t]; cgb = tokG[2 * t + 1];
#pragma unroll
        for (int i = 0; i < 4; ++i) { const int c = 256 * i + 4 * lane; nx[i] = *(const f32x4*)(X1 + (size_t)t * D + c); nya[i] = *(const unsigned*)(YS + (size_t)s0 * D + c); nyb[i] = *(const unsigned*)(YS + (size_t)s1 * D + c); } }
    if (t + tstep < ntok) { ns0 = tokS[2 * (t + tstep)]; ns1 = tokS[2 * (t + tstep) + 1]; nga = tokG[2 * (t + tstep)]; ngb = tokG[2 * (t + tstep) + 1]; }
    for (; t < ntok; t += tstep) {
        const int mr = (t < NLAT) ? (t >> 12) : 4;
        if (mr != mrow) { mrow = mr; const float* m = mod + (size_t)mr * 6144; const float* mn = modn + (size_t)mr * 6144;
#pragma unroll
            for (int i = 0; i < 4; ++i) { const int c = 256 * i + 4 * lane; mg[i] = *(const f32x4*)(m + 5120 + c); if (l == 0) { nsh[i] = *(const f32x4*)(mn + c); nsc[i] = *(const f32x4*)(mn + 1024 + c); } } }
        f32x4 v[4];
#pragma unroll
        for (int i = 0; i < 4; ++i) { const f32x4 gv = mg[i];
            const f32x2 ya0 = __builtin_amdgcn_cvt_pk_f32_fp8(nya[i], false), ya1 = __builtin_amdgcn_cvt_pk_f32_fp8(nya[i], true), yb0 = __builtin_amdgcn_cvt_pk_f32_fp8(nyb[i], false), yb1 = __builtin_amdgcn_cvt_pk_f32_fp8(nyb[i], true);
            const float f0 = cga * ya0[0] + cgb * yb0[0], f1 = cga * ya0[1] + cgb * yb0[1], f2 = cga * ya1[0] + cgb * yb1[0], f3 = cga * ya1[1] + cgb * yb1[1];
            v[i][0] = RES_ALPHA * nx[i][0] + gv[0] * f0; v[i][1] = RES_ALPHA * nx[i][1] + gv[1] * f1; v[i][2] = RES_ALPHA * nx[i][2] + gv[2] * f2; v[i][3] = RES_ALPHA * nx[i][3] + gv[3] * f3; }
        {   const int tn = t + tstep, tn2 = t + 2 * tstep;
            if (tn < ntok) {
#pragma unroll
                for (int i = 0; i < 4; ++i) { const int c = 256 * i + 4 * lane; nx[i] = *(const f32x4*)(X1 + (size_t)tn * D + c); nya[i] = *(const unsigned*)(YS + (size_t)ns0 * D + c); nyb[i] = *(const unsigned*)(YS + (size_t)ns1 * D + c); }
                cga = nga; cgb = ngb; }
            if (tn2 < ntok) { ns0 = tokS[2 * tn2]; ns1 = tokS[2 * tn2 + 1]; nga = tokG[2 * tn2]; ngb = tokG[2 * tn2 + 1]; } }
        float mean, rstd; ln_stats(v, mean, rstd);
        float* dst = (l == 0) ? (float*)(a->ws + WS_XC) + (size_t)t * D : a->out + (size_t)t * D;
#pragma unroll
        for (int i = 0; i < 4; ++i) { const int c = 256 * i + 4 * lane; const f32x4 gg = Lgb[64 * i + lane], bb = Lgb[256 + 64 * i + lane];
#pragma unroll
            for (int e = 0; e < 4; ++e) v[i][e] = (v[i][e] - mean) * rstd * gg[e] + bb[e];
            *(f32x4*)(dst + c) = v[i]; }
        if (l == 0) {
            ln_stats(v, mean, rstd);
            bf16_t* H = (bf16_t*)(a->ws + WS_H);
#pragma unroll
            for (int i = 0; i < 4; ++i) { const int c = 256 * i + 4 * lane; const f32x4 sh = nsh[i], sc = nsc[i];
                f32x4 o;
#pragma unroll
                for (int e = 0; e < 4; ++e) o[e] = (v[i][e] - mean) * rstd * (1.0f + sc[e]) + sh[e];
                u32x2 pk; pk.x = pack2(o[0], o[1]); pk.y = pack2(o[2], o[3]); *(u32x2*)(H + (size_t)t * D + c) = pk; }
        }
    }
}

constexpr int N_PHASES = 18;
template <int P> __device__ __forceinline__ void run_phase(AP a, unsigned char* smem, LAS unsigned char* lds, int l) {
    asm volatile("" : "+s"(a));
    if (P == 0) p0_prologue(a, smem);
    if (P == 1) p_lnmod0(a);
    if (P == 2) p1_inproj(a, smem, lds, l);
    if (P == 3) p2_mix(a, smem, lds, l);
    if (P == 4) p3_outproj(a, smem, lds, l);
    if (P == 5) p4_ln1_router(a, smem, l);
    if (P == 6) p5_dispatch(a, smem, l);
    if (P == 7) p6_gateup(a, smem, lds, l);
    if (P == 8) p7_down(a, smem, lds, l);
    if (P == 9) p8_ln2(a, smem, l);
}
#if N_LAUNCH_MODE == 1
__global__ void __launch_bounds__(NT, 2) fwd(Args a) {
    extern __shared__ __attribute__((aligned(16))) unsigned char smem[];
    LAS unsigned char* lds = (LAS unsigned char*)smem;
    if (threadIdx.x < 4) ((volatile LAS unsigned*)(lds + MISC_OFF + 768))[threadIdx.x] = 0u;
    __syncthreads();
    XcdBarrier bar = xcd_barrier_post((unsigned*)(a.ws + WS_BAR), (volatile LAS unsigned*)(lds + MISC_OFF + 768));
    AP ap = (AP)__builtin_amdgcn_kernarg_segment_ptr();
#define PROBE(P, l) do { if (PROBE_MASK & (1 << (P))) { for (int _r = 0; _r < 2; ++_r) { xcd_barrier(bar); run_phase<P>(ap, smem, lds, l); } } } while (0)
    run_phase<0>(ap, smem, lds, 0); PROBE(0, 0); xcd_barrier(bar);
    run_phase<1>(ap, smem, lds, 0); PROBE(1, 0); xcd_barrier(bar);
    for (int l = 0; l < 2; ++l) {
        run_phase<2>(ap, smem, lds, l); PROBE(2, l); xcd_barrier(bar);
        run_phase<3>(ap, smem, lds, l); PROBE(3, l); xcd_barrier(bar);
        run_phase<4>(ap, smem, lds, l); PROBE(4, l); xcd_barrier(bar);
        run_phase<5>(ap, smem, lds, l); PROBE(5, l); xcd_barrier(bar);
        run_phase<6>(ap, smem, lds, l); PROBE(6, l); xcd_barrier(bar);
        run_phase<7>(ap, smem, lds, l); PROBE(7, l); xcd_barrier(bar);
        run_phase<8>(ap, smem, lds, l); PROBE(8, l); xcd_barrier(bar);
        run_phase<9>(ap, smem, lds, l); PROBE(9, l); if (l == 0) xcd_barrier(bar);
    }
}
#else
template <int P> __global__ void __launch_bounds__(NT, 2) k_phase(Args a) {
    extern __shared__ __attribute__((aligned(16))) unsigned char smem[];
    LAS unsigned char* lds = (LAS unsigned char*)smem;
    AP ap = (AP)__builtin_amdgcn_kernarg_segment_ptr();
    run_phase<P>(ap, smem, lds, ap->ph_lo);
}
template <int P> static void launch_phase(Args a, int l, int grid, hipStream_t stream) {
    static bool attr = false;
    if (!attr) { (void)hipFuncSetAttribute((const void*)k_phase<P>, hipFuncAttributeMaxDynamicSharedMemorySize, LDS_BYTES); attr = true; }
    a.ph_lo = l; a.ph_hi = P;
    hipLaunchKernelGGL(k_phase<P>, dim3(grid), dim3(NT), LDS_BYTES, stream, a);
}
#endif

extern "C" void kernel_launch(void* const* d_in, const int* in_sizes, int n_in, void* d_out, int out_size, void* d_ws, size_t ws_size, hipStream_t stream) {
    static int grid = 0;
    if (grid == 0) {
        if (n_in != 23 || out_size != NLAT * D || ws_size < WS_END) { fprintf(stderr, "kernel_launch: unexpected shapes (n_in %d, out %d, ws %zu, need %zu)\n", n_in, out_size, ws_size, (size_t)WS_END); grid = -1; return; }
        int dev = 0, cus = 0;
        if (hipGetDevice(&dev) != hipSuccess || hipDeviceGetAttribute(&cus, hipDeviceAttributeMultiprocessorCount, dev) != hipSuccess) { grid = -1; return; }
#if N_LAUNCH_MODE == 1
        int per_cu = 0;
        if (hipFuncSetAttribute((const void*)fwd, hipFuncAttributeMaxDynamicSharedMemorySize, LDS_BYTES) != hipSuccess) { fprintf(stderr, "kernel_launch: hipFuncSetAttribute failed\n"); grid = -1; return; }
        if (hipOccupancyMaxActiveBlocksPerMultiprocessor(&per_cu, (const void*)fwd, NT, LDS_BYTES) != hipSuccess || per_cu < 1) { fprintf(stderr, "kernel_launch: occupancy query says %d\n", per_cu); }
        (void)hipGetLastError();
#endif
        grid = cus; if (grid > MAXG) grid = MAXG;
    }
    if (grid < 0) return;
    (void)hipMemsetAsync((char*)d_ws + WS_BAR, 0, 16384 + 256, stream);
    Args a{};
    for (int i = 0; i < 23; ++i) a.in[i] = (const float*)d_in[i];
    a.out = (float*)d_out; a.ws = (unsigned char*)d_ws;
#if N_LAUNCH_MODE == 1
    a.ph_lo = 0; a.ph_hi = N_PHASES;
    hipLaunchKernelGGL(fwd, dim3(grid), dim3(NT), LDS_BYTES, stream, a);
#else
    launch_phase<0>(a, 0, grid, stream);
    launch_phase<1>(a, 0, grid, stream);
    for (int l = 0; l < 2; ++l) {
        launch_phase<2>(a, l, grid, stream); launch_phase<3>(a, l, grid, stream); launch_phase<4>(a, l, grid, stream); launch_phase<5>(a, l, grid, stream);
        launch_phase<6>(a, l, grid, stream); launch_phase<7>(a, l, grid, stream); launch_phase<8>(a, l, grid, stream); launch_phase<9>(a, l, grid, stream);
    }
#endif
}
```

```cpp
#include <hip/hip_runtime.h>
#include <stdint.h>
#include <stdio.h>

#ifndef PROBE_MASK
#define PROBE_MASK 0
#endif
#ifndef PROBE_FFT_REP
#define PROBE_FFT_REP 1
#endif
#ifndef PROBE_MIX_REP
#define PROBE_MIX_REP 1
#endif
#ifndef PROBE_SGU_REP
#define PROBE_SGU_REP 1
#endif
#ifndef N_LAUNCH_MODE
#define N_LAUNCH_MODE 1
#endif

#define LAS __attribute__((address_space(3)))
typedef unsigned short bf16_t;
typedef short bf16x8 __attribute__((ext_vector_type(8)));
typedef float f32x4 __attribute__((ext_vector_type(4)));
typedef unsigned u32x4 __attribute__((ext_vector_type(4)));
typedef unsigned u32x2 __attribute__((ext_vector_type(2)));
typedef float f32x2 __attribute__((ext_vector_type(2)));
typedef int i32x4 __attribute__((ext_vector_type(4)));

constexpr int D = 1024, NBATCH = 4, SEQ = 4096, CTXL = 256;
constexpr int NLAT = NBATCH * SEQ, NCTX = NBATCH * CTXL, NTOK = NLAT + NCTX;
constexpr int ZC = 1792;
constexpr int NEXP = 32, DEXP = 512;
constexpr int NSLOT = 2 * NTOK + NEXP * 256;
constexpr int NT = 512;
constexpr int MAXG = 512;
constexpr float RES_ALPHA = 1.41421356237309515f;
constexpr int MISC_OFF = 155648;
constexpr int RIDX_OFF = 131072;
constexpr int LDS_BYTES = MISC_OFF + 1024;

constexpr size_t WS_BAR   = 0;
constexpr size_t WS_CNT   = 16384;
constexpr size_t WS_BCNT  = WS_CNT + 256;
constexpr size_t WS_MOD   = WS_BCNT + (size_t)2 * MAXG * 32 * 4;
constexpr size_t WS_ROPE  = WS_MOD + (size_t)2 * 5 * 6144 * 4;
constexpr size_t WS_TOKE  = WS_ROPE + 8192;
constexpr size_t WS_TOKR  = WS_TOKE + (size_t)NTOK * 8;
constexpr size_t WS_TOKS  = WS_TOKR + (size_t)NTOK * 8;
constexpr size_t WS_TOKG  = WS_TOKS + (size_t)NTOK * 8;
constexpr size_t WS_SLOTT = WS_TOKG + (size_t)NTOK * 8;
constexpr size_t WS_WIN   = WS_SLOTT + (size_t)NSLOT * 4;
constexpr size_t WS_WOUT  = WS_WIN + (size_t)2 * ZC * 1024 * 2;
constexpr size_t WS_WSGU  = WS_WOUT + (size_t)2 * 1024 * 1024 * 2;
constexpr size_t WS_DFTC  = WS_WSGU + (size_t)2 * 4 * 128 * 128 * 2;
constexpr size_t WS_WEXP  = WS_DFTC + (size_t)256 * 512 * 2;
constexpr size_t EXPMAT   = (size_t)NEXP * 512 * 1024;
constexpr size_t WEXP_LAYER = 3 * EXPMAT;
constexpr size_t WS_X1    = WS_WEXP + 2 * WEXP_LAYER;
constexpr size_t WS_XC    = WS_X1 + (size_t)NTOK * D * 4;
constexpr size_t WS_H     = WS_XC + (size_t)NTOK * D * 4;
constexpr size_t WS_R     = WS_H + (size_t)NTOK * D * 2;
constexpr size_t WS_Z     = WS_R;
constexpr size_t WS_AT    = WS_Z + (size_t)NTOK * ZC * 2;
constexpr size_t WS_ATC   = WS_AT + (size_t)4 * 256 * 8192 * 2;
constexpr size_t WS_VT    = WS_ATC + (size_t)4 * 256 * 512 * 2;
constexpr size_t WS_VTC   = WS_VT + (size_t)4 * 2 * 64 * 4096 * 2;
constexpr size_t WS_CAT   = WS_VTC + (size_t)4 * 2 * 64 * 256 * 2;
constexpr size_t WS_REND  = WS_CAT + (size_t)NTOK * D * 2;
constexpr size_t WS_Y     = WS_R;
constexpr size_t WS_HID   = WS_R;
constexpr size_t WS_YS    = WS_HID + (size_t)NSLOT * DEXP * 2;
constexpr size_t WS_REND2 = (WS_YS + (size_t)NSLOT * D * 2 > WS_REND) ? WS_YS + (size_t)NSLOT * D * 2 : WS_REND;
constexpr size_t WS_H8    = (WS_REND2 + 255) & ~(size_t)255;
constexpr size_t WS_END   = WS_H8 + (size_t)NTOK * D;
static_assert(WS_Y + (size_t)NTOK * D * 4 <= WS_CAT, "Y must not reach CAT");
static_assert(WS_WIN % 256 == 0 && WS_DFTC % 256 == 0 && WS_WEXP % 256 == 0 && WS_X1 % 256 == 0 && WS_H % 256 == 0 && WS_R % 256 == 0 && WS_AT % 256 == 0 && WS_CAT % 256 == 0 && WS_YS % 256 == 0, "alignment");

struct Args { const float* in[23]; float* out; unsigned char* ws; int ph_lo, ph_hi; };
#define CAS __attribute__((address_space(4)))
typedef const CAS Args* AP;

#define XB_TMO      128
#define XB_XCNT(j)  (256  + 64 * (j))
#define XB_XSUB(j)  (1280 + 64 * (j))
#define XB_XGEN(j)  (2304 + 64 * (j))
#define XB_TOP      3328
#define XB_TOPGEN   3392
#define XCD_BAR_WORDS 3456
#define XB_SPIN_CAP (1u << 18)

__device__ __forceinline__ unsigned xb_ld(unsigned* p)              { return __hip_atomic_load(p, __ATOMIC_RELAXED, __HIP_MEMORY_SCOPE_AGENT); }
__device__ __forceinline__ unsigned xb_add(unsigned* p, unsigned v) { return __hip_atomic_fetch_add(p, v, __ATOMIC_RELAXED, __HIP_MEMORY_SCOPE_AGENT); }
__device__ __forceinline__ unsigned xb_xcc_id() { return (unsigned)__builtin_amdgcn_s_getreg((3 << 11) | 20) & 0xFu; }
#define XB_SPIN(cond, bar) do { unsigned _sp = 0; while (cond) { __builtin_amdgcn_s_sleep(1); \
    if ((++_sp & 255u) == 0u) { if (xb_ld(&(bar)[XB_TMO])) break; if (_sp > XB_SPIN_CAP) { atomicAdd(&(bar)[XB_TMO], 1u); break; } } } } while (0)

struct XcdBarrier { unsigned* bar; unsigned x; volatile LAS unsigned* st; };

__device__ __forceinline__ XcdBarrier xcd_barrier_post(unsigned* bar, volatile LAS unsigned* st) {
    XcdBarrier b; b.bar = bar; b.x = (unsigned)__builtin_amdgcn_readfirstlane((int)xb_xcc_id()); b.st = st;
    if (threadIdx.x == 0) (void)xb_add(&bar[XB_XCNT(b.x)], 1u);
    return b;
}
__device__ __forceinline__ void xcd_barrier_complete(unsigned* bar, unsigned x, unsigned& nloc, unsigned& nx) {
    const unsigned G = gridDim.x * gridDim.y * gridDim.z;
    unsigned sum, cnt, mine, sp = 0u;
    for (;;) {
        sum = 0u; cnt = 0u; mine = 0u;
#pragma unroll
        for (unsigned j = 0; j < 16; ++j) { const unsigned c = xb_ld(&bar[XB_XCNT(j)]); sum += c; cnt += (c > 0u) ? 1u : 0u; mine = (j == x) ? c : mine; }
        if (sum == G) break;
        __builtin_amdgcn_s_sleep(1);
        if ((++sp & 255u) == 0u) { if (xb_ld(&bar[XB_TMO])) break; if (sp > XB_SPIN_CAP) { atomicAdd(&bar[XB_TMO], 1u); break; } }
    }
    nloc = mine > 0u ? mine : 1u; nx = cnt > 0u ? cnt : 1u;
}
__device__ __forceinline__ void xcd_barrier(const XcdBarrier& b) {
    asm volatile("s_waitcnt vmcnt(0)" ::: "memory");
    __syncthreads();
    if (threadIdx.x == 0) {
        unsigned* bar = b.bar;
        unsigned bx = b.x;
        asm volatile("" : "+s"(bar), "+s"(bx));
        __builtin_amdgcn_s_waitcnt(0);
        unsigned nloc = b.st[0], nx = b.st[1];
        if (nloc == 0u) { xcd_barrier_complete(bar, bx, nloc, nx); b.st[0] = nloc; b.st[1] = nx; }
        const unsigned old = xb_add(&bar[XB_XSUB(bx)], 1u);
        const unsigned gen = old / nloc;
        if (old + 1u == (gen + 1u) * nloc) {
            __builtin_amdgcn_fence(__ATOMIC_RELEASE, "agent");
            asm volatile("s_waitcnt vmcnt(0)" ::: "memory");
            const unsigned og = xb_add(&bar[XB_TOP], 1u);
            const unsigned tg = og / nx;
            if (og + 1u == (tg + 1u) * nx) xb_add(&bar[XB_TOPGEN], 1u);
            else XB_SPIN(xb_ld(&bar[XB_TOPGEN]) == tg, bar);
            __builtin_amdgcn_fence(__ATOMIC_ACQUIRE, "agent");
            xb_add(&bar[XB_XGEN(bx)], 1u);
            asm volatile("s_waitcnt vmcnt(0)" ::: "memory");
        } else {
            XB_SPIN(xb_ld(&bar[XB_XGEN(bx)]) == gen, bar);
            __builtin_amdgcn_fence(__ATOMIC_ACQUIRE, "agent");
            asm volatile("s_waitcnt vmcnt(0)" ::: "memory");
        }
    }
    __syncthreads();
}

__device__ __forceinline__ int tid_opaque() { int t = threadIdx.x; asm volatile("" : "+v"(t)); return t; }
__device__ __forceinline__ float bf2f(bf16_t v) { return __uint_as_float(((unsigned)v) << 16); }
__device__ __forceinline__ bf16_t f2bf(float f) { return __builtin_bit_cast(unsigned short, (__bf16)f); }
typedef __bf16 hwbf16x2 __attribute__((ext_vector_type(2)));
__device__ __forceinline__ unsigned pack2(float a, float b) { return __builtin_bit_cast(unsigned, __builtin_convertvector((f32x2){a, b}, hwbf16x2)); }
__device__ __forceinline__ unsigned pack4_fp8(float a, float b, float c, float d) {
    a = __builtin_amdgcn_fmed3f(a, -448.f, 448.f); b = __builtin_amdgcn_fmed3f(b, -448.f, 448.f); c = __builtin_amdgcn_fmed3f(c, -448.f, 448.f); d = __builtin_amdgcn_fmed3f(d, -448.f, 448.f);
    int p = __builtin_amdgcn_cvt_pk_fp8_f32(a, b, 0, false); p = __builtin_amdgcn_cvt_pk_fp8_f32(c, d, p, true); return (unsigned)p; }
__device__ __forceinline__ float lo2f(unsigned w) { return __uint_as_float(w << 16); }
__device__ __forceinline__ float hi2f(unsigned w) { return __uint_as_float(w & 0xffff0000u); }
template <int CTRL> __device__ __forceinline__ float dpp_mov(float v) { return __builtin_bit_cast(float, __builtin_amdgcn_update_dpp(0, __builtin_bit_cast(int, v), CTRL, 0xf, 0xf, true)); }
__device__ __forceinline__ float row_sum16(float v) {
    v += dpp_mov<0xB1>(v);
    v += dpp_mov<0x4E>(v);
    v += dpp_mov<0x141>(v);
    v += dpp_mov<0x140>(v);
    return v;
}
__device__ __forceinline__ float row_max16(float v) {
    v = fmaxf(v, dpp_mov<0xB1>(v)); v = fmaxf(v, dpp_mov<0x4E>(v)); v = fmaxf(v, dpp_mov<0x141>(v)); v = fmaxf(v, dpp_mov<0x140>(v));
    return v;
}
__device__ __forceinline__ float wave_sum(float v) {
    v = row_sum16(v);
    const int iv = __builtin_bit_cast(int, v);
    const float a0 = __builtin_bit_cast(float, __builtin_amdgcn_readlane(iv, 0)), a1 = __builtin_bit_cast(float, __builtin_amdgcn_readlane(iv, 16));
    const float a2 = __builtin_bit_cast(float, __builtin_amdgcn_readlane(iv, 32)), a3 = __builtin_bit_cast(float, __builtin_amdgcn_readlane(iv, 48));
    return (a0 + a1) + (a2 + a3);
}
__device__ __forceinline__ float gelu_erf(float v) {
    const float t = __builtin_amdgcn_rcpf(fabsf(v) * 0.2316418882f + 1.0f);
    float q = t * 0.5307027145f + (-0.7265760135f); q = q * t + 0.7107068705f; q = q * t + (-0.142248368f); q = q * t + 0.127414796f; q = q * t;
    const float m = v * (q * __builtin_amdgcn_exp2f((v * v) * (-0.72134752044f)));
    return v < 0.f ? m : v - m;
}
__device__ __forceinline__ float silu_f(float x) { return x * __builtin_amdgcn_rcpf(1.0f + __expf(-x)); }

__device__ __forceinline__ void ln_stats(const f32x4 (&v)[4], float& mean, float& rstd) {
    float s = 0.f;
#pragma unroll
    for (int i = 0; i < 4; ++i) s += (v[i][0] + v[i][1]) + (v[i][2] + v[i][3]);
    s = wave_sum(s); mean = s * (1.0f / 1024.0f);
    float q = 0.f;
#pragma unroll
    for (int i = 0; i < 4; ++i)
#pragma unroll
        for (int e = 0; e < 4; ++e) { const float d = v[i][e] - mean; q += d * d; }
    q = wave_sum(q); rstd = 1.0f / sqrtf(q * (1.0f / 1024.0f) + 1e-6f);
}

template <int BN> struct MfmaLayout {
    static constexpr int FG = BN / 128, NI = 4, NJ = 2 * FG;
    static constexpr bool PAIR8 = false;
    int rbase, cbase;
    __device__ __forceinline__ int row(int i) const { return rbase + 16 * i; }
    __device__ __forceinline__ int col(int jj) const { return (jj / FG) * (BN / 2) + (jj % FG) * 16 + cbase; }
};

__device__ __forceinline__ void glds16(const bf16_t* g, LAS unsigned char* l) {
    __builtin_amdgcn_global_load_lds((const unsigned*)g, (LAS unsigned*)l, 16, 0, 0);
}

template <int BN, bool GATHER, class Epi>
__device__ __forceinline__ void gemm_tile(LAS unsigned char* lds, const bf16_t* A, int lda, const int* rowidx, int valid_rows,
                                          const bf16_t* B0, const bf16_t* B1, int ldb, int K, const Epi& epi) {
    constexpr int A_B = 16384, B_B = BN * 128, STAGE = A_B + B_B, NBL = BN / 64;
    const int tid = tid_opaque(), lane = tid & 63, wid = __builtin_amdgcn_readfirstlane(tid >> 6);
    const bf16_t* ap[2]; const bf16_t* bp[NBL];
#pragma unroll
    for (int i = 0; i < 2; ++i) {
        const int P = i * 512 + tid, row = P >> 3, c = (P & 7) ^ ((row >> 1) & 7);
        size_t ro;
        if (GATHER) ro = (size_t)(row < valid_rows ? rowidx[row] : 0) * (size_t)lda; else ro = (size_t)row * (size_t)lda;
        ap[i] = A + ro + c * 8;
    }
#pragma unroll
    for (int i = 0; i < NBL; ++i) {
        const int P = i * 512 + tid, row = P >> 3, c = (P & 7) ^ ((row >> 1) & 7);
        const bf16_t* base = (row < BN / 2) ? (B0 + (size_t)row * ldb) : (B1 + (size_t)(row - BN / 2) * ldb);
        bp[i] = base + c * 8;
    }
    const int nk = K / 64;
#define GT_STAGE(buf, k0) do { \
        _Pragma("unroll") for (int _i = 0; _i < 2; ++_i) glds16(ap[_i] + (k0), lds + (buf) * STAGE + _i * 8192 + wid * 1024); \
        _Pragma("unroll") for (int _i = 0; _i < NBL; ++_i) glds16(bp[_i] + (k0), lds + (buf) * STAGE + A_B + _i * 8192 + wid * 1024); } while (0)

    typedef MfmaLayout<BN> Lay;
    constexpr int FG = Lay::FG;
    const int fr = lane & 15, g = lane >> 4, wr = wid >> 2, wc = wid & 3;
    Lay lay; lay.rbase = wr * 64 + fr; lay.cbase = wc * 16 * FG + 4 * g;
    f32x4 acc[Lay::NI][Lay::NJ];
#pragma unroll
    for (int i = 0; i < Lay::NI; ++i)
#pragma unroll
        for (int j = 0; j < Lay::NJ; ++j) acc[i][j] = (f32x4){0.f, 0.f, 0.f, 0.f};
    int aoff[4], boff[Lay::NJ];
#pragma unroll
    for (int m = 0; m < 4; ++m) { const int row = wr * 64 + m * 16 + fr; aoff[m] = row * 128 + ((g ^ ((row >> 1) & 7)) << 4); }
#pragma unroll
    for (int jj = 0; jj < Lay::NJ; ++jj) { const int row = (jj / FG) * (BN / 2) + wc * 16 * FG + (jj % FG) * 16 + fr; boff[jj] = A_B + row * 128 + ((g ^ ((row >> 1) & 7)) << 4); }
    GT_STAGE(0, 0);
    asm volatile("s_waitcnt vmcnt(0)" ::: "memory"); __syncthreads();
    for (int kt = 0; kt < nk; ++kt) {
        if (kt + 1 < nk) GT_STAGE((kt + 1) & 1, (kt + 1) * 64);
        const LAS unsigned char* sa = lds + (kt & 1) * STAGE;
#pragma unroll
        for (int ks = 0; ks < 2; ++ks) {
            bf16x8 af[4], bfv[Lay::NJ];
#pragma unroll
            for (int m = 0; m < 4; ++m) af[m] = *(const LAS bf16x8*)(sa + (aoff[m] ^ (ks << 6)));
#pragma unroll
            for (int jj = 0; jj < Lay::NJ; ++jj) bfv[jj] = *(const LAS bf16x8*)(sa + (boff[jj] ^ (ks << 6)));
#pragma unroll
            for (int m = 0; m < 4; ++m)
#pragma unroll
                for (int jj = 0; jj < Lay::NJ; ++jj) acc[m][jj] = __builtin_amdgcn_mfma_f32_16x16x32_bf16(bfv[jj], af[m], acc[m][jj], 0, 0, 0);
        }
        asm volatile("s_waitcnt vmcnt(0)" ::: "memory"); __syncthreads();
    }
    epi.run(acc, lay);
#undef GT_STAGE
}

namespace g256 {
constexpr int BK = 64, HALF = 128, HTB = HALF * BK * 2, STAGE_BYTES = 8 * HTB;
__device__ __forceinline__ int lds_byte(int r, int c) { const int st = (r >> 4) * 2 + (c >> 5), rr = r & 15, cc = c & 31, ob = rr * 64 + cc * 2; return st * 1024 + (ob ^ (((ob >> 9) & 1) << 5)); }
__device__ __forceinline__ int perm32(int rho) { const int n = rho >> 4, i = rho & 15; return 8 * (i >> 2) + 4 * n + (i & 3); }
__device__ __forceinline__ void stage_rc(int b, int& R, int& C) { const int st = b / 1024, sb = b % 1024, swz = sb ^ (((sb >> 9) & 1) << 5); R = (st >> 1) * 16 + swz / 64; C = (st & 1) * 32 + (swz % 64) / 2; }
struct Lay {
    static constexpr int NI = 8, NJ = 4;
    static constexpr bool PAIR8 = true;
    int rbase, cbase;
    __device__ __forceinline__ int row(int i) const { return (i >> 2) * 128 + (i & 3) * 16 + rbase; }
    __device__ __forceinline__ int col(int j) const { return (j >> 1) * 128 + (j & 1) * 4 + cbase; }
};
template <class Epi> struct Unit { const bf16_t* A; const bf16_t* B0; const bf16_t* B1; const LAS int* ridx; int valid; Epi epi; };

template <class Sched>
__device__ __forceinline__ void gemm_phase(LAS unsigned char* lds, const int K, const Sched& S) {
    typedef typename Sched::Epi Epi;
    const int tid = tid_opaque(), wid = __builtin_amdgcn_readfirstlane(tid >> 6), lane = tid & 63, wr = wid >> 2, wc = wid & 3, fr = lane & 15, fq = lane >> 4;
    int nt = K / BK; asm volatile("" : "+s"(nt));
    int sR[2], sC[2];
#pragma unroll
    for (int i = 0; i < 2; ++i) stage_rc(tid * 16 + i * 8192, sR[i], sC[i]);
    unsigned voffB[2];
#pragma unroll
    for (int i = 0; i < 2; ++i) voffB[i] = (unsigned)(((sR[i] & ~31) + perm32(sR[i] & 31)) * K + sC[i]) * 2u;
    const size_t kstep = (size_t)(BK * 2);
    const unsigned ldsw = (unsigned)wid * 1024u;
    const int aoff = lds_byte(wr * 64 + fr, fq * 8), boff = lds_byte(wc * 32 + fr, fq * 8);
#define G2_SA(b, h) (((b) * 2 + (h)) * HTB)
#define G2_SB(b, h) ((4 + (b) * 2 + (h)) * HTB)
#define G2_STAGE(bufoff, gbase, v0, v1) do { \
        __builtin_amdgcn_global_load_lds((const unsigned*)((const char*)(gbase) + (v0)), (LAS unsigned*)(lds + (bufoff) + ldsw), 16, 0, 0); \
        __builtin_amdgcn_global_load_lds((const unsigned*)((const char*)(gbase) + (v1)), (LAS unsigned*)(lds + (bufoff) + ldsw + 8192), 16, 0, 0); } while (0)
#define G2_LDA(dst, b, h) do { _Pragma("unroll") for (int m = 0; m < 4; ++m) _Pragma("unroll") for (int k = 0; k < 2; ++k) dst[m][k] = *(const LAS bf16x8*)(lds + G2_SA(b, h) + aoff + m * 2048 + k * 1024); } while (0)
#define G2_LDB(dst, b, h) do { _Pragma("unroll") for (int n = 0; n < 2; ++n) _Pragma("unroll") for (int k = 0; k < 2; ++k) dst[n][k] = *(const LAS bf16x8*)(lds + G2_SB(b, h) + boff + n * 2048 + k * 1024); } while (0)
#define G2_MMA(ai, bj, At, Bt) do { __builtin_amdgcn_s_setprio(1); _Pragma("unroll") for (int m = 0; m < 4; ++m) _Pragma("unroll") for (int n = 0; n < 2; ++n) _Pragma("unroll") for (int k = 0; k < 2; ++k) { \
        if (Sched::FP8) { const i32x4 _b = __builtin_bit_cast(i32x4, Bt[n][k]), _a = __builtin_bit_cast(i32x4, At[m][k]);     \
            acc[(ai) * 4 + m][(bj) * 2 + n] = __builtin_amdgcn_mfma_f32_16x16x32_fp8_fp8(((long)(unsigned)_b[1] << 32) | (unsigned)_b[0], ((long)(unsigned)_a[1] << 32) | (unsigned)_a[0], acc[(ai) * 4 + m][(bj) * 2 + n], 0, 0, 0); \
            acc[(ai) * 4 + m][(bj) * 2 + n] = __builtin_amdgcn_mfma_f32_16x16x32_fp8_fp8(((long)(unsigned)_b[3] << 32) | (unsigned)_b[2], ((long)(unsigned)_a[3] << 32) | (unsigned)_a[2], acc[(ai) * 4 + m][(bj) * 2 + n], 0, 0, 0); } \
        else acc[(ai) * 4 + m][(bj) * 2 + n] = __builtin_amdgcn_mfma_f32_16x16x32_bf16(Bt[n][k], At[m][k], acc[(ai) * 4 + m][(bj) * 2 + n], 0, 0, 0); } __builtin_amdgcn_s_setprio(0); } while (0)
#define G2_WAIT_V(n) asm volatile("s_waitcnt vmcnt(" #n ")" ::: "memory")
#define G2_WAIT_L(n) asm volatile("s_waitcnt lgkmcnt(" #n ")" ::: "memory")
#define G2_BAR __builtin_amdgcn_s_barrier()
#define G2_SCHED __builtin_amdgcn_sched_barrier(0)
#define G2_VOFFA(U, dst) do { _Pragma("unroll") for (int _h = 0; _h < 2; ++_h) _Pragma("unroll") for (int _i = 0; _i < 2; ++_i) { const int _row = _h * 128 + sR[_i]; \
        int _tok = _row; if (Sched::GATHER) _tok = (_row < (U).valid) ? (U).ridx[_row] : 0; dst[_h][_i] = (unsigned)(_tok * K + sC[_i]) * 2u; } } while (0)
    Unit<Epi> cur, nxt; int ui = 0;
    if (!S.get(0, cur)) return;
    f32x4 acc[8][4];
#pragma unroll
    for (int i = 0; i < 8; ++i)
#pragma unroll
        for (int j = 0; j < 4; ++j) acc[i][j] = (f32x4){0.f, 0.f, 0.f, 0.f};
    bf16x8 At[4][2], B0[2][2], B1[2][2];
    unsigned cvA[2][2], nvA[2][2];
    G2_VOFFA(cur, cvA);
    const char* cA = (const char*)cur.A; const char* cB0 = (const char*)cur.B0; const char* cB1 = (const char*)cur.B1;
    G2_STAGE(G2_SB(0, 0), cB0, voffB[0], voffB[1]); G2_STAGE(G2_SB(0, 1), cB1, voffB[0], voffB[1]); G2_STAGE(G2_SA(0, 0), cA, cvA[0][0], cvA[0][1]); G2_STAGE(G2_SA(0, 1), cA, cvA[1][0], cvA[1][1]);
    if (wr == 1) G2_BAR;
    G2_WAIT_V(2); G2_BAR;
    G2_STAGE(G2_SB(1, 0), cB0 + kstep, voffB[0], voffB[1]); G2_STAGE(G2_SA(1, 0), cA + kstep, cvA[0][0], cvA[0][1]); G2_STAGE(G2_SB(1, 1), cB1 + kstep, voffB[0], voffB[1]);
    G2_WAIT_V(6); G2_BAR;
    for (;;) {
        const bool has_next = S.get(ui + 1, nxt);
        if (Sched::GATHER) {
            if (has_next) { G2_VOFFA(nxt, nvA); }
            else {
#pragma unroll
                for (int h = 0; h < 2; ++h) { nvA[h][0] = cvA[h][0]; nvA[h][1] = cvA[h][1]; } }
        }
        const char* nA = has_next ? (const char*)nxt.A : cA; const char* nB0 = has_next ? (const char*)nxt.B0 : cB0; const char* nB1 = has_next ? (const char*)nxt.B1 : cB1;
#pragma unroll 1
        for (int t = 0; t < nt; t += 2) {
            const bool last = (t == nt - 2);
            const char* a1 = cA + (size_t)(t + 1) * kstep;
            const char* a2 = last ? nA : cA + (size_t)(t + 2) * kstep;
            const char* b20 = last ? nB0 : cB0 + (size_t)(t + 2) * kstep; const char* b21 = last ? nB1 : cB1 + (size_t)(t + 2) * kstep;
#define x00 ((Sched::GATHER && last) ? nvA[0][0] : cvA[0][0])
#define x01 ((Sched::GATHER && last) ? nvA[0][1] : cvA[0][1])
#define x10 ((Sched::GATHER && last) ? nvA[1][0] : cvA[1][0])
#define x11 ((Sched::GATHER && last) ? nvA[1][1] : cvA[1][1])
            G2_LDB(B0, 0, 0); G2_LDB(B1, 0, 1); G2_SCHED; G2_LDA(At, 0, 0); G2_STAGE(G2_SA(1, 1), a1, cvA[1][0], cvA[1][1]);
            G2_WAIT_V(8); G2_WAIT_L(0); G2_BAR; G2_MMA(0, 0, At, B0); G2_MMA(0, 1, At, B1); G2_BAR; G2_SCHED;
            G2_LDA(At, 0, 1); G2_STAGE(G2_SB(0, 0), b20, voffB[0], voffB[1]); G2_STAGE(G2_SB(0, 1), b21, voffB[0], voffB[1]); G2_STAGE(G2_SA(0, 0), a2, x00, x01);
            G2_WAIT_V(8); G2_WAIT_L(0); G2_BAR; G2_MMA(1, 0, At, B0); G2_MMA(1, 1, At, B1); G2_BAR; G2_SCHED;
            G2_LDB(B0, 1, 0); G2_LDB(B1, 1, 1); G2_SCHED; G2_LDA(At, 1, 0); G2_STAGE(G2_SA(0, 1), a2, x10, x11);
            G2_WAIT_V(8); G2_WAIT_L(0); G2_BAR; G2_MMA(0, 0, At, B0); G2_MMA(0, 1, At, B1); G2_BAR; G2_SCHED;
            G2_LDA(At, 1, 1); G2_STAGE(G2_SB(1, 0), b20 + kstep, voffB[0], voffB[1]); G2_STAGE(G2_SB(1, 1), b21 + kstep, voffB[0], voffB[1]); G2_STAGE(G2_SA(1, 0), a2 + kstep, x00, x01);
            G2_WAIT_V(8); G2_WAIT_L(0); G2_BAR; G2_MMA(1, 0, At, B0); G2_MMA(1, 1, At, B1); G2_BAR; G2_SCHED;
        }
        if (wr == 0) G2_BAR;
        { Lay lay; int rbv = wr * 64 + fr, cbv = wc * 32 + 8 * fq; asm volatile("" : "+v"(rbv), "+v"(cbv));
          lay.rbase = rbv; lay.cbase = cbv; cur.epi.run(acc, lay); }
        if (!has_next) break;
#pragma unroll
        for (int i = 0; i < 8; ++i)
#pragma unroll
            for (int j = 0; j < 4; ++j) acc[i][j] = (f32x4){0.f, 0.f, 0.f, 0.f};
        cur = nxt; cA = nA; cB0 = nB0; cB1 = nB1; ++ui;
        if (wr == 1) G2_BAR;
        if (Sched::GATHER) {
#pragma unroll
            for (int h = 0; h < 2; ++h) { cvA[h][0] = nvA[h][0]; cvA[h][1] = nvA[h][1]; } }
    }
#undef x00
#undef x01
#undef x10
#undef x11
    G2_WAIT_V(0);
    G2_BAR;
#undef G2_SA
#undef G2_SB
#undef G2_STAGE
#undef G2_LDA
#undef G2_LDB
#undef G2_MMA
#undef G2_WAIT_V
#undef G2_WAIT_L
#undef G2_BAR
#undef G2_SCHED
#undef G2_VOFFA
}
}

struct EpiF32 {
    float* C; int ld;
    template <class L> __device__ __forceinline__ void run(const f32x4 (&acc)[L::NI][L::NJ], const L& lay) const {
#pragma unroll
        for (int i = 0; i < L::NI; ++i)
#pragma unroll
            for (int j = 0; j < L::NJ; ++j) *(f32x4*)(C + (size_t)lay.row(i) * ld + lay.col(j)) = acc[i][j];
    }
};
struct EpiBf16 {
    bf16_t* C; int ld; float scale;
    template <class L> __device__ __forceinline__ void run(const f32x4 (&acc)[L::NI][L::NJ], const L& lay) const {
#pragma unroll
        for (int i = 0; i < L::NI; ++i) {
            if (L::PAIR8) {
#pragma unroll
                for (int j = 0; j < L::NJ; j += 2) { const f32x4 p = acc[i][j] * scale, q = acc[i][j + 1] * scale; u32x4 w; w.x = pack2(p[0], p[1]); w.y = pack2(p[2], p[3]); w.z = pack2(q[0], q[1]); w.w = pack2(q[2], q[3]);
                    *(u32x4*)(C + (size_t)lay.row(i) * ld + lay.col(j)) = w; }
            } else {
#pragma unroll
                for (int j = 0; j < L::NJ; ++j) { const f32x4 p = acc[i][j] * scale; u32x2 w; w.x = pack2(p[0], p[1]); w.y = pack2(p[2], p[3]);
                    *(u32x2*)(C + (size_t)lay.row(i) * ld + lay.col(j)) = w; }
            }
        }
    }
};
struct EpiFp8 {
    unsigned char* C; int ld; float scale;
    template <class L> __device__ __forceinline__ void run(const f32x4 (&acc)[L::NI][L::NJ], const L& lay) const {
        static_assert(L::PAIR8, "written for the paired-column layout");
#pragma unroll
        for (int i = 0; i < L::NI; ++i)
#pragma unroll
            for (int j = 0; j < L::NJ; j += 2) { const f32x4 p = acc[i][j] * scale, q = acc[i][j + 1] * scale; u32x2 w; w.x = pack4_fp8(p[0], p[1], p[2], p[3]); w.y = pack4_fp8(q[0], q[1], q[2], q[3]);
                *(u32x2*)(C + (size_t)lay.row(i) * ld + lay.col(j)) = w; }
    }
};
struct EpiGateUp8 {
    unsigned char* C; int ld;
    template <class L> __device__ __forceinline__ void run(const f32x4 (&acc)[L::NI][L::NJ], const L& lay) const {
        static_assert(L::PAIR8 && L::NJ == 4, "written for the paired-column 256x256 layout");
#pragma unroll
        for (int i = 0; i < L::NI; ++i) {
            const f32x4 g0 = acc[i][0] * (1.0f / 32.0f), g1 = acc[i][1] * (1.0f / 32.0f), u0 = acc[i][2] * (1.0f / 32.0f), u1 = acc[i][3] * (1.0f / 32.0f);
            u32x2 w; w.x = pack4_fp8(silu_f(g0[0]) * u0[0], silu_f(g0[1]) * u0[1], silu_f(g0[2]) * u0[2], silu_f(g0[3]) * u0[3]);
            w.y = pack4_fp8(silu_f(g1[0]) * u1[0], silu_f(g1[1]) * u1[1], silu_f(g1[2]) * u1[2], silu_f(g1[3]) * u1[3]);
            *(u32x2*)(C + (size_t)lay.row(i) * ld + lay.col(0)) = w;
        }
    }
};
struct EpiGateUp {
    bf16_t* C; int ld;
    template <class L> __device__ __forceinline__ void run(const f32x4 (&acc)[L::NI][L::NJ], const L& lay) const {
#pragma unroll
        for (int i = 0; i < L::NI; ++i) {
            if (L::PAIR8 && L::NJ == 4) {
                const f32x4 g0 = acc[i][0], g1 = acc[i][1], u0 = acc[i][2], u1 = acc[i][3];
                u32x4 w; w.x = pack2(silu_f(g0[0]) * u0[0], silu_f(g0[1]) * u0[1]); w.y = pack2(silu_f(g0[2]) * u0[2], silu_f(g0[3]) * u0[3]);
                w.z = pack2(silu_f(g1[0]) * u1[0], silu_f(g1[1]) * u1[1]); w.w = pack2(silu_f(g1[2]) * u1[2], silu_f(g1[3]) * u1[3]);
                *(u32x4*)(C + (size_t)lay.row(i) * ld + lay.col(0)) = w;
            } else {
#pragma unroll
                for (int j = 0; j < L::NJ / 2; ++j) { const f32x4 gt = acc[i][j], up = acc[i][j + L::NJ / 2];
                    u32x2 w; w.x = pack2(silu_f(gt[0]) * up[0], silu_f(gt[1]) * up[1]); w.y = pack2(silu_f(gt[2]) * up[2], silu_f(gt[3]) * up[3]);
                    *(u32x2*)(C + (size_t)lay.row(i) * ld + lay.col(j)) = w; }
            }
        }
    }
};
struct EpiInProj {
    bf16_t* Zt;
    bf16_t* tF;
    bf16_t* tV;
    int n0, pos0, n;
    template <class L> __device__ __forceinline__ void run(const f32x4 (&acc)[L::NI][L::NJ], const L& lay) const {
        static_assert(L::PAIR8, "written for the paired-column layout");
#pragma unroll
        for (int i = 0; i < L::NI; ++i)
#pragma unroll
            for (int j = 0; j < L::NJ; j += 2) {
                const int r = lay.row(i), cl = lay.col(j), c = n0 + cl;
                const f32x4 v0 = acc[i][j], v1 = acc[i][j + 1];
                if (c < 512) {
                    const int part = c >> 8, ch = c & 255;
#pragma unroll
                    for (int e = 0; e < 4; ++e) { tF[((size_t)(ch + e) * 2 + part) * n + pos0 + r] = f2bf(v0[e]); tF[((size_t)(ch + 4 + e) * 2 + part) * n + pos0 + r] = f2bf(v1[e]); }
                } else {
                    u32x4 w; w.x = pack2(v0[0], v0[1]); w.y = pack2(v0[2], v0[3]); w.z = pack2(v1[0], v1[1]); w.w = pack2(v1[2], v1[3]);
                    *(u32x4*)(Zt + (size_t)r * ZC + cl) = w;
                    if (c >= 896 && c < 1024) {
#pragma unroll
                        for (int e = 0; e < 4; ++e) { tV[(size_t)(c - 896 + e) * n + pos0 + r] = f2bf(v0[e]); tV[(size_t)(c - 896 + 4 + e) * n + pos0 + r] = f2bf(v1[e]); }
                    }
                }
            }
    }
};

constexpr int U_ADA = 192, U_WIN = 2 * 16 * 28, U_WOUT = 2 * 16 * 16, U_SGU = 32, U_DFT = 256, U_ROPE = 1, U_EXP = 3 * 32 * 32;
constexpr int LDS_SIL = 0, LDS_RED = 20480, LDS_TILE = 32768, LDS_T64 = 49408, LDS_CTAB = 50176;

__device__ __forceinline__ void ada_unit(AP a, unsigned char* lds, int u) {
    float* sil = (float*)(lds + LDS_SIL); float* red = (float*)(lds + LDS_RED);
    const int tid = tid_opaque(), lane = tid & 63, w = tid >> 6;
    const int l = u / 96, cg = u % 96;
    for (int i = tid; i < 5120; i += NT) { const int r = i >> 10, k = i & 1023; const float v = (r < 4) ? a->in[1][r * 1024 + k] : a->in[3][k]; sil[i] = v / (1.0f + expf(-v)); }
    __syncthreads();
    const float* W = a->in[4] + (size_t)l * 1024 * 6144 + cg * 64 + lane;
    float acc[5] = {0.f, 0.f, 0.f, 0.f, 0.f};
#pragma unroll 32
    for (int k = w * 128; k < w * 128 + 128; ++k) { const float wv = W[(size_t)k * 6144];
#pragma unroll
        for (int r = 0; r < 5; ++r) acc[r] += sil[r * 1024 + k] * wv; }
#pragma unroll
    for (int r = 0; r < 5; ++r) red[(w * 5 + r) * 64 + lane] = acc[r];
    __syncthreads();
    if (tid < 320) { const int r = tid >> 6; float s = 0.f;
#pragma unroll
        for (int ww = 0; ww < 8; ++ww) s += red[(ww * 5 + r) * 64 + lane];
        const int j = cg * 64 + lane; ((float*)(a->ws + WS_MOD))[(size_t)(l * 5 + r) * 6144 + j] = s + a->in[5][l * 6144 + j]; }
    __syncthreads();
}

__device__ __forceinline__ void tile_store_T(const float* tile, bf16_t* dst, int ldd) {
    const int tid = tid_opaque(), n = tid >> 3, kc = tid & 7;
    u32x4 w;
    w.x = pack2(tile[(kc * 8 + 0) * 65 + n], tile[(kc * 8 + 1) * 65 + n]); w.y = pack2(tile[(kc * 8 + 2) * 65 + n], tile[(kc * 8 + 3) * 65 + n]);
    w.z = pack2(tile[(kc * 8 + 4) * 65 + n], tile[(kc * 8 + 5) * 65 + n]); w.w = pack2(tile[(kc * 8 + 6) * 65 + n], tile[(kc * 8 + 7) * 65 + n]);
    *(u32x4*)(dst + (size_t)n * ldd + kc * 8) = w;
}
__device__ __forceinline__ void tile_load(float* tile, const float* src, int lds_) {
    const int tid = tid_opaque();
#pragma unroll
    for (int i = 0; i < 2; ++i) { const int row = (tid >> 4) + 32 * i, c4 = (tid & 15) * 4; const f32x4 v = *(const f32x4*)(src + (size_t)row * lds_ + c4);
        tile[row * 65 + c4 + 0] = v[0]; tile[row * 65 + c4 + 1] = v[1]; tile[row * 65 + c4 + 2] = v[2]; tile[row * 65 + c4 + 3] = v[3]; }
}

__device__ __forceinline__ void mm64_f32(const float* tA, int lda, const float* tB, int ldb, int K, float* out) {
    const int tid = tid_opaque(), lane = tid & 63, w = tid >> 6, fr = lane & 15, g = lane >> 4, mi = w >> 1, nj = 2 * (w & 1);
    f32x4 acc0 = (f32x4){0.f, 0.f, 0.f, 0.f}, acc1 = (f32x4){0.f, 0.f, 0.f, 0.f};
    const float* pa = tA + (16 * mi + fr) * lda + g; const float* pb = tB + g * ldb + 16 * nj + fr;
#pragma unroll 4
    for (int k0 = 0; k0 < K; k0 += 4) { const float av = pa[k0], b0 = pb[k0 * ldb], b1 = pb[k0 * ldb + 16];
        acc0 = __builtin_amdgcn_mfma_f32_16x16x4f32(av, b0, acc0, 0, 0, 0); acc1 = __builtin_amdgcn_mfma_f32_16x16x4f32(av, b1, acc1, 0, 0, 0); }
#pragma unroll
    for (int r = 0; r < 4; ++r) { out[(16 * mi + 4 * g + r) * 65 + 16 * nj + fr] = acc0[r]; out[(16 * mi + 4 * g + r) * 65 + 16 * nj + 16 + fr] = acc1[r]; }
}

__device__ __forceinline__ void win_unit(AP a, unsigned char* lds, int u) {
    float* tile = (float*)(lds + LDS_TILE); float* T = (float*)(lds + LDS_T64);
    const int tid = tid_opaque();
    const int l = u / 448, r = u % 448, kb = r / 28, nb = r % 28;
    const float* Win = a->in[6] + (size_t)l * 1024 * 1536;
    const int srccol = (nb >= 8) ? nb * 64 - 256 : (nb & 3) * 64;
    tile_load(tile, Win + (size_t)(kb * 64) * 1536 + srccol, 1536);
    if (nb < 8 && tid < 64) { T[tid] = cospif((float)tid / 32.0f); T[64 + tid] = sinpif((float)tid / 32.0f); }
    __syncthreads();
    bf16_t* dst = (bf16_t*)(a->ws + WS_WIN) + ((size_t)l * ZC + nb * 64) * 1024 + kb * 64;
    if (nb >= 8) tile_store_T(tile, dst, 1024);
    else {
        const int part = nb >> 2;
        float* Tm = (float*)(lds + 65536); float* out = (float*)(lds + 98304);
        for (int i = tid; i < 4096; i += NT) { const int c = i >> 6, cp = i & 63; const float t = T[part * 64 + ((c * cp) & 63)]; Tm[i] = (part ? -t : t) * 0.125f; }
        __syncthreads();
        mm64_f32(tile, 65, Tm, 64, 64, out);
        __syncthreads();
        tile_store_T(out, dst, 1024);
    }
    __syncthreads();
}

__device__ __forceinline__ void wout_unit(AP a, unsigned char* lds, int u) {
    float* tile = (float*)(lds + LDS_TILE);
    __syncthreads();
    const int tid = tid_opaque();
    const int l = u / 256, r = u % 256, kb = r / 16, nb = r % 16;
    const float* Wo = a->in[13] + (size_t)l * 1024 * 1024;
    const int n = tid & 63, kq = __builtin_amdgcn_readfirstlane(tid >> 6);
    if (kb < 4) {
        float* tA = (float*)lds; float* tB = (float*)(lds + 65536);
        const float* wf = a->in[7] + (size_t)l * 256 * 256 + (size_t)(kb * 64) * 256;
        __syncthreads();
        f32x4 va[8], vb[8];
#pragma unroll
        for (int i = 0; i < 8; ++i) { const int q = tid + 512 * i; va[i] = *(const f32x4*)(wf + (size_t)q * 4); vb[i] = *(const f32x4*)(Wo + (size_t)(q >> 4) * 1024 + nb * 64 + (q & 15) * 4); }
#pragma unroll
        for (int i = 0; i < 8; ++i) { const int q = tid + 512 * i; *(f32x4*)(tA + (size_t)q * 4) = va[i]; *(f32x4*)(tB + (size_t)q * 4) = vb[i]; }
        __syncthreads();
        tile = (float*)(lds + 133120);
        mm64_f32(tA, 256, tB, 64, 256, tile);
    } else if (kb >= 8 && kb < 12) {
        const int g = kb - 8;
        float* tA = (float*)lds; float* tB = (float*)(lds + 65536);
        const float* wp = a->in[9] + (size_t)(l * 4 + g) * 64 * 64;
        const float* ps = a->in[10] + l * 256 + g * 64;
        f32x4 va[2], vb[2];
#pragma unroll
        for (int i = 0; i < 2; ++i) { const int q = tid + 512 * i; va[i] = *(const f32x4*)(wp + (size_t)q * 4); vb[i] = *(const f32x4*)(Wo + (size_t)(512 + g * 64 + (q >> 4)) * 1024 + nb * 64 + (q & 15) * 4) * ps[q >> 4]; }
#pragma unroll
        for (int i = 0; i < 2; ++i) { const int q = tid + 512 * i; *(f32x4*)(tA + (size_t)q * 4) = va[i]; *(f32x4*)(tB + (size_t)q * 4) = vb[i]; }
        __syncthreads();
        tile = (float*)(lds + 133120);
        mm64_f32(tA, 64, tB, 64, 64, tile);
    } else tile_load(tile, Wo + (size_t)(kb * 64) * 1024 + nb * 64, 1024);
    __syncthreads();
    tile_store_T(tile, (bf16_t*)(a->ws + WS_WOUT) + ((size_t)l * 1024 + nb * 64) * 1024 + kb * 64, 1024);
    __syncthreads();
}

__device__ __forceinline__ void exp_src_dst(AP a, int l, int u, const float*& src, int& srcld, unsigned char*& dst, int& dstld) {
    const int mat = u / 1024, e = (u % 1024) / 32, t = u % 32;
    const int kb = (mat < 2) ? t / 4 : t / 8, nb = (mat < 2) ? t % 4 : t % 8;
    srcld = (mat < 2) ? 512 : 1024; dstld = (mat < 2) ? 1024 : 512;
    src = a->in[18 + mat] + ((size_t)(l * 32 + e) * 512 * 1024) + (size_t)(kb * 128) * srcld + nb * 128;
    dst = a->ws + WS_WEXP + (size_t)l * WEXP_LAYER + (size_t)mat * EXPMAT + (size_t)e * 512 * 1024 + (size_t)(nb * 128) * dstld + kb * 128;
}
#define EXP_LOAD(vv, uu) do { exp_src_dst(a, l, (uu), src, srcld, dst, dstld); _Pragma("unroll") for (int _i = 0; _i < 8; ++_i) vv[_i] = *(const f32x4*)(src + (size_t)((tid >> 5) + 16 * _i) * srcld + (tid & 31) * 4); } while (0)
#define EXP_PUT(vv) do { _Pragma("unroll") for (int _i = 0; _i < 8; ++_i) { float* tp = tile + ((tid >> 5) + 16 * _i) * 129 + (tid & 31) * 4; tp[0] = vv[_i][0] * 32.0f; tp[1] = vv[_i][1] * 32.0f; tp[2] = vv[_i][2] * 32.0f; tp[3] = vv[_i][3] * 32.0f; } } while (0)
#define EXP_STORE(dd, ld_) do { const int n = tid >> 2, kq = tid & 3; _Pragma("unroll") for (int j = 0; j < 2; ++j) { const float* tp = tile + (kq * 32 + j * 16) * 129 + n; u32x4 w; \
        w.x = pack4_fp8(tp[0], tp[129], tp[2 * 129], tp[3 * 129]); w.y = pack4_fp8(tp[4 * 129], tp[5 * 129], tp[6 * 129], tp[7 * 129]); \
        w.z = pack4_fp8(tp[8 * 129], tp[9 * 129], tp[10 * 129], tp[11 * 129]); w.w = pack4_fp8(tp[12 * 129], tp[13 * 129], tp[14 * 129], tp[15 * 129]); \
        *(u32x4*)((dd) + (size_t)n * (ld_) + kq * 32 + j * 16) = w; } } while (0)
__device__ __forceinline__ void exp_range(AP a, unsigned char* lds, int l, int u0, int u_end) {
    float* tile = (float*)lds;
    const int tid = tid_opaque();
    __syncthreads();
    if (u0 >= u_end) return;
    const float* src; unsigned char* dst; int srcld, dstld;
    f32x4 va[8], vb[8];
    unsigned char *da, *db = nullptr; int lda_, ldb_ = 0;
    EXP_LOAD(va, u0); da = dst; lda_ = dstld;
    if (u0 + 1 < u_end) { EXP_LOAD(vb, u0 + 1); db = dst; ldb_ = dstld; }
    for (int u = u0; u < u_end; u += 2) {
        EXP_PUT(va);
        __syncthreads();
        { unsigned char* cd = da; const int cl = lda_; if (u + 2 < u_end) { EXP_LOAD(va, u + 2); da = dst; lda_ = dstld; } EXP_STORE(cd, cl); }
        __syncthreads();
        if (u + 1 < u_end) {
            EXP_PUT(vb);
            __syncthreads();
            { unsigned char* cd = db; const int cl = ldb_; if (u + 3 < u_end) { EXP_LOAD(vb, u + 3); db = dst; ldb_ = dstld; } EXP_STORE(cd, cl); }
            __syncthreads();
        }
    }
}
#undef EXP_LOAD
#undef EXP_PUT
#undef EXP_STORE
__device__ __forceinline__ void exp_queue(AP a, unsigned char* lds, int l) {
    const int tid = tid_opaque();
    int* qslot = (int*)(lds + MISC_OFF + 128);
    unsigned* qc = (unsigned*)(a->ws + WS_BAR + 14336 + l * 256);
    for (;;) {
        __syncthreads();
        if (tid == 0) *qslot = (int)__hip_atomic_fetch_add(qc, 2u, __ATOMIC_RELAXED, __HIP_MEMORY_SCOPE_AGENT);
        __syncthreads();
        const int c0 = *qslot;
        if (c0 >= U_EXP) break;
        exp_range(a, lds, l, c0, c0 + 2);
    }
}

__device__ __forceinline__ void exp_fill(AP a, unsigned char* lds, int ql, int budget) {
    const int tid = tid_opaque();
    int* qslot = (int*)(lds + MISC_OFF + 128);
    unsigned* qc = (unsigned*)(a->ws + WS_BAR + 14336 + ql * 256);
    for (int done = 0; done < budget; done += 2) {
        __syncthreads();
        if (tid == 0) *qslot = (int)__hip_atomic_fetch_add(qc, 2u, __ATOMIC_RELAXED, __HIP_MEMORY_SCOPE_AGENT);
        __syncthreads();
        const int c0 = *qslot;
        if (c0 >= U_EXP) break;
        exp_range(a, lds, ql, c0, c0 + 2);
    }
    __syncthreads();
}

__device__ __forceinline__ void p0_prologue(AP a, unsigned char* lds) {
    const int tid = tid_opaque();
    bool have_tab = false;
    constexpr int E0 = U_ADA, E1 = E0 + U_WIN, E2 = E1 + U_WOUT, E3 = E2 + U_SGU, E4 = E3 + U_DFT, E5 = E4 + U_ROPE;
    int u = blockIdx.x;
    for (; u < E5; u += gridDim.x) {
        if (u < E0) ada_unit(a, lds, u);
        else if (u < E1) win_unit(a, lds, u - E0);
        else if (u < E2) wout_unit(a, lds, u - E1);
        else if (u < E3) { const size_t i0 = (size_t)(u - E2) * 4096 + tid * 8; const float* s = a->in[11] + i0; bf16_t* d = (bf16_t*)(a->ws + WS_WSGU) + i0;
            const f32x4 v0 = *(const f32x4*)s, v1 = *(const f32x4*)(s + 4); u32x4 w; w.x = pack2(v0[0], v0[1]); w.y = pack2(v0[2], v0[3]); w.z = pack2(v1[0], v1[1]); w.w = pack2(v1[2], v1[3]); *(u32x4*)d = w; }
        else if (u < E4) {
            float* ctab = (float*)(lds + LDS_CTAB);
            if (!have_tab) { for (int i = tid; i < 4096; i += NT) ctab[i] = cospif((float)i / 2048.0f); __syncthreads(); have_tab = true; }
            const int k = u - E3 + 4096;
            if (tid < 32) {
                const int kk = k - 4096, n0 = tid * 8; float c[8], s[8];
#pragma unroll
                for (int e = 0; e < 8; ++e) { const int idx = ((kk * (n0 + e)) & 255) * 16; c[e] = ctab[idx] * (1.0f / 16.0f); s[e] = ctab[(idx - 1024) & 4095] * (1.0f / 16.0f); }
                bf16_t* d = (bf16_t*)(a->ws + WS_DFTC) + (size_t)kk * 512 + n0;
                u32x4 w; w.x = pack2(c[0], c[1]); w.y = pack2(c[2], c[3]); w.z = pack2(c[4], c[5]); w.w = pack2(c[6], c[7]); *(u32x4*)d = w;
                w.x = pack2(s[0], s[1]); w.y = pack2(s[2], s[3]); w.z = pack2(s[4], s[5]); w.w = pack2(s[6], s[7]); *(u32x4*)(d + 256) = w;
            }
        }
        else {
            for (int i = tid; i < 1024; i += NT) { const int pos = i >> 4, f = i & 15; const float freq = powf(10000.0f, -(float)f / 16.0f); const float ang = (float)pos * freq;
                ((float2*)(a->ws + WS_ROPE))[i] = make_float2(cosf(ang), sinf(ang)); }
        }
    }
}

__device__ __forceinline__ void p_lnmod0(AP a) {
    const int tid = tid_opaque(), lane = tid & 63, w = tid >> 6;
    const float* mod = (const float*)(a->ws + WS_MOD);
    bf16_t* H = (bf16_t*)(a->ws + WS_H);
    const int tstep = gridDim.x * 8;
    f32x4 nx[4];
    { const int t = blockIdx.x * 8 + w; if (t < NTOK) { const float* src = (t < NLAT) ? a->in[0] + (size_t)t * D : a->in[2] + (size_t)(t - NLAT) * D;
#pragma unroll
        for (int i = 0; i < 4; ++i) nx[i] = *(const f32x4*)(src + 256 * i + 4 * lane); } }
    int mrow = -1; f32x4 msh[4], msc[4];
    for (int t = blockIdx.x * 8 + w; t < NTOK; t += tstep) {
        const int mr = (t < NLAT) ? (t >> 12) : 4;
        if (mr != mrow) { mrow = mr; const float* m = mod + (size_t)mr * 6144;
#pragma unroll
            for (int i = 0; i < 4; ++i) { msh[i] = *(const f32x4*)(m + 256 * i + 4 * lane); msc[i] = *(const f32x4*)(m + 1024 + 256 * i + 4 * lane); } }
        f32x4 v[4];
#pragma unroll
        for (int i = 0; i < 4; ++i) v[i] = nx[i];
        { const int tn = t + tstep; if (tn < NTOK) { const float* src = (tn < NLAT) ? a->in[0] + (size_t)tn * D : a->in[2] + (size_t)(tn - NLAT) * D;
#pragma unroll
            for (int i = 0; i < 4; ++i) nx[i] = *(const f32x4*)(src + 256 * i + 4 * lane); } }
        float mean, rstd; ln_stats(v, mean, rstd);
#pragma unroll
        for (int i = 0; i < 4; ++i) { const int c = 256 * i + 4 * lane;
            f32x4 o;
#pragma unroll
            for (int e = 0; e < 4; ++e) o[e] = (v[i][e] - mean) * rstd * (1.0f + msc[i][e]) + msh[i][e];
            u32x2 pk; pk.x = pack2(o[0], o[1]); pk.y = pack2(o[2], o[3]); *(u32x2*)(H + (size_t)t * D + c) = pk; }
    }
}

__device__ __forceinline__ void p1_inproj(AP a, unsigned char* smem, LAS unsigned char* lds, int l);
__device__ __forceinline__ u32x4 ld16g(const bf16_t* p) { return *(const u32x4*)p; }
__device__ __forceinline__ void rope_pack8(u32x4& wl, u32x4& wh, const LAS f32x2* tab, bool do_rope, float scale) {
    float tl[8] = {lo2f(wl.x), hi2f(wl.x), lo2f(wl.y), hi2f(wl.y), lo2f(wl.z), hi2f(wl.z), lo2f(wl.w), hi2f(wl.w)};
    float th[8] = {lo2f(wh.x), hi2f(wh.x), lo2f(wh.y), hi2f(wh.y), lo2f(wh.z), hi2f(wh.z), lo2f(wh.w), hi2f(wh.w)};
#pragma unroll
    for (int j = 0; j < 8; ++j) {
        float r1 = tl[j], r2 = th[j];
        if (do_rope) { const f32x2 cs = tab[j]; r1 = tl[j] * cs.x - th[j] * cs.y; r2 = tl[j] * cs.y + th[j] * cs.x; }
        tl[j] = r1 * scale; th[j] = r2 * scale;
    }
    wl.x = pack2(tl[0], tl[1]); wl.y = pack2(tl[2], tl[3]); wl.z = pack2(tl[4], tl[5]); wl.w = pack2(tl[6], tl[7]);
    wh.x = pack2(th[0], th[1]); wh.y = pack2(th[2], th[3]); wh.z = pack2(th[4], th[5]); wh.w = pack2(th[6], th[7]);
}

__device__ __forceinline__ void mixer_sgu_pool(AP a, LAS unsigned char* lds, int l, int row0, int seq_row0, int pos0, int n) {
    const int tid = tid_opaque(), lane = tid & 63, w = __builtin_amdgcn_readfirstlane(tid >> 6), fr = lane & 15, g = lane >> 4;
    const bf16_t* Z = (const bf16_t*)(a->ws + WS_Z);
    bf16_t* CAT = (bf16_t*)(a->ws + WS_CAT);
    {
#pragma unroll
        for (int it = 0; it < 9; ++it) { const int id = tid + 512 * it, rr = id >> 5, ch = id & 31, j = pos0 - 8 + rr;
            u32x4 v = (u32x4){0u, 0u, 0u, 0u};
            if (j >= 0 && j < n) v = ld16g(Z + (size_t)(seq_row0 + j) * ZC + 1024 + ch * 8);
            *(LAS u32x4*)(lds + rr * 512 + ch * 16) = v; }
        __syncthreads();
        const int c = tid & 255, half = tid >> 8, hw = 1 << (c >> 6);
        const LAS bf16_t* P = (const LAS bf16_t*)lds + c;
        const int t0 = half * 64;
        float s = 0.f;
        for (int j = t0 - hw; j < t0 + hw; ++j) s += bf2f(P[(8 + j) * 256]);
        for (int tl = t0; tl < t0 + 64; ++tl) {
            const int pos = pos0 + tl; const int lo = max(pos - hw, 0), hi = min(pos + hw, n);
            CAT[(size_t)(row0 + tl) * D + 512 + c] = f2bf(s / (float)(hi - lo) - bf2f(P[(8 + tl) * 256]));
            s += bf2f(P[(8 + tl + hw) * 256]) - bf2f(P[(8 + tl - hw) * 256]);
        }
        __syncthreads();
    }
    {
        const int i16 = lane & 15;
        u32x4 gw[4][2];
#pragma unroll
        for (int ps = 0; ps < 4; ++ps) { const int q = w * 16 + ps * 4 + g; const bf16_t* src = Z + (size_t)(row0 + q) * ZC + 1536 + 16 * i16; gw[ps][0] = ld16g(src); gw[ps][1] = ld16g(src + 8); }
#pragma unroll
        for (int ps = 0; ps < 4; ++ps) {
            const int q = w * 16 + ps * 4 + g;
            float gv[16];
#pragma unroll
            for (int hh = 0; hh < 2; ++hh) { const u32x4 x = gw[ps][hh];
                gv[8 * hh + 0] = gelu_erf(lo2f(x.x)); gv[8 * hh + 1] = gelu_erf(hi2f(x.x)); gv[8 * hh + 2] = gelu_erf(lo2f(x.y)); gv[8 * hh + 3] = gelu_erf(hi2f(x.y));
                gv[8 * hh + 4] = gelu_erf(lo2f(x.z)); gv[8 * hh + 5] = gelu_erf(hi2f(x.z)); gv[8 * hh + 6] = gelu_erf(lo2f(x.w)); gv[8 * hh + 7] = gelu_erf(hi2f(x.w)); }
            float sm = 0.f;
#pragma unroll
            for (int e = 0; e < 16; ++e) sm += gv[e];
            const float mean = row_sum16(sm) * (1.0f / 256.0f);
            float qq = 0.f;
#pragma unroll
            for (int e = 0; e < 16; ++e) { const float d = gv[e] - mean; qq += d * d; }
            const float rstd = 1.0f / sqrtf(row_sum16(qq) * (1.0f / 256.0f) + 1e-6f);
#pragma unroll
            for (int e = 0; e < 16; ++e) { const int c = 16 * i16 + e; *(LAS bf16_t*)(lds + c * 256 + ((((q >> 3) ^ (c & 15))) << 4) + (q & 7) * 2) = f2bf((gv[e] - mean) * rstd); }
        }
    }
    __syncthreads();
    {
        const int h = w >> 1, ph = w & 1;
        const bf16_t* Ws = (const bf16_t*)(a->ws + WS_WSGU) + (size_t)(l * 4 + h) * 128 * 128;
        const float* bs = a->in[12] + (size_t)(l * 4 + h) * 128;
        f32x4 acc[4][4];
#pragma unroll
        for (int i = 0; i < 4; ++i)
#pragma unroll
            for (int j = 0; j < 4; ++j) acc[i][j] = (f32x4){0.f, 0.f, 0.f, 0.f};
#pragma unroll
        for (int ks = 0; ks < 4; ++ks) {
            bf16x8 af[4], bfv[4];
#pragma unroll
            for (int cf = 0; cf < 4; ++cf) { const int c = h * 64 + 16 * cf + fr; af[cf] = *(const LAS bf16x8*)(lds + c * 256 + (((4 * ks + g) ^ (c & 15)) << 4)); }
#pragma unroll
            for (int pf = 0; pf < 4; ++pf) { const int p = ph * 64 + 16 * pf + fr; bfv[pf] = *(const bf16x8*)(Ws + (size_t)p * 128 + 32 * ks + 8 * g); }
#pragma unroll
            for (int cf = 0; cf < 4; ++cf)
#pragma unroll
                for (int pf = 0; pf < 4; ++pf) acc[cf][pf] = __builtin_amdgcn_mfma_f32_16x16x32_bf16(af[cf], bfv[pf], acc[cf][pf], 0, 0, 0);
        }
#pragma unroll
        for (int pf = 0; pf < 4; ++pf) { const int p = ph * 64 + 16 * pf + fr; const float bias = bs[p];
#pragma unroll
            for (int cf = 0; cf < 4; ++cf) { const int c0 = h * 64 + 16 * cf + 4 * g;
                const u32x2 uw = *(const u32x2*)(Z + (size_t)(row0 + p) * ZC + 1280 + c0);
                u32x2 o; o.x = pack2(gelu_erf(lo2f(uw.x)) * (acc[cf][pf][0] + bias), gelu_erf(hi2f(uw.x)) * (acc[cf][pf][1] + bias));
                o.y = pack2(gelu_erf(lo2f(uw.y)) * (acc[cf][pf][2] + bias), gelu_erf(hi2f(uw.y)) * (acc[cf][pf][3] + bias));
                *(u32x2*)(CAT + (size_t)(row0 + p) * D + 768 + c0) = o; } }
    }
    __syncthreads();
}

__device__ __forceinline__ void mixer_attn(AP a, LAS unsigned char* lds, int l, int row0, int seq_row0, int pos0, int n, int b, bool is_ctx, int kvh) {
    const int tid = tid_opaque(), lane = tid & 63, w = __builtin_amdgcn_readfirstlane(tid >> 6), fr = lane & 15, g = lane >> 4;
    const bf16_t* Z = (const bf16_t*)(a->ws + WS_Z);
    bf16_t* CAT = (bf16_t*)(a->ws + WS_CAT);
    __syncthreads();
    ((LAS u32x4*)(lds + 98304))[tid] = ((const u32x4*)(a->ws + WS_ROPE))[tid];
    const LAS f32x2* rope = (const LAS f32x2*)(lds + 98304);
    constexpr float QS = 0.125f * 1.44269504088896341f;
    constexpr int QS_OFF = 0, KS_OFF = 32768, VS_OFF = 65536;
    const int nbq = pos0 >> 7;
    unsigned bmask = 0x18u;
    if (!is_ctx) { if (nbq > 0) bmask |= 1u; bmask |= 2u; if (nbq + 1 < (n >> 7)) bmask |= 4u; }
    const int kr = tid >> 2, kax = (tid >> 1) & 1, kh8 = tid & 1;
#define MX_KSRC(blk) (Z + (size_t)((((blk) < 3) ? seq_row0 + (nbq + (blk) - 1) * 128 : NLAT + b * 256 + ((blk) - 3) * 128) + kr) * ZC + 768 + kvh * 64 + kax * 32 + kh8 * 8)
#define MX_VSTAGE(blk, buf) do { const bool _band = (blk) < 3; const int _key0 = _band ? (nbq + (blk) - 1) * 128 : ((blk) - 3) * 128; \
        const bf16_t* _vs = _band ? (const bf16_t*)(a->ws + WS_VT) + (size_t)(b * 2 + kvh) * 64 * 4096 + _key0 : (const bf16_t*)(a->ws + WS_VTC) + (size_t)(b * 2 + kvh) * 64 * 256 + _key0; \
        const int _vld = _band ? 4096 : 256; \
        _Pragma("unroll") for (int _i = 0; _i < 2; ++_i) { const int _P = _i * 512 + tid, _d = _P >> 4, _c = (_P & 15) ^ (_d & 15); \
            glds16(_vs + (size_t)_d * _vld + _c * 8, lds + VS_OFF + (buf) * 16384 + _i * 8192 + w * 1024); } } while (0)
    {
        __syncthreads();
#pragma unroll
        for (int it = 0; it < 2; ++it) {
            const int item = tid + 512 * it, r = item >> 2, ax = (item >> 1) & 1, h8 = item & 1, i = r & 127, qpos = pos0 + i;
            const bf16_t* src = Z + (size_t)(row0 + i) * ZC + 512 + (2 * kvh + (r >> 7)) * 64 + ax * 32 + h8 * 8;
            u32x4 wl = ld16g(src), wh = ld16g(src + 16);
            rope_pack8(wl, wh, rope + (ax ? (qpos & 63) : (qpos >> 6)) * 16 + h8 * 8, !is_ctx, QS);
            const int ch = ax * 4 + h8, sw = (r >> 1) & 7;
            *(LAS u32x4*)(lds + QS_OFF + r * 128 + ((ch ^ sw) << 4)) = wl;
            *(LAS u32x4*)(lds + QS_OFF + r * 128 + (((ch + 2) ^ sw) << 4)) = wh;
        }
        const int hh = w >> 2, qb = (w & 3) * 32, h = 2 * kvh + hh;
        float m[2], lsum[2];
        m[0] = m[1] = a->in[8][l * 4 + h] * 1.44269504088896341f;
        lsum[0] = lsum[1] = (g == 0) ? 1.0f : 0.0f;
        f32x4 O[4][2];
#pragma unroll
        for (int i = 0; i < 4; ++i) { O[i][0] = (f32x4){0.f, 0.f, 0.f, 0.f}; O[i][1] = (f32x4){0.f, 0.f, 0.f, 0.f}; }
        bf16x8 Qf[2][2];
        bool have_q = false;
        unsigned rem = bmask;
        int cur = __builtin_ctz(rem); rem &= rem - 1u;
        int buf = 0;
        u32x4 kl = ld16g(MX_KSRC(cur)), kh = ld16g(MX_KSRC(cur) + 16);
        MX_VSTAGE(cur, 0);
#pragma unroll 1
        for (;;) {
            const int jb = cur - 1; const bool band = cur < 3;
            {
                const int kpos = (nbq + jb) * 128 + kr;
                rope_pack8(kl, kh, rope + (kax ? (kpos & 63) : (kpos >> 6)) * 16 + kh8 * 8, band, 1.0f);
                const int ch = kax * 4 + kh8, sw = (kr >> 1) & 7;
                *(LAS u32x4*)(lds + KS_OFF + buf * 16384 + kr * 128 + ((ch ^ sw) << 4)) = kl;
                *(LAS u32x4*)(lds + KS_OFF + buf * 16384 + kr * 128 + (((ch + 2) ^ sw) << 4)) = kh;
            }
            asm volatile("s_waitcnt vmcnt(0)" ::: "memory");
            __syncthreads();
            const int nxt = rem ? __builtin_ctz(rem) : -1; rem &= rem - 1u;
            if (nxt >= 0) { kl = ld16g(MX_KSRC(nxt)); kh = ld16g(MX_KSRC(nxt) + 16); MX_VSTAGE(nxt, buf ^ 1); }
            if (!have_q) {
#pragma unroll
                for (int qf = 0; qf < 2; ++qf)
#pragma unroll
                    for (int ks = 0; ks < 2; ++ks) { const int r = hh * 128 + qb + 16 * qf + fr; Qf[qf][ks] = *(const LAS bf16x8*)(lds + QS_OFF + r * 128 + (((4 * ks + g) ^ ((r >> 1) & 7)) << 4)); }
                have_q = true;
            }
            const int kso = KS_OFF + buf * 16384, vso = VS_OFF + buf * 16384;
            f32x4 S[8][2];
#pragma unroll
            for (int kf = 0; kf < 8; ++kf) { S[kf][0] = (f32x4){0.f, 0.f, 0.f, 0.f}; S[kf][1] = (f32x4){0.f, 0.f, 0.f, 0.f}; }
#pragma unroll
            for (int kf = 0; kf < 8; ++kf)
#pragma unroll
                for (int ks = 0; ks < 2; ++ks) { const int r = 16 * kf + fr;
                    const bf16x8 kfr = *(const LAS bf16x8*)(lds + kso + r * 128 + (((4 * ks + g) ^ ((r >> 1) & 7)) << 4));
                    S[kf][0] = __builtin_amdgcn_mfma_f32_16x16x32_bf16(kfr, Qf[0][ks], S[kf][0], 0, 0, 0);
                    S[kf][1] = __builtin_amdgcn_mfma_f32_16x16x32_bf16(kfr, Qf[1][ks], S[kf][1], 0, 0, 0); }
            bf16x8 Pp[4][2];
#pragma unroll
            for (int qf = 0; qf < 2; ++qf) {
                const int qi = qb + 16 * qf + fr;
                if (band && jb != 0) {
#pragma unroll
                    for (int kf = 0; kf < 8; ++kf)
#pragma unroll
                        for (int r = 0; r < 4; ++r) { const int kk = 16 * kf + 4 * g + r; const bool ok = (jb < 0) ? (kk >= qi) : (kk <= qi); if (!ok) S[kf][qf][r] = -1.0e30f; }
                }
                float mx = S[0][qf][0];
#pragma unroll
                for (int kf = 0; kf < 8; ++kf)
#pragma unroll
                    for (int r = 0; r < 4; ++r) mx = fmaxf(mx, S[kf][qf][r]);
                mx = fmaxf(mx, __shfl_xor(mx, 16)); mx = fmaxf(mx, __shfl_xor(mx, 32));
                const float mn = fmaxf(m[qf], mx), corr = __builtin_amdgcn_exp2f(m[qf] - mn);
                m[qf] = mn;
                float ps = 0.f;
#pragma unroll
                for (int kf = 0; kf < 8; ++kf)
#pragma unroll
                    for (int r = 0; r < 4; ++r) { const float p = __builtin_amdgcn_exp2f(S[kf][qf][r] - mn); S[kf][qf][r] = p; ps += p; }
                lsum[qf] = lsum[qf] * corr + ps;
#pragma unroll
                for (int df = 0; df < 4; ++df) O[df][qf] *= corr;
#pragma unroll
                for (int t = 0; t < 4; ++t) { u32x4 pw; pw.x = pack2(S[2 * t][qf][0], S[2 * t][qf][1]); pw.y = pack2(S[2 * t][qf][2], S[2 * t][qf][3]);
                    pw.z = pack2(S[2 * t + 1][qf][0], S[2 * t + 1][qf][1]); pw.w = pack2(S[2 * t + 1][qf][2], S[2 * t + 1][qf][3]); Pp[t][qf] = __builtin_bit_cast(bf16x8, pw); }
            }
#pragma unroll
            for (int t = 0; t < 4; ++t)
#pragma unroll
                for (int df = 0; df < 4; ++df) { const int d = 16 * df + fr;
                    const u32x2 v0 = *(const LAS u32x2*)(lds + vso + d * 256 + (((4 * t + (g >> 1)) ^ (d & 15)) << 4) + (g & 1) * 8);
                    const u32x2 v1 = *(const LAS u32x2*)(lds + vso + d * 256 + (((4 * t + 2 + (g >> 1)) ^ (d & 15)) << 4) + (g & 1) * 8);
                    u32x4 vw; vw.x = v0.x; vw.y = v0.y; vw.z = v1.x; vw.w = v1.y; const bf16x8 vf = __builtin_bit_cast(bf16x8, vw);
                    O[df][0] = __builtin_amdgcn_mfma_f32_16x16x32_bf16(vf, Pp[t][0], O[df][0], 0, 0, 0);
                    O[df][1] = __builtin_amdgcn_mfma_f32_16x16x32_bf16(vf, Pp[t][1], O[df][1], 0, 0, 0); }
            if (nxt < 0) break;
            cur = nxt; buf ^= 1;
        }
#pragma unroll
        for (int qf = 0; qf < 2; ++qf) {
            float lt = lsum[qf]; lt += __shfl_xor(lt, 16); lt += __shfl_xor(lt, 32);
            const float inv = 1.0f / lt;
            bf16_t* dst = CAT + (size_t)(row0 + qb + 16 * qf + fr) * D + 256 + h * 64 + 4 * g;
#pragma unroll
            for (int df = 0; df < 4; ++df) { u32x2 o; o.x = pack2(O[df][qf][0] * inv, O[df][qf][1] * inv); o.y = pack2(O[df][qf][2] * inv, O[df][qf][3] * inv); *(u32x2*)(dst + 16 * df) = o; }
        }
    }
#undef MX_KSRC
#undef MX_VSTAGE
    __syncthreads();
}

constexpr int FF_DA = 0, FF_DC = 32768, FF_XT = 49152  , FF_Z2 = 81920  , FF_OB = 114688  ;
__device__ __forceinline__ int ff_addr(int row, int k) { return row * 256 + ((((k >> 3) ^ (row & 15))) << 4) + (k & 7) * 2; }
__device__ __forceinline__ float cos_turns(float x) { return __builtin_amdgcn_cosf(x); }
__device__ __forceinline__ float sin_turns(float x) { return __builtin_amdgcn_sinf(x); }
__device__ __forceinline__ void fft_setup(LAS unsigned char* lds) {
    const int tid = tid_opaque();
    __syncthreads();
    for (int idx = tid; idx < 16384; idx += NT) { const int i = idx >> 7, k = idx & 127, ro = i >> 6, k1 = i & 63, part = k >> 6, n1 = k & 63; const float t = (float)((k1 * n1) & 63) * (1.0f / 64.0f);
        const float c = cos_turns(t), sn = sin_turns(t);
        const float v = (ro == 0) ? (part == 0 ? c : sn) : (part == 0 ? -sn : c);
        *(LAS bf16_t*)(lds + FF_DA + ff_addr(i, k)) = f2bf(v * 0.125f); }
    for (int idx = tid; idx < 8192; idx += NT) { const int k2 = idx >> 7, k = idx & 127, ri = k >> 6, n2 = k & 63; const float t = (float)((k2 * n2) & 63) * (1.0f / 64.0f);
        const float v = (ri == 0) ? cos_turns(t) : sin_turns(t);
        *(LAS bf16_t*)(lds + FF_DC + ff_addr(k2, k)) = f2bf(v * 0.125f); }
    __syncthreads();
}
__device__ __forceinline__ void fft_unit(AP a, LAS unsigned char* lds, int b, int cg) {
    const int tid = tid_opaque(), lane = tid & 63, w = __builtin_amdgcn_readfirstlane(tid >> 6), fr = lane & 15, g = lane >> 4;
    const int mf = w & 3, nh = w >> 2;
    const bf16_t* AT = (const bf16_t*)(a->ws + WS_AT) + (size_t)(b * 256 + cg * 4) * 8192;
    u32x4 xin[2][2];
#pragma unroll
    for (int h = 0; h < 2; ++h)
#pragma unroll
        for (int it = 0; it < 2; ++it) xin[h][it] = ld16g(AT + (size_t)h * 8192 + (size_t)(tid + 512 * it) * 8);
#pragma unroll 1
    for (int cp = 0; cp < 2; ++cp) {
#pragma unroll
        for (int h = 0; h < 2; ++h)
#pragma unroll
            for (int it = 0; it < 2; ++it) { const int q = tid + 512 * it, part = q >> 9, pos0 = (q & 511) * 8, n1 = pos0 >> 6, n2 = pos0 & 63, k = part * 64 + n1;
                const unsigned wv[4] = {xin[h][it].x, xin[h][it].y, xin[h][it].z, xin[h][it].w};
#pragma unroll
                for (int e = 0; e < 4; ++e) { *(LAS bf16_t*)(lds + FF_XT + h * 16384 + ff_addr(n2 + 2 * e, k)) = (bf16_t)(wv[e] & 0xffffu); *(LAS bf16_t*)(lds + FF_XT + h * 16384 + ff_addr(n2 + 2 * e + 1, k)) = (bf16_t)(wv[e] >> 16); } }
        if (cp == 0) {
#pragma unroll
            for (int h = 0; h < 2; ++h)
#pragma unroll
                for (int it = 0; it < 2; ++it) xin[h][it] = ld16g(AT + (size_t)(2 + h) * 8192 + (size_t)(tid + 512 * it) * 8); }
        __syncthreads();
        f32x4 acc[2][2][2];
#pragma unroll
        for (int h = 0; h < 2; ++h)
#pragma unroll
            for (int x = 0; x < 2; ++x) { acc[h][x][0] = (f32x4){0.f, 0.f, 0.f, 0.f}; acc[h][x][1] = (f32x4){0.f, 0.f, 0.f, 0.f}; }
#pragma unroll
        for (int ks = 0; ks < 4; ++ks) {
            bf16x8 af[2];
#pragma unroll
            for (int x = 0; x < 2; ++x) { const int i = 16 * (mf + 4 * x) + fr; af[x] = *(const LAS bf16x8*)(lds + FF_DA + i * 256 + (((4 * ks + g) ^ (i & 15)) << 4)); }
#pragma unroll
            for (int h = 0; h < 2; ++h)
#pragma unroll
                for (int n = 0; n < 2; ++n) { const int j = 16 * (2 * nh + n) + fr; const bf16x8 bfv = *(const LAS bf16x8*)(lds + FF_XT + h * 16384 + j * 256 + (((4 * ks + g) ^ (j & 15)) << 4));
                    acc[h][0][n] = __builtin_amdgcn_mfma_f32_16x16x32_bf16(af[0], bfv, acc[h][0][n], 0, 0, 0);
                    acc[h][1][n] = __builtin_amdgcn_mfma_f32_16x16x32_bf16(af[1], bfv, acc[h][1][n], 0, 0, 0); }
        }
#pragma unroll
        for (int n = 0; n < 2; ++n)
#pragma unroll
            for (int r = 0; r < 4; ++r) { const int k1 = 16 * mf + 4 * g + r, n2 = 16 * (2 * nh + n) + fr; const float t = (float)((k1 * n2) & 4095) * (1.0f / 4096.0f);
                const float c = cos_turns(t), sn = sin_turns(t);
#pragma unroll
                for (int h = 0; h < 2; ++h) { const float zr = acc[h][0][n][r], zi = acc[h][1][n][r];
                    *(LAS bf16_t*)(lds + FF_Z2 + h * 16384 + ff_addr(k1, n2)) = f2bf(zr * c + zi * sn);
                    *(LAS bf16_t*)(lds + FF_Z2 + h * 16384 + ff_addr(k1, 64 + n2)) = f2bf(zi * c - zr * sn); } }
        __syncthreads();
        f32x4 acc2[2][2];
#pragma unroll
        for (int h = 0; h < 2; ++h) { acc2[h][0] = (f32x4){0.f, 0.f, 0.f, 0.f}; acc2[h][1] = (f32x4){0.f, 0.f, 0.f, 0.f}; }
#pragma unroll
        for (int ks = 0; ks < 4; ++ks) {
            const int i = 16 * mf + fr; const bf16x8 af = *(const LAS bf16x8*)(lds + FF_DC + i * 256 + (((4 * ks + g) ^ (i & 15)) << 4));
#pragma unroll
            for (int h = 0; h < 2; ++h)
#pragma unroll
                for (int n = 0; n < 2; ++n) { const int j = 16 * (2 * nh + n) + fr; const bf16x8 bfv = *(const LAS bf16x8*)(lds + FF_Z2 + h * 16384 + j * 256 + (((4 * ks + g) ^ (j & 15)) << 4));
                    acc2[h][n] = __builtin_amdgcn_mfma_f32_16x16x32_bf16(af, bfv, acc2[h][n], 0, 0, 0); }
        }
#pragma unroll
        for (int n = 0; n < 2; ++n)
#pragma unroll
            for (int r = 0; r < 4; ++r) { const int k = 16 * (2 * nh + n) + fr + 64 * (16 * mf + 4 * g + r);
                *(LAS unsigned*)(lds + FF_OB + k * 8 + cp * 4) = pack2(acc2[0][n][r], acc2[1][n][r]); }
    }
    __syncthreads();
    bf16_t* CAT = (bf16_t*)(a->ws + WS_CAT) + (size_t)(b * 4096) * D + cg * 4;
#pragma unroll
    for (int it = 0; it < 8; ++it) { const int k = tid + 512 * it; *(u32x2*)(CAT + (size_t)k * D) = *(const LAS u32x2*)(lds + FF_OB + k * 8); }
    __syncthreads();
}

__device__ __forceinline__ void p2_mix(AP a, unsigned char* ldsg, LAS unsigned char* lds, int l) {
    const int n_tile = 128 + ((l == 0) ? 8 : 0), n_att = 2 * n_tile, n_dft = 256, n_dftc = (l == 0) ? 16 : 0;
    bf16_t* CAT = (bf16_t*)(a->ws + WS_CAT);
    bool fft_ready = false;
    for (int u = blockIdx.x; u < n_att + n_dft + n_tile + n_dftc; u += gridDim.x) {
        if (u < n_att || (u >= n_att + n_dft && u < n_att + n_dft + n_tile)) {
            const bool att = u < n_att;
            const int t = att ? (u >> 1) : (u - n_att - n_dft);
            const bool isc = t >= 128; const int tt = t - 128;
            const int b = isc ? (tt >> 1) : (t >> 5);
            const int row0 = isc ? NLAT + tt * 128 : t * 128, seq_row0 = isc ? NLAT + b * 256 : b * 4096, pos0 = isc ? (tt & 1) * 128 : (t & 31) * 128, n = isc ? 256 : 4096;
            if (att) { for (int rep = 0; rep < PROBE_MIX_REP; ++rep) mixer_attn(a, lds, l, row0, seq_row0, pos0, n, b, isc, u & 1); }
            else { for (int rep = 0; rep < PROBE_SGU_REP; ++rep) mixer_sgu_pool(a, lds, l, row0, seq_row0, pos0, n); }
            fft_ready = false;
        } else if (u < n_att + n_dft) {
            const int uu = u - n_att;
            if (!fft_ready) { fft_setup(lds); fft_ready = true; }
            for (int rep = 0; rep < PROBE_FFT_REP; ++rep) fft_unit(a, lds, uu >> 6, uu & 63);
        } else {
            const int uu = u - n_att - n_dft - n_tile, b = uu >> 2, mt = (uu >> 1) & 1, ch0 = (uu & 1) * 128;
            const bf16_t* A = (const bf16_t*)(a->ws + WS_DFTC) + (size_t)(mt * 128) * 512;
            const bf16_t* B0 = (const bf16_t*)(a->ws + WS_ATC) + ((size_t)b * 256 + ch0) * 512;
            EpiBf16 E; E.C = CAT + (size_t)(NLAT + b * 256 + mt * 128) * D + ch0; E.ld = D; E.scale = 1.0f;
            gemm_tile<128, false, EpiBf16>(lds, A, 512, nullptr, 128, B0, B0 + (size_t)64 * 512, 512, 512, E);
            fft_ready = false;
        }
    }
    exp_queue(a, ldsg, l);
}

__device__ __forceinline__ int uni(int v) { return __builtin_amdgcn_readfirstlane(v); }
__device__ __forceinline__ int vblock() { const int G = gridDim.x, b = blockIdx.x; return (G % 8 == 0) ? (b % 8) * (G / 8) + b / 8 : b; }
template <class T> __device__ __forceinline__ T* unip(T* p) { const unsigned long long v = (unsigned long long)p; const unsigned lo = __builtin_amdgcn_readfirstlane((unsigned)v), hi = __builtin_amdgcn_readfirstlane((unsigned)(v >> 32)); return (T*)(((unsigned long long)hi << 32) | lo); }
struct SchedInProj {
    typedef EpiInProj Epi; static constexpr bool GATHER = false, FP8 = false;
    unsigned char* ws; int l, G, me;
    __device__ __forceinline__ bool get(int i, g256::Unit<Epi>& u) const {
        const int n_lat = 64 * 7, n_ctx = (l == 0) ? 4 * 7 : 4;
        const int idx = i * G + me; if (idx >= n_lat + n_ctx) return false;
        int row0, b, ct, n; bf16_t *tF, *tV;
        if (idx < n_lat) { const int rt = idx / 7; ct = idx % 7; row0 = rt * 256; b = row0 >> 12; n = 4096;
            tF = (bf16_t*)(ws + WS_AT) + (size_t)b * 256 * 2 * 4096; tV = (bf16_t*)(ws + WS_VT) + (size_t)b * 128 * 4096; }
        else { const int uu = idx - n_lat; int rt; if (l == 0) { rt = uu / 7; ct = uu % 7; } else { rt = uu; ct = 3; }
            row0 = NLAT + rt * 256; b = rt; n = 256;
            tF = (bf16_t*)(ws + WS_ATC) + (size_t)b * 256 * 2 * 256; tV = (bf16_t*)(ws + WS_VTC) + (size_t)b * 128 * 256; }
        u.A = (const bf16_t*)(ws + WS_H) + (size_t)row0 * D;
        u.B0 = (const bf16_t*)(ws + WS_WIN) + ((size_t)l * ZC + ct * 256) * 1024; u.B1 = u.B0 + (size_t)128 * 1024; u.ridx = nullptr; u.valid = 256;
        u.epi.Zt = (bf16_t*)(ws + WS_Z) + (size_t)row0 * ZC + ct * 256; u.epi.tF = tF; u.epi.tV = tV; u.epi.n0 = ct * 256; u.epi.pos0 = (idx < n_lat) ? (row0 & 4095) : 0; u.epi.n = n;
        return true;
    }
};
struct SchedOutProj {
    typedef EpiBf16 Epi; static constexpr bool GATHER = false, FP8 = false;
    unsigned char* ws; int l, G, me;
    __device__ __forceinline__ bool get(int i, g256::Unit<Epi>& u) const {
        const int nrt = NLAT / 256;
        const int idx = i * G + me; if (idx >= nrt * 4) return false;
        const int rt = idx >> 2, ct = idx & 3;
        u.A = (const bf16_t*)(ws + WS_CAT) + (size_t)(rt * 256) * D;
        u.B0 = (const bf16_t*)(ws + WS_WOUT) + ((size_t)l * 1024 + ct * 256) * 1024; u.B1 = u.B0 + (size_t)128 * 1024; u.ridx = nullptr; u.valid = 256;
        u.epi.C = (bf16_t*)(ws + WS_Y) + (size_t)(rt * 256) * D + ct * 256; u.epi.ld = D; u.epi.scale = 1.0f;
        return true;
    }
};
__device__ __forceinline__ void moe_units(const LAS int* blk, LAS int* uinf, int G, int me) {
    const int i = threadIdx.x;
    if (i < 8) { const int idx = i * G + me, nu = blk[32] * 4; int e = 0, valid = 0;
        if (idx < nu) { const int rb = idx >> 2; for (int q = 1; q < 32; ++q) if (blk[q] <= rb) e = q; valid = min(256, blk[33 + e] - (rb - blk[e]) * 256); }
        uinf[2 * i] = e; uinf[2 * i + 1] = valid; }
    __syncthreads();
}
struct SchedGateUp {
    typedef EpiGateUp8 Epi; static constexpr bool GATHER = true, FP8 = true;
    unsigned char* ws; const LAS int* uinf; const LAS int* ridx_lds; int G, me, l, nu;
    __device__ __forceinline__ bool get(int i, g256::Unit<Epi>& u) const {
        const int idx = i * G + me; if (idx >= nu) return false;
        const int rb = idx >> 2, ct = idx & 3, e = uni(uinf[2 * i]);
        u.A = (const bf16_t*)(ws + WS_H8);
        { const unsigned char* b0 = ws + WS_WEXP + (size_t)l * WEXP_LAYER + ((size_t)e * 512 + ct * 128) * 1024; u.B0 = (const bf16_t*)b0; u.B1 = (const bf16_t*)(b0 + EXPMAT); }
        u.ridx = ridx_lds + (i & 7) * 256; u.valid = uni(uinf[2 * i + 1]);
        u.epi.C = ws + WS_HID + (size_t)(rb * 256) * DEXP + ct * 128; u.epi.ld = DEXP;
        return true;
    }
};
struct SchedDown {
    typedef EpiFp8 Epi; static constexpr bool GATHER = false, FP8 = true;
    unsigned char* ws; const LAS int* uinf; int G, me, l, nu;
    __device__ __forceinline__ bool get(int i, g256::Unit<Epi>& u) const {
        const int idx = i * G + me; if (idx >= nu) return false;
        const int rb = idx >> 2, ct = idx & 3, e = uni(uinf[2 * i]);
        u.A = (const bf16_t*)(ws + WS_HID + (size_t)(rb * 256) * DEXP);
        { const unsigned char* b0 = ws + WS_WEXP + (size_t)l * WEXP_LAYER + 2 * EXPMAT + ((size_t)e * 1024 + ct * 256) * 512; u.B0 = (const bf16_t*)b0; u.B1 = (const bf16_t*)(b0 + (size_t)128 * 512); } u.ridx = nullptr; u.valid = 256;
        u.epi.C = ws + WS_YS + (size_t)(rb * 256) * D + ct * 256; u.epi.ld = D; u.epi.scale = 1.0f / 32.0f;
        return true;
    }
};

__device__ __forceinline__ void p4_ln1_router(AP a, unsigned char* lds, int l) {
    const int tid = tid_opaque(), lane = tid & 63, w = tid >> 6;
    const int ntok = (l == 0) ? NTOK : NLAT;
    int* cnt = (int*)(lds + MISC_OFF);
    if (tid < 32) cnt[tid] = 0;
    f32x4* Lg = (f32x4*)lds; f32x4* Le = (f32x4*)(lds + 16384); f32x4* Lgb = (f32x4*)(lds + 147456);
    {
        const float* wrg_ = a->in[16] + (size_t)l * 1024 * 4; const float* wre_ = a->in[17] + (size_t)l * 1024 * 32;
#pragma unroll
        for (int it = 0; it < 2; ++it) { const int c = tid + 512 * it, slot = (((c >> 8) * 4 + (c & 3)) << 6) + ((c >> 2) & 63);
            Lg[slot] = *(const f32x4*)(wrg_ + (size_t)c * 4);
#pragma unroll
            for (int q = 0; q < 8; ++q) Le[q * 1024 + slot] = *(const f32x4*)(wre_ + (size_t)c * 32 + q * 4); }
        Lgb[tid] = (tid < 256) ? *(const f32x4*)(a->in[14] + l * 1024 + tid * 4) : *(const f32x4*)(a->in[15] + l * 1024 + (tid - 256) * 4);
    }
    __syncthreads();
    const float* mod = (const float*)(a->ws + WS_MOD) + (size_t)l * 5 * 6144;
    const bf16_t* Y = (const bf16_t*)(a->ws + WS_Y);
    float* X1 = (float*)(a->ws + WS_X1);
    unsigned char* H8 = a->ws + WS_H8;
    int* tokE = (int*)(a->ws + WS_TOKE); int* tokR = (int*)(a->ws + WS_TOKR); float* tokG = (float*)(a->ws + WS_TOKG);
    const int tstep = gridDim.x * 8;
    f32x4 nx[4]; u32x2 ny[4];
    {   const int t = blockIdx.x * 8 + w;
        if (t < ntok) { const float* xs = (l == 0) ? ((t < NLAT) ? a->in[0] + (size_t)t * D : a->in[2] + (size_t)(t - NLAT) * D) : (const float*)(a->ws + WS_XC) + (size_t)t * D;
#pragma unroll
            for (int i = 0; i < 4; ++i) { nx[i] = *(const f32x4*)(xs + 256 * i + 4 * lane); ny[i] = *(const u32x2*)(Y + (size_t)t * D + 256 * i + 4 * lane); } } }
    int mrow = -1; f32x4 mg[4], msh[4], msc[4];
    for (int t = blockIdx.x * 8 + w; t < ntok; t += tstep) {
        const int mr = (t < NLAT) ? (t >> 12) : 4;
        if (mr != mrow) { mrow = mr; const float* m = mod + (size_t)mr * 6144;
#pragma unroll
            for (int i = 0; i < 4; ++i) { const int c = 256 * i + 4 * lane; mg[i] = *(const f32x4*)(m + 2048 + c); msh[i] = *(const f32x4*)(m + 3072 + c); msc[i] = *(const f32x4*)(m + 4096 + c); } }
        f32x4 v[4];
#pragma unroll
        for (int i = 0; i < 4; ++i) { const f32x4 yv = (f32x4){lo2f(ny[i].x), hi2f(ny[i].x), lo2f(ny[i].y), hi2f(ny[i].y)};
#pragma unroll
            for (int e = 0; e < 4; ++e) v[i][e] = RES_ALPHA * nx[i][e] + mg[i][e] * yv[e]; }
        {   const int tn = t + tstep;
            if (tn < ntok) { const float* xs = (l == 0) ? ((tn < NLAT) ? a->in[0] + (size_t)tn * D : a->in[2] + (size_t)(tn - NLAT) * D) : (const float*)(a->ws + WS_XC) + (size_t)tn * D;
#pragma unroll
                for (int i = 0; i < 4; ++i) { nx[i] = *(const f32x4*)(xs + 256 * i + 4 * lane); ny[i] = *(const u32x2*)(Y + (size_t)tn * D + 256 * i + 4 * lane); } } }
        float mean, rstd; ln_stats(v, mean, rstd);
#pragma unroll
        for (int i = 0; i < 4; ++i) { const int c = 256 * i + 4 * lane; const f32x4 gg = Lgb[64 * i + lane], bb = Lgb[256 + 64 * i + lane];
#pragma unroll
            for (int e = 0; e < 4; ++e) v[i][e] = (v[i][e] - mean) * rstd * gg[e] + bb[e];
            *(f32x4*)(X1 + (size_t)t * D + c) = v[i]; }
        ln_stats(v, mean, rstd);
#pragma unroll
        for (int i = 0; i < 4; ++i) { const int c = 256 * i + 4 * lane; const f32x4 sh = msh[i], sc = msc[i];
#pragma unroll
            for (int e = 0; e < 4; ++e) v[i][e] = (v[i][e] - mean) * rstd * (1.0f + sc[e]) + sh[e];
            *(unsigned*)(H8 + (size_t)t * D + c) = pack4_fp8(v[i][0], v[i][1], v[i][2], v[i][3]); }
        f32x2 lg01 = (f32x2){0.f, 0.f}, lg23 = (f32x2){0.f, 0.f};
#pragma unroll
        for (int i = 0; i < 4; ++i)
#pragma unroll
            for (int e = 0; e < 4; ++e) { const f32x4 wv = Lg[((i * 4 + e) << 6) + lane]; const f32x2 vv = (f32x2){v[i][e], v[i][e]};
                lg01 += vv * (f32x2){wv[0], wv[1]}; lg23 += vv * (f32x2){wv[2], wv[3]}; }
        float lg[4] = {wave_sum(lg01[0]), wave_sum(lg01[1]), wave_sum(lg23[0]), wave_sum(lg23[1])};
        int grp = 0; float mx = lg[0];
#pragma unroll
        for (int q = 1; q < 4; ++q) if (lg[q] > mx) { mx = lg[q]; grp = q; }
        float se = 0.f;
#pragma unroll
        for (int q = 0; q < 4; ++q) se += expf(lg[q] - mx);
        const float gate_group = 1.0f / se;
        f32x2 le01 = (f32x2){0.f, 0.f}, le23 = (f32x2){0.f, 0.f}, le45 = (f32x2){0.f, 0.f}, le67 = (f32x2){0.f, 0.f};
#pragma unroll
        for (int i = 0; i < 4; ++i)
#pragma unroll
            for (int e = 0; e < 4; ++e) { const f32x4* wp = Le + grp * 2048 + ((i * 4 + e) << 6) + lane; const f32x4 w0 = wp[0], w1 = wp[1024]; const f32x2 vv = (f32x2){v[i][e], v[i][e]};
                le01 += vv * (f32x2){w0[0], w0[1]}; le23 += vv * (f32x2){w0[2], w0[3]}; le45 += vv * (f32x2){w1[0], w1[1]}; le67 += vv * (f32x2){w1[2], w1[3]}; }
        float le[8] = {wave_sum(le01[0]), wave_sum(le01[1]), wave_sum(le23[0]), wave_sum(le23[1]), wave_sum(le45[0]), wave_sum(le45[1]), wave_sum(le67[0]), wave_sum(le67[1])};
        int j1 = 0; float l1 = le[0];
#pragma unroll
        for (int q = 1; q < 8; ++q) if (le[q] > l1) { l1 = le[q]; j1 = q; }
        int j2 = -1; float l2 = -3.0e38f;
#pragma unroll
        for (int q = 0; q < 8; ++q) if (q != j1 && le[q] > l2) { l2 = le[q]; j2 = q; }
        const float e2 = expf(l2 - l1), p1 = 1.0f / (1.0f + e2), p2 = e2 / (1.0f + e2);
        if (lane == 0) {
            const int ex0 = grp * 8 + j1, ex1 = grp * 8 + j2;
            const int r0 = atomicAdd(&cnt[ex0], 1), r1 = atomicAdd(&cnt[ex1], 1);
            tokE[2 * t] = ex0; tokE[2 * t + 1] = ex1; tokR[2 * t] = r0; tokR[2 * t + 1] = r1;
            tokG[2 * t] = gate_group * p1; tokG[2 * t + 1] = gate_group * p2;
        }
    }
    __syncthreads();
    if (tid < 32) ((int*)(a->ws + WS_BCNT))[((size_t)l * MAXG + blockIdx.x) * 32 + tid] = cnt[tid];
    __syncthreads();
}

__device__ __forceinline__ void p5_dispatch(AP a, unsigned char* lds, int l) {
    const int tid = tid_opaque();
    const int ntok = (l == 0) ? NTOK : NLAT;
    int* part = (int*)lds;
    int* tot = (int*)(lds + 4096);
    int* off = (int*)(lds + 4096 + 128);
    int* pstart = (int*)(lds + 4096 + 256);
    const int* bc = (const int*)(a->ws + WS_BCNT) + (size_t)l * MAXG * 32;
    const int G = gridDim.x, me = blockIdx.x;
    { const int e = tid & 31, p = tid >> 5; int s = 0, so = 0; for (int bb = p; bb < G; bb += 16) { const int c = bc[bb * 32 + e]; s += c; if (bb < me) so += c; } part[p * 32 + e] = s; part[512 + p * 32 + e] = so; }
    __syncthreads();
    if (tid < 32) { int s = 0, so = 0; for (int p = 0; p < 16; ++p) { s += part[p * 32 + tid]; so += part[512 + p * 32 + tid]; } tot[tid] = s; off[tid] = so; }
    __syncthreads();
    if (tid == 0) { int acc = 0; for (int e = 0; e < 32; ++e) { pstart[e] = acc; acc += ((tot[e] + 255) >> 8) << 8; } }
    __syncthreads();
    if (me == 0 && tid < 32) ((int*)(a->ws + WS_CNT))[l * 32 + tid] = tot[tid];
    const int* tokE = (const int*)(a->ws + WS_TOKE); const int* tokR = (const int*)(a->ws + WS_TOKR);
    int* tokS = (int*)(a->ws + WS_TOKS); int* slotT = (int*)(a->ws + WS_SLOTT);
    for (int q = tid; ; q += NT) { const int it = q >> 4, j = q & 15, t = (it * G + me) * 8 + (j >> 1); if (t >= ntok) break;
        const int idx = 2 * t + (j & 1); const int e = tokE[idx]; const int slot = pstart[e] + off[e] + tokR[idx]; tokS[idx] = slot; slotT[slot] = t; }
    __syncthreads();
}

__device__ __forceinline__ void moe_table(AP a, int l, LAS int* blk) {
    const int* tot = (const int*)(a->ws + WS_CNT) + l * 32;
    if (threadIdx.x == 0) { int acc = 0; for (int e = 0; e < 32; ++e) { const int c = tot[e]; blk[e] = acc; blk[33 + e] = c; acc += (c + 255) >> 8; } blk[32] = acc; }
    __syncthreads();
}
__device__ __forceinline__ int units_of(int nu, int v, int G) { return (v < nu) ? (nu - v + G - 1) / G : 0; }
__device__ __forceinline__ void p1_inproj(AP a, unsigned char* smem, LAS unsigned char* lds, int l) {
    SchedInProj S; S.ws = a->ws; S.l = l; S.G = gridDim.x; S.me = vblock();
    g256::gemm_phase(lds, 1024, S);
    if (l == 0) { const int nu = 64 * 7 + 4 * 7, G = gridDim.x; if (units_of(nu, S.me, G) < (nu + G - 1) / G) exp_fill(a, smem, 0, 8); }
}
__device__ __forceinline__ void p3_outproj(AP a, unsigned char* smem, LAS unsigned char* lds, int l) {
    SchedOutProj S; S.ws = a->ws; S.l = l; S.G = gridDim.x; S.me = vblock();
    g256::gemm_phase(lds, 1024, S);
    if (l == 0) {
        const bf16_t* W = (const bf16_t*)(a->ws + WS_WOUT);
        for (int u = blockIdx.x; u < 64; u += gridDim.x) { const int rt = u >> 3, ct = u & 7;
            EpiBf16 E; E.C = (bf16_t*)(a->ws + WS_Y) + (size_t)(NLAT + rt * 128) * D + ct * 128; E.ld = D; E.scale = 1.0f;
            const bf16_t* B0 = W + (size_t)(ct * 128) * 1024;
            gemm_tile<128, false, EpiBf16>(lds, (const bf16_t*)(a->ws + WS_CAT) + (size_t)(NLAT + rt * 128) * D, D, nullptr, 128, B0, B0 + (size_t)64 * 1024, 1024, 1024, E); }
        if (blockIdx.x >= 64) exp_fill(a, smem, 0, 3);
    }
}
__device__ __forceinline__ void p6_gateup(AP a, unsigned char* smem, LAS unsigned char* lds, int l) {
    LAS int* blk = (LAS int*)(lds + MISC_OFF + 256);
    moe_table(a, l, blk);
    LAS int* ridx = (LAS int*)(lds + RIDX_OFF);
    const int tid = tid_opaque(), G = gridDim.x, me = vblock(), nu = uni(blk[32]) * 4;
    LAS int* uinf = (LAS int*)(lds + MISC_OFF + 528);
    moe_units(blk, uinf, G, me);
    const int* slotT = (const int*)(a->ws + WS_SLOTT);
    for (int i = 0; i < 8; ++i) { const int idx = i * G + me; if (idx >= nu) break;
        const int rb = idx >> 2, valid = uinf[2 * i + 1];
        if (tid < 256) ridx[i * 256 + tid] = (tid < valid) ? slotT[rb * 256 + tid] : 0; }
    __syncthreads();
    SchedGateUp S; S.ws = a->ws; S.uinf = uinf; S.ridx_lds = ridx; S.G = G; S.me = me; S.l = l; S.nu = nu;
    g256::gemm_phase(lds, 512, S);
    __syncthreads();
    if (l == 0 && units_of(nu, me, G) < (nu + G - 1) / G) exp_fill(a, smem, 1, 4);
}
__device__ __forceinline__ void p7_down(AP a, unsigned char* smem, LAS unsigned char* lds, int l) {
    LAS int* blk = (LAS int*)(lds + MISC_OFF + 256);
    moe_table(a, l, blk);
    LAS int* uinf = (LAS int*)(lds + MISC_OFF + 528);
    SchedDown S; S.ws = a->ws; S.uinf = uinf; S.G = gridDim.x; S.me = vblock(); S.l = l; S.nu = uni(blk[32]) * 4;
    moe_units(blk, uinf, S.G, S.me);
    g256::gemm_phase(lds, 256, S);
    __syncthreads();
    { const int nu = S.nu, G = gridDim.x; if (l == 0 && units_of(nu, S.me, G) < (nu + G - 1) / G) exp_fill(a, smem, 1, 2); }
}

__device__ __forceinline__ void p8_ln2(AP a, unsigned char* lds, int l) {
    const int tid = tid_opaque(), lane = tid & 63, w = tid >> 6;
    const int ntok = (l == 0) ? NTOK : NLAT;
    const float* mod = (const float*)(a->ws + WS_MOD) + (size_t)l * 5 * 6144;
    const float* modn = (const float*)(a->ws + WS_MOD) + (size_t)5 * 6144;
    const float* X1 = (const float*)(a->ws + WS_X1);
    const unsigned char* YS = a->ws + WS_YS;
    const int* tokS = (const int*)(a->ws + WS_TOKS); const float* tokG = (const float*)(a->ws + WS_TOKG);
    f32x4* Lgb = (f32x4*)lds;
    __syncthreads();
    Lgb[tid] = (tid < 256) ? *(const f32x4*)(a->in[21] + l * 1024 + tid * 4) : *(const f32x4*)(a->in[22] + l * 1024 + (tid - 256) * 4);
    __syncthreads();
    int mrow = -1; f32x4 mg[4], nsh[4], nsc[4];
    const int tstep = gridDim.x * 8;
    int t = blockIdx.x * 8 + w;
    int ns0 = 0, ns1 = 0; float nga = 0.f, ngb = 0.f;
    f32x4 nx[4]; unsigned nya[4], nyb[4];
    float cga = 0.f, cgb = 0.f;
    if (t < ntok) { const int s0 = tokS[2 * t], s1 = tokS[2 * t + 1]; cga = tokG[2 * t]; cgb = tokG[2 * t + 1];
#pragma unroll
        for (int i = 0; i < 4; ++i) { const int c = 256 * i + 4 * lane; nx[i] = *(const f32x4*)(X1 + (size_t)t * D + c); nya[i] = *(const unsigned*)(YS + (size_t)s0 * D + c); nyb[i] = *(const unsigned*)(YS + (size_t)s1 * D + c); } }
    if (t + tstep < ntok) { ns0 = tokS[2 * (t + tstep)]; ns1 = tokS[2 * (t + tstep) + 1]; nga = tokG[2 * (t + tstep)]; ngb = tokG[2 * (t + tstep) + 1]; }
    for (; t < ntok; t += tstep) {
        const int mr = (t < NLAT) ? (t >> 12) : 4;
        if (mr != mrow) { mrow = mr; const float* m = mod + (size_t)mr * 6144; const float* mn = modn + (size_t)mr * 6144;
#pragma unroll
            for (int i = 0; i < 4; ++i) { const int c = 256 * i + 4 * lane; mg[i] = *(const f32x4*)(m + 5120 + c); if (l == 0) { nsh[i] = *(const f32x4*)(mn + c); nsc[i] = *(const f32x4*)(mn + 1024 + c); } } }
        f32x4 v[4];
#pragma unroll
        for (int i = 0; i < 4; ++i) { const f32x4 gv = mg[i];
            const f32x2 ya0 = __builtin_amdgcn_cvt_pk_f32_fp8(nya[i], false), ya1 = __builtin_amdgcn_cvt_pk_f32_fp8(nya[i], true), yb0 = __builtin_amdgcn_cvt_pk_f32_fp8(nyb[i], false), yb1 = __builtin_amdgcn_cvt_pk_f32_fp8(nyb[i], true);
            const float f0 = cga * ya0[0] + cgb * yb0[0], f1 = cga * ya0[1] + cgb * yb0[1], f2 = cga * ya1[0] + cgb * yb1[0], f3 = cga * ya1[1] + cgb * yb1[1];
            v[i][0] = RES_ALPHA * nx[i][0] + gv[0] * f0; v[i][1] = RES_ALPHA * nx[i][1] + gv[1] * f1; v[i][2] = RES_ALPHA * nx[i][2] + gv[2] * f2; v[i][3] = RES_ALPHA * nx[i][3] + gv[3] * f3; }
        {   const int tn = t + tstep, tn2 = t + 2 * tstep;
            if (tn < ntok) {
#pragma unroll
                for (int i = 0; i < 4; ++i) { const int c = 256 * i + 4 * lane; nx[i] = *(const f32x4*)(X1 + (size_t)tn * D + c); nya[i] = *(const unsigned*)(YS + (size_t)ns0 * D + c); nyb[i] = *(const unsigned*)(YS + (size_t)ns1 * D + c); }
                cga = nga; cgb = ngb; }
            if (tn2 < ntok) { ns0 = tokS[2 * tn2]; ns1 = tokS[2 * tn2 + 1]; nga = tokG[2 * tn2]; ngb = tokG[2 * tn2 + 1]; } }
        float mean, rstd; ln_stats(v, mean, rstd);
        float* dst = (l == 0) ? (float*)(a->ws + WS_XC) + (size_t)t * D : a->out + (size_t)t * D;
#pragma unroll
        for (int i = 0; i < 4; ++i) { const int c = 256 * i + 4 * lane; const f32x4 gg = Lgb[64 * i + lane], bb = Lgb[256 + 64 * i + lane];
#pragma unroll
            for (int e = 0; e < 4; ++e) v[i][e] = (v[i][e] - mean) * rstd * gg[e] + bb[e];
            *(f32x4*)(dst + c) = v[i]; }
        if (l == 0) {
            ln_stats(v, mean, rstd);
            bf16_t* H = (bf16_t*)(a->ws + WS_H);
#pragma unroll
            for (int i = 0; i < 4; ++i) { const int c = 256 * i + 4 * lane; const f32x4 sh = nsh[i], sc = nsc[i];
                f32x4 o;
#pragma unroll
                for (int e = 0; e < 4; ++e) o[e] = (v[i][e] - mean) * rstd * (1.0f + sc[e]) + sh[e];
                u32x2 pk; pk.x = pack2(o[0], o[1]); pk.y = pack2(o[2], o[3]); *(u32x2*)(H + (size_t)t * D + c) = pk; }
        }
    }
}

constexpr int N_PHASES = 18;
template <int P> __device__ __forceinline__ void run_phase(AP a, unsigned char* smem, LAS unsigned char* lds, int l) {
    asm volatile("" : "+s"(a));
    if (P == 0) p0_prologue(a, smem);
    if (P == 1) p_lnmod0(a);
    if (P == 2) p1_inproj(a, smem, lds, l);
    if (P == 3) p2_mix(a, smem, lds, l);
    if (P == 4) p3_outproj(a, smem, lds, l);
    if (P == 5) p4_ln1_router(a, smem, l);
    if (P == 6) p5_dispatch(a, smem, l);
    if (P == 7) p6_gateup(a, smem, lds, l);
    if (P == 8) p7_down(a, smem, lds, l);
    if (P == 9) p8_ln2(a, smem, l);
}
#if N_LAUNCH_MODE == 1
__global__ void __launch_bounds__(NT, 2) fwd(Args a) {
    extern __shared__ __attribute__((aligned(16))) unsigned char smem[];
    LAS unsigned char* lds = (LAS unsigned char*)smem;
    if (threadIdx.x < 4) ((volatile LAS unsigned*)(lds + MISC_OFF + 768))[threadIdx.x] = 0u;
    __syncthreads();
    XcdBarrier bar = xcd_barrier_post((unsigned*)(a.ws + WS_BAR), (volatile LAS unsigned*)(lds + MISC_OFF + 768));
    AP ap = (AP)__builtin_amdgcn_kernarg_segment_ptr();
#define PROBE(P, l) do { if (PROBE_MASK & (1 << (P))) { for (int _r = 0; _r < 2; ++_r) { xcd_barrier(bar); run_phase<P>(ap, smem, lds, l); } } } while (0)
    run_phase<0>(ap, smem, lds, 0); PROBE(0, 0); xcd_barrier(bar);
    run_phase<1>(ap, smem, lds, 0); PROBE(1, 0); xcd_barrier(bar);
    for (int l = 0; l < 2; ++l) {
        run_phase<2>(ap, smem, lds, l); PROBE(2, l); xcd_barrier(bar);
        run_phase<3>(ap, smem, lds, l); PROBE(3, l); xcd_barrier(bar);
        run_phase<4>(ap, smem, lds, l); PROBE(4, l); xcd_barrier(bar);
        run_phase<5>(ap, smem, lds, l); PROBE(5, l); xcd_barrier(bar);
        run_phase<6>(ap, smem, lds, l); PROBE(6, l); xcd_barrier(bar);
        run_phase<7>(ap, smem, lds, l); PROBE(7, l); xcd_barrier(bar);
        run_phase<8>(ap, smem, lds, l); PROBE(8, l); xcd_barrier(bar);
        run_phase<9>(ap, smem, lds, l); PROBE(9, l); if (l == 0) xcd_barrier(bar);
    }
}
#else
template <int P> __global__ void __launch_bounds__(NT, 2) k_phase(Args a) {
    extern __shared__ __attribute__((aligned(16))) unsigned char smem[];
    LAS unsigned char* lds = (LAS unsigned char*)smem;
    AP ap = (AP)__builtin_amdgcn_kernarg_segment_ptr();
    run_phase<P>(ap, smem, lds, ap->ph_lo);
}
template <int P> static void launch_phase(Args a, int l, int grid, hipStream_t stream) {
    static bool attr = false;
    if (!attr) { (void)hipFuncSetAttribute((const void*)k_phase<P>, hipFuncAttributeMaxDynamicSharedMemorySize, LDS_BYTES); attr = true; }
    a.ph_lo = l; a.ph_hi = P;
    hipLaunchKernelGGL(k_phase<P>, dim3(grid), dim3(NT), LDS_BYTES, stream, a);
}
#endif

extern "C" void kernel_launch(void* const* d_in, const int* in_sizes, int n_in, void* d_out, int out_size, void* d_ws, size_t ws_size, hipStream_t stream) {
    static int grid = 0;
    if (grid == 0) {
        if (n_in != 23 || out_size != NLAT * D || ws_size < WS_END) { fprintf(stderr, "kernel_launch: unexpected shapes (n_in %d, out %d, ws %zu, need %zu)\n", n_in, out_size, ws_size, (size_t)WS_END); grid = -1; return; }
        int dev = 0, cus = 0;
        if (hipGetDevice(&dev) != hipSuccess || hipDeviceGetAttribute(&cus, hipDeviceAttributeMultiprocessorCount, dev) != hipSuccess) { grid = -1; return; }
#if N_LAUNCH_MODE == 1
        int per_cu = 0;
        if (hipFuncSetAttribute((const void*)fwd, hipFuncAttributeMaxDynamicSharedMemorySize, LDS_BYTES) != hipSuccess) { fprintf(stderr, "kernel_launch: hipFuncSetAttribute failed\n"); grid = -1; return; }
        if (hipOccupancyMaxActiveBlocksPerMultiprocessor(&per_cu, (const void*)fwd, NT, LDS_BYTES) != hipSuccess || per_cu < 1) { fprintf(stderr, "kernel_launch: occupancy query says %d\n", per_cu); }
        (void)hipGetLastError();
#endif
        grid = cus; if (grid > MAXG) grid = MAXG;
    }
    if (grid < 0) return;
    (void)hipMemsetAsync((char*)d_ws + WS_BAR, 0, 16384 + 256, stream);
    Args a{};
    for (int i = 0; i < 23; ++i) a.in[i] = (const float*)d_in[i];
    a.out = (float*)d_out; a.ws = (unsigned char*)d_ws;
#if N_LAUNCH_MODE == 1
    a.ph_lo = 0; a.ph_hi = N_PHASES;
    hipLaunchKernelGGL(fwd, dim3(grid), dim3(NT), LDS_BYTES, stream, a);
#else
    launch_phase<0>(a, 0, grid, stream);
    launch_phase<1>(a, 0, grid, stream);
    for (int l = 0; l < 2; ++l) {
        launch_phase<2>(a, l, grid, stream); launch_phase<3>(a, l, grid, stream); launch_phase<4>(a, l, grid, stream); launch_phase<5>(a, l, grid, stream);
        launch_phase<6>(a, l, grid, stream); launch_phase<7>(a, l, grid, stream); launch_phase<8>(a, l, grid, stream); launch_phase<9>(a, l, grid, stream);
    }
#endif
}
```

```cpp
#include <hip/hip_runtime.h>
#include <stdint.h>
#include <stdio.h>

#ifndef PROBE_MASK
#define PROBE_MASK 0
#endif
#ifndef PROBE_FFT_REP
#define PROBE_FFT_REP 1
#endif
#ifndef PROBE_MIX_REP
#define PROBE_MIX_REP 1
#endif
#ifndef PROBE_SGU_REP
#define PROBE_SGU_REP 1
#endif
#ifndef N_LAUNCH_MODE
#define N_LAUNCH_MODE 1
#endif

#define LAS __attribute__((address_space(3)))
typedef unsigned short bf16_t;
typedef short bf16x8 __attribute__((ext_vector_type(8)));
typedef float f32x4 __attribute__((ext_vector_type(4)));
typedef unsigned u32x4 __attribute__((ext_vector_type(4)));
typedef unsigned u32x2 __attribute__((ext_vector_type(2)));
typedef float f32x2 __attribute__((ext_vector_type(2)));
typedef int i32x4 __attribute__((ext_vector_type(4)));

constexpr int D = 1024, NBATCH = 4, SEQ = 4096, CTXL = 256;
constexpr int NLAT = NBATCH * SEQ, NCTX = NBATCH * CTXL, NTOK = NLAT + NCTX;
constexpr int ZC = 1792;
constexpr int NEXP = 32, DEXP = 512;
constexpr int NSLOT = 2 * NTOK + NEXP * 256;
constexpr int NT = 512;
constexpr int MAXG = 512;
constexpr float RES_ALPHA = 1.41421356237309515f;
constexpr int MISC_OFF = 155648;
constexpr int RIDX_OFF = 131072;
constexpr int LDS_BYTES = MISC_OFF + 1024;

constexpr size_t WS_BAR   = 0;
constexpr size_t WS_CNT   = 16384;
constexpr size_t WS_BCNT  = WS_CNT + 256;
constexpr size_t WS_MOD   = WS_BCNT + (size_t)2 * MAXG * 32 * 4;
constexpr size_t WS_ROPE  = WS_MOD + (size_t)2 * 5 * 6144 * 4;
constexpr size_t WS_TOKE  = WS_ROPE + 8192;
constexpr size_t WS_TOKR  = WS_TOKE + (size_t)NTOK * 8;
constexpr size_t WS_TOKS  = WS_TOKR + (size_t)NTOK * 8;
constexpr size_t WS_TOKG  = WS_TOKS + (size_t)NTOK * 8;
constexpr size_t WS_SLOTT = WS_TOKG + (size_t)NTOK * 8;
constexpr size_t WS_WIN   = WS_SLOTT + (size_t)NSLOT * 4;
constexpr size_t WS_WOUT  = WS_WIN + (size_t)2 * ZC * 1024 * 2;
constexpr size_t WS_WSGU  = WS_WOUT + (size_t)2 * 1024 * 1024 * 2;
constexpr size_t WS_DFTC  = WS_WSGU + (size_t)2 * 4 * 128 * 128 * 2;
constexpr size_t WS_WEXP  = WS_DFTC + (size_t)256 * 512 * 2;
constexpr size_t EXPMAT   = (size_t)NEXP * 512 * 1024;
constexpr size_t WEXP_LAYER = 3 * EXPMAT;
constexpr size_t WS_X1    = WS_WEXP + 2 * WEXP_LAYER;
constexpr size_t WS_XC    = WS_X1 + (size_t)NTOK * D * 4;
constexpr size_t WS_H     = WS_XC + (size_t)NTOK * D * 4;
constexpr size_t WS_R     = WS_H + (size_t)NTOK * D * 2;
constexpr size_t WS_Z     = WS_R;
constexpr size_t WS_AT    = WS_Z + (size_t)NTOK * ZC * 2;
constexpr size_t WS_ATC   = WS_AT + (size_t)4 * 256 * 8192 * 2;
constexpr size_t WS_VT    = WS_ATC + (size_t)4 * 256 * 512 * 2;
constexpr size_t WS_VTC   = WS_VT + (size_t)4 * 2 * 64 * 4096 * 2;
constexpr size_t WS_CAT   = WS_VTC + (size_t)4 * 2 * 64 * 256 * 2;
constexpr size_t WS_REND  = WS_CAT + (size_t)NTOK * D * 2;
constexpr size_t WS_Y     = WS_R;
constexpr size_t WS_HID   = WS_R;
constexpr size_t WS_YS    = WS_HID + (size_t)NSLOT * DEXP * 2;
constexpr size_t WS_REND2 = (WS_YS + (size_t)NSLOT * D * 2 > WS_REND) ? WS_YS + (size_t)NSLOT * D * 2 : WS_REND;
constexpr size_t WS_H8    = (WS_REND2 + 255) & ~(size_t)255;
constexpr size_t WS_END   = WS_H8 + (size_t)NTOK * D;
static_assert(WS_Y + (size_t)NTOK * D * 4 <= WS_CAT, "Y must not reach CAT");
static_assert(WS_WIN % 256 == 0 && WS_DFTC % 256 == 0 && WS_WEXP % 256 == 0 && WS_X1 % 256 == 0 && WS_H % 256 == 0 && WS_R % 256 == 0 && WS_AT % 256 == 0 && WS_CAT % 256 == 0 && WS_YS % 256 == 0, "alignment");

struct Args { const float* in[23]; float* out; unsigned char* ws; int ph_lo, ph_hi; };
#define CAS __attribute__((address_space(4)))
typedef const CAS Args* AP;

#define XB_TMO      128
#define XB_XCNT(j)  (256  + 64 * (j))
#define XB_XSUB(j)  (1280 + 64 * (j))
#define XB_XGEN(j)  (2304 + 64 * (j))
#define XB_TOP      3328
#define XB_TOPGEN   3392
#define XCD_BAR_WORDS 3456
#define XB_SPIN_CAP (1u << 18)

__device__ __forceinline__ unsigned xb_ld(unsigned* p)              { return __hip_atomic_load(p, __ATOMIC_RELAXED, __HIP_MEMORY_SCOPE_AGENT); }
__device__ __forceinline__ unsigned xb_add(unsigned* p, unsigned v) { return __hip_atomic_fetch_add(p, v, __ATOMIC_RELAXED, __HIP_MEMORY_SCOPE_AGENT); }
__device__ __forceinline__ unsigned xb_xcc_id() { return (unsigned)__builtin_amdgcn_s_getreg((3 << 11) | 20) & 0xFu; }
#define XB_SPIN(cond, bar) do { unsigned _sp = 0; while (cond) { __builtin_amdgcn_s_sleep(1); \
    if ((++_sp & 255u) == 0u) { if (xb_ld(&(bar)[XB_TMO])) break; if (_sp > XB_SPIN_CAP) { atomicAdd(&(bar)[XB_TMO], 1u); break; } } } } while (0)

struct XcdBarrier { unsigned* bar; unsigned x; volatile LAS unsigned* st; };

__device__ __forceinline__ XcdBarrier xcd_barrier_post(unsigned* bar, volatile LAS unsigned* st) {
    XcdBarrier b; b.bar = bar; b.x = (unsigned)__builtin_amdgcn_readfirstlane((int)xb_xcc_id()); b.st = st;
    if (threadIdx.x == 0) (void)xb_add(&bar[XB_XCNT(b.x)], 1u);
    return b;
}
__device__ __forceinline__ void xcd_barrier_complete(unsigned* bar, unsigned x, unsigned& nloc, unsigned& nx) {
    const unsigned G = gridDim.x * gridDim.y * gridDim.z;
    unsigned sum, cnt, mine, sp = 0u;
    for (;;) {
        sum = 0u; cnt = 0u; mine = 0u;
#pragma unroll
        for (unsigned j = 0; j < 16; ++j) { const unsigned c = xb_ld(&bar[XB_XCNT(j)]); sum += c; cnt += (c > 0u) ? 1u : 0u; mine = (j == x) ? c : mine; }
        if (sum == G) break;
        __builtin_amdgcn_s_sleep(1);
        if ((++sp & 255u) == 0u) { if (xb_ld(&bar[XB_TMO])) break; if (sp > XB_SPIN_CAP) { atomicAdd(&bar[XB_TMO], 1u); break; } }
    }
    nloc = mine > 0u ? mine : 1u; nx = cnt > 0u ? cnt : 1u;
}
__device__ __forceinline__ void xcd_barrier(const XcdBarrier& b) {
    asm volatile("s_waitcnt vmcnt(0)" ::: "memory");
    __syncthreads();
    if (threadIdx.x == 0) {
        unsigned* bar = b.bar;
        unsigned bx = b.x;
        asm volatile("" : "+s"(bar), "+s"(bx));
        __builtin_amdgcn_s_waitcnt(0);
        unsigned nloc = b.st[0], nx = b.st[1];
        if (nloc == 0u) { xcd_barrier_complete(bar, bx, nloc, nx); b.st[0] = nloc; b.st[1] = nx; }
        const unsigned old = xb_add(&bar[XB_XSUB(bx)], 1u);
        const unsigned gen = old / nloc;
        if (old + 1u == (gen + 1u) * nloc) {
            __builtin_amdgcn_fence(__ATOMIC_RELEASE, "agent");
            asm volatile("s_waitcnt vmcnt(0)" ::: "memory");
            const unsigned og = xb_add(&bar[XB_TOP], 1u);
            const unsigned tg = og / nx;
            if (og + 1u == (tg + 1u) * nx) xb_add(&bar[XB_TOPGEN], 1u);
            else XB_SPIN(xb_ld(&bar[XB_TOPGEN]) == tg, bar);
            __builtin_amdgcn_fence(__ATOMIC_ACQUIRE, "agent");
            xb_add(&bar[XB_XGEN(bx)], 1u);
            asm volatile("s_waitcnt vmcnt(0)" ::: "memory");
        } else {
            XB_SPIN(xb_ld(&bar[XB_XGEN(bx)]) == gen, bar);
            __builtin_amdgcn_fence(__ATOMIC_ACQUIRE, "agent");
            asm volatile("s_waitcnt vmcnt(0)" ::: "memory");
        }
    }
    __syncthreads();
}

__device__ __forceinline__ int tid_opaque() { int t = threadIdx.x; asm volatile("" : "+v"(t)); return t; }
__device__ __forceinline__ float bf2f(bf16_t v) { return __uint_as_float(((unsigned)v) << 16); }
__device__ __forceinline__ bf16_t f2bf(float f) { return __builtin_bit_cast(unsigned short, (__bf16)f); }
typedef __bf16 hwbf16x2 __attribute__((ext_vector_type(2)));
__device__ __forceinline__ unsigned pack2(float a, float b) { return __builtin_bit_cast(unsigned, __builtin_convertvector((f32x2){a, b}, hwbf16x2)); }
__device__ __forceinline__ unsigned pack4_fp8(float a, float b, float c, float d) {
    a = __builtin_amdgcn_fmed3f(a, -448.f, 448.f); b = __builtin_amdgcn_fmed3f(b, -448.f, 448.f); c = __builtin_amdgcn_fmed3f(c, -448.f, 448.f); d = __builtin_amdgcn_fmed3f(d, -448.f, 448.f);
    int p = __builtin_amdgcn_cvt_pk_fp8_f32(a, b, 0, false); p = __builtin_amdgcn_cvt_pk_fp8_f32(c, d, p, true); return (unsigned)p; }
__device__ __forceinline__ float lo2f(unsigned w) { return __uint_as_float(w << 16); }
__device__ __forceinline__ float hi2f(unsigned w) { return __uint_as_float(w & 0xffff0000u); }
template <int CTRL> __device__ __forceinline__ float dpp_mov(float v) { return __builtin_bit_cast(float, __builtin_amdgcn_update_dpp(0, __builtin_bit_cast(int, v), CTRL, 0xf, 0xf, true)); }
__device__ __forceinline__ float row_sum16(float v) {
    v += dpp_mov<0xB1>(v);
    v += dpp_mov<0x4E>(v);
    v += dpp_mov<0x141>(v);
    v += dpp_mov<0x140>(v);
    return v;
}
__device__ __forceinline__ float row_max16(float v) {
    v = fmaxf(v, dpp_mov<0xB1>(v)); v = fmaxf(v, dpp_mov<0x4E>(v)); v = fmaxf(v, dpp_mov<0x141>(v)); v = fmaxf(v, dpp_mov<0x140>(v));
    return v;
}
__device__ __forceinline__ float wave_sum(float v) {
    v = row_sum16(v);
    const int iv = __builtin_bit_cast(int, v);
    const float a0 = __builtin_bit_cast(float, __builtin_amdgcn_readlane(iv, 0)), a1 = __builtin_bit_cast(float, __builtin_amdgcn_readlane(iv, 16));
    const float a2 = __builtin_bit_cast(float, __builtin_amdgcn_readlane(iv, 32)), a3 = __builtin_bit_cast(float, __builtin_amdgcn_readlane(iv, 48));
    return (a0 + a1) + (a2 + a3);
}
__device__ __forceinline__ float gelu_erf(float v) {
    const float t = __builtin_amdgcn_rcpf(fabsf(v) * 0.2316418882f + 1.0f);
    float q = t * 0.5307027145f + (-0.7265760135f); q = q * t + 0.7107068705f; q = q * t + (-0.142248368f); q = q * t + 0.127414796f; q = q * t;
    const float m = v * (q * __builtin_amdgcn_exp2f((v * v) * (-0.72134752044f)));
    return v < 0.f ? m : v - m;
}
__device__ __forceinline__ float silu_f(float x) { return x * __builtin_amdgcn_rcpf(1.0f + __expf(-x)); }

__device__ __forceinline__ void ln_stats(const f32x4 (&v)[4], float& mean, float& rstd) {
    float s = 0.f;
#pragma unroll
    for (int i = 0; i < 4; ++i) s += (v[i][0] + v[i][1]) + (v[i][2] + v[i][3]);
    s = wave_sum(s); mean = s * (1.0f / 1024.0f);
    float q = 0.f;
#pragma unroll
    for (int i = 0; i < 4; ++i)
#pragma unroll
        for (int e = 0; e < 4; ++e) { const float d = v[i][e] - mean; q += d * d; }
    q = wave_sum(q); rstd = 1.0f / sqrtf(q * (1.0f / 1024.0f) + 1e-6f);
}

template <int BN> struct MfmaLayout {
    static constexpr int FG = BN / 128, NI = 4, NJ = 2 * FG;
    static constexpr bool PAIR8 = false;
    int rbase, cbase;
    __device__ __forceinline__ int row(int i) const { return rbase + 16 * i; }
    __device__ __forceinline__ int col(int jj) const { return (jj / FG) * (BN / 2) + (jj % FG) * 16 + cbase; }
};

__device__ __forceinline__ void glds16(const bf16_t* g, LAS unsigned char* l) {
    __builtin_amdgcn_global_load_lds((const unsigned*)g, (LAS unsigned*)l, 16, 0, 0);
}

template <int BN, bool GATHER, class Epi>
__device__ __forceinline__ void gemm_tile(LAS unsigned char* lds, const bf16_t* A, int lda, const int* rowidx, int valid_rows,
                                          const bf16_t* B0, const bf16_t* B1, int ldb, int K, const Epi& epi) {
    constexpr int A_B = 16384, B_B = BN * 128, STAGE = A_B + B_B, NBL = BN / 64;
    const int tid = tid_opaque(), lane = tid & 63, wid = __builtin_amdgcn_readfirstlane(tid >> 6);
    const bf16_t* ap[2]; const bf16_t* bp[NBL];
#pragma unroll
    for (int i = 0; i < 2; ++i) {
        const int P = i * 512 + tid, row = P >> 3, c = (P & 7) ^ ((row >> 1) & 7);
        size_t ro;
        if (GATHER) ro = (size_t)(row < valid_rows ? rowidx[row] : 0) * (size_t)lda; else ro = (size_t)row * (size_t)lda;
        ap[i] = A + ro + c * 8;
    }
#pragma unroll
    for (int i = 0; i < NBL; ++i) {
        const int P = i * 512 + tid, row = P >> 3, c = (P & 7) ^ ((row >> 1) & 7);
        const bf16_t* base = (row < BN / 2) ? (B0 + (size_t)row * ldb) : (B1 + (size_t)(row - BN / 2) * ldb);
        bp[i] = base + c * 8;
    }
    const int nk = K / 64;
#define GT_STAGE(buf, k0) do { \
        _Pragma("unroll") for (int _i = 0; _i < 2; ++_i) glds16(ap[_i] + (k0), lds + (buf) * STAGE + _i * 8192 + wid * 1024); \
        _Pragma("unroll") for (int _i = 0; _i < NBL; ++_i) glds16(bp[_i] + (k0), lds + (buf) * STAGE + A_B + _i * 8192 + wid * 1024); } while (0)

    typedef MfmaLayout<BN> Lay;
    constexpr int FG = Lay::FG;
    const int fr = lane & 15, g = lane >> 4, wr = wid >> 2, wc = wid & 3;
    Lay lay; lay.rbase = wr * 64 + fr; lay.cbase = wc * 16 * FG + 4 * g;
    f32x4 acc[Lay::NI][Lay::NJ];
#pragma unroll
    for (int i = 0; i < Lay::NI; ++i)
#pragma unroll
        for (int j = 0; j < Lay::NJ; ++j) acc[i][j] = (f32x4){0.f, 0.f, 0.f, 0.f};
    int aoff[4], boff[Lay::NJ];
#pragma unroll
    for (int m = 0; m < 4; ++m) { const int row = wr * 64 + m * 16 + fr; aoff[m] = row * 128 + ((g ^ ((row >> 1) & 7)) << 4); }
#pragma unroll
    for (int jj = 0; jj < Lay::NJ; ++jj) { const int row = (jj / FG) * (BN / 2) + wc * 16 * FG + (jj % FG) * 16 + fr; boff[jj] = A_B + row * 128 + ((g ^ ((row >> 1) & 7)) << 4); }
    GT_STAGE(0, 0);
    asm volatile("s_waitcnt vmcnt(0)" ::: "memory"); __syncthreads();
    for (int kt = 0; kt < nk; ++kt) {
        if (kt + 1 < nk) GT_STAGE((kt + 1) & 1, (kt + 1) * 64);
        const LAS unsigned char* sa = lds + (kt & 1) * STAGE;
#pragma unroll
        for (int ks = 0; ks < 2; ++ks) {
            bf16x8 af[4], bfv[Lay::NJ];
#pragma unroll
            for (int m = 0; m < 4; ++m) af[m] = *(const LAS bf16x8*)(sa + (aoff[m] ^ (ks << 6)));
#pragma unroll
            for (int jj = 0; jj < Lay::NJ; ++jj) bfv[jj] = *(const LAS bf16x8*)(sa + (boff[jj] ^ (ks << 6)));
#pragma unroll
            for (int m = 0; m < 4; ++m)
#pragma unroll
                for (int jj = 0; jj < Lay::NJ; ++jj) acc[m][jj] = __builtin_amdgcn_mfma_f32_16x16x32_bf16(bfv[jj], af[m], acc[m][jj], 0, 0, 0);
        }
        asm volatile("s_waitcnt vmcnt(0)" ::: "memory"); __syncthreads();
    }
    epi.run(acc, lay);
#undef GT_STAGE
}

namespace g256 {
constexpr int BK = 64, HALF = 128, HTB = HALF * BK * 2, STAGE_BYTES = 8 * HTB;
__device__ __forceinline__ int lds_byte(int r, int c) { const int st = (r >> 4) * 2 + (c >> 5), rr = r & 15, cc = c & 31, ob = rr * 64 + cc * 2; return st * 1024 + (ob ^ (((ob >> 9) & 1) << 5)); }
__device__ __forceinline__ int perm32(int rho) { const int n = rho >> 4, i = rho & 15; return 8 * (i >> 2) + 4 * n + (i & 3); }
__device__ __forceinline__ void stage_rc(int b, int& R, int& C) { const int st = b / 1024, sb = b % 1024, swz = sb ^ (((sb >> 9) & 1) << 5); R = (st >> 1) * 16 + swz / 64; C = (st & 1) * 32 + (swz % 64) / 2; }
struct Lay {
    static constexpr int NI = 8, NJ = 4;
    static constexpr bool PAIR8 = true;
    int rbase, cbase;
    __device__ __forceinline__ int row(int i) const { return (i >> 2) * 128 + (i & 3) * 16 + rbase; }
    __device__ __forceinline__ int col(int j) const { return (j >> 1) * 128 + (j & 1) * 4 + cbase; }
};
template <class Epi> struct Unit { const bf16_t* A; const bf16_t* B0; const bf16_t* B1; const LAS int* ridx; int valid; Epi epi; };

template <class Sched>
__device__ __forceinline__ void gemm_phase(LAS unsigned char* lds, const int K, const Sched& S) {
    typedef typename Sched::Epi Epi;
    const int tid = tid_opaque(), wid = __builtin_amdgcn_readfirstlane(tid >> 6), lane = tid & 63, wr = wid >> 2, wc = wid & 3, fr = lane & 15, fq = lane >> 4;
    int nt = K / BK; asm volatile("" : "+s"(nt));
    int sR[2], sC[2];
#pragma unroll
    for (int i = 0; i < 2; ++i) stage_rc(tid * 16 + i * 8192, sR[i], sC[i]);
    unsigned voffB[2];
#pragma unroll
    for (int i = 0; i < 2; ++i) voffB[i] = (unsigned)(((sR[i] & ~31) + perm32(sR[i] & 31)) * K + sC[i]) * 2u;
    const size_t kstep = (size_t)(BK * 2);
    const unsigned ldsw = (unsigned)wid * 1024u;
    const int aoff = lds_byte(wr * 64 + fr, fq * 8), boff = lds_byte(wc * 32 + fr, fq * 8);
#define G2_SA(b, h) (((b) * 2 + (h)) * HTB)
#define G2_SB(b, h) ((4 + (b) * 2 + (h)) * HTB)
#define G2_STAGE(bufoff, gbase, v0, v1) do { \
        __builtin_amdgcn_global_load_lds((const unsigned*)((const char*)(gbase) + (v0)), (LAS unsigned*)(lds + (bufoff) + ldsw), 16, 0, 0); \
        __builtin_amdgcn_global_load_lds((const unsigned*)((const char*)(gbase) + (v1)), (LAS unsigned*)(lds + (bufoff) + ldsw + 8192), 16, 0, 0); } while (0)
#define G2_LDA(dst, b, h) do { _Pragma("unroll") for (int m = 0; m < 4; ++m) _Pragma("unroll") for (int k = 0; k < 2; ++k) dst[m][k] = *(const LAS bf16x8*)(lds + G2_SA(b, h) + aoff + m * 2048 + k * 1024); } while (0)
#define G2_LDB(dst, b, h) do { _Pragma("unroll") for (int n = 0; n < 2; ++n) _Pragma("unroll") for (int k = 0; k < 2; ++k) dst[n][k] = *(const LAS bf16x8*)(lds + G2_SB(b, h) + boff + n * 2048 + k * 1024); } while (0)
#define G2_MMA(ai, bj, At, Bt) do { __builtin_amdgcn_s_setprio(1); _Pragma("unroll") for (int m = 0; m < 4; ++m) _Pragma("unroll") for (int n = 0; n < 2; ++n) _Pragma("unroll") for (int k = 0; k < 2; ++k) { \
        if (Sched::FP8) { const i32x4 _b = __builtin_bit_cast(i32x4, Bt[n][k]), _a = __builtin_bit_cast(i32x4, At[m][k]);     \
            acc[(ai) * 4 + m][(bj) * 2 + n] = __builtin_amdgcn_mfma_f32_16x16x32_fp8_fp8(((long)(unsigned)_b[1] << 32) | (unsigned)_b[0], ((long)(unsigned)_a[1] << 32) | (unsigned)_a[0], acc[(ai) * 4 + m][(bj) * 2 + n], 0, 0, 0); \
            acc[(ai) * 4 + m][(bj) * 2 + n] = __builtin_amdgcn_mfma_f32_16x16x32_fp8_fp8(((long)(unsigned)_b[3] << 32) | (unsigned)_b[2], ((long)(unsigned)_a[3] << 32) | (unsigned)_a[2], acc[(ai) * 4 + m][(bj) * 2 + n], 0, 0, 0); } \
        else acc[(ai) * 4 + m][(bj) * 2 + n] = __builtin_amdgcn_mfma_f32_16x16x32_bf16(Bt[n][k], At[m][k], acc[(ai) * 4 + m][(bj) * 2 + n], 0, 0, 0); } __builtin_amdgcn_s_setprio(0); } while (0)
#define G2_WAIT_V(n) asm volatile("s_waitcnt vmcnt(" #n ")" ::: "memory")
#define G2_WAIT_L(n) asm volatile("s_waitcnt lgkmcnt(" #n ")" ::: "memory")
#define G2_BAR __builtin_amdgcn_s_barrier()
#define G2_SCHED __builtin_amdgcn_sched_barrier(0)
#define G2_VOFFA(U, dst) do { _Pragma("unroll") for (int _h = 0; _h < 2; ++_h) _Pragma("unroll") for (int _i = 0; _i < 2; ++_i) { const int _row = _h * 128 + sR[_i]; \
        int _tok = _row; if (Sched::GATHER) _tok = (_row < (U).valid) ? (U).ridx[_row] : 0; dst[_h][_i] = (unsigned)(_tok * K + sC[_i]) * 2u; } } while (0)
    Unit<Epi> cur, nxt; int ui = 0;
    if (!S.get(0, cur)) return;
    f32x4 acc[8][4];
#pragma unroll
    for (int i = 0; i < 8; ++i)
#pragma unroll
        for (int j = 0; j < 4; ++j) acc[i][j] = (f32x4){0.f, 0.f, 0.f, 0.f};
    bf16x8 At[4][2], B0[2][2], B1[2][2];
    unsigned cvA[2][2], nvA[2][2];
    G2_VOFFA(cur, cvA);
    const char* cA = (const char*)cur.A; const char* cB0 = (const char*)cur.B0; const char* cB1 = (const char*)cur.B1;
    G2_STAGE(G2_SB(0, 0), cB0, voffB[0], voffB[1]); G2_STAGE(G2_SB(0, 1), cB1, voffB[0], voffB[1]); G2_STAGE(G2_SA(0, 0), cA, cvA[0][0], cvA[0][1]); G2_STAGE(G2_SA(0, 1), cA, cvA[1][0], cvA[1][1]);
    if (wr == 1) G2_BAR;
    G2_WAIT_V(2); G2_BAR;
    G2_STAGE(G2_SB(1, 0), cB0 + kstep, voffB[0], voffB[1]); G2_STAGE(G2_SA(1, 0), cA + kstep, cvA[0][0], cvA[0][1]); G2_STAGE(G2_SB(1, 1), cB1 + kstep, voffB[0], voffB[1]);
    G2_WAIT_V(6); G2_BAR;
    for (;;) {
        const bool has_next = S.get(ui + 1, nxt);
        if (Sched::GATHER) {
            if (has_next) { G2_VOFFA(nxt, nvA); }
            else {
#pragma unroll
                for (int h = 0; h < 2; ++h) { nvA[h][0] = cvA[h][0]; nvA[h][1] = cvA[h][1]; } }
        }
        const char* nA = has_next ? (const char*)nxt.A : cA; const char* nB0 = has_next ? (const char*)nxt.B0 : cB0; const char* nB1 = has_next ? (const char*)nxt.B1 : cB1;
#pragma unroll 1
        for (int t = 0; t < nt; t += 2) {
            const bool last = (t == nt - 2);
            const char* a1 = cA + (size_t)(t + 1) * kstep;
            const char* a2 = last ? nA : cA + (size_t)(t + 2) * kstep;
            const char* b20 = last ? nB0 : cB0 + (size_t)(t + 2) * kstep; const char* b21 = last ? nB1 : cB1 + (size_t)(t + 2) * kstep;
#define x00 ((Sched::GATHER && last) ? nvA[0][0] : cvA[0][0])
#define x01 ((Sched::GATHER && last) ? nvA[0][1] : cvA[0][1])
#define x10 ((Sched::GATHER && last) ? nvA[1][0] : cvA[1][0])
#define x11 ((Sched::GATHER && last) ? nvA[1][1] : cvA[1][1])
            G2_LDB(B0, 0, 0); G2_LDB(B1, 0, 1); G2_SCHED; G2_LDA(At, 0, 0); G2_STAGE(G2_SA(1, 1), a1, cvA[1][0], cvA[1][1]);
            G2_WAIT_V(8); G2_WAIT_L(0); G2_BAR; G2_MMA(0, 0, At, B0); G2_MMA(0, 1, At, B1); G2_BAR; G2_SCHED;
            G2_LDA(At, 0, 1); G2_STAGE(G2_SB(0, 0), b20, voffB[0], voffB[1]); G2_STAGE(G2_SB(0, 1), b21, voffB[0], voffB[1]); G2_STAGE(G2_SA(0, 0), a2, x00, x01);
            G2_WAIT_V(8); G2_WAIT_L(0); G2_BAR; G2_MMA(1, 0, At, B0); G2_MMA(1, 1, At, B1); G2_BAR; G2_SCHED;
            G2_LDB(B0, 1, 0); G2_LDB(B1, 1, 1); G2_SCHED; G2_LDA(At, 1, 0); G2_STAGE(G2_SA(0, 1), a2, x10, x11);
            G2_WAIT_V(8); G2_WAIT_L(0); G2_BAR; G2_MMA(0, 0, At, B0); G2_MMA(0, 1, At, B1); G2_BAR; G2_SCHED;
            G2_LDA(At, 1, 1); G2_STAGE(G2_SB(1, 0), b20 + kstep, voffB[0], voffB[1]); G2_STAGE(G2_SB(1, 1), b21 + kstep, voffB[0], voffB[1]); G2_STAGE(G2_SA(1, 0), a2 + kstep, x00, x01);
            G2_WAIT_V(8); G2_WAIT_L(0); G2_BAR; G2_MMA(1, 0, At, B0); G2_MMA(1, 1, At, B1); G2_BAR; G2_SCHED;
        }
        if (wr == 0) G2_BAR;
        { Lay lay; int rbv = wr * 64 + fr, cbv = wc * 32 + 8 * fq; asm volatile("" : "+v"(rbv), "+v"(cbv));
          lay.rbase = rbv; lay.cbase = cbv; cur.epi.run(acc, lay); }
        if (!has_next) break;
#pragma unroll
        for (int i = 0; i < 8; ++i)
#pragma unroll
            for (int j = 0; j < 4; ++j) acc[i][j] = (f32x4){0.f, 0.f, 0.f, 0.f};
        cur = nxt; cA = nA; cB0 = nB0; cB1 = nB1; ++ui;
        if (wr == 1) G2_BAR;
        if (Sched::GATHER) {
#pragma unroll
            for (int h = 0; h < 2; ++h) { cvA[h][0] = nvA[h][0]; cvA[h][1] = nvA[h][1]; } }
    }
#undef x00
#undef x01
#undef x10
#undef x11
    G2_WAIT_V(0);
    G2_BAR;
#undef G2_SA
#undef G2_SB
#undef G2_STAGE
#undef G2_LDA
#undef G2_LDB
#undef G2_MMA
#undef G2_WAIT_V
#undef G2_WAIT_L
#undef G2_BAR
#undef G2_SCHED
#undef G2_VOFFA
}
}

struct EpiF32 {
    float* C; int ld;
    template <class L> __device__ __forceinline__ void run(const f32x4 (&acc)[L::NI][L::NJ], const L& lay) const {
#pragma unroll
        for (int i = 0; i < L::NI; ++i)
#pragma unroll
            for (int j = 0; j < L::NJ; ++j) *(f32x4*)(C + (size_t)lay.row(i) * ld + lay.col(j)) = acc[i][j];
    }
};
struct EpiBf16 {
    bf16_t* C; int ld; float scale;
    template <class L> __device__ __forceinline__ void run(const f32x4 (&acc)[L::NI][L::NJ], const L& lay) const {
#pragma unroll
        for (int i = 0; i < L::NI; ++i) {
            if (L::PAIR8) {
#pragma unroll
                for (int j = 0; j < L::NJ; j += 2) { const f32x4 p = acc[i][j] * scale, q = acc[i][j + 1] * scale; u32x4 w; w.x = pack2(p[0], p[1]); w.y = pack2(p[2], p[3]); w.z = pack2(q[0], q[1]); w.w = pack2(q[2], q[3]);
                    *(u32x4*)(C + (size_t)lay.row(i) * ld + lay.col(j)) = w; }
            } else {
#pragma unroll
                for (int j = 0; j < L::NJ; ++j) { const f32x4 p = acc[i][j] * scale; u32x2 w; w.x = pack2(p[0], p[1]); w.y = pack2(p[2], p[3]);
                    *(u32x2*)(C + (size_t)lay.row(i) * ld + lay.col(j)) = w; }
            }
        }
    }
};
struct EpiFp8 {
    unsigned char* C; int ld; float scale;
    template <class L> __device__ __forceinline__ void run(const f32x4 (&acc)[L::NI][L::NJ], const L& lay) const {
        static_assert(L::PAIR8, "written for the paired-column layout");
#pragma unroll
        for (int i = 0; i < L::NI; ++i)
#pragma unroll
            for (int j = 0; j < L::NJ; j += 2) { const f32x4 p = acc[i][j] * scale, q = acc[i][j + 1] * scale; u32x2 w; w.x = pack4_fp8(p[0], p[1], p[2], p[3]); w.y = pack4_fp8(q[0], q[1], q[2], q[3]);
                *(u32x2*)(C + (size_t)lay.row(i) * ld + lay.col(j)) = w; }
    }
};
struct EpiGateUp8 {
    unsigned char* C; int ld;
    template <class L> __device__ __forceinline__ void run(const f32x4 (&acc)[L::NI][L::NJ], const L& lay) const {
        static_assert(L::PAIR8 && L::NJ == 4, "written for the paired-column 256x256 layout");
#pragma unroll
        for (int i = 0; i < L::NI; ++i) {
            const f32x4 g0 = acc[i][0] * (1.0f / 32.0f), g1 = acc[i][1] * (1.0f / 32.0f), u0 = acc[i][2] * (1.0f / 32.0f), u1 = acc[i][3] * (1.0f / 32.0f);
            u32x2 w; w.x = pack4_fp8(silu_f(g0[0]) * u0[0], silu_f(g0[1]) * u0[1], silu_f(g0[2]) * u0[2], silu_f(g0[3]) * u0[3]);
            w.y = pack4_fp8(silu_f(g1[0]) * u1[0], silu_f(g1[1]) * u1[1], silu_f(g1[2]) * u1[2], silu_f(g1[3]) * u1[3]);
            *(u32x2*)(C + (size_t)lay.row(i) * ld + lay.col(0)) = w;
        }
    }
};
struct EpiGateUp {
    bf16_t* C; int ld;
    template <class L> __device__ __forceinline__ void run(const f32x4 (&acc)[L::NI][L::NJ], const L& lay) const {
#pragma unroll
        for (int i = 0; i < L::NI; ++i) {
            if (L::PAIR8 && L::NJ == 4) {
                const f32x4 g0 = acc[i][0], g1 = acc[i][1], u0 = acc[i][2], u1 = acc[i][3];
                u32x4 w; w.x = pack2(silu_f(g0[0]) * u0[0], silu_f(g0[1]) * u0[1]); w.y = pack2(silu_f(g0[2]) * u0[2], silu_f(g0[3]) * u0[3]);
                w.z = pack2(silu_f(g1[0]) * u1[0], silu_f(g1[1]) * u1[1]); w.w = pack2(silu_f(g1[2]) * u1[2], silu_f(g1[3]) * u1[3]);
                *(u32x4*)(C + (size_t)lay.row(i) * ld + lay.col(0)) = w;
            } else {
#pragma unroll
                for (int j = 0; j < L::NJ / 2; ++j) { const f32x4 gt = acc[i][j], up = acc[i][j + L::NJ / 2];
                    u32x2 w; w.x = pack2(silu_f(gt[0]) * up[0], silu_f(gt[1]) * up[1]); w.y = pack2(silu_f(gt[2]) * up[2], silu_f(gt[3]) * up[3]);
                    *(u32x2*)(C + (size_t)lay.row(i) * ld + lay.col(j)) = w; }
            }
        }
    }
};
struct EpiInProj {
    bf16_t* Zt;
    bf16_t* tF;
    bf16_t* tV;
    int n0, pos0, n;
    template <class L> __device__ __forceinline__ void run(const f32x4 (&acc)[L::NI][L::NJ], const L& lay) const {
        static_assert(L::PAIR8, "written for the paired-column layout");
#pragma unroll
        for (int i = 0; i < L::NI; ++i)
#pragma unroll
            for (int j = 0; j < L::NJ; j += 2) {
                const int r = lay.row(i), cl = lay.col(j), c = n0 + cl;
                const f32x4 v0 = acc[i][j], v1 = acc[i][j + 1];
                if (c < 512) {
                    const int part = c >> 8, ch = c & 255;
#pragma unroll
                    for (int e = 0; e < 4; ++e) { tF[((size_t)(ch + e) * 2 + part) * n + pos0 + r] = f2bf(v0[e]); tF[((size_t)(ch + 4 + e) * 2 + part) * n + pos0 + r] = f2bf(v1[e]); }
                } else {
                    u32x4 w; w.x = pack2(v0[0], v0[1]); w.y = pack2(v0[2], v0[3]); w.z = pack2(v1[0], v1[1]); w.w = pack2(v1[2], v1[3]);
                    *(u32x4*)(Zt + (size_t)r * ZC + cl) = w;
                    if (c >= 896 && c < 1024) {
#pragma unroll
                        for (int e = 0; e < 4; ++e) { tV[(size_t)(c - 896 + e) * n + pos0 + r] = f2bf(v0[e]); tV[(size_t)(c - 896 + 4 + e) * n + pos0 + r] = f2bf(v1[e]); }
                    }
                }
            }
    }
};

constexpr int U_ADA = 192, U_WIN = 2 * 16 * 28, U_WOUT = 2 * 16 * 16, U_SGU = 32, U_DFT = 256, U_ROPE = 1, U_EXP = 3 * 32 * 32;
constexpr int LDS_SIL = 0, LDS_RED = 20480, LDS_TILE = 32768, LDS_T64 = 49408, LDS_CTAB = 50176;

__device__ __forceinline__ void ada_unit(AP a, unsigned char* lds, int u) {
    float* sil = (float*)(lds + LDS_SIL); float* red = (float*)(lds + LDS_RED);
    const int tid = tid_opaque(), lane = tid & 63, w = tid >> 6;
    const int l = u / 96, cg = u % 96;
    for (int i = tid; i < 5120; i += NT) { const int r = i >> 10, k = i & 1023; const float v = (r < 4) ? a->in[1][r * 1024 + k] : a->in[3][k]; sil[i] = v / (1.0f + expf(-v)); }
    __syncthreads();
    const float* W = a->in[4] + (size_t)l * 1024 * 6144 + cg * 64 + lane;
    float acc[5] = {0.f, 0.f, 0.f, 0.f, 0.f};
#pragma unroll 32
    for (int k = w * 128; k < w * 128 + 128; ++k) { const float wv = W[(size_t)k * 6144];
#pragma unroll
        for (int r = 0; r < 5; ++r) acc[r] += sil[r * 1024 + k] * wv; }
#pragma unroll
    for (int r = 0; r < 5; ++r) red[(w * 5 + r) * 64 + lane] = acc[r];
    __syncthreads();
    if (tid < 320) { const int r = tid >> 6; float s = 0.f;
#pragma unroll
        for (int ww = 0; ww < 8; ++ww) s += red[(ww * 5 + r) * 64 + lane];
        const int j = cg * 64 + lane; ((float*)(a->ws + WS_MOD))[(size_t)(l * 5 + r) * 6144 + j] = s + a->in[5][l * 6144 + j]; }
    __syncthreads();
}

__device__ __forceinline__ void tile_store_T(const float* tile, bf16_t* dst, int ldd) {
    const int tid = tid_opaque(), n = tid >> 3, kc = tid & 7;
    u32x4 w;
    w.x = pack2(tile[(kc * 8 + 0) * 65 + n], tile[(kc * 8 + 1) * 65 + n]); w.y = pack2(tile[(kc * 8 + 2) * 65 + n], tile[(kc * 8 + 3) * 65 + n]);
    w.z = pack2(tile[(kc * 8 + 4) * 65 + n], tile[(kc * 8 + 5) * 65 + n]); w.w = pack2(tile[(kc * 8 + 6) * 65 + n], tile[(kc * 8 + 7) * 65 + n]);
    *(u32x4*)(dst + (size_t)n * ldd + kc * 8) = w;
}
__device__ __forceinline__ void tile_load(float* tile, const float* src, int lds_) {
    const int tid = tid_opaque();
#pragma unroll
    for (int i = 0; i < 2; ++i) { const int row = (tid >> 4) + 32 * i, c4 = (tid & 15) * 4; const f32x4 v = *(const f32x4*)(src + (size_t)row * lds_ + c4);
        tile[row * 65 + c4 + 0] = v[0]; tile[row * 65 + c4 + 1] = v[1]; tile[row * 65 + c4 + 2] = v[2]; tile[row * 65 + c4 + 3] = v[3]; }
}

__device__ __forceinline__ void mm64_f32(const float* tA, int lda, const float* tB, int ldb, int K, float* out) {
    const int tid = tid_opaque(), lane = tid & 63, w = tid >> 6, fr = lane & 15, g = lane >> 4, mi = w >> 1, nj = 2 * (w & 1);
    f32x4 acc0 = (f32x4){0.f, 0.f, 0.f, 0.f}, acc1 = (f32x4){0.f, 0.f, 0.f, 0.f};
    const float* pa = tA + (16 * mi + fr) * lda + g; const float* pb = tB + g * ldb + 16 * nj + fr;
#pragma unroll 4
    for (int k0 = 0; k0 < K; k0 += 4) { const float av = pa[k0], b0 = pb[k0 * ldb], b1 = pb[k0 * ldb + 16];
        acc0 = __builtin_amdgcn_mfma_f32_16x16x4f32(av, b0, acc0, 0, 0, 0); acc1 = __builtin_amdgcn_mfma_f32_16x16x4f32(av, b1, acc1, 0, 0, 0); }
#pragma unroll
    for (int r = 0; r < 4; ++r) { out[(16 * mi + 4 * g + r) * 65 + 16 * nj + fr] = acc0[r]; out[(16 * mi + 4 * g + r) * 65 + 16 * nj + 16 + fr] = acc1[r]; }
}

__device__ __forceinline__ void win_unit(AP a, unsigned char* lds, int u) {
    float* tile = (float*)(lds + LDS_TILE); float* T = (float*)(lds + LDS_T64);
    const int tid = tid_opaque();
    const int l = u / 448, r = u % 448, kb = r / 28, nb = r % 28;
    const float* Win = a->in[6] + (size_t)l * 1024 * 1536;
    const int srccol = (nb >= 8) ? nb * 64 - 256 : (nb & 3) * 64;
    tile_load(tile, Win + (size_t)(kb * 64) * 1536 + srccol, 1536);
    if (nb < 8 && tid < 64) { T[tid] = cospif((float)tid / 32.0f); T[64 + tid] = sinpif((float)tid / 32.0f); }
    __syncthreads();
    bf16_t* dst = (bf16_t*)(a->ws + WS_WIN) + ((size_t)l * ZC + nb * 64) * 1024 + kb * 64;
    if (nb >= 8) tile_store_T(tile, dst, 1024);
    else {
        const int part = nb >> 2;
        float* Tm = (float*)(lds + 65536); float* out = (float*)(lds + 98304);
        for (int i = tid; i < 4096; i += NT) { const int c = i >> 6, cp = i & 63; const float t = T[part * 64 + ((c * cp) & 63)]; Tm[i] = (part ? -t : t) * 0.125f; }
        __syncthreads();
        mm64_f32(tile, 65, Tm, 64, 64, out);
        __syncthreads();
        tile_store_T(out, dst, 1024);
    }
    __syncthreads();
}

__device__ __forceinline__ void wout_unit(AP a, unsigned char* lds, int u) {
    float* tile = (float*)(lds + LDS_TILE);
    __syncthreads();
    const int tid = tid_opaque();
    const int l = u / 256, r = u % 256, kb = r / 16, nb = r % 16;
    const float* Wo = a->in[13] + (size_t)l * 1024 * 1024;
    const int n = tid & 63, kq = __builtin_amdgcn_readfirstlane(tid >> 6);
    if (kb < 4) {
        float* tA = (float*)lds; float* tB = (float*)(lds + 65536);
        const float* wf = a->in[7] + (size_t)l * 256 * 256 + (size_t)(kb * 64) * 256;
        __syncthreads();
        f32x4 va[8], vb[8];
#pragma unroll
        for (int i = 0; i < 8; ++i) { const int q = tid + 512 * i; va[i] = *(const f32x4*)(wf + (size_t)q * 4); vb[i] = *(const f32x4*)(Wo + (size_t)(q >> 4) * 1024 + nb * 64 + (q & 15) * 4); }
#pragma unroll
        for (int i = 0; i < 8; ++i) { const int q = tid + 512 * i; *(f32x4*)(tA + (size_t)q * 4) = va[i]; *(f32x4*)(tB + (size_t)q * 4) = vb[i]; }
        __syncthreads();
        tile = (float*)(lds + 133120);
        mm64_f32(tA, 256, tB, 64, 256, tile);
    } else if (kb >= 8 && kb < 12) {
        const int g = kb - 8;
        float* tA = (float*)lds; float* tB = (float*)(lds + 65536);
        const float* wp = a->in[9] + (size_t)(l * 4 + g) * 64 * 64;
        const float* ps = a->in[10] + l * 256 + g * 64;
        f32x4 va[2], vb[2];
#pragma unroll
        for (int i = 0; i < 2; ++i) { const int q = tid + 512 * i; va[i] = *(const f32x4*)(wp + (size_t)q * 4); vb[i] = *(const f32x4*)(Wo + (size_t)(512 + g * 64 + (q >> 4)) * 1024 + nb * 64 + (q & 15) * 4) * ps[q >> 4]; }
#pragma unroll
        for (int i = 0; i < 2; ++i) { const int q = tid + 512 * i; *(f32x4*)(tA + (size_t)q * 4) = va[i]; *(f32x4*)(tB + (size_t)q * 4) = vb[i]; }
        __syncthreads();
        tile = (float*)(lds + 133120);
        mm64_f32(tA, 64, tB, 64, 64, tile);
    } else tile_load(tile, Wo + (size_t)(kb * 64) * 1024 + nb * 64, 1024);
    __syncthreads();
    tile_store_T(tile, (bf16_t*)(a->ws + WS_WOUT) + ((size_t)l * 1024 + nb * 64) * 1024 + kb * 64, 1024);
    __syncthreads();
}

__device__ __forceinline__ void exp_src_dst(AP a, int l, int u, const float*& src, int& srcld, unsigned char*& dst, int& dstld) {
    const int mat = u / 1024, e = (u % 1024) / 32, t = u % 32;
    const int kb = (mat < 2) ? t / 4 : t / 8, nb = (mat < 2) ? t % 4 : t % 8;
    srcld = (mat < 2) ? 512 : 1024; dstld = (mat < 2) ? 1024 : 512;
    src = a->in[18 + mat] + ((size_t)(l * 32 + e) * 512 * 1024) + (size_t)(kb * 128) * srcld + nb * 128;
    dst = a->ws + WS_WEXP + (size_t)l * WEXP_LAYER + (size_t)mat * EXPMAT + (size_t)e * 512 * 1024 + (size_t)(nb * 128) * dstld + kb * 128;
}
#define EXP_LOAD(vv, uu) do { exp_src_dst(a, l, (uu), src, srcld, dst, dstld); _Pragma("unroll") for (int _i = 0; _i < 8; ++_i) vv[_i] = *(const f32x4*)(src + (size_t)((tid >> 5) + 16 * _i) * srcld + (tid & 31) * 4); } while (0)
#define EXP_PUT(vv) do { _Pragma("unroll") for (int _i = 0; _i < 8; ++_i) { float* tp = tile + ((tid >> 5) + 16 * _i) * 129 + (tid & 31) * 4; tp[0] = vv[_i][0] * 32.0f; tp[1] = vv[_i][1] * 32.0f; tp[2] = vv[_i][2] * 32.0f; tp[3] = vv[_i][3] * 32.0f; } } while (0)
#define EXP_STORE(dd, ld_) do { const int n = tid >> 2, kq = tid & 3; _Pragma("unroll") for (int j = 0; j < 2; ++j) { const float* tp = tile + (kq * 32 + j * 16) * 129 + n; u32x4 w; \
        w.x = pack4_fp8(tp[0], tp[129], tp[2 * 129], tp[3 * 129]); w.y = pack4_fp8(tp[4 * 129], tp[5 * 129], tp[6 * 129], tp[7 * 129]); \
        w.z = pack4_fp8(tp[8 * 129], tp[9 * 129], tp[10 * 129], tp[11 * 129]); w.w = pack4_fp8(tp[12 * 129], tp[13 * 129], tp[14 * 129], tp[15 * 129]); \
        *(u32x4*)((dd) + (size_t)n * (ld_) + kq * 32 + j * 16) = w; } } while (0)
__device__ __forceinline__ void exp_range(AP a, unsigned char* lds, int l, int u0, int u_end) {
    float* tile = (float*)lds;
    const int tid = tid_opaque();
    __syncthreads();
    if (u0 >= u_end) return;
    const float* src; unsigned char* dst; int srcld, dstld;
    f32x4 va[8], vb[8];
    unsigned char *da, *db = nullptr; int lda_, ldb_ = 0;
    EXP_LOAD(va, u0); da = dst; lda_ = dstld;
    if (u0 + 1 < u_end) { EXP_LOAD(vb, u0 + 1); db = dst; ldb_ = dstld; }
    for (int u = u0; u < u_end; u += 2) {
        EXP_PUT(va);
        __syncthreads();
        { unsigned char* cd = da; const int cl = lda_; if (u + 2 < u_end) { EXP_LOAD(va, u + 2); da = dst; lda_ = dstld; } EXP_STORE(cd, cl); }
        __syncthreads();
        if (u + 1 < u_end) {
            EXP_PUT(vb);
            __syncthreads();
            { unsigned char* cd = db; const int cl = ldb_; if (u + 3 < u_end) { EXP_LOAD(vb, u + 3); db = dst; ldb_ = dstld; } EXP_STORE(cd, cl); }
            __syncthreads();
        }
    }
}
#undef EXP_LOAD
#undef EXP_PUT
#undef EXP_STORE
__device__ __forceinline__ void exp_queue(AP a, unsigned char* lds, int l) {
    const int tid = tid_opaque();
    int* qslot = (int*)(lds + MISC_OFF + 128);
    unsigned* qc = (unsigned*)(a->ws + WS_BAR + 14336 + l * 256);
    for (;;) {
        __syncthreads();
        if (tid == 0) *qslot = (int)__hip_atomic_fetch_add(qc, 2u, __ATOMIC_RELAXED, __HIP_MEMORY_SCOPE_AGENT);
        __syncthreads();
        const int c0 = *qslot;
        if (c0 >= U_EXP) break;
        exp_range(a, lds, l, c0, c0 + 2);
    }
}

__device__ __forceinline__ void exp_fill(AP a, unsigned char* lds, int ql, int budget) {
    const int tid = tid_opaque();
    int* qslot = (int*)(lds + MISC_OFF + 128);
    unsigned* qc = (unsigned*)(a->ws + WS_BAR + 14336 + ql * 256);
    for (int done = 0; done < budget; done += 2) {
        __syncthreads();
        if (tid == 0) *qslot = (int)__hip_atomic_fetch_add(qc, 2u, __ATOMIC_RELAXED, __HIP_MEMORY_SCOPE_AGENT);
        __syncthreads();
        const int c0 = *qslot;
        if (c0 >= U_EXP) break;
        exp_range(a, lds, ql, c0, c0 + 2);
    }
    __syncthreads();
}

__device__ __forceinline__ void p0_prologue(AP a, unsigned char* lds) {
    const int tid = tid_opaque();
    bool have_tab = false;
    constexpr int E0 = U_ADA, E1 = E0 + U_WIN, E2 = E1 + U_WOUT, E3 = E2 + U_SGU, E4 = E3 + U_DFT, E5 = E4 + U_ROPE;
    int u = blockIdx.x;
    for (; u < E5; u += gridDim.x) {
        if (u < E0) ada_unit(a, lds, u);
        else if (u < E1) win_unit(a, lds, u - E0);
        else if (u < E2) wout_unit(a, lds, u - E1);
        else if (u < E3) { const size_t i0 = (size_t)(u - E2) * 4096 + tid * 8; const float* s = a->in[11] + i0; bf16_t* d = (bf16_t*)(a->ws + WS_WSGU) + i0;
            const f32x4 v0 = *(const f32x4*)s, v1 = *(const f32x4*)(s + 4); u32x4 w; w.x = pack2(v0[0], v0[1]); w.y = pack2(v0[2], v0[3]); w.z = pack2(v1[0], v1[1]); w.w = pack2(v1[2], v1[3]); *(u32x4*)d = w; }
        else if (u < E4) {
            float* ctab = (float*)(lds + LDS_CTAB);
            if (!have_tab) { for (int i = tid; i < 4096; i += NT) ctab[i] = cospif((float)i / 2048.0f); __syncthreads(); have_tab = true; }
            const int k = u - E3 + 4096;
            if (tid < 32) {
                const int kk = k - 4096, n0 = tid * 8; float c[8], s[8];
#pragma unroll
                for (int e = 0; e < 8; ++e) { const int idx = ((kk * (n0 + e)) & 255) * 16; c[e] = ctab[idx] * (1.0f / 16.0f); s[e] = ctab[(idx - 1024) & 4095] * (1.0f / 16.0f); }
                bf16_t* d = (bf16_t*)(a->ws + WS_DFTC) + (size_t)kk * 512 + n0;
                u32x4 w; w.x = pack2(c[0], c[1]); w.y = pack2(c[2], c[3]); w.z = pack2(c[4], c[5]); w.w = pack2(c[6], c[7]); *(u32x4*)d = w;
                w.x = pack2(s[0], s[1]); w.y = pack2(s[2], s[3]); w.z = pack2(s[4], s[5]); w.w = pack2(s[6], s[7]); *(u32x4*)(d + 256) = w;
            }
        }
        else {
            for (int i = tid; i < 1024; i += NT) { const int pos = i >> 4, f = i & 15; const float freq = powf(10000.0f, -(float)f / 16.0f); const float ang = (float)pos * freq;
                ((float2*)(a->ws + WS_ROPE))[i] = make_float2(cosf(ang), sinf(ang)); }
        }
    }
}

__device__ __forceinline__ void p_lnmod0(AP a) {
    const int tid = tid_opaque(), lane = tid & 63, w = tid >> 6;
    const float* mod = (const float*)(a->ws + WS_MOD);
    bf16_t* H = (bf16_t*)(a->ws + WS_H);
    const int tstep = gridDim.x * 8;
    f32x4 nx[4];
    { const int t = blockIdx.x * 8 + w; if (t < NTOK) { const float* src = (t < NLAT) ? a->in[0] + (size_t)t * D : a->in[2] + (size_t)(t - NLAT) * D;
#pragma unroll
        for (int i = 0; i < 4; ++i) nx[i] = *(const f32x4*)(src + 256 * i + 4 * lane); } }
    int mrow = -1; f32x4 msh[4], msc[4];
    for (int t = blockIdx.x * 8 + w; t < NTOK; t += tstep) {
        const int mr = (t < NLAT) ? (t >> 12) : 4;
        if (mr != mrow) { mrow = mr; const float* m = mod + (size_t)mr * 6144;
#pragma unroll
            for (int i = 0; i < 4; ++i) { msh[i] = *(const f32x4*)(m + 256 * i + 4 * lane); msc[i] = *(const f32x4*)(m + 1024 + 256 * i + 4 * lane); } }
        f32x4 v[4];
#pragma unroll
        for (int i = 0; i < 4; ++i) v[i] = nx[i];
        { const int tn = t + tstep; if (tn < NTOK) { const float* src = (tn < NLAT) ? a->in[0] + (size_t)tn * D : a->in[2] + (size_t)(tn - NLAT) * D;
#pragma unroll
            for (int i = 0; i < 4; ++i) nx[i] = *(const f32x4*)(src + 256 * i + 4 * lane); } }
        float mean, rstd; ln_stats(v, mean, rstd);
#pragma unroll
        for (int i = 0; i < 4; ++i) { const int c = 256 * i + 4 * lane;
            f32x4 o;
#pragma unroll
            for (int e = 0; e < 4; ++e) o[e] = (v[i][e] - mean) * rstd * (1.0f + msc[i][e]) + msh[i][e];
            u32x2 pk; pk.x = pack2(o[0], o[1]); pk.y = pack2(o[2], o[3]); *(u32x2*)(H + (size_t)t * D + c) = pk; }
    }
}

__device__ __forceinline__ void p1_inproj(AP a, unsigned char* smem, LAS unsigned char* lds, int l);
__device__ __forceinline__ u32x4 ld16g(const bf16_t* p) { return *(const u32x4*)p; }
__device__ __forceinline__ void rope_pack8(u32x4& wl, u32x4& wh, const LAS f32x2* tab, bool do_rope, float scale) {
    float tl[8] = {lo2f(wl.x), hi2f(wl.x), lo2f(wl.y), hi2f(wl.y), lo2f(wl.z), hi2f(wl.z), lo2f(wl.w), hi2f(wl.w)};
    float th[8] = {lo2f(wh.x), hi2f(wh.x), lo2f(wh.y), hi2f(wh.y), lo2f(wh.z), hi2f(wh.z), lo2f(wh.w), hi2f(wh.w)};
#pragma unroll
    for (int j = 0; j < 8; ++j) {
        float r1 = tl[j], r2 = th[j];
        if (do_rope) { const f32x2 cs = tab[j]; r1 = tl[j] * cs.x - th[j] * cs.y; r2 = tl[j] * cs.y + th[j] * cs.x; }
        tl[j] = r1 * scale; th[j] = r2 * scale;
    }
    wl.x = pack2(tl[0], tl[1]); wl.y = pack2(tl[2], tl[3]); wl.z = pack2(tl[4], tl[5]); wl.w = pack2(tl[6], tl[7]);
    wh.x = pack2(th[0], th[1]); wh.y = pack2(th[2], th[3]); wh.z = pack2(th[4], th[5]); wh.w = pack2(th[6], th[7]);
}

__device__ __forceinline__ void mixer_sgu_pool(AP a, LAS unsigned char* lds, int l, int row0, int seq_row0, int pos0, int n) {
    const int tid = tid_opaque(), lane = tid & 63, w = __builtin_amdgcn_readfirstlane(tid >> 6), fr = lane & 15, g = lane >> 4;
    const bf16_t* Z = (const bf16_t*)(a->ws + WS_Z);
    bf16_t* CAT = (bf16_t*)(a->ws + WS_CAT);
    {
#pragma unroll
        for (int it = 0; it < 9; ++it) { const int id = tid + 512 * it, rr = id >> 5, ch = id & 31, j = pos0 - 8 + rr;
            u32x4 v = (u32x4){0u, 0u, 0u, 0u};
            if (j >= 0 && j < n) v = ld16g(Z + (size_t)(seq_row0 + j) * ZC + 1024 + ch * 8);
            *(LAS u32x4*)(lds + rr * 512 + ch * 16) = v; }
        __syncthreads();
        const int c = tid & 255, half = tid >> 8, hw = 1 << (c >> 6);
        const LAS bf16_t* P = (const LAS bf16_t*)lds + c;
        const int t0 = half * 64;
        float s = 0.f;
        for (int j = t0 - hw; j < t0 + hw; ++j) s += bf2f(P[(8 + j) * 256]);
        for (int tl = t0; tl < t0 + 64; ++tl) {
            const int pos = pos0 + tl; const int lo = max(pos - hw, 0), hi = min(pos + hw, n);
            CAT[(size_t)(row0 + tl) * D + 512 + c] = f2bf(s / (float)(hi - lo) - bf2f(P[(8 + tl) * 256]));
            s += bf2f(P[(8 + tl + hw) * 256]) - bf2f(P[(8 + tl - hw) * 256]);
        }
        __syncthreads();
    }
    {
        const int i16 = lane & 15;
        u32x4 gw[4][2];
#pragma unroll
        for (int ps = 0; ps < 4; ++ps) { const int q = w * 16 + ps * 4 + g; const bf16_t* src = Z + (size_t)(row0 + q) * ZC + 1536 + 16 * i16; gw[ps][0] = ld16g(src); gw[ps][1] = ld16g(src + 8); }
#pragma unroll
        for (int ps = 0; ps < 4; ++ps) {
            const int q = w * 16 + ps * 4 + g;
            float gv[16];
#pragma unroll
            for (int hh = 0; hh < 2; ++hh) { const u32x4 x = gw[ps][hh];
                gv[8 * hh + 0] = gelu_erf(lo2f(x.x)); gv[8 * hh + 1] = gelu_erf(hi2f(x.x)); gv[8 * hh + 2] = gelu_erf(lo2f(x.y)); gv[8 * hh + 3] = gelu_erf(hi2f(x.y));
                gv[8 * hh + 4] = gelu_erf(lo2f(x.z)); gv[8 * hh + 5] = gelu_erf(hi2f(x.z)); gv[8 * hh + 6] = gelu_erf(lo2f(x.w)); gv[8 * hh + 7] = gelu_erf(hi2f(x.w)); }
            float sm = 0.f;
#pragma unroll
            for (int e = 0; e < 16; ++e) sm += gv[e];
            const float mean = row_sum16(sm) * (1.0f / 256.0f);
            float qq = 0.f;
#pragma unroll
            for (int e = 0; e < 16; ++e) { const float d = gv[e] - mean; qq += d * d; }
            const float rstd = 1.0f / sqrtf(row_sum16(qq) * (1.0f / 256.0f) + 1e-6f);
#pragma unroll
            for (int e = 0; e < 16; ++e) { const int c = 16 * i16 + e; *(LAS bf16_t*)(lds + c * 256 + ((((q >> 3) ^ (c & 15))) << 4) + (q & 7) * 2) = f2bf((gv[e] - mean) * rstd); }
        }
    }
    __syncthreads();
    {
        const int h = w >> 1, ph = w & 1;
        const bf16_t* Ws = (const bf16_t*)(a->ws + WS_WSGU) + (size_t)(l * 4 + h) * 128 * 128;
        const float* bs = a->in[12] + (size_t)(l * 4 + h) * 128;
        f32x4 acc[4][4];
#pragma unroll
        for (int i = 0; i < 4; ++i)
#pragma unroll
            for (int j = 0; j < 4; ++j) acc[i][j] = (f32x4){0.f, 0.f, 0.f, 0.f};
#pragma unroll
        for (int ks = 0; ks < 4; ++ks) {
            bf16x8 af[4], bfv[4];
#pragma unroll
            for (int cf = 0; cf < 4; ++cf) { const int c = h * 64 + 16 * cf + fr; af[cf] = *(const LAS bf16x8*)(lds + c * 256 + (((4 * ks + g) ^ (c & 15)) << 4)); }
#pragma unroll
            for (int pf = 0; pf < 4; ++pf) { const int p = ph * 64 + 16 * pf + fr; bfv[pf] = *(const bf16x8*)(Ws + (size_t)p * 128 + 32 * ks + 8 * g); }
#pragma unroll
            for (int cf = 0; cf < 4; ++cf)
#pragma unroll
                for (int pf = 0; pf < 4; ++pf) acc[cf][pf] = __builtin_amdgcn_mfma_f32_16x16x32_bf16(af[cf], bfv[pf], acc[cf][pf], 0, 0, 0);
        }
#pragma unroll
        for (int pf = 0; pf < 4; ++pf) { const int p = ph * 64 + 16 * pf + fr; const float bias = bs[p];
#pragma unroll
            for (int cf = 0; cf < 4; ++cf) { const int c0 = h * 64 + 16 * cf + 4 * g;
                const u32x2 uw = *(const u32x2*)(Z + (size_t)(row0 + p) * ZC + 1280 + c0);
                u32x2 o; o.x = pack2(gelu_erf(lo2f(uw.x)) * (acc[cf][pf][0] + bias), gelu_erf(hi2f(uw.x)) * (acc[cf][pf][1] + bias));
                o.y = pack2(gelu_erf(lo2f(uw.y)) * (acc[cf][pf][2] + bias), gelu_erf(hi2f(uw.y)) * (acc[cf][pf][3] + bias));
                *(u32x2*)(CAT + (size_t)(row0 + p) * D + 768 + c0) = o; } }
    }
    __syncthreads();
}

__device__ __forceinline__ void mixer_attn(AP a, LAS unsigned char* lds, int l, int row0, int seq_row0, int pos0, int n, int b, bool is_ctx, int kvh) {
    const int tid = tid_opaque(), lane = tid & 63, w = __builtin_amdgcn_readfirstlane(tid >> 6), fr = lane & 15, g = lane >> 4;
    const bf16_t* Z = (const bf16_t*)(a->ws + WS_Z);
    bf16_t* CAT = (bf16_t*)(a->ws + WS_CAT);
    __syncthreads();
    ((LAS u32x4*)(lds + 98304))[tid] = ((const u32x4*)(a->ws + WS_ROPE))[tid];
    const LAS f32x2* rope = (const LAS f32x2*)(lds + 98304);
    constexpr float QS = 0.125f * 1.44269504088896341f;
    constexpr int QS_OFF = 0, KS_OFF = 32768, VS_OFF = 65536;
    const int nbq = pos0 >> 7;
    unsigned bmask = 0x18u;
    if (!is_ctx) { if (nbq > 0) bmask |= 1u; bmask |= 2u; if (nbq + 1 < (n >> 7)) bmask |= 4u; }
    const int kr = tid >> 2, kax = (tid >> 1) & 1, kh8 = tid & 1;
#define MX_KSRC(blk) (Z + (size_t)((((blk) < 3) ? seq_row0 + (nbq + (blk) - 1) * 128 : NLAT + b * 256 + ((blk) - 3) * 128) + kr) * ZC + 768 + kvh * 64 + kax * 32 + kh8 * 8)
#define MX_VSTAGE(blk, buf) do { const bool _band = (blk) < 3; const int _key0 = _band ? (nbq + (blk) - 1) * 128 : ((blk) - 3) * 128; \
        const bf16_t* _vs = _band ? (const bf16_t*)(a->ws + WS_VT) + (size_t)(b * 2 + kvh) * 64 * 4096 + _key0 : (const bf16_t*)(a->ws + WS_VTC) + (size_t)(b * 2 + kvh) * 64 * 256 + _key0; \
        const int _vld = _band ? 4096 : 256; \
        _Pragma("unroll") for (int _i = 0; _i < 2; ++_i) { const int _P = _i * 512 + tid, _d = _P >> 4, _c = (_P & 15) ^ (_d & 15); \
            glds16(_vs + (size_t)_d * _vld + _c * 8, lds + VS_OFF + (buf) * 16384 + _i * 8192 + w * 1024); } } while (0)
    {
        __syncthreads();
#pragma unroll
        for (int it = 0; it < 2; ++it) {
            const int item = tid + 512 * it, r = item >> 2, ax = (item >> 1) & 1, h8 = item & 1, i = r & 127, qpos = pos0 + i;
            const bf16_t* src = Z + (size_t)(row0 + i) * ZC + 512 + (2 * kvh + (r >> 7)) * 64 + ax * 32 + h8 * 8;
            u32x4 wl = ld16g(src), wh = ld16g(src + 16);
            rope_pack8(wl, wh, rope + (ax ? (qpos & 63) : (qpos >> 6)) * 16 + h8 * 8, !is_ctx, QS);
            const int ch = ax * 4 + h8, sw = (r >> 1) & 7;
            *(LAS u32x4*)(lds + QS_OFF + r * 128 + ((ch ^ sw) << 4)) = wl;
            *(LAS u32x4*)(lds + QS_OFF + r * 128 + (((ch + 2) ^ sw) << 4)) = wh;
        }
        const int hh = w >> 2, qb = (w & 3) * 32, h = 2 * kvh + hh;
        float m[2], lsum[2];
        m[0] = m[1] = a->in[8][l * 4 + h] * 1.44269504088896341f;
        lsum[0] = lsum[1] = (g == 0) ? 1.0f : 0.0f;
        f32x4 O[4][2];
#pragma unroll
        for (int i = 0; i < 4; ++i) { O[i][0] = (f32x4){0.f, 0.f, 0.f, 0.f}; O[i][1] = (f32x4){0.f, 0.f, 0.f, 0.f}; }
        bf16x8 Qf[2][2];
        bool have_q = false;
        unsigned rem = bmask;
        int cur = __builtin_ctz(rem); rem &= rem - 1u;
        int buf = 0;
        u32x4 kl = ld16g(MX_KSRC(cur)), kh = ld16g(MX_KSRC(cur) + 16);
        MX_VSTAGE(cur, 0);
#pragma unroll 1
        for (;;) {
            const int jb = cur - 1; const bool band = cur < 3;
            {
                const int kpos = (nbq + jb) * 128 + kr;
                rope_pack8(kl, kh, rope + (kax ? (kpos & 63) : (kpos >> 6)) * 16 + kh8 * 8, band, 1.0f);
                const int ch = kax * 4 + kh8, sw = (kr >> 1) & 7;
                *(LAS u32x4*)(lds + KS_OFF + buf * 16384 + kr * 128 + ((ch ^ sw) << 4)) = kl;
                *(LAS u32x4*)(lds + KS_OFF + buf * 16384 + kr * 128 + (((ch + 2) ^ sw) << 4)) = kh;
            }
            asm volatile("s_waitcnt vmcnt(0)" ::: "memory");
            __syncthreads();
            const int nxt = rem ? __builtin_ctz(rem) : -1; rem &= rem - 1u;
            if (nxt >= 0) { kl = ld16g(MX_KSRC(nxt)); kh = ld16g(MX_KSRC(nxt) + 16); MX_VSTAGE(nxt, buf ^ 1); }
            if (!have_q) {
#pragma unroll
                for (int qf = 0; qf < 2; ++qf)
#pragma unroll
                    for (int ks = 0; ks < 2; ++ks) { const int r = hh * 128 + qb + 16 * qf + fr; Qf[qf][ks] = *(const LAS bf16x8*)(lds + QS_OFF + r * 128 + (((4 * ks + g) ^ ((r >> 1) & 7)) << 4)); }
                have_q = true;
            }
            const int kso = KS_OFF + buf * 16384, vso = VS_OFF + buf * 16384;
            f32x4 S[8][2];
#pragma unroll
            for (int kf = 0; kf < 8; ++kf) { S[kf][0] = (f32x4){0.f, 0.f, 0.f, 0.f}; S[kf][1] = (f32x4){0.f, 0.f, 0.f, 0.f}; }
#pragma unroll
            for (int kf = 0; kf < 8; ++kf)
#pragma unroll
                for (int ks = 0; ks < 2; ++ks) { const int r = 16 * kf + fr;
                    const bf16x8 kfr = *(const LAS bf16x8*)(lds + kso + r * 128 + (((4 * ks + g) ^ ((r >> 1) & 7)) << 4));
                    S[kf][0] = __builtin_amdgcn_mfma_f32_16x16x32_bf16(kfr, Qf[0][ks], S[kf][0], 0, 0, 0);
                    S[kf][1] = __builtin_amdgcn_mfma_f32_16x16x32_bf16(kfr, Qf[1][ks], S[kf][1], 0, 0, 0); }
            bf16x8 Pp[4][2];
#pragma unroll
            for (int qf = 0; qf < 2; ++qf) {
                const int qi = qb + 16 * qf + fr;
                if (band && jb != 0) {
#pragma unroll
                    for (int kf = 0; kf < 8; ++kf)
#pragma unroll
                        for (int r = 0; r < 4; ++r) { const int kk = 16 * kf + 4 * g + r; const bool ok = (jb < 0) ? (kk >= qi) : (kk <= qi); if (!ok) S[kf][qf][r] = -1.0e30f; }
                }
                float mx = S[0][qf][0];
#pragma unroll
                for (int kf = 0; kf < 8; ++kf)
#pragma unroll
                    for (int r = 0; r < 4; ++r) mx = fmaxf(mx, S[kf][qf][r]);
                mx = fmaxf(mx, __shfl_xor(mx, 16)); mx = fmaxf(mx, __shfl_xor(mx, 32));
                const float mn = fmaxf(m[qf], mx), corr = __builtin_amdgcn_exp2f(m[qf] - mn);
                m[qf] = mn;
                float ps = 0.f;
#pragma unroll
                for (int kf = 0; kf < 8; ++kf)
#pragma unroll
                    for (int r = 0; r < 4; ++r) { const float p = __builtin_amdgcn_exp2f(S[kf][qf][r] - mn); S[kf][qf][r] = p; ps += p; }
                lsum[qf] = lsum[qf] * corr + ps;
#pragma unroll
                for (int df = 0; df < 4; ++df) O[df][qf] *= corr;
#pragma unroll
                for (int t = 0; t < 4; ++t) { u32x4 pw; pw.x = pack2(S[2 * t][qf][0], S[2 * t][qf][1]); pw.y = pack2(S[2 * t][qf][2], S[2 * t][qf][3]);
                    pw.z = pack2(S[2 * t + 1][qf][0], S[2 * t + 1][qf][1]); pw.w = pack2(S[2 * t + 1][qf][2], S[2 * t + 1][qf][3]); Pp[t][qf] = __builtin_bit_cast(bf16x8, pw); }
            }
#pragma unroll
            for (int t = 0; t < 4; ++t)
#pragma unroll
                for (int df = 0; df < 4; ++df) { const int d = 16 * df + fr;
                    const u32x2 v0 = *(const LAS u32x2*)(lds + vso + d * 256 + (((4 * t + (g >> 1)) ^ (d & 15)) << 4) + (g & 1) * 8);
                    const u32x2 v1 = *(const LAS u32x2*)(lds + vso + d * 256 + (((4 * t + 2 + (g >> 1)) ^ (d & 15)) << 4) + (g & 1) * 8);
                    u32x4 vw; vw.x = v0.x; vw.y = v0.y; vw.z = v1.x; vw.w = v1.y; const bf16x8 vf = __builtin_bit_cast(bf16x8, vw);
                    O[df][0] = __builtin_amdgcn_mfma_f32_16x16x32_bf16(vf, Pp[t][0], O[df][0], 0, 0, 0);
                    O[df][1] = __builtin_amdgcn_mfma_f32_16x16x32_bf16(vf, Pp[t][1], O[df][1], 0, 0, 0); }
            if (nxt < 0) break;
            cur = nxt; buf ^= 1;
        }
#pragma unroll
        for (int qf = 0; qf < 2; ++qf) {
            float lt = lsum[qf]; lt += __shfl_xor(lt, 16); lt += __shfl_xor(lt, 32);
            const float inv = 1.0f / lt;
            bf16_t* dst = CAT + (size_t)(row0 + qb + 16 * qf + fr) * D + 256 + h * 64 + 4 * g;
#pragma unroll
            for (int df = 0; df < 4; ++df) { u32x2 o; o.x = pack2(O[df][qf][0] * inv, O[df][qf][1] * inv); o.y = pack2(O[df][qf][2] * inv, O[df][qf][3] * inv); *(u32x2*)(dst + 16 * df) = o; }
        }
    }
#undef MX_KSRC
#undef MX_VSTAGE
    __syncthreads();
}

constexpr int FF_DA = 0, FF_DC = 32768, FF_XT = 49152  , FF_Z2 = 81920  , FF_OB = 114688  ;
__device__ __forceinline__ int ff_addr(int row, int k) { return row * 256 + ((((k >> 3) ^ (row & 15))) << 4) + (k & 7) * 2; }
__device__ __forceinline__ float cos_turns(float x) { return __builtin_amdgcn_cosf(x); }
__device__ __forceinline__ float sin_turns(float x) { return __builtin_amdgcn_sinf(x); }
__device__ __forceinline__ void fft_setup(LAS unsigned char* lds) {
    const int tid = tid_opaque();
    __syncthreads();
    for (int idx = tid; idx < 16384; idx += NT) { const int i = idx >> 7, k = idx & 127, ro = i >> 6, k1 = i & 63, part = k >> 6, n1 = k & 63; const float t = (float)((k1 * n1) & 63) * (1.0f / 64.0f);
        const float c = cos_turns(t), sn = sin_turns(t);
        const float v = (ro == 0) ? (part == 0 ? c : sn) : (part == 0 ? -sn : c);
        *(LAS bf16_t*)(lds + FF_DA + ff_addr(i, k)) = f2bf(v * 0.125f); }
    for (int idx = tid; idx < 8192; idx += NT) { const int k2 = idx >> 7, k = idx & 127, ri = k >> 6, n2 = k & 63; const float t = (float)((k2 * n2) & 63) * (1.0f / 64.0f);
        const float v = (ri == 0) ? cos_turns(t) : sin_turns(t);
        *(LAS bf16_t*)(lds + FF_DC + ff_addr(k2, k)) = f2bf(v * 0.125f); }
    __syncthreads();
}
__device__ __forceinline__ void fft_unit(AP a, LAS unsigned char* lds, int b, int cg) {
    const int tid = tid_opaque(), lane = tid & 63, w = __builtin_amdgcn_readfirstlane(tid >> 6), fr = lane & 15, g = lane >> 4;
    const int mf = w & 3, nh = w >> 2;
    const bf16_t* AT = (const bf16_t*)(a->ws + WS_AT) + (size_t)(b * 256 + cg * 4) * 8192;
    u32x4 xin[2][2];
#pragma unroll
    for (int h = 0; h < 2; ++h)
#pragma unroll
        for (int it = 0; it < 2; ++it) xin[h][it] = ld16g(AT + (size_t)h * 8192 + (size_t)(tid + 512 * it) * 8);
#pragma unroll 1
    for (int cp = 0; cp < 2; ++cp) {
#pragma unroll
        for (int h = 0; h < 2; ++h)
#pragma unroll
            for (int it = 0; it < 2; ++it) { const int q = tid + 512 * it, part = q >> 9, pos0 = (q & 511) * 8, n1 = pos0 >> 6, n2 = pos0 & 63, k = part * 64 + n1;
                const unsigned wv[4] = {xin[h][it].x, xin[h][it].y, xin[h][it].z, xin[h][it].w};
#pragma unroll
                for (int e = 0; e < 4; ++e) { *(LAS bf16_t*)(lds + FF_XT + h * 16384 + ff_addr(n2 + 2 * e, k)) = (bf16_t)(wv[e] & 0xffffu); *(LAS bf16_t*)(lds + FF_XT + h * 16384 + ff_addr(n2 + 2 * e + 1, k)) = (bf16_t)(wv[e] >> 16); } }
        if (cp == 0) {
#pragma unroll
            for (int h = 0; h < 2; ++h)
#pragma unroll
                for (int it = 0; it < 2; ++it) xin[h][it] = ld16g(AT + (size_t)(2 + h) * 8192 + (size_t)(tid + 512 * it) * 8); }
        __syncthreads();
        f32x4 acc[2][2][2];
#pragma unroll
        for (int h = 0; h < 2; ++h)
#pragma unroll
            for (int x = 0; x < 2; ++x) { acc[h][x][0] = (f32x4){0.f, 0.f, 0.f, 0.f}; acc[h][x][1] = (f32x4){0.f, 0.f, 0.f, 0.f}; }
#pragma unroll
        for (int ks = 0; ks < 4; ++ks) {
            bf16x8 af[2];
#pragma unroll
            for (int x = 0; x < 2; ++x) { const int i = 16 * (mf + 4 * x) + fr; af[x] = *(const LAS bf16x8*)(lds + FF_DA + i * 256 + (((4 * ks + g) ^ (i & 15)) << 4)); }
#pragma unroll
            for (int h = 0; h < 2; ++h)
#pragma unroll
                for (int n = 0; n < 2; ++n) { const int j = 16 * (2 * nh + n) + fr; const bf16x8 bfv = *(const LAS bf16x8*)(lds + FF_XT + h * 16384 + j * 256 + (((4 * ks + g) ^ (j & 15)) << 4));
                    acc[h][0][n] = __builtin_amdgcn_mfma_f32_16x16x32_bf16(af[0], bfv, acc[h][0][n], 0, 0, 0);
                    acc[h][1][n] = __builtin_amdgcn_mfma_f32_16x16x32_bf16(af[1], bfv, acc[h][1][n], 0, 0, 0); }
        }
#pragma unroll
        for (int n = 0; n < 2; ++n)
#pragma unroll
            for (int r = 0; r < 4; ++r) { const int k1 = 16 * mf + 4 * g + r, n2 = 16 * (2 * nh + n) + fr; const float t = (float)((k1 * n2) & 4095) * (1.0f / 4096.0f);
                const float c = cos_turns(t), sn = sin_turns(t);
#pragma unroll
                for (int h = 0; h < 2; ++h) { const float zr = acc[h][0][n][r], zi = acc[h][1][n][r];
                    *(LAS bf16_t*)(lds + FF_Z2 + h * 16384 + ff_addr(k1, n2)) = f2bf(zr * c + zi * sn);
                    *(LAS bf16_t*)(lds + FF_Z2 + h * 16384 + ff_addr(k1, 64 + n2)) = f2bf(zi * c - zr * sn); } }
        __syncthreads();
        f32x4 acc2[2][2];
#pragma unroll
        for (int h = 0; h < 2; ++h) { acc2[h][0] = (f32x4){0.f, 0.f, 0.f, 0.f}; acc2[h][1] = (f32x4){0.f, 0.f, 0.f, 0.f}; }
#pragma unroll
        for (int ks = 0; ks < 4; ++ks) {
            const int i = 16 * mf + fr; const bf16x8 af = *(const LAS bf16x8*)(lds + FF_DC + i * 256 + (((4 * ks + g) ^ (i & 15)) << 4));
#pragma unroll
            for (int h = 0; h < 2; ++h)
#pragma unroll
                for (int n = 0; n < 2; ++n) { const int j = 16 * (2 * nh + n) + fr; const bf16x8 bfv = *(const LAS bf16x8*)(lds + FF_Z2 + h * 16384 + j * 256 + (((4 * ks + g) ^ (j & 15)) << 4));
                    acc2[h][n] = __builtin_amdgcn_mfma_f32_16x16x32_bf16(af, bfv, acc2[h][n], 0, 0, 0); }
        }
#pragma unroll
        for (int n = 0; n < 2; ++n)
#pragma unroll
            for (int r = 0; r < 4; ++r) { const int k = 16 * (2 * nh + n) + fr + 64 * (16 * mf + 4 * g + r);
                *(LAS unsigned*)(lds + FF_OB + k * 8 + cp * 4) = pack2(acc2[0][n][r], acc2[1][n][r]); }
    }
    __syncthreads();
    bf16_t* CAT = (bf16_t*)(a->ws + WS_CAT) + (size_t)(b * 4096) * D + cg * 4;
#pragma unroll
    for (int it = 0; it < 8; ++it) { const int k = tid + 512 * it; *(u32x2*)(CAT + (size_t)k * D) = *(const LAS u32x2*)(lds + FF_OB + k * 8); }
    __syncthreads();
}

__device__ __forceinline__ void p2_mix(AP a, unsigned char* ldsg, LAS unsigned char* lds, int l) {
    const int n_tile = 128 + ((l == 0) ? 8 : 0), n_att = 2 * n_tile, n_dft = 256, n_dftc = (l == 0) ? 16 : 0;
    bf16_t* CAT = (bf16_t*)(a->ws + WS_CAT);
    bool fft_ready = false;
    for (int u = blockIdx.x; u < n_att + n_dft + n_tile + n_dftc; u += gridDim.x) {
        if (u < n_att || (u >= n_att + n_dft && u < n_att + n_dft + n_tile)) {
            const bool att = u < n_att;
            const int t = att ? (u >> 1) : (u - n_att - n_dft);
            const bool isc = t >= 128; const int tt = t - 128;
            const int b = isc ? (tt >> 1) : (t >> 5);
            const int row0 = isc ? NLAT + tt * 128 : t * 128, seq_row0 = isc ? NLAT + b * 256 : b * 4096, pos0 = isc ? (tt & 1) * 128 : (t & 31) * 128, n = isc ? 256 : 4096;
            if (att) { for (int rep = 0; rep < PROBE_MIX_REP; ++rep) mixer_attn(a, lds, l, row0, seq_row0, pos0, n, b, isc, u & 1); }
            else { for (int rep = 0; rep < PROBE_SGU_REP; ++rep) mixer_sgu_pool(a, lds, l, row0, seq_row0, pos0, n); }
            fft_ready = false;
        } else if (u < n_att + n_dft) {
            const int uu = u - n_att;
            if (!fft_ready) { fft_setup(lds); fft_ready = true; }
            for (int rep = 0; rep < PROBE_FFT_REP; ++rep) fft_unit(a, lds, uu >> 6, uu & 63);
        } else {
            const int uu = u - n_att - n_dft - n_tile, b = uu >> 2, mt = (uu >> 1) & 1, ch0 = (uu & 1) * 128;
            const bf16_t* A = (const bf16_t*)(a->ws + WS_DFTC) + (size_t)(mt * 128) * 512;
            const bf16_t* B0 = (const bf16_t*)(a->ws + WS_ATC) + ((size_t)b * 256 + ch0) * 512;
            EpiBf16 E; E.C = CAT + (size_t)(NLAT + b * 256 + mt * 128) * D + ch0; E.ld = D; E.scale = 1.0f;
            gemm_tile<128, false, EpiBf16>(lds, A, 512, nullptr, 128, B0, B0 + (size_t)64 * 512, 512, 512, E);
            fft_ready = false;
        }
    }
    exp_queue(a, ldsg, l);
}

__device__ __forceinline__ int uni(int v) { return __builtin_amdgcn_readfirstlane(v); }
__device__ __forceinline__ int vblock() { const int G = gridDim.x, b = blockIdx.x; return (G % 8 == 0) ? (b % 8) * (G / 8) + b / 8 : b; }
template <class T> __device__ __forceinline__ T* unip(T* p) { const unsigned long long v = (unsigned long long)p; const unsigned lo = __builtin_amdgcn_readfirstlane((unsigned)v), hi = __builtin_amdgcn_readfirstlane((unsigned)(v >> 32)); return (T*)(((unsigned long long)hi << 32) | lo); }
struct SchedInProj {
    typedef EpiInProj Epi; static constexpr bool GATHER = false, FP8 = false;
    unsigned char* ws; int l, G, me;
    __device__ __forceinline__ bool get(int i, g256::Unit<Epi>& u) const {
        const int n_lat = 64 * 7, n_ctx = (l == 0) ? 4 * 7 : 4;
        const int idx = i * G + me; if (idx >= n_lat + n_ctx) return false;
        int row0, b, ct, n; bf16_t *tF, *tV;
        if (idx < n_lat) { const int rt = idx / 7; ct = idx % 7; row0 = rt * 256; b = row0 >> 12; n = 4096;
            tF = (bf16_t*)(ws + WS_AT) + (size_t)b * 256 * 2 * 4096; tV = (bf16_t*)(ws + WS_VT) + (size_t)b * 128 * 4096; }
        else { const int uu = idx - n_lat; int rt; if (l == 0) { rt = uu / 7; ct = uu % 7; } else { rt = uu; ct = 3; }
            row0 = NLAT + rt * 256; b = rt; n = 256;
            tF = (bf16_t*)(ws + WS_ATC) + (size_t)b * 256 * 2 * 256; tV = (bf16_t*)(ws + WS_VTC) + (size_t)b * 128 * 256; }
        u.A = (const bf16_t*)(ws + WS_H) + (size_t)row0 * D;
        u.B0 = (const bf16_t*)(ws + WS_WIN) + ((size_t)l * ZC + ct * 256) * 1024; u.B1 = u.B0 + (size_t)128 * 1024; u.ridx = nullptr; u.valid = 256;
        u.epi.Zt = (bf16_t*)(ws + WS_Z) + (size_t)row0 * ZC + ct * 256; u.epi.tF = tF; u.epi.tV = tV; u.epi.n0 = ct * 256; u.epi.pos0 = (idx < n_lat) ? (row0 & 4095) : 0; u.epi.n = n;
        return true;
    }
};
struct SchedOutProj {
    typedef EpiBf16 Epi; static constexpr bool GATHER = false, FP8 = false;
    unsigned char* ws; int l, G, me;
    __device__ __forceinline__ bool get(int i, g256::Unit<Epi>& u) const {
        const int nrt = NLAT / 256;
        const int idx = i * G + me; if (idx >= nrt * 4) return false;
        const int rt = idx >> 2, ct = idx & 3;
        u.A = (const bf16_t*)(ws + WS_CAT) + (size_t)(rt * 256) * D;
        u.B0 = (const bf16_t*)(ws + WS_WOUT) + ((size_t)l * 1024 + ct * 256) * 1024; u.B1 = u.B0 + (size_t)128 * 1024; u.ridx = nullptr; u.valid = 256;
        u.epi.C = (bf16_t*)(ws + WS_Y) + (size_t)(rt * 256) * D + ct * 256; u.epi.ld = D; u.epi.scale = 1.0f;
        return true;
    }
};
__device__ __forceinline__ void moe_units(const LAS int* blk, LAS int* uinf, int G, int me) {
    const int i = threadIdx.x;
    if (i < 8) { const int idx = i * G + me, nu = blk[32] * 4; int e = 0, valid = 0;
        if (idx < nu) { const int rb = idx >> 2; for (int q = 1; q < 32; ++q) if (blk[q] <= rb) e = q; valid = min(256, blk[33 + e] - (rb - blk[e]) * 256); }
        uinf[2 * i] = e; uinf[2 * i + 1] = valid; }
    __syncthreads();
}
struct SchedGateUp {
    typedef EpiGateUp8 Epi; static constexpr bool GATHER = true, FP8 = true;
    unsigned char* ws; const LAS int* uinf; const LAS int* ridx_lds; int G, me, l, nu;
    __device__ __forceinline__ bool get(int i, g256::Unit<Epi>& u) const {
        const int idx = i * G + me; if (idx >= nu) return false;
        const int rb = idx >> 2, ct = idx & 3, e = uni(uinf[2 * i]);
        u.A = (const bf16_t*)(ws + WS_H8);
        { const unsigned char* b0 = ws + WS_WEXP + (size_t)l * WEXP_LAYER + ((size_t)e * 512 + ct * 128) * 1024; u.B0 = (const bf16_t*)b0; u.B1 = (const bf16_t*)(b0 + EXPMAT); }
        u.ridx = ridx_lds + (i & 7) * 256; u.valid = uni(uinf[2 * i + 1]);
        u.epi.C = ws + WS_HID + (size_t)(rb * 256) * DEXP + ct * 128; u.epi.ld = DEXP;
        return true;
    }
};
struct SchedDown {
    typedef EpiFp8 Epi; static constexpr bool GATHER = false, FP8 = true;
    unsigned char* ws; const LAS int* uinf; int G, me, l, nu;
    __device__ __forceinline__ bool get(int i, g256::Unit<Epi>& u) const {
        const int idx = i * G + me; if (idx >= nu) return false;
        const int rb = idx >> 2, ct = idx & 3, e = uni(uinf[2 * i]);
        u.A = (const bf16_t*)(ws + WS_HID + (size_t)(rb * 256) * DEXP);
        { const unsigned char* b0 = ws + WS_WEXP + (size_t)l * WEXP_LAYER + 2 * EXPMAT + ((size_t)e * 1024 + ct * 256) * 512; u.B0 = (const bf16_t*)b0; u.B1 = (const bf16_t*)(b0 + (size_t)128 * 512); } u.ridx = nullptr; u.valid = 256;
        u.epi.C = ws + WS_YS + (size_t)(rb * 256) * D + ct * 256; u.epi.ld = D; u.epi.scale = 1.0f / 32.0f;
        return true;
    }
};

__device__ __forceinline__ void p4_ln1_router(AP a, unsigned char* lds, int l) {
    const int tid = tid_opaque(), lane = tid & 63, w = tid >> 6;
    const int ntok = (l == 0) ? NTOK : NLAT;
    int* cnt = (int*)(lds + MISC_OFF);
    if (tid < 32) cnt[tid] = 0;
    f32x4* Lg = (f32x4*)lds; f32x4* Le = (f32x4*)(lds + 16384); f32x4* Lgb = (f32x4*)(lds + 147456);
    {
        const float* wrg_ = a->in[16] + (size_t)l * 1024 * 4; const float* wre_ = a->in[17] + (size_t)l * 1024 * 32;
#pragma unroll
        for (int it = 0; it < 2; ++it) { const int c = tid + 512 * it, slot = (((c >> 8) * 4 + (c & 3)) << 6) + ((c >> 2) & 63);
            Lg[slot] = *(const f32x4*)(wrg_ + (size_t)c * 4);
#pragma unroll
            for (int q = 0; q < 8; ++q) Le[q * 1024 + slot] = *(const f32x4*)(wre_ + (size_t)c * 32 + q * 4); }
        Lgb[tid] = (tid < 256) ? *(const f32x4*)(a->in[14] + l * 1024 + tid * 4) : *(const f32x4*)(a->in[15] + l * 1024 + (tid - 256) * 4);
    }
    __syncthreads();
    const float* mod = (const float*)(a->ws + WS_MOD) + (size_t)l * 5 * 6144;
    const bf16_t* Y = (const bf16_t*)(a->ws + WS_Y);
    float* X1 = (float*)(a->ws + WS_X1);
    unsigned char* H8 = a->ws + WS_H8;
    int* tokE = (int*)(a->ws + WS_TOKE); int* tokR = (int*)(a->ws + WS_TOKR); float* tokG = (float*)(a->ws + WS_TOKG);
    const int tstep = gridDim.x * 8;
    f32x4 nx[4]; u32x2 ny[4];
    {   const int t = blockIdx.x * 8 + w;
        if (t < ntok) { const float* xs = (l == 0) ? ((t < NLAT) ? a->in[0] + (size_t)t * D : a->in[2] + (size_t)(t - NLAT) * D) : (const float*)(a->ws + WS_XC) + (size_t)t * D;
#pragma unroll
            for (int i = 0; i < 4; ++i) { nx[i] = *(const f32x4*)(xs + 256 * i + 4 * lane); ny[i] = *(const u32x2*)(Y + (size_t)t * D + 256 * i + 4 * lane); } } }
    int mrow = -1; f32x4 mg[4], msh[4], msc[4];
    for (int t = blockIdx.x * 8 + w; t < ntok; t += tstep) {
        const int mr = (t < NLAT) ? (t >> 12) : 4;
        if (mr != mrow) { mrow = mr; const float* m = mod + (size_t)mr * 6144;
#pragma unroll
            for (int i = 0; i < 4; ++i) { const int c = 256 * i + 4 * lane; mg[i] = *(const f32x4*)(m + 2048 + c); msh[i] = *(const f32x4*)(m + 3072 + c); msc[i] = *(const f32x4*)(m + 4096 + c); } }
        f32x4 v[4];
#pragma unroll
        for (int i = 0; i < 4; ++i) { const f32x4 yv = (f32x4){lo2f(ny[i].x), hi2f(ny[i].x), lo2f(ny[i].y), hi2f(ny[i].y)};
#pragma unroll
            for (int e = 0; e < 4; ++e) v[i][e] = RES_ALPHA * nx[i][e] + mg[i][e] * yv[e]; }
        {   const int tn = t + tstep;
            if (tn < ntok) { const float* xs = (l == 0) ? ((tn < NLAT) ? a->in[0] + (size_t)tn * D : a->in[2] + (size_t)(tn - NLAT) * D) : (const float*)(a->ws + WS_XC) + (size_t)tn * D;
#pragma unroll
                for (int i = 0; i < 4; ++i) { nx[i] = *(const f32x4*)(xs + 256 * i + 4 * lane); ny[i] = *(const u32x2*)(Y + (size_t)tn * D + 256 * i + 4 * lane); } } }
        float mean, rstd; ln_stats(v, mean, rstd);
#pragma unroll
        for (int i = 0; i < 4; ++i) { const int c = 256 * i + 4 * lane; const f32x4 gg = Lgb[64 * i + lane], bb = Lgb[256 + 64 * i + lane];
#pragma unroll
            for (int e = 0; e < 4; ++e) v[i][e] = (v[i][e] - mean) * rstd * gg[e] + bb[e];
            *(f32x4*)(X1 + (size_t)t * D + c) = v[i]; }
        ln_stats(v, mean, rstd);
#pragma unroll
        for (int i = 0; i < 4; ++i) { const int c = 256 * i + 4 * lane; const f32x4 sh = msh[i], sc = msc[i];
#pragma unroll
            for (int e = 0; e < 4; ++e) v[i][e] = (v[i][e] - mean) * rstd * (1.0f + sc[e]) + sh[e];
            *(unsigned*)(H8 + (size_t)t * D + c) = pack4_fp8(v[i][0], v[i][1], v[i][2], v[i][3]); }
        f32x2 lg01 = (f32x2){0.f, 0.f}, lg23 = (f32x2){0.f, 0.f};
#pragma unroll
        for (int i = 0; i < 4; ++i)
#pragma unroll
            for (int e = 0; e < 4; ++e) { const f32x4 wv = Lg[((i * 4 + e) << 6) + lane]; const f32x2 vv = (f32x2){v[i][e], v[i][e]};
                lg01 += vv * (f32x2){wv[0], wv[1]}; lg23 += vv * (f32x2){wv[2], wv[3]}; }
        float lg[4] = {wave_sum(lg01[0]), wave_sum(lg01[1]), wave_sum(lg23[0]), wave_sum(lg23[1])};
        int grp = 0; float mx = lg[0];
#pragma unroll
        for (int q = 1; q < 4; ++q) if (lg[q] > mx) { mx = lg[q]; grp = q; }
        float se = 0.f;
#pragma unroll
        for (int q = 0; q < 4; ++q) se += expf(lg[q] - mx);
        const float gate_group = 1.0f / se;
        f32x2 le01 = (f32x2){0.f, 0.f}, le23 = (f32x2){0.f, 0.f}, le45 = (f32x2){0.f, 0.f}, le67 = (f32x2){0.f, 0.f};
#pragma unroll
        for (int i = 0; i < 4; ++i)
#pragma unroll
            for (int e = 0; e < 4; ++e) { const f32x4* wp = Le + grp * 2048 + ((i * 4 + e) << 6) + lane; const f32x4 w0 = wp[0], w1 = wp[1024]; const f32x2 vv = (f32x2){v[i][e], v[i][e]};
                le01 += vv * (f32x2){w0[0], w0[1]}; le23 += vv * (f32x2){w0[2], w0[3]}; le45 += vv * (f32x2){w1[0], w1[1]}; le67 += vv * (f32x2){w1[2], w1[3]}; }
        float le[8] = {wave_sum(le01[0]), wave_sum(le01[1]), wave_sum(le23[0]), wave_sum(le23[1]), wave_sum(le45[0]), wave_sum(le45[1]), wave_sum(le67[0]), wave_sum(le67[1])};
        int j1 = 0; float l1 = le[0];
#pragma unroll
        for (int q = 1; q < 8; ++q) if (le[q] > l1) { l1 = le[q]; j1 = q; }
        int j2 = -1; float l2 = -3.0e38f;
#pragma unroll
        for (int q = 0; q < 8; ++q) if (q != j1 && le[q] > l2) { l2 = le[q]; j2 = q; }
        const float e2 = expf(l2 - l1), p1 = 1.0f / (1.0f + e2), p2 = e2 / (1.0f + e2);
        if (lane == 0) {
            const int ex0 = grp * 8 + j1, ex1 = grp * 8 + j2;
            const int r0 = atomicAdd(&cnt[ex0], 1), r1 = atomicAdd(&cnt[ex1], 1);
            tokE[2 * t] = ex0; tokE[2 * t + 1] = ex1; tokR[2 * t] = r0; tokR[2 * t + 1] = r1;
            tokG[2 * t] = gate_group * p1; tokG[2 * t + 1] = gate_group * p2;
        }
    }
    __syncthreads();
    if (tid < 32) ((int*)(a->ws + WS_BCNT))[((size_t)l * MAXG + blockIdx.x) * 32 + tid] = cnt[tid];
    __syncthreads();
}

__device__ __forceinline__ void p5_dispatch(AP a, unsigned char* lds, int l) {
    const int tid = tid_opaque();
    const int ntok = (l == 0) ? NTOK : NLAT;
    int* part = (int*)lds;
    int* tot = (int*)(lds + 4096);
    int* off = (int*)(lds + 4096 + 128);
    int* pstart = (int*)(lds + 4096 + 256);
    const int* bc = (const int*)(a->ws + WS_BCNT) + (size_t)l * MAXG * 32;
    const int G = gridDim.x, me = blockIdx.x;
    { const int e = tid & 31, p = tid >> 5; int s = 0, so = 0; for (int bb = p; bb < G; bb += 16) { const int c = bc[bb * 32 + e]; s += c; if (bb < me) so += c; } part[p * 32 + e] = s; part[512 + p * 32 + e] = so; }
    __syncthreads();
    if (tid < 32) { int s = 0, so = 0; for (int p = 0; p < 16; ++p) { s += part[p * 32 + tid]; so += part[512 + p * 32 + tid]; } tot[tid] = s; off[tid] = so; }
    __syncthreads();
    if (tid == 0) { int acc = 0; for (int e = 0; e < 32; ++e) { pstart[e] = acc; acc += ((tot[e] + 255) >> 8) << 8; } }
    __syncthreads();
    if (me == 0 && tid < 32) ((int*)(a->ws + WS_CNT))[l * 32 + tid] = tot[tid];
    const int* tokE = (const int*)(a->ws + WS_TOKE); const int* tokR = (const int*)(a->ws + WS_TOKR);
    int* tokS = (int*)(a->ws + WS_TOKS); int* slotT = (int*)(a->ws + WS_SLOTT);
    for (int q = tid; ; q += NT) { const int it = q >> 4, j = q & 15, t = (it * G + me) * 8 + (j >> 1); if (t >= ntok) break;
        const int idx = 2 * t + (j & 1); const int e = tokE[idx]; const int slot = pstart[e] + off[e] + tokR[idx]; tokS[idx] = slot; slotT[slot] = t; }
    __syncthreads();
}

__device__ __forceinline__ void moe_table(AP a, int l, LAS int* blk) {
    const int* tot = (const int*)(a->ws + WS_CNT) + l * 32;
    __syncthreads();
    if (threadIdx.x < 32) blk[33 + threadIdx.x] = tot[threadIdx.x];
    __syncthreads();
    if (threadIdx.x == 0) { int acc = 0; for (int e = 0; e < 32; ++e) { blk[e] = acc; acc += (blk[33 + e] + 255) >> 8; } blk[32] = acc; }
    __syncthreads();
}
__device__ __forceinline__ int units_of(int nu, int v, int G) { return (v < nu) ? (nu - v + G - 1) / G : 0; }
__device__ __forceinline__ void p1_inproj(AP a, unsigned char* smem, LAS unsigned char* lds, int l) {
    SchedInProj S; S.ws = a->ws; S.l = l; S.G = gridDim.x; S.me = vblock();
    g256::gemm_phase(lds, 1024, S);
    { const int nu = (l == 0) ? 64 * 7 + 4 * 7 : 64 * 7 + 4, G = gridDim.x; if (units_of(nu, S.me, G) < (nu + G - 1) / G) exp_fill(a, smem, l, 8); }
}
__device__ __forceinline__ void p3_outproj(AP a, unsigned char* smem, LAS unsigned char* lds, int l) {
    SchedOutProj S; S.ws = a->ws; S.l = l; S.G = gridDim.x; S.me = vblock();
    g256::gemm_phase(lds, 1024, S);
    if (l == 0) {
        const bf16_t* W = (const bf16_t*)(a->ws + WS_WOUT);
        for (int u = blockIdx.x; u < 64; u += gridDim.x) { const int rt = u >> 3, ct = u & 7;
            EpiBf16 E; E.C = (bf16_t*)(a->ws + WS_Y) + (size_t)(NLAT + rt * 128) * D + ct * 128; E.ld = D; E.scale = 1.0f;
            const bf16_t* B0 = W + (size_t)(ct * 128) * 1024;
            gemm_tile<128, false, EpiBf16>(lds, (const bf16_t*)(a->ws + WS_CAT) + (size_t)(NLAT + rt * 128) * D, D, nullptr, 128, B0, B0 + (size_t)64 * 1024, 1024, 1024, E); }
        if (blockIdx.x >= 64) exp_fill(a, smem, 0, 3);
    }
}
__device__ __forceinline__ void p6_gateup(AP a, unsigned char* smem, LAS unsigned char* lds, int l) {
    LAS int* blk = (LAS int*)(lds + MISC_OFF + 256);
    moe_table(a, l, blk);
    LAS int* ridx = (LAS int*)(lds + RIDX_OFF);
    const int tid = tid_opaque(), G = gridDim.x, me = vblock(), nu = uni(blk[32]) * 4;
    LAS int* uinf = (LAS int*)(lds + MISC_OFF + 528);
    moe_units(blk, uinf, G, me);
    const int* slotT = (const int*)(a->ws + WS_SLOTT);
    for (int i = 0; i < 8; ++i) { const int idx = i * G + me; if (idx >= nu) break;
        const int rb = idx >> 2, valid = uinf[2 * i + 1];
        if (tid < 256) ridx[i * 256 + tid] = (tid < valid) ? slotT[rb * 256 + tid] : 0; }
    __syncthreads();
    SchedGateUp S; S.ws = a->ws; S.uinf = uinf; S.ridx_lds = ridx; S.G = G; S.me = me; S.l = l; S.nu = nu;
    g256::gemm_phase(lds, 512, S);
    __syncthreads();
    if (l == 0 && units_of(nu, me, G) < (nu + G - 1) / G) exp_fill(a, smem, 1, 4);
}
__device__ __forceinline__ void p7_down(AP a, unsigned char* smem, LAS unsigned char* lds, int l) {
    LAS int* blk = (LAS int*)(lds + MISC_OFF + 256);
    moe_table(a, l, blk);
    LAS int* uinf = (LAS int*)(lds + MISC_OFF + 528);
    SchedDown S; S.ws = a->ws; S.uinf = uinf; S.G = gridDim.x; S.me = vblock(); S.l = l; S.nu = uni(blk[32]) * 4;
    moe_units(blk, uinf, S.G, S.me);
    g256::gemm_phase(lds, 256, S);
    __syncthreads();
    { const int nu = S.nu, G = gridDim.x; if (l == 0 && units_of(nu, S.me, G) < (nu + G - 1) / G) exp_fill(a, smem, 1, 2); }
}

__device__ __forceinline__ void p8_ln2(AP a, unsigned char* lds, int l) {
    const int tid = tid_opaque(), lane = tid & 63, w = tid >> 6;
    const int ntok = (l == 0) ? NTOK : NLAT;
    const float* mod = (const float*)(a->ws + WS_MOD) + (size_t)l * 5 * 6144;
    const float* modn = (const float*)(a->ws + WS_MOD) + (size_t)5 * 6144;
    const float* X1 = (const float*)(a->ws + WS_X1);
    const unsigned char* YS = a->ws + WS_YS;
    const int* tokS = (const int*)(a->ws + WS_TOKS); const float* tokG = (const float*)(a->ws + WS_TOKG);
    f32x4* Lgb = (f32x4*)lds;
    __syncthreads();
    Lgb[tid] = (tid < 256) ? *(const f32x4*)(a->in[21] + l * 1024 + tid * 4) : *(const f32x4*)(a->in[22] + l * 1024 + (tid - 256) * 4);
    __syncthreads();
    int mrow = -1; f32x4 mg[4], nsh[4], nsc[4];
    const int tstep = gridDim.x * 8;
    int t = blockIdx.x * 8 + w;
    int ns0 = 0, ns1 = 0; float nga = 0.f, ngb = 0.f;
    f32x4 nx[4]; unsigned nya[4], nyb[4];
    float cga = 0.f, cgb = 0.f;
    if (t < ntok) { const int s0 = tokS[2 * t], s1 = tokS[2 * t + 1]; cga = tokG[2 * t]; cgb = tokG[2 * t + 1];
#pragma unroll
        for (int i = 0; i < 4; ++i) { const int c = 256 * i + 4 * lane; nx[i] = *(const f32x4*)(X1 + (size_t)t * D + c); nya[i] = *(const unsigned*)(YS + (size_t)s0 * D + c); nyb[i] = *(const unsigned*)(YS + (size_t)s1 * D + c); } }
    if (t + tstep < ntok) { ns0 = tokS[2 * (t + tstep)]; ns1 = tokS[2 * (t + tstep) + 1]; nga = tokG[2 * (t + tstep)]; ngb = tokG[2 * (t + tstep) + 1]; }
    for (; t < ntok; t += tstep) {
        const int mr = (t < NLAT) ? (t >> 12) : 4;
        if (mr != mrow) { mrow = mr; const float* m = mod + (size_t)mr * 6144; const float* mn = modn + (size_t)mr * 6144;
#pragma unroll
            for (int i = 0; i < 4; ++i) { const int c = 256 * i + 4 * lane; mg[i] = *(const f32x4*)(m + 5120 + c); if (l == 0) { nsh[i] = *(const f32x4*)(mn + c); nsc[i] = *(const f32x4*)(mn + 1024 + c); } } }
        f32x4 v[4];
#pragma unroll
        for (int i = 0; i < 4; ++i) { const f32x4 gv = mg[i];
            const f32x2 ya0 = __builtin_amdgcn_cvt_pk_f32_fp8(nya[i], false), ya1 = __builtin_amdgcn_cvt_pk_f32_fp8(nya[i], true), yb0 = __builtin_amdgcn_cvt_pk_f32_fp8(nyb[i], false), yb1 = __builtin_amdgcn_cvt_pk_f32_fp8(nyb[i], true);
            const float f0 = cga * ya0[0] + cgb * yb0[0], f1 = cga * ya0[1] + cgb * yb0[1], f2 = cga * ya1[0] + cgb * yb1[0], f3 = cga * ya1[1] + cgb * yb1[1];
            v[i][0] = RES_ALPHA * nx[i][0] + gv[0] * f0; v[i][1] = RES_ALPHA * nx[i][1] + gv[1] * f1; v[i][2] = RES_ALPHA * nx[i][2] + gv[2] * f2; v[i][3] = RES_ALPHA * nx[i][3] + gv[3] * f3; }
        {   const int tn = t + tstep, tn2 = t + 2 * tstep;
            if (tn < ntok) {
#pragma unroll
                for (int i = 0; i < 4; ++i) { const int c = 256 * i + 4 * lane; nx[i] = *(const f32x4*)(X1 + (size_t)tn * D + c); nya[i] = *(const unsigned*)(YS + (size_t)ns0 * D + c); nyb[i] = *(const unsigned*)(YS + (size_t)ns1 * D + c); }
                cga = nga; cgb = ngb; }
            if (tn2 < ntok) { ns0 = tokS[2 * tn2]; ns1 = tokS[2 * tn2 + 1]; nga = tokG[2 * tn2]; ngb = tokG[2 * tn2 + 1]; } }
        float mean, rstd; ln_stats(v, mean, rstd);
        float* dst = (l == 0) ? (float*)(a->ws + WS_XC) + (size_t)t * D : a->out + (size_t)t * D;
#pragma unroll
        for (int i = 0; i < 4; ++i) { const int c = 256 * i + 4 * lane; const f32x4 gg = Lgb[64 * i + lane], bb = Lgb[256 + 64 * i + lane];
#pragma unroll
            for (int e = 0; e < 4; ++e) v[i][e] = (v[i][e] - mean) * rstd * gg[e] + bb[e];
            *(f32x4*)(dst + c) = v[i]; }
        if (l == 0) {
            ln_stats(v, mean, rstd);
            bf16_t* H = (bf16_t*)(a->ws + WS_H);
#pragma unroll
            for (int i = 0; i < 4; ++i) { const int c = 256 * i + 4 * lane; const f32x4 sh = nsh[i], sc = nsc[i];
                f32x4 o;
#pragma unroll
                for (int e = 0; e < 4; ++e) o[e] = (v[i][e] - mean) * rstd * (1.0f + sc[e]) + sh[e];
                u32x2 pk; pk.x = pack2(o[0], o[1]); pk.y = pack2(o[2], o[3]); *(u32x2*)(H + (size_t)t * D + c) = pk; }
        }
    }
}

constexpr int N_PHASES = 18;
template <int P> __device__ __forceinline__ void run_phase(AP a, unsigned char* smem, LAS unsigned char* lds, int l) {
    asm volatile("" : "+s"(a));
    if (P == 0) p0_prologue(a, smem);
    if (P == 1) p_lnmod0(a);
    if (P == 2) p1_inproj(a, smem, lds, l);
    if (P == 3) p2_mix(a, smem, lds, l);
    if (P == 4) p3_outproj(a, smem, lds, l);
    if (P == 5) p4_ln1_router(a, smem, l);
    if (P == 6) p5_dispatch(a, smem, l);
    if (P == 7) p6_gateup(a, smem, lds, l);
    if (P == 8) p7_down(a, smem, lds, l);
    if (P == 9) p8_ln2(a, smem, l);
}
#if N_LAUNCH_MODE == 1
__global__ void __launch_bounds__(NT, 2) fwd(Args a) {
    extern __shared__ __attribute__((aligned(16))) unsigned char smem[];
    LAS unsigned char* lds = (LAS unsigned char*)smem;
    if (threadIdx.x < 4) ((volatile LAS unsigned*)(lds + MISC_OFF + 768))[threadIdx.x] = 0u;
    __syncthreads();
    XcdBarrier bar = xcd_barrier_post((unsigned*)(a.ws + WS_BAR), (volatile LAS unsigned*)(lds + MISC_OFF + 768));
    AP ap = (AP)__builtin_amdgcn_kernarg_segment_ptr();
#define PROBE(P, l) do { if (PROBE_MASK & (1 << (P))) { for (int _r = 0; _r < 2; ++_r) { xcd_barrier(bar); run_phase<P>(ap, smem, lds, l); } } } while (0)
    run_phase<0>(ap, smem, lds, 0); PROBE(0, 0); xcd_barrier(bar);
    run_phase<1>(ap, smem, lds, 0); PROBE(1, 0); xcd_barrier(bar);
    for (int l = 0; l < 2; ++l) {
        run_phase<2>(ap, smem, lds, l); PROBE(2, l); xcd_barrier(bar);
        run_phase<3>(ap, smem, lds, l); PROBE(3, l); xcd_barrier(bar);
        run_phase<4>(ap, smem, lds, l); PROBE(4, l); xcd_barrier(bar);
        run_phase<5>(ap, smem, lds, l); PROBE(5, l); xcd_barrier(bar);
        run_phase<6>(ap, smem, lds, l); PROBE(6, l); xcd_barrier(bar);
        run_phase<7>(ap, smem, lds, l); PROBE(7, l); xcd_barrier(bar);
        run_phase<8>(ap, smem, lds, l); PROBE(8, l); xcd_barrier(bar);
        run_phase<9>(ap, smem, lds, l); PROBE(9, l); if (l == 0) xcd_barrier(bar);
    }
}
#else
template <int P> __global__ void __launch_bounds__(NT, 2) k_phase(Args a) {
    extern __shared__ __attribute__((aligned(16))) unsigned char smem[];
    LAS unsigned char* lds = (LAS unsigned char*)smem;
    AP ap = (AP)__builtin_amdgcn_kernarg_segment_ptr();
    run_phase<P>(ap, smem, lds, ap->ph_lo);
}
template <int P> static void launch_phase(Args a, int l, int grid, hipStream_t stream) {
    static bool attr = false;
    if (!attr) { (void)hipFuncSetAttribute((const void*)k_phase<P>, hipFuncAttributeMaxDynamicSharedMemorySize, LDS_BYTES); attr = true; }
    a.ph_lo = l; a.ph_hi = P;
    hipLaunchKernelGGL(k_phase<P>, dim3(grid), dim3(NT), LDS_BYTES, stream, a);
}
#endif

extern "C" void kernel_launch(void* const* d_in, const int* in_sizes, int n_in, void* d_out, int out_size, void* d_ws, size_t ws_size, hipStream_t stream) {
    static int grid = 0;
    if (grid == 0) {
        if (n_in != 23 || out_size != NLAT * D || ws_size < WS_END) { fprintf(stderr, "kernel_launch: unexpected shapes (n_in %d, out %d, ws %zu, need %zu)\n", n_in, out_size, ws_size, (size_t)WS_END); grid = -1; return; }
        int dev = 0, cus = 0;
        if (hipGetDevice(&dev) != hipSuccess || hipDeviceGetAttribute(&cus, hipDeviceAttributeMultiprocessorCount, dev) != hipSuccess) { grid = -1; return; }
#if N_LAUNCH_MODE == 1
        int per_cu = 0;
        if (hipFuncSetAttribute((const void*)fwd, hipFuncAttributeMaxDynamicSharedMemorySize, LDS_BYTES) != hipSuccess) { fprintf(stderr, "kernel_launch: hipFuncSetAttribute failed\n"); grid = -1; return; }
        if (hipOccupancyMaxActiveBlocksPerMultiprocessor(&per_cu, (const void*)fwd, NT, LDS_BYTES) != hipSuccess || per_cu < 1) { fprintf(stderr, "kernel_launch: occupancy query says %d\n", per_cu); }
        (void)hipGetLastError();
#endif
        grid = cus; if (grid > MAXG) grid = MAXG;
    }
    if (grid < 0) return;
    (void)hipMemsetAsync((char*)d_ws + WS_BAR, 0, 16384 + 256, stream);
    Args a{};
    for (int i = 0; i < 23; ++i) a.in[i] = (const float*)d_in[i];
    a.out = (float*)d_out; a.ws = (unsigned char*)d_ws;
#if N_LAUNCH_MODE == 1
    a.ph_lo = 0; a.ph_hi = N_PHASES;
    hipLaunchKernelGGL(fwd, dim3(grid), dim3(NT), LDS_BYTES, stream, a);
#else
    launch_phase<0>(a, 0, grid, stream);
    launch_phase<1>(a, 0, grid, stream);
    for (int l = 0; l < 2; ++l) {
        launch_phase<2>(a, l, grid, stream); launch_phase<3>(a, l, grid, stream); launch_phase<4>(a, l, grid, stream); launch_phase<5>(a, l, grid, stream);
        launch_phase<6>(a, l, grid, stream); launch_phase<7>(a, l, grid, stream); launch_phase<8>(a, l, grid, stream); launch_phase<9>(a, l, grid, stream);
    }
#endif
}
```

```cpp
#include <hip/hip_runtime.h>
#include <stdint.h>
#include <stdio.h>

#ifndef PROBE_MASK
#define PROBE_MASK 0
#endif
#ifndef PROBE_FFT_REP
#define PROBE_FFT_REP 1
#endif
#ifndef PROBE_MIX_REP
#define PROBE_MIX_REP 1
#endif
#ifndef PROBE_SGU_REP
#define PROBE_SGU_REP 1
#endif
#ifndef N_LAUNCH_MODE
#define N_LAUNCH_MODE 1
#endif

#define LAS __attribute__((address_space(3)))
typedef unsigned short bf16_t;
typedef short bf16x8 __attribute__((ext_vector_type(8)));
typedef float f32x4 __attribute__((ext_vector_type(4)));
typedef unsigned u32x4 __attribute__((ext_vector_type(4)));
typedef unsigned u32x2 __attribute__((ext_vector_type(2)));
typedef float f32x2 __attribute__((ext_vector_type(2)));
typedef int i32x4 __attribute__((ext_vector_type(4)));

constexpr int D = 1024, NBATCH = 4, SEQ = 4096, CTXL = 256;
constexpr int NLAT = NBATCH * SEQ, NCTX = NBATCH * CTXL, NTOK = NLAT + NCTX;
constexpr int ZC = 1792;
constexpr int NEXP = 32, DEXP = 512;
constexpr int NSLOT = 2 * NTOK + NEXP * 256;
constexpr int NT = 512;
constexpr int MAXG = 512;
constexpr float RES_ALPHA = 1.41421356237309515f;
constexpr int MISC_OFF = 155648;
constexpr int RIDX_OFF = 131072;
constexpr int LDS_BYTES = MISC_OFF + 1024;

constexpr size_t WS_BAR   = 0;
constexpr size_t WS_CNT   = 16384;
constexpr size_t WS_BCNT  = WS_CNT + 256;
constexpr size_t WS_MOD   = WS_BCNT + (size_t)2 * MAXG * 32 * 4;
constexpr size_t WS_ROPE  = WS_MOD + (size_t)2 * 5 * 6144 * 4;
constexpr size_t WS_TOKE  = WS_ROPE + 8192;
constexpr size_t WS_TOKR  = WS_TOKE + (size_t)NTOK * 8;
constexpr size_t WS_TOKS  = WS_TOKR + (size_t)NTOK * 8;
constexpr size_t WS_TOKG  = WS_TOKS + (size_t)NTOK * 8;
constexpr size_t WS_SLOTT = WS_TOKG + (size_t)NTOK * 8;
constexpr size_t WS_WIN   = WS_SLOTT + (size_t)NSLOT * 4;
constexpr size_t WS_WOUT  = WS_WIN + (size_t)2 * ZC * 1024 * 2;
constexpr size_t WS_WSGU  = WS_WOUT + (size_t)2 * 1024 * 1024 * 2;
constexpr size_t WS_DFTC  = WS_WSGU + (size_t)2 * 4 * 128 * 128 * 2;
constexpr size_t WS_WEXP  = WS_DFTC + (size_t)256 * 512 * 2;
constexpr size_t EXPMAT   = (size_t)NEXP * 512 * 1024;
constexpr size_t WEXP_LAYER = 3 * EXPMAT;
constexpr size_t WS_X1    = WS_WEXP + 2 * WEXP_LAYER;
constexpr size_t WS_XC    = WS_X1 + (size_t)NTOK * D * 4;
constexpr size_t WS_H     = WS_XC + (size_t)NTOK * D * 4;
constexpr size_t WS_R     = WS_H + (size_t)NTOK * D * 2;
constexpr size_t WS_Z     = WS_R;
constexpr size_t WS_AT    = WS_Z + (size_t)NTOK * ZC * 2;
constexpr size_t WS_ATC   = WS_AT + (size_t)4 * 256 * 8192 * 2;
constexpr size_t WS_VT    = WS_ATC + (size_t)4 * 256 * 512 * 2;
constexpr size_t WS_VTC   = WS_VT + (size_t)4 * 2 * 64 * 4096 * 2;
constexpr size_t WS_CAT   = WS_VTC + (size_t)4 * 2 * 64 * 256 * 2;
constexpr size_t WS_REND  = WS_CAT + (size_t)NTOK * D * 2;
constexpr size_t WS_Y     = WS_R;
constexpr size_t WS_HID   = WS_R;
constexpr size_t WS_YS    = WS_HID + (size_t)NSLOT * DEXP * 2;
constexpr size_t WS_REND2 = (WS_YS + (size_t)NSLOT * D * 2 > WS_REND) ? WS_YS + (size_t)NSLOT * D * 2 : WS_REND;
constexpr size_t WS_H8    = (WS_REND2 + 255) & ~(size_t)255;
constexpr size_t WS_END   = WS_H8 + (size_t)NTOK * D;
static_assert(WS_Y + (size_t)NTOK * D * 4 <= WS_CAT, "Y must not reach CAT");
static_assert(WS_WIN % 256 == 0 && WS_DFTC % 256 == 0 && WS_WEXP % 256 == 0 && WS_X1 % 256 == 0 && WS_H % 256 == 0 && WS_R % 256 == 0 && WS_AT % 256 == 0 && WS_CAT % 256 == 0 && WS_YS % 256 == 0, "alignment");

struct Args { const float* in[23]; float* out; unsigned char* ws; int ph_lo, ph_hi; };
#define CAS __attribute__((address_space(4)))
typedef const CAS Args* AP;

#define XB_TMO      128
#define XB_XCNT(j)  (256  + 64 * (j))
#define XB_XSUB(j)  (1280 + 64 * (j))
#define XB_XGEN(j)  (2304 + 64 * (j))
#define XB_TOP      3328
#define XB_TOPGEN   3392
#define XCD_BAR_WORDS 3456
#define XB_SPIN_CAP (1u << 18)

__device__ __forceinline__ unsigned xb_ld(unsigned* p)              { return __hip_atomic_load(p, __ATOMIC_RELAXED, __HIP_MEMORY_SCOPE_AGENT); }
__device__ __forceinline__ unsigned xb_add(unsigned* p, unsigned v) { return __hip_atomic_fetch_add(p, v, __ATOMIC_RELAXED, __HIP_MEMORY_SCOPE_AGENT); }
__device__ __forceinline__ unsigned xb_xcc_id() { return (unsigned)__builtin_amdgcn_s_getreg((3 << 11) | 20) & 0xFu; }
#define XB_SPIN(cond, bar) do { unsigned _sp = 0; while (cond) { __builtin_amdgcn_s_sleep(1); \
    if ((++_sp & 255u) == 0u) { if (xb_ld(&(bar)[XB_TMO])) break; if (_sp > XB_SPIN_CAP) { atomicAdd(&(bar)[XB_TMO], 1u); break; } } } } while (0)

struct XcdBarrier { unsigned* bar; unsigned x; volatile LAS unsigned* st; };

__device__ __forceinline__ XcdBarrier xcd_barrier_post(unsigned* bar, volatile LAS unsigned* st) {
    XcdBarrier b; b.bar = bar; b.x = (unsigned)__builtin_amdgcn_readfirstlane((int)xb_xcc_id()); b.st = st;
    if (threadIdx.x == 0) (void)xb_add(&bar[XB_XCNT(b.x)], 1u);
    return b;
}
__device__ __forceinline__ void xcd_barrier_complete(unsigned* bar, unsigned x, unsigned& nloc, unsigned& nx) {
    const unsigned G = gridDim.x * gridDim.y * gridDim.z;
    unsigned sum, cnt, mine, sp = 0u;
    for (;;) {
        sum = 0u; cnt = 0u; mine = 0u;
#pragma unroll
        for (unsigned j = 0; j < 16; ++j) { const unsigned c = xb_ld(&bar[XB_XCNT(j)]); sum += c; cnt += (c > 0u) ? 1u : 0u; mine = (j == x) ? c : mine; }
        if (sum == G) break;
        __builtin_amdgcn_s_sleep(1);
        if ((++sp & 255u) == 0u) { if (xb_ld(&bar[XB_TMO])) break; if (sp > XB_SPIN_CAP) { atomicAdd(&bar[XB_TMO], 1u); break; } }
    }
    nloc = mine > 0u ? mine : 1u; nx = cnt > 0u ? cnt : 1u;
}
__device__ __forceinline__ void xcd_barrier(const XcdBarrier& b) {
    asm volatile("s_waitcnt vmcnt(0)" ::: "memory");
    __syncthreads();
    if (threadIdx.x == 0) {
        unsigned* bar = b.bar;
        unsigned bx = b.x;
        asm volatile("" : "+s"(bar), "+s"(bx));
        __builtin_amdgcn_s_waitcnt(0);
        unsigned nloc = b.st[0], nx = b.st[1];
        if (nloc == 0u) { xcd_barrier_complete(bar, bx, nloc, nx); b.st[0] = nloc; b.st[1] = nx; }
        const unsigned old = xb_add(&bar[XB_XSUB(bx)], 1u);
        const unsigned gen = old / nloc;
        if (old + 1u == (gen + 1u) * nloc) {
            __builtin_amdgcn_fence(__ATOMIC_RELEASE, "agent");
            asm volatile("s_waitcnt vmcnt(0)" ::: "memory");
            const unsigned og = xb_add(&bar[XB_TOP], 1u);
            const unsigned tg = og / nx;
            if (og + 1u == (tg + 1u) * nx) xb_add(&bar[XB_TOPGEN], 1u);
            else XB_SPIN(xb_ld(&bar[XB_TOPGEN]) == tg, bar);
            __builtin_amdgcn_fence(__ATOMIC_ACQUIRE, "agent");
            xb_add(&bar[XB_XGEN(bx)], 1u);
            asm volatile("s_waitcnt vmcnt(0)" ::: "memory");
        } else {
            XB_SPIN(xb_ld(&bar[XB_XGEN(bx)]) == gen, bar);
            __builtin_amdgcn_fence(__ATOMIC_ACQUIRE, "agent");
            asm volatile("s_waitcnt vmcnt(0)" ::: "memory");
        }
    }
    __syncthreads();
}

__device__ __forceinline__ int tid_opaque() { int t = threadIdx.x; asm volatile("" : "+v"(t)); return t; }
__device__ __forceinline__ float bf2f(bf16_t v) { return __uint_as_float(((unsigned)v) << 16); }
__device__ __forceinline__ bf16_t f2bf(float f) { return __builtin_bit_cast(unsigned short, (__bf16)f); }
typedef __bf16 hwbf16x2 __attribute__((ext_vector_type(2)));
__device__ __forceinline__ unsigned pack2(float a, float b) { return __builtin_bit_cast(unsigned, __builtin_convertvector((f32x2){a, b}, hwbf16x2)); }
__device__ __forceinline__ unsigned pack4_fp8(float a, float b, float c, float d) {
    a = __builtin_amdgcn_fmed3f(a, -448.f, 448.f); b = __builtin_amdgcn_fmed3f(b, -448.f, 448.f); c = __builtin_amdgcn_fmed3f(c, -448.f, 448.f); d = __builtin_amdgcn_fmed3f(d, -448.f, 448.f);
    int p = __builtin_amdgcn_cvt_pk_fp8_f32(a, b, 0, false); p = __builtin_amdgcn_cvt_pk_fp8_f32(c, d, p, true); return (unsigned)p; }
__device__ __forceinline__ float lo2f(unsigned w) { return __uint_as_float(w << 16); }
__device__ __forceinline__ float hi2f(unsigned w) { return __uint_as_float(w & 0xffff0000u); }
template <int CTRL> __device__ __forceinline__ float dpp_mov(float v) { return __builtin_bit_cast(float, __builtin_amdgcn_update_dpp(0, __builtin_bit_cast(int, v), CTRL, 0xf, 0xf, true)); }
__device__ __forceinline__ float row_sum16(float v) {
    v += dpp_mov<0xB1>(v);
    v += dpp_mov<0x4E>(v);
    v += dpp_mov<0x141>(v);
    v += dpp_mov<0x140>(v);
    return v;
}
__device__ __forceinline__ float row_max16(float v) {
    v = fmaxf(v, dpp_mov<0xB1>(v)); v = fmaxf(v, dpp_mov<0x4E>(v)); v = fmaxf(v, dpp_mov<0x141>(v)); v = fmaxf(v, dpp_mov<0x140>(v));
    return v;
}
__device__ __forceinline__ float wave_sum(float v) {
    v = row_sum16(v);
    const int iv = __builtin_bit_cast(int, v);
    const float a0 = __builtin_bit_cast(float, __builtin_amdgcn_readlane(iv, 0)), a1 = __builtin_bit_cast(float, __builtin_amdgcn_readlane(iv, 16));
    const float a2 = __builtin_bit_cast(float, __builtin_amdgcn_readlane(iv, 32)), a3 = __builtin_bit_cast(float, __builtin_amdgcn_readlane(iv, 48));
    return (a0 + a1) + (a2 + a3);
}
__device__ __forceinline__ float gelu_erf(float v) {
    const float t = __builtin_amdgcn_rcpf(fabsf(v) * 0.2316418882f + 1.0f);
    float q = t * 0.5307027145f + (-0.7265760135f); q = q * t + 0.7107068705f; q = q * t + (-0.142248368f); q = q * t + 0.127414796f; q = q * t;
    const float m = v * (q * __builtin_amdgcn_exp2f((v * v) * (-0.72134752044f)));
    return v < 0.f ? m : v - m;
}
__device__ __forceinline__ float silu_f(float x) { return x * __builtin_amdgcn_rcpf(1.0f + __expf(-x)); }

__device__ __forceinline__ void ln_stats(const f32x4 (&v)[4], float& mean, float& rstd) {
    float s = 0.f;
#pragma unroll
    for (int i = 0; i < 4; ++i) s += (v[i][0] + v[i][1]) + (v[i][2] + v[i][3]);
    s = wave_sum(s); mean = s * (1.0f / 1024.0f);
    float q = 0.f;
#pragma unroll
    for (int i = 0; i < 4; ++i)
#pragma unroll
        for (int e = 0; e < 4; ++e) { const float d = v[i][e] - mean; q += d * d; }
    q = wave_sum(q); rstd = 1.0f / sqrtf(q * (1.0f / 1024.0f) + 1e-6f);
}

template <int BN> struct MfmaLayout {
    static constexpr int FG = BN / 128, NI = 4, NJ = 2 * FG;
    static constexpr bool PAIR8 = false;
    int rbase, cbase;
    __device__ __forceinline__ int row(int i) const { return rbase + 16 * i; }
    __device__ __forceinline__ int col(int jj) const { return (jj / FG) * (BN / 2) + (jj % FG) * 16 + cbase; }
};

__device__ __forceinline__ void glds16(const bf16_t* g, LAS unsigned char* l) {
    __builtin_amdgcn_global_load_lds((const unsigned*)g, (LAS unsigned*)l, 16, 0, 0);
}

template <int BN, bool GATHER, class Epi>
__device__ __forceinline__ void gemm_tile(LAS unsigned char* lds, const bf16_t* A, int lda, const int* rowidx, int valid_rows,
                                          const bf16_t* B0, const bf16_t* B1, int ldb, int K, const Epi& epi) {
    constexpr int A_B = 16384, B_B = BN * 128, STAGE = A_B + B_B, NBL = BN / 64;
    const int tid = tid_opaque(), lane = tid & 63, wid = __builtin_amdgcn_readfirstlane(tid >> 6);
    const bf16_t* ap[2]; const bf16_t* bp[NBL];
#pragma unroll
    for (int i = 0; i < 2; ++i) {
        const int P = i * 512 + tid, row = P >> 3, c = (P & 7) ^ ((row >> 1) & 7);
        size_t ro;
        if (GATHER) ro = (size_t)(row < valid_rows ? rowidx[row] : 0) * (size_t)lda; else ro = (size_t)row * (size_t)lda;
        ap[i] = A + ro + c * 8;
    }
#pragma unroll
    for (int i = 0; i < NBL; ++i) {
        const int P = i * 512 + tid, row = P >> 3, c = (P & 7) ^ ((row >> 1) & 7);
        const bf16_t* base = (row < BN / 2) ? (B0 + (size_t)row * ldb) : (B1 + (size_t)(row - BN / 2) * ldb);
        bp[i] = base + c * 8;
    }
    const int nk = K / 64;
#define GT_STAGE(buf, k0) do { \
        _Pragma("unroll") for (int _i = 0; _i < 2; ++_i) glds16(ap[_i] + (k0), lds + (buf) * STAGE + _i * 8192 + wid * 1024); \
        _Pragma("unroll") for (int _i = 0; _i < NBL; ++_i) glds16(bp[_i] + (k0), lds + (buf) * STAGE + A_B + _i * 8192 + wid * 1024); } while (0)

    typedef MfmaLayout<BN> Lay;
    constexpr int FG = Lay::FG;
    const int fr = lane & 15, g = lane >> 4, wr = wid >> 2, wc = wid & 3;
    Lay lay; lay.rbase = wr * 64 + fr; lay.cbase = wc * 16 * FG + 4 * g;
    f32x4 acc[Lay::NI][Lay::NJ];
#pragma unroll
    for (int i = 0; i < Lay::NI; ++i)
#pragma unroll
        for (int j = 0; j < Lay::NJ; ++j) acc[i][j] = (f32x4){0.f, 0.f, 0.f, 0.f};
    int aoff[4], boff[Lay::NJ];
#pragma unroll
    for (int m = 0; m < 4; ++m) { const int row = wr * 64 + m * 16 + fr; aoff[m] = row * 128 + ((g ^ ((row >> 1) & 7)) << 4); }
#pragma unroll
    for (int jj = 0; jj < Lay::NJ; ++jj) { const int row = (jj / FG) * (BN / 2) + wc * 16 * FG + (jj % FG) * 16 + fr; boff[jj] = A_B + row * 128 + ((g ^ ((row >> 1) & 7)) << 4); }
    GT_STAGE(0, 0);
    asm volatile("s_waitcnt vmcnt(0)" ::: "memory"); __syncthreads();
    for (int kt = 0; kt < nk; ++kt) {
        if (kt + 1 < nk) GT_STAGE((kt + 1) & 1, (kt + 1) * 64);
        const LAS unsigned char* sa = lds + (kt & 1) * STAGE;
#pragma unroll
        for (int ks = 0; ks < 2; ++ks) {
            bf16x8 af[4], bfv[Lay::NJ];
#pragma unroll
            for (int m = 0; m < 4; ++m) af[m] = *(const LAS bf16x8*)(sa + (aoff[m] ^ (ks << 6)));
#pragma unroll
            for (int jj = 0; jj < Lay::NJ; ++jj) bfv[jj] = *(const LAS bf16x8*)(sa + (boff[jj] ^ (ks << 6)));
#pragma unroll
            for (int m = 0; m < 4; ++m)
#pragma unroll
                for (int jj = 0; jj < Lay::NJ; ++jj) acc[m][jj] = __builtin_amdgcn_mfma_f32_16x16x32_bf16(bfv[jj], af[m], acc[m][jj], 0, 0, 0);
        }
        asm volatile("s_waitcnt vmcnt(0)" ::: "memory"); __syncthreads();
    }
    epi.run(acc, lay);
#undef GT_STAGE
}

namespace g256 {
constexpr int BK = 64, HALF = 128, HTB = HALF * BK * 2, STAGE_BYTES = 8 * HTB;
__device__ __forceinline__ int lds_byte(int r, int c) { const int st = (r >> 4) * 2 + (c >> 5), rr = r & 15, cc = c & 31, ob = rr * 64 + cc * 2; return st * 1024 + (ob ^ (((ob >> 9) & 1) << 5)); }
__device__ __forceinline__ int perm32(int rho) { const int n = rho >> 4, i = rho & 15; return 8 * (i >> 2) + 4 * n + (i & 3); }
__device__ __forceinline__ void stage_rc(int b, int& R, int& C) { const int st = b / 1024, sb = b % 1024, swz = sb ^ (((sb >> 9) & 1) << 5); R = (st >> 1) * 16 + swz / 64; C = (st & 1) * 32 + (swz % 64) / 2; }
struct Lay {
    static constexpr int NI = 8, NJ = 4;
    static constexpr bool PAIR8 = true;
    int rbase, cbase;
    __device__ __forceinline__ int row(int i) const { return (i >> 2) * 128 + (i & 3) * 16 + rbase; }
    __device__ __forceinline__ int col(int j) const { return (j >> 1) * 128 + (j & 1) * 4 + cbase; }
};
template <class Epi> struct Unit { const bf16_t* A; const bf16_t* B0; const bf16_t* B1; const LAS int* ridx; int valid; Epi epi; };

template <class Sched>
__device__ __forceinline__ void gemm_phase(LAS unsigned char* lds, const int K, const Sched& S) {
    typedef typename Sched::Epi Epi;
    const int tid = tid_opaque(), wid = __builtin_amdgcn_readfirstlane(tid >> 6), lane = tid & 63, wr = wid >> 2, wc = wid & 3, fr = lane & 15, fq = lane >> 4;
    int nt = K / BK; asm volatile("" : "+s"(nt));
    int sR[2], sC[2];
#pragma unroll
    for (int i = 0; i < 2; ++i) stage_rc(tid * 16 + i * 8192, sR[i], sC[i]);
    unsigned voffB[2];
#pragma unroll
    for (int i = 0; i < 2; ++i) voffB[i] = (unsigned)(((sR[i] & ~31) + perm32(sR[i] & 31)) * K + sC[i]) * 2u;
    const size_t kstep = (size_t)(BK * 2);
    const unsigned ldsw = (unsigned)wid * 1024u;
    const int aoff = lds_byte(wr * 64 + fr, fq * 8), boff = lds_byte(wc * 32 + fr, fq * 8);
#define G2_SA(b, h) (((b) * 2 + (h)) * HTB)
#define G2_SB(b, h) ((4 + (b) * 2 + (h)) * HTB)
#define G2_STAGE(bufoff, gbase, v0, v1) do { \
        __builtin_amdgcn_global_load_lds((const unsigned*)((const char*)(gbase) + (v0)), (LAS unsigned*)(lds + (bufoff) + ldsw), 16, 0, 0); \
        __builtin_amdgcn_global_load_lds((const unsigned*)((const char*)(gbase) + (v1)), (LAS unsigned*)(lds + (bufoff) + ldsw + 8192), 16, 0, 0); } while (0)
#define G2_LDA(dst, b, h) do { _Pragma("unroll") for (int m = 0; m < 4; ++m) _Pragma("unroll") for (int k = 0; k < 2; ++k) dst[m][k] = *(const LAS bf16x8*)(lds + G2_SA(b, h) + aoff + m * 2048 + k * 1024); } while (0)
#define G2_LDB(dst, b, h) do { _Pragma("unroll") for (int n = 0; n < 2; ++n) _Pragma("unroll") for (int k = 0; k < 2; ++k) dst[n][k] = *(const LAS bf16x8*)(lds + G2_SB(b, h) + boff + n * 2048 + k * 1024); } while (0)
#define G2_MMA(ai, bj, At, Bt) do { __builtin_amdgcn_s_setprio(1); _Pragma("unroll") for (int m = 0; m < 4; ++m) _Pragma("unroll") for (int n = 0; n < 2; ++n) _Pragma("unroll") for (int k = 0; k < 2; ++k) { \
        if (Sched::FP8) { const i32x4 _b = __builtin_bit_cast(i32x4, Bt[n][k]), _a = __builtin_bit_cast(i32x4, At[m][k]);     \
            acc[(ai) * 4 + m][(bj) * 2 + n] = __builtin_amdgcn_mfma_f32_16x16x32_fp8_fp8(((long)(unsigned)_b[1] << 32) | (unsigned)_b[0], ((long)(unsigned)_a[1] << 32) | (unsigned)_a[0], acc[(ai) * 4 + m][(bj) * 2 + n], 0, 0, 0); \
            acc[(ai) * 4 + m][(bj) * 2 + n] = __builtin_amdgcn_mfma_f32_16x16x32_fp8_fp8(((long)(unsigned)_b[3] << 32) | (unsigned)_b[2], ((long)(unsigned)_a[3] << 32) | (unsigned)_a[2], acc[(ai) * 4 + m][(bj) * 2 + n], 0, 0, 0); } \
        else acc[(ai) * 4 + m][(bj) * 2 + n] = __builtin_amdgcn_mfma_f32_16x16x32_bf16(Bt[n][k], At[m][k], acc[(ai) * 4 + m][(bj) * 2 + n], 0, 0, 0); } __builtin_amdgcn_s_setprio(0); } while (0)
#define G2_WAIT_V(n) asm volatile("s_waitcnt vmcnt(" #n ")" ::: "memory")
#define G2_WAIT_L(n) asm volatile("s_waitcnt lgkmcnt(" #n ")" ::: "memory")
#define G2_BAR __builtin_amdgcn_s_barrier()
#define G2_SCHED __builtin_amdgcn_sched_barrier(0)
#define G2_VOFFA(U, dst) do { _Pragma("unroll") for (int _h = 0; _h < 2; ++_h) _Pragma("unroll") for (int _i = 0; _i < 2; ++_i) { const int _row = _h * 128 + sR[_i]; \
        int _tok = _row; if (Sched::GATHER) _tok = (_row < (U).valid) ? (U).ridx[_row] : 0; dst[_h][_i] = (unsigned)(_tok * K + sC[_i]) * 2u; } } while (0)
    Unit<Epi> cur, nxt; int ui = 0;
    if (!S.get(0, cur)) return;
    f32x4 acc[8][4];
#pragma unroll
    for (int i = 0; i < 8; ++i)
#pragma unroll
        for (int j = 0; j < 4; ++j) acc[i][j] = (f32x4){0.f, 0.f, 0.f, 0.f};
    bf16x8 At[4][2], B0[2][2], B1[2][2];
    unsigned cvA[2][2], nvA[2][2];
    G2_VOFFA(cur, cvA);
    const char* cA = (const char*)cur.A; const char* cB0 = (const char*)cur.B0; const char* cB1 = (const char*)cur.B1;
    G2_STAGE(G2_SB(0, 0), cB0, voffB[0], voffB[1]); G2_STAGE(G2_SB(0, 1), cB1, voffB[0], voffB[1]); G2_STAGE(G2_SA(0, 0), cA, cvA[0][0], cvA[0][1]); G2_STAGE(G2_SA(0, 1), cA, cvA[1][0], cvA[1][1]);
    if (wr == 1) G2_BAR;
    G2_WAIT_V(2); G2_BAR;
    G2_STAGE(G2_SB(1, 0), cB0 + kstep, voffB[0], voffB[1]); G2_STAGE(G2_SA(1, 0), cA + kstep, cvA[0][0], cvA[0][1]); G2_STAGE(G2_SB(1, 1), cB1 + kstep, voffB[0], voffB[1]);
    G2_WAIT_V(6); G2_BAR;
    for (;;) {
        const bool has_next = S.get(ui + 1, nxt);
        if (Sched::GATHER) {
            if (has_next) { G2_VOFFA(nxt, nvA); }
            else {
#pragma unroll
                for (int h = 0; h < 2; ++h) { nvA[h][0] = cvA[h][0]; nvA[h][1] = cvA[h][1]; } }
        }
        const char* nA = has_next ? (const char*)nxt.A : cA; const char* nB0 = has_next ? (const char*)nxt.B0 : cB0; const char* nB1 = has_next ? (const char*)nxt.B1 : cB1;
#pragma unroll 1
        for (int t = 0; t < nt; t += 2) {
            const bool last = (t == nt - 2);
            const char* a1 = cA + (size_t)(t + 1) * kstep;
            const char* a2 = last ? nA : cA + (size_t)(t + 2) * kstep;
            const char* b20 = last ? nB0 : cB0 + (size_t)(t + 2) * kstep; const char* b21 = last ? nB1 : cB1 + (size_t)(t + 2) * kstep;
#define x00 ((Sched::GATHER && last) ? nvA[0][0] : cvA[0][0])
#define x01 ((Sched::GATHER && last) ? nvA[0][1] : cvA[0][1])
#define x10 ((Sched::GATHER && last) ? nvA[1][0] : cvA[1][0])
#define x11 ((Sched::GATHER && last) ? nvA[1][1] : cvA[1][1])
            G2_LDB(B0, 0, 0); G2_LDB(B1, 0, 1); G2_SCHED; G2_LDA(At, 0, 0); G2_STAGE(G2_SA(1, 1), a1, cvA[1][0], cvA[1][1]);
            G2_WAIT_V(8); G2_WAIT_L(0); G2_BAR; G2_MMA(0, 0, At, B0); G2_MMA(0, 1, At, B1); G2_BAR; G2_SCHED;
            G2_LDA(At, 0, 1); G2_STAGE(G2_SB(0, 0), b20, voffB[0], voffB[1]); G2_STAGE(G2_SB(0, 1), b21, voffB[0], voffB[1]); G2_STAGE(G2_SA(0, 0), a2, x00, x01);
            G2_WAIT_V(8); G2_WAIT_L(0); G2_BAR; G2_MMA(1, 0, At, B0); G2_MMA(1, 1, At, B1); G2_BAR; G2_SCHED;
            G2_LDB(B0, 1, 0); G2_LDB(B1, 1, 1); G2_SCHED; G2_LDA(At, 1, 0); G2_STAGE(G2_SA(0, 1), a2, x10, x11);
            G2_WAIT_V(8); G2_WAIT_L(0); G2_BAR; G2_MMA(0, 0, At, B0); G2_MMA(0, 1, At, B1); G2_BAR; G2_SCHED;
            G2_LDA(At, 1, 1); G2_STAGE(G2_SB(1, 0), b20 + kstep, voffB[0], voffB[1]); G2_STAGE(G2_SB(1, 1), b21 + kstep, voffB[0], voffB[1]); G2_STAGE(G2_SA(1, 0), a2 + kstep, x00, x01);
            G2_WAIT_V(8); G2_WAIT_L(0); G2_BAR; G2_MMA(1, 0, At, B0); G2_MMA(1, 1, At, B1); G2_BAR; G2_SCHED;
        }
        if (wr == 0) G2_BAR;
        { Lay lay; int rbv = wr * 64 + fr, cbv = wc * 32 + 8 * fq; asm volatile("" : "+v"(rbv), "+v"(cbv));
          lay.rbase = rbv; lay.cbase = cbv; cur.epi.run(acc, lay); }
        if (!has_next) break;
#pragma unroll
        for (int i = 0; i < 8; ++i)
#pragma unroll
            for (int j = 0; j < 4; ++j) acc[i][j] = (f32x4){0.f, 0.f, 0.f, 0.f};
        cur = nxt; cA = nA; cB0 = nB0; cB1 = nB1; ++ui;
        if (wr == 1) G2_BAR;
        if (Sched::GATHER) {
#pragma unroll
            for (int h = 0; h < 2; ++h) { cvA[h][0] = nvA[h][0]; cvA[h][1] = nvA[h][1]; } }
    }
#undef x00
#undef x01
#undef x10
#undef x11
    G2_WAIT_V(0);
    G2_BAR;
#undef G2_SA
#undef G2_SB
#undef G2_STAGE
#undef G2_LDA
#undef G2_LDB
#undef G2_MMA
#undef G2_WAIT_V
#undef G2_WAIT_L
#undef G2_BAR
#undef G2_SCHED
#undef G2_VOFFA
}
}

struct EpiF32 {
    float* C; int ld;
    template <class L> __device__ __forceinline__ void run(const f32x4 (&acc)[L::NI][L::NJ], const L& lay) const {
#pragma unroll
        for (int i = 0; i < L::NI; ++i)
#pragma unroll
            for (int j = 0; j < L::NJ; ++j) *(f32x4*)(C + (size_t)lay.row(i) * ld + lay.col(j)) = acc[i][j];
    }
};
struct EpiBf16 {
    bf16_t* C; int ld; float scale;
    template <class L> __device__ __forceinline__ void run(const f32x4 (&acc)[L::NI][L::NJ], const L& lay) const {
#pragma unroll
        for (int i = 0; i < L::NI; ++i) {
            if (L::PAIR8) {
#pragma unroll
                for (int j = 0; j < L::NJ; j += 2) { const f32x4 p = acc[i][j] * scale, q = acc[i][j + 1] * scale; u32x4 w; w.x = pack2(p[0], p[1]); w.y = pack2(p[2], p[3]); w.z = pack2(q[0], q[1]); w.w = pack2(q[2], q[3]);
                    *(u32x4*)(C + (size_t)lay.row(i) * ld + lay.col(j)) = w; }
            } else {
#pragma unroll
                for (int j = 0; j < L::NJ; ++j) { const f32x4 p = acc[i][j] * scale; u32x2 w; w.x = pack2(p[0], p[1]); w.y = pack2(p[2], p[3]);
                    *(u32x2*)(C + (size_t)lay.row(i) * ld + lay.col(j)) = w; }
            }
        }
    }
};
struct EpiFp8 {
    unsigned char* C; int ld; float scale;
    template <class L> __device__ __forceinline__ void run(const f32x4 (&acc)[L::NI][L::NJ], const L& lay) const {
        static_assert(L::PAIR8, "written for the paired-column layout");
#pragma unroll
        for (int i = 0; i < L::NI; ++i)
#pragma unroll
            for (int j = 0; j < L::NJ; j += 2) { const f32x4 p = acc[i][j] * scale, q = acc[i][j + 1] * scale; u32x2 w; w.x = pack4_fp8(p[0], p[1], p[2], p[3]); w.y = pack4_fp8(q[0], q[1], q[2], q[3]);
                *(u32x2*)(C + (size_t)lay.row(i) * ld + lay.col(j)) = w; }
    }
};
struct EpiGateUp8 {
    unsigned char* C; int ld;
    template <class L> __device__ __forceinline__ void run(const f32x4 (&acc)[L::NI][L::NJ], const L& lay) const {
        static_assert(L::PAIR8 && L::NJ == 4, "written for the paired-column 256x256 layout");
#pragma unroll
        for (int i = 0; i < L::NI; ++i) {
            const f32x4 g0 = acc[i][0] * (1.0f / 32.0f), g1 = acc[i][1] * (1.0f / 32.0f), u0 = acc[i][2] * (1.0f / 32.0f), u1 = acc[i][3] * (1.0f / 32.0f);
            u32x2 w; w.x = pack4_fp8(silu_f(g0[0]) * u0[0], silu_f(g0[1]) * u0[1], silu_f(g0[2]) * u0[2], silu_f(g0[3]) * u0[3]);
            w.y = pack4_fp8(silu_f(g1[0]) * u1[0], silu_f(g1[1]) * u1[1], silu_f(g1[2]) * u1[2], silu_f(g1[3]) * u1[3]);
            *(u32x2*)(C + (size_t)lay.row(i) * ld + lay.col(0)) = w;
        }
    }
};
struct EpiGateUp {
    bf16_t* C; int ld;
    template <class L> __device__ __forceinline__ void run(const f32x4 (&acc)[L::NI][L::NJ], const L& lay) const {
#pragma unroll
        for (int i = 0; i < L::NI; ++i) {
            if (L::PAIR8 && L::NJ == 4) {
                const f32x4 g0 = acc[i][0], g1 = acc[i][1], u0 = acc[i][2], u1 = acc[i][3];
                u32x4 w; w.x = pack2(silu_f(g0[0]) * u0[0], silu_f(g0[1]) * u0[1]); w.y = pack2(silu_f(g0[2]) * u0[2], silu_f(g0[3]) * u0[3]);
                w.z = pack2(silu_f(g1[0]) * u1[0], silu_f(g1[1]) * u1[1]); w.w = pack2(silu_f(g1[2]) * u1[2], silu_f(g1[3]) * u1[3]);
                *(u32x4*)(C + (size_t)lay.row(i) * ld + lay.col(0)) = w;
            } else {
#pragma unroll
                for (int j = 0; j < L::NJ / 2; ++j) { const f32x4 gt = acc[i][j], up = acc[i][j + L::NJ / 2];
                    u32x2 w; w.x = pack2(silu_f(gt[0]) * up[0], silu_f(gt[1]) * up[1]); w.y = pack2(silu_f(gt[2]) * up[2], silu_f(gt[3]) * up[3]);
                    *(u32x2*)(C + (size_t)lay.row(i) * ld + lay.col(j)) = w; }
            }
        }
    }
};
struct EpiInProj {
    bf16_t* Zt;
    bf16_t* tF;
    bf16_t* tV;
    int n0, pos0, n;
    template <class L> __device__ __forceinline__ void run(const f32x4 (&acc)[L::NI][L::NJ], const L& lay) const {
        static_assert(L::PAIR8, "written for the paired-column layout");
#pragma unroll
        for (int i = 0; i < L::NI; ++i)
#pragma unroll
            for (int j = 0; j < L::NJ; j += 2) {
                const int r = lay.row(i), cl = lay.col(j), c = n0 + cl;
                const f32x4 v0 = acc[i][j], v1 = acc[i][j + 1];
                if (c < 512) {
                    const int part = c >> 8, ch = c & 255;
#pragma unroll
                    for (int e = 0; e < 4; ++e) { tF[((size_t)(ch + e) * 2 + part) * n + pos0 + r] = f2bf(v0[e]); tF[((size_t)(ch + 4 + e) * 2 + part) * n + pos0 + r] = f2bf(v1[e]); }
                } else {
                    u32x4 w; w.x = pack2(v0[0], v0[1]); w.y = pack2(v0[2], v0[3]); w.z = pack2(v1[0], v1[1]); w.w = pack2(v1[2], v1[3]);
                    *(u32x4*)(Zt + (size_t)r * ZC + cl) = w;
                    if (c >= 896 && c < 1024) {
#pragma unroll
                        for (int e = 0; e < 4; ++e) { tV[(size_t)(c - 896 + e) * n + pos0 + r] = f2bf(v0[e]); tV[(size_t)(c - 896 + 4 + e) * n + pos0 + r] = f2bf(v1[e]); }
                    }
                }
            }
    }
};

constexpr int U_ADA = 192, U_WIN = 2 * 16 * 28, U_WOUT = 2 * 16 * 16, U_SGU = 32, U_DFT = 256, U_ROPE = 1, U_EXP = 3 * 32 * 32;
constexpr int LDS_SIL = 0, LDS_RED = 20480, LDS_TILE = 32768, LDS_T64 = 49408, LDS_CTAB = 50176;

__device__ __forceinline__ void ada_unit(AP a, unsigned char* lds, int u) {
    float* sil = (float*)(lds + LDS_SIL); float* red = (float*)(lds + LDS_RED);
    const int tid = tid_opaque(), lane = tid & 63, w = tid >> 6;
    const int l = u / 96, cg = u % 96;
    for (int i = tid; i < 5120; i += NT) { const int r = i >> 10, k = i & 1023; const float v = (r < 4) ? a->in[1][r * 1024 + k] : a->in[3][k]; sil[i] = v / (1.0f + expf(-v)); }
    __syncthreads();
    const float* W = a->in[4] + (size_t)l * 1024 * 6144 + cg * 64 + lane;
    float acc[5] = {0.f, 0.f, 0.f, 0.f, 0.f};
#pragma unroll 32
    for (int k = w * 128; k < w * 128 + 128; ++k) { const float wv = W[(size_t)k * 6144];
#pragma unroll
        for (int r = 0; r < 5; ++r) acc[r] += sil[r * 1024 + k] * wv; }
#pragma unroll
    for (int r = 0; r < 5; ++r) red[(w * 5 + r) * 64 + lane] = acc[r];
    __syncthreads();
    if (tid < 320) { const int r = tid >> 6; float s = 0.f;
#pragma unroll
        for (int ww = 0; ww < 8; ++ww) s += red[(ww * 5 + r) * 64 + lane];
        const int j = cg * 64 + lane; ((float*)(a->ws + WS_MOD))[(size_t)(l * 5 + r) * 6144 + j] = s + a->in[5][l * 6144 + j]; }
    __syncthreads();
}

__device__ __forceinline__ void tile_store_T(const float* tile, bf16_t* dst, int ldd) {
    const int tid = tid_opaque(), n = tid >> 3, kc = tid & 7;
    u32x4 w;
    w.x = pack2(tile[(kc * 8 + 0) * 65 + n], tile[(kc * 8 + 1) * 65 + n]); w.y = pack2(tile[(kc * 8 + 2) * 65 + n], tile[(kc * 8 + 3) * 65 + n]);
    w.z = pack2(tile[(kc * 8 + 4) * 65 + n], tile[(kc * 8 + 5) * 65 + n]); w.w = pack2(tile[(kc * 8 + 6) * 65 + n], tile[(kc * 8 + 7) * 65 + n]);
    *(u32x4*)(dst + (size_t)n * ldd + kc * 8) = w;
}
__device__ __forceinline__ void tile_load(float* tile, const float* src, int lds_) {
    const int tid = tid_opaque();
#pragma unroll
    for (int i = 0; i < 2; ++i) { const int row = (tid >> 4) + 32 * i, c4 = (tid & 15) * 4; const f32x4 v = *(const f32x4*)(src + (size_t)row * lds_ + c4);
        tile[row * 65 + c4 + 0] = v[0]; tile[row * 65 + c4 + 1] = v[1]; tile[row * 65 + c4 + 2] = v[2]; tile[row * 65 + c4 + 3] = v[3]; }
}

__device__ __forceinline__ void mm64_f32(const float* tA, int lda, const float* tB, int ldb, int K, float* out) {
    const int tid = tid_opaque(), lane = tid & 63, w = tid >> 6, fr = lane & 15, g = lane >> 4, mi = w >> 1, nj = 2 * (w & 1);
    f32x4 acc0 = (f32x4){0.f, 0.f, 0.f, 0.f}, acc1 = (f32x4){0.f, 0.f, 0.f, 0.f};
    const float* pa = tA + (16 * mi + fr) * lda + g; const float* pb = tB + g * ldb + 16 * nj + fr;
#pragma unroll 4
    for (int k0 = 0; k0 < K; k0 += 4) { const float av = pa[k0], b0 = pb[k0 * ldb], b1 = pb[k0 * ldb + 16];
        acc0 = __builtin_amdgcn_mfma_f32_16x16x4f32(av, b0, acc0, 0, 0, 0); acc1 = __builtin_amdgcn_mfma_f32_16x16x4f32(av, b1, acc1, 0, 0, 0); }
#pragma unroll
    for (int r = 0; r < 4; ++r) { out[(16 * mi + 4 * g + r) * 65 + 16 * nj + fr] = acc0[r]; out[(16 * mi + 4 * g + r) * 65 + 16 * nj + 16 + fr] = acc1[r]; }
}

__device__ __forceinline__ void win_unit(AP a, unsigned char* lds, int u) {
    float* tile = (float*)(lds + LDS_TILE); float* T = (float*)(lds + LDS_T64);
    const int tid = tid_opaque();
    const int l = u / 448, r = u % 448, kb = r / 28, nb = r % 28;
    const float* Win = a->in[6] + (size_t)l * 1024 * 1536;
    const int srccol = (nb >= 8) ? nb * 64 - 256 : (nb & 3) * 64;
    tile_load(tile, Win + (size_t)(kb * 64) * 1536 + srccol, 1536);
    if (nb < 8 && tid < 64) { T[tid] = cospif((float)tid / 32.0f); T[64 + tid] = sinpif((float)tid / 32.0f); }
    __syncthreads();
    bf16_t* dst = (bf16_t*)(a->ws + WS_WIN) + ((size_t)l * ZC + nb * 64) * 1024 + kb * 64;
    if (nb >= 8) tile_store_T(tile, dst, 1024);
    else {
        const int part = nb >> 2;
        float* Tm = (float*)(lds + 65536); float* out = (float*)(lds + 98304);
        for (int i = tid; i < 4096; i += NT) { const int c = i >> 6, cp = i & 63; const float t = T[part * 64 + ((c * cp) & 63)]; Tm[i] = (part ? -t : t) * 0.125f; }
        __syncthreads();
        mm64_f32(tile, 65, Tm, 64, 64, out);
        __syncthreads();
        tile_store_T(out, dst, 1024);
    }
    __syncthreads();
}

__device__ __forceinline__ void wout_unit(AP a, unsigned char* lds, int u) {
    float* tile = (float*)(lds + LDS_TILE);
    __syncthreads();
    const int tid = tid_opaque();
    const int l = u / 256, r = u % 256, kb = r / 16, nb = r % 16;
    const float* Wo = a->in[13] + (size_t)l * 1024 * 1024;
    const int n = tid & 63, kq = __builtin_amdgcn_readfirstlane(tid >> 6);
    if (kb < 4) {
        float* tA = (float*)lds; float* tB = (float*)(lds + 65536);
        const float* wf = a->in[7] + (size_t)l * 256 * 256 + (size_t)(kb * 64) * 256;
        __syncthreads();
        f32x4 va[8], vb[8];
#pragma unroll
        for (int i = 0; i < 8; ++i) { const int q = tid + 512 * i; va[i] = *(const f32x4*)(wf + (size_t)q * 4); vb[i] = *(const f32x4*)(Wo + (size_t)(q >> 4) * 1024 + nb * 64 + (q & 15) * 4); }
#pragma unroll
        for (int i = 0; i < 8; ++i) { const int q = tid + 512 * i; *(f32x4*)(tA + (size_t)q * 4) = va[i]; *(f32x4*)(tB + (size_t)q * 4) = vb[i]; }
        __syncthreads();
        tile = (float*)(lds + 133120);
        mm64_f32(tA, 256, tB, 64, 256, tile);
    } else if (kb >= 8 && kb < 12) {
        const int g = kb - 8;
        float* tA = (float*)lds; float* tB = (float*)(lds + 65536);
        const float* wp = a->in[9] + (size_t)(l * 4 + g) * 64 * 64;
        const float* ps = a->in[10] + l * 256 + g * 64;
        f32x4 va[2], vb[2];
#pragma unroll
        for (int i = 0; i < 2; ++i) { const int q = tid + 512 * i; va[i] = *(const f32x4*)(wp + (size_t)q * 4); vb[i] = *(const f32x4*)(Wo + (size_t)(512 + g * 64 + (q >> 4)) * 1024 + nb * 64 + (q & 15) * 4) * ps[q >> 4]; }
#pragma unroll
        for (int i = 0; i < 2; ++i) { const int q = tid + 512 * i; *(f32x4*)(tA + (size_t)q * 4) = va[i]; *(f32x4*)(tB + (size_t)q * 4) = vb[i]; }
        __syncthreads();
        tile = (float*)(lds + 133120);
        mm64_f32(tA, 64, tB, 64, 64, tile);
    } else tile_load(tile, Wo + (size_t)(kb * 64) * 1024 + nb * 64, 1024);
    __syncthreads();
    tile_store_T(tile, (bf16_t*)(a->ws + WS_WOUT) + ((size_t)l * 1024 + nb * 64) * 1024 + kb * 64, 1024);
    __syncthreads();
}

__device__ __forceinline__ void exp_src_dst(AP a, int l, int u, const float*& src, int& srcld, unsigned char*& dst, int& dstld) {
    const int mat = u / 1024, e = (u % 1024) / 32, t = u % 32;
    const int kb = (mat < 2) ? t / 4 : t / 8, nb = (mat < 2) ? t % 4 : t % 8;
    srcld = (mat < 2) ? 512 : 1024; dstld = (mat < 2) ? 1024 : 512;
    src = a->in[18 + mat] + ((size_t)(l * 32 + e) * 512 * 1024) + (size_t)(kb * 128) * srcld + nb * 128;
    dst = a->ws + WS_WEXP + (size_t)l * WEXP_LAYER + (size_t)mat * EXPMAT + (size_t)e * 512 * 1024 + (size_t)(nb * 128) * dstld + kb * 128;
}
#define EXP_LOAD(vv, uu) do { exp_src_dst(a, l, (uu), src, srcld, dst, dstld); _Pragma("unroll") for (int _i = 0; _i < 8; ++_i) vv[_i] = *(const f32x4*)(src + (size_t)((tid >> 5) + 16 * _i) * srcld + (tid & 31) * 4); } while (0)
#define EXP_PUT(vv) do { _Pragma("unroll") for (int _i = 0; _i < 8; ++_i) *(f32x4*)(tile + ((tid >> 5) + 16 * _i) * 132 + (tid & 31) * 4) = vv[_i] * 32.0f; } while (0)
#define EXP_STORE(dd, ld_) do { const int n = tid & 127, kq = tid >> 7;        \
        _Pragma("unroll") for (int j = 0; j < 2; ++j) { const float* tp = tile + (kq * 32 + j * 16) * 132 + n; u32x4 w; \
        w.x = pack4_fp8(tp[0], tp[132], tp[2 * 132], tp[3 * 132]); w.y = pack4_fp8(tp[4 * 132], tp[5 * 132], tp[6 * 132], tp[7 * 132]); \
        w.z = pack4_fp8(tp[8 * 132], tp[9 * 132], tp[10 * 132], tp[11 * 132]); w.w = pack4_fp8(tp[12 * 132], tp[13 * 132], tp[14 * 132], tp[15 * 132]); \
        *(u32x4*)((dd) + (size_t)n * (ld_) + kq * 32 + j * 16) = w; } } while (0)
__device__ __forceinline__ void exp_range(AP a, unsigned char* lds, int l, int u0, int u_end) {
    float* tile = (float*)lds;
    const int tid = tid_opaque();
    __syncthreads();
    if (u0 >= u_end) return;
    const float* src; unsigned char* dst; int srcld, dstld;
    f32x4 va[8], vb[8];
    unsigned char *da, *db = nullptr; int lda_, ldb_ = 0;
    EXP_LOAD(va, u0); da = dst; lda_ = dstld;
    if (u0 + 1 < u_end) { EXP_LOAD(vb, u0 + 1); db = dst; ldb_ = dstld; }
    for (int u = u0; u < u_end; u += 2) {
        EXP_PUT(va);
        __syncthreads();
        { unsigned char* cd = da; const int cl = lda_; if (u + 2 < u_end) { EXP_LOAD(va, u + 2); da = dst; lda_ = dstld; } EXP_STORE(cd, cl); }
        __syncthreads();
        if (u + 1 < u_end) {
            EXP_PUT(vb);
            __syncthreads();
            { unsigned char* cd = db; const int cl = ldb_; if (u + 3 < u_end) { EXP_LOAD(vb, u + 3); db = dst; ldb_ = dstld; } EXP_STORE(cd, cl); }
            __syncthreads();
        }
    }
}
#undef EXP_LOAD
#undef EXP_PUT
#undef EXP_STORE
__device__ __forceinline__ void exp_queue(AP a, unsigned char* lds, int l) {
    const int tid = tid_opaque();
    int* qslot = (int*)(lds + MISC_OFF + 128);
    unsigned* qc = (unsigned*)(a->ws + WS_BAR + 14336 + l * 256);
    for (;;) {
        __syncthreads();
        if (tid == 0) *qslot = (int)__hip_atomic_fetch_add(qc, 2u, __ATOMIC_RELAXED, __HIP_MEMORY_SCOPE_AGENT);
        __syncthreads();
        const int c0 = *qslot;
        if (c0 >= U_EXP) break;
        exp_range(a, lds, l, c0, c0 + 2);
    }
}

__device__ __forceinline__ void exp_fill(AP a, unsigned char* lds, int ql, int budget) {
    const int tid = tid_opaque();
    int* qslot = (int*)(lds + MISC_OFF + 128);
    unsigned* qc = (unsigned*)(a->ws + WS_BAR + 14336 + ql * 256);
    for (int done = 0; done < budget; done += 2) {
        __syncthreads();
        if (tid == 0) *qslot = (int)__hip_atomic_fetch_add(qc, 2u, __ATOMIC_RELAXED, __HIP_MEMORY_SCOPE_AGENT);
        __syncthreads();
        const int c0 = *qslot;
        if (c0 >= U_EXP) break;
        exp_range(a, lds, ql, c0, c0 + 2);
    }
    __syncthreads();
}

__device__ __forceinline__ void p0_prologue(AP a, unsigned char* lds) {
    const int tid = tid_opaque();
    bool have_tab = false;
    constexpr int E0 = U_ADA, E1 = E0 + U_WIN, E2 = E1 + U_WOUT, E3 = E2 + U_SGU, E4 = E3 + U_DFT, E5 = E4 + U_ROPE;
    int u = blockIdx.x;
    for (; u < E5; u += gridDim.x) {
        if (u < E0) ada_unit(a, lds, u);
        else if (u < E1) win_unit(a, lds, u - E0);
        else if (u < E2) wout_unit(a, lds, u - E1);
        else if (u < E3) { const size_t i0 = (size_t)(u - E2) * 4096 + tid * 8; const float* s = a->in[11] + i0; bf16_t* d = (bf16_t*)(a->ws + WS_WSGU) + i0;
            const f32x4 v0 = *(const f32x4*)s, v1 = *(const f32x4*)(s + 4); u32x4 w; w.x = pack2(v0[0], v0[1]); w.y = pack2(v0[2], v0[3]); w.z = pack2(v1[0], v1[1]); w.w = pack2(v1[2], v1[3]); *(u32x4*)d = w; }
        else if (u < E4) {
            float* ctab = (float*)(lds + LDS_CTAB);
            if (!have_tab) { for (int i = tid; i < 4096; i += NT) ctab[i] = cospif((float)i / 2048.0f); __syncthreads(); have_tab = true; }
            const int k = u - E3 + 4096;
            if (tid < 32) {
                const int kk = k - 4096, n0 = tid * 8; float c[8], s[8];
#pragma unroll
                for (int e = 0; e < 8; ++e) { const int idx = ((kk * (n0 + e)) & 255) * 16; c[e] = ctab[idx] * (1.0f / 16.0f); s[e] = ctab[(idx - 1024) & 4095] * (1.0f / 16.0f); }
                bf16_t* d = (bf16_t*)(a->ws + WS_DFTC) + (size_t)kk * 512 + n0;
                u32x4 w; w.x = pack2(c[0], c[1]); w.y = pack2(c[2], c[3]); w.z = pack2(c[4], c[5]); w.w = pack2(c[6], c[7]); *(u32x4*)d = w;
                w.x = pack2(s[0], s[1]); w.y = pack2(s[2], s[3]); w.z = pack2(s[4], s[5]); w.w = pack2(s[6], s[7]); *(u32x4*)(d + 256) = w;
            }
        }
        else {
            for (int i = tid; i < 1024; i += NT) { const int pos = i >> 4, f = i & 15; const float freq = powf(10000.0f, -(float)f / 16.0f); const float ang = (float)pos * freq;
                ((float2*)(a->ws + WS_ROPE))[i] = make_float2(cosf(ang), sinf(ang)); }
        }
    }
}

__device__ __forceinline__ void p_lnmod0(AP a) {
    const int tid = tid_opaque(), lane = tid & 63, w = tid >> 6;
    const float* mod = (const float*)(a->ws + WS_MOD);
    bf16_t* H = (bf16_t*)(a->ws + WS_H);
    const int tstep = gridDim.x * 8;
    f32x4 nx[4];
    { const int t = blockIdx.x * 8 + w; if (t < NTOK) { const float* src = (t < NLAT) ? a->in[0] + (size_t)t * D : a->in[2] + (size_t)(t - NLAT) * D;
#pragma unroll
        for (int i = 0; i < 4; ++i) nx[i] = *(const f32x4*)(src + 256 * i + 4 * lane); } }
    int mrow = -1; f32x4 msh[4], msc[4];
    for (int t = blockIdx.x * 8 + w; t < NTOK; t += tstep) {
        const int mr = (t < NLAT) ? (t >> 12) : 4;
        if (mr != mrow) { mrow = mr; const float* m = mod + (size_t)mr * 6144;
#pragma unroll
            for (int i = 0; i < 4; ++i) { msh[i] = *(const f32x4*)(m + 256 * i + 4 * lane); msc[i] = *(const f32x4*)(m + 1024 + 256 * i + 4 * lane); } }
        f32x4 v[4];
#pragma unroll
        for (int i = 0; i < 4; ++i) v[i] = nx[i];
        { const int tn = t + tstep; if (tn < NTOK) { const float* src = (tn < NLAT) ? a->in[0] + (size_t)tn * D : a->in[2] + (size_t)(tn - NLAT) * D;
#pragma unroll
            for (int i = 0; i < 4; ++i) nx[i] = *(const f32x4*)(src + 256 * i + 4 * lane); } }
        float mean, rstd; ln_stats(v, mean, rstd);
#pragma unroll
        for (int i = 0; i < 4; ++i) { const int c = 256 * i + 4 * lane;
            f32x4 o;
#pragma unroll
            for (int e = 0; e < 4; ++e) o[e] = (v[i][e] - mean) * rstd * (1.0f + msc[i][e]) + msh[i][e];
            u32x2 pk; pk.x = pack2(o[0], o[1]); pk.y = pack2(o[2], o[3]); *(u32x2*)(H + (size_t)t * D + c) = pk; }
    }
}

__device__ __forceinline__ void p1_inproj(AP a, unsigned char* smem, LAS unsigned char* lds, int l);
__device__ __forceinline__ u32x4 ld16g(const bf16_t* p) { return *(const u32x4*)p; }
__device__ __forceinline__ void rope_pack8(u32x4& wl, u32x4& wh, const LAS f32x2* tab, bool do_rope, float scale) {
    float tl[8] = {lo2f(wl.x), hi2f(wl.x), lo2f(wl.y), hi2f(wl.y), lo2f(wl.z), hi2f(wl.z), lo2f(wl.w), hi2f(wl.w)};
    float th[8] = {lo2f(wh.x), hi2f(wh.x), lo2f(wh.y), hi2f(wh.y), lo2f(wh.z), hi2f(wh.z), lo2f(wh.w), hi2f(wh.w)};
#pragma unroll
    for (int j = 0; j < 8; ++j) {
        float r1 = tl[j], r2 = th[j];
        if (do_rope) { const f32x2 cs = tab[j]; r1 = tl[j] * cs.x - th[j] * cs.y; r2 = tl[j] * cs.y + th[j] * cs.x; }
        tl[j] = r1 * scale; th[j] = r2 * scale;
    }
    wl.x = pack2(tl[0], tl[1]); wl.y = pack2(tl[2], tl[3]); wl.z = pack2(tl[4], tl[5]); wl.w = pack2(tl[6], tl[7]);
    wh.x = pack2(th[0], th[1]); wh.y = pack2(th[2], th[3]); wh.z = pack2(th[4], th[5]); wh.w = pack2(th[6], th[7]);
}

__device__ __forceinline__ void mixer_sgu_pool(AP a, LAS unsigned char* lds, int l, int row0, int seq_row0, int pos0, int n) {
    typedef short s16x4 __attribute__((ext_vector_type(4)));
    const int tid = tid_opaque(), lane = tid & 63, w = __builtin_amdgcn_readfirstlane(tid >> 6), fr = lane & 15, g = lane >> 4;
    const bf16_t* Z = (const bf16_t*)(a->ws + WS_Z);
    bf16_t* CAT = (bf16_t*)(a->ws + WS_CAT);
    constexpr int VOFF = 73728;
    u32x4 pr[9];
#pragma unroll
    for (int it = 0; it < 9; ++it) { const int id = tid + 512 * it, rr = id >> 5, ch = id & 31, j = pos0 - 8 + rr;
        pr[it] = (u32x4){0u, 0u, 0u, 0u};
        if (j >= 0 && j < n) pr[it] = ld16g(Z + (size_t)(seq_row0 + j) * ZC + 1024 + ch * 8); }
    bf16x8 wfrag[4][4];
    {   const int h = w >> 1, ph = w & 1; const bf16_t* Ws = (const bf16_t*)(a->ws + WS_WSGU) + (size_t)(l * 4 + h) * 128 * 128;
#pragma unroll
        for (int ks = 0; ks < 4; ++ks)
#pragma unroll
            for (int pf = 0; pf < 4; ++pf) wfrag[ks][pf] = *(const bf16x8*)(Ws + (size_t)(ph * 64 + 16 * pf + fr) * 128 + 32 * ks + 8 * g); }
    u32x4 gw[4][2];
#pragma unroll
    for (int ps = 0; ps < 4; ++ps) { const int q = w * 16 + ps * 4 + g; const bf16_t* src = Z + (size_t)(row0 + q) * ZC + 1536 + 16 * fr; gw[ps][0] = ld16g(src); gw[ps][1] = ld16g(src + 8); }
#pragma unroll
    for (int it = 0; it < 9; ++it) { const int id = tid + 512 * it; *(LAS u32x4*)(lds + (id >> 5) * 512 + (id & 31) * 16) = pr[it]; }
#pragma unroll
    for (int ps = 0; ps < 4; ++ps) {
        const int q = w * 16 + ps * 4 + g;
        float gv[16];
#pragma unroll
        for (int hh = 0; hh < 2; ++hh) { const u32x4 x = gw[ps][hh];
            gv[8 * hh + 0] = gelu_erf(lo2f(x.x)); gv[8 * hh + 1] = gelu_erf(hi2f(x.x)); gv[8 * hh + 2] = gelu_erf(lo2f(x.y)); gv[8 * hh + 3] = gelu_erf(hi2f(x.y));
            gv[8 * hh + 4] = gelu_erf(lo2f(x.z)); gv[8 * hh + 5] = gelu_erf(hi2f(x.z)); gv[8 * hh + 6] = gelu_erf(lo2f(x.w)); gv[8 * hh + 7] = gelu_erf(hi2f(x.w)); }
        float sm = 0.f;
#pragma unroll
        for (int e = 0; e < 16; ++e) sm += gv[e];
        const float mean = row_sum16(sm) * (1.0f / 256.0f);
        float qq = 0.f;
#pragma unroll
        for (int e = 0; e < 16; ++e) { const float d = gv[e] - mean; qq += d * d; }
        const float rstd = 1.0f / sqrtf(row_sum16(qq) * (1.0f / 256.0f) + 1e-6f);
        u32x4 o0, o1;
        o0.x = pack2((gv[0] - mean) * rstd, (gv[1] - mean) * rstd); o0.y = pack2((gv[2] - mean) * rstd, (gv[3] - mean) * rstd); o0.z = pack2((gv[4] - mean) * rstd, (gv[5] - mean) * rstd); o0.w = pack2((gv[6] - mean) * rstd, (gv[7] - mean) * rstd);
        o1.x = pack2((gv[8] - mean) * rstd, (gv[9] - mean) * rstd); o1.y = pack2((gv[10] - mean) * rstd, (gv[11] - mean) * rstd); o1.z = pack2((gv[12] - mean) * rstd, (gv[13] - mean) * rstd); o1.w = pack2((gv[14] - mean) * rstd, (gv[15] - mean) * rstd);
        const int sg = fr ^ ((q & 3) | (((q >> 3) & 1) << 2));
        *(LAS u32x4*)(lds + VOFF + q * 512 + sg * 32) = o0; *(LAS u32x4*)(lds + VOFF + q * 512 + sg * 32 + 16) = o1;
    }
    __syncthreads();
    {
        const int c = tid & 255, half = tid >> 8, hw = 1 << (c >> 6);
        const LAS bf16_t* P = (const LAS bf16_t*)lds + c;
        const int t0 = half * 64;
        const float invfull = 1.0f / (float)(2 * hw);
        float s = 0.f;
        for (int j = t0 - hw; j < t0 + hw; ++j) s += bf2f(P[(8 + j) * 256]);
        for (int tl = t0; tl < t0 + 64; ++tl) {
            const int pos = pos0 + tl; const int cntw = min(pos + hw, n) - max(pos - hw, 0);
            const float inv = (cntw == 2 * hw) ? invfull : 1.0f / (float)cntw;
            CAT[(size_t)(row0 + tl) * D + 512 + c] = f2bf(s * inv - bf2f(P[(8 + tl) * 256]));
            s += bf2f(P[(8 + tl + hw) * 256]) - bf2f(P[(8 + tl - hw) * 256]);
        }
    }
    {
        const int h = w >> 1, ph = w & 1;
        const float* bs = a->in[12] + (size_t)(l * 4 + h) * 128;
        f32x4 acc[4][4];
#pragma unroll
        for (int i = 0; i < 4; ++i)
#pragma unroll
            for (int j = 0; j < 4; ++j) acc[i][j] = (f32x4){0.f, 0.f, 0.f, 0.f};
        const int qq4 = fr >> 2, p4 = fr & 3, fsw = qq4 | ((g & 1) << 2);
#pragma unroll
        for (int ks = 0; ks < 4; ++ks) {
            bf16x8 af[4];
            const int r0 = 32 * ks + 8 * g + qq4;
#pragma unroll
            for (int cf = 0; cf < 4; ++cf) { const int so = (((4 * h + cf) ^ fsw) << 5) + p4 * 8;
                const s16x4 lo = __builtin_amdgcn_ds_read_tr16_b64_v4i16((LAS s16x4*)(lds + VOFF + r0 * 512 + so));
                const s16x4 hi = __builtin_amdgcn_ds_read_tr16_b64_v4i16((LAS s16x4*)(lds + VOFF + (r0 + 4) * 512 + so));
                af[cf] = __builtin_shufflevector(lo, hi, 0, 1, 2, 3, 4, 5, 6, 7); }
#pragma unroll
            for (int cf = 0; cf < 4; ++cf)
#pragma unroll
                for (int pf = 0; pf < 4; ++pf) acc[cf][pf] = __builtin_amdgcn_mfma_f32_16x16x32_bf16(af[cf], wfrag[ks][pf], acc[cf][pf], 0, 0, 0);
        }
#pragma unroll
        for (int pf = 0; pf < 4; ++pf) { const int p = ph * 64 + 16 * pf + fr; const float bias = bs[p];
#pragma unroll
            for (int cf = 0; cf < 4; ++cf) { const int c0 = h * 64 + 16 * cf + 4 * g;
                const u32x2 uw = *(const u32x2*)(Z + (size_t)(row0 + p) * ZC + 1280 + c0);
                u32x2 o; o.x = pack2(gelu_erf(lo2f(uw.x)) * (acc[cf][pf][0] + bias), gelu_erf(hi2f(uw.x)) * (acc[cf][pf][1] + bias));
                o.y = pack2(gelu_erf(lo2f(uw.y)) * (acc[cf][pf][2] + bias), gelu_erf(hi2f(uw.y)) * (acc[cf][pf][3] + bias));
                *(u32x2*)(CAT + (size_t)(row0 + p) * D + 768 + c0) = o; } }
    }
    __syncthreads();
}

__device__ __forceinline__ void mixer_attn(AP a, LAS unsigned char* lds, int l, int row0, int seq_row0, int pos0, int n, int b, bool is_ctx, int kvh) {
    const int tid = tid_opaque(), lane = tid & 63, w = __builtin_amdgcn_readfirstlane(tid >> 6), fr = lane & 15, g = lane >> 4;
    const bf16_t* Z = (const bf16_t*)(a->ws + WS_Z);
    bf16_t* CAT = (bf16_t*)(a->ws + WS_CAT);
    __syncthreads();
    ((LAS u32x4*)(lds + 98304))[tid] = ((const u32x4*)(a->ws + WS_ROPE))[tid];
    const LAS f32x2* rope = (const LAS f32x2*)(lds + 98304);
    constexpr float QS = 0.125f * 1.44269504088896341f;
    constexpr int QS_OFF = 0, KS_OFF = 32768, VS_OFF = 65536;
    const int nbq = pos0 >> 7;
    unsigned bmask = 0x18u;
    if (!is_ctx) { if (nbq > 0) bmask |= 1u; bmask |= 2u; if (nbq + 1 < (n >> 7)) bmask |= 4u; }
    const int kr = tid >> 2, kax = (tid >> 1) & 1, kh8 = tid & 1;
#define MX_KSRC(blk) (Z + (size_t)((((blk) < 3) ? seq_row0 + (nbq + (blk) - 1) * 128 : NLAT + b * 256 + ((blk) - 3) * 128) + kr) * ZC + 768 + kvh * 64 + kax * 32 + kh8 * 8)
#define MX_VSTAGE(blk, buf) do { const bool _band = (blk) < 3; const int _key0 = _band ? (nbq + (blk) - 1) * 128 : ((blk) - 3) * 128; \
        const bf16_t* _vs = _band ? (const bf16_t*)(a->ws + WS_VT) + (size_t)(b * 2 + kvh) * 64 * 4096 + _key0 : (const bf16_t*)(a->ws + WS_VTC) + (size_t)(b * 2 + kvh) * 64 * 256 + _key0; \
        const int _vld = _band ? 4096 : 256; \
        _Pragma("unroll") for (int _i = 0; _i < 2; ++_i) { const int _P = _i * 512 + tid, _d = _P >> 4, _c = (_P & 15) ^ (_d & 15); \
            glds16(_vs + (size_t)_d * _vld + _c * 8, lds + VS_OFF + (buf) * 16384 + _i * 8192 + w * 1024); } } while (0)
    {
        __syncthreads();
#pragma unroll
        for (int it = 0; it < 2; ++it) {
            const int item = tid + 512 * it, r = item >> 2, ax = (item >> 1) & 1, h8 = item & 1, i = r & 127, qpos = pos0 + i;
            const bf16_t* src = Z + (size_t)(row0 + i) * ZC + 512 + (2 * kvh + (r >> 7)) * 64 + ax * 32 + h8 * 8;
            u32x4 wl = ld16g(src), wh = ld16g(src + 16);
            rope_pack8(wl, wh, rope + (ax ? (qpos & 63) : (qpos >> 6)) * 16 + h8 * 8, !is_ctx, QS);
            const int ch = ax * 4 + h8, sw = (r >> 1) & 7;
            *(LAS u32x4*)(lds + QS_OFF + r * 128 + ((ch ^ sw) << 4)) = wl;
            *(LAS u32x4*)(lds + QS_OFF + r * 128 + (((ch + 2) ^ sw) << 4)) = wh;
        }
        const int hh = w >> 2, qb = (w & 3) * 32, h = 2 * kvh + hh;
        float m[2], lsum[2];
        m[0] = m[1] = a->in[8][l * 4 + h] * 1.44269504088896341f;
        lsum[0] = lsum[1] = (g == 0) ? 1.0f : 0.0f;
        f32x4 O[4][2];
#pragma unroll
        for (int i = 0; i < 4; ++i) { O[i][0] = (f32x4){0.f, 0.f, 0.f, 0.f}; O[i][1] = (f32x4){0.f, 0.f, 0.f, 0.f}; }
        bf16x8 Qf[2][2];
        bool have_q = false;
        unsigned rem = bmask;
        int cur = __builtin_ctz(rem); rem &= rem - 1u;
        int buf = 0;
        u32x4 kl = ld16g(MX_KSRC(cur)), kh = ld16g(MX_KSRC(cur) + 16);
        MX_VSTAGE(cur, 0);
#pragma unroll 1
        for (;;) {
            const int jb = cur - 1; const bool band = cur < 3;
            {
                const int kpos = (nbq + jb) * 128 + kr;
                rope_pack8(kl, kh, rope + (kax ? (kpos & 63) : (kpos >> 6)) * 16 + kh8 * 8, band, 1.0f);
                const int ch = kax * 4 + kh8, sw = (kr >> 1) & 7;
                *(LAS u32x4*)(lds + KS_OFF + buf * 16384 + kr * 128 + ((ch ^ sw) << 4)) = kl;
                *(LAS u32x4*)(lds + KS_OFF + buf * 16384 + kr * 128 + (((ch + 2) ^ sw) << 4)) = kh;
            }
            asm volatile("s_waitcnt vmcnt(0)" ::: "memory");
            __syncthreads();
            const int nxt = rem ? __builtin_ctz(rem) : -1; rem &= rem - 1u;
            if (nxt >= 0) { kl = ld16g(MX_KSRC(nxt)); kh = ld16g(MX_KSRC(nxt) + 16); MX_VSTAGE(nxt, buf ^ 1); }
            if (!have_q) {
#pragma unroll
                for (int qf = 0; qf < 2; ++qf)
#pragma unroll
                    for (int ks = 0; ks < 2; ++ks) { const int r = hh * 128 + qb + 16 * qf + fr; Qf[qf][ks] = *(const LAS bf16x8*)(lds + QS_OFF + r * 128 + (((4 * ks + g) ^ ((r >> 1) & 7)) << 4)); }
                have_q = true;
            }
            const int kso = KS_OFF + buf * 16384, vso = VS_OFF + buf * 16384;
            f32x4 S[8][2];
#pragma unroll
            for (int kf = 0; kf < 8; ++kf) { S[kf][0] = (f32x4){0.f, 0.f, 0.f, 0.f}; S[kf][1] = (f32x4){0.f, 0.f, 0.f, 0.f}; }
#pragma unroll
            for (int kf = 0; kf < 8; ++kf)
#pragma unroll
                for (int ks = 0; ks < 2; ++ks) { const int r = 16 * kf + fr;
                    const bf16x8 kfr = *(const LAS bf16x8*)(lds + kso + r * 128 + (((4 * ks + g) ^ ((r >> 1) & 7)) << 4));
                    S[kf][0] = __builtin_amdgcn_mfma_f32_16x16x32_bf16(kfr, Qf[0][ks], S[kf][0], 0, 0, 0);
                    S[kf][1] = __builtin_amdgcn_mfma_f32_16x16x32_bf16(kfr, Qf[1][ks], S[kf][1], 0, 0, 0); }
            bf16x8 Pp[4][2];
#pragma unroll
            for (int qf = 0; qf < 2; ++qf) {
                const int qi = qb + 16 * qf + fr;
                if (band && jb != 0) {
#pragma unroll
                    for (int kf = 0; kf < 8; ++kf)
#pragma unroll
                        for (int r = 0; r < 4; ++r) { const int kk = 16 * kf + 4 * g + r; const bool ok = (jb < 0) ? (kk >= qi) : (kk <= qi); if (!ok) S[kf][qf][r] = -1.0e30f; }
                }
                float mx = S[0][qf][0];
#pragma unroll
                for (int kf = 0; kf < 8; ++kf)
#pragma unroll
                    for (int r = 0; r < 4; ++r) mx = fmaxf(mx, S[kf][qf][r]);
                mx = fmaxf(mx, __shfl_xor(mx, 16)); mx = fmaxf(mx, __shfl_xor(mx, 32));
                const float mn = fmaxf(m[qf], mx), corr = __builtin_amdgcn_exp2f(m[qf] - mn);
                m[qf] = mn;
                float ps = 0.f;
#pragma unroll
                for (int kf = 0; kf < 8; ++kf)
#pragma unroll
                    for (int r = 0; r < 4; ++r) { const float p = __builtin_amdgcn_exp2f(S[kf][qf][r] - mn); S[kf][qf][r] = p; ps += p; }
                lsum[qf] = lsum[qf] * corr + ps;
#pragma unroll
                for (int df = 0; df < 4; ++df) O[df][qf] *= corr;
#pragma unroll
                for (int t = 0; t < 4; ++t) { u32x4 pw; pw.x = pack2(S[2 * t][qf][0], S[2 * t][qf][1]); pw.y = pack2(S[2 * t][qf][2], S[2 * t][qf][3]);
                    pw.z = pack2(S[2 * t + 1][qf][0], S[2 * t + 1][qf][1]); pw.w = pack2(S[2 * t + 1][qf][2], S[2 * t + 1][qf][3]); Pp[t][qf] = __builtin_bit_cast(bf16x8, pw); }
            }
#pragma unroll
            for (int t = 0; t < 4; ++t)
#pragma unroll
                for (int df = 0; df < 4; ++df) { const int d = 16 * df + fr;
                    const u32x2 v0 = *(const LAS u32x2*)(lds + vso + d * 256 + (((4 * t + (g >> 1)) ^ (d & 15)) << 4) + (g & 1) * 8);
                    const u32x2 v1 = *(const LAS u32x2*)(lds + vso + d * 256 + (((4 * t + 2 + (g >> 1)) ^ (d & 15)) << 4) + (g & 1) * 8);
                    u32x4 vw; vw.x = v0.x; vw.y = v0.y; vw.z = v1.x; vw.w = v1.y; const bf16x8 vf = __builtin_bit_cast(bf16x8, vw);
                    O[df][0] = __builtin_amdgcn_mfma_f32_16x16x32_bf16(vf, Pp[t][0], O[df][0], 0, 0, 0);
                    O[df][1] = __builtin_amdgcn_mfma_f32_16x16x32_bf16(vf, Pp[t][1], O[df][1], 0, 0, 0); }
            if (nxt < 0) break;
            cur = nxt; buf ^= 1;
        }
#pragma unroll
        for (int qf = 0; qf < 2; ++qf) {
            float lt = lsum[qf]; lt += __shfl_xor(lt, 16); lt += __shfl_xor(lt, 32);
            const float inv = 1.0f / lt;
            bf16_t* dst = CAT + (size_t)(row0 + qb + 16 * qf + fr) * D + 256 + h * 64 + 4 * g;
#pragma unroll
            for (int df = 0; df < 4; ++df) { u32x2 o; o.x = pack2(O[df][qf][0] * inv, O[df][qf][1] * inv); o.y = pack2(O[df][qf][2] * inv, O[df][qf][3] * inv); *(u32x2*)(dst + 16 * df) = o; }
        }
    }
#undef MX_KSRC
#undef MX_VSTAGE
    __syncthreads();
}

constexpr int FF_DA = 0, FF_DC = 32768, FF_XT = 49152  , FF_Z2 = 81920  , FF_OB = 114688  ;
__device__ __forceinline__ int ff_addr(int row, int k) { return row * 256 + ((((k >> 3) ^ (row & 15))) << 4) + (k & 7) * 2; }
__device__ __forceinline__ float cos_turns(float x) { return __builtin_amdgcn_cosf(x); }
__device__ __forceinline__ float sin_turns(float x) { return __builtin_amdgcn_sinf(x); }
__device__ __forceinline__ void fft_setup(LAS unsigned char* lds) {
    const int tid = tid_opaque();
    __syncthreads();
    for (int idx = tid; idx < 16384; idx += NT) { const int i = idx >> 7, k = idx & 127, ro = i >> 6, k1 = i & 63, part = k >> 6, n1 = k & 63; const float t = (float)((k1 * n1) & 63) * (1.0f / 64.0f);
        const float c = cos_turns(t), sn = sin_turns(t);
        const float v = (ro == 0) ? (part == 0 ? c : sn) : (part == 0 ? -sn : c);
        *(LAS bf16_t*)(lds + FF_DA + ff_addr(i, k)) = f2bf(v * 0.125f); }
    for (int idx = tid; idx < 8192; idx += NT) { const int k2 = idx >> 7, k = idx & 127, ri = k >> 6, n2 = k & 63; const float t = (float)((k2 * n2) & 63) * (1.0f / 64.0f);
        const float v = (ri == 0) ? cos_turns(t) : sin_turns(t);
        *(LAS bf16_t*)(lds + FF_DC + ff_addr(k2, k)) = f2bf(v * 0.125f); }
    __syncthreads();
}
__device__ __forceinline__ void fft_unit(AP a, LAS unsigned char* lds, int b, int cg) {
    const int tid = tid_opaque(), lane = tid & 63, w = __builtin_amdgcn_readfirstlane(tid >> 6), fr = lane & 15, g = lane >> 4;
    const int mf = w & 3, nh = w >> 2;
    const bf16_t* AT = (const bf16_t*)(a->ws + WS_AT) + (size_t)(b * 256 + cg * 4) * 8192;
    u32x4 xin[2][2];
#pragma unroll
    for (int h = 0; h < 2; ++h)
#pragma unroll
        for (int it = 0; it < 2; ++it) xin[h][it] = ld16g(AT + (size_t)h * 8192 + (size_t)(tid + 512 * it) * 8);
#pragma unroll 1
    for (int cp = 0; cp < 2; ++cp) {
#pragma unroll
        for (int h = 0; h < 2; ++h)
#pragma unroll
            for (int it = 0; it < 2; ++it) { const int q = tid + 512 * it, part = q >> 9, pos0 = (q & 511) * 8, n1 = pos0 >> 6, n2 = pos0 & 63, k = part * 64 + n1;
                const unsigned wv[4] = {xin[h][it].x, xin[h][it].y, xin[h][it].z, xin[h][it].w};
#pragma unroll
                for (int e = 0; e < 4; ++e) { *(LAS bf16_t*)(lds + FF_XT + h * 16384 + ff_addr(n2 + 2 * e, k)) = (bf16_t)(wv[e] & 0xffffu); *(LAS bf16_t*)(lds + FF_XT + h * 16384 + ff_addr(n2 + 2 * e + 1, k)) = (bf16_t)(wv[e] >> 16); } }
        if (cp == 0) {
#pragma unroll
            for (int h = 0; h < 2; ++h)
#pragma unroll
                for (int it = 0; it < 2; ++it) xin[h][it] = ld16g(AT + (size_t)(2 + h) * 8192 + (size_t)(tid + 512 * it) * 8); }
        __syncthreads();
        f32x4 acc[2][2][2];
#pragma unroll
        for (int h = 0; h < 2; ++h)
#pragma unroll
            for (int x = 0; x < 2; ++x) { acc[h][x][0] = (f32x4){0.f, 0.f, 0.f, 0.f}; acc[h][x][1] = (f32x4){0.f, 0.f, 0.f, 0.f}; }
#pragma unroll
        for (int ks = 0; ks < 4; ++ks) {
            bf16x8 af[2];
#pragma unroll
            for (int x = 0; x < 2; ++x) { const int i = 16 * (mf + 4 * x) + fr; af[x] = *(const LAS bf16x8*)(lds + FF_DA + i * 256 + (((4 * ks + g) ^ (i & 15)) << 4)); }
#pragma unroll
            for (int h = 0; h < 2; ++h)
#pragma unroll
                for (int n = 0; n < 2; ++n) { const int j = 16 * (2 * nh + n) + fr; const bf16x8 bfv = *(const LAS bf16x8*)(lds + FF_XT + h * 16384 + j * 256 + (((4 * ks + g) ^ (j & 15)) << 4));
                    acc[h][0][n] = __builtin_amdgcn_mfma_f32_16x16x32_bf16(af[0], bfv, acc[h][0][n], 0, 0, 0);
                    acc[h][1][n] = __builtin_amdgcn_mfma_f32_16x16x32_bf16(af[1], bfv, acc[h][1][n], 0, 0, 0); }
        }
#pragma unroll
        for (int n = 0; n < 2; ++n)
#pragma unroll
            for (int r = 0; r < 4; ++r) { const int k1 = 16 * mf + 4 * g + r, n2 = 16 * (2 * nh + n) + fr; const float t = (float)((k1 * n2) & 4095) * (1.0f / 4096.0f);
                const float c = cos_turns(t), sn = sin_turns(t);
#pragma unroll
                for (int h = 0; h < 2; ++h) { const float zr = acc[h][0][n][r], zi = acc[h][1][n][r];
                    *(LAS bf16_t*)(lds + FF_Z2 + h * 16384 + ff_addr(k1, n2)) = f2bf(zr * c + zi * sn);
                    *(LAS bf16_t*)(lds + FF_Z2 + h * 16384 + ff_addr(k1, 64 + n2)) = f2bf(zi * c - zr * sn); } }
        __syncthreads();
        f32x4 acc2[2][2];
#pragma unroll
        for (int h = 0; h < 2; ++h) { acc2[h][0] = (f32x4){0.f, 0.f, 0.f, 0.f}; acc2[h][1] = (f32x4){0.f, 0.f, 0.f, 0.f}; }
#pragma unroll
        for (int ks = 0; ks < 4; ++ks) {
            const int i = 16 * mf + fr; const bf16x8 af = *(const LAS bf16x8*)(lds + FF_DC + i * 256 + (((4 * ks + g) ^ (i & 15)) << 4));
#pragma unroll
            for (int h = 0; h < 2; ++h)
#pragma unroll
                for (int n = 0; n < 2; ++n) { const int j = 16 * (2 * nh + n) + fr; const bf16x8 bfv = *(const LAS bf16x8*)(lds + FF_Z2 + h * 16384 + j * 256 + (((4 * ks + g) ^ (j & 15)) << 4));
                    acc2[h][n] = __builtin_amdgcn_mfma_f32_16x16x32_bf16(af, bfv, acc2[h][n], 0, 0, 0); }
        }
#pragma unroll
        for (int n = 0; n < 2; ++n)
#pragma unroll
            for (int r = 0; r < 4; ++r) { const int k = 16 * (2 * nh + n) + fr + 64 * (16 * mf + 4 * g + r);
                *(LAS unsigned*)(lds + FF_OB + k * 8 + cp * 4) = pack2(acc2[0][n][r], acc2[1][n][r]); }
    }
    __syncthreads();
    bf16_t* CAT = (bf16_t*)(a->ws + WS_CAT) + (size_t)(b * 4096) * D + cg * 4;
#pragma unroll
    for (int it = 0; it < 8; ++it) { const int k = tid + 512 * it; *(u32x2*)(CAT + (size_t)k * D) = *(const LAS u32x2*)(lds + FF_OB + k * 8); }
    __syncthreads();
}

__device__ __forceinline__ void p2_mix(AP a, unsigned char* ldsg, LAS unsigned char* lds, int l) {
    const int n_tile = 128 + ((l == 0) ? 8 : 0), n_att = 2 * n_tile, n_dft = 256, n_dftc = (l == 0) ? 16 : 0;
    bf16_t* CAT = (bf16_t*)(a->ws + WS_CAT);
    bool fft_ready = false;
    for (int u = blockIdx.x; u < n_att + n_dft + n_tile + n_dftc; u += gridDim.x) {
        if (u < n_att || (u >= n_att + n_dft && u < n_att + n_dft + n_tile)) {
            const bool att = u < n_att;
            const int t = att ? (u >> 1) : (u - n_att - n_dft);
            const bool isc = t >= 128; const int tt = t - 128;
            const int b = isc ? (tt >> 1) : (t >> 5);
            const int row0 = isc ? NLAT + tt * 128 : t * 128, seq_row0 = isc ? NLAT + b * 256 : b * 4096, pos0 = isc ? (tt & 1) * 128 : (t & 31) * 128, n = isc ? 256 : 4096;
            if (att) { for (int rep = 0; rep < PROBE_MIX_REP; ++rep) mixer_attn(a, lds, l, row0, seq_row0, pos0, n, b, isc, u & 1); }
            else { for (int rep = 0; rep < PROBE_SGU_REP; ++rep) mixer_sgu_pool(a, lds, l, row0, seq_row0, pos0, n); }
            fft_ready = false;
        } else if (u < n_att + n_dft) {
            const int uu = u - n_att;
            if (!fft_ready) { fft_setup(lds); fft_ready = true; }
            for (int rep = 0; rep < PROBE_FFT_REP; ++rep) fft_unit(a, lds, uu >> 6, uu & 63);
        } else {
            const int uu = u - n_att - n_dft - n_tile, b = uu >> 2, mt = (uu >> 1) & 1, ch0 = (uu & 1) * 128;
            const bf16_t* A = (const bf16_t*)(a->ws + WS_DFTC) + (size_t)(mt * 128) * 512;
            const bf16_t* B0 = (const bf16_t*)(a->ws + WS_ATC) + ((size_t)b * 256 + ch0) * 512;
            EpiBf16 E; E.C = CAT + (size_t)(NLAT + b * 256 + mt * 128) * D + ch0; E.ld = D; E.scale = 1.0f;
            gemm_tile<128, false, EpiBf16>(lds, A, 512, nullptr, 128, B0, B0 + (size_t)64 * 512, 512, 512, E);
            fft_ready = false;
        }
    }
    exp_queue(a, ldsg, l);
}

__device__ __forceinline__ int uni(int v) { return __builtin_amdgcn_readfirstlane(v); }
__device__ __forceinline__ int vblock() { const int G = gridDim.x, b = blockIdx.x; return (G % 8 == 0) ? (b % 8) * (G / 8) + b / 8 : b; }
template <class T> __device__ __forceinline__ T* unip(T* p) { const unsigned long long v = (unsigned long long)p; const unsigned lo = __builtin_amdgcn_readfirstlane((unsigned)v), hi = __builtin_amdgcn_readfirstlane((unsigned)(v >> 32)); return (T*)(((unsigned long long)hi << 32) | lo); }
struct SchedInProj {
    typedef EpiInProj Epi; static constexpr bool GATHER = false, FP8 = false;
    unsigned char* ws; int l, G, me;
    __device__ __forceinline__ bool get(int i, g256::Unit<Epi>& u) const {
        const int n_lat = 64 * 7, n_ctx = (l == 0) ? 4 * 7 : 4;
        const int idx = i * G + me; if (idx >= n_lat + n_ctx) return false;
        int row0, b, ct, n; bf16_t *tF, *tV;
        if (idx < n_lat) { const int rt = idx / 7; ct = idx % 7; row0 = rt * 256; b = row0 >> 12; n = 4096;
            tF = (bf16_t*)(ws + WS_AT) + (size_t)b * 256 * 2 * 4096; tV = (bf16_t*)(ws + WS_VT) + (size_t)b * 128 * 4096; }
        else { const int uu = idx - n_lat; int rt; if (l == 0) { rt = uu / 7; ct = uu % 7; } else { rt = uu; ct = 3; }
            row0 = NLAT + rt * 256; b = rt; n = 256;
            tF = (bf16_t*)(ws + WS_ATC) + (size_t)b * 256 * 2 * 256; tV = (bf16_t*)(ws + WS_VTC) + (size_t)b * 128 * 256; }
        u.A = (const bf16_t*)(ws + WS_H) + (size_t)row0 * D;
        u.B0 = (const bf16_t*)(ws + WS_WIN) + ((size_t)l * ZC + ct * 256) * 1024; u.B1 = u.B0 + (size_t)128 * 1024; u.ridx = nullptr; u.valid = 256;
        u.epi.Zt = (bf16_t*)(ws + WS_Z) + (size_t)row0 * ZC + ct * 256; u.epi.tF = tF; u.epi.tV = tV; u.epi.n0 = ct * 256; u.epi.pos0 = (idx < n_lat) ? (row0 & 4095) : 0; u.epi.n = n;
        return true;
    }
};
struct SchedOutProj {
    typedef EpiBf16 Epi; static constexpr bool GATHER = false, FP8 = false;
    unsigned char* ws; int l, G, me;
    __device__ __forceinline__ bool get(int i, g256::Unit<Epi>& u) const {
        const int nrt = NLAT / 256;
        const int idx = i * G + me; if (idx >= nrt * 4) return false;
        const int rt = idx >> 2, ct = idx & 3;
        u.A = (const bf16_t*)(ws + WS_CAT) + (size_t)(rt * 256) * D;
        u.B0 = (const bf16_t*)(ws + WS_WOUT) + ((size_t)l * 1024 + ct * 256) * 1024; u.B1 = u.B0 + (size_t)128 * 1024; u.ridx = nullptr; u.valid = 256;
        u.epi.C = (bf16_t*)(ws + WS_Y) + (size_t)(rt * 256) * D + ct * 256; u.epi.ld = D; u.epi.scale = 1.0f;
        return true;
    }
};
__device__ __forceinline__ void moe_units(const LAS int* blk, LAS int* uinf, int G, int me) {
    const int i = threadIdx.x;
    if (i < 8) { const int idx = i * G + me, nu = blk[32] * 4; int e = 0, valid = 0;
        if (idx < nu) { const int rb = idx >> 2; for (int q = 1; q < 32; ++q) if (blk[q] <= rb) e = q; valid = min(256, blk[33 + e] - (rb - blk[e]) * 256); }
        uinf[2 * i] = e; uinf[2 * i + 1] = valid; }
    __syncthreads();
}
struct SchedGateUp {
    typedef EpiGateUp8 Epi; static constexpr bool GATHER = true, FP8 = true;
    unsigned char* ws; const LAS int* uinf; const LAS int* ridx_lds; int G, me, l, nu;
    __device__ __forceinline__ bool get(int i, g256::Unit<Epi>& u) const {
        const int idx = i * G + me; if (idx >= nu) return false;
        const int rb = idx >> 2, ct = idx & 3, e = uni(uinf[2 * i]);
        u.A = (const bf16_t*)(ws + WS_H8);
        { const unsigned char* b0 = ws + WS_WEXP + (size_t)l * WEXP_LAYER + ((size_t)e * 512 + ct * 128) * 1024; u.B0 = (const bf16_t*)b0; u.B1 = (const bf16_t*)(b0 + EXPMAT); }
        u.ridx = ridx_lds + (i & 7) * 256; u.valid = uni(uinf[2 * i + 1]);
        u.epi.C = ws + WS_HID + (size_t)(rb * 256) * DEXP + ct * 128; u.epi.ld = DEXP;
        return true;
    }
};
struct SchedDown {
    typedef EpiFp8 Epi; static constexpr bool GATHER = false, FP8 = true;
    unsigned char* ws; const LAS int* uinf; int G, me, l, nu;
    __device__ __forceinline__ bool get(int i, g256::Unit<Epi>& u) const {
        const int idx = i * G + me; if (idx >= nu) return false;
        const int rb = idx >> 2, ct = idx & 3, e = uni(uinf[2 * i]);
        u.A = (const bf16_t*)(ws + WS_HID + (size_t)(rb * 256) * DEXP);
        { const unsigned char* b0 = ws + WS_WEXP + (size_t)l * WEXP_LAYER + 2 * EXPMAT + ((size_t)e * 1024 + ct * 256) * 512; u.B0 = (const bf16_t*)b0; u.B1 = (const bf16_t*)(b0 + (size_t)128 * 512); } u.ridx = nullptr; u.valid = 256;
        u.epi.C = ws + WS_YS + (size_t)(rb * 256) * D + ct * 256; u.epi.ld = D; u.epi.scale = 1.0f / 32.0f;
        return true;
    }
};

__device__ __forceinline__ void p4_ln1_router(AP a, unsigned char* lds, int l) {
    const int tid = tid_opaque(), lane = tid & 63, w = tid >> 6;
    const int ntok = (l == 0) ? NTOK : NLAT;
    int* cnt = (int*)(lds + MISC_OFF);
    if (tid < 32) cnt[tid] = 0;
    f32x4* Lg = (f32x4*)lds; f32x4* Le = (f32x4*)(lds + 16384); f32x4* Lgb = (f32x4*)(lds + 147456);
    {
        const float* wrg_ = a->in[16] + (size_t)l * 1024 * 4; const float* wre_ = a->in[17] + (size_t)l * 1024 * 32;
#pragma unroll
        for (int it = 0; it < 2; ++it) { const int c = tid + 512 * it, slot = (((c >> 8) * 4 + (c & 3)) << 6) + ((c >> 2) & 63);
            Lg[slot] = *(const f32x4*)(wrg_ + (size_t)c * 4);
#pragma unroll
            for (int q = 0; q < 8; ++q) Le[q * 1024 + slot] = *(const f32x4*)(wre_ + (size_t)c * 32 + q * 4); }
        Lgb[tid] = (tid < 256) ? *(const f32x4*)(a->in[14] + l * 1024 + tid * 4) : *(const f32x4*)(a->in[15] + l * 1024 + (tid - 256) * 4);
    }
    __syncthreads();
    const float* mod = (const float*)(a->ws + WS_MOD) + (size_t)l * 5 * 6144;
    const bf16_t* Y = (const bf16_t*)(a->ws + WS_Y);
    float* X1 = (float*)(a->ws + WS_X1);
    unsigned char* H8 = a->ws + WS_H8;
    int* tokE = (int*)(a->ws + WS_TOKE); int* tokR = (int*)(a->ws + WS_TOKR); float* tokG = (float*)(a->ws + WS_TOKG);
    const int tstep = gridDim.x * 8;
    f32x4 nx[4]; u32x2 ny[4];
    {   const int t = blockIdx.x * 8 + w;
        if (t < ntok) { const float* xs = (l == 0) ? ((t < NLAT) ? a->in[0] + (size_t)t * D : a->in[2] + (size_t)(t - NLAT) * D) : (const float*)(a->ws + WS_XC) + (size_t)t * D;
#pragma unroll
            for (int i = 0; i < 4; ++i) { nx[i] = *(const f32x4*)(xs + 256 * i + 4 * lane); ny[i] = *(const u32x2*)(Y + (size_t)t * D + 256 * i + 4 * lane); } } }
    int mrow = -1; f32x4 mg[4], msh[4], msc[4];
    for (int t = blockIdx.x * 8 + w; t < ntok; t += tstep) {
        const int mr = (t < NLAT) ? (t >> 12) : 4;
        if (mr != mrow) { mrow = mr; const float* m = mod + (size_t)mr * 6144;
#pragma unroll
            for (int i = 0; i < 4; ++i) { const int c = 256 * i + 4 * lane; mg[i] = *(const f32x4*)(m + 2048 + c); msh[i] = *(const f32x4*)(m + 3072 + c); msc[i] = *(const f32x4*)(m + 4096 + c); } }
        f32x4 v[4];
#pragma unroll
        for (int i = 0; i < 4; ++i) { const f32x4 yv = (f32x4){lo2f(ny[i].x), hi2f(ny[i].x), lo2f(ny[i].y), hi2f(ny[i].y)};
#pragma unroll
            for (int e = 0; e < 4; ++e) v[i][e] = RES_ALPHA * nx[i][e] + mg[i][e] * yv[e]; }
        {   const int tn = t + tstep;
            if (tn < ntok) { const float* xs = (l == 0) ? ((tn < NLAT) ? a->in[0] + (size_t)tn * D : a->in[2] + (size_t)(tn - NLAT) * D) : (const float*)(a->ws + WS_XC) + (size_t)tn * D;
#pragma unroll
                for (int i = 0; i < 4; ++i) { nx[i] = *(const f32x4*)(xs + 256 * i + 4 * lane); ny[i] = *(const u32x2*)(Y + (size_t)tn * D + 256 * i + 4 * lane); } } }
        float mean, rstd; ln_stats(v, mean, rstd);
#pragma unroll
        for (int i = 0; i < 4; ++i) { const int c = 256 * i + 4 * lane; const f32x4 gg = Lgb[64 * i + lane], bb = Lgb[256 + 64 * i + lane];
#pragma unroll
            for (int e = 0; e < 4; ++e) v[i][e] = (v[i][e] - mean) * rstd * gg[e] + bb[e];
            *(f32x4*)(X1 + (size_t)t * D + c) = v[i]; }
        ln_stats(v, mean, rstd);
#pragma unroll
        for (int i = 0; i < 4; ++i) { const int c = 256 * i + 4 * lane; const f32x4 sh = msh[i], sc = msc[i];
#pragma unroll
            for (int e = 0; e < 4; ++e) v[i][e] = (v[i][e] - mean) * rstd * (1.0f + sc[e]) + sh[e];
            *(unsigned*)(H8 + (size_t)t * D + c) = pack4_fp8(v[i][0], v[i][1], v[i][2], v[i][3]); }
        f32x2 lg01 = (f32x2){0.f, 0.f}, lg23 = (f32x2){0.f, 0.f};
#pragma unroll
        for (int i = 0; i < 4; ++i)
#pragma unroll
            for (int e = 0; e < 4; ++e) { const f32x4 wv = Lg[((i * 4 + e) << 6) + lane]; const f32x2 vv = (f32x2){v[i][e], v[i][e]};
                lg01 += vv * (f32x2){wv[0], wv[1]}; lg23 += vv * (f32x2){wv[2], wv[3]}; }
        float lg[4] = {wave_sum(lg01[0]), wave_sum(lg01[1]), wave_sum(lg23[0]), wave_sum(lg23[1])};
        int grp = 0; float mx = lg[0];
#pragma unroll
        for (int q = 1; q < 4; ++q) if (lg[q] > mx) { mx = lg[q]; grp = q; }
        float se = 0.f;
#pragma unroll
        for (int q = 0; q < 4; ++q) se += expf(lg[q] - mx);
        const float gate_group = 1.0f / se;
        f32x2 le01 = (f32x2){0.f, 0.f}, le23 = (f32x2){0.f, 0.f}, le45 = (f32x2){0.f, 0.f}, le67 = (f32x2){0.f, 0.f};
#pragma unroll
        for (int i = 0; i < 4; ++i)
#pragma unroll
            for (int e = 0; e < 4; ++e) { const f32x4* wp = Le + grp * 2048 + ((i * 4 + e) << 6) + lane; const f32x4 w0 = wp[0], w1 = wp[1024]; const f32x2 vv = (f32x2){v[i][e], v[i][e]};
                le01 += vv * (f32x2){w0[0], w0[1]}; le23 += vv * (f32x2){w0[2], w0[3]}; le45 += vv * (f32x2){w1[0], w1[1]}; le67 += vv * (f32x2){w1[2], w1[3]}; }
        float le[8] = {wave_sum(le01[0]), wave_sum(le01[1]), wave_sum(le23[0]), wave_sum(le23[1]), wave_sum(le45[0]), wave_sum(le45[1]), wave_sum(le67[0]), wave_sum(le67[1])};
        int j1 = 0; float l1 = le[0];
#pragma unroll
        for (int q = 1; q < 8; ++q) if (le[q] > l1) { l1 = le[q]; j1 = q; }
        int j2 = -1; float l2 = -3.0e38f;
#pragma unroll
        for (int q = 0; q < 8; ++q) if (q != j1 && le[q] > l2) { l2 = le[q]; j2 = q; }
        const float e2 = expf(l2 - l1), p1 = 1.0f / (1.0f + e2), p2 = e2 / (1.0f + e2);
        if (lane == 0) {
            const int ex0 = grp * 8 + j1, ex1 = grp * 8 + j2;
            const int r0 = atomicAdd(&cnt[ex0], 1), r1 = atomicAdd(&cnt[ex1], 1);
            tokE[2 * t] = ex0; tokE[2 * t + 1] = ex1; tokR[2 * t] = r0; tokR[2 * t + 1] = r1;
            tokG[2 * t] = gate_group * p1; tokG[2 * t + 1] = gate_group * p2;
        }
    }
    __syncthreads();
    if (tid < 32) ((int*)(a->ws + WS_BCNT))[((size_t)l * MAXG + blockIdx.x) * 32 + tid] = cnt[tid];
    __syncthreads();
}

__device__ __forceinline__ void p5_dispatch(AP a, unsigned char* lds, int l) {
    const int tid = tid_opaque();
    const int ntok = (l == 0) ? NTOK : NLAT;
    int* part = (int*)lds;
    int* tot = (int*)(lds + 4096);
    int* off = (int*)(lds + 4096 + 128);
    int* pstart = (int*)(lds + 4096 + 256);
    const int* bc = (const int*)(a->ws + WS_BCNT) + (size_t)l * MAXG * 32;
    const int G = gridDim.x, me = blockIdx.x;
    { const int e = tid & 31, p = tid >> 5; int s = 0, so = 0; for (int bb = p; bb < G; bb += 16) { const int c = bc[bb * 32 + e]; s += c; if (bb < me) so += c; } part[p * 32 + e] = s; part[512 + p * 32 + e] = so; }
    __syncthreads();
    if (tid < 32) { int s = 0, so = 0; for (int p = 0; p < 16; ++p) { s += part[p * 32 + tid]; so += part[512 + p * 32 + tid]; } tot[tid] = s; off[tid] = so; }
    __syncthreads();
    if (tid == 0) { int acc = 0; for (int e = 0; e < 32; ++e) { pstart[e] = acc; acc += ((tot[e] + 255) >> 8) << 8; } }
    __syncthreads();
    if (me == 0 && tid < 32) ((int*)(a->ws + WS_CNT))[l * 32 + tid] = tot[tid];
    const int* tokE = (const int*)(a->ws + WS_TOKE); const int* tokR = (const int*)(a->ws + WS_TOKR);
    int* tokS = (int*)(a->ws + WS_TOKS); int* slotT = (int*)(a->ws + WS_SLOTT);
    for (int q = tid; ; q += NT) { const int it = q >> 4, j = q & 15, t = (it * G + me) * 8 + (j >> 1); if (t >= ntok) break;
        const int idx = 2 * t + (j & 1); const int e = tokE[idx]; const int slot = pstart[e] + off[e] + tokR[idx]; tokS[idx] = slot; slotT[slot] = t; }
    __syncthreads();
}

__device__ __forceinline__ void moe_table(AP a, int l, LAS int* blk) {
    const int* tot = (const int*)(a->ws + WS_CNT) + l * 32;
    __syncthreads();
    if (threadIdx.x < 32) blk[33 + threadIdx.x] = tot[threadIdx.x];
    __syncthreads();
    if (threadIdx.x == 0) { int acc = 0; for (int e = 0; e < 32; ++e) { blk[e] = acc; acc += (blk[33 + e] + 255) >> 8; } blk[32] = acc; }
    __syncthreads();
}
__device__ __forceinline__ int units_of(int nu, int v, int G) { return (v < nu) ? (nu - v + G - 1) / G : 0; }
__device__ __forceinline__ void p1_inproj(AP a, unsigned char* smem, LAS unsigned char* lds, int l) {
    SchedInProj S; S.ws = a->ws; S.l = l; S.G = gridDim.x; S.me = vblock();
    g256::gemm_phase(lds, 1024, S);
    { const int nu = (l == 0) ? 64 * 7 + 4 * 7 : 64 * 7 + 4, G = gridDim.x; if (units_of(nu, S.me, G) < (nu + G - 1) / G) exp_fill(a, smem, l, 8); }
}
__device__ __forceinline__ void p3_outproj(AP a, unsigned char* smem, LAS unsigned char* lds, int l) {
    SchedOutProj S; S.ws = a->ws; S.l = l; S.G = gridDim.x; S.me = vblock();
    g256::gemm_phase(lds, 1024, S);
    if (l == 0) {
        const bf16_t* W = (const bf16_t*)(a->ws + WS_WOUT);
        for (int u = blockIdx.x; u < 64; u += gridDim.x) { const int rt = u >> 3, ct = u & 7;
            EpiBf16 E; E.C = (bf16_t*)(a->ws + WS_Y) + (size_t)(NLAT + rt * 128) * D + ct * 128; E.ld = D; E.scale = 1.0f;
            const bf16_t* B0 = W + (size_t)(ct * 128) * 1024;
            gemm_tile<128, false, EpiBf16>(lds, (const bf16_t*)(a->ws + WS_CAT) + (size_t)(NLAT + rt * 128) * D, D, nullptr, 128, B0, B0 + (size_t)64 * 1024, 1024, 1024, E); }
        if (blockIdx.x >= 64) exp_fill(a, smem, 0, 3);
    }
}
__device__ __forceinline__ void p6_gateup(AP a, unsigned char* smem, LAS unsigned char* lds, int l) {
    LAS int* blk = (LAS int*)(lds + MISC_OFF + 256);
    moe_table(a, l, blk);
    LAS int* ridx = (LAS int*)(lds + RIDX_OFF);
    const int tid = tid_opaque(), G = gridDim.x, me = vblock(), nu = uni(blk[32]) * 4;
    LAS int* uinf = (LAS int*)(lds + MISC_OFF + 528);
    moe_units(blk, uinf, G, me);
    const int* slotT = (const int*)(a->ws + WS_SLOTT);
    for (int i = 0; i < 8; ++i) { const int idx = i * G + me; if (idx >= nu) break;
        const int rb = idx >> 2, valid = uinf[2 * i + 1];
        if (tid < 256) ridx[i * 256 + tid] = (tid < valid) ? slotT[rb * 256 + tid] : 0; }
    __syncthreads();
    SchedGateUp S; S.ws = a->ws; S.uinf = uinf; S.ridx_lds = ridx; S.G = G; S.me = me; S.l = l; S.nu = nu;
    g256::gemm_phase(lds, 512, S);
    __syncthreads();
    if (l == 0 && units_of(nu, me, G) < (nu + G - 1) / G) exp_fill(a, smem, 1, 4);
}
__device__ __forceinline__ void p7_down(AP a, unsigned char* smem, LAS unsigned char* lds, int l) {
    LAS int* blk = (LAS int*)(lds + MISC_OFF + 256);
    moe_table(a, l, blk);
    LAS int* uinf = (LAS int*)(lds + MISC_OFF + 528);
    SchedDown S; S.ws = a->ws; S.uinf = uinf; S.G = gridDim.x; S.me = vblock(); S.l = l; S.nu = uni(blk[32]) * 4;
    moe_units(blk, uinf, S.G, S.me);
    g256::gemm_phase(lds, 256, S);
    __syncthreads();
    { const int nu = S.nu, G = gridDim.x; if (l == 0 && units_of(nu, S.me, G) < (nu + G - 1) / G) exp_fill(a, smem, 1, 2); }
}

__device__ __forceinline__ void p8_ln2(AP a, unsigned char* lds, int l) {
    const int tid = tid_opaque(), lane = tid & 63, w = tid >> 6;
    const int ntok = (l == 0) ? NTOK : NLAT;
    const float* mod = (const float*)(a->ws + WS_MOD) + (size_t)l * 5 * 6144;
    const float* modn = (const float*)(a->ws + WS_MOD) + (size_t)5 * 6144;
    const float* X1 = (const float*)(a->ws + WS_X1);
    const unsigned char* YS = a->ws + WS_YS;
    const int* tokS = (const int*)(a->ws + WS_TOKS); const float* tokG = (const float*)(a->ws + WS_TOKG);
    f32x4* Lgb = (f32x4*)lds;
    __syncthreads();
    Lgb[tid] = (tid < 256) ? *(const f32x4*)(a->in[21] + l * 1024 + tid * 4) : *(const f32x4*)(a->in[22] + l * 1024 + (tid - 256) * 4);
    __syncthreads();
    int mrow = -1; f32x4 mg[4], nsh[4], nsc[4];
    const int tstep = gridDim.x * 8;
    int t = blockIdx.x * 8 + w;
    int ns0 = 0, ns1 = 0; float nga = 0.f, ngb = 0.f;
    f32x4 nx[4]; unsigned nya[4], nyb[4];
    float cga = 0.f, cgb = 0.f;
    if (t < ntok) { const int s0 = tokS[2 * t], s1 = tokS[2 * t + 1]; cga = tokG[2 * t]; cgb = tokG[2 * t + 1];
#pragma unroll
        for (int i = 0; i < 4; ++i) { const int c = 256 * i + 4 * lane; nx[i] = *(const f32x4*)(X1 + (size_t)t * D + c); nya[i] = *(const unsigned*)(YS + (size_t)s0 * D + c); nyb[i] = *(const unsigned*)(YS + (size_t)s1 * D + c); } }
    if (t + tstep < ntok) { ns0 = tokS[2 * (t + tstep)]; ns1 = tokS[2 * (t + tstep) + 1]; nga = tokG[2 * (t + tstep)]; ngb = tokG[2 * (t + tstep) + 1]; }
    for (; t < ntok; t += tstep) {
        const int mr = (t < NLAT) ? (t >> 12) : 4;
        if (mr != mrow) { mrow = mr; const float* m = mod + (size_t)mr * 6144; const float* mn = modn + (size_t)mr * 6144;
#pragma unroll
            for (int i = 0; i < 4; ++i) { const int c = 256 * i + 4 * lane; mg[i] = *(const f32x4*)(m + 5120 + c); if (l == 0) { nsh[i] = *(const f32x4*)(mn + c); nsc[i] = *(const f32x4*)(mn + 1024 + c); } } }
        f32x4 v[4];
#pragma unroll
        for (int i = 0; i < 4; ++i) { const f32x4 gv = mg[i];
            const f32x2 ya0 = __builtin_amdgcn_cvt_pk_f32_fp8(nya[i], false), ya1 = __builtin_amdgcn_cvt_pk_f32_fp8(nya[i], true), yb0 = __builtin_amdgcn_cvt_pk_f32_fp8(nyb[i], false), yb1 = __builtin_amdgcn_cvt_pk_f32_fp8(nyb[i], true);
            const float f0 = cga * ya0[0] + cgb * yb0[0], f1 = cga * ya0[1] + cgb * yb0[1], f2 = cga * ya1[0] + cgb * yb1[0], f3 = cga * ya1[1] + cgb * yb1[1];
            v[i][0] = RES_ALPHA * nx[i][0] + gv[0] * f0; v[i][1] = RES_ALPHA * nx[i][1] + gv[1] * f1; v[i][2] = RES_ALPHA * nx[i][2] + gv[2] * f2; v[i][3] = RES_ALPHA * nx[i][3] + gv[3] * f3; }
        {   const int tn = t + tstep, tn2 = t + 2 * tstep;
            if (tn < ntok) {
#pragma unroll
                for (int i = 0; i < 4; ++i) { const int c = 256 * i + 4 * lane; nx[i] = *(const f32x4*)(X1 + (size_t)tn * D + c); nya[i] = *(const unsigned*)(YS + (size_t)ns0 * D + c); nyb[i] = *(const unsigned*)(YS + (size_t)ns1 * D + c); }
                cga = nga; cgb = ngb; }
            if (tn2 < ntok) { ns0 = tokS[2 * tn2]; ns1 = tokS[2 * tn2 + 1]; nga = tokG[2 * tn2]; ngb = tokG[2 * tn2 + 1]; } }
        float mean, rstd; ln_stats(v, mean, rstd);
        float* dst = (l == 0) ? (float*)(a->ws + WS_XC) + (size_t)t * D : a->out + (size_t)t * D;
#pragma unroll
        for (int i = 0; i < 4; ++i) { const int c = 256 * i + 4 * lane; const f32x4 gg = Lgb[64 * i + lane], bb = Lgb[256 + 64 * i + lane];
#pragma unroll
            for (int e = 0; e < 4; ++e) v[i][e] = (v[i][e] - mean) * rstd * gg[e] + bb[e];
            *(f32x4*)(dst + c) = v[i]; }
        if (l == 0) {
            ln_stats(v, mean, rstd);
            bf16_t* H = (bf16_t*)(a->ws + WS_H);
#pragma unroll
            for (int i = 0; i < 4; ++i) { const int c = 256 * i + 4 * lane; const f32x4 sh = nsh[i], sc = nsc[i];
                f32x4 o;
#pragma unroll
                for (int e = 0; e < 4; ++e) o[e] = (v[i][e] - mean) * rstd * (1.0f + sc[e]) + sh[e];
                u32x2 pk; pk.x = pack2(o[0], o[1]); pk.y = pack2(o[2], o[3]); *(u32x2*)(H + (size_t)t * D + c) = pk; }
        }
    }
}

constexpr int N_PHASES = 18;
template <int P> __device__ __forceinline__ void run_phase(AP a, unsigned char* smem, LAS unsigned char* lds, int l) {
    asm volatile("" : "+s"(a));
    if (P == 0) p0_prologue(a, smem);
    if (P == 1) p_lnmod0(a);
    if (P == 2) p1_inproj(a, smem, lds, l);
    if (P == 3) p2_mix(a, smem, lds, l);
    if (P == 4) p3_outproj(a, smem, lds, l);
    if (P == 5) p4_ln1_router(a, smem, l);
    if (P == 6) p5_dispatch(a, smem, l);
    if (P == 7) p6_gateup(a, smem, lds, l);
    if (P == 8) p7_down(a, smem, lds, l);
    if (P == 9) p8_ln2(a, smem, l);
}
#if N_LAUNCH_MODE == 1
__global__ void __launch_bounds__(NT, 2) fwd(Args a) {
    extern __shared__ __attribute__((aligned(16))) unsigned char smem[];
    LAS unsigned char* lds = (LAS unsigned char*)smem;
    if (threadIdx.x < 4) ((volatile LAS unsigned*)(lds + MISC_OFF + 768))[threadIdx.x] = 0u;
    __syncthreads();
    XcdBarrier bar = xcd_barrier_post((unsigned*)(a.ws + WS_BAR), (volatile LAS unsigned*)(lds + MISC_OFF + 768));
    AP ap = (AP)__builtin_amdgcn_kernarg_segment_ptr();
#define PROBE(P, l) do { if (PROBE_MASK & (1 << (P))) { for (int _r = 0; _r < 2; ++_r) { xcd_barrier(bar); run_phase<P>(ap, smem, lds, l); } } } while (0)
    run_phase<0>(ap, smem, lds, 0); PROBE(0, 0); xcd_barrier(bar);
    run_phase<1>(ap, smem, lds, 0); PROBE(1, 0); xcd_barrier(bar);
    for (int l = 0; l < 2; ++l) {
        run_phase<2>(ap, smem, lds, l); PROBE(2, l); xcd_barrier(bar);
        run_phase<3>(ap, smem, lds, l); PROBE(3, l); xcd_barrier(bar);
        run_phase<4>(ap, smem, lds, l); PROBE(4, l); xcd_barrier(bar);
        run_phase<5>(ap, smem, lds, l); PROBE(5, l); xcd_barrier(bar);
        run_phase<6>(ap, smem, lds, l); PROBE(6, l); xcd_barrier(bar);
        run_phase<7>(ap, smem, lds, l); PROBE(7, l); xcd_barrier(bar);
        run_phase<8>(ap, smem, lds, l); PROBE(8, l); xcd_barrier(bar);
        run_phase<9>(ap, smem, lds, l); PROBE(9, l); if (l == 0) xcd_barrier(bar);
    }
}
#else
template <int P> __global__ void __launch_bounds__(NT, 2) k_phase(Args a) {
    extern __shared__ __attribute__((aligned(16))) unsigned char smem[];
    LAS unsigned char* lds = (LAS unsigned char*)smem;
    AP ap = (AP)__builtin_amdgcn_kernarg_segment_ptr();
    run_phase<P>(ap, smem, lds, ap->ph_lo);
}
template <int P> static void launch_phase(Args a, int l, int grid, hipStream_t stream) {
    static bool attr = false;
    if (!attr) { (void)hipFuncSetAttribute((const void*)k_phase<P>, hipFuncAttributeMaxDynamicSharedMemorySize, LDS_BYTES); attr = true; }
    a.ph_lo = l; a.ph_hi = P;
    hipLaunchKernelGGL(k_phase<P>, dim3(grid), dim3(NT), LDS_BYTES, stream, a);
}
#endif

extern "C" void kernel_launch(void* const* d_in, const int* in_sizes, int n_in, void* d_out, int out_size, void* d_ws, size_t ws_size, hipStream_t stream) {
    static int grid = 0;
    if (grid == 0) {
        if (n_in != 23 || out_size != NLAT * D || ws_size < WS_END) { fprintf(stderr, "kernel_launch: unexpected shapes (n_in %d, out %d, ws %zu, need %zu)\n", n_in, out_size, ws_size, (size_t)WS_END); grid = -1; return; }
        int dev = 0, cus = 0;
        if (hipGetDevice(&dev) != hipSuccess || hipDeviceGetAttribute(&cus, hipDeviceAttributeMultiprocessorCount, dev) != hipSuccess) { grid = -1; return; }
#if N_LAUNCH_MODE == 1
        int per_cu = 0;
        if (hipFuncSetAttribute((const void*)fwd, hipFuncAttributeMaxDynamicSharedMemorySize, LDS_BYTES) != hipSuccess) { fprintf(stderr, "kernel_launch: hipFuncSetAttribute failed\n"); grid = -1; return; }
        if (hipOccupancyMaxActiveBlocksPerMultiprocessor(&per_cu, (const void*)fwd, NT, LDS_BYTES) != hipSuccess || per_cu < 1) { fprintf(stderr, "kernel_launch: occupancy query says %d\n", per_cu); }
        (void)hipGetLastError();
#endif
        grid = cus; if (grid > MAXG) grid = MAXG;
    }
    if (grid < 0) return;
    (void)hipMemsetAsync((char*)d_ws + WS_BAR, 0, 16384 + 256, stream);
    Args a{};
    for (int i = 0; i < 23; ++i) a.in[i] = (const float*)d_in[i];
    a.out = (float*)d_out; a.ws = (unsigned char*)d_ws;
#if N_LAUNCH_MODE == 1
    a.ph_lo = 0; a.ph_hi = N_PHASES;
    hipLaunchKernelGGL(fwd, dim3(grid), dim3(NT), LDS_BYTES, stream, a);
#else
    launch_phase<0>(a, 0, grid, stream);
    launch_phase<1>(a, 0, grid, stream);
    for (int l = 0; l < 2; ++l) {
        launch_phase<2>(a, l, grid, stream); launch_phase<3>(a, l, grid, stream); launch_phase<4>(a, l, grid, stream); launch_phase<5>(a, l, grid, stream);
        launch_phase<6>(a, l, grid, stream); launch_phase<7>(a, l, grid, stream); launch_phase<8>(a, l, grid, stream); launch_phase<9>(a, l, grid, stream);
    }
#endif
}
```

```cpp
#include <hip/hip_runtime.h>
#include <stdint.h>
#include <stdio.h>

#ifndef PROBE_MASK
#define PROBE_MASK 0
#endif
#ifndef PROBE_FFT_REP
#define PROBE_FFT_REP 1
#endif
#ifndef PROBE_MIX_REP
#define PROBE_MIX_REP 1
#endif
#ifndef PROBE_SGU_REP
#define PROBE_SGU_REP 1
#endif
#ifndef N_LAUNCH_MODE
#define N_LAUNCH_MODE 1
#endif

#define LAS __attribute__((address_space(3)))
typedef unsigned short bf16_t;
typedef short bf16x8 __attribute__((ext_vector_type(8)));
typedef float f32x4 __attribute__((ext_vector_type(4)));
typedef unsigned u32x4 __attribute__((ext_vector_type(4)));
typedef unsigned u32x2 __attribute__((ext_vector_type(2)));
typedef float f32x2 __attribute__((ext_vector_type(2)));
typedef int i32x4 __attribute__((ext_vector_type(4)));

constexpr int D = 1024, NBATCH = 4, SEQ = 4096, CTXL = 256;
constexpr int NLAT = NBATCH * SEQ, NCTX = NBATCH * CTXL, NTOK = NLAT + NCTX;
constexpr int ZC = 1792;
constexpr int NEXP = 32, DEXP = 512;
constexpr int NSLOT = 2 * NTOK + NEXP * 256;
constexpr int NT = 512;
constexpr int MAXG = 512;
constexpr float RES_ALPHA = 1.41421356237309515f;
constexpr int MISC_OFF = 155648;
constexpr int RIDX_OFF = 131072;
constexpr int LDS_BYTES = MISC_OFF + 1024;

constexpr size_t WS_BAR   = 0;
constexpr size_t WS_CNT   = 16384;
constexpr size_t WS_BCNT  = WS_CNT + 256;
constexpr size_t WS_MOD   = WS_BCNT + (size_t)2 * MAXG * 32 * 4;
constexpr size_t WS_ROPE  = WS_MOD + (size_t)2 * 5 * 6144 * 4;
constexpr size_t WS_TOKE  = WS_ROPE + 8192;
constexpr size_t WS_TOKR  = WS_TOKE + (size_t)NTOK * 8;
constexpr size_t WS_TOKS  = WS_TOKR + (size_t)NTOK * 8;
constexpr size_t WS_TOKG  = WS_TOKS + (size_t)NTOK * 8;
constexpr size_t WS_SLOTT = WS_TOKG + (size_t)NTOK * 8;
constexpr size_t WS_WIN   = WS_SLOTT + (size_t)NSLOT * 4;
constexpr size_t WS_WOUT  = WS_WIN + (size_t)2 * ZC * 1024 * 2;
constexpr size_t WS_WSGU  = WS_WOUT + (size_t)2 * 1024 * 1024 * 2;
constexpr size_t WS_DFTC  = WS_WSGU + (size_t)2 * 4 * 128 * 128 * 2;
constexpr size_t WS_WEXP  = WS_DFTC + (size_t)256 * 512 * 2;
constexpr size_t EXPMAT   = (size_t)NEXP * 512 * 1024;
constexpr size_t WEXP_LAYER = 3 * EXPMAT;
constexpr size_t WS_X1    = WS_WEXP + 2 * WEXP_LAYER;
constexpr size_t WS_XC    = WS_X1 + (size_t)NTOK * D * 4;
constexpr size_t WS_H     = WS_XC + (size_t)NTOK * D * 4;
constexpr size_t WS_R     = WS_H + (size_t)NTOK * D * 2;
constexpr size_t WS_Z     = WS_R;
constexpr size_t WS_AT    = WS_Z + (size_t)NTOK * ZC * 2;
constexpr size_t WS_ATC   = WS_AT + (size_t)4 * 256 * 8192 * 2;
constexpr size_t WS_VT    = WS_ATC + (size_t)4 * 256 * 512 * 2;
constexpr size_t WS_VTC   = WS_VT + (size_t)4 * 2 * 64 * 4096 * 2;
constexpr size_t WS_CAT   = WS_VTC + (size_t)4 * 2 * 64 * 256 * 2;
constexpr size_t WS_REND  = WS_CAT + (size_t)NTOK * D * 2;
constexpr size_t WS_Y     = WS_R;
constexpr size_t WS_HID   = WS_R;
constexpr size_t WS_YS    = WS_HID + (size_t)NSLOT * DEXP * 2;
constexpr size_t WS_REND2 = (WS_YS + (size_t)NSLOT * D * 2 > WS_REND) ? WS_YS + (size_t)NSLOT * D * 2 : WS_REND;
constexpr size_t WS_H8    = (WS_REND2 + 255) & ~(size_t)255;
constexpr size_t WS_END   = WS_H8 + (size_t)NTOK * D;
static_assert(WS_Y + (size_t)NTOK * D * 4 <= WS_CAT, "Y must not reach CAT");
static_assert(WS_WIN % 256 == 0 && WS_DFTC % 256 == 0 && WS_WEXP % 256 == 0 && WS_X1 % 256 == 0 && WS_H % 256 == 0 && WS_R % 256 == 0 && WS_AT % 256 == 0 && WS_CAT % 256 == 0 && WS_YS % 256 == 0, "alignment");

struct Args { const float* in[23]; float* out; unsigned char* ws; int ph_lo, ph_hi; };
#define CAS __attribute__((address_space(4)))
typedef const CAS Args* AP;

#define XB_TMO      128
#define XB_XCNT(j)  (256  + 64 * (j))
#define XB_XSUB(j)  (1280 + 64 * (j))
#define XB_XGEN(j)  (2304 + 64 * (j))
#define XB_TOP      3328
#define XB_TOPGEN   3392
#define XCD_BAR_WORDS 3456
#define XB_SPIN_CAP (1u << 18)

__device__ __forceinline__ unsigned xb_ld(unsigned* p)              { return __hip_atomic_load(p, __ATOMIC_RELAXED, __HIP_MEMORY_SCOPE_AGENT); }
__device__ __forceinline__ unsigned xb_add(unsigned* p, unsigned v) { return __hip_atomic_fetch_add(p, v, __ATOMIC_RELAXED, __HIP_MEMORY_SCOPE_AGENT); }
__device__ __forceinline__ unsigned xb_xcc_id() { return (unsigned)__builtin_amdgcn_s_getreg((3 << 11) | 20) & 0xFu; }
#define XB_SPIN(cond, bar) do { unsigned _sp = 0; while (cond) { __builtin_amdgcn_s_sleep(1); \
    if ((++_sp & 255u) == 0u) { if (xb_ld(&(bar)[XB_TMO])) break; if (_sp > XB_SPIN_CAP) { atomicAdd(&(bar)[XB_TMO], 1u); break; } } } } while (0)

struct XcdBarrier { unsigned* bar; unsigned x; volatile LAS unsigned* st; };

__device__ __forceinline__ XcdBarrier xcd_barrier_post(unsigned* bar, volatile LAS unsigned* st) {
    XcdBarrier b; b.bar = bar; b.x = (unsigned)__builtin_amdgcn_readfirstlane((int)xb_xcc_id()); b.st = st;
    if (threadIdx.x == 0) (void)xb_add(&bar[XB_XCNT(b.x)], 1u);
    return b;
}
__device__ __forceinline__ void xcd_barrier_complete(unsigned* bar, unsigned x, unsigned& nloc, unsigned& nx) {
    const unsigned G = gridDim.x * gridDim.y * gridDim.z;
    unsigned sum, cnt, mine, sp = 0u;
    for (;;) {
        sum = 0u; cnt = 0u; mine = 0u;
#pragma unroll
        for (unsigned j = 0; j < 16; ++j) { const unsigned c = xb_ld(&bar[XB_XCNT(j)]); sum += c; cnt += (c > 0u) ? 1u : 0u; mine = (j == x) ? c : mine; }
        if (sum == G) break;
        __builtin_amdgcn_s_sleep(1);
        if ((++sp & 255u) == 0u) { if (xb_ld(&bar[XB_TMO])) break; if (sp > XB_SPIN_CAP) { atomicAdd(&bar[XB_TMO], 1u); break; } }
    }
    nloc = mine > 0u ? mine : 1u; nx = cnt > 0u ? cnt : 1u;
}
__device__ __forceinline__ void xcd_barrier(const XcdBarrier& b) {
    asm volatile("s_waitcnt vmcnt(0)" ::: "memory");
    __syncthreads();
    if (threadIdx.x == 0) {
        unsigned* bar = b.bar;
        unsigned bx = b.x;
        asm volatile("" : "+s"(bar), "+s"(bx));
        __builtin_amdgcn_s_waitcnt(0);
        unsigned nloc = b.st[0], nx = b.st[1];
        if (nloc == 0u) { xcd_barrier_complete(bar, bx, nloc, nx); b.st[0] = nloc; b.st[1] = nx; }
        const unsigned old = xb_add(&bar[XB_XSUB(bx)], 1u);
        const unsigned gen = old / nloc;
        if (old + 1u == (gen + 1u) * nloc) {
            __builtin_amdgcn_fence(__ATOMIC_RELEASE, "agent");
            asm volatile("s_waitcnt vmcnt(0)" ::: "memory");
            const unsigned og = xb_add(&bar[XB_TOP], 1u);
            const unsigned tg = og / nx;
            if (og + 1u == (tg + 1u) * nx) xb_add(&bar[XB_TOPGEN], 1u);
            else XB_SPIN(xb_ld(&bar[XB_TOPGEN]) == tg, bar);
            __builtin_amdgcn_fence(__ATOMIC_ACQUIRE, "agent");
            xb_add(&bar[XB_XGEN(bx)], 1u);
            asm volatile("s_waitcnt vmcnt(0)" ::: "memory");
        } else {
            XB_SPIN(xb_ld(&bar[XB_XGEN(bx)]) == gen, bar);
            __builtin_amdgcn_fence(__ATOMIC_ACQUIRE, "agent");
            asm volatile("s_waitcnt vmcnt(0)" ::: "memory");
        }
    }
    __syncthreads();
}

__device__ __forceinline__ int tid_opaque() { int t = threadIdx.x; asm volatile("" : "+v"(t)); return t; }
__device__ __forceinline__ float bf2f(bf16_t v) { return __uint_as_float(((unsigned)v) << 16); }
__device__ __forceinline__ bf16_t f2bf(float f) { return __builtin_bit_cast(unsigned short, (__bf16)f); }
typedef __bf16 hwbf16x2 __attribute__((ext_vector_type(2)));
__device__ __forceinline__ unsigned pack2(float a, float b) { return __builtin_bit_cast(unsigned, __builtin_convertvector((f32x2){a, b}, hwbf16x2)); }
__device__ __forceinline__ unsigned pack4_fp8(float a, float b, float c, float d) {
    a = __builtin_amdgcn_fmed3f(a, -448.f, 448.f); b = __builtin_amdgcn_fmed3f(b, -448.f, 448.f); c = __builtin_amdgcn_fmed3f(c, -448.f, 448.f); d = __builtin_amdgcn_fmed3f(d, -448.f, 448.f);
    int p = __builtin_amdgcn_cvt_pk_fp8_f32(a, b, 0, false); p = __builtin_amdgcn_cvt_pk_fp8_f32(c, d, p, true); return (unsigned)p; }
__device__ __forceinline__ float lo2f(unsigned w) { return __uint_as_float(w << 16); }
__device__ __forceinline__ float hi2f(unsigned w) { return __uint_as_float(w & 0xffff0000u); }
template <int CTRL> __device__ __forceinline__ float dpp_mov(float v) { return __builtin_bit_cast(float, __builtin_amdgcn_update_dpp(0, __builtin_bit_cast(int, v), CTRL, 0xf, 0xf, true)); }
__device__ __forceinline__ float row_sum16(float v) {
    v += dpp_mov<0xB1>(v);
    v += dpp_mov<0x4E>(v);
    v += dpp_mov<0x141>(v);
    v += dpp_mov<0x140>(v);
    return v;
}
__device__ __forceinline__ float row_max16(float v) {
    v = fmaxf(v, dpp_mov<0xB1>(v)); v = fmaxf(v, dpp_mov<0x4E>(v)); v = fmaxf(v, dpp_mov<0x141>(v)); v = fmaxf(v, dpp_mov<0x140>(v));
    return v;
}
__device__ __forceinline__ float wave_sum(float v) {
    v = row_sum16(v);
    const int iv = __builtin_bit_cast(int, v);
    const float a0 = __builtin_bit_cast(float, __builtin_amdgcn_readlane(iv, 0)), a1 = __builtin_bit_cast(float, __builtin_amdgcn_readlane(iv, 16));
    const float a2 = __builtin_bit_cast(float, __builtin_amdgcn_readlane(iv, 32)), a3 = __builtin_bit_cast(float, __builtin_amdgcn_readlane(iv, 48));
    return (a0 + a1) + (a2 + a3);
}
__device__ __forceinline__ float gelu_erf(float v) {
    const float t = __builtin_amdgcn_rcpf(fabsf(v) * 0.2316418882f + 1.0f);
    float q = t * 0.5307027145f + (-0.7265760135f); q = q * t + 0.7107068705f; q = q * t + (-0.142248368f); q = q * t + 0.127414796f; q = q * t;
    const float m = v * (q * __builtin_amdgcn_exp2f((v * v) * (-0.72134752044f)));
    return v < 0.f ? m : v - m;
}
__device__ __forceinline__ float silu_f(float x) { return x * __builtin_amdgcn_rcpf(1.0f + __expf(-x)); }

__device__ __forceinline__ void ln_stats(const f32x4 (&v)[4], float& mean, float& rstd) {
    float s = 0.f;
#pragma unroll
    for (int i = 0; i < 4; ++i) s += (v[i][0] + v[i][1]) + (v[i][2] + v[i][3]);
    s = wave_sum(s); mean = s * (1.0f / 1024.0f);
    float q = 0.f;
#pragma unroll
    for (int i = 0; i < 4; ++i)
#pragma unroll
        for (int e = 0; e < 4; ++e) { const float d = v[i][e] - mean; q += d * d; }
    q = wave_sum(q); rstd = 1.0f / sqrtf(q * (1.0f / 1024.0f) + 1e-6f);
}

template <int BN> struct MfmaLayout {
    static constexpr int FG = BN / 128, NI = 4, NJ = 2 * FG;
    static constexpr bool PAIR8 = false;
    int rbase, cbase;
    __device__ __forceinline__ int row(int i) const { return rbase + 16 * i; }
    __device__ __forceinline__ int col(int jj) const { return (jj / FG) * (BN / 2) + (jj % FG) * 16 + cbase; }
};

__device__ __forceinline__ void glds16(const bf16_t* g, LAS unsigned char* l) {
    __builtin_amdgcn_global_load_lds((const unsigned*)g, (LAS unsigned*)l, 16, 0, 0);
}

template <int BN, bool GATHER, class Epi>
__device__ __forceinline__ void gemm_tile(LAS unsigned char* lds, const bf16_t* A, int lda, const int* rowidx, int valid_rows,
                                          const bf16_t* B0, const bf16_t* B1, int ldb, int K, const Epi& epi) {
    constexpr int A_B = 16384, B_B = BN * 128, STAGE = A_B + B_B, NBL = BN / 64;
    const int tid = tid_opaque(), lane = tid & 63, wid = __builtin_amdgcn_readfirstlane(tid >> 6);
    const bf16_t* ap[2]; const bf16_t* bp[NBL];
#pragma unroll
    for (int i = 0; i < 2; ++i) {
        const int P = i * 512 + tid, row = P >> 3, c = (P & 7) ^ ((row >> 1) & 7);
        size_t ro;
        if (GATHER) ro = (size_t)(row < valid_rows ? rowidx[row] : 0) * (size_t)lda; else ro = (size_t)row * (size_t)lda;
        ap[i] = A + ro + c * 8;
    }
#pragma unroll
    for (int i = 0; i < NBL; ++i) {
        const int P = i * 512 + tid, row = P >> 3, c = (P & 7) ^ ((row >> 1) & 7);
        const bf16_t* base = (row < BN / 2) ? (B0 + (size_t)row * ldb) : (B1 + (size_t)(row - BN / 2) * ldb);
        bp[i] = base + c * 8;
    }
    const int nk = K / 64;
#define GT_STAGE(buf, k0) do { \
        _Pragma("unroll") for (int _i = 0; _i < 2; ++_i) glds16(ap[_i] + (k0), lds + (buf) * STAGE + _i * 8192 + wid * 1024); \
        _Pragma("unroll") for (int _i = 0; _i < NBL; ++_i) glds16(bp[_i] + (k0), lds + (buf) * STAGE + A_B + _i * 8192 + wid * 1024); } while (0)

    typedef MfmaLayout<BN> Lay;
    constexpr int FG = Lay::FG;
    const int fr = lane & 15, g = lane >> 4, wr = wid >> 2, wc = wid & 3;
    Lay lay; lay.rbase = wr * 64 + fr; lay.cbase = wc * 16 * FG + 4 * g;
    f32x4 acc[Lay::NI][Lay::NJ];
#pragma unroll
    for (int i = 0; i < Lay::NI; ++i)
#pragma unroll
        for (int j = 0; j < Lay::NJ; ++j) acc[i][j] = (f32x4){0.f, 0.f, 0.f, 0.f};
    int aoff[4], boff[Lay::NJ];
#pragma unroll
    for (int m = 0; m < 4; ++m) { const int row = wr * 64 + m * 16 + fr; aoff[m] = row * 128 + ((g ^ ((row >> 1) & 7)) << 4); }
#pragma unroll
    for (int jj = 0; jj < Lay::NJ; ++jj) { const int row = (jj / FG) * (BN / 2) + wc * 16 * FG + (jj % FG) * 16 + fr; boff[jj] = A_B + row * 128 + ((g ^ ((row >> 1) & 7)) << 4); }
    GT_STAGE(0, 0);
    asm volatile("s_waitcnt vmcnt(0)" ::: "memory"); __syncthreads();
    for (int kt = 0; kt < nk; ++kt) {
        if (kt + 1 < nk) GT_STAGE((kt + 1) & 1, (kt + 1) * 64);
        const LAS unsigned char* sa = lds + (kt & 1) * STAGE;
#pragma unroll
        for (int ks = 0; ks < 2; ++ks) {
            bf16x8 af[4], bfv[Lay::NJ];
#pragma unroll
            for (int m = 0; m < 4; ++m) af[m] = *(const LAS bf16x8*)(sa + (aoff[m] ^ (ks << 6)));
#pragma unroll
            for (int jj = 0; jj < Lay::NJ; ++jj) bfv[jj] = *(const LAS bf16x8*)(sa + (boff[jj] ^ (ks << 6)));
#pragma unroll
            for (int m = 0; m < 4; ++m)
#pragma unroll
                for (int jj = 0; jj < Lay::NJ; ++jj) acc[m][jj] = __builtin_amdgcn_mfma_f32_16x16x32_bf16(bfv[jj], af[m], acc[m][jj], 0, 0, 0);
        }
        asm volatile("s_waitcnt vmcnt(0)" ::: "memory"); __syncthreads();
    }
    epi.run(acc, lay);
#undef GT_STAGE
}

namespace g256 {
constexpr int BK = 64, HALF = 128, HTB = HALF * BK * 2, STAGE_BYTES = 8 * HTB;
__device__ __forceinline__ int lds_byte(int r, int c) { const int st = (r >> 4) * 2 + (c >> 5), rr = r & 15, cc = c & 31, ob = rr * 64 + cc * 2; return st * 1024 + (ob ^ (((ob >> 9) & 1) << 5)); }
__device__ __forceinline__ int perm32(int rho) { const int n = rho >> 4, i = rho & 15; return 8 * (i >> 2) + 4 * n + (i & 3); }
__device__ __forceinline__ void stage_rc(int b, int& R, int& C) { const int st = b / 1024, sb = b % 1024, swz = sb ^ (((sb >> 9) & 1) << 5); R = (st >> 1) * 16 + swz / 64; C = (st & 1) * 32 + (swz % 64) / 2; }
struct Lay {
    static constexpr int NI = 8, NJ = 4;
    static constexpr bool PAIR8 = true;
    int rbase, cbase;
    __device__ __forceinline__ int row(int i) const { return (i >> 2) * 128 + (i & 3) * 16 + rbase; }
    __device__ __forceinline__ int col(int j) const { return (j >> 1) * 128 + (j & 1) * 4 + cbase; }
};
template <class Epi> struct Unit { const bf16_t* A; const bf16_t* B0; const bf16_t* B1; const LAS int* ridx; int valid; Epi epi; };

template <class Sched>
__device__ __forceinline__ void gemm_phase(LAS unsigned char* lds, const int K, const Sched& S) {
    typedef typename Sched::Epi Epi;
    const int tid = tid_opaque(), wid = __builtin_amdgcn_readfirstlane(tid >> 6), lane = tid & 63, wr = wid >> 2, wc = wid & 3, fr = lane & 15, fq = lane >> 4;
    int nt = K / BK; asm volatile("" : "+s"(nt));
    int sR[2], sC[2];
#pragma unroll
    for (int i = 0; i < 2; ++i) stage_rc(tid * 16 + i * 8192, sR[i], sC[i]);
    unsigned voffB[2];
#pragma unroll
    for (int i = 0; i < 2; ++i) voffB[i] = (unsigned)(((sR[i] & ~31) + perm32(sR[i] & 31)) * K + sC[i]) * 2u;
    const size_t kstep = (size_t)(BK * 2);
    const unsigned ldsw = (unsigned)wid * 1024u;
    const int aoff = lds_byte(wr * 64 + fr, fq * 8), boff = lds_byte(wc * 32 + fr, fq * 8);
#define G2_SA(b, h) (((b) * 2 + (h)) * HTB)
#define G2_SB(b, h) ((4 + (b) * 2 + (h)) * HTB)
#define G2_STAGE(bufoff, gbase, v0, v1) do { \
        __builtin_amdgcn_global_load_lds((const unsigned*)((const char*)(gbase) + (v0)), (LAS unsigned*)(lds + (bufoff) + ldsw), 16, 0, 0); \
        __builtin_amdgcn_global_load_lds((const unsigned*)((const char*)(gbase) + (v1)), (LAS unsigned*)(lds + (bufoff) + ldsw + 8192), 16, 0, 0); } while (0)
#define G2_LDA(dst, b, h) do { _Pragma("unroll") for (int m = 0; m < 4; ++m) _Pragma("unroll") for (int k = 0; k < 2; ++k) dst[m][k] = *(const LAS bf16x8*)(lds + G2_SA(b, h) + aoff + m * 2048 + k * 1024); } while (0)
#define G2_LDB(dst, b, h) do { _Pragma("unroll") for (int n = 0; n < 2; ++n) _Pragma("unroll") for (int k = 0; k < 2; ++k) dst[n][k] = *(const LAS bf16x8*)(lds + G2_SB(b, h) + boff + n * 2048 + k * 1024); } while (0)
#define G2_MMA(ai, bj, At, Bt) do { __builtin_amdgcn_s_setprio(1); _Pragma("unroll") for (int m = 0; m < 4; ++m) _Pragma("unroll") for (int n = 0; n < 2; ++n) _Pragma("unroll") for (int k = 0; k < 2; ++k) { \
        if (Sched::FP8) { const i32x4 _b = __builtin_bit_cast(i32x4, Bt[n][k]), _a = __builtin_bit_cast(i32x4, At[m][k]);     \
            acc[(ai) * 4 + m][(bj) * 2 + n] = __builtin_amdgcn_mfma_f32_16x16x32_fp8_fp8(((long)(unsigned)_b[1] << 32) | (unsigned)_b[0], ((long)(unsigned)_a[1] << 32) | (unsigned)_a[0], acc[(ai) * 4 + m][(bj) * 2 + n], 0, 0, 0); \
            acc[(ai) * 4 + m][(bj) * 2 + n] = __builtin_amdgcn_mfma_f32_16x16x32_fp8_fp8(((long)(unsigned)_b[3] << 32) | (unsigned)_b[2], ((long)(unsigned)_a[3] << 32) | (unsigned)_a[2], acc[(ai) * 4 + m][(bj) * 2 + n], 0, 0, 0); } \
        else acc[(ai) * 4 + m][(bj) * 2 + n] = __builtin_amdgcn_mfma_f32_16x16x32_bf16(Bt[n][k], At[m][k], acc[(ai) * 4 + m][(bj) * 2 + n], 0, 0, 0); } __builtin_amdgcn_s_setprio(0); } while (0)
#define G2_WAIT_V(n) asm volatile("s_waitcnt vmcnt(" #n ")" ::: "memory")
#define G2_WAIT_L(n) asm volatile("s_waitcnt lgkmcnt(" #n ")" ::: "memory")
#define G2_BAR __builtin_amdgcn_s_barrier()
#define G2_SCHED __builtin_amdgcn_sched_barrier(0)
#define G2_VOFFA(U, dst) do { _Pragma("unroll") for (int _h = 0; _h < 2; ++_h) _Pragma("unroll") for (int _i = 0; _i < 2; ++_i) { const int _row = _h * 128 + sR[_i]; \
        int _tok = _row; if (Sched::GATHER) _tok = (_row < (U).valid) ? (U).ridx[_row] : 0; dst[_h][_i] = (unsigned)(_tok * K + sC[_i]) * 2u; } } while (0)
    Unit<Epi> cur, nxt; int ui = 0;
    if (!S.get(0, cur)) return;
    f32x4 acc[8][4];
#pragma unroll
    for (int i = 0; i < 8; ++i)
#pragma unroll
        for (int j = 0; j < 4; ++j) acc[i][j] = (f32x4){0.f, 0.f, 0.f, 0.f};
    bf16x8 At[4][2], B0[2][2], B1[2][2];
    unsigned cvA[2][2], nvA[2][2];
    G2_VOFFA(cur, cvA);
    const char* cA = (const char*)cur.A; const char* cB0 = (const char*)cur.B0; const char* cB1 = (const char*)cur.B1;
    G2_STAGE(G2_SB(0, 0), cB0, voffB[0], voffB[1]); G2_STAGE(G2_SB(0, 1), cB1, voffB[0], voffB[1]); G2_STAGE(G2_SA(0, 0), cA, cvA[0][0], cvA[0][1]); G2_STAGE(G2_SA(0, 1), cA, cvA[1][0], cvA[1][1]);
    if (wr == 1) G2_BAR;
    G2_WAIT_V(2); G2_BAR;
    G2_STAGE(G2_SB(1, 0), cB0 + kstep, voffB[0], voffB[1]); G2_STAGE(G2_SA(1, 0), cA + kstep, cvA[0][0], cvA[0][1]); G2_STAGE(G2_SB(1, 1), cB1 + kstep, voffB[0], voffB[1]);
    G2_WAIT_V(6); G2_BAR;
    for (;;) {
        const bool has_next = S.get(ui + 1, nxt);
        if (Sched::GATHER) {
            if (has_next) { G2_VOFFA(nxt, nvA); }
            else {
#pragma unroll
                for (int h = 0; h < 2; ++h) { nvA[h][0] = cvA[h][0]; nvA[h][1] = cvA[h][1]; } }
        }
        const char* nA = has_next ? (const char*)nxt.A : cA; const char* nB0 = has_next ? (const char*)nxt.B0 : cB0; const char* nB1 = has_next ? (const char*)nxt.B1 : cB1;
#pragma unroll 1
        for (int t = 0; t < nt; t += 2) {
            const bool last = (t == nt - 2);
            const char* a1 = cA + (size_t)(t + 1) * kstep;
            const char* a2 = last ? nA : cA + (size_t)(t + 2) * kstep;
            const char* b20 = last ? nB0 : cB0 + (size_t)(t + 2) * kstep; const char* b21 = last ? nB1 : cB1 + (size_t)(t + 2) * kstep;
#define x00 ((Sched::GATHER && last) ? nvA[0][0] : cvA[0][0])
#define x01 ((Sched::GATHER && last) ? nvA[0][1] : cvA[0][1])
#define x10 ((Sched::GATHER && last) ? nvA[1][0] : cvA[1][0])
#define x11 ((Sched::GATHER && last) ? nvA[1][1] : cvA[1][1])
            G2_LDB(B0, 0, 0); G2_LDB(B1, 0, 1); G2_SCHED; G2_LDA(At, 0, 0); G2_STAGE(G2_SA(1, 1), a1, cvA[1][0], cvA[1][1]);
            G2_WAIT_V(8); G2_WAIT_L(0); G2_BAR; G2_MMA(0, 0, At, B0); G2_MMA(0, 1, At, B1); G2_BAR; G2_SCHED;
            G2_LDA(At, 0, 1); G2_STAGE(G2_SB(0, 0), b20, voffB[0], voffB[1]); G2_STAGE(G2_SB(0, 1), b21, voffB[0], voffB[1]); G2_STAGE(G2_SA(0, 0), a2, x00, x01);
            G2_WAIT_V(8); G2_WAIT_L(0); G2_BAR; G2_MMA(1, 0, At, B0); G2_MMA(1, 1, At, B1); G2_BAR; G2_SCHED;
            G2_LDB(B0, 1, 0); G2_LDB(B1, 1, 1); G2_SCHED; G2_LDA(At, 1, 0); G2_STAGE(G2_SA(0, 1), a2, x10, x11);
            G2_WAIT_V(8); G2_WAIT_L(0); G2_BAR; G2_MMA(0, 0, At, B0); G2_MMA(0, 1, At, B1); G2_BAR; G2_SCHED;
            G2_LDA(At, 1, 1); G2_STAGE(G2_SB(1, 0), b20 + kstep, voffB[0], voffB[1]); G2_STAGE(G2_SB(1, 1), b21 + kstep, voffB[0], voffB[1]); G2_STAGE(G2_SA(1, 0), a2 + kstep, x00, x01);
            G2_WAIT_V(8); G2_WAIT_L(0); G2_BAR; G2_MMA(1, 0, At, B0); G2_MMA(1, 1, At, B1); G2_BAR; G2_SCHED;
        }
        if (wr == 0) G2_BAR;
        { Lay lay; int rbv = wr * 64 + fr, cbv = wc * 32 + 8 * fq; asm volatile("" : "+v"(rbv), "+v"(cbv));
          lay.rbase = rbv; lay.cbase = cbv; cur.epi.run(acc, lay); }
        if (!has_next) break;
#pragma unroll
        for (int i = 0; i < 8; ++i)
#pragma unroll
            for (int j = 0; j < 4; ++j) acc[i][j] = (f32x4){0.f, 0.f, 0.f, 0.f};
        cur = nxt; cA = nA; cB0 = nB0; cB1 = nB1; ++ui;
        if (wr == 1) G2_BAR;
        if (Sched::GATHER) {
#pragma unroll
            for (int h = 0; h < 2; ++h) { cvA[h][0] = nvA[h][0]; cvA[h][1] = nvA[h][1]; } }
    }
#undef x00
#undef x01
#undef x10
#undef x11
    G2_WAIT_V(0);
    G2_BAR;
#undef G2_SA
#undef G2_SB
#undef G2_STAGE
#undef G2_LDA
#undef G2_LDB
#undef G2_MMA
#undef G2_WAIT_V
#undef G2_WAIT_L
#undef G2_BAR
#undef G2_SCHED
#undef G2_VOFFA
}
}

struct EpiF32 {
    float* C; int ld;
    template <class L> __device__ __forceinline__ void run(const f32x4 (&acc)[L::NI][L::NJ], const L& lay) const {
#pragma unroll
        for (int i = 0; i < L::NI; ++i)
#pragma unroll
            for (int j = 0; j < L::NJ; ++j) *(f32x4*)(C + (size_t)lay.row(i) * ld + lay.col(j)) = acc[i][j];
    }
};
struct EpiBf16 {
    bf16_t* C; int ld; float scale;
    template <class L> __device__ __forceinline__ void run(const f32x4 (&acc)[L::NI][L::NJ], const L& lay) const {
#pragma unroll
        for (int i = 0; i < L::NI; ++i) {
            if (L::PAIR8) {
#pragma unroll
                for (int j = 0; j < L::NJ; j += 2) { const f32x4 p = acc[i][j] * scale, q = acc[i][j + 1] * scale; u32x4 w; w.x = pack2(p[0], p[1]); w.y = pack2(p[2], p[3]); w.z = pack2(q[0], q[1]); w.w = pack2(q[2], q[3]);
                    *(u32x4*)(C + (size_t)lay.row(i) * ld + lay.col(j)) = w; }
            } else {
#pragma unroll
                for (int j = 0; j < L::NJ; ++j) { const f32x4 p = acc[i][j] * scale; u32x2 w; w.x = pack2(p[0], p[1]); w.y = pack2(p[2], p[3]);
                    *(u32x2*)(C + (size_t)lay.row(i) * ld + lay.col(j)) = w; }
            }
        }
    }
};
struct EpiFp8 {
    unsigned char* C; int ld; float scale;
    template <class L> __device__ __forceinline__ void run(const f32x4 (&acc)[L::NI][L::NJ], const L& lay) const {
        static_assert(L::PAIR8, "written for the paired-column layout");
#pragma unroll
        for (int i = 0; i < L::NI; ++i)
#pragma unroll
            for (int j = 0; j < L::NJ; j += 2) { const f32x4 p = acc[i][j] * scale, q = acc[i][j + 1] * scale; u32x2 w; w.x = pack4_fp8(p[0], p[1], p[2], p[3]); w.y = pack4_fp8(q[0], q[1], q[2], q[3]);
                *(u32x2*)(C + (size_t)lay.row(i) * ld + lay.col(j)) = w; }
    }
};
struct EpiGateUp8 {
    unsigned char* C; int ld;
    template <class L> __device__ __forceinline__ void run(const f32x4 (&acc)[L::NI][L::NJ], const L& lay) const {
        static_assert(L::PAIR8 && L::NJ == 4, "written for the paired-column 256x256 layout");
#pragma unroll
        for (int i = 0; i < L::NI; ++i) {
            const f32x4 g0 = acc[i][0] * (1.0f / 32.0f), g1 = acc[i][1] * (1.0f / 32.0f), u0 = acc[i][2] * (1.0f / 32.0f), u1 = acc[i][3] * (1.0f / 32.0f);
            u32x2 w; w.x = pack4_fp8(silu_f(g0[0]) * u0[0], silu_f(g0[1]) * u0[1], silu_f(g0[2]) * u0[2], silu_f(g0[3]) * u0[3]);
            w.y = pack4_fp8(silu_f(g1[0]) * u1[0], silu_f(g1[1]) * u1[1], silu_f(g1[2]) * u1[2], silu_f(g1[3]) * u1[3]);
            *(u32x2*)(C + (size_t)lay.row(i) * ld + lay.col(0)) = w;
        }
    }
};
struct EpiGateUp {
    bf16_t* C; int ld;
    template <class L> __device__ __forceinline__ void run(const f32x4 (&acc)[L::NI][L::NJ], const L& lay) const {
#pragma unroll
        for (int i = 0; i < L::NI; ++i) {
            if (L::PAIR8 && L::NJ == 4) {
                const f32x4 g0 = acc[i][0], g1 = acc[i][1], u0 = acc[i][2], u1 = acc[i][3];
                u32x4 w; w.x = pack2(silu_f(g0[0]) * u0[0], silu_f(g0[1]) * u0[1]); w.y = pack2(silu_f(g0[2]) * u0[2], silu_f(g0[3]) * u0[3]);
                w.z = pack2(silu_f(g1[0]) * u1[0], silu_f(g1[1]) * u1[1]); w.w = pack2(silu_f(g1[2]) * u1[2], silu_f(g1[3]) * u1[3]);
                *(u32x4*)(C + (size_t)lay.row(i) * ld + lay.col(0)) = w;
            } else {
#pragma unroll
                for (int j = 0; j < L::NJ / 2; ++j) { const f32x4 gt = acc[i][j], up = acc[i][j + L::NJ / 2];
                    u32x2 w; w.x = pack2(silu_f(gt[0]) * up[0], silu_f(gt[1]) * up[1]); w.y = pack2(silu_f(gt[2]) * up[2], silu_f(gt[3]) * up[3]);
                    *(u32x2*)(C + (size_t)lay.row(i) * ld + lay.col(j)) = w; }
            }
        }
    }
};
struct EpiInProj {
    bf16_t* Zt;
    bf16_t* tF;
    bf16_t* tV;
    int n0, pos0, n;
    template <class L> __device__ __forceinline__ void run(const f32x4 (&acc)[L::NI][L::NJ], const L& lay) const {
        static_assert(L::PAIR8, "written for the paired-column layout");
#pragma unroll
        for (int i = 0; i < L::NI; ++i)
#pragma unroll
            for (int j = 0; j < L::NJ; j += 2) {
                const int r = lay.row(i), cl = lay.col(j), c = n0 + cl;
                const f32x4 v0 = acc[i][j], v1 = acc[i][j + 1];
                if (c < 512) {
                    const int part = c >> 8, ch = c & 255;
#pragma unroll
                    for (int e = 0; e < 4; ++e) { tF[((size_t)(ch + e) * 2 + part) * n + pos0 + r] = f2bf(v0[e]); tF[((size_t)(ch + 4 + e) * 2 + part) * n + pos0 + r] = f2bf(v1[e]); }
                } else {
                    u32x4 w; w.x = pack2(v0[0], v0[1]); w.y = pack2(v0[2], v0[3]); w.z = pack2(v1[0], v1[1]); w.w = pack2(v1[2], v1[3]);
                    *(u32x4*)(Zt + (size_t)r * ZC + cl) = w;
                    if (c >= 896 && c < 1024) {
#pragma unroll
                        for (int e = 0; e < 4; ++e) { tV[(size_t)(c - 896 + e) * n + pos0 + r] = f2bf(v0[e]); tV[(size_t)(c - 896 + 4 + e) * n + pos0 + r] = f2bf(v1[e]); }
                    }
                }
            }
    }
};

constexpr int U_ADA = 192, U_WIN = 2 * 16 * 28, U_WOUT = 2 * 16 * 16, U_SGU = 32, U_DFT = 256, U_ROPE = 1, U_EXP = 3 * 32 * 32;
constexpr int LDS_SIL = 0, LDS_RED = 20480, LDS_TILE = 32768, LDS_T64 = 49408, LDS_CTAB = 50176;

__device__ __forceinline__ void ada_unit(AP a, unsigned char* lds, int u) {
    float* sil = (float*)(lds + LDS_SIL); float* red = (float*)(lds + LDS_RED);
    const int tid = tid_opaque(), lane = tid & 63, w = tid >> 6;
    const int l = u / 96, cg = u % 96;
    for (int i = tid; i < 5120; i += NT) { const int r = i >> 10, k = i & 1023; const float v = (r < 4) ? a->in[1][r * 1024 + k] : a->in[3][k]; sil[i] = v / (1.0f + expf(-v)); }
    __syncthreads();
    const float* W = a->in[4] + (size_t)l * 1024 * 6144 + cg * 64 + lane;
    float acc[5] = {0.f, 0.f, 0.f, 0.f, 0.f};
#pragma unroll 32
    for (int k = w * 128; k < w * 128 + 128; ++k) { const float wv = W[(size_t)k * 6144];
#pragma unroll
        for (int r = 0; r < 5; ++r) acc[r] += sil[r * 1024 + k] * wv; }
#pragma unroll
    for (int r = 0; r < 5; ++r) red[(w * 5 + r) * 64 + lane] = acc[r];
    __syncthreads();
    if (tid < 320) { const int r = tid >> 6; float s = 0.f;
#pragma unroll
        for (int ww = 0; ww < 8; ++ww) s += red[(ww * 5 + r) * 64 + lane];
        const int j = cg * 64 + lane; ((float*)(a->ws + WS_MOD))[(size_t)(l * 5 + r) * 6144 + j] = s + a->in[5][l * 6144 + j]; }
    __syncthreads();
}

__device__ __forceinline__ void tile_store_T(const float* tile, bf16_t* dst, int ldd) {
    const int tid = tid_opaque(), n = tid >> 3, kc = tid & 7;
    u32x4 w;
    w.x = pack2(tile[(kc * 8 + 0) * 65 + n], tile[(kc * 8 + 1) * 65 + n]); w.y = pack2(tile[(kc * 8 + 2) * 65 + n], tile[(kc * 8 + 3) * 65 + n]);
    w.z = pack2(tile[(kc * 8 + 4) * 65 + n], tile[(kc * 8 + 5) * 65 + n]); w.w = pack2(tile[(kc * 8 + 6) * 65 + n], tile[(kc * 8 + 7) * 65 + n]);
    *(u32x4*)(dst + (size_t)n * ldd + kc * 8) = w;
}
__device__ __forceinline__ void tile_load(float* tile, const float* src, int lds_) {
    const int tid = tid_opaque();
#pragma unroll
    for (int i = 0; i < 2; ++i) { const int row = (tid >> 4) + 32 * i, c4 = (tid & 15) * 4; const f32x4 v = *(const f32x4*)(src + (size_t)row * lds_ + c4);
        tile[row * 65 + c4 + 0] = v[0]; tile[row * 65 + c4 + 1] = v[1]; tile[row * 65 + c4 + 2] = v[2]; tile[row * 65 + c4 + 3] = v[3]; }
}

__device__ __forceinline__ void mm64_f32(const float* tA, int lda, const float* tB, int ldb, int K, float* out) {
    const int tid = tid_opaque(), lane = tid & 63, w = tid >> 6, fr = lane & 15, g = lane >> 4, mi = w >> 1, nj = 2 * (w & 1);
    f32x4 acc0 = (f32x4){0.f, 0.f, 0.f, 0.f}, acc1 = (f32x4){0.f, 0.f, 0.f, 0.f};
    const float* pa = tA + (16 * mi + fr) * lda + g; const float* pb = tB + g * ldb + 16 * nj + fr;
#pragma unroll 4
    for (int k0 = 0; k0 < K; k0 += 4) { const float av = pa[k0], b0 = pb[k0 * ldb], b1 = pb[k0 * ldb + 16];
        acc0 = __builtin_amdgcn_mfma_f32_16x16x4f32(av, b0, acc0, 0, 0, 0); acc1 = __builtin_amdgcn_mfma_f32_16x16x4f32(av, b1, acc1, 0, 0, 0); }
#pragma unroll
    for (int r = 0; r < 4; ++r) { out[(16 * mi + 4 * g + r) * 65 + 16 * nj + fr] = acc0[r]; out[(16 * mi + 4 * g + r) * 65 + 16 * nj + 16 + fr] = acc1[r]; }
}

__device__ __forceinline__ void win_unit(AP a, unsigned char* lds, int u) {
    float* tile = (float*)(lds + LDS_TILE); float* T = (float*)(lds + LDS_T64);
    const int tid = tid_opaque();
    const int l = u / 448, r = u % 448, kb = r / 28, nb = r % 28;
    const float* Win = a->in[6] + (size_t)l * 1024 * 1536;
    const int srccol = (nb >= 8) ? nb * 64 - 256 : (nb & 3) * 64;
    tile_load(tile, Win + (size_t)(kb * 64) * 1536 + srccol, 1536);
    if (nb < 8 && tid < 64) { T[tid] = cospif((float)tid / 32.0f); T[64 + tid] = sinpif((float)tid / 32.0f); }
    __syncthreads();
    bf16_t* dst = (bf16_t*)(a->ws + WS_WIN) + ((size_t)l * ZC + nb * 64) * 1024 + kb * 64;
    if (nb >= 8) tile_store_T(tile, dst, 1024);
    else {
        const int part = nb >> 2;
        float* Tm = (float*)(lds + 65536); float* out = (float*)(lds + 98304);
        for (int i = tid; i < 4096; i += NT) { const int c = i >> 6, cp = i & 63; const float t = T[part * 64 + ((c * cp) & 63)]; Tm[i] = (part ? -t : t) * 0.125f; }
        __syncthreads();
        mm64_f32(tile, 65, Tm, 64, 64, out);
        __syncthreads();
        tile_store_T(out, dst, 1024);
    }
    __syncthreads();
}

__device__ __forceinline__ void wout_unit(AP a, unsigned char* lds, int u) {
    float* tile = (float*)(lds + LDS_TILE);
    __syncthreads();
    const int tid = tid_opaque();
    const int l = u / 256, r = u % 256, kb = r / 16, nb = r % 16;
    const float* Wo = a->in[13] + (size_t)l * 1024 * 1024;
    const int n = tid & 63, kq = __builtin_amdgcn_readfirstlane(tid >> 6);
    if (kb < 4) {
        float* tA = (float*)lds; float* tB = (float*)(lds + 65536);
        const float* wf = a->in[7] + (size_t)l * 256 * 256 + (size_t)(kb * 64) * 256;
        __syncthreads();
        f32x4 va[8], vb[8];
#pragma unroll
        for (int i = 0; i < 8; ++i) { const int q = tid + 512 * i; va[i] = *(const f32x4*)(wf + (size_t)q * 4); vb[i] = *(const f32x4*)(Wo + (size_t)(q >> 4) * 1024 + nb * 64 + (q & 15) * 4); }
#pragma unroll
        for (int i = 0; i < 8; ++i) { const int q = tid + 512 * i; *(f32x4*)(tA + (size_t)q * 4) = va[i]; *(f32x4*)(tB + (size_t)q * 4) = vb[i]; }
        __syncthreads();
        tile = (float*)(lds + 133120);
        mm64_f32(tA, 256, tB, 64, 256, tile);
    } else if (kb >= 8 && kb < 12) {
        const int g = kb - 8;
        float* tA = (float*)lds; float* tB = (float*)(lds + 65536);
        const float* wp = a->in[9] + (size_t)(l * 4 + g) * 64 * 64;
        const float* ps = a->in[10] + l * 256 + g * 64;
        f32x4 va[2], vb[2];
#pragma unroll
        for (int i = 0; i < 2; ++i) { const int q = tid + 512 * i; va[i] = *(const f32x4*)(wp + (size_t)q * 4); vb[i] = *(const f32x4*)(Wo + (size_t)(512 + g * 64 + (q >> 4)) * 1024 + nb * 64 + (q & 15) * 4) * ps[q >> 4]; }
#pragma unroll
        for (int i = 0; i < 2; ++i) { const int q = tid + 512 * i; *(f32x4*)(tA + (size_t)q * 4) = va[i]; *(f32x4*)(tB + (size_t)q * 4) = vb[i]; }
        __syncthreads();
        tile = (float*)(lds + 133120);
        mm64_f32(tA, 64, tB, 64, 64, tile);
    } else tile_load(tile, Wo + (size_t)(kb * 64) * 1024 + nb * 64, 1024);
    __syncthreads();
    tile_store_T(tile, (bf16_t*)(a->ws + WS_WOUT) + ((size_t)l * 1024 + nb * 64) * 1024 + kb * 64, 1024);
    __syncthreads();
}

__device__ __forceinline__ void exp_src_dst(AP a, int l, int u, const float*& src, int& srcld, unsigned char*& dst, int& dstld) {
    const int mat = u / 1024, e = (u % 1024) / 32, t = u % 32;
    const int kb = (mat < 2) ? t / 4 : t / 8, nb = (mat < 2) ? t % 4 : t % 8;
    srcld = (mat < 2) ? 512 : 1024; dstld = (mat < 2) ? 1024 : 512;
    src = a->in[18 + mat] + ((size_t)(l * 32 + e) * 512 * 1024) + (size_t)(kb * 128) * srcld + nb * 128;
    dst = a->ws + WS_WEXP + (size_t)l * WEXP_LAYER + (size_t)mat * EXPMAT + (size_t)e * 512 * 1024 + (size_t)(nb * 128) * dstld + kb * 128;
}
#define EXP_LOAD(vv, uu) do { exp_src_dst(a, l, (uu), src, srcld, dst, dstld); _Pragma("unroll") for (int _i = 0; _i < 8; ++_i) vv[_i] = *(const f32x4*)(src + (size_t)((tid >> 5) + 16 * _i) * srcld + (tid & 31) * 4); } while (0)
#define EXP_PUT(vv) do { _Pragma("unroll") for (int _i = 0; _i < 8; ++_i) *(f32x4*)(tile + ((tid >> 5) + 16 * _i) * 132 + (tid & 31) * 4) = vv[_i] * 32.0f; } while (0)
#define EXP_STORE(dd, ld_) do { const int n = tid & 127, kq = tid >> 7;        \
        _Pragma("unroll") for (int j = 0; j < 2; ++j) { const float* tp = tile + (kq * 32 + j * 16) * 132 + n; u32x4 w; \
        w.x = pack4_fp8(tp[0], tp[132], tp[2 * 132], tp[3 * 132]); w.y = pack4_fp8(tp[4 * 132], tp[5 * 132], tp[6 * 132], tp[7 * 132]); \
        w.z = pack4_fp8(tp[8 * 132], tp[9 * 132], tp[10 * 132], tp[11 * 132]); w.w = pack4_fp8(tp[12 * 132], tp[13 * 132], tp[14 * 132], tp[15 * 132]); \
        *(u32x4*)((dd) + (size_t)n * (ld_) + kq * 32 + j * 16) = w; } } while (0)
__device__ __forceinline__ void exp_range(AP a, unsigned char* lds, int l, int u0, int u_end) {
    float* tile = (float*)lds;
    const int tid = tid_opaque();
    __syncthreads();
    if (u0 >= u_end) return;
    const float* src; unsigned char* dst; int srcld, dstld;
    f32x4 va[8], vb[8];
    unsigned char *da, *db = nullptr; int lda_, ldb_ = 0;
    EXP_LOAD(va, u0); da = dst; lda_ = dstld;
    if (u0 + 1 < u_end) { EXP_LOAD(vb, u0 + 1); db = dst; ldb_ = dstld; }
    for (int u = u0; u < u_end; u += 2) {
        EXP_PUT(va);
        __syncthreads();
        { unsigned char* cd = da; const int cl = lda_; if (u + 2 < u_end) { EXP_LOAD(va, u + 2); da = dst; lda_ = dstld; } EXP_STORE(cd, cl); }
        __syncthreads();
        if (u + 1 < u_end) {
            EXP_PUT(vb);
            __syncthreads();
            { unsigned char* cd = db; const int cl = ldb_; if (u + 3 < u_end) { EXP_LOAD(vb, u + 3); db = dst; ldb_ = dstld; } EXP_STORE(cd, cl); }
            __syncthreads();
        }
    }
}
#undef EXP_LOAD
#undef EXP_PUT
#undef EXP_STORE
__device__ __forceinline__ void exp_queue(AP a, unsigned char* lds, int l) {
    const int tid = tid_opaque();
    int* qslot = (int*)(lds + MISC_OFF + 128);
    unsigned* qc = (unsigned*)(a->ws + WS_BAR + 14336 + l * 256);
    for (;;) {
        __syncthreads();
        if (tid == 0) *qslot = (int)__hip_atomic_fetch_add(qc, 2u, __ATOMIC_RELAXED, __HIP_MEMORY_SCOPE_AGENT);
        __syncthreads();
        const int c0 = *qslot;
        if (c0 >= U_EXP) break;
        exp_range(a, lds, l, c0, c0 + 2);
    }
}

__device__ __forceinline__ void exp_fill(AP a, unsigned char* lds, int ql, int budget) {
    const int tid = tid_opaque();
    int* qslot = (int*)(lds + MISC_OFF + 128);
    unsigned* qc = (unsigned*)(a->ws + WS_BAR + 14336 + ql * 256);
    for (int done = 0; done < budget; done += 2) {
        __syncthreads();
        if (tid == 0) *qslot = (int)__hip_atomic_fetch_add(qc, 2u, __ATOMIC_RELAXED, __HIP_MEMORY_SCOPE_AGENT);
        __syncthreads();
        const int c0 = *qslot;
        if (c0 >= U_EXP) break;
        exp_range(a, lds, ql, c0, c0 + 2);
    }
    __syncthreads();
}

__device__ __forceinline__ void p0_prologue(AP a, unsigned char* lds) {
    const int tid = tid_opaque();
    bool have_tab = false;
    constexpr int E0 = U_ADA, E1 = E0 + U_WIN, E2 = E1 + U_WOUT, E3 = E2 + U_SGU, E4 = E3 + U_DFT, E5 = E4 + U_ROPE;
    int u = blockIdx.x;
    for (; u < E5; u += gridDim.x) {
        if (u < E0) ada_unit(a, lds, u);
        else if (u < E1) win_unit(a, lds, u - E0);
        else if (u < E2) wout_unit(a, lds, u - E1);
        else if (u < E3) { const size_t i0 = (size_t)(u - E2) * 4096 + tid * 8; const float* s = a->in[11] + i0; bf16_t* d = (bf16_t*)(a->ws + WS_WSGU) + i0;
            const f32x4 v0 = *(const f32x4*)s, v1 = *(const f32x4*)(s + 4); u32x4 w; w.x = pack2(v0[0], v0[1]); w.y = pack2(v0[2], v0[3]); w.z = pack2(v1[0], v1[1]); w.w = pack2(v1[2], v1[3]); *(u32x4*)d = w; }
        else if (u < E4) {
            float* ctab = (float*)(lds + LDS_CTAB);
            if (!have_tab) { for (int i = tid; i < 4096; i += NT) ctab[i] = cospif((float)i / 2048.0f); __syncthreads(); have_tab = true; }
            const int k = u - E3 + 4096;
            if (tid < 32) {
                const int kk = k - 4096, n0 = tid * 8; float c[8], s[8];
#pragma unroll
                for (int e = 0; e < 8; ++e) { const int idx = ((kk * (n0 + e)) & 255) * 16; c[e] = ctab[idx] * (1.0f / 16.0f); s[e] = ctab[(idx - 1024) & 4095] * (1.0f / 16.0f); }
                bf16_t* d = (bf16_t*)(a->ws + WS_DFTC) + (size_t)kk * 512 + n0;
                u32x4 w; w.x = pack2(c[0], c[1]); w.y = pack2(c[2], c[3]); w.z = pack2(c[4], c[5]); w.w = pack2(c[6], c[7]); *(u32x4*)d = w;
                w.x = pack2(s[0], s[1]); w.y = pack2(s[2], s[3]); w.z = pack2(s[4], s[5]); w.w = pack2(s[6], s[7]); *(u32x4*)(d + 256) = w;
            }
        }
        else {
            for (int i = tid; i < 1024; i += NT) { const int pos = i >> 4, f = i & 15; const float freq = powf(10000.0f, -(float)f / 16.0f); const float ang = (float)pos * freq;
                ((float2*)(a->ws + WS_ROPE))[i] = make_float2(cosf(ang), sinf(ang)); }
        }
    }
}

__device__ __forceinline__ void p_lnmod0(AP a) {
    const int tid = tid_opaque(), lane = tid & 63, w = tid >> 6;
    const float* mod = (const float*)(a->ws + WS_MOD);
    bf16_t* H = (bf16_t*)(a->ws + WS_H);
    const int tstep = gridDim.x * 8;
    f32x4 nx[4];
    { const int t = blockIdx.x * 8 + w; if (t < NTOK) { const float* src = (t < NLAT) ? a->in[0] + (size_t)t * D : a->in[2] + (size_t)(t - NLAT) * D;
#pragma unroll
        for (int i = 0; i < 4; ++i) nx[i] = *(const f32x4*)(src + 256 * i + 4 * lane); } }
    int mrow = -1; f32x4 msh[4], msc[4];
    for (int t = blockIdx.x * 8 + w; t < NTOK; t += tstep) {
        const int mr = (t < NLAT) ? (t >> 12) : 4;
        if (mr != mrow) { mrow = mr; const float* m = mod + (size_t)mr * 6144;
#pragma unroll
            for (int i = 0; i < 4; ++i) { msh[i] = *(const f32x4*)(m + 256 * i + 4 * lane); msc[i] = *(const f32x4*)(m + 1024 + 256 * i + 4 * lane); } }
        f32x4 v[4];
#pragma unroll
        for (int i = 0; i < 4; ++i) v[i] = nx[i];
        { const int tn = t + tstep; if (tn < NTOK) { const float* src = (tn < NLAT) ? a->in[0] + (size_t)tn * D : a->in[2] + (size_t)(tn - NLAT) * D;
#pragma unroll
            for (int i = 0; i < 4; ++i) nx[i] = *(const f32x4*)(src + 256 * i + 4 * lane); } }
        float mean, rstd; ln_stats(v, mean, rstd);
#pragma unroll
        for (int i = 0; i < 4; ++i) { const int c = 256 * i + 4 * lane;
            f32x4 o;
#pragma unroll
            for (int e = 0; e < 4; ++e) o[e] = (v[i][e] - mean) * rstd * (1.0f + msc[i][e]) + msh[i][e];
            u32x2 pk; pk.x = pack2(o[0], o[1]); pk.y = pack2(o[2], o[3]); *(u32x2*)(H + (size_t)t * D + c) = pk; }
    }
}

__device__ __forceinline__ void p1_inproj(AP a, unsigned char* smem, LAS unsigned char* lds, int l);
__device__ __forceinline__ u32x4 ld16g(const bf16_t* p) { return *(const u32x4*)p; }
__device__ __forceinline__ void rope_pack8(u32x4& wl, u32x4& wh, const LAS f32x2* tab, bool do_rope, float scale) {
    float tl[8] = {lo2f(wl.x), hi2f(wl.x), lo2f(wl.y), hi2f(wl.y), lo2f(wl.z), hi2f(wl.z), lo2f(wl.w), hi2f(wl.w)};
    float th[8] = {lo2f(wh.x), hi2f(wh.x), lo2f(wh.y), hi2f(wh.y), lo2f(wh.z), hi2f(wh.z), lo2f(wh.w), hi2f(wh.w)};
#pragma unroll
    for (int j = 0; j < 8; ++j) {
        float r1 = tl[j], r2 = th[j];
        if (do_rope) { const f32x2 cs = tab[j]; r1 = tl[j] * cs.x - th[j] * cs.y; r2 = tl[j] * cs.y + th[j] * cs.x; }
        tl[j] = r1 * scale; th[j] = r2 * scale;
    }
    wl.x = pack2(tl[0], tl[1]); wl.y = pack2(tl[2], tl[3]); wl.z = pack2(tl[4], tl[5]); wl.w = pack2(tl[6], tl[7]);
    wh.x = pack2(th[0], th[1]); wh.y = pack2(th[2], th[3]); wh.z = pack2(th[4], th[5]); wh.w = pack2(th[6], th[7]);
}

__device__ __forceinline__ void mixer_sgu_pool(AP a, LAS unsigned char* lds, int l, int row0, int seq_row0, int pos0, int n) {
    typedef short s16x4 __attribute__((ext_vector_type(4)));
    const int tid = tid_opaque(), lane = tid & 63, w = __builtin_amdgcn_readfirstlane(tid >> 6), fr = lane & 15, g = lane >> 4;
    const bf16_t* Z = (const bf16_t*)(a->ws + WS_Z);
    bf16_t* CAT = (bf16_t*)(a->ws + WS_CAT);
    constexpr int VOFF = 73728;
    u32x4 pr[9];
#pragma unroll
    for (int it = 0; it < 9; ++it) { const int id = tid + 512 * it, rr = id >> 5, ch = id & 31, j = pos0 - 8 + rr;
        pr[it] = (u32x4){0u, 0u, 0u, 0u};
        if (j >= 0 && j < n) pr[it] = ld16g(Z + (size_t)(seq_row0 + j) * ZC + 1024 + ch * 8); }
    bf16x8 wfrag[4][4];
    {   const int h = w >> 1, ph = w & 1; const bf16_t* Ws = (const bf16_t*)(a->ws + WS_WSGU) + (size_t)(l * 4 + h) * 128 * 128;
#pragma unroll
        for (int ks = 0; ks < 4; ++ks)
#pragma unroll
            for (int pf = 0; pf < 4; ++pf) wfrag[ks][pf] = *(const bf16x8*)(Ws + (size_t)(ph * 64 + 16 * pf + fr) * 128 + 32 * ks + 8 * g); }
    u32x4 gw[4][2];
#pragma unroll
    for (int ps = 0; ps < 4; ++ps) { const int q = w * 16 + ps * 4 + g; const bf16_t* src = Z + (size_t)(row0 + q) * ZC + 1536 + 16 * fr; gw[ps][0] = ld16g(src); gw[ps][1] = ld16g(src + 8); }
#pragma unroll
    for (int it = 0; it < 9; ++it) { const int id = tid + 512 * it; *(LAS u32x4*)(lds + (id >> 5) * 512 + (id & 31) * 16) = pr[it]; }
#pragma unroll
    for (int ps = 0; ps < 4; ++ps) {
        const int q = w * 16 + ps * 4 + g;
        float gv[16];
#pragma unroll
        for (int hh = 0; hh < 2; ++hh) { const u32x4 x = gw[ps][hh];
            gv[8 * hh + 0] = gelu_erf(lo2f(x.x)); gv[8 * hh + 1] = gelu_erf(hi2f(x.x)); gv[8 * hh + 2] = gelu_erf(lo2f(x.y)); gv[8 * hh + 3] = gelu_erf(hi2f(x.y));
            gv[8 * hh + 4] = gelu_erf(lo2f(x.z)); gv[8 * hh + 5] = gelu_erf(hi2f(x.z)); gv[8 * hh + 6] = gelu_erf(lo2f(x.w)); gv[8 * hh + 7] = gelu_erf(hi2f(x.w)); }
        float sm = 0.f;
#pragma unroll
        for (int e = 0; e < 16; ++e) sm += gv[e];
        const float mean = row_sum16(sm) * (1.0f / 256.0f);
        float qq = 0.f;
#pragma unroll
        for (int e = 0; e < 16; ++e) { const float d = gv[e] - mean; qq += d * d; }
        const float rstd = 1.0f / sqrtf(row_sum16(qq) * (1.0f / 256.0f) + 1e-6f);
        u32x4 o0, o1;
        o0.x = pack2((gv[0] - mean) * rstd, (gv[1] - mean) * rstd); o0.y = pack2((gv[2] - mean) * rstd, (gv[3] - mean) * rstd); o0.z = pack2((gv[4] - mean) * rstd, (gv[5] - mean) * rstd); o0.w = pack2((gv[6] - mean) * rstd, (gv[7] - mean) * rstd);
        o1.x = pack2((gv[8] - mean) * rstd, (gv[9] - mean) * rstd); o1.y = pack2((gv[10] - mean) * rstd, (gv[11] - mean) * rstd); o1.z = pack2((gv[12] - mean) * rstd, (gv[13] - mean) * rstd); o1.w = pack2((gv[14] - mean) * rstd, (gv[15] - mean) * rstd);
        const int sg = fr ^ ((q & 3) | (((q >> 3) & 1) << 2));
        *(LAS u32x4*)(lds + VOFF + q * 512 + sg * 32) = o0; *(LAS u32x4*)(lds + VOFF + q * 512 + sg * 32 + 16) = o1;
    }
    __syncthreads();
    {
        const int c = tid & 255, half = tid >> 8, hw = 1 << (c >> 6);
        const LAS bf16_t* P = (const LAS bf16_t*)lds + c;
        const int t0 = half * 64;
        const float invfull = 1.0f / (float)(2 * hw);
        float s = 0.f;
        for (int j = t0 - hw; j < t0 + hw; ++j) s += bf2f(P[(8 + j) * 256]);
        for (int tl = t0; tl < t0 + 64; ++tl) {
            const int pos = pos0 + tl; const int cntw = min(pos + hw, n) - max(pos - hw, 0);
            const float inv = (cntw == 2 * hw) ? invfull : 1.0f / (float)cntw;
            CAT[(size_t)(row0 + tl) * D + 512 + c] = f2bf(s * inv - bf2f(P[(8 + tl) * 256]));
            s += bf2f(P[(8 + tl + hw) * 256]) - bf2f(P[(8 + tl - hw) * 256]);
        }
    }
    {
        const int h = w >> 1, ph = w & 1;
        const float* bs = a->in[12] + (size_t)(l * 4 + h) * 128;
        f32x4 acc[4][4];
#pragma unroll
        for (int i = 0; i < 4; ++i)
#pragma unroll
            for (int j = 0; j < 4; ++j) acc[i][j] = (f32x4){0.f, 0.f, 0.f, 0.f};
        const int qq4 = fr >> 2, p4 = fr & 3, fsw = qq4 | ((g & 1) << 2);
#pragma unroll
        for (int ks = 0; ks < 4; ++ks) {
            bf16x8 af[4];
            const int r0 = 32 * ks + 8 * g + qq4;
#pragma unroll
            for (int cf = 0; cf < 4; ++cf) { const int so = (((4 * h + cf) ^ fsw) << 5) + p4 * 8;
                const s16x4 lo = __builtin_amdgcn_ds_read_tr16_b64_v4i16((LAS s16x4*)(lds + VOFF + r0 * 512 + so));
                const s16x4 hi = __builtin_amdgcn_ds_read_tr16_b64_v4i16((LAS s16x4*)(lds + VOFF + (r0 + 4) * 512 + so));
                af[cf] = __builtin_shufflevector(lo, hi, 0, 1, 2, 3, 4, 5, 6, 7); }
#pragma unroll
            for (int cf = 0; cf < 4; ++cf)
#pragma unroll
                for (int pf = 0; pf < 4; ++pf) acc[cf][pf] = __builtin_amdgcn_mfma_f32_16x16x32_bf16(af[cf], wfrag[ks][pf], acc[cf][pf], 0, 0, 0);
        }
#pragma unroll
        for (int pf = 0; pf < 4; ++pf) { const int p = ph * 64 + 16 * pf + fr; const float bias = bs[p];
#pragma unroll
            for (int cf = 0; cf < 4; ++cf) { const int c0 = h * 64 + 16 * cf + 4 * g;
                const u32x2 uw = *(const u32x2*)(Z + (size_t)(row0 + p) * ZC + 1280 + c0);
                u32x2 o; o.x = pack2(gelu_erf(lo2f(uw.x)) * (acc[cf][pf][0] + bias), gelu_erf(hi2f(uw.x)) * (acc[cf][pf][1] + bias));
                o.y = pack2(gelu_erf(lo2f(uw.y)) * (acc[cf][pf][2] + bias), gelu_erf(hi2f(uw.y)) * (acc[cf][pf][3] + bias));
                *(u32x2*)(CAT + (size_t)(row0 + p) * D + 768 + c0) = o; } }
    }
    __syncthreads();
}

__device__ __forceinline__ void mixer_attn(AP a, LAS unsigned char* lds, int l, int row0, int seq_row0, int pos0, int n, int b, bool is_ctx, int kvh) {
    const int tid = tid_opaque(), lane = tid & 63, w = __builtin_amdgcn_readfirstlane(tid >> 6), fr = lane & 15, g = lane >> 4;
    const bf16_t* Z = (const bf16_t*)(a->ws + WS_Z);
    bf16_t* CAT = (bf16_t*)(a->ws + WS_CAT);
    __syncthreads();
    ((LAS u32x4*)(lds + 98304))[tid] = ((const u32x4*)(a->ws + WS_ROPE))[tid];
    const LAS f32x2* rope = (const LAS f32x2*)(lds + 98304);
    constexpr float QS = 0.125f * 1.44269504088896341f;
    constexpr int QS_OFF = 0, KS_OFF = 32768, VS_OFF = 65536;
    const int nbq = pos0 >> 7;
    unsigned bmask = 0x18u;
    if (!is_ctx) { if (nbq > 0) bmask |= 1u; bmask |= 2u; if (nbq + 1 < (n >> 7)) bmask |= 4u; }
    const int kr = tid >> 2, kax = (tid >> 1) & 1, kh8 = tid & 1;
#define MX_KSRC(blk) (Z + (size_t)((((blk) < 3) ? seq_row0 + (nbq + (blk) - 1) * 128 : NLAT + b * 256 + ((blk) - 3) * 128) + kr) * ZC + 768 + kvh * 64 + kax * 32 + kh8 * 8)
#define MX_VSTAGE(blk, buf) do { const bool _band = (blk) < 3; const int _key0 = _band ? (nbq + (blk) - 1) * 128 : ((blk) - 3) * 128; \
        const bf16_t* _vs = _band ? (const bf16_t*)(a->ws + WS_VT) + (size_t)(b * 2 + kvh) * 64 * 4096 + _key0 : (const bf16_t*)(a->ws + WS_VTC) + (size_t)(b * 2 + kvh) * 64 * 256 + _key0; \
        const int _vld = _band ? 4096 : 256; \
        _Pragma("unroll") for (int _i = 0; _i < 2; ++_i) { const int _P = _i * 512 + tid, _d = _P >> 4, _c = (_P & 15) ^ (_d & 15); \
            glds16(_vs + (size_t)_d * _vld + _c * 8, lds + VS_OFF + (buf) * 16384 + _i * 8192 + w * 1024); } } while (0)
    {
        __syncthreads();
#pragma unroll
        for (int it = 0; it < 2; ++it) {
            const int item = tid + 512 * it, r = item >> 2, ax = (item >> 1) & 1, h8 = item & 1, i = r & 127, qpos = pos0 + i;
            const bf16_t* src = Z + (size_t)(row0 + i) * ZC + 512 + (2 * kvh + (r >> 7)) * 64 + ax * 32 + h8 * 8;
            u32x4 wl = ld16g(src), wh = ld16g(src + 16);
            rope_pack8(wl, wh, rope + (ax ? (qpos & 63) : (qpos >> 6)) * 16 + h8 * 8, !is_ctx, QS);
            const int ch = ax * 4 + h8, sw = (r >> 1) & 7;
            *(LAS u32x4*)(lds + QS_OFF + r * 128 + ((ch ^ sw) << 4)) = wl;
            *(LAS u32x4*)(lds + QS_OFF + r * 128 + (((ch + 2) ^ sw) << 4)) = wh;
        }
        const int hh = w >> 2, qb = (w & 3) * 32, h = 2 * kvh + hh;
        float m[2], lsum[2];
        m[0] = m[1] = a->in[8][l * 4 + h] * 1.44269504088896341f;
        lsum[0] = lsum[1] = (g == 0) ? 1.0f : 0.0f;
        f32x4 O[4][2];
#pragma unroll
        for (int i = 0; i < 4; ++i) { O[i][0] = (f32x4){0.f, 0.f, 0.f, 0.f}; O[i][1] = (f32x4){0.f, 0.f, 0.f, 0.f}; }
        bf16x8 Qf[2][2];
        bool have_q = false;
        unsigned rem = bmask;
        int cur = __builtin_ctz(rem); rem &= rem - 1u;
        int buf = 0;
        u32x4 kl = ld16g(MX_KSRC(cur)), kh = ld16g(MX_KSRC(cur) + 16);
        MX_VSTAGE(cur, 0);
#pragma unroll 1
        for (;;) {
            const int jb = cur - 1; const bool band = cur < 3;
            {
                const int kpos = (nbq + jb) * 128 + kr;
                rope_pack8(kl, kh, rope + (kax ? (kpos & 63) : (kpos >> 6)) * 16 + kh8 * 8, band, 1.0f);
                const int ch = kax * 4 + kh8, sw = (kr >> 1) & 7;
                *(LAS u32x4*)(lds + KS_OFF + buf * 16384 + kr * 128 + ((ch ^ sw) << 4)) = kl;
                *(LAS u32x4*)(lds + KS_OFF + buf * 16384 + kr * 128 + (((ch + 2) ^ sw) << 4)) = kh;
            }
            asm volatile("s_waitcnt vmcnt(0)" ::: "memory");
            __syncthreads();
            const int nxt = rem ? __builtin_ctz(rem) : -1; rem &= rem - 1u;
            if (nxt >= 0) { kl = ld16g(MX_KSRC(nxt)); kh = ld16g(MX_KSRC(nxt) + 16); MX_VSTAGE(nxt, buf ^ 1); }
            if (!have_q) {
#pragma unroll
                for (int qf = 0; qf < 2; ++qf)
#pragma unroll
                    for (int ks = 0; ks < 2; ++ks) { const int r = hh * 128 + qb + 16 * qf + fr; Qf[qf][ks] = *(const LAS bf16x8*)(lds + QS_OFF + r * 128 + (((4 * ks + g) ^ ((r >> 1) & 7)) << 4)); }
                have_q = true;
            }
            const int kso = KS_OFF + buf * 16384, vso = VS_OFF + buf * 16384;
            f32x4 S[8][2];
#pragma unroll
            for (int kf = 0; kf < 8; ++kf) { S[kf][0] = (f32x4){0.f, 0.f, 0.f, 0.f}; S[kf][1] = (f32x4){0.f, 0.f, 0.f, 0.f}; }
#pragma unroll
            for (int kf = 0; kf < 8; ++kf)
#pragma unroll
                for (int ks = 0; ks < 2; ++ks) { const int r = 16 * kf + fr;
                    const bf16x8 kfr = *(const LAS bf16x8*)(lds + kso + r * 128 + (((4 * ks + g) ^ ((r >> 1) & 7)) << 4));
                    S[kf][0] = __builtin_amdgcn_mfma_f32_16x16x32_bf16(kfr, Qf[0][ks], S[kf][0], 0, 0, 0);
                    S[kf][1] = __builtin_amdgcn_mfma_f32_16x16x32_bf16(kfr, Qf[1][ks], S[kf][1], 0, 0, 0); }
            bf16x8 Pp[4][2];
#pragma unroll
            for (int qf = 0; qf < 2; ++qf) {
                const int qi = qb + 16 * qf + fr;
                if (band && jb != 0) {
#pragma unroll
                    for (int kf = 0; kf < 8; ++kf)
#pragma unroll
                        for (int r = 0; r < 4; ++r) { const int kk = 16 * kf + 4 * g + r; const bool ok = (jb < 0) ? (kk >= qi) : (kk <= qi); if (!ok) S[kf][qf][r] = -1.0e30f; }
                }
                float mx = S[0][qf][0];
#pragma unroll
                for (int kf = 0; kf < 8; ++kf)
#pragma unroll
                    for (int r = 0; r < 4; ++r) mx = fmaxf(mx, S[kf][qf][r]);
                mx = fmaxf(mx, __shfl_xor(mx, 16)); mx = fmaxf(mx, __shfl_xor(mx, 32));
                const float mn = fmaxf(m[qf], mx), corr = __builtin_amdgcn_exp2f(m[qf] - mn);
                m[qf] = mn;
                float ps = 0.f;
#pragma unroll
                for (int kf = 0; kf < 8; ++kf)
#pragma unroll
                    for (int r = 0; r < 4; ++r) { const float p = __builtin_amdgcn_exp2f(S[kf][qf][r] - mn); S[kf][qf][r] = p; ps += p; }
                lsum[qf] = lsum[qf] * corr + ps;
#pragma unroll
                for (int df = 0; df < 4; ++df) O[df][qf] *= corr;
#pragma unroll
                for (int t = 0; t < 4; ++t) { u32x4 pw; pw.x = pack2(S[2 * t][qf][0], S[2 * t][qf][1]); pw.y = pack2(S[2 * t][qf][2], S[2 * t][qf][3]);
                    pw.z = pack2(S[2 * t + 1][qf][0], S[2 * t + 1][qf][1]); pw.w = pack2(S[2 * t + 1][qf][2], S[2 * t + 1][qf][3]); Pp[t][qf] = __builtin_bit_cast(bf16x8, pw); }
            }
#pragma unroll
            for (int t = 0; t < 4; ++t)
#pragma unroll
                for (int df = 0; df < 4; ++df) { const int d = 16 * df + fr;
                    const u32x2 v0 = *(const LAS u32x2*)(lds + vso + d * 256 + (((4 * t + (g >> 1)) ^ (d & 15)) << 4) + (g & 1) * 8);
                    const u32x2 v1 = *(const LAS u32x2*)(lds + vso + d * 256 + (((4 * t + 2 + (g >> 1)) ^ (d & 15)) << 4) + (g & 1) * 8);
                    u32x4 vw; vw.x = v0.x; vw.y = v0.y; vw.z = v1.x; vw.w = v1.y; const bf16x8 vf = __builtin_bit_cast(bf16x8, vw);
                    O[df][0] = __builtin_amdgcn_mfma_f32_16x16x32_bf16(vf, Pp[t][0], O[df][0], 0, 0, 0);
                    O[df][1] = __builtin_amdgcn_mfma_f32_16x16x32_bf16(vf, Pp[t][1], O[df][1], 0, 0, 0); }
            if (nxt < 0) break;
            cur = nxt; buf ^= 1;
        }
#pragma unroll
        for (int qf = 0; qf < 2; ++qf) {
            float lt = lsum[qf]; lt += __shfl_xor(lt, 16); lt += __shfl_xor(lt, 32);
            const float inv = 1.0f / lt;
            bf16_t* dst = CAT + (size_t)(row0 + qb + 16 * qf + fr) * D + 256 + h * 64 + 4 * g;
#pragma unroll
            for (int df = 0; df < 4; ++df) { u32x2 o; o.x = pack2(O[df][qf][0] * inv, O[df][qf][1] * inv); o.y = pack2(O[df][qf][2] * inv, O[df][qf][3] * inv); *(u32x2*)(dst + 16 * df) = o; }
        }
    }
#undef MX_KSRC
#undef MX_VSTAGE
    __syncthreads();
}

constexpr int FF_DA = 0, FF_DC = 32768, FF_XT = 49152  , FF_Z2 = 81920  , FF_OB = 114688  ;
__device__ __forceinline__ int ff_addr(int row, int k) { return row * 256 + ((((k >> 3) ^ (row & 15))) << 4) + (k & 7) * 2; }
__device__ __forceinline__ float cos_turns(float x) { return __builtin_amdgcn_cosf(x); }
__device__ __forceinline__ float sin_turns(float x) { return __builtin_amdgcn_sinf(x); }
__device__ __forceinline__ void fft_setup(LAS unsigned char* lds) {
    const int tid = tid_opaque();
    __syncthreads();
    for (int idx = tid; idx < 16384; idx += NT) { const int i = idx >> 7, k = idx & 127, ro = i >> 6, k1 = i & 63, part = k >> 6, n1 = k & 63; const float t = (float)((k1 * n1) & 63) * (1.0f / 64.0f);
        const float c = cos_turns(t), sn = sin_turns(t);
        const float v = (ro == 0) ? (part == 0 ? c : sn) : (part == 0 ? -sn : c);
        *(LAS bf16_t*)(lds + FF_DA + ff_addr(i, k)) = f2bf(v * 0.125f); }
    for (int idx = tid; idx < 8192; idx += NT) { const int k2 = idx >> 7, k = idx & 127, ri = k >> 6, n2 = k & 63; const float t = (float)((k2 * n2) & 63) * (1.0f / 64.0f);
        const float v = (ri == 0) ? cos_turns(t) : sin_turns(t);
        *(LAS bf16_t*)(lds + FF_DC + ff_addr(k2, k)) = f2bf(v * 0.125f); }
    __syncthreads();
}
__device__ __forceinline__ void fft_unit(AP a, LAS unsigned char* lds, int b, int cg) {
    const int tid = tid_opaque(), lane = tid & 63, w = __builtin_amdgcn_readfirstlane(tid >> 6), fr = lane & 15, g = lane >> 4;
    const int mf = w & 3, nh = w >> 2;
    const bf16_t* AT = (const bf16_t*)(a->ws + WS_AT) + (size_t)(b * 256 + cg * 4) * 8192;
    u32x4 xin[2][2];
#pragma unroll
    for (int h = 0; h < 2; ++h)
#pragma unroll
        for (int it = 0; it < 2; ++it) xin[h][it] = ld16g(AT + (size_t)h * 8192 + (size_t)(tid + 512 * it) * 8);
#pragma unroll 1
    for (int cp = 0; cp < 2; ++cp) {
#pragma unroll
        for (int h = 0; h < 2; ++h)
#pragma unroll
            for (int it = 0; it < 2; ++it) { const int q = tid + 512 * it, part = q >> 9, pos0 = (q & 511) * 8, n1 = pos0 >> 6, n2 = pos0 & 63, k = part * 64 + n1;
                const unsigned wv[4] = {xin[h][it].x, xin[h][it].y, xin[h][it].z, xin[h][it].w};
#pragma unroll
                for (int e = 0; e < 4; ++e) { *(LAS bf16_t*)(lds + FF_XT + h * 16384 + ff_addr(n2 + 2 * e, k)) = (bf16_t)(wv[e] & 0xffffu); *(LAS bf16_t*)(lds + FF_XT + h * 16384 + ff_addr(n2 + 2 * e + 1, k)) = (bf16_t)(wv[e] >> 16); } }
        if (cp == 0) {
#pragma unroll
            for (int h = 0; h < 2; ++h)
#pragma unroll
                for (int it = 0; it < 2; ++it) xin[h][it] = ld16g(AT + (size_t)(2 + h) * 8192 + (size_t)(tid + 512 * it) * 8); }
        __syncthreads();
        f32x4 acc[2][2][2];
#pragma unroll
        for (int h = 0; h < 2; ++h)
#pragma unroll
            for (int x = 0; x < 2; ++x) { acc[h][x][0] = (f32x4){0.f, 0.f, 0.f, 0.f}; acc[h][x][1] = (f32x4){0.f, 0.f, 0.f, 0.f}; }
#pragma unroll
        for (int ks = 0; ks < 4; ++ks) {
            bf16x8 af[2];
#pragma unroll
            for (int x = 0; x < 2; ++x) { const int i = 16 * (mf + 4 * x) + fr; af[x] = *(const LAS bf16x8*)(lds + FF_DA + i * 256 + (((4 * ks + g) ^ (i & 15)) << 4)); }
#pragma unroll
            for (int h = 0; h < 2; ++h)
#pragma unroll
                for (int n = 0; n < 2; ++n) { const int j = 16 * (2 * nh + n) + fr; const bf16x8 bfv = *(const LAS bf16x8*)(lds + FF_XT + h * 16384 + j * 256 + (((4 * ks + g) ^ (j & 15)) << 4));
                    acc[h][0][n] = __builtin_amdgcn_mfma_f32_16x16x32_bf16(af[0], bfv, acc[h][0][n], 0, 0, 0);
                    acc[h][1][n] = __builtin_amdgcn_mfma_f32_16x16x32_bf16(af[1], bfv, acc[h][1][n], 0, 0, 0); }
        }
#pragma unroll
        for (int n = 0; n < 2; ++n)
#pragma unroll
            for (int r = 0; r < 4; ++r) { const int k1 = 16 * mf + 4 * g + r, n2 = 16 * (2 * nh + n) + fr; const float t = (float)((k1 * n2) & 4095) * (1.0f / 4096.0f);
                const float c = cos_turns(t), sn = sin_turns(t);
#pragma unroll
                for (int h = 0; h < 2; ++h) { const float zr = acc[h][0][n][r], zi = acc[h][1][n][r];
                    *(LAS bf16_t*)(lds + FF_Z2 + h * 16384 + ff_addr(k1, n2)) = f2bf(zr * c + zi * sn);
                    *(LAS bf16_t*)(lds + FF_Z2 + h * 16384 + ff_addr(k1, 64 + n2)) = f2bf(zi * c - zr * sn); } }
        __syncthreads();
        f32x4 acc2[2][2];
#pragma unroll
        for (int h = 0; h < 2; ++h) { acc2[h][0] = (f32x4){0.f, 0.f, 0.f, 0.f}; acc2[h][1] = (f32x4){0.f, 0.f, 0.f, 0.f}; }
#pragma unroll
        for (int ks = 0; ks < 4; ++ks) {
            const int i = 16 * mf + fr; const bf16x8 af = *(const LAS bf16x8*)(lds + FF_DC + i * 256 + (((4 * ks + g) ^ (i & 15)) << 4));
#pragma unroll
            for (int h = 0; h < 2; ++h)
#pragma unroll
                for (int n = 0; n < 2; ++n) { const int j = 16 * (2 * nh + n) + fr; const bf16x8 bfv = *(const LAS bf16x8*)(lds + FF_Z2 + h * 16384 + j * 256 + (((4 * ks + g) ^ (j & 15)) << 4));
                    acc2[h][n] = __builtin_amdgcn_mfma_f32_16x16x32_bf16(af, bfv, acc2[h][n], 0, 0, 0); }
        }
#pragma unroll
        for (int n = 0; n < 2; ++n)
#pragma unroll
            for (int r = 0; r < 4; ++r) { const int k = 16 * (2 * nh + n) + fr + 64 * (16 * mf + 4 * g + r);
                *(LAS unsigned*)(lds + FF_OB + k * 8 + cp * 4) = pack2(acc2[0][n][r], acc2[1][n][r]); }
    }
    __syncthreads();
    bf16_t* CAT = (bf16_t*)(a->ws + WS_CAT) + (size_t)(b * 4096) * D + cg * 4;
#pragma unroll
    for (int it = 0; it < 8; ++it) { const int k = tid + 512 * it; *(u32x2*)(CAT + (size_t)k * D) = *(const LAS u32x2*)(lds + FF_OB + k * 8); }
    __syncthreads();
}

__device__ __forceinline__ void p2_mix(AP a, unsigned char* ldsg, LAS unsigned char* lds, int l) {
    const int n_tile = 128 + ((l == 0) ? 8 : 0), n_att = 2 * n_tile, n_dft = 256, n_dftc = (l == 0) ? 16 : 0;
    bf16_t* CAT = (bf16_t*)(a->ws + WS_CAT);
    bool fft_ready = false;
    for (int u = blockIdx.x; u < n_att + n_dft + n_tile + n_dftc; u += gridDim.x) {
        if (u < n_att || (u >= n_att + n_dft && u < n_att + n_dft + n_tile)) {
            const bool att = u < n_att;
            const int t = att ? (u >> 1) : (u - n_att - n_dft);
            const bool isc = t >= 128; const int tt = t - 128;
            const int b = isc ? (tt >> 1) : (t >> 5);
            const int row0 = isc ? NLAT + tt * 128 : t * 128, seq_row0 = isc ? NLAT + b * 256 : b * 4096, pos0 = isc ? (tt & 1) * 128 : (t & 31) * 128, n = isc ? 256 : 4096;
            if (att) { for (int rep = 0; rep < PROBE_MIX_REP; ++rep) mixer_attn(a, lds, l, row0, seq_row0, pos0, n, b, isc, u & 1); }
            else { for (int rep = 0; rep < PROBE_SGU_REP; ++rep) mixer_sgu_pool(a, lds, l, row0, seq_row0, pos0, n); }
            fft_ready = false;
        } else if (u < n_att + n_dft) {
            const int uu = u - n_att;
            if (!fft_ready) { fft_setup(lds); fft_ready = true; }
            for (int rep = 0; rep < PROBE_FFT_REP; ++rep) fft_unit(a, lds, uu >> 6, uu & 63);
        } else {
            const int uu = u - n_att - n_dft - n_tile, b = uu >> 2, mt = (uu >> 1) & 1, ch0 = (uu & 1) * 128;
            const bf16_t* A = (const bf16_t*)(a->ws + WS_DFTC) + (size_t)(mt * 128) * 512;
            const bf16_t* B0 = (const bf16_t*)(a->ws + WS_ATC) + ((size_t)b * 256 + ch0) * 512;
            EpiBf16 E; E.C = CAT + (size_t)(NLAT + b * 256 + mt * 128) * D + ch0; E.ld = D; E.scale = 1.0f;
            gemm_tile<128, false, EpiBf16>(lds, A, 512, nullptr, 128, B0, B0 + (size_t)64 * 512, 512, 512, E);
            fft_ready = false;
        }
    }
    exp_queue(a, ldsg, l);
}

__device__ __forceinline__ int uni(int v) { return __builtin_amdgcn_readfirstlane(v); }
__device__ __forceinline__ int vblock() { const int G = gridDim.x, b = blockIdx.x; return (G % 8 == 0) ? (b % 8) * (G / 8) + b / 8 : b; }
template <class T> __device__ __forceinline__ T* unip(T* p) { const unsigned long long v = (unsigned long long)p; const unsigned lo = __builtin_amdgcn_readfirstlane((unsigned)v), hi = __builtin_amdgcn_readfirstlane((unsigned)(v >> 32)); return (T*)(((unsigned long long)hi << 32) | lo); }
struct SchedInProj {
    typedef EpiInProj Epi; static constexpr bool GATHER = false, FP8 = false;
    unsigned char* ws; int l, G, me;
    __device__ __forceinline__ bool get(int i, g256::Unit<Epi>& u) const {
        const int n_lat = 64 * 7, n_ctx = (l == 0) ? 4 * 7 : 4;
        const int idx = i * G + me; if (idx >= n_lat + n_ctx) return false;
        int row0, b, ct, n; bf16_t *tF, *tV;
        if (idx < n_lat) { const int rt = idx / 7; ct = idx % 7; row0 = rt * 256; b = row0 >> 12; n = 4096;
            tF = (bf16_t*)(ws + WS_AT) + (size_t)b * 256 * 2 * 4096; tV = (bf16_t*)(ws + WS_VT) + (size_t)b * 128 * 4096; }
        else { const int uu = idx - n_lat; int rt; if (l == 0) { rt = uu / 7; ct = uu % 7; } else { rt = uu; ct = 3; }
            row0 = NLAT + rt * 256; b = rt; n = 256;
            tF = (bf16_t*)(ws + WS_ATC) + (size_t)b * 256 * 2 * 256; tV = (bf16_t*)(ws + WS_VTC) + (size_t)b * 128 * 256; }
        u.A = (const bf16_t*)(ws + WS_H) + (size_t)row0 * D;
        u.B0 = (const bf16_t*)(ws + WS_WIN) + ((size_t)l * ZC + ct * 256) * 1024; u.B1 = u.B0 + (size_t)128 * 1024; u.ridx = nullptr; u.valid = 256;
        u.epi.Zt = (bf16_t*)(ws + WS_Z) + (size_t)row0 * ZC + ct * 256; u.epi.tF = tF; u.epi.tV = tV; u.epi.n0 = ct * 256; u.epi.pos0 = (idx < n_lat) ? (row0 & 4095) : 0; u.epi.n = n;
        return true;
    }
};
struct SchedOutProj {
    typedef EpiBf16 Epi; static constexpr bool GATHER = false, FP8 = false;
    unsigned char* ws; int l, G, me;
    __device__ __forceinline__ bool get(int i, g256::Unit<Epi>& u) const {
        const int nrt = NLAT / 256;
        const int idx = i * G + me; if (idx >= nrt * 4) return false;
        const int rt = idx >> 2, ct = idx & 3;
        u.A = (const bf16_t*)(ws + WS_CAT) + (size_t)(rt * 256) * D;
        u.B0 = (const bf16_t*)(ws + WS_WOUT) + ((size_t)l * 1024 + ct * 256) * 1024; u.B1 = u.B0 + (size_t)128 * 1024; u.ridx = nullptr; u.valid = 256;
        u.epi.C = (bf16_t*)(ws + WS_Y) + (size_t)(rt * 256) * D + ct * 256; u.epi.ld = D; u.epi.scale = 1.0f;
        return true;
    }
};
__device__ __forceinline__ void moe_units(const LAS int* blk, LAS int* uinf, int G, int me) {
    const int i = threadIdx.x;
    if (i < 8) { const int idx = i * G + me, nu = blk[32] * 4; int e = 0, valid = 0;
        if (idx < nu) { const int rb = idx >> 2; for (int q = 1; q < 32; ++q) if (blk[q] <= rb) e = q; valid = min(256, blk[33 + e] - (rb - blk[e]) * 256); }
        uinf[2 * i] = e; uinf[2 * i + 1] = valid; }
    __syncthreads();
}
struct SchedGateUp {
    typedef EpiGateUp8 Epi; static constexpr bool GATHER = true, FP8 = true;
    unsigned char* ws; const LAS int* uinf; const LAS int* ridx_lds; int G, me, l, nu;
    __device__ __forceinline__ bool get(int i, g256::Unit<Epi>& u) const {
        const int idx = i * G + me; if (idx >= nu) return false;
        const int rb = idx >> 2, ct = idx & 3, e = uni(uinf[2 * i]);
        u.A = (const bf16_t*)(ws + WS_H8);
        { const unsigned char* b0 = ws + WS_WEXP + (size_t)l * WEXP_LAYER + ((size_t)e * 512 + ct * 128) * 1024; u.B0 = (const bf16_t*)b0; u.B1 = (const bf16_t*)(b0 + EXPMAT); }
        u.ridx = ridx_lds + (i & 7) * 256; u.valid = uni(uinf[2 * i + 1]);
        u.epi.C = ws + WS_HID + (size_t)(rb * 256) * DEXP + ct * 128; u.epi.ld = DEXP;
        return true;
    }
};
struct SchedDown {
    typedef EpiFp8 Epi; static constexpr bool GATHER = false, FP8 = true;
    unsigned char* ws; const LAS int* uinf; int G, me, l, nu;
    __device__ __forceinline__ bool get(int i, g256::Unit<Epi>& u) const {
        const int idx = i * G + me; if (idx >= nu) return false;
        const int rb = idx >> 2, ct = idx & 3, e = uni(uinf[2 * i]);
        u.A = (const bf16_t*)(ws + WS_HID + (size_t)(rb * 256) * DEXP);
        { const unsigned char* b0 = ws + WS_WEXP + (size_t)l * WEXP_LAYER + 2 * EXPMAT + ((size_t)e * 1024 + ct * 256) * 512; u.B0 = (const bf16_t*)b0; u.B1 = (const bf16_t*)(b0 + (size_t)128 * 512); } u.ridx = nullptr; u.valid = 256;
        u.epi.C = ws + WS_YS + (size_t)(rb * 256) * D + ct * 256; u.epi.ld = D; u.epi.scale = 1.0f / 32.0f;
        return true;
    }
};

__device__ __forceinline__ void p4_ln1_router(AP a, unsigned char* lds, int l) {
    const int tid = tid_opaque(), lane = tid & 63, w = tid >> 6;
    const int ntok = (l == 0) ? NTOK : NLAT;
    int* cnt = (int*)(lds + MISC_OFF);
    if (tid < 32) cnt[tid] = 0;
    f32x4* Lg = (f32x4*)lds; f32x4* Le = (f32x4*)(lds + 16384); f32x4* Lgb = (f32x4*)(lds + 147456);
    {
        const float* wrg_ = a->in[16] + (size_t)l * 1024 * 4; const float* wre_ = a->in[17] + (size_t)l * 1024 * 32;
#pragma unroll
        for (int it = 0; it < 2; ++it) { const int c = tid + 512 * it, slot = (((c >> 8) * 4 + (c & 3)) << 6) + ((c >> 2) & 63);
            Lg[slot] = *(const f32x4*)(wrg_ + (size_t)c * 4);
#pragma unroll
            for (int q = 0; q < 8; ++q) Le[q * 1024 + slot] = *(const f32x4*)(wre_ + (size_t)c * 32 + q * 4); }
        Lgb[tid] = (tid < 256) ? *(const f32x4*)(a->in[14] + l * 1024 + tid * 4) : *(const f32x4*)(a->in[15] + l * 1024 + (tid - 256) * 4);
    }
    __syncthreads();
    const float* mod = (const float*)(a->ws + WS_MOD) + (size_t)l * 5 * 6144;
    const bf16_t* Y = (const bf16_t*)(a->ws + WS_Y);
    bf16_t* X1 = (bf16_t*)(a->ws + WS_X1);
    unsigned char* H8 = a->ws + WS_H8;
    int* tokE = (int*)(a->ws + WS_TOKE); int* tokR = (int*)(a->ws + WS_TOKR); float* tokG = (float*)(a->ws + WS_TOKG);
    const int tstep = gridDim.x * 8;
    f32x4 nx[4]; u32x2 ny[4];
    {   const int t = blockIdx.x * 8 + w;
        if (t < ntok) { const float* xs = (l == 0) ? ((t < NLAT) ? a->in[0] + (size_t)t * D : a->in[2] + (size_t)(t - NLAT) * D) : (const float*)(a->ws + WS_XC) + (size_t)t * D;
#pragma unroll
            for (int i = 0; i < 4; ++i) { nx[i] = *(const f32x4*)(xs + 256 * i + 4 * lane); ny[i] = *(const u32x2*)(Y + (size_t)t * D + 256 * i + 4 * lane); } } }
    int mrow = -1; f32x4 mg[4], msh[4], msc[4];
    for (int t = blockIdx.x * 8 + w; t < ntok; t += tstep) {
        const int mr = (t < NLAT) ? (t >> 12) : 4;
        if (mr != mrow) { mrow = mr; const float* m = mod + (size_t)mr * 6144;
#pragma unroll
            for (int i = 0; i < 4; ++i) { const int c = 256 * i + 4 * lane; mg[i] = *(const f32x4*)(m + 2048 + c); msh[i] = *(const f32x4*)(m + 3072 + c); msc[i] = *(const f32x4*)(m + 4096 + c); } }
        f32x4 v[4];
#pragma unroll
        for (int i = 0; i < 4; ++i) { const f32x4 yv = (f32x4){lo2f(ny[i].x), hi2f(ny[i].x), lo2f(ny[i].y), hi2f(ny[i].y)};
#pragma unroll
            for (int e = 0; e < 4; ++e) v[i][e] = RES_ALPHA * nx[i][e] + mg[i][e] * yv[e]; }
        {   const int tn = t + tstep;
            if (tn < ntok) { const float* xs = (l == 0) ? ((tn < NLAT) ? a->in[0] + (size_t)tn * D : a->in[2] + (size_t)(tn - NLAT) * D) : (const float*)(a->ws + WS_XC) + (size_t)tn * D;
#pragma unroll
                for (int i = 0; i < 4; ++i) { nx[i] = *(const f32x4*)(xs + 256 * i + 4 * lane); ny[i] = *(const u32x2*)(Y + (size_t)tn * D + 256 * i + 4 * lane); } } }
        float mean, rstd; ln_stats(v, mean, rstd);
#pragma unroll
        for (int i = 0; i < 4; ++i) { const int c = 256 * i + 4 * lane; const f32x4 gg = Lgb[64 * i + lane], bb = Lgb[256 + 64 * i + lane];
#pragma unroll
            for (int e = 0; e < 4; ++e) v[i][e] = (v[i][e] - mean) * rstd * gg[e] + bb[e];
            { u32x2 pk; pk.x = pack2(v[i][0], v[i][1]); pk.y = pack2(v[i][2], v[i][3]); *(u32x2*)(X1 + (size_t)t * D + c) = pk; } }
        ln_stats(v, mean, rstd);
#pragma unroll
        for (int i = 0; i < 4; ++i) { const int c = 256 * i + 4 * lane; const f32x4 sh = msh[i], sc = msc[i];
#pragma unroll
            for (int e = 0; e < 4; ++e) v[i][e] = (v[i][e] - mean) * rstd * (1.0f + sc[e]) + sh[e];
            *(unsigned*)(H8 + (size_t)t * D + c) = pack4_fp8(v[i][0], v[i][1], v[i][2], v[i][3]); }
        f32x2 lg01 = (f32x2){0.f, 0.f}, lg23 = (f32x2){0.f, 0.f};
#pragma unroll
        for (int i = 0; i < 4; ++i)
#pragma unroll
            for (int e = 0; e < 4; ++e) { const f32x4 wv = Lg[((i * 4 + e) << 6) + lane]; const f32x2 vv = (f32x2){v[i][e], v[i][e]};
                lg01 += vv * (f32x2){wv[0], wv[1]}; lg23 += vv * (f32x2){wv[2], wv[3]}; }
        float lg[4] = {wave_sum(lg01[0]), wave_sum(lg01[1]), wave_sum(lg23[0]), wave_sum(lg23[1])};
        int grp = 0; float mx = lg[0];
#pragma unroll
        for (int q = 1; q < 4; ++q) if (lg[q] > mx) { mx = lg[q]; grp = q; }
        float se = 0.f;
#pragma unroll
        for (int q = 0; q < 4; ++q) se += expf(lg[q] - mx);
        const float gate_group = 1.0f / se;
        f32x2 le01 = (f32x2){0.f, 0.f}, le23 = (f32x2){0.f, 0.f}, le45 = (f32x2){0.f, 0.f}, le67 = (f32x2){0.f, 0.f};
#pragma unroll
        for (int i = 0; i < 4; ++i)
#pragma unroll
            for (int e = 0; e < 4; ++e) { const f32x4* wp = Le + grp * 2048 + ((i * 4 + e) << 6) + lane; const f32x4 w0 = wp[0], w1 = wp[1024]; const f32x2 vv = (f32x2){v[i][e], v[i][e]};
                le01 += vv * (f32x2){w0[0], w0[1]}; le23 += vv * (f32x2){w0[2], w0[3]}; le45 += vv * (f32x2){w1[0], w1[1]}; le67 += vv * (f32x2){w1[2], w1[3]}; }
        float le[8] = {wave_sum(le01[0]), wave_sum(le01[1]), wave_sum(le23[0]), wave_sum(le23[1]), wave_sum(le45[0]), wave_sum(le45[1]), wave_sum(le67[0]), wave_sum(le67[1])};
        int j1 = 0; float l1 = le[0];
#pragma unroll
        for (int q = 1; q < 8; ++q) if (le[q] > l1) { l1 = le[q]; j1 = q; }
        int j2 = -1; float l2 = -3.0e38f;
#pragma unroll
        for (int q = 0; q < 8; ++q) if (q != j1 && le[q] > l2) { l2 = le[q]; j2 = q; }
        const float e2 = expf(l2 - l1), p1 = 1.0f / (1.0f + e2), p2 = e2 / (1.0f + e2);
        if (lane == 0) {
            const int ex0 = grp * 8 + j1, ex1 = grp * 8 + j2;
            const int r0 = atomicAdd(&cnt[ex0], 1), r1 = atomicAdd(&cnt[ex1], 1);
            tokE[2 * t] = ex0; tokE[2 * t + 1] = ex1; tokR[2 * t] = r0; tokR[2 * t + 1] = r1;
            tokG[2 * t] = gate_group * p1; tokG[2 * t + 1] = gate_group * p2;
        }
    }
    __syncthreads();
    if (tid < 32) ((int*)(a->ws + WS_BCNT))[((size_t)l * MAXG + blockIdx.x) * 32 + tid] = cnt[tid];
    __syncthreads();
}

__device__ __forceinline__ void p5_dispatch(AP a, unsigned char* lds, int l) {
    const int tid = tid_opaque();
    const int ntok = (l == 0) ? NTOK : NLAT;
    int* part = (int*)lds;
    int* tot = (int*)(lds + 4096);
    int* off = (int*)(lds + 4096 + 128);
    int* pstart = (int*)(lds + 4096 + 256);
    const int* bc = (const int*)(a->ws + WS_BCNT) + (size_t)l * MAXG * 32;
    const int G = gridDim.x, me = blockIdx.x;
    { const int e = tid & 31, p = tid >> 5; int s = 0, so = 0; for (int bb = p; bb < G; bb += 16) { const int c = bc[bb * 32 + e]; s += c; if (bb < me) so += c; } part[p * 32 + e] = s; part[512 + p * 32 + e] = so; }
    __syncthreads();
    if (tid < 32) { int s = 0, so = 0; for (int p = 0; p < 16; ++p) { s += part[p * 32 + tid]; so += part[512 + p * 32 + tid]; } tot[tid] = s; off[tid] = so; }
    __syncthreads();
    if (tid == 0) { int acc = 0; for (int e = 0; e < 32; ++e) { pstart[e] = acc; acc += ((tot[e] + 255) >> 8) << 8; } }
    __syncthreads();
    if (me == 0 && tid < 32) ((int*)(a->ws + WS_CNT))[l * 32 + tid] = tot[tid];
    const int* tokE = (const int*)(a->ws + WS_TOKE); const int* tokR = (const int*)(a->ws + WS_TOKR);
    int* tokS = (int*)(a->ws + WS_TOKS); int* slotT = (int*)(a->ws + WS_SLOTT);
    for (int q = tid; ; q += NT) { const int it = q >> 4, j = q & 15, t = (it * G + me) * 8 + (j >> 1); if (t >= ntok) break;
        const int idx = 2 * t + (j & 1); const int e = tokE[idx]; const int slot = pstart[e] + off[e] + tokR[idx]; tokS[idx] = slot; slotT[slot] = t; }
    __syncthreads();
}

__device__ __forceinline__ void moe_table(AP a, int l, LAS int* blk) {
    const int* tot = (const int*)(a->ws + WS_CNT) + l * 32;
    __syncthreads();
    if (threadIdx.x < 32) blk[33 + threadIdx.x] = tot[threadIdx.x];
    __syncthreads();
    if (threadIdx.x == 0) { int acc = 0; for (int e = 0; e < 32; ++e) { blk[e] = acc; acc += (blk[33 + e] + 255) >> 8; } blk[32] = acc; }
    __syncthreads();
}
__device__ __forceinline__ int units_of(int nu, int v, int G) { return (v < nu) ? (nu - v + G - 1) / G : 0; }
__device__ __forceinline__ void p1_inproj(AP a, unsigned char* smem, LAS unsigned char* lds, int l) {
    SchedInProj S; S.ws = a->ws; S.l = l; S.G = gridDim.x; S.me = vblock();
    g256::gemm_phase(lds, 1024, S);
    { const int nu = (l == 0) ? 64 * 7 + 4 * 7 : 64 * 7 + 4, G = gridDim.x; if (units_of(nu, S.me, G) < (nu + G - 1) / G) exp_fill(a, smem, l, 8); }
}
__device__ __forceinline__ void p3_outproj(AP a, unsigned char* smem, LAS unsigned char* lds, int l) {
    SchedOutProj S; S.ws = a->ws; S.l = l; S.G = gridDim.x; S.me = vblock();
    g256::gemm_phase(lds, 1024, S);
    if (l == 0) {
        const bf16_t* W = (const bf16_t*)(a->ws + WS_WOUT);
        for (int u = blockIdx.x; u < 64; u += gridDim.x) { const int rt = u >> 3, ct = u & 7;
            EpiBf16 E; E.C = (bf16_t*)(a->ws + WS_Y) + (size_t)(NLAT + rt * 128) * D + ct * 128; E.ld = D; E.scale = 1.0f;
            const bf16_t* B0 = W + (size_t)(ct * 128) * 1024;
            gemm_tile<128, false, EpiBf16>(lds, (const bf16_t*)(a->ws + WS_CAT) + (size_t)(NLAT + rt * 128) * D, D, nullptr, 128, B0, B0 + (size_t)64 * 1024, 1024, 1024, E); }
        if (blockIdx.x >= 64) exp_fill(a, smem, 0, 3);
    }
}
__device__ __forceinline__ void p6_gateup(AP a, unsigned char* smem, LAS unsigned char* lds, int l) {
    LAS int* blk = (LAS int*)(lds + MISC_OFF + 256);
    moe_table(a, l, blk);
    LAS int* ridx = (LAS int*)(lds + RIDX_OFF);
    const int tid = tid_opaque(), G = gridDim.x, me = vblock(), nu = uni(blk[32]) * 4;
    LAS int* uinf = (LAS int*)(lds + MISC_OFF + 528);
    moe_units(blk, uinf, G, me);
    const int* slotT = (const int*)(a->ws + WS_SLOTT);
    for (int i = 0; i < 8; ++i) { const int idx = i * G + me; if (idx >= nu) break;
        const int rb = idx >> 2, valid = uinf[2 * i + 1];
        if (tid < 256) ridx[i * 256 + tid] = (tid < valid) ? slotT[rb * 256 + tid] : 0; }
    __syncthreads();
    SchedGateUp S; S.ws = a->ws; S.uinf = uinf; S.ridx_lds = ridx; S.G = G; S.me = me; S.l = l; S.nu = nu;
    g256::gemm_phase(lds, 512, S);
    __syncthreads();
    if (l == 0 && units_of(nu, me, G) < (nu + G - 1) / G) exp_fill(a, smem, 1, 4);
}
__device__ __forceinline__ void p7_down(AP a, unsigned char* smem, LAS unsigned char* lds, int l) {
    LAS int* blk = (LAS int*)(lds + MISC_OFF + 256);
    moe_table(a, l, blk);
    LAS int* uinf = (LAS int*)(lds + MISC_OFF + 528);
    SchedDown S; S.ws = a->ws; S.uinf = uinf; S.G = gridDim.x; S.me = vblock(); S.l = l; S.nu = uni(blk[32]) * 4;
    moe_units(blk, uinf, S.G, S.me);
    g256::gemm_phase(lds, 256, S);
    __syncthreads();
    { const int nu = S.nu, G = gridDim.x; if (l == 0 && units_of(nu, S.me, G) < (nu + G - 1) / G) exp_fill(a, smem, 1, 2); }
}

__device__ __forceinline__ void p8_ln2(AP a, unsigned char* lds, int l) {
    const int tid = tid_opaque(), lane = tid & 63, w = tid >> 6;
    const int ntok = (l == 0) ? NTOK : NLAT;
    const float* mod = (const float*)(a->ws + WS_MOD) + (size_t)l * 5 * 6144;
    const float* modn = (const float*)(a->ws + WS_MOD) + (size_t)5 * 6144;
    const bf16_t* X1 = (const bf16_t*)(a->ws + WS_X1);
    const unsigned char* YS = a->ws + WS_YS;
    const int* tokS = (const int*)(a->ws + WS_TOKS); const float* tokG = (const float*)(a->ws + WS_TOKG);
    f32x4* Lgb = (f32x4*)lds;
    __syncthreads();
    Lgb[tid] = (tid < 256) ? *(const f32x4*)(a->in[21] + l * 1024 + tid * 4) : *(const f32x4*)(a->in[22] + l * 1024 + (tid - 256) * 4);
    __syncthreads();
    int mrow = -1; f32x4 mg[4], nsh[4], nsc[4];
    const int tstep = gridDim.x * 8;
    int t = blockIdx.x * 8 + w;
    int ns0 = 0, ns1 = 0; float nga = 0.f, ngb = 0.f;
    u32x2 nx[4]; unsigned nya[4], nyb[4];
    float cga = 0.f, cgb = 0.f;
    if (t < ntok) { const int s0 = tokS[2 * t], s1 = tokS[2 * t + 1]; cga = tokG[2 * t]; cgb = tokG[2 * t + 1];
#pragma unroll
        for (int i = 0; i < 4; ++i) { const int c = 256 * i + 4 * lane; nx[i] = *(const u32x2*)(X1 + (size_t)t * D + c); nya[i] = *(const unsigned*)(YS + (size_t)s0 * D + c); nyb[i] = *(const unsigned*)(YS + (size_t)s1 * D + c); } }
    if (t + tstep < ntok) { ns0 = tokS[2 * (t + tstep)]; ns1 = tokS[2 * (t + tstep) + 1]; nga = tokG[2 * (t + tstep)]; ngb = tokG[2 * (t + tstep) + 1]; }
    for (; t < ntok; t += tstep) {
        const int mr = (t < NLAT) ? (t >> 12) : 4;
        if (mr != mrow) { mrow = mr; const float* m = mod + (size_t)mr * 6144; const float* mn = modn + (size_t)mr * 6144;
#pragma unroll
            for (int i = 0; i < 4; ++i) { const int c = 256 * i + 4 * lane; mg[i] = *(const f32x4*)(m + 5120 + c); if (l == 0) { nsh[i] = *(const f32x4*)(mn + c); nsc[i] = *(const f32x4*)(mn + 1024 + c); } } }
        f32x4 v[4];
#pragma unroll
        for (int i = 0; i < 4; ++i) { const f32x4 gv = mg[i];
            const f32x2 ya0 = __builtin_amdgcn_cvt_pk_f32_fp8(nya[i], false), ya1 = __builtin_amdgcn_cvt_pk_f32_fp8(nya[i], true), yb0 = __builtin_amdgcn_cvt_pk_f32_fp8(nyb[i], false), yb1 = __builtin_amdgcn_cvt_pk_f32_fp8(nyb[i], true);
            const float f0 = cga * ya0[0] + cgb * yb0[0], f1 = cga * ya0[1] + cgb * yb0[1], f2 = cga * ya1[0] + cgb * yb1[0], f3 = cga * ya1[1] + cgb * yb1[1];
            v[i][0] = RES_ALPHA * lo2f(nx[i].x) + gv[0] * f0; v[i][1] = RES_ALPHA * hi2f(nx[i].x) + gv[1] * f1; v[i][2] = RES_ALPHA * lo2f(nx[i].y) + gv[2] * f2; v[i][3] = RES_ALPHA * hi2f(nx[i].y) + gv[3] * f3; }
        {   const int tn = t + tstep, tn2 = t + 2 * tstep;
            if (tn < ntok) {
#pragma unroll
                for (int i = 0; i < 4; ++i) { const int c = 256 * i + 4 * lane; nx[i] = *(const u32x2*)(X1 + (size_t)tn * D + c); nya[i] = *(const unsigned*)(YS + (size_t)ns0 * D + c); nyb[i] = *(const unsigned*)(YS + (size_t)ns1 * D + c); }
                cga = nga; cgb = ngb; }
            if (tn2 < ntok) { ns0 = tokS[2 * tn2]; ns1 = tokS[2 * tn2 + 1]; nga = tokG[2 * tn2]; ngb = tokG[2 * tn2 + 1]; } }
        float mean, rstd; ln_stats(v, mean, rstd);
        float* dst = (l == 0) ? (float*)(a->ws + WS_XC) + (size_t)t * D : a->out + (size_t)t * D;
#pragma unroll
        for (int i = 0; i < 4; ++i) { const int c = 256 * i + 4 * lane; const f32x4 gg = Lgb[64 * i + lane], bb = Lgb[256 + 64 * i + lane];
#pragma unroll
            for (int e = 0; e < 4; ++e) v[i][e] = (v[i][e] - mean) * rstd * gg[e] + bb[e];
            *(f32x4*)(dst + c) = v[i]; }
        if (l == 0) {
            ln_stats(v, mean, rstd);
            bf16_t* H = (bf16_t*)(a->ws + WS_H);
#pragma unroll
            for (int i = 0; i < 4; ++i) { const int c = 256 * i + 4 * lane; const f32x4 sh = nsh[i], sc = nsc[i];
                f32x4 o;
#pragma unroll
                for (int e = 0; e < 4; ++e) o[e] = (v[i][e] - mean) * rstd * (1.0f + sc[e]) + sh[e];
                u32x2 pk; pk.x = pack2(o[0], o[1]); pk.y = pack2(o[2], o[3]); *(u32x2*)(H + (size_t)t * D + c) = pk; }
        }
    }
}

constexpr int N_PHASES = 18;
template <int P> __device__ __forceinline__ void run_phase(AP a, unsigned char* smem, LAS unsigned char* lds, int l) {
    asm volatile("" : "+s"(a));
    if (P == 0) p0_prologue(a, smem);
    if (P == 1) p_lnmod0(a);
    if (P == 2) p1_inproj(a, smem, lds, l);
    if (P == 3) p2_mix(a, smem, lds, l);
    if (P == 4) p3_outproj(a, smem, lds, l);
    if (P == 5) p4_ln1_router(a, smem, l);
    if (P == 6) p5_dispatch(a, smem, l);
    if (P == 7) p6_gateup(a, smem, lds, l);
    if (P == 8) p7_down(a, smem, lds, l);
    if (P == 9) p8_ln2(a, smem, l);
}
#if N_LAUNCH_MODE == 1
__global__ void __launch_bounds__(NT, 2) fwd(Args a) {
    extern __shared__ __attribute__((aligned(16))) unsigned char smem[];
    LAS unsigned char* lds = (LAS unsigned char*)smem;
    if (threadIdx.x < 4) ((volatile LAS unsigned*)(lds + MISC_OFF + 768))[threadIdx.x] = 0u;
    __syncthreads();
    XcdBarrier bar = xcd_barrier_post((unsigned*)(a.ws + WS_BAR), (volatile LAS unsigned*)(lds + MISC_OFF + 768));
    AP ap = (AP)__builtin_amdgcn_kernarg_segment_ptr();
#define PROBE(P, l) do { if (PROBE_MASK & (1 << (P))) { for (int _r = 0; _r < 2; ++_r) { xcd_barrier(bar); run_phase<P>(ap, smem, lds, l); } } } while (0)
    run_phase<0>(ap, smem, lds, 0); PROBE(0, 0); xcd_barrier(bar);
    run_phase<1>(ap, smem, lds, 0); PROBE(1, 0); xcd_barrier(bar);
    for (int l = 0; l < 2; ++l) {
        run_phase<2>(ap, smem, lds, l); PROBE(2, l); xcd_barrier(bar);
        run_phase<3>(ap, smem, lds, l); PROBE(3, l); xcd_barrier(bar);
        run_phase<4>(ap, smem, lds, l); PROBE(4, l); xcd_barrier(bar);
        run_phase<5>(ap, smem, lds, l); PROBE(5, l); xcd_barrier(bar);
        run_phase<6>(ap, smem, lds, l); PROBE(6, l); xcd_barrier(bar);
        run_phase<7>(ap, smem, lds, l); PROBE(7, l); xcd_barrier(bar);
        run_phase<8>(ap, smem, lds, l); PROBE(8, l); xcd_barrier(bar);
        run_phase<9>(ap, smem, lds, l); PROBE(9, l); if (l == 0) xcd_barrier(bar);
    }
}
#else
template <int P> __global__ void __launch_bounds__(NT, 2) k_phase(Args a) {
    extern __shared__ __attribute__((aligned(16))) unsigned char smem[];
    LAS unsigned char* lds = (LAS unsigned char*)smem;
    AP ap = (AP)__builtin_amdgcn_kernarg_segment_ptr();
    run_phase<P>(ap, smem, lds, ap->ph_lo);
}
template <int P> static void launch_phase(Args a, int l, int grid, hipStream_t stream) {
    static bool attr = false;
    if (!attr) { (void)hipFuncSetAttribute((const void*)k_phase<P>, hipFuncAttributeMaxDynamicSharedMemorySize, LDS_BYTES); attr = true; }
    a.ph_lo = l; a.ph_hi = P;
    hipLaunchKernelGGL(k_phase<P>, dim3(grid), dim3(NT), LDS_BYTES, stream, a);
}
#endif

extern "C" void kernel_launch(void* const* d_in, const int* in_sizes, int n_in, void* d_out, int out_size, void* d_ws, size_t ws_size, hipStream_t stream) {
    static int grid = 0;
    if (grid == 0) {
        if (n_in != 23 || out_size != NLAT * D || ws_size < WS_END) { fprintf(stderr, "kernel_launch: unexpected shapes (n_in %d, out %d, ws %zu, need %zu)\n", n_in, out_size, ws_size, (size_t)WS_END); grid = -1; return; }
        int dev = 0, cus = 0;
        if (hipGetDevice(&dev) != hipSuccess || hipDeviceGetAttribute(&cus, hipDeviceAttributeMultiprocessorCount, dev) != hipSuccess) { grid = -1; return; }
#if N_LAUNCH_MODE == 1
        int per_cu = 0;
        if (hipFuncSetAttribute((const void*)fwd, hipFuncAttributeMaxDynamicSharedMemorySize, LDS_BYTES) != hipSuccess) { fprintf(stderr, "kernel_launch: hipFuncSetAttribute failed\n"); grid = -1; return; }
        if (hipOccupancyMaxActiveBlocksPerMultiprocessor(&per_cu, (const void*)fwd, NT, LDS_BYTES) != hipSuccess || per_cu < 1) { fprintf(stderr, "kernel_launch: occupancy query says %d\n", per_cu); }
        (void)hipGetLastError();
#endif
        grid = cus; if (grid > MAXG) grid = MAXG;
    }
    if (grid < 0) return;
    (void)hipMemsetAsync((char*)d_ws + WS_BAR, 0, 16384 + 256, stream);
    Args a{};
    for (int i = 0; i < 23; ++i) a.in[i] = (const float*)d_in[i];
    a.out = (float*)d_out; a.ws = (unsigned char*)d_ws;
#if N_LAUNCH_MODE == 1
    a.ph_lo = 0; a.ph_hi = N_PHASES;
    hipLaunchKernelGGL(fwd, dim3(grid), dim3(NT), LDS_BYTES, stream, a);
#else
    launch_phase<0>(a, 0, grid, stream);
    launch_phase<1>(a, 0, grid, stream);
    for (int l = 0; l < 2; ++l) {
        launch_phase<2>(a, l, grid, stream); launch_phase<3>(a, l, grid, stream); launch_phase<4>(a, l, grid, stream); launch_phase<5>(a, l, grid, stream);
        launch_phase<6>(a, l, grid, stream); launch_phase<7>(a, l, grid, stream); launch_phase<8>(a, l, grid, stream); launch_phase<9>(a, l, grid, stream);
    }
#endif
}
```

```cpp
#include <hip/hip_runtime.h>
#include <stdint.h>
#include <stdio.h>

#ifndef PROBE_MASK
#define PROBE_MASK 0
#endif
#ifndef PROBE_FFT_REP
#define PROBE_FFT_REP 1
#endif
#ifndef PROBE_MIX_REP
#define PROBE_MIX_REP 1
#endif
#ifndef PROBE_SGU_REP
#define PROBE_SGU_REP 1
#endif
#ifndef N_LAUNCH_MODE
#define N_LAUNCH_MODE 1
#endif

#define LAS __attribute__((address_space(3)))
typedef unsigned short bf16_t;
typedef short bf16x8 __attribute__((ext_vector_type(8)));
typedef float f32x4 __attribute__((ext_vector_type(4)));
typedef unsigned u32x4 __attribute__((ext_vector_type(4)));
typedef unsigned u32x2 __attribute__((ext_vector_type(2)));
typedef float f32x2 __attribute__((ext_vector_type(2)));
typedef int i32x4 __attribute__((ext_vector_type(4)));

constexpr int D = 1024, NBATCH = 4, SEQ = 4096, CTXL = 256;
constexpr int NLAT = NBATCH * SEQ, NCTX = NBATCH * CTXL, NTOK = NLAT + NCTX;
constexpr int ZC = 1792;
constexpr int NEXP = 32, DEXP = 512;
constexpr int NSLOT = 2 * NTOK + NEXP * 256;
constexpr int NT = 512;
constexpr int MAXG = 512;
constexpr float RES_ALPHA = 1.41421356237309515f;
constexpr int MISC_OFF = 155648;
constexpr int RIDX_OFF = 131072;
constexpr int LDS_BYTES = MISC_OFF + 1024;

constexpr size_t WS_BAR   = 0;
constexpr size_t WS_CNT   = 16384;
constexpr size_t WS_BCNT  = WS_CNT + 256;
constexpr size_t WS_MOD   = WS_BCNT + (size_t)2 * MAXG * 32 * 4;
constexpr size_t WS_ROPE  = WS_MOD + (size_t)2 * 5 * 6144 * 4;
constexpr size_t WS_TOKE  = WS_ROPE + 8192;
constexpr size_t WS_TOKR  = WS_TOKE + (size_t)NTOK * 8;
constexpr size_t WS_TOKS  = WS_TOKR + (size_t)NTOK * 8;
constexpr size_t WS_TOKG  = WS_TOKS + (size_t)NTOK * 8;
constexpr size_t WS_SLOTT = WS_TOKG + (size_t)NTOK * 8;
constexpr size_t WS_WIN   = WS_SLOTT + (size_t)NSLOT * 4;
constexpr size_t WS_WOUT  = WS_WIN + (size_t)2 * ZC * 1024 * 2;
constexpr size_t WS_WSGU  = WS_WOUT + (size_t)2 * 1024 * 1024 * 2;
constexpr size_t WS_DFTC  = WS_WSGU + (size_t)2 * 4 * 128 * 128 * 2;
constexpr size_t WS_WEXP  = WS_DFTC + (size_t)256 * 512 * 2;
constexpr size_t EXPMAT   = (size_t)NEXP * 512 * 1024;
constexpr size_t WEXP_LAYER = 3 * EXPMAT;
constexpr size_t WS_X1    = WS_WEXP + 2 * WEXP_LAYER;
constexpr size_t WS_XC    = WS_X1 + (size_t)NTOK * D * 4;
constexpr size_t WS_H     = WS_XC + (size_t)NTOK * D * 4;
constexpr size_t WS_R     = WS_H + (size_t)NTOK * D * 2;
constexpr size_t WS_Z     = WS_R;
constexpr size_t WS_AT    = WS_Z + (size_t)NTOK * ZC * 2;
constexpr size_t WS_ATC   = WS_AT + (size_t)4 * 256 * 8192 * 2;
constexpr size_t WS_VT    = WS_ATC + (size_t)4 * 256 * 512 * 2;
constexpr size_t WS_VTC   = WS_VT + (size_t)4 * 2 * 64 * 4096 * 2;
constexpr size_t WS_CAT   = WS_VTC + (size_t)4 * 2 * 64 * 256 * 2;
constexpr size_t WS_REND  = WS_CAT + (size_t)NTOK * D * 2;
constexpr size_t WS_Y     = WS_R;
constexpr size_t WS_HID   = WS_R;
constexpr size_t WS_YS    = WS_HID + (size_t)NSLOT * DEXP * 2;
constexpr size_t WS_REND2 = (WS_YS + (size_t)NSLOT * D * 2 > WS_REND) ? WS_YS + (size_t)NSLOT * D * 2 : WS_REND;
constexpr size_t WS_H8    = (WS_REND2 + 255) & ~(size_t)255;
constexpr size_t WS_END   = WS_H8 + (size_t)NTOK * D;
static_assert(WS_Y + (size_t)NTOK * D * 4 <= WS_CAT, "Y must not reach CAT");
static_assert(WS_WIN % 256 == 0 && WS_DFTC % 256 == 0 && WS_WEXP % 256 == 0 && WS_X1 % 256 == 0 && WS_H % 256 == 0 && WS_R % 256 == 0 && WS_AT % 256 == 0 && WS_CAT % 256 == 0 && WS_YS % 256 == 0, "alignment");

struct Args { const float* in[23]; float* out; unsigned char* ws; int ph_lo, ph_hi; };
#define CAS __attribute__((address_space(4)))
typedef const CAS Args* AP;

#define XB_TMO      128
#define XB_XCNT(j)  (256  + 64 * (j))
#define XB_XSUB(j)  (1280 + 64 * (j))
#define XB_XGEN(j)  (2304 + 64 * (j))
#define XB_TOP      3328
#define XB_TOPGEN   3392
#define XCD_BAR_WORDS 3456
#define XB_SPIN_CAP (1u << 18)

__device__ __forceinline__ unsigned xb_ld(unsigned* p)              { return __hip_atomic_load(p, __ATOMIC_RELAXED, __HIP_MEMORY_SCOPE_AGENT); }
__device__ __forceinline__ unsigned xb_add(unsigned* p, unsigned v) { return __hip_atomic_fetch_add(p, v, __ATOMIC_RELAXED, __HIP_MEMORY_SCOPE_AGENT); }
__device__ __forceinline__ unsigned xb_xcc_id() { return (unsigned)__builtin_amdgcn_s_getreg((3 << 11) | 20) & 0xFu; }
#define XB_SPIN(cond, bar) do { unsigned _sp = 0; while (cond) { __builtin_amdgcn_s_sleep(1); \
    if ((++_sp & 255u) == 0u) { if (xb_ld(&(bar)[XB_TMO])) break; if (_sp > XB_SPIN_CAP) { atomicAdd(&(bar)[XB_TMO], 1u); break; } } } } while (0)

struct XcdBarrier { unsigned* bar; unsigned x; volatile LAS unsigned* st; };

__device__ __forceinline__ XcdBarrier xcd_barrier_post(unsigned* bar, volatile LAS unsigned* st) {
    XcdBarrier b; b.bar = bar; b.x = (unsigned)__builtin_amdgcn_readfirstlane((int)xb_xcc_id()); b.st = st;
    if (threadIdx.x == 0) (void)xb_add(&bar[XB_XCNT(b.x)], 1u);
    return b;
}
__device__ __forceinline__ void xcd_barrier_complete(unsigned* bar, unsigned x, unsigned& nloc, unsigned& nx) {
    const unsigned G = gridDim.x * gridDim.y * gridDim.z;
    unsigned sum, cnt, mine, sp = 0u;
    for (;;) {
        sum = 0u; cnt = 0u; mine = 0u;
#pragma unroll
        for (unsigned j = 0; j < 16; ++j) { const unsigned c = xb_ld(&bar[XB_XCNT(j)]); sum += c; cnt += (c > 0u) ? 1u : 0u; mine = (j == x) ? c : mine; }
        if (sum == G) break;
        __builtin_amdgcn_s_sleep(1);
        if ((++sp & 255u) == 0u) { if (xb_ld(&bar[XB_TMO])) break; if (sp > XB_SPIN_CAP) { atomicAdd(&bar[XB_TMO], 1u); break; } }
    }
    nloc = mine > 0u ? mine : 1u; nx = cnt > 0u ? cnt : 1u;
}
__device__ __forceinline__ void xcd_barrier(const XcdBarrier& b) {
    asm volatile("s_waitcnt vmcnt(0)" ::: "memory");
    __syncthreads();
    if (threadIdx.x == 0) {
        unsigned* bar = b.bar;
        unsigned bx = b.x;
        asm volatile("" : "+s"(bar), "+s"(bx));
        __builtin_amdgcn_s_waitcnt(0);
        unsigned nloc = b.st[0], nx = b.st[1];
        if (nloc == 0u) { xcd_barrier_complete(bar, bx, nloc, nx); b.st[0] = nloc; b.st[1] = nx; }
        const unsigned old = xb_add(&bar[XB_XSUB(bx)], 1u);
        const unsigned gen = old / nloc;
        if (old + 1u == (gen + 1u) * nloc) {
            __builtin_amdgcn_fence(__ATOMIC_RELEASE, "agent");
            asm volatile("s_waitcnt vmcnt(0)" ::: "memory");
            const unsigned og = xb_add(&bar[XB_TOP], 1u);
            const unsigned tg = og / nx;
            if (og + 1u == (tg + 1u) * nx) xb_add(&bar[XB_TOPGEN], 1u);
            else XB_SPIN(xb_ld(&bar[XB_TOPGEN]) == tg, bar);
            __builtin_amdgcn_fence(__ATOMIC_ACQUIRE, "agent");
            xb_add(&bar[XB_XGEN(bx)], 1u);
            asm volatile("s_waitcnt vmcnt(0)" ::: "memory");
        } else {
            XB_SPIN(xb_ld(&bar[XB_XGEN(bx)]) == gen, bar);
            __builtin_amdgcn_fence(__ATOMIC_ACQUIRE, "agent");
            asm volatile("s_waitcnt vmcnt(0)" ::: "memory");
        }
    }
    __syncthreads();
}

__device__ __forceinline__ int tid_opaque() { int t = threadIdx.x; asm volatile("" : "+v"(t)); return t; }
__device__ __forceinline__ float bf2f(bf16_t v) { return __uint_as_float(((unsigned)v) << 16); }
__device__ __forceinline__ bf16_t f2bf(float f) { return __builtin_bit_cast(unsigned short, (__bf16)f); }
typedef __bf16 hwbf16x2 __attribute__((ext_vector_type(2)));
__device__ __forceinline__ unsigned pack2(float a, float b) { return __builtin_bit_cast(unsigned, __builtin_convertvector((f32x2){a, b}, hwbf16x2)); }
__device__ __forceinline__ unsigned pack4_fp8(float a, float b, float c, float d) {
    a = __builtin_amdgcn_fmed3f(a, -448.f, 448.f); b = __builtin_amdgcn_fmed3f(b, -448.f, 448.f); c = __builtin_amdgcn_fmed3f(c, -448.f, 448.f); d = __builtin_amdgcn_fmed3f(d, -448.f, 448.f);
    int p = __builtin_amdgcn_cvt_pk_fp8_f32(a, b, 0, false); p = __builtin_amdgcn_cvt_pk_fp8_f32(c, d, p, true); return (unsigned)p; }
__device__ __forceinline__ float lo2f(unsigned w) { return __uint_as_float(w << 16); }
__device__ __forceinline__ float hi2f(unsigned w) { return __uint_as_float(w & 0xffff0000u); }
template <int CTRL> __device__ __forceinline__ float dpp_mov(float v) { return __builtin_bit_cast(float, __builtin_amdgcn_update_dpp(0, __builtin_bit_cast(int, v), CTRL, 0xf, 0xf, true)); }
__device__ __forceinline__ float row_sum16(float v) {
    v += dpp_mov<0xB1>(v);
    v += dpp_mov<0x4E>(v);
    v += dpp_mov<0x141>(v);
    v += dpp_mov<0x140>(v);
    return v;
}
__device__ __forceinline__ float row_max16(float v) {
    v = fmaxf(v, dpp_mov<0xB1>(v)); v = fmaxf(v, dpp_mov<0x4E>(v)); v = fmaxf(v, dpp_mov<0x141>(v)); v = fmaxf(v, dpp_mov<0x140>(v));
    return v;
}
__device__ __forceinline__ float wave_sum(float v) {
    v = row_sum16(v);
    const int iv = __builtin_bit_cast(int, v);
    const float a0 = __builtin_bit_cast(float, __builtin_amdgcn_readlane(iv, 0)), a1 = __builtin_bit_cast(float, __builtin_amdgcn_readlane(iv, 16));
    const float a2 = __builtin_bit_cast(float, __builtin_amdgcn_readlane(iv, 32)), a3 = __builtin_bit_cast(float, __builtin_amdgcn_readlane(iv, 48));
    return (a0 + a1) + (a2 + a3);
}
__device__ __forceinline__ float gelu_erf(float v) {
    const float t = __builtin_amdgcn_rcpf(fabsf(v) * 0.2316418882f + 1.0f);
    float q = t * 0.5307027145f + (-0.7265760135f); q = q * t + 0.7107068705f; q = q * t + (-0.142248368f); q = q * t + 0.127414796f; q = q * t;
    const float m = v * (q * __builtin_amdgcn_exp2f((v * v) * (-0.72134752044f)));
    return v < 0.f ? m : v - m;
}
__device__ __forceinline__ float silu_f(float x) { return x * __builtin_amdgcn_rcpf(1.0f + __expf(-x)); }

__device__ __forceinline__ void ln_stats(const f32x4 (&v)[4], float& mean, float& rstd) {
    float s = 0.f;
#pragma unroll
    for (int i = 0; i < 4; ++i) s += (v[i][0] + v[i][1]) + (v[i][2] + v[i][3]);
    s = wave_sum(s); mean = s * (1.0f / 1024.0f);
    float q = 0.f;
#pragma unroll
    for (int i = 0; i < 4; ++i)
#pragma unroll
        for (int e = 0; e < 4; ++e) { const float d = v[i][e] - mean; q += d * d; }
    q = wave_sum(q); rstd = 1.0f / sqrtf(q * (1.0f / 1024.0f) + 1e-6f);
}

template <int BN> struct MfmaLayout {
    static constexpr int FG = BN / 128, NI = 4, NJ = 2 * FG;
    static constexpr bool PAIR8 = false;
    int rbase, cbase;
    __device__ __forceinline__ int row(int i) const { return rbase + 16 * i; }
    __device__ __forceinline__ int col(int jj) const { return (jj / FG) * (BN / 2) + (jj % FG) * 16 + cbase; }
};

__device__ __forceinline__ void glds16(const bf16_t* g, LAS unsigned char* l) {
    __builtin_amdgcn_global_load_lds((const unsigned*)g, (LAS unsigned*)l, 16, 0, 0);
}

template <int BN, bool GATHER, class Epi>
__device__ __forceinline__ void gemm_tile(LAS unsigned char* lds, const bf16_t* A, int lda, const int* rowidx, int valid_rows,
                                          const bf16_t* B0, const bf16_t* B1, int ldb, int K, const Epi& epi) {
    constexpr int A_B = 16384, B_B = BN * 128, STAGE = A_B + B_B, NBL = BN / 64;
    const int tid = tid_opaque(), lane = tid & 63, wid = __builtin_amdgcn_readfirstlane(tid >> 6);
    const bf16_t* ap[2]; const bf16_t* bp[NBL];
#pragma unroll
    for (int i = 0; i < 2; ++i) {
        const int P = i * 512 + tid, row = P >> 3, c = (P & 7) ^ ((row >> 1) & 7);
        size_t ro;
        if (GATHER) ro = (size_t)(row < valid_rows ? rowidx[row] : 0) * (size_t)lda; else ro = (size_t)row * (size_t)lda;
        ap[i] = A + ro + c * 8;
    }
#pragma unroll
    for (int i = 0; i < NBL; ++i) {
        const int P = i * 512 + tid, row = P >> 3, c = (P & 7) ^ ((row >> 1) & 7);
        const bf16_t* base = (row < BN / 2) ? (B0 + (size_t)row * ldb) : (B1 + (size_t)(row - BN / 2) * ldb);
        bp[i] = base + c * 8;
    }
    const int nk = K / 64;
#define GT_STAGE(buf, k0) do { \
        _Pragma("unroll") for (int _i = 0; _i < 2; ++_i) glds16(ap[_i] + (k0), lds + (buf) * STAGE + _i * 8192 + wid * 1024); \
        _Pragma("unroll") for (int _i = 0; _i < NBL; ++_i) glds16(bp[_i] + (k0), lds + (buf) * STAGE + A_B + _i * 8192 + wid * 1024); } while (0)

    typedef MfmaLayout<BN> Lay;
    constexpr int FG = Lay::FG;
    const int fr = lane & 15, g = lane >> 4, wr = wid >> 2, wc = wid & 3;
    Lay lay; lay.rbase = wr * 64 + fr; lay.cbase = wc * 16 * FG + 4 * g;
    f32x4 acc[Lay::NI][Lay::NJ];
#pragma unroll
    for (int i = 0; i < Lay::NI; ++i)
#pragma unroll
        for (int j = 0; j < Lay::NJ; ++j) acc[i][j] = (f32x4){0.f, 0.f, 0.f, 0.f};
    int aoff[4], boff[Lay::NJ];
#pragma unroll
    for (int m = 0; m < 4; ++m) { const int row = wr * 64 + m * 16 + fr; aoff[m] = row * 128 + ((g ^ ((row >> 1) & 7)) << 4); }
#pragma unroll
    for (int jj = 0; jj < Lay::NJ; ++jj) { const int row = (jj / FG) * (BN / 2) + wc * 16 * FG + (jj % FG) * 16 + fr; boff[jj] = A_B + row * 128 + ((g ^ ((row >> 1) & 7)) << 4); }
    GT_STAGE(0, 0);
    asm volatile("s_waitcnt vmcnt(0)" ::: "memory"); __syncthreads();
    for (int kt = 0; kt < nk; ++kt) {
        if (kt + 1 < nk) GT_STAGE((kt + 1) & 1, (kt + 1) * 64);
        const LAS unsigned char* sa = lds + (kt & 1) * STAGE;
#pragma unroll
        for (int ks = 0; ks < 2; ++ks) {
            bf16x8 af[4], bfv[Lay::NJ];
#pragma unroll
            for (int m = 0; m < 4; ++m) af[m] = *(const LAS bf16x8*)(sa + (aoff[m] ^ (ks << 6)));
#pragma unroll
            for (int jj = 0; jj < Lay::NJ; ++jj) bfv[jj] = *(const LAS bf16x8*)(sa + (boff[jj] ^ (ks << 6)));
#pragma unroll
            for (int m = 0; m < 4; ++m)
#pragma unroll
                for (int jj = 0; jj < Lay::NJ; ++jj) acc[m][jj] = __builtin_amdgcn_mfma_f32_16x16x32_bf16(bfv[jj], af[m], acc[m][jj], 0, 0, 0);
        }
        asm volatile("s_waitcnt vmcnt(0)" ::: "memory"); __syncthreads();
    }
    epi.run(acc, lay);
#undef GT_STAGE
}

namespace g256 {
constexpr int BK = 64, HALF = 128, HTB = HALF * BK * 2, STAGE_BYTES = 8 * HTB;
__device__ __forceinline__ int lds_byte(int r, int c) { const int st = (r >> 4) * 2 + (c >> 5), rr = r & 15, cc = c & 31, ob = rr * 64 + cc * 2; return st * 1024 + (ob ^ (((ob >> 9) & 1) << 5)); }
__device__ __forceinline__ int perm32(int rho) { const int n = rho >> 4, i = rho & 15; return 8 * (i >> 2) + 4 * n + (i & 3); }
__device__ __forceinline__ void stage_rc(int b, int& R, int& C) { const int st = b / 1024, sb = b % 1024, swz = sb ^ (((sb >> 9) & 1) << 5); R = (st >> 1) * 16 + swz / 64; C = (st & 1) * 32 + (swz % 64) / 2; }
struct Lay {
    static constexpr int NI = 8, NJ = 4;
    static constexpr bool PAIR8 = true;
    int rbase, cbase;
    __device__ __forceinline__ int row(int i) const { return (i >> 2) * 128 + (i & 3) * 16 + rbase; }
    __device__ __forceinline__ int col(int j) const { return (j >> 1) * 128 + (j & 1) * 4 + cbase; }
};
template <class Epi> struct Unit { const bf16_t* A; const bf16_t* B0; const bf16_t* B1; const LAS int* ridx; int valid; Epi epi; };

template <class Sched>
__device__ __forceinline__ void gemm_phase(LAS unsigned char* lds, const int K, const Sched& S) {
    typedef typename Sched::Epi Epi;
    const int tid = tid_opaque(), wid = __builtin_amdgcn_readfirstlane(tid >> 6), lane = tid & 63, wr = wid >> 2, wc = wid & 3, fr = lane & 15, fq = lane >> 4;
    int nt = K / BK; asm volatile("" : "+s"(nt));
    int sR[2], sC[2];
#pragma unroll
    for (int i = 0; i < 2; ++i) stage_rc(tid * 16 + i * 8192, sR[i], sC[i]);
    unsigned voffB[2];
#pragma unroll
    for (int i = 0; i < 2; ++i) voffB[i] = (unsigned)(((sR[i] & ~31) + perm32(sR[i] & 31)) * K + sC[i]) * 2u;
    const size_t kstep = (size_t)(BK * 2);
    const unsigned ldsw = (unsigned)wid * 1024u;
    const int aoff = lds_byte(wr * 64 + fr, fq * 8), boff = lds_byte(wc * 32 + fr, fq * 8);
#define G2_SA(b, h) (((b) * 2 + (h)) * HTB)
#define G2_SB(b, h) ((4 + (b) * 2 + (h)) * HTB)
#define G2_STAGE(bufoff, gbase, v0, v1) do { \
        __builtin_amdgcn_global_load_lds((const unsigned*)((const char*)(gbase) + (v0)), (LAS unsigned*)(lds + (bufoff) + ldsw), 16, 0, 0); \
        __builtin_amdgcn_global_load_lds((const unsigned*)((const char*)(gbase) + (v1)), (LAS unsigned*)(lds + (bufoff) + ldsw + 8192), 16, 0, 0); } while (0)
#define G2_LDA(dst, b, h) do { _Pragma("unroll") for (int m = 0; m < 4; ++m) _Pragma("unroll") for (int k = 0; k < 2; ++k) dst[m][k] = *(const LAS bf16x8*)(lds + G2_SA(b, h) + aoff + m * 2048 + k * 1024); } while (0)
#define G2_LDB(dst, b, h) do { _Pragma("unroll") for (int n = 0; n < 2; ++n) _Pragma("unroll") for (int k = 0; k < 2; ++k) dst[n][k] = *(const LAS bf16x8*)(lds + G2_SB(b, h) + boff + n * 2048 + k * 1024); } while (0)
#define G2_MMA(ai, bj, At, Bt) do { __builtin_amdgcn_s_setprio(1); _Pragma("unroll") for (int m = 0; m < 4; ++m) _Pragma("unroll") for (int n = 0; n < 2; ++n) _Pragma("unroll") for (int k = 0; k < 2; ++k) { \
        if (Sched::FP8) { const i32x4 _b = __builtin_bit_cast(i32x4, Bt[n][k]), _a = __builtin_bit_cast(i32x4, At[m][k]);     \
            acc[(ai) * 4 + m][(bj) * 2 + n] = __builtin_amdgcn_mfma_f32_16x16x32_fp8_fp8(((long)(unsigned)_b[1] << 32) | (unsigned)_b[0], ((long)(unsigned)_a[1] << 32) | (unsigned)_a[0], acc[(ai) * 4 + m][(bj) * 2 + n], 0, 0, 0); \
            acc[(ai) * 4 + m][(bj) * 2 + n] = __builtin_amdgcn_mfma_f32_16x16x32_fp8_fp8(((long)(unsigned)_b[3] << 32) | (unsigned)_b[2], ((long)(unsigned)_a[3] << 32) | (unsigned)_a[2], acc[(ai) * 4 + m][(bj) * 2 + n], 0, 0, 0); } \
        else acc[(ai) * 4 + m][(bj) * 2 + n] = __builtin_amdgcn_mfma_f32_16x16x32_bf16(Bt[n][k], At[m][k], acc[(ai) * 4 + m][(bj) * 2 + n], 0, 0, 0); } __builtin_amdgcn_s_setprio(0); } while (0)
#define G2_WAIT_V(n) asm volatile("s_waitcnt vmcnt(" #n ")" ::: "memory")
#define G2_WAIT_L(n) asm volatile("s_waitcnt lgkmcnt(" #n ")" ::: "memory")
#define G2_BAR __builtin_amdgcn_s_barrier()
#define G2_SCHED __builtin_amdgcn_sched_barrier(0)
#define G2_VOFFA(U, dst) do { _Pragma("unroll") for (int _h = 0; _h < 2; ++_h) _Pragma("unroll") for (int _i = 0; _i < 2; ++_i) { const int _row = _h * 128 + sR[_i]; \
        int _tok = _row; if (Sched::GATHER) _tok = (_row < (U).valid) ? (U).ridx[_row] : 0; dst[_h][_i] = (unsigned)(_tok * K + sC[_i]) * 2u; } } while (0)
    Unit<Epi> cur, nxt; int ui = 0;
    if (!S.get(0, cur)) return;
    f32x4 acc[8][4];
#pragma unroll
    for (int i = 0; i < 8; ++i)
#pragma unroll
        for (int j = 0; j < 4; ++j) acc[i][j] = (f32x4){0.f, 0.f, 0.f, 0.f};
    bf16x8 At[4][2], B0[2][2], B1[2][2];
    unsigned cvA[2][2], nvA[2][2];
    G2_VOFFA(cur, cvA);
    const char* cA = (const char*)cur.A; const char* cB0 = (const char*)cur.B0; const char* cB1 = (const char*)cur.B1;
    G2_STAGE(G2_SB(0, 0), cB0, voffB[0], voffB[1]); G2_STAGE(G2_SB(0, 1), cB1, voffB[0], voffB[1]); G2_STAGE(G2_SA(0, 0), cA, cvA[0][0], cvA[0][1]); G2_STAGE(G2_SA(0, 1), cA, cvA[1][0], cvA[1][1]);
    if (wr == 1) G2_BAR;
    G2_WAIT_V(2); G2_BAR;
    G2_STAGE(G2_SB(1, 0), cB0 + kstep, voffB[0], voffB[1]); G2_STAGE(G2_SA(1, 0), cA + kstep, cvA[0][0], cvA[0][1]); G2_STAGE(G2_SB(1, 1), cB1 + kstep, voffB[0], voffB[1]);
    G2_WAIT_V(6); G2_BAR;
    for (;;) {
        const bool has_next = S.get(ui + 1, nxt);
        if (Sched::GATHER) {
            if (has_next) { G2_VOFFA(nxt, nvA); }
            else {
#pragma unroll
                for (int h = 0; h < 2; ++h) { nvA[h][0] = cvA[h][0]; nvA[h][1] = cvA[h][1]; } }
        }
        const char* nA = has_next ? (const char*)nxt.A : cA; const char* nB0 = has_next ? (const char*)nxt.B0 : cB0; const char* nB1 = has_next ? (const char*)nxt.B1 : cB1;
#pragma unroll 1
        for (int t = 0; t < nt; t += 2) {
            const bool last = (t == nt - 2);
            const char* a1 = cA + (size_t)(t + 1) * kstep;
            const char* a2 = last ? nA : cA + (size_t)(t + 2) * kstep;
            const char* b20 = last ? nB0 : cB0 + (size_t)(t + 2) * kstep; const char* b21 = last ? nB1 : cB1 + (size_t)(t + 2) * kstep;
#define x00 ((Sched::GATHER && last) ? nvA[0][0] : cvA[0][0])
#define x01 ((Sched::GATHER && last) ? nvA[0][1] : cvA[0][1])
#define x10 ((Sched::GATHER && last) ? nvA[1][0] : cvA[1][0])
#define x11 ((Sched::GATHER && last) ? nvA[1][1] : cvA[1][1])
            G2_LDB(B0, 0, 0); G2_LDB(B1, 0, 1); G2_SCHED; G2_LDA(At, 0, 0); G2_STAGE(G2_SA(1, 1), a1, cvA[1][0], cvA[1][1]);
            G2_WAIT_V(8); G2_WAIT_L(0); G2_BAR; G2_MMA(0, 0, At, B0); G2_MMA(0, 1, At, B1); G2_BAR; G2_SCHED;
            G2_LDA(At, 0, 1); G2_STAGE(G2_SB(0, 0), b20, voffB[0], voffB[1]); G2_STAGE(G2_SB(0, 1), b21, voffB[0], voffB[1]); G2_STAGE(G2_SA(0, 0), a2, x00, x01);
            G2_WAIT_V(8); G2_WAIT_L(0); G2_BAR; G2_MMA(1, 0, At, B0); G2_MMA(1, 1, At, B1); G2_BAR; G2_SCHED;
            G2_LDB(B0, 1, 0); G2_LDB(B1, 1, 1); G2_SCHED; G2_LDA(At, 1, 0); G2_STAGE(G2_SA(0, 1), a2, x10, x11);
            G2_WAIT_V(8); G2_WAIT_L(0); G2_BAR; G2_MMA(0, 0, At, B0); G2_MMA(0, 1, At, B1); G2_BAR; G2_SCHED;
            G2_LDA(At, 1, 1); G2_STAGE(G2_SB(1, 0), b20 + kstep, voffB[0], voffB[1]); G2_STAGE(G2_SB(1, 1), b21 + kstep, voffB[0], voffB[1]); G2_STAGE(G2_SA(1, 0), a2 + kstep, x00, x01);
            G2_WAIT_V(8); G2_WAIT_L(0); G2_BAR; G2_MMA(1, 0, At, B0); G2_MMA(1, 1, At, B1); G2_BAR; G2_SCHED;
        }
        if (wr == 0) G2_BAR;
        { Lay lay; int rbv = wr * 64 + fr, cbv = wc * 32 + 8 * fq; asm volatile("" : "+v"(rbv), "+v"(cbv));
          lay.rbase = rbv; lay.cbase = cbv; cur.epi.run(acc, lay); }
        if (!has_next) break;
#pragma unroll
        for (int i = 0; i < 8; ++i)
#pragma unroll
            for (int j = 0; j < 4; ++j) acc[i][j] = (f32x4){0.f, 0.f, 0.f, 0.f};
        cur = nxt; cA = nA; cB0 = nB0; cB1 = nB1; ++ui;
        if (wr == 1) G2_BAR;
        if (Sched::GATHER) {
#pragma unroll
            for (int h = 0; h < 2; ++h) { cvA[h][0] = nvA[h][0]; cvA[h][1] = nvA[h][1]; } }
    }
#undef x00
#undef x01
#undef x10
#undef x11
    G2_WAIT_V(0);
    G2_BAR;
#undef G2_SA
#undef G2_SB
#undef G2_STAGE
#undef G2_LDA
#undef G2_LDB
#undef G2_MMA
#undef G2_WAIT_V
#undef G2_WAIT_L
#undef G2_BAR
#undef G2_SCHED
#undef G2_VOFFA
}
}

struct EpiF32 {
    float* C; int ld;
    template <class L> __device__ __forceinline__ void run(const f32x4 (&acc)[L::NI][L::NJ], const L& lay) const {
#pragma unroll
        for (int i = 0; i < L::NI; ++i)
#pragma unroll
            for (int j = 0; j < L::NJ; ++j) *(f32x4*)(C + (size_t)lay.row(i) * ld + lay.col(j)) = acc[i][j];
    }
};
struct EpiBf16 {
    bf16_t* C; int ld; float scale;
    template <class L> __device__ __forceinline__ void run(const f32x4 (&acc)[L::NI][L::NJ], const L& lay) const {
#pragma unroll
        for (int i = 0; i < L::NI; ++i) {
            if (L::PAIR8) {
#pragma unroll
                for (int j = 0; j < L::NJ; j += 2) { const f32x4 p = acc[i][j] * scale, q = acc[i][j + 1] * scale; u32x4 w; w.x = pack2(p[0], p[1]); w.y = pack2(p[2], p[3]); w.z = pack2(q[0], q[1]); w.w = pack2(q[2], q[3]);
                    *(u32x4*)(C + (size_t)lay.row(i) * ld + lay.col(j)) = w; }
            } else {
#pragma unroll
                for (int j = 0; j < L::NJ; ++j) { const f32x4 p = acc[i][j] * scale; u32x2 w; w.x = pack2(p[0], p[1]); w.y = pack2(p[2], p[3]);
                    *(u32x2*)(C + (size_t)lay.row(i) * ld + lay.col(j)) = w; }
            }
        }
    }
};
struct EpiFp8 {
    unsigned char* C; int ld; float scale;
    template <class L> __device__ __forceinline__ void run(const f32x4 (&acc)[L::NI][L::NJ], const L& lay) const {
        static_assert(L::PAIR8, "written for the paired-column layout");
#pragma unroll
        for (int i = 0; i < L::NI; ++i)
#pragma unroll
            for (int j = 0; j < L::NJ; j += 2) { const f32x4 p = acc[i][j] * scale, q = acc[i][j + 1] * scale; u32x2 w; w.x = pack4_fp8(p[0], p[1], p[2], p[3]); w.y = pack4_fp8(q[0], q[1], q[2], q[3]);
                *(u32x2*)(C + (size_t)lay.row(i) * ld + lay.col(j)) = w; }
    }
};
struct EpiGateUp8 {
    unsigned char* C; int ld;
    template <class L> __device__ __forceinline__ void run(const f32x4 (&acc)[L::NI][L::NJ], const L& lay) const {
        static_assert(L::PAIR8 && L::NJ == 4, "written for the paired-column 256x256 layout");
#pragma unroll
        for (int i = 0; i < L::NI; ++i) {
            const f32x4 g0 = acc[i][0] * (1.0f / 32.0f), g1 = acc[i][1] * (1.0f / 32.0f), u0 = acc[i][2] * (1.0f / 32.0f), u1 = acc[i][3] * (1.0f / 32.0f);
            u32x2 w; w.x = pack4_fp8(silu_f(g0[0]) * u0[0], silu_f(g0[1]) * u0[1], silu_f(g0[2]) * u0[2], silu_f(g0[3]) * u0[3]);
            w.y = pack4_fp8(silu_f(g1[0]) * u1[0], silu_f(g1[1]) * u1[1], silu_f(g1[2]) * u1[2], silu_f(g1[3]) * u1[3]);
            *(u32x2*)(C + (size_t)lay.row(i) * ld + lay.col(0)) = w;
        }
    }
};
struct EpiGateUp {
    bf16_t* C; int ld;
    template <class L> __device__ __forceinline__ void run(const f32x4 (&acc)[L::NI][L::NJ], const L& lay) const {
#pragma unroll
        for (int i = 0; i < L::NI; ++i) {
            if (L::PAIR8 && L::NJ == 4) {
                const f32x4 g0 = acc[i][0], g1 = acc[i][1], u0 = acc[i][2], u1 = acc[i][3];
                u32x4 w; w.x = pack2(silu_f(g0[0]) * u0[0], silu_f(g0[1]) * u0[1]); w.y = pack2(silu_f(g0[2]) * u0[2], silu_f(g0[3]) * u0[3]);
                w.z = pack2(silu_f(g1[0]) * u1[0], silu_f(g1[1]) * u1[1]); w.w = pack2(silu_f(g1[2]) * u1[2], silu_f(g1[3]) * u1[3]);
                *(u32x4*)(C + (size_t)lay.row(i) * ld + lay.col(0)) = w;
            } else {
#pragma unroll
                for (int j = 0; j < L::NJ / 2; ++j) { const f32x4 gt = acc[i][j], up = acc[i][j + L::NJ / 2];
                    u32x2 w; w.x = pack2(silu_f(gt[0]) * up[0], silu_f(gt[1]) * up[1]); w.y = pack2(silu_f(gt[2]) * up[2], silu_f(gt[3]) * up[3]);
                    *(u32x2*)(C + (size_t)lay.row(i) * ld + lay.col(j)) = w; }
            }
        }
    }
};
struct EpiInProj {
    bf16_t* Zt;
    bf16_t* tF;
    bf16_t* tV;
    int n0, pos0, n;
    template <class L> __device__ __forceinline__ void run(const f32x4 (&acc)[L::NI][L::NJ], const L& lay) const {
        static_assert(L::PAIR8, "written for the paired-column layout");
#pragma unroll
        for (int i = 0; i < L::NI; ++i)
#pragma unroll
            for (int j = 0; j < L::NJ; j += 2) {
                const int r = lay.row(i), cl = lay.col(j), c = n0 + cl;
                const f32x4 v0 = acc[i][j], v1 = acc[i][j + 1];
                if (c < 512) {
                    const int part = c >> 8, ch = c & 255;
#pragma unroll
                    for (int e = 0; e < 4; ++e) { tF[((size_t)(ch + e) * 2 + part) * n + pos0 + r] = f2bf(v0[e]); tF[((size_t)(ch + 4 + e) * 2 + part) * n + pos0 + r] = f2bf(v1[e]); }
                } else {
                    u32x4 w; w.x = pack2(v0[0], v0[1]); w.y = pack2(v0[2], v0[3]); w.z = pack2(v1[0], v1[1]); w.w = pack2(v1[2], v1[3]);
                    *(u32x4*)(Zt + (size_t)r * ZC + cl) = w;
                    if (c >= 896 && c < 1024) {
#pragma unroll
                        for (int e = 0; e < 4; ++e) { tV[(size_t)(c - 896 + e) * n + pos0 + r] = f2bf(v0[e]); tV[(size_t)(c - 896 + 4 + e) * n + pos0 + r] = f2bf(v1[e]); }
                    }
                }
            }
    }
};

constexpr int U_ADA = 192, U_WIN = 2 * 16 * 28, U_WOUT = 2 * 16 * 16, U_SGU = 32, U_DFT = 256, U_ROPE = 1, U_EXP = 3 * 32 * 32;
constexpr int LDS_SIL = 0, LDS_RED = 20480, LDS_TILE = 32768, LDS_T64 = 49408, LDS_CTAB = 50176;

__device__ __forceinline__ void ada_unit(AP a, unsigned char* lds, int u) {
    float* sil = (float*)(lds + LDS_SIL); float* red = (float*)(lds + LDS_RED);
    const int tid = tid_opaque(), lane = tid & 63, w = tid >> 6;
    const int l = u / 96, cg = u % 96;
    for (int i = tid; i < 5120; i += NT) { const int r = i >> 10, k = i & 1023; const float v = (r < 4) ? a->in[1][r * 1024 + k] : a->in[3][k]; sil[i] = v / (1.0f + expf(-v)); }
    __syncthreads();
    const float* W = a->in[4] + (size_t)l * 1024 * 6144 + cg * 64 + lane;
    float acc[5] = {0.f, 0.f, 0.f, 0.f, 0.f};
#pragma unroll 32
    for (int k = w * 128; k < w * 128 + 128; ++k) { const float wv = W[(size_t)k * 6144];
#pragma unroll
        for (int r = 0; r < 5; ++r) acc[r] += sil[r * 1024 + k] * wv; }
#pragma unroll
    for (int r = 0; r < 5; ++r) red[(w * 5 + r) * 64 + lane] = acc[r];
    __syncthreads();
    if (tid < 320) { const int r = tid >> 6; float s = 0.f;
#pragma unroll
        for (int ww = 0; ww < 8; ++ww) s += red[(ww * 5 + r) * 64 + lane];
        const int j = cg * 64 + lane; ((float*)(a->ws + WS_MOD))[(size_t)(l * 5 + r) * 6144 + j] = s + a->in[5][l * 6144 + j]; }
    __syncthreads();
}

__device__ __forceinline__ void tile_store_T(const float* tile, bf16_t* dst, int ldd) {
    const int tid = tid_opaque(), n = tid >> 3, kc = tid & 7;
    u32x4 w;
    w.x = pack2(tile[(kc * 8 + 0) * 65 + n], tile[(kc * 8 + 1) * 65 + n]); w.y = pack2(tile[(kc * 8 + 2) * 65 + n], tile[(kc * 8 + 3) * 65 + n]);
    w.z = pack2(tile[(kc * 8 + 4) * 65 + n], tile[(kc * 8 + 5) * 65 + n]); w.w = pack2(tile[(kc * 8 + 6) * 65 + n], tile[(kc * 8 + 7) * 65 + n]);
    *(u32x4*)(dst + (size_t)n * ldd + kc * 8) = w;
}
__device__ __forceinline__ void tile_load(float* tile, const float* src, int lds_) {
    const int tid = tid_opaque();
#pragma unroll
    for (int i = 0; i < 2; ++i) { const int row = (tid >> 4) + 32 * i, c4 = (tid & 15) * 4; const f32x4 v = *(const f32x4*)(src + (size_t)row * lds_ + c4);
        tile[row * 65 + c4 + 0] = v[0]; tile[row * 65 + c4 + 1] = v[1]; tile[row * 65 + c4 + 2] = v[2]; tile[row * 65 + c4 + 3] = v[3]; }
}

__device__ __forceinline__ void mm64_f32(const float* tA, int lda, const float* tB, int ldb, int K, float* out) {
    const int tid = tid_opaque(), lane = tid & 63, w = tid >> 6, fr = lane & 15, g = lane >> 4, mi = w >> 1, nj = 2 * (w & 1);
    f32x4 acc0 = (f32x4){0.f, 0.f, 0.f, 0.f}, acc1 = (f32x4){0.f, 0.f, 0.f, 0.f};
    const float* pa = tA + (16 * mi + fr) * lda + g; const float* pb = tB + g * ldb + 16 * nj + fr;
#pragma unroll 4
    for (int k0 = 0; k0 < K; k0 += 4) { const float av = pa[k0], b0 = pb[k0 * ldb], b1 = pb[k0 * ldb + 16];
        acc0 = __builtin_amdgcn_mfma_f32_16x16x4f32(av, b0, acc0, 0, 0, 0); acc1 = __builtin_amdgcn_mfma_f32_16x16x4f32(av, b1, acc1, 0, 0, 0); }
#pragma unroll
    for (int r = 0; r < 4; ++r) { out[(16 * mi + 4 * g + r) * 65 + 16 * nj + fr] = acc0[r]; out[(16 * mi + 4 * g + r) * 65 + 16 * nj + 16 + fr] = acc1[r]; }
}

__device__ __forceinline__ void win_unit(AP a, unsigned char* lds, int u) {
    float* tile = (float*)(lds + LDS_TILE); float* T = (float*)(lds + LDS_T64);
    const int tid = tid_opaque();
    const int l = u / 448, r = u % 448, kb = r / 28, nb = r % 28;
    const float* Win = a->in[6] + (size_t)l * 1024 * 1536;
    const int srccol = (nb >= 8) ? nb * 64 - 256 : (nb & 3) * 64;
    tile_load(tile, Win + (size_t)(kb * 64) * 1536 + srccol, 1536);
    if (nb < 8 && tid < 64) { T[tid] = cospif((float)tid / 32.0f); T[64 + tid] = sinpif((float)tid / 32.0f); }
    __syncthreads();
    bf16_t* dst = (bf16_t*)(a->ws + WS_WIN) + ((size_t)l * ZC + nb * 64) * 1024 + kb * 64;
    if (nb >= 8) tile_store_T(tile, dst, 1024);
    else {
        const int part = nb >> 2;
        float* Tm = (float*)(lds + 65536); float* out = (float*)(lds + 98304);
        for (int i = tid; i < 4096; i += NT) { const int c = i >> 6, cp = i & 63; const float t = T[part * 64 + ((c * cp) & 63)]; Tm[i] = (part ? -t : t) * 0.125f; }
        __syncthreads();
        mm64_f32(tile, 65, Tm, 64, 64, out);
        __syncthreads();
        tile_store_T(out, dst, 1024);
    }
    __syncthreads();
}

__device__ __forceinline__ void wout_unit(AP a, unsigned char* lds, int u) {
    float* tile = (float*)(lds + LDS_TILE);
    __syncthreads();
    const int tid = tid_opaque();
    const int l = u / 256, r = u % 256, kb = r / 16, nb = r % 16;
    const float* Wo = a->in[13] + (size_t)l * 1024 * 1024;
    const int n = tid & 63, kq = __builtin_amdgcn_readfirstlane(tid >> 6);
    if (kb < 4) {
        float* tA = (float*)lds; float* tB = (float*)(lds + 65536);
        const float* wf = a->in[7] + (size_t)l * 256 * 256 + (size_t)(kb * 64) * 256;
        __syncthreads();
        f32x4 va[8], vb[8];
#pragma unroll
        for (int i = 0; i < 8; ++i) { const int q = tid + 512 * i; va[i] = *(const f32x4*)(wf + (size_t)q * 4); vb[i] = *(const f32x4*)(Wo + (size_t)(q >> 4) * 1024 + nb * 64 + (q & 15) * 4); }
#pragma unroll
        for (int i = 0; i < 8; ++i) { const int q = tid + 512 * i; *(f32x4*)(tA + (size_t)q * 4) = va[i]; *(f32x4*)(tB + (size_t)q * 4) = vb[i]; }
        __syncthreads();
        tile = (float*)(lds + 133120);
        mm64_f32(tA, 256, tB, 64, 256, tile);
    } else if (kb >= 8 && kb < 12) {
        const int g = kb - 8;
        float* tA = (float*)lds; float* tB = (float*)(lds + 65536);
        const float* wp = a->in[9] + (size_t)(l * 4 + g) * 64 * 64;
        const float* ps = a->in[10] + l * 256 + g * 64;
        f32x4 va[2], vb[2];
#pragma unroll
        for (int i = 0; i < 2; ++i) { const int q = tid + 512 * i; va[i] = *(const f32x4*)(wp + (size_t)q * 4); vb[i] = *(const f32x4*)(Wo + (size_t)(512 + g * 64 + (q >> 4)) * 1024 + nb * 64 + (q & 15) * 4) * ps[q >> 4]; }
#pragma unroll
        for (int i = 0; i < 2; ++i) { const int q = tid + 512 * i; *(f32x4*)(tA + (size_t)q * 4) = va[i]; *(f32x4*)(tB + (size_t)q * 4) = vb[i]; }
        __syncthreads();
        tile = (float*)(lds + 133120);
        mm64_f32(tA, 64, tB, 64, 64, tile);
    } else tile_load(tile, Wo + (size_t)(kb * 64) * 1024 + nb * 64, 1024);
    __syncthreads();
    tile_store_T(tile, (bf16_t*)(a->ws + WS_WOUT) + ((size_t)l * 1024 + nb * 64) * 1024 + kb * 64, 1024);
    __syncthreads();
}

__device__ __forceinline__ void exp_src_dst(AP a, int l, int u, const float*& src, int& srcld, unsigned char*& dst, int& dstld) {
    const int mat = u / 1024, e = (u % 1024) / 32, t = u % 32;
    const int kb = (mat < 2) ? t / 4 : t / 8, nb = (mat < 2) ? t % 4 : t % 8;
    srcld = (mat < 2) ? 512 : 1024; dstld = (mat < 2) ? 1024 : 512;
    src = a->in[18 + mat] + ((size_t)(l * 32 + e) * 512 * 1024) + (size_t)(kb * 128) * srcld + nb * 128;
    dst = a->ws + WS_WEXP + (size_t)l * WEXP_LAYER + (size_t)mat * EXPMAT + (size_t)e * 512 * 1024 + (size_t)(nb * 128) * dstld + kb * 128;
}
#define EXP_LOAD(vv, uu) do { exp_src_dst(a, l, (uu), src, srcld, dst, dstld); _Pragma("unroll") for (int _i = 0; _i < 8; ++_i) vv[_i] = *(const f32x4*)(src + (size_t)((tid >> 5) + 16 * _i) * srcld + (tid & 31) * 4); } while (0)
#define EXP_PUT(vv) do { _Pragma("unroll") for (int _i = 0; _i < 8; ++_i) *(f32x4*)(tile + ((tid >> 5) + 16 * _i) * 132 + (tid & 31) * 4) = vv[_i] * 32.0f; } while (0)
#define EXP_STORE(dd, ld_) do { const int n = tid & 127, kq = tid >> 7;        \
        _Pragma("unroll") for (int j = 0; j < 2; ++j) { const float* tp = tile + (kq * 32 + j * 16) * 132 + n; u32x4 w; \
        w.x = pack4_fp8(tp[0], tp[132], tp[2 * 132], tp[3 * 132]); w.y = pack4_fp8(tp[4 * 132], tp[5 * 132], tp[6 * 132], tp[7 * 132]); \
        w.z = pack4_fp8(tp[8 * 132], tp[9 * 132], tp[10 * 132], tp[11 * 132]); w.w = pack4_fp8(tp[12 * 132], tp[13 * 132], tp[14 * 132], tp[15 * 132]); \
        *(u32x4*)((dd) + (size_t)n * (ld_) + kq * 32 + j * 16) = w; } } while (0)
__device__ __forceinline__ void exp_range(AP a, unsigned char* lds, int l, int u0, int u_end) {
    float* tile = (float*)lds;
    const int tid = tid_opaque();
    __syncthreads();
    if (u0 >= u_end) return;
    const float* src; unsigned char* dst; int srcld, dstld;
    f32x4 va[8], vb[8];
    unsigned char *da, *db = nullptr; int lda_, ldb_ = 0;
    EXP_LOAD(va, u0); da = dst; lda_ = dstld;
    if (u0 + 1 < u_end) { EXP_LOAD(vb, u0 + 1); db = dst; ldb_ = dstld; }
    for (int u = u0; u < u_end; u += 2) {
        EXP_PUT(va);
        __syncthreads();
        { unsigned char* cd = da; const int cl = lda_; if (u + 2 < u_end) { EXP_LOAD(va, u + 2); da = dst; lda_ = dstld; } EXP_STORE(cd, cl); }
        __syncthreads();
        if (u + 1 < u_end) {
            EXP_PUT(vb);
            __syncthreads();
            { unsigned char* cd = db; const int cl = ldb_; if (u + 3 < u_end) { EXP_LOAD(vb, u + 3); db = dst; ldb_ = dstld; } EXP_STORE(cd, cl); }
            __syncthreads();
        }
    }
}
#undef EXP_LOAD
#undef EXP_PUT
#undef EXP_STORE
__device__ __forceinline__ void exp_queue(AP a, unsigned char* lds, int l) {
    const int tid = tid_opaque();
    int* qslot = (int*)(lds + MISC_OFF + 128);
    unsigned* qc = (unsigned*)(a->ws + WS_BAR + 14336 + l * 256);
    for (;;) {
        __syncthreads();
        if (tid == 0) *qslot = (int)__hip_atomic_fetch_add(qc, 2u, __ATOMIC_RELAXED, __HIP_MEMORY_SCOPE_AGENT);
        __syncthreads();
        const int c0 = *qslot;
        if (c0 >= U_EXP) break;
        exp_range(a, lds, l, c0, c0 + 2);
    }
}

__device__ __forceinline__ void exp_fill(AP a, unsigned char* lds, int ql, int budget) {
    const int tid = tid_opaque();
    int* qslot = (int*)(lds + MISC_OFF + 128);
    unsigned* qc = (unsigned*)(a->ws + WS_BAR + 14336 + ql * 256);
    for (int done = 0; done < budget; done += 2) {
        __syncthreads();
        if (tid == 0) *qslot = (int)__hip_atomic_fetch_add(qc, 2u, __ATOMIC_RELAXED, __HIP_MEMORY_SCOPE_AGENT);
        __syncthreads();
        const int c0 = *qslot;
        if (c0 >= U_EXP) break;
        exp_range(a, lds, ql, c0, c0 + 2);
    }
    __syncthreads();
}

__device__ __forceinline__ void p0_prologue(AP a, unsigned char* lds) {
    const int tid = tid_opaque();
    bool have_tab = false;
    constexpr int E0 = U_ADA, E1 = E0 + U_WIN, E2 = E1 + U_WOUT, E3 = E2 + U_SGU, E4 = E3 + U_DFT, E5 = E4 + U_ROPE;
    int u = blockIdx.x;
    for (; u < E5; u += gridDim.x) {
        if (u < E0) ada_unit(a, lds, u);
        else if (u < E1) win_unit(a, lds, u - E0);
        else if (u < E2) wout_unit(a, lds, u - E1);
        else if (u < E3) { const size_t i0 = (size_t)(u - E2) * 4096 + tid * 8; const float* s = a->in[11] + i0; bf16_t* d = (bf16_t*)(a->ws + WS_WSGU) + i0;
            const f32x4 v0 = *(const f32x4*)s, v1 = *(const f32x4*)(s + 4); u32x4 w; w.x = pack2(v0[0], v0[1]); w.y = pack2(v0[2], v0[3]); w.z = pack2(v1[0], v1[1]); w.w = pack2(v1[2], v1[3]); *(u32x4*)d = w; }
        else if (u < E4) {
            float* ctab = (float*)(lds + LDS_CTAB);
            if (!have_tab) { for (int i = tid; i < 4096; i += NT) ctab[i] = cospif((float)i / 2048.0f); __syncthreads(); have_tab = true; }
            const int k = u - E3 + 4096;
            if (tid < 32) {
                const int kk = k - 4096, n0 = tid * 8; float c[8], s[8];
#pragma unroll
                for (int e = 0; e < 8; ++e) { const int idx = ((kk * (n0 + e)) & 255) * 16; c[e] = ctab[idx] * (1.0f / 16.0f); s[e] = ctab[(idx - 1024) & 4095] * (1.0f / 16.0f); }
                bf16_t* d = (bf16_t*)(a->ws + WS_DFTC) + (size_t)kk * 512 + n0;
                u32x4 w; w.x = pack2(c[0], c[1]); w.y = pack2(c[2], c[3]); w.z = pack2(c[4], c[5]); w.w = pack2(c[6], c[7]); *(u32x4*)d = w;
                w.x = pack2(s[0], s[1]); w.y = pack2(s[2], s[3]); w.z = pack2(s[4], s[5]); w.w = pack2(s[6], s[7]); *(u32x4*)(d + 256) = w;
            }
        }
        else {
            for (int i = tid; i < 1024; i += NT) { const int pos = i >> 4, f = i & 15; const float freq = powf(10000.0f, -(float)f / 16.0f); const float ang = (float)pos * freq;
                ((float2*)(a->ws + WS_ROPE))[i] = make_float2(cosf(ang), sinf(ang)); }
        }
    }
}

__device__ __forceinline__ void p_lnmod0(AP a) {
    const int tid = tid_opaque(), lane = tid & 63, w = tid >> 6;
    const float* mod = (const float*)(a->ws + WS_MOD);
    bf16_t* H = (bf16_t*)(a->ws + WS_H);
    const int tstep = gridDim.x * 8;
    f32x4 nx[4];
    { const int t = blockIdx.x * 8 + w; if (t < NTOK) { const float* src = (t < NLAT) ? a->in[0] + (size_t)t * D : a->in[2] + (size_t)(t - NLAT) * D;
#pragma unroll
        for (int i = 0; i < 4; ++i) nx[i] = *(const f32x4*)(src + 256 * i + 4 * lane); } }
    int mrow = -1; f32x4 msh[4], msc[4];
    for (int t = blockIdx.x * 8 + w; t < NTOK; t += tstep) {
        const int mr = (t < NLAT) ? (t >> 12) : 4;
        if (mr != mrow) { mrow = mr; const float* m = mod + (size_t)mr * 6144;
#pragma unroll
            for (int i = 0; i < 4; ++i) { msh[i] = *(const f32x4*)(m + 256 * i + 4 * lane); msc[i] = *(const f32x4*)(m + 1024 + 256 * i + 4 * lane); } }
        f32x4 v[4];
#pragma unroll
        for (int i = 0; i < 4; ++i) v[i] = nx[i];
        { const int tn = t + tstep; if (tn < NTOK) { const float* src = (tn < NLAT) ? a->in[0] + (size_t)tn * D : a->in[2] + (size_t)(tn - NLAT) * D;
#pragma unroll
            for (int i = 0; i < 4; ++i) nx[i] = *(const f32x4*)(src + 256 * i + 4 * lane); } }
        float mean, rstd; ln_stats(v, mean, rstd);
#pragma unroll
        for (int i = 0; i < 4; ++i) { const int c = 256 * i + 4 * lane;
            f32x4 o;
#pragma unroll
            for (int e = 0; e < 4; ++e) o[e] = (v[i][e] - mean) * rstd * (1.0f + msc[i][e]) + msh[i][e];
            u32x2 pk; pk.x = pack2(o[0], o[1]); pk.y = pack2(o[2], o[3]); *(u32x2*)(H + (size_t)t * D + c) = pk; }
    }
}

__device__ __forceinline__ void p1_inproj(AP a, unsigned char* smem, LAS unsigned char* lds, int l);
__device__ __forceinline__ u32x4 ld16g(const bf16_t* p) { return *(const u32x4*)p; }
__device__ __forceinline__ void rope_pack8(u32x4& wl, u32x4& wh, const LAS f32x2* tab, bool do_rope, float scale) {
    float tl[8] = {lo2f(wl.x), hi2f(wl.x), lo2f(wl.y), hi2f(wl.y), lo2f(wl.z), hi2f(wl.z), lo2f(wl.w), hi2f(wl.w)};
    float th[8] = {lo2f(wh.x), hi2f(wh.x), lo2f(wh.y), hi2f(wh.y), lo2f(wh.z), hi2f(wh.z), lo2f(wh.w), hi2f(wh.w)};
#pragma unroll
    for (int j = 0; j < 8; ++j) {
        float r1 = tl[j], r2 = th[j];
        if (do_rope) { const f32x2 cs = tab[j]; r1 = tl[j] * cs.x - th[j] * cs.y; r2 = tl[j] * cs.y + th[j] * cs.x; }
        tl[j] = r1 * scale; th[j] = r2 * scale;
    }
    wl.x = pack2(tl[0], tl[1]); wl.y = pack2(tl[2], tl[3]); wl.z = pack2(tl[4], tl[5]); wl.w = pack2(tl[6], tl[7]);
    wh.x = pack2(th[0], th[1]); wh.y = pack2(th[2], th[3]); wh.z = pack2(th[4], th[5]); wh.w = pack2(th[6], th[7]);
}

__device__ __forceinline__ void mixer_sgu_pool(AP a, LAS unsigned char* lds, int l, int row0, int seq_row0, int pos0, int n) {
    typedef short s16x4 __attribute__((ext_vector_type(4)));
    const int tid = tid_opaque(), lane = tid & 63, w = __builtin_amdgcn_readfirstlane(tid >> 6), fr = lane & 15, g = lane >> 4;
    const bf16_t* Z = (const bf16_t*)(a->ws + WS_Z);
    bf16_t* CAT = (bf16_t*)(a->ws + WS_CAT);
    constexpr int VOFF = 73728;
    u32x4 pr[9];
#pragma unroll
    for (int it = 0; it < 9; ++it) { const int id = tid + 512 * it, rr = id >> 5, ch = id & 31, j = pos0 - 8 + rr;
        pr[it] = (u32x4){0u, 0u, 0u, 0u};
        if (j >= 0 && j < n) pr[it] = ld16g(Z + (size_t)(seq_row0 + j) * ZC + 1024 + ch * 8); }
    bf16x8 wfrag[4][4];
    {   const int h = w >> 1, ph = w & 1; const bf16_t* Ws = (const bf16_t*)(a->ws + WS_WSGU) + (size_t)(l * 4 + h) * 128 * 128;
#pragma unroll
        for (int ks = 0; ks < 4; ++ks)
#pragma unroll
            for (int pf = 0; pf < 4; ++pf) wfrag[ks][pf] = *(const bf16x8*)(Ws + (size_t)(ph * 64 + 16 * pf + fr) * 128 + 32 * ks + 8 * g); }
    u32x4 gw[4][2];
#pragma unroll
    for (int ps = 0; ps < 4; ++ps) { const int q = w * 16 + ps * 4 + g; const bf16_t* src = Z + (size_t)(row0 + q) * ZC + 1536 + 16 * fr; gw[ps][0] = ld16g(src); gw[ps][1] = ld16g(src + 8); }
#pragma unroll
    for (int it = 0; it < 9; ++it) { const int id = tid + 512 * it; *(LAS u32x4*)(lds + (id >> 5) * 512 + (id & 31) * 16) = pr[it]; }
#pragma unroll
    for (int ps = 0; ps < 4; ++ps) {
        const int q = w * 16 + ps * 4 + g;
        float gv[16];
#pragma unroll
        for (int hh = 0; hh < 2; ++hh) { const u32x4 x = gw[ps][hh];
            gv[8 * hh + 0] = gelu_erf(lo2f(x.x)); gv[8 * hh + 1] = gelu_erf(hi2f(x.x)); gv[8 * hh + 2] = gelu_erf(lo2f(x.y)); gv[8 * hh + 3] = gelu_erf(hi2f(x.y));
            gv[8 * hh + 4] = gelu_erf(lo2f(x.z)); gv[8 * hh + 5] = gelu_erf(hi2f(x.z)); gv[8 * hh + 6] = gelu_erf(lo2f(x.w)); gv[8 * hh + 7] = gelu_erf(hi2f(x.w)); }
        float sm = 0.f;
#pragma unroll
        for (int e = 0; e < 16; ++e) sm += gv[e];
        const float mean = row_sum16(sm) * (1.0f / 256.0f);
        float qq = 0.f;
#pragma unroll
        for (int e = 0; e < 16; ++e) { const float d = gv[e] - mean; qq += d * d; }
        const float rstd = 1.0f / sqrtf(row_sum16(qq) * (1.0f / 256.0f) + 1e-6f);
        u32x4 o0, o1;
        o0.x = pack2((gv[0] - mean) * rstd, (gv[1] - mean) * rstd); o0.y = pack2((gv[2] - mean) * rstd, (gv[3] - mean) * rstd); o0.z = pack2((gv[4] - mean) * rstd, (gv[5] - mean) * rstd); o0.w = pack2((gv[6] - mean) * rstd, (gv[7] - mean) * rstd);
        o1.x = pack2((gv[8] - mean) * rstd, (gv[9] - mean) * rstd); o1.y = pack2((gv[10] - mean) * rstd, (gv[11] - mean) * rstd); o1.z = pack2((gv[12] - mean) * rstd, (gv[13] - mean) * rstd); o1.w = pack2((gv[14] - mean) * rstd, (gv[15] - mean) * rstd);
        const int sg = fr ^ ((q & 3) | (((q >> 3) & 1) << 2));
        *(LAS u32x4*)(lds + VOFF + q * 512 + sg * 32) = o0; *(LAS u32x4*)(lds + VOFF + q * 512 + sg * 32 + 16) = o1;
    }
    __syncthreads();
    {
        const int c = tid & 255, half = tid >> 8, hw = 1 << (c >> 6);
        const LAS bf16_t* P = (const LAS bf16_t*)lds + c;
        const int t0 = half * 64;
        const float invfull = 1.0f / (float)(2 * hw);
        float s = 0.f;
        for (int j = t0 - hw; j < t0 + hw; ++j) s += bf2f(P[(8 + j) * 256]);
        for (int tl = t0; tl < t0 + 64; ++tl) {
            const int pos = pos0 + tl; const int cntw = min(pos + hw, n) - max(pos - hw, 0);
            const float inv = (cntw == 2 * hw) ? invfull : 1.0f / (float)cntw;
            CAT[(size_t)(row0 + tl) * D + 512 + c] = f2bf(s * inv - bf2f(P[(8 + tl) * 256]));
            s += bf2f(P[(8 + tl + hw) * 256]) - bf2f(P[(8 + tl - hw) * 256]);
        }
    }
    {
        const int h = w >> 1, ph = w & 1;
        const float* bs = a->in[12] + (size_t)(l * 4 + h) * 128;
        f32x4 acc[4][4];
#pragma unroll
        for (int i = 0; i < 4; ++i)
#pragma unroll
            for (int j = 0; j < 4; ++j) acc[i][j] = (f32x4){0.f, 0.f, 0.f, 0.f};
        const int qq4 = fr >> 2, p4 = fr & 3, fsw = qq4 | ((g & 1) << 2);
#pragma unroll
        for (int ks = 0; ks < 4; ++ks) {
            bf16x8 af[4];
            const int r0 = 32 * ks + 8 * g + qq4;
#pragma unroll
            for (int cf = 0; cf < 4; ++cf) { const int so = (((4 * h + cf) ^ fsw) << 5) + p4 * 8;
                const s16x4 lo = __builtin_amdgcn_ds_read_tr16_b64_v4i16((LAS s16x4*)(lds + VOFF + r0 * 512 + so));
                const s16x4 hi = __builtin_amdgcn_ds_read_tr16_b64_v4i16((LAS s16x4*)(lds + VOFF + (r0 + 4) * 512 + so));
                af[cf] = __builtin_shufflevector(lo, hi, 0, 1, 2, 3, 4, 5, 6, 7); }
#pragma unroll
            for (int cf = 0; cf < 4; ++cf)
#pragma unroll
                for (int pf = 0; pf < 4; ++pf) acc[cf][pf] = __builtin_amdgcn_mfma_f32_16x16x32_bf16(af[cf], wfrag[ks][pf], acc[cf][pf], 0, 0, 0);
        }
#pragma unroll
        for (int pf = 0; pf < 4; ++pf) { const int p = ph * 64 + 16 * pf + fr; const float bias = bs[p];
#pragma unroll
            for (int cf = 0; cf < 4; ++cf) { const int c0 = h * 64 + 16 * cf + 4 * g;
                const u32x2 uw = *(const u32x2*)(Z + (size_t)(row0 + p) * ZC + 1280 + c0);
                u32x2 o; o.x = pack2(gelu_erf(lo2f(uw.x)) * (acc[cf][pf][0] + bias), gelu_erf(hi2f(uw.x)) * (acc[cf][pf][1] + bias));
                o.y = pack2(gelu_erf(lo2f(uw.y)) * (acc[cf][pf][2] + bias), gelu_erf(hi2f(uw.y)) * (acc[cf][pf][3] + bias));
                *(u32x2*)(CAT + (size_t)(row0 + p) * D + 768 + c0) = o; } }
    }
    __syncthreads();
}

__device__ __forceinline__ void mixer_attn(AP a, LAS unsigned char* lds, int l, int row0, int seq_row0, int pos0, int n, int b, bool is_ctx, int kvh) {
    const int tid = tid_opaque(), lane = tid & 63, w = __builtin_amdgcn_readfirstlane(tid >> 6), fr = lane & 15, g = lane >> 4;
    const bf16_t* Z = (const bf16_t*)(a->ws + WS_Z);
    bf16_t* CAT = (bf16_t*)(a->ws + WS_CAT);
    __syncthreads();
    ((LAS u32x4*)(lds + 98304))[tid] = ((const u32x4*)(a->ws + WS_ROPE))[tid];
    const LAS f32x2* rope = (const LAS f32x2*)(lds + 98304);
    constexpr float QS = 0.125f * 1.44269504088896341f;
    constexpr int QS_OFF = 0, KS_OFF = 32768, VS_OFF = 65536;
    const int nbq = pos0 >> 7;
    unsigned bmask = 0x18u;
    if (!is_ctx) { if (nbq > 0) bmask |= 1u; bmask |= 2u; if (nbq + 1 < (n >> 7)) bmask |= 4u; }
    const int kr = tid >> 2, kax = (tid >> 1) & 1, kh8 = tid & 1;
#define MX_KSRC(blk) (Z + (size_t)((((blk) < 3) ? seq_row0 + (nbq + (blk) - 1) * 128 : NLAT + b * 256 + ((blk) - 3) * 128) + kr) * ZC + 768 + kvh * 64 + kax * 32 + kh8 * 8)
#define MX_VSTAGE(blk, buf) do { const bool _band = (blk) < 3; const int _key0 = _band ? (nbq + (blk) - 1) * 128 : ((blk) - 3) * 128; \
        const bf16_t* _vs = _band ? (const bf16_t*)(a->ws + WS_VT) + (size_t)(b * 2 + kvh) * 64 * 4096 + _key0 : (const bf16_t*)(a->ws + WS_VTC) + (size_t)(b * 2 + kvh) * 64 * 256 + _key0; \
        const int _vld = _band ? 4096 : 256; \
        _Pragma("unroll") for (int _i = 0; _i < 2; ++_i) { const int _P = _i * 512 + tid, _d = _P >> 4, _c = (_P & 15) ^ (_d & 15); \
            glds16(_vs + (size_t)_d * _vld + _c * 8, lds + VS_OFF + (buf) * 16384 + _i * 8192 + w * 1024); } } while (0)
    {
        __syncthreads();
#pragma unroll
        for (int it = 0; it < 2; ++it) {
            const int item = tid + 512 * it, r = item >> 2, ax = (item >> 1) & 1, h8 = item & 1, i = r & 127, qpos = pos0 + i;
            const bf16_t* src = Z + (size_t)(row0 + i) * ZC + 512 + (2 * kvh + (r >> 7)) * 64 + ax * 32 + h8 * 8;
            u32x4 wl = ld16g(src), wh = ld16g(src + 16);
            rope_pack8(wl, wh, rope + (ax ? (qpos & 63) : (qpos >> 6)) * 16 + h8 * 8, !is_ctx, QS);
            const int ch = ax * 4 + h8, sw = (r >> 1) & 7;
            *(LAS u32x4*)(lds + QS_OFF + r * 128 + ((ch ^ sw) << 4)) = wl;
            *(LAS u32x4*)(lds + QS_OFF + r * 128 + (((ch + 2) ^ sw) << 4)) = wh;
        }
        const int hh = w >> 2, qb = (w & 3) * 32, h = 2 * kvh + hh;
        float m[2], lsum[2];
        m[0] = m[1] = a->in[8][l * 4 + h] * 1.44269504088896341f;
        lsum[0] = lsum[1] = (g == 0) ? 1.0f : 0.0f;
        f32x4 O[4][2];
#pragma unroll
        for (int i = 0; i < 4; ++i) { O[i][0] = (f32x4){0.f, 0.f, 0.f, 0.f}; O[i][1] = (f32x4){0.f, 0.f, 0.f, 0.f}; }
        bf16x8 Qf[2][2];
        bool have_q = false;
        unsigned rem = bmask;
        int cur = __builtin_ctz(rem); rem &= rem - 1u;
        int buf = 0;
        u32x4 kl = ld16g(MX_KSRC(cur)), kh = ld16g(MX_KSRC(cur) + 16);
        MX_VSTAGE(cur, 0);
#pragma unroll 1
        for (;;) {
            const int jb = cur - 1; const bool band = cur < 3;
            {
                const int kpos = (nbq + jb) * 128 + kr;
                rope_pack8(kl, kh, rope + (kax ? (kpos & 63) : (kpos >> 6)) * 16 + kh8 * 8, band, 1.0f);
                const int ch = kax * 4 + kh8, sw = (kr >> 1) & 7;
                *(LAS u32x4*)(lds + KS_OFF + buf * 16384 + kr * 128 + ((ch ^ sw) << 4)) = kl;
                *(LAS u32x4*)(lds + KS_OFF + buf * 16384 + kr * 128 + (((ch + 2) ^ sw) << 4)) = kh;
            }
            asm volatile("s_waitcnt vmcnt(0)" ::: "memory");
            __syncthreads();
            const int nxt = rem ? __builtin_ctz(rem) : -1; rem &= rem - 1u;
            if (nxt >= 0) { kl = ld16g(MX_KSRC(nxt)); kh = ld16g(MX_KSRC(nxt) + 16); MX_VSTAGE(nxt, buf ^ 1); }
            if (!have_q) {
#pragma unroll
                for (int qf = 0; qf < 2; ++qf)
#pragma unroll
                    for (int ks = 0; ks < 2; ++ks) { const int r = hh * 128 + qb + 16 * qf + fr; Qf[qf][ks] = *(const LAS bf16x8*)(lds + QS_OFF + r * 128 + (((4 * ks + g) ^ ((r >> 1) & 7)) << 4)); }
                have_q = true;
            }
            const int kso = KS_OFF + buf * 16384, vso = VS_OFF + buf * 16384;
            f32x4 S[8][2];
#pragma unroll
            for (int kf = 0; kf < 8; ++kf) { S[kf][0] = (f32x4){0.f, 0.f, 0.f, 0.f}; S[kf][1] = (f32x4){0.f, 0.f, 0.f, 0.f}; }
#pragma unroll
            for (int kf = 0; kf < 8; ++kf)
#pragma unroll
                for (int ks = 0; ks < 2; ++ks) { const int r = 16 * kf + fr;
                    const bf16x8 kfr = *(const LAS bf16x8*)(lds + kso + r * 128 + (((4 * ks + g) ^ ((r >> 1) & 7)) << 4));
                    S[kf][0] = __builtin_amdgcn_mfma_f32_16x16x32_bf16(kfr, Qf[0][ks], S[kf][0], 0, 0, 0);
                    S[kf][1] = __builtin_amdgcn_mfma_f32_16x16x32_bf16(kfr, Qf[1][ks], S[kf][1], 0, 0, 0); }
            bf16x8 Pp[4][2];
#pragma unroll
            for (int qf = 0; qf < 2; ++qf) {
                const int qi = qb + 16 * qf + fr;
                if (band && jb != 0) {
#pragma unroll
                    for (int kf = 0; kf < 8; ++kf)
#pragma unroll
                        for (int r = 0; r < 4; ++r) { const int kk = 16 * kf + 4 * g + r; const bool ok = (jb < 0) ? (kk >= qi) : (kk <= qi); if (!ok) S[kf][qf][r] = -1.0e30f; }
                }
                float mx = S[0][qf][0];
#pragma unroll
                for (int kf = 0; kf < 8; ++kf)
#pragma unroll
                    for (int r = 0; r < 4; ++r) mx = fmaxf(mx, S[kf][qf][r]);
                mx = fmaxf(mx, __shfl_xor(mx, 16)); mx = fmaxf(mx, __shfl_xor(mx, 32));
                const float mn = fmaxf(m[qf], mx), corr = __builtin_amdgcn_exp2f(m[qf] - mn);
                m[qf] = mn;
                float ps = 0.f;
#pragma unroll
                for (int kf = 0; kf < 8; ++kf)
#pragma unroll
                    for (int r = 0; r < 4; ++r) { const float p = __builtin_amdgcn_exp2f(S[kf][qf][r] - mn); S[kf][qf][r] = p; ps += p; }
                lsum[qf] = lsum[qf] * corr + ps;
#pragma unroll
                for (int df = 0; df < 4; ++df) O[df][qf] *= corr;
#pragma unroll
                for (int t = 0; t < 4; ++t) { u32x4 pw; pw.x = pack2(S[2 * t][qf][0], S[2 * t][qf][1]); pw.y = pack2(S[2 * t][qf][2], S[2 * t][qf][3]);
                    pw.z = pack2(S[2 * t + 1][qf][0], S[2 * t + 1][qf][1]); pw.w = pack2(S[2 * t + 1][qf][2], S[2 * t + 1][qf][3]); Pp[t][qf] = __builtin_bit_cast(bf16x8, pw); }
            }
#pragma unroll
            for (int t = 0; t < 4; ++t)
#pragma unroll
                for (int df = 0; df < 4; ++df) { const int d = 16 * df + fr;
                    const u32x2 v0 = *(const LAS u32x2*)(lds + vso + d * 256 + (((4 * t + (g >> 1)) ^ (d & 15)) << 4) + (g & 1) * 8);
                    const u32x2 v1 = *(const LAS u32x2*)(lds + vso + d * 256 + (((4 * t + 2 + (g >> 1)) ^ (d & 15)) << 4) + (g & 1) * 8);
                    u32x4 vw; vw.x = v0.x; vw.y = v0.y; vw.z = v1.x; vw.w = v1.y; const bf16x8 vf = __builtin_bit_cast(bf16x8, vw);
                    O[df][0] = __builtin_amdgcn_mfma_f32_16x16x32_bf16(vf, Pp[t][0], O[df][0], 0, 0, 0);
                    O[df][1] = __builtin_amdgcn_mfma_f32_16x16x32_bf16(vf, Pp[t][1], O[df][1], 0, 0, 0); }
            if (nxt < 0) break;
            cur = nxt; buf ^= 1;
        }
#pragma unroll
        for (int qf = 0; qf < 2; ++qf) {
            float lt = lsum[qf]; lt += __shfl_xor(lt, 16); lt += __shfl_xor(lt, 32);
            const float inv = 1.0f / lt;
            bf16_t* dst = CAT + (size_t)(row0 + qb + 16 * qf + fr) * D + 256 + h * 64 + 4 * g;
#pragma unroll
            for (int df = 0; df < 4; ++df) { u32x2 o; o.x = pack2(O[df][qf][0] * inv, O[df][qf][1] * inv); o.y = pack2(O[df][qf][2] * inv, O[df][qf][3] * inv); *(u32x2*)(dst + 16 * df) = o; }
        }
    }
#undef MX_KSRC
#undef MX_VSTAGE
    __syncthreads();
}

constexpr int FF_DA = 0, FF_DC = 32768, FF_XT = 49152  , FF_Z2 = 81920  , FF_OB = 114688  ;
__device__ __forceinline__ int ff_addr(int row, int k) { return row * 256 + ((((k >> 3) ^ (row & 15))) << 4) + (k & 7) * 2; }
__device__ __forceinline__ float cos_turns(float x) { return __builtin_amdgcn_cosf(x); }
__device__ __forceinline__ float sin_turns(float x) { return __builtin_amdgcn_sinf(x); }
__device__ __forceinline__ void fft_setup(LAS unsigned char* lds) {
    const int tid = tid_opaque();
    __syncthreads();
    for (int idx = tid; idx < 16384; idx += NT) { const int i = idx >> 7, k = idx & 127, ro = i >> 6, k1 = i & 63, part = k >> 6, n1 = k & 63; const float t = (float)((k1 * n1) & 63) * (1.0f / 64.0f);
        const float c = cos_turns(t), sn = sin_turns(t);
        const float v = (ro == 0) ? (part == 0 ? c : sn) : (part == 0 ? -sn : c);
        *(LAS bf16_t*)(lds + FF_DA + ff_addr(i, k)) = f2bf(v * 0.125f); }
    for (int idx = tid; idx < 8192; idx += NT) { const int k2 = idx >> 7, k = idx & 127, ri = k >> 6, n2 = k & 63; const float t = (float)((k2 * n2) & 63) * (1.0f / 64.0f);
        const float v = (ri == 0) ? cos_turns(t) : sin_turns(t);
        *(LAS bf16_t*)(lds + FF_DC + ff_addr(k2, k)) = f2bf(v * 0.125f); }
    __syncthreads();
}
__device__ __forceinline__ void fft_unit(AP a, LAS unsigned char* lds, int b, int cg) {
    const int tid = tid_opaque(), lane = tid & 63, w = __builtin_amdgcn_readfirstlane(tid >> 6), fr = lane & 15, g = lane >> 4;
    const int mf = w & 3, nh = w >> 2;
    const bf16_t* AT = (const bf16_t*)(a->ws + WS_AT) + (size_t)(b * 256 + cg * 4) * 8192;
    u32x4 xin[2][2];
#pragma unroll
    for (int h = 0; h < 2; ++h)
#pragma unroll
        for (int it = 0; it < 2; ++it) xin[h][it] = ld16g(AT + (size_t)h * 8192 + (size_t)(tid + 512 * it) * 8);
#pragma unroll 1
    for (int cp = 0; cp < 2; ++cp) {
#pragma unroll
        for (int h = 0; h < 2; ++h)
#pragma unroll
            for (int it = 0; it < 2; ++it) { const int q = tid + 512 * it, part = q >> 9, pos0 = (q & 511) * 8, n1 = pos0 >> 6, n2 = pos0 & 63, k = part * 64 + n1;
                const unsigned wv[4] = {xin[h][it].x, xin[h][it].y, xin[h][it].z, xin[h][it].w};
#pragma unroll
                for (int e = 0; e < 4; ++e) { *(LAS bf16_t*)(lds + FF_XT + h * 16384 + ff_addr(n2 + 2 * e, k)) = (bf16_t)(wv[e] & 0xffffu); *(LAS bf16_t*)(lds + FF_XT + h * 16384 + ff_addr(n2 + 2 * e + 1, k)) = (bf16_t)(wv[e] >> 16); } }
        if (cp == 0) {
#pragma unroll
            for (int h = 0; h < 2; ++h)
#pragma unroll
                for (int it = 0; it < 2; ++it) xin[h][it] = ld16g(AT + (size_t)(2 + h) * 8192 + (size_t)(tid + 512 * it) * 8); }
        __syncthreads();
        f32x4 acc[2][2][2];
#pragma unroll
        for (int h = 0; h < 2; ++h)
#pragma unroll
            for (int x = 0; x < 2; ++x) { acc[h][x][0] = (f32x4){0.f, 0.f, 0.f, 0.f}; acc[h][x][1] = (f32x4){0.f, 0.f, 0.f, 0.f}; }
#pragma unroll
        for (int ks = 0; ks < 4; ++ks) {
            bf16x8 af[2];
#pragma unroll
            for (int x = 0; x < 2; ++x) { const int i = 16 * (mf + 4 * x) + fr; af[x] = *(const LAS bf16x8*)(lds + FF_DA + i * 256 + (((4 * ks + g) ^ (i & 15)) << 4)); }
#pragma unroll
            for (int h = 0; h < 2; ++h)
#pragma unroll
                for (int n = 0; n < 2; ++n) { const int j = 16 * (2 * nh + n) + fr; const bf16x8 bfv = *(const LAS bf16x8*)(lds + FF_XT + h * 16384 + j * 256 + (((4 * ks + g) ^ (j & 15)) << 4));
                    acc[h][0][n] = __builtin_amdgcn_mfma_f32_16x16x32_bf16(af[0], bfv, acc[h][0][n], 0, 0, 0);
                    acc[h][1][n] = __builtin_amdgcn_mfma_f32_16x16x32_bf16(af[1], bfv, acc[h][1][n], 0, 0, 0); }
        }
#pragma unroll
        for (int n = 0; n < 2; ++n)
#pragma unroll
            for (int r = 0; r < 4; ++r) { const int k1 = 16 * mf + 4 * g + r, n2 = 16 * (2 * nh + n) + fr; const float t = (float)((k1 * n2) & 4095) * (1.0f / 4096.0f);
                const float c = cos_turns(t), sn = sin_turns(t);
#pragma unroll
                for (int h = 0; h < 2; ++h) { const float zr = acc[h][0][n][r], zi = acc[h][1][n][r];
                    *(LAS bf16_t*)(lds + FF_Z2 + h * 16384 + ff_addr(k1, n2)) = f2bf(zr * c + zi * sn);
                    *(LAS bf16_t*)(lds + FF_Z2 + h * 16384 + ff_addr(k1, 64 + n2)) = f2bf(zi * c - zr * sn); } }
        __syncthreads();
        f32x4 acc2[2][2];
#pragma unroll
        for (int h = 0; h < 2; ++h) { acc2[h][0] = (f32x4){0.f, 0.f, 0.f, 0.f}; acc2[h][1] = (f32x4){0.f, 0.f, 0.f, 0.f}; }
#pragma unroll
        for (int ks = 0; ks < 4; ++ks) {
            const int i = 16 * mf + fr; const bf16x8 af = *(const LAS bf16x8*)(lds + FF_DC + i * 256 + (((4 * ks + g) ^ (i & 15)) << 4));
#pragma unroll
            for (int h = 0; h < 2; ++h)
#pragma unroll
                for (int n = 0; n < 2; ++n) { const int j = 16 * (2 * nh + n) + fr; const bf16x8 bfv = *(const LAS bf16x8*)(lds + FF_Z2 + h * 16384 + j * 256 + (((4 * ks + g) ^ (j & 15)) << 4));
                    acc2[h][n] = __builtin_amdgcn_mfma_f32_16x16x32_bf16(af, bfv, acc2[h][n], 0, 0, 0); }
        }
#pragma unroll
        for (int n = 0; n < 2; ++n)
#pragma unroll
            for (int r = 0; r < 4; ++r) { const int k = 16 * (2 * nh + n) + fr + 64 * (16 * mf + 4 * g + r);
                *(LAS unsigned*)(lds + FF_OB + k * 8 + cp * 4) = pack2(acc2[0][n][r], acc2[1][n][r]); }
    }
    __syncthreads();
    bf16_t* CAT = (bf16_t*)(a->ws + WS_CAT) + (size_t)(b * 4096) * D + cg * 4;
#pragma unroll
    for (int it = 0; it < 8; ++it) { const int k = tid + 512 * it; *(u32x2*)(CAT + (size_t)k * D) = *(const LAS u32x2*)(lds + FF_OB + k * 8); }
    __syncthreads();
}

__device__ __forceinline__ void p2_mix(AP a, unsigned char* ldsg, LAS unsigned char* lds, int l) {
    const int n_tile = 128 + ((l == 0) ? 8 : 0), n_att = 2 * n_tile, n_dft = 256, n_dftc = (l == 0) ? 16 : 0;
    bf16_t* CAT = (bf16_t*)(a->ws + WS_CAT);
    bool fft_ready = false;
    for (int u = blockIdx.x; u < n_att + n_dft + n_tile + n_dftc; u += gridDim.x) {
        if (u < n_att || (u >= n_att + n_dft && u < n_att + n_dft + n_tile)) {
            const bool att = u < n_att;
            const int t = att ? (u >> 1) : (u - n_att - n_dft);
            const bool isc = t >= 128; const int tt = t - 128;
            const int b = isc ? (tt >> 1) : (t >> 5);
            const int row0 = isc ? NLAT + tt * 128 : t * 128, seq_row0 = isc ? NLAT + b * 256 : b * 4096, pos0 = isc ? (tt & 1) * 128 : (t & 31) * 128, n = isc ? 256 : 4096;
            if (att) { for (int rep = 0; rep < PROBE_MIX_REP; ++rep) mixer_attn(a, lds, l, row0, seq_row0, pos0, n, b, isc, u & 1); }
            else { for (int rep = 0; rep < PROBE_SGU_REP; ++rep) mixer_sgu_pool(a, lds, l, row0, seq_row0, pos0, n); }
            fft_ready = false;
        } else if (u < n_att + n_dft) {
            const int uu = u - n_att;
            if (!fft_ready) { fft_setup(lds); fft_ready = true; }
            for (int rep = 0; rep < PROBE_FFT_REP; ++rep) fft_unit(a, lds, uu >> 6, uu & 63);
        } else {
            const int uu = u - n_att - n_dft - n_tile, b = uu >> 2, mt = (uu >> 1) & 1, ch0 = (uu & 1) * 128;
            const bf16_t* A = (const bf16_t*)(a->ws + WS_DFTC) + (size_t)(mt * 128) * 512;
            const bf16_t* B0 = (const bf16_t*)(a->ws + WS_ATC) + ((size_t)b * 256 + ch0) * 512;
            EpiBf16 E; E.C = CAT + (size_t)(NLAT + b * 256 + mt * 128) * D + ch0; E.ld = D; E.scale = 1.0f;
            gemm_tile<128, false, EpiBf16>(lds, A, 512, nullptr, 128, B0, B0 + (size_t)64 * 512, 512, 512, E);
            fft_ready = false;
        }
    }
    exp_queue(a, ldsg, l);
}

__device__ __forceinline__ int uni(int v) { return __builtin_amdgcn_readfirstlane(v); }
__device__ __forceinline__ int vblock() { const int G = gridDim.x, b = blockIdx.x; return (G % 8 == 0) ? (b % 8) * (G / 8) + b / 8 : b; }
template <class T> __device__ __forceinline__ T* unip(T* p) { const unsigned long long v = (unsigned long long)p; const unsigned lo = __builtin_amdgcn_readfirstlane((unsigned)v), hi = __builtin_amdgcn_readfirstlane((unsigned)(v >> 32)); return (T*)(((unsigned long long)hi << 32) | lo); }
struct SchedInProj {
    typedef EpiInProj Epi; static constexpr bool GATHER = false, FP8 = false;
    unsigned char* ws; int l, G, me;
    __device__ __forceinline__ bool get(int i, g256::Unit<Epi>& u) const {
        const int n_lat = 64 * 7, n_ctx = (l == 0) ? 4 * 7 : 4;
        const int idx = i * G + me; if (idx >= n_lat + n_ctx) return false;
        int row0, b, ct, n; bf16_t *tF, *tV;
        if (idx < n_lat) { const int rt = idx / 7; ct = idx % 7; row0 = rt * 256; b = row0 >> 12; n = 4096;
            tF = (bf16_t*)(ws + WS_AT) + (size_t)b * 256 * 2 * 4096; tV = (bf16_t*)(ws + WS_VT) + (size_t)b * 128 * 4096; }
        else { const int uu = idx - n_lat; int rt; if (l == 0) { rt = uu / 7; ct = uu % 7; } else { rt = uu; ct = 3; }
            row0 = NLAT + rt * 256; b = rt; n = 256;
            tF = (bf16_t*)(ws + WS_ATC) + (size_t)b * 256 * 2 * 256; tV = (bf16_t*)(ws + WS_VTC) + (size_t)b * 128 * 256; }
        u.A = (const bf16_t*)(ws + WS_H) + (size_t)row0 * D;
        u.B0 = (const bf16_t*)(ws + WS_WIN) + ((size_t)l * ZC + ct * 256) * 1024; u.B1 = u.B0 + (size_t)128 * 1024; u.ridx = nullptr; u.valid = 256;
        u.epi.Zt = (bf16_t*)(ws + WS_Z) + (size_t)row0 * ZC + ct * 256; u.epi.tF = tF; u.epi.tV = tV; u.epi.n0 = ct * 256; u.epi.pos0 = (idx < n_lat) ? (row0 & 4095) : 0; u.epi.n = n;
        return true;
    }
};
struct SchedOutProj {
    typedef EpiBf16 Epi; static constexpr bool GATHER = false, FP8 = false;
    unsigned char* ws; int l, G, me;
    __device__ __forceinline__ bool get(int i, g256::Unit<Epi>& u) const {
        const int nrt = NLAT / 256;
        const int idx = i * G + me; if (idx >= nrt * 4) return false;
        const int rt = idx >> 2, ct = idx & 3;
        u.A = (const bf16_t*)(ws + WS_CAT) + (size_t)(rt * 256) * D;
        u.B0 = (const bf16_t*)(ws + WS_WOUT) + ((size_t)l * 1024 + ct * 256) * 1024; u.B1 = u.B0 + (size_t)128 * 1024; u.ridx = nullptr; u.valid = 256;
        u.epi.C = (bf16_t*)(ws + WS_Y) + (size_t)(rt * 256) * D + ct * 256; u.epi.ld = D; u.epi.scale = 1.0f;
        return true;
    }
};
__device__ __forceinline__ void moe_units(const LAS int* blk, LAS int* uinf, int G, int me) {
    const int i = threadIdx.x;
    if (i < 8) { const int idx = i * G + me, nu = blk[32] * 4; int e = 0, valid = 0;
        if (idx < nu) { const int rb = idx >> 2; for (int q = 1; q < 32; ++q) if (blk[q] <= rb) e = q; valid = min(256, blk[33 + e] - (rb - blk[e]) * 256); }
        uinf[2 * i] = e; uinf[2 * i + 1] = valid; }
    __syncthreads();
}
struct SchedGateUp {
    typedef EpiGateUp8 Epi; static constexpr bool GATHER = true, FP8 = true;
    unsigned char* ws; const LAS int* uinf; const LAS int* ridx_lds; int G, me, l, nu;
    __device__ __forceinline__ bool get(int i, g256::Unit<Epi>& u) const {
        const int idx = i * G + me; if (idx >= nu) return false;
        const int rb = idx >> 2, ct = idx & 3, e = uni(uinf[2 * i]);
        u.A = (const bf16_t*)(ws + WS_H8);
        { const unsigned char* b0 = ws + WS_WEXP + (size_t)l * WEXP_LAYER + ((size_t)e * 512 + ct * 128) * 1024; u.B0 = (const bf16_t*)b0; u.B1 = (const bf16_t*)(b0 + EXPMAT); }
        u.ridx = ridx_lds + (i & 7) * 256; u.valid = uni(uinf[2 * i + 1]);
        u.epi.C = ws + WS_HID + (size_t)(rb * 256) * DEXP + ct * 128; u.epi.ld = DEXP;
        return true;
    }
};
struct SchedDown {
    typedef EpiFp8 Epi; static constexpr bool GATHER = false, FP8 = true;
    unsigned char* ws; const LAS int* uinf; int G, me, l, nu;
    __device__ __forceinline__ bool get(int i, g256::Unit<Epi>& u) const {
        const int idx = i * G + me; if (idx >= nu) return false;
        const int rb = idx >> 2, ct = idx & 3, e = uni(uinf[2 * i]);
        u.A = (const bf16_t*)(ws + WS_HID + (size_t)(rb * 256) * DEXP);
        { const unsigned char* b0 = ws + WS_WEXP + (size_t)l * WEXP_LAYER + 2 * EXPMAT + ((size_t)e * 1024 + ct * 256) * 512; u.B0 = (const bf16_t*)b0; u.B1 = (const bf16_t*)(b0 + (size_t)128 * 512); } u.ridx = nullptr; u.valid = 256;
        u.epi.C = ws + WS_YS + (size_t)(rb * 256) * D + ct * 256; u.epi.ld = D; u.epi.scale = 1.0f / 32.0f;
        return true;
    }
};

template <int l> __device__ __forceinline__ void p4_ln1_router(AP a, unsigned char* lds) {
    const int tid = tid_opaque(), lane = tid & 63, w = tid >> 6;
    const int ntok = (l == 0) ? NTOK : NLAT;
    int* cnt = (int*)(lds + MISC_OFF);
    if (tid < 32) cnt[tid] = 0;
    f32x4* Lg = (f32x4*)lds; f32x4* Le = (f32x4*)(lds + 16384); f32x4* Lgb = (f32x4*)(lds + 147456);
    {
        const float* wrg_ = a->in[16] + (size_t)l * 1024 * 4; const float* wre_ = a->in[17] + (size_t)l * 1024 * 32;
#pragma unroll
        for (int it = 0; it < 2; ++it) { const int c = tid + 512 * it, slot = (((c >> 8) * 4 + (c & 3)) << 6) + ((c >> 2) & 63);
            Lg[slot] = *(const f32x4*)(wrg_ + (size_t)c * 4);
#pragma unroll
            for (int q = 0; q < 8; ++q) Le[q * 1024 + slot] = *(const f32x4*)(wre_ + (size_t)c * 32 + q * 4); }
        Lgb[tid] = (tid < 256) ? *(const f32x4*)(a->in[14] + l * 1024 + tid * 4) : *(const f32x4*)(a->in[15] + l * 1024 + (tid - 256) * 4);
    }
    __syncthreads();
    const float* mod = (const float*)(a->ws + WS_MOD) + (size_t)l * 5 * 6144;
    const bf16_t* Y = (const bf16_t*)(a->ws + WS_Y);
    bf16_t* X1 = (bf16_t*)(a->ws + WS_X1);
    unsigned char* H8 = a->ws + WS_H8;
    int* tokE = (int*)(a->ws + WS_TOKE); int* tokR = (int*)(a->ws + WS_TOKR); float* tokG = (float*)(a->ws + WS_TOKG);
    const int tstep = gridDim.x * 8;
    f32x4 nx[4]; u32x2 nxb[4], ny[4];
    const bf16_t* XC = (const bf16_t*)(a->ws + WS_XC);
    {   const int t = blockIdx.x * 8 + w;
        if (t < ntok) { const float* xs = (t < NLAT) ? a->in[0] + (size_t)t * D : a->in[2] + (size_t)(t - NLAT) * D;
#pragma unroll
            for (int i = 0; i < 4; ++i) { if (l == 0) nx[i] = *(const f32x4*)(xs + 256 * i + 4 * lane); else nxb[i] = *(const u32x2*)(XC + (size_t)t * D + 256 * i + 4 * lane);
                ny[i] = *(const u32x2*)(Y + (size_t)t * D + 256 * i + 4 * lane); } } }
    int mrow = -1; f32x4 mg[4], msh[4], msc[4];
    for (int t = blockIdx.x * 8 + w; t < ntok; t += tstep) {
        const int mr = (t < NLAT) ? (t >> 12) : 4;
        if (mr != mrow) { mrow = mr; const float* m = mod + (size_t)mr * 6144;
#pragma unroll
            for (int i = 0; i < 4; ++i) { const int c = 256 * i + 4 * lane; mg[i] = *(const f32x4*)(m + 2048 + c); msh[i] = *(const f32x4*)(m + 3072 + c); msc[i] = *(const f32x4*)(m + 4096 + c); } }
        f32x4 v[4];
#pragma unroll
        for (int i = 0; i < 4; ++i) { const f32x4 yv = (f32x4){lo2f(ny[i].x), hi2f(ny[i].x), lo2f(ny[i].y), hi2f(ny[i].y)};
            const f32x4 xv = (l == 0) ? nx[i] : (f32x4){lo2f(nxb[i].x), hi2f(nxb[i].x), lo2f(nxb[i].y), hi2f(nxb[i].y)};
#pragma unroll
            for (int e = 0; e < 4; ++e) v[i][e] = RES_ALPHA * xv[e] + mg[i][e] * yv[e]; }
        {   const int tn = t + tstep;
            if (tn < ntok) { const float* xs = (tn < NLAT) ? a->in[0] + (size_t)tn * D : a->in[2] + (size_t)(tn - NLAT) * D;
#pragma unroll
                for (int i = 0; i < 4; ++i) { if (l == 0) nx[i] = *(const f32x4*)(xs + 256 * i + 4 * lane); else nxb[i] = *(const u32x2*)(XC + (size_t)tn * D + 256 * i + 4 * lane);
                    ny[i] = *(const u32x2*)(Y + (size_t)tn * D + 256 * i + 4 * lane); } } }
        float mean, rstd; ln_stats(v, mean, rstd);
#pragma unroll
        for (int i = 0; i < 4; ++i) { const int c = 256 * i + 4 * lane; const f32x4 gg = Lgb[64 * i + lane], bb = Lgb[256 + 64 * i + lane];
#pragma unroll
            for (int e = 0; e < 4; ++e) v[i][e] = (v[i][e] - mean) * rstd * gg[e] + bb[e];
            { u32x2 pk; pk.x = pack2(v[i][0], v[i][1]); pk.y = pack2(v[i][2], v[i][3]); *(u32x2*)(X1 + (size_t)t * D + c) = pk; } }
        ln_stats(v, mean, rstd);
#pragma unroll
        for (int i = 0; i < 4; ++i) { const int c = 256 * i + 4 * lane; const f32x4 sh = msh[i], sc = msc[i];
#pragma unroll
            for (int e = 0; e < 4; ++e) v[i][e] = (v[i][e] - mean) * rstd * (1.0f + sc[e]) + sh[e];
            *(unsigned*)(H8 + (size_t)t * D + c) = pack4_fp8(v[i][0], v[i][1], v[i][2], v[i][3]); }
        f32x2 lg01 = (f32x2){0.f, 0.f}, lg23 = (f32x2){0.f, 0.f};
#pragma unroll
        for (int i = 0; i < 4; ++i)
#pragma unroll
            for (int e = 0; e < 4; ++e) { const f32x4 wv = Lg[((i * 4 + e) << 6) + lane]; const f32x2 vv = (f32x2){v[i][e], v[i][e]};
                lg01 += vv * (f32x2){wv[0], wv[1]}; lg23 += vv * (f32x2){wv[2], wv[3]}; }
        float lg[4] = {wave_sum(lg01[0]), wave_sum(lg01[1]), wave_sum(lg23[0]), wave_sum(lg23[1])};
        int grp = 0; float mx = lg[0];
#pragma unroll
        for (int q = 1; q < 4; ++q) if (lg[q] > mx) { mx = lg[q]; grp = q; }
        float se = 0.f;
#pragma unroll
        for (int q = 0; q < 4; ++q) se += expf(lg[q] - mx);
        const float gate_group = 1.0f / se;
        f32x2 le01 = (f32x2){0.f, 0.f}, le23 = (f32x2){0.f, 0.f}, le45 = (f32x2){0.f, 0.f}, le67 = (f32x2){0.f, 0.f};
#pragma unroll
        for (int i = 0; i < 4; ++i)
#pragma unroll
            for (int e = 0; e < 4; ++e) { const f32x4* wp = Le + grp * 2048 + ((i * 4 + e) << 6) + lane; const f32x4 w0 = wp[0], w1 = wp[1024]; const f32x2 vv = (f32x2){v[i][e], v[i][e]};
                le01 += vv * (f32x2){w0[0], w0[1]}; le23 += vv * (f32x2){w0[2], w0[3]}; le45 += vv * (f32x2){w1[0], w1[1]}; le67 += vv * (f32x2){w1[2], w1[3]}; }
        float le[8] = {wave_sum(le01[0]), wave_sum(le01[1]), wave_sum(le23[0]), wave_sum(le23[1]), wave_sum(le45[0]), wave_sum(le45[1]), wave_sum(le67[0]), wave_sum(le67[1])};
        int j1 = 0; float l1 = le[0];
#pragma unroll
        for (int q = 1; q < 8; ++q) if (le[q] > l1) { l1 = le[q]; j1 = q; }
        int j2 = -1; float l2 = -3.0e38f;
#pragma unroll
        for (int q = 0; q < 8; ++q) if (q != j1 && le[q] > l2) { l2 = le[q]; j2 = q; }
        const float e2 = expf(l2 - l1), p1 = 1.0f / (1.0f + e2), p2 = e2 / (1.0f + e2);
        if (lane == 0) {
            const int ex0 = grp * 8 + j1, ex1 = grp * 8 + j2;
            const int r0 = atomicAdd(&cnt[ex0], 1), r1 = atomicAdd(&cnt[ex1], 1);
            tokE[2 * t] = ex0; tokE[2 * t + 1] = ex1; tokR[2 * t] = r0; tokR[2 * t + 1] = r1;
            tokG[2 * t] = gate_group * p1; tokG[2 * t + 1] = gate_group * p2;
        }
    }
    __syncthreads();
    if (tid < 32) ((int*)(a->ws + WS_BCNT))[((size_t)l * MAXG + blockIdx.x) * 32 + tid] = cnt[tid];
    __syncthreads();
}

__device__ __forceinline__ void p5_dispatch(AP a, unsigned char* lds, int l) {
    const int tid = tid_opaque();
    const int ntok = (l == 0) ? NTOK : NLAT;
    int* part = (int*)lds;
    int* tot = (int*)(lds + 4096);
    int* off = (int*)(lds + 4096 + 128);
    int* pstart = (int*)(lds + 4096 + 256);
    const int* bc = (const int*)(a->ws + WS_BCNT) + (size_t)l * MAXG * 32;
    const int G = gridDim.x, me = blockIdx.x;
    { const int e = tid & 31, p = tid >> 5; int s = 0, so = 0; for (int bb = p; bb < G; bb += 16) { const int c = bc[bb * 32 + e]; s += c; if (bb < me) so += c; } part[p * 32 + e] = s; part[512 + p * 32 + e] = so; }
    __syncthreads();
    if (tid < 32) { int s = 0, so = 0; for (int p = 0; p < 16; ++p) { s += part[p * 32 + tid]; so += part[512 + p * 32 + tid]; } tot[tid] = s; off[tid] = so; }
    __syncthreads();
    if (tid == 0) { int acc = 0; for (int e = 0; e < 32; ++e) { pstart[e] = acc; acc += ((tot[e] + 255) >> 8) << 8; } }
    __syncthreads();
    if (me == 0 && tid < 32) ((int*)(a->ws + WS_CNT))[l * 32 + tid] = tot[tid];
    const int* tokE = (const int*)(a->ws + WS_TOKE); const int* tokR = (const int*)(a->ws + WS_TOKR);
    int* tokS = (int*)(a->ws + WS_TOKS); int* slotT = (int*)(a->ws + WS_SLOTT);
    for (int q = tid; ; q += NT) { const int it = q >> 4, j = q & 15, t = (it * G + me) * 8 + (j >> 1); if (t >= ntok) break;
        const int idx = 2 * t + (j & 1); const int e = tokE[idx]; const int slot = pstart[e] + off[e] + tokR[idx]; tokS[idx] = slot; slotT[slot] = t; }
    __syncthreads();
}

__device__ __forceinline__ void moe_table(AP a, int l, LAS int* blk) {
    const int* tot = (const int*)(a->ws + WS_CNT) + l * 32;
    __syncthreads();
    if (threadIdx.x < 32) blk[33 + threadIdx.x] = tot[threadIdx.x];
    __syncthreads();
    if (threadIdx.x == 0) { int acc = 0; for (int e = 0; e < 32; ++e) { blk[e] = acc; acc += (blk[33 + e] + 255) >> 8; } blk[32] = acc; }
    __syncthreads();
}
__device__ __forceinline__ int units_of(int nu, int v, int G) { return (v < nu) ? (nu - v + G - 1) / G : 0; }
__device__ __forceinline__ void p1_inproj(AP a, unsigned char* smem, LAS unsigned char* lds, int l) {
    SchedInProj S; S.ws = a->ws; S.l = l; S.G = gridDim.x; S.me = vblock();
    g256::gemm_phase(lds, 1024, S);
    { const int nu = (l == 0) ? 64 * 7 + 4 * 7 : 64 * 7 + 4, G = gridDim.x; if (units_of(nu, S.me, G) < (nu + G - 1) / G) exp_fill(a, smem, l, 8); }
}
__device__ __forceinline__ void p3_outproj(AP a, unsigned char* smem, LAS unsigned char* lds, int l) {
    SchedOutProj S; S.ws = a->ws; S.l = l; S.G = gridDim.x; S.me = vblock();
    g256::gemm_phase(lds, 1024, S);
    if (l == 0) {
        const bf16_t* W = (const bf16_t*)(a->ws + WS_WOUT);
        for (int u = blockIdx.x; u < 64; u += gridDim.x) { const int rt = u >> 3, ct = u & 7;
            EpiBf16 E; E.C = (bf16_t*)(a->ws + WS_Y) + (size_t)(NLAT + rt * 128) * D + ct * 128; E.ld = D; E.scale = 1.0f;
            const bf16_t* B0 = W + (size_t)(ct * 128) * 1024;
            gemm_tile<128, false, EpiBf16>(lds, (const bf16_t*)(a->ws + WS_CAT) + (size_t)(NLAT + rt * 128) * D, D, nullptr, 128, B0, B0 + (size_t)64 * 1024, 1024, 1024, E); }
        if (blockIdx.x >= 64) exp_fill(a, smem, 0, 3);
    }
}
__device__ __forceinline__ void p6_gateup(AP a, unsigned char* smem, LAS unsigned char* lds, int l) {
    LAS int* blk = (LAS int*)(lds + MISC_OFF + 256);
    moe_table(a, l, blk);
    LAS int* ridx = (LAS int*)(lds + RIDX_OFF);
    const int tid = tid_opaque(), G = gridDim.x, me = vblock(), nu = uni(blk[32]) * 4;
    LAS int* uinf = (LAS int*)(lds + MISC_OFF + 528);
    moe_units(blk, uinf, G, me);
    const int* slotT = (const int*)(a->ws + WS_SLOTT);
    for (int i = 0; i < 8; ++i) { const int idx = i * G + me; if (idx >= nu) break;
        const int rb = idx >> 2, valid = uinf[2 * i + 1];
        if (tid < 256) ridx[i * 256 + tid] = (tid < valid) ? slotT[rb * 256 + tid] : 0; }
    __syncthreads();
    SchedGateUp S; S.ws = a->ws; S.uinf = uinf; S.ridx_lds = ridx; S.G = G; S.me = me; S.l = l; S.nu = nu;
    g256::gemm_phase(lds, 512, S);
    __syncthreads();
    if (l == 0 && units_of(nu, me, G) < (nu + G - 1) / G) exp_fill(a, smem, 1, 4);
}
__device__ __forceinline__ void p7_down(AP a, unsigned char* smem, LAS unsigned char* lds, int l) {
    LAS int* blk = (LAS int*)(lds + MISC_OFF + 256);
    moe_table(a, l, blk);
    LAS int* uinf = (LAS int*)(lds + MISC_OFF + 528);
    SchedDown S; S.ws = a->ws; S.uinf = uinf; S.G = gridDim.x; S.me = vblock(); S.l = l; S.nu = uni(blk[32]) * 4;
    moe_units(blk, uinf, S.G, S.me);
    g256::gemm_phase(lds, 256, S);
    __syncthreads();
    { const int nu = S.nu, G = gridDim.x; if (l == 0 && units_of(nu, S.me, G) < (nu + G - 1) / G) exp_fill(a, smem, 1, 2); }
}

template <int l> __device__ __forceinline__ void p8_ln2(AP a, unsigned char* lds) {
    const int tid = tid_opaque(), lane = tid & 63, w = tid >> 6;
    const int ntok = (l == 0) ? NTOK : NLAT;
    const float* mod = (const float*)(a->ws + WS_MOD) + (size_t)l * 5 * 6144;
    const float* modn = (const float*)(a->ws + WS_MOD) + (size_t)5 * 6144;
    const bf16_t* X1 = (const bf16_t*)(a->ws + WS_X1);
    const unsigned char* YS = a->ws + WS_YS;
    const int* tokS = (const int*)(a->ws + WS_TOKS); const float* tokG = (const float*)(a->ws + WS_TOKG);
    f32x4* Lgb = (f32x4*)lds;
    __syncthreads();
    Lgb[tid] = (tid < 256) ? *(const f32x4*)(a->in[21] + l * 1024 + tid * 4) : *(const f32x4*)(a->in[22] + l * 1024 + (tid - 256) * 4);
    __syncthreads();
    int mrow = -1; f32x4 mg[4], nsh[4], nsc[4];
    const int tstep = gridDim.x * 8;
    int t = blockIdx.x * 8 + w;
    int ns0 = 0, ns1 = 0; float nga = 0.f, ngb = 0.f;
    u32x2 nx[4]; unsigned nya[4], nyb[4];
    float cga = 0.f, cgb = 0.f;
    if (t < ntok) { const int s0 = tokS[2 * t], s1 = tokS[2 * t + 1]; cga = tokG[2 * t]; cgb = tokG[2 * t + 1];
#pragma unroll
        for (int i = 0; i < 4; ++i) { const int c = 256 * i + 4 * lane; nx[i] = *(const u32x2*)(X1 + (size_t)t * D + c); nya[i] = *(const unsigned*)(YS + (size_t)s0 * D + c); nyb[i] = *(const unsigned*)(YS + (size_t)s1 * D + c); } }
    if (t + tstep < ntok) { ns0 = tokS[2 * (t + tstep)]; ns1 = tokS[2 * (t + tstep) + 1]; nga = tokG[2 * (t + tstep)]; ngb = tokG[2 * (t + tstep) + 1]; }
    for (; t < ntok; t += tstep) {
        const int mr = (t < NLAT) ? (t >> 12) : 4;
        if (mr != mrow) { mrow = mr; const float* m = mod + (size_t)mr * 6144; const float* mn = modn + (size_t)mr * 6144;
#pragma unroll
            for (int i = 0; i < 4; ++i) { const int c = 256 * i + 4 * lane; mg[i] = *(const f32x4*)(m + 5120 + c); if (l == 0) { nsh[i] = *(const f32x4*)(mn + c); nsc[i] = *(const f32x4*)(mn + 1024 + c); } } }
        f32x4 v[4];
#pragma unroll
        for (int i = 0; i < 4; ++i) { const f32x4 gv = mg[i];
            const f32x2 ya0 = __builtin_amdgcn_cvt_pk_f32_fp8(nya[i], false), ya1 = __builtin_amdgcn_cvt_pk_f32_fp8(nya[i], true), yb0 = __builtin_amdgcn_cvt_pk_f32_fp8(nyb[i], false), yb1 = __builtin_amdgcn_cvt_pk_f32_fp8(nyb[i], true);
            const float f0 = cga * ya0[0] + cgb * yb0[0], f1 = cga * ya0[1] + cgb * yb0[1], f2 = cga * ya1[0] + cgb * yb1[0], f3 = cga * ya1[1] + cgb * yb1[1];
            v[i][0] = RES_ALPHA * lo2f(nx[i].x) + gv[0] * f0; v[i][1] = RES_ALPHA * hi2f(nx[i].x) + gv[1] * f1; v[i][2] = RES_ALPHA * lo2f(nx[i].y) + gv[2] * f2; v[i][3] = RES_ALPHA * hi2f(nx[i].y) + gv[3] * f3; }
        {   const int tn = t + tstep, tn2 = t + 2 * tstep;
            if (tn < ntok) {
#pragma unroll
                for (int i = 0; i < 4; ++i) { const int c = 256 * i + 4 * lane; nx[i] = *(const u32x2*)(X1 + (size_t)tn * D + c); nya[i] = *(const unsigned*)(YS + (size_t)ns0 * D + c); nyb[i] = *(const unsigned*)(YS + (size_t)ns1 * D + c); }
                cga = nga; cgb = ngb; }
            if (tn2 < ntok) { ns0 = tokS[2 * tn2]; ns1 = tokS[2 * tn2 + 1]; nga = tokG[2 * tn2]; ngb = tokG[2 * tn2 + 1]; } }
        float mean, rstd; ln_stats(v, mean, rstd);
#pragma unroll
        for (int i = 0; i < 4; ++i) { const int c = 256 * i + 4 * lane; const f32x4 gg = Lgb[64 * i + lane], bb = Lgb[256 + 64 * i + lane];
#pragma unroll
            for (int e = 0; e < 4; ++e) v[i][e] = (v[i][e] - mean) * rstd * gg[e] + bb[e];
            if (l == 0) { u32x2 pk; pk.x = pack2(v[i][0], v[i][1]); pk.y = pack2(v[i][2], v[i][3]); *(u32x2*)((bf16_t*)(a->ws + WS_XC) + (size_t)t * D + c) = pk; }
            else *(f32x4*)(a->out + (size_t)t * D + c) = v[i]; }
        if (l == 0) {
            ln_stats(v, mean, rstd);
            bf16_t* H = (bf16_t*)(a->ws + WS_H);
#pragma unroll
            for (int i = 0; i < 4; ++i) { const int c = 256 * i + 4 * lane; const f32x4 sh = nsh[i], sc = nsc[i];
                f32x4 o;
#pragma unroll
                for (int e = 0; e < 4; ++e) o[e] = (v[i][e] - mean) * rstd * (1.0f + sc[e]) + sh[e];
                u32x2 pk; pk.x = pack2(o[0], o[1]); pk.y = pack2(o[2], o[3]); *(u32x2*)(H + (size_t)t * D + c) = pk; }
        }
    }
}

constexpr int N_PHASES = 18;
template <int P> __device__ __forceinline__ void run_phase(AP a, unsigned char* smem, LAS unsigned char* lds, int l) {
    asm volatile("" : "+s"(a));
    if (P == 0) p0_prologue(a, smem);
    if (P == 1) p_lnmod0(a);
    if (P == 2) p1_inproj(a, smem, lds, l);
    if (P == 3) p2_mix(a, smem, lds, l);
    if (P == 4) p3_outproj(a, smem, lds, l);
    if (P == 5) { if (l == 0) p4_ln1_router<0>(a, smem); else p4_ln1_router<1>(a, smem); }
    if (P == 6) p5_dispatch(a, smem, l);
    if (P == 7) p6_gateup(a, smem, lds, l);
    if (P == 8) p7_down(a, smem, lds, l);
    if (P == 9) { if (l == 0) p8_ln2<0>(a, smem); else p8_ln2<1>(a, smem); }
}
#if N_LAUNCH_MODE == 1
__global__ void __launch_bounds__(NT, 2) fwd(Args a) {
    extern __shared__ __attribute__((aligned(16))) unsigned char smem[];
    LAS unsigned char* lds = (LAS unsigned char*)smem;
    if (threadIdx.x < 4) ((volatile LAS unsigned*)(lds + MISC_OFF + 768))[threadIdx.x] = 0u;
    __syncthreads();
    XcdBarrier bar = xcd_barrier_post((unsigned*)(a.ws + WS_BAR), (volatile LAS unsigned*)(lds + MISC_OFF + 768));
    AP ap = (AP)__builtin_amdgcn_kernarg_segment_ptr();
#define PROBE(P, l) do { if (PROBE_MASK & (1 << (P))) { for (int _r = 0; _r < 2; ++_r) { xcd_barrier(bar); run_phase<P>(ap, smem, lds, l); } } } while (0)
    run_phase<0>(ap, smem, lds, 0); PROBE(0, 0); xcd_barrier(bar);
    run_phase<1>(ap, smem, lds, 0); PROBE(1, 0); xcd_barrier(bar);
    for (int l = 0; l < 2; ++l) {
        run_phase<2>(ap, smem, lds, l); PROBE(2, l); xcd_barrier(bar);
        run_phase<3>(ap, smem, lds, l); PROBE(3, l); xcd_barrier(bar);
        run_phase<4>(ap, smem, lds, l); PROBE(4, l); xcd_barrier(bar);
        run_phase<5>(ap, smem, lds, l); PROBE(5, l); xcd_barrier(bar);
        run_phase<6>(ap, smem, lds, l); PROBE(6, l); xcd_barrier(bar);
        run_phase<7>(ap, smem, lds, l); PROBE(7, l); xcd_barrier(bar);
        run_phase<8>(ap, smem, lds, l); PROBE(8, l); xcd_barrier(bar);
        run_phase<9>(ap, smem, lds, l); PROBE(9, l); if (l == 0) xcd_barrier(bar);
    }
}
#else
template <int P> __global__ void __launch_bounds__(NT, 2) k_phase(Args a) {
    extern __shared__ __attribute__((aligned(16))) unsigned char smem[];
    LAS unsigned char* lds = (LAS unsigned char*)smem;
    AP ap = (AP)__builtin_amdgcn_kernarg_segment_ptr();
    run_phase<P>(ap, smem, lds, ap->ph_lo);
}
template <int P> static void launch_phase(Args a, int l, int grid, hipStream_t stream) {
    static bool attr = false;
    if (!attr) { (void)hipFuncSetAttribute((const void*)k_phase<P>, hipFuncAttributeMaxDynamicSharedMemorySize, LDS_BYTES); attr = true; }
    a.ph_lo = l; a.ph_hi = P;
    hipLaunchKernelGGL(k_phase<P>, dim3(grid), dim3(NT), LDS_BYTES, stream, a);
}
#endif

extern "C" void kernel_launch(void* const* d_in, const int* in_sizes, int n_in, void* d_out, int out_size, void* d_ws, size_t ws_size, hipStream_t stream) {
    static int grid = 0;
    if (grid == 0) {
        if (n_in != 23 || out_size != NLAT * D || ws_size < WS_END) { fprintf(stderr, "kernel_launch: unexpected shapes (n_in %d, out %d, ws %zu, need %zu)\n", n_in, out_size, ws_size, (size_t)WS_END); grid = -1; return; }
        int dev = 0, cus = 0;
        if (hipGetDevice(&dev) != hipSuccess || hipDeviceGetAttribute(&cus, hipDeviceAttributeMultiprocessorCount, dev) != hipSuccess) { grid = -1; return; }
#if N_LAUNCH_MODE == 1
        int per_cu = 0;
        if (hipFuncSetAttribute((const void*)fwd, hipFuncAttributeMaxDynamicSharedMemorySize, LDS_BYTES) != hipSuccess) { fprintf(stderr, "kernel_launch: hipFuncSetAttribute failed\n"); grid = -1; return; }
        if (hipOccupancyMaxActiveBlocksPerMultiprocessor(&per_cu, (const void*)fwd, NT, LDS_BYTES) != hipSuccess || per_cu < 1) { fprintf(stderr, "kernel_launch: occupancy query says %d\n", per_cu); }
        (void)hipGetLastError();
#endif
        grid = cus; if (grid > MAXG) grid = MAXG;
    }
    if (grid < 0) return;
    (void)hipMemsetAsync((char*)d_ws + WS_BAR, 0, 16384 + 256, stream);
    Args a{};
    for (int i = 0; i < 23; ++i) a.in[i] = (const float*)d_in[i];
    a.out = (float*)d_out; a.ws = (unsigned char*)d_ws;
#if N_LAUNCH_MODE == 1
    a.ph_lo = 0; a.ph_hi = N_PHASES;
    hipLaunchKernelGGL(fwd, dim3(grid), dim3(NT), LDS_BYTES, stream, a);
#else
    launch_phase<0>(a, 0, grid, stream);
    launch_phase<1>(a, 0, grid, stream);
    for (int l = 0; l < 2; ++l) {
        launch_phase<2>(a, l, grid, stream); launch_phase<3>(a, l, grid, stream); launch_phase<4>(a, l, grid, stream); launch_phase<5>(a, l, grid, stream);
        launch_phase<6>(a, l, grid, stream); launch_phase<7>(a, l, grid, stream); launch_phase<8>(a, l, grid, stream); launch_phase<9>(a, l, grid, stream);
    }
#endif
}
```

```cpp
#include <hip/hip_runtime.h>
#include <stdint.h>
#include <stdio.h>

#ifndef PROBE_MASK
#define PROBE_MASK 0
#endif
#ifndef PROBE_FFT_REP
#define PROBE_FFT_REP 1
#endif
#ifndef PROBE_MIX_REP
#define PROBE_MIX_REP 1
#endif
#ifndef PROBE_SGU_REP
#define PROBE_SGU_REP 1
#endif
#ifndef N_LAUNCH_MODE
#define N_LAUNCH_MODE 1
#endif

#define LAS __attribute__((address_space(3)))
typedef unsigned short bf16_t;
typedef short bf16x8 __attribute__((ext_vector_type(8)));
typedef float f32x4 __attribute__((ext_vector_type(4)));
typedef unsigned u32x4 __attribute__((ext_vector_type(4)));
typedef unsigned u32x2 __attribute__((ext_vector_type(2)));
typedef float f32x2 __attribute__((ext_vector_type(2)));
typedef int i32x4 __attribute__((ext_vector_type(4)));

constexpr int D = 1024, NBATCH = 4, SEQ = 4096, CTXL = 256;
constexpr int NLAT = NBATCH * SEQ, NCTX = NBATCH * CTXL, NTOK = NLAT + NCTX;
constexpr int ZC = 1792;
constexpr int NEXP = 32, DEXP = 512;
constexpr int NSLOT = 2 * NTOK + NEXP * 256;
constexpr int NT = 512;
constexpr int MAXG = 512;
constexpr float RES_ALPHA = 1.41421356237309515f;
constexpr int MISC_OFF = 155648;
constexpr int RIDX_OFF = 131072;
constexpr int LDS_BYTES = MISC_OFF + 1024;

constexpr size_t WS_BAR   = 0;
constexpr size_t WS_CNT   = 16384;
constexpr size_t WS_BCNT  = WS_CNT + 256;
constexpr size_t WS_MOD   = WS_BCNT + (size_t)2 * MAXG * 32 * 4;
constexpr size_t WS_ROPE  = WS_MOD + (size_t)2 * 5 * 6144 * 4;
constexpr size_t WS_TOKE  = WS_ROPE + 8192;
constexpr size_t WS_TOKR  = WS_TOKE + (size_t)NTOK * 8;
constexpr size_t WS_TOKS  = WS_TOKR + (size_t)NTOK * 8;
constexpr size_t WS_TOKG  = WS_TOKS + (size_t)NTOK * 8;
constexpr size_t WS_SLOTT = WS_TOKG + (size_t)NTOK * 8;
constexpr size_t WS_WIN   = WS_SLOTT + (size_t)NSLOT * 4;
constexpr size_t WS_WOUT  = WS_WIN + (size_t)2 * ZC * 1024 * 2;
constexpr size_t WS_WSGU  = WS_WOUT + (size_t)2 * 1024 * 1024 * 2;
constexpr size_t WS_DFTC  = WS_WSGU + (size_t)2 * 4 * 128 * 128 * 2;
constexpr size_t WS_WEXP  = WS_DFTC + (size_t)256 * 512 * 2;
constexpr size_t EXPMAT   = (size_t)NEXP * 512 * 1024;
constexpr size_t WEXP_LAYER = 3 * EXPMAT;
constexpr size_t WS_X1    = WS_WEXP + 2 * WEXP_LAYER;
constexpr size_t WS_XC    = WS_X1 + (size_t)NTOK * D * 4;
constexpr size_t WS_H     = WS_XC + (size_t)NTOK * D * 4;
constexpr size_t WS_R     = WS_H + (size_t)NTOK * D * 2;
constexpr size_t WS_Z     = WS_R;
constexpr size_t WS_AT    = WS_Z + (size_t)NTOK * ZC * 2;
constexpr size_t WS_ATC   = WS_AT + (size_t)4 * 256 * 8192 * 2;
constexpr size_t WS_VT    = WS_ATC + (size_t)4 * 256 * 512 * 2;
constexpr size_t WS_VTC   = WS_VT + (size_t)4 * 2 * 64 * 4096 * 2;
constexpr size_t WS_CAT   = WS_VTC + (size_t)4 * 2 * 64 * 256 * 2;
constexpr size_t WS_REND  = WS_CAT + (size_t)NTOK * D * 2;
constexpr size_t WS_Y     = WS_R;
constexpr size_t WS_HID   = WS_R;
constexpr size_t WS_YS    = WS_HID + (size_t)NSLOT * DEXP * 2;
constexpr size_t WS_REND2 = (WS_YS + (size_t)NSLOT * D * 2 > WS_REND) ? WS_YS + (size_t)NSLOT * D * 2 : WS_REND;
constexpr size_t WS_H8    = (WS_REND2 + 255) & ~(size_t)255;
constexpr size_t WS_END   = WS_H8 + (size_t)NTOK * D;
static_assert(WS_Y + (size_t)NTOK * D * 4 <= WS_CAT, "Y must not reach CAT");
static_assert(WS_WIN % 256 == 0 && WS_DFTC % 256 == 0 && WS_WEXP % 256 == 0 && WS_X1 % 256 == 0 && WS_H % 256 == 0 && WS_R % 256 == 0 && WS_AT % 256 == 0 && WS_CAT % 256 == 0 && WS_YS % 256 == 0, "alignment");

struct Args { const float* in[23]; float* out; unsigned char* ws; int ph_lo, ph_hi; };
#define CAS __attribute__((address_space(4)))
typedef const CAS Args* AP;

#define XB_TMO      128
#define XB_XCNT(j)  (256  + 64 * (j))
#define XB_XSUB(j)  (1280 + 64 * (j))
#define XB_XGEN(j)  (2304 + 64 * (j))
#define XB_TOP      3328
#define XB_TOPGEN   3392
#define XCD_BAR_WORDS 3456
#define XB_SPIN_CAP (1u << 18)

__device__ __forceinline__ unsigned xb_ld(unsigned* p)              { return __hip_atomic_load(p, __ATOMIC_RELAXED, __HIP_MEMORY_SCOPE_AGENT); }
__device__ __forceinline__ unsigned xb_add(unsigned* p, unsigned v) { return __hip_atomic_fetch_add(p, v, __ATOMIC_RELAXED, __HIP_MEMORY_SCOPE_AGENT); }
__device__ __forceinline__ unsigned xb_xcc_id() { return (unsigned)__builtin_amdgcn_s_getreg((3 << 11) | 20) & 0xFu; }
#define XB_SPIN(cond, bar) do { unsigned _sp = 0; while (cond) { __builtin_amdgcn_s_sleep(1); \
    if ((++_sp & 255u) == 0u) { if (xb_ld(&(bar)[XB_TMO])) break; if (_sp > XB_SPIN_CAP) { atomicAdd(&(bar)[XB_TMO], 1u); break; } } } } while (0)

struct XcdBarrier { unsigned* bar; unsigned x; volatile LAS unsigned* st; };

__device__ __forceinline__ XcdBarrier xcd_barrier_post(unsigned* bar, volatile LAS unsigned* st) {
    XcdBarrier b; b.bar = bar; b.x = (unsigned)__builtin_amdgcn_readfirstlane((int)xb_xcc_id()); b.st = st;
    if (threadIdx.x == 0) (void)xb_add(&bar[XB_XCNT(b.x)], 1u);
    return b;
}
__device__ __forceinline__ void xcd_barrier_complete(unsigned* bar, unsigned x, unsigned& nloc, unsigned& nx) {
    const unsigned G = gridDim.x * gridDim.y * gridDim.z;
    unsigned sum, cnt, mine, sp = 0u;
    for (;;) {
        sum = 0u; cnt = 0u; mine = 0u;
#pragma unroll
        for (unsigned j = 0; j < 16; ++j) { const unsigned c = xb_ld(&bar[XB_XCNT(j)]); sum += c; cnt += (c > 0u) ? 1u : 0u; mine = (j == x) ? c : mine; }
        if (sum == G) break;
        __builtin_amdgcn_s_sleep(1);
        if ((++sp & 255u) == 0u) { if (xb_ld(&bar[XB_TMO])) break; if (sp > XB_SPIN_CAP) { atomicAdd(&bar[XB_TMO], 1u); break; } }
    }
    nloc = mine > 0u ? mine : 1u; nx = cnt > 0u ? cnt : 1u;
}
__device__ __forceinline__ void xcd_barrier(const XcdBarrier& b) {
    asm volatile("s_waitcnt vmcnt(0)" ::: "memory");
    __syncthreads();
    if (threadIdx.x == 0) {
        unsigned* bar = b.bar;
        unsigned bx = b.x;
        asm volatile("" : "+s"(bar), "+s"(bx));
        __builtin_amdgcn_s_waitcnt(0);
        unsigned nloc = b.st[0], nx = b.st[1];
        if (nloc == 0u) { xcd_barrier_complete(bar, bx, nloc, nx); b.st[0] = nloc; b.st[1] = nx; }
        const unsigned old = xb_add(&bar[XB_XSUB(bx)], 1u);
        const unsigned gen = old / nloc;
        if (old + 1u == (gen + 1u) * nloc) {
            __builtin_amdgcn_fence(__ATOMIC_RELEASE, "agent");
            asm volatile("s_waitcnt vmcnt(0)" ::: "memory");
            const unsigned og = xb_add(&bar[XB_TOP], 1u);
            const unsigned tg = og / nx;
            if (og + 1u == (tg + 1u) * nx) xb_add(&bar[XB_TOPGEN], 1u);
            else XB_SPIN(xb_ld(&bar[XB_TOPGEN]) == tg, bar);
            __builtin_amdgcn_fence(__ATOMIC_ACQUIRE, "agent");
            xb_add(&bar[XB_XGEN(bx)], 1u);
            asm volatile("s_waitcnt vmcnt(0)" ::: "memory");
        } else {
            XB_SPIN(xb_ld(&bar[XB_XGEN(bx)]) == gen, bar);
            __builtin_amdgcn_fence(__ATOMIC_ACQUIRE, "agent");
            asm volatile("s_waitcnt vmcnt(0)" ::: "memory");
        }
    }
    __syncthreads();
}

__device__ __forceinline__ int tid_opaque() { int t = threadIdx.x; asm volatile("" : "+v"(t)); return t; }
__device__ __forceinline__ float bf2f(bf16_t v) { return __uint_as_float(((unsigned)v) << 16); }
__device__ __forceinline__ bf16_t f2bf(float f) { return __builtin_bit_cast(unsigned short, (__bf16)f); }
typedef __bf16 hwbf16x2 __attribute__((ext_vector_type(2)));
__device__ __forceinline__ unsigned pack2(float a, float b) { return __builtin_bit_cast(unsigned, __builtin_convertvector((f32x2){a, b}, hwbf16x2)); }
__device__ __forceinline__ unsigned pack4_fp8(float a, float b, float c, float d) {
    a = __builtin_amdgcn_fmed3f(a, -448.f, 448.f); b = __builtin_amdgcn_fmed3f(b, -448.f, 448.f); c = __builtin_amdgcn_fmed3f(c, -448.f, 448.f); d = __builtin_amdgcn_fmed3f(d, -448.f, 448.f);
    int p = __builtin_amdgcn_cvt_pk_fp8_f32(a, b, 0, false); p = __builtin_amdgcn_cvt_pk_fp8_f32(c, d, p, true); return (unsigned)p; }
__device__ __forceinline__ float lo2f(unsigned w) { return __uint_as_float(w << 16); }
__device__ __forceinline__ float hi2f(unsigned w) { return __uint_as_float(w & 0xffff0000u); }
template <int CTRL> __device__ __forceinline__ float dpp_mov(float v) { return __builtin_bit_cast(float, __builtin_amdgcn_update_dpp(0, __builtin_bit_cast(int, v), CTRL, 0xf, 0xf, true)); }
__device__ __forceinline__ float row_sum16(float v) {
    v += dpp_mov<0xB1>(v);
    v += dpp_mov<0x4E>(v);
    v += dpp_mov<0x141>(v);
    v += dpp_mov<0x140>(v);
    return v;
}
__device__ __forceinline__ float row_max16(float v) {
    v = fmaxf(v, dpp_mov<0xB1>(v)); v = fmaxf(v, dpp_mov<0x4E>(v)); v = fmaxf(v, dpp_mov<0x141>(v)); v = fmaxf(v, dpp_mov<0x140>(v));
    return v;
}
__device__ __forceinline__ float xsum32(float p, float q) { const auto rr = __builtin_amdgcn_permlane32_swap(__float_as_uint(p), __float_as_uint(q), false, false); return __uint_as_float(rr[0]) + __uint_as_float(rr[1]); }
__device__ __forceinline__ float xsum16(float p, float q) { const auto rr = __builtin_amdgcn_permlane16_swap(__float_as_uint(p), __float_as_uint(q), false, false); return __uint_as_float(rr[0]) + __uint_as_float(rr[1]); }
__device__ __forceinline__ float lane_f(float v, int lane) { return __builtin_bit_cast(float, __builtin_amdgcn_readlane(__builtin_bit_cast(int, v), lane)); }
__device__ __forceinline__ float wave_sum(float v) {
    v = row_sum16(v); v = xsum16(v, v); return xsum32(v, v);
}
__device__ __forceinline__ void wave_sum4(float a, float b, float c, float d, float (&o)[4]) {
    float w = xsum16(xsum32(a, b), xsum32(c, d));
    w = row_sum16(w);
    o[0] = lane_f(w, 0); o[1] = lane_f(w, 32); o[2] = lane_f(w, 16); o[3] = lane_f(w, 48);
}
__device__ __forceinline__ void wave_sum8(const float (&e)[8], int lane, float (&o)[8]) {
    const float w0 = xsum16(xsum32(e[0], e[1]), xsum32(e[2], e[3]));
    const float w1 = xsum16(xsum32(e[4], e[5]), xsum32(e[6], e[7]));
    const bool odd = lane & 1;
    float r = (odd ? w1 : w0) + dpp_mov<0xB1>(odd ? w0 : w1);
    r += dpp_mov<0x4E>(r); r += dpp_mov<0x124>(r); r += dpp_mov<0x128>(r);
    o[0] = lane_f(r, 0); o[1] = lane_f(r, 32); o[2] = lane_f(r, 16); o[3] = lane_f(r, 48);
    o[4] = lane_f(r, 1); o[5] = lane_f(r, 33); o[6] = lane_f(r, 17); o[7] = lane_f(r, 49);
}
__device__ __forceinline__ float gelu_erf(float v) {
    const float t = __builtin_amdgcn_rcpf(fabsf(v) * 0.2316418882f + 1.0f);
    float q = t * 0.5307027145f + (-0.7265760135f); q = q * t + 0.7107068705f; q = q * t + (-0.142248368f); q = q * t + 0.127414796f; q = q * t;
    const float m = v * (q * __builtin_amdgcn_exp2f((v * v) * (-0.72134752044f)));
    return v < 0.f ? m : v - m;
}
__device__ __forceinline__ float silu_f(float x) { return x * __builtin_amdgcn_rcpf(1.0f + __expf(-x)); }

__device__ __forceinline__ void ln_stats(const f32x4 (&v)[4], float& mean, float& rstd) {
    float s = 0.f;
#pragma unroll
    for (int i = 0; i < 4; ++i) s += (v[i][0] + v[i][1]) + (v[i][2] + v[i][3]);
    s = wave_sum(s); mean = s * (1.0f / 1024.0f);
    float q = 0.f;
#pragma unroll
    for (int i = 0; i < 4; ++i)
#pragma unroll
        for (int e = 0; e < 4; ++e) { const float d = v[i][e] - mean; q += d * d; }
    q = wave_sum(q); rstd = __builtin_amdgcn_rsqf(q * (1.0f / 1024.0f) + 1e-6f);
}

template <int BN> struct MfmaLayout {
    static constexpr int FG = BN / 128, NI = 4, NJ = 2 * FG;
    static constexpr bool PAIR8 = false;
    int rbase, cbase;
    __device__ __forceinline__ int row(int i) const { return rbase + 16 * i; }
    __device__ __forceinline__ int col(int jj) const { return (jj / FG) * (BN / 2) + (jj % FG) * 16 + cbase; }
};

__device__ __forceinline__ void glds16(const bf16_t* g, LAS unsigned char* l) {
    __builtin_amdgcn_global_load_lds((const unsigned*)g, (LAS unsigned*)l, 16, 0, 0);
}

template <int BN, bool GATHER, class Epi>
__device__ __forceinline__ void gemm_tile(LAS unsigned char* lds, const bf16_t* A, int lda, const int* rowidx, int valid_rows,
                                          const bf16_t* B0, const bf16_t* B1, int ldb, int K, const Epi& epi) {
    constexpr int A_B = 16384, B_B = BN * 128, STAGE = A_B + B_B, NBL = BN / 64;
    const int tid = tid_opaque(), lane = tid & 63, wid = __builtin_amdgcn_readfirstlane(tid >> 6);
    const bf16_t* ap[2]; const bf16_t* bp[NBL];
#pragma unroll
    for (int i = 0; i < 2; ++i) {
        const int P = i * 512 + tid, row = P >> 3, c = (P & 7) ^ ((row >> 1) & 7);
        size_t ro;
        if (GATHER) ro = (size_t)(row < valid_rows ? rowidx[row] : 0) * (size_t)lda; else ro = (size_t)row * (size_t)lda;
        ap[i] = A + ro + c * 8;
    }
#pragma unroll
    for (int i = 0; i < NBL; ++i) {
        const int P = i * 512 + tid, row = P >> 3, c = (P & 7) ^ ((row >> 1) & 7);
        const bf16_t* base = (row < BN / 2) ? (B0 + (size_t)row * ldb) : (B1 + (size_t)(row - BN / 2) * ldb);
        bp[i] = base + c * 8;
    }
    const int nk = K / 64;
#define GT_STAGE(buf, k0) do { \
        _Pragma("unroll") for (int _i = 0; _i < 2; ++_i) glds16(ap[_i] + (k0), lds + (buf) * STAGE + _i * 8192 + wid * 1024); \
        _Pragma("unroll") for (int _i = 0; _i < NBL; ++_i) glds16(bp[_i] + (k0), lds + (buf) * STAGE + A_B + _i * 8192 + wid * 1024); } while (0)

    typedef MfmaLayout<BN> Lay;
    constexpr int FG = Lay::FG;
    const int fr = lane & 15, g = lane >> 4, wr = wid >> 2, wc = wid & 3;
    Lay lay; lay.rbase = wr * 64 + fr; lay.cbase = wc * 16 * FG + 4 * g;
    f32x4 acc[Lay::NI][Lay::NJ];
#pragma unroll
    for (int i = 0; i < Lay::NI; ++i)
#pragma unroll
        for (int j = 0; j < Lay::NJ; ++j) acc[i][j] = (f32x4){0.f, 0.f, 0.f, 0.f};
    int aoff[4], boff[Lay::NJ];
#pragma unroll
    for (int m = 0; m < 4; ++m) { const int row = wr * 64 + m * 16 + fr; aoff[m] = row * 128 + ((g ^ ((row >> 1) & 7)) << 4); }
#pragma unroll
    for (int jj = 0; jj < Lay::NJ; ++jj) { const int row = (jj / FG) * (BN / 2) + wc * 16 * FG + (jj % FG) * 16 + fr; boff[jj] = A_B + row * 128 + ((g ^ ((row >> 1) & 7)) << 4); }
    GT_STAGE(0, 0);
    asm volatile("s_waitcnt vmcnt(0)" ::: "memory"); __syncthreads();
    for (int kt = 0; kt < nk; ++kt) {
        if (kt + 1 < nk) GT_STAGE((kt + 1) & 1, (kt + 1) * 64);
        const LAS unsigned char* sa = lds + (kt & 1) * STAGE;
#pragma unroll
        for (int ks = 0; ks < 2; ++ks) {
            bf16x8 af[4], bfv[Lay::NJ];
#pragma unroll
            for (int m = 0; m < 4; ++m) af[m] = *(const LAS bf16x8*)(sa + (aoff[m] ^ (ks << 6)));
#pragma unroll
            for (int jj = 0; jj < Lay::NJ; ++jj) bfv[jj] = *(const LAS bf16x8*)(sa + (boff[jj] ^ (ks << 6)));
#pragma unroll
            for (int m = 0; m < 4; ++m)
#pragma unroll
                for (int jj = 0; jj < Lay::NJ; ++jj) acc[m][jj] = __builtin_amdgcn_mfma_f32_16x16x32_bf16(bfv[jj], af[m], acc[m][jj], 0, 0, 0);
        }
        asm volatile("s_waitcnt vmcnt(0)" ::: "memory"); __syncthreads();
    }
    epi.run(acc, lay);
#undef GT_STAGE
}

namespace g256 {
constexpr int BK = 64, HALF = 128, HTB = HALF * BK * 2, STAGE_BYTES = 8 * HTB;
__device__ __forceinline__ int lds_byte(int r, int c) { const int st = (r >> 4) * 2 + (c >> 5), rr = r & 15, cc = c & 31, ob = rr * 64 + cc * 2; return st * 1024 + (ob ^ (((ob >> 9) & 1) << 5)); }
__device__ __forceinline__ int perm32(int rho) { const int n = rho >> 4, i = rho & 15; return 8 * (i >> 2) + 4 * n + (i & 3); }
__device__ __forceinline__ void stage_rc(int b, int& R, int& C) { const int st = b / 1024, sb = b % 1024, swz = sb ^ (((sb >> 9) & 1) << 5); R = (st >> 1) * 16 + swz / 64; C = (st & 1) * 32 + (swz % 64) / 2; }
struct Lay {
    static constexpr int NI = 8, NJ = 4;
    static constexpr bool PAIR8 = true;
    int rbase, cbase;
    __device__ __forceinline__ int row(int i) const { return (i >> 2) * 128 + (i & 3) * 16 + rbase; }
    __device__ __forceinline__ int col(int j) const { return (j >> 1) * 128 + (j & 1) * 4 + cbase; }
};
template <class Epi> struct Unit { const bf16_t* A; const bf16_t* B0; const bf16_t* B1; const LAS int* ridx; int valid; Epi epi; };

template <class Sched>
__device__ __forceinline__ void gemm_phase(LAS unsigned char* lds, const int K, const Sched& S) {
    typedef typename Sched::Epi Epi;
    const int tid = tid_opaque(), wid = __builtin_amdgcn_readfirstlane(tid >> 6), lane = tid & 63, wr = wid >> 2, wc = wid & 3, fr = lane & 15, fq = lane >> 4;
    int nt = K / BK; asm volatile("" : "+s"(nt));
    int sR[2], sC[2];
#pragma unroll
    for (int i = 0; i < 2; ++i) stage_rc(tid * 16 + i * 8192, sR[i], sC[i]);
    unsigned voffB[2];
#pragma unroll
    for (int i = 0; i < 2; ++i) voffB[i] = (unsigned)(((sR[i] & ~31) + perm32(sR[i] & 31)) * K + sC[i]) * 2u;
    const size_t kstep = (size_t)(BK * 2);
    const unsigned ldsw = (unsigned)wid * 1024u;
    const int aoff = lds_byte(wr * 64 + fr, fq * 8), boff = lds_byte(wc * 32 + fr, fq * 8);
#define G2_SA(b, h) (((b) * 2 + (h)) * HTB)
#define G2_SB(b, h) ((4 + (b) * 2 + (h)) * HTB)
#define G2_STAGE(bufoff, gbase, v0, v1) do { \
        __builtin_amdgcn_global_load_lds((const unsigned*)((const char*)(gbase) + (v0)), (LAS unsigned*)(lds + (bufoff) + ldsw), 16, 0, 0); \
        __builtin_amdgcn_global_load_lds((const unsigned*)((const char*)(gbase) + (v1)), (LAS unsigned*)(lds + (bufoff) + ldsw + 8192), 16, 0, 0); } while (0)
#define G2_LDA(dst, b, h) do { _Pragma("unroll") for (int m = 0; m < 4; ++m) _Pragma("unroll") for (int k = 0; k < 2; ++k) dst[m][k] = *(const LAS bf16x8*)(lds + G2_SA(b, h) + aoff + m * 2048 + k * 1024); } while (0)
#define G2_LDB(dst, b, h) do { _Pragma("unroll") for (int n = 0; n < 2; ++n) _Pragma("unroll") for (int k = 0; k < 2; ++k) dst[n][k] = *(const LAS bf16x8*)(lds + G2_SB(b, h) + boff + n * 2048 + k * 1024); } while (0)
#define G2_MMA(ai, bj, At, Bt) do { __builtin_amdgcn_s_setprio(1); _Pragma("unroll") for (int m = 0; m < 4; ++m) _Pragma("unroll") for (int n = 0; n < 2; ++n) _Pragma("unroll") for (int k = 0; k < 2; ++k) { \
        if (Sched::FP8) { const i32x4 _b = __builtin_bit_cast(i32x4, Bt[n][k]), _a = __builtin_bit_cast(i32x4, At[m][k]);     \
            acc[(ai) * 4 + m][(bj) * 2 + n] = __builtin_amdgcn_mfma_f32_16x16x32_fp8_fp8(((long)(unsigned)_b[1] << 32) | (unsigned)_b[0], ((long)(unsigned)_a[1] << 32) | (unsigned)_a[0], acc[(ai) * 4 + m][(bj) * 2 + n], 0, 0, 0); \
            acc[(ai) * 4 + m][(bj) * 2 + n] = __builtin_amdgcn_mfma_f32_16x16x32_fp8_fp8(((long)(unsigned)_b[3] << 32) | (unsigned)_b[2], ((long)(unsigned)_a[3] << 32) | (unsigned)_a[2], acc[(ai) * 4 + m][(bj) * 2 + n], 0, 0, 0); } \
        else acc[(ai) * 4 + m][(bj) * 2 + n] = __builtin_amdgcn_mfma_f32_16x16x32_bf16(Bt[n][k], At[m][k], acc[(ai) * 4 + m][(bj) * 2 + n], 0, 0, 0); } __builtin_amdgcn_s_setprio(0); } while (0)
#define G2_WAIT_V(n) asm volatile("s_waitcnt vmcnt(" #n ")" ::: "memory")
#define G2_WAIT_L(n) asm volatile("s_waitcnt lgkmcnt(" #n ")" ::: "memory")
#define G2_BAR __builtin_amdgcn_s_barrier()
#define G2_SCHED __builtin_amdgcn_sched_barrier(0)
#define G2_VOFFA(U, dst) do { _Pragma("unroll") for (int _h = 0; _h < 2; ++_h) _Pragma("unroll") for (int _i = 0; _i < 2; ++_i) { const int _row = _h * 128 + sR[_i]; \
        int _tok = _row; if (Sched::GATHER) _tok = (_row < (U).valid) ? (U).ridx[_row] : 0; dst[_h][_i] = (unsigned)(_tok * K + sC[_i]) * 2u; } } while (0)
    Unit<Epi> cur, nxt; int ui = 0;
    if (!S.get(0, cur)) return;
    f32x4 acc[8][4];
#pragma unroll
    for (int i = 0; i < 8; ++i)
#pragma unroll
        for (int j = 0; j < 4; ++j) acc[i][j] = (f32x4){0.f, 0.f, 0.f, 0.f};
    bf16x8 At[4][2], B0[2][2], B1[2][2];
    unsigned cvA[2][2], nvA[2][2];
    G2_VOFFA(cur, cvA);
    const char* cA = (const char*)cur.A; const char* cB0 = (const char*)cur.B0; const char* cB1 = (const char*)cur.B1;
    G2_STAGE(G2_SB(0, 0), cB0, voffB[0], voffB[1]); G2_STAGE(G2_SB(0, 1), cB1, voffB[0], voffB[1]); G2_STAGE(G2_SA(0, 0), cA, cvA[0][0], cvA[0][1]); G2_STAGE(G2_SA(0, 1), cA, cvA[1][0], cvA[1][1]);
    if (wr == 1) G2_BAR;
    G2_WAIT_V(2); G2_BAR;
    G2_STAGE(G2_SB(1, 0), cB0 + kstep, voffB[0], voffB[1]); G2_STAGE(G2_SA(1, 0), cA + kstep, cvA[0][0], cvA[0][1]); G2_STAGE(G2_SB(1, 1), cB1 + kstep, voffB[0], voffB[1]);
    G2_WAIT_V(6); G2_BAR;
    for (;;) {
        const bool has_next = S.get(ui + 1, nxt);
        if (Sched::GATHER) {
            if (has_next) { G2_VOFFA(nxt, nvA); }
            else {
#pragma unroll
                for (int h = 0; h < 2; ++h) { nvA[h][0] = cvA[h][0]; nvA[h][1] = cvA[h][1]; } }
        }
        const char* nA = has_next ? (const char*)nxt.A : cA; const char* nB0 = has_next ? (const char*)nxt.B0 : cB0; const char* nB1 = has_next ? (const char*)nxt.B1 : cB1;
#pragma unroll 1
        for (int t = 0; t < nt; t += 2) {
            const bool last = (t == nt - 2);
            const char* a1 = cA + (size_t)(t + 1) * kstep;
            const char* a2 = last ? nA : cA + (size_t)(t + 2) * kstep;
            const char* b20 = last ? nB0 : cB0 + (size_t)(t + 2) * kstep; const char* b21 = last ? nB1 : cB1 + (size_t)(t + 2) * kstep;
#define x00 ((Sched::GATHER && last) ? nvA[0][0] : cvA[0][0])
#define x01 ((Sched::GATHER && last) ? nvA[0][1] : cvA[0][1])
#define x10 ((Sched::GATHER && last) ? nvA[1][0] : cvA[1][0])
#define x11 ((Sched::GATHER && last) ? nvA[1][1] : cvA[1][1])
            G2_LDB(B0, 0, 0); G2_LDB(B1, 0, 1); G2_SCHED; G2_LDA(At, 0, 0); G2_STAGE(G2_SA(1, 1), a1, cvA[1][0], cvA[1][1]);
            G2_WAIT_V(8); G2_WAIT_L(0); G2_BAR; G2_MMA(0, 0, At, B0); G2_MMA(0, 1, At, B1); G2_BAR; G2_SCHED;
            G2_LDA(At, 0, 1); G2_STAGE(G2_SB(0, 0), b20, voffB[0], voffB[1]); G2_STAGE(G2_SB(0, 1), b21, voffB[0], voffB[1]); G2_STAGE(G2_SA(0, 0), a2, x00, x01);
            G2_WAIT_V(8); G2_WAIT_L(0); G2_BAR; G2_MMA(1, 0, At, B0); G2_MMA(1, 1, At, B1); G2_BAR; G2_SCHED;
            G2_LDB(B0, 1, 0); G2_LDB(B1, 1, 1); G2_SCHED; G2_LDA(At, 1, 0); G2_STAGE(G2_SA(0, 1), a2, x10, x11);
            G2_WAIT_V(8); G2_WAIT_L(0); G2_BAR; G2_MMA(0, 0, At, B0); G2_MMA(0, 1, At, B1); G2_BAR; G2_SCHED;
            G2_LDA(At, 1, 1); G2_STAGE(G2_SB(1, 0), b20 + kstep, voffB[0], voffB[1]); G2_STAGE(G2_SB(1, 1), b21 + kstep, voffB[0], voffB[1]); G2_STAGE(G2_SA(1, 0), a2 + kstep, x00, x01);
            G2_WAIT_V(8); G2_WAIT_L(0); G2_BAR; G2_MMA(1, 0, At, B0); G2_MMA(1, 1, At, B1); G2_BAR; G2_SCHED;
        }
        if (wr == 0) G2_BAR;
        { Lay lay; int rbv = wr * 64 + fr, cbv = wc * 32 + 8 * fq; asm volatile("" : "+v"(rbv), "+v"(cbv));
          lay.rbase = rbv; lay.cbase = cbv; cur.epi.run(acc, lay); }
        if (!has_next) break;
#pragma unroll
        for (int i = 0; i < 8; ++i)
#pragma unroll
            for (int j = 0; j < 4; ++j) acc[i][j] = (f32x4){0.f, 0.f, 0.f, 0.f};
        cur = nxt; cA = nA; cB0 = nB0; cB1 = nB1; ++ui;
        if (wr == 1) G2_BAR;
        if (Sched::GATHER) {
#pragma unroll
            for (int h = 0; h < 2; ++h) { cvA[h][0] = nvA[h][0]; cvA[h][1] = nvA[h][1]; } }
    }
#undef x00
#undef x01
#undef x10
#undef x11
    G2_WAIT_V(0);
    G2_BAR;
#undef G2_SA
#undef G2_SB
#undef G2_STAGE
#undef G2_LDA
#undef G2_LDB
#undef G2_MMA
#undef G2_WAIT_V
#undef G2_WAIT_L
#undef G2_BAR
#undef G2_SCHED
#undef G2_VOFFA
}
}

struct EpiF32 {
    float* C; int ld;
    template <class L> __device__ __forceinline__ void run(const f32x4 (&acc)[L::NI][L::NJ], const L& lay) const {
#pragma unroll
        for (int i = 0; i < L::NI; ++i)
#pragma unroll
            for (int j = 0; j < L::NJ; ++j) *(f32x4*)(C + (size_t)lay.row(i) * ld + lay.col(j)) = acc[i][j];
    }
};
struct EpiBf16 {
    bf16_t* C; int ld; float scale;
    template <class L> __device__ __forceinline__ void run(const f32x4 (&acc)[L::NI][L::NJ], const L& lay) const {
#pragma unroll
        for (int i = 0; i < L::NI; ++i) {
            if (L::PAIR8) {
#pragma unroll
                for (int j = 0; j < L::NJ; j += 2) { const f32x4 p = acc[i][j] * scale, q = acc[i][j + 1] * scale; u32x4 w; w.x = pack2(p[0], p[1]); w.y = pack2(p[2], p[3]); w.z = pack2(q[0], q[1]); w.w = pack2(q[2], q[3]);
                    *(u32x4*)(C + (size_t)lay.row(i) * ld + lay.col(j)) = w; }
            } else {
#pragma unroll
                for (int j = 0; j < L::NJ; ++j) { const f32x4 p = acc[i][j] * scale; u32x2 w; w.x = pack2(p[0], p[1]); w.y = pack2(p[2], p[3]);
                    *(u32x2*)(C + (size_t)lay.row(i) * ld + lay.col(j)) = w; }
            }
        }
    }
};
struct EpiFp8 {
    unsigned char* C; int ld; float scale;
    template <class L> __device__ __forceinline__ void run(const f32x4 (&acc)[L::NI][L::NJ], const L& lay) const {
        static_assert(L::PAIR8, "written for the paired-column layout");
#pragma unroll
        for (int i = 0; i < L::NI; ++i)
#pragma unroll
            for (int j = 0; j < L::NJ; j += 2) { const f32x4 p = acc[i][j] * scale, q = acc[i][j + 1] * scale; u32x2 w; w.x = pack4_fp8(p[0], p[1], p[2], p[3]); w.y = pack4_fp8(q[0], q[1], q[2], q[3]);
                *(u32x2*)(C + (size_t)lay.row(i) * ld + lay.col(j)) = w; }
    }
};
struct EpiGateUp8 {
    unsigned char* C; int ld;
    template <class L> __device__ __forceinline__ void run(const f32x4 (&acc)[L::NI][L::NJ], const L& lay) const {
        static_assert(L::PAIR8 && L::NJ == 4, "written for the paired-column 256x256 layout");
#pragma unroll
        for (int i = 0; i < L::NI; ++i) {
            const f32x4 g0 = acc[i][0] * (1.0f / 32.0f), g1 = acc[i][1] * (1.0f / 32.0f), u0 = acc[i][2] * (1.0f / 32.0f), u1 = acc[i][3] * (1.0f / 32.0f);
            u32x2 w; w.x = pack4_fp8(silu_f(g0[0]) * u0[0], silu_f(g0[1]) * u0[1], silu_f(g0[2]) * u0[2], silu_f(g0[3]) * u0[3]);
            w.y = pack4_fp8(silu_f(g1[0]) * u1[0], silu_f(g1[1]) * u1[1], silu_f(g1[2]) * u1[2], silu_f(g1[3]) * u1[3]);
            *(u32x2*)(C + (size_t)lay.row(i) * ld + lay.col(0)) = w;
        }
    }
};
struct EpiGateUp {
    bf16_t* C; int ld;
    template <class L> __device__ __forceinline__ void run(const f32x4 (&acc)[L::NI][L::NJ], const L& lay) const {
#pragma unroll
        for (int i = 0; i < L::NI; ++i) {
            if (L::PAIR8 && L::NJ == 4) {
                const f32x4 g0 = acc[i][0], g1 = acc[i][1], u0 = acc[i][2], u1 = acc[i][3];
                u32x4 w; w.x = pack2(silu_f(g0[0]) * u0[0], silu_f(g0[1]) * u0[1]); w.y = pack2(silu_f(g0[2]) * u0[2], silu_f(g0[3]) * u0[3]);
                w.z = pack2(silu_f(g1[0]) * u1[0], silu_f(g1[1]) * u1[1]); w.w = pack2(silu_f(g1[2]) * u1[2], silu_f(g1[3]) * u1[3]);
                *(u32x4*)(C + (size_t)lay.row(i) * ld + lay.col(0)) = w;
            } else {
#pragma unroll
                for (int j = 0; j < L::NJ / 2; ++j) { const f32x4 gt = acc[i][j], up = acc[i][j + L::NJ / 2];
                    u32x2 w; w.x = pack2(silu_f(gt[0]) * up[0], silu_f(gt[1]) * up[1]); w.y = pack2(silu_f(gt[2]) * up[2], silu_f(gt[3]) * up[3]);
                    *(u32x2*)(C + (size_t)lay.row(i) * ld + lay.col(j)) = w; }
            }
        }
    }
};
struct EpiInProj {
    bf16_t* Zt;
    bf16_t* tF;
    bf16_t* tV;
    int n0, pos0, n;
    template <class L> __device__ __forceinline__ void run(const f32x4 (&acc)[L::NI][L::NJ], const L& lay) const {
        static_assert(L::PAIR8, "written for the paired-column layout");
#pragma unroll
        for (int i = 0; i < L::NI; ++i)
#pragma unroll
            for (int j = 0; j < L::NJ; j += 2) {
                const int r = lay.row(i), cl = lay.col(j), c = n0 + cl;
                const f32x4 v0 = acc[i][j], v1 = acc[i][j + 1];
                if (c < 512) {
                    const int part = c >> 8, ch = c & 255;
#pragma unroll
                    for (int e = 0; e < 4; ++e) { tF[((size_t)(ch + e) * 2 + part) * n + pos0 + r] = f2bf(v0[e]); tF[((size_t)(ch + 4 + e) * 2 + part) * n + pos0 + r] = f2bf(v1[e]); }
                } else {
                    u32x4 w; w.x = pack2(v0[0], v0[1]); w.y = pack2(v0[2], v0[3]); w.z = pack2(v1[0], v1[1]); w.w = pack2(v1[2], v1[3]);
                    *(u32x4*)(Zt + (size_t)r * ZC + cl) = w;
                    if (c >= 896 && c < 1024) {
#pragma unroll
                        for (int e = 0; e < 4; ++e) { tV[(size_t)(c - 896 + e) * n + pos0 + r] = f2bf(v0[e]); tV[(size_t)(c - 896 + 4 + e) * n + pos0 + r] = f2bf(v1[e]); }
                    }
                }
            }
    }
};

constexpr int U_ADA = 192, U_WIN = 2 * 16 * 28, U_WOUT = 2 * 16 * 16, U_SGU = 32, U_DFT = 256, U_ROPE = 1, U_EXP = 3 * 32 * 32;
constexpr int LDS_SIL = 0, LDS_RED = 20480, LDS_TILE = 32768, LDS_T64 = 49408, LDS_CTAB = 50176;

__device__ __forceinline__ void ada_unit(AP a, unsigned char* lds, int u) {
    float* sil = (float*)(lds + LDS_SIL); float* red = (float*)(lds + LDS_RED);
    const int tid = tid_opaque(), lane = tid & 63, w = tid >> 6;
    const int l = u / 96, cg = u % 96;
    for (int i = tid; i < 5120; i += NT) { const int r = i >> 10, k = i & 1023; const float v = (r < 4) ? a->in[1][r * 1024 + k] : a->in[3][k]; sil[i] = v / (1.0f + expf(-v)); }
    __syncthreads();
    const float* W = a->in[4] + (size_t)l * 1024 * 6144 + cg * 64 + lane;
    float acc[5] = {0.f, 0.f, 0.f, 0.f, 0.f};
#pragma unroll 32
    for (int k = w * 128; k < w * 128 + 128; ++k) { const float wv = W[(size_t)k * 6144];
#pragma unroll
        for (int r = 0; r < 5; ++r) acc[r] += sil[r * 1024 + k] * wv; }
#pragma unroll
    for (int r = 0; r < 5; ++r) red[(w * 5 + r) * 64 + lane] = acc[r];
    __syncthreads();
    if (tid < 320) { const int r = tid >> 6; float s = 0.f;
#pragma unroll
        for (int ww = 0; ww < 8; ++ww) s += red[(ww * 5 + r) * 64 + lane];
        const int j = cg * 64 + lane; ((float*)(a->ws + WS_MOD))[(size_t)(l * 5 + r) * 6144 + j] = s + a->in[5][l * 6144 + j]; }
    __syncthreads();
}

__device__ __forceinline__ void tile_store_T(const float* tile, bf16_t* dst, int ldd) {
    const int tid = tid_opaque(), n = tid >> 3, kc = tid & 7;
    u32x4 w;
    w.x = pack2(tile[(kc * 8 + 0) * 65 + n], tile[(kc * 8 + 1) * 65 + n]); w.y = pack2(tile[(kc * 8 + 2) * 65 + n], tile[(kc * 8 + 3) * 65 + n]);
    w.z = pack2(tile[(kc * 8 + 4) * 65 + n], tile[(kc * 8 + 5) * 65 + n]); w.w = pack2(tile[(kc * 8 + 6) * 65 + n], tile[(kc * 8 + 7) * 65 + n]);
    *(u32x4*)(dst + (size_t)n * ldd + kc * 8) = w;
}
__device__ __forceinline__ void tile_load(float* tile, const float* src, int lds_) {
    const int tid = tid_opaque();
#pragma unroll
    for (int i = 0; i < 2; ++i) { const int row = (tid >> 4) + 32 * i, c4 = (tid & 15) * 4; const f32x4 v = *(const f32x4*)(src + (size_t)row * lds_ + c4);
        tile[row * 65 + c4 + 0] = v[0]; tile[row * 65 + c4 + 1] = v[1]; tile[row * 65 + c4 + 2] = v[2]; tile[row * 65 + c4 + 3] = v[3]; }
}

__device__ __forceinline__ void mm64_f32(const float* tA, int lda, const float* tB, int ldb, int K, float* out) {
    const int tid = tid_opaque(), lane = tid & 63, w = tid >> 6, fr = lane & 15, g = lane >> 4, mi = w >> 1, nj = 2 * (w & 1);
    f32x4 acc0 = (f32x4){0.f, 0.f, 0.f, 0.f}, acc1 = (f32x4){0.f, 0.f, 0.f, 0.f};
    const float* pa = tA + (16 * mi + fr) * lda + g; const float* pb = tB + g * ldb + 16 * nj + fr;
#pragma unroll 4
    for (int k0 = 0; k0 < K; k0 += 4) { const float av = pa[k0], b0 = pb[k0 * ldb], b1 = pb[k0 * ldb + 16];
        acc0 = __builtin_amdgcn_mfma_f32_16x16x4f32(av, b0, acc0, 0, 0, 0); acc1 = __builtin_amdgcn_mfma_f32_16x16x4f32(av, b1, acc1, 0, 0, 0); }
#pragma unroll
    for (int r = 0; r < 4; ++r) { out[(16 * mi + 4 * g + r) * 65 + 16 * nj + fr] = acc0[r]; out[(16 * mi + 4 * g + r) * 65 + 16 * nj + 16 + fr] = acc1[r]; }
}

__device__ __forceinline__ void win_unit(AP a, unsigned char* lds, int u) {
    float* tile = (float*)(lds + LDS_TILE); float* T = (float*)(lds + LDS_T64);
    const int tid = tid_opaque();
    const int l = u / 448, r = u % 448, kb = r / 28, nb = r % 28;
    const float* Win = a->in[6] + (size_t)l * 1024 * 1536;
    const int srccol = (nb >= 8) ? nb * 64 - 256 : (nb & 3) * 64;
    tile_load(tile, Win + (size_t)(kb * 64) * 1536 + srccol, 1536);
    if (nb < 8 && tid < 64) { T[tid] = cospif((float)tid / 32.0f); T[64 + tid] = sinpif((float)tid / 32.0f); }
    __syncthreads();
    bf16_t* dst = (bf16_t*)(a->ws + WS_WIN) + ((size_t)l * ZC + nb * 64) * 1024 + kb * 64;
    if (nb >= 8) tile_store_T(tile, dst, 1024);
    else {
        const int part = nb >> 2;
        float* Tm = (float*)(lds + 65536); float* out = (float*)(lds + 98304);
        for (int i = tid; i < 4096; i += NT) { const int c = i >> 6, cp = i & 63; const float t = T[part * 64 + ((c * cp) & 63)]; Tm[i] = (part ? -t : t) * 0.125f; }
        __syncthreads();
        mm64_f32(tile, 65, Tm, 64, 64, out);
        __syncthreads();
        tile_store_T(out, dst, 1024);
    }
    __syncthreads();
}

__device__ __forceinline__ void wout_unit(AP a, unsigned char* lds, int u) {
    float* tile = (float*)(lds + LDS_TILE);
    __syncthreads();
    const int tid = tid_opaque();
    const int l = u / 256, r = u % 256, kb = r / 16, nb = r % 16;
    const float* Wo = a->in[13] + (size_t)l * 1024 * 1024;
    const int n = tid & 63, kq = __builtin_amdgcn_readfirstlane(tid >> 6);
    if (kb < 4) {
        float* tA = (float*)lds; float* tB = (float*)(lds + 65536);
        const float* wf = a->in[7] + (size_t)l * 256 * 256 + (size_t)(kb * 64) * 256;
        __syncthreads();
        f32x4 va[8], vb[8];
#pragma unroll
        for (int i = 0; i < 8; ++i) { const int q = tid + 512 * i; va[i] = *(const f32x4*)(wf + (size_t)q * 4); vb[i] = *(const f32x4*)(Wo + (size_t)(q >> 4) * 1024 + nb * 64 + (q & 15) * 4); }
#pragma unroll
        for (int i = 0; i < 8; ++i) { const int q = tid + 512 * i; *(f32x4*)(tA + (size_t)q * 4) = va[i]; *(f32x4*)(tB + (size_t)q * 4) = vb[i]; }
        __syncthreads();
        tile = (float*)(lds + 133120);
        mm64_f32(tA, 256, tB, 64, 256, tile);
    } else if (kb >= 8 && kb < 12) {
        const int g = kb - 8;
        float* tA = (float*)lds; float* tB = (float*)(lds + 65536);
        const float* wp = a->in[9] + (size_t)(l * 4 + g) * 64 * 64;
        const float* ps = a->in[10] + l * 256 + g * 64;
        f32x4 va[2], vb[2];
#pragma unroll
        for (int i = 0; i < 2; ++i) { const int q = tid + 512 * i; va[i] = *(const f32x4*)(wp + (size_t)q * 4); vb[i] = *(const f32x4*)(Wo + (size_t)(512 + g * 64 + (q >> 4)) * 1024 + nb * 64 + (q & 15) * 4) * ps[q >> 4]; }
#pragma unroll
        for (int i = 0; i < 2; ++i) { const int q = tid + 512 * i; *(f32x4*)(tA + (size_t)q * 4) = va[i]; *(f32x4*)(tB + (size_t)q * 4) = vb[i]; }
        __syncthreads();
        tile = (float*)(lds + 133120);
        mm64_f32(tA, 64, tB, 64, 64, tile);
    } else tile_load(tile, Wo + (size_t)(kb * 64) * 1024 + nb * 64, 1024);
    __syncthreads();
    tile_store_T(tile, (bf16_t*)(a->ws + WS_WOUT) + ((size_t)l * 1024 + nb * 64) * 1024 + kb * 64, 1024);
    __syncthreads();
}

__device__ __forceinline__ void exp_src_dst(AP a, int l, int u, const float*& src, int& srcld, unsigned char*& dst, int& dstld) {
    const int mat = u / 1024, e = (u % 1024) / 32, t = u % 32;
    const int kb = (mat < 2) ? t / 4 : t / 8, nb = (mat < 2) ? t % 4 : t % 8;
    srcld = (mat < 2) ? 512 : 1024; dstld = (mat < 2) ? 1024 : 512;
    src = a->in[18 + mat] + ((size_t)(l * 32 + e) * 512 * 1024) + (size_t)(kb * 128) * srcld + nb * 128;
    dst = a->ws + WS_WEXP + (size_t)l * WEXP_LAYER + (size_t)mat * EXPMAT + (size_t)e * 512 * 1024 + (size_t)(nb * 128) * dstld + kb * 128;
}
#define EXP_LOAD(vv, uu) do { exp_src_dst(a, l, (uu), src, srcld, dst, dstld); _Pragma("unroll") for (int _i = 0; _i < 8; ++_i) vv[_i] = *(const f32x4*)(src + (size_t)((tid >> 5) + 16 * _i) * srcld + (tid & 31) * 4); } while (0)
#define EXP_PUT(vv) do { _Pragma("unroll") for (int _i = 0; _i < 8; ++_i) *(f32x4*)(tile + ((tid >> 5) + 16 * _i) * 132 + (tid & 31) * 4) = vv[_i] * 32.0f; } while (0)
#define EXP_STORE(dd, ld_) do { const int n = tid & 127, kq = tid >> 7;        \
        _Pragma("unroll") for (int j = 0; j < 2; ++j) { const float* tp = tile + (kq * 32 + j * 16) * 132 + n; u32x4 w; \
        w.x = pack4_fp8(tp[0], tp[132], tp[2 * 132], tp[3 * 132]); w.y = pack4_fp8(tp[4 * 132], tp[5 * 132], tp[6 * 132], tp[7 * 132]); \
        w.z = pack4_fp8(tp[8 * 132], tp[9 * 132], tp[10 * 132], tp[11 * 132]); w.w = pack4_fp8(tp[12 * 132], tp[13 * 132], tp[14 * 132], tp[15 * 132]); \
        *(u32x4*)((dd) + (size_t)n * (ld_) + kq * 32 + j * 16) = w; } } while (0)
__device__ __forceinline__ void exp_range(AP a, unsigned char* lds, int l, int u0, int u_end) {
    float* tile = (float*)lds;
    const int tid = tid_opaque();
    __syncthreads();
    if (u0 >= u_end) return;
    const float* src; unsigned char* dst; int srcld, dstld;
    f32x4 va[8], vb[8];
    unsigned char *da, *db = nullptr; int lda_, ldb_ = 0;
    EXP_LOAD(va, u0); da = dst; lda_ = dstld;
    if (u0 + 1 < u_end) { EXP_LOAD(vb, u0 + 1); db = dst; ldb_ = dstld; }
    for (int u = u0; u < u_end; u += 2) {
        EXP_PUT(va);
        __syncthreads();
        { unsigned char* cd = da; const int cl = lda_; if (u + 2 < u_end) { EXP_LOAD(va, u + 2); da = dst; lda_ = dstld; } EXP_STORE(cd, cl); }
        __syncthreads();
        if (u + 1 < u_end) {
            EXP_PUT(vb);
            __syncthreads();
            { unsigned char* cd = db; const int cl = ldb_; if (u + 3 < u_end) { EXP_LOAD(vb, u + 3); db = dst; ldb_ = dstld; } EXP_STORE(cd, cl); }
            __syncthreads();
        }
    }
}
#undef EXP_LOAD
#undef EXP_PUT
#undef EXP_STORE
__device__ __forceinline__ void exp_queue(AP a, unsigned char* lds, int l) {
    const int tid = tid_opaque();
    int* qslot = (int*)(lds + MISC_OFF + 128);
    unsigned* qc = (unsigned*)(a->ws + WS_BAR + 14336 + l * 256);
    for (;;) {
        __syncthreads();
        if (tid == 0) *qslot = (int)__hip_atomic_fetch_add(qc, 2u, __ATOMIC_RELAXED, __HIP_MEMORY_SCOPE_AGENT);
        __syncthreads();
        const int c0 = *qslot;
        if (c0 >= U_EXP) break;
        exp_range(a, lds, l, c0, c0 + 2);
    }
}

__device__ __forceinline__ void exp_fill(AP a, unsigned char* lds, int ql, int budget) {
    const int tid = tid_opaque();
    int* qslot = (int*)(lds + MISC_OFF + 128);
    unsigned* qc = (unsigned*)(a->ws + WS_BAR + 14336 + ql * 256);
    for (int done = 0; done < budget; done += 2) {
        __syncthreads();
        if (tid == 0) *qslot = (int)__hip_atomic_fetch_add(qc, 2u, __ATOMIC_RELAXED, __HIP_MEMORY_SCOPE_AGENT);
        __syncthreads();
        const int c0 = *qslot;
        if (c0 >= U_EXP) break;
        exp_range(a, lds, ql, c0, c0 + 2);
    }
    __syncthreads();
}

__device__ __forceinline__ void p0_prologue(AP a, unsigned char* lds) {
    const int tid = tid_opaque();
    bool have_tab = false;
    constexpr int E0 = U_ADA, E1 = E0 + U_WIN, E2 = E1 + U_WOUT, E3 = E2 + U_SGU, E4 = E3 + U_DFT, E5 = E4 + U_ROPE;
    int u = blockIdx.x;
    for (; u < E5; u += gridDim.x) {
        if (u < E0) ada_unit(a, lds, u);
        else if (u < E1) win_unit(a, lds, u - E0);
        else if (u < E2) wout_unit(a, lds, u - E1);
        else if (u < E3) { const size_t i0 = (size_t)(u - E2) * 4096 + tid * 8; const float* s = a->in[11] + i0; bf16_t* d = (bf16_t*)(a->ws + WS_WSGU) + i0;
            const f32x4 v0 = *(const f32x4*)s, v1 = *(const f32x4*)(s + 4); u32x4 w; w.x = pack2(v0[0], v0[1]); w.y = pack2(v0[2], v0[3]); w.z = pack2(v1[0], v1[1]); w.w = pack2(v1[2], v1[3]); *(u32x4*)d = w; }
        else if (u < E4) {
            float* ctab = (float*)(lds + LDS_CTAB);
            if (!have_tab) { for (int i = tid; i < 4096; i += NT) ctab[i] = cospif((float)i / 2048.0f); __syncthreads(); have_tab = true; }
            const int k = u - E3 + 4096;
            if (tid < 32) {
                const int kk = k - 4096, n0 = tid * 8; float c[8], s[8];
#pragma unroll
                for (int e = 0; e < 8; ++e) { const int idx = ((kk * (n0 + e)) & 255) * 16; c[e] = ctab[idx] * (1.0f / 16.0f); s[e] = ctab[(idx - 1024) & 4095] * (1.0f / 16.0f); }
                bf16_t* d = (bf16_t*)(a->ws + WS_DFTC) + (size_t)kk * 512 + n0;
                u32x4 w; w.x = pack2(c[0], c[1]); w.y = pack2(c[2], c[3]); w.z = pack2(c[4], c[5]); w.w = pack2(c[6], c[7]); *(u32x4*)d = w;
                w.x = pack2(s[0], s[1]); w.y = pack2(s[2], s[3]); w.z = pack2(s[4], s[5]); w.w = pack2(s[6], s[7]); *(u32x4*)(d + 256) = w;
            }
        }
        else {
            for (int i = tid; i < 1024; i += NT) { const int pos = i >> 4, f = i & 15; const float freq = powf(10000.0f, -(float)f / 16.0f); const float ang = (float)pos * freq;
                ((float2*)(a->ws + WS_ROPE))[i] = make_float2(cosf(ang), sinf(ang)); }
        }
    }
}

__device__ __forceinline__ void p_lnmod0(AP a) {
    const int tid = tid_opaque(), lane = tid & 63, w = tid >> 6;
    const float* mod = (const float*)(a->ws + WS_MOD);
    bf16_t* H = (bf16_t*)(a->ws + WS_H);
    const int tstep = gridDim.x * 8;
    f32x4 nx[4];
    { const int t = blockIdx.x * 8 + w; if (t < NTOK) { const float* src = (t < NLAT) ? a->in[0] + (size_t)t * D : a->in[2] + (size_t)(t - NLAT) * D;
#pragma unroll
        for (int i = 0; i < 4; ++i) nx[i] = *(const f32x4*)(src + 256 * i + 4 * lane); } }
    int mrow = -1; f32x4 msh[4], msc[4];
    for (int t = blockIdx.x * 8 + w; t < NTOK; t += tstep) {
        const int mr = (t < NLAT) ? (t >> 12) : 4;
        if (mr != mrow) { mrow = mr; const float* m = mod + (size_t)mr * 6144;
#pragma unroll
            for (int i = 0; i < 4; ++i) { msh[i] = *(const f32x4*)(m + 256 * i + 4 * lane); msc[i] = *(const f32x4*)(m + 1024 + 256 * i + 4 * lane); } }
        f32x4 v[4];
#pragma unroll
        for (int i = 0; i < 4; ++i) v[i] = nx[i];
        { const int tn = t + tstep; if (tn < NTOK) { const float* src = (tn < NLAT) ? a->in[0] + (size_t)tn * D : a->in[2] + (size_t)(tn - NLAT) * D;
#pragma unroll
            for (int i = 0; i < 4; ++i) nx[i] = *(const f32x4*)(src + 256 * i + 4 * lane); } }
        float mean, rstd; ln_stats(v, mean, rstd);
#pragma unroll
        for (int i = 0; i < 4; ++i) { const int c = 256 * i + 4 * lane;
            f32x4 o;
#pragma unroll
            for (int e = 0; e < 4; ++e) o[e] = (v[i][e] - mean) * rstd * (1.0f + msc[i][e]) + msh[i][e];
            u32x2 pk; pk.x = pack2(o[0], o[1]); pk.y = pack2(o[2], o[3]); *(u32x2*)(H + (size_t)t * D + c) = pk; }
    }
}

__device__ __forceinline__ void p1_inproj(AP a, unsigned char* smem, LAS unsigned char* lds, int l);
__device__ __forceinline__ u32x4 ld16g(const bf16_t* p) { return *(const u32x4*)p; }
__device__ __forceinline__ void rope_pack8(u32x4& wl, u32x4& wh, const LAS f32x2* tab, bool do_rope, float scale) {
    float tl[8] = {lo2f(wl.x), hi2f(wl.x), lo2f(wl.y), hi2f(wl.y), lo2f(wl.z), hi2f(wl.z), lo2f(wl.w), hi2f(wl.w)};
    float th[8] = {lo2f(wh.x), hi2f(wh.x), lo2f(wh.y), hi2f(wh.y), lo2f(wh.z), hi2f(wh.z), lo2f(wh.w), hi2f(wh.w)};
#pragma unroll
    for (int j = 0; j < 8; ++j) {
        float r1 = tl[j], r2 = th[j];
        if (do_rope) { const f32x2 cs = tab[j]; r1 = tl[j] * cs.x - th[j] * cs.y; r2 = tl[j] * cs.y + th[j] * cs.x; }
        tl[j] = r1 * scale; th[j] = r2 * scale;
    }
    wl.x = pack2(tl[0], tl[1]); wl.y = pack2(tl[2], tl[3]); wl.z = pack2(tl[4], tl[5]); wl.w = pack2(tl[6], tl[7]);
    wh.x = pack2(th[0], th[1]); wh.y = pack2(th[2], th[3]); wh.z = pack2(th[4], th[5]); wh.w = pack2(th[6], th[7]);
}

__device__ __forceinline__ void mixer_sgu_pool(AP a, LAS unsigned char* lds, int l, int row0, int seq_row0, int pos0, int n) {
    typedef short s16x4 __attribute__((ext_vector_type(4)));
    const int tid = tid_opaque(), lane = tid & 63, w = __builtin_amdgcn_readfirstlane(tid >> 6), fr = lane & 15, g = lane >> 4;
    const bf16_t* Z = (const bf16_t*)(a->ws + WS_Z);
    bf16_t* CAT = (bf16_t*)(a->ws + WS_CAT);
    constexpr int VOFF = 73728;
    u32x4 pr[9];
#pragma unroll
    for (int it = 0; it < 9; ++it) { const int id = tid + 512 * it, rr = id >> 5, ch = id & 31, j = pos0 - 8 + rr;
        pr[it] = (u32x4){0u, 0u, 0u, 0u};
        if (j >= 0 && j < n) pr[it] = ld16g(Z + (size_t)(seq_row0 + j) * ZC + 1024 + ch * 8); }
    bf16x8 wfrag[4][4];
    {   const int h = w >> 1, ph = w & 1; const bf16_t* Ws = (const bf16_t*)(a->ws + WS_WSGU) + (size_t)(l * 4 + h) * 128 * 128;
#pragma unroll
        for (int ks = 0; ks < 4; ++ks)
#pragma unroll
            for (int pf = 0; pf < 4; ++pf) wfrag[ks][pf] = *(const bf16x8*)(Ws + (size_t)(ph * 64 + 16 * pf + fr) * 128 + 32 * ks + 8 * g); }
    u32x4 gw[4][2];
#pragma unroll
    for (int ps = 0; ps < 4; ++ps) { const int q = w * 16 + ps * 4 + g; const bf16_t* src = Z + (size_t)(row0 + q) * ZC + 1536 + 16 * fr; gw[ps][0] = ld16g(src); gw[ps][1] = ld16g(src + 8); }
#pragma unroll
    for (int it = 0; it < 9; ++it) { const int id = tid + 512 * it; *(LAS u32x4*)(lds + (id >> 5) * 512 + (id & 31) * 16) = pr[it]; }
#pragma unroll
    for (int ps = 0; ps < 4; ++ps) {
        const int q = w * 16 + ps * 4 + g;
        float gv[16];
#pragma unroll
        for (int hh = 0; hh < 2; ++hh) { const u32x4 x = gw[ps][hh];
            gv[8 * hh + 0] = gelu_erf(lo2f(x.x)); gv[8 * hh + 1] = gelu_erf(hi2f(x.x)); gv[8 * hh + 2] = gelu_erf(lo2f(x.y)); gv[8 * hh + 3] = gelu_erf(hi2f(x.y));
            gv[8 * hh + 4] = gelu_erf(lo2f(x.z)); gv[8 * hh + 5] = gelu_erf(hi2f(x.z)); gv[8 * hh + 6] = gelu_erf(lo2f(x.w)); gv[8 * hh + 7] = gelu_erf(hi2f(x.w)); }
        float sm = 0.f;
#pragma unroll
        for (int e = 0; e < 16; ++e) sm += gv[e];
        const float mean = row_sum16(sm) * (1.0f / 256.0f);
        float qq = 0.f;
#pragma unroll
        for (int e = 0; e < 16; ++e) { const float d = gv[e] - mean; qq += d * d; }
        const float rstd = 1.0f / sqrtf(row_sum16(qq) * (1.0f / 256.0f) + 1e-6f);
        u32x4 o0, o1;
        o0.x = pack2((gv[0] - mean) * rstd, (gv[1] - mean) * rstd); o0.y = pack2((gv[2] - mean) * rstd, (gv[3] - mean) * rstd); o0.z = pack2((gv[4] - mean) * rstd, (gv[5] - mean) * rstd); o0.w = pack2((gv[6] - mean) * rstd, (gv[7] - mean) * rstd);
        o1.x = pack2((gv[8] - mean) * rstd, (gv[9] - mean) * rstd); o1.y = pack2((gv[10] - mean) * rstd, (gv[11] - mean) * rstd); o1.z = pack2((gv[12] - mean) * rstd, (gv[13] - mean) * rstd); o1.w = pack2((gv[14] - mean) * rstd, (gv[15] - mean) * rstd);
        const int sg = fr ^ ((q & 3) | (((q >> 3) & 1) << 2));
        *(LAS u32x4*)(lds + VOFF + q * 512 + sg * 32) = o0; *(LAS u32x4*)(lds + VOFF + q * 512 + sg * 32 + 16) = o1;
    }
    __syncthreads();
    {
        const int c = tid & 255, half = tid >> 8, hw = 1 << (c >> 6);
        const LAS bf16_t* P = (const LAS bf16_t*)lds + c;
        const int t0 = half * 64;
        const float invfull = 1.0f / (float)(2 * hw);
        float s = 0.f;
        for (int j = t0 - hw; j < t0 + hw; ++j) s += bf2f(P[(8 + j) * 256]);
        for (int tl = t0; tl < t0 + 64; ++tl) {
            const int pos = pos0 + tl; const int cntw = min(pos + hw, n) - max(pos - hw, 0);
            const float inv = (cntw == 2 * hw) ? invfull : 1.0f / (float)cntw;
            CAT[(size_t)(row0 + tl) * D + 512 + c] = f2bf(s * inv - bf2f(P[(8 + tl) * 256]));
            s += bf2f(P[(8 + tl + hw) * 256]) - bf2f(P[(8 + tl - hw) * 256]);
        }
    }
    {
        const int h = w >> 1, ph = w & 1;
        const float* bs = a->in[12] + (size_t)(l * 4 + h) * 128;
        f32x4 acc[4][4];
#pragma unroll
        for (int i = 0; i < 4; ++i)
#pragma unroll
            for (int j = 0; j < 4; ++j) acc[i][j] = (f32x4){0.f, 0.f, 0.f, 0.f};
        const int qq4 = fr >> 2, p4 = fr & 3, fsw = qq4 | ((g & 1) << 2);
#pragma unroll
        for (int ks = 0; ks < 4; ++ks) {
            bf16x8 af[4];
            const int r0 = 32 * ks + 8 * g + qq4;
#pragma unroll
            for (int cf = 0; cf < 4; ++cf) { const int so = (((4 * h + cf) ^ fsw) << 5) + p4 * 8;
                const s16x4 lo = __builtin_amdgcn_ds_read_tr16_b64_v4i16((LAS s16x4*)(lds + VOFF + r0 * 512 + so));
                const s16x4 hi = __builtin_amdgcn_ds_read_tr16_b64_v4i16((LAS s16x4*)(lds + VOFF + (r0 + 4) * 512 + so));
                af[cf] = __builtin_shufflevector(lo, hi, 0, 1, 2, 3, 4, 5, 6, 7); }
#pragma unroll
            for (int cf = 0; cf < 4; ++cf)
#pragma unroll
                for (int pf = 0; pf < 4; ++pf) acc[cf][pf] = __builtin_amdgcn_mfma_f32_16x16x32_bf16(af[cf], wfrag[ks][pf], acc[cf][pf], 0, 0, 0);
        }
#pragma unroll
        for (int pf = 0; pf < 4; ++pf) { const int p = ph * 64 + 16 * pf + fr; const float bias = bs[p];
#pragma unroll
            for (int cf = 0; cf < 4; ++cf) { const int c0 = h * 64 + 16 * cf + 4 * g;
                const u32x2 uw = *(const u32x2*)(Z + (size_t)(row0 + p) * ZC + 1280 + c0);
                u32x2 o; o.x = pack2(gelu_erf(lo2f(uw.x)) * (acc[cf][pf][0] + bias), gelu_erf(hi2f(uw.x)) * (acc[cf][pf][1] + bias));
                o.y = pack2(gelu_erf(lo2f(uw.y)) * (acc[cf][pf][2] + bias), gelu_erf(hi2f(uw.y)) * (acc[cf][pf][3] + bias));
                *(u32x2*)(CAT + (size_t)(row0 + p) * D + 768 + c0) = o; } }
    }
    __syncthreads();
}

__device__ __forceinline__ void mixer_attn(AP a, LAS unsigned char* lds, int l, int row0, int seq_row0, int pos0, int n, int b, bool is_ctx, int kvh) {
    const int tid = tid_opaque(), lane = tid & 63, w = __builtin_amdgcn_readfirstlane(tid >> 6), fr = lane & 15, g = lane >> 4;
    const bf16_t* Z = (const bf16_t*)(a->ws + WS_Z);
    bf16_t* CAT = (bf16_t*)(a->ws + WS_CAT);
    __syncthreads();
    ((LAS u32x4*)(lds + 98304))[tid] = ((const u32x4*)(a->ws + WS_ROPE))[tid];
    const LAS f32x2* rope = (const LAS f32x2*)(lds + 98304);
    constexpr float QS = 0.125f * 1.44269504088896341f;
    constexpr int QS_OFF = 0, KS_OFF = 32768, VS_OFF = 65536;
    const int nbq = pos0 >> 7;
    unsigned bmask = 0x18u;
    if (!is_ctx) { if (nbq > 0) bmask |= 1u; bmask |= 2u; if (nbq + 1 < (n >> 7)) bmask |= 4u; }
    const int kr = tid >> 2, kax = (tid >> 1) & 1, kh8 = tid & 1;
#define MX_KSRC(blk) (Z + (size_t)((((blk) < 3) ? seq_row0 + (nbq + (blk) - 1) * 128 : NLAT + b * 256 + ((blk) - 3) * 128) + kr) * ZC + 768 + kvh * 64 + kax * 32 + kh8 * 8)
#define MX_VSTAGE(blk, buf) do { const bool _band = (blk) < 3; const int _key0 = _band ? (nbq + (blk) - 1) * 128 : ((blk) - 3) * 128; \
        const bf16_t* _vs = _band ? (const bf16_t*)(a->ws + WS_VT) + (size_t)(b * 2 + kvh) * 64 * 4096 + _key0 : (const bf16_t*)(a->ws + WS_VTC) + (size_t)(b * 2 + kvh) * 64 * 256 + _key0; \
        const int _vld = _band ? 4096 : 256; \
        _Pragma("unroll") for (int _i = 0; _i < 2; ++_i) { const int _P = _i * 512 + tid, _d = _P >> 4, _c = (_P & 15) ^ (_d & 15); \
            glds16(_vs + (size_t)_d * _vld + _c * 8, lds + VS_OFF + (buf) * 16384 + _i * 8192 + w * 1024); } } while (0)
    {
        __syncthreads();
#pragma unroll
        for (int it = 0; it < 2; ++it) {
            const int item = tid + 512 * it, r = item >> 2, ax = (item >> 1) & 1, h8 = item & 1, i = r & 127, qpos = pos0 + i;
            const bf16_t* src = Z + (size_t)(row0 + i) * ZC + 512 + (2 * kvh + (r >> 7)) * 64 + ax * 32 + h8 * 8;
            u32x4 wl = ld16g(src), wh = ld16g(src + 16);
            rope_pack8(wl, wh, rope + (ax ? (qpos & 63) : (qpos >> 6)) * 16 + h8 * 8, !is_ctx, QS);
            const int ch = ax * 4 + h8, sw = (r >> 1) & 7;
            *(LAS u32x4*)(lds + QS_OFF + r * 128 + ((ch ^ sw) << 4)) = wl;
            *(LAS u32x4*)(lds + QS_OFF + r * 128 + (((ch + 2) ^ sw) << 4)) = wh;
        }
        const int hh = w >> 2, qb = (w & 3) * 32, h = 2 * kvh + hh;
        float m[2], lsum[2];
        m[0] = m[1] = a->in[8][l * 4 + h] * 1.44269504088896341f;
        lsum[0] = lsum[1] = (g == 0) ? 1.0f : 0.0f;
        f32x4 O[4][2];
#pragma unroll
        for (int i = 0; i < 4; ++i) { O[i][0] = (f32x4){0.f, 0.f, 0.f, 0.f}; O[i][1] = (f32x4){0.f, 0.f, 0.f, 0.f}; }
        bf16x8 Qf[2][2];
        bool have_q = false;
        unsigned rem = bmask;
        int cur = __builtin_ctz(rem); rem &= rem - 1u;
        int buf = 0;
        u32x4 kl = ld16g(MX_KSRC(cur)), kh = ld16g(MX_KSRC(cur) + 16);
        MX_VSTAGE(cur, 0);
#pragma unroll 1
        for (;;) {
            const int jb = cur - 1; const bool band = cur < 3;
            {
                const int kpos = (nbq + jb) * 128 + kr;
                rope_pack8(kl, kh, rope + (kax ? (kpos & 63) : (kpos >> 6)) * 16 + kh8 * 8, band, 1.0f);
                const int ch = kax * 4 + kh8, sw = (kr >> 1) & 7;
                *(LAS u32x4*)(lds + KS_OFF + buf * 16384 + kr * 128 + ((ch ^ sw) << 4)) = kl;
                *(LAS u32x4*)(lds + KS_OFF + buf * 16384 + kr * 128 + (((ch + 2) ^ sw) << 4)) = kh;
            }
            asm volatile("s_waitcnt vmcnt(0)" ::: "memory");
            __syncthreads();
            const int nxt = rem ? __builtin_ctz(rem) : -1; rem &= rem - 1u;
            if (nxt >= 0) { kl = ld16g(MX_KSRC(nxt)); kh = ld16g(MX_KSRC(nxt) + 16); MX_VSTAGE(nxt, buf ^ 1); }
            if (!have_q) {
#pragma unroll
                for (int qf = 0; qf < 2; ++qf)
#pragma unroll
                    for (int ks = 0; ks < 2; ++ks) { const int r = hh * 128 + qb + 16 * qf + fr; Qf[qf][ks] = *(const LAS bf16x8*)(lds + QS_OFF + r * 128 + (((4 * ks + g) ^ ((r >> 1) & 7)) << 4)); }
                have_q = true;
            }
            const int kso = KS_OFF + buf * 16384, vso = VS_OFF + buf * 16384;
            f32x4 S[8][2];
#pragma unroll
            for (int kf = 0; kf < 8; ++kf) { S[kf][0] = (f32x4){0.f, 0.f, 0.f, 0.f}; S[kf][1] = (f32x4){0.f, 0.f, 0.f, 0.f}; }
#pragma unroll
            for (int kf = 0; kf < 8; ++kf)
#pragma unroll
                for (int ks = 0; ks < 2; ++ks) { const int r = 16 * kf + fr;
                    const bf16x8 kfr = *(const LAS bf16x8*)(lds + kso + r * 128 + (((4 * ks + g) ^ ((r >> 1) & 7)) << 4));
                    S[kf][0] = __builtin_amdgcn_mfma_f32_16x16x32_bf16(kfr, Qf[0][ks], S[kf][0], 0, 0, 0);
                    S[kf][1] = __builtin_amdgcn_mfma_f32_16x16x32_bf16(kfr, Qf[1][ks], S[kf][1], 0, 0, 0); }
            bf16x8 Pp[4][2];
#pragma unroll
            for (int qf = 0; qf < 2; ++qf) {
                const int qi = qb + 16 * qf + fr;
                if (band && jb != 0) {
#pragma unroll
                    for (int kf = 0; kf < 8; ++kf)
#pragma unroll
                        for (int r = 0; r < 4; ++r) { const int kk = 16 * kf + 4 * g + r; const bool ok = (jb < 0) ? (kk >= qi) : (kk <= qi); if (!ok) S[kf][qf][r] = -1.0e30f; }
                }
                float mx = S[0][qf][0];
#pragma unroll
                for (int kf = 0; kf < 8; ++kf)
#pragma unroll
                    for (int r = 0; r < 4; ++r) mx = fmaxf(mx, S[kf][qf][r]);
                mx = fmaxf(mx, __shfl_xor(mx, 16)); mx = fmaxf(mx, __shfl_xor(mx, 32));
                const float mn = fmaxf(m[qf], mx), corr = __builtin_amdgcn_exp2f(m[qf] - mn);
                m[qf] = mn;
                float ps = 0.f;
#pragma unroll
                for (int kf = 0; kf < 8; ++kf)
#pragma unroll
                    for (int r = 0; r < 4; ++r) { const float p = __builtin_amdgcn_exp2f(S[kf][qf][r] - mn); S[kf][qf][r] = p; ps += p; }
                lsum[qf] = lsum[qf] * corr + ps;
#pragma unroll
                for (int df = 0; df < 4; ++df) O[df][qf] *= corr;
#pragma unroll
                for (int t = 0; t < 4; ++t) { u32x4 pw; pw.x = pack2(S[2 * t][qf][0], S[2 * t][qf][1]); pw.y = pack2(S[2 * t][qf][2], S[2 * t][qf][3]);
                    pw.z = pack2(S[2 * t + 1][qf][0], S[2 * t + 1][qf][1]); pw.w = pack2(S[2 * t + 1][qf][2], S[2 * t + 1][qf][3]); Pp[t][qf] = __builtin_bit_cast(bf16x8, pw); }
            }
#pragma unroll
            for (int t = 0; t < 4; ++t)
#pragma unroll
                for (int df = 0; df < 4; ++df) { const int d = 16 * df + fr;
                    const u32x2 v0 = *(const LAS u32x2*)(lds + vso + d * 256 + (((4 * t + (g >> 1)) ^ (d & 15)) << 4) + (g & 1) * 8);
                    const u32x2 v1 = *(const LAS u32x2*)(lds + vso + d * 256 + (((4 * t + 2 + (g >> 1)) ^ (d & 15)) << 4) + (g & 1) * 8);
                    u32x4 vw; vw.x = v0.x; vw.y = v0.y; vw.z = v1.x; vw.w = v1.y; const bf16x8 vf = __builtin_bit_cast(bf16x8, vw);
                    O[df][0] = __builtin_amdgcn_mfma_f32_16x16x32_bf16(vf, Pp[t][0], O[df][0], 0, 0, 0);
                    O[df][1] = __builtin_amdgcn_mfma_f32_16x16x32_bf16(vf, Pp[t][1], O[df][1], 0, 0, 0); }
            if (nxt < 0) break;
            cur = nxt; buf ^= 1;
        }
#pragma unroll
        for (int qf = 0; qf < 2; ++qf) {
            float lt = lsum[qf]; lt += __shfl_xor(lt, 16); lt += __shfl_xor(lt, 32);
            const float inv = 1.0f / lt;
            bf16_t* dst = CAT + (size_t)(row0 + qb + 16 * qf + fr) * D + 256 + h * 64 + 4 * g;
#pragma unroll
            for (int df = 0; df < 4; ++df) { u32x2 o; o.x = pack2(O[df][qf][0] * inv, O[df][qf][1] * inv); o.y = pack2(O[df][qf][2] * inv, O[df][qf][3] * inv); *(u32x2*)(dst + 16 * df) = o; }
        }
    }
#undef MX_KSRC
#undef MX_VSTAGE
    __syncthreads();
}

constexpr int FF_DA = 0, FF_DC = 32768, FF_XT = 49152  , FF_Z2 = 81920  , FF_OB = 114688  ;
__device__ __forceinline__ int ff_addr(int row, int k) { return row * 256 + ((((k >> 3) ^ (row & 15))) << 4) + (k & 7) * 2; }
__device__ __forceinline__ float cos_turns(float x) { return __builtin_amdgcn_cosf(x); }
__device__ __forceinline__ float sin_turns(float x) { return __builtin_amdgcn_sinf(x); }
__device__ __forceinline__ void fft_setup(LAS unsigned char* lds) {
    const int tid = tid_opaque();
    __syncthreads();
    for (int idx = tid; idx < 16384; idx += NT) { const int i = idx >> 7, k = idx & 127, ro = i >> 6, k1 = i & 63, part = k >> 6, n1 = k & 63; const float t = (float)((k1 * n1) & 63) * (1.0f / 64.0f);
        const float c = cos_turns(t), sn = sin_turns(t);
        const float v = (ro == 0) ? (part == 0 ? c : sn) : (part == 0 ? -sn : c);
        *(LAS bf16_t*)(lds + FF_DA + ff_addr(i, k)) = f2bf(v * 0.125f); }
    for (int idx = tid; idx < 8192; idx += NT) { const int k2 = idx >> 7, k = idx & 127, ri = k >> 6, n2 = k & 63; const float t = (float)((k2 * n2) & 63) * (1.0f / 64.0f);
        const float v = (ri == 0) ? cos_turns(t) : sin_turns(t);
        *(LAS bf16_t*)(lds + FF_DC + ff_addr(k2, k)) = f2bf(v * 0.125f); }
    __syncthreads();
}
__device__ __forceinline__ void fft_unit(AP a, LAS unsigned char* lds, int b, int cg) {
    const int tid = tid_opaque(), lane = tid & 63, w = __builtin_amdgcn_readfirstlane(tid >> 6), fr = lane & 15, g = lane >> 4;
    const int mf = w & 3, nh = w >> 2;
    const bf16_t* AT = (const bf16_t*)(a->ws + WS_AT) + (size_t)(b * 256 + cg * 4) * 8192;
    u32x4 xin[2][2];
#pragma unroll
    for (int h = 0; h < 2; ++h)
#pragma unroll
        for (int it = 0; it < 2; ++it) xin[h][it] = ld16g(AT + (size_t)h * 8192 + (size_t)(tid + 512 * it) * 8);
#pragma unroll 1
    for (int cp = 0; cp < 2; ++cp) {
#pragma unroll
        for (int h = 0; h < 2; ++h)
#pragma unroll
            for (int it = 0; it < 2; ++it) { const int q = tid + 512 * it, part = q >> 9, pos0 = (q & 511) * 8, n1 = pos0 >> 6, n2 = pos0 & 63, k = part * 64 + n1;
                const unsigned wv[4] = {xin[h][it].x, xin[h][it].y, xin[h][it].z, xin[h][it].w};
#pragma unroll
                for (int e = 0; e < 4; ++e) { *(LAS bf16_t*)(lds + FF_XT + h * 16384 + ff_addr(n2 + 2 * e, k)) = (bf16_t)(wv[e] & 0xffffu); *(LAS bf16_t*)(lds + FF_XT + h * 16384 + ff_addr(n2 + 2 * e + 1, k)) = (bf16_t)(wv[e] >> 16); } }
        if (cp == 0) {
#pragma unroll
            for (int h = 0; h < 2; ++h)
#pragma unroll
                for (int it = 0; it < 2; ++it) xin[h][it] = ld16g(AT + (size_t)(2 + h) * 8192 + (size_t)(tid + 512 * it) * 8); }
        __syncthreads();
        f32x4 acc[2][2][2];
#pragma unroll
        for (int h = 0; h < 2; ++h)
#pragma unroll
            for (int x = 0; x < 2; ++x) { acc[h][x][0] = (f32x4){0.f, 0.f, 0.f, 0.f}; acc[h][x][1] = (f32x4){0.f, 0.f, 0.f, 0.f}; }
#pragma unroll
        for (int ks = 0; ks < 4; ++ks) {
            bf16x8 af[2];
#pragma unroll
            for (int x = 0; x < 2; ++x) { const int i = 16 * (mf + 4 * x) + fr; af[x] = *(const LAS bf16x8*)(lds + FF_DA + i * 256 + (((4 * ks + g) ^ (i & 15)) << 4)); }
#pragma unroll
            for (int h = 0; h < 2; ++h)
#pragma unroll
                for (int n = 0; n < 2; ++n) { const int j = 16 * (2 * nh + n) + fr; const bf16x8 bfv = *(const LAS bf16x8*)(lds + FF_XT + h * 16384 + j * 256 + (((4 * ks + g) ^ (j & 15)) << 4));
                    acc[h][0][n] = __builtin_amdgcn_mfma_f32_16x16x32_bf16(af[0], bfv, acc[h][0][n], 0, 0, 0);
                    acc[h][1][n] = __builtin_amdgcn_mfma_f32_16x16x32_bf16(af[1], bfv, acc[h][1][n], 0, 0, 0); }
        }
#pragma unroll
        for (int n = 0; n < 2; ++n)
#pragma unroll
            for (int r = 0; r < 4; ++r) { const int k1 = 16 * mf + 4 * g + r, n2 = 16 * (2 * nh + n) + fr; const float t = (float)((k1 * n2) & 4095) * (1.0f / 4096.0f);
                const float c = cos_turns(t), sn = sin_turns(t);
#pragma unroll
                for (int h = 0; h < 2; ++h) { const float zr = acc[h][0][n][r], zi = acc[h][1][n][r];
                    *(LAS bf16_t*)(lds + FF_Z2 + h * 16384 + ff_addr(k1, n2)) = f2bf(zr * c + zi * sn);
                    *(LAS bf16_t*)(lds + FF_Z2 + h * 16384 + ff_addr(k1, 64 + n2)) = f2bf(zi * c - zr * sn); } }
        __syncthreads();
        f32x4 acc2[2][2];
#pragma unroll
        for (int h = 0; h < 2; ++h) { acc2[h][0] = (f32x4){0.f, 0.f, 0.f, 0.f}; acc2[h][1] = (f32x4){0.f, 0.f, 0.f, 0.f}; }
#pragma unroll
        for (int ks = 0; ks < 4; ++ks) {
            const int i = 16 * mf + fr; const bf16x8 af = *(const LAS bf16x8*)(lds + FF_DC + i * 256 + (((4 * ks + g) ^ (i & 15)) << 4));
#pragma unroll
            for (int h = 0; h < 2; ++h)
#pragma unroll
                for (int n = 0; n < 2; ++n) { const int j = 16 * (2 * nh + n) + fr; const bf16x8 bfv = *(const LAS bf16x8*)(lds + FF_Z2 + h * 16384 + j * 256 + (((4 * ks + g) ^ (j & 15)) << 4));
                    acc2[h][n] = __builtin_amdgcn_mfma_f32_16x16x32_bf16(af, bfv, acc2[h][n], 0, 0, 0); }
        }
#pragma unroll
        for (int n = 0; n < 2; ++n)
#pragma unroll
            for (int r = 0; r < 4; ++r) { const int k = 16 * (2 * nh + n) + fr + 64 * (16 * mf + 4 * g + r);
                *(LAS unsigned*)(lds + FF_OB + k * 8 + cp * 4) = pack2(acc2[0][n][r], acc2[1][n][r]); }
    }
    __syncthreads();
    bf16_t* CAT = (bf16_t*)(a->ws + WS_CAT) + (size_t)(b * 4096) * D + cg * 4;
#pragma unroll
    for (int it = 0; it < 8; ++it) { const int k = tid + 512 * it; *(u32x2*)(CAT + (size_t)k * D) = *(const LAS u32x2*)(lds + FF_OB + k * 8); }
    __syncthreads();
}

__device__ __forceinline__ void p2_mix(AP a, unsigned char* ldsg, LAS unsigned char* lds, int l) {
    const int n_tile = 128 + ((l == 0) ? 8 : 0), n_att = 2 * n_tile, n_dft = 256, n_dftc = (l == 0) ? 16 : 0;
    bf16_t* CAT = (bf16_t*)(a->ws + WS_CAT);
    bool fft_ready = false;
    for (int u = blockIdx.x; u < n_att + n_dft + n_tile + n_dftc; u += gridDim.x) {
        if (u < n_att || (u >= n_att + n_dft && u < n_att + n_dft + n_tile)) {
            const bool att = u < n_att;
            const int t = att ? (u >> 1) : (u - n_att - n_dft);
            const bool isc = t >= 128; const int tt = t - 128;
            const int b = isc ? (tt >> 1) : (t >> 5);
            const int row0 = isc ? NLAT + tt * 128 : t * 128, seq_row0 = isc ? NLAT + b * 256 : b * 4096, pos0 = isc ? (tt & 1) * 128 : (t & 31) * 128, n = isc ? 256 : 4096;
            if (att) { for (int rep = 0; rep < PROBE_MIX_REP; ++rep) mixer_attn(a, lds, l, row0, seq_row0, pos0, n, b, isc, u & 1); }
            else { for (int rep = 0; rep < PROBE_SGU_REP; ++rep) mixer_sgu_pool(a, lds, l, row0, seq_row0, pos0, n); }
            fft_ready = false;
        } else if (u < n_att + n_dft) {
            const int uu = u - n_att;
            if (!fft_ready) { fft_setup(lds); fft_ready = true; }
            for (int rep = 0; rep < PROBE_FFT_REP; ++rep) fft_unit(a, lds, uu >> 6, uu & 63);
        } else {
            const int uu = u - n_att - n_dft - n_tile, b = uu >> 2, mt = (uu >> 1) & 1, ch0 = (uu & 1) * 128;
            const bf16_t* A = (const bf16_t*)(a->ws + WS_DFTC) + (size_t)(mt * 128) * 512;
            const bf16_t* B0 = (const bf16_t*)(a->ws + WS_ATC) + ((size_t)b * 256 + ch0) * 512;
            EpiBf16 E; E.C = CAT + (size_t)(NLAT + b * 256 + mt * 128) * D + ch0; E.ld = D; E.scale = 1.0f;
            gemm_tile<128, false, EpiBf16>(lds, A, 512, nullptr, 128, B0, B0 + (size_t)64 * 512, 512, 512, E);
            fft_ready = false;
        }
    }
    exp_queue(a, ldsg, l);
}

__device__ __forceinline__ int uni(int v) { return __builtin_amdgcn_readfirstlane(v); }
__device__ __forceinline__ int vblock() { const int G = gridDim.x, b = blockIdx.x; return (G % 8 == 0) ? (b % 8) * (G / 8) + b / 8 : b; }
template <class T> __device__ __forceinline__ T* unip(T* p) { const unsigned long long v = (unsigned long long)p; const unsigned lo = __builtin_amdgcn_readfirstlane((unsigned)v), hi = __builtin_amdgcn_readfirstlane((unsigned)(v >> 32)); return (T*)(((unsigned long long)hi << 32) | lo); }
struct SchedInProj {
    typedef EpiInProj Epi; static constexpr bool GATHER = false, FP8 = false;
    unsigned char* ws; int l, G, me;
    __device__ __forceinline__ bool get(int i, g256::Unit<Epi>& u) const {
        const int n_lat = 64 * 7, n_ctx = (l == 0) ? 4 * 7 : 4;
        const int idx = i * G + me; if (idx >= n_lat + n_ctx) return false;
        int row0, b, ct, n; bf16_t *tF, *tV;
        if (idx < n_lat) { const int rt = idx / 7; ct = idx % 7; row0 = rt * 256; b = row0 >> 12; n = 4096;
            tF = (bf16_t*)(ws + WS_AT) + (size_t)b * 256 * 2 * 4096; tV = (bf16_t*)(ws + WS_VT) + (size_t)b * 128 * 4096; }
        else { const int uu = idx - n_lat; int rt; if (l == 0) { rt = uu / 7; ct = uu % 7; } else { rt = uu; ct = 3; }
            row0 = NLAT + rt * 256; b = rt; n = 256;
            tF = (bf16_t*)(ws + WS_ATC) + (size_t)b * 256 * 2 * 256; tV = (bf16_t*)(ws + WS_VTC) + (size_t)b * 128 * 256; }
        u.A = (const bf16_t*)(ws + WS_H) + (size_t)row0 * D;
        u.B0 = (const bf16_t*)(ws + WS_WIN) + ((size_t)l * ZC + ct * 256) * 1024; u.B1 = u.B0 + (size_t)128 * 1024; u.ridx = nullptr; u.valid = 256;
        u.epi.Zt = (bf16_t*)(ws + WS_Z) + (size_t)row0 * ZC + ct * 256; u.epi.tF = tF; u.epi.tV = tV; u.epi.n0 = ct * 256; u.epi.pos0 = (idx < n_lat) ? (row0 & 4095) : 0; u.epi.n = n;
        return true;
    }
};
struct SchedOutProj {
    typedef EpiBf16 Epi; static constexpr bool GATHER = false, FP8 = false;
    unsigned char* ws; int l, G, me;
    __device__ __forceinline__ bool get(int i, g256::Unit<Epi>& u) const {
        const int nrt = NLAT / 256;
        const int idx = i * G + me; if (idx >= nrt * 4) return false;
        const int rt = idx >> 2, ct = idx & 3;
        u.A = (const bf16_t*)(ws + WS_CAT) + (size_t)(rt * 256) * D;
        u.B0 = (const bf16_t*)(ws + WS_WOUT) + ((size_t)l * 1024 + ct * 256) * 1024; u.B1 = u.B0 + (size_t)128 * 1024; u.ridx = nullptr; u.valid = 256;
        u.epi.C = (bf16_t*)(ws + WS_Y) + (size_t)(rt * 256) * D + ct * 256; u.epi.ld = D; u.epi.scale = 1.0f;
        return true;
    }
};
__device__ __forceinline__ void moe_units(const LAS int* blk, LAS int* uinf, int G, int me) {
    const int i = threadIdx.x;
    if (i < 8) { const int idx = i * G + me, nu = blk[32] * 4; int e = 0, valid = 0;
        if (idx < nu) { const int rb = idx >> 2; for (int q = 1; q < 32; ++q) if (blk[q] <= rb) e = q; valid = min(256, blk[33 + e] - (rb - blk[e]) * 256); }
        uinf[2 * i] = e; uinf[2 * i + 1] = valid; }
    __syncthreads();
}
struct SchedGateUp {
    typedef EpiGateUp8 Epi; static constexpr bool GATHER = true, FP8 = true;
    unsigned char* ws; const LAS int* uinf; const LAS int* ridx_lds; int G, me, l, nu;
    __device__ __forceinline__ bool get(int i, g256::Unit<Epi>& u) const {
        const int idx = i * G + me; if (idx >= nu) return false;
        const int rb = idx >> 2, ct = idx & 3, e = uni(uinf[2 * i]);
        u.A = (const bf16_t*)(ws + WS_H8);
        { const unsigned char* b0 = ws + WS_WEXP + (size_t)l * WEXP_LAYER + ((size_t)e * 512 + ct * 128) * 1024; u.B0 = (const bf16_t*)b0; u.B1 = (const bf16_t*)(b0 + EXPMAT); }
        u.ridx = ridx_lds + (i & 7) * 256; u.valid = uni(uinf[2 * i + 1]);
        u.epi.C = ws + WS_HID + (size_t)(rb * 256) * DEXP + ct * 128; u.epi.ld = DEXP;
        return true;
    }
};
struct SchedDown {
    typedef EpiFp8 Epi; static constexpr bool GATHER = false, FP8 = true;
    unsigned char* ws; const LAS int* uinf; int G, me, l, nu;
    __device__ __forceinline__ bool get(int i, g256::Unit<Epi>& u) const {
        const int idx = i * G + me; if (idx >= nu) return false;
        const int rb = idx >> 2, ct = idx & 3, e = uni(uinf[2 * i]);
        u.A = (const bf16_t*)(ws + WS_HID + (size_t)(rb * 256) * DEXP);
        { const unsigned char* b0 = ws + WS_WEXP + (size_t)l * WEXP_LAYER + 2 * EXPMAT + ((size_t)e * 1024 + ct * 256) * 512; u.B0 = (const bf16_t*)b0; u.B1 = (const bf16_t*)(b0 + (size_t)128 * 512); } u.ridx = nullptr; u.valid = 256;
        u.epi.C = ws + WS_YS + (size_t)(rb * 256) * D + ct * 256; u.epi.ld = D; u.epi.scale = 1.0f / 32.0f;
        return true;
    }
};

template <int l> __device__ __forceinline__ void p4_ln1_router(AP a, unsigned char* lds) {
    const int tid = tid_opaque(), lane = tid & 63, w = tid >> 6;
    const int ntok = (l == 0) ? NTOK : NLAT;
    int* cnt = (int*)(lds + MISC_OFF);
    if (tid < 32) cnt[tid] = 0;
    f32x4* Lg = (f32x4*)lds; f32x4* Le = (f32x4*)(lds + 16384); f32x4* Lgb = (f32x4*)(lds + 147456);
    {
        const float* wrg_ = a->in[16] + (size_t)l * 1024 * 4; const float* wre_ = a->in[17] + (size_t)l * 1024 * 32;
#pragma unroll
        for (int it = 0; it < 2; ++it) { const int c = tid + 512 * it, slot = (((c >> 8) * 4 + (c & 3)) << 6) + ((c >> 2) & 63);
            Lg[slot] = *(const f32x4*)(wrg_ + (size_t)c * 4);
#pragma unroll
            for (int q = 0; q < 8; ++q) Le[q * 1024 + slot] = *(const f32x4*)(wre_ + (size_t)c * 32 + q * 4); }
        Lgb[tid] = (tid < 256) ? *(const f32x4*)(a->in[14] + l * 1024 + tid * 4) : *(const f32x4*)(a->in[15] + l * 1024 + (tid - 256) * 4);
    }
    __syncthreads();
    const float* mod = (const float*)(a->ws + WS_MOD) + (size_t)l * 5 * 6144;
    const bf16_t* Y = (const bf16_t*)(a->ws + WS_Y);
    bf16_t* X1 = (bf16_t*)(a->ws + WS_X1);
    unsigned char* H8 = a->ws + WS_H8;
    int* tokE = (int*)(a->ws + WS_TOKE); int* tokR = (int*)(a->ws + WS_TOKR); float* tokG = (float*)(a->ws + WS_TOKG);
    const int tstep = gridDim.x * 8;
    f32x4 nx[4]; u32x2 nxb[4], ny[4];
    const bf16_t* XC = (const bf16_t*)(a->ws + WS_XC);
    {   const int t = blockIdx.x * 8 + w;
        if (t < ntok) { const float* xs = (t < NLAT) ? a->in[0] + (size_t)t * D : a->in[2] + (size_t)(t - NLAT) * D;
#pragma unroll
            for (int i = 0; i < 4; ++i) { if (l == 0) nx[i] = *(const f32x4*)(xs + 256 * i + 4 * lane); else nxb[i] = *(const u32x2*)(XC + (size_t)t * D + 256 * i + 4 * lane);
                ny[i] = *(const u32x2*)(Y + (size_t)t * D + 256 * i + 4 * lane); } } }
    int mrow = -1; f32x4 mg[4], msh[4], msc[4];
    for (int t = blockIdx.x * 8 + w; t < ntok; t += tstep) {
        const int mr = (t < NLAT) ? (t >> 12) : 4;
        if (mr != mrow) { mrow = mr; const float* m = mod + (size_t)mr * 6144;
#pragma unroll
            for (int i = 0; i < 4; ++i) { const int c = 256 * i + 4 * lane; mg[i] = *(const f32x4*)(m + 2048 + c); msh[i] = *(const f32x4*)(m + 3072 + c); msc[i] = *(const f32x4*)(m + 4096 + c); } }
        f32x4 v[4];
#pragma unroll
        for (int i = 0; i < 4; ++i) { const f32x4 yv = (f32x4){lo2f(ny[i].x), hi2f(ny[i].x), lo2f(ny[i].y), hi2f(ny[i].y)};
            const f32x4 xv = (l == 0) ? nx[i] : (f32x4){lo2f(nxb[i].x), hi2f(nxb[i].x), lo2f(nxb[i].y), hi2f(nxb[i].y)};
#pragma unroll
            for (int e = 0; e < 4; ++e) v[i][e] = RES_ALPHA * xv[e] + mg[i][e] * yv[e]; }
        {   const int tn = t + tstep;
            if (tn < ntok) { const float* xs = (tn < NLAT) ? a->in[0] + (size_t)tn * D : a->in[2] + (size_t)(tn - NLAT) * D;
#pragma unroll
                for (int i = 0; i < 4; ++i) { if (l == 0) nx[i] = *(const f32x4*)(xs + 256 * i + 4 * lane); else nxb[i] = *(const u32x2*)(XC + (size_t)tn * D + 256 * i + 4 * lane);
                    ny[i] = *(const u32x2*)(Y + (size_t)tn * D + 256 * i + 4 * lane); } } }
        float mean, rstd; ln_stats(v, mean, rstd);
#pragma unroll
        for (int i = 0; i < 4; ++i) { const int c = 256 * i + 4 * lane; const f32x4 gg = Lgb[64 * i + lane], bb = Lgb[256 + 64 * i + lane];
#pragma unroll
            for (int e = 0; e < 4; ++e) v[i][e] = (v[i][e] - mean) * rstd * gg[e] + bb[e];
            { u32x2 pk; pk.x = pack2(v[i][0], v[i][1]); pk.y = pack2(v[i][2], v[i][3]); *(u32x2*)(X1 + (size_t)t * D + c) = pk; } }
        ln_stats(v, mean, rstd);
#pragma unroll
        for (int i = 0; i < 4; ++i) { const int c = 256 * i + 4 * lane; const f32x4 sh = msh[i], sc = msc[i];
#pragma unroll
            for (int e = 0; e < 4; ++e) v[i][e] = (v[i][e] - mean) * rstd * (1.0f + sc[e]) + sh[e];
            *(unsigned*)(H8 + (size_t)t * D + c) = pack4_fp8(v[i][0], v[i][1], v[i][2], v[i][3]); }
        f32x2 lg01 = (f32x2){0.f, 0.f}, lg23 = (f32x2){0.f, 0.f};
#pragma unroll
        for (int i = 0; i < 4; ++i)
#pragma unroll
            for (int e = 0; e < 4; ++e) { const f32x4 wv = Lg[((i * 4 + e) << 6) + lane]; const f32x2 vv = (f32x2){v[i][e], v[i][e]};
                lg01 += vv * (f32x2){wv[0], wv[1]}; lg23 += vv * (f32x2){wv[2], wv[3]}; }
        float lg[4]; wave_sum4(lg01[0], lg01[1], lg23[0], lg23[1], lg);
        int grp = 0; float mx = lg[0];
#pragma unroll
        for (int q = 1; q < 4; ++q) if (lg[q] > mx) { mx = lg[q]; grp = q; }
        float se = 0.f;
#pragma unroll
        for (int q = 0; q < 4; ++q) se += __expf(lg[q] - mx);
        const float gate_group = __builtin_amdgcn_rcpf(se);
        f32x2 le01 = (f32x2){0.f, 0.f}, le23 = (f32x2){0.f, 0.f}, le45 = (f32x2){0.f, 0.f}, le67 = (f32x2){0.f, 0.f};
#pragma unroll
        for (int i = 0; i < 4; ++i)
#pragma unroll
            for (int e = 0; e < 4; ++e) { const f32x4* wp = Le + grp * 2048 + ((i * 4 + e) << 6) + lane; const f32x4 w0 = wp[0], w1 = wp[1024]; const f32x2 vv = (f32x2){v[i][e], v[i][e]};
                le01 += vv * (f32x2){w0[0], w0[1]}; le23 += vv * (f32x2){w0[2], w0[3]}; le45 += vv * (f32x2){w1[0], w1[1]}; le67 += vv * (f32x2){w1[2], w1[3]}; }
        float le[8]; { const float lp[8] = {le01[0], le01[1], le23[0], le23[1], le45[0], le45[1], le67[0], le67[1]}; wave_sum8(lp, lane, le); }
        int j1 = 0; float l1 = le[0];
#pragma unroll
        for (int q = 1; q < 8; ++q) if (le[q] > l1) { l1 = le[q]; j1 = q; }
        int j2 = -1; float l2 = -3.0e38f;
#pragma unroll
        for (int q = 0; q < 8; ++q) if (q != j1 && le[q] > l2) { l2 = le[q]; j2 = q; }
        const float e2 = __expf(l2 - l1), p1 = __builtin_amdgcn_rcpf(1.0f + e2), p2 = e2 * p1;
        if (lane == 0) {
            const int ex0 = grp * 8 + j1, ex1 = grp * 8 + j2;
            const int r0 = atomicAdd(&cnt[ex0], 1), r1 = atomicAdd(&cnt[ex1], 1);
            tokE[2 * t] = ex0; tokE[2 * t + 1] = ex1; tokR[2 * t] = r0; tokR[2 * t + 1] = r1;
            tokG[2 * t] = gate_group * p1; tokG[2 * t + 1] = gate_group * p2;
        }
    }
    __syncthreads();
    if (tid < 32) ((int*)(a->ws + WS_BCNT))[((size_t)l * MAXG + blockIdx.x) * 32 + tid] = cnt[tid];
    __syncthreads();
}

__device__ __forceinline__ void p5_dispatch(AP a, unsigned char* lds, int l) {
    const int tid = tid_opaque();
    const int ntok = (l == 0) ? NTOK : NLAT;
    int* part = (int*)lds;
    int* tot = (int*)(lds + 4096);
    int* off = (int*)(lds + 4096 + 128);
    int* pstart = (int*)(lds + 4096 + 256);
    const int* bc = (const int*)(a->ws + WS_BCNT) + (size_t)l * MAXG * 32;
    const int G = gridDim.x, me = blockIdx.x;
    { const int e = tid & 31, p = tid >> 5; int s = 0, so = 0; for (int bb = p; bb < G; bb += 16) { const int c = bc[bb * 32 + e]; s += c; if (bb < me) so += c; } part[p * 32 + e] = s; part[512 + p * 32 + e] = so; }
    __syncthreads();
    if (tid < 32) { int s = 0, so = 0; for (int p = 0; p < 16; ++p) { s += part[p * 32 + tid]; so += part[512 + p * 32 + tid]; } tot[tid] = s; off[tid] = so; }
    __syncthreads();
    if (tid == 0) { int acc = 0; for (int e = 0; e < 32; ++e) { pstart[e] = acc; acc += ((tot[e] + 255) >> 8) << 8; } }
    __syncthreads();
    if (me == 0 && tid < 32) ((int*)(a->ws + WS_CNT))[l * 32 + tid] = tot[tid];
    const int* tokE = (const int*)(a->ws + WS_TOKE); const int* tokR = (const int*)(a->ws + WS_TOKR);
    int* tokS = (int*)(a->ws + WS_TOKS); int* slotT = (int*)(a->ws + WS_SLOTT);
    for (int q = tid; ; q += NT) { const int it = q >> 4, j = q & 15, t = (it * G + me) * 8 + (j >> 1); if (t >= ntok) break;
        const int idx = 2 * t + (j & 1); const int e = tokE[idx]; const int slot = pstart[e] + off[e] + tokR[idx]; tokS[idx] = slot; slotT[slot] = t; }
    __syncthreads();
}

__device__ __forceinline__ void moe_table(AP a, int l, LAS int* blk) {
    const int* tot = (const int*)(a->ws + WS_CNT) + l * 32;
    __syncthreads();
    if (threadIdx.x < 32) blk[33 + threadIdx.x] = tot[threadIdx.x];
    __syncthreads();
    if (threadIdx.x == 0) { int acc = 0; for (int e = 0; e < 32; ++e) { blk[e] = acc; acc += (blk[33 + e] + 255) >> 8; } blk[32] = acc; }
    __syncthreads();
}
__device__ __forceinline__ int units_of(int nu, int v, int G) { return (v < nu) ? (nu - v + G - 1) / G : 0; }
__device__ __forceinline__ void p1_inproj(AP a, unsigned char* smem, LAS unsigned char* lds, int l) {
    SchedInProj S; S.ws = a->ws; S.l = l; S.G = gridDim.x; S.me = vblock();
    g256::gemm_phase(lds, 1024, S);
    { const int nu = (l == 0) ? 64 * 7 + 4 * 7 : 64 * 7 + 4, G = gridDim.x; if (units_of(nu, S.me, G) < (nu + G - 1) / G) exp_fill(a, smem, l, 8); }
}
__device__ __forceinline__ void p3_outproj(AP a, unsigned char* smem, LAS unsigned char* lds, int l) {
    SchedOutProj S; S.ws = a->ws; S.l = l; S.G = gridDim.x; S.me = vblock();
    g256::gemm_phase(lds, 1024, S);
    if (l == 0) {
        const bf16_t* W = (const bf16_t*)(a->ws + WS_WOUT);
        for (int u = blockIdx.x; u < 64; u += gridDim.x) { const int rt = u >> 3, ct = u & 7;
            EpiBf16 E; E.C = (bf16_t*)(a->ws + WS_Y) + (size_t)(NLAT + rt * 128) * D + ct * 128; E.ld = D; E.scale = 1.0f;
            const bf16_t* B0 = W + (size_t)(ct * 128) * 1024;
            gemm_tile<128, false, EpiBf16>(lds, (const bf16_t*)(a->ws + WS_CAT) + (size_t)(NLAT + rt * 128) * D, D, nullptr, 128, B0, B0 + (size_t)64 * 1024, 1024, 1024, E); }
        if (blockIdx.x >= 64) exp_fill(a, smem, 0, 3);
    }
}
__device__ __forceinline__ void p6_gateup(AP a, unsigned char* smem, LAS unsigned char* lds, int l) {
    LAS int* blk = (LAS int*)(lds + MISC_OFF + 256);
    moe_table(a, l, blk);
    LAS int* ridx = (LAS int*)(lds + RIDX_OFF);
    const int tid = tid_opaque(), G = gridDim.x, me = vblock(), nu = uni(blk[32]) * 4;
    LAS int* uinf = (LAS int*)(lds + MISC_OFF + 528);
    moe_units(blk, uinf, G, me);
    const int* slotT = (const int*)(a->ws + WS_SLOTT);
    for (int i = 0; i < 8; ++i) { const int idx = i * G + me; if (idx >= nu) break;
        const int rb = idx >> 2, valid = uinf[2 * i + 1];
        if (tid < 256) ridx[i * 256 + tid] = (tid < valid) ? slotT[rb * 256 + tid] : 0; }
    __syncthreads();
    SchedGateUp S; S.ws = a->ws; S.uinf = uinf; S.ridx_lds = ridx; S.G = G; S.me = me; S.l = l; S.nu = nu;
    g256::gemm_phase(lds, 512, S);
    __syncthreads();
    if (l == 0 && units_of(nu, me, G) < (nu + G - 1) / G) exp_fill(a, smem, 1, 4);
}
__device__ __forceinline__ void p7_down(AP a, unsigned char* smem, LAS unsigned char* lds, int l) {
    LAS int* blk = (LAS int*)(lds + MISC_OFF + 256);
    moe_table(a, l, blk);
    LAS int* uinf = (LAS int*)(lds + MISC_OFF + 528);
    SchedDown S; S.ws = a->ws; S.uinf = uinf; S.G = gridDim.x; S.me = vblock(); S.l = l; S.nu = uni(blk[32]) * 4;
    moe_units(blk, uinf, S.G, S.me);
    g256::gemm_phase(lds, 256, S);
    __syncthreads();
    { const int nu = S.nu, G = gridDim.x; if (l == 0 && units_of(nu, S.me, G) < (nu + G - 1) / G) exp_fill(a, smem, 1, 2); }
}

template <int l> __device__ __forceinline__ void p8_ln2(AP a, unsigned char* lds) {
    const int tid = tid_opaque(), lane = tid & 63, w = tid >> 6;
    const int ntok = (l == 0) ? NTOK : NLAT;
    const float* mod = (const float*)(a->ws + WS_MOD) + (size_t)l * 5 * 6144;
    const float* modn = (const float*)(a->ws + WS_MOD) + (size_t)5 * 6144;
    const bf16_t* X1 = (const bf16_t*)(a->ws + WS_X1);
    const unsigned char* YS = a->ws + WS_YS;
    const int* tokS = (const int*)(a->ws + WS_TOKS); const float* tokG = (const float*)(a->ws + WS_TOKG);
    f32x4* Lgb = (f32x4*)lds;
    __syncthreads();
    Lgb[tid] = (tid < 256) ? *(const f32x4*)(a->in[21] + l * 1024 + tid * 4) : *(const f32x4*)(a->in[22] + l * 1024 + (tid - 256) * 4);
    __syncthreads();
    int mrow = -1; f32x4 mg[4], nsh[4], nsc[4];
    const int tstep = gridDim.x * 8;
    int t = blockIdx.x * 8 + w;
    int ns0 = 0, ns1 = 0; float nga = 0.f, ngb = 0.f;
    u32x2 nx[4]; unsigned nya[4], nyb[4];
    float cga = 0.f, cgb = 0.f;
    if (t < ntok) { const int s0 = tokS[2 * t], s1 = tokS[2 * t + 1]; cga = tokG[2 * t]; cgb = tokG[2 * t + 1];
#pragma unroll
        for (int i = 0; i < 4; ++i) { const int c = 256 * i + 4 * lane; nx[i] = *(const u32x2*)(X1 + (size_t)t * D + c); nya[i] = *(const unsigned*)(YS + (size_t)s0 * D + c); nyb[i] = *(const unsigned*)(YS + (size_t)s1 * D + c); } }
    if (t + tstep < ntok) { ns0 = tokS[2 * (t + tstep)]; ns1 = tokS[2 * (t + tstep) + 1]; nga = tokG[2 * (t + tstep)]; ngb = tokG[2 * (t + tstep) + 1]; }
    for (; t < ntok; t += tstep) {
        const int mr = (t < NLAT) ? (t >> 12) : 4;
        if (mr != mrow) { mrow = mr; const float* m = mod + (size_t)mr * 6144; const float* mn = modn + (size_t)mr * 6144;
#pragma unroll
            for (int i = 0; i < 4; ++i) { const int c = 256 * i + 4 * lane; mg[i] = *(const f32x4*)(m + 5120 + c); if (l == 0) { nsh[i] = *(const f32x4*)(mn + c); nsc[i] = *(const f32x4*)(mn + 1024 + c); } } }
        f32x4 v[4];
#pragma unroll
        for (int i = 0; i < 4; ++i) { const f32x4 gv = mg[i];
            const f32x2 ya0 = __builtin_amdgcn_cvt_pk_f32_fp8(nya[i], false), ya1 = __builtin_amdgcn_cvt_pk_f32_fp8(nya[i], true), yb0 = __builtin_amdgcn_cvt_pk_f32_fp8(nyb[i], false), yb1 = __builtin_amdgcn_cvt_pk_f32_fp8(nyb[i], true);
            const float f0 = cga * ya0[0] + cgb * yb0[0], f1 = cga * ya0[1] + cgb * yb0[1], f2 = cga * ya1[0] + cgb * yb1[0], f3 = cga * ya1[1] + cgb * yb1[1];
            v[i][0] = RES_ALPHA * lo2f(nx[i].x) + gv[0] * f0; v[i][1] = RES_ALPHA * hi2f(nx[i].x) + gv[1] * f1; v[i][2] = RES_ALPHA * lo2f(nx[i].y) + gv[2] * f2; v[i][3] = RES_ALPHA * hi2f(nx[i].y) + gv[3] * f3; }
        {   const int tn = t + tstep, tn2 = t + 2 * tstep;
            if (tn < ntok) {
#pragma unroll
                for (int i = 0; i < 4; ++i) { const int c = 256 * i + 4 * lane; nx[i] = *(const u32x2*)(X1 + (size_t)tn * D + c); nya[i] = *(const unsigned*)(YS + (size_t)ns0 * D + c); nyb[i] = *(const unsigned*)(YS + (size_t)ns1 * D + c); }
                cga = nga; cgb = ngb; }
            if (tn2 < ntok) { ns0 = tokS[2 * tn2]; ns1 = tokS[2 * tn2 + 1]; nga = tokG[2 * tn2]; ngb = tokG[2 * tn2 + 1]; } }
        float mean, rstd; ln_stats(v, mean, rstd);
#pragma unroll
        for (int i = 0; i < 4; ++i) { const int c = 256 * i + 4 * lane; const f32x4 gg = Lgb[64 * i + lane], bb = Lgb[256 + 64 * i + lane];
#pragma unroll
            for (int e = 0; e < 4; ++e) v[i][e] = (v[i][e] - mean) * rstd * gg[e] + bb[e];
            if (l == 0) { u32x2 pk; pk.x = pack2(v[i][0], v[i][1]); pk.y = pack2(v[i][2], v[i][3]); *(u32x2*)((bf16_t*)(a->ws + WS_XC) + (size_t)t * D + c) = pk; }
            else *(f32x4*)(a->out + (size_t)t * D + c) = v[i]; }
        if (l == 0) {
            ln_stats(v, mean, rstd);
            bf16_t* H = (bf16_t*)(a->ws + WS_H);
#pragma unroll
            for (int i = 0; i < 4; ++i) { const int c = 256 * i + 4 * lane; const f32x4 sh = nsh[i], sc = nsc[i];
                f32x4 o;
#pragma unroll
                for (int e = 0; e < 4; ++e) o[e] = (v[i][e] - mean) * rstd * (1.0f + sc[e]) + sh[e];
                u32x2 pk; pk.x = pack2(o[0], o[1]); pk.y = pack2(o[2], o[3]); *(u32x2*)(H + (size_t)t * D + c) = pk; }
        }
    }
}

constexpr int N_PHASES = 18;
template <int P> __device__ __forceinline__ void run_phase(AP a, unsigned char* smem, LAS unsigned char* lds, int l) {
    asm volatile("" : "+s"(a));
    if (P == 0) p0_prologue(a, smem);
    if (P == 1) p_lnmod0(a);
    if (P == 2) p1_inproj(a, smem, lds, l);
    if (P == 3) p2_mix(a, smem, lds, l);
    if (P == 4) p3_outproj(a, smem, lds, l);
    if (P == 5) { if (l == 0) p4_ln1_router<0>(a, smem); else p4_ln1_router<1>(a, smem); }
    if (P == 6) p5_dispatch(a, smem, l);
    if (P == 7) p6_gateup(a, smem, lds, l);
    if (P == 8) p7_down(a, smem, lds, l);
    if (P == 9) { if (l == 0) p8_ln2<0>(a, smem); else p8_ln2<1>(a, smem); }
}
#if N_LAUNCH_MODE == 1
__global__ void __launch_bounds__(NT, 2) fwd(Args a) {
    extern __shared__ __attribute__((aligned(16))) unsigned char smem[];
    LAS unsigned char* lds = (LAS unsigned char*)smem;
    if (threadIdx.x < 4) ((volatile LAS unsigned*)(lds + MISC_OFF + 768))[threadIdx.x] = 0u;
    __syncthreads();
    XcdBarrier bar = xcd_barrier_post((unsigned*)(a.ws + WS_BAR), (volatile LAS unsigned*)(lds + MISC_OFF + 768));
    AP ap = (AP)__builtin_amdgcn_kernarg_segment_ptr();
#define PROBE(P, l) do { if (PROBE_MASK & (1 << (P))) { for (int _r = 0; _r < 2; ++_r) { xcd_barrier(bar); run_phase<P>(ap, smem, lds, l); } } } while (0)
    run_phase<0>(ap, smem, lds, 0); PROBE(0, 0); xcd_barrier(bar);
    run_phase<1>(ap, smem, lds, 0); PROBE(1, 0); xcd_barrier(bar);
    for (int l = 0; l < 2; ++l) {
        run_phase<2>(ap, smem, lds, l); PROBE(2, l); xcd_barrier(bar);
        run_phase<3>(ap, smem, lds, l); PROBE(3, l); xcd_barrier(bar);
        run_phase<4>(ap, smem, lds, l); PROBE(4, l); xcd_barrier(bar);
        run_phase<5>(ap, smem, lds, l); PROBE(5, l); xcd_barrier(bar);
        run_phase<6>(ap, smem, lds, l); PROBE(6, l); xcd_barrier(bar);
        run_phase<7>(ap, smem, lds, l); PROBE(7, l); xcd_barrier(bar);
        run_phase<8>(ap, smem, lds, l); PROBE(8, l); xcd_barrier(bar);
        run_phase<9>(ap, smem, lds, l); PROBE(9, l); if (l == 0) xcd_barrier(bar);
    }
}
#else
template <int P> __global__ void __launch_bounds__(NT, 2) k_phase(Args a) {
    extern __shared__ __attribute__((aligned(16))) unsigned char smem[];
    LAS unsigned char* lds = (LAS unsigned char*)smem;
    AP ap = (AP)__builtin_amdgcn_kernarg_segment_ptr();
    run_phase<P>(ap, smem, lds, ap->ph_lo);
}
template <int P> static void launch_phase(Args a, int l, int grid, hipStream_t stream) {
    static bool attr = false;
    if (!attr) { (void)hipFuncSetAttribute((const void*)k_phase<P>, hipFuncAttributeMaxDynamicSharedMemorySize, LDS_BYTES); attr = true; }
    a.ph_lo = l; a.ph_hi = P;
    hipLaunchKernelGGL(k_phase<P>, dim3(grid), dim3(NT), LDS_BYTES, stream, a);
}
#endif

extern "C" void kernel_launch(void* const* d_in, const int* in_sizes, int n_in, void* d_out, int out_size, void* d_ws, size_t ws_size, hipStream_t stream) {
    static int grid = 0;
    if (grid == 0) {
        if (n_in != 23 || out_size != NLAT * D || ws_size < WS_END) { fprintf(stderr, "kernel_launch: unexpected shapes (n_in %d, out %d, ws %zu, need %zu)\n", n_in, out_size, ws_size, (size_t)WS_END); grid = -1; return; }
        int dev = 0, cus = 0;
        if (hipGetDevice(&dev) != hipSuccess || hipDeviceGetAttribute(&cus, hipDeviceAttributeMultiprocessorCount, dev) != hipSuccess) { grid = -1; return; }
#if N_LAUNCH_MODE == 1
        int per_cu = 0;
        if (hipFuncSetAttribute((const void*)fwd, hipFuncAttributeMaxDynamicSharedMemorySize, LDS_BYTES) != hipSuccess) { fprintf(stderr, "kernel_launch: hipFuncSetAttribute failed\n"); grid = -1; return; }
        if (hipOccupancyMaxActiveBlocksPerMultiprocessor(&per_cu, (const void*)fwd, NT, LDS_BYTES) != hipSuccess || per_cu < 1) { fprintf(stderr, "kernel_launch: occupancy query says %d\n", per_cu); }
        (void)hipGetLastError();
#endif
        grid = cus; if (grid > MAXG) grid = MAXG;
    }
    if (grid < 0) return;
    (void)hipMemsetAsync((char*)d_ws + WS_BAR, 0, 16384 + 256, stream);
    Args a{};
    for (int i = 0; i < 23; ++i) a.in[i] = (const float*)d_in[i];
    a.out = (float*)d_out; a.ws = (unsigned char*)d_ws;
#if N_LAUNCH_MODE == 1
    a.ph_lo = 0; a.ph_hi = N_PHASES;
    hipLaunchKernelGGL(fwd, dim3(grid), dim3(NT), LDS_BYTES, stream, a);
#else
    launch_phase<0>(a, 0, grid, stream);
    launch_phase<1>(a, 0, grid, stream);
    for (int l = 0; l < 2; ++l) {
        launch_phase<2>(a, l, grid, stream); launch_phase<3>(a, l, grid, stream); launch_phase<4>(a, l, grid, stream); launch_phase<5>(a, l, grid, stream);
        launch_phase<6>(a, l, grid, stream); launch_phase<7>(a, l, grid, stream); launch_phase<8>(a, l, grid, stream); launch_phase<9>(a, l, grid, stream);
    }
#endif
}
```

```cpp
#include <hip/hip_runtime.h>
#include <stdint.h>
#include <stdio.h>

#ifndef PROBE_MASK
#define PROBE_MASK 0
#endif
#ifndef PROBE_FFT_REP
#define PROBE_FFT_REP 1
#endif
#ifndef PROBE_MIX_REP
#define PROBE_MIX_REP 1
#endif
#ifndef PROBE_SGU_REP
#define PROBE_SGU_REP 1
#endif
#ifndef N_LAUNCH_MODE
#define N_LAUNCH_MODE 1
#endif

#define LAS __attribute__((address_space(3)))
typedef unsigned short bf16_t;
typedef short bf16x8 __attribute__((ext_vector_type(8)));
typedef float f32x4 __attribute__((ext_vector_type(4)));
typedef unsigned u32x4 __attribute__((ext_vector_type(4)));
typedef unsigned u32x2 __attribute__((ext_vector_type(2)));
typedef float f32x2 __attribute__((ext_vector_type(2)));
typedef int i32x4 __attribute__((ext_vector_type(4)));

constexpr int D = 1024, NBATCH = 4, SEQ = 4096, CTXL = 256;
constexpr int NLAT = NBATCH * SEQ, NCTX = NBATCH * CTXL, NTOK = NLAT + NCTX;
constexpr int ZC = 1792;
constexpr int NEXP = 32, DEXP = 512;
constexpr int NSLOT = 2 * NTOK + NEXP * 256;
constexpr int NT = 512;
constexpr int MAXG = 512;
constexpr float RES_ALPHA = 1.41421356237309515f;
constexpr int MISC_OFF = 155648;
constexpr int RIDX_OFF = 131072;
constexpr int LDS_BYTES = MISC_OFF + 1024;

constexpr size_t WS_BAR   = 0;
constexpr size_t WS_CNT   = 16384;
constexpr size_t WS_BCNT  = WS_CNT + 256;
constexpr size_t WS_MOD   = WS_BCNT + (size_t)2 * MAXG * 32 * 4;
constexpr size_t WS_ROPE  = WS_MOD + (size_t)2 * 5 * 6144 * 4;
constexpr size_t WS_TOKE  = WS_ROPE + 8192;
constexpr size_t WS_TOKR  = WS_TOKE + (size_t)NTOK * 8;
constexpr size_t WS_TOKS  = WS_TOKR + (size_t)NTOK * 8;
constexpr size_t WS_TOKG  = WS_TOKS + (size_t)NTOK * 8;
constexpr size_t WS_SLOTT = WS_TOKG + (size_t)NTOK * 8;
constexpr size_t WS_WIN   = WS_SLOTT + (size_t)NSLOT * 4;
constexpr size_t WS_WOUT  = WS_WIN + (size_t)2 * ZC * 1024 * 2;
constexpr size_t WS_WSGU  = WS_WOUT + (size_t)2 * 1024 * 1024 * 2;
constexpr size_t WS_DFTC  = WS_WSGU + (size_t)2 * 4 * 128 * 128 * 2;
constexpr size_t WS_WEXP  = WS_DFTC + (size_t)256 * 512 * 2;
constexpr size_t EXPMAT   = (size_t)NEXP * 512 * 1024;
constexpr size_t WEXP_LAYER = 3 * EXPMAT;
constexpr size_t WS_X1    = WS_WEXP + 2 * WEXP_LAYER;
constexpr size_t WS_XC    = WS_X1 + (size_t)NTOK * D * 4;
constexpr size_t WS_H     = WS_XC + (size_t)NTOK * D * 4;
constexpr size_t WS_R     = WS_H + (size_t)NTOK * D * 2;
constexpr size_t WS_Z     = WS_R;
constexpr size_t WS_AT    = WS_Z + (size_t)NTOK * ZC * 2;
constexpr size_t WS_ATC   = WS_AT + (size_t)4 * 256 * 8192 * 2;
constexpr size_t WS_VT    = WS_ATC + (size_t)4 * 256 * 512 * 2;
constexpr size_t WS_VTC   = WS_VT + (size_t)4 * 2 * 64 * 4096 * 2;
constexpr size_t WS_CAT   = WS_VTC + (size_t)4 * 2 * 64 * 256 * 2;
constexpr size_t WS_REND  = WS_CAT + (size_t)NTOK * D * 2;
constexpr size_t WS_Y     = WS_R;
constexpr size_t WS_HID   = WS_R;
constexpr size_t WS_YS    = WS_HID + (size_t)NSLOT * DEXP * 2;
constexpr size_t WS_REND2 = (WS_YS + (size_t)NSLOT * D * 2 > WS_REND) ? WS_YS + (size_t)NSLOT * D * 2 : WS_REND;
constexpr size_t WS_H8    = (WS_REND2 + 255) & ~(size_t)255;
constexpr size_t WS_END   = WS_H8 + (size_t)NTOK * D;
static_assert(WS_Y + (size_t)NTOK * D * 4 <= WS_CAT, "Y must not reach CAT");
static_assert(WS_WIN % 256 == 0 && WS_DFTC % 256 == 0 && WS_WEXP % 256 == 0 && WS_X1 % 256 == 0 && WS_H % 256 == 0 && WS_R % 256 == 0 && WS_AT % 256 == 0 && WS_CAT % 256 == 0 && WS_YS % 256 == 0, "alignment");

struct Args { const float* in[23]; float* out; unsigned char* ws; int ph_lo, ph_hi; };
#define CAS __attribute__((address_space(4)))
typedef const CAS Args* AP;

#define XB_TMO      128
#define XB_XCNT(j)  (256  + 64 * (j))
#define XB_XSUB(j)  (1280 + 64 * (j))
#define XB_XGEN(j)  (2304 + 64 * (j))
#define XB_TOP      3328
#define XB_TOPGEN   3392
#define XCD_BAR_WORDS 3456
#define XB_SPIN_CAP (1u << 18)

__device__ __forceinline__ unsigned xb_ld(unsigned* p)              { return __hip_atomic_load(p, __ATOMIC_RELAXED, __HIP_MEMORY_SCOPE_AGENT); }
__device__ __forceinline__ unsigned xb_add(unsigned* p, unsigned v) { return __hip_atomic_fetch_add(p, v, __ATOMIC_RELAXED, __HIP_MEMORY_SCOPE_AGENT); }
__device__ __forceinline__ unsigned xb_xcc_id() { return (unsigned)__builtin_amdgcn_s_getreg((3 << 11) | 20) & 0xFu; }
#define XB_SPIN(cond, bar) do { unsigned _sp = 0; while (cond) { __builtin_amdgcn_s_sleep(1); \
    if ((++_sp & 255u) == 0u) { if (xb_ld(&(bar)[XB_TMO])) break; if (_sp > XB_SPIN_CAP) { atomicAdd(&(bar)[XB_TMO], 1u); break; } } } } while (0)

struct XcdBarrier { unsigned* bar; unsigned x; volatile LAS unsigned* st; };

__device__ __forceinline__ XcdBarrier xcd_barrier_post(unsigned* bar, volatile LAS unsigned* st) {
    XcdBarrier b; b.bar = bar; b.x = (unsigned)__builtin_amdgcn_readfirstlane((int)xb_xcc_id()); b.st = st;
    if (threadIdx.x == 0) (void)xb_add(&bar[XB_XCNT(b.x)], 1u);
    return b;
}
__device__ __forceinline__ void xcd_barrier_complete(unsigned* bar, unsigned x, unsigned& nloc, unsigned& nx) {
    const unsigned G = gridDim.x * gridDim.y * gridDim.z;
    unsigned sum, cnt, mine, sp = 0u;
    for (;;) {
        sum = 0u; cnt = 0u; mine = 0u;
#pragma unroll
        for (unsigned j = 0; j < 16; ++j) { const unsigned c = xb_ld(&bar[XB_XCNT(j)]); sum += c; cnt += (c > 0u) ? 1u : 0u; mine = (j == x) ? c : mine; }
        if (sum == G) break;
        __builtin_amdgcn_s_sleep(1);
        if ((++sp & 255u) == 0u) { if (xb_ld(&bar[XB_TMO])) break; if (sp > XB_SPIN_CAP) { atomicAdd(&bar[XB_TMO], 1u); break; } }
    }
    nloc = mine > 0u ? mine : 1u; nx = cnt > 0u ? cnt : 1u;
}
__device__ __forceinline__ void xcd_barrier(const XcdBarrier& b) {
    asm volatile("s_waitcnt vmcnt(0)" ::: "memory");
    __syncthreads();
    if (threadIdx.x == 0) {
        unsigned* bar = b.bar;
        unsigned bx = b.x;
        asm volatile("" : "+s"(bar), "+s"(bx));
        __builtin_amdgcn_s_waitcnt(0);
        unsigned nloc = b.st[0], nx = b.st[1];
        if (nloc == 0u) { xcd_barrier_complete(bar, bx, nloc, nx); b.st[0] = nloc; b.st[1] = nx; }
        const unsigned old = xb_add(&bar[XB_XSUB(bx)], 1u);
        const unsigned gen = old / nloc;
        if (old + 1u == (gen + 1u) * nloc) {
            __builtin_amdgcn_fence(__ATOMIC_RELEASE, "agent");
            asm volatile("s_waitcnt vmcnt(0)" ::: "memory");
            const unsigned og = xb_add(&bar[XB_TOP], 1u);
            const unsigned tg = og / nx;
            if (og + 1u == (tg + 1u) * nx) xb_add(&bar[XB_TOPGEN], 1u);
            else XB_SPIN(xb_ld(&bar[XB_TOPGEN]) == tg, bar);
            __builtin_amdgcn_fence(__ATOMIC_ACQUIRE, "agent");
            xb_add(&bar[XB_XGEN(bx)], 1u);
            asm volatile("s_waitcnt vmcnt(0)" ::: "memory");
        } else {
            XB_SPIN(xb_ld(&bar[XB_XGEN(bx)]) == gen, bar);
            __builtin_amdgcn_fence(__ATOMIC_ACQUIRE, "agent");
            asm volatile("s_waitcnt vmcnt(0)" ::: "memory");
        }
    }
    __syncthreads();
}

__device__ __forceinline__ int tid_opaque() { int t = threadIdx.x; asm volatile("" : "+v"(t)); return t; }
__device__ __forceinline__ float bf2f(bf16_t v) { return __uint_as_float(((unsigned)v) << 16); }
__device__ __forceinline__ bf16_t f2bf(float f) { return __builtin_bit_cast(unsigned short, (__bf16)f); }
typedef __bf16 hwbf16x2 __attribute__((ext_vector_type(2)));
__device__ __forceinline__ unsigned pack2(float a, float b) { return __builtin_bit_cast(unsigned, __builtin_convertvector((f32x2){a, b}, hwbf16x2)); }
__device__ __forceinline__ unsigned pack4_fp8(float a, float b, float c, float d) {
    a = __builtin_amdgcn_fmed3f(a, -448.f, 448.f); b = __builtin_amdgcn_fmed3f(b, -448.f, 448.f); c = __builtin_amdgcn_fmed3f(c, -448.f, 448.f); d = __builtin_amdgcn_fmed3f(d, -448.f, 448.f);
    int p = __builtin_amdgcn_cvt_pk_fp8_f32(a, b, 0, false); p = __builtin_amdgcn_cvt_pk_fp8_f32(c, d, p, true); return (unsigned)p; }
__device__ __forceinline__ float lo2f(unsigned w) { return __uint_as_float(w << 16); }
__device__ __forceinline__ float hi2f(unsigned w) { return __uint_as_float(w & 0xffff0000u); }
template <int CTRL> __device__ __forceinline__ float dpp_mov(float v) { return __builtin_bit_cast(float, __builtin_amdgcn_update_dpp(0, __builtin_bit_cast(int, v), CTRL, 0xf, 0xf, true)); }
__device__ __forceinline__ float row_sum16(float v) {
    v += dpp_mov<0xB1>(v);
    v += dpp_mov<0x4E>(v);
    v += dpp_mov<0x141>(v);
    v += dpp_mov<0x140>(v);
    return v;
}
__device__ __forceinline__ float row_max16(float v) {
    v = fmaxf(v, dpp_mov<0xB1>(v)); v = fmaxf(v, dpp_mov<0x4E>(v)); v = fmaxf(v, dpp_mov<0x141>(v)); v = fmaxf(v, dpp_mov<0x140>(v));
    return v;
}
__device__ __forceinline__ float xsum32(float p, float q) { const auto rr = __builtin_amdgcn_permlane32_swap(__float_as_uint(p), __float_as_uint(q), false, false); return __uint_as_float(rr[0]) + __uint_as_float(rr[1]); }
__device__ __forceinline__ float xsum16(float p, float q) { const auto rr = __builtin_amdgcn_permlane16_swap(__float_as_uint(p), __float_as_uint(q), false, false); return __uint_as_float(rr[0]) + __uint_as_float(rr[1]); }
__device__ __forceinline__ float lane_f(float v, int lane) { return __builtin_bit_cast(float, __builtin_amdgcn_readlane(__builtin_bit_cast(int, v), lane)); }
__device__ __forceinline__ float wave_sum(float v) {
    v = row_sum16(v); v = xsum16(v, v); return xsum32(v, v);
}
__device__ __forceinline__ void wave_sum4(float a, float b, float c, float d, float (&o)[4]) {
    float w = xsum16(xsum32(a, b), xsum32(c, d));
    w = row_sum16(w);
    o[0] = lane_f(w, 0); o[1] = lane_f(w, 32); o[2] = lane_f(w, 16); o[3] = lane_f(w, 48);
}
__device__ __forceinline__ void wave_sum8(const float (&e)[8], int lane, float (&o)[8]) {
    const float w0 = xsum16(xsum32(e[0], e[1]), xsum32(e[2], e[3]));
    const float w1 = xsum16(xsum32(e[4], e[5]), xsum32(e[6], e[7]));
    const bool odd = lane & 1;
    float r = (odd ? w1 : w0) + dpp_mov<0xB1>(odd ? w0 : w1);
    r += dpp_mov<0x4E>(r); r += dpp_mov<0x124>(r); r += dpp_mov<0x128>(r);
    o[0] = lane_f(r, 0); o[1] = lane_f(r, 32); o[2] = lane_f(r, 16); o[3] = lane_f(r, 48);
    o[4] = lane_f(r, 1); o[5] = lane_f(r, 33); o[6] = lane_f(r, 17); o[7] = lane_f(r, 49);
}
__device__ __forceinline__ float gelu_erf(float v) {
    const float t = __builtin_amdgcn_rcpf(fabsf(v) * 0.2316418882f + 1.0f);
    float q = t * 0.5307027145f + (-0.7265760135f); q = q * t + 0.7107068705f; q = q * t + (-0.142248368f); q = q * t + 0.127414796f; q = q * t;
    const float m = v * (q * __builtin_amdgcn_exp2f((v * v) * (-0.72134752044f)));
    return v < 0.f ? m : v - m;
}
__device__ __forceinline__ float silu_f(float x) { return x * __builtin_amdgcn_rcpf(1.0f + __expf(-x)); }

__device__ __forceinline__ void ln_stats(const f32x4 (&v)[4], float& mean, float& rstd) {
    float s = 0.f;
#pragma unroll
    for (int i = 0; i < 4; ++i) s += (v[i][0] + v[i][1]) + (v[i][2] + v[i][3]);
    s = wave_sum(s); mean = s * (1.0f / 1024.0f);
    float q = 0.f;
#pragma unroll
    for (int i = 0; i < 4; ++i)
#pragma unroll
        for (int e = 0; e < 4; ++e) { const float d = v[i][e] - mean; q += d * d; }
    q = wave_sum(q); rstd = __builtin_amdgcn_rsqf(q * (1.0f / 1024.0f) + 1e-6f);
}

template <int BN> struct MfmaLayout {
    static constexpr int FG = BN / 128, NI = 4, NJ = 2 * FG;
    static constexpr bool PAIR8 = false;
    int rbase, cbase;
    __device__ __forceinline__ int row(int i) const { return rbase + 16 * i; }
    __device__ __forceinline__ int col(int jj) const { return (jj / FG) * (BN / 2) + (jj % FG) * 16 + cbase; }
};

__device__ __forceinline__ void glds16(const bf16_t* g, LAS unsigned char* l) {
    __builtin_amdgcn_global_load_lds((const unsigned*)g, (LAS unsigned*)l, 16, 0, 0);
}

template <int BN, bool GATHER, class Epi>
__device__ __forceinline__ void gemm_tile(LAS unsigned char* lds, const bf16_t* A, int lda, const int* rowidx, int valid_rows,
                                          const bf16_t* B0, const bf16_t* B1, int ldb, int K, const Epi& epi) {
    constexpr int A_B = 16384, B_B = BN * 128, STAGE = A_B + B_B, NBL = BN / 64;
    const int tid = tid_opaque(), lane = tid & 63, wid = __builtin_amdgcn_readfirstlane(tid >> 6);
    const bf16_t* ap[2]; const bf16_t* bp[NBL];
#pragma unroll
    for (int i = 0; i < 2; ++i) {
        const int P = i * 512 + tid, row = P >> 3, c = (P & 7) ^ ((row >> 1) & 7);
        size_t ro;
        if (GATHER) ro = (size_t)(row < valid_rows ? rowidx[row] : 0) * (size_t)lda; else ro = (size_t)row * (size_t)lda;
        ap[i] = A + ro + c * 8;
    }
#pragma unroll
    for (int i = 0; i < NBL; ++i) {
        const int P = i * 512 + tid, row = P >> 3, c = (P & 7) ^ ((row >> 1) & 7);
        const bf16_t* base = (row < BN / 2) ? (B0 + (size_t)row * ldb) : (B1 + (size_t)(row - BN / 2) * ldb);
        bp[i] = base + c * 8;
    }
    const int nk = K / 64;
#define GT_STAGE(buf, k0) do { \
        _Pragma("unroll") for (int _i = 0; _i < 2; ++_i) glds16(ap[_i] + (k0), lds + (buf) * STAGE + _i * 8192 + wid * 1024); \
        _Pragma("unroll") for (int _i = 0; _i < NBL; ++_i) glds16(bp[_i] + (k0), lds + (buf) * STAGE + A_B + _i * 8192 + wid * 1024); } while (0)

    typedef MfmaLayout<BN> Lay;
    constexpr int FG = Lay::FG;
    const int fr = lane & 15, g = lane >> 4, wr = wid >> 2, wc = wid & 3;
    Lay lay; lay.rbase = wr * 64 + fr; lay.cbase = wc * 16 * FG + 4 * g;
    f32x4 acc[Lay::NI][Lay::NJ];
#pragma unroll
    for (int i = 0; i < Lay::NI; ++i)
#pragma unroll
        for (int j = 0; j < Lay::NJ; ++j) acc[i][j] = (f32x4){0.f, 0.f, 0.f, 0.f};
    int aoff[4], boff[Lay::NJ];
#pragma unroll
    for (int m = 0; m < 4; ++m) { const int row = wr * 64 + m * 16 + fr; aoff[m] = row * 128 + ((g ^ ((row >> 1) & 7)) << 4); }
#pragma unroll
    for (int jj = 0; jj < Lay::NJ; ++jj) { const int row = (jj / FG) * (BN / 2) + wc * 16 * FG + (jj % FG) * 16 + fr; boff[jj] = A_B + row * 128 + ((g ^ ((row >> 1) & 7)) << 4); }
    GT_STAGE(0, 0);
    asm volatile("s_waitcnt vmcnt(0)" ::: "memory"); __syncthreads();
    for (int kt = 0; kt < nk; ++kt) {
        if (kt + 1 < nk) GT_STAGE((kt + 1) & 1, (kt + 1) * 64);
        const LAS unsigned char* sa = lds + (kt & 1) * STAGE;
#pragma unroll
        for (int ks = 0; ks < 2; ++ks) {
            bf16x8 af[4], bfv[Lay::NJ];
#pragma unroll
            for (int m = 0; m < 4; ++m) af[m] = *(const LAS bf16x8*)(sa + (aoff[m] ^ (ks << 6)));
#pragma unroll
            for (int jj = 0; jj < Lay::NJ; ++jj) bfv[jj] = *(const LAS bf16x8*)(sa + (boff[jj] ^ (ks << 6)));
#pragma unroll
            for (int m = 0; m < 4; ++m)
#pragma unroll
                for (int jj = 0; jj < Lay::NJ; ++jj) acc[m][jj] = __builtin_amdgcn_mfma_f32_16x16x32_bf16(bfv[jj], af[m], acc[m][jj], 0, 0, 0);
        }
        asm volatile("s_waitcnt vmcnt(0)" ::: "memory"); __syncthreads();
    }
    epi.run(acc, lay);
#undef GT_STAGE
}

namespace g256 {
constexpr int BK = 64, HALF = 128, HTB = HALF * BK * 2, STAGE_BYTES = 8 * HTB;
__device__ __forceinline__ int lds_byte(int r, int c) { const int st = (r >> 4) * 2 + (c >> 5), rr = r & 15, cc = c & 31, ob = rr * 64 + cc * 2; return st * 1024 + (ob ^ (((ob >> 9) & 1) << 5)); }
__device__ __forceinline__ int perm32(int rho) { const int n = rho >> 4, i = rho & 15; return 8 * (i >> 2) + 4 * n + (i & 3); }
__device__ __forceinline__ void stage_rc(int b, int& R, int& C) { const int st = b / 1024, sb = b % 1024, swz = sb ^ (((sb >> 9) & 1) << 5); R = (st >> 1) * 16 + swz / 64; C = (st & 1) * 32 + (swz % 64) / 2; }
struct Lay {
    static constexpr int NI = 8, NJ = 4;
    static constexpr bool PAIR8 = true;
    int rbase, cbase;
    __device__ __forceinline__ int row(int i) const { return (i >> 2) * 128 + (i & 3) * 16 + rbase; }
    __device__ __forceinline__ int col(int j) const { return (j >> 1) * 128 + (j & 1) * 4 + cbase; }
};
template <class Epi> struct Unit { const bf16_t* A; const bf16_t* B0; const bf16_t* B1; const LAS int* ridx; int valid; int tag; Epi epi; };

template <class Sched>
__device__ __forceinline__ void gemm_phase(LAS unsigned char* lds, const int K, const Sched& S) {
    typedef typename Sched::Epi Epi;
    const int tid = tid_opaque(), wid = __builtin_amdgcn_readfirstlane(tid >> 6), lane = tid & 63, wr = wid >> 2, wc = wid & 3, fr = lane & 15, fq = lane >> 4;
    int nt = K / BK; asm volatile("" : "+s"(nt));
    int sR[2], sC[2];
#pragma unroll
    for (int i = 0; i < 2; ++i) stage_rc(tid * 16 + i * 8192, sR[i], sC[i]);
    unsigned voffB[2];
#pragma unroll
    for (int i = 0; i < 2; ++i) voffB[i] = (unsigned)(((sR[i] & ~31) + perm32(sR[i] & 31)) * K + sC[i]) * 2u;
    const size_t kstep = (size_t)(BK * 2);
    const unsigned ldsw = (unsigned)wid * 1024u;
    const int aoff = lds_byte(wr * 64 + fr, fq * 8), boff = lds_byte(wc * 32 + fr, fq * 8);
#define G2_SA(b, h) (((b) * 2 + (h)) * HTB)
#define G2_SB(b, h) ((4 + (b) * 2 + (h)) * HTB)
#define G2_STAGE(bufoff, gbase, v0, v1) do { \
        __builtin_amdgcn_global_load_lds((const unsigned*)((const char*)(gbase) + (v0)), (LAS unsigned*)(lds + (bufoff) + ldsw), 16, 0, 0); \
        __builtin_amdgcn_global_load_lds((const unsigned*)((const char*)(gbase) + (v1)), (LAS unsigned*)(lds + (bufoff) + ldsw + 8192), 16, 0, 0); } while (0)
#define G2_LDA(dst, b, h) do { _Pragma("unroll") for (int m = 0; m < 4; ++m) _Pragma("unroll") for (int k = 0; k < 2; ++k) dst[m][k] = *(const LAS bf16x8*)(lds + G2_SA(b, h) + aoff + m * 2048 + k * 1024); } while (0)
#define G2_LDB(dst, b, h) do { _Pragma("unroll") for (int n = 0; n < 2; ++n) _Pragma("unroll") for (int k = 0; k < 2; ++k) dst[n][k] = *(const LAS bf16x8*)(lds + G2_SB(b, h) + boff + n * 2048 + k * 1024); } while (0)
#define G2_MMA(ai, bj, At, Bt) do { __builtin_amdgcn_s_setprio(1); _Pragma("unroll") for (int m = 0; m < 4; ++m) _Pragma("unroll") for (int n = 0; n < 2; ++n) _Pragma("unroll") for (int k = 0; k < 2; ++k) { \
        if (Sched::FP8) { const i32x4 _b = __builtin_bit_cast(i32x4, Bt[n][k]), _a = __builtin_bit_cast(i32x4, At[m][k]);     \
            acc[(ai) * 4 + m][(bj) * 2 + n] = __builtin_amdgcn_mfma_f32_16x16x32_fp8_fp8(((long)(unsigned)_b[1] << 32) | (unsigned)_b[0], ((long)(unsigned)_a[1] << 32) | (unsigned)_a[0], acc[(ai) * 4 + m][(bj) * 2 + n], 0, 0, 0); \
            acc[(ai) * 4 + m][(bj) * 2 + n] = __builtin_amdgcn_mfma_f32_16x16x32_fp8_fp8(((long)(unsigned)_b[3] << 32) | (unsigned)_b[2], ((long)(unsigned)_a[3] << 32) | (unsigned)_a[2], acc[(ai) * 4 + m][(bj) * 2 + n], 0, 0, 0); } \
        else acc[(ai) * 4 + m][(bj) * 2 + n] = __builtin_amdgcn_mfma_f32_16x16x32_bf16(Bt[n][k], At[m][k], acc[(ai) * 4 + m][(bj) * 2 + n], 0, 0, 0); } __builtin_amdgcn_s_setprio(0); } while (0)
#define G2_WAIT_V(n) asm volatile("s_waitcnt vmcnt(" #n ")" ::: "memory")
#define G2_WAIT_L(n) asm volatile("s_waitcnt lgkmcnt(" #n ")" ::: "memory")
#define G2_BAR __builtin_amdgcn_s_barrier()
#define G2_SCHED __builtin_amdgcn_sched_barrier(0)
#define G2_VOFFA(U, dst) do { _Pragma("unroll") for (int _h = 0; _h < 2; ++_h) _Pragma("unroll") for (int _i = 0; _i < 2; ++_i) { const int _row = _h * 128 + sR[_i]; \
        int _tok = _row; if (Sched::GATHER) _tok = (_row < (U).valid) ? (U).ridx[_row] : 0; dst[_h][_i] = (unsigned)(_tok * K + sC[_i]) * 2u; } } while (0)
    Unit<Epi> cur, nxt; int ui = 0;
    if (!S.get(0, cur)) return;
#define G2_DEPWAIT(tag_) do { if (wid == 0) { unsigned* _d = S.dep + (tag_); unsigned _sp = 0; while (xb_ld(_d) < 4u) { __builtin_amdgcn_s_sleep(2); if (++_sp > (1u << 22)) break; } __builtin_amdgcn_fence(__ATOMIC_ACQUIRE, "agent"); } G2_BAR; } while (0)
    if (Sched::WAITDEP) G2_DEPWAIT(cur.tag);
    f32x4 acc[8][4];
#pragma unroll
    for (int i = 0; i < 8; ++i)
#pragma unroll
        for (int j = 0; j < 4; ++j) acc[i][j] = (f32x4){0.f, 0.f, 0.f, 0.f};
    bf16x8 At[4][2], B0[2][2], B1[2][2];
    unsigned cvA[2][2], nvA[2][2];
    G2_VOFFA(cur, cvA);
    const char* cA = (const char*)cur.A; const char* cB0 = (const char*)cur.B0; const char* cB1 = (const char*)cur.B1;
    G2_STAGE(G2_SB(0, 0), cB0, voffB[0], voffB[1]); G2_STAGE(G2_SB(0, 1), cB1, voffB[0], voffB[1]); G2_STAGE(G2_SA(0, 0), cA, cvA[0][0], cvA[0][1]); G2_STAGE(G2_SA(0, 1), cA, cvA[1][0], cvA[1][1]);
    if (wr == 1) G2_BAR;
    G2_WAIT_V(2); G2_BAR;
    G2_STAGE(G2_SB(1, 0), cB0 + kstep, voffB[0], voffB[1]); G2_STAGE(G2_SA(1, 0), cA + kstep, cvA[0][0], cvA[0][1]); G2_STAGE(G2_SB(1, 1), cB1 + kstep, voffB[0], voffB[1]);
    G2_WAIT_V(6); G2_BAR;
    for (;;) {
        const bool has_next = S.get(ui + 1, nxt);
        if (Sched::WAITDEP) { if (has_next) G2_DEPWAIT(nxt.tag); }
        if (Sched::GATHER) {
            if (has_next) { G2_VOFFA(nxt, nvA); }
            else {
#pragma unroll
                for (int h = 0; h < 2; ++h) { nvA[h][0] = cvA[h][0]; nvA[h][1] = cvA[h][1]; } }
        }
        const char* nA = has_next ? (const char*)nxt.A : cA; const char* nB0 = has_next ? (const char*)nxt.B0 : cB0; const char* nB1 = has_next ? (const char*)nxt.B1 : cB1;
#pragma unroll 1
        for (int t = 0; t < nt; t += 2) {
            const bool last = (t == nt - 2);
            const char* a1 = cA + (size_t)(t + 1) * kstep;
            const char* a2 = last ? nA : cA + (size_t)(t + 2) * kstep;
            const char* b20 = last ? nB0 : cB0 + (size_t)(t + 2) * kstep; const char* b21 = last ? nB1 : cB1 + (size_t)(t + 2) * kstep;
#define x00 ((Sched::GATHER && last) ? nvA[0][0] : cvA[0][0])
#define x01 ((Sched::GATHER && last) ? nvA[0][1] : cvA[0][1])
#define x10 ((Sched::GATHER && last) ? nvA[1][0] : cvA[1][0])
#define x11 ((Sched::GATHER && last) ? nvA[1][1] : cvA[1][1])
            G2_LDB(B0, 0, 0); G2_LDB(B1, 0, 1); G2_SCHED; G2_LDA(At, 0, 0); G2_STAGE(G2_SA(1, 1), a1, cvA[1][0], cvA[1][1]);
            G2_WAIT_V(8); G2_WAIT_L(0); G2_BAR; G2_MMA(0, 0, At, B0); G2_MMA(0, 1, At, B1); G2_BAR; G2_SCHED;
            G2_LDA(At, 0, 1); G2_STAGE(G2_SB(0, 0), b20, voffB[0], voffB[1]); G2_STAGE(G2_SB(0, 1), b21, voffB[0], voffB[1]); G2_STAGE(G2_SA(0, 0), a2, x00, x01);
            G2_WAIT_V(8); G2_WAIT_L(0); G2_BAR; G2_MMA(1, 0, At, B0); G2_MMA(1, 1, At, B1); G2_BAR; G2_SCHED;
            G2_LDB(B0, 1, 0); G2_LDB(B1, 1, 1); G2_SCHED; G2_LDA(At, 1, 0); G2_STAGE(G2_SA(0, 1), a2, x10, x11);
            G2_WAIT_V(8); G2_WAIT_L(0); G2_BAR; G2_MMA(0, 0, At, B0); G2_MMA(0, 1, At, B1); G2_BAR; G2_SCHED;
            G2_LDA(At, 1, 1); G2_STAGE(G2_SB(1, 0), b20 + kstep, voffB[0], voffB[1]); G2_STAGE(G2_SB(1, 1), b21 + kstep, voffB[0], voffB[1]); G2_STAGE(G2_SA(1, 0), a2 + kstep, x00, x01);
            G2_WAIT_V(8); G2_WAIT_L(0); G2_BAR; G2_MMA(1, 0, At, B0); G2_MMA(1, 1, At, B1); G2_BAR; G2_SCHED;
        }
        if (wr == 0) G2_BAR;
        { Lay lay; int rbv = wr * 64 + fr, cbv = wc * 32 + 8 * fq; asm volatile("" : "+v"(rbv), "+v"(cbv));
          lay.rbase = rbv; lay.cbase = cbv; cur.epi.run(acc, lay); }
        if (Sched::SIGNAL) {
            G2_WAIT_V(0); G2_BAR;
            if (tid == 0) (void)xb_add(S.dep + cur.tag, 1u);
        }
        if (!has_next) break;
#pragma unroll
        for (int i = 0; i < 8; ++i)
#pragma unroll
            for (int j = 0; j < 4; ++j) acc[i][j] = (f32x4){0.f, 0.f, 0.f, 0.f};
        cur = nxt; cA = nA; cB0 = nB0; cB1 = nB1; ++ui;
        if (wr == 1) G2_BAR;
        if (Sched::GATHER) {
#pragma unroll
            for (int h = 0; h < 2; ++h) { cvA[h][0] = nvA[h][0]; cvA[h][1] = nvA[h][1]; } }
    }
#undef x00
#undef x01
#undef x10
#undef x11
    G2_WAIT_V(0);
    G2_BAR;
#undef G2_SA
#undef G2_SB
#undef G2_STAGE
#undef G2_LDA
#undef G2_LDB
#undef G2_MMA
#undef G2_WAIT_V
#undef G2_WAIT_L
#undef G2_BAR
#undef G2_SCHED
#undef G2_VOFFA
#undef G2_DEPWAIT
}
}

struct EpiF32 {
    float* C; int ld;
    template <class L> __device__ __forceinline__ void run(const f32x4 (&acc)[L::NI][L::NJ], const L& lay) const {
#pragma unroll
        for (int i = 0; i < L::NI; ++i)
#pragma unroll
            for (int j = 0; j < L::NJ; ++j) *(f32x4*)(C + (size_t)lay.row(i) * ld + lay.col(j)) = acc[i][j];
    }
};
struct EpiBf16 {
    bf16_t* C; int ld; float scale;
    template <class L> __device__ __forceinline__ void run(const f32x4 (&acc)[L::NI][L::NJ], const L& lay) const {
#pragma unroll
        for (int i = 0; i < L::NI; ++i) {
            if (L::PAIR8) {
#pragma unroll
                for (int j = 0; j < L::NJ; j += 2) { const f32x4 p = acc[i][j] * scale, q = acc[i][j + 1] * scale; u32x4 w; w.x = pack2(p[0], p[1]); w.y = pack2(p[2], p[3]); w.z = pack2(q[0], q[1]); w.w = pack2(q[2], q[3]);
                    *(u32x4*)(C + (size_t)lay.row(i) * ld + lay.col(j)) = w; }
            } else {
#pragma unroll
                for (int j = 0; j < L::NJ; ++j) { const f32x4 p = acc[i][j] * scale; u32x2 w; w.x = pack2(p[0], p[1]); w.y = pack2(p[2], p[3]);
                    *(u32x2*)(C + (size_t)lay.row(i) * ld + lay.col(j)) = w; }
            }
        }
    }
};
struct EpiFp8 {
    unsigned char* C; int ld; float scale;
    template <class L> __device__ __forceinline__ void run(const f32x4 (&acc)[L::NI][L::NJ], const L& lay) const {
        static_assert(L::PAIR8, "written for the paired-column layout");
#pragma unroll
        for (int i = 0; i < L::NI; ++i)
#pragma unroll
            for (int j = 0; j < L::NJ; j += 2) { const f32x4 p = acc[i][j] * scale, q = acc[i][j + 1] * scale; u32x2 w; w.x = pack4_fp8(p[0], p[1], p[2], p[3]); w.y = pack4_fp8(q[0], q[1], q[2], q[3]);
                *(u32x2*)(C + (size_t)lay.row(i) * ld + lay.col(j)) = w; }
    }
};
struct EpiGateUp8 {
    unsigned char* C; int ld;
    template <class L> __device__ __forceinline__ void run(const f32x4 (&acc)[L::NI][L::NJ], const L& lay) const {
        static_assert(L::PAIR8 && L::NJ == 4, "written for the paired-column 256x256 layout");
#pragma unroll
        for (int i = 0; i < L::NI; ++i) {
            const f32x4 g0 = acc[i][0] * (1.0f / 32.0f), g1 = acc[i][1] * (1.0f / 32.0f), u0 = acc[i][2] * (1.0f / 32.0f), u1 = acc[i][3] * (1.0f / 32.0f);
            u32x2 w; w.x = pack4_fp8(silu_f(g0[0]) * u0[0], silu_f(g0[1]) * u0[1], silu_f(g0[2]) * u0[2], silu_f(g0[3]) * u0[3]);
            w.y = pack4_fp8(silu_f(g1[0]) * u1[0], silu_f(g1[1]) * u1[1], silu_f(g1[2]) * u1[2], silu_f(g1[3]) * u1[3]);
            { const unsigned char* pw = C + (size_t)lay.row(i) * ld + lay.col(0); asm volatile("global_store_dwordx2 %0, %1, off sc0 sc1" :: "v"(pw), "v"(w) : "memory"); }
        }
    }
};
struct EpiGateUp {
    bf16_t* C; int ld;
    template <class L> __device__ __forceinline__ void run(const f32x4 (&acc)[L::NI][L::NJ], const L& lay) const {
#pragma unroll
        for (int i = 0; i < L::NI; ++i) {
            if (L::PAIR8 && L::NJ == 4) {
                const f32x4 g0 = acc[i][0], g1 = acc[i][1], u0 = acc[i][2], u1 = acc[i][3];
                u32x4 w; w.x = pack2(silu_f(g0[0]) * u0[0], silu_f(g0[1]) * u0[1]); w.y = pack2(silu_f(g0[2]) * u0[2], silu_f(g0[3]) * u0[3]);
                w.z = pack2(silu_f(g1[0]) * u1[0], silu_f(g1[1]) * u1[1]); w.w = pack2(silu_f(g1[2]) * u1[2], silu_f(g1[3]) * u1[3]);
                *(u32x4*)(C + (size_t)lay.row(i) * ld + lay.col(0)) = w;
            } else {
#pragma unroll
                for (int j = 0; j < L::NJ / 2; ++j) { const f32x4 gt = acc[i][j], up = acc[i][j + L::NJ / 2];
                    u32x2 w; w.x = pack2(silu_f(gt[0]) * up[0], silu_f(gt[1]) * up[1]); w.y = pack2(silu_f(gt[2]) * up[2], silu_f(gt[3]) * up[3]);
                    *(u32x2*)(C + (size_t)lay.row(i) * ld + lay.col(j)) = w; }
            }
        }
    }
};
struct EpiInProj {
    bf16_t* Zt;
    bf16_t* tF;
    bf16_t* tV;
    int n0, pos0, n;
    template <class L> __device__ __forceinline__ void run(const f32x4 (&acc)[L::NI][L::NJ], const L& lay) const {
        static_assert(L::PAIR8, "written for the paired-column layout");
#pragma unroll
        for (int i = 0; i < L::NI; ++i)
#pragma unroll
            for (int j = 0; j < L::NJ; j += 2) {
                const int r = lay.row(i), cl = lay.col(j), c = n0 + cl;
                const f32x4 v0 = acc[i][j], v1 = acc[i][j + 1];
                if (c < 512) {
                    const int part = c >> 8, ch = c & 255;
#pragma unroll
                    for (int e = 0; e < 4; ++e) { tF[((size_t)(ch + e) * 2 + part) * n + pos0 + r] = f2bf(v0[e]); tF[((size_t)(ch + 4 + e) * 2 + part) * n + pos0 + r] = f2bf(v1[e]); }
                } else {
                    u32x4 w; w.x = pack2(v0[0], v0[1]); w.y = pack2(v0[2], v0[3]); w.z = pack2(v1[0], v1[1]); w.w = pack2(v1[2], v1[3]);
                    *(u32x4*)(Zt + (size_t)r * ZC + cl) = w;
                    if (c >= 896 && c < 1024) {
#pragma unroll
                        for (int e = 0; e < 4; ++e) { tV[(size_t)(c - 896 + e) * n + pos0 + r] = f2bf(v0[e]); tV[(size_t)(c - 896 + 4 + e) * n + pos0 + r] = f2bf(v1[e]); }
                    }
                }
            }
    }
};

constexpr int U_ADA = 192, U_WIN = 2 * 16 * 28, U_WOUT = 2 * 16 * 16, U_SGU = 32, U_DFT = 256, U_ROPE = 1, U_EXP = 3 * 32 * 32;
constexpr int LDS_SIL = 0, LDS_RED = 20480, LDS_TILE = 32768, LDS_T64 = 49408, LDS_CTAB = 50176;

__device__ __forceinline__ void ada_unit(AP a, unsigned char* lds, int u) {
    float* sil = (float*)(lds + LDS_SIL); float* red = (float*)(lds + LDS_RED);
    const int tid = tid_opaque(), lane = tid & 63, w = tid >> 6;
    const int l = u / 96, cg = u % 96;
    for (int i = tid; i < 5120; i += NT) { const int r = i >> 10, k = i & 1023; const float v = (r < 4) ? a->in[1][r * 1024 + k] : a->in[3][k]; sil[i] = v / (1.0f + expf(-v)); }
    __syncthreads();
    const float* W = a->in[4] + (size_t)l * 1024 * 6144 + cg * 64 + lane;
    float acc[5] = {0.f, 0.f, 0.f, 0.f, 0.f};
#pragma unroll 32
    for (int k = w * 128; k < w * 128 + 128; ++k) { const float wv = W[(size_t)k * 6144];
#pragma unroll
        for (int r = 0; r < 5; ++r) acc[r] += sil[r * 1024 + k] * wv; }
#pragma unroll
    for (int r = 0; r < 5; ++r) red[(w * 5 + r) * 64 + lane] = acc[r];
    __syncthreads();
    if (tid < 320) { const int r = tid >> 6; float s = 0.f;
#pragma unroll
        for (int ww = 0; ww < 8; ++ww) s += red[(ww * 5 + r) * 64 + lane];
        const int j = cg * 64 + lane; ((float*)(a->ws + WS_MOD))[(size_t)(l * 5 + r) * 6144 + j] = s + a->in[5][l * 6144 + j]; }
    __syncthreads();
}

__device__ __forceinline__ void tile_store_T(const float* tile, bf16_t* dst, int ldd) {
    const int tid = tid_opaque(), n = tid >> 3, kc = tid & 7;
    u32x4 w;
    w.x = pack2(tile[(kc * 8 + 0) * 65 + n], tile[(kc * 8 + 1) * 65 + n]); w.y = pack2(tile[(kc * 8 + 2) * 65 + n], tile[(kc * 8 + 3) * 65 + n]);
    w.z = pack2(tile[(kc * 8 + 4) * 65 + n], tile[(kc * 8 + 5) * 65 + n]); w.w = pack2(tile[(kc * 8 + 6) * 65 + n], tile[(kc * 8 + 7) * 65 + n]);
    *(u32x4*)(dst + (size_t)n * ldd + kc * 8) = w;
}
__device__ __forceinline__ void tile_load(float* tile, const float* src, int lds_) {
    const int tid = tid_opaque();
#pragma unroll
    for (int i = 0; i < 2; ++i) { const int row = (tid >> 4) + 32 * i, c4 = (tid & 15) * 4; const f32x4 v = *(const f32x4*)(src + (size_t)row * lds_ + c4);
        tile[row * 65 + c4 + 0] = v[0]; tile[row * 65 + c4 + 1] = v[1]; tile[row * 65 + c4 + 2] = v[2]; tile[row * 65 + c4 + 3] = v[3]; }
}

__device__ __forceinline__ void mm64_f32(const float* tA, int lda, const float* tB, int ldb, int K, float* out) {
    const int tid = tid_opaque(), lane = tid & 63, w = tid >> 6, fr = lane & 15, g = lane >> 4, mi = w >> 1, nj = 2 * (w & 1);
    f32x4 acc0 = (f32x4){0.f, 0.f, 0.f, 0.f}, acc1 = (f32x4){0.f, 0.f, 0.f, 0.f};
    const float* pa = tA + (16 * mi + fr) * lda + g; const float* pb = tB + g * ldb + 16 * nj + fr;
#pragma unroll 4
    for (int k0 = 0; k0 < K; k0 += 4) { const float av = pa[k0], b0 = pb[k0 * ldb], b1 = pb[k0 * ldb + 16];
        acc0 = __builtin_amdgcn_mfma_f32_16x16x4f32(av, b0, acc0, 0, 0, 0); acc1 = __builtin_amdgcn_mfma_f32_16x16x4f32(av, b1, acc1, 0, 0, 0); }
#pragma unroll
    for (int r = 0; r < 4; ++r) { out[(16 * mi + 4 * g + r) * 65 + 16 * nj + fr] = acc0[r]; out[(16 * mi + 4 * g + r) * 65 + 16 * nj + 16 + fr] = acc1[r]; }
}

__device__ __forceinline__ void win_unit(AP a, unsigned char* lds, int u) {
    float* tile = (float*)(lds + LDS_TILE); float* T = (float*)(lds + LDS_T64);
    const int tid = tid_opaque();
    const int l = u / 448, r = u % 448, kb = r / 28, nb = r % 28;
    const float* Win = a->in[6] + (size_t)l * 1024 * 1536;
    const int srccol = (nb >= 8) ? nb * 64 - 256 : (nb & 3) * 64;
    tile_load(tile, Win + (size_t)(kb * 64) * 1536 + srccol, 1536);
    if (nb < 8 && tid < 64) { T[tid] = cospif((float)tid / 32.0f); T[64 + tid] = sinpif((float)tid / 32.0f); }
    __syncthreads();
    bf16_t* dst = (bf16_t*)(a->ws + WS_WIN) + ((size_t)l * ZC + nb * 64) * 1024 + kb * 64;
    if (nb >= 8) tile_store_T(tile, dst, 1024);
    else {
        const int part = nb >> 2;
        float* Tm = (float*)(lds + 65536); float* out = (float*)(lds + 98304);
        for (int i = tid; i < 4096; i += NT) { const int c = i >> 6, cp = i & 63; const float t = T[part * 64 + ((c * cp) & 63)]; Tm[i] = (part ? -t : t) * 0.125f; }
        __syncthreads();
        mm64_f32(tile, 65, Tm, 64, 64, out);
        __syncthreads();
        tile_store_T(out, dst, 1024);
    }
    __syncthreads();
}

__device__ __forceinline__ void wout_unit(AP a, unsigned char* lds, int u) {
    float* tile = (float*)(lds + LDS_TILE);
    __syncthreads();
    const int tid = tid_opaque();
    const int l = u / 256, r = u % 256, kb = r / 16, nb = r % 16;
    const float* Wo = a->in[13] + (size_t)l * 1024 * 1024;
    const int n = tid & 63, kq = __builtin_amdgcn_readfirstlane(tid >> 6);
    if (kb < 4) {
        float* tA = (float*)lds; float* tB = (float*)(lds + 65536);
        const float* wf = a->in[7] + (size_t)l * 256 * 256 + (size_t)(kb * 64) * 256;
        __syncthreads();
        f32x4 va[8], vb[8];
#pragma unroll
        for (int i = 0; i < 8; ++i) { const int q = tid + 512 * i; va[i] = *(const f32x4*)(wf + (size_t)q * 4); vb[i] = *(const f32x4*)(Wo + (size_t)(q >> 4) * 1024 + nb * 64 + (q & 15) * 4); }
#pragma unroll
        for (int i = 0; i < 8; ++i) { const int q = tid + 512 * i; *(f32x4*)(tA + (size_t)q * 4) = va[i]; *(f32x4*)(tB + (size_t)q * 4) = vb[i]; }
        __syncthreads();
        tile = (float*)(lds + 133120);
        mm64_f32(tA, 256, tB, 64, 256, tile);
    } else if (kb >= 8 && kb < 12) {
        const int g = kb - 8;
        float* tA = (float*)lds; float* tB = (float*)(lds + 65536);
        const float* wp = a->in[9] + (size_t)(l * 4 + g) * 64 * 64;
        const float* ps = a->in[10] + l * 256 + g * 64;
        f32x4 va[2], vb[2];
#pragma unroll
        for (int i = 0; i < 2; ++i) { const int q = tid + 512 * i; va[i] = *(const f32x4*)(wp + (size_t)q * 4); vb[i] = *(const f32x4*)(Wo + (size_t)(512 + g * 64 + (q >> 4)) * 1024 + nb * 64 + (q & 15) * 4) * ps[q >> 4]; }
#pragma unroll
        for (int i = 0; i < 2; ++i) { const int q = tid + 512 * i; *(f32x4*)(tA + (size_t)q * 4) = va[i]; *(f32x4*)(tB + (size_t)q * 4) = vb[i]; }
        __syncthreads();
        tile = (float*)(lds + 133120);
        mm64_f32(tA, 64, tB, 64, 64, tile);
    } else tile_load(tile, Wo + (size_t)(kb * 64) * 1024 + nb * 64, 1024);
    __syncthreads();
    tile_store_T(tile, (bf16_t*)(a->ws + WS_WOUT) + ((size_t)l * 1024 + nb * 64) * 1024 + kb * 64, 1024);
    __syncthreads();
}

__device__ __forceinline__ void exp_src_dst(AP a, int l, int u, const float*& src, int& srcld, unsigned char*& dst, int& dstld) {
    const int mat = u / 1024, e = (u % 1024) / 32, t = u % 32;
    const int kb = (mat < 2) ? t / 4 : t / 8, nb = (mat < 2) ? t % 4 : t % 8;
    srcld = (mat < 2) ? 512 : 1024; dstld = (mat < 2) ? 1024 : 512;
    src = a->in[18 + mat] + ((size_t)(l * 32 + e) * 512 * 1024) + (size_t)(kb * 128) * srcld + nb * 128;
    dst = a->ws + WS_WEXP + (size_t)l * WEXP_LAYER + (size_t)mat * EXPMAT + (size_t)e * 512 * 1024 + (size_t)(nb * 128) * dstld + kb * 128;
}
#define EXP_LOAD(vv, uu) do { exp_src_dst(a, l, (uu), src, srcld, dst, dstld); _Pragma("unroll") for (int _i = 0; _i < 8; ++_i) vv[_i] = *(const f32x4*)(src + (size_t)((tid >> 5) + 16 * _i) * srcld + (tid & 31) * 4); } while (0)
#define EXP_PUT(vv) do { _Pragma("unroll") for (int _i = 0; _i < 8; ++_i) *(f32x4*)(tile + ((tid >> 5) + 16 * _i) * 132 + (tid & 31) * 4) = vv[_i] * 32.0f; } while (0)
#define EXP_STORE(dd, ld_) do { const int n = tid & 127, kq = tid >> 7;        \
        _Pragma("unroll") for (int j = 0; j < 2; ++j) { const float* tp = tile + (kq * 32 + j * 16) * 132 + n; u32x4 w; \
        w.x = pack4_fp8(tp[0], tp[132], tp[2 * 132], tp[3 * 132]); w.y = pack4_fp8(tp[4 * 132], tp[5 * 132], tp[6 * 132], tp[7 * 132]); \
        w.z = pack4_fp8(tp[8 * 132], tp[9 * 132], tp[10 * 132], tp[11 * 132]); w.w = pack4_fp8(tp[12 * 132], tp[13 * 132], tp[14 * 132], tp[15 * 132]); \
        *(u32x4*)((dd) + (size_t)n * (ld_) + kq * 32 + j * 16) = w; } } while (0)
__device__ __forceinline__ void exp_range(AP a, unsigned char* lds, int l, int u0, int u_end) {
    float* tile = (float*)lds;
    const int tid = tid_opaque();
    __syncthreads();
    if (u0 >= u_end) return;
    const float* src; unsigned char* dst; int srcld, dstld;
    f32x4 va[8], vb[8];
    unsigned char *da, *db = nullptr; int lda_, ldb_ = 0;
    EXP_LOAD(va, u0); da = dst; lda_ = dstld;
    if (u0 + 1 < u_end) { EXP_LOAD(vb, u0 + 1); db = dst; ldb_ = dstld; }
    for (int u = u0; u < u_end; u += 2) {
        EXP_PUT(va);
        __syncthreads();
        { unsigned char* cd = da; const int cl = lda_; if (u + 2 < u_end) { EXP_LOAD(va, u + 2); da = dst; lda_ = dstld; } EXP_STORE(cd, cl); }
        __syncthreads();
        if (u + 1 < u_end) {
            EXP_PUT(vb);
            __syncthreads();
            { unsigned char* cd = db; const int cl = ldb_; if (u + 3 < u_end) { EXP_LOAD(vb, u + 3); db = dst; ldb_ = dstld; } EXP_STORE(cd, cl); }
            __syncthreads();
        }
    }
}
#undef EXP_LOAD
#undef EXP_PUT
#undef EXP_STORE
__device__ __forceinline__ void exp_queue(AP a, unsigned char* lds, int l) {
    const int tid = tid_opaque();
    int* qslot = (int*)(lds + MISC_OFF + 128);
    unsigned* qc = (unsigned*)(a->ws + WS_BAR + 14336 + l * 256);
    for (;;) {
        __syncthreads();
        if (tid == 0) *qslot = (int)__hip_atomic_fetch_add(qc, 2u, __ATOMIC_RELAXED, __HIP_MEMORY_SCOPE_AGENT);
        __syncthreads();
        const int c0 = *qslot;
        if (c0 >= U_EXP) break;
        exp_range(a, lds, l, c0, c0 + 2);
    }
}

__device__ __forceinline__ void exp_fill(AP a, unsigned char* lds, int ql, int budget) {
    const int tid = tid_opaque();
    int* qslot = (int*)(lds + MISC_OFF + 128);
    unsigned* qc = (unsigned*)(a->ws + WS_BAR + 14336 + ql * 256);
    for (int done = 0; done < budget; done += 2) {
        __syncthreads();
        if (tid == 0) *qslot = (int)__hip_atomic_fetch_add(qc, 2u, __ATOMIC_RELAXED, __HIP_MEMORY_SCOPE_AGENT);
        __syncthreads();
        const int c0 = *qslot;
        if (c0 >= U_EXP) break;
        exp_range(a, lds, ql, c0, c0 + 2);
    }
    __syncthreads();
}

__device__ __forceinline__ void p0_prologue(AP a, unsigned char* lds) {
    const int tid = tid_opaque();
    bool have_tab = false;
    constexpr int E0 = U_ADA, E1 = E0 + U_WIN, E2 = E1 + U_WOUT, E3 = E2 + U_SGU, E4 = E3 + U_DFT, E5 = E4 + U_ROPE;
    int u = blockIdx.x;
    for (; u < E5; u += gridDim.x) {
        if (u < E0) ada_unit(a, lds, u);
        else if (u < E1) win_unit(a, lds, u - E0);
        else if (u < E2) wout_unit(a, lds, u - E1);
        else if (u < E3) { const size_t i0 = (size_t)(u - E2) * 4096 + tid * 8; const float* s = a->in[11] + i0; bf16_t* d = (bf16_t*)(a->ws + WS_WSGU) + i0;
            const f32x4 v0 = *(const f32x4*)s, v1 = *(const f32x4*)(s + 4); u32x4 w; w.x = pack2(v0[0], v0[1]); w.y = pack2(v0[2], v0[3]); w.z = pack2(v1[0], v1[1]); w.w = pack2(v1[2], v1[3]); *(u32x4*)d = w; }
        else if (u < E4) {
            float* ctab = (float*)(lds + LDS_CTAB);
            if (!have_tab) { for (int i = tid; i < 4096; i += NT) ctab[i] = cospif((float)i / 2048.0f); __syncthreads(); have_tab = true; }
            const int k = u - E3 + 4096;
            if (tid < 32) {
                const int kk = k - 4096, n0 = tid * 8; float c[8], s[8];
#pragma unroll
                for (int e = 0; e < 8; ++e) { const int idx = ((kk * (n0 + e)) & 255) * 16; c[e] = ctab[idx] * (1.0f / 16.0f); s[e] = ctab[(idx - 1024) & 4095] * (1.0f / 16.0f); }
                bf16_t* d = (bf16_t*)(a->ws + WS_DFTC) + (size_t)kk * 512 + n0;
                u32x4 w; w.x = pack2(c[0], c[1]); w.y = pack2(c[2], c[3]); w.z = pack2(c[4], c[5]); w.w = pack2(c[6], c[7]); *(u32x4*)d = w;
                w.x = pack2(s[0], s[1]); w.y = pack2(s[2], s[3]); w.z = pack2(s[4], s[5]); w.w = pack2(s[6], s[7]); *(u32x4*)(d + 256) = w;
            }
        }
        else {
            for (int i = tid; i < 1024; i += NT) { const int pos = i >> 4, f = i & 15; const float freq = powf(10000.0f, -(float)f / 16.0f); const float ang = (float)pos * freq;
                ((float2*)(a->ws + WS_ROPE))[i] = make_float2(cosf(ang), sinf(ang)); }
        }
    }
}

__device__ __forceinline__ void p_lnmod0(AP a) {
    const int tid = tid_opaque(), lane = tid & 63, w = tid >> 6;
    const float* mod = (const float*)(a->ws + WS_MOD);
    bf16_t* H = (bf16_t*)(a->ws + WS_H);
    const int tstep = gridDim.x * 8;
    f32x4 nx[4];
    { const int t = blockIdx.x * 8 + w; if (t < NTOK) { const float* src = (t < NLAT) ? a->in[0] + (size_t)t * D : a->in[2] + (size_t)(t - NLAT) * D;
#pragma unroll
        for (int i = 0; i < 4; ++i) nx[i] = *(const f32x4*)(src + 256 * i + 4 * lane); } }
    int mrow = -1; f32x4 msh[4], msc[4];
    for (int t = blockIdx.x * 8 + w; t < NTOK; t += tstep) {
        const int mr = (t < NLAT) ? (t >> 12) : 4;
        if (mr != mrow) { mrow = mr; const float* m = mod + (size_t)mr * 6144;
#pragma unroll
            for (int i = 0; i < 4; ++i) { msh[i] = *(const f32x4*)(m + 256 * i + 4 * lane); msc[i] = *(const f32x4*)(m + 1024 + 256 * i + 4 * lane); } }
        f32x4 v[4];
#pragma unroll
        for (int i = 0; i < 4; ++i) v[i] = nx[i];
        { const int tn = t + tstep; if (tn < NTOK) { const float* src = (tn < NLAT) ? a->in[0] + (size_t)tn * D : a->in[2] + (size_t)(tn - NLAT) * D;
#pragma unroll
            for (int i = 0; i < 4; ++i) nx[i] = *(const f32x4*)(src + 256 * i + 4 * lane); } }
        float mean, rstd; ln_stats(v, mean, rstd);
#pragma unroll
        for (int i = 0; i < 4; ++i) { const int c = 256 * i + 4 * lane;
            f32x4 o;
#pragma unroll
            for (int e = 0; e < 4; ++e) o[e] = (v[i][e] - mean) * rstd * (1.0f + msc[i][e]) + msh[i][e];
            u32x2 pk; pk.x = pack2(o[0], o[1]); pk.y = pack2(o[2], o[3]); *(u32x2*)(H + (size_t)t * D + c) = pk; }
    }
}

__device__ __forceinline__ void p1_inproj(AP a, unsigned char* smem, LAS unsigned char* lds, int l);
__device__ __forceinline__ u32x4 ld16g(const bf16_t* p) { return *(const u32x4*)p; }
__device__ __forceinline__ void rope_pack8(u32x4& wl, u32x4& wh, const LAS f32x2* tab, bool do_rope, float scale) {
    float tl[8] = {lo2f(wl.x), hi2f(wl.x), lo2f(wl.y), hi2f(wl.y), lo2f(wl.z), hi2f(wl.z), lo2f(wl.w), hi2f(wl.w)};
    float th[8] = {lo2f(wh.x), hi2f(wh.x), lo2f(wh.y), hi2f(wh.y), lo2f(wh.z), hi2f(wh.z), lo2f(wh.w), hi2f(wh.w)};
#pragma unroll
    for (int j = 0; j < 8; ++j) {
        float r1 = tl[j], r2 = th[j];
        if (do_rope) { const f32x2 cs = tab[j]; r1 = tl[j] * cs.x - th[j] * cs.y; r2 = tl[j] * cs.y + th[j] * cs.x; }
        tl[j] = r1 * scale; th[j] = r2 * scale;
    }
    wl.x = pack2(tl[0], tl[1]); wl.y = pack2(tl[2], tl[3]); wl.z = pack2(tl[4], tl[5]); wl.w = pack2(tl[6], tl[7]);
    wh.x = pack2(th[0], th[1]); wh.y = pack2(th[2], th[3]); wh.z = pack2(th[4], th[5]); wh.w = pack2(th[6], th[7]);
}

__device__ __forceinline__ void mixer_sgu_pool(AP a, LAS unsigned char* lds, int l, int row0, int seq_row0, int pos0, int n) {
    typedef short s16x4 __attribute__((ext_vector_type(4)));
    const int tid = tid_opaque(), lane = tid & 63, w = __builtin_amdgcn_readfirstlane(tid >> 6), fr = lane & 15, g = lane >> 4;
    const bf16_t* Z = (const bf16_t*)(a->ws + WS_Z);
    bf16_t* CAT = (bf16_t*)(a->ws + WS_CAT);
    constexpr int VOFF = 73728;
    u32x4 pr[9];
#pragma unroll
    for (int it = 0; it < 9; ++it) { const int id = tid + 512 * it, rr = id >> 5, ch = id & 31, j = pos0 - 8 + rr;
        pr[it] = (u32x4){0u, 0u, 0u, 0u};
        if (j >= 0 && j < n) pr[it] = ld16g(Z + (size_t)(seq_row0 + j) * ZC + 1024 + ch * 8); }
    bf16x8 wfrag[4][4];
    {   const int h = w >> 1, ph = w & 1; const bf16_t* Ws = (const bf16_t*)(a->ws + WS_WSGU) + (size_t)(l * 4 + h) * 128 * 128;
#pragma unroll
        for (int ks = 0; ks < 4; ++ks)
#pragma unroll
            for (int pf = 0; pf < 4; ++pf) wfrag[ks][pf] = *(const bf16x8*)(Ws + (size_t)(ph * 64 + 16 * pf + fr) * 128 + 32 * ks + 8 * g); }
    u32x4 gw[4][2];
#pragma unroll
    for (int ps = 0; ps < 4; ++ps) { const int q = w * 16 + ps * 4 + g; const bf16_t* src = Z + (size_t)(row0 + q) * ZC + 1536 + 16 * fr; gw[ps][0] = ld16g(src); gw[ps][1] = ld16g(src + 8); }
#pragma unroll
    for (int it = 0; it < 9; ++it) { const int id = tid + 512 * it; *(LAS u32x4*)(lds + (id >> 5) * 512 + (id & 31) * 16) = pr[it]; }
#pragma unroll
    for (int ps = 0; ps < 4; ++ps) {
        const int q = w * 16 + ps * 4 + g;
        float gv[16];
#pragma unroll
        for (int hh = 0; hh < 2; ++hh) { const u32x4 x = gw[ps][hh];
            gv[8 * hh + 0] = gelu_erf(lo2f(x.x)); gv[8 * hh + 1] = gelu_erf(hi2f(x.x)); gv[8 * hh + 2] = gelu_erf(lo2f(x.y)); gv[8 * hh + 3] = gelu_erf(hi2f(x.y));
            gv[8 * hh + 4] = gelu_erf(lo2f(x.z)); gv[8 * hh + 5] = gelu_erf(hi2f(x.z)); gv[8 * hh + 6] = gelu_erf(lo2f(x.w)); gv[8 * hh + 7] = gelu_erf(hi2f(x.w)); }
        float sm = 0.f;
#pragma unroll
        for (int e = 0; e < 16; ++e) sm += gv[e];
        const float mean = row_sum16(sm) * (1.0f / 256.0f);
        float qq = 0.f;
#pragma unroll
        for (int e = 0; e < 16; ++e) { const float d = gv[e] - mean; qq += d * d; }
        const float rstd = 1.0f / sqrtf(row_sum16(qq) * (1.0f / 256.0f) + 1e-6f);
        u32x4 o0, o1;
        o0.x = pack2((gv[0] - mean) * rstd, (gv[1] - mean) * rstd); o0.y = pack2((gv[2] - mean) * rstd, (gv[3] - mean) * rstd); o0.z = pack2((gv[4] - mean) * rstd, (gv[5] - mean) * rstd); o0.w = pack2((gv[6] - mean) * rstd, (gv[7] - mean) * rstd);
        o1.x = pack2((gv[8] - mean) * rstd, (gv[9] - mean) * rstd); o1.y = pack2((gv[10] - mean) * rstd, (gv[11] - mean) * rstd); o1.z = pack2((gv[12] - mean) * rstd, (gv[13] - mean) * rstd); o1.w = pack2((gv[14] - mean) * rstd, (gv[15] - mean) * rstd);
        const int sg = fr ^ ((q & 3) | (((q >> 3) & 1) << 2));
        *(LAS u32x4*)(lds + VOFF + q * 512 + sg * 32) = o0; *(LAS u32x4*)(lds + VOFF + q * 512 + sg * 32 + 16) = o1;
    }
    __syncthreads();
    {
        const int c = tid & 255, half = tid >> 8, hw = 1 << (c >> 6);
        const LAS bf16_t* P = (const LAS bf16_t*)lds + c;
        const int t0 = half * 64;
        const float invfull = 1.0f / (float)(2 * hw);
        float s = 0.f;
        for (int j = t0 - hw; j < t0 + hw; ++j) s += bf2f(P[(8 + j) * 256]);
        for (int tl = t0; tl < t0 + 64; ++tl) {
            const int pos = pos0 + tl; const int cntw = min(pos + hw, n) - max(pos - hw, 0);
            const float inv = (cntw == 2 * hw) ? invfull : 1.0f / (float)cntw;
            CAT[(size_t)(row0 + tl) * D + 512 + c] = f2bf(s * inv - bf2f(P[(8 + tl) * 256]));
            s += bf2f(P[(8 + tl + hw) * 256]) - bf2f(P[(8 + tl - hw) * 256]);
        }
    }
    {
        const int h = w >> 1, ph = w & 1;
        const float* bs = a->in[12] + (size_t)(l * 4 + h) * 128;
        f32x4 acc[4][4];
#pragma unroll
        for (int i = 0; i < 4; ++i)
#pragma unroll
            for (int j = 0; j < 4; ++j) acc[i][j] = (f32x4){0.f, 0.f, 0.f, 0.f};
        const int qq4 = fr >> 2, p4 = fr & 3, fsw = qq4 | ((g & 1) << 2);
#pragma unroll
        for (int ks = 0; ks < 4; ++ks) {
            bf16x8 af[4];
            const int r0 = 32 * ks + 8 * g + qq4;
#pragma unroll
            for (int cf = 0; cf < 4; ++cf) { const int so = (((4 * h + cf) ^ fsw) << 5) + p4 * 8;
                const s16x4 lo = __builtin_amdgcn_ds_read_tr16_b64_v4i16((LAS s16x4*)(lds + VOFF + r0 * 512 + so));
                const s16x4 hi = __builtin_amdgcn_ds_read_tr16_b64_v4i16((LAS s16x4*)(lds + VOFF + (r0 + 4) * 512 + so));
                af[cf] = __builtin_shufflevector(lo, hi, 0, 1, 2, 3, 4, 5, 6, 7); }
#pragma unroll
            for (int cf = 0; cf < 4; ++cf)
#pragma unroll
                for (int pf = 0; pf < 4; ++pf) acc[cf][pf] = __builtin_amdgcn_mfma_f32_16x16x32_bf16(af[cf], wfrag[ks][pf], acc[cf][pf], 0, 0, 0);
        }
#pragma unroll
        for (int pf = 0; pf < 4; ++pf) { const int p = ph * 64 + 16 * pf + fr; const float bias = bs[p];
#pragma unroll
            for (int cf = 0; cf < 4; ++cf) { const int c0 = h * 64 + 16 * cf + 4 * g;
                const u32x2 uw = *(const u32x2*)(Z + (size_t)(row0 + p) * ZC + 1280 + c0);
                u32x2 o; o.x = pack2(gelu_erf(lo2f(uw.x)) * (acc[cf][pf][0] + bias), gelu_erf(hi2f(uw.x)) * (acc[cf][pf][1] + bias));
                o.y = pack2(gelu_erf(lo2f(uw.y)) * (acc[cf][pf][2] + bias), gelu_erf(hi2f(uw.y)) * (acc[cf][pf][3] + bias));
                *(u32x2*)(CAT + (size_t)(row0 + p) * D + 768 + c0) = o; } }
    }
    __syncthreads();
}

__device__ __forceinline__ void mixer_attn(AP a, LAS unsigned char* lds, int l, int row0, int seq_row0, int pos0, int n, int b, bool is_ctx, int kvh) {
    const int tid = tid_opaque(), lane = tid & 63, w = __builtin_amdgcn_readfirstlane(tid >> 6), fr = lane & 15, g = lane >> 4;
    const bf16_t* Z = (const bf16_t*)(a->ws + WS_Z);
    bf16_t* CAT = (bf16_t*)(a->ws + WS_CAT);
    __syncthreads();
    ((LAS u32x4*)(lds + 98304))[tid] = ((const u32x4*)(a->ws + WS_ROPE))[tid];
    const LAS f32x2* rope = (const LAS f32x2*)(lds + 98304);
    constexpr float QS = 0.125f * 1.44269504088896341f;
    constexpr int QS_OFF = 0, KS_OFF = 32768, VS_OFF = 65536;
    const int nbq = pos0 >> 7;
    unsigned bmask = 0x18u;
    if (!is_ctx) { if (nbq > 0) bmask |= 1u; bmask |= 2u; if (nbq + 1 < (n >> 7)) bmask |= 4u; }
    const int kr = tid >> 2, kax = (tid >> 1) & 1, kh8 = tid & 1;
#define MX_KSRC(blk) (Z + (size_t)((((blk) < 3) ? seq_row0 + (nbq + (blk) - 1) * 128 : NLAT + b * 256 + ((blk) - 3) * 128) + kr) * ZC + 768 + kvh * 64 + kax * 32 + kh8 * 8)
#define MX_VSTAGE(blk, buf) do { const bool _band = (blk) < 3; const int _key0 = _band ? (nbq + (blk) - 1) * 128 : ((blk) - 3) * 128; \
        const bf16_t* _vs = _band ? (const bf16_t*)(a->ws + WS_VT) + (size_t)(b * 2 + kvh) * 64 * 4096 + _key0 : (const bf16_t*)(a->ws + WS_VTC) + (size_t)(b * 2 + kvh) * 64 * 256 + _key0; \
        const int _vld = _band ? 4096 : 256; \
        _Pragma("unroll") for (int _i = 0; _i < 2; ++_i) { const int _P = _i * 512 + tid, _d = _P >> 4, _c = (_P & 15) ^ (_d & 15); \
            glds16(_vs + (size_t)_d * _vld + _c * 8, lds + VS_OFF + (buf) * 16384 + _i * 8192 + w * 1024); } } while (0)
    {
        __syncthreads();
#pragma unroll
        for (int it = 0; it < 2; ++it) {
            const int item = tid + 512 * it, r = item >> 2, ax = (item >> 1) & 1, h8 = item & 1, i = r & 127, qpos = pos0 + i;
            const bf16_t* src = Z + (size_t)(row0 + i) * ZC + 512 + (2 * kvh + (r >> 7)) * 64 + ax * 32 + h8 * 8;
            u32x4 wl = ld16g(src), wh = ld16g(src + 16);
            rope_pack8(wl, wh, rope + (ax ? (qpos & 63) : (qpos >> 6)) * 16 + h8 * 8, !is_ctx, QS);
            const int ch = ax * 4 + h8, sw = (r >> 1) & 7;
            *(LAS u32x4*)(lds + QS_OFF + r * 128 + ((ch ^ sw) << 4)) = wl;
            *(LAS u32x4*)(lds + QS_OFF + r * 128 + (((ch + 2) ^ sw) << 4)) = wh;
        }
        const int hh = w >> 2, qb = (w & 3) * 32, h = 2 * kvh + hh;
        float m[2], lsum[2];
        m[0] = m[1] = a->in[8][l * 4 + h] * 1.44269504088896341f;
        lsum[0] = lsum[1] = (g == 0) ? 1.0f : 0.0f;
        f32x4 O[4][2];
#pragma unroll
        for (int i = 0; i < 4; ++i) { O[i][0] = (f32x4){0.f, 0.f, 0.f, 0.f}; O[i][1] = (f32x4){0.f, 0.f, 0.f, 0.f}; }
        bf16x8 Qf[2][2];
        bool have_q = false;
        unsigned rem = bmask;
        int cur = __builtin_ctz(rem); rem &= rem - 1u;
        int buf = 0;
        u32x4 kl = ld16g(MX_KSRC(cur)), kh = ld16g(MX_KSRC(cur) + 16);
        MX_VSTAGE(cur, 0);
#pragma unroll 1
        for (;;) {
            const int jb = cur - 1; const bool band = cur < 3;
            {
                const int kpos = (nbq + jb) * 128 + kr;
                rope_pack8(kl, kh, rope + (kax ? (kpos & 63) : (kpos >> 6)) * 16 + kh8 * 8, band, 1.0f);
                const int ch = kax * 4 + kh8, sw = (kr >> 1) & 7;
                *(LAS u32x4*)(lds + KS_OFF + buf * 16384 + kr * 128 + ((ch ^ sw) << 4)) = kl;
                *(LAS u32x4*)(lds + KS_OFF + buf * 16384 + kr * 128 + (((ch + 2) ^ sw) << 4)) = kh;
            }
            asm volatile("s_waitcnt vmcnt(0)" ::: "memory");
            __syncthreads();
            const int nxt = rem ? __builtin_ctz(rem) : -1; rem &= rem - 1u;
            if (nxt >= 0) { kl = ld16g(MX_KSRC(nxt)); kh = ld16g(MX_KSRC(nxt) + 16); MX_VSTAGE(nxt, buf ^ 1); }
            if (!have_q) {
#pragma unroll
                for (int qf = 0; qf < 2; ++qf)
#pragma unroll
                    for (int ks = 0; ks < 2; ++ks) { const int r = hh * 128 + qb + 16 * qf + fr; Qf[qf][ks] = *(const LAS bf16x8*)(lds + QS_OFF + r * 128 + (((4 * ks + g) ^ ((r >> 1) & 7)) << 4)); }
                have_q = true;
            }
            const int kso = KS_OFF + buf * 16384, vso = VS_OFF + buf * 16384;
            f32x4 S[8][2];
#pragma unroll
            for (int kf = 0; kf < 8; ++kf) { S[kf][0] = (f32x4){0.f, 0.f, 0.f, 0.f}; S[kf][1] = (f32x4){0.f, 0.f, 0.f, 0.f}; }
#pragma unroll
            for (int kf = 0; kf < 8; ++kf)
#pragma unroll
                for (int ks = 0; ks < 2; ++ks) { const int r = 16 * kf + fr;
                    const bf16x8 kfr = *(const LAS bf16x8*)(lds + kso + r * 128 + (((4 * ks + g) ^ ((r >> 1) & 7)) << 4));
                    S[kf][0] = __builtin_amdgcn_mfma_f32_16x16x32_bf16(kfr, Qf[0][ks], S[kf][0], 0, 0, 0);
                    S[kf][1] = __builtin_amdgcn_mfma_f32_16x16x32_bf16(kfr, Qf[1][ks], S[kf][1], 0, 0, 0); }
            bf16x8 Pp[4][2];
#pragma unroll
            for (int qf = 0; qf < 2; ++qf) {
                const int qi = qb + 16 * qf + fr;
                if (band && jb != 0) {
#pragma unroll
                    for (int kf = 0; kf < 8; ++kf)
#pragma unroll
                        for (int r = 0; r < 4; ++r) { const int kk = 16 * kf + 4 * g + r; const bool ok = (jb < 0) ? (kk >= qi) : (kk <= qi); if (!ok) S[kf][qf][r] = -1.0e30f; }
                }
                float mx = S[0][qf][0];
#pragma unroll
                for (int kf = 0; kf < 8; ++kf)
#pragma unroll
                    for (int r = 0; r < 4; ++r) mx = fmaxf(mx, S[kf][qf][r]);
                mx = fmaxf(mx, __shfl_xor(mx, 16)); mx = fmaxf(mx, __shfl_xor(mx, 32));
                const float mn = fmaxf(m[qf], mx), corr = __builtin_amdgcn_exp2f(m[qf] - mn);
                m[qf] = mn;
                float ps = 0.f;
#pragma unroll
                for (int kf = 0; kf < 8; ++kf)
#pragma unroll
                    for (int r = 0; r < 4; ++r) { const float p = __builtin_amdgcn_exp2f(S[kf][qf][r] - mn); S[kf][qf][r] = p; ps += p; }
                lsum[qf] = lsum[qf] * corr + ps;
#pragma unroll
                for (int df = 0; df < 4; ++df) O[df][qf] *= corr;
#pragma unroll
                for (int t = 0; t < 4; ++t) { u32x4 pw; pw.x = pack2(S[2 * t][qf][0], S[2 * t][qf][1]); pw.y = pack2(S[2 * t][qf][2], S[2 * t][qf][3]);
                    pw.z = pack2(S[2 * t + 1][qf][0], S[2 * t + 1][qf][1]); pw.w = pack2(S[2 * t + 1][qf][2], S[2 * t + 1][qf][3]); Pp[t][qf] = __builtin_bit_cast(bf16x8, pw); }
            }
#pragma unroll
            for (int t = 0; t < 4; ++t)
#pragma unroll
                for (int df = 0; df < 4; ++df) { const int d = 16 * df + fr;
                    const u32x2 v0 = *(const LAS u32x2*)(lds + vso + d * 256 + (((4 * t + (g >> 1)) ^ (d & 15)) << 4) + (g & 1) * 8);
                    const u32x2 v1 = *(const LAS u32x2*)(lds + vso + d * 256 + (((4 * t + 2 + (g >> 1)) ^ (d & 15)) << 4) + (g & 1) * 8);
                    u32x4 vw; vw.x = v0.x; vw.y = v0.y; vw.z = v1.x; vw.w = v1.y; const bf16x8 vf = __builtin_bit_cast(bf16x8, vw);
                    O[df][0] = __builtin_amdgcn_mfma_f32_16x16x32_bf16(vf, Pp[t][0], O[df][0], 0, 0, 0);
                    O[df][1] = __builtin_amdgcn_mfma_f32_16x16x32_bf16(vf, Pp[t][1], O[df][1], 0, 0, 0); }
            if (nxt < 0) break;
            cur = nxt; buf ^= 1;
        }
#pragma unroll
        for (int qf = 0; qf < 2; ++qf) {
            float lt = lsum[qf]; lt += __shfl_xor(lt, 16); lt += __shfl_xor(lt, 32);
            const float inv = 1.0f / lt;
            bf16_t* dst = CAT + (size_t)(row0 + qb + 16 * qf + fr) * D + 256 + h * 64 + 4 * g;
#pragma unroll
            for (int df = 0; df < 4; ++df) { u32x2 o; o.x = pack2(O[df][qf][0] * inv, O[df][qf][1] * inv); o.y = pack2(O[df][qf][2] * inv, O[df][qf][3] * inv); *(u32x2*)(dst + 16 * df) = o; }
        }
    }
#undef MX_KSRC
#undef MX_VSTAGE
    __syncthreads();
}

constexpr int FF_DA = 0, FF_DC = 32768, FF_XT = 49152  , FF_Z2 = 81920  , FF_OB = 114688  ;
__device__ __forceinline__ int ff_addr(int row, int k) { return row * 256 + ((((k >> 3) ^ (row & 15))) << 4) + (k & 7) * 2; }
__device__ __forceinline__ float cos_turns(float x) { return __builtin_amdgcn_cosf(x); }
__device__ __forceinline__ float sin_turns(float x) { return __builtin_amdgcn_sinf(x); }
__device__ __forceinline__ void fft_setup(LAS unsigned char* lds) {
    const int tid = tid_opaque();
    __syncthreads();
    for (int idx = tid; idx < 16384; idx += NT) { const int i = idx >> 7, k = idx & 127, ro = i >> 6, k1 = i & 63, part = k >> 6, n1 = k & 63; const float t = (float)((k1 * n1) & 63) * (1.0f / 64.0f);
        const float c = cos_turns(t), sn = sin_turns(t);
        const float v = (ro == 0) ? (part == 0 ? c : sn) : (part == 0 ? -sn : c);
        *(LAS bf16_t*)(lds + FF_DA + ff_addr(i, k)) = f2bf(v * 0.125f); }
    for (int idx = tid; idx < 8192; idx += NT) { const int k2 = idx >> 7, k = idx & 127, ri = k >> 6, n2 = k & 63; const float t = (float)((k2 * n2) & 63) * (1.0f / 64.0f);
        const float v = (ri == 0) ? cos_turns(t) : sin_turns(t);
        *(LAS bf16_t*)(lds + FF_DC + ff_addr(k2, k)) = f2bf(v * 0.125f); }
    __syncthreads();
}
__device__ __forceinline__ void fft_unit(AP a, LAS unsigned char* lds, int b, int cg) {
    const int tid = tid_opaque(), lane = tid & 63, w = __builtin_amdgcn_readfirstlane(tid >> 6), fr = lane & 15, g = lane >> 4;
    const int mf = w & 3, nh = w >> 2;
    const bf16_t* AT = (const bf16_t*)(a->ws + WS_AT) + (size_t)(b * 256 + cg * 4) * 8192;
    u32x4 xin[2][2];
#pragma unroll
    for (int h = 0; h < 2; ++h)
#pragma unroll
        for (int it = 0; it < 2; ++it) xin[h][it] = ld16g(AT + (size_t)h * 8192 + (size_t)(tid + 512 * it) * 8);
#pragma unroll 1
    for (int cp = 0; cp < 2; ++cp) {
#pragma unroll
        for (int h = 0; h < 2; ++h)
#pragma unroll
            for (int it = 0; it < 2; ++it) { const int q = tid + 512 * it, part = q >> 9, pos0 = (q & 511) * 8, n1 = pos0 >> 6, n2 = pos0 & 63, k = part * 64 + n1;
                const unsigned wv[4] = {xin[h][it].x, xin[h][it].y, xin[h][it].z, xin[h][it].w};
#pragma unroll
                for (int e = 0; e < 4; ++e) { *(LAS bf16_t*)(lds + FF_XT + h * 16384 + ff_addr(n2 + 2 * e, k)) = (bf16_t)(wv[e] & 0xffffu); *(LAS bf16_t*)(lds + FF_XT + h * 16384 + ff_addr(n2 + 2 * e + 1, k)) = (bf16_t)(wv[e] >> 16); } }
        if (cp == 0) {
#pragma unroll
            for (int h = 0; h < 2; ++h)
#pragma unroll
                for (int it = 0; it < 2; ++it) xin[h][it] = ld16g(AT + (size_t)(2 + h) * 8192 + (size_t)(tid + 512 * it) * 8); }
        __syncthreads();
        f32x4 acc[2][2][2];
#pragma unroll
        for (int h = 0; h < 2; ++h)
#pragma unroll
            for (int x = 0; x < 2; ++x) { acc[h][x][0] = (f32x4){0.f, 0.f, 0.f, 0.f}; acc[h][x][1] = (f32x4){0.f, 0.f, 0.f, 0.f}; }
#pragma unroll
        for (int ks = 0; ks < 4; ++ks) {
            bf16x8 af[2];
#pragma unroll
            for (int x = 0; x < 2; ++x) { const int i = 16 * (mf + 4 * x) + fr; af[x] = *(const LAS bf16x8*)(lds + FF_DA + i * 256 + (((4 * ks + g) ^ (i & 15)) << 4)); }
#pragma unroll
            for (int h = 0; h < 2; ++h)
#pragma unroll
                for (int n = 0; n < 2; ++n) { const int j = 16 * (2 * nh + n) + fr; const bf16x8 bfv = *(const LAS bf16x8*)(lds + FF_XT + h * 16384 + j * 256 + (((4 * ks + g) ^ (j & 15)) << 4));
                    acc[h][0][n] = __builtin_amdgcn_mfma_f32_16x16x32_bf16(af[0], bfv, acc[h][0][n], 0, 0, 0);
                    acc[h][1][n] = __builtin_amdgcn_mfma_f32_16x16x32_bf16(af[1], bfv, acc[h][1][n], 0, 0, 0); }
        }
#pragma unroll
        for (int n = 0; n < 2; ++n)
#pragma unroll
            for (int r = 0; r < 4; ++r) { const int k1 = 16 * mf + 4 * g + r, n2 = 16 * (2 * nh + n) + fr; const float t = (float)((k1 * n2) & 4095) * (1.0f / 4096.0f);
                const float c = cos_turns(t), sn = sin_turns(t);
#pragma unroll
                for (int h = 0; h < 2; ++h) { const float zr = acc[h][0][n][r], zi = acc[h][1][n][r];
                    *(LAS bf16_t*)(lds + FF_Z2 + h * 16384 + ff_addr(k1, n2)) = f2bf(zr * c + zi * sn);
                    *(LAS bf16_t*)(lds + FF_Z2 + h * 16384 + ff_addr(k1, 64 + n2)) = f2bf(zi * c - zr * sn); } }
        __syncthreads();
        f32x4 acc2[2][2];
#pragma unroll
        for (int h = 0; h < 2; ++h) { acc2[h][0] = (f32x4){0.f, 0.f, 0.f, 0.f}; acc2[h][1] = (f32x4){0.f, 0.f, 0.f, 0.f}; }
#pragma unroll
        for (int ks = 0; ks < 4; ++ks) {
            const int i = 16 * mf + fr; const bf16x8 af = *(const LAS bf16x8*)(lds + FF_DC + i * 256 + (((4 * ks + g) ^ (i & 15)) << 4));
#pragma unroll
            for (int h = 0; h < 2; ++h)
#pragma unroll
                for (int n = 0; n < 2; ++n) { const int j = 16 * (2 * nh + n) + fr; const bf16x8 bfv = *(const LAS bf16x8*)(lds + FF_Z2 + h * 16384 + j * 256 + (((4 * ks + g) ^ (j & 15)) << 4));
                    acc2[h][n] = __builtin_amdgcn_mfma_f32_16x16x32_bf16(af, bfv, acc2[h][n], 0, 0, 0); }
        }
#pragma unroll
        for (int n = 0; n < 2; ++n)
#pragma unroll
            for (int r = 0; r < 4; ++r) { const int k = 16 * (2 * nh + n) + fr + 64 * (16 * mf + 4 * g + r);
                *(LAS unsigned*)(lds + FF_OB + k * 8 + cp * 4) = pack2(acc2[0][n][r], acc2[1][n][r]); }
    }
    __syncthreads();
    bf16_t* CAT = (bf16_t*)(a->ws + WS_CAT) + (size_t)(b * 4096) * D + cg * 4;
#pragma unroll
    for (int it = 0; it < 8; ++it) { const int k = tid + 512 * it; *(u32x2*)(CAT + (size_t)k * D) = *(const LAS u32x2*)(lds + FF_OB + k * 8); }
    __syncthreads();
}

__device__ __forceinline__ void p2_mix(AP a, unsigned char* ldsg, LAS unsigned char* lds, int l) {
    const int n_tile = 128 + ((l == 0) ? 8 : 0), n_att = 2 * n_tile, n_dft = 256, n_dftc = (l == 0) ? 16 : 0;
    bf16_t* CAT = (bf16_t*)(a->ws + WS_CAT);
    bool fft_ready = false;
    for (int u = blockIdx.x; u < n_att + n_dft + n_tile + n_dftc; u += gridDim.x) {
        if (u < n_att || (u >= n_att + n_dft && u < n_att + n_dft + n_tile)) {
            const bool att = u < n_att;
            const int t = att ? (u >> 1) : (u - n_att - n_dft);
            const bool isc = t >= 128; const int tt = t - 128;
            const int b = isc ? (tt >> 1) : (t >> 5);
            const int row0 = isc ? NLAT + tt * 128 : t * 128, seq_row0 = isc ? NLAT + b * 256 : b * 4096, pos0 = isc ? (tt & 1) * 128 : (t & 31) * 128, n = isc ? 256 : 4096;
            if (att) { for (int rep = 0; rep < PROBE_MIX_REP; ++rep) mixer_attn(a, lds, l, row0, seq_row0, pos0, n, b, isc, u & 1); }
            else { for (int rep = 0; rep < PROBE_SGU_REP; ++rep) mixer_sgu_pool(a, lds, l, row0, seq_row0, pos0, n); }
            fft_ready = false;
        } else if (u < n_att + n_dft) {
            const int uu = u - n_att;
            if (!fft_ready) { fft_setup(lds); fft_ready = true; }
            for (int rep = 0; rep < PROBE_FFT_REP; ++rep) fft_unit(a, lds, uu >> 6, uu & 63);
        } else {
            const int uu = u - n_att - n_dft - n_tile, b = uu >> 2, mt = (uu >> 1) & 1, ch0 = (uu & 1) * 128;
            const bf16_t* A = (const bf16_t*)(a->ws + WS_DFTC) + (size_t)(mt * 128) * 512;
            const bf16_t* B0 = (const bf16_t*)(a->ws + WS_ATC) + ((size_t)b * 256 + ch0) * 512;
            EpiBf16 E; E.C = CAT + (size_t)(NLAT + b * 256 + mt * 128) * D + ch0; E.ld = D; E.scale = 1.0f;
            gemm_tile<128, false, EpiBf16>(lds, A, 512, nullptr, 128, B0, B0 + (size_t)64 * 512, 512, 512, E);
            fft_ready = false;
        }
    }
    exp_queue(a, ldsg, l);
}

__device__ __forceinline__ int uni(int v) { return __builtin_amdgcn_readfirstlane(v); }
__device__ __forceinline__ int vblock() { const int G = gridDim.x, b = blockIdx.x; return (G % 8 == 0) ? (b % 8) * (G / 8) + b / 8 : b; }
template <class T> __device__ __forceinline__ T* unip(T* p) { const unsigned long long v = (unsigned long long)p; const unsigned lo = __builtin_amdgcn_readfirstlane((unsigned)v), hi = __builtin_amdgcn_readfirstlane((unsigned)(v >> 32)); return (T*)(((unsigned long long)hi << 32) | lo); }
struct SchedInProj {
    typedef EpiInProj Epi; static constexpr bool GATHER = false, FP8 = false, SIGNAL = false, WAITDEP = false; unsigned* dep;
    unsigned char* ws; int l, G, me;
    __device__ __forceinline__ bool get(int i, g256::Unit<Epi>& u) const {
        const int n_lat = 64 * 7, n_ctx = (l == 0) ? 4 * 7 : 4;
        const int idx = i * G + me; if (idx >= n_lat + n_ctx) return false;
        int row0, b, ct, n; bf16_t *tF, *tV;
        if (idx < n_lat) { const int rt = idx / 7; ct = idx % 7; row0 = rt * 256; b = row0 >> 12; n = 4096;
            tF = (bf16_t*)(ws + WS_AT) + (size_t)b * 256 * 2 * 4096; tV = (bf16_t*)(ws + WS_VT) + (size_t)b * 128 * 4096; }
        else { const int uu = idx - n_lat; int rt; if (l == 0) { rt = uu / 7; ct = uu % 7; } else { rt = uu; ct = 3; }
            row0 = NLAT + rt * 256; b = rt; n = 256;
            tF = (bf16_t*)(ws + WS_ATC) + (size_t)b * 256 * 2 * 256; tV = (bf16_t*)(ws + WS_VTC) + (size_t)b * 128 * 256; }
        u.A = (const bf16_t*)(ws + WS_H) + (size_t)row0 * D;
        u.B0 = (const bf16_t*)(ws + WS_WIN) + ((size_t)l * ZC + ct * 256) * 1024; u.B1 = u.B0 + (size_t)128 * 1024; u.ridx = nullptr; u.valid = 256;
        u.epi.Zt = (bf16_t*)(ws + WS_Z) + (size_t)row0 * ZC + ct * 256; u.epi.tF = tF; u.epi.tV = tV; u.epi.n0 = ct * 256; u.epi.pos0 = (idx < n_lat) ? (row0 & 4095) : 0; u.epi.n = n;
        return true;
    }
};
struct SchedOutProj {
    typedef EpiBf16 Epi; static constexpr bool GATHER = false, FP8 = false, SIGNAL = false, WAITDEP = false; unsigned* dep;
    unsigned char* ws; int l, G, me;
    __device__ __forceinline__ bool get(int i, g256::Unit<Epi>& u) const {
        const int nrt = NLAT / 256;
        const int idx = i * G + me; if (idx >= nrt * 4) return false;
        const int rt = idx >> 2, ct = idx & 3;
        u.A = (const bf16_t*)(ws + WS_CAT) + (size_t)(rt * 256) * D;
        u.B0 = (const bf16_t*)(ws + WS_WOUT) + ((size_t)l * 1024 + ct * 256) * 1024; u.B1 = u.B0 + (size_t)128 * 1024; u.ridx = nullptr; u.valid = 256;
        u.epi.C = (bf16_t*)(ws + WS_Y) + (size_t)(rt * 256) * D + ct * 256; u.epi.ld = D; u.epi.scale = 1.0f;
        return true;
    }
};
__device__ __forceinline__ void moe_units(const LAS int* blk, LAS int* uinf, int G, int me) {
    const int i = threadIdx.x;
    if (i < 8) { const int idx = i * G + me, nu = blk[32] * 4; int e = 0, valid = 0;
        if (idx < nu) { const int rb = idx >> 2; for (int q = 1; q < 32; ++q) if (blk[q] <= rb) e = q; valid = min(256, blk[33 + e] - (rb - blk[e]) * 256); }
        uinf[2 * i] = e; uinf[2 * i + 1] = valid; }
    __syncthreads();
}
struct SchedGateUp {
    typedef EpiGateUp8 Epi; static constexpr bool GATHER = true, FP8 = true, SIGNAL = true, WAITDEP = false; unsigned* dep;
    unsigned char* ws; const LAS int* uinf; const LAS int* ridx_lds; int G, me, l, nu;
    __device__ __forceinline__ bool get(int i, g256::Unit<Epi>& u) const {
        const int idx = i * G + me; if (idx >= nu) return false;
        const int rb = idx >> 2, ct = idx & 3, e = uni(uinf[2 * i]);
        u.A = (const bf16_t*)(ws + WS_H8);
        { const unsigned char* b0 = ws + WS_WEXP + (size_t)l * WEXP_LAYER + ((size_t)e * 512 + ct * 128) * 1024; u.B0 = (const bf16_t*)b0; u.B1 = (const bf16_t*)(b0 + EXPMAT); }
        u.ridx = ridx_lds + (i & 7) * 256; u.valid = uni(uinf[2 * i + 1]);
        u.epi.C = ws + WS_HID + (size_t)(rb * 256) * DEXP + ct * 128; u.epi.ld = DEXP; u.tag = rb;
        return true;
    }
};
struct SchedDown {
    typedef EpiFp8 Epi; static constexpr bool GATHER = false, FP8 = true, SIGNAL = false, WAITDEP = true; unsigned* dep;
    unsigned char* ws; const LAS int* uinf; int G, me, l, nu;
    __device__ __forceinline__ bool get(int i, g256::Unit<Epi>& u) const {
        const int idx = i * G + me; if (idx >= nu) return false;
        const int rb = idx >> 2, ct = idx & 3, e = uni(uinf[2 * i]);
        u.A = (const bf16_t*)(ws + WS_HID + (size_t)(rb * 256) * DEXP);
        { const unsigned char* b0 = ws + WS_WEXP + (size_t)l * WEXP_LAYER + 2 * EXPMAT + ((size_t)e * 1024 + ct * 256) * 512; u.B0 = (const bf16_t*)b0; u.B1 = (const bf16_t*)(b0 + (size_t)128 * 512); } u.ridx = nullptr; u.valid = 256;
        u.epi.C = ws + WS_YS + (size_t)(rb * 256) * D + ct * 256; u.epi.ld = D; u.epi.scale = 1.0f / 32.0f; u.tag = rb;
        return true;
    }
};

template <int l> __device__ __forceinline__ void p4_ln1_router(AP a, unsigned char* lds) {
    const int tid = tid_opaque(), lane = tid & 63, w = tid >> 6;
    const int ntok = (l == 0) ? NTOK : NLAT;
    int* cnt = (int*)(lds + MISC_OFF);
    if (tid < 32) cnt[tid] = 0;
    f32x4* Lg = (f32x4*)lds; f32x4* Le = (f32x4*)(lds + 16384); f32x4* Lgb = (f32x4*)(lds + 147456);
    {
        const float* wrg_ = a->in[16] + (size_t)l * 1024 * 4; const float* wre_ = a->in[17] + (size_t)l * 1024 * 32;
#pragma unroll
        for (int it = 0; it < 2; ++it) { const int c = tid + 512 * it, slot = (((c >> 8) * 4 + (c & 3)) << 6) + ((c >> 2) & 63);
            Lg[slot] = *(const f32x4*)(wrg_ + (size_t)c * 4);
#pragma unroll
            for (int q = 0; q < 8; ++q) Le[q * 1024 + slot] = *(const f32x4*)(wre_ + (size_t)c * 32 + q * 4); }
        Lgb[tid] = (tid < 256) ? *(const f32x4*)(a->in[14] + l * 1024 + tid * 4) : *(const f32x4*)(a->in[15] + l * 1024 + (tid - 256) * 4);
    }
    __syncthreads();
    const float* mod = (const float*)(a->ws + WS_MOD) + (size_t)l * 5 * 6144;
    const bf16_t* Y = (const bf16_t*)(a->ws + WS_Y);
    bf16_t* X1 = (bf16_t*)(a->ws + WS_X1);
    unsigned char* H8 = a->ws + WS_H8;
    int* tokE = (int*)(a->ws + WS_TOKE); int* tokR = (int*)(a->ws + WS_TOKR); float* tokG = (float*)(a->ws + WS_TOKG);
    const int tstep = gridDim.x * 8;
    f32x4 nx[4]; u32x2 nxb[4], ny[4];
    const bf16_t* XC = (const bf16_t*)(a->ws + WS_XC);
    {   const int t = blockIdx.x * 8 + w;
        if (t < ntok) { const float* xs = (t < NLAT) ? a->in[0] + (size_t)t * D : a->in[2] + (size_t)(t - NLAT) * D;
#pragma unroll
            for (int i = 0; i < 4; ++i) { if (l == 0) nx[i] = *(const f32x4*)(xs + 256 * i + 4 * lane); else nxb[i] = *(const u32x2*)(XC + (size_t)t * D + 256 * i + 4 * lane);
                ny[i] = *(const u32x2*)(Y + (size_t)t * D + 256 * i + 4 * lane); } } }
    int mrow = -1; f32x4 mg[4], msh[4], msc[4];
    for (int t = blockIdx.x * 8 + w; t < ntok; t += tstep) {
        const int mr = (t < NLAT) ? (t >> 12) : 4;
        if (mr != mrow) { mrow = mr; const float* m = mod + (size_t)mr * 6144;
#pragma unroll
            for (int i = 0; i < 4; ++i) { const int c = 256 * i + 4 * lane; mg[i] = *(const f32x4*)(m + 2048 + c); msh[i] = *(const f32x4*)(m + 3072 + c); msc[i] = *(const f32x4*)(m + 4096 + c); } }
        f32x4 v[4];
#pragma unroll
        for (int i = 0; i < 4; ++i) { const f32x4 yv = (f32x4){lo2f(ny[i].x), hi2f(ny[i].x), lo2f(ny[i].y), hi2f(ny[i].y)};
            const f32x4 xv = (l == 0) ? nx[i] : (f32x4){lo2f(nxb[i].x), hi2f(nxb[i].x), lo2f(nxb[i].y), hi2f(nxb[i].y)};
#pragma unroll
            for (int e = 0; e < 4; ++e) v[i][e] = RES_ALPHA * xv[e] + mg[i][e] * yv[e]; }
        {   const int tn = t + tstep;
            if (tn < ntok) { const float* xs = (tn < NLAT) ? a->in[0] + (size_t)tn * D : a->in[2] + (size_t)(tn - NLAT) * D;
#pragma unroll
                for (int i = 0; i < 4; ++i) { if (l == 0) nx[i] = *(const f32x4*)(xs + 256 * i + 4 * lane); else nxb[i] = *(const u32x2*)(XC + (size_t)tn * D + 256 * i + 4 * lane);
                    ny[i] = *(const u32x2*)(Y + (size_t)tn * D + 256 * i + 4 * lane); } } }
        float mean, rstd; ln_stats(v, mean, rstd);
#pragma unroll
        for (int i = 0; i < 4; ++i) { const int c = 256 * i + 4 * lane; const f32x4 gg = Lgb[64 * i + lane], bb = Lgb[256 + 64 * i + lane];
#pragma unroll
            for (int e = 0; e < 4; ++e) v[i][e] = (v[i][e] - mean) * rstd * gg[e] + bb[e];
            { u32x2 pk; pk.x = pack2(v[i][0], v[i][1]); pk.y = pack2(v[i][2], v[i][3]); *(u32x2*)(X1 + (size_t)t * D + c) = pk; } }
        ln_stats(v, mean, rstd);
#pragma unroll
        for (int i = 0; i < 4; ++i) { const int c = 256 * i + 4 * lane; const f32x4 sh = msh[i], sc = msc[i];
#pragma unroll
            for (int e = 0; e < 4; ++e) v[i][e] = (v[i][e] - mean) * rstd * (1.0f + sc[e]) + sh[e];
            *(unsigned*)(H8 + (size_t)t * D + c) = pack4_fp8(v[i][0], v[i][1], v[i][2], v[i][3]); }
        f32x2 lg01 = (f32x2){0.f, 0.f}, lg23 = (f32x2){0.f, 0.f};
#pragma unroll
        for (int i = 0; i < 4; ++i)
#pragma unroll
            for (int e = 0; e < 4; ++e) { const f32x4 wv = Lg[((i * 4 + e) << 6) + lane]; const f32x2 vv = (f32x2){v[i][e], v[i][e]};
                lg01 += vv * (f32x2){wv[0], wv[1]}; lg23 += vv * (f32x2){wv[2], wv[3]}; }
        float lg[4]; wave_sum4(lg01[0], lg01[1], lg23[0], lg23[1], lg);
        int grp = 0; float mx = lg[0];
#pragma unroll
        for (int q = 1; q < 4; ++q) if (lg[q] > mx) { mx = lg[q]; grp = q; }
        float se = 0.f;
#pragma unroll
        for (int q = 0; q < 4; ++q) se += __expf(lg[q] - mx);
        const float gate_group = __builtin_amdgcn_rcpf(se);
        f32x2 le01 = (f32x2){0.f, 0.f}, le23 = (f32x2){0.f, 0.f}, le45 = (f32x2){0.f, 0.f}, le67 = (f32x2){0.f, 0.f};
#pragma unroll
        for (int i = 0; i < 4; ++i)
#pragma unroll
            for (int e = 0; e < 4; ++e) { const f32x4* wp = Le + grp * 2048 + ((i * 4 + e) << 6) + lane; const f32x4 w0 = wp[0], w1 = wp[1024]; const f32x2 vv = (f32x2){v[i][e], v[i][e]};
                le01 += vv * (f32x2){w0[0], w0[1]}; le23 += vv * (f32x2){w0[2], w0[3]}; le45 += vv * (f32x2){w1[0], w1[1]}; le67 += vv * (f32x2){w1[2], w1[3]}; }
        float le[8]; { const float lp[8] = {le01[0], le01[1], le23[0], le23[1], le45[0], le45[1], le67[0], le67[1]}; wave_sum8(lp, lane, le); }
        int j1 = 0; float l1 = le[0];
#pragma unroll
        for (int q = 1; q < 8; ++q) if (le[q] > l1) { l1 = le[q]; j1 = q; }
        int j2 = -1; float l2 = -3.0e38f;
#pragma unroll
        for (int q = 0; q < 8; ++q) if (q != j1 && le[q] > l2) { l2 = le[q]; j2 = q; }
        const float e2 = __expf(l2 - l1), p1 = __builtin_amdgcn_rcpf(1.0f + e2), p2 = e2 * p1;
        if (lane == 0) {
            const int ex0 = grp * 8 + j1, ex1 = grp * 8 + j2;
            const int r0 = atomicAdd(&cnt[ex0], 1), r1 = atomicAdd(&cnt[ex1], 1);
            tokE[2 * t] = ex0; tokE[2 * t + 1] = ex1; tokR[2 * t] = r0; tokR[2 * t + 1] = r1;
            tokG[2 * t] = gate_group * p1; tokG[2 * t + 1] = gate_group * p2;
        }
    }
    __syncthreads();
    if (tid < 32) ((int*)(a->ws + WS_BCNT))[((size_t)l * MAXG + blockIdx.x) * 32 + tid] = cnt[tid];
    __syncthreads();
}

__device__ __forceinline__ void p5_dispatch(AP a, unsigned char* lds, int l) {
    const int tid = tid_opaque();
    const int ntok = (l == 0) ? NTOK : NLAT;
    int* part = (int*)lds;
    int* tot = (int*)(lds + 4096);
    int* off = (int*)(lds + 4096 + 128);
    int* pstart = (int*)(lds + 4096 + 256);
    const int* bc = (const int*)(a->ws + WS_BCNT) + (size_t)l * MAXG * 32;
    const int G = gridDim.x, me = blockIdx.x;
    { const int e = tid & 31, p = tid >> 5; int s = 0, so = 0; for (int bb = p; bb < G; bb += 16) { const int c = bc[bb * 32 + e]; s += c; if (bb < me) so += c; } part[p * 32 + e] = s; part[512 + p * 32 + e] = so; }
    __syncthreads();
    if (tid < 32) { int s = 0, so = 0; for (int p = 0; p < 16; ++p) { s += part[p * 32 + tid]; so += part[512 + p * 32 + tid]; } tot[tid] = s; off[tid] = so; }
    __syncthreads();
    if (tid == 0) { int acc = 0; for (int e = 0; e < 32; ++e) { pstart[e] = acc; acc += ((tot[e] + 255) >> 8) << 8; } }
    __syncthreads();
    if (me == 0 && tid < 32) ((int*)(a->ws + WS_CNT))[l * 32 + tid] = tot[tid];
    const int* tokE = (const int*)(a->ws + WS_TOKE); const int* tokR = (const int*)(a->ws + WS_TOKR);
    int* tokS = (int*)(a->ws + WS_TOKS); int* slotT = (int*)(a->ws + WS_SLOTT);
    for (int q = tid; ; q += NT) { const int it = q >> 4, j = q & 15, t = (it * G + me) * 8 + (j >> 1); if (t >= ntok) break;
        const int idx = 2 * t + (j & 1); const int e = tokE[idx]; const int slot = pstart[e] + off[e] + tokR[idx]; tokS[idx] = slot; slotT[slot] = t; }
    __syncthreads();
}

__device__ __forceinline__ void moe_table(AP a, int l, LAS int* blk) {
    const int* tot = (const int*)(a->ws + WS_CNT) + l * 32;
    __syncthreads();
    if (threadIdx.x < 32) blk[33 + threadIdx.x] = tot[threadIdx.x];
    __syncthreads();
    if (threadIdx.x == 0) { int acc = 0; for (int e = 0; e < 32; ++e) { blk[e] = acc; acc += (blk[33 + e] + 255) >> 8; } blk[32] = acc; }
    __syncthreads();
}
__device__ __forceinline__ int units_of(int nu, int v, int G) { return (v < nu) ? (nu - v + G - 1) / G : 0; }
__device__ __forceinline__ void p1_inproj(AP a, unsigned char* smem, LAS unsigned char* lds, int l) {
    SchedInProj S; S.ws = a->ws; S.l = l; S.G = gridDim.x; S.me = vblock();
    g256::gemm_phase(lds, 1024, S);
    { const int nu = (l == 0) ? 64 * 7 + 4 * 7 : 64 * 7 + 4, G = gridDim.x; if (units_of(nu, S.me, G) < (nu + G - 1) / G) exp_fill(a, smem, l, 8); }
}
__device__ __forceinline__ void p3_outproj(AP a, unsigned char* smem, LAS unsigned char* lds, int l) {
    SchedOutProj S; S.ws = a->ws; S.l = l; S.G = gridDim.x; S.me = vblock();
    g256::gemm_phase(lds, 1024, S);
    if (l == 0) {
        const bf16_t* W = (const bf16_t*)(a->ws + WS_WOUT);
        for (int u = blockIdx.x; u < 64; u += gridDim.x) { const int rt = u >> 3, ct = u & 7;
            EpiBf16 E; E.C = (bf16_t*)(a->ws + WS_Y) + (size_t)(NLAT + rt * 128) * D + ct * 128; E.ld = D; E.scale = 1.0f;
            const bf16_t* B0 = W + (size_t)(ct * 128) * 1024;
            gemm_tile<128, false, EpiBf16>(lds, (const bf16_t*)(a->ws + WS_CAT) + (size_t)(NLAT + rt * 128) * D, D, nullptr, 128, B0, B0 + (size_t)64 * 1024, 1024, 1024, E); }
        if (blockIdx.x >= 64) exp_fill(a, smem, 0, 3);
    }
}
__device__ __forceinline__ void p6_gateup(AP a, unsigned char* smem, LAS unsigned char* lds, int l) {
    LAS int* blk = (LAS int*)(lds + MISC_OFF + 256);
    moe_table(a, l, blk);
    LAS int* ridx = (LAS int*)(lds + RIDX_OFF);
    const int tid = tid_opaque(), G = gridDim.x, me = vblock(), nu = uni(blk[32]) * 4;
    LAS int* uinf = (LAS int*)(lds + MISC_OFF + 528);
    moe_units(blk, uinf, G, me);
    const int* slotT = (const int*)(a->ws + WS_SLOTT);
    for (int i = 0; i < 8; ++i) { const int idx = i * G + me; if (idx >= nu) break;
        const int rb = idx >> 2, valid = uinf[2 * i + 1];
        if (tid < 256) ridx[i * 256 + tid] = (tid < valid) ? slotT[rb * 256 + tid] : 0; }
    __syncthreads();
    SchedGateUp S; S.ws = a->ws; S.uinf = uinf; S.ridx_lds = ridx; S.G = G; S.me = me; S.l = l; S.nu = nu; S.dep = (unsigned*)(a->ws + WS_BAR + 14336 + 512) + l * 192;
    g256::gemm_phase(lds, 512, S);
    __syncthreads();
}
__device__ __forceinline__ void p7_down(AP a, unsigned char* smem, LAS unsigned char* lds, int l) {
    LAS int* blk = (LAS int*)(lds + MISC_OFF + 256);
    moe_table(a, l, blk);
    LAS int* uinf = (LAS int*)(lds + MISC_OFF + 528);
    SchedDown S; S.ws = a->ws; S.uinf = uinf; S.G = gridDim.x; S.me = (int)gridDim.x - 1 - vblock(); S.l = l; S.nu = uni(blk[32]) * 4; S.dep = (unsigned*)(a->ws + WS_BAR + 14336 + 512) + l * 192;
    moe_units(blk, uinf, S.G, S.me);
    g256::gemm_phase(lds, 256, S);
    __syncthreads();
    { const int nu = S.nu, G = gridDim.x; if (l == 0 && units_of(nu, vblock(), G) < (nu + G - 1) / G) exp_fill(a, smem, 1, 2); }
}

template <int l> __device__ __forceinline__ void p8_ln2(AP a, unsigned char* lds) {
    const int tid = tid_opaque(), lane = tid & 63, w = tid >> 6;
    const int ntok = (l == 0) ? NTOK : NLAT;
    const float* mod = (const float*)(a->ws + WS_MOD) + (size_t)l * 5 * 6144;
    const float* modn = (const float*)(a->ws + WS_MOD) + (size_t)5 * 6144;
    const bf16_t* X1 = (const bf16_t*)(a->ws + WS_X1);
    const unsigned char* YS = a->ws + WS_YS;
    const int* tokS = (const int*)(a->ws + WS_TOKS); const float* tokG = (const float*)(a->ws + WS_TOKG);
    f32x4* Lgb = (f32x4*)lds;
    __syncthreads();
    Lgb[tid] = (tid < 256) ? *(const f32x4*)(a->in[21] + l * 1024 + tid * 4) : *(const f32x4*)(a->in[22] + l * 1024 + (tid - 256) * 4);
    __syncthreads();
    int mrow = -1; f32x4 mg[4], nsh[4], nsc[4];
    const int tstep = gridDim.x * 8;
    int t = blockIdx.x * 8 + w;
    int ns0 = 0, ns1 = 0; float nga = 0.f, ngb = 0.f;
    u32x2 nx[4]; unsigned nya[4], nyb[4];
    float cga = 0.f, cgb = 0.f;
    if (t < ntok) { const int s0 = tokS[2 * t], s1 = tokS[2 * t + 1]; cga = tokG[2 * t]; cgb = tokG[2 * t + 1];
#pragma unroll
        for (int i = 0; i < 4; ++i) { const int c = 256 * i + 4 * lane; nx[i] = *(const u32x2*)(X1 + (size_t)t * D + c); nya[i] = *(const unsigned*)(YS + (size_t)s0 * D + c); nyb[i] = *(const unsigned*)(YS + (size_t)s1 * D + c); } }
    if (t + tstep < ntok) { ns0 = tokS[2 * (t + tstep)]; ns1 = tokS[2 * (t + tstep) + 1]; nga = tokG[2 * (t + tstep)]; ngb = tokG[2 * (t + tstep) + 1]; }
    for (; t < ntok; t += tstep) {
        const int mr = (t < NLAT) ? (t >> 12) : 4;
        if (mr != mrow) { mrow = mr; const float* m = mod + (size_t)mr * 6144; const float* mn = modn + (size_t)mr * 6144;
#pragma unroll
            for (int i = 0; i < 4; ++i) { const int c = 256 * i + 4 * lane; mg[i] = *(const f32x4*)(m + 5120 + c); if (l == 0) { nsh[i] = *(const f32x4*)(mn + c); nsc[i] = *(const f32x4*)(mn + 1024 + c); } } }
        f32x4 v[4];
#pragma unroll
        for (int i = 0; i < 4; ++i) { const f32x4 gv = mg[i];
            const f32x2 ya0 = __builtin_amdgcn_cvt_pk_f32_fp8(nya[i], false), ya1 = __builtin_amdgcn_cvt_pk_f32_fp8(nya[i], true), yb0 = __builtin_amdgcn_cvt_pk_f32_fp8(nyb[i], false), yb1 = __builtin_amdgcn_cvt_pk_f32_fp8(nyb[i], true);
            const float f0 = cga * ya0[0] + cgb * yb0[0], f1 = cga * ya0[1] + cgb * yb0[1], f2 = cga * ya1[0] + cgb * yb1[0], f3 = cga * ya1[1] + cgb * yb1[1];
            v[i][0] = RES_ALPHA * lo2f(nx[i].x) + gv[0] * f0; v[i][1] = RES_ALPHA * hi2f(nx[i].x) + gv[1] * f1; v[i][2] = RES_ALPHA * lo2f(nx[i].y) + gv[2] * f2; v[i][3] = RES_ALPHA * hi2f(nx[i].y) + gv[3] * f3; }
        {   const int tn = t + tstep, tn2 = t + 2 * tstep;
            if (tn < ntok) {
#pragma unroll
                for (int i = 0; i < 4; ++i) { const int c = 256 * i + 4 * lane; nx[i] = *(const u32x2*)(X1 + (size_t)tn * D + c); nya[i] = *(const unsigned*)(YS + (size_t)ns0 * D + c); nyb[i] = *(const unsigned*)(YS + (size_t)ns1 * D + c); }
                cga = nga; cgb = ngb; }
            if (tn2 < ntok) { ns0 = tokS[2 * tn2]; ns1 = tokS[2 * tn2 + 1]; nga = tokG[2 * tn2]; ngb = tokG[2 * tn2 + 1]; } }
        float mean, rstd; ln_stats(v, mean, rstd);
#pragma unroll
        for (int i = 0; i < 4; ++i) { const int c = 256 * i + 4 * lane; const f32x4 gg = Lgb[64 * i + lane], bb = Lgb[256 + 64 * i + lane];
#pragma unroll
            for (int e = 0; e < 4; ++e) v[i][e] = (v[i][e] - mean) * rstd * gg[e] + bb[e];
            if (l == 0) { u32x2 pk; pk.x = pack2(v[i][0], v[i][1]); pk.y = pack2(v[i][2], v[i][3]); *(u32x2*)((bf16_t*)(a->ws + WS_XC) + (size_t)t * D + c) = pk; }
            else *(f32x4*)(a->out + (size_t)t * D + c) = v[i]; }
        if (l == 0) {
            ln_stats(v, mean, rstd);
            bf16_t* H = (bf16_t*)(a->ws + WS_H);
#pragma unroll
            for (int i = 0; i < 4; ++i) { const int c = 256 * i + 4 * lane; const f32x4 sh = nsh[i], sc = nsc[i];
                f32x4 o;
#pragma unroll
                for (int e = 0; e < 4; ++e) o[e] = (v[i][e] - mean) * rstd * (1.0f + sc[e]) + sh[e];
                u32x2 pk; pk.x = pack2(o[0], o[1]); pk.y = pack2(o[2], o[3]); *(u32x2*)(H + (size_t)t * D + c) = pk; }
        }
    }
}

constexpr int N_PHASES = 18;
template <int P> __device__ __forceinline__ void run_phase(AP a, unsigned char* smem, LAS unsigned char* lds, int l) {
    asm volatile("" : "+s"(a));
    if (P == 0) p0_prologue(a, smem);
    if (P == 1) p_lnmod0(a);
    if (P == 2) p1_inproj(a, smem, lds, l);
    if (P == 3) p2_mix(a, smem, lds, l);
    if (P == 4) p3_outproj(a, smem, lds, l);
    if (P == 5) { if (l == 0) p4_ln1_router<0>(a, smem); else p4_ln1_router<1>(a, smem); }
    if (P == 6) p5_dispatch(a, smem, l);
    if (P == 7) p6_gateup(a, smem, lds, l);
    if (P == 8) p7_down(a, smem, lds, l);
    if (P == 9) { if (l == 0) p8_ln2<0>(a, smem); else p8_ln2<1>(a, smem); }
}
#if N_LAUNCH_MODE == 1
__global__ void __launch_bounds__(NT, 2) fwd(Args a) {
    extern __shared__ __attribute__((aligned(16))) unsigned char smem[];
    LAS unsigned char* lds = (LAS unsigned char*)smem;
    if (threadIdx.x < 4) ((volatile LAS unsigned*)(lds + MISC_OFF + 768))[threadIdx.x] = 0u;
    __syncthreads();
    XcdBarrier bar = xcd_barrier_post((unsigned*)(a.ws + WS_BAR), (volatile LAS unsigned*)(lds + MISC_OFF + 768));
    AP ap = (AP)__builtin_amdgcn_kernarg_segment_ptr();
#define PROBE(P, l) do { if (PROBE_MASK & (1 << (P))) { for (int _r = 0; _r < 2; ++_r) { xcd_barrier(bar); run_phase<P>(ap, smem, lds, l); } } } while (0)
    run_phase<0>(ap, smem, lds, 0); PROBE(0, 0); xcd_barrier(bar);
    run_phase<1>(ap, smem, lds, 0); PROBE(1, 0); xcd_barrier(bar);
    for (int l = 0; l < 2; ++l) {
        run_phase<2>(ap, smem, lds, l); PROBE(2, l); xcd_barrier(bar);
        run_phase<3>(ap, smem, lds, l); PROBE(3, l); xcd_barrier(bar);
        run_phase<4>(ap, smem, lds, l); PROBE(4, l); xcd_barrier(bar);
        run_phase<5>(ap, smem, lds, l); PROBE(5, l); xcd_barrier(bar);
        run_phase<6>(ap, smem, lds, l); PROBE(6, l); xcd_barrier(bar);
        run_phase<7>(ap, smem, lds, l); PROBE(7, l);
        run_phase<8>(ap, smem, lds, l); PROBE(8, l); xcd_barrier(bar);
        run_phase<9>(ap, smem, lds, l); PROBE(9, l); if (l == 0) xcd_barrier(bar);
    }
}
#else
template <int P> __global__ void __launch_bounds__(NT, 2) k_phase(Args a) {
    extern __shared__ __attribute__((aligned(16))) unsigned char smem[];
    LAS unsigned char* lds = (LAS unsigned char*)smem;
    AP ap = (AP)__builtin_amdgcn_kernarg_segment_ptr();
    run_phase<P>(ap, smem, lds, ap->ph_lo);
}
template <int P> static void launch_phase(Args a, int l, int grid, hipStream_t stream) {
    static bool attr = false;
    if (!attr) { (void)hipFuncSetAttribute((const void*)k_phase<P>, hipFuncAttributeMaxDynamicSharedMemorySize, LDS_BYTES); attr = true; }
    a.ph_lo = l; a.ph_hi = P;
    hipLaunchKernelGGL(k_phase<P>, dim3(grid), dim3(NT), LDS_BYTES, stream, a);
}
#endif

extern "C" void kernel_launch(void* const* d_in, const int* in_sizes, int n_in, void* d_out, int out_size, void* d_ws, size_t ws_size, hipStream_t stream) {
    static int grid = 0;
    if (grid == 0) {
        if (n_in != 23 || out_size != NLAT * D || ws_size < WS_END) { fprintf(stderr, "kernel_launch: unexpected shapes (n_in %d, out %d, ws %zu, need %zu)\n", n_in, out_size, ws_size, (size_t)WS_END); grid = -1; return; }
        int dev = 0, cus = 0;
        if (hipGetDevice(&dev) != hipSuccess || hipDeviceGetAttribute(&cus, hipDeviceAttributeMultiprocessorCount, dev) != hipSuccess) { grid = -1; return; }
#if N_LAUNCH_MODE == 1
        int per_cu = 0;
        if (hipFuncSetAttribute((const void*)fwd, hipFuncAttributeMaxDynamicSharedMemorySize, LDS_BYTES) != hipSuccess) { fprintf(stderr, "kernel_launch: hipFuncSetAttribute failed\n"); grid = -1; return; }
        if (hipOccupancyMaxActiveBlocksPerMultiprocessor(&per_cu, (const void*)fwd, NT, LDS_BYTES) != hipSuccess || per_cu < 1) { fprintf(stderr, "kernel_launch: occupancy query says %d\n", per_cu); }
        (void)hipGetLastError();
#endif
        grid = cus; if (grid > MAXG) grid = MAXG;
    }
    if (grid < 0) return;
    (void)hipMemsetAsync((char*)d_ws + WS_BAR, 0, 16384 + 256, stream);
    Args a{};
    for (int i = 0; i < 23; ++i) a.in[i] = (const float*)d_in[i];
    a.out = (float*)d_out; a.ws = (unsigned char*)d_ws;
#if N_LAUNCH_MODE == 1
    a.ph_lo = 0; a.ph_hi = N_PHASES;
    hipLaunchKernelGGL(fwd, dim3(grid), dim3(NT), LDS_BYTES, stream, a);
#else
    launch_phase<0>(a, 0, grid, stream);
    launch_phase<1>(a, 0, grid, stream);
    for (int l = 0; l < 2; ++l) {
        launch_phase<2>(a, l, grid, stream); launch_phase<3>(a, l, grid, stream); launch_phase<4>(a, l, grid, stream); launch_phase<5>(a, l, grid, stream);
        launch_phase<6>(a, l, grid, stream); launch_phase<7>(a, l, grid, stream); launch_phase<8>(a, l, grid, stream); launch_phase<9>(a, l, grid, stream);
    }
#endif
}
```

```cpp
#include <hip/hip_runtime.h>
#include <stdint.h>
#include <stdio.h>

#ifndef PROBE_MASK
#define PROBE_MASK 0
#endif
#ifndef PROBE_FFT_REP
#define PROBE_FFT_REP 1
#endif
#ifndef PROBE_MIX_REP
#define PROBE_MIX_REP 1
#endif
#ifndef PROBE_SGU_REP
#define PROBE_SGU_REP 1
#endif
#ifndef N_LAUNCH_MODE
#define N_LAUNCH_MODE 1
#endif

#define LAS __attribute__((address_space(3)))
typedef unsigned short bf16_t;
typedef short bf16x8 __attribute__((ext_vector_type(8)));
typedef float f32x4 __attribute__((ext_vector_type(4)));
typedef unsigned u32x4 __attribute__((ext_vector_type(4)));
typedef unsigned u32x2 __attribute__((ext_vector_type(2)));
typedef float f32x2 __attribute__((ext_vector_type(2)));
typedef int i32x4 __attribute__((ext_vector_type(4)));

constexpr int D = 1024, NBATCH = 4, SEQ = 4096, CTXL = 256;
constexpr int NLAT = NBATCH * SEQ, NCTX = NBATCH * CTXL, NTOK = NLAT + NCTX;
constexpr int ZC = 1792;
constexpr int NEXP = 32, DEXP = 512;
constexpr int NSLOT = 2 * NTOK + NEXP * 256;
constexpr int NT = 512;
constexpr int MAXG = 512;
constexpr float RES_ALPHA = 1.41421356237309515f;
constexpr int MISC_OFF = 155648;
constexpr int RIDX_OFF = 131072;
constexpr int LDS_BYTES = MISC_OFF + 1024;

constexpr size_t WS_BAR   = 0;
constexpr size_t WS_CNT   = 16384;
constexpr size_t WS_BCNT  = WS_CNT + 256;
constexpr size_t WS_MOD   = WS_BCNT + (size_t)2 * MAXG * 32 * 4;
constexpr size_t WS_ROPE  = WS_MOD + (size_t)2 * 5 * 6144 * 4;
constexpr size_t WS_TOKE  = WS_ROPE + 8192;
constexpr size_t WS_TOKR  = WS_TOKE + (size_t)NTOK * 8;
constexpr size_t WS_TOKS  = WS_TOKR + (size_t)NTOK * 8;
constexpr size_t WS_TOKG  = WS_TOKS + (size_t)NTOK * 8;
constexpr size_t WS_SLOTT = WS_TOKG + (size_t)NTOK * 8;
constexpr size_t WS_WIN   = WS_SLOTT + (size_t)NSLOT * 4;
constexpr size_t WS_WOUT  = WS_WIN + (size_t)2 * ZC * 1024 * 2;
constexpr size_t WS_WSGU  = WS_WOUT + (size_t)2 * 1024 * 1024 * 2;
constexpr size_t WS_DFTC  = WS_WSGU + (size_t)2 * 4 * 128 * 128 * 2;
constexpr size_t WS_WEXP  = WS_DFTC + (size_t)256 * 512 * 2;
constexpr size_t EXPMAT   = (size_t)NEXP * 512 * 1024;
constexpr size_t WEXP_LAYER = 3 * EXPMAT;
constexpr size_t WS_X1    = WS_WEXP + 2 * WEXP_LAYER;
constexpr size_t WS_XC    = WS_X1 + (size_t)NTOK * D * 4;
constexpr size_t WS_H     = WS_XC + (size_t)NTOK * D * 4;
constexpr size_t WS_R     = WS_H + (size_t)NTOK * D * 2;
constexpr size_t WS_Z     = WS_R;
constexpr size_t WS_AT    = WS_Z + (size_t)NTOK * ZC * 2;
constexpr size_t WS_ATC   = WS_AT + (size_t)4 * 256 * 8192 * 2;
constexpr size_t WS_VT    = WS_ATC + (size_t)4 * 256 * 512 * 2;
constexpr size_t WS_VTC   = WS_VT + (size_t)4 * 2 * 64 * 4096 * 2;
constexpr size_t WS_CAT   = WS_VTC + (size_t)4 * 2 * 64 * 256 * 2;
constexpr size_t WS_REND  = WS_CAT + (size_t)NTOK * D * 2;
constexpr size_t WS_Y     = WS_R;
constexpr size_t WS_HID   = WS_R;
constexpr size_t WS_YS    = WS_HID + (size_t)NSLOT * DEXP * 2;
constexpr size_t WS_REND2 = (WS_YS + (size_t)NSLOT * D * 2 > WS_REND) ? WS_YS + (size_t)NSLOT * D * 2 : WS_REND;
constexpr size_t WS_H8    = (WS_REND2 + 255) & ~(size_t)255;
constexpr size_t WS_END   = WS_H8 + (size_t)NTOK * D;
static_assert(WS_Y + (size_t)NTOK * D * 4 <= WS_CAT, "Y must not reach CAT");
static_assert(WS_WIN % 256 == 0 && WS_DFTC % 256 == 0 && WS_WEXP % 256 == 0 && WS_X1 % 256 == 0 && WS_H % 256 == 0 && WS_R % 256 == 0 && WS_AT % 256 == 0 && WS_CAT % 256 == 0 && WS_YS % 256 == 0, "alignment");

struct Args { const float* in[23]; float* out; unsigned char* ws; int ph_lo, ph_hi; };
#define CAS __attribute__((address_space(4)))
typedef const CAS Args* AP;

#define XB_TMO      128
#define XB_XCNT(j)  (256  + 64 * (j))
#define XB_XSUB(j)  (1280 + 64 * (j))
#define XB_XGEN(j)  (2304 + 64 * (j))
#define XB_TOP      3328
#define XB_TOPGEN   3392
#define XCD_BAR_WORDS 3456
#define XB_SPIN_CAP (1u << 18)

__device__ __forceinline__ unsigned xb_ld(unsigned* p)              { return __hip_atomic_load(p, __ATOMIC_RELAXED, __HIP_MEMORY_SCOPE_AGENT); }
__device__ __forceinline__ unsigned xb_add(unsigned* p, unsigned v) { return __hip_atomic_fetch_add(p, v, __ATOMIC_RELAXED, __HIP_MEMORY_SCOPE_AGENT); }
__device__ __forceinline__ unsigned xb_xcc_id() { return (unsigned)__builtin_amdgcn_s_getreg((3 << 11) | 20) & 0xFu; }
#define XB_SPIN(cond, bar) do { unsigned _sp = 0; while (cond) { __builtin_amdgcn_s_sleep(1); \
    if ((++_sp & 255u) == 0u) { if (xb_ld(&(bar)[XB_TMO])) break; if (_sp > XB_SPIN_CAP) { atomicAdd(&(bar)[XB_TMO], 1u); break; } } } } while (0)

struct XcdBarrier { unsigned* bar; unsigned x; volatile LAS unsigned* st; };

__device__ __forceinline__ XcdBarrier xcd_barrier_post(unsigned* bar, volatile LAS unsigned* st) {
    XcdBarrier b; b.bar = bar; b.x = (unsigned)__builtin_amdgcn_readfirstlane((int)xb_xcc_id()); b.st = st;
    if (threadIdx.x == 0) (void)xb_add(&bar[XB_XCNT(b.x)], 1u);
    return b;
}
__device__ __forceinline__ void xcd_barrier_complete(unsigned* bar, unsigned x, unsigned& nloc, unsigned& nx) {
    const unsigned G = gridDim.x * gridDim.y * gridDim.z;
    unsigned sum, cnt, mine, sp = 0u;
    for (;;) {
        sum = 0u; cnt = 0u; mine = 0u;
#pragma unroll
        for (unsigned j = 0; j < 16; ++j) { const unsigned c = xb_ld(&bar[XB_XCNT(j)]); sum += c; cnt += (c > 0u) ? 1u : 0u; mine = (j == x) ? c : mine; }
        if (sum == G) break;
        __builtin_amdgcn_s_sleep(1);
        if ((++sp & 255u) == 0u) { if (xb_ld(&bar[XB_TMO])) break; if (sp > XB_SPIN_CAP) { atomicAdd(&bar[XB_TMO], 1u); break; } }
    }
    nloc = mine > 0u ? mine : 1u; nx = cnt > 0u ? cnt : 1u;
}
__device__ __forceinline__ void xcd_barrier(const XcdBarrier& b) {
    asm volatile("s_waitcnt vmcnt(0)" ::: "memory");
    __syncthreads();
    if (threadIdx.x == 0) {
        unsigned* bar = b.bar;
        unsigned bx = b.x;
        asm volatile("" : "+s"(bar), "+s"(bx));
        __builtin_amdgcn_s_waitcnt(0);
        unsigned nloc = b.st[0], nx = b.st[1];
        if (nloc == 0u) { xcd_barrier_complete(bar, bx, nloc, nx); b.st[0] = nloc; b.st[1] = nx; }
        const unsigned old = xb_add(&bar[XB_XSUB(bx)], 1u);
        const unsigned gen = old / nloc;
        if (old + 1u == (gen + 1u) * nloc) {
            __builtin_amdgcn_fence(__ATOMIC_RELEASE, "agent");
            asm volatile("s_waitcnt vmcnt(0)" ::: "memory");
            const unsigned og = xb_add(&bar[XB_TOP], 1u);
            const unsigned tg = og / nx;
            if (og + 1u == (tg + 1u) * nx) xb_add(&bar[XB_TOPGEN], 1u);
            else XB_SPIN(xb_ld(&bar[XB_TOPGEN]) == tg, bar);
            __builtin_amdgcn_fence(__ATOMIC_ACQUIRE, "agent");
            xb_add(&bar[XB_XGEN(bx)], 1u);
            asm volatile("s_waitcnt vmcnt(0)" ::: "memory");
        } else {
            XB_SPIN(xb_ld(&bar[XB_XGEN(bx)]) == gen, bar);
            __builtin_amdgcn_fence(__ATOMIC_ACQUIRE, "agent");
            asm volatile("s_waitcnt vmcnt(0)" ::: "memory");
        }
    }
    __syncthreads();
}

__device__ __forceinline__ int tid_opaque() { int t = threadIdx.x; asm volatile("" : "+v"(t)); return t; }
__device__ __forceinline__ float bf2f(bf16_t v) { return __uint_as_float(((unsigned)v) << 16); }
__device__ __forceinline__ bf16_t f2bf(float f) { return __builtin_bit_cast(unsigned short, (__bf16)f); }
typedef __bf16 hwbf16x2 __attribute__((ext_vector_type(2)));
__device__ __forceinline__ unsigned pack2(float a, float b) { return __builtin_bit_cast(unsigned, __builtin_convertvector((f32x2){a, b}, hwbf16x2)); }
__device__ __forceinline__ unsigned pack4_fp8(float a, float b, float c, float d) {
    a = __builtin_amdgcn_fmed3f(a, -448.f, 448.f); b = __builtin_amdgcn_fmed3f(b, -448.f, 448.f); c = __builtin_amdgcn_fmed3f(c, -448.f, 448.f); d = __builtin_amdgcn_fmed3f(d, -448.f, 448.f);
    int p = __builtin_amdgcn_cvt_pk_fp8_f32(a, b, 0, false); p = __builtin_amdgcn_cvt_pk_fp8_f32(c, d, p, true); return (unsigned)p; }
__device__ __forceinline__ float lo2f(unsigned w) { return __uint_as_float(w << 16); }
__device__ __forceinline__ float hi2f(unsigned w) { return __uint_as_float(w & 0xffff0000u); }
template <int CTRL> __device__ __forceinline__ float dpp_mov(float v) { return __builtin_bit_cast(float, __builtin_amdgcn_update_dpp(0, __builtin_bit_cast(int, v), CTRL, 0xf, 0xf, true)); }
__device__ __forceinline__ float row_sum16(float v) {
    v += dpp_mov<0xB1>(v);
    v += dpp_mov<0x4E>(v);
    v += dpp_mov<0x141>(v);
    v += dpp_mov<0x140>(v);
    return v;
}
__device__ __forceinline__ float row_max16(float v) {
    v = fmaxf(v, dpp_mov<0xB1>(v)); v = fmaxf(v, dpp_mov<0x4E>(v)); v = fmaxf(v, dpp_mov<0x141>(v)); v = fmaxf(v, dpp_mov<0x140>(v));
    return v;
}
__device__ __forceinline__ float xsum32(float p, float q) { const auto rr = __builtin_amdgcn_permlane32_swap(__float_as_uint(p), __float_as_uint(q), false, false); return __uint_as_float(rr[0]) + __uint_as_float(rr[1]); }
__device__ __forceinline__ float xsum16(float p, float q) { const auto rr = __builtin_amdgcn_permlane16_swap(__float_as_uint(p), __float_as_uint(q), false, false); return __uint_as_float(rr[0]) + __uint_as_float(rr[1]); }
__device__ __forceinline__ float lane_f(float v, int lane) { return __builtin_bit_cast(float, __builtin_amdgcn_readlane(__builtin_bit_cast(int, v), lane)); }
__device__ __forceinline__ float wave_sum(float v) {
    v = row_sum16(v); v = xsum16(v, v); return xsum32(v, v);
}
__device__ __forceinline__ void wave_sum4(float a, float b, float c, float d, float (&o)[4]) {
    float w = xsum16(xsum32(a, b), xsum32(c, d));
    w = row_sum16(w);
    o[0] = lane_f(w, 0); o[1] = lane_f(w, 32); o[2] = lane_f(w, 16); o[3] = lane_f(w, 48);
}
__device__ __forceinline__ void wave_sum8(const float (&e)[8], int lane, float (&o)[8]) {
    const float w0 = xsum16(xsum32(e[0], e[1]), xsum32(e[2], e[3]));
    const float w1 = xsum16(xsum32(e[4], e[5]), xsum32(e[6], e[7]));
    const bool odd = lane & 1;
    float r = (odd ? w1 : w0) + dpp_mov<0xB1>(odd ? w0 : w1);
    r += dpp_mov<0x4E>(r); r += dpp_mov<0x124>(r); r += dpp_mov<0x128>(r);
    o[0] = lane_f(r, 0); o[1] = lane_f(r, 32); o[2] = lane_f(r, 16); o[3] = lane_f(r, 48);
    o[4] = lane_f(r, 1); o[5] = lane_f(r, 33); o[6] = lane_f(r, 17); o[7] = lane_f(r, 49);
}
__device__ __forceinline__ float gelu_erf(float v) {
    const float t = __builtin_amdgcn_rcpf(fabsf(v) * 0.2316418882f + 1.0f);
    float q = t * 0.5307027145f + (-0.7265760135f); q = q * t + 0.7107068705f; q = q * t + (-0.142248368f); q = q * t + 0.127414796f; q = q * t;
    const float m = v * (q * __builtin_amdgcn_exp2f((v * v) * (-0.72134752044f)));
    return v < 0.f ? m : v - m;
}
__device__ __forceinline__ float silu_f(float x) { return x * __builtin_amdgcn_rcpf(1.0f + __expf(-x)); }

__device__ __forceinline__ void ln_stats(const f32x4 (&v)[4], float& mean, float& rstd) {
    float s = 0.f;
#pragma unroll
    for (int i = 0; i < 4; ++i) s += (v[i][0] + v[i][1]) + (v[i][2] + v[i][3]);
    s = wave_sum(s); mean = s * (1.0f / 1024.0f);
    float q = 0.f;
#pragma unroll
    for (int i = 0; i < 4; ++i)
#pragma unroll
        for (int e = 0; e < 4; ++e) { const float d = v[i][e] - mean; q += d * d; }
    q = wave_sum(q); rstd = __builtin_amdgcn_rsqf(q * (1.0f / 1024.0f) + 1e-6f);
}

template <int BN> struct MfmaLayout {
    static constexpr int FG = BN / 128, NI = 4, NJ = 2 * FG;
    static constexpr bool PAIR8 = false;
    int rbase, cbase;
    __device__ __forceinline__ int row(int i) const { return rbase + 16 * i; }
    __device__ __forceinline__ int col(int jj) const { return (jj / FG) * (BN / 2) + (jj % FG) * 16 + cbase; }
};

__device__ __forceinline__ void glds16(const bf16_t* g, LAS unsigned char* l) {
    __builtin_amdgcn_global_load_lds((const unsigned*)g, (LAS unsigned*)l, 16, 0, 0);
}

template <int BN, bool GATHER, class Epi>
__device__ __forceinline__ void gemm_tile(LAS unsigned char* lds, const bf16_t* A, int lda, const int* rowidx, int valid_rows,
                                          const bf16_t* B0, const bf16_t* B1, int ldb, int K, const Epi& epi) {
    constexpr int A_B = 16384, B_B = BN * 128, STAGE = A_B + B_B, NBL = BN / 64;
    const int tid = tid_opaque(), lane = tid & 63, wid = __builtin_amdgcn_readfirstlane(tid >> 6);
    const bf16_t* ap[2]; const bf16_t* bp[NBL];
#pragma unroll
    for (int i = 0; i < 2; ++i) {
        const int P = i * 512 + tid, row = P >> 3, c = (P & 7) ^ ((row >> 1) & 7);
        size_t ro;
        if (GATHER) ro = (size_t)(row < valid_rows ? rowidx[row] : 0) * (size_t)lda; else ro = (size_t)row * (size_t)lda;
        ap[i] = A + ro + c * 8;
    }
#pragma unroll
    for (int i = 0; i < NBL; ++i) {
        const int P = i * 512 + tid, row = P >> 3, c = (P & 7) ^ ((row >> 1) & 7);
        const bf16_t* base = (row < BN / 2) ? (B0 + (size_t)row * ldb) : (B1 + (size_t)(row - BN / 2) * ldb);
        bp[i] = base + c * 8;
    }
    const int nk = K / 64;
#define GT_STAGE(buf, k0) do { \
        _Pragma("unroll") for (int _i = 0; _i < 2; ++_i) glds16(ap[_i] + (k0), lds + (buf) * STAGE + _i * 8192 + wid * 1024); \
        _Pragma("unroll") for (int _i = 0; _i < NBL; ++_i) glds16(bp[_i] + (k0), lds + (buf) * STAGE + A_B + _i * 8192 + wid * 1024); } while (0)

    typedef MfmaLayout<BN> Lay;
    constexpr int FG = Lay::FG;
    const int fr = lane & 15, g = lane >> 4, wr = wid >> 2, wc = wid & 3;
    Lay lay; lay.rbase = wr * 64 + fr; lay.cbase = wc * 16 * FG + 4 * g;
    f32x4 acc[Lay::NI][Lay::NJ];
#pragma unroll
    for (int i = 0; i < Lay::NI; ++i)
#pragma unroll
        for (int j = 0; j < Lay::NJ; ++j) acc[i][j] = (f32x4){0.f, 0.f, 0.f, 0.f};
    int aoff[4], boff[Lay::NJ];
#pragma unroll
    for (int m = 0; m < 4; ++m) { const int row = wr * 64 + m * 16 + fr; aoff[m] = row * 128 + ((g ^ ((row >> 1) & 7)) << 4); }
#pragma unroll
    for (int jj = 0; jj < Lay::NJ; ++jj) { const int row = (jj / FG) * (BN / 2) + wc * 16 * FG + (jj % FG) * 16 + fr; boff[jj] = A_B + row * 128 + ((g ^ ((row >> 1) & 7)) << 4); }
    GT_STAGE(0, 0);
    asm volatile("s_waitcnt vmcnt(0)" ::: "memory"); __syncthreads();
    for (int kt = 0; kt < nk; ++kt) {
        if (kt + 1 < nk) GT_STAGE((kt + 1) & 1, (kt + 1) * 64);
        const LAS unsigned char* sa = lds + (kt & 1) * STAGE;
#pragma unroll
        for (int ks = 0; ks < 2; ++ks) {
            bf16x8 af[4], bfv[Lay::NJ];
#pragma unroll
            for (int m = 0; m < 4; ++m) af[m] = *(const LAS bf16x8*)(sa + (aoff[m] ^ (ks << 6)));
#pragma unroll
            for (int jj = 0; jj < Lay::NJ; ++jj) bfv[jj] = *(const LAS bf16x8*)(sa + (boff[jj] ^ (ks << 6)));
#pragma unroll
            for (int m = 0; m < 4; ++m)
#pragma unroll
                for (int jj = 0; jj < Lay::NJ; ++jj) acc[m][jj] = __builtin_amdgcn_mfma_f32_16x16x32_bf16(bfv[jj], af[m], acc[m][jj], 0, 0, 0);
        }
        asm volatile("s_waitcnt vmcnt(0)" ::: "memory"); __syncthreads();
    }
    epi.run(acc, lay);
#undef GT_STAGE
}

namespace g256 {
constexpr int BK = 64, HALF = 128, HTB = HALF * BK * 2, STAGE_BYTES = 8 * HTB;
__device__ __forceinline__ int lds_byte(int r, int c) { const int st = (r >> 4) * 2 + (c >> 5), rr = r & 15, cc = c & 31, ob = rr * 64 + cc * 2; return st * 1024 + (ob ^ (((ob >> 9) & 1) << 5)); }
__device__ __forceinline__ int perm32(int rho) { const int n = rho >> 4, i = rho & 15; return 8 * (i >> 2) + 4 * n + (i & 3); }
__device__ __forceinline__ void stage_rc(int b, int& R, int& C) { const int st = b / 1024, sb = b % 1024, swz = sb ^ (((sb >> 9) & 1) << 5); R = (st >> 1) * 16 + swz / 64; C = (st & 1) * 32 + (swz % 64) / 2; }
struct Lay {
    static constexpr int NI = 8, NJ = 4;
    static constexpr bool PAIR8 = true;
    int rbase, cbase;
    __device__ __forceinline__ int row(int i) const { return (i >> 2) * 128 + (i & 3) * 16 + rbase; }
    __device__ __forceinline__ int col(int j) const { return (j >> 1) * 128 + (j & 1) * 4 + cbase; }
};
template <class Epi> struct Unit { const bf16_t* A; const bf16_t* B0; const bf16_t* B1; const LAS int* ridx; int valid; int tag; Epi epi; };

template <class Sched>
__device__ __forceinline__ void gemm_phase(LAS unsigned char* lds, const int K, const Sched& S) {
    typedef typename Sched::Epi Epi;
    const int tid = tid_opaque(), wid = __builtin_amdgcn_readfirstlane(tid >> 6), lane = tid & 63, wr = wid >> 2, wc = wid & 3, fr = lane & 15, fq = lane >> 4;
    int nt = K / BK; asm volatile("" : "+s"(nt));
    int sR[2], sC[2];
#pragma unroll
    for (int i = 0; i < 2; ++i) stage_rc(tid * 16 + i * 8192, sR[i], sC[i]);
    unsigned voffB[2];
#pragma unroll
    for (int i = 0; i < 2; ++i) voffB[i] = (unsigned)(((sR[i] & ~31) + perm32(sR[i] & 31)) * K + sC[i]) * 2u;
    const size_t kstep = (size_t)(BK * 2);
    const unsigned ldsw = (unsigned)wid * 1024u;
    const int aoff = lds_byte(wr * 64 + fr, fq * 8), boff = lds_byte(wc * 32 + fr, fq * 8);
#define G2_SA(b, h) (((b) * 2 + (h)) * HTB)
#define G2_SB(b, h) ((4 + (b) * 2 + (h)) * HTB)
#define G2_STAGE(bufoff, gbase, v0, v1) do { \
        __builtin_amdgcn_global_load_lds((const unsigned*)((const char*)(gbase) + (v0)), (LAS unsigned*)(lds + (bufoff) + ldsw), 16, 0, 0); \
        __builtin_amdgcn_global_load_lds((const unsigned*)((const char*)(gbase) + (v1)), (LAS unsigned*)(lds + (bufoff) + ldsw + 8192), 16, 0, 0); } while (0)
#define G2_LDA(dst, b, h) do { _Pragma("unroll") for (int m = 0; m < 4; ++m) _Pragma("unroll") for (int k = 0; k < 2; ++k) dst[m][k] = *(const LAS bf16x8*)(lds + G2_SA(b, h) + aoff + m * 2048 + k * 1024); } while (0)
#define G2_LDB(dst, b, h) do { _Pragma("unroll") for (int n = 0; n < 2; ++n) _Pragma("unroll") for (int k = 0; k < 2; ++k) dst[n][k] = *(const LAS bf16x8*)(lds + G2_SB(b, h) + boff + n * 2048 + k * 1024); } while (0)
#define G2_MMA(ai, bj, At, Bt) do { __builtin_amdgcn_s_setprio(1); _Pragma("unroll") for (int m = 0; m < 4; ++m) _Pragma("unroll") for (int n = 0; n < 2; ++n) _Pragma("unroll") for (int k = 0; k < 2; ++k) { \
        if (Sched::FP8) { const i32x4 _b = __builtin_bit_cast(i32x4, Bt[n][k]), _a = __builtin_bit_cast(i32x4, At[m][k]);     \
            acc[(ai) * 4 + m][(bj) * 2 + n] = __builtin_amdgcn_mfma_f32_16x16x32_fp8_fp8(((long)(unsigned)_b[1] << 32) | (unsigned)_b[0], ((long)(unsigned)_a[1] << 32) | (unsigned)_a[0], acc[(ai) * 4 + m][(bj) * 2 + n], 0, 0, 0); \
            acc[(ai) * 4 + m][(bj) * 2 + n] = __builtin_amdgcn_mfma_f32_16x16x32_fp8_fp8(((long)(unsigned)_b[3] << 32) | (unsigned)_b[2], ((long)(unsigned)_a[3] << 32) | (unsigned)_a[2], acc[(ai) * 4 + m][(bj) * 2 + n], 0, 0, 0); } \
        else acc[(ai) * 4 + m][(bj) * 2 + n] = __builtin_amdgcn_mfma_f32_16x16x32_bf16(Bt[n][k], At[m][k], acc[(ai) * 4 + m][(bj) * 2 + n], 0, 0, 0); } __builtin_amdgcn_s_setprio(0); } while (0)
#define G2_WAIT_V(n) asm volatile("s_waitcnt vmcnt(" #n ")" ::: "memory")
#define G2_WAIT_L(n) asm volatile("s_waitcnt lgkmcnt(" #n ")" ::: "memory")
#define G2_BAR __builtin_amdgcn_s_barrier()
#define G2_SCHED __builtin_amdgcn_sched_barrier(0)
#define G2_VOFFA(U, dst) do { _Pragma("unroll") for (int _h = 0; _h < 2; ++_h) _Pragma("unroll") for (int _i = 0; _i < 2; ++_i) { const int _row = _h * 128 + sR[_i]; \
        int _tok = _row; if (Sched::GATHER) _tok = (_row < (U).valid) ? (U).ridx[_row] : 0; dst[_h][_i] = (unsigned)(_tok * K + sC[_i]) * 2u; } } while (0)
    Unit<Epi> cur, nxt; int ui = 0;
    if (!S.get(0, cur)) return;
#define G2_DEPWAIT(tag_) do { if (wid == 0) { unsigned* _d = S.dep + (tag_); unsigned _sp = 0; while (xb_ld(_d) < 4u) { __builtin_amdgcn_s_sleep(2); if (++_sp > (1u << 22)) break; } __builtin_amdgcn_fence(__ATOMIC_ACQUIRE, "agent"); } G2_BAR; } while (0)
    if (Sched::WAITDEP) G2_DEPWAIT(cur.tag);
    f32x4 acc[8][4];
#pragma unroll
    for (int i = 0; i < 8; ++i)
#pragma unroll
        for (int j = 0; j < 4; ++j) acc[i][j] = (f32x4){0.f, 0.f, 0.f, 0.f};
    bf16x8 At[4][2], B0[2][2], B1[2][2];
    unsigned cvA[2][2], nvA[2][2];
    G2_VOFFA(cur, cvA);
    const char* cA = (const char*)cur.A; const char* cB0 = (const char*)cur.B0; const char* cB1 = (const char*)cur.B1;
    G2_STAGE(G2_SB(0, 0), cB0, voffB[0], voffB[1]); G2_STAGE(G2_SB(0, 1), cB1, voffB[0], voffB[1]); G2_STAGE(G2_SA(0, 0), cA, cvA[0][0], cvA[0][1]); G2_STAGE(G2_SA(0, 1), cA, cvA[1][0], cvA[1][1]);
    if (wr == 1) G2_BAR;
    G2_WAIT_V(2); G2_BAR;
    G2_STAGE(G2_SB(1, 0), cB0 + kstep, voffB[0], voffB[1]); G2_STAGE(G2_SA(1, 0), cA + kstep, cvA[0][0], cvA[0][1]); G2_STAGE(G2_SB(1, 1), cB1 + kstep, voffB[0], voffB[1]);
    G2_WAIT_V(6); G2_BAR;
    for (;;) {
        const bool has_next = S.get(ui + 1, nxt);
        if (Sched::WAITDEP) { if (has_next) G2_DEPWAIT(nxt.tag); }
        if (Sched::GATHER) {
            if (has_next) { G2_VOFFA(nxt, nvA); }
            else {
#pragma unroll
                for (int h = 0; h < 2; ++h) { nvA[h][0] = cvA[h][0]; nvA[h][1] = cvA[h][1]; } }
        }
        const char* nA = has_next ? (const char*)nxt.A : cA; const char* nB0 = has_next ? (const char*)nxt.B0 : cB0; const char* nB1 = has_next ? (const char*)nxt.B1 : cB1;
#pragma unroll 1
        for (int t = 0; t < nt; t += 2) {
            const bool last = (t == nt - 2);
            const char* a1 = cA + (size_t)(t + 1) * kstep;
            const char* a2 = last ? nA : cA + (size_t)(t + 2) * kstep;
            const char* b20 = last ? nB0 : cB0 + (size_t)(t + 2) * kstep; const char* b21 = last ? nB1 : cB1 + (size_t)(t + 2) * kstep;
#define x00 ((Sched::GATHER && last) ? nvA[0][0] : cvA[0][0])
#define x01 ((Sched::GATHER && last) ? nvA[0][1] : cvA[0][1])
#define x10 ((Sched::GATHER && last) ? nvA[1][0] : cvA[1][0])
#define x11 ((Sched::GATHER && last) ? nvA[1][1] : cvA[1][1])
            G2_LDB(B0, 0, 0); G2_LDB(B1, 0, 1); G2_SCHED; G2_LDA(At, 0, 0); G2_STAGE(G2_SA(1, 1), a1, cvA[1][0], cvA[1][1]);
            G2_WAIT_V(8); G2_WAIT_L(0); G2_BAR; G2_MMA(0, 0, At, B0); G2_MMA(0, 1, At, B1); G2_BAR; G2_SCHED;
            G2_LDA(At, 0, 1); G2_STAGE(G2_SB(0, 0), b20, voffB[0], voffB[1]); G2_STAGE(G2_SB(0, 1), b21, voffB[0], voffB[1]); G2_STAGE(G2_SA(0, 0), a2, x00, x01);
            G2_WAIT_V(8); G2_WAIT_L(0); G2_BAR; G2_MMA(1, 0, At, B0); G2_MMA(1, 1, At, B1); G2_BAR; G2_SCHED;
            G2_LDB(B0, 1, 0); G2_LDB(B1, 1, 1); G2_SCHED; G2_LDA(At, 1, 0); G2_STAGE(G2_SA(0, 1), a2, x10, x11);
            G2_WAIT_V(8); G2_WAIT_L(0); G2_BAR; G2_MMA(0, 0, At, B0); G2_MMA(0, 1, At, B1); G2_BAR; G2_SCHED;
            G2_LDA(At, 1, 1); G2_STAGE(G2_SB(1, 0), b20 + kstep, voffB[0], voffB[1]); G2_STAGE(G2_SB(1, 1), b21 + kstep, voffB[0], voffB[1]); G2_STAGE(G2_SA(1, 0), a2 + kstep, x00, x01);
            G2_WAIT_V(8); G2_WAIT_L(0); G2_BAR; G2_MMA(1, 0, At, B0); G2_MMA(1, 1, At, B1); G2_BAR; G2_SCHED;
        }
        if (wr == 0) G2_BAR;
        { Lay lay; int rbv = wr * 64 + fr, cbv = wc * 32 + 8 * fq; asm volatile("" : "+v"(rbv), "+v"(cbv));
          lay.rbase = rbv; lay.cbase = cbv; cur.epi.run(acc, lay); }
        if (Sched::SIGNAL) {
            G2_WAIT_V(0); G2_BAR;
            if (tid == 0) (void)xb_add(S.dep + cur.tag, 1u);
        }
        if (!has_next) break;
#pragma unroll
        for (int i = 0; i < 8; ++i)
#pragma unroll
            for (int j = 0; j < 4; ++j) acc[i][j] = (f32x4){0.f, 0.f, 0.f, 0.f};
        cur = nxt; cA = nA; cB0 = nB0; cB1 = nB1; ++ui;
        if (wr == 1) G2_BAR;
        if (Sched::GATHER) {
#pragma unroll
            for (int h = 0; h < 2; ++h) { cvA[h][0] = nvA[h][0]; cvA[h][1] = nvA[h][1]; } }
    }
#undef x00
#undef x01
#undef x10
#undef x11
    G2_WAIT_V(0);
    G2_BAR;
#undef G2_SA
#undef G2_SB
#undef G2_STAGE
#undef G2_LDA
#undef G2_LDB
#undef G2_MMA
#undef G2_WAIT_V
#undef G2_WAIT_L
#undef G2_BAR
#undef G2_SCHED
#undef G2_VOFFA
#undef G2_DEPWAIT
}
}

struct EpiF32 {
    float* C; int ld;
    template <class L> __device__ __forceinline__ void run(const f32x4 (&acc)[L::NI][L::NJ], const L& lay) const {
#pragma unroll
        for (int i = 0; i < L::NI; ++i)
#pragma unroll
            for (int j = 0; j < L::NJ; ++j) *(f32x4*)(C + (size_t)lay.row(i) * ld + lay.col(j)) = acc[i][j];
    }
};
struct EpiBf16 {
    bf16_t* C; int ld; float scale;
    template <class L> __device__ __forceinline__ void run(const f32x4 (&acc)[L::NI][L::NJ], const L& lay) const {
#pragma unroll
        for (int i = 0; i < L::NI; ++i) {
            if (L::PAIR8) {
#pragma unroll
                for (int j = 0; j < L::NJ; j += 2) { const f32x4 p = acc[i][j] * scale, q = acc[i][j + 1] * scale; u32x4 w; w.x = pack2(p[0], p[1]); w.y = pack2(p[2], p[3]); w.z = pack2(q[0], q[1]); w.w = pack2(q[2], q[3]);
                    *(u32x4*)(C + (size_t)lay.row(i) * ld + lay.col(j)) = w; }
            } else {
#pragma unroll
                for (int j = 0; j < L::NJ; ++j) { const f32x4 p = acc[i][j] * scale; u32x2 w; w.x = pack2(p[0], p[1]); w.y = pack2(p[2], p[3]);
                    *(u32x2*)(C + (size_t)lay.row(i) * ld + lay.col(j)) = w; }
            }
        }
    }
};
struct EpiFp8 {
    unsigned char* C; int ld; float scale;
    template <class L> __device__ __forceinline__ void run(const f32x4 (&acc)[L::NI][L::NJ], const L& lay) const {
        static_assert(L::PAIR8, "written for the paired-column layout");
#pragma unroll
        for (int i = 0; i < L::NI; ++i)
#pragma unroll
            for (int j = 0; j < L::NJ; j += 2) { const f32x4 p = acc[i][j] * scale, q = acc[i][j + 1] * scale; u32x2 w; w.x = pack4_fp8(p[0], p[1], p[2], p[3]); w.y = pack4_fp8(q[0], q[1], q[2], q[3]);
                *(u32x2*)(C + (size_t)lay.row(i) * ld + lay.col(j)) = w; }
    }
};
struct EpiGateUp8 {
    unsigned char* C; int ld;
    template <class L> __device__ __forceinline__ void run(const f32x4 (&acc)[L::NI][L::NJ], const L& lay) const {
        static_assert(L::PAIR8 && L::NJ == 4, "written for the paired-column 256x256 layout");
#pragma unroll
        for (int i = 0; i < L::NI; ++i) {
            const f32x4 g0 = acc[i][0] * (1.0f / 32.0f), g1 = acc[i][1] * (1.0f / 32.0f), u0 = acc[i][2] * (1.0f / 32.0f), u1 = acc[i][3] * (1.0f / 32.0f);
            u32x2 w; w.x = pack4_fp8(silu_f(g0[0]) * u0[0], silu_f(g0[1]) * u0[1], silu_f(g0[2]) * u0[2], silu_f(g0[3]) * u0[3]);
            w.y = pack4_fp8(silu_f(g1[0]) * u1[0], silu_f(g1[1]) * u1[1], silu_f(g1[2]) * u1[2], silu_f(g1[3]) * u1[3]);
            { const unsigned char* pw = C + (size_t)lay.row(i) * ld + lay.col(0); asm volatile("global_store_dwordx2 %0, %1, off sc0 sc1" :: "v"(pw), "v"(w) : "memory"); }
        }
    }
};
struct EpiGateUp {
    bf16_t* C; int ld;
    template <class L> __device__ __forceinline__ void run(const f32x4 (&acc)[L::NI][L::NJ], const L& lay) const {
#pragma unroll
        for (int i = 0; i < L::NI; ++i) {
            if (L::PAIR8 && L::NJ == 4) {
                const f32x4 g0 = acc[i][0], g1 = acc[i][1], u0 = acc[i][2], u1 = acc[i][3];
                u32x4 w; w.x = pack2(silu_f(g0[0]) * u0[0], silu_f(g0[1]) * u0[1]); w.y = pack2(silu_f(g0[2]) * u0[2], silu_f(g0[3]) * u0[3]);
                w.z = pack2(silu_f(g1[0]) * u1[0], silu_f(g1[1]) * u1[1]); w.w = pack2(silu_f(g1[2]) * u1[2], silu_f(g1[3]) * u1[3]);
                *(u32x4*)(C + (size_t)lay.row(i) * ld + lay.col(0)) = w;
            } else {
#pragma unroll
                for (int j = 0; j < L::NJ / 2; ++j) { const f32x4 gt = acc[i][j], up = acc[i][j + L::NJ / 2];
                    u32x2 w; w.x = pack2(silu_f(gt[0]) * up[0], silu_f(gt[1]) * up[1]); w.y = pack2(silu_f(gt[2]) * up[2], silu_f(gt[3]) * up[3]);
                    *(u32x2*)(C + (size_t)lay.row(i) * ld + lay.col(j)) = w; }
            }
        }
    }
};
struct EpiInProj {
    bf16_t* Zt;
    bf16_t* tF;
    bf16_t* tV;
    int n0, pos0, n;
    template <class L> __device__ __forceinline__ void run(const f32x4 (&acc)[L::NI][L::NJ], const L& lay) const {
        static_assert(L::PAIR8, "written for the paired-column layout");
#pragma unroll
        for (int i = 0; i < L::NI; ++i)
#pragma unroll
            for (int j = 0; j < L::NJ; j += 2) {
                const int r = lay.row(i), cl = lay.col(j), c = n0 + cl;
                const f32x4 v0 = acc[i][j], v1 = acc[i][j + 1];
                if (c < 512) {
                    const int part = c >> 8, ch = c & 255;
#pragma unroll
                    for (int e = 0; e < 4; ++e) { tF[((size_t)(ch + e) * 2 + part) * n + pos0 + r] = f2bf(v0[e]); tF[((size_t)(ch + 4 + e) * 2 + part) * n + pos0 + r] = f2bf(v1[e]); }
                } else {
                    u32x4 w; w.x = pack2(v0[0], v0[1]); w.y = pack2(v0[2], v0[3]); w.z = pack2(v1[0], v1[1]); w.w = pack2(v1[2], v1[3]);
                    *(u32x4*)(Zt + (size_t)r * ZC + cl) = w;
                    if (c >= 896 && c < 1024) {
#pragma unroll
                        for (int e = 0; e < 4; ++e) { tV[(size_t)(c - 896 + e) * n + pos0 + r] = f2bf(v0[e]); tV[(size_t)(c - 896 + 4 + e) * n + pos0 + r] = f2bf(v1[e]); }
                    }
                }
            }
    }
};

constexpr int U_ADA = 192, U_WIN = 2 * 16 * 28, U_WOUT = 2 * 16 * 16, U_SGU = 32, U_DFT = 256, U_ROPE = 1, U_EXP = 3 * 32 * 32;
constexpr int LDS_SIL = 0, LDS_RED = 20480, LDS_TILE = 32768, LDS_T64 = 49408, LDS_CTAB = 50176;

__device__ __forceinline__ void ada_unit(AP a, unsigned char* lds, int u) {
    float* sil = (float*)(lds + LDS_SIL); float* red = (float*)(lds + LDS_RED);
    const int tid = tid_opaque(), lane = tid & 63, w = tid >> 6;
    const int l = u / 96, cg = u % 96;
    for (int i = tid; i < 5120; i += NT) { const int r = i >> 10, k = i & 1023; const float v = (r < 4) ? a->in[1][r * 1024 + k] : a->in[3][k]; sil[i] = v / (1.0f + expf(-v)); }
    __syncthreads();
    const float* W = a->in[4] + (size_t)l * 1024 * 6144 + cg * 64 + lane;
    float acc[5] = {0.f, 0.f, 0.f, 0.f, 0.f};
#pragma unroll 32
    for (int k = w * 128; k < w * 128 + 128; ++k) { const float wv = W[(size_t)k * 6144];
#pragma unroll
        for (int r = 0; r < 5; ++r) acc[r] += sil[r * 1024 + k] * wv; }
#pragma unroll
    for (int r = 0; r < 5; ++r) red[(w * 5 + r) * 64 + lane] = acc[r];
    __syncthreads();
    if (tid < 320) { const int r = tid >> 6; float s = 0.f;
#pragma unroll
        for (int ww = 0; ww < 8; ++ww) s += red[(ww * 5 + r) * 64 + lane];
        const int j = cg * 64 + lane; ((float*)(a->ws + WS_MOD))[(size_t)(l * 5 + r) * 6144 + j] = s + a->in[5][l * 6144 + j]; }
    __syncthreads();
}

__device__ __forceinline__ void tile_store_T(const float* tile, bf16_t* dst, int ldd) {
    const int tid = tid_opaque(), n = tid >> 3, kc = tid & 7;
    u32x4 w;
    w.x = pack2(tile[(kc * 8 + 0) * 65 + n], tile[(kc * 8 + 1) * 65 + n]); w.y = pack2(tile[(kc * 8 + 2) * 65 + n], tile[(kc * 8 + 3) * 65 + n]);
    w.z = pack2(tile[(kc * 8 + 4) * 65 + n], tile[(kc * 8 + 5) * 65 + n]); w.w = pack2(tile[(kc * 8 + 6) * 65 + n], tile[(kc * 8 + 7) * 65 + n]);
    *(u32x4*)(dst + (size_t)n * ldd + kc * 8) = w;
}
__device__ __forceinline__ void tile_load(float* tile, const float* src, int lds_) {
    const int tid = tid_opaque();
#pragma unroll
    for (int i = 0; i < 2; ++i) { const int row = (tid >> 4) + 32 * i, c4 = (tid & 15) * 4; const f32x4 v = *(const f32x4*)(src + (size_t)row * lds_ + c4);
        tile[row * 65 + c4 + 0] = v[0]; tile[row * 65 + c4 + 1] = v[1]; tile[row * 65 + c4 + 2] = v[2]; tile[row * 65 + c4 + 3] = v[3]; }
}

__device__ __forceinline__ void mm64_f32(const float* tA, int lda, const float* tB, int ldb, int K, float* out) {
    const int tid = tid_opaque(), lane = tid & 63, w = tid >> 6, fr = lane & 15, g = lane >> 4, mi = w >> 1, nj = 2 * (w & 1);
    f32x4 acc0 = (f32x4){0.f, 0.f, 0.f, 0.f}, acc1 = (f32x4){0.f, 0.f, 0.f, 0.f};
    const float* pa = tA + (16 * mi + fr) * lda + g; const float* pb = tB + g * ldb + 16 * nj + fr;
#pragma unroll 4
    for (int k0 = 0; k0 < K; k0 += 4) { const float av = pa[k0], b0 = pb[k0 * ldb], b1 = pb[k0 * ldb + 16];
        acc0 = __builtin_amdgcn_mfma_f32_16x16x4f32(av, b0, acc0, 0, 0, 0); acc1 = __builtin_amdgcn_mfma_f32_16x16x4f32(av, b1, acc1, 0, 0, 0); }
#pragma unroll
    for (int r = 0; r < 4; ++r) { out[(16 * mi + 4 * g + r) * 65 + 16 * nj + fr] = acc0[r]; out[(16 * mi + 4 * g + r) * 65 + 16 * nj + 16 + fr] = acc1[r]; }
}

__device__ __forceinline__ void win_unit(AP a, unsigned char* lds, int u) {
    float* tile = (float*)(lds + LDS_TILE); float* T = (float*)(lds + LDS_T64);
    const int tid = tid_opaque();
    const int l = u / 448, r = u % 448, kb = r / 28, nb = r % 28;
    const float* Win = a->in[6] + (size_t)l * 1024 * 1536;
    const int srccol = (nb >= 8) ? nb * 64 - 256 : (nb & 3) * 64;
    tile_load(tile, Win + (size_t)(kb * 64) * 1536 + srccol, 1536);
    if (nb < 8 && tid < 64) { T[tid] = cospif((float)tid / 32.0f); T[64 + tid] = sinpif((float)tid / 32.0f); }
    __syncthreads();
    bf16_t* dst = (bf16_t*)(a->ws + WS_WIN) + ((size_t)l * ZC + nb * 64) * 1024 + kb * 64;
    if (nb >= 8) tile_store_T(tile, dst, 1024);
    else {
        const int part = nb >> 2;
        float* Tm = (float*)(lds + 65536); float* out = (float*)(lds + 98304);
        for (int i = tid; i < 4096; i += NT) { const int c = i >> 6, cp = i & 63; const float t = T[part * 64 + ((c * cp) & 63)]; Tm[i] = (part ? -t : t) * 0.125f; }
        __syncthreads();
        mm64_f32(tile, 65, Tm, 64, 64, out);
        __syncthreads();
        tile_store_T(out, dst, 1024);
    }
    __syncthreads();
}

__device__ __forceinline__ void wout_unit(AP a, unsigned char* lds, int u) {
    float* tile = (float*)(lds + LDS_TILE);
    __syncthreads();
    const int tid = tid_opaque();
    const int l = u / 256, r = u % 256, kb = r / 16, nb = r % 16;
    const float* Wo = a->in[13] + (size_t)l * 1024 * 1024;
    const int n = tid & 63, kq = __builtin_amdgcn_readfirstlane(tid >> 6);
    if (kb < 4) {
        float* tA = (float*)lds; float* tB = (float*)(lds + 65536);
        const float* wf = a->in[7] + (size_t)l * 256 * 256 + (size_t)(kb * 64) * 256;
        __syncthreads();
        f32x4 va[8], vb[8];
#pragma unroll
        for (int i = 0; i < 8; ++i) { const int q = tid + 512 * i; va[i] = *(const f32x4*)(wf + (size_t)q * 4); vb[i] = *(const f32x4*)(Wo + (size_t)(q >> 4) * 1024 + nb * 64 + (q & 15) * 4); }
#pragma unroll
        for (int i = 0; i < 8; ++i) { const int q = tid + 512 * i; *(f32x4*)(tA + (size_t)q * 4) = va[i]; *(f32x4*)(tB + (size_t)q * 4) = vb[i]; }
        __syncthreads();
        tile = (float*)(lds + 133120);
        mm64_f32(tA, 256, tB, 64, 256, tile);
    } else if (kb >= 8 && kb < 12) {
        const int g = kb - 8;
        float* tA = (float*)lds; float* tB = (float*)(lds + 65536);
        const float* wp = a->in[9] + (size_t)(l * 4 + g) * 64 * 64;
        const float* ps = a->in[10] + l * 256 + g * 64;
        f32x4 va[2], vb[2];
#pragma unroll
        for (int i = 0; i < 2; ++i) { const int q = tid + 512 * i; va[i] = *(const f32x4*)(wp + (size_t)q * 4); vb[i] = *(const f32x4*)(Wo + (size_t)(512 + g * 64 + (q >> 4)) * 1024 + nb * 64 + (q & 15) * 4) * ps[q >> 4]; }
#pragma unroll
        for (int i = 0; i < 2; ++i) { const int q = tid + 512 * i; *(f32x4*)(tA + (size_t)q * 4) = va[i]; *(f32x4*)(tB + (size_t)q * 4) = vb[i]; }
        __syncthreads();
        tile = (float*)(lds + 133120);
        mm64_f32(tA, 64, tB, 64, 64, tile);
    } else tile_load(tile, Wo + (size_t)(kb * 64) * 1024 + nb * 64, 1024);
    __syncthreads();
    tile_store_T(tile, (bf16_t*)(a->ws + WS_WOUT) + ((size_t)l * 1024 + nb * 64) * 1024 + kb * 64, 1024);
    __syncthreads();
}

__device__ __forceinline__ void exp_src_dst(AP a, int l, int u, const float*& src, int& srcld, unsigned char*& dst, int& dstld) {
    const int mat = u / 1024, e = (u % 1024) / 32, t = u % 32;
    const int kb = (mat < 2) ? t / 4 : t / 8, nb = (mat < 2) ? t % 4 : t % 8;
    srcld = (mat < 2) ? 512 : 1024; dstld = (mat < 2) ? 1024 : 512;
    src = a->in[18 + mat] + ((size_t)(l * 32 + e) * 512 * 1024) + (size_t)(kb * 128) * srcld + nb * 128;
    dst = a->ws + WS_WEXP + (size_t)l * WEXP_LAYER + (size_t)mat * EXPMAT + (size_t)e * 512 * 1024 + (size_t)(nb * 128) * dstld + kb * 128;
}
#define EXP_LOAD(vv, uu) do { exp_src_dst(a, l, (uu), src, srcld, dst, dstld); _Pragma("unroll") for (int _i = 0; _i < 8; ++_i) vv[_i] = *(const f32x4*)(src + (size_t)((tid >> 5) + 16 * _i) * srcld + (tid & 31) * 4); } while (0)
#define EXP_PUT(vv) do { _Pragma("unroll") for (int _i = 0; _i < 8; ++_i) *(f32x4*)(tile + ((tid >> 5) + 16 * _i) * 132 + (tid & 31) * 4) = vv[_i] * 32.0f; } while (0)
#define EXP_STORE(dd, ld_) do { const int n = ((tid >> 6) & 3) * 32 + (tid & 31), kb = (tid >> 8) * 64 + ((tid >> 5) & 1) * 16;        \
        _Pragma("unroll") for (int j = 0; j < 2; ++j) { const float* tp = tile + (kb + j * 32) * 132 + n; u32x4 w; \
        w.x = pack4_fp8(tp[0], tp[132], tp[2 * 132], tp[3 * 132]); w.y = pack4_fp8(tp[4 * 132], tp[5 * 132], tp[6 * 132], tp[7 * 132]); \
        w.z = pack4_fp8(tp[8 * 132], tp[9 * 132], tp[10 * 132], tp[11 * 132]); w.w = pack4_fp8(tp[12 * 132], tp[13 * 132], tp[14 * 132], tp[15 * 132]); \
        *(u32x4*)((dd) + (size_t)n * (ld_) + kb + j * 32) = w; } } while (0)
__device__ __forceinline__ void exp_range(AP a, unsigned char* lds, int l, int u0, int u_end) {
    float* tile = (float*)lds;
    const int tid = tid_opaque();
    __syncthreads();
    if (u0 >= u_end) return;
    const float* src; unsigned char* dst; int srcld, dstld;
    f32x4 va[8], vb[8];
    unsigned char *da, *db = nullptr; int lda_, ldb_ = 0;
    EXP_LOAD(va, u0); da = dst; lda_ = dstld;
    if (u0 + 1 < u_end) { EXP_LOAD(vb, u0 + 1); db = dst; ldb_ = dstld; }
    for (int u = u0; u < u_end; u += 2) {
        EXP_PUT(va);
        __syncthreads();
        { unsigned char* cd = da; const int cl = lda_; if (u + 2 < u_end) { EXP_LOAD(va, u + 2); da = dst; lda_ = dstld; } EXP_STORE(cd, cl); }
        __syncthreads();
        if (u + 1 < u_end) {
            EXP_PUT(vb);
            __syncthreads();
            { unsigned char* cd = db; const int cl = ldb_; if (u + 3 < u_end) { EXP_LOAD(vb, u + 3); db = dst; ldb_ = dstld; } EXP_STORE(cd, cl); }
            __syncthreads();
        }
    }
}
#undef EXP_LOAD
#undef EXP_PUT
#undef EXP_STORE
__device__ __forceinline__ void exp_queue(AP a, unsigned char* lds, int l) {
    const int tid = tid_opaque();
    int* qslot = (int*)(lds + MISC_OFF + 128);
    unsigned* qc = (unsigned*)(a->ws + WS_BAR + 14336 + l * 256);
    for (;;) {
        __syncthreads();
        if (tid == 0) *qslot = (int)__hip_atomic_fetch_add(qc, 2u, __ATOMIC_RELAXED, __HIP_MEMORY_SCOPE_AGENT);
        __syncthreads();
        const int c0 = *qslot;
        if (c0 >= U_EXP) break;
        exp_range(a, lds, l, c0, c0 + 2);
    }
}

__device__ __forceinline__ void exp_fill(AP a, unsigned char* lds, int ql, int budget) {
    const int tid = tid_opaque();
    int* qslot = (int*)(lds + MISC_OFF + 128);
    unsigned* qc = (unsigned*)(a->ws + WS_BAR + 14336 + ql * 256);
    for (int done = 0; done < budget; done += 2) {
        __syncthreads();
        if (tid == 0) *qslot = (int)__hip_atomic_fetch_add(qc, 2u, __ATOMIC_RELAXED, __HIP_MEMORY_SCOPE_AGENT);
        __syncthreads();
        const int c0 = *qslot;
        if (c0 >= U_EXP) break;
        exp_range(a, lds, ql, c0, c0 + 2);
    }
    __syncthreads();
}

__device__ __forceinline__ void p0_prologue(AP a, unsigned char* lds) {
    const int tid = tid_opaque();
    bool have_tab = false;
    constexpr int E0 = U_ADA, E1 = E0 + U_WIN, E2 = E1 + U_WOUT, E3 = E2 + U_SGU, E4 = E3 + U_DFT, E5 = E4 + U_ROPE;
    int u = blockIdx.x;
    for (; u < E5; u += gridDim.x) {
        if (u < E0) ada_unit(a, lds, u);
        else if (u < E1) win_unit(a, lds, u - E0);
        else if (u < E2) wout_unit(a, lds, u - E1);
        else if (u < E3) { const size_t i0 = (size_t)(u - E2) * 4096 + tid * 8; const float* s = a->in[11] + i0; bf16_t* d = (bf16_t*)(a->ws + WS_WSGU) + i0;
            const f32x4 v0 = *(const f32x4*)s, v1 = *(const f32x4*)(s + 4); u32x4 w; w.x = pack2(v0[0], v0[1]); w.y = pack2(v0[2], v0[3]); w.z = pack2(v1[0], v1[1]); w.w = pack2(v1[2], v1[3]); *(u32x4*)d = w; }
        else if (u < E4) {
            float* ctab = (float*)(lds + LDS_CTAB);
            if (!have_tab) { for (int i = tid; i < 4096; i += NT) ctab[i] = cospif((float)i / 2048.0f); __syncthreads(); have_tab = true; }
            const int k = u - E3 + 4096;
            if (tid < 32) {
                const int kk = k - 4096, n0 = tid * 8; float c[8], s[8];
#pragma unroll
                for (int e = 0; e < 8; ++e) { const int idx = ((kk * (n0 + e)) & 255) * 16; c[e] = ctab[idx] * (1.0f / 16.0f); s[e] = ctab[(idx - 1024) & 4095] * (1.0f / 16.0f); }
                bf16_t* d = (bf16_t*)(a->ws + WS_DFTC) + (size_t)kk * 512 + n0;
                u32x4 w; w.x = pack2(c[0], c[1]); w.y = pack2(c[2], c[3]); w.z = pack2(c[4], c[5]); w.w = pack2(c[6], c[7]); *(u32x4*)d = w;
                w.x = pack2(s[0], s[1]); w.y = pack2(s[2], s[3]); w.z = pack2(s[4], s[5]); w.w = pack2(s[6], s[7]); *(u32x4*)(d + 256) = w;
            }
        }
        else {
            for (int i = tid; i < 1024; i += NT) { const int pos = i >> 4, f = i & 15; const float freq = powf(10000.0f, -(float)f / 16.0f); const float ang = (float)pos * freq;
                ((float2*)(a->ws + WS_ROPE))[i] = make_float2(cosf(ang), sinf(ang)); }
        }
    }
}

__device__ __forceinline__ void p_lnmod0(AP a) {
    const int tid = tid_opaque(), lane = tid & 63, w = tid >> 6;
    const float* mod = (const float*)(a->ws + WS_MOD);
    bf16_t* H = (bf16_t*)(a->ws + WS_H);
    const int tstep = gridDim.x * 8;
    f32x4 nx[4];
    { const int t = blockIdx.x * 8 + w; if (t < NTOK) { const float* src = (t < NLAT) ? a->in[0] + (size_t)t * D : a->in[2] + (size_t)(t - NLAT) * D;
#pragma unroll
        for (int i = 0; i < 4; ++i) nx[i] = *(const f32x4*)(src + 256 * i + 4 * lane); } }
    int mrow = -1; f32x4 msh[4], msc[4];
    for (int t = blockIdx.x * 8 + w; t < NTOK; t += tstep) {
        const int mr = (t < NLAT) ? (t >> 12) : 4;
        if (mr != mrow) { mrow = mr; const float* m = mod + (size_t)mr * 6144;
#pragma unroll
            for (int i = 0; i < 4; ++i) { msh[i] = *(const f32x4*)(m + 256 * i + 4 * lane); msc[i] = *(const f32x4*)(m + 1024 + 256 * i + 4 * lane); } }
        f32x4 v[4];
#pragma unroll
        for (int i = 0; i < 4; ++i) v[i] = nx[i];
        { const int tn = t + tstep; if (tn < NTOK) { const float* src = (tn < NLAT) ? a->in[0] + (size_t)tn * D : a->in[2] + (size_t)(tn - NLAT) * D;
#pragma unroll
            for (int i = 0; i < 4; ++i) nx[i] = *(const f32x4*)(src + 256 * i + 4 * lane); } }
        float mean, rstd; ln_stats(v, mean, rstd);
#pragma unroll
        for (int i = 0; i < 4; ++i) { const int c = 256 * i + 4 * lane;
            f32x4 o;
#pragma unroll
            for (int e = 0; e < 4; ++e) o[e] = (v[i][e] - mean) * rstd * (1.0f + msc[i][e]) + msh[i][e];
            u32x2 pk; pk.x = pack2(o[0], o[1]); pk.y = pack2(o[2], o[3]); *(u32x2*)(H + (size_t)t * D + c) = pk; }
    }
}

__device__ __forceinline__ void p1_inproj(AP a, unsigned char* smem, LAS unsigned char* lds, int l);
__device__ __forceinline__ u32x4 ld16g(const bf16_t* p) { return *(const u32x4*)p; }
__device__ __forceinline__ void rope_pack8(u32x4& wl, u32x4& wh, const LAS f32x2* tab, bool do_rope, float scale) {
    float tl[8] = {lo2f(wl.x), hi2f(wl.x), lo2f(wl.y), hi2f(wl.y), lo2f(wl.z), hi2f(wl.z), lo2f(wl.w), hi2f(wl.w)};
    float th[8] = {lo2f(wh.x), hi2f(wh.x), lo2f(wh.y), hi2f(wh.y), lo2f(wh.z), hi2f(wh.z), lo2f(wh.w), hi2f(wh.w)};
#pragma unroll
    for (int j = 0; j < 8; ++j) {
        float r1 = tl[j], r2 = th[j];
        if (do_rope) { const f32x2 cs = tab[j]; r1 = tl[j] * cs.x - th[j] * cs.y; r2 = tl[j] * cs.y + th[j] * cs.x; }
        tl[j] = r1 * scale; th[j] = r2 * scale;
    }
    wl.x = pack2(tl[0], tl[1]); wl.y = pack2(tl[2], tl[3]); wl.z = pack2(tl[4], tl[5]); wl.w = pack2(tl[6], tl[7]);
    wh.x = pack2(th[0], th[1]); wh.y = pack2(th[2], th[3]); wh.z = pack2(th[4], th[5]); wh.w = pack2(th[6], th[7]);
}

__device__ __forceinline__ void mixer_sgu_pool(AP a, LAS unsigned char* lds, int l, int row0, int seq_row0, int pos0, int n) {
    typedef short s16x4 __attribute__((ext_vector_type(4)));
    const int tid = tid_opaque(), lane = tid & 63, w = __builtin_amdgcn_readfirstlane(tid >> 6), fr = lane & 15, g = lane >> 4;
    const bf16_t* Z = (const bf16_t*)(a->ws + WS_Z);
    bf16_t* CAT = (bf16_t*)(a->ws + WS_CAT);
    constexpr int VOFF = 73728;
    u32x4 pr[9];
#pragma unroll
    for (int it = 0; it < 9; ++it) { const int id = tid + 512 * it, rr = id >> 5, ch = id & 31, j = pos0 - 8 + rr;
        pr[it] = (u32x4){0u, 0u, 0u, 0u};
        if (j >= 0 && j < n) pr[it] = ld16g(Z + (size_t)(seq_row0 + j) * ZC + 1024 + ch * 8); }
    bf16x8 wfrag[4][4];
    {   const int h = w >> 1, ph = w & 1; const bf16_t* Ws = (const bf16_t*)(a->ws + WS_WSGU) + (size_t)(l * 4 + h) * 128 * 128;
#pragma unroll
        for (int ks = 0; ks < 4; ++ks)
#pragma unroll
            for (int pf = 0; pf < 4; ++pf) wfrag[ks][pf] = *(const bf16x8*)(Ws + (size_t)(ph * 64 + 16 * pf + fr) * 128 + 32 * ks + 8 * g); }
    u32x4 gw[4][2];
#pragma unroll
    for (int ps = 0; ps < 4; ++ps) { const int q = w * 16 + ps * 4 + g; const bf16_t* src = Z + (size_t)(row0 + q) * ZC + 1536 + 16 * fr; gw[ps][0] = ld16g(src); gw[ps][1] = ld16g(src + 8); }
#pragma unroll
    for (int it = 0; it < 9; ++it) { const int id = tid + 512 * it; *(LAS u32x4*)(lds + (id >> 5) * 512 + (id & 31) * 16) = pr[it]; }
#pragma unroll
    for (int ps = 0; ps < 4; ++ps) {
        const int q = w * 16 + ps * 4 + g;
        float gv[16];
#pragma unroll
        for (int hh = 0; hh < 2; ++hh) { const u32x4 x = gw[ps][hh];
            gv[8 * hh + 0] = gelu_erf(lo2f(x.x)); gv[8 * hh + 1] = gelu_erf(hi2f(x.x)); gv[8 * hh + 2] = gelu_erf(lo2f(x.y)); gv[8 * hh + 3] = gelu_erf(hi2f(x.y));
            gv[8 * hh + 4] = gelu_erf(lo2f(x.z)); gv[8 * hh + 5] = gelu_erf(hi2f(x.z)); gv[8 * hh + 6] = gelu_erf(lo2f(x.w)); gv[8 * hh + 7] = gelu_erf(hi2f(x.w)); }
        float sm = 0.f;
#pragma unroll
        for (int e = 0; e < 16; ++e) sm += gv[e];
        const float mean = row_sum16(sm) * (1.0f / 256.0f);
        float qq = 0.f;
#pragma unroll
        for (int e = 0; e < 16; ++e) { const float d = gv[e] - mean; qq += d * d; }
        const float rstd = 1.0f / sqrtf(row_sum16(qq) * (1.0f / 256.0f) + 1e-6f);
        u32x4 o0, o1;
        o0.x = pack2((gv[0] - mean) * rstd, (gv[1] - mean) * rstd); o0.y = pack2((gv[2] - mean) * rstd, (gv[3] - mean) * rstd); o0.z = pack2((gv[4] - mean) * rstd, (gv[5] - mean) * rstd); o0.w = pack2((gv[6] - mean) * rstd, (gv[7] - mean) * rstd);
        o1.x = pack2((gv[8] - mean) * rstd, (gv[9] - mean) * rstd); o1.y = pack2((gv[10] - mean) * rstd, (gv[11] - mean) * rstd); o1.z = pack2((gv[12] - mean) * rstd, (gv[13] - mean) * rstd); o1.w = pack2((gv[14] - mean) * rstd, (gv[15] - mean) * rstd);
        const int sg = fr ^ ((q & 3) | (((q >> 3) & 1) << 2));
        *(LAS u32x4*)(lds + VOFF + q * 512 + sg * 32) = o0; *(LAS u32x4*)(lds + VOFF + q * 512 + sg * 32 + 16) = o1;
    }
    __syncthreads();
    {
        const int c = tid & 255, half = tid >> 8, hw = 1 << (c >> 6);
        const LAS bf16_t* P = (const LAS bf16_t*)lds + c;
        const int t0 = half * 64;
        const float invfull = 1.0f / (float)(2 * hw);
        float s = 0.f;
        for (int j = t0 - hw; j < t0 + hw; ++j) s += bf2f(P[(8 + j) * 256]);
        for (int tl = t0; tl < t0 + 64; ++tl) {
            const int pos = pos0 + tl; const int cntw = min(pos + hw, n) - max(pos - hw, 0);
            const float inv = (cntw == 2 * hw) ? invfull : 1.0f / (float)cntw;
            CAT[(size_t)(row0 + tl) * D + 512 + c] = f2bf(s * inv - bf2f(P[(8 + tl) * 256]));
            s += bf2f(P[(8 + tl + hw) * 256]) - bf2f(P[(8 + tl - hw) * 256]);
        }
    }
    {
        const int h = w >> 1, ph = w & 1;
        const float* bs = a->in[12] + (size_t)(l * 4 + h) * 128;
        f32x4 acc[4][4];
#pragma unroll
        for (int i = 0; i < 4; ++i)
#pragma unroll
            for (int j = 0; j < 4; ++j) acc[i][j] = (f32x4){0.f, 0.f, 0.f, 0.f};
        const int qq4 = fr >> 2, p4 = fr & 3, fsw = qq4 | ((g & 1) << 2);
#pragma unroll
        for (int ks = 0; ks < 4; ++ks) {
            bf16x8 af[4];
            const int r0 = 32 * ks + 8 * g + qq4;
#pragma unroll
            for (int cf = 0; cf < 4; ++cf) { const int so = (((4 * h + cf) ^ fsw) << 5) + p4 * 8;
                const s16x4 lo = __builtin_amdgcn_ds_read_tr16_b64_v4i16((LAS s16x4*)(lds + VOFF + r0 * 512 + so));
                const s16x4 hi = __builtin_amdgcn_ds_read_tr16_b64_v4i16((LAS s16x4*)(lds + VOFF + (r0 + 4) * 512 + so));
                af[cf] = __builtin_shufflevector(lo, hi, 0, 1, 2, 3, 4, 5, 6, 7); }
#pragma unroll
            for (int cf = 0; cf < 4; ++cf)
#pragma unroll
                for (int pf = 0; pf < 4; ++pf) acc[cf][pf] = __builtin_amdgcn_mfma_f32_16x16x32_bf16(af[cf], wfrag[ks][pf], acc[cf][pf], 0, 0, 0);
        }
#pragma unroll
        for (int pf = 0; pf < 4; ++pf) { const int p = ph * 64 + 16 * pf + fr; const float bias = bs[p];
#pragma unroll
            for (int cf = 0; cf < 4; ++cf) { const int c0 = h * 64 + 16 * cf + 4 * g;
                const u32x2 uw = *(const u32x2*)(Z + (size_t)(row0 + p) * ZC + 1280 + c0);
                u32x2 o; o.x = pack2(gelu_erf(lo2f(uw.x)) * (acc[cf][pf][0] + bias), gelu_erf(hi2f(uw.x)) * (acc[cf][pf][1] + bias));
                o.y = pack2(gelu_erf(lo2f(uw.y)) * (acc[cf][pf][2] + bias), gelu_erf(hi2f(uw.y)) * (acc[cf][pf][3] + bias));
                *(u32x2*)(CAT + (size_t)(row0 + p) * D + 768 + c0) = o; } }
    }
    __syncthreads();
}

__device__ __forceinline__ void mixer_attn(AP a, LAS unsigned char* lds, int l, int row0, int seq_row0, int pos0, int n, int b, bool is_ctx, int kvh) {
    const int tid = tid_opaque(), lane = tid & 63, w = __builtin_amdgcn_readfirstlane(tid >> 6), fr = lane & 15, g = lane >> 4;
    const bf16_t* Z = (const bf16_t*)(a->ws + WS_Z);
    bf16_t* CAT = (bf16_t*)(a->ws + WS_CAT);
    __syncthreads();
    ((LAS u32x4*)(lds + 98304))[tid] = ((const u32x4*)(a->ws + WS_ROPE))[tid];
    const LAS f32x2* rope = (const LAS f32x2*)(lds + 98304);
    constexpr float QS = 0.125f * 1.44269504088896341f;
    constexpr int QS_OFF = 0, KS_OFF = 32768, VS_OFF = 65536;
    const int nbq = pos0 >> 7;
    unsigned bmask = 0x18u;
    if (!is_ctx) { if (nbq > 0) bmask |= 1u; bmask |= 2u; if (nbq + 1 < (n >> 7)) bmask |= 4u; }
    const int kr = tid >> 2, kax = (tid >> 1) & 1, kh8 = tid & 1;
#define MX_KSRC(blk) (Z + (size_t)((((blk) < 3) ? seq_row0 + (nbq + (blk) - 1) * 128 : NLAT + b * 256 + ((blk) - 3) * 128) + kr) * ZC + 768 + kvh * 64 + kax * 32 + kh8 * 8)
#define MX_VSTAGE(blk, buf) do { const bool _band = (blk) < 3; const int _key0 = _band ? (nbq + (blk) - 1) * 128 : ((blk) - 3) * 128; \
        const bf16_t* _vs = _band ? (const bf16_t*)(a->ws + WS_VT) + (size_t)(b * 2 + kvh) * 64 * 4096 + _key0 : (const bf16_t*)(a->ws + WS_VTC) + (size_t)(b * 2 + kvh) * 64 * 256 + _key0; \
        const int _vld = _band ? 4096 : 256; \
        _Pragma("unroll") for (int _i = 0; _i < 2; ++_i) { const int _P = _i * 512 + tid, _d = _P >> 4, _c = (_P & 15) ^ (_d & 15); \
            glds16(_vs + (size_t)_d * _vld + _c * 8, lds + VS_OFF + (buf) * 16384 + _i * 8192 + w * 1024); } } while (0)
    {
        __syncthreads();
#pragma unroll
        for (int it = 0; it < 2; ++it) {
            const int item = tid + 512 * it, r = item >> 2, ax = (item >> 1) & 1, h8 = item & 1, i = r & 127, qpos = pos0 + i;
            const bf16_t* src = Z + (size_t)(row0 + i) * ZC + 512 + (2 * kvh + (r >> 7)) * 64 + ax * 32 + h8 * 8;
            u32x4 wl = ld16g(src), wh = ld16g(src + 16);
            rope_pack8(wl, wh, rope + (ax ? (qpos & 63) : (qpos >> 6)) * 16 + h8 * 8, !is_ctx, QS);
            const int ch = ax * 4 + h8, sw = (r >> 1) & 7;
            *(LAS u32x4*)(lds + QS_OFF + r * 128 + ((ch ^ sw) << 4)) = wl;
            *(LAS u32x4*)(lds + QS_OFF + r * 128 + (((ch + 2) ^ sw) << 4)) = wh;
        }
        const int hh = w >> 2, qb = (w & 3) * 32, h = 2 * kvh + hh;
        float m[2], lsum[2];
        m[0] = m[1] = a->in[8][l * 4 + h] * 1.44269504088896341f;
        lsum[0] = lsum[1] = (g == 0) ? 1.0f : 0.0f;
        f32x4 O[4][2];
#pragma unroll
        for (int i = 0; i < 4; ++i) { O[i][0] = (f32x4){0.f, 0.f, 0.f, 0.f}; O[i][1] = (f32x4){0.f, 0.f, 0.f, 0.f}; }
        bf16x8 Qf[2][2];
        bool have_q = false;
        unsigned rem = bmask;
        int cur = __builtin_ctz(rem); rem &= rem - 1u;
        int buf = 0;
        u32x4 kl = ld16g(MX_KSRC(cur)), kh = ld16g(MX_KSRC(cur) + 16);
        MX_VSTAGE(cur, 0);
#pragma unroll 1
        for (;;) {
            const int jb = cur - 1; const bool band = cur < 3;
            {
                const int kpos = (nbq + jb) * 128 + kr;
                rope_pack8(kl, kh, rope + (kax ? (kpos & 63) : (kpos >> 6)) * 16 + kh8 * 8, band, 1.0f);
                const int ch = kax * 4 + kh8, sw = (kr >> 1) & 7;
                *(LAS u32x4*)(lds + KS_OFF + buf * 16384 + kr * 128 + ((ch ^ sw) << 4)) = kl;
                *(LAS u32x4*)(lds + KS_OFF + buf * 16384 + kr * 128 + (((ch + 2) ^ sw) << 4)) = kh;
            }
            asm volatile("s_waitcnt vmcnt(0)" ::: "memory");
            __syncthreads();
            const int nxt = rem ? __builtin_ctz(rem) : -1; rem &= rem - 1u;
            if (nxt >= 0) { kl = ld16g(MX_KSRC(nxt)); kh = ld16g(MX_KSRC(nxt) + 16); MX_VSTAGE(nxt, buf ^ 1); }
            if (!have_q) {
#pragma unroll
                for (int qf = 0; qf < 2; ++qf)
#pragma unroll
                    for (int ks = 0; ks < 2; ++ks) { const int r = hh * 128 + qb + 16 * qf + fr; Qf[qf][ks] = *(const LAS bf16x8*)(lds + QS_OFF + r * 128 + (((4 * ks + g) ^ ((r >> 1) & 7)) << 4)); }
                have_q = true;
            }
            const int kso = KS_OFF + buf * 16384, vso = VS_OFF + buf * 16384;
            f32x4 S[8][2];
#pragma unroll
            for (int kf = 0; kf < 8; ++kf) { S[kf][0] = (f32x4){0.f, 0.f, 0.f, 0.f}; S[kf][1] = (f32x4){0.f, 0.f, 0.f, 0.f}; }
#pragma unroll
            for (int kf = 0; kf < 8; ++kf)
#pragma unroll
                for (int ks = 0; ks < 2; ++ks) { const int r = 16 * kf + fr;
                    const bf16x8 kfr = *(const LAS bf16x8*)(lds + kso + r * 128 + (((4 * ks + g) ^ ((r >> 1) & 7)) << 4));
                    S[kf][0] = __builtin_amdgcn_mfma_f32_16x16x32_bf16(kfr, Qf[0][ks], S[kf][0], 0, 0, 0);
                    S[kf][1] = __builtin_amdgcn_mfma_f32_16x16x32_bf16(kfr, Qf[1][ks], S[kf][1], 0, 0, 0); }
            bf16x8 Pp[4][2];
#pragma unroll
            for (int qf = 0; qf < 2; ++qf) {
                const int qi = qb + 16 * qf + fr;
                if (band && jb != 0) {
#pragma unroll
                    for (int kf = 0; kf < 8; ++kf)
#pragma unroll
                        for (int r = 0; r < 4; ++r) { const int kk = 16 * kf + 4 * g + r; const bool ok = (jb < 0) ? (kk >= qi) : (kk <= qi); if (!ok) S[kf][qf][r] = -1.0e30f; }
                }
                float mx = S[0][qf][0];
#pragma unroll
                for (int kf = 0; kf < 8; ++kf)
#pragma unroll
                    for (int r = 0; r < 4; ++r) mx = fmaxf(mx, S[kf][qf][r]);
                mx = fmaxf(mx, __shfl_xor(mx, 16)); mx = fmaxf(mx, __shfl_xor(mx, 32));
                const float mn = fmaxf(m[qf], mx), corr = __builtin_amdgcn_exp2f(m[qf] - mn);
                m[qf] = mn;
                float ps = 0.f;
#pragma unroll
                for (int kf = 0; kf < 8; ++kf)
#pragma unroll
                    for (int r = 0; r < 4; ++r) { const float p = __builtin_amdgcn_exp2f(S[kf][qf][r] - mn); S[kf][qf][r] = p; ps += p; }
                lsum[qf] = lsum[qf] * corr + ps;
#pragma unroll
                for (int df = 0; df < 4; ++df) O[df][qf] *= corr;
#pragma unroll
                for (int t = 0; t < 4; ++t) { u32x4 pw; pw.x = pack2(S[2 * t][qf][0], S[2 * t][qf][1]); pw.y = pack2(S[2 * t][qf][2], S[2 * t][qf][3]);
                    pw.z = pack2(S[2 * t + 1][qf][0], S[2 * t + 1][qf][1]); pw.w = pack2(S[2 * t + 1][qf][2], S[2 * t + 1][qf][3]); Pp[t][qf] = __builtin_bit_cast(bf16x8, pw); }
            }
#pragma unroll
            for (int t = 0; t < 4; ++t)
#pragma unroll
                for (int df = 0; df < 4; ++df) { const int d = 16 * df + fr;
                    const u32x2 v0 = *(const LAS u32x2*)(lds + vso + d * 256 + (((4 * t + (g >> 1)) ^ (d & 15)) << 4) + (g & 1) * 8);
                    const u32x2 v1 = *(const LAS u32x2*)(lds + vso + d * 256 + (((4 * t + 2 + (g >> 1)) ^ (d & 15)) << 4) + (g & 1) * 8);
                    u32x4 vw; vw.x = v0.x; vw.y = v0.y; vw.z = v1.x; vw.w = v1.y; const bf16x8 vf = __builtin_bit_cast(bf16x8, vw);
                    O[df][0] = __builtin_amdgcn_mfma_f32_16x16x32_bf16(vf, Pp[t][0], O[df][0], 0, 0, 0);
                    O[df][1] = __builtin_amdgcn_mfma_f32_16x16x32_bf16(vf, Pp[t][1], O[df][1], 0, 0, 0); }
            if (nxt < 0) break;
            cur = nxt; buf ^= 1;
        }
#pragma unroll
        for (int qf = 0; qf < 2; ++qf) {
            float lt = lsum[qf]; lt += __shfl_xor(lt, 16); lt += __shfl_xor(lt, 32);
            const float inv = 1.0f / lt;
            bf16_t* dst = CAT + (size_t)(row0 + qb + 16 * qf + fr) * D + 256 + h * 64 + 4 * g;
#pragma unroll
            for (int df = 0; df < 4; ++df) { u32x2 o; o.x = pack2(O[df][qf][0] * inv, O[df][qf][1] * inv); o.y = pack2(O[df][qf][2] * inv, O[df][qf][3] * inv); *(u32x2*)(dst + 16 * df) = o; }
        }
    }
#undef MX_KSRC
#undef MX_VSTAGE
    __syncthreads();
}

constexpr int FF_DA = 0, FF_DC = 32768, FF_XT = 49152  , FF_Z2 = 81920  , FF_OB = 114688  ;
__device__ __forceinline__ int ff_addr(int row, int k) { return row * 256 + ((((k >> 3) ^ (row & 15))) << 4) + (k & 7) * 2; }
__device__ __forceinline__ float cos_turns(float x) { return __builtin_amdgcn_cosf(x); }
__device__ __forceinline__ float sin_turns(float x) { return __builtin_amdgcn_sinf(x); }
__device__ __forceinline__ void fft_setup(LAS unsigned char* lds) {
    const int tid = tid_opaque();
    __syncthreads();
    for (int idx = tid; idx < 16384; idx += NT) { const int i = idx >> 7, k = idx & 127, ro = i >> 6, k1 = i & 63, part = k >> 6, n1 = k & 63; const float t = (float)((k1 * n1) & 63) * (1.0f / 64.0f);
        const float c = cos_turns(t), sn = sin_turns(t);
        const float v = (ro == 0) ? (part == 0 ? c : sn) : (part == 0 ? -sn : c);
        *(LAS bf16_t*)(lds + FF_DA + ff_addr(i, k)) = f2bf(v * 0.125f); }
    for (int idx = tid; idx < 8192; idx += NT) { const int k2 = idx >> 7, k = idx & 127, ri = k >> 6, n2 = k & 63; const float t = (float)((k2 * n2) & 63) * (1.0f / 64.0f);
        const float v = (ri == 0) ? cos_turns(t) : sin_turns(t);
        *(LAS bf16_t*)(lds + FF_DC + ff_addr(k2, k)) = f2bf(v * 0.125f); }
    __syncthreads();
}
__device__ __forceinline__ void fft_unit(AP a, LAS unsigned char* lds, int b, int cg) {
    const int tid = tid_opaque(), lane = tid & 63, w = __builtin_amdgcn_readfirstlane(tid >> 6), fr = lane & 15, g = lane >> 4;
    const int mf = w & 3, nh = w >> 2;
    const bf16_t* AT = (const bf16_t*)(a->ws + WS_AT) + (size_t)(b * 256 + cg * 4) * 8192;
    u32x4 xin[2][2];
#pragma unroll
    for (int h = 0; h < 2; ++h)
#pragma unroll
        for (int it = 0; it < 2; ++it) xin[h][it] = ld16g(AT + (size_t)h * 8192 + (size_t)(tid + 512 * it) * 8);
#pragma unroll 1
    for (int cp = 0; cp < 2; ++cp) {
#pragma unroll
        for (int h = 0; h < 2; ++h)
#pragma unroll
            for (int it = 0; it < 2; ++it) { const int q = tid + 512 * it, part = q >> 9, pos0 = (q & 511) * 8, n1 = pos0 >> 6, n2 = pos0 & 63, k = part * 64 + n1;
                const unsigned wv[4] = {xin[h][it].x, xin[h][it].y, xin[h][it].z, xin[h][it].w};
#pragma unroll
                for (int e = 0; e < 4; ++e) { *(LAS bf16_t*)(lds + FF_XT + h * 16384 + ff_addr(n2 + 2 * e, k)) = (bf16_t)(wv[e] & 0xffffu); *(LAS bf16_t*)(lds + FF_XT + h * 16384 + ff_addr(n2 + 2 * e + 1, k)) = (bf16_t)(wv[e] >> 16); } }
        if (cp == 0) {
#pragma unroll
            for (int h = 0; h < 2; ++h)
#pragma unroll
                for (int it = 0; it < 2; ++it) xin[h][it] = ld16g(AT + (size_t)(2 + h) * 8192 + (size_t)(tid + 512 * it) * 8); }
        __syncthreads();
        f32x4 acc[2][2][2];
#pragma unroll
        for (int h = 0; h < 2; ++h)
#pragma unroll
            for (int x = 0; x < 2; ++x) { acc[h][x][0] = (f32x4){0.f, 0.f, 0.f, 0.f}; acc[h][x][1] = (f32x4){0.f, 0.f, 0.f, 0.f}; }
#pragma unroll
        for (int ks = 0; ks < 4; ++ks) {
            bf16x8 af[2];
#pragma unroll
            for (int x = 0; x < 2; ++x) { const int i = 16 * (mf + 4 * x) + fr; af[x] = *(const LAS bf16x8*)(lds + FF_DA + i * 256 + (((4 * ks + g) ^ (i & 15)) << 4)); }
#pragma unroll
            for (int h = 0; h < 2; ++h)
#pragma unroll
                for (int n = 0; n < 2; ++n) { const int j = 16 * (2 * nh + n) + fr; const bf16x8 bfv = *(const LAS bf16x8*)(lds + FF_XT + h * 16384 + j * 256 + (((4 * ks + g) ^ (j & 15)) << 4));
                    acc[h][0][n] = __builtin_amdgcn_mfma_f32_16x16x32_bf16(af[0], bfv, acc[h][0][n], 0, 0, 0);
                    acc[h][1][n] = __builtin_amdgcn_mfma_f32_16x16x32_bf16(af[1], bfv, acc[h][1][n], 0, 0, 0); }
        }
#pragma unroll
        for (int n = 0; n < 2; ++n)
#pragma unroll
            for (int r = 0; r < 4; ++r) { const int k1 = 16 * mf + 4 * g + r, n2 = 16 * (2 * nh + n) + fr; const float t = (float)((k1 * n2) & 4095) * (1.0f / 4096.0f);
                const float c = cos_turns(t), sn = sin_turns(t);
#pragma unroll
                for (int h = 0; h < 2; ++h) { const float zr = acc[h][0][n][r], zi = acc[h][1][n][r];
                    *(LAS bf16_t*)(lds + FF_Z2 + h * 16384 + ff_addr(k1, n2)) = f2bf(zr * c + zi * sn);
                    *(LAS bf16_t*)(lds + FF_Z2 + h * 16384 + ff_addr(k1, 64 + n2)) = f2bf(zi * c - zr * sn); } }
        __syncthreads();
        f32x4 acc2[2][2];
#pragma unroll
        for (int h = 0; h < 2; ++h) { acc2[h][0] = (f32x4){0.f, 0.f, 0.f, 0.f}; acc2[h][1] = (f32x4){0.f, 0.f, 0.f, 0.f}; }
#pragma unroll
        for (int ks = 0; ks < 4; ++ks) {
            const int i = 16 * mf + fr; const bf16x8 af = *(const LAS bf16x8*)(lds + FF_DC + i * 256 + (((4 * ks + g) ^ (i & 15)) << 4));
#pragma unroll
            for (int h = 0; h < 2; ++h)
#pragma unroll
                for (int n = 0; n < 2; ++n) { const int j = 16 * (2 * nh + n) + fr; const bf16x8 bfv = *(const LAS bf16x8*)(lds + FF_Z2 + h * 16384 + j * 256 + (((4 * ks + g) ^ (j & 15)) << 4));
                    acc2[h][n] = __builtin_amdgcn_mfma_f32_16x16x32_bf16(af, bfv, acc2[h][n], 0, 0, 0); }
        }
#pragma unroll
        for (int n = 0; n < 2; ++n)
#pragma unroll
            for (int r = 0; r < 4; ++r) { const int k = 16 * (2 * nh + n) + fr + 64 * (16 * mf + 4 * g + r);
                *(LAS unsigned*)(lds + FF_OB + k * 8 + cp * 4) = pack2(acc2[0][n][r], acc2[1][n][r]); }
    }
    __syncthreads();
    bf16_t* CAT = (bf16_t*)(a->ws + WS_CAT) + (size_t)(b * 4096) * D + cg * 4;
#pragma unroll
    for (int it = 0; it < 8; ++it) { const int k = tid + 512 * it; *(u32x2*)(CAT + (size_t)k * D) = *(const LAS u32x2*)(lds + FF_OB + k * 8); }
    __syncthreads();
}

__device__ __forceinline__ void p2_mix(AP a, unsigned char* ldsg, LAS unsigned char* lds, int l) {
    const int n_tile = 128 + ((l == 0) ? 8 : 0), n_att = 2 * n_tile, n_dft = 256, n_dftc = (l == 0) ? 16 : 0;
    bf16_t* CAT = (bf16_t*)(a->ws + WS_CAT);
    bool fft_ready = false;
    for (int u = blockIdx.x; u < n_att + n_dft + n_tile + n_dftc; u += gridDim.x) {
        if (u < n_att || (u >= n_att + n_dft && u < n_att + n_dft + n_tile)) {
            const bool att = u < n_att;
            const int t = att ? (u >> 1) : (u - n_att - n_dft);
            const bool isc = t >= 128; const int tt = t - 128;
            const int b = isc ? (tt >> 1) : (t >> 5);
            const int row0 = isc ? NLAT + tt * 128 : t * 128, seq_row0 = isc ? NLAT + b * 256 : b * 4096, pos0 = isc ? (tt & 1) * 128 : (t & 31) * 128, n = isc ? 256 : 4096;
            if (att) { for (int rep = 0; rep < PROBE_MIX_REP; ++rep) mixer_attn(a, lds, l, row0, seq_row0, pos0, n, b, isc, u & 1); }
            else { for (int rep = 0; rep < PROBE_SGU_REP; ++rep) mixer_sgu_pool(a, lds, l, row0, seq_row0, pos0, n); }
            fft_ready = false;
        } else if (u < n_att + n_dft) {
            const int uu = u - n_att;
            if (!fft_ready) { fft_setup(lds); fft_ready = true; }
            for (int rep = 0; rep < PROBE_FFT_REP; ++rep) fft_unit(a, lds, uu >> 6, uu & 63);
        } else {
            const int uu = u - n_att - n_dft - n_tile, b = uu >> 2, mt = (uu >> 1) & 1, ch0 = (uu & 1) * 128;
            const bf16_t* A = (const bf16_t*)(a->ws + WS_DFTC) + (size_t)(mt * 128) * 512;
            const bf16_t* B0 = (const bf16_t*)(a->ws + WS_ATC) + ((size_t)b * 256 + ch0) * 512;
            EpiBf16 E; E.C = CAT + (size_t)(NLAT + b * 256 + mt * 128) * D + ch0; E.ld = D; E.scale = 1.0f;
            gemm_tile<128, false, EpiBf16>(lds, A, 512, nullptr, 128, B0, B0 + (size_t)64 * 512, 512, 512, E);
            fft_ready = false;
        }
    }
    exp_queue(a, ldsg, l);
}

__device__ __forceinline__ int uni(int v) { return __builtin_amdgcn_readfirstlane(v); }
__device__ __forceinline__ int vblock() { const int G = gridDim.x, b = blockIdx.x; return (G % 8 == 0) ? (b % 8) * (G / 8) + b / 8 : b; }
template <class T> __device__ __forceinline__ T* unip(T* p) { const unsigned long long v = (unsigned long long)p; const unsigned lo = __builtin_amdgcn_readfirstlane((unsigned)v), hi = __builtin_amdgcn_readfirstlane((unsigned)(v >> 32)); return (T*)(((unsigned long long)hi << 32) | lo); }
struct SchedInProj {
    typedef EpiInProj Epi; static constexpr bool GATHER = false, FP8 = false, SIGNAL = false, WAITDEP = false; unsigned* dep;
    unsigned char* ws; int l, G, me;
    __device__ __forceinline__ bool get(int i, g256::Unit<Epi>& u) const {
        const int n_lat = 64 * 7, n_ctx = (l == 0) ? 4 * 7 : 4;
        const int idx = i * G + me; if (idx >= n_lat + n_ctx) return false;
        int row0, b, ct, n; bf16_t *tF, *tV;
        if (idx < n_lat) { const int rt = idx / 7; ct = idx % 7; row0 = rt * 256; b = row0 >> 12; n = 4096;
            tF = (bf16_t*)(ws + WS_AT) + (size_t)b * 256 * 2 * 4096; tV = (bf16_t*)(ws + WS_VT) + (size_t)b * 128 * 4096; }
        else { const int uu = idx - n_lat; int rt; if (l == 0) { rt = uu / 7; ct = uu % 7; } else { rt = uu; ct = 3; }
            row0 = NLAT + rt * 256; b = rt; n = 256;
            tF = (bf16_t*)(ws + WS_ATC) + (size_t)b * 256 * 2 * 256; tV = (bf16_t*)(ws + WS_VTC) + (size_t)b * 128 * 256; }
        u.A = (const bf16_t*)(ws + WS_H) + (size_t)row0 * D;
        u.B0 = (const bf16_t*)(ws + WS_WIN) + ((size_t)l * ZC + ct * 256) * 1024; u.B1 = u.B0 + (size_t)128 * 1024; u.ridx = nullptr; u.valid = 256;
        u.epi.Zt = (bf16_t*)(ws + WS_Z) + (size_t)row0 * ZC + ct * 256; u.epi.tF = tF; u.epi.tV = tV; u.epi.n0 = ct * 256; u.epi.pos0 = (idx < n_lat) ? (row0 & 4095) : 0; u.epi.n = n;
        return true;
    }
};
struct SchedOutProj {
    typedef EpiBf16 Epi; static constexpr bool GATHER = false, FP8 = false, SIGNAL = false, WAITDEP = false; unsigned* dep;
    unsigned char* ws; int l, G, me;
    __device__ __forceinline__ bool get(int i, g256::Unit<Epi>& u) const {
        const int nrt = NLAT / 256;
        const int idx = i * G + me; if (idx >= nrt * 4) return false;
        const int rt = idx >> 2, ct = idx & 3;
        u.A = (const bf16_t*)(ws + WS_CAT) + (size_t)(rt * 256) * D;
        u.B0 = (const bf16_t*)(ws + WS_WOUT) + ((size_t)l * 1024 + ct * 256) * 1024; u.B1 = u.B0 + (size_t)128 * 1024; u.ridx = nullptr; u.valid = 256;
        u.epi.C = (bf16_t*)(ws + WS_Y) + (size_t)(rt * 256) * D + ct * 256; u.epi.ld = D; u.epi.scale = 1.0f;
        return true;
    }
};
__device__ __forceinline__ void moe_units(const LAS int* blk, LAS int* uinf, int G, int me) {
    const int i = threadIdx.x;
    if (i < 8) { const int idx = i * G + me, nu = blk[32] * 4; int e = 0, valid = 0;
        if (idx < nu) { const int rb = idx >> 2; for (int q = 1; q < 32; ++q) if (blk[q] <= rb) e = q; valid = min(256, blk[33 + e] - (rb - blk[e]) * 256); }
        uinf[2 * i] = e; uinf[2 * i + 1] = valid; }
    __syncthreads();
}
struct SchedGateUp {
    typedef EpiGateUp8 Epi; static constexpr bool GATHER = true, FP8 = true, SIGNAL = true, WAITDEP = false; unsigned* dep;
    unsigned char* ws; const LAS int* uinf; const LAS int* ridx_lds; int G, me, l, nu;
    __device__ __forceinline__ bool get(int i, g256::Unit<Epi>& u) const {
        const int idx = i * G + me; if (idx >= nu) return false;
        const int rb = idx >> 2, ct = idx & 3, e = uni(uinf[2 * i]);
        u.A = (const bf16_t*)(ws + WS_H8);
        { const unsigned char* b0 = ws + WS_WEXP + (size_t)l * WEXP_LAYER + ((size_t)e * 512 + ct * 128) * 1024; u.B0 = (const bf16_t*)b0; u.B1 = (const bf16_t*)(b0 + EXPMAT); }
        u.ridx = ridx_lds + (i & 7) * 256; u.valid = uni(uinf[2 * i + 1]);
        u.epi.C = ws + WS_HID + (size_t)(rb * 256) * DEXP + ct * 128; u.epi.ld = DEXP; u.tag = rb;
        return true;
    }
};
struct SchedDown {
    typedef EpiFp8 Epi; static constexpr bool GATHER = false, FP8 = true, SIGNAL = false, WAITDEP = true; unsigned* dep;
    unsigned char* ws; const LAS int* uinf; int G, me, l, nu;
    __device__ __forceinline__ bool get(int i, g256::Unit<Epi>& u) const {
        const int idx = i * G + me; if (idx >= nu) return false;
        const int rb = idx >> 2, ct = idx & 3, e = uni(uinf[2 * i]);
        u.A = (const bf16_t*)(ws + WS_HID + (size_t)(rb * 256) * DEXP);
        { const unsigned char* b0 = ws + WS_WEXP + (size_t)l * WEXP_LAYER + 2 * EXPMAT + ((size_t)e * 1024 + ct * 256) * 512; u.B0 = (const bf16_t*)b0; u.B1 = (const bf16_t*)(b0 + (size_t)128 * 512); } u.ridx = nullptr; u.valid = 256;
        u.epi.C = ws + WS_YS + (size_t)(rb * 256) * D + ct * 256; u.epi.ld = D; u.epi.scale = 1.0f / 32.0f; u.tag = rb;
        return true;
    }
};

template <int l> __device__ __forceinline__ void p4_ln1_router(AP a, unsigned char* lds) {
    const int tid = tid_opaque(), lane = tid & 63, w = tid >> 6;
    const int ntok = (l == 0) ? NTOK : NLAT;
    int* cnt = (int*)(lds + MISC_OFF);
    if (tid < 32) cnt[tid] = 0;
    f32x4* Lg = (f32x4*)lds; f32x4* Le = (f32x4*)(lds + 16384); f32x4* Lgb = (f32x4*)(lds + 147456);
    {
        const float* wrg_ = a->in[16] + (size_t)l * 1024 * 4; const float* wre_ = a->in[17] + (size_t)l * 1024 * 32;
#pragma unroll
        for (int it = 0; it < 2; ++it) { const int c = tid + 512 * it, slot = (((c >> 8) * 4 + (c & 3)) << 6) + ((c >> 2) & 63);
            Lg[slot] = *(const f32x4*)(wrg_ + (size_t)c * 4);
#pragma unroll
            for (int q = 0; q < 8; ++q) Le[q * 1024 + slot] = *(const f32x4*)(wre_ + (size_t)c * 32 + q * 4); }
        Lgb[tid] = (tid < 256) ? *(const f32x4*)(a->in[14] + l * 1024 + tid * 4) : *(const f32x4*)(a->in[15] + l * 1024 + (tid - 256) * 4);
    }
    __syncthreads();
    const float* mod = (const float*)(a->ws + WS_MOD) + (size_t)l * 5 * 6144;
    const bf16_t* Y = (const bf16_t*)(a->ws + WS_Y);
    bf16_t* X1 = (bf16_t*)(a->ws + WS_X1);
    unsigned char* H8 = a->ws + WS_H8;
    int* tokE = (int*)(a->ws + WS_TOKE); int* tokR = (int*)(a->ws + WS_TOKR); float* tokG = (float*)(a->ws + WS_TOKG);
    const int tstep = gridDim.x * 8;
    f32x4 nx[4]; u32x2 nxb[4], ny[4];
    const bf16_t* XC = (const bf16_t*)(a->ws + WS_XC);
    {   const int t = blockIdx.x * 8 + w;
        if (t < ntok) { const float* xs = (t < NLAT) ? a->in[0] + (size_t)t * D : a->in[2] + (size_t)(t - NLAT) * D;
#pragma unroll
            for (int i = 0; i < 4; ++i) { if (l == 0) nx[i] = *(const f32x4*)(xs + 256 * i + 4 * lane); else nxb[i] = *(const u32x2*)(XC + (size_t)t * D + 256 * i + 4 * lane);
                ny[i] = *(const u32x2*)(Y + (size_t)t * D + 256 * i + 4 * lane); } } }
    int mrow = -1; f32x4 mg[4], msh[4], msc[4];
    for (int t = blockIdx.x * 8 + w; t < ntok; t += tstep) {
        const int mr = (t < NLAT) ? (t >> 12) : 4;
        if (mr != mrow) { mrow = mr; const float* m = mod + (size_t)mr * 6144;
#pragma unroll
            for (int i = 0; i < 4; ++i) { const int c = 256 * i + 4 * lane; mg[i] = *(const f32x4*)(m + 2048 + c); msh[i] = *(const f32x4*)(m + 3072 + c); msc[i] = *(const f32x4*)(m + 4096 + c); } }
        f32x4 v[4];
#pragma unroll
        for (int i = 0; i < 4; ++i) { const f32x4 yv = (f32x4){lo2f(ny[i].x), hi2f(ny[i].x), lo2f(ny[i].y), hi2f(ny[i].y)};
            const f32x4 xv = (l == 0) ? nx[i] : (f32x4){lo2f(nxb[i].x), hi2f(nxb[i].x), lo2f(nxb[i].y), hi2f(nxb[i].y)};
#pragma unroll
            for (int e = 0; e < 4; ++e) v[i][e] = RES_ALPHA * xv[e] + mg[i][e] * yv[e]; }
        {   const int tn = t + tstep;
            if (tn < ntok) { const float* xs = (tn < NLAT) ? a->in[0] + (size_t)tn * D : a->in[2] + (size_t)(tn - NLAT) * D;
#pragma unroll
                for (int i = 0; i < 4; ++i) { if (l == 0) nx[i] = *(const f32x4*)(xs + 256 * i + 4 * lane); else nxb[i] = *(const u32x2*)(XC + (size_t)tn * D + 256 * i + 4 * lane);
                    ny[i] = *(const u32x2*)(Y + (size_t)tn * D + 256 * i + 4 * lane); } } }
        float mean, rstd; ln_stats(v, mean, rstd);
#pragma unroll
        for (int i = 0; i < 4; ++i) { const int c = 256 * i + 4 * lane; const f32x4 gg = Lgb[64 * i + lane], bb = Lgb[256 + 64 * i + lane];
#pragma unroll
            for (int e = 0; e < 4; ++e) v[i][e] = (v[i][e] - mean) * rstd * gg[e] + bb[e];
            { u32x2 pk; pk.x = pack2(v[i][0], v[i][1]); pk.y = pack2(v[i][2], v[i][3]); *(u32x2*)(X1 + (size_t)t * D + c) = pk; } }
        ln_stats(v, mean, rstd);
#pragma unroll
        for (int i = 0; i < 4; ++i) { const int c = 256 * i + 4 * lane; const f32x4 sh = msh[i], sc = msc[i];
#pragma unroll
            for (int e = 0; e < 4; ++e) v[i][e] = (v[i][e] - mean) * rstd * (1.0f + sc[e]) + sh[e];
            *(unsigned*)(H8 + (size_t)t * D + c) = pack4_fp8(v[i][0], v[i][1], v[i][2], v[i][3]); }
        f32x2 lg01 = (f32x2){0.f, 0.f}, lg23 = (f32x2){0.f, 0.f};
#pragma unroll
        for (int i = 0; i < 4; ++i)
#pragma unroll
            for (int e = 0; e < 4; ++e) { const f32x4 wv = Lg[((i * 4 + e) << 6) + lane]; const f32x2 vv = (f32x2){v[i][e], v[i][e]};
                lg01 += vv * (f32x2){wv[0], wv[1]}; lg23 += vv * (f32x2){wv[2], wv[3]}; }
        float lg[4]; wave_sum4(lg01[0], lg01[1], lg23[0], lg23[1], lg);
        int grp = 0; float mx = lg[0];
#pragma unroll
        for (int q = 1; q < 4; ++q) if (lg[q] > mx) { mx = lg[q]; grp = q; }
        float se = 0.f;
#pragma unroll
        for (int q = 0; q < 4; ++q) se += __expf(lg[q] - mx);
        const float gate_group = __builtin_amdgcn_rcpf(se);
        f32x2 le01 = (f32x2){0.f, 0.f}, le23 = (f32x2){0.f, 0.f}, le45 = (f32x2){0.f, 0.f}, le67 = (f32x2){0.f, 0.f};
#pragma unroll
        for (int i = 0; i < 4; ++i)
#pragma unroll
            for (int e = 0; e < 4; ++e) { const f32x4* wp = Le + grp * 2048 + ((i * 4 + e) << 6) + lane; const f32x4 w0 = wp[0], w1 = wp[1024]; const f32x2 vv = (f32x2){v[i][e], v[i][e]};
                le01 += vv * (f32x2){w0[0], w0[1]}; le23 += vv * (f32x2){w0[2], w0[3]}; le45 += vv * (f32x2){w1[0], w1[1]}; le67 += vv * (f32x2){w1[2], w1[3]}; }
        float le[8]; { const float lp[8] = {le01[0], le01[1], le23[0], le23[1], le45[0], le45[1], le67[0], le67[1]}; wave_sum8(lp, lane, le); }
        int j1 = 0; float l1 = le[0];
#pragma unroll
        for (int q = 1; q < 8; ++q) if (le[q] > l1) { l1 = le[q]; j1 = q; }
        int j2 = -1; float l2 = -3.0e38f;
#pragma unroll
        for (int q = 0; q < 8; ++q) if (q != j1 && le[q] > l2) { l2 = le[q]; j2 = q; }
        const float e2 = __expf(l2 - l1), p1 = __builtin_amdgcn_rcpf(1.0f + e2), p2 = e2 * p1;
        if (lane == 0) {
            const int ex0 = grp * 8 + j1, ex1 = grp * 8 + j2;
            const int r0 = atomicAdd(&cnt[ex0], 1), r1 = atomicAdd(&cnt[ex1], 1);
            tokE[2 * t] = ex0; tokE[2 * t + 1] = ex1; tokR[2 * t] = r0; tokR[2 * t + 1] = r1;
            tokG[2 * t] = gate_group * p1; tokG[2 * t + 1] = gate_group * p2;
        }
    }
    __syncthreads();
    if (tid < 32) ((int*)(a->ws + WS_BCNT))[((size_t)l * MAXG + blockIdx.x) * 32 + tid] = cnt[tid];
    __syncthreads();
}

__device__ __forceinline__ void p5_dispatch(AP a, unsigned char* lds, int l) {
    const int tid = tid_opaque();
    const int ntok = (l == 0) ? NTOK : NLAT;
    int* part = (int*)lds;
    int* tot = (int*)(lds + 4096);
    int* off = (int*)(lds + 4096 + 128);
    int* pstart = (int*)(lds + 4096 + 256);
    const int* bc = (const int*)(a->ws + WS_BCNT) + (size_t)l * MAXG * 32;
    const int G = gridDim.x, me = blockIdx.x;
    { const int e = tid & 31, p = tid >> 5; int s = 0, so = 0; for (int bb = p; bb < G; bb += 16) { const int c = bc[bb * 32 + e]; s += c; if (bb < me) so += c; } part[p * 32 + e] = s; part[512 + p * 32 + e] = so; }
    __syncthreads();
    if (tid < 32) { int s = 0, so = 0; for (int p = 0; p < 16; ++p) { s += part[p * 32 + tid]; so += part[512 + p * 32 + tid]; } tot[tid] = s; off[tid] = so; }
    __syncthreads();
    if (tid == 0) { int acc = 0; for (int e = 0; e < 32; ++e) { pstart[e] = acc; acc += ((tot[e] + 255) >> 8) << 8; } }
    __syncthreads();
    if (me == 0 && tid < 32) ((int*)(a->ws + WS_CNT))[l * 32 + tid] = tot[tid];
    const int* tokE = (const int*)(a->ws + WS_TOKE); const int* tokR = (const int*)(a->ws + WS_TOKR);
    int* tokS = (int*)(a->ws + WS_TOKS); int* slotT = (int*)(a->ws + WS_SLOTT);
    for (int q = tid; ; q += NT) { const int it = q >> 4, j = q & 15, t = (it * G + me) * 8 + (j >> 1); if (t >= ntok) break;
        const int idx = 2 * t + (j & 1); const int e = tokE[idx]; const int slot = pstart[e] + off[e] + tokR[idx]; tokS[idx] = slot; slotT[slot] = t; }
    __syncthreads();
}

__device__ __forceinline__ void moe_table(AP a, int l, LAS int* blk) {
    const int* tot = (const int*)(a->ws + WS_CNT) + l * 32;
    __syncthreads();
    if (threadIdx.x < 32) blk[33 + threadIdx.x] = tot[threadIdx.x];
    __syncthreads();
    if (threadIdx.x == 0) { int acc = 0; for (int e = 0; e < 32; ++e) { blk[e] = acc; acc += (blk[33 + e] + 255) >> 8; } blk[32] = acc; }
    __syncthreads();
}
__device__ __forceinline__ int units_of(int nu, int v, int G) { return (v < nu) ? (nu - v + G - 1) / G : 0; }
__device__ __forceinline__ void p1_inproj(AP a, unsigned char* smem, LAS unsigned char* lds, int l) {
    SchedInProj S; S.ws = a->ws; S.l = l; S.G = gridDim.x; S.me = vblock();
    g256::gemm_phase(lds, 1024, S);
    { const int nu = (l == 0) ? 64 * 7 + 4 * 7 : 64 * 7 + 4, G = gridDim.x; if (units_of(nu, S.me, G) < (nu + G - 1) / G) exp_fill(a, smem, l, 8); }
}
__device__ __forceinline__ void p3_outproj(AP a, unsigned char* smem, LAS unsigned char* lds, int l) {
    SchedOutProj S; S.ws = a->ws; S.l = l; S.G = gridDim.x; S.me = vblock();
    g256::gemm_phase(lds, 1024, S);
    if (l == 0) {
        const bf16_t* W = (const bf16_t*)(a->ws + WS_WOUT);
        for (int u = blockIdx.x; u < 64; u += gridDim.x) { const int rt = u >> 3, ct = u & 7;
            EpiBf16 E; E.C = (bf16_t*)(a->ws + WS_Y) + (size_t)(NLAT + rt * 128) * D + ct * 128; E.ld = D; E.scale = 1.0f;
            const bf16_t* B0 = W + (size_t)(ct * 128) * 1024;
            gemm_tile<128, false, EpiBf16>(lds, (const bf16_t*)(a->ws + WS_CAT) + (size_t)(NLAT + rt * 128) * D, D, nullptr, 128, B0, B0 + (size_t)64 * 1024, 1024, 1024, E); }
        if (blockIdx.x >= 64) exp_fill(a, smem, 0, 3);
    }
}
__device__ __forceinline__ void p6_gateup(AP a, unsigned char* smem, LAS unsigned char* lds, int l) {
    LAS int* blk = (LAS int*)(lds + MISC_OFF + 256);
    moe_table(a, l, blk);
    LAS int* ridx = (LAS int*)(lds + RIDX_OFF);
    const int tid = tid_opaque(), G = gridDim.x, me = vblock(), nu = uni(blk[32]) * 4;
    LAS int* uinf = (LAS int*)(lds + MISC_OFF + 528);
    moe_units(blk, uinf, G, me);
    const int* slotT = (const int*)(a->ws + WS_SLOTT);
    for (int i = 0; i < 8; ++i) { const int idx = i * G + me; if (idx >= nu) break;
        const int rb = idx >> 2, valid = uinf[2 * i + 1];
        if (tid < 256) ridx[i * 256 + tid] = (tid < valid) ? slotT[rb * 256 + tid] : 0; }
    __syncthreads();
    SchedGateUp S; S.ws = a->ws; S.uinf = uinf; S.ridx_lds = ridx; S.G = G; S.me = me; S.l = l; S.nu = nu; S.dep = (unsigned*)(a->ws + WS_BAR + 14336 + 512) + l * 192;
    g256::gemm_phase(lds, 512, S);
    __syncthreads();
}
__device__ __forceinline__ void p7_down(AP a, unsigned char* smem, LAS unsigned char* lds, int l) {
    LAS int* blk = (LAS int*)(lds + MISC_OFF + 256);
    moe_table(a, l, blk);
    LAS int* uinf = (LAS int*)(lds + MISC_OFF + 528);
    SchedDown S; S.ws = a->ws; S.uinf = uinf; S.G = gridDim.x; S.me = (int)gridDim.x - 1 - vblock(); S.l = l; S.nu = uni(blk[32]) * 4; S.dep = (unsigned*)(a->ws + WS_BAR + 14336 + 512) + l * 192;
    moe_units(blk, uinf, S.G, S.me);
    g256::gemm_phase(lds, 256, S);
    __syncthreads();
    { const int nu = S.nu, G = gridDim.x; if (l == 0 && units_of(nu, vblock(), G) < (nu + G - 1) / G) exp_fill(a, smem, 1, 2); }
}

template <int l> __device__ __forceinline__ void p8_ln2(AP a, unsigned char* lds) {
    const int tid = tid_opaque(), lane = tid & 63, w = tid >> 6;
    const int ntok = (l == 0) ? NTOK : NLAT;
    const float* mod = (const float*)(a->ws + WS_MOD) + (size_t)l * 5 * 6144;
    const float* modn = (const float*)(a->ws + WS_MOD) + (size_t)5 * 6144;
    const bf16_t* X1 = (const bf16_t*)(a->ws + WS_X1);
    const unsigned char* YS = a->ws + WS_YS;
    const int* tokS = (const int*)(a->ws + WS_TOKS); const float* tokG = (const float*)(a->ws + WS_TOKG);
    f32x4* Lgb = (f32x4*)lds;
    __syncthreads();
    Lgb[tid] = (tid < 256) ? *(const f32x4*)(a->in[21] + l * 1024 + tid * 4) : *(const f32x4*)(a->in[22] + l * 1024 + (tid - 256) * 4);
    __syncthreads();
    int mrow = -1; f32x4 mg[4], nsh[4], nsc[4];
    const int tstep = gridDim.x * 8;
    int t = blockIdx.x * 8 + w;
    int ns0 = 0, ns1 = 0; float nga = 0.f, ngb = 0.f;
    u32x2 nx[4]; unsigned nya[4], nyb[4];
    float cga = 0.f, cgb = 0.f;
    if (t < ntok) { const int s0 = tokS[2 * t], s1 = tokS[2 * t + 1]; cga = tokG[2 * t]; cgb = tokG[2 * t + 1];
#pragma unroll
        for (int i = 0; i < 4; ++i) { const int c = 256 * i + 4 * lane; nx[i] = *(const u32x2*)(X1 + (size_t)t * D + c); nya[i] = *(const unsigned*)(YS + (size_t)s0 * D + c); nyb[i] = *(const unsigned*)(YS + (size_t)s1 * D + c); } }
    if (t + tstep < ntok) { ns0 = tokS[2 * (t + tstep)]; ns1 = tokS[2 * (t + tstep) + 1]; nga = tokG[2 * (t + tstep)]; ngb = tokG[2 * (t + tstep) + 1]; }
    for (; t < ntok; t += tstep) {
        const int mr = (t < NLAT) ? (t >> 12) : 4;
        if (mr != mrow) { mrow = mr; const float* m = mod + (size_t)mr * 6144; const float* mn = modn + (size_t)mr * 6144;
#pragma unroll
            for (int i = 0; i < 4; ++i) { const int c = 256 * i + 4 * lane; mg[i] = *(const f32x4*)(m + 5120 + c); if (l == 0) { nsh[i] = *(const f32x4*)(mn + c); nsc[i] = *(const f32x4*)(mn + 1024 + c); } } }
        f32x4 v[4];
#pragma unroll
        for (int i = 0; i < 4; ++i) { const f32x4 gv = mg[i];
            const f32x2 ya0 = __builtin_amdgcn_cvt_pk_f32_fp8(nya[i], false), ya1 = __builtin_amdgcn_cvt_pk_f32_fp8(nya[i], true), yb0 = __builtin_amdgcn_cvt_pk_f32_fp8(nyb[i], false), yb1 = __builtin_amdgcn_cvt_pk_f32_fp8(nyb[i], true);
            const float f0 = cga * ya0[0] + cgb * yb0[0], f1 = cga * ya0[1] + cgb * yb0[1], f2 = cga * ya1[0] + cgb * yb1[0], f3 = cga * ya1[1] + cgb * yb1[1];
            v[i][0] = RES_ALPHA * lo2f(nx[i].x) + gv[0] * f0; v[i][1] = RES_ALPHA * hi2f(nx[i].x) + gv[1] * f1; v[i][2] = RES_ALPHA * lo2f(nx[i].y) + gv[2] * f2; v[i][3] = RES_ALPHA * hi2f(nx[i].y) + gv[3] * f3; }
        {   const int tn = t + tstep, tn2 = t + 2 * tstep;
            if (tn < ntok) {
#pragma unroll
                for (int i = 0; i < 4; ++i) { const int c = 256 * i + 4 * lane; nx[i] = *(const u32x2*)(X1 + (size_t)tn * D + c); nya[i] = *(const unsigned*)(YS + (size_t)ns0 * D + c); nyb[i] = *(const unsigned*)(YS + (size_t)ns1 * D + c); }
                cga = nga; cgb = ngb; }
            if (tn2 < ntok) { ns0 = tokS[2 * tn2]; ns1 = tokS[2 * tn2 + 1]; nga = tokG[2 * tn2]; ngb = tokG[2 * tn2 + 1]; } }
        float mean, rstd; ln_stats(v, mean, rstd);
#pragma unroll
        for (int i = 0; i < 4; ++i) { const int c = 256 * i + 4 * lane; const f32x4 gg = Lgb[64 * i + lane], bb = Lgb[256 + 64 * i + lane];
#pragma unroll
            for (int e = 0; e < 4; ++e) v[i][e] = (v[i][e] - mean) * rstd * gg[e] + bb[e];
            if (l == 0) { u32x2 pk; pk.x = pack2(v[i][0], v[i][1]); pk.y = pack2(v[i][2], v[i][3]); *(u32x2*)((bf16_t*)(a->ws + WS_XC) + (size_t)t * D + c) = pk; }
            else *(f32x4*)(a->out + (size_t)t * D + c) = v[i]; }
        if (l == 0) {
            ln_stats(v, mean, rstd);
            bf16_t* H = (bf16_t*)(a->ws + WS_H);
#pragma unroll
            for (int i = 0; i < 4; ++i) { const int c = 256 * i + 4 * lane; const f32x4 sh = nsh[i], sc = nsc[i];
                f32x4 o;
#pragma unroll
                for (int e = 0; e < 4; ++e) o[e] = (v[i][e] - mean) * rstd * (1.0f + sc[e]) + sh[e];
                u32x2 pk; pk.x = pack2(o[0], o[1]); pk.y = pack2(o[2], o[3]); *(u32x2*)(H + (size_t)t * D + c) = pk; }
        }
    }
}

constexpr int N_PHASES = 18;
template <int P> __device__ __forceinline__ void run_phase(AP a, unsigned char* smem, LAS unsigned char* lds, int l) {
    asm volatile("" : "+s"(a));
    if (P == 0) p0_prologue(a, smem);
    if (P == 1) p_lnmod0(a);
    if (P == 2) p1_inproj(a, smem, lds, l);
    if (P == 3) p2_mix(a, smem, lds, l);
    if (P == 4) p3_outproj(a, smem, lds, l);
    if (P == 5) { if (l == 0) p4_ln1_router<0>(a, smem); else p4_ln1_router<1>(a, smem); }
    if (P == 6) p5_dispatch(a, smem, l);
    if (P == 7) p6_gateup(a, smem, lds, l);
    if (P == 8) p7_down(a, smem, lds, l);
    if (P == 9) { if (l == 0) p8_ln2<0>(a, smem); else p8_ln2<1>(a, smem); }
}
#if N_LAUNCH_MODE == 1
__global__ void __launch_bounds__(NT, 2) fwd(Args a) {
    extern __shared__ __attribute__((aligned(16))) unsigned char smem[];
    LAS unsigned char* lds = (LAS unsigned char*)smem;
    if (threadIdx.x < 4) ((volatile LAS unsigned*)(lds + MISC_OFF + 768))[threadIdx.x] = 0u;
    __syncthreads();
    XcdBarrier bar = xcd_barrier_post((unsigned*)(a.ws + WS_BAR), (volatile LAS unsigned*)(lds + MISC_OFF + 768));
    AP ap = (AP)__builtin_amdgcn_kernarg_segment_ptr();
#define PROBE(P, l) do { if (PROBE_MASK & (1 << (P))) { for (int _r = 0; _r < 2; ++_r) { xcd_barrier(bar); run_phase<P>(ap, smem, lds, l); } } } while (0)
    run_phase<0>(ap, smem, lds, 0); PROBE(0, 0); xcd_barrier(bar);
    run_phase<1>(ap, smem, lds, 0); PROBE(1, 0); xcd_barrier(bar);
    for (int l = 0; l < 2; ++l) {
        run_phase<2>(ap, smem, lds, l); PROBE(2, l); xcd_barrier(bar);
        run_phase<3>(ap, smem, lds, l); PROBE(3, l); xcd_barrier(bar);
        run_phase<4>(ap, smem, lds, l); PROBE(4, l); xcd_barrier(bar);
        run_phase<5>(ap, smem, lds, l); PROBE(5, l); xcd_barrier(bar);
        run_phase<6>(ap, smem, lds, l); PROBE(6, l); xcd_barrier(bar);
        run_phase<7>(ap, smem, lds, l); PROBE(7, l);
        run_phase<8>(ap, smem, lds, l); PROBE(8, l); xcd_barrier(bar);
        run_phase<9>(ap, smem, lds, l); PROBE(9, l); if (l == 0) xcd_barrier(bar);
    }
}
#else
template <int P> __global__ void __launch_bounds__(NT, 2) k_phase(Args a) {
    extern __shared__ __attribute__((aligned(16))) unsigned char smem[];
    LAS unsigned char* lds = (LAS unsigned char*)smem;
    AP ap = (AP)__builtin_amdgcn_kernarg_segment_ptr();
    run_phase<P>(ap, smem, lds, ap->ph_lo);
}
template <int P> static void launch_phase(Args a, int l, int grid, hipStream_t stream) {
    static bool attr = false;
    if (!attr) { (void)hipFuncSetAttribute((const void*)k_phase<P>, hipFuncAttributeMaxDynamicSharedMemorySize, LDS_BYTES); attr = true; }
    a.ph_lo = l; a.ph_hi = P;
    hipLaunchKernelGGL(k_phase<P>, dim3(grid), dim3(NT), LDS_BYTES, stream, a);
}
#endif

extern "C" void kernel_launch(void* const* d_in, const int* in_sizes, int n_in, void* d_out, int out_size, void* d_ws, size_t ws_size, hipStream_t stream) {
    static int grid = 0;
    if (grid == 0) {
        if (n_in != 23 || out_size != NLAT * D || ws_size < WS_END) { fprintf(stderr, "kernel_launch: unexpected shapes (n_in %d, out %d, ws %zu, need %zu)\n", n_in, out_size, ws_size, (size_t)WS_END); grid = -1; return; }
        int dev = 0, cus = 0;
        if (hipGetDevice(&dev) != hipSuccess || hipDeviceGetAttribute(&cus, hipDeviceAttributeMultiprocessorCount, dev) != hipSuccess) { grid = -1; return; }
#if N_LAUNCH_MODE == 1
        int per_cu = 0;
        if (hipFuncSetAttribute((const void*)fwd, hipFuncAttributeMaxDynamicSharedMemorySize, LDS_BYTES) != hipSuccess) { fprintf(stderr, "kernel_launch: hipFuncSetAttribute failed\n"); grid = -1; return; }
        if (hipOccupancyMaxActiveBlocksPerMultiprocessor(&per_cu, (const void*)fwd, NT, LDS_BYTES) != hipSuccess || per_cu < 1) { fprintf(stderr, "kernel_launch: occupancy query says %d\n", per_cu); }
        (void)hipGetLastError();
#endif
        grid = cus; if (grid > MAXG) grid = MAXG;
    }
    if (grid < 0) return;
    (void)hipMemsetAsync((char*)d_ws + WS_BAR, 0, 16384 + 256, stream);
    Args a{};
    for (int i = 0; i < 23; ++i) a.in[i] = (const float*)d_in[i];
    a.out = (float*)d_out; a.ws = (unsigned char*)d_ws;
#if N_LAUNCH_MODE == 1
    a.ph_lo = 0; a.ph_hi = N_PHASES;
    hipLaunchKernelGGL(fwd, dim3(grid), dim3(NT), LDS_BYTES, stream, a);
#else
    launch_phase<0>(a, 0, grid, stream);
    launch_phase<1>(a, 0, grid, stream);
    for (int l = 0; l < 2; ++l) {
        launch_phase<2>(a, l, grid, stream); launch_phase<3>(a, l, grid, stream); launch_phase<4>(a, l, grid, stream); launch_phase<5>(a, l, grid, stream);
        launch_phase<6>(a, l, grid, stream); launch_phase<7>(a, l, grid, stream); launch_phase<8>(a, l, grid, stream); launch_phase<9>(a, l, grid, stream);
    }
#endif
}
```

```cpp
#include <hip/hip_runtime.h>
#include <stdint.h>
#include <stdio.h>

#ifndef PROBE_MASK
#define PROBE_MASK 0
#endif
#ifndef PROBE_FFT_REP
#define PROBE_FFT_REP 1
#endif
#ifndef PROBE_MIX_REP
#define PROBE_MIX_REP 1
#endif
#ifndef PROBE_SGU_REP
#define PROBE_SGU_REP 1
#endif
#ifndef N_LAUNCH_MODE
#define N_LAUNCH_MODE 1
#endif

#define LAS __attribute__((address_space(3)))
typedef unsigned short bf16_t;
typedef short bf16x8 __attribute__((ext_vector_type(8)));
typedef float f32x4 __attribute__((ext_vector_type(4)));
typedef unsigned u32x4 __attribute__((ext_vector_type(4)));
typedef unsigned u32x2 __attribute__((ext_vector_type(2)));
typedef float f32x2 __attribute__((ext_vector_type(2)));
typedef int i32x4 __attribute__((ext_vector_type(4)));
typedef int i32x8 __attribute__((ext_vector_type(8)));

constexpr int D = 1024, NBATCH = 4, SEQ = 4096, CTXL = 256;
constexpr int NLAT = NBATCH * SEQ, NCTX = NBATCH * CTXL, NTOK = NLAT + NCTX;
constexpr int ZC = 1792;
constexpr int NEXP = 32, DEXP = 512;
constexpr int NSLOT = 2 * NTOK + NEXP * 256;
constexpr int NT = 512;
constexpr int MAXG = 512;
constexpr float RES_ALPHA = 1.41421356237309515f;
constexpr int MISC_OFF = 155648;
constexpr int RIDX_OFF = 131072;
constexpr int LDS_BYTES = MISC_OFF + 1024;

constexpr size_t WS_BAR   = 0;
constexpr size_t WS_CNT   = 16384;
constexpr size_t WS_BCNT  = WS_CNT + 256;
constexpr size_t WS_MOD   = WS_BCNT + (size_t)2 * MAXG * 32 * 4;
constexpr size_t WS_ROPE  = WS_MOD + (size_t)2 * 5 * 6144 * 4;
constexpr size_t WS_TOKE  = WS_ROPE + 8192;
constexpr size_t WS_TOKR  = WS_TOKE + (size_t)NTOK * 8;
constexpr size_t WS_TOKS  = WS_TOKR + (size_t)NTOK * 8;
constexpr size_t WS_TOKG  = WS_TOKS + (size_t)NTOK * 8;
constexpr size_t WS_SLOTT = WS_TOKG + (size_t)NTOK * 8;
constexpr size_t WS_WIN   = WS_SLOTT + (size_t)NSLOT * 4;
constexpr size_t WS_WOUT  = WS_WIN + (size_t)2 * ZC * 1024 * 2;
constexpr size_t WS_WSGU  = WS_WOUT + (size_t)2 * 1024 * 1024 * 2;
constexpr size_t WS_DFTC  = WS_WSGU + (size_t)2 * 4 * 128 * 128 * 2;
constexpr size_t WS_WEXP  = WS_DFTC + (size_t)256 * 512 * 2;
constexpr size_t EXPMAT   = (size_t)NEXP * 512 * 1024;
constexpr size_t WEXP_LAYER = 3 * EXPMAT;
constexpr size_t WS_X1    = WS_WEXP + 2 * WEXP_LAYER;
constexpr size_t WS_XC    = WS_X1 + (size_t)NTOK * D * 4;
constexpr size_t WS_H     = WS_XC + (size_t)NTOK * D * 4;
constexpr size_t WS_R     = WS_H + (size_t)NTOK * D * 2;
constexpr size_t WS_Z     = WS_R;
constexpr size_t WS_AT    = WS_Z + (size_t)NTOK * ZC * 2;
constexpr size_t WS_ATC   = WS_AT + (size_t)4 * 256 * 8192 * 2;
constexpr size_t WS_VT    = WS_ATC + (size_t)4 * 256 * 512 * 2;
constexpr size_t WS_VTC   = WS_VT + (size_t)4 * 2 * 64 * 4096 * 2;
constexpr size_t WS_CAT   = WS_VTC + (size_t)4 * 2 * 64 * 256 * 2;
constexpr size_t WS_REND  = WS_CAT + (size_t)NTOK * D * 2;
constexpr size_t WS_Y     = WS_R;
constexpr size_t WS_HID   = WS_R;
constexpr size_t WS_YS    = WS_HID + (size_t)NSLOT * DEXP * 2;
constexpr size_t WS_REND2 = (WS_YS + (size_t)NSLOT * D * 2 > WS_REND) ? WS_YS + (size_t)NSLOT * D * 2 : WS_REND;
constexpr size_t WS_H8    = (WS_REND2 + 255) & ~(size_t)255;
constexpr size_t WS_END   = WS_H8 + (size_t)NTOK * D;
static_assert(WS_Y + (size_t)NTOK * D * 4 <= WS_CAT, "Y must not reach CAT");
static_assert(WS_WIN % 256 == 0 && WS_DFTC % 256 == 0 && WS_WEXP % 256 == 0 && WS_X1 % 256 == 0 && WS_H % 256 == 0 && WS_R % 256 == 0 && WS_AT % 256 == 0 && WS_CAT % 256 == 0 && WS_YS % 256 == 0, "alignment");

struct Args { const float* in[23]; float* out; unsigned char* ws; int ph_lo, ph_hi; };
#define CAS __attribute__((address_space(4)))
typedef const CAS Args* AP;

#define XB_TMO      128
#define XB_XCNT(j)  (256  + 64 * (j))
#define XB_XSUB(j)  (1280 + 64 * (j))
#define XB_XGEN(j)  (2304 + 64 * (j))
#define XB_TOP      3328
#define XB_TOPGEN   3392
#define XCD_BAR_WORDS 3456
#define XB_SPIN_CAP (1u << 18)

__device__ __forceinline__ unsigned xb_ld(unsigned* p)              { return __hip_atomic_load(p, __ATOMIC_RELAXED, __HIP_MEMORY_SCOPE_AGENT); }
__device__ __forceinline__ unsigned xb_add(unsigned* p, unsigned v) { return __hip_atomic_fetch_add(p, v, __ATOMIC_RELAXED, __HIP_MEMORY_SCOPE_AGENT); }
__device__ __forceinline__ unsigned xb_xcc_id() { return (unsigned)__builtin_amdgcn_s_getreg((3 << 11) | 20) & 0xFu; }
#define XB_SPIN(cond, bar) do { unsigned _sp = 0; while (cond) { \
    if ((++_sp & 255u) == 0u) { if (xb_ld(&(bar)[XB_TMO])) break; if (_sp > XB_SPIN_CAP) { atomicAdd(&(bar)[XB_TMO], 1u); break; } } } } while (0)

struct XcdBarrier { unsigned* bar; unsigned x; volatile LAS unsigned* st; };

__device__ __forceinline__ XcdBarrier xcd_barrier_post(unsigned* bar, volatile LAS unsigned* st) {
    XcdBarrier b; b.bar = bar; b.x = (unsigned)__builtin_amdgcn_readfirstlane((int)xb_xcc_id()); b.st = st;
    if (threadIdx.x == 0) (void)xb_add(&bar[XB_XCNT(b.x)], 1u);
    return b;
}
__device__ __forceinline__ void xcd_barrier_complete(unsigned* bar, unsigned x, unsigned& nloc, unsigned& nx) {
    const unsigned G = gridDim.x * gridDim.y * gridDim.z;
    unsigned sum, cnt, mine, sp = 0u;
    for (;;) {
        sum = 0u; cnt = 0u; mine = 0u;
#pragma unroll
        for (unsigned j = 0; j < 16; ++j) { const unsigned c = xb_ld(&bar[XB_XCNT(j)]); sum += c; cnt += (c > 0u) ? 1u : 0u; mine = (j == x) ? c : mine; }
        if (sum == G) break;
        __builtin_amdgcn_s_sleep(1);
        if ((++sp & 255u) == 0u) { if (xb_ld(&bar[XB_TMO])) break; if (sp > XB_SPIN_CAP) { atomicAdd(&bar[XB_TMO], 1u); break; } }
    }
    nloc = mine > 0u ? mine : 1u; nx = cnt > 0u ? cnt : 1u;
}
__device__ __forceinline__ void xcd_barrier(const XcdBarrier& b) {
    asm volatile("s_waitcnt vmcnt(0)" ::: "memory");
    __syncthreads();
    if (threadIdx.x == 0) {
        unsigned* bar = b.bar;
        unsigned bx = b.x;
        asm volatile("" : "+s"(bar), "+s"(bx));
        __builtin_amdgcn_s_waitcnt(0);
        unsigned nloc = b.st[0], nx = b.st[1];
        if (nloc == 0u) { xcd_barrier_complete(bar, bx, nloc, nx); b.st[0] = nloc; b.st[1] = nx; }
        const unsigned old = xb_add(&bar[XB_XSUB(bx)], 1u);
        unsigned gen = old / nloc;
        asm volatile("buffer_inv sc1" : "+v"(gen) :: "memory");
        if (old + 1u == (gen + 1u) * nloc) {
            __builtin_amdgcn_fence(__ATOMIC_RELEASE, "agent");
            asm volatile("s_waitcnt vmcnt(0)" ::: "memory");
            const unsigned og = xb_add(&bar[XB_TOP], 1u);
            const unsigned tgt = (og / nx + 1u) * nx;
            if (og + 1u != tgt) XB_SPIN((int)(xb_ld(&bar[XB_TOP]) - tgt) < 0, bar);
            xb_add(&bar[XB_XGEN(bx)], 1u);
            asm volatile("s_waitcnt vmcnt(0)" ::: "memory");
        } else {
            XB_SPIN(xb_ld(&bar[XB_XGEN(bx)]) == gen, bar);
            asm volatile("s_waitcnt vmcnt(0)" ::: "memory");
        }
    }
    __syncthreads();
}

__device__ __forceinline__ int tid_opaque() { int t = threadIdx.x; asm volatile("" : "+v"(t)); return t; }
__device__ __forceinline__ float bf2f(bf16_t v) { return __uint_as_float(((unsigned)v) << 16); }
__device__ __forceinline__ bf16_t f2bf(float f) { return __builtin_bit_cast(unsigned short, (__bf16)f); }
typedef __bf16 hwbf16x2 __attribute__((ext_vector_type(2)));
__device__ __forceinline__ unsigned pack2(float a, float b) { return __builtin_bit_cast(unsigned, __builtin_convertvector((f32x2){a, b}, hwbf16x2)); }
__device__ __forceinline__ unsigned pack4_fp8(float a, float b, float c, float d) {
    a = __builtin_amdgcn_fmed3f(a, -448.f, 448.f); b = __builtin_amdgcn_fmed3f(b, -448.f, 448.f); c = __builtin_amdgcn_fmed3f(c, -448.f, 448.f); d = __builtin_amdgcn_fmed3f(d, -448.f, 448.f);
    int p = __builtin_amdgcn_cvt_pk_fp8_f32(a, b, 0, false); p = __builtin_amdgcn_cvt_pk_fp8_f32(c, d, p, true); return (unsigned)p; }
__device__ __forceinline__ float lo2f(unsigned w) { return __uint_as_float(w << 16); }
__device__ __forceinline__ float hi2f(unsigned w) { return __uint_as_float(w & 0xffff0000u); }
template <int CTRL> __device__ __forceinline__ float dpp_mov(float v) { return __builtin_bit_cast(float, __builtin_amdgcn_update_dpp(0, __builtin_bit_cast(int, v), CTRL, 0xf, 0xf, true)); }
__device__ __forceinline__ float row_sum16(float v) {
    v += dpp_mov<0xB1>(v);
    v += dpp_mov<0x4E>(v);
    v += dpp_mov<0x141>(v);
    v += dpp_mov<0x140>(v);
    return v;
}
__device__ __forceinline__ float row_max16(float v) {
    v = fmaxf(v, dpp_mov<0xB1>(v)); v = fmaxf(v, dpp_mov<0x4E>(v)); v = fmaxf(v, dpp_mov<0x141>(v)); v = fmaxf(v, dpp_mov<0x140>(v));
    return v;
}
__device__ __forceinline__ float xsum32(float p, float q) { const auto rr = __builtin_amdgcn_permlane32_swap(__float_as_uint(p), __float_as_uint(q), false, false); return __uint_as_float(rr[0]) + __uint_as_float(rr[1]); }
__device__ __forceinline__ float xsum16(float p, float q) { const auto rr = __builtin_amdgcn_permlane16_swap(__float_as_uint(p), __float_as_uint(q), false, false); return __uint_as_float(rr[0]) + __uint_as_float(rr[1]); }
__device__ __forceinline__ float lane_f(float v, int lane) { return __builtin_bit_cast(float, __builtin_amdgcn_readlane(__builtin_bit_cast(int, v), lane)); }
__device__ __forceinline__ float wave_sum(float v) {
    v = row_sum16(v); v = xsum16(v, v); return xsum32(v, v);
}
__device__ __forceinline__ void wave_sum4(float a, float b, float c, float d, float (&o)[4]) {
    float w = xsum16(xsum32(a, b), xsum32(c, d));
    w = row_sum16(w);
    o[0] = lane_f(w, 0); o[1] = lane_f(w, 32); o[2] = lane_f(w, 16); o[3] = lane_f(w, 48);
}
__device__ __forceinline__ void wave_sum8(const float (&e)[8], int lane, float (&o)[8]) {
    const float w0 = xsum16(xsum32(e[0], e[1]), xsum32(e[2], e[3]));
    const float w1 = xsum16(xsum32(e[4], e[5]), xsum32(e[6], e[7]));
    const bool odd = lane & 1;
    float r = (odd ? w1 : w0) + dpp_mov<0xB1>(odd ? w0 : w1);
    r += dpp_mov<0x4E>(r); r += dpp_mov<0x124>(r); r += dpp_mov<0x128>(r);
    o[0] = lane_f(r, 0); o[1] = lane_f(r, 32); o[2] = lane_f(r, 16); o[3] = lane_f(r, 48);
    o[4] = lane_f(r, 1); o[5] = lane_f(r, 33); o[6] = lane_f(r, 17); o[7] = lane_f(r, 49);
}
__device__ __forceinline__ float gelu_erf(float v) {
    const float t = __builtin_amdgcn_rcpf(fabsf(v) * 0.2316418882f + 1.0f);
    float q = t * 0.5307027145f + (-0.7265760135f); q = q * t + 0.7107068705f; q = q * t + (-0.142248368f); q = q * t + 0.127414796f; q = q * t;
    const float m = v * (q * __builtin_amdgcn_exp2f((v * v) * (-0.72134752044f)));
    return v < 0.f ? m : v - m;
}
__device__ __forceinline__ float silu_f(float x) { return x * __builtin_amdgcn_rcpf(1.0f + __expf(-x)); }

__device__ __forceinline__ void ln_stats(const f32x4 (&v)[4], float& mean, float& rstd) {
    float s = 0.f;
#pragma unroll
    for (int i = 0; i < 4; ++i) s += (v[i][0] + v[i][1]) + (v[i][2] + v[i][3]);
    s = wave_sum(s); mean = s * (1.0f / 1024.0f);
    float q = 0.f;
#pragma unroll
    for (int i = 0; i < 4; ++i)
#pragma unroll
        for (int e = 0; e < 4; ++e) { const float d = v[i][e] - mean; q += d * d; }
    q = wave_sum(q); rstd = __builtin_amdgcn_rsqf(q * (1.0f / 1024.0f) + 1e-6f);
}

template <int BN> struct MfmaLayout {
    static constexpr int FG = BN / 128, NI = 4, NJ = 2 * FG;
    static constexpr bool PAIR8 = false;
    int rbase, cbase;
    __device__ __forceinline__ int row(int i) const { return rbase + 16 * i; }
    __device__ __forceinline__ int col(int jj) const { return (jj / FG) * (BN / 2) + (jj % FG) * 16 + cbase; }
};

__device__ __forceinline__ void glds16(const bf16_t* g, LAS unsigned char* l) {
    __builtin_amdgcn_global_load_lds((const unsigned*)g, (LAS unsigned*)l, 16, 0, 0);
}

template <int BN, bool GATHER, class Epi>
__device__ __forceinline__ void gemm_tile(LAS unsigned char* lds, const bf16_t* A, int lda, const int* rowidx, int valid_rows,
                                          const bf16_t* B0, const bf16_t* B1, int ldb, int K, const Epi& epi) {
    constexpr int A_B = 16384, B_B = BN * 128, STAGE = A_B + B_B, NBL = BN / 64;
    const int tid = tid_opaque(), lane = tid & 63, wid = __builtin_amdgcn_readfirstlane(tid >> 6);
    const bf16_t* ap[2]; const bf16_t* bp[NBL];
#pragma unroll
    for (int i = 0; i < 2; ++i) {
        const int P = i * 512 + tid, row = P >> 3, c = (P & 7) ^ ((row >> 1) & 7);
        size_t ro;
        if (GATHER) ro = (size_t)(row < valid_rows ? rowidx[row] : 0) * (size_t)lda; else ro = (size_t)row * (size_t)lda;
        ap[i] = A + ro + c * 8;
    }
#pragma unroll
    for (int i = 0; i < NBL; ++i) {
        const int P = i * 512 + tid, row = P >> 3, c = (P & 7) ^ ((row >> 1) & 7);
        const bf16_t* base = (row < BN / 2) ? (B0 + (size_t)row * ldb) : (B1 + (size_t)(row - BN / 2) * ldb);
        bp[i] = base + c * 8;
    }
    const int nk = K / 64;
#define GT_STAGE(buf, k0) do { \
        _Pragma("unroll") for (int _i = 0; _i < 2; ++_i) glds16(ap[_i] + (k0), lds + (buf) * STAGE + _i * 8192 + wid * 1024); \
        _Pragma("unroll") for (int _i = 0; _i < NBL; ++_i) glds16(bp[_i] + (k0), lds + (buf) * STAGE + A_B + _i * 8192 + wid * 1024); } while (0)

    typedef MfmaLayout<BN> Lay;
    constexpr int FG = Lay::FG;
    const int fr = lane & 15, g = lane >> 4, wr = wid >> 2, wc = wid & 3;
    Lay lay; lay.rbase = wr * 64 + fr; lay.cbase = wc * 16 * FG + 4 * g;
    f32x4 acc[Lay::NI][Lay::NJ];
#pragma unroll
    for (int i = 0; i < Lay::NI; ++i)
#pragma unroll
        for (int j = 0; j < Lay::NJ; ++j) acc[i][j] = (f32x4){0.f, 0.f, 0.f, 0.f};
    int aoff[4], boff[Lay::NJ];
#pragma unroll
    for (int m = 0; m < 4; ++m) { const int row = wr * 64 + m * 16 + fr; aoff[m] = row * 128 + ((g ^ ((row >> 1) & 7)) << 4); }
#pragma unroll
    for (int jj = 0; jj < Lay::NJ; ++jj) { const int row = (jj / FG) * (BN / 2) + wc * 16 * FG + (jj % FG) * 16 + fr; boff[jj] = A_B + row * 128 + ((g ^ ((row >> 1) & 7)) << 4); }
    GT_STAGE(0, 0);
    asm volatile("s_waitcnt vmcnt(0)" ::: "memory"); __syncthreads();
    for (int kt = 0; kt < nk; ++kt) {
        if (kt + 1 < nk) GT_STAGE((kt + 1) & 1, (kt + 1) * 64);
        const LAS unsigned char* sa = lds + (kt & 1) * STAGE;
#pragma unroll
        for (int ks = 0; ks < 2; ++ks) {
            bf16x8 af[4], bfv[Lay::NJ];
#pragma unroll
            for (int m = 0; m < 4; ++m) af[m] = *(const LAS bf16x8*)(sa + (aoff[m] ^ (ks << 6)));
#pragma unroll
            for (int jj = 0; jj < Lay::NJ; ++jj) bfv[jj] = *(const LAS bf16x8*)(sa + (boff[jj] ^ (ks << 6)));
#pragma unroll
            for (int m = 0; m < 4; ++m)
#pragma unroll
                for (int jj = 0; jj < Lay::NJ; ++jj) acc[m][jj] = __builtin_amdgcn_mfma_f32_16x16x32_bf16(bfv[jj], af[m], acc[m][jj], 0, 0, 0);
        }
        asm volatile("s_waitcnt vmcnt(0)" ::: "memory"); __syncthreads();
    }
    epi.run(acc, lay);
#undef GT_STAGE
}

namespace g256 {
constexpr int BK = 64, HALF = 128, HTB = HALF * BK * 2, STAGE_BYTES = 8 * HTB;
__device__ __forceinline__ int lds_byte(int r, int c) { const int st = (r >> 4) * 2 + (c >> 5), rr = r & 15, cc = c & 31, ob = rr * 64 + cc * 2; return st * 1024 + (ob ^ (((ob >> 9) & 1) << 5)); }
__device__ __forceinline__ int perm32(int rho) { const int n = rho >> 4, i = rho & 15; return 8 * (i >> 2) + 4 * n + (i & 3); }
__device__ __forceinline__ void stage_rc(int b, int& R, int& C) { const int st = b / 1024, sb = b % 1024, swz = sb ^ (((sb >> 9) & 1) << 5); R = (st >> 1) * 16 + swz / 64; C = (st & 1) * 32 + (swz % 64) / 2; }
struct Lay {
    static constexpr int NI = 8, NJ = 4;
    static constexpr bool PAIR8 = true;
    int rbase, cbase;
    __device__ __forceinline__ int row(int i) const { return (i >> 2) * 128 + (i & 3) * 16 + rbase; }
    __device__ __forceinline__ int col(int j) const { return (j >> 1) * 128 + (j & 1) * 4 + cbase; }
};
template <class Epi> struct Unit { const bf16_t* A; const bf16_t* B0; const bf16_t* B1; const LAS int* ridx; int valid; int tag; Epi epi; };

template <class Sched>
__device__ __forceinline__ void gemm_phase(LAS unsigned char* lds, const int K, const Sched& S) {
    typedef typename Sched::Epi Epi;
    const int tid = tid_opaque(), wid = __builtin_amdgcn_readfirstlane(tid >> 6), lane = tid & 63, wr = wid >> 2, wc = wid & 3, fr = lane & 15, fq = lane >> 4;
    int nt = K / BK; asm volatile("" : "+s"(nt));
    int sR[2], sC[2];
#pragma unroll
    for (int i = 0; i < 2; ++i) stage_rc(tid * 16 + i * 8192, sR[i], sC[i]);
    unsigned voffB[2];
#pragma unroll
    for (int i = 0; i < 2; ++i) { const int nat = (sR[i] & ~31) + perm32(sR[i] & 31);
        voffB[i] = (unsigned)((Sched::ILV8 ? nat + 8 * (nat >> 3) : nat) * K + sC[i]) * 2u; }
    const size_t kstep = (size_t)(BK * 2);
    const unsigned ldsw = (unsigned)wid * 1024u;
    const int aoff = lds_byte(wr * 64 + fr, fq * 8), boff = lds_byte(wc * 32 + fr, fq * 8);
#define G2_SA(b, h) (((b) * 2 + (h)) * HTB)
#define G2_SB(b, h) ((4 + (b) * 2 + (h)) * HTB)
#define G2_STAGE(bufoff, gbase, v0, v1) do { \
        __builtin_amdgcn_global_load_lds((const unsigned*)((const char*)(gbase) + (v0)), (LAS unsigned*)(lds + (bufoff) + ldsw), 16, 0, 0); \
        __builtin_amdgcn_global_load_lds((const unsigned*)((const char*)(gbase) + (v1)), (LAS unsigned*)(lds + (bufoff) + ldsw + 8192), 16, 0, 0); } while (0)
#define G2_LDA(dst, b, h) do { _Pragma("unroll") for (int m = 0; m < 4; ++m) _Pragma("unroll") for (int k = 0; k < 2; ++k) dst[m][k] = *(const LAS bf16x8*)(lds + G2_SA(b, h) + aoff + m * 2048 + k * 1024); } while (0)
#define G2_LDB(dst, b, h) do { _Pragma("unroll") for (int n = 0; n < 2; ++n) _Pragma("unroll") for (int k = 0; k < 2; ++k) dst[n][k] = *(const LAS bf16x8*)(lds + G2_SB(b, h) + boff + n * 2048 + k * 1024); } while (0)
#define G2_MMA(ai, bj, At, Bt) do { __builtin_amdgcn_s_setprio(1); _Pragma("unroll") for (int m = 0; m < 4; ++m) _Pragma("unroll") for (int n = 0; n < 2; ++n) _Pragma("unroll") for (int k = 0; k < 2; ++k) { \
        if (Sched::FP8) { if (k == 0) {     \
            const i32x8 _b = __builtin_shufflevector(__builtin_bit_cast(i32x4, Bt[n][0]), __builtin_bit_cast(i32x4, Bt[n][1]), 0, 1, 2, 3, 4, 5, 6, 7), _a = __builtin_shufflevector(__builtin_bit_cast(i32x4, At[m][0]), __builtin_bit_cast(i32x4, At[m][1]), 0, 1, 2, 3, 4, 5, 6, 7); \
            asm volatile("v_mfma_f32_16x16x128_f8f6f4 %0, %1, %2, %0" : "+v"(acc[(ai) * 4 + m][(bj) * 2 + n]) : "v"(_b), "v"(_a)); } } \
        else acc[(ai) * 4 + m][(bj) * 2 + n] = __builtin_amdgcn_mfma_f32_16x16x32_bf16(Bt[n][k], At[m][k], acc[(ai) * 4 + m][(bj) * 2 + n], 0, 0, 0); } __builtin_amdgcn_s_setprio(0); } while (0)
#define G2_WAIT_V(n) asm volatile("s_waitcnt vmcnt(" #n ")" ::: "memory")
#define G2_WAIT_L(n) asm volatile("s_waitcnt lgkmcnt(" #n ")" ::: "memory")
#define G2_BAR __builtin_amdgcn_s_barrier()
#define G2_SCHED __builtin_amdgcn_sched_barrier(0)
#define G2_VOFFA(U, dst) do { _Pragma("unroll") for (int _h = 0; _h < 2; ++_h) _Pragma("unroll") for (int _i = 0; _i < 2; ++_i) { const int _row = _h * 128 + sR[_i]; \
        int _tok = _row; if (Sched::GATHER) _tok = (_row < (U).valid) ? (U).ridx[_row] : 0; dst[_h][_i] = (unsigned)(_tok * K + sC[_i]) * 2u; } } while (0)
    Unit<Epi> cur, nxt; int ui = 0;
    if (!S.get(0, cur)) return;
#define G2_DEPWAIT(tag_) do { if (wid == 0) { unsigned* _d = S.dep + (tag_); unsigned _sp = 0; while (xb_ld(_d) < 4u) { __builtin_amdgcn_s_sleep(2); if (++_sp > (1u << 22)) break; } __builtin_amdgcn_fence(__ATOMIC_ACQUIRE, "agent"); } G2_BAR; } while (0)
    if (Sched::WAITDEP) G2_DEPWAIT(cur.tag);
    f32x4 acc[8][4];
#pragma unroll
    for (int i = 0; i < 8; ++i)
#pragma unroll
        for (int j = 0; j < 4; ++j) acc[i][j] = (f32x4){0.f, 0.f, 0.f, 0.f};
    bf16x8 At[4][2], B0[2][2], B1[2][2];
    unsigned cvA[2][2], nvA[2][2];
    G2_VOFFA(cur, cvA);
    const char* cA = (const char*)cur.A; const char* cB0 = (const char*)cur.B0; const char* cB1 = (const char*)cur.B1;
    G2_STAGE(G2_SB(0, 0), cB0, voffB[0], voffB[1]); G2_STAGE(G2_SB(0, 1), cB1, voffB[0], voffB[1]); G2_STAGE(G2_SA(0, 0), cA, cvA[0][0], cvA[0][1]); G2_STAGE(G2_SA(0, 1), cA, cvA[1][0], cvA[1][1]);
    if (wr == 1) G2_BAR;
    G2_WAIT_V(2); G2_BAR;
    G2_STAGE(G2_SB(1, 0), cB0 + kstep, voffB[0], voffB[1]); G2_STAGE(G2_SA(1, 0), cA + kstep, cvA[0][0], cvA[0][1]); G2_STAGE(G2_SB(1, 1), cB1 + kstep, voffB[0], voffB[1]);
    G2_WAIT_V(6); G2_BAR;
    for (;;) {
        const bool has_next = S.get(ui + 1, nxt);
        if (Sched::WAITDEP) { if (has_next) G2_DEPWAIT(nxt.tag); }
        if (Sched::GATHER) {
            if (has_next) { G2_VOFFA(nxt, nvA); }
            else {
#pragma unroll
                for (int h = 0; h < 2; ++h) { nvA[h][0] = cvA[h][0]; nvA[h][1] = cvA[h][1]; } }
        }
        const char* nA = has_next ? (const char*)nxt.A : cA; const char* nB0 = has_next ? (const char*)nxt.B0 : cB0; const char* nB1 = has_next ? (const char*)nxt.B1 : cB1;
#pragma unroll 1
        for (int t = 0; t < nt; t += 2) {
            const bool last = (t == nt - 2);
            const char* a1 = cA + (size_t)(t + 1) * kstep;
            const char* a2 = last ? nA : cA + (size_t)(t + 2) * kstep;
            const char* b20 = last ? nB0 : cB0 + (size_t)(t + 2) * kstep; const char* b21 = last ? nB1 : cB1 + (size_t)(t + 2) * kstep;
#define x00 ((Sched::GATHER && last) ? nvA[0][0] : cvA[0][0])
#define x01 ((Sched::GATHER && last) ? nvA[0][1] : cvA[0][1])
#define x10 ((Sched::GATHER && last) ? nvA[1][0] : cvA[1][0])
#define x11 ((Sched::GATHER && last) ? nvA[1][1] : cvA[1][1])
            G2_LDB(B0, 0, 0); G2_LDB(B1, 0, 1); G2_SCHED; G2_LDA(At, 0, 0); G2_STAGE(G2_SA(1, 1), a1, cvA[1][0], cvA[1][1]);
            G2_WAIT_V(8); G2_WAIT_L(0); G2_BAR; G2_MMA(0, 0, At, B0); G2_MMA(0, 1, At, B1); G2_BAR; G2_SCHED;
            G2_LDA(At, 0, 1); G2_STAGE(G2_SB(0, 0), b20, voffB[0], voffB[1]); G2_STAGE(G2_SB(0, 1), b21, voffB[0], voffB[1]); G2_STAGE(G2_SA(0, 0), a2, x00, x01);
            G2_WAIT_V(8); G2_WAIT_L(0); G2_BAR; G2_MMA(1, 0, At, B0); G2_MMA(1, 1, At, B1); G2_BAR; G2_SCHED;
            G2_LDB(B0, 1, 0); G2_LDB(B1, 1, 1); G2_SCHED; G2_LDA(At, 1, 0); G2_STAGE(G2_SA(0, 1), a2, x10, x11);
            G2_WAIT_V(8); G2_WAIT_L(0); G2_BAR; G2_MMA(0, 0, At, B0); G2_MMA(0, 1, At, B1); G2_BAR; G2_SCHED;
            G2_LDA(At, 1, 1); G2_STAGE(G2_SB(1, 0), b20 + kstep, voffB[0], voffB[1]); G2_STAGE(G2_SB(1, 1), b21 + kstep, voffB[0], voffB[1]); G2_STAGE(G2_SA(1, 0), a2 + kstep, x00, x01);
            G2_WAIT_V(8); G2_WAIT_L(0); G2_BAR; G2_MMA(1, 0, At, B0); G2_MMA(1, 1, At, B1); G2_BAR; G2_SCHED;
        }
        if (wr == 0) G2_BAR;
        if (Sched::FP8) asm volatile("s_nop 15" ::: "memory");
        { Lay lay; int rbv = wr * 64 + fr, cbv = wc * 32 + 8 * fq; asm volatile("" : "+v"(rbv), "+v"(cbv));
          lay.rbase = rbv; lay.cbase = cbv; cur.epi.run(acc, lay); }
        if (Sched::SIGNAL) {
            G2_WAIT_V(0); G2_BAR;
            if (tid == 0) (void)xb_add(S.dep + cur.tag, 1u);
        }
        if (!has_next) break;
#pragma unroll
        for (int i = 0; i < 8; ++i)
#pragma unroll
            for (int j = 0; j < 4; ++j) acc[i][j] = (f32x4){0.f, 0.f, 0.f, 0.f};
        cur = nxt; cA = nA; cB0 = nB0; cB1 = nB1; ++ui;
        if (wr == 1) G2_BAR;
        if (Sched::GATHER) {
#pragma unroll
            for (int h = 0; h < 2; ++h) { cvA[h][0] = nvA[h][0]; cvA[h][1] = nvA[h][1]; } }
    }
#undef x00
#undef x01
#undef x10
#undef x11
    G2_WAIT_V(0);
    G2_BAR;
#undef G2_SA
#undef G2_SB
#undef G2_STAGE
#undef G2_LDA
#undef G2_LDB
#undef G2_MMA
#undef G2_WAIT_V
#undef G2_WAIT_L
#undef G2_BAR
#undef G2_SCHED
#undef G2_VOFFA
#undef G2_DEPWAIT
}
}

struct EpiF32 {
    float* C; int ld;
    template <class L> __device__ __forceinline__ void run(const f32x4 (&acc)[L::NI][L::NJ], const L& lay) const {
#pragma unroll
        for (int i = 0; i < L::NI; ++i)
#pragma unroll
            for (int j = 0; j < L::NJ; ++j) *(f32x4*)(C + (size_t)lay.row(i) * ld + lay.col(j)) = acc[i][j];
    }
};
struct EpiBf16 {
    bf16_t* C; int ld; float scale;
    template <class L> __device__ __forceinline__ void run(const f32x4 (&acc)[L::NI][L::NJ], const L& lay) const {
#pragma unroll
        for (int i = 0; i < L::NI; ++i) {
            if (L::PAIR8) {
#pragma unroll
                for (int j = 0; j < L::NJ; j += 2) { const f32x4 p = acc[i][j] * scale, q = acc[i][j + 1] * scale; u32x4 w; w.x = pack2(p[0], p[1]); w.y = pack2(p[2], p[3]); w.z = pack2(q[0], q[1]); w.w = pack2(q[2], q[3]);
                    *(u32x4*)(C + (size_t)lay.row(i) * ld + lay.col(j)) = w; }
            } else {
#pragma unroll
                for (int j = 0; j < L::NJ; ++j) { const f32x4 p = acc[i][j] * scale; u32x2 w; w.x = pack2(p[0], p[1]); w.y = pack2(p[2], p[3]);
                    *(u32x2*)(C + (size_t)lay.row(i) * ld + lay.col(j)) = w; }
            }
        }
    }
};
struct EpiFp8 {
    unsigned char* C; int ld; float scale;
    template <class L> __device__ __forceinline__ void run(const f32x4 (&acc)[L::NI][L::NJ], const L& lay) const {
        static_assert(L::PAIR8, "written for the paired-column layout");
#pragma unroll
        for (int i = 0; i < L::NI; ++i)
#pragma unroll
            for (int j = 0; j < L::NJ; j += 2) { const f32x4 p = acc[i][j] * scale, q = acc[i][j + 1] * scale; u32x2 w; w.x = pack4_fp8(p[0], p[1], p[2], p[3]); w.y = pack4_fp8(q[0], q[1], q[2], q[3]);
                *(u32x2*)(C + (size_t)lay.row(i) * ld + lay.col(j)) = w; }
    }
};
struct EpiFp8I {
    unsigned char* C; int ld; float scale;
    template <class L> __device__ __forceinline__ void run(const f32x4 (&acc)[L::NI][L::NJ], const L& lay) const {
        static_assert(L::PAIR8 && L::NJ == 4, "written for the paired-column 256x256 layout");
#pragma unroll
        for (int i = 0; i < L::NI; ++i) { const f32x4 p = acc[i][0] * scale, q = acc[i][1] * scale, r = acc[i][2] * scale, t = acc[i][3] * scale; u32x4 w;
            w.x = pack4_fp8(p[0], p[1], p[2], p[3]); w.y = pack4_fp8(q[0], q[1], q[2], q[3]); w.z = pack4_fp8(r[0], r[1], r[2], r[3]); w.w = pack4_fp8(t[0], t[1], t[2], t[3]);
            *(u32x4*)(C + (size_t)lay.row(i) * ld + 2 * lay.col(0)) = w; }
    }
};
struct EpiGateUp8 {
    unsigned char* C; int ld;
    template <class L> __device__ __forceinline__ void run(const f32x4 (&acc)[L::NI][L::NJ], const L& lay) const {
        static_assert(L::PAIR8 && L::NJ == 4, "written for the paired-column 256x256 layout");
#pragma unroll
        for (int i = 0; i < L::NI; ++i) {
            f32x4 h0, h1;
            { const f32x4 t0 = acc[i][0] * (-1.44269504088896341f / 32.0f), t1 = acc[i][1] * (-1.44269504088896341f / 32.0f), p0 = acc[i][0] * acc[i][2], p1 = acc[i][1] * acc[i][3];
#pragma unroll
              for (int e = 0; e < 4; ++e) { h0[e] = p0[e] * __builtin_amdgcn_rcpf(__builtin_fmaf(__builtin_amdgcn_exp2f(t0[e]), 1024.0f, 1024.0f)); h1[e] = p1[e] * __builtin_amdgcn_rcpf(__builtin_fmaf(__builtin_amdgcn_exp2f(t1[e]), 1024.0f, 1024.0f)); } }
            u32x2 w; w.x = pack4_fp8(h0[0], h0[1], h0[2], h0[3]); w.y = pack4_fp8(h1[0], h1[1], h1[2], h1[3]);
            { const unsigned char* pw = C + (size_t)lay.row(i) * ld + lay.col(0); asm volatile("global_store_dwordx2 %0, %1, off sc0 sc1" :: "v"(pw), "v"(w) : "memory"); }
        }
    }
};
struct EpiGateUp {
    bf16_t* C; int ld;
    template <class L> __device__ __forceinline__ void run(const f32x4 (&acc)[L::NI][L::NJ], const L& lay) const {
#pragma unroll
        for (int i = 0; i < L::NI; ++i) {
            if (L::PAIR8 && L::NJ == 4) {
                const f32x4 g0 = acc[i][0], g1 = acc[i][1], u0 = acc[i][2], u1 = acc[i][3];
                u32x4 w; w.x = pack2(silu_f(g0[0]) * u0[0], silu_f(g0[1]) * u0[1]); w.y = pack2(silu_f(g0[2]) * u0[2], silu_f(g0[3]) * u0[3]);
                w.z = pack2(silu_f(g1[0]) * u1[0], silu_f(g1[1]) * u1[1]); w.w = pack2(silu_f(g1[2]) * u1[2], silu_f(g1[3]) * u1[3]);
                *(u32x4*)(C + (size_t)lay.row(i) * ld + lay.col(0)) = w;
            } else {
#pragma unroll
                for (int j = 0; j < L::NJ / 2; ++j) { const f32x4 gt = acc[i][j], up = acc[i][j + L::NJ / 2];
                    u32x2 w; w.x = pack2(silu_f(gt[0]) * up[0], silu_f(gt[1]) * up[1]); w.y = pack2(silu_f(gt[2]) * up[2], silu_f(gt[3]) * up[3]);
                    *(u32x2*)(C + (size_t)lay.row(i) * ld + lay.col(j)) = w; }
            }
        }
    }
};
struct EpiInProj {
    bf16_t* Zt;
    bf16_t* tF;
    bf16_t* tV;
    int n0, pos0, n;
    template <class L> __device__ __forceinline__ void run(const f32x4 (&acc)[L::NI][L::NJ], const L& lay) const {
        static_assert(L::PAIR8, "written for the paired-column layout");
#pragma unroll
        for (int i = 0; i < L::NI; ++i)
#pragma unroll
            for (int j = 0; j < L::NJ; j += 2) {
                const int r = lay.row(i), cl = lay.col(j), c = n0 + cl;
                const f32x4 v0 = acc[i][j], v1 = acc[i][j + 1];
                if (c < 512) {
                    const int part = c >> 8, ch = c & 255;
#pragma unroll
                    for (int e = 0; e < 4; ++e) { tF[((size_t)(ch + e) * 2 + part) * n + pos0 + r] = f2bf(v0[e]); tF[((size_t)(ch + 4 + e) * 2 + part) * n + pos0 + r] = f2bf(v1[e]); }
                } else {
                    u32x4 w; w.x = pack2(v0[0], v0[1]); w.y = pack2(v0[2], v0[3]); w.z = pack2(v1[0], v1[1]); w.w = pack2(v1[2], v1[3]);
                    *(u32x4*)(Zt + (size_t)r * ZC + cl) = w;
                    if (c >= 896 && c < 1024) {
#pragma unroll
                        for (int e = 0; e < 4; ++e) { tV[(size_t)(c - 896 + e) * n + pos0 + r] = f2bf(v0[e]); tV[(size_t)(c - 896 + 4 + e) * n + pos0 + r] = f2bf(v1[e]); }
                    }
                }
            }
    }
};

constexpr int U_ADA = 192, U_WIN = 2 * 16 * 8, U_WOUT = 2 * 8 * 16, U_PLAIN = 2 * 80 + 2 * 32, U_SGU = 32, U_DFT = 16, U_ROPE = 1, U_EXP = 3 * 32 * 32;
constexpr int LDS_SIL = 0, LDS_RED = 20480, LDS_TILE = 32768, LDS_T64 = 49408, LDS_CTAB = 50176;

__device__ __forceinline__ void ada_unit(AP a, unsigned char* lds, int u) {
    float* sil = (float*)(lds + LDS_SIL); float* red = (float*)(lds + LDS_TILE);
    const int tid = tid_opaque();
    const int l = u / 96, cg = u % 96;
    for (int i = tid; i < 5120; i += NT) { const int r = i >> 10, k = i & 1023; const float v = (r < 4) ? a->in[1][r * 1024 + k] : a->in[3][k]; sil[i] = v / (1.0f + expf(-v)); }
    __syncthreads();
    const int c4 = (tid & 15) * 4, kr = tid >> 4;
    const float* W = a->in[4] + (size_t)l * 1024 * 6144 + cg * 64 + c4;
    f32x4 acc[5];
#pragma unroll
    for (int r = 0; r < 5; ++r) acc[r] = (f32x4){0.f, 0.f, 0.f, 0.f};
#pragma unroll 8
    for (int i = 0; i < 32; ++i) { const int k = kr + 32 * i; const f32x4 wv = __builtin_nontemporal_load((const f32x4*)(W + (size_t)k * 6144));
#pragma unroll
        for (int r = 0; r < 5; ++r) acc[r] += wv * sil[r * 1024 + k]; }
#pragma unroll
    for (int r = 0; r < 5; ++r) *(f32x4*)(red + (kr * 5 + r) * 64 + c4) = acc[r];
    __syncthreads();
    if (tid < 320) { const int r = tid >> 6, c = tid & 63; float s_ = 0.f;
#pragma unroll 8
        for (int g = 0; g < 32; ++g) s_ += red[(g * 5 + r) * 64 + c];
        const int j = cg * 64 + c; ((float*)(a->ws + WS_MOD))[(size_t)(l * 5 + r) * 6144 + j] = s_ + a->in[5][l * 6144 + j]; }
    __syncthreads();
}

__device__ __forceinline__ void tile_store_T(const float* tile, bf16_t* dst, int ldd) {
    const int tid = tid_opaque(), n = tid >> 3, kc = tid & 7;
    u32x4 w;
    w.x = pack2(tile[(kc * 8 + 0) * 65 + n], tile[(kc * 8 + 1) * 65 + n]); w.y = pack2(tile[(kc * 8 + 2) * 65 + n], tile[(kc * 8 + 3) * 65 + n]);
    w.z = pack2(tile[(kc * 8 + 4) * 65 + n], tile[(kc * 8 + 5) * 65 + n]); w.w = pack2(tile[(kc * 8 + 6) * 65 + n], tile[(kc * 8 + 7) * 65 + n]);
    *(u32x4*)(dst + (size_t)n * ldd + kc * 8) = w;
}
__device__ __forceinline__ void tile_load(float* tile, const float* src, int lds_) {
    const int tid = tid_opaque();
#pragma unroll
    for (int i = 0; i < 2; ++i) { const int row = (tid >> 4) + 32 * i, c4 = (tid & 15) * 4; const f32x4 v = __builtin_nontemporal_load((const f32x4*)(src + (size_t)row * lds_ + c4));
        tile[row * 65 + c4 + 0] = v[0]; tile[row * 65 + c4 + 1] = v[1]; tile[row * 65 + c4 + 2] = v[2]; tile[row * 65 + c4 + 3] = v[3]; }
}

__device__ __forceinline__ void mm64_f32(const float* tA, int lda, const float* tB, int ldb, int K, float* out) {
    const int tid = tid_opaque(), lane = tid & 63, w = tid >> 6, fr = lane & 15, g = lane >> 4, mi = w >> 1, nj = 2 * (w & 1);
    f32x4 acc0 = (f32x4){0.f, 0.f, 0.f, 0.f}, acc1 = (f32x4){0.f, 0.f, 0.f, 0.f};
    const float* pa = tA + (16 * mi + fr) * lda + g; const float* pb = tB + g * ldb + 16 * nj + fr;
#pragma unroll 4
    for (int k0 = 0; k0 < K; k0 += 4) { const float av = pa[k0], b0 = pb[k0 * ldb], b1 = pb[k0 * ldb + 16];
        acc0 = __builtin_amdgcn_mfma_f32_16x16x4f32(av, b0, acc0, 0, 0, 0); acc1 = __builtin_amdgcn_mfma_f32_16x16x4f32(av, b1, acc1, 0, 0, 0); }
#pragma unroll
    for (int r = 0; r < 4; ++r) { out[(16 * mi + 4 * g + r) * 65 + 16 * nj + fr] = acc0[r]; out[(16 * mi + 4 * g + r) * 65 + 16 * nj + 16 + fr] = acc1[r]; }
}

__device__ __forceinline__ void win_unit(AP a, unsigned char* lds, int u) {
    float* tile = (float*)(lds + LDS_TILE); float* T = (float*)(lds + LDS_T64);
    const int tid = tid_opaque();
    const int l = u / 128, r = u % 128, kb = r / 8, nb = r % 8;
    const float* Win = a->in[6] + (size_t)l * 1024 * 1536;
    const int srccol = (nb >= 8) ? nb * 64 - 256 : (nb & 3) * 64;
    tile_load(tile, Win + (size_t)(kb * 64) * 1536 + srccol, 1536);
    if (nb < 8 && tid < 64) { T[tid] = cospif((float)tid / 32.0f); T[64 + tid] = sinpif((float)tid / 32.0f); }
    __syncthreads();
    bf16_t* dst = (bf16_t*)(a->ws + WS_WIN) + ((size_t)l * ZC + nb * 64) * 1024 + kb * 64;
    if (nb >= 8) tile_store_T(tile, dst, 1024);
    else {
        const int part = nb >> 2;
        float* Tm = (float*)(lds + 65536); float* out = (float*)(lds + 98304);
        for (int i = tid; i < 4096; i += NT) { const int c = i >> 6, cp = i & 63; const float t = T[part * 64 + ((c * cp) & 63)]; Tm[i] = (part ? -t : t) * 0.125f; }
        __syncthreads();
        mm64_f32(tile, 65, Tm, 64, 64, out);
        __syncthreads();
        tile_store_T(out, dst, 1024);
    }
    __syncthreads();
}

__device__ __forceinline__ void wout_unit(AP a, unsigned char* lds, int u) {
    float* tile = (float*)(lds + LDS_TILE);
    __syncthreads();
    const int tid = tid_opaque();
    const int l = u / 128, r = u % 128, kbi = r / 16, kb = (kbi < 4) ? kbi : kbi + 4, nb = r % 16;
    const float* Wo = a->in[13] + (size_t)l * 1024 * 1024;
    const int n = tid & 63, kq = __builtin_amdgcn_readfirstlane(tid >> 6);
    if (kb < 4) {
        float* tA = (float*)lds; float* tB = (float*)(lds + 65536);
        const float* wf = a->in[7] + (size_t)l * 256 * 256 + (size_t)(kb * 64) * 256;
        __syncthreads();
        f32x4 va[8], vb[8];
#pragma unroll
        for (int i = 0; i < 8; ++i) { const int q = tid + 512 * i; va[i] = *(const f32x4*)(wf + (size_t)q * 4); vb[i] = *(const f32x4*)(Wo + (size_t)(q >> 4) * 1024 + nb * 64 + (q & 15) * 4); }
#pragma unroll
        for (int i = 0; i < 8; ++i) { const int q = tid + 512 * i; *(f32x4*)(tA + (size_t)q * 4) = va[i]; *(f32x4*)(tB + (size_t)q * 4) = vb[i]; }
        __syncthreads();
        tile = (float*)(lds + 133120);
        mm64_f32(tA, 256, tB, 64, 256, tile);
    } else if (kb >= 8 && kb < 12) {
        const int g = kb - 8;
        float* tA = (float*)lds; float* tB = (float*)(lds + 65536);
        const float* wp = a->in[9] + (size_t)(l * 4 + g) * 64 * 64;
        const float* ps = a->in[10] + l * 256 + g * 64;
        f32x4 va[2], vb[2];
#pragma unroll
        for (int i = 0; i < 2; ++i) { const int q = tid + 512 * i; va[i] = *(const f32x4*)(wp + (size_t)q * 4); vb[i] = *(const f32x4*)(Wo + (size_t)(512 + g * 64 + (q >> 4)) * 1024 + nb * 64 + (q & 15) * 4) * ps[q >> 4]; }
#pragma unroll
        for (int i = 0; i < 2; ++i) { const int q = tid + 512 * i; *(f32x4*)(tA + (size_t)q * 4) = va[i]; *(f32x4*)(tB + (size_t)q * 4) = vb[i]; }
        __syncthreads();
        tile = (float*)(lds + 133120);
        mm64_f32(tA, 64, tB, 64, 64, tile);
    } else tile_load(tile, Wo + (size_t)(kb * 64) * 1024 + nb * 64, 1024);
    __syncthreads();
    tile_store_T(tile, (bf16_t*)(a->ws + WS_WOUT) + ((size_t)l * 1024 + nb * 64) * 1024 + kb * 64, 1024);
    __syncthreads();
}

__device__ __forceinline__ void exp_src_dst(AP a, int l, int u, const float*& src, int& srcld, unsigned char*& dst, int& dstld) {
    const int mat = u / 1024, e = (u % 1024) / 32, t = u % 32;
    const int kb = (mat < 2) ? t / 4 : t / 8, nb = (mat < 2) ? t % 4 : t % 8;
    srcld = (mat < 2) ? 512 : 1024; dstld = (mat < 2) ? 1024 : 512;
    src = a->in[18 + mat] + ((size_t)(l * 32 + e) * 512 * 1024) + (size_t)(kb * 128) * srcld + nb * 128;
    dst = a->ws + WS_WEXP + (size_t)l * WEXP_LAYER + (size_t)mat * EXPMAT + (size_t)e * 512 * 1024 + (size_t)(nb * 128) * dstld + kb * 128;
}
#define EXP_LOAD(vv, uu) do { exp_src_dst(a, l, (uu), src, srcld, dst, dstld); _Pragma("unroll") for (int _i = 0; _i < 8; ++_i) vv[_i] = __builtin_nontemporal_load((const f32x4*)(src + (size_t)((tid >> 5) + 16 * _i) * srcld + (tid & 31) * 4)); } while (0)
#define EXP_PUT(vv) do { _Pragma("unroll") for (int _i = 0; _i < 8; ++_i) *(f32x4*)(tile + ((tid >> 5) + 16 * _i) * 132 + (tid & 31) * 4) = vv[_i] * 32.0f; } while (0)
#define EXP_STORE(dd, ld_) do { const int n = ((tid >> 6) & 3) * 32 + (tid & 31), kb = (tid >> 8) * 64 + ((tid >> 5) & 1) * 16;        \
        _Pragma("unroll") for (int j = 0; j < 2; ++j) { const float* tp = tile + (kb + j * 32) * 132 + n; u32x4 w; \
        w.x = pack4_fp8(tp[0], tp[132], tp[2 * 132], tp[3 * 132]); w.y = pack4_fp8(tp[4 * 132], tp[5 * 132], tp[6 * 132], tp[7 * 132]); \
        w.z = pack4_fp8(tp[8 * 132], tp[9 * 132], tp[10 * 132], tp[11 * 132]); w.w = pack4_fp8(tp[12 * 132], tp[13 * 132], tp[14 * 132], tp[15 * 132]); \
        *(u32x4*)((dd) + (size_t)n * (ld_) + kb + j * 32) = w; } } while (0)
__device__ __forceinline__ void exp_range(AP a, unsigned char* lds, int l, int u0, int u_end) {
    float* tile = (float*)lds;
    const int tid = tid_opaque();
    __syncthreads();
    if (u0 >= u_end) return;
    const float* src; unsigned char* dst; int srcld, dstld;
    f32x4 va[8], vb[8];
    unsigned char *da, *db = nullptr; int lda_, ldb_ = 0;
    EXP_LOAD(va, u0); da = dst; lda_ = dstld;
    if (u0 + 1 < u_end) { EXP_LOAD(vb, u0 + 1); db = dst; ldb_ = dstld; }
    for (int u = u0; u < u_end; u += 2) {
        EXP_PUT(va);
        __syncthreads();
        { unsigned char* cd = da; const int cl = lda_; if (u + 2 < u_end) { EXP_LOAD(va, u + 2); da = dst; lda_ = dstld; } EXP_STORE(cd, cl); }
        __syncthreads();
        if (u + 1 < u_end) {
            EXP_PUT(vb);
            __syncthreads();
            { unsigned char* cd = db; const int cl = ldb_; if (u + 3 < u_end) { EXP_LOAD(vb, u + 3); db = dst; ldb_ = dstld; } EXP_STORE(cd, cl); }
            __syncthreads();
        }
    }
}
#undef EXP_LOAD
#undef EXP_PUT
#undef EXP_STORE
__device__ __forceinline__ void exp_queue(AP a, unsigned char* lds, int l) {
    const int tid = tid_opaque();
    int* qslot = (int*)(lds + MISC_OFF + 128);
    unsigned* qc = (unsigned*)(a->ws + WS_BAR + 14336 + l * 256);
    for (;;) {
        __syncthreads();
        if (tid == 0) *qslot = (int)__hip_atomic_fetch_add(qc, 2u, __ATOMIC_RELAXED, __HIP_MEMORY_SCOPE_AGENT);
        __syncthreads();
        const int c0 = *qslot;
        if (c0 >= U_EXP) break;
        exp_range(a, lds, l, c0, c0 + 2);
    }
}

__device__ __forceinline__ void exp_fill(AP a, unsigned char* lds, int ql, int budget) {
    const int tid = tid_opaque();
    int* qslot = (int*)(lds + MISC_OFF + 128);
    unsigned* qc = (unsigned*)(a->ws + WS_BAR + 14336 + ql * 256);
    for (int done = 0; done < budget; done += 2) {
        __syncthreads();
        if (tid == 0) *qslot = (int)__hip_atomic_fetch_add(qc, 2u, __ATOMIC_RELAXED, __HIP_MEMORY_SCOPE_AGENT);
        __syncthreads();
        const int c0 = *qslot;
        if (c0 >= U_EXP) break;
        exp_range(a, lds, ql, c0, c0 + 2);
    }
    __syncthreads();
}

__device__ __forceinline__ void plain_unit(AP a, unsigned char* lds, int u) {
    float* tile = (float*)lds;
    const int tid = tid_opaque();
    const float* src; bf16_t* dst; int srcld;
    if (u < 160) { const int l = u / 80, r = u % 80, kb = r / 10, nb = r % 10;
        src = a->in[6] + (size_t)l * 1024 * 1536 + (size_t)(kb * 128) * 1536 + 256 + nb * 128; srcld = 1536;
        dst = (bf16_t*)(a->ws + WS_WIN) + ((size_t)l * ZC + 512 + nb * 128) * 1024 + kb * 128; }
    else { const int v = u - 160, l = v / 32, r = v % 32, kq = r / 8, nb = r % 8, kb = (kq < 2) ? 2 + kq : 4 + kq;
        src = a->in[13] + (size_t)l * 1024 * 1024 + (size_t)(kb * 128) * 1024 + nb * 128; srcld = 1024;
        dst = (bf16_t*)(a->ws + WS_WOUT) + ((size_t)l * 1024 + nb * 128) * 1024 + kb * 128; }
    f32x4 v[8];
#pragma unroll
    for (int i = 0; i < 8; ++i) v[i] = __builtin_nontemporal_load((const f32x4*)(src + (size_t)((tid >> 5) + 16 * i) * srcld + (tid & 31) * 4));
    __syncthreads();
#pragma unroll
    for (int i = 0; i < 8; ++i) *(f32x4*)(tile + ((tid >> 5) + 16 * i) * 132 + (tid & 31) * 4) = v[i];
    __syncthreads();
    const int n = ((tid >> 6) & 3) * 32 + (tid & 31), pb = (tid >> 8) * 8 + ((tid >> 5) & 1);
#pragma unroll
    for (int j = 0; j < 4; ++j) { const float* tp = tile + ((pb + 2 * j) * 8) * 132 + n; u32x4 w;
        w.x = pack2(tp[0], tp[132]); w.y = pack2(tp[2 * 132], tp[3 * 132]); w.z = pack2(tp[4 * 132], tp[5 * 132]); w.w = pack2(tp[6 * 132], tp[7 * 132]);
        *(u32x4*)(dst + (size_t)n * 1024 + (pb + 2 * j) * 8) = w; }
    __syncthreads();
}

__device__ __forceinline__ void p0_prologue(AP a, unsigned char* lds) {
    const int tid = tid_opaque();
    constexpr int E0 = U_ADA, E1 = E0 + U_WIN, E2 = E1 + U_WOUT, E3 = E2 + U_PLAIN, E4 = E3 + U_SGU, E5 = E4 + U_DFT, E6 = E5 + U_ROPE;
    const int G_ = (int)gridDim.x, n_mine = (E6 - (int)blockIdx.x + G_ - 1) / G_, rot = (int)((blockIdx.x >> 3) % 4u);
    for (int kk = 0; kk < n_mine; ++kk) { const int u = (int)blockIdx.x + ((kk + rot) % n_mine) * G_;
        if (u < E0) ada_unit(a, lds, u);
        else if (u < E1) win_unit(a, lds, u - E0);
        else if (u < E2) wout_unit(a, lds, u - E1);
        else if (u < E3) plain_unit(a, lds, u - E2);
        else if (u < E4) { const size_t i0 = (size_t)(u - E3) * 4096 + tid * 8; const float* s = a->in[11] + i0; bf16_t* d = (bf16_t*)(a->ws + WS_WSGU) + i0;
            const f32x4 v0 = *(const f32x4*)s, v1 = *(const f32x4*)(s + 4); u32x4 w; w.x = pack2(v0[0], v0[1]); w.y = pack2(v0[2], v0[3]); w.z = pack2(v1[0], v1[1]); w.w = pack2(v1[2], v1[3]); *(u32x4*)d = w; }
        else if (u < E5) {
            const int kk = (u - E4) * 16 + (tid >> 5), n0 = (tid & 31) * 8; float c[8], sn[8];
#pragma unroll
            for (int e = 0; e < 8; ++e) { const float x = (float)((kk * (n0 + e)) & 255) * (1.0f / 128.0f); c[e] = cospif(x) * (1.0f / 16.0f); sn[e] = sinpif(x) * (1.0f / 16.0f); }
            bf16_t* d = (bf16_t*)(a->ws + WS_DFTC) + (size_t)kk * 512 + n0;
            u32x4 w; w.x = pack2(c[0], c[1]); w.y = pack2(c[2], c[3]); w.z = pack2(c[4], c[5]); w.w = pack2(c[6], c[7]); *(u32x4*)d = w;
            w.x = pack2(sn[0], sn[1]); w.y = pack2(sn[2], sn[3]); w.z = pack2(sn[4], sn[5]); w.w = pack2(sn[6], sn[7]); *(u32x4*)(d + 256) = w;
        }
        else {
            for (int i = tid; i < 1024; i += NT) { const int pos = i >> 4, f = i & 15; const float freq = powf(10000.0f, -(float)f / 16.0f); const float ang = (float)pos * freq;
                ((float2*)(a->ws + WS_ROPE))[i] = make_float2(cosf(ang), sinf(ang)); }
        }
    }
}

struct WaveToks { int base, j, stride, lim;
    __device__ __forceinline__ WaveToks(int gw, int NW, bool with_ctx) { const int WB = with_ctx ? NW * 4 / 17 : NW / 4, WC = NW - 4 * WB;
        if (gw < 4 * WB) { base = (gw / WB) * 4096; j = gw % WB; stride = WB; lim = 4096; } else { base = NLAT; j = gw - 4 * WB; stride = WC; lim = with_ctx ? 1024 : 0; } }
    __device__ __forceinline__ int tok(int k) const { const int idx = j + stride * k; return (idx < lim) ? base + idx : -1; }
    __device__ __forceinline__ int mrow() const { return (base < NLAT) ? (base >> 12) : 4; } };
static_assert(NBATCH == 4 && SEQ == 4096 && NCTX == 1024, "WaveToks is written for these shapes");
__device__ __forceinline__ void p_lnmod0(AP a) {
    const int tid = tid_opaque(), lane = tid & 63, w = tid >> 6;
    const float* mod = (const float*)(a->ws + WS_MOD);
    bf16_t* H = (bf16_t*)(a->ws + WS_H);
    const WaveToks wt(__builtin_amdgcn_readfirstlane(blockIdx.x * 8 + w), gridDim.x * 8, true);
    f32x4 nx[4];
    { const int t = wt.tok(0); if (t >= 0) { const float* src = (t < NLAT) ? a->in[0] + (size_t)t * D : a->in[2] + (size_t)(t - NLAT) * D;
#pragma unroll
        for (int i = 0; i < 4; ++i) nx[i] = __builtin_nontemporal_load((const f32x4*)(src + 256 * i + 4 * lane)); } }
    f32x4 msh[4], msc[4];
    {   const float* m = mod + (size_t)wt.mrow() * 6144;
#pragma unroll
        for (int i = 0; i < 4; ++i) { msh[i] = *(const f32x4*)(m + 256 * i + 4 * lane); msc[i] = *(const f32x4*)(m + 1024 + 256 * i + 4 * lane); } }
    int t = wt.tok(0);
    for (int k = 0; t >= 0; ++k) { const int tn = wt.tok(k + 1);
        f32x4 v[4];
#pragma unroll
        for (int i = 0; i < 4; ++i) v[i] = nx[i];
        { if (tn >= 0) { const float* src = (tn < NLAT) ? a->in[0] + (size_t)tn * D : a->in[2] + (size_t)(tn - NLAT) * D;
#pragma unroll
            for (int i = 0; i < 4; ++i) nx[i] = __builtin_nontemporal_load((const f32x4*)(src + 256 * i + 4 * lane)); } }
        float mean, rstd; ln_stats(v, mean, rstd);
#pragma unroll
        for (int i = 0; i < 4; ++i) { const int c = 256 * i + 4 * lane;
            f32x4 o;
#pragma unroll
            for (int e = 0; e < 4; ++e) o[e] = (v[i][e] - mean) * rstd * (1.0f + msc[i][e]) + msh[i][e];
            u32x2 pk; pk.x = pack2(o[0], o[1]); pk.y = pack2(o[2], o[3]); *(u32x2*)(H + (size_t)t * D + c) = pk; }
        t = tn;
    }
}

__device__ __forceinline__ void p1_inproj(AP a, unsigned char* smem, LAS unsigned char* lds, int l);
__device__ __forceinline__ u32x4 ld16g(const bf16_t* p) { return *(const u32x4*)p; }
__device__ __forceinline__ void rope_pack8(u32x4& wl, u32x4& wh, const LAS f32x2* tab, bool do_rope, float scale) {
    float tl[8] = {lo2f(wl.x), hi2f(wl.x), lo2f(wl.y), hi2f(wl.y), lo2f(wl.z), hi2f(wl.z), lo2f(wl.w), hi2f(wl.w)};
    float th[8] = {lo2f(wh.x), hi2f(wh.x), lo2f(wh.y), hi2f(wh.y), lo2f(wh.z), hi2f(wh.z), lo2f(wh.w), hi2f(wh.w)};
#pragma unroll
    for (int j = 0; j < 8; ++j) {
        float r1 = tl[j], r2 = th[j];
        if (do_rope) { const f32x2 cs = tab[j]; r1 = tl[j] * cs.x - th[j] * cs.y; r2 = tl[j] * cs.y + th[j] * cs.x; }
        tl[j] = r1 * scale; th[j] = r2 * scale;
    }
    wl.x = pack2(tl[0], tl[1]); wl.y = pack2(tl[2], tl[3]); wl.z = pack2(tl[4], tl[5]); wl.w = pack2(tl[6], tl[7]);
    wh.x = pack2(th[0], th[1]); wh.y = pack2(th[2], th[3]); wh.z = pack2(th[4], th[5]); wh.w = pack2(th[6], th[7]);
}

__device__ __forceinline__ void mixer_sgu_pool(AP a, LAS unsigned char* lds, int l, int row0, int seq_row0, int pos0, int n) {
    typedef short s16x4 __attribute__((ext_vector_type(4)));
    const int tid = tid_opaque(), lane = tid & 63, w = __builtin_amdgcn_readfirstlane(tid >> 6), fr = lane & 15, g = lane >> 4;
    const bf16_t* Z = (const bf16_t*)(a->ws + WS_Z);
    bf16_t* CAT = (bf16_t*)(a->ws + WS_CAT);
    constexpr int VOFF = 73728;
    u32x4 pr[9];
#pragma unroll
    for (int it = 0; it < 9; ++it) { const int id = tid + 512 * it, rr = id >> 5, ch = id & 31, j = pos0 - 8 + rr;
        pr[it] = (u32x4){0u, 0u, 0u, 0u};
        if (j >= 0 && j < n) pr[it] = ld16g(Z + (size_t)(seq_row0 + j) * ZC + 1024 + ch * 8); }
    bf16x8 wfrag[4][4];
    {   const int h = w >> 1, ph = w & 1; const bf16_t* Ws = (const bf16_t*)(a->ws + WS_WSGU) + (size_t)(l * 4 + h) * 128 * 128;
#pragma unroll
        for (int ks = 0; ks < 4; ++ks)
#pragma unroll
            for (int pf = 0; pf < 4; ++pf) wfrag[ks][pf] = *(const bf16x8*)(Ws + (size_t)(ph * 64 + 16 * pf + fr) * 128 + 32 * ks + 8 * g); }
    u32x4 gw[4][2];
#pragma unroll
    for (int ps = 0; ps < 4; ++ps) { const int q = w * 16 + ps * 4 + g; const bf16_t* src = Z + (size_t)(row0 + q) * ZC + 1536 + 16 * fr; gw[ps][0] = ld16g(src); gw[ps][1] = ld16g(src + 8); }
#pragma unroll
    for (int it = 0; it < 9; ++it) { const int id = tid + 512 * it; *(LAS u32x4*)(lds + (id >> 5) * 512 + (id & 31) * 16) = pr[it]; }
#pragma unroll
    for (int ps = 0; ps < 4; ++ps) {
        const int q = w * 16 + ps * 4 + g;
        float gv[16];
#pragma unroll
        for (int hh = 0; hh < 2; ++hh) { const u32x4 x = gw[ps][hh];
            gv[8 * hh + 0] = gelu_erf(lo2f(x.x)); gv[8 * hh + 1] = gelu_erf(hi2f(x.x)); gv[8 * hh + 2] = gelu_erf(lo2f(x.y)); gv[8 * hh + 3] = gelu_erf(hi2f(x.y));
            gv[8 * hh + 4] = gelu_erf(lo2f(x.z)); gv[8 * hh + 5] = gelu_erf(hi2f(x.z)); gv[8 * hh + 6] = gelu_erf(lo2f(x.w)); gv[8 * hh + 7] = gelu_erf(hi2f(x.w)); }
        float sm = 0.f;
#pragma unroll
        for (int e = 0; e < 16; ++e) sm += gv[e];
        const float mean = row_sum16(sm) * (1.0f / 256.0f);
        float qq = 0.f;
#pragma unroll
        for (int e = 0; e < 16; ++e) { const float d = gv[e] - mean; qq += d * d; }
        const float rstd = 1.0f / sqrtf(row_sum16(qq) * (1.0f / 256.0f) + 1e-6f);
        u32x4 o0, o1;
        o0.x = pack2((gv[0] - mean) * rstd, (gv[1] - mean) * rstd); o0.y = pack2((gv[2] - mean) * rstd, (gv[3] - mean) * rstd); o0.z = pack2((gv[4] - mean) * rstd, (gv[5] - mean) * rstd); o0.w = pack2((gv[6] - mean) * rstd, (gv[7] - mean) * rstd);
        o1.x = pack2((gv[8] - mean) * rstd, (gv[9] - mean) * rstd); o1.y = pack2((gv[10] - mean) * rstd, (gv[11] - mean) * rstd); o1.z = pack2((gv[12] - mean) * rstd, (gv[13] - mean) * rstd); o1.w = pack2((gv[14] - mean) * rstd, (gv[15] - mean) * rstd);
        const int sg = fr ^ ((q & 3) | (((q >> 3) & 1) << 2));
        *(LAS u32x4*)(lds + VOFF + q * 512 + sg * 32) = o0; *(LAS u32x4*)(lds + VOFF + q * 512 + sg * 32 + 16) = o1;
    }
    __syncthreads();
    {
        const int c2 = tid & 127, quarter = tid >> 7, hw = 1 << (c2 >> 5);
        const LAS unsigned* P = (const LAS unsigned*)lds + c2;
        const int t0 = quarter * 32;
        const float invfull = 1.0f / (float)(2 * hw);
        float s0 = 0.f, s1 = 0.f;
        for (int j = t0 - hw; j < t0 + hw; ++j) { const unsigned v = P[(8 + j) * 128]; s0 += lo2f(v); s1 += hi2f(v); }
        for (int tl = t0; tl < t0 + 32; ++tl) {
            const int pos = pos0 + tl; const int cntw = min(pos + hw, n) - max(pos - hw, 0);
            const float inv = (cntw == 2 * hw) ? invfull : 1.0f / (float)cntw;
            const unsigned self = P[(8 + tl) * 128], add = P[(8 + tl + hw) * 128], sub = P[(8 + tl - hw) * 128];
            *(unsigned*)(CAT + (size_t)(row0 + tl) * D + 512 + 2 * c2) = pack2(s0 * inv - lo2f(self), s1 * inv - hi2f(self));
            s0 += lo2f(add) - lo2f(sub); s1 += hi2f(add) - hi2f(sub);
        }
    }
    {
        const int h = w >> 1, ph = w & 1;
        const float* bs = a->in[12] + (size_t)(l * 4 + h) * 128;
        f32x4 acc[4][4];
#pragma unroll
        for (int i = 0; i < 4; ++i)
#pragma unroll
            for (int j = 0; j < 4; ++j) acc[i][j] = (f32x4){0.f, 0.f, 0.f, 0.f};
        const int qq4 = fr >> 2, p4 = fr & 3, fsw = qq4 | ((g & 1) << 2);
#pragma unroll
        for (int ks = 0; ks < 4; ++ks) {
            bf16x8 af[4];
            const int r0 = 32 * ks + 8 * g + qq4;
#pragma unroll
            for (int cf = 0; cf < 4; ++cf) { const int so = (((4 * h + cf) ^ fsw) << 5) + p4 * 8;
                const s16x4 lo = __builtin_amdgcn_ds_read_tr16_b64_v4i16((LAS s16x4*)(lds + VOFF + r0 * 512 + so));
                const s16x4 hi = __builtin_amdgcn_ds_read_tr16_b64_v4i16((LAS s16x4*)(lds + VOFF + (r0 + 4) * 512 + so));
                af[cf] = __builtin_shufflevector(lo, hi, 0, 1, 2, 3, 4, 5, 6, 7); }
#pragma unroll
            for (int cf = 0; cf < 4; ++cf)
#pragma unroll
                for (int pf = 0; pf < 4; ++pf) acc[cf][pf] = __builtin_amdgcn_mfma_f32_16x16x32_bf16(af[cf], wfrag[ks][pf], acc[cf][pf], 0, 0, 0);
        }
#pragma unroll
        for (int pf = 0; pf < 4; ++pf) { const int p = ph * 64 + 16 * pf + fr; const float bias = bs[p];
#pragma unroll
            for (int cfp = 0; cfp < 2; ++cfp) { const int chan = h * 64 + 16 * (2 * cfp + (g & 1)) + 8 * (g >> 1);
                const u32x4 L = __builtin_nontemporal_load((const u32x4*)(Z + (size_t)(row0 + p) * ZC + 1280 + chan));
                const auto ux = __builtin_amdgcn_permlane16_swap(L.x, L.z, false, false), uy = __builtin_amdgcn_permlane16_swap(L.y, L.w, false, false);
                const f32x4 a0 = acc[2 * cfp][pf], a1 = acc[2 * cfp + 1][pf];
                u32x2 oa, ob;
                oa.x = pack2(gelu_erf(lo2f(ux[0])) * (a0[0] + bias), gelu_erf(hi2f(ux[0])) * (a0[1] + bias)); oa.y = pack2(gelu_erf(lo2f(uy[0])) * (a0[2] + bias), gelu_erf(hi2f(uy[0])) * (a0[3] + bias));
                ob.x = pack2(gelu_erf(lo2f(ux[1])) * (a1[0] + bias), gelu_erf(hi2f(ux[1])) * (a1[1] + bias)); ob.y = pack2(gelu_erf(lo2f(uy[1])) * (a1[2] + bias), gelu_erf(hi2f(uy[1])) * (a1[3] + bias));
                const auto sx = __builtin_amdgcn_permlane16_swap(oa.x, ob.x, false, false), sy = __builtin_amdgcn_permlane16_swap(oa.y, ob.y, false, false);
                u32x4 o; o.x = sx[0]; o.y = sy[0]; o.z = sx[1]; o.w = sy[1];
                *(u32x4*)(CAT + (size_t)(row0 + p) * D + 768 + chan) = o; } }
    }
    __syncthreads();
}

__device__ __forceinline__ void mixer_attn(AP a, LAS unsigned char* lds, int l, int row0, int seq_row0, int pos0, int n, int b, bool is_ctx, int kvh) {
    const int tid = tid_opaque(), lane = tid & 63, w = __builtin_amdgcn_readfirstlane(tid >> 6), fr = lane & 15, g = lane >> 4;
    const bf16_t* Z = (const bf16_t*)(a->ws + WS_Z);
    bf16_t* CAT = (bf16_t*)(a->ws + WS_CAT);
    __syncthreads();
    ((LAS u32x4*)(lds + 98304))[tid] = ((const u32x4*)(a->ws + WS_ROPE))[tid];
    const LAS f32x2* rope = (const LAS f32x2*)(lds + 98304);
    constexpr float QS = 0.125f * 1.44269504088896341f;
    constexpr int QS_OFF = 0, KS_OFF = 32768, VS_OFF = 65536;
    const int nbq = pos0 >> 7;
    unsigned bmask = 0x18u;
    if (!is_ctx) { if (nbq > 0) bmask |= 1u; bmask |= 2u; if (nbq + 1 < (n >> 7)) bmask |= 4u; }
    const int kr = tid >> 2, kax = (tid >> 1) & 1, kh8 = tid & 1;
#define MX_KSRC(blk) (Z + (size_t)((((blk) < 3) ? seq_row0 + (nbq + (blk) - 1) * 128 : NLAT + b * 256 + ((blk) - 3) * 128) + kr) * ZC + 768 + kvh * 64 + kax * 32 + kh8 * 8)
#define MX_VSTAGE(blk, buf) do { const bool _band = (blk) < 3; const int _key0 = _band ? (nbq + (blk) - 1) * 128 : ((blk) - 3) * 128; \
        const bf16_t* _vs = _band ? (const bf16_t*)(a->ws + WS_VT) + (size_t)(b * 2 + kvh) * 64 * 4096 + _key0 : (const bf16_t*)(a->ws + WS_VTC) + (size_t)(b * 2 + kvh) * 64 * 256 + _key0; \
        const int _vld = _band ? 4096 : 256; \
        _Pragma("unroll") for (int _i = 0; _i < 2; ++_i) { const int _P = _i * 512 + tid, _d = _P >> 4, _c = (_P & 15) ^ (_d & 15); \
            glds16(_vs + (size_t)_d * _vld + _c * 8, lds + VS_OFF + (buf) * 16384 + _i * 8192 + w * 1024); } } while (0)
    {
        __syncthreads();
#pragma unroll
        for (int it = 0; it < 2; ++it) {
            const int item = tid + 512 * it, r = item >> 2, ax = (item >> 1) & 1, h8 = item & 1, i = r & 127, qpos = pos0 + i;
            const bf16_t* src = Z + (size_t)(row0 + i) * ZC + 512 + (2 * kvh + (r >> 7)) * 64 + ax * 32 + h8 * 8;
            u32x4 wl = ld16g(src), wh = ld16g(src + 16);
            rope_pack8(wl, wh, rope + (ax ? (qpos & 63) : (qpos >> 6)) * 16 + h8 * 8, !is_ctx, QS);
            const int ch = ax * 4 + h8, sw = (r >> 1) & 7;
            *(LAS u32x4*)(lds + QS_OFF + r * 128 + ((ch ^ sw) << 4)) = wl;
            *(LAS u32x4*)(lds + QS_OFF + r * 128 + (((ch + 2) ^ sw) << 4)) = wh;
        }
        const int hh = w >> 2, qb = (w & 3) * 32, h = 2 * kvh + hh;
        float m[2], lsum[2];
        m[0] = m[1] = a->in[8][l * 4 + h] * 1.44269504088896341f;
        lsum[0] = lsum[1] = (g == 0) ? 1.0f : 0.0f;
        f32x4 O[4][2];
#pragma unroll
        for (int i = 0; i < 4; ++i) { O[i][0] = (f32x4){0.f, 0.f, 0.f, 0.f}; O[i][1] = (f32x4){0.f, 0.f, 0.f, 0.f}; }
        bf16x8 Qf[2][2];
        bool have_q = false;
        unsigned rem = bmask;
        int cur = __builtin_ctz(rem); rem &= rem - 1u;
        int buf = 0;
        u32x4 kl = ld16g(MX_KSRC(cur)), kh = ld16g(MX_KSRC(cur) + 16);
        MX_VSTAGE(cur, 0);
#pragma unroll 1
        for (;;) {
            const int jb = cur - 1; const bool band = cur < 3;
            {
                const int kpos = (nbq + jb) * 128 + kr;
                rope_pack8(kl, kh, rope + (kax ? (kpos & 63) : (kpos >> 6)) * 16 + kh8 * 8, band, 1.0f);
                const int ch = kax * 4 + kh8, sw = (kr >> 1) & 7;
                *(LAS u32x4*)(lds + KS_OFF + buf * 16384 + kr * 128 + ((ch ^ sw) << 4)) = kl;
                *(LAS u32x4*)(lds + KS_OFF + buf * 16384 + kr * 128 + (((ch + 2) ^ sw) << 4)) = kh;
            }
            asm volatile("s_waitcnt vmcnt(0)" ::: "memory");
            __syncthreads();
            const int nxt = rem ? __builtin_ctz(rem) : -1; rem &= rem - 1u;
            if (nxt >= 0) { kl = ld16g(MX_KSRC(nxt)); kh = ld16g(MX_KSRC(nxt) + 16); MX_VSTAGE(nxt, buf ^ 1); }
            if (!have_q) {
#pragma unroll
                for (int qf = 0; qf < 2; ++qf)
#pragma unroll
                    for (int ks = 0; ks < 2; ++ks) { const int r = hh * 128 + qb + 16 * qf + fr; Qf[qf][ks] = *(const LAS bf16x8*)(lds + QS_OFF + r * 128 + (((4 * ks + g) ^ ((r >> 1) & 7)) << 4)); }
                have_q = true;
            }
            const int kso = KS_OFF + buf * 16384, vso = VS_OFF + buf * 16384;
            f32x4 S[8][2];
#pragma unroll
            for (int kf = 0; kf < 8; ++kf) { S[kf][0] = (f32x4){0.f, 0.f, 0.f, 0.f}; S[kf][1] = (f32x4){0.f, 0.f, 0.f, 0.f}; }
#pragma unroll
            for (int kf = 0; kf < 8; ++kf)
#pragma unroll
                for (int ks = 0; ks < 2; ++ks) { const int r = 16 * kf + fr;
                    const bf16x8 kfr = *(const LAS bf16x8*)(lds + kso + r * 128 + (((4 * ks + g) ^ ((r >> 1) & 7)) << 4));
                    S[kf][0] = __builtin_amdgcn_mfma_f32_16x16x32_bf16(kfr, Qf[0][ks], S[kf][0], 0, 0, 0);
                    S[kf][1] = __builtin_amdgcn_mfma_f32_16x16x32_bf16(kfr, Qf[1][ks], S[kf][1], 0, 0, 0); }
            bf16x8 Pp[4][2];
#pragma unroll
            for (int qf = 0; qf < 2; ++qf) {
                const int qi = qb + 16 * qf + fr;
                if (band && jb != 0) {
                    const int kd = 2 * (w & 3) + qf;
                    if (jb < 0) {
#pragma unroll
                        for (int kf = 0; kf < 8; ++kf)
#pragma unroll
                            for (int r = 0; r < 4; ++r) if (kf < kd || (kf == kd && 4 * g + r < fr)) S[kf][qf][r] = -1.0e30f;
                    } else {
#pragma unroll
                        for (int kf = 0; kf < 8; ++kf)
#pragma unroll
                            for (int r = 0; r < 4; ++r) if (kf > kd || (kf == kd && 4 * g + r > fr)) S[kf][qf][r] = -1.0e30f;
                    }
                }
                float mx = S[0][qf][0];
#pragma unroll
                for (int kf = 0; kf < 8; ++kf)
#pragma unroll
                    for (int r = 0; r < 4; ++r) mx = fmaxf(mx, S[kf][qf][r]);
                { const auto r16 = __builtin_amdgcn_permlane16_swap(__float_as_uint(mx), __float_as_uint(mx), false, false); mx = fmaxf(__uint_as_float(r16[0]), __uint_as_float(r16[1]));
                  const auto r32 = __builtin_amdgcn_permlane32_swap(__float_as_uint(mx), __float_as_uint(mx), false, false); mx = fmaxf(__uint_as_float(r32[0]), __uint_as_float(r32[1])); }
                const float mn = fmaxf(m[qf], mx), corr = __builtin_amdgcn_exp2f(m[qf] - mn);
                m[qf] = mn;
                float ps = 0.f;
#pragma unroll
                for (int kf = 0; kf < 8; ++kf)
#pragma unroll
                    for (int r = 0; r < 4; ++r) { const float p = __builtin_amdgcn_exp2f(S[kf][qf][r] - mn); S[kf][qf][r] = p; ps += p; }
                lsum[qf] = lsum[qf] * corr + ps;
#pragma unroll
                for (int df = 0; df < 4; ++df) O[df][qf] *= corr;
#pragma unroll
                for (int t = 0; t < 4; ++t) { u32x4 pw; pw.x = pack2(S[2 * t][qf][0], S[2 * t][qf][1]); pw.y = pack2(S[2 * t][qf][2], S[2 * t][qf][3]);
                    pw.z = pack2(S[2 * t + 1][qf][0], S[2 * t + 1][qf][1]); pw.w = pack2(S[2 * t + 1][qf][2], S[2 * t + 1][qf][3]); Pp[t][qf] = __builtin_bit_cast(bf16x8, pw); }
            }
#pragma unroll
            for (int t = 0; t < 4; ++t)
#pragma unroll
                for (int df = 0; df < 4; ++df) { const int d = 16 * df + fr;
                    const u32x2 v0 = *(const LAS u32x2*)(lds + vso + d * 256 + (((4 * t + (g >> 1)) ^ (d & 15)) << 4) + (g & 1) * 8);
                    const u32x2 v1 = *(const LAS u32x2*)(lds + vso + d * 256 + (((4 * t + 2 + (g >> 1)) ^ (d & 15)) << 4) + (g & 1) * 8);
                    u32x4 vw; vw.x = v0.x; vw.y = v0.y; vw.z = v1.x; vw.w = v1.y; const bf16x8 vf = __builtin_bit_cast(bf16x8, vw);
                    O[df][0] = __builtin_amdgcn_mfma_f32_16x16x32_bf16(vf, Pp[t][0], O[df][0], 0, 0, 0);
                    O[df][1] = __builtin_amdgcn_mfma_f32_16x16x32_bf16(vf, Pp[t][1], O[df][1], 0, 0, 0); }
            if (nxt < 0) break;
            cur = nxt; buf ^= 1;
        }
#pragma unroll
        for (int qf = 0; qf < 2; ++qf) {
            float lt = lsum[qf]; lt = xsum16(lt, lt); lt = xsum32(lt, lt);
            const float inv = 1.0f / lt;
            bf16_t* dst = CAT + (size_t)(row0 + qb + 16 * qf + fr) * D + 256 + h * 64 + 4 * g;
#pragma unroll
            for (int df = 0; df < 4; ++df) { u32x2 o; o.x = pack2(O[df][qf][0] * inv, O[df][qf][1] * inv); o.y = pack2(O[df][qf][2] * inv, O[df][qf][3] * inv); *(u32x2*)(dst + 16 * df) = o; }
        }
    }
#undef MX_KSRC
#undef MX_VSTAGE
    __syncthreads();
}

constexpr int FF_DA = 0, FF_DC = 32768, FF_XT = 49152  , FF_Z2 = 81920  , FF_OB = 114688  ;
__device__ __forceinline__ int ff_addr(int row, int k) { return row * 256 + ((((k >> 3) ^ (row & 15))) << 4) + (k & 7) * 2; }
__device__ __forceinline__ float cos_turns(float x) { return __builtin_amdgcn_cosf(x); }
__device__ __forceinline__ float sin_turns(float x) { return __builtin_amdgcn_sinf(x); }
__device__ __forceinline__ void fft_setup(LAS unsigned char* lds) {
    const int tid = tid_opaque();
    __syncthreads();
    for (int idx = tid; idx < 16384; idx += NT) { const int i = idx >> 7, k = idx & 127, ro = i >> 6, k1 = i & 63, part = k >> 6, n1 = k & 63; const float t = (float)((k1 * n1) & 63) * (1.0f / 64.0f);
        const float c = cos_turns(t), sn = sin_turns(t);
        const float v = (ro == 0) ? (part == 0 ? c : sn) : (part == 0 ? -sn : c);
        *(LAS bf16_t*)(lds + FF_DA + ff_addr(i, k)) = f2bf(v * 0.125f); }
    for (int idx = tid; idx < 8192; idx += NT) { const int k2 = idx >> 7, k = idx & 127, ri = k >> 6, n2 = k & 63; const float t = (float)((k2 * n2) & 63) * (1.0f / 64.0f);
        const float v = (ri == 0) ? cos_turns(t) : sin_turns(t);
        *(LAS bf16_t*)(lds + FF_DC + ff_addr(k2, k)) = f2bf(v * 0.125f); }
    __syncthreads();
}
__device__ __forceinline__ void fft_unit(AP a, LAS unsigned char* lds, int b, int cg) {
    const int tid = tid_opaque(), lane = tid & 63, w = __builtin_amdgcn_readfirstlane(tid >> 6), fr = lane & 15, g = lane >> 4;
    const int mf = w & 3, nh = w >> 2;
    const bf16_t* AT = (const bf16_t*)(a->ws + WS_AT) + (size_t)(b * 256 + cg * 4) * 8192;
    u32x4 xin[2][2];
#pragma unroll
    for (int h = 0; h < 2; ++h)
#pragma unroll
        for (int it = 0; it < 2; ++it) xin[h][it] = ld16g(AT + (size_t)h * 8192 + (size_t)(tid + 512 * it) * 8);
#pragma unroll 1
    for (int cp = 0; cp < 2; ++cp) {
#pragma unroll
        for (int h = 0; h < 2; ++h)
#pragma unroll
            for (int it = 0; it < 2; ++it) { const int q = tid + 512 * it, part = q >> 9, pos0 = (q & 511) * 8, n1 = pos0 >> 6, n2 = pos0 & 63, k = part * 64 + n1;
                const unsigned wv[4] = {xin[h][it].x, xin[h][it].y, xin[h][it].z, xin[h][it].w};
#pragma unroll
                for (int e = 0; e < 4; ++e) { *(LAS bf16_t*)(lds + FF_XT + h * 16384 + ff_addr(n2 + 2 * e, k)) = (bf16_t)(wv[e] & 0xffffu); *(LAS bf16_t*)(lds + FF_XT + h * 16384 + ff_addr(n2 + 2 * e + 1, k)) = (bf16_t)(wv[e] >> 16); } }
        if (cp == 0) {
#pragma unroll
            for (int h = 0; h < 2; ++h)
#pragma unroll
                for (int it = 0; it < 2; ++it) xin[h][it] = ld16g(AT + (size_t)(2 + h) * 8192 + (size_t)(tid + 512 * it) * 8); }
        __syncthreads();
        f32x4 acc[2][2][2];
#pragma unroll
        for (int h = 0; h < 2; ++h)
#pragma unroll
            for (int x = 0; x < 2; ++x) { acc[h][x][0] = (f32x4){0.f, 0.f, 0.f, 0.f}; acc[h][x][1] = (f32x4){0.f, 0.f, 0.f, 0.f}; }
#pragma unroll
        for (int ks = 0; ks < 4; ++ks) {
            bf16x8 af[2];
#pragma unroll
            for (int x = 0; x < 2; ++x) { const int i = 16 * (mf + 4 * x) + fr; af[x] = *(const LAS bf16x8*)(lds + FF_DA + i * 256 + (((4 * ks + g) ^ (i & 15)) << 4)); }
#pragma unroll
            for (int h = 0; h < 2; ++h)
#pragma unroll
                for (int n = 0; n < 2; ++n) { const int j = 16 * (2 * nh + n) + fr; const bf16x8 bfv = *(const LAS bf16x8*)(lds + FF_XT + h * 16384 + j * 256 + (((4 * ks + g) ^ (j & 15)) << 4));
                    acc[h][0][n] = __builtin_amdgcn_mfma_f32_16x16x32_bf16(af[0], bfv, acc[h][0][n], 0, 0, 0);
                    acc[h][1][n] = __builtin_amdgcn_mfma_f32_16x16x32_bf16(af[1], bfv, acc[h][1][n], 0, 0, 0); }
        }
#pragma unroll
        for (int n = 0; n < 2; ++n)
#pragma unroll
            for (int r = 0; r < 4; ++r) { const int k1 = 16 * mf + 4 * g + r, n2 = 16 * (2 * nh + n) + fr; const float t = (float)((k1 * n2) & 4095) * (1.0f / 4096.0f);
                const float c = cos_turns(t), sn = sin_turns(t);
#pragma unroll
                for (int h = 0; h < 2; ++h) { const float zr = acc[h][0][n][r], zi = acc[h][1][n][r];
                    *(LAS bf16_t*)(lds + FF_Z2 + h * 16384 + ff_addr(k1, n2)) = f2bf(zr * c + zi * sn);
                    *(LAS bf16_t*)(lds + FF_Z2 + h * 16384 + ff_addr(k1, 64 + n2)) = f2bf(zi * c - zr * sn); } }
        __syncthreads();
        f32x4 acc2[2][2];
#pragma unroll
        for (int h = 0; h < 2; ++h) { acc2[h][0] = (f32x4){0.f, 0.f, 0.f, 0.f}; acc2[h][1] = (f32x4){0.f, 0.f, 0.f, 0.f}; }
#pragma unroll
        for (int ks = 0; ks < 4; ++ks) {
            const int i = 16 * mf + fr; const bf16x8 af = *(const LAS bf16x8*)(lds + FF_DC + i * 256 + (((4 * ks + g) ^ (i & 15)) << 4));
#pragma unroll
            for (int h = 0; h < 2; ++h)
#pragma unroll
                for (int n = 0; n < 2; ++n) { const int j = 16 * (2 * nh + n) + fr; const bf16x8 bfv = *(const LAS bf16x8*)(lds + FF_Z2 + h * 16384 + j * 256 + (((4 * ks + g) ^ (j & 15)) << 4));
                    acc2[h][n] = __builtin_amdgcn_mfma_f32_16x16x32_bf16(af, bfv, acc2[h][n], 0, 0, 0); }
        }
#pragma unroll
        for (int n = 0; n < 2; ++n)
#pragma unroll
            for (int r = 0; r < 4; ++r) { const int k = 16 * (2 * nh + n) + fr + 64 * (16 * mf + 4 * g + r);
                *(LAS unsigned*)(lds + FF_OB + k * 8 + cp * 4) = pack2(acc2[0][n][r], acc2[1][n][r]); }
    }
    __syncthreads();
    bf16_t* CAT = (bf16_t*)(a->ws + WS_CAT) + (size_t)(b * 4096) * D + cg * 4;
#pragma unroll
    for (int it = 0; it < 8; ++it) { const int k = tid + 512 * it; *(u32x2*)(CAT + (size_t)k * D) = *(const LAS u32x2*)(lds + FF_OB + k * 8); }
    __syncthreads();
}

__device__ __forceinline__ void p2_mix(AP a, unsigned char* ldsg, LAS unsigned char* lds, int l) {
    const int n_tile = 128 + ((l == 0) ? 8 : 0), n_att = 2 * n_tile, n_dft = 256, n_dftc = (l == 0) ? 16 : 0;
    bf16_t* CAT = (bf16_t*)(a->ws + WS_CAT);
    bool fft_ready = false;
    const int n_units = n_att + n_dft + n_tile + n_dftc, G_ = (int)gridDim.x, n_mine = (n_units - (int)blockIdx.x + G_ - 1) / G_, rot = (int)((blockIdx.x >> 3) % 3u);
    for (int kk = 0; kk < n_mine; ++kk) { const int u = (int)blockIdx.x + ((kk + rot) % n_mine) * G_;
        if (u < n_att || (u >= n_att + n_dft && u < n_att + n_dft + n_tile)) {
            const bool att = u < n_att;
            const int t = att ? (u >> 1) : (u - n_att - n_dft);
            const bool isc = t >= 128; const int tt = t - 128;
            const int b = isc ? (tt >> 1) : (t >> 5);
            const int row0 = isc ? NLAT + tt * 128 : t * 128, seq_row0 = isc ? NLAT + b * 256 : b * 4096, pos0 = isc ? (tt & 1) * 128 : (t & 31) * 128, n = isc ? 256 : 4096;
            if (att) { for (int rep = 0; rep < PROBE_MIX_REP; ++rep) mixer_attn(a, lds, l, row0, seq_row0, pos0, n, b, isc, u & 1); }
            else { for (int rep = 0; rep < PROBE_SGU_REP; ++rep) mixer_sgu_pool(a, lds, l, row0, seq_row0, pos0, n); }
            fft_ready = false;
        } else if (u < n_att + n_dft) {
            const int uu = u - n_att;
            if (!fft_ready) { fft_setup(lds); fft_ready = true; }
            for (int rep = 0; rep < PROBE_FFT_REP; ++rep) fft_unit(a, lds, uu >> 6, uu & 63);
        } else {
            const int uu = u - n_att - n_dft - n_tile, b = uu >> 2, mt = (uu >> 1) & 1, ch0 = (uu & 1) * 128;
            const bf16_t* A = (const bf16_t*)(a->ws + WS_DFTC) + (size_t)(mt * 128) * 512;
            const bf16_t* B0 = (const bf16_t*)(a->ws + WS_ATC) + ((size_t)b * 256 + ch0) * 512;
            EpiBf16 E; E.C = CAT + (size_t)(NLAT + b * 256 + mt * 128) * D + ch0; E.ld = D; E.scale = 1.0f;
            gemm_tile<128, false, EpiBf16>(lds, A, 512, nullptr, 128, B0, B0 + (size_t)64 * 512, 512, 512, E);
            fft_ready = false;
        }
    }
    exp_queue(a, ldsg, l);
}

__device__ __forceinline__ int uni(int v) { return __builtin_amdgcn_readfirstlane(v); }
__device__ __forceinline__ int vblock() { const int G = gridDim.x, b = blockIdx.x; return (G % 8 == 0) ? (b % 8) * (G / 8) + b / 8 : b; }
template <class T> __device__ __forceinline__ T* unip(T* p) { const unsigned long long v = (unsigned long long)p; const unsigned lo = __builtin_amdgcn_readfirstlane((unsigned)v), hi = __builtin_amdgcn_readfirstlane((unsigned)(v >> 32)); return (T*)(((unsigned long long)hi << 32) | lo); }
struct SchedInProj {
    typedef EpiInProj Epi; static constexpr bool GATHER = false, FP8 = false, SIGNAL = false, WAITDEP = false, ILV8 = false; unsigned* dep;
    unsigned char* ws; int l, G, me;
    __device__ __forceinline__ bool get(int i, g256::Unit<Epi>& u) const {
        const int n_lat = 64 * 7, n_ctx = (l == 0) ? 4 * 7 : 4;
        const int idx = i * G + me; if (idx >= n_lat + n_ctx) return false;
        int row0, b, ct, n; bf16_t *tF, *tV;
        if (idx < n_lat) { const int rt = idx / 7; ct = idx % 7; row0 = rt * 256; b = row0 >> 12; n = 4096;
            tF = (bf16_t*)(ws + WS_AT) + (size_t)b * 256 * 2 * 4096; tV = (bf16_t*)(ws + WS_VT) + (size_t)b * 128 * 4096; }
        else { const int uu = idx - n_lat; int rt; if (l == 0) { rt = uu / 7; ct = uu % 7; } else { rt = uu; ct = 3; }
            row0 = NLAT + rt * 256; b = rt; n = 256;
            tF = (bf16_t*)(ws + WS_ATC) + (size_t)b * 256 * 2 * 256; tV = (bf16_t*)(ws + WS_VTC) + (size_t)b * 128 * 256; }
        u.A = (const bf16_t*)(ws + WS_H) + (size_t)row0 * D;
        u.B0 = (const bf16_t*)(ws + WS_WIN) + ((size_t)l * ZC + ct * 256) * 1024; u.B1 = u.B0 + (size_t)128 * 1024; u.ridx = nullptr; u.valid = 256;
        u.epi.Zt = (bf16_t*)(ws + WS_Z) + (size_t)row0 * ZC + ct * 256; u.epi.tF = tF; u.epi.tV = tV; u.epi.n0 = ct * 256; u.epi.pos0 = (idx < n_lat) ? (row0 & 4095) : 0; u.epi.n = n;
        return true;
    }
};
struct SchedOutProj {
    typedef EpiBf16 Epi; static constexpr bool GATHER = false, FP8 = false, SIGNAL = false, WAITDEP = false, ILV8 = false; unsigned* dep;
    unsigned char* ws; int l, G, me;
    __device__ __forceinline__ bool get(int i, g256::Unit<Epi>& u) const {
        const int nrt = NLAT / 256;
        const int idx = i * G + me; if (idx >= nrt * 4) return false;
        const int rt = idx >> 2, ct = idx & 3;
        u.A = (const bf16_t*)(ws + WS_CAT) + (size_t)(rt * 256) * D;
        u.B0 = (const bf16_t*)(ws + WS_WOUT) + ((size_t)l * 1024 + ct * 256) * 1024; u.B1 = u.B0 + (size_t)128 * 1024; u.ridx = nullptr; u.valid = 256;
        u.epi.C = (bf16_t*)(ws + WS_Y) + (size_t)(rt * 256) * D + ct * 256; u.epi.ld = D; u.epi.scale = 1.0f;
        return true;
    }
};
__device__ __forceinline__ void moe_units(const LAS int* blk, LAS int* uinf, int G, int me) {
    const int i = threadIdx.x;
    if (i < 8) { const int idx = i * G + me, nu = blk[32] * 4; int e = 0, valid = 0;
        if (idx < nu) { const int rb = idx >> 2; for (int q = 1; q < 32; ++q) if (blk[q] <= rb) e = q; valid = min(256, blk[33 + e] - (rb - blk[e]) * 256); }
        uinf[2 * i] = e; uinf[2 * i + 1] = valid; }
    __syncthreads();
}
struct SchedGateUp {
    typedef EpiGateUp8 Epi; static constexpr bool GATHER = true, FP8 = true, SIGNAL = true, WAITDEP = false, ILV8 = false; unsigned* dep;
    unsigned char* ws; const LAS int* uinf; const LAS int* ridx_lds; int G, me, l, nu;
    __device__ __forceinline__ bool get(int i, g256::Unit<Epi>& u) const {
        const int idx = i * G + me; if (idx >= nu) return false;
        const int rb = idx >> 2, ct = idx & 3, e = uni(uinf[2 * i]);
        u.A = (const bf16_t*)(ws + WS_H8);
        { const unsigned char* b0 = ws + WS_WEXP + (size_t)l * WEXP_LAYER + ((size_t)e * 512 + ct * 128) * 1024; u.B0 = (const bf16_t*)b0; u.B1 = (const bf16_t*)(b0 + EXPMAT); }
        u.ridx = ridx_lds + (i & 7) * 256; u.valid = uni(uinf[2 * i + 1]);
        u.epi.C = ws + WS_HID + (size_t)(rb * 256) * DEXP + ct * 128; u.epi.ld = DEXP; u.tag = rb;
        return true;
    }
};
struct SchedDown {
    typedef EpiFp8I Epi; static constexpr bool GATHER = false, FP8 = true, SIGNAL = false, WAITDEP = true, ILV8 = true; unsigned* dep;
    unsigned char* ws; const LAS int* uinf; int G, me, l, nu;
    __device__ __forceinline__ bool get(int i, g256::Unit<Epi>& u) const {
        const int idx = i * G + me; if (idx >= nu) return false;
        const int rb = idx >> 2, ct = idx & 3, e = uni(uinf[2 * i]);
        u.A = (const bf16_t*)(ws + WS_HID + (size_t)(rb * 256) * DEXP);
        { const unsigned char* b0 = ws + WS_WEXP + (size_t)l * WEXP_LAYER + 2 * EXPMAT + ((size_t)e * 1024 + ct * 256) * 512; u.B0 = (const bf16_t*)b0; u.B1 = (const bf16_t*)(b0 + (size_t)8 * 512); } u.ridx = nullptr; u.valid = 256;
        u.epi.C = ws + WS_YS + (size_t)(rb * 256) * D + ct * 256; u.epi.ld = D; u.epi.scale = 1.0f / 32.0f; u.tag = rb;
        return true;
    }
};

__device__ __forceinline__ void router_preload(AP a, unsigned char* lds, int l) {
    const int tid = tid_opaque();
    f32x4* Lg = (f32x4*)lds; f32x4* Le = (f32x4*)(lds + 16384); f32x4* Lgb = (f32x4*)(lds + 147456);
    const float* wrg_ = a->in[16] + (size_t)l * 1024 * 4; const float* wre_ = a->in[17] + (size_t)l * 1024 * 32;
    __syncthreads();
#pragma unroll
    for (int it = 0; it < 2; ++it) { const int c = tid + 512 * it, slot = (((c >> 8) * 4 + (c & 3)) << 6) + ((c >> 2) & 63);
        Lg[slot] = *(const f32x4*)(wrg_ + (size_t)c * 4);
#pragma unroll
        for (int q = 0; q < 8; ++q) Le[q * 1024 + slot] = *(const f32x4*)(wre_ + (size_t)c * 32 + q * 4); }
    Lgb[tid] = (tid < 256) ? *(const f32x4*)(a->in[14] + l * 1024 + tid * 4) : *(const f32x4*)(a->in[15] + l * 1024 + (tid - 256) * 4);
    __syncthreads();
}

template <int l> __device__ __forceinline__ void p4_ln1_router(AP a, unsigned char* lds) {
    const int tid = tid_opaque(), lane = tid & 63, w = tid >> 6;
    const int ntok = (l == 0) ? NTOK : NLAT;
    int* cnt = (int*)(lds + MISC_OFF);
    if (tid < 32) cnt[tid] = 0;
    f32x4* Lg = (f32x4*)lds; f32x4* Le = (f32x4*)(lds + 16384); f32x4* Lgb = (f32x4*)(lds + 147456);
    __syncthreads();
    const float* mod = (const float*)(a->ws + WS_MOD) + (size_t)l * 5 * 6144;
    const bf16_t* Y = (const bf16_t*)(a->ws + WS_Y);
    bf16_t* X1 = (bf16_t*)(a->ws + WS_X1);
    unsigned char* H8 = a->ws + WS_H8;
    int* tokE = (int*)(a->ws + WS_TOKE); int* tokR = (int*)(a->ws + WS_TOKR); float* tokG = (float*)(a->ws + WS_TOKG);
    const WaveToks wt(__builtin_amdgcn_readfirstlane(blockIdx.x * 8 + w), gridDim.x * 8, l == 0);
    f32x4 nx[4]; u32x2 nxb[4], ny[4];
    const bf16_t* XC = (const bf16_t*)(a->ws + WS_XC);
    {   const int t = wt.tok(0);
        if (t >= 0) { const float* xs = (t < NLAT) ? a->in[0] + (size_t)t * D : a->in[2] + (size_t)(t - NLAT) * D;
#pragma unroll
            for (int i = 0; i < 4; ++i) { if (l == 0) nx[i] = __builtin_nontemporal_load((const f32x4*)(xs + 256 * i + 4 * lane)); else nxb[i] = __builtin_nontemporal_load((const u32x2*)(XC + (size_t)t * D + 256 * i + 4 * lane));
                ny[i] = __builtin_nontemporal_load((const u32x2*)(Y + (size_t)t * D + 256 * i + 4 * lane)); } } }
    f32x4 mg[4], msh[4], msc[4];
    {   const float* m = mod + (size_t)wt.mrow() * 6144;
#pragma unroll
        for (int i = 0; i < 4; ++i) { const int c = 256 * i + 4 * lane; mg[i] = *(const f32x4*)(m + 2048 + c); msh[i] = *(const f32x4*)(m + 3072 + c); msc[i] = *(const f32x4*)(m + 4096 + c); } }
    int t = wt.tok(0);
    for (int k = 0; t >= 0; ++k) { const int tn = wt.tok(k + 1);
        f32x4 v[4];
#pragma unroll
        for (int i = 0; i < 4; ++i) { const f32x4 yv = (f32x4){lo2f(ny[i].x), hi2f(ny[i].x), lo2f(ny[i].y), hi2f(ny[i].y)};
            const f32x4 xv = (l == 0) ? nx[i] : (f32x4){lo2f(nxb[i].x), hi2f(nxb[i].x), lo2f(nxb[i].y), hi2f(nxb[i].y)};
#pragma unroll
            for (int e = 0; e < 4; ++e) v[i][e] = RES_ALPHA * xv[e] + mg[i][e] * yv[e]; }
        {
            if (tn >= 0) { const float* xs = (tn < NLAT) ? a->in[0] + (size_t)tn * D : a->in[2] + (size_t)(tn - NLAT) * D;
#pragma unroll
                for (int i = 0; i < 4; ++i) { if (l == 0) nx[i] = __builtin_nontemporal_load((const f32x4*)(xs + 256 * i + 4 * lane)); else nxb[i] = __builtin_nontemporal_load((const u32x2*)(XC + (size_t)tn * D + 256 * i + 4 * lane));
                    ny[i] = __builtin_nontemporal_load((const u32x2*)(Y + (size_t)tn * D + 256 * i + 4 * lane)); } } }
        float mean, rstd; ln_stats(v, mean, rstd);
#pragma unroll
        for (int i = 0; i < 4; ++i) { const int c = 256 * i + 4 * lane; const f32x4 gg = Lgb[64 * i + lane], bb = Lgb[256 + 64 * i + lane];
#pragma unroll
            for (int e = 0; e < 4; ++e) v[i][e] = (v[i][e] - mean) * rstd * gg[e] + bb[e];
            { u32x2 pk; pk.x = pack2(v[i][0], v[i][1]); pk.y = pack2(v[i][2], v[i][3]); *(u32x2*)(X1 + (size_t)t * D + c) = pk; } }
        ln_stats(v, mean, rstd);
#pragma unroll
        for (int i = 0; i < 4; ++i) { const int c = 256 * i + 4 * lane; const f32x4 sh = msh[i], sc = msc[i];
#pragma unroll
            for (int e = 0; e < 4; ++e) v[i][e] = (v[i][e] - mean) * rstd * (1.0f + sc[e]) + sh[e];
            *(unsigned*)(H8 + (size_t)t * D + c) = pack4_fp8(v[i][0], v[i][1], v[i][2], v[i][3]); }
        f32x2 lg01 = (f32x2){0.f, 0.f}, lg23 = (f32x2){0.f, 0.f};
#pragma unroll
        for (int i = 0; i < 4; ++i)
#pragma unroll
            for (int e = 0; e < 4; ++e) { const f32x4 wv = Lg[((i * 4 + e) << 6) + lane]; const f32x2 vv = (f32x2){v[i][e], v[i][e]};
                lg01 += vv * (f32x2){wv[0], wv[1]}; lg23 += vv * (f32x2){wv[2], wv[3]}; }
        float lg[4]; wave_sum4(lg01[0], lg01[1], lg23[0], lg23[1], lg);
        int grp = 0; float mx = lg[0];
#pragma unroll
        for (int q = 1; q < 4; ++q) if (lg[q] > mx) { mx = lg[q]; grp = q; }
        float se = 0.f;
#pragma unroll
        for (int q = 0; q < 4; ++q) se += __expf(lg[q] - mx);
        const float gate_group = __builtin_amdgcn_rcpf(se);
        f32x2 le01 = (f32x2){0.f, 0.f}, le23 = (f32x2){0.f, 0.f}, le45 = (f32x2){0.f, 0.f}, le67 = (f32x2){0.f, 0.f};
#pragma unroll
        for (int i = 0; i < 4; ++i)
#pragma unroll
            for (int e = 0; e < 4; ++e) { const f32x4* wp = Le + grp * 2048 + ((i * 4 + e) << 6) + lane; const f32x4 w0 = wp[0], w1 = wp[1024]; const f32x2 vv = (f32x2){v[i][e], v[i][e]};
                le01 += vv * (f32x2){w0[0], w0[1]}; le23 += vv * (f32x2){w0[2], w0[3]}; le45 += vv * (f32x2){w1[0], w1[1]}; le67 += vv * (f32x2){w1[2], w1[3]}; }
        float le[8]; { const float lp[8] = {le01[0], le01[1], le23[0], le23[1], le45[0], le45[1], le67[0], le67[1]}; wave_sum8(lp, lane, le); }
        int j1 = 0; float l1 = le[0];
#pragma unroll
        for (int q = 1; q < 8; ++q) if (le[q] > l1) { l1 = le[q]; j1 = q; }
        int j2 = -1; float l2 = -3.0e38f;
#pragma unroll
        for (int q = 0; q < 8; ++q) if (q != j1 && le[q] > l2) { l2 = le[q]; j2 = q; }
        const float e2 = __expf(l2 - l1), p1 = __builtin_amdgcn_rcpf(1.0f + e2), p2 = e2 * p1;
        if (lane == 0) {
            const int ex0 = grp * 8 + j1, ex1 = grp * 8 + j2;
            const int r0 = atomicAdd(&cnt[ex0], 1), r1 = atomicAdd(&cnt[ex1], 1);
            tokE[2 * t] = ex0; tokE[2 * t + 1] = ex1; tokR[2 * t] = r0; tokR[2 * t + 1] = r1;
            tokG[2 * t] = gate_group * p1; tokG[2 * t + 1] = gate_group * p2;
        }
        t = tn;
    }
    __syncthreads();
    if (tid < 32) { const int c = cnt[tid]; int off = 0; if (c > 0) off = (int)__hip_atomic_fetch_add((unsigned*)(a->ws + WS_BCNT) + (l * 32 + tid) * 64, (unsigned)c, __ATOMIC_RELAXED, __HIP_MEMORY_SCOPE_AGENT);
        ((int*)(lds + MISC_OFF + 128))[tid] = off; }
    __syncthreads();
}

__device__ __forceinline__ void p5_dispatch(AP a, unsigned char* lds, int l) {
    const int tid = tid_opaque();
    const int ntok = (l == 0) ? NTOK : NLAT;
    int* part = (int*)lds;
    int* tot = (int*)(lds + 4096);
    int* off = (int*)(lds + 4096 + 128);
    int* pstart = (int*)(lds + 4096 + 256);
    const int G = gridDim.x, me = blockIdx.x;
    (void)part;
    if (tid < 32) { tot[tid] = ((const int*)(a->ws + WS_BCNT))[(l * 32 + tid) * 64]; off[tid] = ((const int*)(lds + MISC_OFF + 128))[tid]; }
    __syncthreads();
    if (tid < 64) { const int c = (tid < 32) ? tot[tid] : 0, pad = ((c + 255) >> 8) << 8; int incl = pad;
#pragma unroll
        for (int d = 1; d < 32; d <<= 1) { const int t = __shfl_up(incl, d); if (tid >= d) incl += t; }
        if (tid < 32) pstart[tid] = incl - pad;
        int* blk = (int*)(lds + MISC_OFF + 256);
        if (tid < 32) { blk[33 + tid] = c; blk[tid] = (incl - pad) >> 8; }
        if (tid == 31) blk[32] = incl >> 8; }
    __syncthreads();
    if (me == 0 && tid < 32) ((int*)(a->ws + WS_CNT))[l * 32 + tid] = tot[tid];
    const int* tokE = (const int*)(a->ws + WS_TOKE); const int* tokR = (const int*)(a->ws + WS_TOKR);
    int* tokS = (int*)(a->ws + WS_TOKS); int* slotT = (int*)(a->ws + WS_SLOTT);
    const WaveToks wt(me * 8 + ((tid & 15) >> 1), G * 8, l == 0);
    for (int q = tid; ; q += NT) { const int it = q >> 4, j = q & 15, t = wt.tok(it); if (t < 0) break;
        const int idx = 2 * t + (j & 1); const int e = tokE[idx]; const int slot = pstart[e] + off[e] + tokR[idx]; tokS[idx] = slot; slotT[slot] = t; }
    __syncthreads();
}

__device__ __forceinline__ void moe_table(AP a, int l, LAS int* blk) {
    const int* tot = (const int*)(a->ws + WS_CNT) + l * 32;
    __syncthreads();
    if (threadIdx.x < 64) {
        const int lane = threadIdx.x, c = (lane < 32) ? tot[lane] : 0, nb = (c + 255) >> 8; int incl = nb;
#pragma unroll
        for (int d = 1; d < 32; d <<= 1) { const int t = __shfl_up(incl, d); if (lane >= d) incl += t; }
        if (lane < 32) { blk[33 + lane] = c; blk[lane] = incl - nb; }
        if (lane == 31) blk[32] = incl;
    }
    __syncthreads();
}
__device__ __forceinline__ int units_of(int nu, int v, int G) { return (v < nu) ? (nu - v + G - 1) / G : 0; }
__device__ __forceinline__ void p1_inproj(AP a, unsigned char* smem, LAS unsigned char* lds, int l) {
    SchedInProj S; S.ws = a->ws; S.l = l; S.G = gridDim.x; S.me = vblock();
    g256::gemm_phase(lds, 1024, S);
    { const int nu = (l == 0) ? 64 * 7 + 4 * 7 : 64 * 7 + 4, G = gridDim.x; if (units_of(nu, S.me, G) < (nu + G - 1) / G) exp_fill(a, smem, l, 8); }
}
__device__ __forceinline__ void p3_outproj(AP a, unsigned char* smem, LAS unsigned char* lds, int l) {
    SchedOutProj S; S.ws = a->ws; S.l = l; S.G = gridDim.x; S.me = vblock();
    g256::gemm_phase(lds, 1024, S);
    if (l == 0) {
        const bf16_t* W = (const bf16_t*)(a->ws + WS_WOUT);
        for (int u = blockIdx.x; u < 64; u += gridDim.x) { const int rt = u >> 3, ct = u & 7;
            EpiBf16 E; E.C = (bf16_t*)(a->ws + WS_Y) + (size_t)(NLAT + rt * 128) * D + ct * 128; E.ld = D; E.scale = 1.0f;
            const bf16_t* B0 = W + (size_t)(ct * 128) * 1024;
            gemm_tile<128, false, EpiBf16>(lds, (const bf16_t*)(a->ws + WS_CAT) + (size_t)(NLAT + rt * 128) * D, D, nullptr, 128, B0, B0 + (size_t)64 * 1024, 1024, 1024, E); }
    }
    router_preload(a, smem, l);
}
__device__ __forceinline__ void p6_gateup(AP a, unsigned char* smem, LAS unsigned char* lds, int l) {
    LAS int* blk = (LAS int*)(lds + MISC_OFF + 256);
    LAS int* ridx = (LAS int*)(lds + RIDX_OFF);
    const int tid = tid_opaque(), G = gridDim.x, me = vblock(), nu = uni(blk[32]) * 4;
    LAS int* uinf = (LAS int*)(lds + MISC_OFF + 528);
    moe_units(blk, uinf, G, me);
    const int* slotT = (const int*)(a->ws + WS_SLOTT);
    for (int i = 0; i < 8; ++i) { const int idx = i * G + me; if (idx >= nu) break;
        const int rb = idx >> 2, valid = uinf[2 * i + 1];
        if (tid < 256) ridx[i * 256 + tid] = (tid < valid) ? slotT[rb * 256 + tid] : 0; }
    __syncthreads();
    SchedGateUp S; S.ws = a->ws; S.uinf = uinf; S.ridx_lds = ridx; S.G = G; S.me = me; S.l = l; S.nu = nu; S.dep = (unsigned*)(a->ws + WS_BAR + 14336 + 512) + l * 192;
    g256::gemm_phase(lds, 512, S);
    __syncthreads();
}
__device__ __forceinline__ void p7_down(AP a, unsigned char* smem, LAS unsigned char* lds, int l) {
    LAS int* blk = (LAS int*)(lds + MISC_OFF + 256);
    LAS int* uinf = (LAS int*)(lds + MISC_OFF + 528);
    SchedDown S; S.ws = a->ws; S.uinf = uinf; S.G = gridDim.x; S.me = (int)gridDim.x - 1 - vblock(); S.l = l; S.nu = uni(blk[32]) * 4; S.dep = (unsigned*)(a->ws + WS_BAR + 14336 + 512) + l * 192;
    moe_units(blk, uinf, S.G, S.me);
    g256::gemm_phase(lds, 256, S);
    __syncthreads();
    { const int nu = S.nu, G = gridDim.x; if (l == 0 && units_of(nu, vblock(), G) < (nu + G - 1) / G) exp_fill(a, smem, 1, 0); }
}

template <int l> __device__ __forceinline__ void p8_ln2(AP a, unsigned char* lds) {
    const int tid = tid_opaque(), lane = tid & 63, w = tid >> 6;
    const int ntok = (l == 0) ? NTOK : NLAT;
    const float* mod = (const float*)(a->ws + WS_MOD) + (size_t)l * 5 * 6144;
    const float* modn = (const float*)(a->ws + WS_MOD) + (size_t)5 * 6144;
    const bf16_t* X1 = (const bf16_t*)(a->ws + WS_X1);
    const unsigned char* YS = a->ws + WS_YS;
    const int* tokS = (const int*)(a->ws + WS_TOKS); const float* tokG = (const float*)(a->ws + WS_TOKG);
    f32x4* Lgb = (f32x4*)lds;
    __syncthreads();
    Lgb[tid] = (tid < 256) ? *(const f32x4*)(a->in[21] + l * 1024 + tid * 4) : *(const f32x4*)(a->in[22] + l * 1024 + (tid - 256) * 4);
    __syncthreads();
    f32x4 mg[4], nsh[4], nsc[4];
    const WaveToks wt(__builtin_amdgcn_readfirstlane(blockIdx.x * 8 + w), gridDim.x * 8, l == 0);
    {   const float* m = mod + (size_t)wt.mrow() * 6144; const float* mn = modn + (size_t)wt.mrow() * 6144;
#pragma unroll
        for (int i = 0; i < 4; ++i) { const int c = 256 * i + 4 * lane; mg[i] = *(const f32x4*)(m + 5120 + c); if (l == 0) { nsh[i] = *(const f32x4*)(mn + c); nsc[i] = *(const f32x4*)(mn + 1024 + c); } } }
    int t = wt.tok(0);
    int ns0 = 0, ns1 = 0; float nga = 0.f, ngb = 0.f;
    u32x2 nx[4]; unsigned nya[4], nyb[4];
    float cga = 0.f, cgb = 0.f;
    if (t >= 0) { const int s0 = tokS[2 * t], s1 = tokS[2 * t + 1]; cga = tokG[2 * t]; cgb = tokG[2 * t + 1];
#pragma unroll
        for (int i = 0; i < 4; ++i) { const int c = 256 * i + 4 * lane; nx[i] = __builtin_nontemporal_load((const u32x2*)(X1 + (size_t)t * D + c)); nya[i] = __builtin_nontemporal_load((const unsigned*)(YS + (size_t)s0 * D + c)); nyb[i] = __builtin_nontemporal_load((const unsigned*)(YS + (size_t)s1 * D + c)); } }
    { const int t1 = wt.tok(1); if (t1 >= 0) { ns0 = tokS[2 * t1]; ns1 = tokS[2 * t1 + 1]; nga = tokG[2 * t1]; ngb = tokG[2 * t1 + 1]; } }
    for (int k = 0; t >= 0; ++k) {
        f32x4 v[4];
#pragma unroll
        for (int i = 0; i < 4; ++i) { const f32x4 gv = mg[i];
            const f32x2 ya0 = __builtin_amdgcn_cvt_pk_f32_fp8(nya[i], false), ya1 = __builtin_amdgcn_cvt_pk_f32_fp8(nya[i], true), yb0 = __builtin_amdgcn_cvt_pk_f32_fp8(nyb[i], false), yb1 = __builtin_amdgcn_cvt_pk_f32_fp8(nyb[i], true);
            const float f0 = cga * ya0[0] + cgb * yb0[0], f1 = cga * ya0[1] + cgb * yb0[1], f2 = cga * ya1[0] + cgb * yb1[0], f3 = cga * ya1[1] + cgb * yb1[1];
            v[i][0] = RES_ALPHA * lo2f(nx[i].x) + gv[0] * f0; v[i][1] = RES_ALPHA * hi2f(nx[i].x) + gv[1] * f1; v[i][2] = RES_ALPHA * lo2f(nx[i].y) + gv[2] * f2; v[i][3] = RES_ALPHA * hi2f(nx[i].y) + gv[3] * f3; }
        const int tn = wt.tok(k + 1), tn2 = wt.tok(k + 2);
        {   if (tn >= 0) {
#pragma unroll
                for (int i = 0; i < 4; ++i) { const int c = 256 * i + 4 * lane; nx[i] = __builtin_nontemporal_load((const u32x2*)(X1 + (size_t)tn * D + c)); nya[i] = __builtin_nontemporal_load((const unsigned*)(YS + (size_t)ns0 * D + c)); nyb[i] = __builtin_nontemporal_load((const unsigned*)(YS + (size_t)ns1 * D + c)); }
                cga = nga; cgb = ngb; }
            if (tn2 >= 0) { ns0 = tokS[2 * tn2]; ns1 = tokS[2 * tn2 + 1]; nga = tokG[2 * tn2]; ngb = tokG[2 * tn2 + 1]; } }
        float mean, rstd; ln_stats(v, mean, rstd);
#pragma unroll
        for (int i = 0; i < 4; ++i) { const int c = 256 * i + 4 * lane; const f32x4 gg = Lgb[64 * i + lane], bb = Lgb[256 + 64 * i + lane];
#pragma unroll
            for (int e = 0; e < 4; ++e) v[i][e] = (v[i][e] - mean) * rstd * gg[e] + bb[e];
            if (l == 0) { u32x2 pk; pk.x = pack2(v[i][0], v[i][1]); pk.y = pack2(v[i][2], v[i][3]); *(u32x2*)((bf16_t*)(a->ws + WS_XC) + (size_t)t * D + c) = pk; }
            else __builtin_nontemporal_store(v[i], (f32x4*)(a->out + (size_t)t * D + c)); }
        if (l == 0) {
            ln_stats(v, mean, rstd);
            bf16_t* H = (bf16_t*)(a->ws + WS_H);
#pragma unroll
            for (int i = 0; i < 4; ++i) { const int c = 256 * i + 4 * lane; const f32x4 sh = nsh[i], sc = nsc[i];
                f32x4 o;
#pragma unroll
                for (int e = 0; e < 4; ++e) o[e] = (v[i][e] - mean) * rstd * (1.0f + sc[e]) + sh[e];
                u32x2 pk; pk.x = pack2(o[0], o[1]); pk.y = pack2(o[2], o[3]); *(u32x2*)(H + (size_t)t * D + c) = pk; }
        }
        t = tn;
    }
}

constexpr int N_PHASES = 18;
template <int P> __device__ __forceinline__ void run_phase(AP a, unsigned char* smem, LAS unsigned char* lds, int l) {
    asm volatile("" : "+s"(a));
    if (P == 0) p0_prologue(a, smem);
    if (P == 1) p_lnmod0(a);
    if (P == 2) p1_inproj(a, smem, lds, l);
    if (P == 3) p2_mix(a, smem, lds, l);
    if (P == 4) p3_outproj(a, smem, lds, l);
    if (P == 5) { if (l == 0) p4_ln1_router<0>(a, smem); else p4_ln1_router<1>(a, smem); }
    if (P == 6) p5_dispatch(a, smem, l);
    if (P == 7) p6_gateup(a, smem, lds, l);
    if (P == 8) p7_down(a, smem, lds, l);
    if (P == 9) { if (l == 0) p8_ln2<0>(a, smem); else p8_ln2<1>(a, smem); }
}
#if N_LAUNCH_MODE == 1
__global__ void __launch_bounds__(NT, 2) fwd(Args a) {
    extern __shared__ __attribute__((aligned(16))) unsigned char smem[];
    LAS unsigned char* lds = (LAS unsigned char*)smem;
    if (threadIdx.x < 4) ((volatile LAS unsigned*)(lds + MISC_OFF + 768))[threadIdx.x] = 0u;
    __syncthreads();
    XcdBarrier bar = xcd_barrier_post((unsigned*)(a.ws + WS_BAR), (volatile LAS unsigned*)(lds + MISC_OFF + 768));
    AP ap = (AP)__builtin_amdgcn_kernarg_segment_ptr();
#define PROBE(P, l) do { if (PROBE_MASK & (1 << (P))) { for (int _r = 0; _r < 2; ++_r) { xcd_barrier(bar); run_phase<P>(ap, smem, lds, l); } } } while (0)
    run_phase<0>(ap, smem, lds, 0); PROBE(0, 0); xcd_barrier(bar);
    run_phase<1>(ap, smem, lds, 0); PROBE(1, 0); xcd_barrier(bar);
    for (int l = 0; l < 2; ++l) {
        run_phase<2>(ap, smem, lds, l); PROBE(2, l); xcd_barrier(bar);
        run_phase<3>(ap, smem, lds, l); PROBE(3, l); xcd_barrier(bar);
        run_phase<4>(ap, smem, lds, l); PROBE(4, l); xcd_barrier(bar);
        run_phase<5>(ap, smem, lds, l); PROBE(5, l); xcd_barrier(bar);
        run_phase<6>(ap, smem, lds, l); PROBE(6, l); xcd_barrier(bar);
        run_phase<7>(ap, smem, lds, l); PROBE(7, l);
        run_phase<8>(ap, smem, lds, l); PROBE(8, l); xcd_barrier(bar);
        run_phase<9>(ap, smem, lds, l); PROBE(9, l); if (l == 0) xcd_barrier(bar);
    }
}
#else
template <int P> __global__ void __launch_bounds__(NT, 2) k_phase(Args a) {
    extern __shared__ __attribute__((aligned(16))) unsigned char smem[];
    LAS unsigned char* lds = (LAS unsigned char*)smem;
    AP ap = (AP)__builtin_amdgcn_kernarg_segment_ptr();
    run_phase<P>(ap, smem, lds, ap->ph_lo);
}
template <int P> static void launch_phase(Args a, int l, int grid, hipStream_t stream) {
    static bool attr = false;
    if (!attr) { (void)hipFuncSetAttribute((const void*)k_phase<P>, hipFuncAttributeMaxDynamicSharedMemorySize, LDS_BYTES); attr = true; }
    a.ph_lo = l; a.ph_hi = P;
    hipLaunchKernelGGL(k_phase<P>, dim3(grid), dim3(NT), LDS_BYTES, stream, a);
}
#endif

extern "C" void kernel_launch(void* const* d_in, const int* in_sizes, int n_in, void* d_out, int out_size, void* d_ws, size_t ws_size, hipStream_t stream) {
    static int grid = 0;
    if (grid == 0) {
        if (n_in != 23 || out_size != NLAT * D || ws_size < WS_END) { fprintf(stderr, "kernel_launch: unexpected shapes (n_in %d, out %d, ws %zu, need %zu)\n", n_in, out_size, ws_size, (size_t)WS_END); grid = -1; return; }
        int dev = 0, cus = 0;
        if (hipGetDevice(&dev) != hipSuccess || hipDeviceGetAttribute(&cus, hipDeviceAttributeMultiprocessorCount, dev) != hipSuccess) { grid = -1; return; }
#if N_LAUNCH_MODE == 1
        int per_cu = 0;
        if (hipFuncSetAttribute((const void*)fwd, hipFuncAttributeMaxDynamicSharedMemorySize, LDS_BYTES) != hipSuccess) { fprintf(stderr, "kernel_launch: hipFuncSetAttribute failed\n"); grid = -1; return; }
        if (hipOccupancyMaxActiveBlocksPerMultiprocessor(&per_cu, (const void*)fwd, NT, LDS_BYTES) != hipSuccess || per_cu < 1) { fprintf(stderr, "kernel_launch: occupancy query says %d\n", per_cu); }
        (void)hipGetLastError();
#endif
        grid = cus; if (grid > MAXG) grid = MAXG;
    }
    if (grid < 0) return;
    (void)hipMemsetAsync((char*)d_ws + WS_BAR, 0, WS_BCNT + 2 * 32 * 256, stream);
    Args a{};
    for (int i = 0; i < 23; ++i) a.in[i] = (const float*)d_in[i];
    a.out = (float*)d_out; a.ws = (unsigned char*)d_ws;
#if N_LAUNCH_MODE == 1
    a.ph_lo = 0; a.ph_hi = N_PHASES;
    hipLaunchKernelGGL(fwd, dim3(grid), dim3(NT), LDS_BYTES, stream, a);
#else
    launch_phase<0>(a, 0, grid, stream);
    launch_phase<1>(a, 0, grid, stream);
    for (int l = 0; l < 2; ++l) {
        launch_phase<2>(a, l, grid, stream); launch_phase<3>(a, l, grid, stream); launch_phase<4>(a, l, grid, stream); launch_phase<5>(a, l, grid, stream);
        launch_phase<6>(a, l, grid, stream); launch_phase<7>(a, l, grid, stream); launch_phase<8>(a, l, grid, stream); launch_phase<9>(a, l, grid, stream);
    }
#endif
}
```
